# Optimizing an MI355X kernel written in HIP

```python
import math
import jax, jax.numpy as jnp
from jax import lax
import numpy as np

D_MODEL = 2048
BATCH = 1
SEQ = 16384
DEPTH = 1

N_MEM = 256
D_MIX = D_MODEL
D_CONV = 3 * D_MIX // 8
D_POOL = 3 * D_MIX // 8
D_XATT = D_MIX // 4
CONV_HEAD_DIM = 128
CONV_HEADS = D_CONV // CONV_HEAD_DIM
CONV_WIDTH = 3
POOL_WINDOWS = (2, 4, 8, 16)
POOL_GROUPS = len(POOL_WINDOWS)
POOL_GROUP_DIM = D_POOL // POOL_GROUPS
XATT_HEADS = 4
XATT_HEAD_DIM = D_XATT // XATT_HEADS
D_FF = ((8 * D_MODEL // 3 + 255) // 256) * 256
FFN_CONV_WIDTH = 3
D_IN = 3 * D_CONV + D_POOL + D_XATT
EPS = 1e-6

kernel_name = "hybrid_conv_pool_memxattn_block"


def rmsnorm(x, g):
    xf = x.astype(jnp.float32)
    y = xf * lax.rsqrt(jnp.mean(xf * xf, axis=-1, keepdims=True) + EPS)
    return (y * g.astype(jnp.float32)).astype(x.dtype)


def causal_dwconv(u, w):
    k = w.shape[0]
    s = u.shape[1]
    up = jnp.pad(u, ((0, 0), (k - 1, 0), (0, 0)))
    out = w[k - 1] * u
    for j in range(k - 1):
        out = out + w[j] * up[:, j:j + s]
    return out


def causal_pool_minus_self(v):
    s = v.shape[1]
    vf = v.astype(jnp.float32)
    c = jnp.pad(jnp.cumsum(vf, axis=1), ((0, 0), (1, 0), (0, 0), (0, 0)))
    t = jnp.arange(s, dtype=jnp.float32)[None, :, None]
    outs = []
    for g, k in enumerate(POOL_WINDOWS):
        cg = c[:, :, g]
        hi = cg[:, 1:]
        lo = jnp.pad(cg[:, :s + 1 - k], ((0, 0), (k - 1, 0), (0, 0)))
        cnt = jnp.minimum(t + 1.0, float(k))
        outs.append((hi - lo) / cnt - vf[:, :, g])
    return jnp.stack(outs, axis=2).astype(v.dtype)


def setup_inputs(seed: int = 0) -> dict:
    key = jax.random.key(seed)
    ks = jax.random.split(key, 18)
    f32 = jnp.float32
    nrm = lambda k, shape, scale: (jax.random.normal(k, shape, f32) * scale)
    gain = lambda k, shape: 1.0 + 0.05 * jax.random.normal(k, shape, f32)
    L = DEPTH
    return {
        "x": jax.random.normal(ks[0], (BATCH, SEQ, D_MODEL), f32),
        "mem": jax.random.normal(ks[1], (BATCH, N_MEM, D_MODEL), f32),
        "g_mix": gain(ks[2], (L, D_MODEL)),
        "g_mem": gain(ks[3], (L, D_MODEL)),
        "w_in": nrm(ks[4], (L, D_MODEL, D_IN), D_MODEL ** -0.5),
        "conv_w": nrm(ks[5], (L, CONV_WIDTH, D_CONV), CONV_WIDTH ** -0.5),
        "pool_w": nrm(ks[6], (L, POOL_GROUPS, POOL_GROUP_DIM, POOL_GROUP_DIM), POOL_GROUP_DIM ** -0.5),
        "pool_scale": gain(ks[7], (L, D_POOL)),
        "w_kv": nrm(ks[8], (L, D_MODEL, 2 * D_XATT), D_MODEL ** -0.5),
        "w_out": nrm(ks[9], (L, D_MIX, D_MODEL), D_MIX ** -0.5),
        "g_ffn": gain(ks[10], (L, D_MODEL)),
        "w_up": nrm(ks[11], (L, D_MODEL, 2 * D_FF), D_MODEL ** -0.5),
        "ffn_conv_w": nrm(ks[12], (L, FFN_CONV_WIDTH, 2 * D_FF), FFN_CONV_WIDTH ** -0.5),
        "ffn_conv_b": nrm(ks[13], (L, 2 * D_FF), 0.01),
        "w_down": nrm(ks[14], (L, D_FF, D_MODEL), D_FF ** -0.5),
        "g_final": gain(ks[15], (D_MODEL,)),
    }


def reference(x, mem, g_mix, g_mem, w_in, conv_w, pool_w, pool_scale, w_kv, w_out,
              g_ffn, w_up, ffn_conv_w, ffn_conv_b, w_down, g_final):
    b, s, _ = x.shape
    split_pts = [D_CONV, 2 * D_CONV, 3 * D_CONV, 3 * D_CONV + D_POOL]
    att_scale = 1.0 / math.sqrt(XATT_HEAD_DIM)
    for l in range(DEPTH):
        h = rmsnorm(x, g_mix[l])
        z = h @ w_in[l]
        cb, cc, cx, pv, q = jnp.split(z, split_pts, axis=-1)

        conv_out = cb * causal_dwconv(cc * cx, conv_w[l])

        pooled = causal_pool_minus_self(pv.reshape(b, s, POOL_GROUPS, POOL_GROUP_DIM))
        pool_out = jnp.einsum('bsgc,gcd->bsgd', pooled, pool_w[l]).reshape(b, s, D_POOL)
        pool_out = pool_out * pool_scale[l]

        m = rmsnorm(mem, g_mem[l])
        kv = m @ w_kv[l]
        k, v = jnp.split(kv, 2, axis=-1)
        k = k.reshape(b, N_MEM, XATT_HEADS, XATT_HEAD_DIM)
        v = v.reshape(b, N_MEM, XATT_HEADS, XATT_HEAD_DIM)
        qh = q.reshape(b, s, XATT_HEADS, XATT_HEAD_DIM)
        scores = jnp.einsum('bshd,bmhd->bhsm', qh, k).astype(jnp.float32) * att_scale
        probs = jax.nn.softmax(scores, axis=-1).astype(x.dtype)
        att = jnp.einsum('bhsm,bmhd->bshd', probs, v).reshape(b, s, D_XATT)

        mix = jnp.concatenate([conv_out, pool_out, att], axis=-1)
        x = x + mix @ w_out[l]

        h = rmsnorm(x, g_ffn[l])
        u = causal_dwconv(h @ w_up[l], ffn_conv_w[l]) + ffn_conv_b[l]
        gate, val = jnp.split(u, 2, axis=-1)
        x = x + (jax.nn.silu(gate) * val) @ w_down[l]
    return rmsnorm(x, g_final)
```

```cpp
#include <hip/hip_runtime.h>
#include <hip/hip_cooperative_groups.h>
#include <cstdio>
#include <cstdint>
namespace cg = cooperative_groups;
namespace pg8 {
#define PG8_LAS __attribute__((address_space(3)))
typedef unsigned short bf16_t;
typedef short bf16x8 __attribute__((ext_vector_type(8)));
typedef float f32x4 __attribute__((ext_vector_type(4)));
typedef unsigned u32x4 __attribute__((ext_vector_type(4)));
constexpr int BM = 256, BK = 64, HALF = 128, HTB = HALF * BK * 2  , STAGE_BYTES = 8 * HTB, NXCD = 8, WGM = 8;

__host__ __device__ __forceinline__ int lds_byte(int r, int c) { const int st = (r >> 4) * 2 + (c >> 5), rr = r & 15, cc = c & 31, ob = rr * 64 + cc * 2; return st * 1024 + (ob ^ (((ob >> 9) & 1) << 5)); }
__host__ __device__ __forceinline__ void stage_rc(int b, int& R, int& C) { const int st = b / 1024, sb = b % 1024, swz = sb ^ (((sb >> 9) & 1) << 5); R = (st >> 1) * 16 + swz / 64; C = (st & 1) * 32 + (swz % 64) / 2; }
__host__ __device__ __forceinline__ int perm32(int rho) { const int n = rho >> 4, i = rho & 15; return 8 * (i >> 2) + 4 * n + (i & 3); }

struct Unit { int pm, pn; };
struct Gemm { const bf16_t* A; const bf16_t* Bt; int M, N, K; };

struct StaticOrder {
    int nM, nN, nwg, G, c;
    __host__ __device__ void init(int M, int N, int G_, int c_) { nM = M / BM; nN = N / BM; nwg = nM * nN; G = G_; c = c_; }
    __host__ __device__ bool next(int i, Unit& u) const {
        const long L = (long)i * G + c; if (L >= nwg) return false;
        int wgid = (int)L; { const int q = nwg / NXCD, r = nwg % NXCD, xcd = wgid % NXCD, off = wgid / NXCD; wgid = (xcd < r ? xcd * (q + 1) : r * (q + 1) + (xcd - r) * q) + off; }
        const int nig = WGM * nN, gid = wgid / nig, fm = gid * WGM, gsz = (nM - fm) < WGM ? (nM - fm) : WGM;
        u.pm = fm + ((wgid % nig) % gsz); u.pn = (wgid % nig) / gsz; return true;
    }
    __device__ __forceinline__ void a_ready(const Unit&) const {}
    __device__ __forceinline__ void done(const Unit&) const {}
};
__device__ __forceinline__ unsigned cvt_pk_bf16(float lo, float hi) { unsigned r; asm volatile("v_cvt_pk_bf16_f32 %0, %1, %2" : "=v"(r) : "v"(lo), "v"(hi)); return r; }
typedef unsigned u32x2 __attribute__((ext_vector_type(2)));
constexpr int DM = 2048;
constexpr float RMS_EPS = 1e-6f;

struct EpiZ {
    static constexpr bool PERM = true, AFTER_DRAIN = false;
    bf16_t* O; int ldc;
    __device__ __forceinline__ void operator()(const f32x4 (&acc)[2][2][4][2], const Unit& u, int wr, int wc, int fr, int fq) const {
        const int row0 = u.pm * BM + wr * 64 + fr, col0 = u.pn * BM + wc * 32 + 8 * fq;
#pragma unroll
        for (int ai = 0; ai < 2; ++ai)
#pragma unroll
            for (int m = 0; m < 4; ++m) { bf16_t* rowp = O + (size_t)(row0 + ai * HALF + m * 16) * ldc + col0;
#pragma unroll
                for (int bj = 0; bj < 2; ++bj) { const f32x4 v0 = acc[ai][bj][m][0], v1 = acc[ai][bj][m][1];
                    u32x4 w; w.x = cvt_pk_bf16(v0[0], v0[1]); w.y = cvt_pk_bf16(v0[2], v0[3]); w.z = cvt_pk_bf16(v1[0], v1[1]); w.w = cvt_pk_bf16(v1[2], v1[3]);
                    *(u32x4*)(rowp + bj * HALF) = w; } }
    }
};

template <bool WB> struct EpiRes {
    static constexpr bool PERM = true, AFTER_DRAIN = false;
    const float* R; float* X; bf16_t* XB; float* slab;
    __device__ __forceinline__ void operator()(const f32x4 (&acc)[2][2][4][2], const Unit& u, int wr, int wc, int fr, int fq) const {
        const int row0 = u.pm * BM + wr * 64 + fr, col0 = u.pn * BM + wc * 32 + 8 * fq;
#pragma unroll
        for (int ai = 0; ai < 2; ++ai)
#pragma unroll
            for (int m = 0; m < 4; ++m) { const int row = row0 + ai * HALF + m * 16; const size_t off = (size_t)row * DM + col0; float ss = 0.f;
#pragma unroll
                for (int bj = 0; bj < 2; ++bj) {
                    const f32x4 r0 = *(const f32x4*)(R + off + bj * HALF), r1 = *(const f32x4*)(R + off + bj * HALF + 4);
                    const f32x4 v0 = acc[ai][bj][m][0] + r0, v1 = acc[ai][bj][m][1] + r1;
                    *(f32x4*)(X + off + bj * HALF) = v0; *(f32x4*)(X + off + bj * HALF + 4) = v1;
                    if (WB) { u32x4 w; w.x = cvt_pk_bf16(v0[0], v0[1]); w.y = cvt_pk_bf16(v0[2], v0[3]); w.z = cvt_pk_bf16(v1[0], v1[1]); w.w = cvt_pk_bf16(v1[2], v1[3]);
                        *(u32x4*)(XB + off + bj * HALF) = w; }
                    ss += (v0[0] * v0[0] + v0[1] * v0[1]) + (v0[2] * v0[2] + v0[3] * v0[3]) + (v1[0] * v1[0] + v1[1] * v1[1]) + (v1[2] * v1[2] + v1[3] * v1[3]); }
                ss += __shfl_xor(ss, 16); ss += __shfl_xor(ss, 32);
                if (fq == 0) slab[(size_t)row * 32 + u.pn * 4 + wc] = ss;
                asm volatile("" ::: "memory"); }
    }
};

struct EpiU {
    static constexpr bool PERM = true, AFTER_DRAIN = false;
    bf16_t* U; int ldu; const float* slab; int row_base; bf16_t* haloB;
    __device__ __forceinline__ void operator()(const f32x4 (&acc)[2][2][4][2], const Unit& u, int wr, int wc, int fr, int fq) const {
        const int row0 = u.pm * BM + wr * 64 + fr, col0 = u.pn * BM + wc * 32 + 8 * fq;
#pragma unroll
        for (int ai = 0; ai < 2; ++ai)
#pragma unroll
            for (int m = 0; m < 4; ++m) { const int rl = row0 + ai * HALF + m * 16, rg = row_base + rl;
                const f32x4 pa = *(const f32x4*)(slab + (size_t)rg * 32 + 8 * fq), pb = *(const f32x4*)(slab + (size_t)rg * 32 + 8 * fq + 4);
                float s = ((pa[0] + pa[1]) + (pa[2] + pa[3])) + ((pb[0] + pb[1]) + (pb[2] + pb[3]));
                s += __shfl_xor(s, 16); s += __shfl_xor(s, 32);
                const float rstd = 1.0f / sqrtf(s * (1.0f / DM) + RMS_EPS);
                bf16_t* rowp = U + (size_t)rl * ldu + col0;
#pragma unroll
                for (int bj = 0; bj < 2; ++bj) { const f32x4 v0 = acc[ai][bj][m][0] * rstd, v1 = acc[ai][bj][m][1] * rstd;
                    u32x4 w; w.x = cvt_pk_bf16(v0[0], v0[1]); w.y = cvt_pk_bf16(v0[2], v0[3]); w.z = cvt_pk_bf16(v1[0], v1[1]); w.w = cvt_pk_bf16(v1[2], v1[3]);
                    *(u32x4*)(rowp + bj * HALF) = w;
                    if (rg == 8190 || rg == 8191) *(u32x4*)(haloB + (size_t)(rg - 8190) * ldu + col0 + bj * HALF) = w; } }
    }
};

template <class Epi, class Sched, bool ALIGN_EPI = false, bool SP2 = false>
__device__ __forceinline__ void gemm_phase(PG8_LAS unsigned char* lds, const Gemm g, const Sched& S, const Epi& E) {
    const int tid = threadIdx.x, wid = __builtin_amdgcn_readfirstlane(tid >> 6), lane = tid & 63, wr = wid >> 2, wc = wid & 3, fr = lane & 15, fq = lane >> 4;
    const int K = g.K, nt = K / BK;
    unsigned voffA[2], voffB[2];
#pragma unroll
    for (int i = 0; i < 2; ++i) { int R, C; stage_rc(tid * 16 + i * 8192, R, C); const int Rb = Epi::PERM ? ((R & ~31) + perm32(R & 31)) : R;
        voffA[i] = (unsigned)(R * K + C) * 2u; voffB[i] = (unsigned)(Rb * K + C) * 2u; }
    const size_t kstep = (size_t)(BK * 2);
    const size_t hstep = (size_t)HALF * K * 2;
    const size_t tstep = 2 * hstep;
    const unsigned ldsw = (unsigned)wid * 1024u;
    const int aoff = lds_byte(wr * 64 + fr, fq * 8), boff = lds_byte(wc * 32 + fr, fq * 8);
#define PG8_SA(b, h) (((b) * 2 + (h)) * HTB)
#define PG8_SB(b, h) ((4 + (b) * 2 + (h)) * HTB)
#define PG8_STAGE(bufoff, gbase, voff) do { _Pragma("unroll") for (int _i = 0; _i < 2; ++_i) \
        __builtin_amdgcn_global_load_lds((const unsigned*)((const char*)(gbase) + (voff)[_i]), (PG8_LAS unsigned*)(lds + (bufoff) + ldsw + _i * 8192), 16, 0, 0); } while (0)
#define PG8_LDA(dst, b, h) do { _Pragma("unroll") for (int m = 0; m < 4; ++m) _Pragma("unroll") for (int k = 0; k < 2; ++k) dst[m][k] = *(const PG8_LAS bf16x8*)(lds + PG8_SA(b, h) + aoff + m * 2048 + k * 1024); } while (0)
#define PG8_LDB(dst, b, h) do { _Pragma("unroll") for (int n = 0; n < 2; ++n) _Pragma("unroll") for (int k = 0; k < 2; ++k) dst[n][k] = *(const PG8_LAS bf16x8*)(lds + PG8_SB(b, h) + boff + n * 2048 + k * 1024); } while (0)
#define PG8_MMA(ai, bj, At, Bt) do { __builtin_amdgcn_s_setprio(1); _Pragma("unroll") for (int m = 0; m < 4; ++m) _Pragma("unroll") for (int n = 0; n < 2; ++n) _Pragma("unroll") for (int k = 0; k < 2; ++k) \
        acc[ai][bj][m][n] = __builtin_amdgcn_mfma_f32_16x16x32_bf16(Bt[n][k], At[m][k], acc[ai][bj][m][n], 0, 0, 0); __builtin_amdgcn_s_setprio(0); } while (0)
#define PG8_WAIT_V(n) asm volatile("s_waitcnt vmcnt(" #n ")" ::: "memory")
#define PG8_WAIT_L(n) asm volatile("s_waitcnt lgkmcnt(" #n ")" ::: "memory")
#define PG8_BAR __builtin_amdgcn_s_barrier()
#define PG8_SCHED __builtin_amdgcn_sched_barrier(0)
    Unit cur, nxt; int ui = 0;
    if (!S.next(0, cur)) return;
    f32x4 acc[2][2][4][2];
#pragma unroll
    for (int a = 0; a < 2; ++a)
#pragma unroll
        for (int b = 0; b < 2; ++b)
#pragma unroll
            for (int m = 0; m < 4; ++m)
#pragma unroll
                for (int n = 0; n < 2; ++n) acc[a][b][m][n] = (f32x4){0.f, 0.f, 0.f, 0.f};
    bf16x8 At[4][2], B0[2][2], B1[2][2];
    const char* cA = (const char*)g.A + (size_t)cur.pm * tstep; const char* cB = (const char*)g.Bt + (size_t)cur.pn * tstep;
    S.a_ready(cur);
    if constexpr (SP2) {
        PG8_STAGE(PG8_SB(0, 0), cB, voffB); PG8_STAGE(PG8_SB(0, 1), cB + hstep, voffB); PG8_STAGE(PG8_SA(0, 0), cA, voffA); PG8_STAGE(PG8_SA(0, 1), cA + hstep, voffA);
        if (wr == 1) PG8_BAR;
        PG8_WAIT_V(2); PG8_BAR;
        PG8_STAGE(PG8_SB(1, 0), cB + kstep, voffB); PG8_STAGE(PG8_SA(1, 0), cA + kstep, voffA); PG8_STAGE(PG8_SB(1, 1), cB + hstep + kstep, voffB);
        PG8_WAIT_V(6); PG8_BAR;
    } else {
        PG8_STAGE(PG8_SB(0, 0), cB, voffB); PG8_STAGE(PG8_SA(0, 0), cA, voffA); PG8_STAGE(PG8_SB(0, 1), cB + hstep, voffB); PG8_STAGE(PG8_SA(0, 1), cA + hstep, voffA);
        if (wr == 1) PG8_BAR;
        PG8_WAIT_V(4); PG8_BAR;
        PG8_STAGE(PG8_SB(1, 0), cB + kstep, voffB); PG8_STAGE(PG8_SA(1, 0), cA + kstep, voffA); PG8_STAGE(PG8_SB(1, 1), cB + hstep + kstep, voffB);
        PG8_WAIT_V(6); PG8_BAR;
    }
    for (;;) {
        const bool has_next = S.next(ui + 1, nxt);
        const char* nA = has_next ? (const char*)g.A + (size_t)nxt.pm * tstep : cA; const char* nB = has_next ? (const char*)g.Bt + (size_t)nxt.pn * tstep : cB;
        for (int t = 0; t < nt; t += 2) {
            const bool last = (t == nt - 2);
            const char* a1 = cA + (size_t)(t + 1) * kstep;
            const char* a2 = last ? nA : cA + (size_t)(t + 2) * kstep; const char* b2 = last ? nB : cB + (size_t)(t + 2) * kstep;
            const char* a3 = a2 + kstep; const char* b3 = b2 + kstep;
            if (last && has_next) S.a_ready(nxt);
            if constexpr (SP2) {
            PG8_LDB(B0, 0, 0); PG8_LDB(B1, 0, 1); PG8_SCHED; PG8_LDA(At, 0, 0); PG8_STAGE(PG8_SA(1, 1), a1 + hstep, voffA);
            PG8_WAIT_V(8); PG8_WAIT_L(0); PG8_BAR; PG8_MMA(0, 0, At, B0); PG8_MMA(0, 1, At, B1); PG8_BAR; PG8_SCHED;
            PG8_LDA(At, 0, 1); PG8_STAGE(PG8_SB(0, 0), b2, voffB); PG8_STAGE(PG8_SB(0, 1), b2 + hstep, voffB); PG8_STAGE(PG8_SA(0, 0), a2, voffA);
            PG8_WAIT_V(8); PG8_WAIT_L(0); PG8_BAR; PG8_MMA(1, 0, At, B0); PG8_MMA(1, 1, At, B1); PG8_BAR; PG8_SCHED;
            PG8_LDB(B0, 1, 0); PG8_LDB(B1, 1, 1); PG8_SCHED; PG8_LDA(At, 1, 0); PG8_STAGE(PG8_SA(0, 1), a2 + hstep, voffA);
            PG8_WAIT_V(8); PG8_WAIT_L(0); PG8_BAR; PG8_MMA(0, 0, At, B0); PG8_MMA(0, 1, At, B1); PG8_BAR; PG8_SCHED;
            PG8_LDA(At, 1, 1); PG8_STAGE(PG8_SB(1, 0), b3, voffB); PG8_STAGE(PG8_SB(1, 1), b3 + hstep, voffB); PG8_STAGE(PG8_SA(1, 0), a3, voffA);
            PG8_WAIT_V(8); PG8_WAIT_L(0); PG8_BAR; PG8_MMA(1, 0, At, B0); PG8_MMA(1, 1, At, B1); PG8_BAR; PG8_SCHED;
            } else {
            PG8_LDB(B0, 0, 0); PG8_SCHED; PG8_LDA(At, 0, 0); PG8_STAGE(PG8_SA(1, 1), a1 + hstep, voffA);
            PG8_WAIT_L(8); PG8_BAR; PG8_WAIT_L(0); PG8_MMA(0, 0, At, B0); PG8_BAR; PG8_SCHED;
            PG8_LDB(B1, 0, 1); PG8_STAGE(PG8_SB(0, 0), b2, voffB);
            PG8_BAR; PG8_WAIT_L(0); PG8_MMA(0, 1, At, B1); PG8_BAR;
            PG8_LDA(At, 0, 1); PG8_STAGE(PG8_SA(0, 0), a2, voffA);
            PG8_BAR; PG8_WAIT_L(0); PG8_MMA(1, 0, At, B0); PG8_BAR; PG8_SCHED;
            PG8_STAGE(PG8_SB(0, 1), b2 + hstep, voffB);
            PG8_WAIT_V(6); PG8_BAR; PG8_MMA(1, 1, At, B1); PG8_BAR;
            PG8_LDB(B0, 1, 0); PG8_SCHED; PG8_LDA(At, 1, 0); PG8_STAGE(PG8_SA(0, 1), a2 + hstep, voffA);
            PG8_WAIT_L(8); PG8_BAR; PG8_WAIT_L(0); PG8_MMA(0, 0, At, B0); PG8_BAR; PG8_SCHED;
            PG8_LDB(B1, 1, 1); PG8_STAGE(PG8_SB(1, 0), b3, voffB);
            PG8_BAR; PG8_WAIT_L(0); PG8_MMA(0, 1, At, B1); PG8_BAR;
            PG8_LDA(At, 1, 1); PG8_STAGE(PG8_SA(1, 0), a3, voffA);
            PG8_BAR; PG8_WAIT_L(0); PG8_MMA(1, 0, At, B0); PG8_BAR; PG8_SCHED;
            PG8_STAGE(PG8_SB(1, 1), b3 + hstep, voffB);
            PG8_WAIT_V(6); PG8_BAR; PG8_MMA(1, 1, At, B1); PG8_BAR;
            }
        }
        if constexpr (ALIGN_EPI) { if (wr == 0) PG8_BAR; }
        if constexpr (!Epi::AFTER_DRAIN) { E(acc, cur, wr, wc, fr, fq); S.done(cur); }
        if (!has_next) break;
#pragma unroll
        for (int a = 0; a < 2; ++a)
#pragma unroll
            for (int b = 0; b < 2; ++b)
#pragma unroll
                for (int m = 0; m < 4; ++m)
#pragma unroll
                    for (int n = 0; n < 2; ++n) acc[a][b][m][n] = (f32x4){0.f, 0.f, 0.f, 0.f};
        cur = nxt; cA = nA; cB = nB; ++ui;
        if constexpr (ALIGN_EPI) { if (wr == 1) PG8_BAR; }
    }
    PG8_WAIT_V(0);
    if constexpr (!ALIGN_EPI) { if (wr == 0) PG8_BAR; }
    PG8_BAR;
    if constexpr (Epi::AFTER_DRAIN) { E.fused(acc, cur, wr, wc, fr, fq, lds, wid, lane); S.done(cur); }
#undef PG8_SA
#undef PG8_SB
#undef PG8_STAGE
#undef PG8_LDA
#undef PG8_LDB
#undef PG8_MMA
#undef PG8_WAIT_V
#undef PG8_WAIT_L
#undef PG8_BAR
#undef PG8_SCHED
}
}

#define GAS __attribute__((address_space(1)))
#define LAS __attribute__((address_space(3)))
typedef unsigned short bf16;
typedef float f32x4 __attribute__((ext_vector_type(4)));
typedef short bf16x8 __attribute__((ext_vector_type(8)));
typedef unsigned u32x4 __attribute__((ext_vector_type(4)));
typedef unsigned u32x2 __attribute__((ext_vector_type(2)));

constexpr int NWAVES = 8;
constexpr int SEQ = 16384, DMODEL = 2048, NMEM = 256, DIN = 3584, DCONV = 768, DPOOL = 768, DXATT = 512, DFF = 5632, DFF2 = 11264;
constexpr int PGD = 192;
constexpr float EPS = 1e-6f;
constexpr int LDS_BYTES = 147456;
#ifndef MK_PER_PHASE
#define MK_PER_PHASE 1
#endif
constexpr int NPHASE = 10;
#ifndef PHM
#define PHM 255
#endif

constexpr size_t MiB = 1u << 20;
constexpr size_t WS_KB = 1 * MiB;
constexpr size_t WS_VT = 1 * MiB + 256 * 1024;
constexpr size_t WS_POOLWT = 1 * MiB + 512 * 1024;
constexpr size_t WS_MB = 2 * MiB;
constexpr size_t WS_WKVT = 3 * MiB;
constexpr size_t WS_HALOB = 7 * MiB;
constexpr size_t WS_SLAB1 = 8 * MiB;
constexpr size_t WS_SLAB2 = 10 * MiB;
constexpr size_t WS_WUPT = 12 * MiB;
constexpr size_t WS_WDOWNT = 56 * MiB;
constexpr size_t WS_U = 80 * MiB;
constexpr size_t WS_ACT = 256 * MiB;
constexpr size_t WS_X1B = 432 * MiB;
constexpr size_t WS_H = 80 * MiB;
constexpr size_t WS_Z = 144 * MiB;
constexpr size_t WS_MIX = 256 * MiB;
constexpr size_t WS_WINT = 320 * MiB;
constexpr size_t WS_WOUTT = 334 * MiB;
constexpr size_t WS_END = 496 * MiB;

__device__ __forceinline__ unsigned f2bf(float f) { unsigned u = __builtin_bit_cast(unsigned, f); return (u + 0x7fffu + ((u >> 16) & 1u)) >> 16; }
__device__ __forceinline__ unsigned pk2(float lo, float hi) { return f2bf(lo) | (f2bf(hi) << 16); }
__device__ __forceinline__ float bflo(unsigned w) { return __builtin_bit_cast(float, w << 16); }
__device__ __forceinline__ float bfhi(unsigned w) { return __builtin_bit_cast(float, w & 0xffff0000u); }
__device__ __forceinline__ void unpack8(const u32x4 w, float (&f)[8]) { f[0] = bflo(w.x); f[1] = bfhi(w.x); f[2] = bflo(w.y); f[3] = bfhi(w.y); f[4] = bflo(w.z); f[5] = bfhi(w.z); f[6] = bflo(w.w); f[7] = bfhi(w.w); }
__device__ __forceinline__ u32x4 pack8(const float (&f)[8]) { u32x4 w; w.x = pk2(f[0], f[1]); w.y = pk2(f[2], f[3]); w.z = pk2(f[4], f[5]); w.w = pk2(f[6], f[7]); return w; }
__device__ __forceinline__ float wave_sum(float v) {
#pragma unroll
    for (int o = 1; o < 64; o <<= 1) v += __shfl_xor(v, o);
    return v;
}
#define LDS_WAIT() asm volatile("s_waitcnt lgkmcnt(0)" ::: "memory")

__device__ __forceinline__ void p0_transpose_item(const float* W, int K, int N, bf16* WT, const float* ks, LAS float* scr, int item, int lane) {
    const int nblk = N / 32, kb = item / nblk, nb = item % nblk, k0 = 64 * kb, n0 = 32 * nb;
#pragma unroll 8
    for (int i = 0; i < 32; ++i) { const int kk = 2 * i + (lane >> 5); float v = W[(size_t)(k0 + kk) * N + n0 + (lane & 31)]; if (ks) v *= ks[k0 + kk]; scr[kk * 33 + (lane & 31)] = v; }
    LDS_WAIT(); asm volatile("" ::: "memory");
    const int c = lane & 7;
#pragma unroll
    for (int j = 0; j < 4; ++j) { const int n = (lane >> 3) + 8 * j; const LAS float* s = scr + (8 * c) * 33 + n;
        u32x4 o; o.x = pk2(s[0 * 33], s[1 * 33]); o.y = pk2(s[2 * 33], s[3 * 33]); o.z = pk2(s[4 * 33], s[5 * 33]); o.w = pk2(s[6 * 33], s[7 * 33]);
        *(u32x4*)(WT + (size_t)(n0 + n) * K + k0 + 8 * c) = o; }
    LDS_WAIT(); asm volatile("" ::: "memory");
}
__device__ __forceinline__ void rms_row_to_bf16(const float* xrow, const float* g, bf16* orow, int lane) {
    const f32x4* xr = (const f32x4*)xrow + lane; const f32x4* gr = (const f32x4*)g + lane;
    f32x4 v[8]; float s = 0.f;
#pragma unroll
    for (int j = 0; j < 8; ++j) { v[j] = xr[64 * j]; s += (v[j].x * v[j].x + v[j].y * v[j].y) + (v[j].z * v[j].z + v[j].w * v[j].w); }
    const float rstd = 1.0f / sqrtf(wave_sum(s) * (1.0f / DMODEL) + EPS);
    u32x2* o8 = (u32x2*)orow + lane;
#pragma unroll
    for (int j = 0; j < 8; ++j) { const f32x4 gg = gr[64 * j]; u32x2 w; w.x = pk2(v[j].x * rstd * gg.x, v[j].y * rstd * gg.y); w.y = pk2(v[j].z * rstd * gg.z, v[j].w * rstd * gg.w); o8[64 * j] = w; }
}

struct Ptrs {
    const float *x, *mem, *g_mix, *g_mem, *w_in, *conv_w, *pool_w, *pool_scale, *w_kv, *w_out, *g_ffn, *w_up, *ffn_conv_w, *ffn_conv_b, *w_down, *g_final;
    float* out; unsigned char* ws;
};

__device__ __forceinline__ void p0_prologue(const Ptrs& P, LAS unsigned char* lds, int gw, int NGW, int wave, int lane) {
    LAS float* scr = (LAS float*)(lds + wave * 16384);
    unsigned char* ws = P.ws;
    constexpr int I_IN = (DMODEL / 64) * (DIN / 32), I_OUT = (DMODEL / 64) * (DMODEL / 32), I_UP = (DMODEL / 64) * (DFF2 / 32), I_DN = (DFF / 64) * (DMODEL / 32),
                  I_KV = (DMODEL / 64) * (1024 / 32), I_PW = (PGD / 64) * (PGD / 32);
    constexpr int NITEMS = I_IN + I_OUT + I_UP + I_DN + I_KV + 4 * I_PW;
    for (int it = gw; it < NITEMS; it += NGW) {
        int r = it;
        if (r < I_IN) { p0_transpose_item(P.w_in, DMODEL, DIN, (bf16*)(ws + WS_WINT), nullptr, scr, r, lane); continue; } r -= I_IN;
        if (r < I_OUT) { p0_transpose_item(P.w_out, DMODEL, DMODEL, (bf16*)(ws + WS_WOUTT), nullptr, scr, r, lane); continue; } r -= I_OUT;
        if (r < I_UP) { p0_transpose_item(P.w_up, DMODEL, DFF2, (bf16*)(ws + WS_WUPT), P.g_ffn, scr, r, lane); continue; } r -= I_UP;
        if (r < I_DN) { p0_transpose_item(P.w_down, DFF, DMODEL, (bf16*)(ws + WS_WDOWNT), nullptr, scr, r, lane); continue; } r -= I_DN;
        if (r < I_KV) { p0_transpose_item(P.w_kv, DMODEL, 1024, (bf16*)(ws + WS_WKVT), nullptr, scr, r, lane); continue; } r -= I_KV;
        const int g = r / I_PW; r -= g * I_PW;
        p0_transpose_item(P.pool_w + (size_t)g * PGD * PGD, PGD, PGD, (bf16*)(ws + WS_POOLWT) + (size_t)g * PGD * PGD, nullptr, scr, r, lane);
    }
    for (int m = gw; m < SEQ; m += NGW) rms_row_to_bf16(P.x + (size_t)m * DMODEL, P.g_mix, (bf16*)(ws + WS_H) + (size_t)m * DMODEL, lane);
    for (int m = gw; m < NMEM; m += NGW) rms_row_to_bf16(P.mem + (size_t)m * DMODEL, P.g_mem, (bf16*)(ws + WS_MB) + (size_t)m * DMODEL, lane);
}

__device__ __forceinline__ void kv_tile(const Ptrs& P, int tt, int lane) {
    const bf16* mB = (const bf16*)(P.ws + WS_MB); const bf16* wT = (const bf16*)(P.ws + WS_WKVT);
    const int rb = tt >> 6, cb = tt & 63, fr = lane & 15, fq = lane >> 4;
    const bf16* ap = mB + (size_t)(16 * rb + fr) * DMODEL + 8 * fq; const bf16* wp = wT + (size_t)(16 * cb + fr) * DMODEL + 8 * fq;
    f32x4 acc = {0.f, 0.f, 0.f, 0.f};
    if (cb < 32) {
#pragma unroll 8
        for (int ks = 0; ks < 64; ++ks) { const bf16x8 a = *(const bf16x8*)(ap + 32 * ks), w = *(const bf16x8*)(wp + 32 * ks); acc = __builtin_amdgcn_mfma_f32_16x16x32_bf16(w, a, acc, 0, 0, 0); }
        u32x2 o; o.x = pk2(acc[0], acc[1]); o.y = pk2(acc[2], acc[3]);
        *(u32x2*)((bf16*)(P.ws + WS_KB) + (size_t)(16 * rb + fr) * 512 + 16 * cb + 4 * fq) = o;
    } else {
#pragma unroll 8
        for (int ks = 0; ks < 64; ++ks) { const bf16x8 a = *(const bf16x8*)(ap + 32 * ks), w = *(const bf16x8*)(wp + 32 * ks); acc = __builtin_amdgcn_mfma_f32_16x16x32_bf16(a, w, acc, 0, 0, 0); }
        u32x2 o; o.x = pk2(acc[0], acc[1]); o.y = pk2(acc[2], acc[3]);
        *(u32x2*)((bf16*)(P.ws + WS_VT) + (size_t)(16 * cb - 512 + fr) * 256 + 32 * (rb >> 1) + 8 * fq + 4 * (rb & 1)) = o;
    }
}

__device__ __forceinline__ void mix_conv_task(const Ptrs& P, int blk, int lane) {
    const bf16* z = (const bf16*)(P.ws + WS_Z); bf16* mix = (bf16*)(P.ws + WS_MIX);
    const int t0 = blk * 16;
    for (int cg = lane; cg < DCONV / 8; cg += 64) {
        const int c = cg * 8;
        float w0[8], w1[8], w2[8], p1[8], p2[8];
#pragma unroll
        for (int e = 0; e < 8; ++e) { w0[e] = P.conv_w[c + e]; w1[e] = P.conv_w[DCONV + c + e]; w2[e] = P.conv_w[2 * DCONV + c + e]; p1[e] = 0.f; p2[e] = 0.f; }
        for (int r = -2; r < 16; ++r) {
            const int t = t0 + r; float p[8];
            if (t >= 0) { float a[8], b[8]; unpack8(*(const u32x4*)(z + (size_t)t * DIN + DCONV + c), a); unpack8(*(const u32x4*)(z + (size_t)t * DIN + 2 * DCONV + c), b);
#pragma unroll
                for (int e = 0; e < 8; ++e) p[e] = a[e] * b[e]; }
            else {
#pragma unroll
                for (int e = 0; e < 8; ++e) p[e] = 0.f; }
            if (r >= 0) { float g[8], o[8]; unpack8(*(const u32x4*)(z + (size_t)t * DIN + c), g);
#pragma unroll
                for (int e = 0; e < 8; ++e) o[e] = g[e] * (w2[e] * p[e] + w1[e] * p1[e] + w0[e] * p2[e]);
                *(u32x4*)(mix + (size_t)t * DMODEL + c) = pack8(o); }
#pragma unroll
            for (int e = 0; e < 8; ++e) { p2[e] = p1[e]; p1[e] = p[e]; }
        }
    }
}
__device__ __forceinline__ void mix_pool_task(const Ptrs& P, int g, int blk, int lane) {
    const bf16* z = (const bf16*)(P.ws + WS_Z); bf16* mix = (bf16*)(P.ws + WS_MIX); const bf16* wt = (const bf16*)(P.ws + WS_POOLWT) + (size_t)g * PGD * PGD;
    const int fr = lane & 15, fq = lane >> 4, t = blk * 16 + fr, k = 2 << g;
    const int cnt = (t + 1 < k) ? t + 1 : k; const float inv = 1.0f / (float)cnt;
    f32x4 acc[12];
#pragma unroll
    for (int n = 0; n < 12; ++n) acc[n] = (f32x4){0.f, 0.f, 0.f, 0.f};
    for (int ks = 0; ks < 6; ++ks) {
        const int c = 32 * ks + 8 * fq; const bf16* zc = z + 3 * DCONV + PGD * g + c;
        float sum[8], self[8];
        unpack8(*(const u32x4*)(zc + (size_t)t * DIN), self);
#pragma unroll
        for (int e = 0; e < 8; ++e) sum[e] = self[e];
        for (int j = 1; j < k; ++j) { const int tt = t - j; const bool ok = tt >= 0; float v[8]; unpack8(*(const u32x4*)(zc + (size_t)(ok ? tt : 0) * DIN), v);
#pragma unroll
            for (int e = 0; e < 8; ++e) sum[e] += ok ? v[e] : 0.f; }
        float pl[8];
#pragma unroll
        for (int e = 0; e < 8; ++e) pl[e] = sum[e] * inv - self[e];
        const bf16x8 pf = __builtin_bit_cast(bf16x8, pack8(pl));
#pragma unroll
        for (int n = 0; n < 12; ++n) { const bf16x8 wf = *(const bf16x8*)(wt + (size_t)(16 * n + fr) * PGD + c); acc[n] = __builtin_amdgcn_mfma_f32_16x16x32_bf16(wf, pf, acc[n], 0, 0, 0); }
    }
#pragma unroll
    for (int n = 0; n < 12; ++n) { const int d = 16 * n + 4 * fq; const f32x4 sc = *(const f32x4*)(P.pool_scale + PGD * g + d);
        u32x2 o; o.x = pk2(acc[n][0] * sc[0], acc[n][1] * sc[1]); o.y = pk2(acc[n][2] * sc[2], acc[n][3] * sc[3]);
        *(u32x2*)(mix + (size_t)t * DMODEL + DCONV + PGD * g + d) = o; }
}
__device__ __forceinline__ void mix_attn_task(const Ptrs& P, int h, int blk, int lane) {
    const bf16* z = (const bf16*)(P.ws + WS_Z); bf16* mix = (bf16*)(P.ws + WS_MIX); const bf16* Kb = (const bf16*)(P.ws + WS_KB); const bf16* Vt = (const bf16*)(P.ws + WS_VT);
    const int fr = lane & 15, fq = lane >> 4, t = blk * 16 + fr;
    bf16x8 qf[4];
#pragma unroll
    for (int ks = 0; ks < 4; ++ks) qf[ks] = *(const bf16x8*)(z + (size_t)t * DIN + 3 * DCONV + DPOOL + 128 * h + 32 * ks + 8 * fq);
    f32x4 s[16];
#pragma unroll
    for (int kb = 0; kb < 16; ++kb) { s[kb] = (f32x4){0.f, 0.f, 0.f, 0.f};
#pragma unroll
        for (int ks = 0; ks < 4; ++ks) { const bf16x8 kf = *(const bf16x8*)(Kb + (size_t)(16 * kb + fr) * 512 + 128 * h + 32 * ks + 8 * fq); s[kb] = __builtin_amdgcn_mfma_f32_16x16x32_bf16(kf, qf[ks], s[kb], 0, 0, 0); } }
    float mx = -3.0e38f;
#pragma unroll
    for (int kb = 0; kb < 16; ++kb) mx = fmaxf(fmaxf(fmaxf(s[kb][0], s[kb][1]), fmaxf(s[kb][2], s[kb][3])), mx);
    mx = fmaxf(mx, __shfl_xor(mx, 16)); mx = fmaxf(mx, __shfl_xor(mx, 32));
    const float c2 = 0.08838834764831845f * 1.4426950408889634f;
    float sum = 0.f;
#pragma unroll
    for (int kb = 0; kb < 16; ++kb)
#pragma unroll
        for (int r = 0; r < 4; ++r) { const float p = __builtin_amdgcn_exp2f((s[kb][r] - mx) * c2); s[kb][r] = p; sum += p; }
    sum += __shfl_xor(sum, 16); sum += __shfl_xor(sum, 32);
    const float inv = 1.0f / sum;
    f32x4 o[8];
#pragma unroll
    for (int db = 0; db < 8; ++db) o[db] = (f32x4){0.f, 0.f, 0.f, 0.f};
#pragma unroll
    for (int ks = 0; ks < 8; ++ks) {
        u32x4 pw; pw.x = pk2(s[2 * ks][0], s[2 * ks][1]); pw.y = pk2(s[2 * ks][2], s[2 * ks][3]); pw.z = pk2(s[2 * ks + 1][0], s[2 * ks + 1][1]); pw.w = pk2(s[2 * ks + 1][2], s[2 * ks + 1][3]);
        const bf16x8 pf = __builtin_bit_cast(bf16x8, pw);
#pragma unroll
        for (int db = 0; db < 8; ++db) { const bf16x8 vf = *(const bf16x8*)(Vt + (size_t)(128 * h + 16 * db + fr) * 256 + 32 * ks + 8 * fq); o[db] = __builtin_amdgcn_mfma_f32_16x16x32_bf16(vf, pf, o[db], 0, 0, 0); }
    }
#pragma unroll
    for (int db = 0; db < 8; ++db) { u32x2 w; w.x = pk2(o[db][0] * inv, o[db][1] * inv); w.y = pk2(o[db][2] * inv, o[db][3] * inv);
        *(u32x2*)(mix + (size_t)t * DMODEL + DCONV + DPOOL + 128 * h + 16 * db + 4 * fq) = w; }
}
__device__ __forceinline__ void p2_mixer(const Ptrs& P, int gw, int NGW, int lane) {
    constexpr int NBLK = SEQ / 16;
    for (int it = gw; it < 9 * NBLK; it += NGW) {
        const int task = it / NBLK, blk = it % NBLK;
        if (task == 0) mix_conv_task(P, blk, lane);
        else if (task < 5) mix_pool_task(P, task - 1, blk, lane);
        else mix_attn_task(P, task - 5, blk, lane);
    }
}

__device__ __forceinline__ void p5_act(const Ptrs& P, int half, int gw, int NGW, int lane) {
    const bf16* U = (const bf16*)(P.ws + WS_U); const bf16* haloB = (const bf16*)(P.ws + WS_HALOB); bf16* act = (bf16*)(P.ws + WS_ACT);
    constexpr int NCB = DFF / 512, RS = 32, NSTRIP = 8192 / RS;
    for (int it = gw; it < NSTRIP * NCB; it += NGW) {
        const int cbk = it % NCB, strip = it / NCB, c = cbk * 512 + lane * 8, r0 = strip * RS;
        float wg0[8], wg1[8], wg2[8], bg[8], wv0[8], wv1[8], wv2[8], bv[8], g1[8], g2[8], v1[8], v2[8];
#pragma unroll
        for (int e = 0; e < 8; ++e) { wg0[e] = P.ffn_conv_w[c + e]; wg1[e] = P.ffn_conv_w[DFF2 + c + e]; wg2[e] = P.ffn_conv_w[2 * DFF2 + c + e]; bg[e] = P.ffn_conv_b[c + e];
            wv0[e] = P.ffn_conv_w[DFF + c + e]; wv1[e] = P.ffn_conv_w[DFF2 + DFF + c + e]; wv2[e] = P.ffn_conv_w[2 * DFF2 + DFF + c + e]; bv[e] = P.ffn_conv_b[DFF + c + e]; g1[e] = g2[e] = v1[e] = v2[e] = 0.f; }
        for (int r = -2; r < RS; ++r) {
            const int rl = r0 + r, tg = half * 8192 + rl;
            float g[8], v[8];
            if (tg >= 0) { const bf16* src = (rl >= 0) ? U + (size_t)rl * DFF2 : haloB + (size_t)(tg - 8190) * DFF2;
                unpack8(*(const u32x4*)(src + c), g); unpack8(*(const u32x4*)(src + DFF + c), v); }
            else {
#pragma unroll
                for (int e = 0; e < 8; ++e) { g[e] = 0.f; v[e] = 0.f; } }
            if (r >= 0) { float o[8];
#pragma unroll
                for (int e = 0; e < 8; ++e) { const float G = wg2[e] * g[e] + wg1[e] * g1[e] + wg0[e] * g2[e] + bg[e], V = wv2[e] * v[e] + wv1[e] * v1[e] + wv0[e] * v2[e] + bv[e];
                    o[e] = G * __builtin_amdgcn_rcpf(1.0f + __expf(-G)) * V; }
                *(u32x4*)(act + (size_t)tg * DFF + c) = pack8(o); }
#pragma unroll
            for (int e = 0; e < 8; ++e) { g2[e] = g1[e]; g1[e] = g[e]; v2[e] = v1[e]; v1[e] = v[e]; }
        }
    }
}

__device__ __forceinline__ void p7_final(const Ptrs& P, int gw, int NGW, int lane) {
    const float* slab = (const float*)(P.ws + WS_SLAB2);
    for (int m = gw; m < SEQ; m += NGW) {
        const float part = (lane < 32) ? slab[(size_t)m * 32 + lane] : 0.f;
        const float rstd = 1.0f / sqrtf(wave_sum(part) * (1.0f / DMODEL) + EPS);
        f32x4* xr = (f32x4*)(P.out + (size_t)m * DMODEL) + lane; const f32x4* gr = (const f32x4*)P.g_final + lane;
#pragma unroll
        for (int j = 0; j < 8; ++j) { f32x4 v = xr[64 * j]; const f32x4 gg = gr[64 * j]; v = v * rstd * gg; xr[64 * j] = v; }
    }
}

struct Args { const float* in[16]; float* out; unsigned char* ws; int ph_lo, ph_hi; };
__global__ void __launch_bounds__(NWAVES * 64, 2) hybrid_fwd(Args args) {
    extern __shared__ __attribute__((aligned(16))) unsigned char lds_raw[];
    LAS unsigned char* lds = (LAS unsigned char*)lds_raw;
    cg::grid_group grid = cg::this_grid();
    const int tid = threadIdx.x, lane = tid & 63, wave = __builtin_amdgcn_readfirstlane(tid >> 6);
    const int G = gridDim.x, bx = blockIdx.x, vcu = (G % 8 == 0) ? (bx % 8) * (G / 8) + bx / 8 : bx;
    const int gw = vcu * NWAVES + wave, NGW = G * NWAVES;
    Ptrs P;
    P.x = args.in[0]; P.mem = args.in[1]; P.g_mix = args.in[2]; P.g_mem = args.in[3]; P.w_in = args.in[4]; P.conv_w = args.in[5]; P.pool_w = args.in[6]; P.pool_scale = args.in[7];
    P.w_kv = args.in[8]; P.w_out = args.in[9]; P.g_ffn = args.in[10]; P.w_up = args.in[11]; P.ffn_conv_w = args.in[12]; P.ffn_conv_b = args.in[13]; P.w_down = args.in[14]; P.g_final = args.in[15];
    P.out = args.out; P.ws = args.ws;
    unsigned char* ws = args.ws;
    const int lo = args.ph_lo, hi = args.ph_hi;
#define IN(k) (lo <= (k) && (k) < hi)
#define SYNC(k) do { if ((k) + 1 < hi) grid.sync(); } while (0)
    if (IN(0) && (PHM & 1)) { p0_prologue(P, lds, gw, NGW, wave, lane); SYNC(0); }
    if (IN(1) && (PHM & 2)) {
        pg8::Gemm g{(const bf16*)(ws + WS_H), (const bf16*)(ws + WS_WINT), SEQ, DIN, DMODEL}; pg8::StaticOrder S; S.init(SEQ, DIN, G, bx);
        pg8::EpiZ E{(bf16*)(ws + WS_Z), DIN};
        pg8::gemm_phase<pg8::EpiZ, pg8::StaticOrder, true, true>(lds, g, S, E);
        if (wave < 4) { for (int tt = vcu * 4 + wave; tt < 1024; tt += G * 4) kv_tile(P, tt, lane); }
        SYNC(1);
    }
    if (IN(2) && (PHM & 4)) { p2_mixer(P, gw, NGW, lane); SYNC(2); }
    if (IN(3) && (PHM & 8)) {
        pg8::Gemm g{(const bf16*)(ws + WS_MIX), (const bf16*)(ws + WS_WOUTT), SEQ, DMODEL, DMODEL}; pg8::StaticOrder S; S.init(SEQ, DMODEL, G, bx);
        pg8::EpiRes<true> E{P.x, P.out, (bf16*)(ws + WS_X1B), (float*)(ws + WS_SLAB1)};
        pg8::gemm_phase<pg8::EpiRes<true>, pg8::StaticOrder, true, true>(lds, g, S, E);
        SYNC(3);
    }
    for (int half = 0; half < 2; ++half) {
        if (IN(4 + 2 * half) && (PHM & 16)) {
            pg8::Gemm g{(const bf16*)(ws + WS_X1B) + (size_t)half * 8192 * DMODEL, (const bf16*)(ws + WS_WUPT), 8192, DFF2, DMODEL}; pg8::StaticOrder S; S.init(8192, DFF2, G, bx);
            pg8::EpiU E{(bf16*)(ws + WS_U), DFF2, (const float*)(ws + WS_SLAB1), half * 8192, (bf16*)(ws + WS_HALOB)};
            pg8::gemm_phase<pg8::EpiU, pg8::StaticOrder, true, true>(lds, g, S, E);
            SYNC(4 + 2 * half);
        }
        if (IN(5 + 2 * half) && (PHM & 32)) { p5_act(P, half, gw, NGW, lane); SYNC(5 + 2 * half); }
    }
    if (IN(8) && (PHM & 64)) {
        pg8::Gemm g{(const bf16*)(ws + WS_ACT), (const bf16*)(ws + WS_WDOWNT), SEQ, DMODEL, DFF}; pg8::StaticOrder S; S.init(SEQ, DMODEL, G, bx);
        pg8::EpiRes<false> E{P.out, P.out, nullptr, (float*)(ws + WS_SLAB2)};
        pg8::gemm_phase<pg8::EpiRes<false>, pg8::StaticOrder, true, true>(lds, g, S, E);
        SYNC(8);
    }
    if (IN(9) && (PHM & 128)) p7_final(P, gw, NGW, lane);
#undef IN
#undef SYNC
}

extern "C" void kernel_launch(void* const* d_in, const int* in_sizes, int n_in, void* d_out, int out_size, void* d_ws, size_t ws_size, hipStream_t stream) {
    static int grid = 0;
    if (grid == 0) {
        if (n_in != 16 || in_sizes[0] != SEQ * DMODEL || out_size != SEQ * DMODEL || ws_size < WS_END) { fprintf(stderr, "kernel_launch: unexpected shapes (n_in %d, in0 %d, out %d, ws %zu)\n", n_in, n_in > 0 ? in_sizes[0] : -1, out_size, ws_size); grid = -1; return; }
        int dev = 0, cus = 0, per_cu = 0;
        if (hipGetDevice(&dev) != hipSuccess || hipDeviceGetAttribute(&cus, hipDeviceAttributeMultiprocessorCount, dev) != hipSuccess) { grid = -1; return; }
        if (hipFuncSetAttribute((const void*)hybrid_fwd, hipFuncAttributeMaxDynamicSharedMemorySize, LDS_BYTES) != hipSuccess) { fprintf(stderr, "kernel_launch: hipFuncSetAttribute failed\n"); grid = -1; return; }
        if (hipOccupancyMaxActiveBlocksPerMultiprocessor(&per_cu, (const void*)hybrid_fwd, NWAVES * 64, LDS_BYTES) != hipSuccess || per_cu < 1) { fprintf(stderr, "kernel_launch: occupancy query says %d blocks per CU\n", per_cu); (void)hipGetLastError(); per_cu = 1; }
        grid = cus;
        if (grid % 8 != 0 || grid < 8) { fprintf(stderr, "kernel_launch: %d CUs\n", grid); }
    }
    if (grid < 0) return;
    Args a{};
    for (int i = 0; i < 16; ++i) a.in[i] = (const float*)d_in[i];
    a.out = (float*)d_out; a.ws = (unsigned char*)d_ws;
#if MK_PER_PHASE
    for (int ph = 0; ph < NPHASE; ++ph) { a.ph_lo = ph; a.ph_hi = ph + 1; hipLaunchKernelGGL(hybrid_fwd, dim3(grid), dim3(NWAVES * 64), LDS_BYTES, stream, a); }
#else
    a.ph_lo = 0; a.ph_hi = NPHASE;
    void* kargs[] = {&a};
    hipError_t e = hipLaunchCooperativeKernel((const void*)hybrid_fwd, dim3(grid), dim3(NWAVES * 64), kargs, LDS_BYTES, stream);
    if (e != hipSuccess) fprintf(stderr, "kernel_launch: cooperative launch failed: %s (grid %d)\n", hipGetErrorString(e), grid);
#endif
}
```

```cpp
#include <hip/hip_runtime.h>
#include <hip/hip_cooperative_groups.h>
#include <cstdio>
#include <cstdint>
namespace cg = cooperative_groups;
namespace pg8 {
#define PG8_LAS __attribute__((address_space(3)))
typedef unsigned short bf16_t;
typedef short bf16x8 __attribute__((ext_vector_type(8)));
typedef float f32x4 __attribute__((ext_vector_type(4)));
typedef unsigned u32x4 __attribute__((ext_vector_type(4)));
constexpr int BM = 256, BK = 64, HALF = 128, HTB = HALF * BK * 2  , STAGE_BYTES = 8 * HTB, NXCD = 8, WGM = 8;

__host__ __device__ __forceinline__ int lds_byte(int r, int c) { const int st = (r >> 4) * 2 + (c >> 5), rr = r & 15, cc = c & 31, ob = rr * 64 + cc * 2; return st * 1024 + (ob ^ (((ob >> 9) & 1) << 5)); }
__host__ __device__ __forceinline__ void stage_rc(int b, int& R, int& C) { const int st = b / 1024, sb = b % 1024, swz = sb ^ (((sb >> 9) & 1) << 5); R = (st >> 1) * 16 + swz / 64; C = (st & 1) * 32 + (swz % 64) / 2; }
__host__ __device__ __forceinline__ int perm32(int rho) { const int n = rho >> 4, i = rho & 15; return 8 * (i >> 2) + 4 * n + (i & 3); }

struct Unit { int pm, pn; };
struct Gemm { const bf16_t* A; const bf16_t* Bt; int M, N, K; };

struct StaticOrder {
    int nM, nN, nwg, G, c;
    __host__ __device__ void init(int M, int N, int G_, int c_) { nM = M / BM; nN = N / BM; nwg = nM * nN; G = G_; c = c_; }
    __host__ __device__ bool next(int i, Unit& u) const {
        const long L = (long)i * G + c; if (L >= nwg) return false;
        int wgid = (int)L; { const int q = nwg / NXCD, r = nwg % NXCD, xcd = wgid % NXCD, off = wgid / NXCD; wgid = (xcd < r ? xcd * (q + 1) : r * (q + 1) + (xcd - r) * q) + off; }
        const int nig = WGM * nN, gid = wgid / nig, fm = gid * WGM, gsz = (nM - fm) < WGM ? (nM - fm) : WGM;
        u.pm = fm + ((wgid % nig) % gsz); u.pn = (wgid % nig) / gsz; return true;
    }
    __device__ __forceinline__ void a_ready(const Unit&) const {}
    __device__ __forceinline__ void done(const Unit&) const {}
};
__device__ __forceinline__ unsigned cvt_pk_bf16(float lo, float hi) { unsigned r; asm volatile("v_cvt_pk_bf16_f32 %0, %1, %2" : "=v"(r) : "v"(lo), "v"(hi)); return r; }
typedef unsigned u32x2 __attribute__((ext_vector_type(2)));
constexpr int DM = 2048;
constexpr float RMS_EPS = 1e-6f;

struct EpiZ {
    static constexpr bool PERM = true, AFTER_DRAIN = false;
    bf16_t* O; int ldc;
    __device__ __forceinline__ void operator()(const f32x4 (&acc)[2][2][4][2], const Unit& u, int wr, int wc, int fr, int fq) const {
        const int row0 = u.pm * BM + wr * 64 + fr, col0 = u.pn * BM + wc * 32 + 8 * fq;
#pragma unroll
        for (int ai = 0; ai < 2; ++ai)
#pragma unroll
            for (int m = 0; m < 4; ++m) { bf16_t* rowp = O + (size_t)(row0 + ai * HALF + m * 16) * ldc + col0;
#pragma unroll
                for (int bj = 0; bj < 2; ++bj) { const f32x4 v0 = acc[ai][bj][m][0], v1 = acc[ai][bj][m][1];
                    u32x4 w; w.x = cvt_pk_bf16(v0[0], v0[1]); w.y = cvt_pk_bf16(v0[2], v0[3]); w.z = cvt_pk_bf16(v1[0], v1[1]); w.w = cvt_pk_bf16(v1[2], v1[3]);
                    *(u32x4*)(rowp + bj * HALF) = w; } }
    }
};

template <bool WB> struct EpiRes {
    static constexpr bool PERM = true, AFTER_DRAIN = false;
    const float* R; float* X; bf16_t* XB; float* slab;
    __device__ __forceinline__ void operator()(const f32x4 (&acc)[2][2][4][2], const Unit& u, int wr, int wc, int fr, int fq) const {
        const int row0 = u.pm * BM + wr * 64 + fr, col0 = u.pn * BM + wc * 32 + 8 * fq;
#pragma unroll
        for (int ai = 0; ai < 2; ++ai)
#pragma unroll
            for (int m = 0; m < 4; ++m) { const int row = row0 + ai * HALF + m * 16; const size_t off = (size_t)row * DM + col0; float ss = 0.f;
#pragma unroll
                for (int bj = 0; bj < 2; ++bj) {
                    const f32x4 r0 = *(const f32x4*)(R + off + bj * HALF), r1 = *(const f32x4*)(R + off + bj * HALF + 4);
                    const f32x4 v0 = acc[ai][bj][m][0] + r0, v1 = acc[ai][bj][m][1] + r1;
                    *(f32x4*)(X + off + bj * HALF) = v0; *(f32x4*)(X + off + bj * HALF + 4) = v1;
                    if (WB) { u32x4 w; w.x = cvt_pk_bf16(v0[0], v0[1]); w.y = cvt_pk_bf16(v0[2], v0[3]); w.z = cvt_pk_bf16(v1[0], v1[1]); w.w = cvt_pk_bf16(v1[2], v1[3]);
                        *(u32x4*)(XB + off + bj * HALF) = w; }
                    ss += (v0[0] * v0[0] + v0[1] * v0[1]) + (v0[2] * v0[2] + v0[3] * v0[3]) + (v1[0] * v1[0] + v1[1] * v1[1]) + (v1[2] * v1[2] + v1[3] * v1[3]); }
                ss += __shfl_xor(ss, 16); ss += __shfl_xor(ss, 32);
                if (fq == 0) slab[(size_t)row * 32 + u.pn * 4 + wc] = ss;
                asm volatile("" ::: "memory"); }
    }
};

struct EpiU {
    static constexpr bool PERM = true, AFTER_DRAIN = false;
    bf16_t* U; int ldu; const float* slab; int row_base; bf16_t* haloB;
    __device__ __forceinline__ void operator()(const f32x4 (&acc)[2][2][4][2], const Unit& u, int wr, int wc, int fr, int fq) const {
        const int row0 = u.pm * BM + wr * 64 + fr, col0 = u.pn * BM + wc * 32 + 8 * fq;
#pragma unroll
        for (int ai = 0; ai < 2; ++ai)
#pragma unroll
            for (int m = 0; m < 4; ++m) { const int rl = row0 + ai * HALF + m * 16, rg = row_base + rl;
                const f32x4 pa = *(const f32x4*)(slab + (size_t)rg * 32 + 8 * fq), pb = *(const f32x4*)(slab + (size_t)rg * 32 + 8 * fq + 4);
                float s = ((pa[0] + pa[1]) + (pa[2] + pa[3])) + ((pb[0] + pb[1]) + (pb[2] + pb[3]));
                s += __shfl_xor(s, 16); s += __shfl_xor(s, 32);
                const float rstd = 1.0f / sqrtf(s * (1.0f / DM) + RMS_EPS);
                bf16_t* rowp = U + (size_t)rl * ldu + col0;
#pragma unroll
                for (int bj = 0; bj < 2; ++bj) { const f32x4 v0 = acc[ai][bj][m][0] * rstd, v1 = acc[ai][bj][m][1] * rstd;
                    u32x4 w; w.x = cvt_pk_bf16(v0[0], v0[1]); w.y = cvt_pk_bf16(v0[2], v0[3]); w.z = cvt_pk_bf16(v1[0], v1[1]); w.w = cvt_pk_bf16(v1[2], v1[3]);
                    *(u32x4*)(rowp + bj * HALF) = w;
                    if (rg == 8190 || rg == 8191) *(u32x4*)(haloB + (size_t)(rg - 8190) * ldu + col0 + bj * HALF) = w; } }
    }
};

template <class Epi, class Sched, bool ALIGN_EPI = false, bool SP2 = false>
__device__ __forceinline__ void gemm_phase(PG8_LAS unsigned char* lds, const Gemm g, const Sched& S, const Epi& E) {
    const int tid = threadIdx.x, wid = __builtin_amdgcn_readfirstlane(tid >> 6), lane = tid & 63, wr = wid >> 2, wc = wid & 3, fr = lane & 15, fq = lane >> 4;
    const int K = g.K, nt = K / BK;
    unsigned voffA[2], voffB[2];
#pragma unroll
    for (int i = 0; i < 2; ++i) { int R, C; stage_rc(tid * 16 + i * 8192, R, C); const int Rb = Epi::PERM ? ((R & ~31) + perm32(R & 31)) : R;
        voffA[i] = (unsigned)(R * K + C) * 2u; voffB[i] = (unsigned)(Rb * K + C) * 2u; }
    const size_t kstep = (size_t)(BK * 2);
    const size_t hstep = (size_t)HALF * K * 2;
    const size_t tstep = 2 * hstep;
    const unsigned ldsw = (unsigned)wid * 1024u;
    const int aoff = lds_byte(wr * 64 + fr, fq * 8), boff = lds_byte(wc * 32 + fr, fq * 8);
#define PG8_SA(b, h) (((b) * 2 + (h)) * HTB)
#define PG8_SB(b, h) ((4 + (b) * 2 + (h)) * HTB)
#define PG8_STAGE(bufoff, gbase, voff) do { _Pragma("unroll") for (int _i = 0; _i < 2; ++_i) \
        __builtin_amdgcn_global_load_lds((const unsigned*)((const char*)(gbase) + (voff)[_i]), (PG8_LAS unsigned*)(lds + (bufoff) + ldsw + _i * 8192), 16, 0, 0); } while (0)
#define PG8_LDA(dst, b, h) do { _Pragma("unroll") for (int m = 0; m < 4; ++m) _Pragma("unroll") for (int k = 0; k < 2; ++k) dst[m][k] = *(const PG8_LAS bf16x8*)(lds + PG8_SA(b, h) + aoff + m * 2048 + k * 1024); } while (0)
#define PG8_LDB(dst, b, h) do { _Pragma("unroll") for (int n = 0; n < 2; ++n) _Pragma("unroll") for (int k = 0; k < 2; ++k) dst[n][k] = *(const PG8_LAS bf16x8*)(lds + PG8_SB(b, h) + boff + n * 2048 + k * 1024); } while (0)
#define PG8_MMA(ai, bj, At, Bt) do { __builtin_amdgcn_s_setprio(1); _Pragma("unroll") for (int m = 0; m < 4; ++m) _Pragma("unroll") for (int n = 0; n < 2; ++n) _Pragma("unroll") for (int k = 0; k < 2; ++k) \
        acc[ai][bj][m][n] = __builtin_amdgcn_mfma_f32_16x16x32_bf16(Bt[n][k], At[m][k], acc[ai][bj][m][n], 0, 0, 0); __builtin_amdgcn_s_setprio(0); } while (0)
#define PG8_WAIT_V(n) asm volatile("s_waitcnt vmcnt(" #n ")" ::: "memory")
#define PG8_WAIT_L(n) asm volatile("s_waitcnt lgkmcnt(" #n ")" ::: "memory")
#define PG8_BAR __builtin_amdgcn_s_barrier()
#define PG8_SCHED __builtin_amdgcn_sched_barrier(0)
    Unit cur, nxt; int ui = 0;
    if (!S.next(0, cur)) return;
    f32x4 acc[2][2][4][2];
#pragma unroll
    for (int a = 0; a < 2; ++a)
#pragma unroll
        for (int b = 0; b < 2; ++b)
#pragma unroll
            for (int m = 0; m < 4; ++m)
#pragma unroll
                for (int n = 0; n < 2; ++n) acc[a][b][m][n] = (f32x4){0.f, 0.f, 0.f, 0.f};
    bf16x8 At[4][2], B0[2][2], B1[2][2];
    const char* cA = (const char*)g.A + (size_t)cur.pm * tstep; const char* cB = (const char*)g.Bt + (size_t)cur.pn * tstep;
    S.a_ready(cur);
    if constexpr (SP2) {
        PG8_STAGE(PG8_SB(0, 0), cB, voffB); PG8_STAGE(PG8_SB(0, 1), cB + hstep, voffB); PG8_STAGE(PG8_SA(0, 0), cA, voffA); PG8_STAGE(PG8_SA(0, 1), cA + hstep, voffA);
        if (wr == 1) PG8_BAR;
        PG8_WAIT_V(2); PG8_BAR;
        PG8_STAGE(PG8_SB(1, 0), cB + kstep, voffB); PG8_STAGE(PG8_SA(1, 0), cA + kstep, voffA); PG8_STAGE(PG8_SB(1, 1), cB + hstep + kstep, voffB);
        PG8_WAIT_V(6); PG8_BAR;
    } else {
        PG8_STAGE(PG8_SB(0, 0), cB, voffB); PG8_STAGE(PG8_SA(0, 0), cA, voffA); PG8_STAGE(PG8_SB(0, 1), cB + hstep, voffB); PG8_STAGE(PG8_SA(0, 1), cA + hstep, voffA);
        if (wr == 1) PG8_BAR;
        PG8_WAIT_V(4); PG8_BAR;
        PG8_STAGE(PG8_SB(1, 0), cB + kstep, voffB); PG8_STAGE(PG8_SA(1, 0), cA + kstep, voffA); PG8_STAGE(PG8_SB(1, 1), cB + hstep + kstep, voffB);
        PG8_WAIT_V(6); PG8_BAR;
    }
    for (;;) {
        const bool has_next = S.next(ui + 1, nxt);
        const char* nA = has_next ? (const char*)g.A + (size_t)nxt.pm * tstep : cA; const char* nB = has_next ? (const char*)g.Bt + (size_t)nxt.pn * tstep : cB;
        for (int t = 0; t < nt; t += 2) {
            const bool last = (t == nt - 2);
            const char* a1 = cA + (size_t)(t + 1) * kstep;
            const char* a2 = last ? nA : cA + (size_t)(t + 2) * kstep; const char* b2 = last ? nB : cB + (size_t)(t + 2) * kstep;
            const char* a3 = a2 + kstep; const char* b3 = b2 + kstep;
            if (last && has_next) S.a_ready(nxt);
            if constexpr (SP2) {
            PG8_LDB(B0, 0, 0); PG8_LDB(B1, 0, 1); PG8_SCHED; PG8_LDA(At, 0, 0); PG8_STAGE(PG8_SA(1, 1), a1 + hstep, voffA);
            PG8_WAIT_V(8); PG8_WAIT_L(0); PG8_BAR; PG8_MMA(0, 0, At, B0); PG8_MMA(0, 1, At, B1); PG8_BAR; PG8_SCHED;
            PG8_LDA(At, 0, 1); PG8_STAGE(PG8_SB(0, 0), b2, voffB); PG8_STAGE(PG8_SB(0, 1), b2 + hstep, voffB); PG8_STAGE(PG8_SA(0, 0), a2, voffA);
            PG8_WAIT_V(8); PG8_WAIT_L(0); PG8_BAR; PG8_MMA(1, 0, At, B0); PG8_MMA(1, 1, At, B1); PG8_BAR; PG8_SCHED;
            PG8_LDB(B0, 1, 0); PG8_LDB(B1, 1, 1); PG8_SCHED; PG8_LDA(At, 1, 0); PG8_STAGE(PG8_SA(0, 1), a2 + hstep, voffA);
            PG8_WAIT_V(8); PG8_WAIT_L(0); PG8_BAR; PG8_MMA(0, 0, At, B0); PG8_MMA(0, 1, At, B1); PG8_BAR; PG8_SCHED;
            PG8_LDA(At, 1, 1); PG8_STAGE(PG8_SB(1, 0), b3, voffB); PG8_STAGE(PG8_SB(1, 1), b3 + hstep, voffB); PG8_STAGE(PG8_SA(1, 0), a3, voffA);
            PG8_WAIT_V(8); PG8_WAIT_L(0); PG8_BAR; PG8_MMA(1, 0, At, B0); PG8_MMA(1, 1, At, B1); PG8_BAR; PG8_SCHED;
            } else {
            PG8_LDB(B0, 0, 0); PG8_SCHED; PG8_LDA(At, 0, 0); PG8_STAGE(PG8_SA(1, 1), a1 + hstep, voffA);
            PG8_WAIT_L(8); PG8_BAR; PG8_WAIT_L(0); PG8_MMA(0, 0, At, B0); PG8_BAR; PG8_SCHED;
            PG8_LDB(B1, 0, 1); PG8_STAGE(PG8_SB(0, 0), b2, voffB);
            PG8_BAR; PG8_WAIT_L(0); PG8_MMA(0, 1, At, B1); PG8_BAR;
            PG8_LDA(At, 0, 1); PG8_STAGE(PG8_SA(0, 0), a2, voffA);
            PG8_BAR; PG8_WAIT_L(0); PG8_MMA(1, 0, At, B0); PG8_BAR; PG8_SCHED;
            PG8_STAGE(PG8_SB(0, 1), b2 + hstep, voffB);
            PG8_WAIT_V(6); PG8_BAR; PG8_MMA(1, 1, At, B1); PG8_BAR;
            PG8_LDB(B0, 1, 0); PG8_SCHED; PG8_LDA(At, 1, 0); PG8_STAGE(PG8_SA(0, 1), a2 + hstep, voffA);
            PG8_WAIT_L(8); PG8_BAR; PG8_WAIT_L(0); PG8_MMA(0, 0, At, B0); PG8_BAR; PG8_SCHED;
            PG8_LDB(B1, 1, 1); PG8_STAGE(PG8_SB(1, 0), b3, voffB);
            PG8_BAR; PG8_WAIT_L(0); PG8_MMA(0, 1, At, B1); PG8_BAR;
            PG8_LDA(At, 1, 1); PG8_STAGE(PG8_SA(1, 0), a3, voffA);
            PG8_BAR; PG8_WAIT_L(0); PG8_MMA(1, 0, At, B0); PG8_BAR; PG8_SCHED;
            PG8_STAGE(PG8_SB(1, 1), b3 + hstep, voffB);
            PG8_WAIT_V(6); PG8_BAR; PG8_MMA(1, 1, At, B1); PG8_BAR;
            }
        }
        if constexpr (ALIGN_EPI) { if (wr == 0) PG8_BAR; }
        if constexpr (!Epi::AFTER_DRAIN) { E(acc, cur, wr, wc, fr, fq); S.done(cur); }
        if (!has_next) break;
#pragma unroll
        for (int a = 0; a < 2; ++a)
#pragma unroll
            for (int b = 0; b < 2; ++b)
#pragma unroll
                for (int m = 0; m < 4; ++m)
#pragma unroll
                    for (int n = 0; n < 2; ++n) acc[a][b][m][n] = (f32x4){0.f, 0.f, 0.f, 0.f};
        cur = nxt; cA = nA; cB = nB; ++ui;
        if constexpr (ALIGN_EPI) { if (wr == 1) PG8_BAR; }
    }
    PG8_WAIT_V(0);
    if constexpr (!ALIGN_EPI) { if (wr == 0) PG8_BAR; }
    PG8_BAR;
    if constexpr (Epi::AFTER_DRAIN) { E.fused(acc, cur, wr, wc, fr, fq, lds, wid, lane); S.done(cur); }
#undef PG8_SA
#undef PG8_SB
#undef PG8_STAGE
#undef PG8_LDA
#undef PG8_LDB
#undef PG8_MMA
#undef PG8_WAIT_V
#undef PG8_WAIT_L
#undef PG8_BAR
#undef PG8_SCHED
}
}

#define GAS __attribute__((address_space(1)))
#define LAS __attribute__((address_space(3)))
typedef unsigned short bf16;
typedef float f32x4 __attribute__((ext_vector_type(4)));
typedef short bf16x8 __attribute__((ext_vector_type(8)));
typedef unsigned u32x4 __attribute__((ext_vector_type(4)));
typedef unsigned u32x2 __attribute__((ext_vector_type(2)));

constexpr int NWAVES = 8;
constexpr int SEQ = 16384, DMODEL = 2048, NMEM = 256, DIN = 3584, DCONV = 768, DPOOL = 768, DXATT = 512, DFF = 5632, DFF2 = 11264;
constexpr int PGD = 192;
constexpr float EPS = 1e-6f;
constexpr int LDS_BYTES = 147456;
#ifndef MK_PER_PHASE
#define MK_PER_PHASE 0
#endif
constexpr int NPHASE = 10;
#ifndef PHM
#define PHM 255
#endif

constexpr size_t MiB = 1u << 20;
constexpr size_t WS_KB = 1 * MiB;
constexpr size_t WS_VT = 1 * MiB + 256 * 1024;
constexpr size_t WS_POOLWT = 1 * MiB + 512 * 1024;
constexpr size_t WS_MB = 2 * MiB;
constexpr size_t WS_WKVT = 3 * MiB;
constexpr size_t WS_HALOB = 7 * MiB;
constexpr size_t WS_SLAB1 = 8 * MiB;
constexpr size_t WS_SLAB2 = 10 * MiB;
constexpr size_t WS_WUPT = 12 * MiB;
constexpr size_t WS_WDOWNT = 56 * MiB;
constexpr size_t WS_U = 80 * MiB;
constexpr size_t WS_ACT = 256 * MiB;
constexpr size_t WS_X1B = 432 * MiB;
constexpr size_t WS_H = 80 * MiB;
constexpr size_t WS_Z = 144 * MiB;
constexpr size_t WS_MIX = 256 * MiB;
constexpr size_t WS_WINT = 320 * MiB;
constexpr size_t WS_WOUTT = 334 * MiB;
constexpr size_t WS_END = 496 * MiB;

__device__ __forceinline__ unsigned f2bf(float f) { unsigned u = __builtin_bit_cast(unsigned, f); return (u + 0x7fffu + ((u >> 16) & 1u)) >> 16; }
__device__ __forceinline__ unsigned pk2(float lo, float hi) { return f2bf(lo) | (f2bf(hi) << 16); }
__device__ __forceinline__ float bflo(unsigned w) { return __builtin_bit_cast(float, w << 16); }
__device__ __forceinline__ float bfhi(unsigned w) { return __builtin_bit_cast(float, w & 0xffff0000u); }
__device__ __forceinline__ void unpack8(const u32x4 w, float (&f)[8]) { f[0] = bflo(w.x); f[1] = bfhi(w.x); f[2] = bflo(w.y); f[3] = bfhi(w.y); f[4] = bflo(w.z); f[5] = bfhi(w.z); f[6] = bflo(w.w); f[7] = bfhi(w.w); }
__device__ __forceinline__ u32x4 pack8(const float (&f)[8]) { u32x4 w; w.x = pk2(f[0], f[1]); w.y = pk2(f[2], f[3]); w.z = pk2(f[4], f[5]); w.w = pk2(f[6], f[7]); return w; }
__device__ __forceinline__ float wave_sum(float v) {
#pragma unroll
    for (int o = 1; o < 64; o <<= 1) v += __shfl_xor(v, o);
    return v;
}
#define LDS_WAIT() asm volatile("s_waitcnt lgkmcnt(0)" ::: "memory")

__device__ __forceinline__ void p0_transpose_item(const float* W, int K, int N, bf16* WT, const float* ks, LAS float* scr, int item, int lane) {
    const int nblk = N / 32, kb = item / nblk, nb = item % nblk, k0 = 64 * kb, n0 = 32 * nb;
#pragma unroll 8
    for (int i = 0; i < 32; ++i) { const int kk = 2 * i + (lane >> 5); float v = W[(size_t)(k0 + kk) * N + n0 + (lane & 31)]; if (ks) v *= ks[k0 + kk]; scr[kk * 33 + (lane & 31)] = v; }
    LDS_WAIT(); asm volatile("" ::: "memory");
    const int c = lane & 7;
#pragma unroll
    for (int j = 0; j < 4; ++j) { const int n = (lane >> 3) + 8 * j; const LAS float* s = scr + (8 * c) * 33 + n;
        u32x4 o; o.x = pk2(s[0 * 33], s[1 * 33]); o.y = pk2(s[2 * 33], s[3 * 33]); o.z = pk2(s[4 * 33], s[5 * 33]); o.w = pk2(s[6 * 33], s[7 * 33]);
        *(u32x4*)(WT + (size_t)(n0 + n) * K + k0 + 8 * c) = o; }
    LDS_WAIT(); asm volatile("" ::: "memory");
}
__device__ __forceinline__ void rms_row_to_bf16(const float* xrow, const float* g, bf16* orow, int lane) {
    const f32x4* xr = (const f32x4*)xrow + lane; const f32x4* gr = (const f32x4*)g + lane;
    f32x4 v[8]; float s = 0.f;
#pragma unroll
    for (int j = 0; j < 8; ++j) { v[j] = xr[64 * j]; s += (v[j].x * v[j].x + v[j].y * v[j].y) + (v[j].z * v[j].z + v[j].w * v[j].w); }
    const float rstd = 1.0f / sqrtf(wave_sum(s) * (1.0f / DMODEL) + EPS);
    u32x2* o8 = (u32x2*)orow + lane;
#pragma unroll
    for (int j = 0; j < 8; ++j) { const f32x4 gg = gr[64 * j]; u32x2 w; w.x = pk2(v[j].x * rstd * gg.x, v[j].y * rstd * gg.y); w.y = pk2(v[j].z * rstd * gg.z, v[j].w * rstd * gg.w); o8[64 * j] = w; }
}

struct Ptrs {
    const float *x, *mem, *g_mix, *g_mem, *w_in, *conv_w, *pool_w, *pool_scale, *w_kv, *w_out, *g_ffn, *w_up, *ffn_conv_w, *ffn_conv_b, *w_down, *g_final;
    float* out; unsigned char* ws;
};

__device__ __forceinline__ void p0_prologue(const Ptrs& P, LAS unsigned char* lds, int gw, int NGW, int wave, int lane) {
    LAS float* scr = (LAS float*)(lds + wave * 16384);
    unsigned char* ws = P.ws;
    constexpr int I_IN = (DMODEL / 64) * (DIN / 32), I_OUT = (DMODEL / 64) * (DMODEL / 32), I_UP = (DMODEL / 64) * (DFF2 / 32), I_DN = (DFF / 64) * (DMODEL / 32),
                  I_KV = (DMODEL / 64) * (1024 / 32), I_PW = (PGD / 64) * (PGD / 32);
    constexpr int NITEMS = I_IN + I_OUT + I_UP + I_DN + I_KV + 4 * I_PW;
    for (int it = gw; it < NITEMS; it += NGW) {
        int r = it;
        if (r < I_IN) { p0_transpose_item(P.w_in, DMODEL, DIN, (bf16*)(ws + WS_WINT), nullptr, scr, r, lane); continue; } r -= I_IN;
        if (r < I_OUT) { p0_transpose_item(P.w_out, DMODEL, DMODEL, (bf16*)(ws + WS_WOUTT), nullptr, scr, r, lane); continue; } r -= I_OUT;
        if (r < I_UP) { p0_transpose_item(P.w_up, DMODEL, DFF2, (bf16*)(ws + WS_WUPT), P.g_ffn, scr, r, lane); continue; } r -= I_UP;
        if (r < I_DN) { p0_transpose_item(P.w_down, DFF, DMODEL, (bf16*)(ws + WS_WDOWNT), nullptr, scr, r, lane); continue; } r -= I_DN;
        if (r < I_KV) { p0_transpose_item(P.w_kv, DMODEL, 1024, (bf16*)(ws + WS_WKVT), nullptr, scr, r, lane); continue; } r -= I_KV;
        const int g = r / I_PW; r -= g * I_PW;
        p0_transpose_item(P.pool_w + (size_t)g * PGD * PGD, PGD, PGD, (bf16*)(ws + WS_POOLWT) + (size_t)g * PGD * PGD, nullptr, scr, r, lane);
    }
    for (int m = gw; m < SEQ; m += NGW) rms_row_to_bf16(P.x + (size_t)m * DMODEL, P.g_mix, (bf16*)(ws + WS_H) + (size_t)m * DMODEL, lane);
    for (int m = gw; m < NMEM; m += NGW) rms_row_to_bf16(P.mem + (size_t)m * DMODEL, P.g_mem, (bf16*)(ws + WS_MB) + (size_t)m * DMODEL, lane);
}

__device__ __forceinline__ void kv_tile(const Ptrs& P, int tt, int lane) {
    const bf16* mB = (const bf16*)(P.ws + WS_MB); const bf16* wT = (const bf16*)(P.ws + WS_WKVT);
    const int rb = tt >> 6, cb = tt & 63, fr = lane & 15, fq = lane >> 4;
    const bf16* ap = mB + (size_t)(16 * rb + fr) * DMODEL + 8 * fq; const bf16* wp = wT + (size_t)(16 * cb + fr) * DMODEL + 8 * fq;
    f32x4 acc = {0.f, 0.f, 0.f, 0.f};
    if (cb < 32) {
#pragma unroll 8
        for (int ks = 0; ks < 64; ++ks) { const bf16x8 a = *(const bf16x8*)(ap + 32 * ks), w = *(const bf16x8*)(wp + 32 * ks); acc = __builtin_amdgcn_mfma_f32_16x16x32_bf16(w, a, acc, 0, 0, 0); }
        u32x2 o; o.x = pk2(acc[0], acc[1]); o.y = pk2(acc[2], acc[3]);
        *(u32x2*)((bf16*)(P.ws + WS_KB) + (size_t)(16 * rb + fr) * 512 + 16 * cb + 4 * fq) = o;
    } else {
#pragma unroll 8
        for (int ks = 0; ks < 64; ++ks) { const bf16x8 a = *(const bf16x8*)(ap + 32 * ks), w = *(const bf16x8*)(wp + 32 * ks); acc = __builtin_amdgcn_mfma_f32_16x16x32_bf16(a, w, acc, 0, 0, 0); }
        u32x2 o; o.x = pk2(acc[0], acc[1]); o.y = pk2(acc[2], acc[3]);
        *(u32x2*)((bf16*)(P.ws + WS_VT) + (size_t)(16 * cb - 512 + fr) * 256 + 32 * (rb >> 1) + 8 * fq + 4 * (rb & 1)) = o;
    }
}

__device__ __forceinline__ void mix_conv_task(const Ptrs& P, int blk, int lane) {
    const bf16* z = (const bf16*)(P.ws + WS_Z); bf16* mix = (bf16*)(P.ws + WS_MIX);
    const int t0 = blk * 16;
    for (int cg = lane; cg < DCONV / 8; cg += 64) {
        const int c = cg * 8;
        float w0[8], w1[8], w2[8], p1[8], p2[8];
#pragma unroll
        for (int e = 0; e < 8; ++e) { w0[e] = P.conv_w[c + e]; w1[e] = P.conv_w[DCONV + c + e]; w2[e] = P.conv_w[2 * DCONV + c + e]; p1[e] = 0.f; p2[e] = 0.f; }
        for (int r = -2; r < 16; ++r) {
            const int t = t0 + r; float p[8];
            if (t >= 0) { float a[8], b[8]; unpack8(*(const u32x4*)(z + (size_t)t * DIN + DCONV + c), a); unpack8(*(const u32x4*)(z + (size_t)t * DIN + 2 * DCONV + c), b);
#pragma unroll
                for (int e = 0; e < 8; ++e) p[e] = a[e] * b[e]; }
            else {
#pragma unroll
                for (int e = 0; e < 8; ++e) p[e] = 0.f; }
            if (r >= 0) { float g[8], o[8]; unpack8(*(const u32x4*)(z + (size_t)t * DIN + c), g);
#pragma unroll
                for (int e = 0; e < 8; ++e) o[e] = g[e] * (w2[e] * p[e] + w1[e] * p1[e] + w0[e] * p2[e]);
                *(u32x4*)(mix + (size_t)t * DMODEL + c) = pack8(o); }
#pragma unroll
            for (int e = 0; e < 8; ++e) { p2[e] = p1[e]; p1[e] = p[e]; }
        }
    }
}
__device__ __forceinline__ void mix_pool_task(const Ptrs& P, int g, int blk, int lane) {
    const bf16* z = (const bf16*)(P.ws + WS_Z); bf16* mix = (bf16*)(P.ws + WS_MIX); const bf16* wt = (const bf16*)(P.ws + WS_POOLWT) + (size_t)g * PGD * PGD;
    const int fr = lane & 15, fq = lane >> 4, t = blk * 16 + fr, k = 2 << g;
    const int cnt = (t + 1 < k) ? t + 1 : k; const float inv = 1.0f / (float)cnt;
    f32x4 acc[12];
#pragma unroll
    for (int n = 0; n < 12; ++n) acc[n] = (f32x4){0.f, 0.f, 0.f, 0.f};
    for (int ks = 0; ks < 6; ++ks) {
        const int c = 32 * ks + 8 * fq; const bf16* zc = z + 3 * DCONV + PGD * g + c;
        float sum[8], self[8];
        unpack8(*(const u32x4*)(zc + (size_t)t * DIN), self);
#pragma unroll
        for (int e = 0; e < 8; ++e) sum[e] = self[e];
        for (int j = 1; j < k; ++j) { const int tt = t - j; const bool ok = tt >= 0; float v[8]; unpack8(*(const u32x4*)(zc + (size_t)(ok ? tt : 0) * DIN), v);
#pragma unroll
            for (int e = 0; e < 8; ++e) sum[e] += ok ? v[e] : 0.f; }
        float pl[8];
#pragma unroll
        for (int e = 0; e < 8; ++e) pl[e] = sum[e] * inv - self[e];
        const bf16x8 pf = __builtin_bit_cast(bf16x8, pack8(pl));
#pragma unroll
        for (int n = 0; n < 12; ++n) { const bf16x8 wf = *(const bf16x8*)(wt + (size_t)(16 * n + fr) * PGD + c); acc[n] = __builtin_amdgcn_mfma_f32_16x16x32_bf16(wf, pf, acc[n], 0, 0, 0); }
    }
#pragma unroll
    for (int n = 0; n < 12; ++n) { const int d = 16 * n + 4 * fq; const f32x4 sc = *(const f32x4*)(P.pool_scale + PGD * g + d);
        u32x2 o; o.x = pk2(acc[n][0] * sc[0], acc[n][1] * sc[1]); o.y = pk2(acc[n][2] * sc[2], acc[n][3] * sc[3]);
        *(u32x2*)(mix + (size_t)t * DMODEL + DCONV + PGD * g + d) = o; }
}
__device__ __forceinline__ void mix_attn_task(const Ptrs& P, int h, int blk, int lane) {
    const bf16* z = (const bf16*)(P.ws + WS_Z); bf16* mix = (bf16*)(P.ws + WS_MIX); const bf16* Kb = (const bf16*)(P.ws + WS_KB); const bf16* Vt = (const bf16*)(P.ws + WS_VT);
    const int fr = lane & 15, fq = lane >> 4, t = blk * 16 + fr;
    bf16x8 qf[4];
#pragma unroll
    for (int ks = 0; ks < 4; ++ks) qf[ks] = *(const bf16x8*)(z + (size_t)t * DIN + 3 * DCONV + DPOOL + 128 * h + 32 * ks + 8 * fq);
    f32x4 s[16];
#pragma unroll
    for (int kb = 0; kb < 16; ++kb) { s[kb] = (f32x4){0.f, 0.f, 0.f, 0.f};
#pragma unroll
        for (int ks = 0; ks < 4; ++ks) { const bf16x8 kf = *(const bf16x8*)(Kb + (size_t)(16 * kb + fr) * 512 + 128 * h + 32 * ks + 8 * fq); s[kb] = __builtin_amdgcn_mfma_f32_16x16x32_bf16(kf, qf[ks], s[kb], 0, 0, 0); } }
    float mx = -3.0e38f;
#pragma unroll
    for (int kb = 0; kb < 16; ++kb) mx = fmaxf(fmaxf(fmaxf(s[kb][0], s[kb][1]), fmaxf(s[kb][2], s[kb][3])), mx);
    mx = fmaxf(mx, __shfl_xor(mx, 16)); mx = fmaxf(mx, __shfl_xor(mx, 32));
    const float c2 = 0.08838834764831845f * 1.4426950408889634f;
    float sum = 0.f;
#pragma unroll
    for (int kb = 0; kb < 16; ++kb)
#pragma unroll
        for (int r = 0; r < 4; ++r) { const float p = __builtin_amdgcn_exp2f((s[kb][r] - mx) * c2); s[kb][r] = p; sum += p; }
    sum += __shfl_xor(sum, 16); sum += __shfl_xor(sum, 32);
    const float inv = 1.0f / sum;
    f32x4 o[8];
#pragma unroll
    for (int db = 0; db < 8; ++db) o[db] = (f32x4){0.f, 0.f, 0.f, 0.f};
#pragma unroll
    for (int ks = 0; ks < 8; ++ks) {
        u32x4 pw; pw.x = pk2(s[2 * ks][0], s[2 * ks][1]); pw.y = pk2(s[2 * ks][2], s[2 * ks][3]); pw.z = pk2(s[2 * ks + 1][0], s[2 * ks + 1][1]); pw.w = pk2(s[2 * ks + 1][2], s[2 * ks + 1][3]);
        const bf16x8 pf = __builtin_bit_cast(bf16x8, pw);
#pragma unroll
        for (int db = 0; db < 8; ++db) { const bf16x8 vf = *(const bf16x8*)(Vt + (size_t)(128 * h + 16 * db + fr) * 256 + 32 * ks + 8 * fq); o[db] = __builtin_amdgcn_mfma_f32_16x16x32_bf16(vf, pf, o[db], 0, 0, 0); }
    }
#pragma unroll
    for (int db = 0; db < 8; ++db) { u32x2 w; w.x = pk2(o[db][0] * inv, o[db][1] * inv); w.y = pk2(o[db][2] * inv, o[db][3] * inv);
        *(u32x2*)(mix + (size_t)t * DMODEL + DCONV + DPOOL + 128 * h + 16 * db + 4 * fq) = w; }
}
__device__ __forceinline__ void p2_mixer(const Ptrs& P, int gw, int NGW, int lane) {
    constexpr int NBLK = SEQ / 16;
    for (int it = gw; it < 9 * NBLK; it += NGW) {
        const int task = it / NBLK, blk = it % NBLK;
        if (task == 0) mix_conv_task(P, blk, lane);
        else if (task < 5) mix_pool_task(P, task - 1, blk, lane);
        else mix_attn_task(P, task - 5, blk, lane);
    }
}

__device__ __forceinline__ void p5_act(const Ptrs& P, int half, int gw, int NGW, int lane) {
    const bf16* U = (const bf16*)(P.ws + WS_U); const bf16* haloB = (const bf16*)(P.ws + WS_HALOB); bf16* act = (bf16*)(P.ws + WS_ACT);
    constexpr int NCB = DFF / 512, RS = 32, NSTRIP = 8192 / RS;
    for (int it = gw; it < NSTRIP * NCB; it += NGW) {
        const int cbk = it % NCB, strip = it / NCB, c = cbk * 512 + lane * 8, r0 = strip * RS;
        float wg0[8], wg1[8], wg2[8], bg[8], wv0[8], wv1[8], wv2[8], bv[8], g1[8], g2[8], v1[8], v2[8];
#pragma unroll
        for (int e = 0; e < 8; ++e) { wg0[e] = P.ffn_conv_w[c + e]; wg1[e] = P.ffn_conv_w[DFF2 + c + e]; wg2[e] = P.ffn_conv_w[2 * DFF2 + c + e]; bg[e] = P.ffn_conv_b[c + e];
            wv0[e] = P.ffn_conv_w[DFF + c + e]; wv1[e] = P.ffn_conv_w[DFF2 + DFF + c + e]; wv2[e] = P.ffn_conv_w[2 * DFF2 + DFF + c + e]; bv[e] = P.ffn_conv_b[DFF + c + e]; g1[e] = g2[e] = v1[e] = v2[e] = 0.f; }
        for (int r = -2; r < RS; ++r) {
            const int rl = r0 + r, tg = half * 8192 + rl;
            float g[8], v[8];
            if (tg >= 0) { const bf16* src = (rl >= 0) ? U + (size_t)rl * DFF2 : haloB + (size_t)(tg - 8190) * DFF2;
                unpack8(*(const u32x4*)(src + c), g); unpack8(*(const u32x4*)(src + DFF + c), v); }
            else {
#pragma unroll
                for (int e = 0; e < 8; ++e) { g[e] = 0.f; v[e] = 0.f; } }
            if (r >= 0) { float o[8];
#pragma unroll
                for (int e = 0; e < 8; ++e) { const float G = wg2[e] * g[e] + wg1[e] * g1[e] + wg0[e] * g2[e] + bg[e], V = wv2[e] * v[e] + wv1[e] * v1[e] + wv0[e] * v2[e] + bv[e];
                    o[e] = G * __builtin_amdgcn_rcpf(1.0f + __expf(-G)) * V; }
                *(u32x4*)(act + (size_t)tg * DFF + c) = pack8(o); }
#pragma unroll
            for (int e = 0; e < 8; ++e) { g2[e] = g1[e]; g1[e] = g[e]; v2[e] = v1[e]; v1[e] = v[e]; }
        }
    }
}

__device__ __forceinline__ void p7_final(const Ptrs& P, int gw, int NGW, int lane) {
    const float* slab = (const float*)(P.ws + WS_SLAB2);
    for (int m = gw; m < SEQ; m += NGW) {
        const float part = (lane < 32) ? slab[(size_t)m * 32 + lane] : 0.f;
        const float rstd = 1.0f / sqrtf(wave_sum(part) * (1.0f / DMODEL) + EPS);
        f32x4* xr = (f32x4*)(P.out + (size_t)m * DMODEL) + lane; const f32x4* gr = (const f32x4*)P.g_final + lane;
#pragma unroll
        for (int j = 0; j < 8; ++j) { f32x4 v = xr[64 * j]; const f32x4 gg = gr[64 * j]; v = v * rstd * gg; xr[64 * j] = v; }
    }
}

struct Args { const float* in[16]; float* out; unsigned char* ws; int ph_lo, ph_hi; };
__global__ void __launch_bounds__(NWAVES * 64, 2) hybrid_fwd(Args args) {
    extern __shared__ __attribute__((aligned(16))) unsigned char lds_raw[];
    LAS unsigned char* lds = (LAS unsigned char*)lds_raw;
    cg::grid_group grid = cg::this_grid();
    const int tid = threadIdx.x, lane = tid & 63, wave = __builtin_amdgcn_readfirstlane(tid >> 6);
    const int G = gridDim.x, bx = blockIdx.x, vcu = (G % 8 == 0) ? (bx % 8) * (G / 8) + bx / 8 : bx;
    const int gw = vcu * NWAVES + wave, NGW = G * NWAVES;
    Ptrs P;
    P.x = args.in[0]; P.mem = args.in[1]; P.g_mix = args.in[2]; P.g_mem = args.in[3]; P.w_in = args.in[4]; P.conv_w = args.in[5]; P.pool_w = args.in[6]; P.pool_scale = args.in[7];
    P.w_kv = args.in[8]; P.w_out = args.in[9]; P.g_ffn = args.in[10]; P.w_up = args.in[11]; P.ffn_conv_w = args.in[12]; P.ffn_conv_b = args.in[13]; P.w_down = args.in[14]; P.g_final = args.in[15];
    P.out = args.out; P.ws = args.ws;
    unsigned char* ws = args.ws;
    const int lo = args.ph_lo, hi = args.ph_hi;
#define IN(k) (lo <= (k) && (k) < hi)
#define SYNC(k) do { if ((k) + 1 < hi) grid.sync(); } while (0)
    if (IN(0) && (PHM & 1)) { p0_prologue(P, lds, gw, NGW, wave, lane); SYNC(0); }
    if (IN(1) && (PHM & 2)) {
        pg8::Gemm g{(const bf16*)(ws + WS_H), (const bf16*)(ws + WS_WINT), SEQ, DIN, DMODEL}; pg8::StaticOrder S; S.init(SEQ, DIN, G, bx);
        pg8::EpiZ E{(bf16*)(ws + WS_Z), DIN};
        pg8::gemm_phase<pg8::EpiZ, pg8::StaticOrder, true, true>(lds, g, S, E);
        if (wave < 4) { for (int tt = vcu * 4 + wave; tt < 1024; tt += G * 4) kv_tile(P, tt, lane); }
        SYNC(1);
    }
    if (IN(2) && (PHM & 4)) { p2_mixer(P, gw, NGW, lane); SYNC(2); }
    if (IN(3) && (PHM & 8)) {
        pg8::Gemm g{(const bf16*)(ws + WS_MIX), (const bf16*)(ws + WS_WOUTT), SEQ, DMODEL, DMODEL}; pg8::StaticOrder S; S.init(SEQ, DMODEL, G, bx);
        pg8::EpiRes<true> E{P.x, P.out, (bf16*)(ws + WS_X1B), (float*)(ws + WS_SLAB1)};
        pg8::gemm_phase<pg8::EpiRes<true>, pg8::StaticOrder, true, true>(lds, g, S, E);
        SYNC(3);
    }
    for (int half = 0; half < 2; ++half) {
        if (IN(4 + 2 * half) && (PHM & 16)) {
            pg8::Gemm g{(const bf16*)(ws + WS_X1B) + (size_t)half * 8192 * DMODEL, (const bf16*)(ws + WS_WUPT), 8192, DFF2, DMODEL}; pg8::StaticOrder S; S.init(8192, DFF2, G, bx);
            pg8::EpiU E{(bf16*)(ws + WS_U), DFF2, (const float*)(ws + WS_SLAB1), half * 8192, (bf16*)(ws + WS_HALOB)};
            pg8::gemm_phase<pg8::EpiU, pg8::StaticOrder, true, true>(lds, g, S, E);
            SYNC(4 + 2 * half);
        }
        if (IN(5 + 2 * half) && (PHM & 32)) { p5_act(P, half, gw, NGW, lane); SYNC(5 + 2 * half); }
    }
    if (IN(8) && (PHM & 64)) {
        pg8::Gemm g{(const bf16*)(ws + WS_ACT), (const bf16*)(ws + WS_WDOWNT), SEQ, DMODEL, DFF}; pg8::StaticOrder S; S.init(SEQ, DMODEL, G, bx);
        pg8::EpiRes<false> E{P.out, P.out, nullptr, (float*)(ws + WS_SLAB2)};
        pg8::gemm_phase<pg8::EpiRes<false>, pg8::StaticOrder, true, true>(lds, g, S, E);
        SYNC(8);
    }
    if (IN(9) && (PHM & 128)) p7_final(P, gw, NGW, lane);
#undef IN
#undef SYNC
}

extern "C" void kernel_launch(void* const* d_in, const int* in_sizes, int n_in, void* d_out, int out_size, void* d_ws, size_t ws_size, hipStream_t stream) {
    static int grid = 0;
    if (grid == 0) {
        if (n_in != 16 || in_sizes[0] != SEQ * DMODEL || out_size != SEQ * DMODEL || ws_size < WS_END) { fprintf(stderr, "kernel_launch: unexpected shapes (n_in %d, in0 %d, out %d, ws %zu)\n", n_in, n_in > 0 ? in_sizes[0] : -1, out_size, ws_size); grid = -1; return; }
        int dev = 0, cus = 0, per_cu = 0;
        if (hipGetDevice(&dev) != hipSuccess || hipDeviceGetAttribute(&cus, hipDeviceAttributeMultiprocessorCount, dev) != hipSuccess) { grid = -1; return; }
        if (hipFuncSetAttribute((const void*)hybrid_fwd, hipFuncAttributeMaxDynamicSharedMemorySize, LDS_BYTES) != hipSuccess) { fprintf(stderr, "kernel_launch: hipFuncSetAttribute failed\n"); grid = -1; return; }
        if (hipOccupancyMaxActiveBlocksPerMultiprocessor(&per_cu, (const void*)hybrid_fwd, NWAVES * 64, LDS_BYTES) != hipSuccess || per_cu < 1) { fprintf(stderr, "kernel_launch: occupancy query says %d blocks per CU\n", per_cu); (void)hipGetLastError(); per_cu = 1; }
        grid = cus;
        if (grid % 8 != 0 || grid < 8) { fprintf(stderr, "kernel_launch: %d CUs\n", grid); }
    }
    if (grid < 0) return;
    Args a{};
    for (int i = 0; i < 16; ++i) a.in[i] = (const float*)d_in[i];
    a.out = (float*)d_out; a.ws = (unsigned char*)d_ws;
#if MK_PER_PHASE
    for (int ph = 0; ph < NPHASE; ++ph) { a.ph_lo = ph; a.ph_hi = ph + 1; hipLaunchKernelGGL(hybrid_fwd, dim3(grid), dim3(NWAVES * 64), LDS_BYTES, stream, a); }
#else
    a.ph_lo = 0; a.ph_hi = NPHASE;
    void* kargs[] = {&a};
    hipError_t e = hipLaunchCooperativeKernel((const void*)hybrid_fwd, dim3(grid), dim3(NWAVES * 64), kargs, LDS_BYTES, stream);
    if (e != hipSuccess) fprintf(stderr, "kernel_launch: cooperative launch failed: %s (grid %d)\n", hipGetErrorString(e), grid);
#endif
}
```

```cpp
#include <hip/hip_runtime.h>
#include <hip/hip_cooperative_groups.h>
#include <cstdio>
#include <cstdint>
namespace cg = cooperative_groups;
namespace pg8 {
#define PG8_LAS __attribute__((address_space(3)))
typedef unsigned short bf16_t;
typedef short bf16x8 __attribute__((ext_vector_type(8)));
typedef float f32x4 __attribute__((ext_vector_type(4)));
typedef unsigned u32x4 __attribute__((ext_vector_type(4)));
constexpr int BM = 256, BK = 64, HALF = 128, HTB = HALF * BK * 2  , STAGE_BYTES = 8 * HTB, NXCD = 8, WGM = 8;

__host__ __device__ __forceinline__ int lds_byte(int r, int c) { const int st = (r >> 4) * 2 + (c >> 5), rr = r & 15, cc = c & 31, ob = rr * 64 + cc * 2; return st * 1024 + (ob ^ (((ob >> 9) & 1) << 5)); }
__host__ __device__ __forceinline__ void stage_rc(int b, int& R, int& C) { const int st = b / 1024, sb = b % 1024, swz = sb ^ (((sb >> 9) & 1) << 5); R = (st >> 1) * 16 + swz / 64; C = (st & 1) * 32 + (swz % 64) / 2; }
__host__ __device__ __forceinline__ int perm32(int rho) { const int n = rho >> 4, i = rho & 15; return 8 * (i >> 2) + 4 * n + (i & 3); }

struct Unit { int pm, pn; };
struct Gemm { const bf16_t* A; const bf16_t* Bt; int M, N, K; };

struct StaticOrder {
    int nM, nN, nwg, G, c;
    __host__ __device__ void init(int M, int N, int G_, int c_) { nM = M / BM; nN = N / BM; nwg = nM * nN; G = G_; c = c_; }
    __host__ __device__ bool next(int i, Unit& u) const {
        const long L = (long)i * G + c; if (L >= nwg) return false;
        int wgid = (int)L; { const int q = nwg / NXCD, r = nwg % NXCD, xcd = wgid % NXCD, off = wgid / NXCD; wgid = (xcd < r ? xcd * (q + 1) : r * (q + 1) + (xcd - r) * q) + off; }
        const int nig = WGM * nN, gid = wgid / nig, fm = gid * WGM, gsz = (nM - fm) < WGM ? (nM - fm) : WGM;
        u.pm = fm + ((wgid % nig) % gsz); u.pn = (wgid % nig) / gsz; return true;
    }
    __device__ __forceinline__ void a_ready(const Unit&) const {}
    __device__ __forceinline__ void done(const Unit&) const {}
};
__device__ __forceinline__ unsigned cvt_pk_bf16(float lo, float hi) { unsigned r; asm volatile("v_cvt_pk_bf16_f32 %0, %1, %2" : "=v"(r) : "v"(lo), "v"(hi)); return r; }
typedef unsigned u32x2 __attribute__((ext_vector_type(2)));
constexpr int DM = 2048;
constexpr float RMS_EPS = 1e-6f;

struct EpiZ {
    static constexpr bool PERM = true, AFTER_DRAIN = false;
    bf16_t* O; int ldc;
    __device__ __forceinline__ void operator()(const f32x4 (&acc)[2][2][4][2], const Unit& u, int wr, int wc, int fr_, int fq_) const {
        int t_ = threadIdx.x; asm volatile("" : "+v"(t_));
        const int fr = t_ & 15, fq = (t_ >> 4) & 3;
        const int row0 = u.pm * BM + wr * 64 + fr, col0 = u.pn * BM + wc * 32 + 8 * fq;
#pragma unroll
        for (int ai = 0; ai < 2; ++ai)
#pragma unroll
            for (int m = 0; m < 4; ++m) { bf16_t* rowp = O + (size_t)(row0 + ai * HALF + m * 16) * ldc + col0;
#pragma unroll
                for (int bj = 0; bj < 2; ++bj) { const f32x4 v0 = acc[ai][bj][m][0], v1 = acc[ai][bj][m][1];
                    u32x4 w; w.x = cvt_pk_bf16(v0[0], v0[1]); w.y = cvt_pk_bf16(v0[2], v0[3]); w.z = cvt_pk_bf16(v1[0], v1[1]); w.w = cvt_pk_bf16(v1[2], v1[3]);
                    *(u32x4*)(rowp + bj * HALF) = w; } }
    }
};

struct EpiNone {
    static constexpr bool PERM = true, AFTER_DRAIN = false;
    __device__ __forceinline__ void operator()(const f32x4 (&acc)[2][2][4][2], const Unit& u, int wr, int wc, int fr, int fq) const {
#pragma unroll
        for (int ai = 0; ai < 2; ++ai)
#pragma unroll
            for (int bj = 0; bj < 2; ++bj)
#pragma unroll
                for (int m = 0; m < 4; ++m)
#pragma unroll
                    for (int n = 0; n < 2; ++n) asm volatile("" :: "v"(acc[ai][bj][m][n]));
    }
};
template <bool WB> struct EpiRes {
    static constexpr bool PERM = true, AFTER_DRAIN = false;
    const float* R; float* X; bf16_t* XB; float* slab;
    __device__ __forceinline__ void operator()(const f32x4 (&acc)[2][2][4][2], const Unit& u, int wr, int wc, int fr_, int fq_) const {
        int t_ = threadIdx.x; asm volatile("" : "+v"(t_));
        const int fr = t_ & 15, fq = (t_ >> 4) & 3;
        const int row0 = u.pm * BM + wr * 64 + fr, col0 = u.pn * BM + wc * 32 + 8 * fq;
#pragma unroll
        for (int ai = 0; ai < 2; ++ai)
#pragma unroll
            for (int m = 0; m < 4; ++m) { const int row = row0 + ai * HALF + m * 16; const size_t off = (size_t)row * DM + col0; float ss = 0.f;
#pragma unroll
                for (int bj = 0; bj < 2; ++bj) {
                    const f32x4 r0 = *(const f32x4*)(R + off + bj * HALF), r1 = *(const f32x4*)(R + off + bj * HALF + 4);
                    const f32x4 v0 = acc[ai][bj][m][0] + r0, v1 = acc[ai][bj][m][1] + r1;
                    *(f32x4*)(X + off + bj * HALF) = v0; *(f32x4*)(X + off + bj * HALF + 4) = v1;
                    if (WB) { u32x4 w; w.x = cvt_pk_bf16(v0[0], v0[1]); w.y = cvt_pk_bf16(v0[2], v0[3]); w.z = cvt_pk_bf16(v1[0], v1[1]); w.w = cvt_pk_bf16(v1[2], v1[3]);
                        *(u32x4*)(XB + off + bj * HALF) = w; }
                    ss += (v0[0] * v0[0] + v0[1] * v0[1]) + (v0[2] * v0[2] + v0[3] * v0[3]) + (v1[0] * v1[0] + v1[1] * v1[1]) + (v1[2] * v1[2] + v1[3] * v1[3]); }
                ss += __shfl_xor(ss, 16); ss += __shfl_xor(ss, 32);
                if (fq == 0) slab[(size_t)row * 32 + u.pn * 4 + wc] = ss;
                asm volatile("" ::: "memory"); }
    }
};

struct EpiU {
    static constexpr bool PERM = true, AFTER_DRAIN = false;
    bf16_t* U; int ldu; const float* slab; int row_base; bf16_t* haloB;
    __device__ __forceinline__ void operator()(const f32x4 (&acc)[2][2][4][2], const Unit& u, int wr, int wc, int fr_, int fq_) const {
        int t_ = threadIdx.x; asm volatile("" : "+v"(t_));
        const int fr = t_ & 15, fq = (t_ >> 4) & 3;
        const int row0 = u.pm * BM + wr * 64 + fr, col0 = u.pn * BM + wc * 32 + 8 * fq;
#pragma unroll
        for (int ai = 0; ai < 2; ++ai)
#pragma unroll
            for (int m = 0; m < 4; ++m) { const int rl = row0 + ai * HALF + m * 16, rg = row_base + rl;
                const f32x4 pa = *(const f32x4*)(slab + (size_t)rg * 32 + 8 * fq), pb = *(const f32x4*)(slab + (size_t)rg * 32 + 8 * fq + 4);
                float s = ((pa[0] + pa[1]) + (pa[2] + pa[3])) + ((pb[0] + pb[1]) + (pb[2] + pb[3]));
                s += __shfl_xor(s, 16); s += __shfl_xor(s, 32);
                const float rstd = 1.0f / sqrtf(s * (1.0f / DM) + RMS_EPS);
                bf16_t* rowp = U + (size_t)rl * ldu + col0;
#pragma unroll
                for (int bj = 0; bj < 2; ++bj) { const f32x4 v0 = acc[ai][bj][m][0] * rstd, v1 = acc[ai][bj][m][1] * rstd;
                    u32x4 w; w.x = cvt_pk_bf16(v0[0], v0[1]); w.y = cvt_pk_bf16(v0[2], v0[3]); w.z = cvt_pk_bf16(v1[0], v1[1]); w.w = cvt_pk_bf16(v1[2], v1[3]);
                    *(u32x4*)(rowp + bj * HALF) = w;
                    if (rg == 8190 || rg == 8191) *(u32x4*)(haloB + (size_t)(rg - 8190) * ldu + col0 + bj * HALF) = w; } }
    }
};

template <class Epi, class Sched, bool ALIGN_EPI = false, bool SP2 = false>
__device__ __forceinline__ void gemm_phase(PG8_LAS unsigned char* lds, const Gemm g, const Sched& S, const Epi& E) {
    const int tid = threadIdx.x, wid = __builtin_amdgcn_readfirstlane(tid >> 6), lane = tid & 63, wr = wid >> 2, wc = wid & 3, fr = lane & 15, fq = lane >> 4;
    const int K = g.K, nt = K / BK;
    unsigned voffA[2], voffB[2];
#pragma unroll
    for (int i = 0; i < 2; ++i) { int R, C; stage_rc(tid * 16 + i * 8192, R, C); const int Rb = Epi::PERM ? ((R & ~31) + perm32(R & 31)) : R;
        voffA[i] = (unsigned)(R * K + C) * 2u; voffB[i] = (unsigned)(Rb * K + C) * 2u; }
    const size_t kstep = (size_t)(BK * 2);
    const size_t hstep = (size_t)HALF * K * 2;
    const size_t tstep = 2 * hstep;
    const unsigned ldsw = (unsigned)wid * 1024u;
    const int aoff = lds_byte(wr * 64 + fr, fq * 8), boff = lds_byte(wc * 32 + fr, fq * 8);
#define PG8_SA(b, h) (((b) * 2 + (h)) * HTB)
#define PG8_SB(b, h) ((4 + (b) * 2 + (h)) * HTB)
#define PG8_STAGE(bufoff, gbase, voff) do { _Pragma("unroll") for (int _i = 0; _i < 2; ++_i) \
        __builtin_amdgcn_global_load_lds((const unsigned*)((const char*)(gbase) + (voff)[_i]), (PG8_LAS unsigned*)(lds + (bufoff) + ldsw + _i * 8192), 16, 0, 0); } while (0)
#define PG8_LDA(dst, b, h) do { _Pragma("unroll") for (int m = 0; m < 4; ++m) _Pragma("unroll") for (int k = 0; k < 2; ++k) dst[m][k] = *(const PG8_LAS bf16x8*)(lds + PG8_SA(b, h) + aoff + m * 2048 + k * 1024); } while (0)
#define PG8_LDB(dst, b, h) do { _Pragma("unroll") for (int n = 0; n < 2; ++n) _Pragma("unroll") for (int k = 0; k < 2; ++k) dst[n][k] = *(const PG8_LAS bf16x8*)(lds + PG8_SB(b, h) + boff + n * 2048 + k * 1024); } while (0)
#define PG8_MMA(ai, bj, At, Bt) do { __builtin_amdgcn_s_setprio(1); _Pragma("unroll") for (int m = 0; m < 4; ++m) _Pragma("unroll") for (int n = 0; n < 2; ++n) _Pragma("unroll") for (int k = 0; k < 2; ++k) \
        acc[ai][bj][m][n] = __builtin_amdgcn_mfma_f32_16x16x32_bf16(Bt[n][k], At[m][k], acc[ai][bj][m][n], 0, 0, 0); __builtin_amdgcn_s_setprio(0); } while (0)
#define PG8_WAIT_V(n) asm volatile("s_waitcnt vmcnt(" #n ")" ::: "memory")
#define PG8_WAIT_L(n) asm volatile("s_waitcnt lgkmcnt(" #n ")" ::: "memory")
#define PG8_BAR __builtin_amdgcn_s_barrier()
#define PG8_SCHED __builtin_amdgcn_sched_barrier(0)
    Unit cur, nxt; int ui = 0;
    if (!S.next(0, cur)) return;
    f32x4 acc[2][2][4][2];
#pragma unroll
    for (int a = 0; a < 2; ++a)
#pragma unroll
        for (int b = 0; b < 2; ++b)
#pragma unroll
            for (int m = 0; m < 4; ++m)
#pragma unroll
                for (int n = 0; n < 2; ++n) acc[a][b][m][n] = (f32x4){0.f, 0.f, 0.f, 0.f};
    bf16x8 At[4][2], B0[2][2], B1[2][2];
    const char* cA = (const char*)g.A + (size_t)cur.pm * tstep; const char* cB = (const char*)g.Bt + (size_t)cur.pn * tstep;
    S.a_ready(cur);
    if constexpr (SP2) {
        PG8_STAGE(PG8_SB(0, 0), cB, voffB); PG8_STAGE(PG8_SB(0, 1), cB + hstep, voffB); PG8_STAGE(PG8_SA(0, 0), cA, voffA); PG8_STAGE(PG8_SA(0, 1), cA + hstep, voffA);
        if (wr == 1) PG8_BAR;
        PG8_WAIT_V(2); PG8_BAR;
        PG8_STAGE(PG8_SB(1, 0), cB + kstep, voffB); PG8_STAGE(PG8_SA(1, 0), cA + kstep, voffA); PG8_STAGE(PG8_SB(1, 1), cB + hstep + kstep, voffB);
        PG8_WAIT_V(6); PG8_BAR;
    } else {
        PG8_STAGE(PG8_SB(0, 0), cB, voffB); PG8_STAGE(PG8_SA(0, 0), cA, voffA); PG8_STAGE(PG8_SB(0, 1), cB + hstep, voffB); PG8_STAGE(PG8_SA(0, 1), cA + hstep, voffA);
        if (wr == 1) PG8_BAR;
        PG8_WAIT_V(4); PG8_BAR;
        PG8_STAGE(PG8_SB(1, 0), cB + kstep, voffB); PG8_STAGE(PG8_SA(1, 0), cA + kstep, voffA); PG8_STAGE(PG8_SB(1, 1), cB + hstep + kstep, voffB);
        PG8_WAIT_V(6); PG8_BAR;
    }
    for (;;) {
        const bool has_next = S.next(ui + 1, nxt);
        const char* nA = has_next ? (const char*)g.A + (size_t)nxt.pm * tstep : cA; const char* nB = has_next ? (const char*)g.Bt + (size_t)nxt.pn * tstep : cB;
        for (int t = 0; t < nt; t += 2) {
            const bool last = (t == nt - 2);
            const char* a1 = cA + (size_t)(t + 1) * kstep;
            const char* a2 = last ? nA : cA + (size_t)(t + 2) * kstep; const char* b2 = last ? nB : cB + (size_t)(t + 2) * kstep;
            const char* a3 = a2 + kstep; const char* b3 = b2 + kstep;
            if (last && has_next) S.a_ready(nxt);
            if constexpr (SP2) {
            PG8_LDB(B0, 0, 0); PG8_LDB(B1, 0, 1); PG8_SCHED; PG8_LDA(At, 0, 0); PG8_STAGE(PG8_SA(1, 1), a1 + hstep, voffA);
            PG8_WAIT_V(8); PG8_WAIT_L(0); PG8_BAR; PG8_MMA(0, 0, At, B0); PG8_MMA(0, 1, At, B1); PG8_BAR; PG8_SCHED;
            PG8_LDA(At, 0, 1); PG8_STAGE(PG8_SB(0, 0), b2, voffB); PG8_STAGE(PG8_SB(0, 1), b2 + hstep, voffB); PG8_STAGE(PG8_SA(0, 0), a2, voffA);
            PG8_WAIT_V(8); PG8_WAIT_L(0); PG8_BAR; PG8_MMA(1, 0, At, B0); PG8_MMA(1, 1, At, B1); PG8_BAR; PG8_SCHED;
            PG8_LDB(B0, 1, 0); PG8_LDB(B1, 1, 1); PG8_SCHED; PG8_LDA(At, 1, 0); PG8_STAGE(PG8_SA(0, 1), a2 + hstep, voffA);
            PG8_WAIT_V(8); PG8_WAIT_L(0); PG8_BAR; PG8_MMA(0, 0, At, B0); PG8_MMA(0, 1, At, B1); PG8_BAR; PG8_SCHED;
            PG8_LDA(At, 1, 1); PG8_STAGE(PG8_SB(1, 0), b3, voffB); PG8_STAGE(PG8_SB(1, 1), b3 + hstep, voffB); PG8_STAGE(PG8_SA(1, 0), a3, voffA);
            PG8_WAIT_V(8); PG8_WAIT_L(0); PG8_BAR; PG8_MMA(1, 0, At, B0); PG8_MMA(1, 1, At, B1); PG8_BAR; PG8_SCHED;
            } else {
            PG8_LDB(B0, 0, 0); PG8_SCHED; PG8_LDA(At, 0, 0); PG8_STAGE(PG8_SA(1, 1), a1 + hstep, voffA);
            PG8_WAIT_L(8); PG8_BAR; PG8_WAIT_L(0); PG8_MMA(0, 0, At, B0); PG8_BAR; PG8_SCHED;
            PG8_LDB(B1, 0, 1); PG8_STAGE(PG8_SB(0, 0), b2, voffB);
            PG8_BAR; PG8_WAIT_L(0); PG8_MMA(0, 1, At, B1); PG8_BAR;
            PG8_LDA(At, 0, 1); PG8_STAGE(PG8_SA(0, 0), a2, voffA);
            PG8_BAR; PG8_WAIT_L(0); PG8_MMA(1, 0, At, B0); PG8_BAR; PG8_SCHED;
            PG8_STAGE(PG8_SB(0, 1), b2 + hstep, voffB);
            PG8_WAIT_V(6); PG8_BAR; PG8_MMA(1, 1, At, B1); PG8_BAR;
            PG8_LDB(B0, 1, 0); PG8_SCHED; PG8_LDA(At, 1, 0); PG8_STAGE(PG8_SA(0, 1), a2 + hstep, voffA);
            PG8_WAIT_L(8); PG8_BAR; PG8_WAIT_L(0); PG8_MMA(0, 0, At, B0); PG8_BAR; PG8_SCHED;
            PG8_LDB(B1, 1, 1); PG8_STAGE(PG8_SB(1, 0), b3, voffB);
            PG8_BAR; PG8_WAIT_L(0); PG8_MMA(0, 1, At, B1); PG8_BAR;
            PG8_LDA(At, 1, 1); PG8_STAGE(PG8_SA(1, 0), a3, voffA);
            PG8_BAR; PG8_WAIT_L(0); PG8_MMA(1, 0, At, B0); PG8_BAR; PG8_SCHED;
            PG8_STAGE(PG8_SB(1, 1), b3 + hstep, voffB);
            PG8_WAIT_V(6); PG8_BAR; PG8_MMA(1, 1, At, B1); PG8_BAR;
            }
        }
        if constexpr (ALIGN_EPI) { if (wr == 0) PG8_BAR; }
        if constexpr (!Epi::AFTER_DRAIN) { E(acc, cur, wr, wc, fr, fq); S.done(cur); }
        if (!has_next) break;
#pragma unroll
        for (int a = 0; a < 2; ++a)
#pragma unroll
            for (int b = 0; b < 2; ++b)
#pragma unroll
                for (int m = 0; m < 4; ++m)
#pragma unroll
                    for (int n = 0; n < 2; ++n) acc[a][b][m][n] = (f32x4){0.f, 0.f, 0.f, 0.f};
        cur = nxt; cA = nA; cB = nB; ++ui;
        if constexpr (ALIGN_EPI) { if (wr == 1) PG8_BAR; }
    }
    PG8_WAIT_V(0);
    if constexpr (!ALIGN_EPI) { if (wr == 0) PG8_BAR; }
    PG8_BAR;
    if constexpr (Epi::AFTER_DRAIN) { E.fused(acc, cur, wr, wc, fr, fq, lds, wid, lane); S.done(cur); }
#undef PG8_SA
#undef PG8_SB
#undef PG8_STAGE
#undef PG8_LDA
#undef PG8_LDB
#undef PG8_MMA
#undef PG8_WAIT_V
#undef PG8_WAIT_L
#undef PG8_BAR
#undef PG8_SCHED
}
}

#define GAS __attribute__((address_space(1)))
#define LAS __attribute__((address_space(3)))
typedef unsigned short bf16;
typedef float f32x4 __attribute__((ext_vector_type(4)));
typedef short bf16x8 __attribute__((ext_vector_type(8)));
typedef unsigned u32x4 __attribute__((ext_vector_type(4)));
typedef unsigned u32x2 __attribute__((ext_vector_type(2)));

constexpr int NWAVES = 8;
constexpr int SEQ = 16384, DMODEL = 2048, NMEM = 256, DIN = 3584, DCONV = 768, DPOOL = 768, DXATT = 512, DFF = 5632, DFF2 = 11264;
constexpr int PGD = 192;
constexpr float EPS = 1e-6f;
constexpr int LDS_BYTES = 147456;
#ifndef MK_PER_PHASE
#define MK_PER_PHASE 0
#endif
constexpr int NPHASE = 10;
#ifndef PHM
#define PHM 255
#endif
#ifndef PROBE_SYNC
#define PROBE_SYNC 0
#endif
#ifndef PROBE_GEMM
#define PROBE_GEMM 0
#endif
#ifndef PROBE_N
#define PROBE_N 2048
#endif
#ifndef REPM
#define REPM 0
#endif

constexpr size_t MiB = 1u << 20;
constexpr size_t WS_KB = 1 * MiB;
constexpr size_t WS_VT = 1 * MiB + 256 * 1024;
constexpr size_t WS_POOLWT = 1 * MiB + 512 * 1024;
constexpr size_t WS_MB = 2 * MiB;
constexpr size_t WS_WKVT = 3 * MiB;
constexpr size_t WS_HALOB = 7 * MiB;
constexpr size_t WS_SLAB1 = 8 * MiB;
constexpr size_t WS_SLAB2 = 10 * MiB;
constexpr size_t WS_WUPT = 12 * MiB;
constexpr size_t WS_WDOWNT = 56 * MiB;
constexpr size_t WS_U = 80 * MiB;
constexpr size_t WS_ACT = 256 * MiB;
constexpr size_t WS_X1B = 432 * MiB;
constexpr size_t WS_H = 80 * MiB;
constexpr size_t WS_Z = 144 * MiB;
constexpr size_t WS_MIX = 256 * MiB;
constexpr size_t WS_WINT = 320 * MiB;
constexpr size_t WS_WOUTT = 334 * MiB;
constexpr size_t WS_END = 496 * MiB;

__device__ __forceinline__ unsigned f2bf(float f) { unsigned u = __builtin_bit_cast(unsigned, f); return (u + 0x7fffu + ((u >> 16) & 1u)) >> 16; }
__device__ __forceinline__ unsigned pk2(float lo, float hi) { return f2bf(lo) | (f2bf(hi) << 16); }
__device__ __forceinline__ float bflo(unsigned w) { return __builtin_bit_cast(float, w << 16); }
__device__ __forceinline__ float bfhi(unsigned w) { return __builtin_bit_cast(float, w & 0xffff0000u); }
__device__ __forceinline__ void unpack8(const u32x4 w, float (&f)[8]) { f[0] = bflo(w.x); f[1] = bfhi(w.x); f[2] = bflo(w.y); f[3] = bfhi(w.y); f[4] = bflo(w.z); f[5] = bfhi(w.z); f[6] = bflo(w.w); f[7] = bfhi(w.w); }
__device__ __forceinline__ u32x4 pack8(const float (&f)[8]) { u32x4 w; w.x = pk2(f[0], f[1]); w.y = pk2(f[2], f[3]); w.z = pk2(f[4], f[5]); w.w = pk2(f[6], f[7]); return w; }
__device__ __forceinline__ float wave_sum(float v) {
#pragma unroll
    for (int o = 1; o < 64; o <<= 1) v += __shfl_xor(v, o);
    return v;
}
#define LDS_WAIT() asm volatile("s_waitcnt lgkmcnt(0)" ::: "memory")

typedef GAS unsigned gu32;
constexpr size_t WS_CTL = 0, CTL_ZERO_BYTES = 64 * 1024;
constexpr int MISC_OFF = 131072 + 320;
#define XB_TMO      128
#define XB_XCNT(j)  (256  + 64 * (j))
#define XB_XSUB(j)  (1280 + 64 * (j))
#define XB_XGEN(j)  (2304 + 64 * (j))
#define XB_TOP      3328
#define XB_TOPGEN   3392
#define XCD_BAR_WORDS 3456
#define XB_SPIN_CAP (1u << 18)

__device__ __forceinline__ unsigned xb_ld(unsigned* p)              { return __hip_atomic_load(p, __ATOMIC_RELAXED, __HIP_MEMORY_SCOPE_AGENT); }
__device__ __forceinline__ unsigned xb_add(unsigned* p, unsigned v) { return __hip_atomic_fetch_add(p, v, __ATOMIC_RELAXED, __HIP_MEMORY_SCOPE_AGENT); }
__device__ __forceinline__ unsigned xb_xcc_id() { return (unsigned)__builtin_amdgcn_s_getreg((3 << 11) | 20) & 0xFu; }
#define XB_SPIN(cond, bar) do { unsigned _sp = 0; while (cond) { __builtin_amdgcn_s_sleep(1); \
    if ((++_sp & 255u) == 0u) { if (xb_ld(&(bar)[XB_TMO])) break; if (_sp > XB_SPIN_CAP) { atomicAdd(&(bar)[XB_TMO], 1u); break; } } } } while (0)

struct XcdBarrier {
    unsigned* bar; unsigned x;
    volatile LAS unsigned* st;
};

__device__ __forceinline__ XcdBarrier xcd_barrier_post(unsigned* bar, volatile LAS unsigned* st) {
    XcdBarrier b; b.bar = bar; b.x = xb_xcc_id(); b.st = st;
    if (threadIdx.x == 0) (void)xb_add(&bar[XB_XCNT(b.x)], 1u);
    return b;
}
__device__ __forceinline__ void xcd_barrier_complete(unsigned* bar, unsigned x, unsigned& nloc, unsigned& nx) {
    const unsigned G = gridDim.x * gridDim.y * gridDim.z;
    unsigned sum, cnt, mine, sp = 0u;
    for (;;) {
        sum = 0u; cnt = 0u; mine = 0u;
#pragma unroll
        for (unsigned j = 0; j < 16; ++j) { const unsigned c = xb_ld(&bar[XB_XCNT(j)]); sum += c; cnt += (c > 0u) ? 1u : 0u; mine = (j == x) ? c : mine; }
        if (sum == G) break;
        __builtin_amdgcn_s_sleep(1);
        if ((++sp & 255u) == 0u) { if (xb_ld(&bar[XB_TMO])) break; if (sp > XB_SPIN_CAP) { atomicAdd(&bar[XB_TMO], 1u); break; } }
    }
    nloc = mine > 0u ? mine : 1u; nx = cnt > 0u ? cnt : 1u;
}

__device__ __forceinline__ void xcd_barrier(const XcdBarrier& b) {
    asm volatile("s_waitcnt vmcnt(0)" ::: "memory");
    __syncthreads();
    if (threadIdx.x == 0) {
        unsigned* bar = b.bar;
        __builtin_amdgcn_s_waitcnt(0);
        unsigned nloc = b.st[0], nx = b.st[1];
        if (nloc == 0u) { xcd_barrier_complete(bar, b.x, nloc, nx); b.st[0] = nloc; b.st[1] = nx; }
        const unsigned old = xb_add(&bar[XB_XSUB(b.x)], 1u);
        const unsigned gen = old / nloc;
        if (old + 1u == (gen + 1u) * nloc) {
            __builtin_amdgcn_fence(__ATOMIC_RELEASE, "agent");
            asm volatile("s_waitcnt vmcnt(0)" ::: "memory");
            const unsigned og = xb_add(&bar[XB_TOP], 1u);
            const unsigned tg = og / nx;
            if (og + 1u == (tg + 1u) * nx) xb_add(&bar[XB_TOPGEN], 1u);
            else XB_SPIN(xb_ld(&bar[XB_TOPGEN]) == tg, bar);
            __builtin_amdgcn_fence(__ATOMIC_ACQUIRE, "agent");
            xb_add(&bar[XB_XGEN(b.x)], 1u);
            asm volatile("s_waitcnt vmcnt(0)" ::: "memory");
        } else {
            XB_SPIN(xb_ld(&bar[XB_XGEN(b.x)]) == gen, bar);
            __builtin_amdgcn_fence(__ATOMIC_ACQUIRE, "agent");
            asm volatile("s_waitcnt vmcnt(0)" ::: "memory");
        }
    }
    __syncthreads();
}


__device__ __forceinline__ void p0_transpose_item(const float* W, int K, int N, bf16* WT, const float* ks, LAS float* scr, int item, int lane) {
    const int nblk = N / 32, kb = item / nblk, nb = item % nblk, k0 = 64 * kb, n0 = 32 * nb;
#pragma unroll 8
    for (int i = 0; i < 32; ++i) { const int kk = 2 * i + (lane >> 5); float v = W[(size_t)(k0 + kk) * N + n0 + (lane & 31)]; if (ks) v *= ks[k0 + kk]; scr[kk * 33 + (lane & 31)] = v; }
    LDS_WAIT(); asm volatile("" ::: "memory");
    const int c = lane & 7;
#pragma unroll
    for (int j = 0; j < 4; ++j) { const int n = (lane >> 3) + 8 * j; const LAS float* s = scr + (8 * c) * 33 + n;
        u32x4 o; o.x = pk2(s[0 * 33], s[1 * 33]); o.y = pk2(s[2 * 33], s[3 * 33]); o.z = pk2(s[4 * 33], s[5 * 33]); o.w = pk2(s[6 * 33], s[7 * 33]);
        *(u32x4*)(WT + (size_t)(n0 + n) * K + k0 + 8 * c) = o; }
    LDS_WAIT(); asm volatile("" ::: "memory");
}
__device__ __forceinline__ void rms_row_to_bf16(const float* xrow, const float* g, bf16* orow, int lane) {
    const f32x4* xr = (const f32x4*)xrow + lane; const f32x4* gr = (const f32x4*)g + lane;
    f32x4 v[8]; float s = 0.f;
#pragma unroll
    for (int j = 0; j < 8; ++j) { v[j] = xr[64 * j]; s += (v[j].x * v[j].x + v[j].y * v[j].y) + (v[j].z * v[j].z + v[j].w * v[j].w); }
    const float rstd = 1.0f / sqrtf(wave_sum(s) * (1.0f / DMODEL) + EPS);
    u32x2* o8 = (u32x2*)orow + lane;
#pragma unroll
    for (int j = 0; j < 8; ++j) { const f32x4 gg = gr[64 * j]; u32x2 w; w.x = pk2(v[j].x * rstd * gg.x, v[j].y * rstd * gg.y); w.y = pk2(v[j].z * rstd * gg.z, v[j].w * rstd * gg.w); o8[64 * j] = w; }
}

struct Ptrs {
    const float *x, *mem, *g_mix, *g_mem, *w_in, *conv_w, *pool_w, *pool_scale, *w_kv, *w_out, *g_ffn, *w_up, *ffn_conv_w, *ffn_conv_b, *w_down, *g_final;
    float* out; unsigned char* ws;
};

__device__ __forceinline__ void p0_prologue(const Ptrs& P, LAS unsigned char* lds, int gw, int NGW, int wave, int lane) {
    LAS float* scr = (LAS float*)(lds + wave * 16384);
    unsigned char* ws = P.ws;
    constexpr int I_IN = (DMODEL / 64) * (DIN / 32), I_OUT = (DMODEL / 64) * (DMODEL / 32), I_UP = (DMODEL / 64) * (DFF2 / 32), I_DN = (DFF / 64) * (DMODEL / 32),
                  I_KV = (DMODEL / 64) * (1024 / 32), I_PW = (PGD / 64) * (PGD / 32);
    constexpr int NITEMS = I_IN + I_OUT + I_UP + I_DN + I_KV + 4 * I_PW;
    for (int it = gw; it < NITEMS; it += NGW) {
        int r = it;
        if (r < I_IN) { p0_transpose_item(P.w_in, DMODEL, DIN, (bf16*)(ws + WS_WINT), nullptr, scr, r, lane); continue; } r -= I_IN;
        if (r < I_OUT) { p0_transpose_item(P.w_out, DMODEL, DMODEL, (bf16*)(ws + WS_WOUTT), nullptr, scr, r, lane); continue; } r -= I_OUT;
        if (r < I_UP) { p0_transpose_item(P.w_up, DMODEL, DFF2, (bf16*)(ws + WS_WUPT), P.g_ffn, scr, r, lane); continue; } r -= I_UP;
        if (r < I_DN) { p0_transpose_item(P.w_down, DFF, DMODEL, (bf16*)(ws + WS_WDOWNT), nullptr, scr, r, lane); continue; } r -= I_DN;
        if (r < I_KV) { p0_transpose_item(P.w_kv, DMODEL, 1024, (bf16*)(ws + WS_WKVT), nullptr, scr, r, lane); continue; } r -= I_KV;
        const int g = r / I_PW; r -= g * I_PW;
        p0_transpose_item(P.pool_w + (size_t)g * PGD * PGD, PGD, PGD, (bf16*)(ws + WS_POOLWT) + (size_t)g * PGD * PGD, nullptr, scr, r, lane);
    }
    for (int m = gw; m < SEQ; m += NGW) rms_row_to_bf16(P.x + (size_t)m * DMODEL, P.g_mix, (bf16*)(ws + WS_H) + (size_t)m * DMODEL, lane);
    for (int m = gw; m < NMEM; m += NGW) rms_row_to_bf16(P.mem + (size_t)m * DMODEL, P.g_mem, (bf16*)(ws + WS_MB) + (size_t)m * DMODEL, lane);
}

__device__ __forceinline__ void kv_tile(const Ptrs& P, int tt, int lane) {
    const bf16* mB = (const bf16*)(P.ws + WS_MB); const bf16* wT = (const bf16*)(P.ws + WS_WKVT);
    const int rb = tt >> 6, cb = tt & 63, fr = lane & 15, fq = lane >> 4;
    const bf16* ap = mB + (size_t)(16 * rb + fr) * DMODEL + 8 * fq; const bf16* wp = wT + (size_t)(16 * cb + fr) * DMODEL + 8 * fq;
    f32x4 acc = {0.f, 0.f, 0.f, 0.f};
    if (cb < 32) {
#pragma unroll 8
        for (int ks = 0; ks < 64; ++ks) { const bf16x8 a = *(const bf16x8*)(ap + 32 * ks), w = *(const bf16x8*)(wp + 32 * ks); acc = __builtin_amdgcn_mfma_f32_16x16x32_bf16(w, a, acc, 0, 0, 0); }
        u32x2 o; o.x = pk2(acc[0], acc[1]); o.y = pk2(acc[2], acc[3]);
        *(u32x2*)((bf16*)(P.ws + WS_KB) + (size_t)(16 * rb + fr) * 512 + 16 * cb + 4 * fq) = o;
    } else {
#pragma unroll 8
        for (int ks = 0; ks < 64; ++ks) { const bf16x8 a = *(const bf16x8*)(ap + 32 * ks), w = *(const bf16x8*)(wp + 32 * ks); acc = __builtin_amdgcn_mfma_f32_16x16x32_bf16(a, w, acc, 0, 0, 0); }
        u32x2 o; o.x = pk2(acc[0], acc[1]); o.y = pk2(acc[2], acc[3]);
        *(u32x2*)((bf16*)(P.ws + WS_VT) + (size_t)(16 * cb - 512 + fr) * 256 + 32 * (rb >> 1) + 8 * fq + 4 * (rb & 1)) = o;
    }
}

__device__ __forceinline__ void mix_conv_task(const Ptrs& P, int blk, int lane) {
    const bf16* z = (const bf16*)(P.ws + WS_Z); bf16* mix = (bf16*)(P.ws + WS_MIX);
    const int t0 = blk * 16;
    for (int cg = lane; cg < DCONV / 8; cg += 64) {
        const int c = cg * 8;
        float w0[8], w1[8], w2[8], p1[8], p2[8];
#pragma unroll
        for (int e = 0; e < 8; ++e) { w0[e] = P.conv_w[c + e]; w1[e] = P.conv_w[DCONV + c + e]; w2[e] = P.conv_w[2 * DCONV + c + e]; p1[e] = 0.f; p2[e] = 0.f; }
        for (int r = -2; r < 16; ++r) {
            const int t = t0 + r; float p[8];
            if (t >= 0) { float a[8], b[8]; unpack8(*(const u32x4*)(z + (size_t)t * DIN + DCONV + c), a); unpack8(*(const u32x4*)(z + (size_t)t * DIN + 2 * DCONV + c), b);
#pragma unroll
                for (int e = 0; e < 8; ++e) p[e] = a[e] * b[e]; }
            else {
#pragma unroll
                for (int e = 0; e < 8; ++e) p[e] = 0.f; }
            if (r >= 0) { float g[8], o[8]; unpack8(*(const u32x4*)(z + (size_t)t * DIN + c), g);
#pragma unroll
                for (int e = 0; e < 8; ++e) o[e] = g[e] * (w2[e] * p[e] + w1[e] * p1[e] + w0[e] * p2[e]);
                *(u32x4*)(mix + (size_t)t * DMODEL + c) = pack8(o); }
#pragma unroll
            for (int e = 0; e < 8; ++e) { p2[e] = p1[e]; p1[e] = p[e]; }
        }
    }
}
__device__ __forceinline__ void mix_pool_task(const Ptrs& P, int g, int blk, int lane) {
    const bf16* z = (const bf16*)(P.ws + WS_Z); bf16* mix = (bf16*)(P.ws + WS_MIX); const bf16* wt = (const bf16*)(P.ws + WS_POOLWT) + (size_t)g * PGD * PGD;
    const int fr = lane & 15, fq = lane >> 4, t = blk * 16 + fr, k = 2 << g;
    const int cnt = (t + 1 < k) ? t + 1 : k; const float inv = 1.0f / (float)cnt;
    f32x4 acc[12];
#pragma unroll
    for (int n = 0; n < 12; ++n) acc[n] = (f32x4){0.f, 0.f, 0.f, 0.f};
    for (int ks = 0; ks < 6; ++ks) {
        const int c = 32 * ks + 8 * fq; const bf16* zc = z + 3 * DCONV + PGD * g + c;
        float sum[8], self[8];
        unpack8(*(const u32x4*)(zc + (size_t)t * DIN), self);
#pragma unroll
        for (int e = 0; e < 8; ++e) sum[e] = self[e];
        for (int j = 1; j < k; ++j) { const int tt = t - j; const bool ok = tt >= 0; float v[8]; unpack8(*(const u32x4*)(zc + (size_t)(ok ? tt : 0) * DIN), v);
#pragma unroll
            for (int e = 0; e < 8; ++e) sum[e] += ok ? v[e] : 0.f; }
        float pl[8];
#pragma unroll
        for (int e = 0; e < 8; ++e) pl[e] = sum[e] * inv - self[e];
        const bf16x8 pf = __builtin_bit_cast(bf16x8, pack8(pl));
#pragma unroll
        for (int n = 0; n < 12; ++n) { const bf16x8 wf = *(const bf16x8*)(wt + (size_t)(16 * n + fr) * PGD + c); acc[n] = __builtin_amdgcn_mfma_f32_16x16x32_bf16(wf, pf, acc[n], 0, 0, 0); }
    }
#pragma unroll
    for (int n = 0; n < 12; ++n) { const int d = 16 * n + 4 * fq; const f32x4 sc = *(const f32x4*)(P.pool_scale + PGD * g + d);
        u32x2 o; o.x = pk2(acc[n][0] * sc[0], acc[n][1] * sc[1]); o.y = pk2(acc[n][2] * sc[2], acc[n][3] * sc[3]);
        *(u32x2*)(mix + (size_t)t * DMODEL + DCONV + PGD * g + d) = o; }
}
__device__ __forceinline__ void mix_attn_task(const Ptrs& P, int h, int blk, int lane) {
    const bf16* z = (const bf16*)(P.ws + WS_Z); bf16* mix = (bf16*)(P.ws + WS_MIX); const bf16* Kb = (const bf16*)(P.ws + WS_KB); const bf16* Vt = (const bf16*)(P.ws + WS_VT);
    const int fr = lane & 15, fq = lane >> 4, t = blk * 16 + fr;
    bf16x8 qf[4];
#pragma unroll
    for (int ks = 0; ks < 4; ++ks) qf[ks] = *(const bf16x8*)(z + (size_t)t * DIN + 3 * DCONV + DPOOL + 128 * h + 32 * ks + 8 * fq);
    f32x4 s[16];
#pragma unroll
    for (int kb = 0; kb < 16; ++kb) { s[kb] = (f32x4){0.f, 0.f, 0.f, 0.f};
#pragma unroll
        for (int ks = 0; ks < 4; ++ks) { const bf16x8 kf = *(const bf16x8*)(Kb + (size_t)(16 * kb + fr) * 512 + 128 * h + 32 * ks + 8 * fq); s[kb] = __builtin_amdgcn_mfma_f32_16x16x32_bf16(kf, qf[ks], s[kb], 0, 0, 0); } }
    float mx = -3.0e38f;
#pragma unroll
    for (int kb = 0; kb < 16; ++kb) mx = fmaxf(fmaxf(fmaxf(s[kb][0], s[kb][1]), fmaxf(s[kb][2], s[kb][3])), mx);
    mx = fmaxf(mx, __shfl_xor(mx, 16)); mx = fmaxf(mx, __shfl_xor(mx, 32));
    const float c2 = 0.08838834764831845f * 1.4426950408889634f;
    float sum = 0.f;
#pragma unroll
    for (int kb = 0; kb < 16; ++kb)
#pragma unroll
        for (int r = 0; r < 4; ++r) { const float p = __builtin_amdgcn_exp2f((s[kb][r] - mx) * c2); s[kb][r] = p; sum += p; }
    sum += __shfl_xor(sum, 16); sum += __shfl_xor(sum, 32);
    const float inv = 1.0f / sum;
    f32x4 o[8];
#pragma unroll
    for (int db = 0; db < 8; ++db) o[db] = (f32x4){0.f, 0.f, 0.f, 0.f};
#pragma unroll
    for (int ks = 0; ks < 8; ++ks) {
        u32x4 pw; pw.x = pk2(s[2 * ks][0], s[2 * ks][1]); pw.y = pk2(s[2 * ks][2], s[2 * ks][3]); pw.z = pk2(s[2 * ks + 1][0], s[2 * ks + 1][1]); pw.w = pk2(s[2 * ks + 1][2], s[2 * ks + 1][3]);
        const bf16x8 pf = __builtin_bit_cast(bf16x8, pw);
#pragma unroll
        for (int db = 0; db < 8; ++db) { const bf16x8 vf = *(const bf16x8*)(Vt + (size_t)(128 * h + 16 * db + fr) * 256 + 32 * ks + 8 * fq); o[db] = __builtin_amdgcn_mfma_f32_16x16x32_bf16(vf, pf, o[db], 0, 0, 0); }
    }
#pragma unroll
    for (int db = 0; db < 8; ++db) { u32x2 w; w.x = pk2(o[db][0] * inv, o[db][1] * inv); w.y = pk2(o[db][2] * inv, o[db][3] * inv);
        *(u32x2*)(mix + (size_t)t * DMODEL + DCONV + DPOOL + 128 * h + 16 * db + 4 * fq) = w; }
}
__device__ __forceinline__ void p2_mixer(const Ptrs& P, int gw, int NGW, int lane) {
    constexpr int NBLK = SEQ / 16;
    for (int it = gw; it < 9 * NBLK; it += NGW) {
        const int task = it / NBLK, blk = it % NBLK;
        if (task == 0) mix_conv_task(P, blk, lane);
        else if (task < 5) mix_pool_task(P, task - 1, blk, lane);
        else mix_attn_task(P, task - 5, blk, lane);
    }
}

__device__ __forceinline__ void p5_act(const Ptrs& P, int half, int gw, int NGW, int lane) {
    const bf16* U = (const bf16*)(P.ws + WS_U); const bf16* haloB = (const bf16*)(P.ws + WS_HALOB); bf16* act = (bf16*)(P.ws + WS_ACT);
    constexpr int NCB = DFF / 512, RS = 32, NSTRIP = 8192 / RS;
    for (int it = gw; it < NSTRIP * NCB; it += NGW) {
        const int cbk = it % NCB, strip = it / NCB, c = cbk * 512 + lane * 8, r0 = strip * RS;
        float wg0[8], wg1[8], wg2[8], bg[8], wv0[8], wv1[8], wv2[8], bv[8], g1[8], g2[8], v1[8], v2[8];
#pragma unroll
        for (int e = 0; e < 8; ++e) { wg0[e] = P.ffn_conv_w[c + e]; wg1[e] = P.ffn_conv_w[DFF2 + c + e]; wg2[e] = P.ffn_conv_w[2 * DFF2 + c + e]; bg[e] = P.ffn_conv_b[c + e];
            wv0[e] = P.ffn_conv_w[DFF + c + e]; wv1[e] = P.ffn_conv_w[DFF2 + DFF + c + e]; wv2[e] = P.ffn_conv_w[2 * DFF2 + DFF + c + e]; bv[e] = P.ffn_conv_b[DFF + c + e]; g1[e] = g2[e] = v1[e] = v2[e] = 0.f; }
        for (int r = -2; r < RS; ++r) {
            const int rl = r0 + r, tg = half * 8192 + rl;
            float g[8], v[8];
            if (tg >= 0) { const bf16* src = (rl >= 0) ? U + (size_t)rl * DFF2 : haloB + (size_t)(tg - 8190) * DFF2;
                unpack8(*(const u32x4*)(src + c), g); unpack8(*(const u32x4*)(src + DFF + c), v); }
            else {
#pragma unroll
                for (int e = 0; e < 8; ++e) { g[e] = 0.f; v[e] = 0.f; } }
            if (r >= 0) { float o[8];
#pragma unroll
                for (int e = 0; e < 8; ++e) { const float G = wg2[e] * g[e] + wg1[e] * g1[e] + wg0[e] * g2[e] + bg[e], V = wv2[e] * v[e] + wv1[e] * v1[e] + wv0[e] * v2[e] + bv[e];
                    o[e] = G * __builtin_amdgcn_rcpf(1.0f + __expf(-G)) * V; }
                *(u32x4*)(act + (size_t)tg * DFF + c) = pack8(o); }
#pragma unroll
            for (int e = 0; e < 8; ++e) { g2[e] = g1[e]; g1[e] = g[e]; v2[e] = v1[e]; v1[e] = v[e]; }
        }
    }
}

__device__ __forceinline__ void p7_final(const Ptrs& P, int gw, int NGW, int lane) {
    const float* slab = (const float*)(P.ws + WS_SLAB2);
    for (int m = gw; m < SEQ; m += NGW) {
        const float part = (lane < 32) ? slab[(size_t)m * 32 + lane] : 0.f;
        const float rstd = 1.0f / sqrtf(wave_sum(part) * (1.0f / DMODEL) + EPS);
        f32x4* xr = (f32x4*)(P.out + (size_t)m * DMODEL) + lane; const f32x4* gr = (const f32x4*)P.g_final + lane;
#pragma unroll
        for (int j = 0; j < 8; ++j) { f32x4 v = xr[64 * j]; const f32x4 gg = gr[64 * j]; v = v * rstd * gg; xr[64 * j] = v; }
    }
}

struct Args { const float* in[16]; float* out; unsigned char* ws; int ph_lo, ph_hi; };
__global__ void __launch_bounds__(NWAVES * 64, 2) hybrid_fwd(Args args) {
    extern __shared__ __attribute__((aligned(16))) unsigned char lds_raw[];
    LAS unsigned char* lds = (LAS unsigned char*)lds_raw;
    cg::grid_group grid = cg::this_grid();
    const int tid = threadIdx.x, lane = tid & 63, wave = __builtin_amdgcn_readfirstlane(tid >> 6);
    const int G = gridDim.x, bx = blockIdx.x, vcu = (G % 8 == 0) ? (bx % 8) * (G / 8) + bx / 8 : bx;
    const int gw = vcu * NWAVES + wave, NGW = G * NWAVES;
    volatile LAS unsigned* MISC = (volatile LAS unsigned*)(lds + MISC_OFF);
    if (tid < 32) MISC[tid] = 0u;
    __syncthreads();
    const XcdBarrier bar = xcd_barrier_post((unsigned*)(args.ws + WS_CTL), MISC + 8);
    Ptrs P;
    P.x = args.in[0]; P.mem = args.in[1]; P.g_mix = args.in[2]; P.g_mem = args.in[3]; P.w_in = args.in[4]; P.conv_w = args.in[5]; P.pool_w = args.in[6]; P.pool_scale = args.in[7];
    P.w_kv = args.in[8]; P.w_out = args.in[9]; P.g_ffn = args.in[10]; P.w_up = args.in[11]; P.ffn_conv_w = args.in[12]; P.ffn_conv_b = args.in[13]; P.w_down = args.in[14]; P.g_final = args.in[15];
    P.out = args.out; P.ws = args.ws;
    unsigned char* ws = args.ws;
#if PROBE_SYNC
    for (int i = 0; i < 20; ++i) xcd_barrier(bar);
#endif
    const int lo = args.ph_lo, hi = args.ph_hi;
#define IN(k) (lo <= (k) && (k) < hi)
#define SYNC(k) do { if ((k) + 1 < hi) { if ((k) == 0) grid.sync(); else xcd_barrier(bar); } } while (0)
#define SYNCR(k, b) do { if ((k) + 1 < hi || rp + 1 < NREP(b)) { if ((k) == 0) grid.sync(); else xcd_barrier(bar); } } while (0)
#define NREP(b) ((REPM & (b)) ? 2 : 1)
    if (IN(0) && (PHM & 1)) for (int rp = 0; rp < NREP(1); ++rp) { p0_prologue(P, lds, gw, NGW, wave, lane); SYNCR(0, 1); }
    if (IN(1) && (PHM & 2)) for (int rp = 0; rp < NREP(2); ++rp) {
        pg8::Gemm g{(const bf16*)(ws + WS_H), (const bf16*)(ws + WS_WINT), SEQ, DIN, DMODEL}; pg8::StaticOrder S; S.init(SEQ, DIN, G, bx);
        pg8::EpiZ E{(bf16*)(ws + WS_Z), DIN};
        pg8::gemm_phase<pg8::EpiZ, pg8::StaticOrder, true, true>(lds, g, S, E);
        if (wave < 4) { for (int tt = vcu * 4 + wave; tt < 1024; tt += G * 4) kv_tile(P, tt, lane); }
        SYNCR(1, 2);
    }
    if (IN(2) && (PHM & 4)) for (int rp = 0; rp < NREP(4); ++rp) { p2_mixer(P, gw, NGW, lane); SYNCR(2, 4); }
    if (IN(3) && (PHM & 8)) for (int rp = 0; rp < NREP(8); ++rp) {
        pg8::Gemm g{(const bf16*)(ws + WS_MIX), (const bf16*)(ws + WS_WOUTT), SEQ, DMODEL, DMODEL}; pg8::StaticOrder S; S.init(SEQ, DMODEL, G, bx);
        pg8::EpiRes<true> E{P.x, P.out, (bf16*)(ws + WS_X1B), (float*)(ws + WS_SLAB1)};
        pg8::gemm_phase<pg8::EpiRes<true>, pg8::StaticOrder, true, true>(lds, g, S, E);
        SYNCR(3, 8);
    }
#if PROBE_GEMM
    if (IN(3)) {
        pg8::Gemm g{(const bf16*)(ws + WS_X1B), (const bf16*)(ws + WS_WUPT), SEQ, PROBE_N, DMODEL}; pg8::StaticOrder S; S.init(SEQ, PROBE_N, G, bx);
#if PROBE_GEMM == 1
        pg8::EpiZ E{(bf16*)(ws + WS_Z), PROBE_N};
        pg8::gemm_phase<pg8::EpiZ, pg8::StaticOrder, true, true>(lds, g, S, E);
#elif PROBE_GEMM == 2
        pg8::EpiNone E{};
        pg8::gemm_phase<pg8::EpiNone, pg8::StaticOrder, true, true>(lds, g, S, E);
#elif PROBE_GEMM == 3
        pg8::EpiZ E{(bf16*)(ws + WS_Z), PROBE_N};
        pg8::gemm_phase<pg8::EpiZ, pg8::StaticOrder, true, false>(lds, g, S, E);
#elif PROBE_GEMM == 4
        pg8::EpiZ E{(bf16*)(ws + WS_Z), PROBE_N};
        pg8::gemm_phase<pg8::EpiZ, pg8::StaticOrder, false, true>(lds, g, S, E);
#endif
        xcd_barrier(bar);
    }
#endif
    for (int rq = 0; rq < NREP(16); ++rq)
    for (int half = 0; half < 2; ++half) {
        if (IN(4 + 2 * half) && (PHM & 16)) {
            pg8::Gemm g{(const bf16*)(ws + WS_X1B) + (size_t)half * 8192 * DMODEL, (const bf16*)(ws + WS_WUPT), 8192, DFF2, DMODEL}; pg8::StaticOrder S; S.init(8192, DFF2, G, bx);
            pg8::EpiU E{(bf16*)(ws + WS_U), DFF2, (const float*)(ws + WS_SLAB1), half * 8192, (bf16*)(ws + WS_HALOB)};
            pg8::gemm_phase<pg8::EpiU, pg8::StaticOrder, true, true>(lds, g, S, E);
            xcd_barrier(bar);
        }
        if (IN(5 + 2 * half) && (PHM & 32)) for (int rp = 0; rp < NREP(32); ++rp) { p5_act(P, half, gw, NGW, lane); xcd_barrier(bar); }
    }
    if (IN(8) && (PHM & 64)) {
        pg8::Gemm g{(const bf16*)(ws + WS_ACT), (const bf16*)(ws + WS_WDOWNT), SEQ, DMODEL, DFF}; pg8::StaticOrder S; S.init(SEQ, DMODEL, G, bx);
        pg8::EpiRes<false> E{P.out, P.out, nullptr, (float*)(ws + WS_SLAB2)};
        pg8::gemm_phase<pg8::EpiRes<false>, pg8::StaticOrder, true, true>(lds, g, S, E);
        SYNC(8);
    }
    if (IN(9) && (PHM & 128)) p7_final(P, gw, NGW, lane);
#undef IN
#undef SYNC
}

extern "C" void kernel_launch(void* const* d_in, const int* in_sizes, int n_in, void* d_out, int out_size, void* d_ws, size_t ws_size, hipStream_t stream) {
    static int grid = 0;
    if (grid == 0) {
        if (n_in != 16 || in_sizes[0] != SEQ * DMODEL || out_size != SEQ * DMODEL || ws_size < WS_END) { fprintf(stderr, "kernel_launch: unexpected shapes (n_in %d, in0 %d, out %d, ws %zu)\n", n_in, n_in > 0 ? in_sizes[0] : -1, out_size, ws_size); grid = -1; return; }
        int dev = 0, cus = 0, per_cu = 0;
        if (hipGetDevice(&dev) != hipSuccess || hipDeviceGetAttribute(&cus, hipDeviceAttributeMultiprocessorCount, dev) != hipSuccess) { grid = -1; return; }
        if (hipFuncSetAttribute((const void*)hybrid_fwd, hipFuncAttributeMaxDynamicSharedMemorySize, LDS_BYTES) != hipSuccess) { fprintf(stderr, "kernel_launch: hipFuncSetAttribute failed\n"); grid = -1; return; }
        if (hipOccupancyMaxActiveBlocksPerMultiprocessor(&per_cu, (const void*)hybrid_fwd, NWAVES * 64, LDS_BYTES) != hipSuccess || per_cu < 1) { fprintf(stderr, "kernel_launch: occupancy query says %d blocks per CU\n", per_cu); (void)hipGetLastError(); per_cu = 1; }
        grid = cus;
        if (grid % 8 != 0 || grid < 8) { fprintf(stderr, "kernel_launch: %d CUs\n", grid); }
    }
    if (grid < 0) return;
    if (hipMemsetAsync((char*)d_ws + WS_CTL, 0, CTL_ZERO_BYTES, stream) != hipSuccess) { fprintf(stderr, "kernel_launch: hipMemsetAsync failed\n"); return; }
    Args a{};
    for (int i = 0; i < 16; ++i) a.in[i] = (const float*)d_in[i];
    a.out = (float*)d_out; a.ws = (unsigned char*)d_ws;
#if MK_PER_PHASE
    for (int ph = 0; ph < NPHASE; ++ph) { a.ph_lo = ph; a.ph_hi = ph + 1; hipLaunchKernelGGL(hybrid_fwd, dim3(grid), dim3(NWAVES * 64), LDS_BYTES, stream, a); }
#else
    a.ph_lo = 0; a.ph_hi = NPHASE;
    void* kargs[] = {&a};
    hipError_t e = hipLaunchCooperativeKernel((const void*)hybrid_fwd, dim3(grid), dim3(NWAVES * 64), kargs, LDS_BYTES, stream);
    if (e != hipSuccess) fprintf(stderr, "kernel_launch: cooperative launch failed: %s (grid %d)\n", hipGetErrorString(e), grid);
#endif
}
```

```cpp
#include <hip/hip_runtime.h>
#include <hip/hip_cooperative_groups.h>
#include <cstdio>
#include <cstdint>
namespace cg = cooperative_groups;
namespace pg8 {
#define PG8_LAS __attribute__((address_space(3)))
typedef unsigned short bf16_t;
typedef short bf16x8 __attribute__((ext_vector_type(8)));
typedef float f32x4 __attribute__((ext_vector_type(4)));
typedef unsigned u32x4 __attribute__((ext_vector_type(4)));
constexpr int BM = 256, BK = 64, HALF = 128, HTB = HALF * BK * 2  , STAGE_BYTES = 8 * HTB, NXCD = 8, WGM = 8;

__host__ __device__ __forceinline__ int lds_byte(int r, int c) { const int st = (r >> 4) * 2 + (c >> 5), rr = r & 15, cc = c & 31, ob = rr * 64 + cc * 2; return st * 1024 + (ob ^ (((ob >> 9) & 1) << 5)); }
__host__ __device__ __forceinline__ void stage_rc(int b, int& R, int& C) { const int st = b / 1024, sb = b % 1024, swz = sb ^ (((sb >> 9) & 1) << 5); R = (st >> 1) * 16 + swz / 64; C = (st & 1) * 32 + (swz % 64) / 2; }
__host__ __device__ __forceinline__ int perm32(int rho) { const int n = rho >> 4, i = rho & 15; return 8 * (i >> 2) + 4 * n + (i & 3); }

struct Unit { int pm, pn; };
struct Gemm { const bf16_t* A; const bf16_t* Bt; int M, N, K; };

struct StaticOrder {
    int nM, nN, nwg, G, c;
    __host__ __device__ void init(int M, int N, int G_, int c_) { nM = M / BM; nN = N / BM; nwg = nM * nN; G = G_; c = c_; }
    __host__ __device__ bool next(int i, Unit& u) const {
        const long L = (long)i * G + c; if (L >= nwg) return false;
        int wgid = (int)L; { const int q = nwg / NXCD, r = nwg % NXCD, xcd = wgid % NXCD, off = wgid / NXCD; wgid = (xcd < r ? xcd * (q + 1) : r * (q + 1) + (xcd - r) * q) + off; }
        const int nig = WGM * nN, gid = wgid / nig, fm = gid * WGM, gsz = (nM - fm) < WGM ? (nM - fm) : WGM;
        u.pm = fm + ((wgid % nig) % gsz); u.pn = (wgid % nig) / gsz; return true;
    }
    __device__ __forceinline__ void a_ready(const Unit&) const {}
    __device__ __forceinline__ void done(const Unit&) const {}
};
__device__ __forceinline__ unsigned cvt_pk_bf16(float lo, float hi) { unsigned r; asm volatile("v_cvt_pk_bf16_f32 %0, %1, %2" : "=v"(r) : "v"(lo), "v"(hi)); return r; }
typedef unsigned u32x2 __attribute__((ext_vector_type(2)));
constexpr int DM = 2048;
constexpr float RMS_EPS = 1e-6f;

struct EpiZ {
    static constexpr bool PERM = true, AFTER_DRAIN = false;
    bf16_t* O; int ldc;
    __device__ __forceinline__ void operator()(const f32x4 (&acc)[2][2][4][2], const Unit& u, int wr, int wc, int fr_, int fq_, PG8_LAS unsigned char*) const {
        int t_ = threadIdx.x; asm volatile("" : "+v"(t_));
        const int fr = t_ & 15, fq = (t_ >> 4) & 3;
        const int row0 = u.pm * BM + wr * 64 + fr, col0 = u.pn * BM + wc * 32 + 8 * fq;
#pragma unroll
        for (int ai = 0; ai < 2; ++ai)
#pragma unroll
            for (int m = 0; m < 4; ++m) { bf16_t* rowp = O + (size_t)(row0 + ai * HALF + m * 16) * ldc + col0;
#pragma unroll
                for (int bj = 0; bj < 2; ++bj) { const f32x4 v0 = acc[ai][bj][m][0], v1 = acc[ai][bj][m][1];
                    u32x4 w; w.x = cvt_pk_bf16(v0[0], v0[1]); w.y = cvt_pk_bf16(v0[2], v0[3]); w.z = cvt_pk_bf16(v1[0], v1[1]); w.w = cvt_pk_bf16(v1[2], v1[3]);
                    *(u32x4*)(rowp + bj * HALF) = w; } }
    }
};

struct EpiNone {
    static constexpr bool PERM = true, AFTER_DRAIN = false;
    __device__ __forceinline__ void operator()(const f32x4 (&acc)[2][2][4][2], const Unit& u, int wr, int wc, int fr, int fq, PG8_LAS unsigned char*) const {
#pragma unroll
        for (int ai = 0; ai < 2; ++ai)
#pragma unroll
            for (int bj = 0; bj < 2; ++bj)
#pragma unroll
                for (int m = 0; m < 4; ++m)
#pragma unroll
                    for (int n = 0; n < 2; ++n) asm volatile("" :: "v"(acc[ai][bj][m][n]));
    }
};
template <bool WB> struct EpiRes {
    static constexpr bool PERM = true, AFTER_DRAIN = false;
    const float* R; float* X; bf16_t* XB; float* slab;
    __device__ __forceinline__ void operator()(const f32x4 (&acc)[2][2][4][2], const Unit& u, int wr, int wc, int fr_, int fq_, PG8_LAS unsigned char*) const {
        int t_ = threadIdx.x; asm volatile("" : "+v"(t_));
        const int fr = t_ & 15, fq = (t_ >> 4) & 3;
        const int row0 = u.pm * BM + wr * 64 + fr, col0 = u.pn * BM + wc * 32 + 8 * fq;
#pragma unroll
        for (int ai = 0; ai < 2; ++ai)
#pragma unroll
            for (int m = 0; m < 4; ++m) { const int row = row0 + ai * HALF + m * 16; const size_t off = (size_t)row * DM + col0; float ss = 0.f;
#pragma unroll
                for (int bj = 0; bj < 2; ++bj) {
                    const f32x4 r0 = *(const f32x4*)(R + off + bj * HALF), r1 = *(const f32x4*)(R + off + bj * HALF + 4);
                    const f32x4 v0 = acc[ai][bj][m][0] + r0, v1 = acc[ai][bj][m][1] + r1;
                    *(f32x4*)(X + off + bj * HALF) = v0; *(f32x4*)(X + off + bj * HALF + 4) = v1;
                    if (WB) { u32x4 w; w.x = cvt_pk_bf16(v0[0], v0[1]); w.y = cvt_pk_bf16(v0[2], v0[3]); w.z = cvt_pk_bf16(v1[0], v1[1]); w.w = cvt_pk_bf16(v1[2], v1[3]);
                        *(u32x4*)(XB + off + bj * HALF) = w; }
                    ss += (v0[0] * v0[0] + v0[1] * v0[1]) + (v0[2] * v0[2] + v0[3] * v0[3]) + (v1[0] * v1[0] + v1[1] * v1[1]) + (v1[2] * v1[2] + v1[3] * v1[3]); }
                ss += __shfl_xor(ss, 16); ss += __shfl_xor(ss, 32);
                if (fq == 0) slab[(size_t)row * 32 + u.pn * 4 + wc] = ss;
                asm volatile("" ::: "memory"); }
    }
};

__device__ __forceinline__ float dpp_shr1(float old, float src) { return __builtin_bit_cast(float, __builtin_amdgcn_update_dpp(__builtin_bit_cast(int, old), __builtin_bit_cast(int, src), 0x111, 0xf, 0xf, false)); }
__device__ __forceinline__ float dpp_shr2(float old, float src) { return __builtin_bit_cast(float, __builtin_amdgcn_update_dpp(__builtin_bit_cast(int, old), __builtin_bit_cast(int, src), 0x112, 0xf, 0xf, false)); }
__device__ __forceinline__ float dpp_ror1(float src) { return __builtin_bit_cast(float, __builtin_amdgcn_update_dpp(0, __builtin_bit_cast(int, src), 0x121, 0xf, 0xf, false)); }
__device__ __forceinline__ float dpp_ror2(float src) { return __builtin_bit_cast(float, __builtin_amdgcn_update_dpp(0, __builtin_bit_cast(int, src), 0x122, 0xf, 0xf, false)); }
constexpr int FF = 5632, FF2 = 11264;
struct EpiAct {
    static constexpr bool PERM = true, AFTER_DRAIN = false;
    bf16_t* ACT; const float* slab; const float* cw; const float* cb; float* ubnd;
    __device__ __forceinline__ void operator()(f32x4 (&acc)[2][2][4][2], const Unit& u, int wr, int wc, int fr_, int fq_, PG8_LAS unsigned char* xlds) const {
        int t_ = threadIdx.x; asm volatile("" : "+v"(t_));
        const int fr = t_ & 15, fq = (t_ >> 4) & 3;
        const int row0 = u.pm * BM + wr * 64 + fr, cl = wc * 32 + 8 * fq;
#pragma unroll
        for (int ai = 0; ai < 2; ++ai)
#pragma unroll
            for (int m = 0; m < 4; ++m) { const int rg = row0 + ai * HALF + m * 16;
                const f32x4 pa = *(const f32x4*)(slab + (size_t)rg * 32 + 8 * fq), pb = *(const f32x4*)(slab + (size_t)rg * 32 + 8 * fq + 4);
                float s = ((pa[0] + pa[1]) + (pa[2] + pa[3])) + ((pb[0] + pb[1]) + (pb[2] + pb[3]));
                s += __shfl_xor(s, 16); s += __shfl_xor(s, 32);
                const float rstd = 1.0f / sqrtf(s * (1.0f / DM) + RMS_EPS);
#pragma unroll
                for (int bj = 0; bj < 2; ++bj)
#pragma unroll
                    for (int n = 0; n < 2; ++n) acc[ai][bj][m][n] = acc[ai][bj][m][n] * rstd; }
        if (fr >= 14) {
#pragma unroll
            for (int ai = 0; ai < 2; ++ai)
#pragma unroll
                for (int bj = 0; bj < 2; ++bj)
#pragma unroll
                    for (int n = 0; n < 2; ++n) *(PG8_LAS f32x4*)(xlds + ((((2 * ai + wr) * 2 + (fr - 14)) * 256 + 128 * bj + cl + 4 * n) << 2)) = acc[ai][bj][3][n];
            if (wr == 1) {
#pragma unroll
                for (int bj = 0; bj < 2; ++bj)
#pragma unroll
                    for (int n = 0; n < 2; ++n) *(f32x4*)(ubnd + (size_t)(u.pm * 4 + 2 + (fr - 14)) * FF2 + u.pn * BM + 128 * bj + cl + 4 * n) = acc[1][bj][3][n]; }
        }
        if (wr == 0 && fr < 2) {
#pragma unroll
            for (int bj = 0; bj < 2; ++bj)
#pragma unroll
                for (int n = 0; n < 2; ++n) *(f32x4*)(ubnd + (size_t)(u.pm * 4 + fr) * FF2 + u.pn * BM + 128 * bj + cl + 4 * n) = acc[0][bj][0][n]; }
        asm volatile("s_waitcnt lgkmcnt(0)" ::: "memory"); __builtin_amdgcn_s_barrier(); asm volatile("" ::: "memory");
        const int c0 = u.pn * 128 + cl;
        u32x2 hold[2][4];
#pragma unroll
        for (int n = 0; n < 2; ++n) {
            const f32x4 gw0 = *(const f32x4*)(cw + c0 + 4 * n), gw1 = *(const f32x4*)(cw + FF2 + c0 + 4 * n), gw2 = *(const f32x4*)(cw + 2 * FF2 + c0 + 4 * n), gb = *(const f32x4*)(cb + c0 + 4 * n);
            const f32x4 vw0 = *(const f32x4*)(cw + FF + c0 + 4 * n), vw1 = *(const f32x4*)(cw + FF2 + FF + c0 + 4 * n), vw2 = *(const f32x4*)(cw + 2 * FF2 + FF + c0 + 4 * n), vb = *(const f32x4*)(cb + FF + c0 + 4 * n);
#pragma unroll
            for (int ai = 0; ai < 2; ++ai) {
                const int chunk = 2 * ai + wr;
                f32x4 pg = {0.f, 0.f, 0.f, 0.f}, pv = {0.f, 0.f, 0.f, 0.f};
                if (chunk > 0) { const PG8_LAS unsigned char* bp = xlds + ((((chunk - 1) * 2 + (fr & 1)) * 256 + cl + 4 * n) << 2);
                    pg = *(const PG8_LAS f32x4*)bp; pv = *(const PG8_LAS f32x4*)(bp + 512); }
#pragma unroll
                for (int m = 0; m < 4; ++m) {
                    const f32x4 cg = acc[ai][0][m][n], cv = acc[ai][1][m][n]; float a[4];
#pragma unroll
                    for (int j = 0; j < 4; ++j) {
                        const float g1 = dpp_shr1(dpp_ror1(pg[j]), cg[j]), g2 = dpp_shr2(dpp_ror2(pg[j]), cg[j]);
                        const float v1 = dpp_shr1(dpp_ror1(pv[j]), cv[j]), v2 = dpp_shr2(dpp_ror2(pv[j]), cv[j]);
                        const float G = gw2[j] * cg[j] + (gw1[j] * g1 + (gw0[j] * g2 + gb[j]));
                        const float V = vw2[j] * cv[j] + (vw1[j] * v1 + (vw0[j] * v2 + vb[j]));
                        a[j] = G * __builtin_amdgcn_rcpf(1.0f + __builtin_amdgcn_exp2f(-1.4426950408889634f * G)) * V; }
                    u32x2 w; w.x = cvt_pk_bf16(a[0], a[1]); w.y = cvt_pk_bf16(a[2], a[3]);
                    if (n == 0) hold[ai][m] = w;
                    else { u32x4 o; o.x = hold[ai][m].x; o.y = hold[ai][m].y; o.z = w.x; o.w = w.y;
                        *(u32x4*)(ACT + (size_t)(row0 + ai * HALF + m * 16) * FF + c0) = o; }
                    pg = cg; pv = cv;
                }
            }
        }
    }
};

template <class Epi, class Sched, bool ALIGN_EPI = false, bool SP2 = false>
__device__ __forceinline__ void gemm_phase(PG8_LAS unsigned char* lds, const Gemm g, const Sched& S, const Epi& E, PG8_LAS unsigned char* xlds) {
    const int tid = threadIdx.x, wid = __builtin_amdgcn_readfirstlane(tid >> 6), lane = tid & 63, wr = wid >> 2, wc = wid & 3, fr = lane & 15, fq = lane >> 4;
    const int K = g.K, nt = K / BK;
    unsigned voffA[2], voffB[2];
#pragma unroll
    for (int i = 0; i < 2; ++i) { int R, C; stage_rc(tid * 16 + i * 8192, R, C); const int Rb = Epi::PERM ? ((R & ~31) + perm32(R & 31)) : R;
        voffA[i] = (unsigned)(R * K + C) * 2u; voffB[i] = (unsigned)(Rb * K + C) * 2u; }
    const size_t kstep = (size_t)(BK * 2);
    const size_t hstep = (size_t)HALF * K * 2;
    const size_t tstep = 2 * hstep;
    const unsigned ldsw = (unsigned)wid * 1024u;
    const int aoff = lds_byte(wr * 64 + fr, fq * 8), boff = lds_byte(wc * 32 + fr, fq * 8);
#define PG8_SA(b, h) (((b) * 2 + (h)) * HTB)
#define PG8_SB(b, h) ((4 + (b) * 2 + (h)) * HTB)
#define PG8_STAGE(bufoff, gbase, voff) do { _Pragma("unroll") for (int _i = 0; _i < 2; ++_i) \
        __builtin_amdgcn_global_load_lds((const unsigned*)((const char*)(gbase) + (voff)[_i]), (PG8_LAS unsigned*)(lds + (bufoff) + ldsw + _i * 8192), 16, 0, 0); } while (0)
#define PG8_LDA(dst, b, h) do { _Pragma("unroll") for (int m = 0; m < 4; ++m) _Pragma("unroll") for (int k = 0; k < 2; ++k) dst[m][k] = *(const PG8_LAS bf16x8*)(lds + PG8_SA(b, h) + aoff + m * 2048 + k * 1024); } while (0)
#define PG8_LDB(dst, b, h) do { _Pragma("unroll") for (int n = 0; n < 2; ++n) _Pragma("unroll") for (int k = 0; k < 2; ++k) dst[n][k] = *(const PG8_LAS bf16x8*)(lds + PG8_SB(b, h) + boff + n * 2048 + k * 1024); } while (0)
#define PG8_MMA(ai, bj, At, Bt) do { __builtin_amdgcn_s_setprio(1); _Pragma("unroll") for (int m = 0; m < 4; ++m) _Pragma("unroll") for (int n = 0; n < 2; ++n) _Pragma("unroll") for (int k = 0; k < 2; ++k) \
        acc[ai][bj][m][n] = __builtin_amdgcn_mfma_f32_16x16x32_bf16(Bt[n][k], At[m][k], acc[ai][bj][m][n], 0, 0, 0); __builtin_amdgcn_s_setprio(0); } while (0)
#define PG8_WAIT_V(n) asm volatile("s_waitcnt vmcnt(" #n ")" ::: "memory")
#define PG8_WAIT_L(n) asm volatile("s_waitcnt lgkmcnt(" #n ")" ::: "memory")
#define PG8_BAR __builtin_amdgcn_s_barrier()
#define PG8_SCHED __builtin_amdgcn_sched_barrier(0)
    Unit cur, nxt; int ui = 0;
    if (!S.next(0, cur)) return;
    f32x4 acc[2][2][4][2];
#pragma unroll
    for (int a = 0; a < 2; ++a)
#pragma unroll
        for (int b = 0; b < 2; ++b)
#pragma unroll
            for (int m = 0; m < 4; ++m)
#pragma unroll
                for (int n = 0; n < 2; ++n) acc[a][b][m][n] = (f32x4){0.f, 0.f, 0.f, 0.f};
    bf16x8 At[4][2], B0[2][2], B1[2][2];
    const char* cA = (const char*)g.A + (size_t)cur.pm * tstep; const char* cB = (const char*)g.Bt + (size_t)cur.pn * tstep;
    S.a_ready(cur);
    if constexpr (SP2) {
        PG8_STAGE(PG8_SB(0, 0), cB, voffB); PG8_STAGE(PG8_SB(0, 1), cB + hstep, voffB); PG8_STAGE(PG8_SA(0, 0), cA, voffA); PG8_STAGE(PG8_SA(0, 1), cA + hstep, voffA);
        if (wr == 1) PG8_BAR;
        PG8_WAIT_V(2); PG8_BAR;
        PG8_STAGE(PG8_SB(1, 0), cB + kstep, voffB); PG8_STAGE(PG8_SA(1, 0), cA + kstep, voffA); PG8_STAGE(PG8_SB(1, 1), cB + hstep + kstep, voffB);
        PG8_WAIT_V(6); PG8_BAR;
    } else {
        PG8_STAGE(PG8_SB(0, 0), cB, voffB); PG8_STAGE(PG8_SA(0, 0), cA, voffA); PG8_STAGE(PG8_SB(0, 1), cB + hstep, voffB); PG8_STAGE(PG8_SA(0, 1), cA + hstep, voffA);
        if (wr == 1) PG8_BAR;
        PG8_WAIT_V(4); PG8_BAR;
        PG8_STAGE(PG8_SB(1, 0), cB + kstep, voffB); PG8_STAGE(PG8_SA(1, 0), cA + kstep, voffA); PG8_STAGE(PG8_SB(1, 1), cB + hstep + kstep, voffB);
        PG8_WAIT_V(6); PG8_BAR;
    }
    for (;;) {
        const bool has_next = S.next(ui + 1, nxt);
        const char* nA = has_next ? (const char*)g.A + (size_t)nxt.pm * tstep : cA; const char* nB = has_next ? (const char*)g.Bt + (size_t)nxt.pn * tstep : cB;
        for (int t = 0; t < nt; t += 2) {
            const bool last = (t == nt - 2);
            const char* a1 = cA + (size_t)(t + 1) * kstep;
            const char* a2 = last ? nA : cA + (size_t)(t + 2) * kstep; const char* b2 = last ? nB : cB + (size_t)(t + 2) * kstep;
            const char* a3 = a2 + kstep; const char* b3 = b2 + kstep;
            if (last && has_next) S.a_ready(nxt);
            if constexpr (SP2) {
            PG8_LDB(B0, 0, 0); PG8_LDB(B1, 0, 1); PG8_SCHED; PG8_LDA(At, 0, 0); PG8_STAGE(PG8_SA(1, 1), a1 + hstep, voffA);
            PG8_WAIT_V(8); PG8_WAIT_L(0); PG8_BAR; PG8_MMA(0, 0, At, B0); PG8_MMA(0, 1, At, B1); PG8_BAR; PG8_SCHED;
            PG8_LDA(At, 0, 1); PG8_STAGE(PG8_SB(0, 0), b2, voffB); PG8_STAGE(PG8_SB(0, 1), b2 + hstep, voffB); PG8_STAGE(PG8_SA(0, 0), a2, voffA);
            PG8_WAIT_V(8); PG8_WAIT_L(0); PG8_BAR; PG8_MMA(1, 0, At, B0); PG8_MMA(1, 1, At, B1); PG8_BAR; PG8_SCHED;
            PG8_LDB(B0, 1, 0); PG8_LDB(B1, 1, 1); PG8_SCHED; PG8_LDA(At, 1, 0); PG8_STAGE(PG8_SA(0, 1), a2 + hstep, voffA);
            PG8_WAIT_V(8); PG8_WAIT_L(0); PG8_BAR; PG8_MMA(0, 0, At, B0); PG8_MMA(0, 1, At, B1); PG8_BAR; PG8_SCHED;
            PG8_LDA(At, 1, 1); PG8_STAGE(PG8_SB(1, 0), b3, voffB); PG8_STAGE(PG8_SB(1, 1), b3 + hstep, voffB); PG8_STAGE(PG8_SA(1, 0), a3, voffA);
            PG8_WAIT_V(8); PG8_WAIT_L(0); PG8_BAR; PG8_MMA(1, 0, At, B0); PG8_MMA(1, 1, At, B1); PG8_BAR; PG8_SCHED;
            } else {
            PG8_LDB(B0, 0, 0); PG8_SCHED; PG8_LDA(At, 0, 0); PG8_STAGE(PG8_SA(1, 1), a1 + hstep, voffA);
            PG8_WAIT_L(8); PG8_BAR; PG8_WAIT_L(0); PG8_MMA(0, 0, At, B0); PG8_BAR; PG8_SCHED;
            PG8_LDB(B1, 0, 1); PG8_STAGE(PG8_SB(0, 0), b2, voffB);
            PG8_BAR; PG8_WAIT_L(0); PG8_MMA(0, 1, At, B1); PG8_BAR;
            PG8_LDA(At, 0, 1); PG8_STAGE(PG8_SA(0, 0), a2, voffA);
            PG8_BAR; PG8_WAIT_L(0); PG8_MMA(1, 0, At, B0); PG8_BAR; PG8_SCHED;
            PG8_STAGE(PG8_SB(0, 1), b2 + hstep, voffB);
            PG8_WAIT_V(6); PG8_BAR; PG8_MMA(1, 1, At, B1); PG8_BAR;
            PG8_LDB(B0, 1, 0); PG8_SCHED; PG8_LDA(At, 1, 0); PG8_STAGE(PG8_SA(0, 1), a2 + hstep, voffA);
            PG8_WAIT_L(8); PG8_BAR; PG8_WAIT_L(0); PG8_MMA(0, 0, At, B0); PG8_BAR; PG8_SCHED;
            PG8_LDB(B1, 1, 1); PG8_STAGE(PG8_SB(1, 0), b3, voffB);
            PG8_BAR; PG8_WAIT_L(0); PG8_MMA(0, 1, At, B1); PG8_BAR;
            PG8_LDA(At, 1, 1); PG8_STAGE(PG8_SA(1, 0), a3, voffA);
            PG8_BAR; PG8_WAIT_L(0); PG8_MMA(1, 0, At, B0); PG8_BAR; PG8_SCHED;
            PG8_STAGE(PG8_SB(1, 1), b3 + hstep, voffB);
            PG8_WAIT_V(6); PG8_BAR; PG8_MMA(1, 1, At, B1); PG8_BAR;
            }
        }
        if constexpr (ALIGN_EPI) { if (wr == 0) PG8_BAR; }
        if constexpr (!Epi::AFTER_DRAIN) { E(acc, cur, wr, wc, fr, fq, xlds); S.done(cur); }
        if (!has_next) break;
#pragma unroll
        for (int a = 0; a < 2; ++a)
#pragma unroll
            for (int b = 0; b < 2; ++b)
#pragma unroll
                for (int m = 0; m < 4; ++m)
#pragma unroll
                    for (int n = 0; n < 2; ++n) acc[a][b][m][n] = (f32x4){0.f, 0.f, 0.f, 0.f};
        cur = nxt; cA = nA; cB = nB; ++ui;
        if constexpr (ALIGN_EPI) { if (wr == 1) PG8_BAR; }
    }
    PG8_WAIT_V(0);
    if constexpr (!ALIGN_EPI) { if (wr == 0) PG8_BAR; }
    PG8_BAR;

#undef PG8_SA
#undef PG8_SB
#undef PG8_STAGE
#undef PG8_LDA
#undef PG8_LDB
#undef PG8_MMA
#undef PG8_WAIT_V
#undef PG8_WAIT_L
#undef PG8_BAR
#undef PG8_SCHED
}
}

#define GAS __attribute__((address_space(1)))
#define LAS __attribute__((address_space(3)))
typedef unsigned short bf16;
typedef float f32x4 __attribute__((ext_vector_type(4)));
typedef short bf16x8 __attribute__((ext_vector_type(8)));
typedef unsigned u32x4 __attribute__((ext_vector_type(4)));
typedef unsigned u32x2 __attribute__((ext_vector_type(2)));

constexpr int NWAVES = 8;
constexpr int SEQ = 16384, DMODEL = 2048, NMEM = 256, DIN = 3584, DCONV = 768, DPOOL = 768, DXATT = 512, DFF = 5632, DFF2 = 11264;
constexpr int PGD = 192;
constexpr float EPS = 1e-6f;
constexpr int LDS_BYTES = 147456;
#ifndef MK_PER_PHASE
#define MK_PER_PHASE 0
#endif
constexpr int NPHASE = 8;
#ifndef PHM
#define PHM 255
#endif
#ifndef PROBE_SYNC
#define PROBE_SYNC 0
#endif
#ifndef PROBE_GEMM
#define PROBE_GEMM 0
#endif
#ifndef PROBE_N
#define PROBE_N 2048
#endif
#ifndef REPM
#define REPM 0
#endif

constexpr size_t MiB = 1u << 20;
constexpr size_t WS_KB = 1 * MiB;
constexpr size_t WS_VT = 1 * MiB + 256 * 1024;
constexpr size_t WS_POOLWT = 1 * MiB + 512 * 1024;
constexpr size_t WS_MB = 2 * MiB;
constexpr size_t WS_WKVT = 3 * MiB;
constexpr size_t WS_SLAB1 = 8 * MiB;
constexpr size_t WS_SLAB2 = 10 * MiB;
constexpr size_t WS_WUPT = 12 * MiB;
constexpr size_t WS_WDOWNT = 56 * MiB;
constexpr size_t WS_UBND = 80 * MiB;
constexpr size_t WS_X1B = 96 * MiB;
constexpr size_t WS_ACT = 160 * MiB;
constexpr size_t WS_H = 160 * MiB;
constexpr size_t WS_Z = 224 * MiB;
constexpr size_t WS_MIX = 336 * MiB;
constexpr size_t WS_WINT = 400 * MiB;
constexpr size_t WS_WOUTT = 414 * MiB;
constexpr size_t WS_END = 422 * MiB;

__device__ __forceinline__ unsigned f2bf(float f) { unsigned u = __builtin_bit_cast(unsigned, f); return (u + 0x7fffu + ((u >> 16) & 1u)) >> 16; }
__device__ __forceinline__ unsigned pk2(float lo, float hi) { return f2bf(lo) | (f2bf(hi) << 16); }
__device__ __forceinline__ float bflo(unsigned w) { return __builtin_bit_cast(float, w << 16); }
__device__ __forceinline__ float bfhi(unsigned w) { return __builtin_bit_cast(float, w & 0xffff0000u); }
__device__ __forceinline__ void unpack8(const u32x4 w, float (&f)[8]) { f[0] = bflo(w.x); f[1] = bfhi(w.x); f[2] = bflo(w.y); f[3] = bfhi(w.y); f[4] = bflo(w.z); f[5] = bfhi(w.z); f[6] = bflo(w.w); f[7] = bfhi(w.w); }
__device__ __forceinline__ u32x4 pack8(const float (&f)[8]) { u32x4 w; w.x = pk2(f[0], f[1]); w.y = pk2(f[2], f[3]); w.z = pk2(f[4], f[5]); w.w = pk2(f[6], f[7]); return w; }
__device__ __forceinline__ float wave_sum(float v) {
#pragma unroll
    for (int o = 1; o < 64; o <<= 1) v += __shfl_xor(v, o);
    return v;
}
#define LDS_WAIT() asm volatile("s_waitcnt lgkmcnt(0)" ::: "memory")

typedef GAS unsigned gu32;
constexpr size_t WS_CTL = 0, CTL_ZERO_BYTES = 64 * 1024;
constexpr int MISC_OFF = 131072 + 320;
constexpr int XLDS_OFF = 131072 + 1024;
#define XB_TMO      128
#define XB_XCNT(j)  (256  + 64 * (j))
#define XB_XSUB(j)  (1280 + 64 * (j))
#define XB_XGEN(j)  (2304 + 64 * (j))
#define XB_TOP      3328
#define XB_TOPGEN   3392
#define XCD_BAR_WORDS 3456
#define XB_SPIN_CAP (1u << 18)

__device__ __forceinline__ unsigned xb_ld(unsigned* p)              { return __hip_atomic_load(p, __ATOMIC_RELAXED, __HIP_MEMORY_SCOPE_AGENT); }
__device__ __forceinline__ unsigned xb_add(unsigned* p, unsigned v) { return __hip_atomic_fetch_add(p, v, __ATOMIC_RELAXED, __HIP_MEMORY_SCOPE_AGENT); }
__device__ __forceinline__ unsigned xb_xcc_id() { return (unsigned)__builtin_amdgcn_s_getreg((3 << 11) | 20) & 0xFu; }
#define XB_SPIN(cond, bar) do { unsigned _sp = 0; while (cond) { __builtin_amdgcn_s_sleep(1); \
    if ((++_sp & 255u) == 0u) { if (xb_ld(&(bar)[XB_TMO])) break; if (_sp > XB_SPIN_CAP) { atomicAdd(&(bar)[XB_TMO], 1u); break; } } } } while (0)

struct XcdBarrier {
    unsigned* bar; unsigned x;
    volatile LAS unsigned* st;
};

__device__ __forceinline__ XcdBarrier xcd_barrier_post(unsigned* bar, volatile LAS unsigned* st) {
    XcdBarrier b; b.bar = bar; b.x = xb_xcc_id(); b.st = st;
    if (threadIdx.x == 0) (void)xb_add(&bar[XB_XCNT(b.x)], 1u);
    return b;
}
__device__ __forceinline__ void xcd_barrier_complete(unsigned* bar, unsigned x, unsigned& nloc, unsigned& nx) {
    const unsigned G = gridDim.x * gridDim.y * gridDim.z;
    unsigned sum, cnt, mine, sp = 0u;
    for (;;) {
        sum = 0u; cnt = 0u; mine = 0u;
#pragma unroll
        for (unsigned j = 0; j < 16; ++j) { const unsigned c = xb_ld(&bar[XB_XCNT(j)]); sum += c; cnt += (c > 0u) ? 1u : 0u; mine = (j == x) ? c : mine; }
        if (sum == G) break;
        __builtin_amdgcn_s_sleep(1);
        if ((++sp & 255u) == 0u) { if (xb_ld(&bar[XB_TMO])) break; if (sp > XB_SPIN_CAP) { atomicAdd(&bar[XB_TMO], 1u); break; } }
    }
    nloc = mine > 0u ? mine : 1u; nx = cnt > 0u ? cnt : 1u;
}

__device__ __forceinline__ void xcd_barrier(const XcdBarrier& b) {
    asm volatile("s_waitcnt vmcnt(0)" ::: "memory");
    __syncthreads();
    if (threadIdx.x == 0) {
        unsigned* bar = b.bar;
        __builtin_amdgcn_s_waitcnt(0);
        unsigned nloc = b.st[0], nx = b.st[1];
        if (nloc == 0u) { xcd_barrier_complete(bar, b.x, nloc, nx); b.st[0] = nloc; b.st[1] = nx; }
        const unsigned old = xb_add(&bar[XB_XSUB(b.x)], 1u);
        const unsigned gen = old / nloc;
        if (old + 1u == (gen + 1u) * nloc) {
            __builtin_amdgcn_fence(__ATOMIC_RELEASE, "agent");
            asm volatile("s_waitcnt vmcnt(0)" ::: "memory");
            const unsigned og = xb_add(&bar[XB_TOP], 1u);
            const unsigned tg = og / nx;
            if (og + 1u == (tg + 1u) * nx) xb_add(&bar[XB_TOPGEN], 1u);
            else XB_SPIN(xb_ld(&bar[XB_TOPGEN]) == tg, bar);
            __builtin_amdgcn_fence(__ATOMIC_ACQUIRE, "agent");
            xb_add(&bar[XB_XGEN(b.x)], 1u);
            asm volatile("s_waitcnt vmcnt(0)" ::: "memory");
        } else {
            XB_SPIN(xb_ld(&bar[XB_XGEN(b.x)]) == gen, bar);
            __builtin_amdgcn_fence(__ATOMIC_ACQUIRE, "agent");
            asm volatile("s_waitcnt vmcnt(0)" ::: "memory");
        }
    }
    __syncthreads();
}


template <bool UPMAP> __device__ __forceinline__ void p0_transpose_item(const float* W, int K, int N, bf16* WT, const float* ks, LAS float* scr, int item, int lane) {
    const int nblk = N / 32, kb = item / nblk, nb = item % nblk, k0 = 64 * kb, n0 = 32 * nb;
    const int r0 = !UPMAP ? n0 : (n0 < DFF ? 256 * (n0 / 128) + (n0 % 128) : 256 * ((n0 - DFF) / 128) + 128 + ((n0 - DFF) % 128));
#pragma unroll 8
    for (int i = 0; i < 32; ++i) { const int kk = 2 * i + (lane >> 5); float v = W[(size_t)(k0 + kk) * N + n0 + (lane & 31)]; if (ks) v *= ks[k0 + kk]; scr[kk * 33 + (lane & 31)] = v; }
    LDS_WAIT(); asm volatile("" ::: "memory");
    const int c = lane & 7;
#pragma unroll
    for (int j = 0; j < 4; ++j) { const int n = (lane >> 3) + 8 * j; const LAS float* s = scr + (8 * c) * 33 + n;
        u32x4 o; o.x = pk2(s[0 * 33], s[1 * 33]); o.y = pk2(s[2 * 33], s[3 * 33]); o.z = pk2(s[4 * 33], s[5 * 33]); o.w = pk2(s[6 * 33], s[7 * 33]);
        *(u32x4*)(WT + (size_t)(r0 + n) * K + k0 + 8 * c) = o; }
    LDS_WAIT(); asm volatile("" ::: "memory");
}
__device__ __forceinline__ void rms_row_to_bf16(const float* xrow, const float* g, bf16* orow, int lane) {
    const f32x4* xr = (const f32x4*)xrow + lane; const f32x4* gr = (const f32x4*)g + lane;
    f32x4 v[8]; float s = 0.f;
#pragma unroll
    for (int j = 0; j < 8; ++j) { v[j] = xr[64 * j]; s += (v[j].x * v[j].x + v[j].y * v[j].y) + (v[j].z * v[j].z + v[j].w * v[j].w); }
    const float rstd = 1.0f / sqrtf(wave_sum(s) * (1.0f / DMODEL) + EPS);
    u32x2* o8 = (u32x2*)orow + lane;
#pragma unroll
    for (int j = 0; j < 8; ++j) { const f32x4 gg = gr[64 * j]; u32x2 w; w.x = pk2(v[j].x * rstd * gg.x, v[j].y * rstd * gg.y); w.y = pk2(v[j].z * rstd * gg.z, v[j].w * rstd * gg.w); o8[64 * j] = w; }
}

struct Ptrs {
    const float *x, *mem, *g_mix, *g_mem, *w_in, *conv_w, *pool_w, *pool_scale, *w_kv, *w_out, *g_ffn, *w_up, *ffn_conv_w, *ffn_conv_b, *w_down, *g_final;
    float* out; unsigned char* ws;
};

__device__ __forceinline__ void p0_prologue(const Ptrs& P, LAS unsigned char* lds, int gw, int NGW, int wave, int lane) {
    LAS float* scr = (LAS float*)(lds + wave * 16384);
    unsigned char* ws = P.ws;
    constexpr int I_IN = (DMODEL / 64) * (DIN / 32), I_OUT = (DMODEL / 64) * (DMODEL / 32), I_UP = (DMODEL / 64) * (DFF2 / 32), I_DN = (DFF / 64) * (DMODEL / 32),
                  I_KV = (DMODEL / 64) * (1024 / 32), I_PW = (PGD / 64) * (PGD / 32);
    constexpr int NITEMS = I_IN + I_OUT + I_UP + I_DN + I_KV + 4 * I_PW;
    for (int it = gw; it < NITEMS; it += NGW) {
        int r = it;
        if (r < I_IN) { p0_transpose_item<false>(P.w_in, DMODEL, DIN, (bf16*)(ws + WS_WINT), nullptr, scr, r, lane); continue; } r -= I_IN;
        if (r < I_OUT) { p0_transpose_item<false>(P.w_out, DMODEL, DMODEL, (bf16*)(ws + WS_WOUTT), nullptr, scr, r, lane); continue; } r -= I_OUT;
        if (r < I_UP) { p0_transpose_item<true>(P.w_up, DMODEL, DFF2, (bf16*)(ws + WS_WUPT), P.g_ffn, scr, r, lane); continue; } r -= I_UP;
        if (r < I_DN) { p0_transpose_item<false>(P.w_down, DFF, DMODEL, (bf16*)(ws + WS_WDOWNT), nullptr, scr, r, lane); continue; } r -= I_DN;
        if (r < I_KV) { p0_transpose_item<false>(P.w_kv, DMODEL, 1024, (bf16*)(ws + WS_WKVT), nullptr, scr, r, lane); continue; } r -= I_KV;
        const int g = r / I_PW; r -= g * I_PW;
        p0_transpose_item<false>(P.pool_w + (size_t)g * PGD * PGD, PGD, PGD, (bf16*)(ws + WS_POOLWT) + (size_t)g * PGD * PGD, nullptr, scr, r, lane);
    }
    for (int m = gw; m < SEQ; m += NGW) rms_row_to_bf16(P.x + (size_t)m * DMODEL, P.g_mix, (bf16*)(ws + WS_H) + (size_t)m * DMODEL, lane);
    for (int m = gw; m < NMEM; m += NGW) rms_row_to_bf16(P.mem + (size_t)m * DMODEL, P.g_mem, (bf16*)(ws + WS_MB) + (size_t)m * DMODEL, lane);
}

__device__ __forceinline__ void kv_tile(const Ptrs& P, int tt, int lane) {
    const bf16* mB = (const bf16*)(P.ws + WS_MB); const bf16* wT = (const bf16*)(P.ws + WS_WKVT);
    const int rb = tt >> 6, cb = tt & 63, fr = lane & 15, fq = lane >> 4;
    const bf16* ap = mB + (size_t)(16 * rb + fr) * DMODEL + 8 * fq; const bf16* wp = wT + (size_t)(16 * cb + fr) * DMODEL + 8 * fq;
    f32x4 acc = {0.f, 0.f, 0.f, 0.f};
    if (cb < 32) {
#pragma unroll 8
        for (int ks = 0; ks < 64; ++ks) { const bf16x8 a = *(const bf16x8*)(ap + 32 * ks), w = *(const bf16x8*)(wp + 32 * ks); acc = __builtin_amdgcn_mfma_f32_16x16x32_bf16(w, a, acc, 0, 0, 0); }
        u32x2 o; o.x = pk2(acc[0], acc[1]); o.y = pk2(acc[2], acc[3]);
        *(u32x2*)((bf16*)(P.ws + WS_KB) + (size_t)(16 * rb + fr) * 512 + 16 * cb + 4 * fq) = o;
    } else {
#pragma unroll 8
        for (int ks = 0; ks < 64; ++ks) { const bf16x8 a = *(const bf16x8*)(ap + 32 * ks), w = *(const bf16x8*)(wp + 32 * ks); acc = __builtin_amdgcn_mfma_f32_16x16x32_bf16(a, w, acc, 0, 0, 0); }
        u32x2 o; o.x = pk2(acc[0], acc[1]); o.y = pk2(acc[2], acc[3]);
        *(u32x2*)((bf16*)(P.ws + WS_VT) + (size_t)(16 * cb - 512 + fr) * 256 + 32 * (rb >> 1) + 8 * fq + 4 * (rb & 1)) = o;
    }
}

__device__ __forceinline__ void mix_conv_task(const Ptrs& P, int blk, int lane) {
    const bf16* z = (const bf16*)(P.ws + WS_Z); bf16* mix = (bf16*)(P.ws + WS_MIX);
    const int t0 = blk * 16;
    for (int cg = lane; cg < DCONV / 8; cg += 64) {
        const int c = cg * 8;
        float w0[8], w1[8], w2[8], p1[8], p2[8];
#pragma unroll
        for (int e = 0; e < 8; ++e) { w0[e] = P.conv_w[c + e]; w1[e] = P.conv_w[DCONV + c + e]; w2[e] = P.conv_w[2 * DCONV + c + e]; p1[e] = 0.f; p2[e] = 0.f; }
        for (int r = -2; r < 16; ++r) {
            const int t = t0 + r; float p[8];
            if (t >= 0) { float a[8], b[8]; unpack8(*(const u32x4*)(z + (size_t)t * DIN + DCONV + c), a); unpack8(*(const u32x4*)(z + (size_t)t * DIN + 2 * DCONV + c), b);
#pragma unroll
                for (int e = 0; e < 8; ++e) p[e] = a[e] * b[e]; }
            else {
#pragma unroll
                for (int e = 0; e < 8; ++e) p[e] = 0.f; }
            if (r >= 0) { float g[8], o[8]; unpack8(*(const u32x4*)(z + (size_t)t * DIN + c), g);
#pragma unroll
                for (int e = 0; e < 8; ++e) o[e] = g[e] * (w2[e] * p[e] + w1[e] * p1[e] + w0[e] * p2[e]);
                *(u32x4*)(mix + (size_t)t * DMODEL + c) = pack8(o); }
#pragma unroll
            for (int e = 0; e < 8; ++e) { p2[e] = p1[e]; p1[e] = p[e]; }
        }
    }
}
__device__ __forceinline__ void mix_pool_task(const Ptrs& P, int g, int blk, int lane) {
    const bf16* z = (const bf16*)(P.ws + WS_Z); bf16* mix = (bf16*)(P.ws + WS_MIX); const bf16* wt = (const bf16*)(P.ws + WS_POOLWT) + (size_t)g * PGD * PGD;
    const int fr = lane & 15, fq = lane >> 4, t = blk * 16 + fr, k = 2 << g;
    const int cnt = (t + 1 < k) ? t + 1 : k; const float inv = 1.0f / (float)cnt;
    f32x4 acc[12];
#pragma unroll
    for (int n = 0; n < 12; ++n) acc[n] = (f32x4){0.f, 0.f, 0.f, 0.f};
    for (int ks = 0; ks < 6; ++ks) {
        const int c = 32 * ks + 8 * fq; const bf16* zc = z + 3 * DCONV + PGD * g + c;
        float sum[8], self[8];
        unpack8(*(const u32x4*)(zc + (size_t)t * DIN), self);
#pragma unroll
        for (int e = 0; e < 8; ++e) sum[e] = self[e];
        for (int j = 1; j < k; ++j) { const int tt = t - j; const bool ok = tt >= 0; float v[8]; unpack8(*(const u32x4*)(zc + (size_t)(ok ? tt : 0) * DIN), v);
#pragma unroll
            for (int e = 0; e < 8; ++e) sum[e] += ok ? v[e] : 0.f; }
        float pl[8];
#pragma unroll
        for (int e = 0; e < 8; ++e) pl[e] = sum[e] * inv - self[e];
        const bf16x8 pf = __builtin_bit_cast(bf16x8, pack8(pl));
#pragma unroll
        for (int n = 0; n < 12; ++n) { const bf16x8 wf = *(const bf16x8*)(wt + (size_t)(16 * n + fr) * PGD + c); acc[n] = __builtin_amdgcn_mfma_f32_16x16x32_bf16(wf, pf, acc[n], 0, 0, 0); }
    }
#pragma unroll
    for (int n = 0; n < 12; ++n) { const int d = 16 * n + 4 * fq; const f32x4 sc = *(const f32x4*)(P.pool_scale + PGD * g + d);
        u32x2 o; o.x = pk2(acc[n][0] * sc[0], acc[n][1] * sc[1]); o.y = pk2(acc[n][2] * sc[2], acc[n][3] * sc[3]);
        *(u32x2*)(mix + (size_t)t * DMODEL + DCONV + PGD * g + d) = o; }
}
__device__ __forceinline__ void mix_attn_task(const Ptrs& P, int h, int blk, int lane) {
    const bf16* z = (const bf16*)(P.ws + WS_Z); bf16* mix = (bf16*)(P.ws + WS_MIX); const bf16* Kb = (const bf16*)(P.ws + WS_KB); const bf16* Vt = (const bf16*)(P.ws + WS_VT);
    const int fr = lane & 15, fq = lane >> 4, t = blk * 16 + fr;
    bf16x8 qf[4];
#pragma unroll
    for (int ks = 0; ks < 4; ++ks) qf[ks] = *(const bf16x8*)(z + (size_t)t * DIN + 3 * DCONV + DPOOL + 128 * h + 32 * ks + 8 * fq);
    f32x4 s[16];
#pragma unroll
    for (int kb = 0; kb < 16; ++kb) { s[kb] = (f32x4){0.f, 0.f, 0.f, 0.f};
#pragma unroll
        for (int ks = 0; ks < 4; ++ks) { const bf16x8 kf = *(const bf16x8*)(Kb + (size_t)(16 * kb + fr) * 512 + 128 * h + 32 * ks + 8 * fq); s[kb] = __builtin_amdgcn_mfma_f32_16x16x32_bf16(kf, qf[ks], s[kb], 0, 0, 0); } }
    float mx = -3.0e38f;
#pragma unroll
    for (int kb = 0; kb < 16; ++kb) mx = fmaxf(fmaxf(fmaxf(s[kb][0], s[kb][1]), fmaxf(s[kb][2], s[kb][3])), mx);
    mx = fmaxf(mx, __shfl_xor(mx, 16)); mx = fmaxf(mx, __shfl_xor(mx, 32));
    const float c2 = 0.08838834764831845f * 1.4426950408889634f;
    float sum = 0.f;
#pragma unroll
    for (int kb = 0; kb < 16; ++kb)
#pragma unroll
        for (int r = 0; r < 4; ++r) { const float p = __builtin_amdgcn_exp2f((s[kb][r] - mx) * c2); s[kb][r] = p; sum += p; }
    sum += __shfl_xor(sum, 16); sum += __shfl_xor(sum, 32);
    const float inv = 1.0f / sum;
    f32x4 o[8];
#pragma unroll
    for (int db = 0; db < 8; ++db) o[db] = (f32x4){0.f, 0.f, 0.f, 0.f};
#pragma unroll
    for (int ks = 0; ks < 8; ++ks) {
        u32x4 pw; pw.x = pk2(s[2 * ks][0], s[2 * ks][1]); pw.y = pk2(s[2 * ks][2], s[2 * ks][3]); pw.z = pk2(s[2 * ks + 1][0], s[2 * ks + 1][1]); pw.w = pk2(s[2 * ks + 1][2], s[2 * ks + 1][3]);
        const bf16x8 pf = __builtin_bit_cast(bf16x8, pw);
#pragma unroll
        for (int db = 0; db < 8; ++db) { const bf16x8 vf = *(const bf16x8*)(Vt + (size_t)(128 * h + 16 * db + fr) * 256 + 32 * ks + 8 * fq); o[db] = __builtin_amdgcn_mfma_f32_16x16x32_bf16(vf, pf, o[db], 0, 0, 0); }
    }
#pragma unroll
    for (int db = 0; db < 8; ++db) { u32x2 w; w.x = pk2(o[db][0] * inv, o[db][1] * inv); w.y = pk2(o[db][2] * inv, o[db][3] * inv);
        *(u32x2*)(mix + (size_t)t * DMODEL + DCONV + DPOOL + 128 * h + 16 * db + 4 * fq) = w; }
}
__device__ __forceinline__ void p2_mixer(const Ptrs& P, int gw, int NGW, int lane) {
    constexpr int NBLK = SEQ / 16;
    for (int it = gw; it < 9 * NBLK; it += NGW) {
        const int task = it / NBLK, blk = it % NBLK;
        if (task == 0) mix_conv_task(P, blk, lane);
        else if (task < 5) mix_pool_task(P, task - 1, blk, lane);
        else mix_attn_task(P, task - 5, blk, lane);
    }
}

__device__ __forceinline__ void p5_fixup(const Ptrs& P, int gt, int NGT) {
    const float* ub = (const float*)(P.ws + WS_UBND); bf16* act = (bf16*)(P.ws + WS_ACT); const float* cw = P.ffn_conv_w; const float* cb = P.ffn_conv_b;
    for (int i = gt; i < 63 * (DFF / 8); i += NGT) {
        const int pm = 1 + i / (DFF / 8), c = (i % (DFF / 8)) * 8, gi = 256 * (c / 128) + (c % 128);
        const float* p2 = ub + (size_t)((pm - 1) * 4 + 2) * DFF2 + gi; const float* p1 = p2 + DFF2; const float* r0 = ub + (size_t)(pm * 4) * DFF2 + gi; const float* r1 = r0 + DFF2;
        float o0[8], o1[8];
#pragma unroll
        for (int e = 0; e < 8; ++e) {
            const float gw0 = cw[c + e], gw1 = cw[DFF2 + c + e], gw2 = cw[2 * DFF2 + c + e], gb = cb[c + e], vw0 = cw[DFF + c + e], vw1 = cw[DFF2 + DFF + c + e], vw2 = cw[2 * DFF2 + DFF + c + e], vb = cb[DFF + c + e];
            const float G0 = gw2 * r0[e] + (gw1 * p1[e] + (gw0 * p2[e] + gb)), V0 = vw2 * r0[128 + e] + (vw1 * p1[128 + e] + (vw0 * p2[128 + e] + vb));
            const float G1 = gw2 * r1[e] + (gw1 * r0[e] + (gw0 * p1[e] + gb)), V1 = vw2 * r1[128 + e] + (vw1 * r0[128 + e] + (vw0 * p1[128 + e] + vb));
            o0[e] = G0 * __builtin_amdgcn_rcpf(1.0f + __builtin_amdgcn_exp2f(-1.4426950408889634f * G0)) * V0;
            o1[e] = G1 * __builtin_amdgcn_rcpf(1.0f + __builtin_amdgcn_exp2f(-1.4426950408889634f * G1)) * V1; }
        *(u32x4*)(act + (size_t)(256 * pm) * DFF + c) = pack8(o0); *(u32x4*)(act + (size_t)(256 * pm + 1) * DFF + c) = pack8(o1);
    }
}

__device__ __forceinline__ void p7_final(const Ptrs& P, int gw, int NGW, int lane) {
    const float* slab = (const float*)(P.ws + WS_SLAB2);
    for (int m = gw; m < SEQ; m += NGW) {
        const float part = (lane < 32) ? slab[(size_t)m * 32 + lane] : 0.f;
        const float rstd = 1.0f / sqrtf(wave_sum(part) * (1.0f / DMODEL) + EPS);
        f32x4* xr = (f32x4*)(P.out + (size_t)m * DMODEL) + lane; const f32x4* gr = (const f32x4*)P.g_final + lane;
#pragma unroll
        for (int j = 0; j < 8; ++j) { f32x4 v = xr[64 * j]; const f32x4 gg = gr[64 * j]; v = v * rstd * gg; xr[64 * j] = v; }
    }
}

struct Args { const float* in[16]; float* out; unsigned char* ws; int ph_lo, ph_hi; };
__global__ void __launch_bounds__(NWAVES * 64, 2) hybrid_fwd(Args args) {
    extern __shared__ __attribute__((aligned(16))) unsigned char lds_raw[];
    LAS unsigned char* lds = (LAS unsigned char*)lds_raw;
    cg::grid_group grid = cg::this_grid();
    const int tid = threadIdx.x, lane = tid & 63, wave = __builtin_amdgcn_readfirstlane(tid >> 6);
    const int G = gridDim.x, bx = blockIdx.x, vcu = (G % 8 == 0) ? (bx % 8) * (G / 8) + bx / 8 : bx;
    const int gw = vcu * NWAVES + wave, NGW = G * NWAVES;
    volatile LAS unsigned* MISC = (volatile LAS unsigned*)(lds + MISC_OFF);
    if (tid < 32) MISC[tid] = 0u;
    __syncthreads();
    const XcdBarrier bar = xcd_barrier_post((unsigned*)(args.ws + WS_CTL), MISC + 8);
    Ptrs P;
    P.x = args.in[0]; P.mem = args.in[1]; P.g_mix = args.in[2]; P.g_mem = args.in[3]; P.w_in = args.in[4]; P.conv_w = args.in[5]; P.pool_w = args.in[6]; P.pool_scale = args.in[7];
    P.w_kv = args.in[8]; P.w_out = args.in[9]; P.g_ffn = args.in[10]; P.w_up = args.in[11]; P.ffn_conv_w = args.in[12]; P.ffn_conv_b = args.in[13]; P.w_down = args.in[14]; P.g_final = args.in[15];
    P.out = args.out; P.ws = args.ws;
    unsigned char* ws = args.ws;
#if PROBE_SYNC
    for (int i = 0; i < 20; ++i) xcd_barrier(bar);
#endif
    const int lo = args.ph_lo, hi = args.ph_hi;
#define IN(k) (lo <= (k) && (k) < hi)
#define SYNC(k) do { if ((k) + 1 < hi) { if ((k) == 0) grid.sync(); else xcd_barrier(bar); } } while (0)
#define SYNCR(k, b) do { if ((k) + 1 < hi || rp + 1 < NREP(b)) { if ((k) == 0) grid.sync(); else xcd_barrier(bar); } } while (0)
#define NREP(b) ((REPM & (b)) ? 2 : 1)
    if (IN(0) && (PHM & 1)) for (int rp = 0; rp < NREP(1); ++rp) { p0_prologue(P, lds, gw, NGW, wave, lane); SYNCR(0, 1); }
    if (IN(1) && (PHM & 2)) for (int rp = 0; rp < NREP(2); ++rp) {
        pg8::Gemm g{(const bf16*)(ws + WS_H), (const bf16*)(ws + WS_WINT), SEQ, DIN, DMODEL}; pg8::StaticOrder S; S.init(SEQ, DIN, G, bx);
        pg8::EpiZ E{(bf16*)(ws + WS_Z), DIN};
        pg8::gemm_phase<pg8::EpiZ, pg8::StaticOrder, true, true>(lds, g, S, E, lds + XLDS_OFF);
        if (wave < 4) { for (int tt = vcu * 4 + wave; tt < 1024; tt += G * 4) kv_tile(P, tt, lane); }
        SYNCR(1, 2);
    }
    if (IN(2) && (PHM & 4)) for (int rp = 0; rp < NREP(4); ++rp) { p2_mixer(P, gw, NGW, lane); SYNCR(2, 4); }
    if (IN(3) && (PHM & 8)) for (int rp = 0; rp < NREP(8); ++rp) {
        pg8::Gemm g{(const bf16*)(ws + WS_MIX), (const bf16*)(ws + WS_WOUTT), SEQ, DMODEL, DMODEL}; pg8::StaticOrder S; S.init(SEQ, DMODEL, G, bx);
        pg8::EpiRes<true> E{P.x, P.out, (bf16*)(ws + WS_X1B), (float*)(ws + WS_SLAB1)};
        pg8::gemm_phase<pg8::EpiRes<true>, pg8::StaticOrder, true, true>(lds, g, S, E, lds + XLDS_OFF);
        SYNCR(3, 8);
    }
#if PROBE_GEMM
    if (IN(3)) {
        pg8::Gemm g{(const bf16*)(ws + WS_X1B), (const bf16*)(ws + WS_WUPT), SEQ, PROBE_N, DMODEL}; pg8::StaticOrder S; S.init(SEQ, PROBE_N, G, bx);
#if PROBE_GEMM == 1
        pg8::EpiZ E{(bf16*)(ws + WS_Z), PROBE_N};
        pg8::gemm_phase<pg8::EpiZ, pg8::StaticOrder, true, true>(lds, g, S, E, lds + XLDS_OFF);
#elif PROBE_GEMM == 2
        pg8::EpiNone E{};
        pg8::gemm_phase<pg8::EpiNone, pg8::StaticOrder, true, true>(lds, g, S, E, lds + XLDS_OFF);
#elif PROBE_GEMM == 3
        pg8::EpiZ E{(bf16*)(ws + WS_Z), PROBE_N};
        pg8::gemm_phase<pg8::EpiZ, pg8::StaticOrder, true, false>(lds, g, S, E, lds + XLDS_OFF);
#elif PROBE_GEMM == 4
        pg8::EpiZ E{(bf16*)(ws + WS_Z), PROBE_N};
        pg8::gemm_phase<pg8::EpiZ, pg8::StaticOrder, false, true>(lds, g, S, E, lds + XLDS_OFF);
#endif
        xcd_barrier(bar);
    }
#endif
    if (IN(4) && (PHM & 16)) for (int rp = 0; rp < NREP(16); ++rp) {
        pg8::Gemm g{(const bf16*)(ws + WS_X1B), (const bf16*)(ws + WS_WUPT), SEQ, DFF2, DMODEL}; pg8::StaticOrder S; S.init(SEQ, DFF2, G, bx);
        pg8::EpiAct E{(bf16*)(ws + WS_ACT), (const float*)(ws + WS_SLAB1), P.ffn_conv_w, P.ffn_conv_b, (float*)(ws + WS_UBND)};
        pg8::gemm_phase<pg8::EpiAct, pg8::StaticOrder, true, true>(lds, g, S, E, lds + XLDS_OFF);
        xcd_barrier(bar);
    }
    if (IN(5) && (PHM & 32)) { p5_fixup(P, vcu * (NWAVES * 64) + tid, G * NWAVES * 64); xcd_barrier(bar); }
    if (IN(6) && (PHM & 64)) {
        pg8::Gemm g{(const bf16*)(ws + WS_ACT), (const bf16*)(ws + WS_WDOWNT), SEQ, DMODEL, DFF}; pg8::StaticOrder S; S.init(SEQ, DMODEL, G, bx);
        pg8::EpiRes<false> E{P.out, P.out, nullptr, (float*)(ws + WS_SLAB2)};
        pg8::gemm_phase<pg8::EpiRes<false>, pg8::StaticOrder, true, true>(lds, g, S, E, lds + XLDS_OFF);
        SYNC(6);
    }
    if (IN(7) && (PHM & 128)) p7_final(P, gw, NGW, lane);
#undef IN
#undef SYNC
}

extern "C" void kernel_launch(void* const* d_in, const int* in_sizes, int n_in, void* d_out, int out_size, void* d_ws, size_t ws_size, hipStream_t stream) {
    static int grid = 0;
    if (grid == 0) {
        if (n_in != 16 || in_sizes[0] != SEQ * DMODEL || out_size != SEQ * DMODEL || ws_size < WS_END) { fprintf(stderr, "kernel_launch: unexpected shapes (n_in %d, in0 %d, out %d, ws %zu)\n", n_in, n_in > 0 ? in_sizes[0] : -1, out_size, ws_size); grid = -1; return; }
        int dev = 0, cus = 0, per_cu = 0;
        if (hipGetDevice(&dev) != hipSuccess || hipDeviceGetAttribute(&cus, hipDeviceAttributeMultiprocessorCount, dev) != hipSuccess) { grid = -1; return; }
        if (hipFuncSetAttribute((const void*)hybrid_fwd, hipFuncAttributeMaxDynamicSharedMemorySize, LDS_BYTES) != hipSuccess) { fprintf(stderr, "kernel_launch: hipFuncSetAttribute failed\n"); grid = -1; return; }
        if (hipOccupancyMaxActiveBlocksPerMultiprocessor(&per_cu, (const void*)hybrid_fwd, NWAVES * 64, LDS_BYTES) != hipSuccess || per_cu < 1) { fprintf(stderr, "kernel_launch: occupancy query says %d blocks per CU\n", per_cu); (void)hipGetLastError(); per_cu = 1; }
        grid = cus;
        if (grid % 8 != 0 || grid < 8) { fprintf(stderr, "kernel_launch: %d CUs\n", grid); }
    }
    if (grid < 0) return;
    if (hipMemsetAsync((char*)d_ws + WS_CTL, 0, CTL_ZERO_BYTES, stream) != hipSuccess) { fprintf(stderr, "kernel_launch: hipMemsetAsync failed\n"); return; }
    Args a{};
    for (int i = 0; i < 16; ++i) a.in[i] = (const float*)d_in[i];
    a.out = (float*)d_out; a.ws = (unsigned char*)d_ws;
#if MK_PER_PHASE
    for (int ph = 0; ph < NPHASE; ++ph) { a.ph_lo = ph; a.ph_hi = ph + 1; hipLaunchKernelGGL(hybrid_fwd, dim3(grid), dim3(NWAVES * 64), LDS_BYTES, stream, a); }
#else
    a.ph_lo = 0; a.ph_hi = NPHASE;
    void* kargs[] = {&a};
    hipError_t e = hipLaunchCooperativeKernel((const void*)hybrid_fwd, dim3(grid), dim3(NWAVES * 64), kargs, LDS_BYTES, stream);
    if (e != hipSuccess) fprintf(stderr, "kernel_launch: cooperative launch failed: %s (grid %d)\n", hipGetErrorString(e), grid);
#endif
}
```

```cpp
#include <hip/hip_runtime.h>
#include <hip/hip_cooperative_groups.h>
#include <cstdio>
#include <cstdint>
namespace cg = cooperative_groups;
namespace pg8 {
#define PG8_LAS __attribute__((address_space(3)))
typedef unsigned short bf16_t;
typedef short bf16x8 __attribute__((ext_vector_type(8)));
typedef float f32x4 __attribute__((ext_vector_type(4)));
typedef unsigned u32x4 __attribute__((ext_vector_type(4)));
constexpr int BM = 256, BK = 64, HALF = 128, HTB = HALF * BK * 2  , STAGE_BYTES = 8 * HTB, NXCD = 8, WGM = 8;

__host__ __device__ __forceinline__ int lds_byte(int r, int c) { const int st = (r >> 4) * 2 + (c >> 5), rr = r & 15, cc = c & 31, ob = rr * 64 + cc * 2; return st * 1024 + (ob ^ (((ob >> 9) & 1) << 5)); }
__host__ __device__ __forceinline__ void stage_rc(int b, int& R, int& C) { const int st = b / 1024, sb = b % 1024, swz = sb ^ (((sb >> 9) & 1) << 5); R = (st >> 1) * 16 + swz / 64; C = (st & 1) * 32 + (swz % 64) / 2; }
__host__ __device__ __forceinline__ int perm32(int rho) { const int n = rho >> 4, i = rho & 15; return 8 * (i >> 2) + 4 * n + (i & 3); }

struct Unit { int pm, pn; };
struct Gemm { const bf16_t* A; const bf16_t* Bt; int M, N, K; };

struct StaticOrder {
    int nM, nN, nwg, G, c;
    __host__ __device__ void init(int M, int N, int G_, int c_) { nM = M / BM; nN = N / BM; nwg = nM * nN; G = G_; c = c_; }
    __host__ __device__ bool next(int i, Unit& u) const {
        const long L = (long)i * G + c; if (L >= nwg) return false;
        int wgid = (int)L; { const int q = nwg / NXCD, r = nwg % NXCD, xcd = wgid % NXCD, off = wgid / NXCD; wgid = (xcd < r ? xcd * (q + 1) : r * (q + 1) + (xcd - r) * q) + off; }
        const int nig = WGM * nN, gid = wgid / nig, fm = gid * WGM, gsz = (nM - fm) < WGM ? (nM - fm) : WGM;
        u.pm = fm + ((wgid % nig) % gsz); u.pn = (wgid % nig) / gsz; return true;
    }
    __device__ __forceinline__ void a_ready(const Unit&) const {}
    __device__ __forceinline__ void done(const Unit&) const {}
};
__device__ __forceinline__ unsigned cvt_pk_bf16(float lo, float hi) { unsigned r; asm volatile("v_cvt_pk_bf16_f32 %0, %1, %2" : "=v"(r) : "v"(lo), "v"(hi)); return r; }
typedef unsigned u32x2 __attribute__((ext_vector_type(2)));
constexpr int DM = 2048;
constexpr float RMS_EPS = 1e-6f;

struct EpiZ {
    static constexpr bool PERM = true, AFTER_DRAIN = false;
    bf16_t* O; int ldc;
    __device__ __forceinline__ void operator()(const f32x4 (&acc)[2][2][4][2], const Unit& u, int wr, int wc, int fr_, int fq_, PG8_LAS unsigned char*) const {
        int t_ = threadIdx.x; asm volatile("" : "+v"(t_));
        const int fr = t_ & 15, fq = (t_ >> 4) & 3;
        const int row0 = u.pm * BM + wr * 64 + fr, col0 = u.pn * BM + wc * 32 + 8 * fq;
#pragma unroll
        for (int ai = 0; ai < 2; ++ai)
#pragma unroll
            for (int m = 0; m < 4; ++m) { bf16_t* rowp = O + (size_t)(row0 + ai * HALF + m * 16) * ldc + col0;
#pragma unroll
                for (int bj = 0; bj < 2; ++bj) { const f32x4 v0 = acc[ai][bj][m][0], v1 = acc[ai][bj][m][1];
                    u32x4 w; w.x = cvt_pk_bf16(v0[0], v0[1]); w.y = cvt_pk_bf16(v0[2], v0[3]); w.z = cvt_pk_bf16(v1[0], v1[1]); w.w = cvt_pk_bf16(v1[2], v1[3]);
                    *(u32x4*)(rowp + bj * HALF) = w; } }
    }
};

struct EpiNone {
    static constexpr bool PERM = true, AFTER_DRAIN = false;
    __device__ __forceinline__ void operator()(const f32x4 (&acc)[2][2][4][2], const Unit& u, int wr, int wc, int fr, int fq, PG8_LAS unsigned char*) const {
#pragma unroll
        for (int ai = 0; ai < 2; ++ai)
#pragma unroll
            for (int bj = 0; bj < 2; ++bj)
#pragma unroll
                for (int m = 0; m < 4; ++m)
#pragma unroll
                    for (int n = 0; n < 2; ++n) asm volatile("" :: "v"(acc[ai][bj][m][n]));
    }
};
struct EpiResA {
    static constexpr bool PERM = true, AFTER_DRAIN = false;
    const float* R; bf16_t* XB; float* slab;
    __device__ __forceinline__ void operator()(const f32x4 (&acc)[2][2][4][2], const Unit& u, int wr, int wc, int fr_, int fq_, PG8_LAS unsigned char*) const {
        int t_ = threadIdx.x; asm volatile("" : "+v"(t_));
        const int fr = t_ & 15, fq = (t_ >> 4) & 3;
        const int row0 = u.pm * BM + wr * 64 + fr, col0 = u.pn * BM + wc * 32 + 8 * fq;
#pragma unroll
        for (int ai = 0; ai < 2; ++ai) {
            f32x4 r[4][2][2];
#pragma unroll
            for (int m = 0; m < 4; ++m)
#pragma unroll
                for (int bj = 0; bj < 2; ++bj) { const float* p = R + (size_t)(row0 + ai * HALF + m * 16) * DM + col0 + bj * HALF; r[m][bj][0] = *(const f32x4*)p; r[m][bj][1] = *(const f32x4*)(p + 4); }
#pragma unroll
            for (int m = 0; m < 4; ++m) { const int row = row0 + ai * HALF + m * 16; float ss = 0.f;
#pragma unroll
                for (int bj = 0; bj < 2; ++bj) { const f32x4 v0 = acc[ai][bj][m][0] + r[m][bj][0], v1 = acc[ai][bj][m][1] + r[m][bj][1];
                    u32x4 w; w.x = cvt_pk_bf16(v0[0], v0[1]); w.y = cvt_pk_bf16(v0[2], v0[3]); w.z = cvt_pk_bf16(v1[0], v1[1]); w.w = cvt_pk_bf16(v1[2], v1[3]);
                    *(u32x4*)(XB + (size_t)row * DM + col0 + bj * HALF) = w;
                    ss += (v0[0] * v0[0] + v0[1] * v0[1]) + (v0[2] * v0[2] + v0[3] * v0[3]) + (v1[0] * v1[0] + v1[1] * v1[1]) + (v1[2] * v1[2] + v1[3] * v1[3]); }
                ss += __shfl_xor(ss, 16); ss += __shfl_xor(ss, 32);
                if (fq == 0) slab[(size_t)row * 32 + u.pn * 4 + wc] = ss; }
            asm volatile("" ::: "memory"); }
    }
};
struct EpiResB {
    static constexpr bool PERM = true, AFTER_DRAIN = false;
    const bf16_t* RB; float* X; float* slab;
    __device__ __forceinline__ void operator()(const f32x4 (&acc)[2][2][4][2], const Unit& u, int wr, int wc, int fr_, int fq_, PG8_LAS unsigned char*) const {
        int t_ = threadIdx.x; asm volatile("" : "+v"(t_));
        const int fr = t_ & 15, fq = (t_ >> 4) & 3;
        const int row0 = u.pm * BM + wr * 64 + fr, col0 = u.pn * BM + wc * 32 + 8 * fq;
        u32x4 r[2][4][2];
#pragma unroll
        for (int ai = 0; ai < 2; ++ai)
#pragma unroll
            for (int m = 0; m < 4; ++m)
#pragma unroll
                for (int bj = 0; bj < 2; ++bj) r[ai][m][bj] = *(const u32x4*)(RB + (size_t)(row0 + ai * HALF + m * 16) * DM + col0 + bj * HALF);
#pragma unroll
        for (int ai = 0; ai < 2; ++ai)
#pragma unroll
            for (int m = 0; m < 4; ++m) { const int row = row0 + ai * HALF + m * 16; float ss = 0.f;
#pragma unroll
                for (int bj = 0; bj < 2; ++bj) { const u32x4 q = r[ai][m][bj];
                    const f32x4 r0 = {__builtin_bit_cast(float, q.x << 16), __builtin_bit_cast(float, q.x & 0xffff0000u), __builtin_bit_cast(float, q.y << 16), __builtin_bit_cast(float, q.y & 0xffff0000u)};
                    const f32x4 r1 = {__builtin_bit_cast(float, q.z << 16), __builtin_bit_cast(float, q.z & 0xffff0000u), __builtin_bit_cast(float, q.w << 16), __builtin_bit_cast(float, q.w & 0xffff0000u)};
                    const f32x4 v0 = acc[ai][bj][m][0] + r0, v1 = acc[ai][bj][m][1] + r1;
                    float* xp = X + (size_t)row * DM + col0 + bj * HALF; *(f32x4*)xp = v0; *(f32x4*)(xp + 4) = v1;
                    ss += (v0[0] * v0[0] + v0[1] * v0[1]) + (v0[2] * v0[2] + v0[3] * v0[3]) + (v1[0] * v1[0] + v1[1] * v1[1]) + (v1[2] * v1[2] + v1[3] * v1[3]); }
                ss += __shfl_xor(ss, 16); ss += __shfl_xor(ss, 32);
                if (fq == 0) slab[(size_t)row * 32 + u.pn * 4 + wc] = ss; }
    }
};

__device__ __forceinline__ float dpp_shr1(float old, float src) { return __builtin_bit_cast(float, __builtin_amdgcn_update_dpp(__builtin_bit_cast(int, old), __builtin_bit_cast(int, src), 0x111, 0xf, 0xf, false)); }
__device__ __forceinline__ float dpp_shr2(float old, float src) { return __builtin_bit_cast(float, __builtin_amdgcn_update_dpp(__builtin_bit_cast(int, old), __builtin_bit_cast(int, src), 0x112, 0xf, 0xf, false)); }
__device__ __forceinline__ float dpp_ror1(float src) { return __builtin_bit_cast(float, __builtin_amdgcn_update_dpp(0, __builtin_bit_cast(int, src), 0x121, 0xf, 0xf, false)); }
__device__ __forceinline__ float dpp_ror2(float src) { return __builtin_bit_cast(float, __builtin_amdgcn_update_dpp(0, __builtin_bit_cast(int, src), 0x122, 0xf, 0xf, false)); }
constexpr int FF = 5632, FF2 = 11264;
struct EpiAct {
    static constexpr bool PERM = true, AFTER_DRAIN = false;
    bf16_t* ACT; const float* slab; const float* cw; const float* cb; float* ubnd;
    __device__ __forceinline__ void operator()(f32x4 (&acc)[2][2][4][2], const Unit& u, int wr, int wc, int fr_, int fq_, PG8_LAS unsigned char* xlds) const {
        int t_ = threadIdx.x; asm volatile("" : "+v"(t_));
        const int fr = t_ & 15, fq = (t_ >> 4) & 3;
        const int row0 = u.pm * BM + wr * 64 + fr, cl = wc * 32 + 8 * fq;
#pragma unroll
        for (int ai = 0; ai < 2; ++ai)
#pragma unroll
            for (int m = 0; m < 4; ++m) { const int rg = row0 + ai * HALF + m * 16;
                const f32x4 pa = *(const f32x4*)(slab + (size_t)rg * 32 + 8 * fq), pb = *(const f32x4*)(slab + (size_t)rg * 32 + 8 * fq + 4);
                float s = ((pa[0] + pa[1]) + (pa[2] + pa[3])) + ((pb[0] + pb[1]) + (pb[2] + pb[3]));
                s += __shfl_xor(s, 16); s += __shfl_xor(s, 32);
                const float rstd = 1.0f / sqrtf(s * (1.0f / DM) + RMS_EPS);
#pragma unroll
                for (int bj = 0; bj < 2; ++bj)
#pragma unroll
                    for (int n = 0; n < 2; ++n) acc[ai][bj][m][n] = acc[ai][bj][m][n] * rstd; }
        if (fr >= 14) {
#pragma unroll
            for (int ai = 0; ai < 2; ++ai)
#pragma unroll
                for (int bj = 0; bj < 2; ++bj)
#pragma unroll
                    for (int n = 0; n < 2; ++n) *(PG8_LAS f32x4*)(xlds + ((((2 * ai + wr) * 2 + (fr - 14)) * 256 + 128 * bj + cl + 4 * n) << 2)) = acc[ai][bj][3][n];
            if (wr == 1) {
#pragma unroll
                for (int bj = 0; bj < 2; ++bj)
#pragma unroll
                    for (int n = 0; n < 2; ++n) *(f32x4*)(ubnd + (size_t)(u.pm * 4 + 2 + (fr - 14)) * FF2 + u.pn * BM + 128 * bj + cl + 4 * n) = acc[1][bj][3][n]; }
        }
        if (wr == 0 && fr < 2) {
#pragma unroll
            for (int bj = 0; bj < 2; ++bj)
#pragma unroll
                for (int n = 0; n < 2; ++n) *(f32x4*)(ubnd + (size_t)(u.pm * 4 + fr) * FF2 + u.pn * BM + 128 * bj + cl + 4 * n) = acc[0][bj][0][n]; }
        asm volatile("s_waitcnt lgkmcnt(0)" ::: "memory"); __builtin_amdgcn_s_barrier(); asm volatile("" ::: "memory");
        const int c0 = u.pn * 128 + cl;
        u32x2 hold[2][4];
#pragma unroll
        for (int n = 0; n < 2; ++n) {
            const f32x4 gw0 = *(const f32x4*)(cw + c0 + 4 * n), gw1 = *(const f32x4*)(cw + FF2 + c0 + 4 * n), gw2 = *(const f32x4*)(cw + 2 * FF2 + c0 + 4 * n), gb = *(const f32x4*)(cb + c0 + 4 * n);
            const f32x4 vw0 = *(const f32x4*)(cw + FF + c0 + 4 * n), vw1 = *(const f32x4*)(cw + FF2 + FF + c0 + 4 * n), vw2 = *(const f32x4*)(cw + 2 * FF2 + FF + c0 + 4 * n), vb = *(const f32x4*)(cb + FF + c0 + 4 * n);
#pragma unroll
            for (int ai = 0; ai < 2; ++ai) {
                const int chunk = 2 * ai + wr;
                f32x4 pg = {0.f, 0.f, 0.f, 0.f}, pv = {0.f, 0.f, 0.f, 0.f};
                if (chunk > 0) { const PG8_LAS unsigned char* bp = xlds + ((((chunk - 1) * 2 + (fr & 1)) * 256 + cl + 4 * n) << 2);
                    pg = *(const PG8_LAS f32x4*)bp; pv = *(const PG8_LAS f32x4*)(bp + 512); }
#pragma unroll
                for (int m = 0; m < 4; ++m) {
                    const f32x4 cg = acc[ai][0][m][n], cv = acc[ai][1][m][n]; float a[4];
#pragma unroll
                    for (int j = 0; j < 4; ++j) {
                        const float g1 = dpp_shr1(dpp_ror1(pg[j]), cg[j]), g2 = dpp_shr2(dpp_ror2(pg[j]), cg[j]);
                        const float v1 = dpp_shr1(dpp_ror1(pv[j]), cv[j]), v2 = dpp_shr2(dpp_ror2(pv[j]), cv[j]);
                        const float G = gw2[j] * cg[j] + (gw1[j] * g1 + (gw0[j] * g2 + gb[j]));
                        const float V = vw2[j] * cv[j] + (vw1[j] * v1 + (vw0[j] * v2 + vb[j]));
                        a[j] = G * __builtin_amdgcn_rcpf(1.0f + __builtin_amdgcn_exp2f(-1.4426950408889634f * G)) * V; }
                    u32x2 w; w.x = cvt_pk_bf16(a[0], a[1]); w.y = cvt_pk_bf16(a[2], a[3]);
                    if (n == 0) hold[ai][m] = w;
                    else { u32x4 o; o.x = hold[ai][m].x; o.y = hold[ai][m].y; o.z = w.x; o.w = w.y;
                        *(u32x4*)(ACT + (size_t)(row0 + ai * HALF + m * 16) * FF + c0) = o; }
                    pg = cg; pv = cv;
                }
            }
        }
    }
};

template <class Epi, class Sched, bool ALIGN_EPI = false, bool SP2 = false>
__device__ __forceinline__ void gemm_phase(PG8_LAS unsigned char* lds, const Gemm g, const Sched& S, const Epi& E, PG8_LAS unsigned char* xlds) {
    const int tid = threadIdx.x, wid = __builtin_amdgcn_readfirstlane(tid >> 6), lane = tid & 63, wr = wid >> 2, wc = wid & 3, fr = lane & 15, fq = lane >> 4;
    const int K = g.K, nt = K / BK;
    unsigned voffA[2], voffB[2];
#pragma unroll
    for (int i = 0; i < 2; ++i) { int R, C; stage_rc(tid * 16 + i * 8192, R, C); const int Rb = Epi::PERM ? ((R & ~31) + perm32(R & 31)) : R;
        voffA[i] = (unsigned)(R * K + C) * 2u; voffB[i] = (unsigned)(Rb * K + C) * 2u; }
    const size_t kstep = (size_t)(BK * 2);
    const size_t hstep = (size_t)HALF * K * 2;
    const size_t tstep = 2 * hstep;
    const unsigned ldsw = (unsigned)wid * 1024u;
    const int aoff = lds_byte(wr * 64 + fr, fq * 8), boff = lds_byte(wc * 32 + fr, fq * 8);
#define PG8_SA(b, h) (((b) * 2 + (h)) * HTB)
#define PG8_SB(b, h) ((4 + (b) * 2 + (h)) * HTB)
#define PG8_STAGE(bufoff, gbase, voff) do { _Pragma("unroll") for (int _i = 0; _i < 2; ++_i) \
        __builtin_amdgcn_global_load_lds((const unsigned*)((const char*)(gbase) + (voff)[_i]), (PG8_LAS unsigned*)(lds + (bufoff) + ldsw + _i * 8192), 16, 0, 0); } while (0)
#define PG8_LDA(dst, b, h) do { _Pragma("unroll") for (int m = 0; m < 4; ++m) _Pragma("unroll") for (int k = 0; k < 2; ++k) dst[m][k] = *(const PG8_LAS bf16x8*)(lds + PG8_SA(b, h) + aoff + m * 2048 + k * 1024); } while (0)
#define PG8_LDB(dst, b, h) do { _Pragma("unroll") for (int n = 0; n < 2; ++n) _Pragma("unroll") for (int k = 0; k < 2; ++k) dst[n][k] = *(const PG8_LAS bf16x8*)(lds + PG8_SB(b, h) + boff + n * 2048 + k * 1024); } while (0)
#define PG8_MMA(ai, bj, At, Bt) do { __builtin_amdgcn_s_setprio(1); _Pragma("unroll") for (int m = 0; m < 4; ++m) _Pragma("unroll") for (int n = 0; n < 2; ++n) _Pragma("unroll") for (int k = 0; k < 2; ++k) \
        acc[ai][bj][m][n] = __builtin_amdgcn_mfma_f32_16x16x32_bf16(Bt[n][k], At[m][k], acc[ai][bj][m][n], 0, 0, 0); __builtin_amdgcn_s_setprio(0); } while (0)
#define PG8_WAIT_V(n) asm volatile("s_waitcnt vmcnt(" #n ")" ::: "memory")
#define PG8_WAIT_L(n) asm volatile("s_waitcnt lgkmcnt(" #n ")" ::: "memory")
#define PG8_BAR __builtin_amdgcn_s_barrier()
#define PG8_SCHED __builtin_amdgcn_sched_barrier(0)
    Unit cur, nxt; int ui = 0;
    if (!S.next(0, cur)) return;
    f32x4 acc[2][2][4][2];
#pragma unroll
    for (int a = 0; a < 2; ++a)
#pragma unroll
        for (int b = 0; b < 2; ++b)
#pragma unroll
            for (int m = 0; m < 4; ++m)
#pragma unroll
                for (int n = 0; n < 2; ++n) acc[a][b][m][n] = (f32x4){0.f, 0.f, 0.f, 0.f};
    bf16x8 At[4][2], B0[2][2], B1[2][2];
    const char* cA = (const char*)g.A + (size_t)cur.pm * tstep; const char* cB = (const char*)g.Bt + (size_t)cur.pn * tstep;
    S.a_ready(cur);
    if constexpr (SP2) {
        PG8_STAGE(PG8_SB(0, 0), cB, voffB); PG8_STAGE(PG8_SB(0, 1), cB + hstep, voffB); PG8_STAGE(PG8_SA(0, 0), cA, voffA); PG8_STAGE(PG8_SA(0, 1), cA + hstep, voffA);
        if (wr == 1) PG8_BAR;
        PG8_WAIT_V(2); PG8_BAR;
        PG8_STAGE(PG8_SB(1, 0), cB + kstep, voffB); PG8_STAGE(PG8_SA(1, 0), cA + kstep, voffA); PG8_STAGE(PG8_SB(1, 1), cB + hstep + kstep, voffB);
        PG8_WAIT_V(6); PG8_BAR;
    } else {
        PG8_STAGE(PG8_SB(0, 0), cB, voffB); PG8_STAGE(PG8_SA(0, 0), cA, voffA); PG8_STAGE(PG8_SB(0, 1), cB + hstep, voffB); PG8_STAGE(PG8_SA(0, 1), cA + hstep, voffA);
        if (wr == 1) PG8_BAR;
        PG8_WAIT_V(4); PG8_BAR;
        PG8_STAGE(PG8_SB(1, 0), cB + kstep, voffB); PG8_STAGE(PG8_SA(1, 0), cA + kstep, voffA); PG8_STAGE(PG8_SB(1, 1), cB + hstep + kstep, voffB);
        PG8_WAIT_V(6); PG8_BAR;
    }
    for (;;) {
        const bool has_next = S.next(ui + 1, nxt);
        const char* nA = has_next ? (const char*)g.A + (size_t)nxt.pm * tstep : cA; const char* nB = has_next ? (const char*)g.Bt + (size_t)nxt.pn * tstep : cB;
        for (int t = 0; t < nt; t += 2) {
            const bool last = (t == nt - 2);
            const char* a1 = cA + (size_t)(t + 1) * kstep;
            const char* a2 = last ? nA : cA + (size_t)(t + 2) * kstep; const char* b2 = last ? nB : cB + (size_t)(t + 2) * kstep;
            const char* a3 = a2 + kstep; const char* b3 = b2 + kstep;
            if (last && has_next) S.a_ready(nxt);
            if constexpr (SP2) {
            PG8_LDB(B0, 0, 0); PG8_LDB(B1, 0, 1); PG8_SCHED; PG8_LDA(At, 0, 0); PG8_STAGE(PG8_SA(1, 1), a1 + hstep, voffA);
            PG8_WAIT_V(8); PG8_WAIT_L(0); PG8_BAR; PG8_MMA(0, 0, At, B0); PG8_MMA(0, 1, At, B1); PG8_BAR; PG8_SCHED;
            PG8_LDA(At, 0, 1); PG8_STAGE(PG8_SB(0, 0), b2, voffB); PG8_STAGE(PG8_SB(0, 1), b2 + hstep, voffB); PG8_STAGE(PG8_SA(0, 0), a2, voffA);
            PG8_WAIT_V(8); PG8_WAIT_L(0); PG8_BAR; PG8_MMA(1, 0, At, B0); PG8_MMA(1, 1, At, B1); PG8_BAR; PG8_SCHED;
            PG8_LDB(B0, 1, 0); PG8_LDB(B1, 1, 1); PG8_SCHED; PG8_LDA(At, 1, 0); PG8_STAGE(PG8_SA(0, 1), a2 + hstep, voffA);
            PG8_WAIT_V(8); PG8_WAIT_L(0); PG8_BAR; PG8_MMA(0, 0, At, B0); PG8_MMA(0, 1, At, B1); PG8_BAR; PG8_SCHED;
            PG8_LDA(At, 1, 1); PG8_STAGE(PG8_SB(1, 0), b3, voffB); PG8_STAGE(PG8_SB(1, 1), b3 + hstep, voffB); PG8_STAGE(PG8_SA(1, 0), a3, voffA);
            PG8_WAIT_V(8); PG8_WAIT_L(0); PG8_BAR; PG8_MMA(1, 0, At, B0); PG8_MMA(1, 1, At, B1); PG8_BAR; PG8_SCHED;
            } else {
            PG8_LDB(B0, 0, 0); PG8_SCHED; PG8_LDA(At, 0, 0); PG8_STAGE(PG8_SA(1, 1), a1 + hstep, voffA);
            PG8_WAIT_L(8); PG8_BAR; PG8_WAIT_L(0); PG8_MMA(0, 0, At, B0); PG8_BAR; PG8_SCHED;
            PG8_LDB(B1, 0, 1); PG8_STAGE(PG8_SB(0, 0), b2, voffB);
            PG8_BAR; PG8_WAIT_L(0); PG8_MMA(0, 1, At, B1); PG8_BAR;
            PG8_LDA(At, 0, 1); PG8_STAGE(PG8_SA(0, 0), a2, voffA);
            PG8_BAR; PG8_WAIT_L(0); PG8_MMA(1, 0, At, B0); PG8_BAR; PG8_SCHED;
            PG8_STAGE(PG8_SB(0, 1), b2 + hstep, voffB);
            PG8_WAIT_V(6); PG8_BAR; PG8_MMA(1, 1, At, B1); PG8_BAR;
            PG8_LDB(B0, 1, 0); PG8_SCHED; PG8_LDA(At, 1, 0); PG8_STAGE(PG8_SA(0, 1), a2 + hstep, voffA);
            PG8_WAIT_L(8); PG8_BAR; PG8_WAIT_L(0); PG8_MMA(0, 0, At, B0); PG8_BAR; PG8_SCHED;
            PG8_LDB(B1, 1, 1); PG8_STAGE(PG8_SB(1, 0), b3, voffB);
            PG8_BAR; PG8_WAIT_L(0); PG8_MMA(0, 1, At, B1); PG8_BAR;
            PG8_LDA(At, 1, 1); PG8_STAGE(PG8_SA(1, 0), a3, voffA);
            PG8_BAR; PG8_WAIT_L(0); PG8_MMA(1, 0, At, B0); PG8_BAR; PG8_SCHED;
            PG8_STAGE(PG8_SB(1, 1), b3 + hstep, voffB);
            PG8_WAIT_V(6); PG8_BAR; PG8_MMA(1, 1, At, B1); PG8_BAR;
            }
        }
        if constexpr (ALIGN_EPI) { if (wr == 0) PG8_BAR; }
        if constexpr (!Epi::AFTER_DRAIN) { E(acc, cur, wr, wc, fr, fq, xlds); S.done(cur); }
        if (!has_next) break;
#pragma unroll
        for (int a = 0; a < 2; ++a)
#pragma unroll
            for (int b = 0; b < 2; ++b)
#pragma unroll
                for (int m = 0; m < 4; ++m)
#pragma unroll
                    for (int n = 0; n < 2; ++n) acc[a][b][m][n] = (f32x4){0.f, 0.f, 0.f, 0.f};
        cur = nxt; cA = nA; cB = nB; ++ui;
        if constexpr (ALIGN_EPI) { if (wr == 1) PG8_BAR; }
    }
    PG8_WAIT_V(0);
    if constexpr (!ALIGN_EPI) { if (wr == 0) PG8_BAR; }
    PG8_BAR;

#undef PG8_SA
#undef PG8_SB
#undef PG8_STAGE
#undef PG8_LDA
#undef PG8_LDB
#undef PG8_MMA
#undef PG8_WAIT_V
#undef PG8_WAIT_L
#undef PG8_BAR
#undef PG8_SCHED
}
}

#define GAS __attribute__((address_space(1)))
#define LAS __attribute__((address_space(3)))
typedef unsigned short bf16;
typedef float f32x4 __attribute__((ext_vector_type(4)));
typedef short bf16x8 __attribute__((ext_vector_type(8)));
typedef unsigned u32x4 __attribute__((ext_vector_type(4)));
typedef unsigned u32x2 __attribute__((ext_vector_type(2)));

constexpr int NWAVES = 8;
constexpr int SEQ = 16384, DMODEL = 2048, NMEM = 256, DIN = 3584, DCONV = 768, DPOOL = 768, DXATT = 512, DFF = 5632, DFF2 = 11264;
constexpr int PGD = 192;
constexpr float EPS = 1e-6f;
constexpr int LDS_BYTES = 147456;
#ifndef MK_PER_PHASE
#define MK_PER_PHASE 0
#endif
constexpr int NPHASE = 8;
#ifndef PHM
#define PHM 255
#endif
#ifndef PROBE_SYNC
#define PROBE_SYNC 0
#endif
#ifndef PROBE_GEMM
#define PROBE_GEMM 0
#endif
#ifndef PROBE_N
#define PROBE_N 2048
#endif
#ifndef REPM
#define REPM 0
#endif

constexpr size_t MiB = 1u << 20;
constexpr size_t WS_KB = 1 * MiB;
constexpr size_t WS_VT = 1 * MiB + 256 * 1024;
constexpr size_t WS_POOLWT = 1 * MiB + 512 * 1024;
constexpr size_t WS_MB = 2 * MiB;
constexpr size_t WS_WKVT = 3 * MiB;
constexpr size_t WS_SLAB1 = 8 * MiB;
constexpr size_t WS_SLAB2 = 10 * MiB;
constexpr size_t WS_WUPT = 12 * MiB;
constexpr size_t WS_WDOWNT = 56 * MiB;
constexpr size_t WS_UBND = 80 * MiB;
constexpr size_t WS_X1B = 96 * MiB;
constexpr size_t WS_ACT = 160 * MiB;
constexpr size_t WS_H = 160 * MiB;
constexpr size_t WS_Z = 224 * MiB;
constexpr size_t WS_MIX = 336 * MiB;
constexpr size_t WS_WINT = 400 * MiB;
constexpr size_t WS_WOUTT = 414 * MiB;
constexpr size_t WS_END = 422 * MiB;

__device__ __forceinline__ unsigned f2bf(float f) { unsigned u = __builtin_bit_cast(unsigned, f); return (u + 0x7fffu + ((u >> 16) & 1u)) >> 16; }
__device__ __forceinline__ unsigned pk2(float lo, float hi) { return f2bf(lo) | (f2bf(hi) << 16); }
__device__ __forceinline__ float bflo(unsigned w) { return __builtin_bit_cast(float, w << 16); }
__device__ __forceinline__ float bfhi(unsigned w) { return __builtin_bit_cast(float, w & 0xffff0000u); }
__device__ __forceinline__ void unpack8(const u32x4 w, float (&f)[8]) { f[0] = bflo(w.x); f[1] = bfhi(w.x); f[2] = bflo(w.y); f[3] = bfhi(w.y); f[4] = bflo(w.z); f[5] = bfhi(w.z); f[6] = bflo(w.w); f[7] = bfhi(w.w); }
__device__ __forceinline__ u32x4 pack8(const float (&f)[8]) { u32x4 w; w.x = pk2(f[0], f[1]); w.y = pk2(f[2], f[3]); w.z = pk2(f[4], f[5]); w.w = pk2(f[6], f[7]); return w; }
__device__ __forceinline__ float wave_sum(float v) {
#pragma unroll
    for (int o = 1; o < 64; o <<= 1) v += __shfl_xor(v, o);
    return v;
}
#define LDS_WAIT() asm volatile("s_waitcnt lgkmcnt(0)" ::: "memory")

typedef GAS unsigned gu32;
constexpr size_t WS_CTL = 0, CTL_ZERO_BYTES = 64 * 1024;
constexpr int MISC_OFF = 131072 + 320;
constexpr int XLDS_OFF = 131072 + 1024;
#define XB_TMO      128
#define XB_XCNT(j)  (256  + 64 * (j))
#define XB_XSUB(j)  (1280 + 64 * (j))
#define XB_XGEN(j)  (2304 + 64 * (j))
#define XB_TOP      3328
#define XB_TOPGEN   3392
#define XCD_BAR_WORDS 3456
#define XB_SPIN_CAP (1u << 18)

__device__ __forceinline__ unsigned xb_ld(unsigned* p)              { return __hip_atomic_load(p, __ATOMIC_RELAXED, __HIP_MEMORY_SCOPE_AGENT); }
__device__ __forceinline__ unsigned xb_add(unsigned* p, unsigned v) { return __hip_atomic_fetch_add(p, v, __ATOMIC_RELAXED, __HIP_MEMORY_SCOPE_AGENT); }
__device__ __forceinline__ unsigned xb_xcc_id() { return (unsigned)__builtin_amdgcn_s_getreg((3 << 11) | 20) & 0xFu; }
#define XB_SPIN(cond, bar) do { unsigned _sp = 0; while (cond) { __builtin_amdgcn_s_sleep(1); \
    if ((++_sp & 255u) == 0u) { if (xb_ld(&(bar)[XB_TMO])) break; if (_sp > XB_SPIN_CAP) { atomicAdd(&(bar)[XB_TMO], 1u); break; } } } } while (0)

struct XcdBarrier {
    unsigned* bar; unsigned x;
    volatile LAS unsigned* st;
};

__device__ __forceinline__ XcdBarrier xcd_barrier_post(unsigned* bar, volatile LAS unsigned* st) {
    XcdBarrier b; b.bar = bar; b.x = xb_xcc_id(); b.st = st;
    if (threadIdx.x == 0) (void)xb_add(&bar[XB_XCNT(b.x)], 1u);
    return b;
}
__device__ __forceinline__ void xcd_barrier_complete(unsigned* bar, unsigned x, unsigned& nloc, unsigned& nx) {
    const unsigned G = gridDim.x * gridDim.y * gridDim.z;
    unsigned sum, cnt, mine, sp = 0u;
    for (;;) {
        sum = 0u; cnt = 0u; mine = 0u;
#pragma unroll
        for (unsigned j = 0; j < 16; ++j) { const unsigned c = xb_ld(&bar[XB_XCNT(j)]); sum += c; cnt += (c > 0u) ? 1u : 0u; mine = (j == x) ? c : mine; }
        if (sum == G) break;
        __builtin_amdgcn_s_sleep(1);
        if ((++sp & 255u) == 0u) { if (xb_ld(&bar[XB_TMO])) break; if (sp > XB_SPIN_CAP) { atomicAdd(&bar[XB_TMO], 1u); break; } }
    }
    nloc = mine > 0u ? mine : 1u; nx = cnt > 0u ? cnt : 1u;
}

__device__ __forceinline__ void xcd_barrier(const XcdBarrier& b) {
    asm volatile("s_waitcnt vmcnt(0)" ::: "memory");
    __syncthreads();
    if (threadIdx.x == 0) {
        unsigned* bar = b.bar;
        __builtin_amdgcn_s_waitcnt(0);
        unsigned nloc = b.st[0], nx = b.st[1];
        if (nloc == 0u) { xcd_barrier_complete(bar, b.x, nloc, nx); b.st[0] = nloc; b.st[1] = nx; }
        const unsigned old = xb_add(&bar[XB_XSUB(b.x)], 1u);
        const unsigned gen = old / nloc;
        if (old + 1u == (gen + 1u) * nloc) {
            __builtin_amdgcn_fence(__ATOMIC_RELEASE, "agent");
            asm volatile("s_waitcnt vmcnt(0)" ::: "memory");
            const unsigned og = xb_add(&bar[XB_TOP], 1u);
            const unsigned tg = og / nx;
            if (og + 1u == (tg + 1u) * nx) xb_add(&bar[XB_TOPGEN], 1u);
            else XB_SPIN(xb_ld(&bar[XB_TOPGEN]) == tg, bar);
            __builtin_amdgcn_fence(__ATOMIC_ACQUIRE, "agent");
            xb_add(&bar[XB_XGEN(b.x)], 1u);
            asm volatile("s_waitcnt vmcnt(0)" ::: "memory");
        } else {
            XB_SPIN(xb_ld(&bar[XB_XGEN(b.x)]) == gen, bar);
            __builtin_amdgcn_fence(__ATOMIC_ACQUIRE, "agent");
            asm volatile("s_waitcnt vmcnt(0)" ::: "memory");
        }
    }
    __syncthreads();
}


template <bool UPMAP> __device__ __forceinline__ void p0_transpose_item(const float* W, int K, int N, bf16* WT, const float* ks, LAS float* scr, int item, int lane) {
    const int nblk = N / 64, kb = item / nblk, nb = item % nblk, k0 = 64 * kb, n0 = 64 * nb;
    const int r0 = !UPMAP ? n0 : (n0 < DFF ? 256 * (n0 / 128) + (n0 % 128) : 256 * ((n0 - DFF) / 128) + 128 + ((n0 - DFF) % 128));
    f32x4 v[16];
    const float* src = W + (size_t)(k0 + (lane >> 4)) * N + n0 + 4 * (lane & 15);
#pragma unroll
    for (int i = 0; i < 16; ++i) v[i] = *(const f32x4*)(src + (size_t)(4 * i) * N);
#pragma unroll
    for (int i = 0; i < 16; ++i) { f32x4 t = v[i]; if (ks) t = t * ks[k0 + 4 * i + (lane >> 4)];
        *(LAS f32x4*)(scr + (4 * i + (lane >> 4)) * 64 + (((lane & 15) ^ ((i >> 1) & 7)) << 2)) = t; }
    LDS_WAIT(); asm volatile("" ::: "memory");
    const int c = lane & 7;
#pragma unroll
    for (int j = 0; j < 8; ++j) { const int nn = (lane >> 3) + 8 * j; const LAS float* sp = scr + (8 * c) * 64 + ((((nn >> 2) ^ c) & 15) << 2) + (nn & 3);
        u32x4 o; o.x = pk2(sp[0 * 64], sp[1 * 64]); o.y = pk2(sp[2 * 64], sp[3 * 64]); o.z = pk2(sp[4 * 64], sp[5 * 64]); o.w = pk2(sp[6 * 64], sp[7 * 64]);
        *(u32x4*)(WT + (size_t)(r0 + nn) * K + k0 + 8 * c) = o; }
    LDS_WAIT(); asm volatile("" ::: "memory");
}
__device__ __forceinline__ void rms_rows2_to_bf16(const float* xa, const float* xb, const float* g, bf16* oa, bf16* ob, int lane) {
    const f32x4* pa = (const f32x4*)xa + lane; const f32x4* pb = (const f32x4*)xb + lane; const f32x4* gr = (const f32x4*)g + lane;
    f32x4 va[8], vb[8]; float sa = 0.f, sb = 0.f;
#pragma unroll
    for (int j = 0; j < 8; ++j) { va[j] = pa[64 * j]; vb[j] = pb[64 * j]; }
#pragma unroll
    for (int j = 0; j < 8; ++j) { sa += (va[j].x * va[j].x + va[j].y * va[j].y) + (va[j].z * va[j].z + va[j].w * va[j].w); sb += (vb[j].x * vb[j].x + vb[j].y * vb[j].y) + (vb[j].z * vb[j].z + vb[j].w * vb[j].w); }
    const float ra = 1.0f / sqrtf(wave_sum(sa) * (1.0f / DMODEL) + EPS), rb = 1.0f / sqrtf(wave_sum(sb) * (1.0f / DMODEL) + EPS);
    u32x2* qa = (u32x2*)oa + lane; u32x2* qb = (u32x2*)ob + lane;
#pragma unroll
    for (int j = 0; j < 8; ++j) { const f32x4 gg = gr[64 * j]; u32x2 w;
        w.x = pk2(va[j].x * ra * gg.x, va[j].y * ra * gg.y); w.y = pk2(va[j].z * ra * gg.z, va[j].w * ra * gg.w); qa[64 * j] = w;
        w.x = pk2(vb[j].x * rb * gg.x, vb[j].y * rb * gg.y); w.y = pk2(vb[j].z * rb * gg.z, vb[j].w * rb * gg.w); qb[64 * j] = w; }
}

struct Ptrs {
    const float *x, *mem, *g_mix, *g_mem, *w_in, *conv_w, *pool_w, *pool_scale, *w_kv, *w_out, *g_ffn, *w_up, *ffn_conv_w, *ffn_conv_b, *w_down, *g_final;
    float* out; unsigned char* ws;
};

__device__ __forceinline__ void p0_prologue(const Ptrs& P, LAS unsigned char* lds, int gw, int NGW, int wave, int lane) {
    LAS float* scr = (LAS float*)(lds + wave * 16384);
    unsigned char* ws = P.ws;
    constexpr int I_IN = (DMODEL / 64) * (DIN / 64), I_OUT = (DMODEL / 64) * (DMODEL / 64), I_UP = (DMODEL / 64) * (DFF2 / 64), I_DN = (DFF / 64) * (DMODEL / 64),
                  I_KV = (DMODEL / 64) * (1024 / 64), I_PW = (PGD / 64) * (PGD / 64);
    constexpr int NITEMS = I_IN + I_OUT + I_UP + I_DN + I_KV + 4 * I_PW;
    for (int it = gw; it < NITEMS; it += NGW) {
        int r = it;
        if (r < I_IN) { p0_transpose_item<false>(P.w_in, DMODEL, DIN, (bf16*)(ws + WS_WINT), nullptr, scr, r, lane); continue; } r -= I_IN;
        if (r < I_OUT) { p0_transpose_item<false>(P.w_out, DMODEL, DMODEL, (bf16*)(ws + WS_WOUTT), nullptr, scr, r, lane); continue; } r -= I_OUT;
        if (r < I_UP) { p0_transpose_item<true>(P.w_up, DMODEL, DFF2, (bf16*)(ws + WS_WUPT), P.g_ffn, scr, r, lane); continue; } r -= I_UP;
        if (r < I_DN) { p0_transpose_item<false>(P.w_down, DFF, DMODEL, (bf16*)(ws + WS_WDOWNT), nullptr, scr, r, lane); continue; } r -= I_DN;
        if (r < I_KV) { p0_transpose_item<false>(P.w_kv, DMODEL, 1024, (bf16*)(ws + WS_WKVT), nullptr, scr, r, lane); continue; } r -= I_KV;
        const int g = r / I_PW; r -= g * I_PW;
        p0_transpose_item<false>(P.pool_w + (size_t)g * PGD * PGD, PGD, PGD, (bf16*)(ws + WS_POOLWT) + (size_t)g * PGD * PGD, nullptr, scr, r, lane);
    }
    for (int m = 2 * gw; m < SEQ; m += 2 * NGW) rms_rows2_to_bf16(P.x + (size_t)m * DMODEL, P.x + (size_t)(m + 1) * DMODEL, P.g_mix, (bf16*)(ws + WS_H) + (size_t)m * DMODEL, (bf16*)(ws + WS_H) + (size_t)(m + 1) * DMODEL, lane);
    for (int m = 2 * gw; m < NMEM; m += 2 * NGW) rms_rows2_to_bf16(P.mem + (size_t)m * DMODEL, P.mem + (size_t)(m + 1) * DMODEL, P.g_mem, (bf16*)(ws + WS_MB) + (size_t)m * DMODEL, (bf16*)(ws + WS_MB) + (size_t)(m + 1) * DMODEL, lane);
}

__device__ __forceinline__ void kv_tile(const Ptrs& P, int tt, int lane) {
    const bf16* mB = (const bf16*)(P.ws + WS_MB); const bf16* wT = (const bf16*)(P.ws + WS_WKVT);
    const int rb = tt >> 6, cb = tt & 63, fr = lane & 15, fq = lane >> 4;
    const bf16* ap = mB + (size_t)(16 * rb + fr) * DMODEL + 8 * fq; const bf16* wp = wT + (size_t)(16 * cb + fr) * DMODEL + 8 * fq;
    f32x4 acc = {0.f, 0.f, 0.f, 0.f};
    if (cb < 32) {
#pragma unroll 8
        for (int ks = 0; ks < 64; ++ks) { const bf16x8 a = *(const bf16x8*)(ap + 32 * ks), w = *(const bf16x8*)(wp + 32 * ks); acc = __builtin_amdgcn_mfma_f32_16x16x32_bf16(w, a, acc, 0, 0, 0); }
        u32x2 o; o.x = pk2(acc[0], acc[1]); o.y = pk2(acc[2], acc[3]);
        *(u32x2*)((bf16*)(P.ws + WS_KB) + (size_t)(16 * rb + fr) * 512 + 16 * cb + 4 * fq) = o;
    } else {
#pragma unroll 8
        for (int ks = 0; ks < 64; ++ks) { const bf16x8 a = *(const bf16x8*)(ap + 32 * ks), w = *(const bf16x8*)(wp + 32 * ks); acc = __builtin_amdgcn_mfma_f32_16x16x32_bf16(a, w, acc, 0, 0, 0); }
        u32x2 o; o.x = pk2(acc[0], acc[1]); o.y = pk2(acc[2], acc[3]);
        *(u32x2*)((bf16*)(P.ws + WS_VT) + (size_t)(16 * cb - 512 + fr) * 256 + 32 * (rb >> 1) + 8 * fq + 4 * (rb & 1)) = o;
    }
}

__device__ __forceinline__ void mix_conv_task(const Ptrs& P, int blk, int lane) {
    const bf16* z = (const bf16*)(P.ws + WS_Z); bf16* mix = (bf16*)(P.ws + WS_MIX);
    const int t0 = blk * 16;
    for (int cg = lane; cg < DCONV / 8; cg += 64) {
        const int c = cg * 8;
        float w0[8], w1[8], w2[8], p1[8], p2[8];
#pragma unroll
        for (int e = 0; e < 8; ++e) { w0[e] = P.conv_w[c + e]; w1[e] = P.conv_w[DCONV + c + e]; w2[e] = P.conv_w[2 * DCONV + c + e]; p1[e] = 0.f; p2[e] = 0.f; }
        for (int r = -2; r < 16; ++r) {
            const int t = t0 + r; float p[8];
            if (t >= 0) { float a[8], b[8]; unpack8(*(const u32x4*)(z + (size_t)t * DIN + DCONV + c), a); unpack8(*(const u32x4*)(z + (size_t)t * DIN + 2 * DCONV + c), b);
#pragma unroll
                for (int e = 0; e < 8; ++e) p[e] = a[e] * b[e]; }
            else {
#pragma unroll
                for (int e = 0; e < 8; ++e) p[e] = 0.f; }
            if (r >= 0) { float g[8], o[8]; unpack8(*(const u32x4*)(z + (size_t)t * DIN + c), g);
#pragma unroll
                for (int e = 0; e < 8; ++e) o[e] = g[e] * (w2[e] * p[e] + w1[e] * p1[e] + w0[e] * p2[e]);
                *(u32x4*)(mix + (size_t)t * DMODEL + c) = pack8(o); }
#pragma unroll
            for (int e = 0; e < 8; ++e) { p2[e] = p1[e]; p1[e] = p[e]; }
        }
    }
}
__device__ __forceinline__ void mix_pool_task(const Ptrs& P, int g, int blk, int lane) {
    const bf16* z = (const bf16*)(P.ws + WS_Z); bf16* mix = (bf16*)(P.ws + WS_MIX); const bf16* wt = (const bf16*)(P.ws + WS_POOLWT) + (size_t)g * PGD * PGD;
    const int fr = lane & 15, fq = lane >> 4, t = blk * 16 + fr, k = 2 << g;
    const int cnt = (t + 1 < k) ? t + 1 : k; const float inv = 1.0f / (float)cnt;
    f32x4 acc[12];
#pragma unroll
    for (int n = 0; n < 12; ++n) acc[n] = (f32x4){0.f, 0.f, 0.f, 0.f};
    for (int ks = 0; ks < 6; ++ks) {
        const int c = 32 * ks + 8 * fq; const bf16* zc = z + 3 * DCONV + PGD * g + c;
        float sum[8], self[8];
        unpack8(*(const u32x4*)(zc + (size_t)t * DIN), self);
#pragma unroll
        for (int e = 0; e < 8; ++e) sum[e] = self[e];
        for (int j = 1; j < k; ++j) { const int tt = t - j; const bool ok = tt >= 0; float v[8]; unpack8(*(const u32x4*)(zc + (size_t)(ok ? tt : 0) * DIN), v);
#pragma unroll
            for (int e = 0; e < 8; ++e) sum[e] += ok ? v[e] : 0.f; }
        float pl[8];
#pragma unroll
        for (int e = 0; e < 8; ++e) pl[e] = sum[e] * inv - self[e];
        const bf16x8 pf = __builtin_bit_cast(bf16x8, pack8(pl));
#pragma unroll
        for (int n = 0; n < 12; ++n) { const bf16x8 wf = *(const bf16x8*)(wt + (size_t)(16 * n + fr) * PGD + c); acc[n] = __builtin_amdgcn_mfma_f32_16x16x32_bf16(wf, pf, acc[n], 0, 0, 0); }
    }
#pragma unroll
    for (int n = 0; n < 12; ++n) { const int d = 16 * n + 4 * fq; const f32x4 sc = *(const f32x4*)(P.pool_scale + PGD * g + d);
        u32x2 o; o.x = pk2(acc[n][0] * sc[0], acc[n][1] * sc[1]); o.y = pk2(acc[n][2] * sc[2], acc[n][3] * sc[3]);
        *(u32x2*)(mix + (size_t)t * DMODEL + DCONV + PGD * g + d) = o; }
}
__device__ __forceinline__ void mix_attn_task(const Ptrs& P, int h, int blk, int lane) {
    const bf16* z = (const bf16*)(P.ws + WS_Z); bf16* mix = (bf16*)(P.ws + WS_MIX); const bf16* Kb = (const bf16*)(P.ws + WS_KB); const bf16* Vt = (const bf16*)(P.ws + WS_VT);
    const int fr = lane & 15, fq = lane >> 4, t = blk * 16 + fr;
    bf16x8 qf[4];
#pragma unroll
    for (int ks = 0; ks < 4; ++ks) qf[ks] = *(const bf16x8*)(z + (size_t)t * DIN + 3 * DCONV + DPOOL + 128 * h + 32 * ks + 8 * fq);
    f32x4 s[16];
#pragma unroll
    for (int kb = 0; kb < 16; ++kb) { s[kb] = (f32x4){0.f, 0.f, 0.f, 0.f};
#pragma unroll
        for (int ks = 0; ks < 4; ++ks) { const bf16x8 kf = *(const bf16x8*)(Kb + (size_t)(16 * kb + fr) * 512 + 128 * h + 32 * ks + 8 * fq); s[kb] = __builtin_amdgcn_mfma_f32_16x16x32_bf16(kf, qf[ks], s[kb], 0, 0, 0); } }
    float mx = -3.0e38f;
#pragma unroll
    for (int kb = 0; kb < 16; ++kb) mx = fmaxf(fmaxf(fmaxf(s[kb][0], s[kb][1]), fmaxf(s[kb][2], s[kb][3])), mx);
    mx = fmaxf(mx, __shfl_xor(mx, 16)); mx = fmaxf(mx, __shfl_xor(mx, 32));
    const float c2 = 0.08838834764831845f * 1.4426950408889634f;
    float sum = 0.f;
#pragma unroll
    for (int kb = 0; kb < 16; ++kb)
#pragma unroll
        for (int r = 0; r < 4; ++r) { const float p = __builtin_amdgcn_exp2f((s[kb][r] - mx) * c2); s[kb][r] = p; sum += p; }
    sum += __shfl_xor(sum, 16); sum += __shfl_xor(sum, 32);
    const float inv = 1.0f / sum;
    f32x4 o[8];
#pragma unroll
    for (int db = 0; db < 8; ++db) o[db] = (f32x4){0.f, 0.f, 0.f, 0.f};
#pragma unroll
    for (int ks = 0; ks < 8; ++ks) {
        u32x4 pw; pw.x = pk2(s[2 * ks][0], s[2 * ks][1]); pw.y = pk2(s[2 * ks][2], s[2 * ks][3]); pw.z = pk2(s[2 * ks + 1][0], s[2 * ks + 1][1]); pw.w = pk2(s[2 * ks + 1][2], s[2 * ks + 1][3]);
        const bf16x8 pf = __builtin_bit_cast(bf16x8, pw);
#pragma unroll
        for (int db = 0; db < 8; ++db) { const bf16x8 vf = *(const bf16x8*)(Vt + (size_t)(128 * h + 16 * db + fr) * 256 + 32 * ks + 8 * fq); o[db] = __builtin_amdgcn_mfma_f32_16x16x32_bf16(vf, pf, o[db], 0, 0, 0); }
    }
#pragma unroll
    for (int db = 0; db < 8; ++db) { u32x2 w; w.x = pk2(o[db][0] * inv, o[db][1] * inv); w.y = pk2(o[db][2] * inv, o[db][3] * inv);
        *(u32x2*)(mix + (size_t)t * DMODEL + DCONV + DPOOL + 128 * h + 16 * db + 4 * fq) = w; }
}
__device__ __forceinline__ void p2_mixer(const Ptrs& P, int gw, int NGW, int lane) {
    constexpr int NBLK = SEQ / 16;
    for (int it = gw; it < 9 * NBLK; it += NGW) {
        const int task = it / NBLK, blk = it % NBLK;
        if (task == 0) mix_conv_task(P, blk, lane);
        else if (task < 5) mix_pool_task(P, task - 1, blk, lane);
        else mix_attn_task(P, task - 5, blk, lane);
    }
}

__device__ __forceinline__ void p5_fixup(const Ptrs& P, int gt, int NGT) {
    const float* ub = (const float*)(P.ws + WS_UBND); bf16* act = (bf16*)(P.ws + WS_ACT); const float* cw = P.ffn_conv_w; const float* cb = P.ffn_conv_b;
    for (int i = gt; i < 63 * (DFF / 8); i += NGT) {
        const int pm = 1 + i / (DFF / 8), c = (i % (DFF / 8)) * 8, gi = 256 * (c / 128) + (c % 128);
        const float* p2 = ub + (size_t)((pm - 1) * 4 + 2) * DFF2 + gi; const float* p1 = p2 + DFF2; const float* r0 = ub + (size_t)(pm * 4) * DFF2 + gi; const float* r1 = r0 + DFF2;
        float o0[8], o1[8];
#pragma unroll
        for (int e = 0; e < 8; ++e) {
            const float gw0 = cw[c + e], gw1 = cw[DFF2 + c + e], gw2 = cw[2 * DFF2 + c + e], gb = cb[c + e], vw0 = cw[DFF + c + e], vw1 = cw[DFF2 + DFF + c + e], vw2 = cw[2 * DFF2 + DFF + c + e], vb = cb[DFF + c + e];
            const float G0 = gw2 * r0[e] + (gw1 * p1[e] + (gw0 * p2[e] + gb)), V0 = vw2 * r0[128 + e] + (vw1 * p1[128 + e] + (vw0 * p2[128 + e] + vb));
            const float G1 = gw2 * r1[e] + (gw1 * r0[e] + (gw0 * p1[e] + gb)), V1 = vw2 * r1[128 + e] + (vw1 * r0[128 + e] + (vw0 * p1[128 + e] + vb));
            o0[e] = G0 * __builtin_amdgcn_rcpf(1.0f + __builtin_amdgcn_exp2f(-1.4426950408889634f * G0)) * V0;
            o1[e] = G1 * __builtin_amdgcn_rcpf(1.0f + __builtin_amdgcn_exp2f(-1.4426950408889634f * G1)) * V1; }
        *(u32x4*)(act + (size_t)(256 * pm) * DFF + c) = pack8(o0); *(u32x4*)(act + (size_t)(256 * pm + 1) * DFF + c) = pack8(o1);
    }
}

__device__ __forceinline__ void p7_final(const Ptrs& P, int gw, int NGW, int lane) {
    const float* slab = (const float*)(P.ws + WS_SLAB2);
    for (int m = gw; m < SEQ; m += NGW) {
        const float part = (lane < 32) ? slab[(size_t)m * 32 + lane] : 0.f;
        const float rstd = 1.0f / sqrtf(wave_sum(part) * (1.0f / DMODEL) + EPS);
        f32x4* xr = (f32x4*)(P.out + (size_t)m * DMODEL) + lane; const f32x4* gr = (const f32x4*)P.g_final + lane;
#pragma unroll
        for (int j = 0; j < 8; ++j) { f32x4 v = xr[64 * j]; const f32x4 gg = gr[64 * j]; v = v * rstd * gg; xr[64 * j] = v; }
    }
}

struct Args { const float* in[16]; float* out; unsigned char* ws; int ph_lo, ph_hi; };
__global__ void __launch_bounds__(NWAVES * 64, 2) hybrid_fwd(Args args) {
    extern __shared__ __attribute__((aligned(16))) unsigned char lds_raw[];
    LAS unsigned char* lds = (LAS unsigned char*)lds_raw;
    cg::grid_group grid = cg::this_grid();
    const int tid = threadIdx.x, lane = tid & 63, wave = __builtin_amdgcn_readfirstlane(tid >> 6);
    const int G = gridDim.x, bx = blockIdx.x, vcu = (G % 8 == 0) ? (bx % 8) * (G / 8) + bx / 8 : bx;
    const int gw = vcu * NWAVES + wave, NGW = G * NWAVES;
    volatile LAS unsigned* MISC = (volatile LAS unsigned*)(lds + MISC_OFF);
    if (tid < 32) MISC[tid] = 0u;
    __syncthreads();
    const XcdBarrier bar = xcd_barrier_post((unsigned*)(args.ws + WS_CTL), MISC + 8);
    Ptrs P;
    P.x = args.in[0]; P.mem = args.in[1]; P.g_mix = args.in[2]; P.g_mem = args.in[3]; P.w_in = args.in[4]; P.conv_w = args.in[5]; P.pool_w = args.in[6]; P.pool_scale = args.in[7];
    P.w_kv = args.in[8]; P.w_out = args.in[9]; P.g_ffn = args.in[10]; P.w_up = args.in[11]; P.ffn_conv_w = args.in[12]; P.ffn_conv_b = args.in[13]; P.w_down = args.in[14]; P.g_final = args.in[15];
    P.out = args.out; P.ws = args.ws;
    unsigned char* ws = args.ws;
#if PROBE_SYNC
    for (int i = 0; i < 20; ++i) xcd_barrier(bar);
#endif
    const int lo = args.ph_lo, hi = args.ph_hi;
#define IN(k) (lo <= (k) && (k) < hi)
#define SYNC(k) do { if ((k) + 1 < hi) { if ((k) == 0) grid.sync(); else xcd_barrier(bar); } } while (0)
#define SYNCR(k, b) do { if ((k) + 1 < hi || rp + 1 < NREP(b)) { if ((k) == 0) grid.sync(); else xcd_barrier(bar); } } while (0)
#define NREP(b) ((REPM & (b)) ? 2 : 1)
    if (IN(0) && (PHM & 1)) for (int rp = 0; rp < NREP(1); ++rp) { p0_prologue(P, lds, gw, NGW, wave, lane); SYNCR(0, 1); }
    if (IN(1) && (PHM & 2)) for (int rp = 0; rp < NREP(2); ++rp) {
        pg8::Gemm g{(const bf16*)(ws + WS_H), (const bf16*)(ws + WS_WINT), SEQ, DIN, DMODEL}; pg8::StaticOrder S; S.init(SEQ, DIN, G, bx);
        pg8::EpiZ E{(bf16*)(ws + WS_Z), DIN};
        pg8::gemm_phase<pg8::EpiZ, pg8::StaticOrder, true, true>(lds, g, S, E, lds + XLDS_OFF);
        if (wave < 4) { for (int tt = vcu * 4 + wave; tt < 1024; tt += G * 4) kv_tile(P, tt, lane); }
        SYNCR(1, 2);
    }
    if (IN(2) && (PHM & 4)) for (int rp = 0; rp < NREP(4); ++rp) { p2_mixer(P, gw, NGW, lane); SYNCR(2, 4); }
    if (IN(3) && (PHM & 8)) for (int rp = 0; rp < NREP(8); ++rp) {
        pg8::Gemm g{(const bf16*)(ws + WS_MIX), (const bf16*)(ws + WS_WOUTT), SEQ, DMODEL, DMODEL}; pg8::StaticOrder S; S.init(SEQ, DMODEL, G, bx);
        pg8::EpiResA E{P.x, (bf16*)(ws + WS_X1B), (float*)(ws + WS_SLAB1)};
        pg8::gemm_phase<pg8::EpiResA, pg8::StaticOrder, true, true>(lds, g, S, E, lds + XLDS_OFF);
        SYNCR(3, 8);
    }
#if PROBE_GEMM
    if (IN(3)) {
        pg8::Gemm g{(const bf16*)(ws + WS_X1B), (const bf16*)(ws + WS_WUPT), SEQ, PROBE_N, DMODEL}; pg8::StaticOrder S; S.init(SEQ, PROBE_N, G, bx);
#if PROBE_GEMM == 1
        pg8::EpiZ E{(bf16*)(ws + WS_Z), PROBE_N};
        pg8::gemm_phase<pg8::EpiZ, pg8::StaticOrder, true, true>(lds, g, S, E, lds + XLDS_OFF);
#elif PROBE_GEMM == 2
        pg8::EpiNone E{};
        pg8::gemm_phase<pg8::EpiNone, pg8::StaticOrder, true, true>(lds, g, S, E, lds + XLDS_OFF);
#elif PROBE_GEMM == 3
        pg8::EpiZ E{(bf16*)(ws + WS_Z), PROBE_N};
        pg8::gemm_phase<pg8::EpiZ, pg8::StaticOrder, true, false>(lds, g, S, E, lds + XLDS_OFF);
#elif PROBE_GEMM == 5
        pg8::EpiAct E{(bf16*)(ws + WS_ACT), (const float*)(ws + WS_SLAB1), P.ffn_conv_w, P.ffn_conv_b, (float*)(ws + WS_UBND)};
        pg8::gemm_phase<pg8::EpiAct, pg8::StaticOrder, true, true>(lds, g, S, E, lds + XLDS_OFF);
#elif PROBE_GEMM == 4
        pg8::EpiZ E{(bf16*)(ws + WS_Z), PROBE_N};
        pg8::gemm_phase<pg8::EpiZ, pg8::StaticOrder, false, true>(lds, g, S, E, lds + XLDS_OFF);
#endif
        xcd_barrier(bar);
    }
#endif
    if (IN(4) && (PHM & 16)) for (int rp = 0; rp < NREP(16); ++rp) {
        pg8::Gemm g{(const bf16*)(ws + WS_X1B), (const bf16*)(ws + WS_WUPT), SEQ, DFF2, DMODEL}; pg8::StaticOrder S; S.init(SEQ, DFF2, G, bx);
        pg8::EpiAct E{(bf16*)(ws + WS_ACT), (const float*)(ws + WS_SLAB1), P.ffn_conv_w, P.ffn_conv_b, (float*)(ws + WS_UBND)};
        pg8::gemm_phase<pg8::EpiAct, pg8::StaticOrder, true, true>(lds, g, S, E, lds + XLDS_OFF);
        xcd_barrier(bar);
    }
    if (IN(5) && (PHM & 32)) { p5_fixup(P, vcu * (NWAVES * 64) + tid, G * NWAVES * 64); xcd_barrier(bar); }
    if (IN(6) && (PHM & 64)) {
        pg8::Gemm g{(const bf16*)(ws + WS_ACT), (const bf16*)(ws + WS_WDOWNT), SEQ, DMODEL, DFF}; pg8::StaticOrder S; S.init(SEQ, DMODEL, G, bx);
        pg8::EpiResB E{(const bf16*)(ws + WS_X1B), P.out, (float*)(ws + WS_SLAB2)};
        pg8::gemm_phase<pg8::EpiResB, pg8::StaticOrder, true, true>(lds, g, S, E, lds + XLDS_OFF);
        SYNC(6);
    }
    if (IN(7) && (PHM & 128)) p7_final(P, gw, NGW, lane);
#undef IN
#undef SYNC
}

extern "C" void kernel_launch(void* const* d_in, const int* in_sizes, int n_in, void* d_out, int out_size, void* d_ws, size_t ws_size, hipStream_t stream) {
    static int grid = 0;
    if (grid == 0) {
        if (n_in != 16 || in_sizes[0] != SEQ * DMODEL || out_size != SEQ * DMODEL || ws_size < WS_END) { fprintf(stderr, "kernel_launch: unexpected shapes (n_in %d, in0 %d, out %d, ws %zu)\n", n_in, n_in > 0 ? in_sizes[0] : -1, out_size, ws_size); grid = -1; return; }
        int dev = 0, cus = 0, per_cu = 0;
        if (hipGetDevice(&dev) != hipSuccess || hipDeviceGetAttribute(&cus, hipDeviceAttributeMultiprocessorCount, dev) != hipSuccess) { grid = -1; return; }
        if (hipFuncSetAttribute((const void*)hybrid_fwd, hipFuncAttributeMaxDynamicSharedMemorySize, LDS_BYTES) != hipSuccess) { fprintf(stderr, "kernel_launch: hipFuncSetAttribute failed\n"); grid = -1; return; }
        if (hipOccupancyMaxActiveBlocksPerMultiprocessor(&per_cu, (const void*)hybrid_fwd, NWAVES * 64, LDS_BYTES) != hipSuccess || per_cu < 1) { fprintf(stderr, "kernel_launch: occupancy query says %d blocks per CU\n", per_cu); (void)hipGetLastError(); per_cu = 1; }
        grid = cus;
        if (grid % 8 != 0 || grid < 8) { fprintf(stderr, "kernel_launch: %d CUs\n", grid); }
    }
    if (grid < 0) return;
    if (hipMemsetAsync((char*)d_ws + WS_CTL, 0, CTL_ZERO_BYTES, stream) != hipSuccess) { fprintf(stderr, "kernel_launch: hipMemsetAsync failed\n"); return; }
    Args a{};
    for (int i = 0; i < 16; ++i) a.in[i] = (const float*)d_in[i];
    a.out = (float*)d_out; a.ws = (unsigned char*)d_ws;
#if MK_PER_PHASE
    for (int ph = 0; ph < NPHASE; ++ph) { a.ph_lo = ph; a.ph_hi = ph + 1; hipLaunchKernelGGL(hybrid_fwd, dim3(grid), dim3(NWAVES * 64), LDS_BYTES, stream, a); }
#else
    a.ph_lo = 0; a.ph_hi = NPHASE;
    void* kargs[] = {&a};
    hipError_t e = hipLaunchCooperativeKernel((const void*)hybrid_fwd, dim3(grid), dim3(NWAVES * 64), kargs, LDS_BYTES, stream);
    if (e != hipSuccess) fprintf(stderr, "kernel_launch: cooperative launch failed: %s (grid %d)\n", hipGetErrorString(e), grid);
#endif
}
```

```cpp
#include <hip/hip_runtime.h>
#include <hip/hip_cooperative_groups.h>
#include <cstdio>
#include <cstdint>
namespace cg = cooperative_groups;
namespace pg8 {
#define PG8_LAS __attribute__((address_space(3)))
typedef unsigned short bf16_t;
typedef short bf16x8 __attribute__((ext_vector_type(8)));
typedef float f32x4 __attribute__((ext_vector_type(4)));
typedef unsigned u32x4 __attribute__((ext_vector_type(4)));
constexpr int BM = 256, BK = 64, HALF = 128, HTB = HALF * BK * 2  , STAGE_BYTES = 8 * HTB, NXCD = 8, WGM = 8;

__host__ __device__ __forceinline__ int lds_byte(int r, int c) { const int st = (r >> 4) * 2 + (c >> 5), rr = r & 15, cc = c & 31, ob = rr * 64 + cc * 2; return st * 1024 + (ob ^ (((ob >> 9) & 1) << 5)); }
__host__ __device__ __forceinline__ void stage_rc(int b, int& R, int& C) { const int st = b / 1024, sb = b % 1024, swz = sb ^ (((sb >> 9) & 1) << 5); R = (st >> 1) * 16 + swz / 64; C = (st & 1) * 32 + (swz % 64) / 2; }
__host__ __device__ __forceinline__ int perm32(int rho) { const int n = rho >> 4, i = rho & 15; return 8 * (i >> 2) + 4 * n + (i & 3); }

struct Unit { int pm, pn; };
struct Gemm { const bf16_t* A; const bf16_t* Bt; int M, N, K; };

struct StaticOrder {
    int nM, nN, nwg, G, c;
    __host__ __device__ void init(int M, int N, int G_, int c_) { nM = M / BM; nN = N / BM; nwg = nM * nN; G = G_; c = c_; }
    __host__ __device__ bool next(int i, Unit& u) const {
        const long L = (long)i * G + c; if (L >= nwg) return false;
        int wgid = (int)L; { const int q = nwg / NXCD, r = nwg % NXCD, xcd = wgid % NXCD, off = wgid / NXCD; wgid = (xcd < r ? xcd * (q + 1) : r * (q + 1) + (xcd - r) * q) + off; }
        const int nig = WGM * nN, gid = wgid / nig, fm = gid * WGM, gsz = (nM - fm) < WGM ? (nM - fm) : WGM;
        u.pm = fm + ((wgid % nig) % gsz); u.pn = (wgid % nig) / gsz; return true;
    }
    __device__ __forceinline__ void a_ready(const Unit&) const {}
    __device__ __forceinline__ void done(const Unit&) const {}
};
__device__ __forceinline__ unsigned cvt_pk_bf16(float lo, float hi) { unsigned r; asm volatile("v_cvt_pk_bf16_f32 %0, %1, %2" : "=v"(r) : "v"(lo), "v"(hi)); return r; }
typedef unsigned u32x2 __attribute__((ext_vector_type(2)));
constexpr int DM = 2048;
constexpr float RMS_EPS = 1e-6f;

struct EpiZ {
    static constexpr bool PERM = true, AFTER_DRAIN = false;
    bf16_t* O; int ldc;
    __device__ __forceinline__ void operator()(const f32x4 (&acc)[2][2][4][2], const Unit& u, int wr, int wc, int fr_, int fq_, PG8_LAS unsigned char*) const {
        int t_ = threadIdx.x; asm volatile("" : "+v"(t_));
        const int fr = t_ & 15, fq = (t_ >> 4) & 3;
        const int row0 = u.pm * BM + wr * 64 + fr, col0 = u.pn * BM + wc * 32 + 8 * fq;
#pragma unroll
        for (int ai = 0; ai < 2; ++ai)
#pragma unroll
            for (int m = 0; m < 4; ++m) { bf16_t* rowp = O + (size_t)(row0 + ai * HALF + m * 16) * ldc + col0;
#pragma unroll
                for (int bj = 0; bj < 2; ++bj) { const f32x4 v0 = acc[ai][bj][m][0], v1 = acc[ai][bj][m][1];
                    u32x4 w; w.x = cvt_pk_bf16(v0[0], v0[1]); w.y = cvt_pk_bf16(v0[2], v0[3]); w.z = cvt_pk_bf16(v1[0], v1[1]); w.w = cvt_pk_bf16(v1[2], v1[3]);
                    *(u32x4*)(rowp + bj * HALF) = w; } }
    }
};

struct EpiNone {
    static constexpr bool PERM = true, AFTER_DRAIN = false;
    __device__ __forceinline__ void operator()(const f32x4 (&acc)[2][2][4][2], const Unit& u, int wr, int wc, int fr, int fq, PG8_LAS unsigned char*) const {
#pragma unroll
        for (int ai = 0; ai < 2; ++ai)
#pragma unroll
            for (int bj = 0; bj < 2; ++bj)
#pragma unroll
                for (int m = 0; m < 4; ++m)
#pragma unroll
                    for (int n = 0; n < 2; ++n) asm volatile("" :: "v"(acc[ai][bj][m][n]));
    }
};
struct EpiResA {
    static constexpr bool PERM = true, AFTER_DRAIN = false;
    const float* R; bf16_t* XB; float* slab;
    __device__ __forceinline__ void operator()(const f32x4 (&acc)[2][2][4][2], const Unit& u, int wr, int wc, int fr_, int fq_, PG8_LAS unsigned char*) const {
        int t_ = threadIdx.x; asm volatile("" : "+v"(t_));
        const int fr = t_ & 15, fq = (t_ >> 4) & 3;
        const int row0 = u.pm * BM + wr * 64 + fr, col0 = u.pn * BM + wc * 32 + 8 * fq;
#pragma unroll
        for (int ai = 0; ai < 2; ++ai) {
            f32x4 r[4][2][2];
#pragma unroll
            for (int m = 0; m < 4; ++m)
#pragma unroll
                for (int bj = 0; bj < 2; ++bj) { const float* p = R + (size_t)(row0 + ai * HALF + m * 16) * DM + col0 + bj * HALF; r[m][bj][0] = *(const f32x4*)p; r[m][bj][1] = *(const f32x4*)(p + 4); }
#pragma unroll
            for (int m = 0; m < 4; ++m) { const int row = row0 + ai * HALF + m * 16; float ss = 0.f;
#pragma unroll
                for (int bj = 0; bj < 2; ++bj) { const f32x4 v0 = acc[ai][bj][m][0] + r[m][bj][0], v1 = acc[ai][bj][m][1] + r[m][bj][1];
                    u32x4 w; w.x = cvt_pk_bf16(v0[0], v0[1]); w.y = cvt_pk_bf16(v0[2], v0[3]); w.z = cvt_pk_bf16(v1[0], v1[1]); w.w = cvt_pk_bf16(v1[2], v1[3]);
                    *(u32x4*)(XB + (size_t)row * DM + col0 + bj * HALF) = w;
                    ss += (v0[0] * v0[0] + v0[1] * v0[1]) + (v0[2] * v0[2] + v0[3] * v0[3]) + (v1[0] * v1[0] + v1[1] * v1[1]) + (v1[2] * v1[2] + v1[3] * v1[3]); }
                ss += __shfl_xor(ss, 16); ss += __shfl_xor(ss, 32);
                if (fq == 0) slab[(size_t)row * 32 + u.pn * 4 + wc] = ss; }
            asm volatile("" ::: "memory"); }
    }
};
struct EpiResB {
    static constexpr bool PERM = true, AFTER_DRAIN = false;
    const bf16_t* RB; float* X; float* slab;
    __device__ __forceinline__ void operator()(const f32x4 (&acc)[2][2][4][2], const Unit& u, int wr, int wc, int fr_, int fq_, PG8_LAS unsigned char*) const {
        int t_ = threadIdx.x; asm volatile("" : "+v"(t_));
        const int fr = t_ & 15, fq = (t_ >> 4) & 3;
        const int row0 = u.pm * BM + wr * 64 + fr, col0 = u.pn * BM + wc * 32 + 8 * fq;
        u32x4 r[2][4][2];
#pragma unroll
        for (int ai = 0; ai < 2; ++ai)
#pragma unroll
            for (int m = 0; m < 4; ++m)
#pragma unroll
                for (int bj = 0; bj < 2; ++bj) r[ai][m][bj] = *(const u32x4*)(RB + (size_t)(row0 + ai * HALF + m * 16) * DM + col0 + bj * HALF);
#pragma unroll
        for (int ai = 0; ai < 2; ++ai)
#pragma unroll
            for (int m = 0; m < 4; ++m) { const int row = row0 + ai * HALF + m * 16; float ss = 0.f;
#pragma unroll
                for (int bj = 0; bj < 2; ++bj) { const u32x4 q = r[ai][m][bj];
                    const f32x4 r0 = {__builtin_bit_cast(float, q.x << 16), __builtin_bit_cast(float, q.x & 0xffff0000u), __builtin_bit_cast(float, q.y << 16), __builtin_bit_cast(float, q.y & 0xffff0000u)};
                    const f32x4 r1 = {__builtin_bit_cast(float, q.z << 16), __builtin_bit_cast(float, q.z & 0xffff0000u), __builtin_bit_cast(float, q.w << 16), __builtin_bit_cast(float, q.w & 0xffff0000u)};
                    const f32x4 v0 = acc[ai][bj][m][0] + r0, v1 = acc[ai][bj][m][1] + r1;
                    float* xp = X + (size_t)row * DM + col0 + bj * HALF; *(f32x4*)xp = v0; *(f32x4*)(xp + 4) = v1;
                    ss += (v0[0] * v0[0] + v0[1] * v0[1]) + (v0[2] * v0[2] + v0[3] * v0[3]) + (v1[0] * v1[0] + v1[1] * v1[1]) + (v1[2] * v1[2] + v1[3] * v1[3]); }
                ss += __shfl_xor(ss, 16); ss += __shfl_xor(ss, 32);
                if (fq == 0) slab[(size_t)row * 32 + u.pn * 4 + wc] = ss; }
    }
};

__device__ __forceinline__ float dpp_shr1(float old, float src) { return __builtin_bit_cast(float, __builtin_amdgcn_update_dpp(__builtin_bit_cast(int, old), __builtin_bit_cast(int, src), 0x111, 0xf, 0xf, false)); }
__device__ __forceinline__ float dpp_shr2(float old, float src) { return __builtin_bit_cast(float, __builtin_amdgcn_update_dpp(__builtin_bit_cast(int, old), __builtin_bit_cast(int, src), 0x112, 0xf, 0xf, false)); }
__device__ __forceinline__ float dpp_ror1(float src) { return __builtin_bit_cast(float, __builtin_amdgcn_update_dpp(0, __builtin_bit_cast(int, src), 0x121, 0xf, 0xf, false)); }
__device__ __forceinline__ float dpp_ror2(float src) { return __builtin_bit_cast(float, __builtin_amdgcn_update_dpp(0, __builtin_bit_cast(int, src), 0x122, 0xf, 0xf, false)); }
constexpr int FF = 5632, FF2 = 11264;
struct EpiAct {
    static constexpr bool PERM = true, AFTER_DRAIN = false;
    bf16_t* ACT; const float* slab; const float* cw; const float* cb; float* ubnd;
    __device__ __forceinline__ void operator()(f32x4 (&acc)[2][2][4][2], const Unit& u, int wr, int wc, int fr_, int fq_, PG8_LAS unsigned char* xlds) const {
        int t_ = threadIdx.x; asm volatile("" : "+v"(t_));
        const int fr = t_ & 15, fq = (t_ >> 4) & 3;
        const int row0 = u.pm * BM + wr * 64 + fr, cl = wc * 32 + 8 * fq;
#pragma unroll
        for (int ai = 0; ai < 2; ++ai)
#pragma unroll
            for (int m = 0; m < 4; ++m) { const int rg = row0 + ai * HALF + m * 16;
                const f32x4 pa = *(const f32x4*)(slab + (size_t)rg * 32 + 8 * fq), pb = *(const f32x4*)(slab + (size_t)rg * 32 + 8 * fq + 4);
                float s = ((pa[0] + pa[1]) + (pa[2] + pa[3])) + ((pb[0] + pb[1]) + (pb[2] + pb[3]));
                s += __shfl_xor(s, 16); s += __shfl_xor(s, 32);
                const float rstd = 1.0f / sqrtf(s * (1.0f / DM) + RMS_EPS);
#pragma unroll
                for (int bj = 0; bj < 2; ++bj)
#pragma unroll
                    for (int n = 0; n < 2; ++n) acc[ai][bj][m][n] = acc[ai][bj][m][n] * rstd; }
        if (fr >= 14) {
#pragma unroll
            for (int ai = 0; ai < 2; ++ai)
#pragma unroll
                for (int bj = 0; bj < 2; ++bj)
#pragma unroll
                    for (int n = 0; n < 2; ++n) *(PG8_LAS f32x4*)(xlds + ((((2 * ai + wr) * 2 + (fr - 14)) * 256 + 128 * bj + cl + 4 * n) << 2)) = acc[ai][bj][3][n];
            if (wr == 1) {
#pragma unroll
                for (int bj = 0; bj < 2; ++bj)
#pragma unroll
                    for (int n = 0; n < 2; ++n) *(f32x4*)(ubnd + (size_t)(u.pm * 4 + 2 + (fr - 14)) * FF2 + u.pn * BM + 128 * bj + cl + 4 * n) = acc[1][bj][3][n]; }
        }
        if (wr == 0 && fr < 2) {
#pragma unroll
            for (int bj = 0; bj < 2; ++bj)
#pragma unroll
                for (int n = 0; n < 2; ++n) *(f32x4*)(ubnd + (size_t)(u.pm * 4 + fr) * FF2 + u.pn * BM + 128 * bj + cl + 4 * n) = acc[0][bj][0][n]; }
        asm volatile("s_waitcnt lgkmcnt(0)" ::: "memory"); __builtin_amdgcn_s_barrier(); asm volatile("" ::: "memory");
        const int c0 = u.pn * 128 + cl;
        u32x2 hold[2][4];
#pragma unroll
        for (int n = 0; n < 2; ++n) {
            const f32x4 gw0 = *(const f32x4*)(cw + c0 + 4 * n), gw1 = *(const f32x4*)(cw + FF2 + c0 + 4 * n), gw2 = *(const f32x4*)(cw + 2 * FF2 + c0 + 4 * n), gb = *(const f32x4*)(cb + c0 + 4 * n);
            const f32x4 vw0 = *(const f32x4*)(cw + FF + c0 + 4 * n), vw1 = *(const f32x4*)(cw + FF2 + FF + c0 + 4 * n), vw2 = *(const f32x4*)(cw + 2 * FF2 + FF + c0 + 4 * n), vb = *(const f32x4*)(cb + FF + c0 + 4 * n);
#pragma unroll
            for (int ai = 0; ai < 2; ++ai) {
                const int chunk = 2 * ai + wr;
                f32x4 pg = {0.f, 0.f, 0.f, 0.f}, pv = {0.f, 0.f, 0.f, 0.f};
                if (chunk > 0) { const PG8_LAS unsigned char* bp = xlds + ((((chunk - 1) * 2 + (fr & 1)) * 256 + cl + 4 * n) << 2);
                    pg = *(const PG8_LAS f32x4*)bp; pv = *(const PG8_LAS f32x4*)(bp + 512); }
#pragma unroll
                for (int m = 0; m < 4; ++m) {
                    const f32x4 cg = acc[ai][0][m][n], cv = acc[ai][1][m][n]; float a[4];
#pragma unroll
                    for (int j = 0; j < 4; ++j) {
                        const float g1 = dpp_shr1(dpp_ror1(pg[j]), cg[j]), g2 = dpp_shr2(dpp_ror2(pg[j]), cg[j]);
                        const float v1 = dpp_shr1(dpp_ror1(pv[j]), cv[j]), v2 = dpp_shr2(dpp_ror2(pv[j]), cv[j]);
                        const float G = gw2[j] * cg[j] + (gw1[j] * g1 + (gw0[j] * g2 + gb[j]));
                        const float V = vw2[j] * cv[j] + (vw1[j] * v1 + (vw0[j] * v2 + vb[j]));
                        a[j] = G * __builtin_amdgcn_rcpf(1.0f + __builtin_amdgcn_exp2f(-1.4426950408889634f * G)) * V; }
                    u32x2 w; w.x = cvt_pk_bf16(a[0], a[1]); w.y = cvt_pk_bf16(a[2], a[3]);
                    if (n == 0) hold[ai][m] = w;
                    else { u32x4 o; o.x = hold[ai][m].x; o.y = hold[ai][m].y; o.z = w.x; o.w = w.y;
                        *(u32x4*)(ACT + (size_t)(row0 + ai * HALF + m * 16) * FF + c0) = o; }
                    pg = cg; pv = cv;
                }
            }
        }
    }
};

template <class Epi, class Sched, bool ALIGN_EPI = false, bool SP2 = false>
__device__ __forceinline__ void gemm_phase(PG8_LAS unsigned char* lds, const Gemm g, const Sched& S, const Epi& E, PG8_LAS unsigned char* xlds) {
    const int tid = threadIdx.x, wid = __builtin_amdgcn_readfirstlane(tid >> 6), lane = tid & 63, wr = wid >> 2, wc = wid & 3, fr = lane & 15, fq = lane >> 4;
    const int K = g.K, nt = K / BK;
    unsigned voffA[2], voffB[2];
#pragma unroll
    for (int i = 0; i < 2; ++i) { int R, C; stage_rc(tid * 16 + i * 8192, R, C); const int Rb = Epi::PERM ? ((R & ~31) + perm32(R & 31)) : R;
        voffA[i] = (unsigned)(R * K + C) * 2u; voffB[i] = (unsigned)(Rb * K + C) * 2u; }
    const size_t kstep = (size_t)(BK * 2);
    const size_t hstep = (size_t)HALF * K * 2;
    const size_t tstep = 2 * hstep;
    const unsigned ldsw = (unsigned)wid * 1024u;
    const int aoff = lds_byte(wr * 64 + fr, fq * 8), boff = lds_byte(wc * 32 + fr, fq * 8);
#define PG8_SA(b, h) (((b) * 2 + (h)) * HTB)
#define PG8_SB(b, h) ((4 + (b) * 2 + (h)) * HTB)
#define PG8_STAGE(bufoff, gbase, voff) do { _Pragma("unroll") for (int _i = 0; _i < 2; ++_i) \
        __builtin_amdgcn_global_load_lds((const unsigned*)((const char*)(gbase) + (voff)[_i]), (PG8_LAS unsigned*)(lds + (bufoff) + ldsw + _i * 8192), 16, 0, 0); } while (0)
#define PG8_LDA(dst, b, h) do { _Pragma("unroll") for (int m = 0; m < 4; ++m) _Pragma("unroll") for (int k = 0; k < 2; ++k) dst[m][k] = *(const PG8_LAS bf16x8*)(lds + PG8_SA(b, h) + aoff + m * 2048 + k * 1024); } while (0)
#define PG8_LDB(dst, b, h) do { _Pragma("unroll") for (int n = 0; n < 2; ++n) _Pragma("unroll") for (int k = 0; k < 2; ++k) dst[n][k] = *(const PG8_LAS bf16x8*)(lds + PG8_SB(b, h) + boff + n * 2048 + k * 1024); } while (0)
#define PG8_MMA(ai, bj, At, Bt) do { __builtin_amdgcn_s_setprio(1); _Pragma("unroll") for (int m = 0; m < 4; ++m) _Pragma("unroll") for (int n = 0; n < 2; ++n) _Pragma("unroll") for (int k = 0; k < 2; ++k) \
        acc[ai][bj][m][n] = __builtin_amdgcn_mfma_f32_16x16x32_bf16(Bt[n][k], At[m][k], acc[ai][bj][m][n], 0, 0, 0); __builtin_amdgcn_s_setprio(0); } while (0)
#define PG8_WAIT_V(n) asm volatile("s_waitcnt vmcnt(" #n ")" ::: "memory")
#define PG8_WAIT_L(n) asm volatile("s_waitcnt lgkmcnt(" #n ")" ::: "memory")
#define PG8_BAR __builtin_amdgcn_s_barrier()
#define PG8_SCHED __builtin_amdgcn_sched_barrier(0)
    Unit cur, nxt; int ui = 0;
    if (!S.next(0, cur)) return;
    f32x4 acc[2][2][4][2];
#pragma unroll
    for (int a = 0; a < 2; ++a)
#pragma unroll
        for (int b = 0; b < 2; ++b)
#pragma unroll
            for (int m = 0; m < 4; ++m)
#pragma unroll
                for (int n = 0; n < 2; ++n) acc[a][b][m][n] = (f32x4){0.f, 0.f, 0.f, 0.f};
    bf16x8 At[4][2], B0[2][2], B1[2][2];
    const char* cA = (const char*)g.A + (size_t)cur.pm * tstep; const char* cB = (const char*)g.Bt + (size_t)cur.pn * tstep;
    S.a_ready(cur);
    if constexpr (SP2) {
        PG8_STAGE(PG8_SB(0, 0), cB, voffB); PG8_STAGE(PG8_SB(0, 1), cB + hstep, voffB); PG8_STAGE(PG8_SA(0, 0), cA, voffA); PG8_STAGE(PG8_SA(0, 1), cA + hstep, voffA);
        if (wr == 1) PG8_BAR;
        PG8_WAIT_V(2); PG8_BAR;
        PG8_STAGE(PG8_SB(1, 0), cB + kstep, voffB); PG8_STAGE(PG8_SA(1, 0), cA + kstep, voffA); PG8_STAGE(PG8_SB(1, 1), cB + hstep + kstep, voffB);
        PG8_WAIT_V(6); PG8_BAR;
    } else {
        PG8_STAGE(PG8_SB(0, 0), cB, voffB); PG8_STAGE(PG8_SA(0, 0), cA, voffA); PG8_STAGE(PG8_SB(0, 1), cB + hstep, voffB); PG8_STAGE(PG8_SA(0, 1), cA + hstep, voffA);
        if (wr == 1) PG8_BAR;
        PG8_WAIT_V(4); PG8_BAR;
        PG8_STAGE(PG8_SB(1, 0), cB + kstep, voffB); PG8_STAGE(PG8_SA(1, 0), cA + kstep, voffA); PG8_STAGE(PG8_SB(1, 1), cB + hstep + kstep, voffB);
        PG8_WAIT_V(6); PG8_BAR;
    }
    for (;;) {
        const bool has_next = S.next(ui + 1, nxt);
        const char* nA = has_next ? (const char*)g.A + (size_t)nxt.pm * tstep : cA; const char* nB = has_next ? (const char*)g.Bt + (size_t)nxt.pn * tstep : cB;
        for (int t = 0; t < nt; t += 2) {
            const bool last = (t == nt - 2);
            const char* a1 = cA + (size_t)(t + 1) * kstep;
            const char* a2 = last ? nA : cA + (size_t)(t + 2) * kstep; const char* b2 = last ? nB : cB + (size_t)(t + 2) * kstep;
            const char* a3 = a2 + kstep; const char* b3 = b2 + kstep;
            if (last && has_next) S.a_ready(nxt);
            if constexpr (SP2) {
            PG8_LDB(B0, 0, 0); PG8_LDB(B1, 0, 1); PG8_SCHED; PG8_LDA(At, 0, 0); PG8_STAGE(PG8_SA(1, 1), a1 + hstep, voffA);
            PG8_WAIT_V(8); PG8_WAIT_L(0); PG8_BAR; PG8_MMA(0, 0, At, B0); PG8_MMA(0, 1, At, B1); PG8_BAR; PG8_SCHED;
            PG8_LDA(At, 0, 1); PG8_STAGE(PG8_SB(0, 0), b2, voffB); PG8_STAGE(PG8_SB(0, 1), b2 + hstep, voffB); PG8_STAGE(PG8_SA(0, 0), a2, voffA);
            PG8_WAIT_V(8); PG8_WAIT_L(0); PG8_BAR; PG8_MMA(1, 0, At, B0); PG8_MMA(1, 1, At, B1); PG8_BAR; PG8_SCHED;
            PG8_LDB(B0, 1, 0); PG8_LDB(B1, 1, 1); PG8_SCHED; PG8_LDA(At, 1, 0); PG8_STAGE(PG8_SA(0, 1), a2 + hstep, voffA);
            PG8_WAIT_V(8); PG8_WAIT_L(0); PG8_BAR; PG8_MMA(0, 0, At, B0); PG8_MMA(0, 1, At, B1); PG8_BAR; PG8_SCHED;
            PG8_LDA(At, 1, 1); PG8_STAGE(PG8_SB(1, 0), b3, voffB); PG8_STAGE(PG8_SB(1, 1), b3 + hstep, voffB); PG8_STAGE(PG8_SA(1, 0), a3, voffA);
            PG8_WAIT_V(8); PG8_WAIT_L(0); PG8_BAR; PG8_MMA(1, 0, At, B0); PG8_MMA(1, 1, At, B1); PG8_BAR; PG8_SCHED;
            } else {
            PG8_LDB(B0, 0, 0); PG8_SCHED; PG8_LDA(At, 0, 0); PG8_STAGE(PG8_SA(1, 1), a1 + hstep, voffA);
            PG8_WAIT_L(8); PG8_BAR; PG8_WAIT_L(0); PG8_MMA(0, 0, At, B0); PG8_BAR; PG8_SCHED;
            PG8_LDB(B1, 0, 1); PG8_STAGE(PG8_SB(0, 0), b2, voffB);
            PG8_BAR; PG8_WAIT_L(0); PG8_MMA(0, 1, At, B1); PG8_BAR;
            PG8_LDA(At, 0, 1); PG8_STAGE(PG8_SA(0, 0), a2, voffA);
            PG8_BAR; PG8_WAIT_L(0); PG8_MMA(1, 0, At, B0); PG8_BAR; PG8_SCHED;
            PG8_STAGE(PG8_SB(0, 1), b2 + hstep, voffB);
            PG8_WAIT_V(6); PG8_BAR; PG8_MMA(1, 1, At, B1); PG8_BAR;
            PG8_LDB(B0, 1, 0); PG8_SCHED; PG8_LDA(At, 1, 0); PG8_STAGE(PG8_SA(0, 1), a2 + hstep, voffA);
            PG8_WAIT_L(8); PG8_BAR; PG8_WAIT_L(0); PG8_MMA(0, 0, At, B0); PG8_BAR; PG8_SCHED;
            PG8_LDB(B1, 1, 1); PG8_STAGE(PG8_SB(1, 0), b3, voffB);
            PG8_BAR; PG8_WAIT_L(0); PG8_MMA(0, 1, At, B1); PG8_BAR;
            PG8_LDA(At, 1, 1); PG8_STAGE(PG8_SA(1, 0), a3, voffA);
            PG8_BAR; PG8_WAIT_L(0); PG8_MMA(1, 0, At, B0); PG8_BAR; PG8_SCHED;
            PG8_STAGE(PG8_SB(1, 1), b3 + hstep, voffB);
            PG8_WAIT_V(6); PG8_BAR; PG8_MMA(1, 1, At, B1); PG8_BAR;
            }
        }
        if constexpr (ALIGN_EPI) { if (wr == 0) PG8_BAR; }
        if constexpr (!Epi::AFTER_DRAIN) { E(acc, cur, wr, wc, fr, fq, xlds); S.done(cur); }
        if (!has_next) break;
#pragma unroll
        for (int a = 0; a < 2; ++a)
#pragma unroll
            for (int b = 0; b < 2; ++b)
#pragma unroll
                for (int m = 0; m < 4; ++m)
#pragma unroll
                    for (int n = 0; n < 2; ++n) acc[a][b][m][n] = (f32x4){0.f, 0.f, 0.f, 0.f};
        cur = nxt; cA = nA; cB = nB; ++ui;
        if constexpr (ALIGN_EPI) { if (wr == 1) PG8_BAR; }
    }
    PG8_WAIT_V(0);
    if constexpr (!ALIGN_EPI) { if (wr == 0) PG8_BAR; }
    PG8_BAR;

#undef PG8_SA
#undef PG8_SB
#undef PG8_STAGE
#undef PG8_LDA
#undef PG8_LDB
#undef PG8_MMA
#undef PG8_WAIT_V
#undef PG8_WAIT_L
#undef PG8_BAR
#undef PG8_SCHED
}
}

#define GAS __attribute__((address_space(1)))
#define LAS __attribute__((address_space(3)))
typedef unsigned short bf16;
typedef float f32x4 __attribute__((ext_vector_type(4)));
typedef short bf16x8 __attribute__((ext_vector_type(8)));
typedef unsigned u32x4 __attribute__((ext_vector_type(4)));
typedef unsigned u32x2 __attribute__((ext_vector_type(2)));

constexpr int NWAVES = 8;
constexpr int SEQ = 16384, DMODEL = 2048, NMEM = 256, DIN = 3584, DCONV = 768, DPOOL = 768, DXATT = 512, DFF = 5632, DFF2 = 11264;
constexpr int PGD = 192;
constexpr float EPS = 1e-6f;
constexpr int LDS_BYTES = 147456;
#ifndef MK_PER_PHASE
#define MK_PER_PHASE 0
#endif
constexpr int NPHASE = 8;
#ifndef PHM
#define PHM 255
#endif
#ifndef PROBE_P2
#define PROBE_P2 0
#endif
#ifndef PROBE_SYNC
#define PROBE_SYNC 0
#endif
#ifndef PROBE_GEMM
#define PROBE_GEMM 0
#endif
#ifndef PROBE_N
#define PROBE_N 2048
#endif
#ifndef REPM
#define REPM 0
#endif

constexpr size_t MiB = 1u << 20;
constexpr size_t WS_KB = 1 * MiB;
constexpr size_t WS_VT = 1 * MiB + 256 * 1024;
constexpr size_t WS_POOLWT = 1 * MiB + 512 * 1024;
constexpr size_t WS_MB = 2 * MiB;
constexpr size_t WS_WKVT = 3 * MiB;
constexpr size_t WS_SLAB1 = 8 * MiB;
constexpr size_t WS_SLAB2 = 10 * MiB;
constexpr size_t WS_WUPT = 12 * MiB;
constexpr size_t WS_WDOWNT = 56 * MiB;
constexpr size_t WS_UBND = 80 * MiB;
constexpr size_t WS_X1B = 96 * MiB;
constexpr size_t WS_ACT = 160 * MiB;
constexpr size_t WS_H = 160 * MiB;
constexpr size_t WS_Z = 225 * MiB;
constexpr size_t WS_ZPAD = WS_Z - (size_t)16 * 3584 * 2;
constexpr size_t WS_MIX = 338 * MiB;
constexpr size_t WS_WINT = 402 * MiB;
constexpr size_t WS_WOUTT = 416 * MiB;
constexpr size_t WS_END = 424 * MiB;

__device__ __forceinline__ unsigned f2bf(float f) { unsigned u = __builtin_bit_cast(unsigned, f); return (u + 0x7fffu + ((u >> 16) & 1u)) >> 16; }
__device__ __forceinline__ unsigned pk2(float lo, float hi) { return f2bf(lo) | (f2bf(hi) << 16); }
__device__ __forceinline__ float bflo(unsigned w) { return __builtin_bit_cast(float, w << 16); }
__device__ __forceinline__ float bfhi(unsigned w) { return __builtin_bit_cast(float, w & 0xffff0000u); }
__device__ __forceinline__ void unpack8(const u32x4 w, float (&f)[8]) { f[0] = bflo(w.x); f[1] = bfhi(w.x); f[2] = bflo(w.y); f[3] = bfhi(w.y); f[4] = bflo(w.z); f[5] = bfhi(w.z); f[6] = bflo(w.w); f[7] = bfhi(w.w); }
__device__ __forceinline__ u32x4 pack8(const float (&f)[8]) { u32x4 w; w.x = pk2(f[0], f[1]); w.y = pk2(f[2], f[3]); w.z = pk2(f[4], f[5]); w.w = pk2(f[6], f[7]); return w; }
__device__ __forceinline__ float wave_sum(float v) {
#pragma unroll
    for (int o = 1; o < 64; o <<= 1) v += __shfl_xor(v, o);
    return v;
}
#define LDS_WAIT() asm volatile("s_waitcnt lgkmcnt(0)" ::: "memory")

typedef GAS unsigned gu32;
constexpr size_t WS_CTL = 0, CTL_ZERO_BYTES = 64 * 1024;
constexpr int MISC_OFF = 131072 + 320;
constexpr int XLDS_OFF = 131072 + 1024;
#define XB_TMO      128
#define XB_XCNT(j)  (256  + 64 * (j))
#define XB_XSUB(j)  (1280 + 64 * (j))
#define XB_XGEN(j)  (2304 + 64 * (j))
#define XB_TOP      3328
#define XB_TOPGEN   3392
#define XCD_BAR_WORDS 3456
#define XB_SPIN_CAP (1u << 18)

__device__ __forceinline__ unsigned xb_ld(unsigned* p)              { return __hip_atomic_load(p, __ATOMIC_RELAXED, __HIP_MEMORY_SCOPE_AGENT); }
__device__ __forceinline__ unsigned xb_add(unsigned* p, unsigned v) { return __hip_atomic_fetch_add(p, v, __ATOMIC_RELAXED, __HIP_MEMORY_SCOPE_AGENT); }
__device__ __forceinline__ unsigned xb_xcc_id() { return (unsigned)__builtin_amdgcn_s_getreg((3 << 11) | 20) & 0xFu; }
#define XB_SPIN(cond, bar) do { unsigned _sp = 0; while (cond) { __builtin_amdgcn_s_sleep(1); \
    if ((++_sp & 255u) == 0u) { if (xb_ld(&(bar)[XB_TMO])) break; if (_sp > XB_SPIN_CAP) { atomicAdd(&(bar)[XB_TMO], 1u); break; } } } } while (0)

struct XcdBarrier {
    unsigned* bar; unsigned x;
    volatile LAS unsigned* st;
};

__device__ __forceinline__ XcdBarrier xcd_barrier_post(unsigned* bar, volatile LAS unsigned* st) {
    XcdBarrier b; b.bar = bar; b.x = xb_xcc_id(); b.st = st;
    if (threadIdx.x == 0) (void)xb_add(&bar[XB_XCNT(b.x)], 1u);
    return b;
}
__device__ __forceinline__ void xcd_barrier_complete(unsigned* bar, unsigned x, unsigned& nloc, unsigned& nx) {
    const unsigned G = gridDim.x * gridDim.y * gridDim.z;
    unsigned sum, cnt, mine, sp = 0u;
    for (;;) {
        sum = 0u; cnt = 0u; mine = 0u;
#pragma unroll
        for (unsigned j = 0; j < 16; ++j) { const unsigned c = xb_ld(&bar[XB_XCNT(j)]); sum += c; cnt += (c > 0u) ? 1u : 0u; mine = (j == x) ? c : mine; }
        if (sum == G) break;
        __builtin_amdgcn_s_sleep(1);
        if ((++sp & 255u) == 0u) { if (xb_ld(&bar[XB_TMO])) break; if (sp > XB_SPIN_CAP) { atomicAdd(&bar[XB_TMO], 1u); break; } }
    }
    nloc = mine > 0u ? mine : 1u; nx = cnt > 0u ? cnt : 1u;
}

__device__ __forceinline__ void xcd_barrier(const XcdBarrier& b) {
    asm volatile("s_waitcnt vmcnt(0)" ::: "memory");
    __syncthreads();
    if (threadIdx.x == 0) {
        unsigned* bar = b.bar;
        __builtin_amdgcn_s_waitcnt(0);
        unsigned nloc = b.st[0], nx = b.st[1];
        if (nloc == 0u) { xcd_barrier_complete(bar, b.x, nloc, nx); b.st[0] = nloc; b.st[1] = nx; }
        const unsigned old = xb_add(&bar[XB_XSUB(b.x)], 1u);
        const unsigned gen = old / nloc;
        if (old + 1u == (gen + 1u) * nloc) {
            __builtin_amdgcn_fence(__ATOMIC_RELEASE, "agent");
            asm volatile("s_waitcnt vmcnt(0)" ::: "memory");
            const unsigned og = xb_add(&bar[XB_TOP], 1u);
            const unsigned tg = og / nx;
            if (og + 1u == (tg + 1u) * nx) xb_add(&bar[XB_TOPGEN], 1u);
            else XB_SPIN(xb_ld(&bar[XB_TOPGEN]) == tg, bar);
            __builtin_amdgcn_fence(__ATOMIC_ACQUIRE, "agent");
            xb_add(&bar[XB_XGEN(b.x)], 1u);
            asm volatile("s_waitcnt vmcnt(0)" ::: "memory");
        } else {
            XB_SPIN(xb_ld(&bar[XB_XGEN(b.x)]) == gen, bar);
            __builtin_amdgcn_fence(__ATOMIC_ACQUIRE, "agent");
            asm volatile("s_waitcnt vmcnt(0)" ::: "memory");
        }
    }
    __syncthreads();
}


template <bool UPMAP> __device__ __forceinline__ void p0_transpose_item(const float* W, int K, int N, bf16* WT, const float* ks, LAS float* scr, int item, int lane) {
    const int nblk = N / 64, kb = item / nblk, nb = item % nblk, k0 = 64 * kb, n0 = 64 * nb;
    const int r0 = !UPMAP ? n0 : (n0 < DFF ? 256 * (n0 / 128) + (n0 % 128) : 256 * ((n0 - DFF) / 128) + 128 + ((n0 - DFF) % 128));
    f32x4 v[16];
    const float* src = W + (size_t)(k0 + (lane >> 4)) * N + n0 + 4 * (lane & 15);
#pragma unroll
    for (int i = 0; i < 16; ++i) v[i] = *(const f32x4*)(src + (size_t)(4 * i) * N);
#pragma unroll
    for (int i = 0; i < 16; ++i) { f32x4 t = v[i]; if (ks) t = t * ks[k0 + 4 * i + (lane >> 4)];
        *(LAS f32x4*)(scr + (4 * i + (lane >> 4)) * 64 + (((lane & 15) ^ ((i >> 1) & 7)) << 2)) = t; }
    LDS_WAIT(); asm volatile("" ::: "memory");
    const int c = lane & 7;
#pragma unroll
    for (int j = 0; j < 8; ++j) { const int nn = (lane >> 3) + 8 * j; const LAS float* sp = scr + (8 * c) * 64 + ((((nn >> 2) ^ c) & 15) << 2) + (nn & 3);
        u32x4 o; o.x = pk2(sp[0 * 64], sp[1 * 64]); o.y = pk2(sp[2 * 64], sp[3 * 64]); o.z = pk2(sp[4 * 64], sp[5 * 64]); o.w = pk2(sp[6 * 64], sp[7 * 64]);
        *(u32x4*)(WT + (size_t)(r0 + nn) * K + k0 + 8 * c) = o; }
    LDS_WAIT(); asm volatile("" ::: "memory");
}
__device__ __forceinline__ void rms_rows2_to_bf16(const float* xa, const float* xb, const float* g, bf16* oa, bf16* ob, int lane) {
    const f32x4* pa = (const f32x4*)xa + lane; const f32x4* pb = (const f32x4*)xb + lane; const f32x4* gr = (const f32x4*)g + lane;
    f32x4 va[8], vb[8]; float sa = 0.f, sb = 0.f;
#pragma unroll
    for (int j = 0; j < 8; ++j) { va[j] = pa[64 * j]; vb[j] = pb[64 * j]; }
#pragma unroll
    for (int j = 0; j < 8; ++j) { sa += (va[j].x * va[j].x + va[j].y * va[j].y) + (va[j].z * va[j].z + va[j].w * va[j].w); sb += (vb[j].x * vb[j].x + vb[j].y * vb[j].y) + (vb[j].z * vb[j].z + vb[j].w * vb[j].w); }
    const float ra = 1.0f / sqrtf(wave_sum(sa) * (1.0f / DMODEL) + EPS), rb = 1.0f / sqrtf(wave_sum(sb) * (1.0f / DMODEL) + EPS);
    u32x2* qa = (u32x2*)oa + lane; u32x2* qb = (u32x2*)ob + lane;
#pragma unroll
    for (int j = 0; j < 8; ++j) { const f32x4 gg = gr[64 * j]; u32x2 w;
        w.x = pk2(va[j].x * ra * gg.x, va[j].y * ra * gg.y); w.y = pk2(va[j].z * ra * gg.z, va[j].w * ra * gg.w); qa[64 * j] = w;
        w.x = pk2(vb[j].x * rb * gg.x, vb[j].y * rb * gg.y); w.y = pk2(vb[j].z * rb * gg.z, vb[j].w * rb * gg.w); qb[64 * j] = w; }
}

struct Ptrs {
    const float *x, *mem, *g_mix, *g_mem, *w_in, *conv_w, *pool_w, *pool_scale, *w_kv, *w_out, *g_ffn, *w_up, *ffn_conv_w, *ffn_conv_b, *w_down, *g_final;
    float* out; unsigned char* ws;
};

__device__ __forceinline__ void p0_prologue(const Ptrs& P, LAS unsigned char* lds, int gw, int NGW, int wave, int lane) {
    LAS float* scr = (LAS float*)(lds + wave * 16384);
    unsigned char* ws = P.ws;
    constexpr int I_IN = (DMODEL / 64) * (DIN / 64), I_OUT = (DMODEL / 64) * (DMODEL / 64), I_UP = (DMODEL / 64) * (DFF2 / 64), I_DN = (DFF / 64) * (DMODEL / 64),
                  I_KV = (DMODEL / 64) * (1024 / 64), I_PW = (PGD / 64) * (PGD / 64);
    constexpr int NITEMS = I_IN + I_OUT + I_UP + I_DN + I_KV + 4 * I_PW;
    for (int it = gw; it < NITEMS; it += NGW) {
        int r = it;
        if (r < I_IN) { p0_transpose_item<false>(P.w_in, DMODEL, DIN, (bf16*)(ws + WS_WINT), nullptr, scr, r, lane); continue; } r -= I_IN;
        if (r < I_OUT) { p0_transpose_item<false>(P.w_out, DMODEL, DMODEL, (bf16*)(ws + WS_WOUTT), nullptr, scr, r, lane); continue; } r -= I_OUT;
        if (r < I_UP) { p0_transpose_item<true>(P.w_up, DMODEL, DFF2, (bf16*)(ws + WS_WUPT), P.g_ffn, scr, r, lane); continue; } r -= I_UP;
        if (r < I_DN) { p0_transpose_item<false>(P.w_down, DFF, DMODEL, (bf16*)(ws + WS_WDOWNT), nullptr, scr, r, lane); continue; } r -= I_DN;
        if (r < I_KV) { p0_transpose_item<false>(P.w_kv, DMODEL, 1024, (bf16*)(ws + WS_WKVT), nullptr, scr, r, lane); continue; } r -= I_KV;
        const int g = r / I_PW; r -= g * I_PW;
        p0_transpose_item<false>(P.pool_w + (size_t)g * PGD * PGD, PGD, PGD, (bf16*)(ws + WS_POOLWT) + (size_t)g * PGD * PGD, nullptr, scr, r, lane);
    }
    for (int i = gw * 64 + lane; i < 16 * DIN * 2 / 16; i += NGW * 64) ((u32x4*)(ws + WS_ZPAD))[i] = (u32x4){0u, 0u, 0u, 0u};
    for (int m = 2 * gw; m < SEQ; m += 2 * NGW) rms_rows2_to_bf16(P.x + (size_t)m * DMODEL, P.x + (size_t)(m + 1) * DMODEL, P.g_mix, (bf16*)(ws + WS_H) + (size_t)m * DMODEL, (bf16*)(ws + WS_H) + (size_t)(m + 1) * DMODEL, lane);
    for (int m = 2 * gw; m < NMEM; m += 2 * NGW) rms_rows2_to_bf16(P.mem + (size_t)m * DMODEL, P.mem + (size_t)(m + 1) * DMODEL, P.g_mem, (bf16*)(ws + WS_MB) + (size_t)m * DMODEL, (bf16*)(ws + WS_MB) + (size_t)(m + 1) * DMODEL, lane);
}

__device__ __forceinline__ void kv_tile(const Ptrs& P, int tt, int lane) {
    const bf16* mB = (const bf16*)(P.ws + WS_MB); const bf16* wT = (const bf16*)(P.ws + WS_WKVT);
    const int rb = tt >> 6, cb = tt & 63, fr = lane & 15, fq = lane >> 4;
    const bf16* ap = mB + (size_t)(16 * rb + fr) * DMODEL + 8 * fq; const bf16* wp = wT + (size_t)(16 * cb + fr) * DMODEL + 8 * fq;
    f32x4 acc = {0.f, 0.f, 0.f, 0.f};
    if (cb < 32) {
#pragma unroll 8
        for (int ks = 0; ks < 64; ++ks) { const bf16x8 a = *(const bf16x8*)(ap + 32 * ks), w = *(const bf16x8*)(wp + 32 * ks); acc = __builtin_amdgcn_mfma_f32_16x16x32_bf16(w, a, acc, 0, 0, 0); }
        u32x2 o; o.x = pk2(acc[0], acc[1]); o.y = pk2(acc[2], acc[3]);
        *(u32x2*)((bf16*)(P.ws + WS_KB) + (size_t)(16 * rb + fr) * 512 + 16 * cb + 4 * fq) = o;
    } else {
#pragma unroll 8
        for (int ks = 0; ks < 64; ++ks) { const bf16x8 a = *(const bf16x8*)(ap + 32 * ks), w = *(const bf16x8*)(wp + 32 * ks); acc = __builtin_amdgcn_mfma_f32_16x16x32_bf16(a, w, acc, 0, 0, 0); }
        u32x2 o; o.x = pk2(acc[0], acc[1]); o.y = pk2(acc[2], acc[3]);
        *(u32x2*)((bf16*)(P.ws + WS_VT) + (size_t)(16 * cb - 512 + fr) * 256 + 32 * (rb >> 1) + 8 * fq + 4 * (rb & 1)) = o;
    }
}

__device__ __forceinline__ void mix_conv_task(const Ptrs& P, int blk, int lane) {
    const bf16* z = (const bf16*)(P.ws + WS_Z); bf16* mix = (bf16*)(P.ws + WS_MIX);
    const int t0 = blk * 16;
    for (int cg = lane; cg < DCONV / 8; cg += 64) {
        const int c = cg * 8;
        float w0[8], w1[8], w2[8], p1[8], p2[8];
#pragma unroll
        for (int e = 0; e < 8; ++e) { w0[e] = P.conv_w[c + e]; w1[e] = P.conv_w[DCONV + c + e]; w2[e] = P.conv_w[2 * DCONV + c + e]; }
        { float a[8], b[8]; unpack8(*(const u32x4*)(z + (long)(t0 - 2) * DIN + DCONV + c), a); unpack8(*(const u32x4*)(z + (long)(t0 - 2) * DIN + 2 * DCONV + c), b);
#pragma unroll
          for (int e = 0; e < 8; ++e) p2[e] = a[e] * b[e];
          unpack8(*(const u32x4*)(z + (long)(t0 - 1) * DIN + DCONV + c), a); unpack8(*(const u32x4*)(z + (long)(t0 - 1) * DIN + 2 * DCONV + c), b);
#pragma unroll
          for (int e = 0; e < 8; ++e) p1[e] = a[e] * b[e]; }
#pragma unroll 4
        for (int r = 0; r < 16; ++r) {
            const int t = t0 + r; float p[8], a[8], b[8], g[8], o[8];
            unpack8(*(const u32x4*)(z + (size_t)t * DIN + DCONV + c), a); unpack8(*(const u32x4*)(z + (size_t)t * DIN + 2 * DCONV + c), b); unpack8(*(const u32x4*)(z + (size_t)t * DIN + c), g);
#pragma unroll
            for (int e = 0; e < 8; ++e) { p[e] = a[e] * b[e]; o[e] = g[e] * (w2[e] * p[e] + w1[e] * p1[e] + w0[e] * p2[e]); p2[e] = p1[e]; p1[e] = p[e]; }
            *(u32x4*)(mix + (size_t)t * DMODEL + c) = pack8(o);
        }
    }
}
template <int g> __device__ __forceinline__ void mix_pool_task(const Ptrs& P, int blk, int lane) {
    constexpr int k = 2 << g;
    const char* zu = (const char*)((const bf16*)(P.ws + WS_Z) + (size_t)(blk * 16) * DIN + 3 * DCONV + PGD * g);
    const char* wu = (const char*)((const bf16*)(P.ws + WS_POOLWT) + (size_t)g * PGD * PGD);
    bf16* mix = (bf16*)(P.ws + WS_MIX);
    const int fr = lane & 15, fq = lane >> 4, t = blk * 16 + fr;
    const unsigned zl = (unsigned)(fr * DIN + 8 * fq) * 2u, wl = (unsigned)(fr * PGD + 8 * fq) * 2u;
    const int cnt = (t + 1 < k) ? t + 1 : k; const float inv = 1.0f / (float)cnt;
    f32x4 acc[12];
#pragma unroll
    for (int n = 0; n < 12; ++n) acc[n] = (f32x4){0.f, 0.f, 0.f, 0.f};
#pragma unroll 1
    for (int ks = 0; ks < 6; ++ks) {
        float sum[8], self[8];
        unpack8(*(const u32x4*)(zu + ks * 64 + zl), self);
#pragma unroll
        for (int e = 0; e < 8; ++e) sum[e] = self[e];
#pragma unroll
        for (int j = 1; j < k; ++j) { float v[8]; unpack8(*(const u32x4*)(zu + ks * 64 - (long)j * (DIN * 2) + zl), v);
#pragma unroll
            for (int e = 0; e < 8; ++e) sum[e] += v[e]; }
        float pl[8];
#pragma unroll
        for (int e = 0; e < 8; ++e) pl[e] = sum[e] * inv - self[e];
        const bf16x8 pf = __builtin_bit_cast(bf16x8, pack8(pl));
#pragma unroll
        for (int n = 0; n < 12; ++n) { const bf16x8 wf = *(const bf16x8*)(wu + n * (16 * PGD * 2) + ks * 64 + wl); acc[n] = __builtin_amdgcn_mfma_f32_16x16x32_bf16(wf, pf, acc[n], 0, 0, 0); }
    }
#pragma unroll
    for (int n = 0; n < 12; ++n) { const int d = 16 * n + 4 * fq; const f32x4 sc = *(const f32x4*)(P.pool_scale + PGD * g + d);
        u32x2 o; o.x = pk2(acc[n][0] * sc[0], acc[n][1] * sc[1]); o.y = pk2(acc[n][2] * sc[2], acc[n][3] * sc[3]);
        *(u32x2*)(mix + (size_t)t * DMODEL + DCONV + PGD * g + d) = o; }
}
__device__ __forceinline__ void mix_attn_task(const Ptrs& P, int h, int blk, int lane) {
    const bf16* z = (const bf16*)(P.ws + WS_Z); bf16* mix = (bf16*)(P.ws + WS_MIX); const bf16* Kb = (const bf16*)(P.ws + WS_KB); const bf16* Vt = (const bf16*)(P.ws + WS_VT);
    const int fr = lane & 15, fq = lane >> 4, t = blk * 16 + fr;
    bf16x8 qf[4];
#pragma unroll
    for (int ks = 0; ks < 4; ++ks) qf[ks] = *(const bf16x8*)(z + (size_t)t * DIN + 3 * DCONV + DPOOL + 128 * h + 32 * ks + 8 * fq);
    f32x4 s[16];
#pragma unroll
    for (int kb = 0; kb < 16; ++kb) { s[kb] = (f32x4){0.f, 0.f, 0.f, 0.f};
#pragma unroll
        for (int ks = 0; ks < 4; ++ks) { const bf16x8 kf = *(const bf16x8*)(Kb + (size_t)(16 * kb + fr) * 512 + 128 * h + 32 * ks + 8 * fq); s[kb] = __builtin_amdgcn_mfma_f32_16x16x32_bf16(kf, qf[ks], s[kb], 0, 0, 0); } }
    float mx = -3.0e38f;
#pragma unroll
    for (int kb = 0; kb < 16; ++kb) mx = fmaxf(fmaxf(fmaxf(s[kb][0], s[kb][1]), fmaxf(s[kb][2], s[kb][3])), mx);
    mx = fmaxf(mx, __shfl_xor(mx, 16)); mx = fmaxf(mx, __shfl_xor(mx, 32));
    const float c2 = 0.08838834764831845f * 1.4426950408889634f;
    float sum = 0.f;
#pragma unroll
    for (int kb = 0; kb < 16; ++kb)
#pragma unroll
        for (int r = 0; r < 4; ++r) { const float p = __builtin_amdgcn_exp2f((s[kb][r] - mx) * c2); s[kb][r] = p; sum += p; }
    sum += __shfl_xor(sum, 16); sum += __shfl_xor(sum, 32);
    const float inv = 1.0f / sum;
    f32x4 o[8];
#pragma unroll
    for (int db = 0; db < 8; ++db) o[db] = (f32x4){0.f, 0.f, 0.f, 0.f};
#pragma unroll
    for (int ks = 0; ks < 8; ++ks) {
        u32x4 pw; pw.x = pk2(s[2 * ks][0], s[2 * ks][1]); pw.y = pk2(s[2 * ks][2], s[2 * ks][3]); pw.z = pk2(s[2 * ks + 1][0], s[2 * ks + 1][1]); pw.w = pk2(s[2 * ks + 1][2], s[2 * ks + 1][3]);
        const bf16x8 pf = __builtin_bit_cast(bf16x8, pw);
#pragma unroll
        for (int db = 0; db < 8; ++db) { const bf16x8 vf = *(const bf16x8*)(Vt + (size_t)(128 * h + 16 * db + fr) * 256 + 32 * ks + 8 * fq); o[db] = __builtin_amdgcn_mfma_f32_16x16x32_bf16(vf, pf, o[db], 0, 0, 0); }
    }
#pragma unroll
    for (int db = 0; db < 8; ++db) { u32x2 w; w.x = pk2(o[db][0] * inv, o[db][1] * inv); w.y = pk2(o[db][2] * inv, o[db][3] * inv);
        *(u32x2*)(mix + (size_t)t * DMODEL + DCONV + DPOOL + 128 * h + 16 * db + 4 * fq) = w; }
}
template <int R, int C, int PCH> __device__ __forceinline__ void lds_stage_rows(LAS unsigned char* dst, const unsigned char* src, int gp, int tid) {
    constexpr int N = R * C, PER = (N + 511) / 512;
    u32x4 v[PER];
#pragma unroll
    for (int i = 0; i < PER; ++i) { const int idx = tid + 512 * i; if (idx < N) { const int row = idx / C, ch = idx % C; v[i] = *(const u32x4*)(src + (size_t)row * gp + ch * 16); } }
#pragma unroll
    for (int i = 0; i < PER; ++i) { const int idx = tid + 512 * i; if (idx < N) { const int row = idx / C, ch = idx % C; *(LAS u32x4*)(dst + row * (PCH * 16) + (((ch & ~15) | ((ch & 15) ^ (row & 15))) << 4)) = v[i]; } }
}
template <int N> __device__ __forceinline__ float dpp_shrN(float old, float src) { return __builtin_bit_cast(float, __builtin_amdgcn_update_dpp(__builtin_bit_cast(int, old), __builtin_bit_cast(int, src), 0x110 + N, 0xf, 0xf, false)); }
template <int N> __device__ __forceinline__ float dpp_rorN(float src) { return __builtin_bit_cast(float, __builtin_amdgcn_update_dpp(__builtin_bit_cast(int, src), __builtin_bit_cast(int, src), 0x120 + N, 0xf, 0xf, false)); }
template <int N> __device__ __forceinline__ float scan_step(float x, float p) { return x + dpp_shrN<N>(dpp_rorN<N>(p), x); }
template <int N> __device__ __forceinline__ float scan_step_prev(float p) { return p + dpp_shrN<N>(0.f, p); }

__device__ __forceinline__ void mix_attn_wave(const Ptrs& P, LAS unsigned char* ldsK, LAS unsigned char* ldsV, int h, int row0, int lane) {
    const bf16* z = (const bf16*)(P.ws + WS_Z); bf16* mix = (bf16*)(P.ws + WS_MIX);
    const int fr = lane & 15, fq = lane >> 4;
    bf16x8 q0[4], q1[4];
#pragma unroll
    for (int ks = 0; ks < 4; ++ks) { const bf16* qp = z + (size_t)(row0 + fr) * DIN + 3 * DCONV + DPOOL + 128 * h + 32 * ks + 8 * fq; q0[ks] = *(const bf16x8*)qp; q1[ks] = *(const bf16x8*)(qp + 16 * DIN); }
    unsigned offk[4];
#pragma unroll
    for (int ks = 0; ks < 4; ++ks) offk[ks] = (unsigned)(fr * 256 + (((4 * ks + fq) ^ fr) << 4));
    f32x4 s0[16], s1[16];
#pragma unroll
    for (int kb = 0; kb < 16; ++kb) { s0[kb] = (f32x4){0.f, 0.f, 0.f, 0.f}; s1[kb] = (f32x4){0.f, 0.f, 0.f, 0.f};
#pragma unroll
        for (int ks = 0; ks < 4; ++ks) { const bf16x8 kf = *(const LAS bf16x8*)(ldsK + kb * 4096 + offk[ks]);
            s0[kb] = __builtin_amdgcn_mfma_f32_16x16x32_bf16(kf, q0[ks], s0[kb], 0, 0, 0); s1[kb] = __builtin_amdgcn_mfma_f32_16x16x32_bf16(kf, q1[ks], s1[kb], 0, 0, 0); } }
    const float c2 = 0.08838834764831845f * 1.4426950408889634f;
    bf16x8 p0[8], p1[8]; float inv0, inv1;
    {   float mx = -3.0e38f;
#pragma unroll
        for (int kb = 0; kb < 16; ++kb) mx = fmaxf(fmaxf(fmaxf(s0[kb][0], s0[kb][1]), fmaxf(s0[kb][2], s0[kb][3])), mx);
        mx = fmaxf(mx, __shfl_xor(mx, 16)); mx = fmaxf(mx, __shfl_xor(mx, 32));
        float sum = 0.f;
#pragma unroll
        for (int ks = 0; ks < 8; ++ks) { float e[8];
#pragma unroll
            for (int r = 0; r < 4; ++r) { e[r] = __builtin_amdgcn_exp2f((s0[2 * ks][r] - mx) * c2); e[4 + r] = __builtin_amdgcn_exp2f((s0[2 * ks + 1][r] - mx) * c2); }
            sum += ((e[0] + e[1]) + (e[2] + e[3])) + ((e[4] + e[5]) + (e[6] + e[7]));
            p0[ks] = __builtin_bit_cast(bf16x8, pack8(e)); }
        sum += __shfl_xor(sum, 16); sum += __shfl_xor(sum, 32); inv0 = 1.0f / sum; }
    {   float mx = -3.0e38f;
#pragma unroll
        for (int kb = 0; kb < 16; ++kb) mx = fmaxf(fmaxf(fmaxf(s1[kb][0], s1[kb][1]), fmaxf(s1[kb][2], s1[kb][3])), mx);
        mx = fmaxf(mx, __shfl_xor(mx, 16)); mx = fmaxf(mx, __shfl_xor(mx, 32));
        float sum = 0.f;
#pragma unroll
        for (int ks = 0; ks < 8; ++ks) { float e[8];
#pragma unroll
            for (int r = 0; r < 4; ++r) { e[r] = __builtin_amdgcn_exp2f((s1[2 * ks][r] - mx) * c2); e[4 + r] = __builtin_amdgcn_exp2f((s1[2 * ks + 1][r] - mx) * c2); }
            sum += ((e[0] + e[1]) + (e[2] + e[3])) + ((e[4] + e[5]) + (e[6] + e[7]));
            p1[ks] = __builtin_bit_cast(bf16x8, pack8(e)); }
        sum += __shfl_xor(sum, 16); sum += __shfl_xor(sum, 32); inv1 = 1.0f / sum; }
    f32x4 o0[8], o1[8];
#pragma unroll
    for (int db = 0; db < 8; ++db) { o0[db] = (f32x4){0.f, 0.f, 0.f, 0.f}; o1[db] = (f32x4){0.f, 0.f, 0.f, 0.f}; }
#pragma unroll
    for (int ks = 0; ks < 8; ++ks) {
        const unsigned offv = (unsigned)(fr * 512 + ((ks >> 2) << 8) + (((4 * (ks & 3) + fq) ^ fr) << 4));
#pragma unroll
        for (int db = 0; db < 8; ++db) { const bf16x8 vf = *(const LAS bf16x8*)(ldsV + db * 8192 + offv);
            o0[db] = __builtin_amdgcn_mfma_f32_16x16x32_bf16(vf, p0[ks], o0[db], 0, 0, 0); o1[db] = __builtin_amdgcn_mfma_f32_16x16x32_bf16(vf, p1[ks], o1[db], 0, 0, 0); } }
    bf16* op = mix + (size_t)(row0 + fr) * DMODEL + DCONV + DPOOL + 128 * h + 4 * fq;
#pragma unroll
    for (int db = 0; db < 8; ++db) { u32x2 w; w.x = pk2(o0[db][0] * inv0, o0[db][1] * inv0); w.y = pk2(o0[db][2] * inv0, o0[db][3] * inv0); *(u32x2*)(op + 16 * db) = w;
        w.x = pk2(o1[db][0] * inv1, o1[db][1] * inv1); w.y = pk2(o1[db][2] * inv1, o1[db][3] * inv1); *(u32x2*)(op + (size_t)16 * DMODEL + 16 * db) = w; }
}

template <int g> __device__ __forceinline__ void mix_pool_wave(const Ptrs& P, LAS unsigned char* ldsW, int row0, int lane) {
    constexpr int k = 2 << g;
    const bf16* z = (const bf16*)(P.ws + WS_Z); bf16* mix = (bf16*)(P.ws + WS_MIX);
    const int fr = lane & 15, fq = lane >> 4;
    f32x4 acc0[12], acc1[12];
#pragma unroll
    for (int n = 0; n < 12; ++n) { acc0[n] = (f32x4){0.f, 0.f, 0.f, 0.f}; acc1[n] = (f32x4){0.f, 0.f, 0.f, 0.f}; }
    const float invA = 1.0f / (float)((row0 + fr + 1 < k) ? row0 + fr + 1 : k), invB = 1.0f / (float)((row0 + 16 + fr + 1 < k) ? row0 + 16 + fr + 1 : k);
#pragma unroll 1
    for (int ks = 0; ks < 6; ++ks) {
        const bf16* zp = z + (long)(row0 - 16 + fr) * DIN + 3 * DCONV + PGD * g + 32 * ks + 8 * fq;
        float pv[8], xa[8], xb[8], sa[8], sb[8];
        unpack8(*(const u32x4*)zp, pv); unpack8(*(const u32x4*)(zp + 16 * DIN), xa); unpack8(*(const u32x4*)(zp + 32 * DIN), xb);
#pragma unroll
        for (int e = 0; e < 8; ++e) {
            float p = pv[e], a = xa[e], b = xb[e];
            float b1 = scan_step<1>(b, a), a1 = scan_step<1>(a, p), p1 = scan_step_prev<1>(p);
            if (k >= 4) { const float b2 = scan_step<2>(b1, a1), a2 = scan_step<2>(a1, p1), p2 = scan_step_prev<2>(p1); b1 = b2; a1 = a2; p1 = p2; }
            if (k >= 8) { const float b2 = scan_step<4>(b1, a1), a2 = scan_step<4>(a1, p1), p2 = scan_step_prev<4>(p1); b1 = b2; a1 = a2; p1 = p2; }
            if (k >= 16) { const float b2 = scan_step<8>(b1, a1), a2 = scan_step<8>(a1, p1); b1 = b2; a1 = a2; }
            sa[e] = a1 * invA - a; sb[e] = b1 * invB - b; }
        const bf16x8 fa = __builtin_bit_cast(bf16x8, pack8(sa)), fb = __builtin_bit_cast(bf16x8, pack8(sb));
        const unsigned offw = (unsigned)(fr * 512 + ((ks >> 2) << 8) + (((4 * (ks & 3) + fq) ^ fr) << 4));
#pragma unroll
        for (int n = 0; n < 12; ++n) { const bf16x8 wf = *(const LAS bf16x8*)(ldsW + n * 8192 + offw);
            acc0[n] = __builtin_amdgcn_mfma_f32_16x16x32_bf16(wf, fa, acc0[n], 0, 0, 0); acc1[n] = __builtin_amdgcn_mfma_f32_16x16x32_bf16(wf, fb, acc1[n], 0, 0, 0); }
    }
    bf16* op = mix + (size_t)(row0 + fr) * DMODEL + DCONV + PGD * g + 4 * fq;
#pragma unroll
    for (int n = 0; n < 12; ++n) { const f32x4 sc = *(const f32x4*)(P.pool_scale + PGD * g + 16 * n + 4 * fq);
        u32x2 o; o.x = pk2(acc0[n][0] * sc[0], acc0[n][1] * sc[1]); o.y = pk2(acc0[n][2] * sc[2], acc0[n][3] * sc[3]); *(u32x2*)(op + 16 * n) = o;
        o.x = pk2(acc1[n][0] * sc[0], acc1[n][1] * sc[1]); o.y = pk2(acc1[n][2] * sc[2], acc1[n][3] * sc[3]); *(u32x2*)(op + (size_t)16 * DMODEL + 16 * n) = o; }
}

__device__ __forceinline__ void p2_mixer(const Ptrs& P, LAS unsigned char* lds, int w, int tid, int wave, int lane, int tmask) {
    const int sub = w & 3, tile = w >> 2, row0 = tile * 256 + wave * 32;
    if (tmask & 0x1e0) {
        lds_stage_rows<256, 16, 16>(lds, (const unsigned char*)(P.ws + WS_KB) + 256 * sub, 1024, tid);
        lds_stage_rows<128, 32, 32>(lds + 65536, (const unsigned char*)(P.ws + WS_VT) + (size_t)sub * 128 * 512, 512, tid);
        LDS_WAIT(); __syncthreads();
        mix_attn_wave(P, lds, lds + 65536, sub, row0, lane);
        __syncthreads();
    }
    if (tmask & 0x1e) {
        lds_stage_rows<192, 24, 32>(lds, (const unsigned char*)(P.ws + WS_POOLWT) + (size_t)sub * PGD * PGD * 2, PGD * 2, tid);
        LDS_WAIT(); __syncthreads();
        if (sub == 0) mix_pool_wave<0>(P, lds, row0, lane); else if (sub == 1) mix_pool_wave<1>(P, lds, row0, lane); else if (sub == 2) mix_pool_wave<2>(P, lds, row0, lane); else mix_pool_wave<3>(P, lds, row0, lane);
        __syncthreads();
    }
    if (tmask & 1) { for (int b = wave; b < 4; b += 8) mix_conv_task(P, 4 * w + b, lane); }
}

__device__ __forceinline__ void p5_fixup(const Ptrs& P, int gt, int NGT) {
    const float* ub = (const float*)(P.ws + WS_UBND); bf16* act = (bf16*)(P.ws + WS_ACT); const float* cw = P.ffn_conv_w; const float* cb = P.ffn_conv_b;
    for (int i = gt; i < 63 * (DFF / 8); i += NGT) {
        const int pm = 1 + i / (DFF / 8), c = (i % (DFF / 8)) * 8, gi = 256 * (c / 128) + (c % 128);
        const float* p2 = ub + (size_t)((pm - 1) * 4 + 2) * DFF2 + gi; const float* p1 = p2 + DFF2; const float* r0 = ub + (size_t)(pm * 4) * DFF2 + gi; const float* r1 = r0 + DFF2;
        float o0[8], o1[8];
#pragma unroll
        for (int e = 0; e < 8; ++e) {
            const float gw0 = cw[c + e], gw1 = cw[DFF2 + c + e], gw2 = cw[2 * DFF2 + c + e], gb = cb[c + e], vw0 = cw[DFF + c + e], vw1 = cw[DFF2 + DFF + c + e], vw2 = cw[2 * DFF2 + DFF + c + e], vb = cb[DFF + c + e];
            const float G0 = gw2 * r0[e] + (gw1 * p1[e] + (gw0 * p2[e] + gb)), V0 = vw2 * r0[128 + e] + (vw1 * p1[128 + e] + (vw0 * p2[128 + e] + vb));
            const float G1 = gw2 * r1[e] + (gw1 * r0[e] + (gw0 * p1[e] + gb)), V1 = vw2 * r1[128 + e] + (vw1 * r0[128 + e] + (vw0 * p1[128 + e] + vb));
            o0[e] = G0 * __builtin_amdgcn_rcpf(1.0f + __builtin_amdgcn_exp2f(-1.4426950408889634f * G0)) * V0;
            o1[e] = G1 * __builtin_amdgcn_rcpf(1.0f + __builtin_amdgcn_exp2f(-1.4426950408889634f * G1)) * V1; }
        *(u32x4*)(act + (size_t)(256 * pm) * DFF + c) = pack8(o0); *(u32x4*)(act + (size_t)(256 * pm + 1) * DFF + c) = pack8(o1);
    }
}

__device__ __forceinline__ void p7_final(const Ptrs& P, int gw, int NGW, int lane) {
    const float* slab = (const float*)(P.ws + WS_SLAB2);
    for (int m = gw; m < SEQ; m += NGW) {
        const float part = (lane < 32) ? slab[(size_t)m * 32 + lane] : 0.f;
        const float rstd = 1.0f / sqrtf(wave_sum(part) * (1.0f / DMODEL) + EPS);
        f32x4* xr = (f32x4*)(P.out + (size_t)m * DMODEL) + lane; const f32x4* gr = (const f32x4*)P.g_final + lane;
#pragma unroll
        for (int j = 0; j < 8; ++j) { f32x4 v = xr[64 * j]; const f32x4 gg = gr[64 * j]; v = v * rstd * gg; xr[64 * j] = v; }
    }
}

struct Args { const float* in[16]; float* out; unsigned char* ws; int ph_lo, ph_hi; };
__global__ void __launch_bounds__(NWAVES * 64, 2) hybrid_fwd(Args args) {
    extern __shared__ __attribute__((aligned(16))) unsigned char lds_raw[];
    LAS unsigned char* lds = (LAS unsigned char*)lds_raw;
    cg::grid_group grid = cg::this_grid();
    const int tid = threadIdx.x, lane = tid & 63, wave = __builtin_amdgcn_readfirstlane(tid >> 6);
    const int G = gridDim.x, bx = blockIdx.x, vcu = (G % 8 == 0) ? (bx % 8) * (G / 8) + bx / 8 : bx;
    const int gw = vcu * NWAVES + wave, NGW = G * NWAVES;
    volatile LAS unsigned* MISC = (volatile LAS unsigned*)(lds + MISC_OFF);
    if (tid < 32) MISC[tid] = 0u;
    __syncthreads();
    const XcdBarrier bar = xcd_barrier_post((unsigned*)(args.ws + WS_CTL), MISC + 8);
    Ptrs P;
    P.x = args.in[0]; P.mem = args.in[1]; P.g_mix = args.in[2]; P.g_mem = args.in[3]; P.w_in = args.in[4]; P.conv_w = args.in[5]; P.pool_w = args.in[6]; P.pool_scale = args.in[7];
    P.w_kv = args.in[8]; P.w_out = args.in[9]; P.g_ffn = args.in[10]; P.w_up = args.in[11]; P.ffn_conv_w = args.in[12]; P.ffn_conv_b = args.in[13]; P.w_down = args.in[14]; P.g_final = args.in[15];
    P.out = args.out; P.ws = args.ws;
    unsigned char* ws = args.ws;
#if PROBE_SYNC
    for (int i = 0; i < 20; ++i) xcd_barrier(bar);
#endif
    const int lo = args.ph_lo, hi = args.ph_hi;
#define IN(k) (lo <= (k) && (k) < hi)
#define SYNC(k) do { if ((k) + 1 < hi) { if ((k) == 0) grid.sync(); else xcd_barrier(bar); } } while (0)
#define SYNCR(k, b) do { if ((k) + 1 < hi || rp + 1 < NREP(b)) { if ((k) == 0) grid.sync(); else xcd_barrier(bar); } } while (0)
#define NREP(b) ((REPM & (b)) ? 2 : 1)
    if (IN(0) && (PHM & 1)) for (int rp = 0; rp < NREP(1); ++rp) { p0_prologue(P, lds, gw, NGW, wave, lane); SYNCR(0, 1); }
    if (IN(1) && (PHM & 2)) for (int rp = 0; rp < NREP(2); ++rp) {
        pg8::Gemm g{(const bf16*)(ws + WS_H), (const bf16*)(ws + WS_WINT), SEQ, DIN, DMODEL}; pg8::StaticOrder S; S.init(SEQ, DIN, G, bx);
        pg8::EpiZ E{(bf16*)(ws + WS_Z), DIN};
        pg8::gemm_phase<pg8::EpiZ, pg8::StaticOrder, true, true>(lds, g, S, E, lds + XLDS_OFF);
        if (wave < 4) { for (int tt = vcu * 4 + wave; tt < 1024; tt += G * 4) kv_tile(P, tt, lane); }
        SYNCR(1, 2);
    }
    if (IN(2) && (PHM & 4)) for (int rp = 0; rp < NREP(4); ++rp) { p2_mixer(P, lds, vcu, tid, wave, lane, 511);
#if PROBE_P2
        p2_mixer(P, lds, vcu, tid, wave, lane, PROBE_P2);
#endif
        SYNCR(2, 4); }
    if (IN(3) && (PHM & 8)) for (int rp = 0; rp < NREP(8); ++rp) {
        pg8::Gemm g{(const bf16*)(ws + WS_MIX), (const bf16*)(ws + WS_WOUTT), SEQ, DMODEL, DMODEL}; pg8::StaticOrder S; S.init(SEQ, DMODEL, G, bx);
        pg8::EpiResA E{P.x, (bf16*)(ws + WS_X1B), (float*)(ws + WS_SLAB1)};
        pg8::gemm_phase<pg8::EpiResA, pg8::StaticOrder, true, true>(lds, g, S, E, lds + XLDS_OFF);
        SYNCR(3, 8);
    }
#if PROBE_GEMM
    if (IN(3)) {
        pg8::Gemm g{(const bf16*)(ws + WS_X1B), (const bf16*)(ws + WS_WUPT), SEQ, PROBE_N, DMODEL}; pg8::StaticOrder S; S.init(SEQ, PROBE_N, G, bx);
#if PROBE_GEMM == 1
        pg8::EpiZ E{(bf16*)(ws + WS_Z), PROBE_N};
        pg8::gemm_phase<pg8::EpiZ, pg8::StaticOrder, true, true>(lds, g, S, E, lds + XLDS_OFF);
#elif PROBE_GEMM == 2
        pg8::EpiNone E{};
        pg8::gemm_phase<pg8::EpiNone, pg8::StaticOrder, true, true>(lds, g, S, E, lds + XLDS_OFF);
#elif PROBE_GEMM == 3
        pg8::EpiZ E{(bf16*)(ws + WS_Z), PROBE_N};
        pg8::gemm_phase<pg8::EpiZ, pg8::StaticOrder, true, false>(lds, g, S, E, lds + XLDS_OFF);
#elif PROBE_GEMM == 5
        pg8::EpiAct E{(bf16*)(ws + WS_ACT), (const float*)(ws + WS_SLAB1), P.ffn_conv_w, P.ffn_conv_b, (float*)(ws + WS_UBND)};
        pg8::gemm_phase<pg8::EpiAct, pg8::StaticOrder, true, true>(lds, g, S, E, lds + XLDS_OFF);
#elif PROBE_GEMM == 4
        pg8::EpiZ E{(bf16*)(ws + WS_Z), PROBE_N};
        pg8::gemm_phase<pg8::EpiZ, pg8::StaticOrder, false, true>(lds, g, S, E, lds + XLDS_OFF);
#endif
        xcd_barrier(bar);
    }
#endif
    if (IN(4) && (PHM & 16)) for (int rp = 0; rp < NREP(16); ++rp) {
        pg8::Gemm g{(const bf16*)(ws + WS_X1B), (const bf16*)(ws + WS_WUPT), SEQ, DFF2, DMODEL}; pg8::StaticOrder S; S.init(SEQ, DFF2, G, bx);
        pg8::EpiAct E{(bf16*)(ws + WS_ACT), (const float*)(ws + WS_SLAB1), P.ffn_conv_w, P.ffn_conv_b, (float*)(ws + WS_UBND)};
        pg8::gemm_phase<pg8::EpiAct, pg8::StaticOrder, true, true>(lds, g, S, E, lds + XLDS_OFF);
        xcd_barrier(bar);
    }
    if (IN(5) && (PHM & 32)) { p5_fixup(P, vcu * (NWAVES * 64) + tid, G * NWAVES * 64); xcd_barrier(bar); }
    if (IN(6) && (PHM & 64)) {
        pg8::Gemm g{(const bf16*)(ws + WS_ACT), (const bf16*)(ws + WS_WDOWNT), SEQ, DMODEL, DFF}; pg8::StaticOrder S; S.init(SEQ, DMODEL, G, bx);
        pg8::EpiResB E{(const bf16*)(ws + WS_X1B), P.out, (float*)(ws + WS_SLAB2)};
        pg8::gemm_phase<pg8::EpiResB, pg8::StaticOrder, true, true>(lds, g, S, E, lds + XLDS_OFF);
        SYNC(6);
    }
    if (IN(7) && (PHM & 128)) p7_final(P, gw, NGW, lane);
#undef IN
#undef SYNC
}

extern "C" void kernel_launch(void* const* d_in, const int* in_sizes, int n_in, void* d_out, int out_size, void* d_ws, size_t ws_size, hipStream_t stream) {
    static int grid = 0;
    if (grid == 0) {
        if (n_in != 16 || in_sizes[0] != SEQ * DMODEL || out_size != SEQ * DMODEL || ws_size < WS_END) { fprintf(stderr, "kernel_launch: unexpected shapes (n_in %d, in0 %d, out %d, ws %zu)\n", n_in, n_in > 0 ? in_sizes[0] : -1, out_size, ws_size); grid = -1; return; }
        int dev = 0, cus = 0, per_cu = 0;
        if (hipGetDevice(&dev) != hipSuccess || hipDeviceGetAttribute(&cus, hipDeviceAttributeMultiprocessorCount, dev) != hipSuccess) { grid = -1; return; }
        if (hipFuncSetAttribute((const void*)hybrid_fwd, hipFuncAttributeMaxDynamicSharedMemorySize, LDS_BYTES) != hipSuccess) { fprintf(stderr, "kernel_launch: hipFuncSetAttribute failed\n"); grid = -1; return; }
        if (hipOccupancyMaxActiveBlocksPerMultiprocessor(&per_cu, (const void*)hybrid_fwd, NWAVES * 64, LDS_BYTES) != hipSuccess || per_cu < 1) { fprintf(stderr, "kernel_launch: occupancy query says %d blocks per CU\n", per_cu); (void)hipGetLastError(); per_cu = 1; }
        grid = cus;
        if (grid % 8 != 0 || grid < 8) { fprintf(stderr, "kernel_launch: %d CUs\n", grid); }
    }
    if (grid < 0) return;
    if (hipMemsetAsync((char*)d_ws + WS_CTL, 0, CTL_ZERO_BYTES, stream) != hipSuccess) { fprintf(stderr, "kernel_launch: hipMemsetAsync failed\n"); return; }
    Args a{};
    for (int i = 0; i < 16; ++i) a.in[i] = (const float*)d_in[i];
    a.out = (float*)d_out; a.ws = (unsigned char*)d_ws;
#if MK_PER_PHASE
    for (int ph = 0; ph < NPHASE; ++ph) { a.ph_lo = ph; a.ph_hi = ph + 1; hipLaunchKernelGGL(hybrid_fwd, dim3(grid), dim3(NWAVES * 64), LDS_BYTES, stream, a); }
#else
    a.ph_lo = 0; a.ph_hi = NPHASE;
    void* kargs[] = {&a};
    hipError_t e = hipLaunchCooperativeKernel((const void*)hybrid_fwd, dim3(grid), dim3(NWAVES * 64), kargs, LDS_BYTES, stream);
    if (e != hipSuccess) fprintf(stderr, "kernel_launch: cooperative launch failed: %s (grid %d)\n", hipGetErrorString(e), grid);
#endif
}
```

```cpp
#include <hip/hip_runtime.h>
#include <hip/hip_cooperative_groups.h>
#include <cstdio>
#include <cstdint>
namespace cg = cooperative_groups;
namespace pg8 {
#define PG8_LAS __attribute__((address_space(3)))
typedef unsigned short bf16_t;
typedef short bf16x8 __attribute__((ext_vector_type(8)));
typedef float f32x4 __attribute__((ext_vector_type(4)));
typedef unsigned u32x4 __attribute__((ext_vector_type(4)));
constexpr int BM = 256, BK = 64, HALF = 128, HTB = HALF * BK * 2  , STAGE_BYTES = 8 * HTB, NXCD = 8, WGM = 8;

__host__ __device__ __forceinline__ int lds_byte(int r, int c) { const int st = (r >> 4) * 2 + (c >> 5), rr = r & 15, cc = c & 31, ob = rr * 64 + cc * 2; return st * 1024 + (ob ^ (((ob >> 9) & 1) << 5)); }
__host__ __device__ __forceinline__ void stage_rc(int b, int& R, int& C) { const int st = b / 1024, sb = b % 1024, swz = sb ^ (((sb >> 9) & 1) << 5); R = (st >> 1) * 16 + swz / 64; C = (st & 1) * 32 + (swz % 64) / 2; }
__host__ __device__ __forceinline__ int perm32(int rho) { const int n = rho >> 4, i = rho & 15; return 8 * (i >> 2) + 4 * n + (i & 3); }

struct Unit { int pm, pn; };
struct Gemm { const bf16_t* A; const bf16_t* Bt; int M, N, K; };

struct StaticOrder {
    int nM, nN, nwg, G, c;
    __host__ __device__ void init(int M, int N, int G_, int c_) { nM = M / BM; nN = N / BM; nwg = nM * nN; G = G_; c = c_; }
    __host__ __device__ bool next(int i, Unit& u) const {
        const long L = (long)i * G + c; if (L >= nwg) return false;
        int wgid = (int)L; { const int q = nwg / NXCD, r = nwg % NXCD, xcd = wgid % NXCD, off = wgid / NXCD; wgid = (xcd < r ? xcd * (q + 1) : r * (q + 1) + (xcd - r) * q) + off; }
        const int nig = WGM * nN, gid = wgid / nig, fm = gid * WGM, gsz = (nM - fm) < WGM ? (nM - fm) : WGM;
        u.pm = fm + ((wgid % nig) % gsz); u.pn = (wgid % nig) / gsz; return true;
    }
    __device__ __forceinline__ void a_ready(const Unit&) const {}
    __device__ __forceinline__ void done(const Unit&) const {}
};
__device__ __forceinline__ unsigned cvt_pk_bf16(float lo, float hi) { unsigned r; asm volatile("v_cvt_pk_bf16_f32 %0, %1, %2" : "=v"(r) : "v"(lo), "v"(hi)); return r; }
typedef unsigned u32x2 __attribute__((ext_vector_type(2)));
constexpr int DM = 2048;
constexpr float RMS_EPS = 1e-6f;

struct EpiZ {
    static constexpr bool PERM = true, AFTER_DRAIN = false;
    bf16_t* O; int ldc;
    __device__ __forceinline__ void operator()(const f32x4 (&acc)[2][2][4][2], const Unit& u, int wr, int wc, int fr_, int fq_, PG8_LAS unsigned char*) const {
        int t_ = threadIdx.x; asm volatile("" : "+v"(t_));
        const int fr = t_ & 15, fq = (t_ >> 4) & 3;
        const int row0 = u.pm * BM + wr * 64 + fr, col0 = u.pn * BM + wc * 32 + 8 * fq;
#pragma unroll
        for (int ai = 0; ai < 2; ++ai)
#pragma unroll
            for (int m = 0; m < 4; ++m) { bf16_t* rowp = O + (size_t)(row0 + ai * HALF + m * 16) * ldc + col0;
#pragma unroll
                for (int bj = 0; bj < 2; ++bj) { const f32x4 v0 = acc[ai][bj][m][0], v1 = acc[ai][bj][m][1];
                    u32x4 w; w.x = cvt_pk_bf16(v0[0], v0[1]); w.y = cvt_pk_bf16(v0[2], v0[3]); w.z = cvt_pk_bf16(v1[0], v1[1]); w.w = cvt_pk_bf16(v1[2], v1[3]);
                    *(u32x4*)(rowp + bj * HALF) = w; } }
    }
};

struct EpiNone {
    static constexpr bool PERM = true, AFTER_DRAIN = false;
    __device__ __forceinline__ void operator()(const f32x4 (&acc)[2][2][4][2], const Unit& u, int wr, int wc, int fr, int fq, PG8_LAS unsigned char*) const {
#pragma unroll
        for (int ai = 0; ai < 2; ++ai)
#pragma unroll
            for (int bj = 0; bj < 2; ++bj)
#pragma unroll
                for (int m = 0; m < 4; ++m)
#pragma unroll
                    for (int n = 0; n < 2; ++n) asm volatile("" :: "v"(acc[ai][bj][m][n]));
    }
};
struct EpiResA {
    static constexpr bool PERM = true, AFTER_DRAIN = false;
    const float* R; bf16_t* XB; float* slab;
    __device__ __forceinline__ void operator()(const f32x4 (&acc)[2][2][4][2], const Unit& u, int wr, int wc, int fr_, int fq_, PG8_LAS unsigned char*) const {
        int t_ = threadIdx.x; asm volatile("" : "+v"(t_));
        const int fr = t_ & 15, fq = (t_ >> 4) & 3;
        const int row0 = u.pm * BM + wr * 64 + fr, col0 = u.pn * BM + wc * 32 + 8 * fq;
#pragma unroll
        for (int ai = 0; ai < 2; ++ai) {
            f32x4 r[4][2][2];
#pragma unroll
            for (int m = 0; m < 4; ++m)
#pragma unroll
                for (int bj = 0; bj < 2; ++bj) { const float* p = R + (size_t)(row0 + ai * HALF + m * 16) * DM + col0 + bj * HALF; r[m][bj][0] = *(const f32x4*)p; r[m][bj][1] = *(const f32x4*)(p + 4); }
#pragma unroll
            for (int m = 0; m < 4; ++m) { const int row = row0 + ai * HALF + m * 16; float ss = 0.f;
#pragma unroll
                for (int bj = 0; bj < 2; ++bj) { const f32x4 v0 = acc[ai][bj][m][0] + r[m][bj][0], v1 = acc[ai][bj][m][1] + r[m][bj][1];
                    u32x4 w; w.x = cvt_pk_bf16(v0[0], v0[1]); w.y = cvt_pk_bf16(v0[2], v0[3]); w.z = cvt_pk_bf16(v1[0], v1[1]); w.w = cvt_pk_bf16(v1[2], v1[3]);
                    *(u32x4*)(XB + (size_t)row * DM + col0 + bj * HALF) = w;
                    ss += (v0[0] * v0[0] + v0[1] * v0[1]) + (v0[2] * v0[2] + v0[3] * v0[3]) + (v1[0] * v1[0] + v1[1] * v1[1]) + (v1[2] * v1[2] + v1[3] * v1[3]); }
                ss += __shfl_xor(ss, 16); ss += __shfl_xor(ss, 32);
                if (fq == 0) slab[(size_t)row * 32 + u.pn * 4 + wc] = ss; }
            asm volatile("" ::: "memory"); }
    }
};
struct EpiResB {
    static constexpr bool PERM = true, AFTER_DRAIN = false;
    const bf16_t* RB; float* X; float* slab;
    __device__ __forceinline__ void operator()(const f32x4 (&acc)[2][2][4][2], const Unit& u, int wr, int wc, int fr_, int fq_, PG8_LAS unsigned char*) const {
        int t_ = threadIdx.x; asm volatile("" : "+v"(t_));
        const int fr = t_ & 15, fq = (t_ >> 4) & 3;
        const int row0 = u.pm * BM + wr * 64 + fr, col0 = u.pn * BM + wc * 32 + 8 * fq;
        u32x4 r[2][4][2];
#pragma unroll
        for (int ai = 0; ai < 2; ++ai)
#pragma unroll
            for (int m = 0; m < 4; ++m)
#pragma unroll
                for (int bj = 0; bj < 2; ++bj) r[ai][m][bj] = *(const u32x4*)(RB + (size_t)(row0 + ai * HALF + m * 16) * DM + col0 + bj * HALF);
#pragma unroll
        for (int ai = 0; ai < 2; ++ai)
#pragma unroll
            for (int m = 0; m < 4; ++m) { const int row = row0 + ai * HALF + m * 16; float ss = 0.f;
#pragma unroll
                for (int bj = 0; bj < 2; ++bj) { const u32x4 q = r[ai][m][bj];
                    const f32x4 r0 = {__builtin_bit_cast(float, q.x << 16), __builtin_bit_cast(float, q.x & 0xffff0000u), __builtin_bit_cast(float, q.y << 16), __builtin_bit_cast(float, q.y & 0xffff0000u)};
                    const f32x4 r1 = {__builtin_bit_cast(float, q.z << 16), __builtin_bit_cast(float, q.z & 0xffff0000u), __builtin_bit_cast(float, q.w << 16), __builtin_bit_cast(float, q.w & 0xffff0000u)};
                    const f32x4 v0 = acc[ai][bj][m][0] + r0, v1 = acc[ai][bj][m][1] + r1;
                    float* xp = X + (size_t)row * DM + col0 + bj * HALF; *(f32x4*)xp = v0; *(f32x4*)(xp + 4) = v1;
                    ss += (v0[0] * v0[0] + v0[1] * v0[1]) + (v0[2] * v0[2] + v0[3] * v0[3]) + (v1[0] * v1[0] + v1[1] * v1[1]) + (v1[2] * v1[2] + v1[3] * v1[3]); }
                ss += __shfl_xor(ss, 16); ss += __shfl_xor(ss, 32);
                if (fq == 0) slab[(size_t)row * 32 + u.pn * 4 + wc] = ss; }
    }
};

__device__ __forceinline__ float dpp_shr1(float old, float src) { return __builtin_bit_cast(float, __builtin_amdgcn_update_dpp(__builtin_bit_cast(int, old), __builtin_bit_cast(int, src), 0x111, 0xf, 0xf, false)); }
__device__ __forceinline__ float dpp_shr2(float old, float src) { return __builtin_bit_cast(float, __builtin_amdgcn_update_dpp(__builtin_bit_cast(int, old), __builtin_bit_cast(int, src), 0x112, 0xf, 0xf, false)); }
__device__ __forceinline__ float dpp_ror1(float src) { return __builtin_bit_cast(float, __builtin_amdgcn_update_dpp(0, __builtin_bit_cast(int, src), 0x121, 0xf, 0xf, false)); }
__device__ __forceinline__ float dpp_ror2(float src) { return __builtin_bit_cast(float, __builtin_amdgcn_update_dpp(0, __builtin_bit_cast(int, src), 0x122, 0xf, 0xf, false)); }
constexpr int FF = 5632, FF2 = 11264;
struct EpiAct {
    static constexpr bool PERM = true, AFTER_DRAIN = false;
    bf16_t* ACT; const float* slab; const float* cw; const float* cb; float* ubnd;
    __device__ __forceinline__ void operator()(f32x4 (&acc)[2][2][4][2], const Unit& u, int wr, int wc, int fr_, int fq_, PG8_LAS unsigned char* xlds) const {
        int t_ = threadIdx.x; asm volatile("" : "+v"(t_));
        const int fr = t_ & 15, fq = (t_ >> 4) & 3;
        const int row0 = u.pm * BM + wr * 64 + fr, cl = wc * 32 + 8 * fq;
#pragma unroll
        for (int ai = 0; ai < 2; ++ai)
#pragma unroll
            for (int m = 0; m < 4; ++m) { const int rg = row0 + ai * HALF + m * 16;
                const f32x4 pa = *(const f32x4*)(slab + (size_t)rg * 32 + 8 * fq), pb = *(const f32x4*)(slab + (size_t)rg * 32 + 8 * fq + 4);
                float s = ((pa[0] + pa[1]) + (pa[2] + pa[3])) + ((pb[0] + pb[1]) + (pb[2] + pb[3]));
                s += __shfl_xor(s, 16); s += __shfl_xor(s, 32);
                const float rstd = 1.0f / sqrtf(s * (1.0f / DM) + RMS_EPS);
#pragma unroll
                for (int bj = 0; bj < 2; ++bj)
#pragma unroll
                    for (int n = 0; n < 2; ++n) acc[ai][bj][m][n] = acc[ai][bj][m][n] * rstd; }
        if (fr >= 14) {
#pragma unroll
            for (int ai = 0; ai < 2; ++ai)
#pragma unroll
                for (int bj = 0; bj < 2; ++bj)
#pragma unroll
                    for (int n = 0; n < 2; ++n) *(PG8_LAS f32x4*)(xlds + ((((2 * ai + wr) * 2 + (fr - 14)) * 256 + 128 * bj + cl + 4 * n) << 2)) = acc[ai][bj][3][n];
            if (wr == 1) {
#pragma unroll
                for (int bj = 0; bj < 2; ++bj)
#pragma unroll
                    for (int n = 0; n < 2; ++n) *(f32x4*)(ubnd + (size_t)(u.pm * 4 + 2 + (fr - 14)) * FF2 + u.pn * BM + 128 * bj + cl + 4 * n) = acc[1][bj][3][n]; }
        }
        if (wr == 0 && fr < 2) {
#pragma unroll
            for (int bj = 0; bj < 2; ++bj)
#pragma unroll
                for (int n = 0; n < 2; ++n) *(f32x4*)(ubnd + (size_t)(u.pm * 4 + fr) * FF2 + u.pn * BM + 128 * bj + cl + 4 * n) = acc[0][bj][0][n]; }
        asm volatile("s_waitcnt lgkmcnt(0)" ::: "memory"); __builtin_amdgcn_s_barrier(); asm volatile("" ::: "memory");
        const int c0 = u.pn * 128 + cl;
        u32x2 hold[2][4];
#pragma unroll
        for (int n = 0; n < 2; ++n) {
            const f32x4 gw0 = *(const f32x4*)(cw + c0 + 4 * n), gw1 = *(const f32x4*)(cw + FF2 + c0 + 4 * n), gw2 = *(const f32x4*)(cw + 2 * FF2 + c0 + 4 * n), gb = *(const f32x4*)(cb + c0 + 4 * n);
            const f32x4 vw0 = *(const f32x4*)(cw + FF + c0 + 4 * n), vw1 = *(const f32x4*)(cw + FF2 + FF + c0 + 4 * n), vw2 = *(const f32x4*)(cw + 2 * FF2 + FF + c0 + 4 * n), vb = *(const f32x4*)(cb + FF + c0 + 4 * n);
#pragma unroll
            for (int ai = 0; ai < 2; ++ai) {
                const int chunk = 2 * ai + wr;
                f32x4 pg = {0.f, 0.f, 0.f, 0.f}, pv = {0.f, 0.f, 0.f, 0.f};
                if (chunk > 0) { const PG8_LAS unsigned char* bp = xlds + ((((chunk - 1) * 2 + (fr & 1)) * 256 + cl + 4 * n) << 2);
                    pg = *(const PG8_LAS f32x4*)bp; pv = *(const PG8_LAS f32x4*)(bp + 512); }
#pragma unroll
                for (int m = 0; m < 4; ++m) {
                    const f32x4 cg = acc[ai][0][m][n], cv = acc[ai][1][m][n]; float a[4];
#pragma unroll
                    for (int j = 0; j < 4; ++j) {
                        const float g1 = dpp_shr1(dpp_ror1(pg[j]), cg[j]), g2 = dpp_shr2(dpp_ror2(pg[j]), cg[j]);
                        const float v1 = dpp_shr1(dpp_ror1(pv[j]), cv[j]), v2 = dpp_shr2(dpp_ror2(pv[j]), cv[j]);
                        const float G = gw2[j] * cg[j] + (gw1[j] * g1 + (gw0[j] * g2 + gb[j]));
                        const float V = vw2[j] * cv[j] + (vw1[j] * v1 + (vw0[j] * v2 + vb[j]));
                        a[j] = G * __builtin_amdgcn_rcpf(1.0f + __builtin_amdgcn_exp2f(-1.4426950408889634f * G)) * V; }
                    u32x2 w; w.x = cvt_pk_bf16(a[0], a[1]); w.y = cvt_pk_bf16(a[2], a[3]);
                    if (n == 0) hold[ai][m] = w;
                    else { u32x4 o; o.x = hold[ai][m].x; o.y = hold[ai][m].y; o.z = w.x; o.w = w.y;
                        *(u32x4*)(ACT + (size_t)(row0 + ai * HALF + m * 16) * FF + c0) = o; }
                    pg = cg; pv = cv;
                }
            }
        }
    }
};

template <class Epi, class Sched, bool ALIGN_EPI = false, bool SP2 = false>
__device__ __forceinline__ void gemm_phase(PG8_LAS unsigned char* lds, const Gemm g, const Sched& S, const Epi& E, PG8_LAS unsigned char* xlds) {
    const int tid = threadIdx.x, wid = __builtin_amdgcn_readfirstlane(tid >> 6), lane = tid & 63, wr = wid >> 2, wc = wid & 3, fr = lane & 15, fq = lane >> 4;
    const int K = g.K, nt = K / BK;
    unsigned voffA[2], voffB[2];
#pragma unroll
    for (int i = 0; i < 2; ++i) { int R, C; stage_rc(tid * 16 + i * 8192, R, C); const int Rb = Epi::PERM ? ((R & ~31) + perm32(R & 31)) : R;
        voffA[i] = (unsigned)(R * K + C) * 2u; voffB[i] = (unsigned)(Rb * K + C) * 2u; }
    const size_t kstep = (size_t)(BK * 2);
    const size_t hstep = (size_t)HALF * K * 2;
    const size_t tstep = 2 * hstep;
    const unsigned ldsw = (unsigned)wid * 1024u;
    const int aoff = lds_byte(wr * 64 + fr, fq * 8), boff = lds_byte(wc * 32 + fr, fq * 8);
#define PG8_SA(b, h) (((b) * 2 + (h)) * HTB)
#define PG8_SB(b, h) ((4 + (b) * 2 + (h)) * HTB)
#define PG8_STAGE(bufoff, gbase, voff) do { _Pragma("unroll") for (int _i = 0; _i < 2; ++_i) \
        __builtin_amdgcn_global_load_lds((const unsigned*)((const char*)(gbase) + (voff)[_i]), (PG8_LAS unsigned*)(lds + (bufoff) + ldsw + _i * 8192), 16, 0, 0); } while (0)
#define PG8_LDA(dst, b, h) do { _Pragma("unroll") for (int m = 0; m < 4; ++m) _Pragma("unroll") for (int k = 0; k < 2; ++k) dst[m][k] = *(const PG8_LAS bf16x8*)(lds + PG8_SA(b, h) + aoff + m * 2048 + k * 1024); } while (0)
#define PG8_LDB(dst, b, h) do { _Pragma("unroll") for (int n = 0; n < 2; ++n) _Pragma("unroll") for (int k = 0; k < 2; ++k) dst[n][k] = *(const PG8_LAS bf16x8*)(lds + PG8_SB(b, h) + boff + n * 2048 + k * 1024); } while (0)
#define PG8_MMA(ai, bj, At, Bt) do { __builtin_amdgcn_s_setprio(1); _Pragma("unroll") for (int m = 0; m < 4; ++m) _Pragma("unroll") for (int n = 0; n < 2; ++n) _Pragma("unroll") for (int k = 0; k < 2; ++k) \
        acc[ai][bj][m][n] = __builtin_amdgcn_mfma_f32_16x16x32_bf16(Bt[n][k], At[m][k], acc[ai][bj][m][n], 0, 0, 0); __builtin_amdgcn_s_setprio(0); } while (0)
#define PG8_WAIT_V(n) asm volatile("s_waitcnt vmcnt(" #n ")" ::: "memory")
#define PG8_WAIT_L(n) asm volatile("s_waitcnt lgkmcnt(" #n ")" ::: "memory")
#define PG8_BAR __builtin_amdgcn_s_barrier()
#define PG8_SCHED __builtin_amdgcn_sched_barrier(0)
    Unit cur, nxt; int ui = 0;
    if (!S.next(0, cur)) return;
    f32x4 acc[2][2][4][2];
#pragma unroll
    for (int a = 0; a < 2; ++a)
#pragma unroll
        for (int b = 0; b < 2; ++b)
#pragma unroll
            for (int m = 0; m < 4; ++m)
#pragma unroll
                for (int n = 0; n < 2; ++n) acc[a][b][m][n] = (f32x4){0.f, 0.f, 0.f, 0.f};
    bf16x8 At[4][2], B0[2][2], B1[2][2];
    const char* cA = (const char*)g.A + (size_t)cur.pm * tstep; const char* cB = (const char*)g.Bt + (size_t)cur.pn * tstep;
    S.a_ready(cur);
    if constexpr (SP2) {
        PG8_STAGE(PG8_SB(0, 0), cB, voffB); PG8_STAGE(PG8_SB(0, 1), cB + hstep, voffB); PG8_STAGE(PG8_SA(0, 0), cA, voffA); PG8_STAGE(PG8_SA(0, 1), cA + hstep, voffA);
        if (wr == 1) PG8_BAR;
        PG8_WAIT_V(2); PG8_BAR;
        PG8_STAGE(PG8_SB(1, 0), cB + kstep, voffB); PG8_STAGE(PG8_SA(1, 0), cA + kstep, voffA); PG8_STAGE(PG8_SB(1, 1), cB + hstep + kstep, voffB);
        PG8_WAIT_V(6); PG8_BAR;
    } else {
        PG8_STAGE(PG8_SB(0, 0), cB, voffB); PG8_STAGE(PG8_SA(0, 0), cA, voffA); PG8_STAGE(PG8_SB(0, 1), cB + hstep, voffB); PG8_STAGE(PG8_SA(0, 1), cA + hstep, voffA);
        if (wr == 1) PG8_BAR;
        PG8_WAIT_V(4); PG8_BAR;
        PG8_STAGE(PG8_SB(1, 0), cB + kstep, voffB); PG8_STAGE(PG8_SA(1, 0), cA + kstep, voffA); PG8_STAGE(PG8_SB(1, 1), cB + hstep + kstep, voffB);
        PG8_WAIT_V(6); PG8_BAR;
    }
    for (;;) {
        const bool has_next = S.next(ui + 1, nxt);
        const char* nA = has_next ? (const char*)g.A + (size_t)nxt.pm * tstep : cA; const char* nB = has_next ? (const char*)g.Bt + (size_t)nxt.pn * tstep : cB;
        for (int t = 0; t < nt; t += 2) {
            const bool last = (t == nt - 2);
            const char* a1 = cA + (size_t)(t + 1) * kstep;
            const char* a2 = last ? nA : cA + (size_t)(t + 2) * kstep; const char* b2 = last ? nB : cB + (size_t)(t + 2) * kstep;
            const char* a3 = a2 + kstep; const char* b3 = b2 + kstep;
            if (last && has_next) S.a_ready(nxt);
            if constexpr (SP2) {
            PG8_LDB(B0, 0, 0); PG8_LDB(B1, 0, 1); PG8_SCHED; PG8_LDA(At, 0, 0); PG8_STAGE(PG8_SA(1, 1), a1 + hstep, voffA);
            PG8_WAIT_V(8); PG8_WAIT_L(0); PG8_BAR; PG8_MMA(0, 0, At, B0); PG8_MMA(0, 1, At, B1); PG8_BAR; PG8_SCHED;
            PG8_LDA(At, 0, 1); PG8_STAGE(PG8_SB(0, 0), b2, voffB); PG8_STAGE(PG8_SB(0, 1), b2 + hstep, voffB); PG8_STAGE(PG8_SA(0, 0), a2, voffA);
            PG8_WAIT_V(8); PG8_WAIT_L(0); PG8_BAR; PG8_MMA(1, 0, At, B0); PG8_MMA(1, 1, At, B1); PG8_BAR; PG8_SCHED;
            PG8_LDB(B0, 1, 0); PG8_LDB(B1, 1, 1); PG8_SCHED; PG8_LDA(At, 1, 0); PG8_STAGE(PG8_SA(0, 1), a2 + hstep, voffA);
            PG8_WAIT_V(8); PG8_WAIT_L(0); PG8_BAR; PG8_MMA(0, 0, At, B0); PG8_MMA(0, 1, At, B1); PG8_BAR; PG8_SCHED;
            PG8_LDA(At, 1, 1); PG8_STAGE(PG8_SB(1, 0), b3, voffB); PG8_STAGE(PG8_SB(1, 1), b3 + hstep, voffB); PG8_STAGE(PG8_SA(1, 0), a3, voffA);
            PG8_WAIT_V(8); PG8_WAIT_L(0); PG8_BAR; PG8_MMA(1, 0, At, B0); PG8_MMA(1, 1, At, B1); PG8_BAR; PG8_SCHED;
            } else {
            PG8_LDB(B0, 0, 0); PG8_SCHED; PG8_LDA(At, 0, 0); PG8_STAGE(PG8_SA(1, 1), a1 + hstep, voffA);
            PG8_WAIT_L(8); PG8_BAR; PG8_WAIT_L(0); PG8_MMA(0, 0, At, B0); PG8_BAR; PG8_SCHED;
            PG8_LDB(B1, 0, 1); PG8_STAGE(PG8_SB(0, 0), b2, voffB);
            PG8_BAR; PG8_WAIT_L(0); PG8_MMA(0, 1, At, B1); PG8_BAR;
            PG8_LDA(At, 0, 1); PG8_STAGE(PG8_SA(0, 0), a2, voffA);
            PG8_BAR; PG8_WAIT_L(0); PG8_MMA(1, 0, At, B0); PG8_BAR; PG8_SCHED;
            PG8_STAGE(PG8_SB(0, 1), b2 + hstep, voffB);
            PG8_WAIT_V(6); PG8_BAR; PG8_MMA(1, 1, At, B1); PG8_BAR;
            PG8_LDB(B0, 1, 0); PG8_SCHED; PG8_LDA(At, 1, 0); PG8_STAGE(PG8_SA(0, 1), a2 + hstep, voffA);
            PG8_WAIT_L(8); PG8_BAR; PG8_WAIT_L(0); PG8_MMA(0, 0, At, B0); PG8_BAR; PG8_SCHED;
            PG8_LDB(B1, 1, 1); PG8_STAGE(PG8_SB(1, 0), b3, voffB);
            PG8_BAR; PG8_WAIT_L(0); PG8_MMA(0, 1, At, B1); PG8_BAR;
            PG8_LDA(At, 1, 1); PG8_STAGE(PG8_SA(1, 0), a3, voffA);
            PG8_BAR; PG8_WAIT_L(0); PG8_MMA(1, 0, At, B0); PG8_BAR; PG8_SCHED;
            PG8_STAGE(PG8_SB(1, 1), b3 + hstep, voffB);
            PG8_WAIT_V(6); PG8_BAR; PG8_MMA(1, 1, At, B1); PG8_BAR;
            }
        }
        if constexpr (ALIGN_EPI) { if (wr == 0) PG8_BAR; }
        if constexpr (!Epi::AFTER_DRAIN) { E(acc, cur, wr, wc, fr, fq, xlds); S.done(cur); }
        if (!has_next) break;
#pragma unroll
        for (int a = 0; a < 2; ++a)
#pragma unroll
            for (int b = 0; b < 2; ++b)
#pragma unroll
                for (int m = 0; m < 4; ++m)
#pragma unroll
                    for (int n = 0; n < 2; ++n) acc[a][b][m][n] = (f32x4){0.f, 0.f, 0.f, 0.f};
        cur = nxt; cA = nA; cB = nB; ++ui;
        if constexpr (ALIGN_EPI) { if (wr == 1) PG8_BAR; }
    }
    PG8_WAIT_V(0);
    if constexpr (!ALIGN_EPI) { if (wr == 0) PG8_BAR; }
    PG8_BAR;

#undef PG8_SA
#undef PG8_SB
#undef PG8_STAGE
#undef PG8_LDA
#undef PG8_LDB
#undef PG8_MMA
#undef PG8_WAIT_V
#undef PG8_WAIT_L
#undef PG8_BAR
#undef PG8_SCHED
}
}

#define GAS __attribute__((address_space(1)))
#define LAS __attribute__((address_space(3)))
typedef unsigned short bf16;
typedef float f32x4 __attribute__((ext_vector_type(4)));
typedef short bf16x8 __attribute__((ext_vector_type(8)));
typedef unsigned u32x4 __attribute__((ext_vector_type(4)));
typedef unsigned u32x2 __attribute__((ext_vector_type(2)));

constexpr int NWAVES = 8;
constexpr int SEQ = 16384, DMODEL = 2048, NMEM = 256, DIN = 3584, DCONV = 768, DPOOL = 768, DXATT = 512, DFF = 5632, DFF2 = 11264;
constexpr int PGD = 192;
constexpr float EPS = 1e-6f;
constexpr int LDS_BYTES = 147456;
#ifndef MK_PER_PHASE
#define MK_PER_PHASE 0
#endif
constexpr int NPHASE = 8;
#ifndef PHM
#define PHM 255
#endif
#ifndef USE_CG_SYNC
#define USE_CG_SYNC 0
#endif
#ifndef PROBE_P2
#define PROBE_P2 0
#endif
#ifndef PROBE_SYNC
#define PROBE_SYNC 0
#endif
#ifndef PROBE_GEMM
#define PROBE_GEMM 0
#endif
#ifndef PROBE_N
#define PROBE_N 2048
#endif
#ifndef REPM
#define REPM 0
#endif

constexpr size_t MiB = 1u << 20;
constexpr size_t WS_KB = 1 * MiB;
constexpr size_t WS_VT = 1 * MiB + 256 * 1024;
constexpr size_t WS_POOLWT = 1 * MiB + 512 * 1024;
constexpr size_t WS_MB = 2 * MiB;
constexpr size_t WS_WKVT = 3 * MiB;
constexpr size_t WS_SLAB1 = 8 * MiB;
constexpr size_t WS_SLAB2 = 10 * MiB;
constexpr size_t WS_WUPT = 12 * MiB;
constexpr size_t WS_WDOWNT = 56 * MiB;
constexpr size_t WS_UBND = 80 * MiB;
constexpr size_t WS_X1B = 96 * MiB;
constexpr size_t WS_ACT = 160 * MiB;
constexpr size_t WS_H = 160 * MiB;
constexpr size_t WS_Z = 225 * MiB;
constexpr size_t WS_ZPAD = WS_Z - (size_t)16 * 3584 * 2;
constexpr size_t WS_MIX = 338 * MiB;
constexpr size_t WS_WINT = 402 * MiB;
constexpr size_t WS_WOUTT = 416 * MiB;
constexpr size_t WS_END = 424 * MiB;

__device__ __forceinline__ unsigned f2bf(float f) { unsigned u = __builtin_bit_cast(unsigned, f); return (u + 0x7fffu + ((u >> 16) & 1u)) >> 16; }
__device__ __forceinline__ unsigned pk2(float lo, float hi) { return f2bf(lo) | (f2bf(hi) << 16); }
__device__ __forceinline__ float bflo(unsigned w) { return __builtin_bit_cast(float, w << 16); }
__device__ __forceinline__ float bfhi(unsigned w) { return __builtin_bit_cast(float, w & 0xffff0000u); }
__device__ __forceinline__ void unpack8(const u32x4 w, float (&f)[8]) { f[0] = bflo(w.x); f[1] = bfhi(w.x); f[2] = bflo(w.y); f[3] = bfhi(w.y); f[4] = bflo(w.z); f[5] = bfhi(w.z); f[6] = bflo(w.w); f[7] = bfhi(w.w); }
__device__ __forceinline__ u32x4 pack8(const float (&f)[8]) { u32x4 w; w.x = pk2(f[0], f[1]); w.y = pk2(f[2], f[3]); w.z = pk2(f[4], f[5]); w.w = pk2(f[6], f[7]); return w; }
__device__ __forceinline__ float wave_sum(float v) {
#pragma unroll
    for (int o = 1; o < 64; o <<= 1) v += __shfl_xor(v, o);
    return v;
}
#define LDS_WAIT() asm volatile("s_waitcnt lgkmcnt(0)" ::: "memory")

typedef GAS unsigned gu32;
constexpr size_t WS_CTL = 0, CTL_ZERO_BYTES = 64 * 1024;
constexpr int MISC_OFF = 131072 + 320;
constexpr int XLDS_OFF = 131072 + 1024;
#define XB_TMO      128
#define XB_XCNT(j)  (256  + 64 * (j))
#define XB_XSUB(j)  (1280 + 64 * (j))
#define XB_XGEN(j)  (2304 + 64 * (j))
#define XB_TOP      3328
#define XB_TOPGEN   3392
#define XCD_BAR_WORDS 3456
#define XB_SPIN_CAP (1u << 18)

__device__ __forceinline__ unsigned xb_ld(unsigned* p)              { return __hip_atomic_load(p, __ATOMIC_RELAXED, __HIP_MEMORY_SCOPE_AGENT); }
__device__ __forceinline__ unsigned xb_add(unsigned* p, unsigned v) { return __hip_atomic_fetch_add(p, v, __ATOMIC_RELAXED, __HIP_MEMORY_SCOPE_AGENT); }
__device__ __forceinline__ unsigned xb_xcc_id() { return (unsigned)__builtin_amdgcn_s_getreg((3 << 11) | 20) & 0xFu; }
#define XB_SPIN(cond, bar) do { unsigned _sp = 0; while (cond) { __builtin_amdgcn_s_sleep(1); \
    if ((++_sp & 255u) == 0u) { if (xb_ld(&(bar)[XB_TMO])) break; if (_sp > XB_SPIN_CAP) { atomicAdd(&(bar)[XB_TMO], 1u); break; } } } } while (0)

struct XcdBarrier {
    unsigned* bar; unsigned x;
    volatile LAS unsigned* st;
};

__device__ __forceinline__ XcdBarrier xcd_barrier_post(unsigned* bar, volatile LAS unsigned* st) {
    XcdBarrier b; b.bar = bar; b.x = xb_xcc_id(); b.st = st;
    if (threadIdx.x == 0) (void)xb_add(&bar[XB_XCNT(b.x)], 1u);
    return b;
}
__device__ __forceinline__ void xcd_barrier_complete(unsigned* bar, unsigned x, unsigned& nloc, unsigned& nx) {
    const unsigned G = gridDim.x * gridDim.y * gridDim.z;
    unsigned sum, cnt, mine, sp = 0u;
    for (;;) {
        sum = 0u; cnt = 0u; mine = 0u;
#pragma unroll
        for (unsigned j = 0; j < 16; ++j) { const unsigned c = xb_ld(&bar[XB_XCNT(j)]); sum += c; cnt += (c > 0u) ? 1u : 0u; mine = (j == x) ? c : mine; }
        if (sum == G) break;
        __builtin_amdgcn_s_sleep(1);
        if ((++sp & 255u) == 0u) { if (xb_ld(&bar[XB_TMO])) break; if (sp > XB_SPIN_CAP) { atomicAdd(&bar[XB_TMO], 1u); break; } }
    }
    nloc = mine > 0u ? mine : 1u; nx = cnt > 0u ? cnt : 1u;
}

__device__ __forceinline__ void xcd_barrier(const XcdBarrier& b) {
    asm volatile("s_waitcnt vmcnt(0)" ::: "memory");
    __syncthreads();
    if (threadIdx.x == 0) {
        unsigned* bar = b.bar;
        __builtin_amdgcn_s_waitcnt(0);
        unsigned nloc = b.st[0], nx = b.st[1];
        if (nloc == 0u) { xcd_barrier_complete(bar, b.x, nloc, nx); b.st[0] = nloc; b.st[1] = nx; }
        const unsigned old = xb_add(&bar[XB_XSUB(b.x)], 1u);
        const unsigned gen = old / nloc;
        if (old + 1u == (gen + 1u) * nloc) {
            __builtin_amdgcn_fence(__ATOMIC_RELEASE, "agent");
            asm volatile("s_waitcnt vmcnt(0)" ::: "memory");
            const unsigned og = xb_add(&bar[XB_TOP], 1u);
            const unsigned tg = og / nx;
            if (og + 1u == (tg + 1u) * nx) xb_add(&bar[XB_TOPGEN], 1u);
            else XB_SPIN(xb_ld(&bar[XB_TOPGEN]) == tg, bar);
            __builtin_amdgcn_fence(__ATOMIC_ACQUIRE, "agent");
            xb_add(&bar[XB_XGEN(b.x)], 1u);
            asm volatile("s_waitcnt vmcnt(0)" ::: "memory");
        } else {
            XB_SPIN(xb_ld(&bar[XB_XGEN(b.x)]) == gen, bar);
            __builtin_amdgcn_fence(__ATOMIC_ACQUIRE, "agent");
            asm volatile("s_waitcnt vmcnt(0)" ::: "memory");
        }
    }
    __syncthreads();
}


template <bool UPMAP> __device__ __forceinline__ void p0_transpose_item(const float* W, int K, int N, bf16* WT, const float* ks, LAS float* scr, int item, int lane) {
    const int nblk = N / 64, kb = item / nblk, nb = item % nblk, k0 = 64 * kb, n0 = 64 * nb;
    const int r0 = !UPMAP ? n0 : (n0 < DFF ? 256 * (n0 / 128) + (n0 % 128) : 256 * ((n0 - DFF) / 128) + 128 + ((n0 - DFF) % 128));
    f32x4 v[16];
    const float* src = W + (size_t)(k0 + (lane >> 4)) * N + n0 + 4 * (lane & 15);
#pragma unroll
    for (int i = 0; i < 16; ++i) v[i] = *(const f32x4*)(src + (size_t)(4 * i) * N);
#pragma unroll
    for (int i = 0; i < 16; ++i) { f32x4 t = v[i]; if (ks) t = t * ks[k0 + 4 * i + (lane >> 4)];
        *(LAS f32x4*)(scr + (4 * i + (lane >> 4)) * 64 + (((lane & 15) ^ ((i >> 1) & 7)) << 2)) = t; }
    LDS_WAIT(); asm volatile("" ::: "memory");
    const int c = lane & 7;
#pragma unroll
    for (int j = 0; j < 8; ++j) { const int nn = (lane >> 3) + 8 * j; const LAS float* sp = scr + (8 * c) * 64 + ((((nn >> 2) ^ c) & 15) << 2) + (nn & 3);
        u32x4 o; o.x = pk2(sp[0 * 64], sp[1 * 64]); o.y = pk2(sp[2 * 64], sp[3 * 64]); o.z = pk2(sp[4 * 64], sp[5 * 64]); o.w = pk2(sp[6 * 64], sp[7 * 64]);
        *(u32x4*)(WT + (size_t)(r0 + nn) * K + k0 + 8 * c) = o; }
    LDS_WAIT(); asm volatile("" ::: "memory");
}
__device__ __forceinline__ void rms_rows2_to_bf16(const float* xa, const float* xb, const float* g, bf16* oa, bf16* ob, int lane) {
    const f32x4* pa = (const f32x4*)xa + lane; const f32x4* pb = (const f32x4*)xb + lane; const f32x4* gr = (const f32x4*)g + lane;
    f32x4 va[8], vb[8]; float sa = 0.f, sb = 0.f;
#pragma unroll
    for (int j = 0; j < 8; ++j) { va[j] = pa[64 * j]; vb[j] = pb[64 * j]; }
#pragma unroll
    for (int j = 0; j < 8; ++j) { sa += (va[j].x * va[j].x + va[j].y * va[j].y) + (va[j].z * va[j].z + va[j].w * va[j].w); sb += (vb[j].x * vb[j].x + vb[j].y * vb[j].y) + (vb[j].z * vb[j].z + vb[j].w * vb[j].w); }
    const float ra = 1.0f / sqrtf(wave_sum(sa) * (1.0f / DMODEL) + EPS), rb = 1.0f / sqrtf(wave_sum(sb) * (1.0f / DMODEL) + EPS);
    u32x2* qa = (u32x2*)oa + lane; u32x2* qb = (u32x2*)ob + lane;
#pragma unroll
    for (int j = 0; j < 8; ++j) { const f32x4 gg = gr[64 * j]; u32x2 w;
        w.x = pk2(va[j].x * ra * gg.x, va[j].y * ra * gg.y); w.y = pk2(va[j].z * ra * gg.z, va[j].w * ra * gg.w); qa[64 * j] = w;
        w.x = pk2(vb[j].x * rb * gg.x, vb[j].y * rb * gg.y); w.y = pk2(vb[j].z * rb * gg.z, vb[j].w * rb * gg.w); qb[64 * j] = w; }
}

struct Ptrs {
    const float *x, *mem, *g_mix, *g_mem, *w_in, *conv_w, *pool_w, *pool_scale, *w_kv, *w_out, *g_ffn, *w_up, *ffn_conv_w, *ffn_conv_b, *w_down, *g_final;
    float* out; unsigned char* ws;
};

__device__ __forceinline__ void p0_prologue(const Ptrs& P, LAS unsigned char* lds, int gw, int NGW, int wave, int lane) {
    LAS float* scr = (LAS float*)(lds + wave * 16384);
    unsigned char* ws = P.ws;
    constexpr int I_IN = (DMODEL / 64) * (DIN / 64), I_OUT = (DMODEL / 64) * (DMODEL / 64), I_UP = (DMODEL / 64) * (DFF2 / 64), I_DN = (DFF / 64) * (DMODEL / 64),
                  I_KV = (DMODEL / 64) * (1024 / 64), I_PW = (PGD / 64) * (PGD / 64);
    constexpr int NITEMS = I_IN + I_OUT + I_UP + I_DN + I_KV + 4 * I_PW;
    for (int it = gw; it < NITEMS; it += NGW) {
        int r = it;
        if (r < I_IN) { p0_transpose_item<false>(P.w_in, DMODEL, DIN, (bf16*)(ws + WS_WINT), nullptr, scr, r, lane); continue; } r -= I_IN;
        if (r < I_OUT) { p0_transpose_item<false>(P.w_out, DMODEL, DMODEL, (bf16*)(ws + WS_WOUTT), nullptr, scr, r, lane); continue; } r -= I_OUT;
        if (r < I_UP) { p0_transpose_item<true>(P.w_up, DMODEL, DFF2, (bf16*)(ws + WS_WUPT), P.g_ffn, scr, r, lane); continue; } r -= I_UP;
        if (r < I_DN) { p0_transpose_item<false>(P.w_down, DFF, DMODEL, (bf16*)(ws + WS_WDOWNT), nullptr, scr, r, lane); continue; } r -= I_DN;
        if (r < I_KV) { p0_transpose_item<false>(P.w_kv, DMODEL, 1024, (bf16*)(ws + WS_WKVT), nullptr, scr, r, lane); continue; } r -= I_KV;
        const int g = r / I_PW; r -= g * I_PW;
        p0_transpose_item<false>(P.pool_w + (size_t)g * PGD * PGD, PGD, PGD, (bf16*)(ws + WS_POOLWT) + (size_t)g * PGD * PGD, nullptr, scr, r, lane);
    }
    for (int i = gw * 64 + lane; i < 16 * DIN * 2 / 16; i += NGW * 64) ((u32x4*)(ws + WS_ZPAD))[i] = (u32x4){0u, 0u, 0u, 0u};
    for (int m = 2 * gw; m < SEQ; m += 2 * NGW) rms_rows2_to_bf16(P.x + (size_t)m * DMODEL, P.x + (size_t)(m + 1) * DMODEL, P.g_mix, (bf16*)(ws + WS_H) + (size_t)m * DMODEL, (bf16*)(ws + WS_H) + (size_t)(m + 1) * DMODEL, lane);
    for (int m = 2 * gw; m < NMEM; m += 2 * NGW) rms_rows2_to_bf16(P.mem + (size_t)m * DMODEL, P.mem + (size_t)(m + 1) * DMODEL, P.g_mem, (bf16*)(ws + WS_MB) + (size_t)m * DMODEL, (bf16*)(ws + WS_MB) + (size_t)(m + 1) * DMODEL, lane);
}

__device__ __forceinline__ void kv_tile(const Ptrs& P, int tt, int lane) {
    const bf16* mB = (const bf16*)(P.ws + WS_MB); const bf16* wT = (const bf16*)(P.ws + WS_WKVT);
    const int rb = tt >> 6, cb = tt & 63, fr = lane & 15, fq = lane >> 4;
    const bf16* ap = mB + (size_t)(16 * rb + fr) * DMODEL + 8 * fq; const bf16* wp = wT + (size_t)(16 * cb + fr) * DMODEL + 8 * fq;
    f32x4 acc = {0.f, 0.f, 0.f, 0.f};
    if (cb < 32) {
#pragma unroll 8
        for (int ks = 0; ks < 64; ++ks) { const bf16x8 a = *(const bf16x8*)(ap + 32 * ks), w = *(const bf16x8*)(wp + 32 * ks); acc = __builtin_amdgcn_mfma_f32_16x16x32_bf16(w, a, acc, 0, 0, 0); }
        u32x2 o; o.x = pk2(acc[0], acc[1]); o.y = pk2(acc[2], acc[3]);
        *(u32x2*)((bf16*)(P.ws + WS_KB) + (size_t)(16 * rb + fr) * 512 + 16 * cb + 4 * fq) = o;
    } else {
#pragma unroll 8
        for (int ks = 0; ks < 64; ++ks) { const bf16x8 a = *(const bf16x8*)(ap + 32 * ks), w = *(const bf16x8*)(wp + 32 * ks); acc = __builtin_amdgcn_mfma_f32_16x16x32_bf16(a, w, acc, 0, 0, 0); }
        u32x2 o; o.x = pk2(acc[0], acc[1]); o.y = pk2(acc[2], acc[3]);
        *(u32x2*)((bf16*)(P.ws + WS_VT) + (size_t)(16 * cb - 512 + fr) * 256 + 32 * (rb >> 1) + 8 * fq + 4 * (rb & 1)) = o;
    }
}

__device__ __forceinline__ void mix_conv_task(const Ptrs& P, int blk, int lane) {
    const bf16* z = (const bf16*)(P.ws + WS_Z); bf16* mix = (bf16*)(P.ws + WS_MIX);
    const int t0 = blk * 16;
    for (int cg = lane; cg < DCONV / 8; cg += 64) {
        const int c = cg * 8;
        float w0[8], w1[8], w2[8], p1[8], p2[8];
#pragma unroll
        for (int e = 0; e < 8; ++e) { w0[e] = P.conv_w[c + e]; w1[e] = P.conv_w[DCONV + c + e]; w2[e] = P.conv_w[2 * DCONV + c + e]; }
        { float a[8], b[8]; unpack8(*(const u32x4*)(z + (long)(t0 - 2) * DIN + DCONV + c), a); unpack8(*(const u32x4*)(z + (long)(t0 - 2) * DIN + 2 * DCONV + c), b);
#pragma unroll
          for (int e = 0; e < 8; ++e) p2[e] = a[e] * b[e];
          unpack8(*(const u32x4*)(z + (long)(t0 - 1) * DIN + DCONV + c), a); unpack8(*(const u32x4*)(z + (long)(t0 - 1) * DIN + 2 * DCONV + c), b);
#pragma unroll
          for (int e = 0; e < 8; ++e) p1[e] = a[e] * b[e]; }
#pragma unroll 4
        for (int r = 0; r < 16; ++r) {
            const int t = t0 + r; float p[8], a[8], b[8], g[8], o[8];
            unpack8(*(const u32x4*)(z + (size_t)t * DIN + DCONV + c), a); unpack8(*(const u32x4*)(z + (size_t)t * DIN + 2 * DCONV + c), b); unpack8(*(const u32x4*)(z + (size_t)t * DIN + c), g);
#pragma unroll
            for (int e = 0; e < 8; ++e) { p[e] = a[e] * b[e]; o[e] = g[e] * (w2[e] * p[e] + w1[e] * p1[e] + w0[e] * p2[e]); p2[e] = p1[e]; p1[e] = p[e]; }
            *(u32x4*)(mix + (size_t)t * DMODEL + c) = pack8(o);
        }
    }
}
template <int g> __device__ __forceinline__ void mix_pool_task(const Ptrs& P, int blk, int lane) {
    constexpr int k = 2 << g;
    const char* zu = (const char*)((const bf16*)(P.ws + WS_Z) + (size_t)(blk * 16) * DIN + 3 * DCONV + PGD * g);
    const char* wu = (const char*)((const bf16*)(P.ws + WS_POOLWT) + (size_t)g * PGD * PGD);
    bf16* mix = (bf16*)(P.ws + WS_MIX);
    const int fr = lane & 15, fq = lane >> 4, t = blk * 16 + fr;
    const unsigned zl = (unsigned)(fr * DIN + 8 * fq) * 2u, wl = (unsigned)(fr * PGD + 8 * fq) * 2u;
    const int cnt = (t + 1 < k) ? t + 1 : k; const float inv = 1.0f / (float)cnt;
    f32x4 acc[12];
#pragma unroll
    for (int n = 0; n < 12; ++n) acc[n] = (f32x4){0.f, 0.f, 0.f, 0.f};
#pragma unroll 1
    for (int ks = 0; ks < 6; ++ks) {
        float sum[8], self[8];
        unpack8(*(const u32x4*)(zu + ks * 64 + zl), self);
#pragma unroll
        for (int e = 0; e < 8; ++e) sum[e] = self[e];
#pragma unroll
        for (int j = 1; j < k; ++j) { float v[8]; unpack8(*(const u32x4*)(zu + ks * 64 - (long)j * (DIN * 2) + zl), v);
#pragma unroll
            for (int e = 0; e < 8; ++e) sum[e] += v[e]; }
        float pl[8];
#pragma unroll
        for (int e = 0; e < 8; ++e) pl[e] = sum[e] * inv - self[e];
        const bf16x8 pf = __builtin_bit_cast(bf16x8, pack8(pl));
#pragma unroll
        for (int n = 0; n < 12; ++n) { const bf16x8 wf = *(const bf16x8*)(wu + n * (16 * PGD * 2) + ks * 64 + wl); acc[n] = __builtin_amdgcn_mfma_f32_16x16x32_bf16(wf, pf, acc[n], 0, 0, 0); }
    }
#pragma unroll
    for (int n = 0; n < 12; ++n) { const int d = 16 * n + 4 * fq; const f32x4 sc = *(const f32x4*)(P.pool_scale + PGD * g + d);
        u32x2 o; o.x = pk2(acc[n][0] * sc[0], acc[n][1] * sc[1]); o.y = pk2(acc[n][2] * sc[2], acc[n][3] * sc[3]);
        *(u32x2*)(mix + (size_t)t * DMODEL + DCONV + PGD * g + d) = o; }
}
__device__ __forceinline__ void mix_attn_task(const Ptrs& P, int h, int blk, int lane) {
    const bf16* z = (const bf16*)(P.ws + WS_Z); bf16* mix = (bf16*)(P.ws + WS_MIX); const bf16* Kb = (const bf16*)(P.ws + WS_KB); const bf16* Vt = (const bf16*)(P.ws + WS_VT);
    const int fr = lane & 15, fq = lane >> 4, t = blk * 16 + fr;
    bf16x8 qf[4];
#pragma unroll
    for (int ks = 0; ks < 4; ++ks) qf[ks] = *(const bf16x8*)(z + (size_t)t * DIN + 3 * DCONV + DPOOL + 128 * h + 32 * ks + 8 * fq);
    f32x4 s[16];
#pragma unroll
    for (int kb = 0; kb < 16; ++kb) { s[kb] = (f32x4){0.f, 0.f, 0.f, 0.f};
#pragma unroll
        for (int ks = 0; ks < 4; ++ks) { const bf16x8 kf = *(const bf16x8*)(Kb + (size_t)(16 * kb + fr) * 512 + 128 * h + 32 * ks + 8 * fq); s[kb] = __builtin_amdgcn_mfma_f32_16x16x32_bf16(kf, qf[ks], s[kb], 0, 0, 0); } }
    float mx = -3.0e38f;
#pragma unroll
    for (int kb = 0; kb < 16; ++kb) mx = fmaxf(fmaxf(fmaxf(s[kb][0], s[kb][1]), fmaxf(s[kb][2], s[kb][3])), mx);
    mx = fmaxf(mx, __shfl_xor(mx, 16)); mx = fmaxf(mx, __shfl_xor(mx, 32));
    const float c2 = 0.08838834764831845f * 1.4426950408889634f;
    float sum = 0.f;
#pragma unroll
    for (int kb = 0; kb < 16; ++kb)
#pragma unroll
        for (int r = 0; r < 4; ++r) { const float p = __builtin_amdgcn_exp2f((s[kb][r] - mx) * c2); s[kb][r] = p; sum += p; }
    sum += __shfl_xor(sum, 16); sum += __shfl_xor(sum, 32);
    const float inv = 1.0f / sum;
    f32x4 o[8];
#pragma unroll
    for (int db = 0; db < 8; ++db) o[db] = (f32x4){0.f, 0.f, 0.f, 0.f};
#pragma unroll
    for (int ks = 0; ks < 8; ++ks) {
        u32x4 pw; pw.x = pk2(s[2 * ks][0], s[2 * ks][1]); pw.y = pk2(s[2 * ks][2], s[2 * ks][3]); pw.z = pk2(s[2 * ks + 1][0], s[2 * ks + 1][1]); pw.w = pk2(s[2 * ks + 1][2], s[2 * ks + 1][3]);
        const bf16x8 pf = __builtin_bit_cast(bf16x8, pw);
#pragma unroll
        for (int db = 0; db < 8; ++db) { const bf16x8 vf = *(const bf16x8*)(Vt + (size_t)(128 * h + 16 * db + fr) * 256 + 32 * ks + 8 * fq); o[db] = __builtin_amdgcn_mfma_f32_16x16x32_bf16(vf, pf, o[db], 0, 0, 0); }
    }
#pragma unroll
    for (int db = 0; db < 8; ++db) { u32x2 w; w.x = pk2(o[db][0] * inv, o[db][1] * inv); w.y = pk2(o[db][2] * inv, o[db][3] * inv);
        *(u32x2*)(mix + (size_t)t * DMODEL + DCONV + DPOOL + 128 * h + 16 * db + 4 * fq) = w; }
}
template <int R, int C, int PCH> __device__ __forceinline__ void lds_stage_rows(LAS unsigned char* dst, const unsigned char* src, int gp, int tid) {
    constexpr int N = R * C, PER = (N + 511) / 512;
    u32x4 v[PER];
#pragma unroll
    for (int i = 0; i < PER; ++i) { const int idx = tid + 512 * i; if (idx < N) { const int row = idx / C, ch = idx % C; v[i] = *(const u32x4*)(src + (size_t)row * gp + ch * 16); } }
#pragma unroll
    for (int i = 0; i < PER; ++i) { const int idx = tid + 512 * i; if (idx < N) { const int row = idx / C, ch = idx % C; *(LAS u32x4*)(dst + row * (PCH * 16) + (((ch & ~15) | ((ch & 15) ^ (row & 15))) << 4)) = v[i]; } }
}
template <int N> __device__ __forceinline__ float dpp_shrN(float old, float src) { return __builtin_bit_cast(float, __builtin_amdgcn_update_dpp(__builtin_bit_cast(int, old), __builtin_bit_cast(int, src), 0x110 + N, 0xf, 0xf, false)); }
template <int N> __device__ __forceinline__ float dpp_rorN(float src) { return __builtin_bit_cast(float, __builtin_amdgcn_update_dpp(__builtin_bit_cast(int, src), __builtin_bit_cast(int, src), 0x120 + N, 0xf, 0xf, false)); }
template <int N> __device__ __forceinline__ float scan_step(float x, float p) { return x + dpp_shrN<N>(dpp_rorN<N>(p), x); }
template <int N> __device__ __forceinline__ float scan_step_prev(float p) { return p + dpp_shrN<N>(0.f, p); }

__device__ __forceinline__ void mix_attn_wave(const Ptrs& P, LAS unsigned char* ldsK, LAS unsigned char* ldsV, int h, int row0, int lane) {
    const bf16* z = (const bf16*)(P.ws + WS_Z); bf16* mix = (bf16*)(P.ws + WS_MIX);
    const int fr = lane & 15, fq = lane >> 4;
    bf16x8 q0[4], q1[4];
#pragma unroll
    for (int ks = 0; ks < 4; ++ks) { const bf16* qp = z + (size_t)(row0 + fr) * DIN + 3 * DCONV + DPOOL + 128 * h + 32 * ks + 8 * fq; q0[ks] = *(const bf16x8*)qp; q1[ks] = *(const bf16x8*)(qp + 16 * DIN); }
    unsigned offk[4];
#pragma unroll
    for (int ks = 0; ks < 4; ++ks) offk[ks] = (unsigned)(fr * 256 + (((4 * ks + fq) ^ fr) << 4));
    f32x4 s0[16], s1[16];
#pragma unroll
    for (int kb = 0; kb < 16; ++kb) { s0[kb] = (f32x4){0.f, 0.f, 0.f, 0.f}; s1[kb] = (f32x4){0.f, 0.f, 0.f, 0.f};
#pragma unroll
        for (int ks = 0; ks < 4; ++ks) { const bf16x8 kf = *(const LAS bf16x8*)(ldsK + kb * 4096 + offk[ks]);
            s0[kb] = __builtin_amdgcn_mfma_f32_16x16x32_bf16(kf, q0[ks], s0[kb], 0, 0, 0); s1[kb] = __builtin_amdgcn_mfma_f32_16x16x32_bf16(kf, q1[ks], s1[kb], 0, 0, 0); } }
    const float c2 = 0.08838834764831845f * 1.4426950408889634f;
    bf16x8 p0[8], p1[8]; float inv0, inv1;
    {   float mx = -3.0e38f;
#pragma unroll
        for (int kb = 0; kb < 16; ++kb) mx = fmaxf(fmaxf(fmaxf(s0[kb][0], s0[kb][1]), fmaxf(s0[kb][2], s0[kb][3])), mx);
        mx = fmaxf(mx, __shfl_xor(mx, 16)); mx = fmaxf(mx, __shfl_xor(mx, 32));
        float sum = 0.f;
#pragma unroll
        for (int ks = 0; ks < 8; ++ks) { float e[8];
#pragma unroll
            for (int r = 0; r < 4; ++r) { e[r] = __builtin_amdgcn_exp2f((s0[2 * ks][r] - mx) * c2); e[4 + r] = __builtin_amdgcn_exp2f((s0[2 * ks + 1][r] - mx) * c2); }
            sum += ((e[0] + e[1]) + (e[2] + e[3])) + ((e[4] + e[5]) + (e[6] + e[7]));
            p0[ks] = __builtin_bit_cast(bf16x8, pack8(e)); }
        sum += __shfl_xor(sum, 16); sum += __shfl_xor(sum, 32); inv0 = 1.0f / sum; }
    {   float mx = -3.0e38f;
#pragma unroll
        for (int kb = 0; kb < 16; ++kb) mx = fmaxf(fmaxf(fmaxf(s1[kb][0], s1[kb][1]), fmaxf(s1[kb][2], s1[kb][3])), mx);
        mx = fmaxf(mx, __shfl_xor(mx, 16)); mx = fmaxf(mx, __shfl_xor(mx, 32));
        float sum = 0.f;
#pragma unroll
        for (int ks = 0; ks < 8; ++ks) { float e[8];
#pragma unroll
            for (int r = 0; r < 4; ++r) { e[r] = __builtin_amdgcn_exp2f((s1[2 * ks][r] - mx) * c2); e[4 + r] = __builtin_amdgcn_exp2f((s1[2 * ks + 1][r] - mx) * c2); }
            sum += ((e[0] + e[1]) + (e[2] + e[3])) + ((e[4] + e[5]) + (e[6] + e[7]));
            p1[ks] = __builtin_bit_cast(bf16x8, pack8(e)); }
        sum += __shfl_xor(sum, 16); sum += __shfl_xor(sum, 32); inv1 = 1.0f / sum; }
    f32x4 o0[8], o1[8];
#pragma unroll
    for (int db = 0; db < 8; ++db) { o0[db] = (f32x4){0.f, 0.f, 0.f, 0.f}; o1[db] = (f32x4){0.f, 0.f, 0.f, 0.f}; }
#pragma unroll
    for (int ks = 0; ks < 8; ++ks) {
        const unsigned offv = (unsigned)(fr * 512 + ((ks >> 2) << 8) + (((4 * (ks & 3) + fq) ^ fr) << 4));
#pragma unroll
        for (int db = 0; db < 8; ++db) { const bf16x8 vf = *(const LAS bf16x8*)(ldsV + db * 8192 + offv);
            o0[db] = __builtin_amdgcn_mfma_f32_16x16x32_bf16(vf, p0[ks], o0[db], 0, 0, 0); o1[db] = __builtin_amdgcn_mfma_f32_16x16x32_bf16(vf, p1[ks], o1[db], 0, 0, 0); } }
    bf16* op = mix + (size_t)(row0 + fr) * DMODEL + DCONV + DPOOL + 128 * h + 4 * fq;
#pragma unroll
    for (int db = 0; db < 8; ++db) { u32x2 w; w.x = pk2(o0[db][0] * inv0, o0[db][1] * inv0); w.y = pk2(o0[db][2] * inv0, o0[db][3] * inv0); *(u32x2*)(op + 16 * db) = w;
        w.x = pk2(o1[db][0] * inv1, o1[db][1] * inv1); w.y = pk2(o1[db][2] * inv1, o1[db][3] * inv1); *(u32x2*)(op + (size_t)16 * DMODEL + 16 * db) = w; }
}

template <int g> __device__ __forceinline__ void mix_pool_wave(const Ptrs& P, LAS unsigned char* ldsW, int row0, int lane) {
    constexpr int k = 2 << g;
    const bf16* z = (const bf16*)(P.ws + WS_Z); bf16* mix = (bf16*)(P.ws + WS_MIX);
    const int fr = lane & 15, fq = lane >> 4;
    f32x4 acc0[12], acc1[12];
#pragma unroll
    for (int n = 0; n < 12; ++n) { acc0[n] = (f32x4){0.f, 0.f, 0.f, 0.f}; acc1[n] = (f32x4){0.f, 0.f, 0.f, 0.f}; }
    const float invA = 1.0f / (float)((row0 + fr + 1 < k) ? row0 + fr + 1 : k), invB = 1.0f / (float)((row0 + 16 + fr + 1 < k) ? row0 + 16 + fr + 1 : k);
#pragma unroll 1
    for (int ks = 0; ks < 6; ++ks) {
        const bf16* zp = z + (long)(row0 - 16 + fr) * DIN + 3 * DCONV + PGD * g + 32 * ks + 8 * fq;
        float pv[8], xa[8], xb[8], sa[8], sb[8];
        unpack8(*(const u32x4*)zp, pv); unpack8(*(const u32x4*)(zp + 16 * DIN), xa); unpack8(*(const u32x4*)(zp + 32 * DIN), xb);
#pragma unroll
        for (int e = 0; e < 8; ++e) {
            float p = pv[e], a = xa[e], b = xb[e];
            float b1 = scan_step<1>(b, a), a1 = scan_step<1>(a, p), p1 = scan_step_prev<1>(p);
            if (k >= 4) { const float b2 = scan_step<2>(b1, a1), a2 = scan_step<2>(a1, p1), p2 = scan_step_prev<2>(p1); b1 = b2; a1 = a2; p1 = p2; }
            if (k >= 8) { const float b2 = scan_step<4>(b1, a1), a2 = scan_step<4>(a1, p1), p2 = scan_step_prev<4>(p1); b1 = b2; a1 = a2; p1 = p2; }
            if (k >= 16) { const float b2 = scan_step<8>(b1, a1), a2 = scan_step<8>(a1, p1); b1 = b2; a1 = a2; }
            sa[e] = a1 * invA - a; sb[e] = b1 * invB - b; }
        const bf16x8 fa = __builtin_bit_cast(bf16x8, pack8(sa)), fb = __builtin_bit_cast(bf16x8, pack8(sb));
        const unsigned offw = (unsigned)(fr * 512 + ((ks >> 2) << 8) + (((4 * (ks & 3) + fq) ^ fr) << 4));
#pragma unroll
        for (int n = 0; n < 12; ++n) { const bf16x8 wf = *(const LAS bf16x8*)(ldsW + n * 8192 + offw);
            acc0[n] = __builtin_amdgcn_mfma_f32_16x16x32_bf16(wf, fa, acc0[n], 0, 0, 0); acc1[n] = __builtin_amdgcn_mfma_f32_16x16x32_bf16(wf, fb, acc1[n], 0, 0, 0); }
    }
    bf16* op = mix + (size_t)(row0 + fr) * DMODEL + DCONV + PGD * g + 4 * fq;
#pragma unroll
    for (int n = 0; n < 12; ++n) { const f32x4 sc = *(const f32x4*)(P.pool_scale + PGD * g + 16 * n + 4 * fq);
        u32x2 o; o.x = pk2(acc0[n][0] * sc[0], acc0[n][1] * sc[1]); o.y = pk2(acc0[n][2] * sc[2], acc0[n][3] * sc[3]); *(u32x2*)(op + 16 * n) = o;
        o.x = pk2(acc1[n][0] * sc[0], acc1[n][1] * sc[1]); o.y = pk2(acc1[n][2] * sc[2], acc1[n][3] * sc[3]); *(u32x2*)(op + (size_t)16 * DMODEL + 16 * n) = o; }
}

__device__ __forceinline__ void p2_mixer(const Ptrs& P, LAS unsigned char* lds, int w, int tid, int wave, int lane, int tmask) {
    const int sub = w & 3, tile = w >> 2, row0 = tile * 256 + wave * 32;
    if (tmask & 0x1e0) {
        lds_stage_rows<256, 16, 16>(lds, (const unsigned char*)(P.ws + WS_KB) + 256 * sub, 1024, tid);
        lds_stage_rows<128, 32, 32>(lds + 65536, (const unsigned char*)(P.ws + WS_VT) + (size_t)sub * 128 * 512, 512, tid);
        LDS_WAIT(); __syncthreads();
        mix_attn_wave(P, lds, lds + 65536, sub, row0, lane);
        __syncthreads();
    }
    if (tmask & 0x1e) {
        lds_stage_rows<192, 24, 32>(lds, (const unsigned char*)(P.ws + WS_POOLWT) + (size_t)sub * PGD * PGD * 2, PGD * 2, tid);
        LDS_WAIT(); __syncthreads();
        if (sub == 0) mix_pool_wave<0>(P, lds, row0, lane); else if (sub == 1) mix_pool_wave<1>(P, lds, row0, lane); else if (sub == 2) mix_pool_wave<2>(P, lds, row0, lane); else mix_pool_wave<3>(P, lds, row0, lane);
        __syncthreads();
    }
    if (tmask & 1) { for (int b = wave; b < 4; b += 8) mix_conv_task(P, 4 * w + b, lane); }
}

__device__ __forceinline__ void p5_fixup(const Ptrs& P, int gt, int NGT) {
    const float* ub = (const float*)(P.ws + WS_UBND); bf16* act = (bf16*)(P.ws + WS_ACT); const float* cw = P.ffn_conv_w; const float* cb = P.ffn_conv_b;
    for (int i = gt; i < 63 * (DFF / 8); i += NGT) {
        const int pm = 1 + i / (DFF / 8), c = (i % (DFF / 8)) * 8, gi = 256 * (c / 128) + (c % 128);
        const float* p2 = ub + (size_t)((pm - 1) * 4 + 2) * DFF2 + gi; const float* p1 = p2 + DFF2; const float* r0 = ub + (size_t)(pm * 4) * DFF2 + gi; const float* r1 = r0 + DFF2;
        float o0[8], o1[8];
#pragma unroll
        for (int e = 0; e < 8; ++e) {
            const float gw0 = cw[c + e], gw1 = cw[DFF2 + c + e], gw2 = cw[2 * DFF2 + c + e], gb = cb[c + e], vw0 = cw[DFF + c + e], vw1 = cw[DFF2 + DFF + c + e], vw2 = cw[2 * DFF2 + DFF + c + e], vb = cb[DFF + c + e];
            const float G0 = gw2 * r0[e] + (gw1 * p1[e] + (gw0 * p2[e] + gb)), V0 = vw2 * r0[128 + e] + (vw1 * p1[128 + e] + (vw0 * p2[128 + e] + vb));
            const float G1 = gw2 * r1[e] + (gw1 * r0[e] + (gw0 * p1[e] + gb)), V1 = vw2 * r1[128 + e] + (vw1 * r0[128 + e] + (vw0 * p1[128 + e] + vb));
            o0[e] = G0 * __builtin_amdgcn_rcpf(1.0f + __builtin_amdgcn_exp2f(-1.4426950408889634f * G0)) * V0;
            o1[e] = G1 * __builtin_amdgcn_rcpf(1.0f + __builtin_amdgcn_exp2f(-1.4426950408889634f * G1)) * V1; }
        *(u32x4*)(act + (size_t)(256 * pm) * DFF + c) = pack8(o0); *(u32x4*)(act + (size_t)(256 * pm + 1) * DFF + c) = pack8(o1);
    }
}

__device__ __forceinline__ void p7_final(const Ptrs& P, int gw, int NGW, int lane) {
    const float* slab = (const float*)(P.ws + WS_SLAB2);
    for (int m = gw; m < SEQ; m += NGW) {
        const float part = (lane < 32) ? slab[(size_t)m * 32 + lane] : 0.f;
        const float rstd = 1.0f / sqrtf(wave_sum(part) * (1.0f / DMODEL) + EPS);
        f32x4* xr = (f32x4*)(P.out + (size_t)m * DMODEL) + lane; const f32x4* gr = (const f32x4*)P.g_final + lane;
#pragma unroll
        for (int j = 0; j < 8; ++j) { f32x4 v = xr[64 * j]; const f32x4 gg = gr[64 * j]; v = v * rstd * gg; xr[64 * j] = v; }
    }
}

struct Args { const float* in[16]; float* out; unsigned char* ws; int ph_lo, ph_hi; };
__global__ void __launch_bounds__(NWAVES * 64, 2) hybrid_fwd(Args args) {
    extern __shared__ __attribute__((aligned(16))) unsigned char lds_raw[];
    LAS unsigned char* lds = (LAS unsigned char*)lds_raw;
    cg::grid_group grid = cg::this_grid();
    const int tid = threadIdx.x, lane = tid & 63, wave = __builtin_amdgcn_readfirstlane(tid >> 6);
    const int G = gridDim.x, bx = blockIdx.x, vcu = (G % 8 == 0) ? (bx % 8) * (G / 8) + bx / 8 : bx;
    const int gw = vcu * NWAVES + wave, NGW = G * NWAVES;
    volatile LAS unsigned* MISC = (volatile LAS unsigned*)(lds + MISC_OFF);
    if (tid < 32) MISC[tid] = 0u;
    __syncthreads();
    const XcdBarrier bar = xcd_barrier_post((unsigned*)(args.ws + WS_CTL), MISC + 8);
    Ptrs P;
    P.x = args.in[0]; P.mem = args.in[1]; P.g_mix = args.in[2]; P.g_mem = args.in[3]; P.w_in = args.in[4]; P.conv_w = args.in[5]; P.pool_w = args.in[6]; P.pool_scale = args.in[7];
    P.w_kv = args.in[8]; P.w_out = args.in[9]; P.g_ffn = args.in[10]; P.w_up = args.in[11]; P.ffn_conv_w = args.in[12]; P.ffn_conv_b = args.in[13]; P.w_down = args.in[14]; P.g_final = args.in[15];
    P.out = args.out; P.ws = args.ws;
    unsigned char* ws = args.ws;
#if PROBE_SYNC
    for (int i = 0; i < 20; ++i) xcd_barrier(bar);
#endif
    const int lo = args.ph_lo, hi = args.ph_hi;
#define IN(k) (lo <= (k) && (k) < hi)
#define SYNC(k) do { if ((k) + 1 < hi) { if ((k) == 0 && USE_CG_SYNC) grid.sync(); else xcd_barrier(bar); } } while (0)
#define SYNCR(k, b) do { if ((k) + 1 < hi || rp + 1 < NREP(b)) { if ((k) == 0 && USE_CG_SYNC) grid.sync(); else xcd_barrier(bar); } } while (0)
#define NREP(b) ((REPM & (b)) ? 2 : 1)
    if (IN(0) && (PHM & 1)) for (int rp = 0; rp < NREP(1); ++rp) { p0_prologue(P, lds, gw, NGW, wave, lane); SYNCR(0, 1); }
    if (IN(1) && (PHM & 2)) for (int rp = 0; rp < NREP(2); ++rp) {
        pg8::Gemm g{(const bf16*)(ws + WS_H), (const bf16*)(ws + WS_WINT), SEQ, DIN, DMODEL}; pg8::StaticOrder S; S.init(SEQ, DIN, G, bx);
        pg8::EpiZ E{(bf16*)(ws + WS_Z), DIN};
        pg8::gemm_phase<pg8::EpiZ, pg8::StaticOrder, true, true>(lds, g, S, E, lds + XLDS_OFF);
        if (wave < 4) { for (int tt = vcu * 4 + wave; tt < 1024; tt += G * 4) kv_tile(P, tt, lane); }
        SYNCR(1, 2);
    }
    if (IN(2) && (PHM & 4)) for (int rp = 0; rp < NREP(4); ++rp) { p2_mixer(P, lds, vcu, tid, wave, lane, 511);
#if PROBE_P2
        p2_mixer(P, lds, vcu, tid, wave, lane, PROBE_P2);
#endif
        SYNCR(2, 4); }
    if (IN(3) && (PHM & 8)) for (int rp = 0; rp < NREP(8); ++rp) {
        pg8::Gemm g{(const bf16*)(ws + WS_MIX), (const bf16*)(ws + WS_WOUTT), SEQ, DMODEL, DMODEL}; pg8::StaticOrder S; S.init(SEQ, DMODEL, G, bx);
        pg8::EpiResA E{P.x, (bf16*)(ws + WS_X1B), (float*)(ws + WS_SLAB1)};
        pg8::gemm_phase<pg8::EpiResA, pg8::StaticOrder, true, true>(lds, g, S, E, lds + XLDS_OFF);
        SYNCR(3, 8);
    }
#if PROBE_GEMM
    if (IN(3)) {
        pg8::Gemm g{(const bf16*)(ws + WS_X1B), (const bf16*)(ws + WS_WUPT), SEQ, PROBE_N, DMODEL}; pg8::StaticOrder S; S.init(SEQ, PROBE_N, G, bx);
#if PROBE_GEMM == 1
        pg8::EpiZ E{(bf16*)(ws + WS_Z), PROBE_N};
        pg8::gemm_phase<pg8::EpiZ, pg8::StaticOrder, true, true>(lds, g, S, E, lds + XLDS_OFF);
#elif PROBE_GEMM == 2
        pg8::EpiNone E{};
        pg8::gemm_phase<pg8::EpiNone, pg8::StaticOrder, true, true>(lds, g, S, E, lds + XLDS_OFF);
#elif PROBE_GEMM == 3
        pg8::EpiZ E{(bf16*)(ws + WS_Z), PROBE_N};
        pg8::gemm_phase<pg8::EpiZ, pg8::StaticOrder, true, false>(lds, g, S, E, lds + XLDS_OFF);
#elif PROBE_GEMM == 5
        pg8::EpiAct E{(bf16*)(ws + WS_ACT), (const float*)(ws + WS_SLAB1), P.ffn_conv_w, P.ffn_conv_b, (float*)(ws + WS_UBND)};
        pg8::gemm_phase<pg8::EpiAct, pg8::StaticOrder, true, true>(lds, g, S, E, lds + XLDS_OFF);
#elif PROBE_GEMM == 4
        pg8::EpiZ E{(bf16*)(ws + WS_Z), PROBE_N};
        pg8::gemm_phase<pg8::EpiZ, pg8::StaticOrder, false, true>(lds, g, S, E, lds + XLDS_OFF);
#endif
        xcd_barrier(bar);
    }
#endif
    if (IN(4) && (PHM & 16)) for (int rp = 0; rp < NREP(16); ++rp) {
        pg8::Gemm g{(const bf16*)(ws + WS_X1B), (const bf16*)(ws + WS_WUPT), SEQ, DFF2, DMODEL}; pg8::StaticOrder S; S.init(SEQ, DFF2, G, bx);
        pg8::EpiAct E{(bf16*)(ws + WS_ACT), (const float*)(ws + WS_SLAB1), P.ffn_conv_w, P.ffn_conv_b, (float*)(ws + WS_UBND)};
        pg8::gemm_phase<pg8::EpiAct, pg8::StaticOrder, true, true>(lds, g, S, E, lds + XLDS_OFF);
        xcd_barrier(bar);
    }
    if (IN(5) && (PHM & 32)) { p5_fixup(P, vcu * (NWAVES * 64) + tid, G * NWAVES * 64); xcd_barrier(bar); }
    if (IN(6) && (PHM & 64)) {
        pg8::Gemm g{(const bf16*)(ws + WS_ACT), (const bf16*)(ws + WS_WDOWNT), SEQ, DMODEL, DFF}; pg8::StaticOrder S; S.init(SEQ, DMODEL, G, bx);
        pg8::EpiResB E{(const bf16*)(ws + WS_X1B), P.out, (float*)(ws + WS_SLAB2)};
        pg8::gemm_phase<pg8::EpiResB, pg8::StaticOrder, true, true>(lds, g, S, E, lds + XLDS_OFF);
        SYNC(6);
    }
    if (IN(7) && (PHM & 128)) p7_final(P, gw, NGW, lane);
#undef IN
#undef SYNC
}

extern "C" void kernel_launch(void* const* d_in, const int* in_sizes, int n_in, void* d_out, int out_size, void* d_ws, size_t ws_size, hipStream_t stream) {
    static int grid = 0;
    if (grid == 0) {
        if (n_in != 16 || in_sizes[0] != SEQ * DMODEL || out_size != SEQ * DMODEL || ws_size < WS_END) { fprintf(stderr, "kernel_launch: unexpected shapes (n_in %d, in0 %d, out %d, ws %zu)\n", n_in, n_in > 0 ? in_sizes[0] : -1, out_size, ws_size); grid = -1; return; }
        int dev = 0, cus = 0, per_cu = 0;
        if (hipGetDevice(&dev) != hipSuccess || hipDeviceGetAttribute(&cus, hipDeviceAttributeMultiprocessorCount, dev) != hipSuccess) { grid = -1; return; }
        if (hipFuncSetAttribute((const void*)hybrid_fwd, hipFuncAttributeMaxDynamicSharedMemorySize, LDS_BYTES) != hipSuccess) { fprintf(stderr, "kernel_launch: hipFuncSetAttribute failed\n"); grid = -1; return; }
        if (hipOccupancyMaxActiveBlocksPerMultiprocessor(&per_cu, (const void*)hybrid_fwd, NWAVES * 64, LDS_BYTES) != hipSuccess || per_cu < 1) { fprintf(stderr, "kernel_launch: occupancy query says %d blocks per CU\n", per_cu); (void)hipGetLastError(); per_cu = 1; }
        grid = cus;
        if (grid % 8 != 0 || grid < 8) { fprintf(stderr, "kernel_launch: %d CUs\n", grid); }
    }
    if (grid < 0) return;
    if (hipMemsetAsync((char*)d_ws + WS_CTL, 0, CTL_ZERO_BYTES, stream) != hipSuccess) { fprintf(stderr, "kernel_launch: hipMemsetAsync failed\n"); return; }
    Args a{};
    for (int i = 0; i < 16; ++i) a.in[i] = (const float*)d_in[i];
    a.out = (float*)d_out; a.ws = (unsigned char*)d_ws;
#if MK_PER_PHASE
    for (int ph = 0; ph < NPHASE; ++ph) { a.ph_lo = ph; a.ph_hi = ph + 1; hipLaunchKernelGGL(hybrid_fwd, dim3(grid), dim3(NWAVES * 64), LDS_BYTES, stream, a); }
#else
    a.ph_lo = 0; a.ph_hi = NPHASE;
    void* kargs[] = {&a};
    hipError_t e = hipLaunchCooperativeKernel((const void*)hybrid_fwd, dim3(grid), dim3(NWAVES * 64), kargs, LDS_BYTES, stream);
    if (e != hipSuccess) fprintf(stderr, "kernel_launch: cooperative launch failed: %s (grid %d)\n", hipGetErrorString(e), grid);
#endif
}
```

```cpp
#include <hip/hip_runtime.h>
#include <hip/hip_cooperative_groups.h>
#include <cstdio>
#include <cstdint>
namespace cg = cooperative_groups;
namespace pg8 {
#define PG8_LAS __attribute__((address_space(3)))
typedef unsigned short bf16_t;
typedef short bf16x8 __attribute__((ext_vector_type(8)));
typedef float f32x4 __attribute__((ext_vector_type(4)));
typedef unsigned u32x4 __attribute__((ext_vector_type(4)));
constexpr int BM = 256, BK = 64, HALF = 128, HTB = HALF * BK * 2  , STAGE_BYTES = 8 * HTB, NXCD = 8, WGM = 8;

__host__ __device__ __forceinline__ int lds_byte(int r, int c) { const int st = (r >> 4) * 2 + (c >> 5), rr = r & 15, cc = c & 31, ob = rr * 64 + cc * 2; return st * 1024 + (ob ^ (((ob >> 9) & 1) << 5)); }
__host__ __device__ __forceinline__ void stage_rc(int b, int& R, int& C) { const int st = b / 1024, sb = b % 1024, swz = sb ^ (((sb >> 9) & 1) << 5); R = (st >> 1) * 16 + swz / 64; C = (st & 1) * 32 + (swz % 64) / 2; }
__host__ __device__ __forceinline__ int perm32(int rho) { const int n = rho >> 4, i = rho & 15; return 8 * (i >> 2) + 4 * n + (i & 3); }

struct Unit { int pm, pn; };
struct Gemm { const bf16_t* A; const bf16_t* Bt; int M, N, K; };

struct StaticOrder {
    int nM, nN, nwg, G, c;
    __host__ __device__ void init(int M, int N, int G_, int c_) { nM = M / BM; nN = N / BM; nwg = nM * nN; G = G_; c = c_; }
    __host__ __device__ bool next(int i, Unit& u) const {
        const long L = (long)i * G + c; if (L >= nwg) return false;
        int wgid = (int)L; { const int q = nwg / NXCD, r = nwg % NXCD, xcd = wgid % NXCD, off = wgid / NXCD; wgid = (xcd < r ? xcd * (q + 1) : r * (q + 1) + (xcd - r) * q) + off; }
        const int nig = WGM * nN, gid = wgid / nig, fm = gid * WGM, gsz = (nM - fm) < WGM ? (nM - fm) : WGM;
        u.pm = fm + ((wgid % nig) % gsz); u.pn = (wgid % nig) / gsz; return true;
    }
    __device__ __forceinline__ void a_ready(const Unit&) const {}
    __device__ __forceinline__ void done(const Unit&) const {}
};
__device__ __forceinline__ unsigned cvt_pk_bf16(float lo, float hi) { unsigned r; asm volatile("v_cvt_pk_bf16_f32 %0, %1, %2" : "=v"(r) : "v"(lo), "v"(hi)); return r; }
typedef unsigned u32x2 __attribute__((ext_vector_type(2)));
constexpr int DM = 2048;
constexpr float RMS_EPS = 1e-6f;

struct EpiZ {
    static constexpr bool PERM = true, AFTER_DRAIN = false;
    bf16_t* O; int ldc;
    __device__ __forceinline__ void operator()(const f32x4 (&acc)[2][2][4][2], const Unit& u, int wr, int wc, int fr_, int fq_, PG8_LAS unsigned char*) const {
        int t_ = threadIdx.x; asm volatile("" : "+v"(t_));
        const int fr = t_ & 15, fq = (t_ >> 4) & 3;
        const int row0 = u.pm * BM + wr * 64 + fr, col0 = u.pn * BM + wc * 32 + 8 * fq;
#pragma unroll
        for (int ai = 0; ai < 2; ++ai)
#pragma unroll
            for (int m = 0; m < 4; ++m) { bf16_t* rowp = O + (size_t)(row0 + ai * HALF + m * 16) * ldc + col0;
#pragma unroll
                for (int bj = 0; bj < 2; ++bj) { const f32x4 v0 = acc[ai][bj][m][0], v1 = acc[ai][bj][m][1];
                    u32x4 w; w.x = cvt_pk_bf16(v0[0], v0[1]); w.y = cvt_pk_bf16(v0[2], v0[3]); w.z = cvt_pk_bf16(v1[0], v1[1]); w.w = cvt_pk_bf16(v1[2], v1[3]);
                    *(u32x4*)(rowp + bj * HALF) = w; } }
    }
};

struct EpiNone {
    static constexpr bool PERM = true, AFTER_DRAIN = false;
    __device__ __forceinline__ void operator()(const f32x4 (&acc)[2][2][4][2], const Unit& u, int wr, int wc, int fr, int fq, PG8_LAS unsigned char*) const {
#pragma unroll
        for (int ai = 0; ai < 2; ++ai)
#pragma unroll
            for (int bj = 0; bj < 2; ++bj)
#pragma unroll
                for (int m = 0; m < 4; ++m)
#pragma unroll
                    for (int n = 0; n < 2; ++n) asm volatile("" :: "v"(acc[ai][bj][m][n]));
    }
};
struct EpiResA {
    static constexpr bool PERM = true, AFTER_DRAIN = false;
    const float* R; bf16_t* XB; float* slab;
    __device__ __forceinline__ void operator()(const f32x4 (&acc)[2][2][4][2], const Unit& u, int wr, int wc, int fr_, int fq_, PG8_LAS unsigned char*) const {
        int t_ = threadIdx.x; asm volatile("" : "+v"(t_));
        const int fr = t_ & 15, fq = (t_ >> 4) & 3;
        const int row0 = u.pm * BM + wr * 64 + fr, col0 = u.pn * BM + wc * 32 + 8 * fq;
#pragma unroll
        for (int ai = 0; ai < 2; ++ai) {
            f32x4 r[4][2][2];
#pragma unroll
            for (int m = 0; m < 4; ++m)
#pragma unroll
                for (int bj = 0; bj < 2; ++bj) { const float* p = R + (size_t)(row0 + ai * HALF + m * 16) * DM + col0 + bj * HALF; r[m][bj][0] = *(const f32x4*)p; r[m][bj][1] = *(const f32x4*)(p + 4); }
#pragma unroll
            for (int m = 0; m < 4; ++m) { const int row = row0 + ai * HALF + m * 16; float ss = 0.f;
#pragma unroll
                for (int bj = 0; bj < 2; ++bj) { const f32x4 v0 = acc[ai][bj][m][0] + r[m][bj][0], v1 = acc[ai][bj][m][1] + r[m][bj][1];
                    u32x4 w; w.x = cvt_pk_bf16(v0[0], v0[1]); w.y = cvt_pk_bf16(v0[2], v0[3]); w.z = cvt_pk_bf16(v1[0], v1[1]); w.w = cvt_pk_bf16(v1[2], v1[3]);
                    *(u32x4*)(XB + (size_t)row * DM + col0 + bj * HALF) = w;
                    ss += (v0[0] * v0[0] + v0[1] * v0[1]) + (v0[2] * v0[2] + v0[3] * v0[3]) + (v1[0] * v1[0] + v1[1] * v1[1]) + (v1[2] * v1[2] + v1[3] * v1[3]); }
                ss += __shfl_xor(ss, 16); ss += __shfl_xor(ss, 32);
                if (fq == 0) slab[(size_t)row * 32 + u.pn * 4 + wc] = ss; }
            asm volatile("" ::: "memory"); }
    }
};
struct EpiResB {
    static constexpr bool PERM = true, AFTER_DRAIN = false;
    const bf16_t* RB; float* X; float* slab;
    __device__ __forceinline__ void operator()(const f32x4 (&acc)[2][2][4][2], const Unit& u, int wr, int wc, int fr_, int fq_, PG8_LAS unsigned char*) const {
        int t_ = threadIdx.x; asm volatile("" : "+v"(t_));
        const int fr = t_ & 15, fq = (t_ >> 4) & 3;
        const int row0 = u.pm * BM + wr * 64 + fr, col0 = u.pn * BM + wc * 32 + 8 * fq;
        u32x4 r[2][4][2];
#pragma unroll
        for (int ai = 0; ai < 2; ++ai)
#pragma unroll
            for (int m = 0; m < 4; ++m)
#pragma unroll
                for (int bj = 0; bj < 2; ++bj) r[ai][m][bj] = *(const u32x4*)(RB + (size_t)(row0 + ai * HALF + m * 16) * DM + col0 + bj * HALF);
#pragma unroll
        for (int ai = 0; ai < 2; ++ai)
#pragma unroll
            for (int m = 0; m < 4; ++m) { const int row = row0 + ai * HALF + m * 16; float ss = 0.f;
#pragma unroll
                for (int bj = 0; bj < 2; ++bj) { const u32x4 q = r[ai][m][bj];
                    const f32x4 r0 = {__builtin_bit_cast(float, q.x << 16), __builtin_bit_cast(float, q.x & 0xffff0000u), __builtin_bit_cast(float, q.y << 16), __builtin_bit_cast(float, q.y & 0xffff0000u)};
                    const f32x4 r1 = {__builtin_bit_cast(float, q.z << 16), __builtin_bit_cast(float, q.z & 0xffff0000u), __builtin_bit_cast(float, q.w << 16), __builtin_bit_cast(float, q.w & 0xffff0000u)};
                    const f32x4 v0 = acc[ai][bj][m][0] + r0, v1 = acc[ai][bj][m][1] + r1;
                    float* xp = X + (size_t)row * DM + col0 + bj * HALF; *(f32x4*)xp = v0; *(f32x4*)(xp + 4) = v1;
                    ss += (v0[0] * v0[0] + v0[1] * v0[1]) + (v0[2] * v0[2] + v0[3] * v0[3]) + (v1[0] * v1[0] + v1[1] * v1[1]) + (v1[2] * v1[2] + v1[3] * v1[3]); }
                ss += __shfl_xor(ss, 16); ss += __shfl_xor(ss, 32);
                if (fq == 0) slab[(size_t)row * 32 + u.pn * 4 + wc] = ss; }
    }
};

struct PanelOrder {
    int G, vcu, ntot;
    __device__ __forceinline__ bool next(int i, Unit& u) const { const int L = i * G + vcu; if (L >= ntot) return false; u.pm = L >> 3; u.pn = L & 7; return true; }
    __device__ __forceinline__ void a_ready(const Unit&) const {}
    __device__ __forceinline__ void done(const Unit&) const {}
};
struct EpiFinal {
    static constexpr bool PERM = true, AFTER_DRAIN = false;
    const bf16_t* RB; float* OUT; const float* gfin; unsigned* xbuf; unsigned* cnt; unsigned* tmo;
    __device__ __forceinline__ void operator()(f32x4 (&acc)[2][2][4][2], const Unit& u, int wr, int wc, int fr_, int fq_, PG8_LAS unsigned char* xlds) const {
        int t_ = threadIdx.x; asm volatile("" : "+v"(t_));
        const int fr = t_ & 15, fq = (t_ >> 4) & 3, wid = __builtin_amdgcn_readfirstlane(t_ >> 6);
        const int rl0 = wr * 64 + fr, row0 = u.pm * BM + rl0, col0 = u.pn * BM + wc * 32 + 8 * fq;
        PG8_LAS float* Pt = (PG8_LAS float*)xlds;
        PG8_LAS float* St = (PG8_LAS float*)(xlds + 4096);
        { u32x4 r[2][4][2];
#pragma unroll
          for (int ai = 0; ai < 2; ++ai)
#pragma unroll
            for (int m = 0; m < 4; ++m)
#pragma unroll
                for (int bj = 0; bj < 2; ++bj) r[ai][m][bj] = *(const u32x4*)(RB + (size_t)(row0 + ai * HALF + m * 16) * DM + col0 + bj * HALF);
#pragma unroll
          for (int ai = 0; ai < 2; ++ai)
#pragma unroll
            for (int m = 0; m < 4; ++m) { float ss = 0.f;
#pragma unroll
                for (int bj = 0; bj < 2; ++bj) { const u32x4 q = r[ai][m][bj];
                    const f32x4 r0 = {__builtin_bit_cast(float, q.x << 16), __builtin_bit_cast(float, q.x & 0xffff0000u), __builtin_bit_cast(float, q.y << 16), __builtin_bit_cast(float, q.y & 0xffff0000u)};
                    const f32x4 r1 = {__builtin_bit_cast(float, q.z << 16), __builtin_bit_cast(float, q.z & 0xffff0000u), __builtin_bit_cast(float, q.w << 16), __builtin_bit_cast(float, q.w & 0xffff0000u)};
                    const f32x4 v0 = acc[ai][bj][m][0] + r0, v1 = acc[ai][bj][m][1] + r1; acc[ai][bj][m][0] = v0; acc[ai][bj][m][1] = v1;
                    ss += (v0[0] * v0[0] + v0[1] * v0[1]) + (v0[2] * v0[2] + v0[3] * v0[3]) + (v1[0] * v1[0] + v1[1] * v1[1]) + (v1[2] * v1[2] + v1[3] * v1[3]); }
                ss += __shfl_xor(ss, 16); ss += __shfl_xor(ss, 32);
                if (fq == 0) Pt[(ai * HALF + rl0 + m * 16) * 4 + wc] = ss; } }
        asm volatile("s_waitcnt lgkmcnt(0)" ::: "memory"); __builtin_amdgcn_s_barrier(); asm volatile("" ::: "memory");
        if (t_ < 256) { const float s = (Pt[t_ * 4 + 0] + Pt[t_ * 4 + 1]) + (Pt[t_ * 4 + 2] + Pt[t_ * 4 + 3]);
            __hip_atomic_store(xbuf + (size_t)(u.pm * BM + t_) * 8 + u.pn, __builtin_bit_cast(unsigned, s), __ATOMIC_RELAXED, __HIP_MEMORY_SCOPE_AGENT); }
        asm volatile("s_waitcnt vmcnt(0)" ::: "memory");
        if (t_ < 256 && (t_ & 63) == 0) __hip_atomic_fetch_add(cnt + 64 * u.pm, 1u, __ATOMIC_RELAXED, __HIP_MEMORY_SCOPE_AGENT);
        if (wid == 0) {
            unsigned spins = 0;
            while ((unsigned)__builtin_amdgcn_readfirstlane(__hip_atomic_load(cnt + 64 * u.pm, __ATOMIC_RELAXED, __HIP_MEMORY_SCOPE_AGENT)) < 32u) {
                __builtin_amdgcn_s_sleep(2);
                if (++spins > (1u << 20)) { if ((t_ & 63) == 0) __hip_atomic_store(tmo, 1u, __ATOMIC_RELAXED, __HIP_MEMORY_SCOPE_AGENT); break; } }
            __builtin_amdgcn_fence(__ATOMIC_ACQUIRE, "agent");
        }
        asm volatile("s_waitcnt vmcnt(0) lgkmcnt(0)" ::: "memory"); __builtin_amdgcn_s_barrier(); asm volatile("" ::: "memory");
        if (t_ < 256) { const unsigned long long* sp = (const unsigned long long*)(xbuf + (size_t)(u.pm * BM + t_) * 8); float tot = 0.f;
#pragma unroll
            for (int q = 0; q < 4; ++q) { const unsigned long long w = __hip_atomic_load(sp + q, __ATOMIC_RELAXED, __HIP_MEMORY_SCOPE_AGENT);
                tot += __builtin_bit_cast(float, (unsigned)w); tot += __builtin_bit_cast(float, (unsigned)(w >> 32)); }
            St[t_] = 1.0f / sqrtf(tot * (1.0f / DM) + RMS_EPS); }
        asm volatile("s_waitcnt lgkmcnt(0)" ::: "memory"); __builtin_amdgcn_s_barrier(); asm volatile("" ::: "memory");
        f32x4 gg[2][2];
#pragma unroll
        for (int bj = 0; bj < 2; ++bj) { gg[bj][0] = *(const f32x4*)(gfin + col0 + bj * HALF); gg[bj][1] = *(const f32x4*)(gfin + col0 + bj * HALF + 4); }
#pragma unroll
        for (int ai = 0; ai < 2; ++ai)
#pragma unroll
            for (int m = 0; m < 4; ++m) { const float rstd = St[ai * HALF + rl0 + m * 16]; float* op = OUT + (size_t)(row0 + ai * HALF + m * 16) * DM + col0;
#pragma unroll
                for (int bj = 0; bj < 2; ++bj) { *(f32x4*)(op + bj * HALF) = acc[ai][bj][m][0] * rstd * gg[bj][0]; *(f32x4*)(op + bj * HALF + 4) = acc[ai][bj][m][1] * rstd * gg[bj][1]; } }
    }
};

__device__ __forceinline__ float dpp_shr1(float old, float src) { return __builtin_bit_cast(float, __builtin_amdgcn_update_dpp(__builtin_bit_cast(int, old), __builtin_bit_cast(int, src), 0x111, 0xf, 0xf, false)); }
__device__ __forceinline__ float dpp_shr2(float old, float src) { return __builtin_bit_cast(float, __builtin_amdgcn_update_dpp(__builtin_bit_cast(int, old), __builtin_bit_cast(int, src), 0x112, 0xf, 0xf, false)); }
__device__ __forceinline__ float dpp_ror1(float src) { return __builtin_bit_cast(float, __builtin_amdgcn_update_dpp(0, __builtin_bit_cast(int, src), 0x121, 0xf, 0xf, false)); }
__device__ __forceinline__ float dpp_ror2(float src) { return __builtin_bit_cast(float, __builtin_amdgcn_update_dpp(0, __builtin_bit_cast(int, src), 0x122, 0xf, 0xf, false)); }
constexpr int FF = 5632, FF2 = 11264;
struct EpiAct {
    static constexpr bool PERM = true, AFTER_DRAIN = false;
    bf16_t* ACT; const float* slab; const float* cw; const float* cb; float* ubnd;
    __device__ __forceinline__ void operator()(f32x4 (&acc)[2][2][4][2], const Unit& u, int wr, int wc, int fr_, int fq_, PG8_LAS unsigned char* xlds) const {
        int t_ = threadIdx.x; asm volatile("" : "+v"(t_));
        const int fr = t_ & 15, fq = (t_ >> 4) & 3;
        const int row0 = u.pm * BM + wr * 64 + fr, cl = wc * 32 + 8 * fq;
#pragma unroll
        for (int ai = 0; ai < 2; ++ai)
#pragma unroll
            for (int m = 0; m < 4; ++m) { const int rg = row0 + ai * HALF + m * 16;
                const f32x4 pa = *(const f32x4*)(slab + (size_t)rg * 32 + 8 * fq), pb = *(const f32x4*)(slab + (size_t)rg * 32 + 8 * fq + 4);
                float s = ((pa[0] + pa[1]) + (pa[2] + pa[3])) + ((pb[0] + pb[1]) + (pb[2] + pb[3]));
                s += __shfl_xor(s, 16); s += __shfl_xor(s, 32);
                const float rstd = 1.0f / sqrtf(s * (1.0f / DM) + RMS_EPS);
#pragma unroll
                for (int bj = 0; bj < 2; ++bj)
#pragma unroll
                    for (int n = 0; n < 2; ++n) acc[ai][bj][m][n] = acc[ai][bj][m][n] * rstd; }
        if (fr >= 14) {
#pragma unroll
            for (int ai = 0; ai < 2; ++ai)
#pragma unroll
                for (int bj = 0; bj < 2; ++bj)
#pragma unroll
                    for (int n = 0; n < 2; ++n) *(PG8_LAS f32x4*)(xlds + ((((2 * ai + wr) * 2 + (fr - 14)) * 256 + 128 * bj + cl + 4 * n) << 2)) = acc[ai][bj][3][n];
            if (wr == 1) {
#pragma unroll
                for (int bj = 0; bj < 2; ++bj)
#pragma unroll
                    for (int n = 0; n < 2; ++n) *(f32x4*)(ubnd + (size_t)(u.pm * 4 + 2 + (fr - 14)) * FF2 + u.pn * BM + 128 * bj + cl + 4 * n) = acc[1][bj][3][n]; }
        }
        if (wr == 0 && fr < 2) {
#pragma unroll
            for (int bj = 0; bj < 2; ++bj)
#pragma unroll
                for (int n = 0; n < 2; ++n) *(f32x4*)(ubnd + (size_t)(u.pm * 4 + fr) * FF2 + u.pn * BM + 128 * bj + cl + 4 * n) = acc[0][bj][0][n]; }
        asm volatile("s_waitcnt lgkmcnt(0)" ::: "memory"); __builtin_amdgcn_s_barrier(); asm volatile("" ::: "memory");
        const int c0 = u.pn * 128 + cl;
        u32x2 hold[2][4];
#pragma unroll
        for (int n = 0; n < 2; ++n) {
            const f32x4 gw0 = *(const f32x4*)(cw + c0 + 4 * n), gw1 = *(const f32x4*)(cw + FF2 + c0 + 4 * n), gw2 = *(const f32x4*)(cw + 2 * FF2 + c0 + 4 * n), gb = *(const f32x4*)(cb + c0 + 4 * n);
            const f32x4 vw0 = *(const f32x4*)(cw + FF + c0 + 4 * n), vw1 = *(const f32x4*)(cw + FF2 + FF + c0 + 4 * n), vw2 = *(const f32x4*)(cw + 2 * FF2 + FF + c0 + 4 * n), vb = *(const f32x4*)(cb + FF + c0 + 4 * n);
#pragma unroll
            for (int ai = 0; ai < 2; ++ai) {
                const int chunk = 2 * ai + wr;
                f32x4 pg = {0.f, 0.f, 0.f, 0.f}, pv = {0.f, 0.f, 0.f, 0.f};
                if (chunk > 0) { const PG8_LAS unsigned char* bp = xlds + ((((chunk - 1) * 2 + (fr & 1)) * 256 + cl + 4 * n) << 2);
                    pg = *(const PG8_LAS f32x4*)bp; pv = *(const PG8_LAS f32x4*)(bp + 512); }
#pragma unroll
                for (int m = 0; m < 4; ++m) {
                    const f32x4 cg = acc[ai][0][m][n], cv = acc[ai][1][m][n]; float a[4];
#pragma unroll
                    for (int j = 0; j < 4; ++j) {
                        const float g1 = dpp_shr1(dpp_ror1(pg[j]), cg[j]), g2 = dpp_shr2(dpp_ror2(pg[j]), cg[j]);
                        const float v1 = dpp_shr1(dpp_ror1(pv[j]), cv[j]), v2 = dpp_shr2(dpp_ror2(pv[j]), cv[j]);
                        const float G = gw2[j] * cg[j] + (gw1[j] * g1 + (gw0[j] * g2 + gb[j]));
                        const float V = vw2[j] * cv[j] + (vw1[j] * v1 + (vw0[j] * v2 + vb[j]));
                        a[j] = G * __builtin_amdgcn_rcpf(1.0f + __builtin_amdgcn_exp2f(-1.4426950408889634f * G)) * V; }
                    u32x2 w; w.x = cvt_pk_bf16(a[0], a[1]); w.y = cvt_pk_bf16(a[2], a[3]);
                    if (n == 0) hold[ai][m] = w;
                    else { u32x4 o; o.x = hold[ai][m].x; o.y = hold[ai][m].y; o.z = w.x; o.w = w.y;
                        *(u32x4*)(ACT + (size_t)(row0 + ai * HALF + m * 16) * FF + c0) = o; }
                    pg = cg; pv = cv;
                }
            }
        }
    }
};

template <class Epi, class Sched, bool ALIGN_EPI = false, bool SP2 = false>
__device__ __forceinline__ void gemm_phase(PG8_LAS unsigned char* lds, const Gemm g, const Sched& S, const Epi& E, PG8_LAS unsigned char* xlds) {
    const int tid = threadIdx.x, wid = __builtin_amdgcn_readfirstlane(tid >> 6), lane = tid & 63, wr = wid >> 2, wc = wid & 3, fr = lane & 15, fq = lane >> 4;
    const int K = g.K, nt = K / BK;
    unsigned voffA[2], voffB[2];
#pragma unroll
    for (int i = 0; i < 2; ++i) { int R, C; stage_rc(tid * 16 + i * 8192, R, C); const int Rb = Epi::PERM ? ((R & ~31) + perm32(R & 31)) : R;
        voffA[i] = (unsigned)(R * K + C) * 2u; voffB[i] = (unsigned)(Rb * K + C) * 2u; }
    const size_t kstep = (size_t)(BK * 2);
    const size_t hstep = (size_t)HALF * K * 2;
    const size_t tstep = 2 * hstep;
    const unsigned ldsw = (unsigned)wid * 1024u;
    const int aoff = lds_byte(wr * 64 + fr, fq * 8), boff = lds_byte(wc * 32 + fr, fq * 8);
#define PG8_SA(b, h) (((b) * 2 + (h)) * HTB)
#define PG8_SB(b, h) ((4 + (b) * 2 + (h)) * HTB)
#define PG8_STAGE(bufoff, gbase, voff) do { _Pragma("unroll") for (int _i = 0; _i < 2; ++_i) \
        __builtin_amdgcn_global_load_lds((const unsigned*)((const char*)(gbase) + (voff)[_i]), (PG8_LAS unsigned*)(lds + (bufoff) + ldsw + _i * 8192), 16, 0, 0); } while (0)
#define PG8_LDA(dst, b, h) do { _Pragma("unroll") for (int m = 0; m < 4; ++m) _Pragma("unroll") for (int k = 0; k < 2; ++k) dst[m][k] = *(const PG8_LAS bf16x8*)(lds + PG8_SA(b, h) + aoff + m * 2048 + k * 1024); } while (0)
#define PG8_LDB(dst, b, h) do { _Pragma("unroll") for (int n = 0; n < 2; ++n) _Pragma("unroll") for (int k = 0; k < 2; ++k) dst[n][k] = *(const PG8_LAS bf16x8*)(lds + PG8_SB(b, h) + boff + n * 2048 + k * 1024); } while (0)
#define PG8_MMA(ai, bj, At, Bt) do { __builtin_amdgcn_s_setprio(1); _Pragma("unroll") for (int m = 0; m < 4; ++m) _Pragma("unroll") for (int n = 0; n < 2; ++n) _Pragma("unroll") for (int k = 0; k < 2; ++k) \
        acc[ai][bj][m][n] = __builtin_amdgcn_mfma_f32_16x16x32_bf16(Bt[n][k], At[m][k], acc[ai][bj][m][n], 0, 0, 0); __builtin_amdgcn_s_setprio(0); } while (0)
#define PG8_WAIT_V(n) asm volatile("s_waitcnt vmcnt(" #n ")" ::: "memory")
#define PG8_WAIT_L(n) asm volatile("s_waitcnt lgkmcnt(" #n ")" ::: "memory")
#define PG8_BAR __builtin_amdgcn_s_barrier()
#define PG8_SCHED __builtin_amdgcn_sched_barrier(0)
    Unit cur, nxt; int ui = 0;
    if (!S.next(0, cur)) return;
    f32x4 acc[2][2][4][2];
#pragma unroll
    for (int a = 0; a < 2; ++a)
#pragma unroll
        for (int b = 0; b < 2; ++b)
#pragma unroll
            for (int m = 0; m < 4; ++m)
#pragma unroll
                for (int n = 0; n < 2; ++n) acc[a][b][m][n] = (f32x4){0.f, 0.f, 0.f, 0.f};
    bf16x8 At[4][2], B0[2][2], B1[2][2];
    const char* cA = (const char*)g.A + (size_t)cur.pm * tstep; const char* cB = (const char*)g.Bt + (size_t)cur.pn * tstep;
    S.a_ready(cur);
    if constexpr (SP2) {
        PG8_STAGE(PG8_SB(0, 0), cB, voffB); PG8_STAGE(PG8_SB(0, 1), cB + hstep, voffB); PG8_STAGE(PG8_SA(0, 0), cA, voffA); PG8_STAGE(PG8_SA(0, 1), cA + hstep, voffA);
        if (wr == 1) PG8_BAR;
        PG8_WAIT_V(2); PG8_BAR;
        PG8_STAGE(PG8_SB(1, 0), cB + kstep, voffB); PG8_STAGE(PG8_SA(1, 0), cA + kstep, voffA); PG8_STAGE(PG8_SB(1, 1), cB + hstep + kstep, voffB);
        PG8_WAIT_V(6); PG8_BAR;
    } else {
        PG8_STAGE(PG8_SB(0, 0), cB, voffB); PG8_STAGE(PG8_SA(0, 0), cA, voffA); PG8_STAGE(PG8_SB(0, 1), cB + hstep, voffB); PG8_STAGE(PG8_SA(0, 1), cA + hstep, voffA);
        if (wr == 1) PG8_BAR;
        PG8_WAIT_V(4); PG8_BAR;
        PG8_STAGE(PG8_SB(1, 0), cB + kstep, voffB); PG8_STAGE(PG8_SA(1, 0), cA + kstep, voffA); PG8_STAGE(PG8_SB(1, 1), cB + hstep + kstep, voffB);
        PG8_WAIT_V(6); PG8_BAR;
    }
    for (;;) {
        const bool has_next = S.next(ui + 1, nxt);
        const char* nA = has_next ? (const char*)g.A + (size_t)nxt.pm * tstep : cA; const char* nB = has_next ? (const char*)g.Bt + (size_t)nxt.pn * tstep : cB;
        for (int t = 0; t < nt; t += 2) {
            const bool last = (t == nt - 2);
            const char* a1 = cA + (size_t)(t + 1) * kstep;
            const char* a2 = last ? nA : cA + (size_t)(t + 2) * kstep; const char* b2 = last ? nB : cB + (size_t)(t + 2) * kstep;
            const char* a3 = a2 + kstep; const char* b3 = b2 + kstep;
            if (last && has_next) S.a_ready(nxt);
            if constexpr (SP2) {
            PG8_LDB(B0, 0, 0); PG8_LDB(B1, 0, 1); PG8_SCHED; PG8_LDA(At, 0, 0); PG8_STAGE(PG8_SA(1, 1), a1 + hstep, voffA);
            PG8_WAIT_V(8); PG8_WAIT_L(0); PG8_BAR; PG8_MMA(0, 0, At, B0); PG8_MMA(0, 1, At, B1); PG8_BAR; PG8_SCHED;
            PG8_LDA(At, 0, 1); PG8_STAGE(PG8_SB(0, 0), b2, voffB); PG8_STAGE(PG8_SB(0, 1), b2 + hstep, voffB); PG8_STAGE(PG8_SA(0, 0), a2, voffA);
            PG8_WAIT_V(8); PG8_WAIT_L(0); PG8_BAR; PG8_MMA(1, 0, At, B0); PG8_MMA(1, 1, At, B1); PG8_BAR; PG8_SCHED;
            PG8_LDB(B0, 1, 0); PG8_LDB(B1, 1, 1); PG8_SCHED; PG8_LDA(At, 1, 0); PG8_STAGE(PG8_SA(0, 1), a2 + hstep, voffA);
            PG8_WAIT_V(8); PG8_WAIT_L(0); PG8_BAR; PG8_MMA(0, 0, At, B0); PG8_MMA(0, 1, At, B1); PG8_BAR; PG8_SCHED;
            PG8_LDA(At, 1, 1); PG8_STAGE(PG8_SB(1, 0), b3, voffB); PG8_STAGE(PG8_SB(1, 1), b3 + hstep, voffB); PG8_STAGE(PG8_SA(1, 0), a3, voffA);
            PG8_WAIT_V(8); PG8_WAIT_L(0); PG8_BAR; PG8_MMA(1, 0, At, B0); PG8_MMA(1, 1, At, B1); PG8_BAR; PG8_SCHED;
            } else {
            PG8_LDB(B0, 0, 0); PG8_SCHED; PG8_LDA(At, 0, 0); PG8_STAGE(PG8_SA(1, 1), a1 + hstep, voffA);
            PG8_WAIT_L(8); PG8_BAR; PG8_WAIT_L(0); PG8_MMA(0, 0, At, B0); PG8_BAR; PG8_SCHED;
            PG8_LDB(B1, 0, 1); PG8_STAGE(PG8_SB(0, 0), b2, voffB);
            PG8_BAR; PG8_WAIT_L(0); PG8_MMA(0, 1, At, B1); PG8_BAR;
            PG8_LDA(At, 0, 1); PG8_STAGE(PG8_SA(0, 0), a2, voffA);
            PG8_BAR; PG8_WAIT_L(0); PG8_MMA(1, 0, At, B0); PG8_BAR; PG8_SCHED;
            PG8_STAGE(PG8_SB(0, 1), b2 + hstep, voffB);
            PG8_WAIT_V(6); PG8_BAR; PG8_MMA(1, 1, At, B1); PG8_BAR;
            PG8_LDB(B0, 1, 0); PG8_SCHED; PG8_LDA(At, 1, 0); PG8_STAGE(PG8_SA(0, 1), a2 + hstep, voffA);
            PG8_WAIT_L(8); PG8_BAR; PG8_WAIT_L(0); PG8_MMA(0, 0, At, B0); PG8_BAR; PG8_SCHED;
            PG8_LDB(B1, 1, 1); PG8_STAGE(PG8_SB(1, 0), b3, voffB);
            PG8_BAR; PG8_WAIT_L(0); PG8_MMA(0, 1, At, B1); PG8_BAR;
            PG8_LDA(At, 1, 1); PG8_STAGE(PG8_SA(1, 0), a3, voffA);
            PG8_BAR; PG8_WAIT_L(0); PG8_MMA(1, 0, At, B0); PG8_BAR; PG8_SCHED;
            PG8_STAGE(PG8_SB(1, 1), b3 + hstep, voffB);
            PG8_WAIT_V(6); PG8_BAR; PG8_MMA(1, 1, At, B1); PG8_BAR;
            }
        }
        if constexpr (ALIGN_EPI) { if (wr == 0) PG8_BAR; }
        if constexpr (!Epi::AFTER_DRAIN) { E(acc, cur, wr, wc, fr, fq, xlds); S.done(cur); }
        if (!has_next) break;
#pragma unroll
        for (int a = 0; a < 2; ++a)
#pragma unroll
            for (int b = 0; b < 2; ++b)
#pragma unroll
                for (int m = 0; m < 4; ++m)
#pragma unroll
                    for (int n = 0; n < 2; ++n) acc[a][b][m][n] = (f32x4){0.f, 0.f, 0.f, 0.f};
        cur = nxt; cA = nA; cB = nB; ++ui;
        if constexpr (ALIGN_EPI) { if (wr == 1) PG8_BAR; }
    }
    PG8_WAIT_V(0);
    if constexpr (!ALIGN_EPI) { if (wr == 0) PG8_BAR; }
    PG8_BAR;

#undef PG8_SA
#undef PG8_SB
#undef PG8_STAGE
#undef PG8_LDA
#undef PG8_LDB
#undef PG8_MMA
#undef PG8_WAIT_V
#undef PG8_WAIT_L
#undef PG8_BAR
#undef PG8_SCHED
}
}

#define GAS __attribute__((address_space(1)))
#define LAS __attribute__((address_space(3)))
typedef unsigned short bf16;
typedef float f32x4 __attribute__((ext_vector_type(4)));
typedef short bf16x8 __attribute__((ext_vector_type(8)));
typedef unsigned u32x4 __attribute__((ext_vector_type(4)));
typedef unsigned u32x2 __attribute__((ext_vector_type(2)));

constexpr int NWAVES = 8;
constexpr int SEQ = 16384, DMODEL = 2048, NMEM = 256, DIN = 3584, DCONV = 768, DPOOL = 768, DXATT = 512, DFF = 5632, DFF2 = 11264;
constexpr int PGD = 192;
constexpr float EPS = 1e-6f;
constexpr int LDS_BYTES = 147456;
#ifndef MK_PER_PHASE
#define MK_PER_PHASE 0
#endif
constexpr int NPHASE = 7;
#ifndef PHM
#define PHM 255
#endif
#ifndef USE_CG_SYNC
#define USE_CG_SYNC 0
#endif
#ifndef PROBE_P2
#define PROBE_P2 0
#endif
#ifndef PROBE_SYNC
#define PROBE_SYNC 0
#endif
#ifndef PROBE_GEMM
#define PROBE_GEMM 0
#endif
#ifndef PROBE_N
#define PROBE_N 2048
#endif
#ifndef REPM
#define REPM 0
#endif

constexpr size_t MiB = 1u << 20;
constexpr size_t WS_KB = 1 * MiB;
constexpr size_t WS_VT = 1 * MiB + 256 * 1024;
constexpr size_t WS_POOLWT = 1 * MiB + 512 * 1024;
constexpr size_t WS_MB = 2 * MiB;
constexpr size_t WS_WKVT = 3 * MiB;
constexpr size_t WS_SLAB1 = 8 * MiB;
constexpr size_t WS_SLAB2 = 10 * MiB;
constexpr size_t WS_WUPT = 12 * MiB;
constexpr size_t WS_WDOWNT = 56 * MiB;
constexpr size_t WS_UBND = 80 * MiB;
constexpr size_t WS_X1B = 96 * MiB;
constexpr size_t WS_ACT = 160 * MiB;
constexpr size_t WS_H = 160 * MiB;
constexpr size_t WS_Z = 225 * MiB;
constexpr size_t WS_ZPAD = WS_Z - (size_t)16 * 3584 * 2;
constexpr size_t WS_MIX = 338 * MiB;
constexpr size_t WS_WINT = 402 * MiB;
constexpr size_t WS_WOUTT = 416 * MiB;
constexpr size_t WS_END = 424 * MiB;

__device__ __forceinline__ unsigned f2bf(float f) { unsigned u = __builtin_bit_cast(unsigned, f); return (u + 0x7fffu + ((u >> 16) & 1u)) >> 16; }
__device__ __forceinline__ unsigned pk2(float lo, float hi) { return f2bf(lo) | (f2bf(hi) << 16); }
__device__ __forceinline__ float bflo(unsigned w) { return __builtin_bit_cast(float, w << 16); }
__device__ __forceinline__ float bfhi(unsigned w) { return __builtin_bit_cast(float, w & 0xffff0000u); }
__device__ __forceinline__ void unpack8(const u32x4 w, float (&f)[8]) { f[0] = bflo(w.x); f[1] = bfhi(w.x); f[2] = bflo(w.y); f[3] = bfhi(w.y); f[4] = bflo(w.z); f[5] = bfhi(w.z); f[6] = bflo(w.w); f[7] = bfhi(w.w); }
__device__ __forceinline__ u32x4 pack8(const float (&f)[8]) { u32x4 w; w.x = pk2(f[0], f[1]); w.y = pk2(f[2], f[3]); w.z = pk2(f[4], f[5]); w.w = pk2(f[6], f[7]); return w; }
__device__ __forceinline__ float wave_sum(float v) {
#pragma unroll
    for (int o = 1; o < 64; o <<= 1) v += __shfl_xor(v, o);
    return v;
}
#define LDS_WAIT() asm volatile("s_waitcnt lgkmcnt(0)" ::: "memory")

typedef GAS unsigned gu32;
constexpr size_t WS_CTL = 0, CTL_ZERO_BYTES = 64 * 1024;
constexpr int CW_PANEL = 4096;
constexpr int MISC_OFF = 131072 + 320;
constexpr int XLDS_OFF = 131072 + 1024;
#define XB_TMO      128
#define XB_XCNT(j)  (256  + 64 * (j))
#define XB_XSUB(j)  (1280 + 64 * (j))
#define XB_XGEN(j)  (2304 + 64 * (j))
#define XB_TOP      3328
#define XB_TOPGEN   3392
#define XCD_BAR_WORDS 3456
#define XB_SPIN_CAP (1u << 18)

__device__ __forceinline__ unsigned xb_ld(unsigned* p)              { return __hip_atomic_load(p, __ATOMIC_RELAXED, __HIP_MEMORY_SCOPE_AGENT); }
__device__ __forceinline__ unsigned xb_add(unsigned* p, unsigned v) { return __hip_atomic_fetch_add(p, v, __ATOMIC_RELAXED, __HIP_MEMORY_SCOPE_AGENT); }
__device__ __forceinline__ unsigned xb_xcc_id() { return (unsigned)__builtin_amdgcn_s_getreg((3 << 11) | 20) & 0xFu; }
#define XB_SPIN(cond, bar) do { unsigned _sp = 0; while (cond) { __builtin_amdgcn_s_sleep(1); \
    if ((++_sp & 255u) == 0u) { if (xb_ld(&(bar)[XB_TMO])) break; if (_sp > XB_SPIN_CAP) { atomicAdd(&(bar)[XB_TMO], 1u); break; } } } } while (0)

struct XcdBarrier {
    unsigned* bar; unsigned x;
    volatile LAS unsigned* st;
};

__device__ __forceinline__ XcdBarrier xcd_barrier_post(unsigned* bar, volatile LAS unsigned* st) {
    XcdBarrier b; b.bar = bar; b.x = xb_xcc_id(); b.st = st;
    if (threadIdx.x == 0) (void)xb_add(&bar[XB_XCNT(b.x)], 1u);
    return b;
}
__device__ __forceinline__ void xcd_barrier_complete(unsigned* bar, unsigned x, unsigned& nloc, unsigned& nx) {
    const unsigned G = gridDim.x * gridDim.y * gridDim.z;
    unsigned sum, cnt, mine, sp = 0u;
    for (;;) {
        sum = 0u; cnt = 0u; mine = 0u;
#pragma unroll
        for (unsigned j = 0; j < 16; ++j) { const unsigned c = xb_ld(&bar[XB_XCNT(j)]); sum += c; cnt += (c > 0u) ? 1u : 0u; mine = (j == x) ? c : mine; }
        if (sum == G) break;
        __builtin_amdgcn_s_sleep(1);
        if ((++sp & 255u) == 0u) { if (xb_ld(&bar[XB_TMO])) break; if (sp > XB_SPIN_CAP) { atomicAdd(&bar[XB_TMO], 1u); break; } }
    }
    nloc = mine > 0u ? mine : 1u; nx = cnt > 0u ? cnt : 1u;
}

__device__ __forceinline__ void xcd_barrier(const XcdBarrier& b) {
    asm volatile("s_waitcnt vmcnt(0)" ::: "memory");
    __syncthreads();
    if (threadIdx.x == 0) {
        unsigned* bar = b.bar;
        __builtin_amdgcn_s_waitcnt(0);
        unsigned nloc = b.st[0], nx = b.st[1];
        if (nloc == 0u) { xcd_barrier_complete(bar, b.x, nloc, nx); b.st[0] = nloc; b.st[1] = nx; }
        const unsigned old = xb_add(&bar[XB_XSUB(b.x)], 1u);
        const unsigned gen = old / nloc;
        if (old + 1u == (gen + 1u) * nloc) {
            __builtin_amdgcn_fence(__ATOMIC_RELEASE, "agent");
            asm volatile("s_waitcnt vmcnt(0)" ::: "memory");
            const unsigned og = xb_add(&bar[XB_TOP], 1u);
            const unsigned tg = og / nx;
            if (og + 1u == (tg + 1u) * nx) xb_add(&bar[XB_TOPGEN], 1u);
            else XB_SPIN(xb_ld(&bar[XB_TOPGEN]) == tg, bar);
            __builtin_amdgcn_fence(__ATOMIC_ACQUIRE, "agent");
            xb_add(&bar[XB_XGEN(b.x)], 1u);
            asm volatile("s_waitcnt vmcnt(0)" ::: "memory");
        } else {
            XB_SPIN(xb_ld(&bar[XB_XGEN(b.x)]) == gen, bar);
            __builtin_amdgcn_fence(__ATOMIC_ACQUIRE, "agent");
            asm volatile("s_waitcnt vmcnt(0)" ::: "memory");
        }
    }
    __syncthreads();
}


template <bool UPMAP> __device__ __forceinline__ void p0_transpose_item(const float* W, int K, int N, bf16* WT, const float* ks, LAS float* scr, int item, int lane) {
    const int nblk = N / 64, kb = item / nblk, nb = item % nblk, k0 = 64 * kb, n0 = 64 * nb;
    const int r0 = !UPMAP ? n0 : (n0 < DFF ? 256 * (n0 / 128) + (n0 % 128) : 256 * ((n0 - DFF) / 128) + 128 + ((n0 - DFF) % 128));
    f32x4 v[16];
    const float* src = W + (size_t)(k0 + (lane >> 4)) * N + n0 + 4 * (lane & 15);
#pragma unroll
    for (int i = 0; i < 16; ++i) v[i] = *(const f32x4*)(src + (size_t)(4 * i) * N);
#pragma unroll
    for (int i = 0; i < 16; ++i) { f32x4 t = v[i]; if (ks) t = t * ks[k0 + 4 * i + (lane >> 4)];
        *(LAS f32x4*)(scr + (4 * i + (lane >> 4)) * 64 + (((lane & 15) ^ ((i >> 1) & 7)) << 2)) = t; }
    LDS_WAIT(); asm volatile("" ::: "memory");
    const int c = lane & 7;
#pragma unroll
    for (int j = 0; j < 8; ++j) { const int nn = (lane >> 3) + 8 * j; const LAS float* sp = scr + (8 * c) * 64 + ((((nn >> 2) ^ c) & 15) << 2) + (nn & 3);
        u32x4 o; o.x = pk2(sp[0 * 64], sp[1 * 64]); o.y = pk2(sp[2 * 64], sp[3 * 64]); o.z = pk2(sp[4 * 64], sp[5 * 64]); o.w = pk2(sp[6 * 64], sp[7 * 64]);
        *(u32x4*)(WT + (size_t)(r0 + nn) * K + k0 + 8 * c) = o; }
    LDS_WAIT(); asm volatile("" ::: "memory");
}
__device__ __forceinline__ void rms_rows2_to_bf16(const float* xa, const float* xb, const float* g, bf16* oa, bf16* ob, int lane) {
    const f32x4* pa = (const f32x4*)xa + lane; const f32x4* pb = (const f32x4*)xb + lane; const f32x4* gr = (const f32x4*)g + lane;
    f32x4 va[8], vb[8]; float sa = 0.f, sb = 0.f;
#pragma unroll
    for (int j = 0; j < 8; ++j) { va[j] = pa[64 * j]; vb[j] = pb[64 * j]; }
#pragma unroll
    for (int j = 0; j < 8; ++j) { sa += (va[j].x * va[j].x + va[j].y * va[j].y) + (va[j].z * va[j].z + va[j].w * va[j].w); sb += (vb[j].x * vb[j].x + vb[j].y * vb[j].y) + (vb[j].z * vb[j].z + vb[j].w * vb[j].w); }
    const float ra = 1.0f / sqrtf(wave_sum(sa) * (1.0f / DMODEL) + EPS), rb = 1.0f / sqrtf(wave_sum(sb) * (1.0f / DMODEL) + EPS);
    u32x2* qa = (u32x2*)oa + lane; u32x2* qb = (u32x2*)ob + lane;
#pragma unroll
    for (int j = 0; j < 8; ++j) { const f32x4 gg = gr[64 * j]; u32x2 w;
        w.x = pk2(va[j].x * ra * gg.x, va[j].y * ra * gg.y); w.y = pk2(va[j].z * ra * gg.z, va[j].w * ra * gg.w); qa[64 * j] = w;
        w.x = pk2(vb[j].x * rb * gg.x, vb[j].y * rb * gg.y); w.y = pk2(vb[j].z * rb * gg.z, vb[j].w * rb * gg.w); qb[64 * j] = w; }
}

struct Ptrs {
    const float *x, *mem, *g_mix, *g_mem, *w_in, *conv_w, *pool_w, *pool_scale, *w_kv, *w_out, *g_ffn, *w_up, *ffn_conv_w, *ffn_conv_b, *w_down, *g_final;
    float* out; unsigned char* ws;
};

__device__ __forceinline__ void p0_prologue(const Ptrs& P, LAS unsigned char* lds, int gw, int NGW, int wave, int lane) {
    LAS float* scr = (LAS float*)(lds + wave * 16384);
    unsigned char* ws = P.ws;
    constexpr int I_IN = (DMODEL / 64) * (DIN / 64), I_OUT = (DMODEL / 64) * (DMODEL / 64), I_UP = (DMODEL / 64) * (DFF2 / 64), I_DN = (DFF / 64) * (DMODEL / 64),
                  I_KV = (DMODEL / 64) * (1024 / 64), I_PW = (PGD / 64) * (PGD / 64);
    constexpr int NITEMS = I_IN + I_OUT + I_UP + I_DN + I_KV + 4 * I_PW;
    for (int it = gw; it < NITEMS; it += NGW) {
        int r = it;
        if (r < I_IN) { p0_transpose_item<false>(P.w_in, DMODEL, DIN, (bf16*)(ws + WS_WINT), nullptr, scr, r, lane); continue; } r -= I_IN;
        if (r < I_OUT) { p0_transpose_item<false>(P.w_out, DMODEL, DMODEL, (bf16*)(ws + WS_WOUTT), nullptr, scr, r, lane); continue; } r -= I_OUT;
        if (r < I_UP) { p0_transpose_item<true>(P.w_up, DMODEL, DFF2, (bf16*)(ws + WS_WUPT), P.g_ffn, scr, r, lane); continue; } r -= I_UP;
        if (r < I_DN) { p0_transpose_item<false>(P.w_down, DFF, DMODEL, (bf16*)(ws + WS_WDOWNT), nullptr, scr, r, lane); continue; } r -= I_DN;
        if (r < I_KV) { p0_transpose_item<false>(P.w_kv, DMODEL, 1024, (bf16*)(ws + WS_WKVT), nullptr, scr, r, lane); continue; } r -= I_KV;
        const int g = r / I_PW; r -= g * I_PW;
        p0_transpose_item<false>(P.pool_w + (size_t)g * PGD * PGD, PGD, PGD, (bf16*)(ws + WS_POOLWT) + (size_t)g * PGD * PGD, nullptr, scr, r, lane);
    }
    for (int i = gw * 64 + lane; i < 16 * DIN * 2 / 16; i += NGW * 64) ((u32x4*)(ws + WS_ZPAD))[i] = (u32x4){0u, 0u, 0u, 0u};
    for (int m = 2 * gw; m < SEQ; m += 2 * NGW) rms_rows2_to_bf16(P.x + (size_t)m * DMODEL, P.x + (size_t)(m + 1) * DMODEL, P.g_mix, (bf16*)(ws + WS_H) + (size_t)m * DMODEL, (bf16*)(ws + WS_H) + (size_t)(m + 1) * DMODEL, lane);
    for (int m = 2 * gw; m < NMEM; m += 2 * NGW) rms_rows2_to_bf16(P.mem + (size_t)m * DMODEL, P.mem + (size_t)(m + 1) * DMODEL, P.g_mem, (bf16*)(ws + WS_MB) + (size_t)m * DMODEL, (bf16*)(ws + WS_MB) + (size_t)(m + 1) * DMODEL, lane);
}

__device__ __forceinline__ void kv_tile(const Ptrs& P, int tt, int lane) {
    const bf16* mB = (const bf16*)(P.ws + WS_MB); const bf16* wT = (const bf16*)(P.ws + WS_WKVT);
    const int rb = tt >> 6, cb = tt & 63, fr = lane & 15, fq = lane >> 4;
    const bf16* ap = mB + (size_t)(16 * rb + fr) * DMODEL + 8 * fq; const bf16* wp = wT + (size_t)(16 * cb + fr) * DMODEL + 8 * fq;
    f32x4 acc = {0.f, 0.f, 0.f, 0.f};
    if (cb < 32) {
#pragma unroll 8
        for (int ks = 0; ks < 64; ++ks) { const bf16x8 a = *(const bf16x8*)(ap + 32 * ks), w = *(const bf16x8*)(wp + 32 * ks); acc = __builtin_amdgcn_mfma_f32_16x16x32_bf16(w, a, acc, 0, 0, 0); }
        u32x2 o; o.x = pk2(acc[0], acc[1]); o.y = pk2(acc[2], acc[3]);
        *(u32x2*)((bf16*)(P.ws + WS_KB) + (size_t)(16 * rb + fr) * 512 + 16 * cb + 4 * fq) = o;
    } else {
#pragma unroll 8
        for (int ks = 0; ks < 64; ++ks) { const bf16x8 a = *(const bf16x8*)(ap + 32 * ks), w = *(const bf16x8*)(wp + 32 * ks); acc = __builtin_amdgcn_mfma_f32_16x16x32_bf16(a, w, acc, 0, 0, 0); }
        u32x2 o; o.x = pk2(acc[0], acc[1]); o.y = pk2(acc[2], acc[3]);
        *(u32x2*)((bf16*)(P.ws + WS_VT) + (size_t)(16 * cb - 512 + fr) * 256 + 32 * (rb >> 1) + 8 * fq + 4 * (rb & 1)) = o;
    }
}

__device__ __forceinline__ void mix_conv_task(const Ptrs& P, int blk, int lane) {
    const bf16* z = (const bf16*)(P.ws + WS_Z); bf16* mix = (bf16*)(P.ws + WS_MIX);
    const int t0 = blk * 16;
    for (int cg = lane; cg < DCONV / 8; cg += 64) {
        const int c = cg * 8;
        float w0[8], w1[8], w2[8], p1[8], p2[8];
#pragma unroll
        for (int e = 0; e < 8; ++e) { w0[e] = P.conv_w[c + e]; w1[e] = P.conv_w[DCONV + c + e]; w2[e] = P.conv_w[2 * DCONV + c + e]; }
        { float a[8], b[8]; unpack8(*(const u32x4*)(z + (long)(t0 - 2) * DIN + DCONV + c), a); unpack8(*(const u32x4*)(z + (long)(t0 - 2) * DIN + 2 * DCONV + c), b);
#pragma unroll
          for (int e = 0; e < 8; ++e) p2[e] = a[e] * b[e];
          unpack8(*(const u32x4*)(z + (long)(t0 - 1) * DIN + DCONV + c), a); unpack8(*(const u32x4*)(z + (long)(t0 - 1) * DIN + 2 * DCONV + c), b);
#pragma unroll
          for (int e = 0; e < 8; ++e) p1[e] = a[e] * b[e]; }
#pragma unroll 4
        for (int r = 0; r < 16; ++r) {
            const int t = t0 + r; float p[8], a[8], b[8], g[8], o[8];
            unpack8(*(const u32x4*)(z + (size_t)t * DIN + DCONV + c), a); unpack8(*(const u32x4*)(z + (size_t)t * DIN + 2 * DCONV + c), b); unpack8(*(const u32x4*)(z + (size_t)t * DIN + c), g);
#pragma unroll
            for (int e = 0; e < 8; ++e) { p[e] = a[e] * b[e]; o[e] = g[e] * (w2[e] * p[e] + w1[e] * p1[e] + w0[e] * p2[e]); p2[e] = p1[e]; p1[e] = p[e]; }
            *(u32x4*)(mix + (size_t)t * DMODEL + c) = pack8(o);
        }
    }
}
template <int g> __device__ __forceinline__ void mix_pool_task(const Ptrs& P, int blk, int lane) {
    constexpr int k = 2 << g;
    const char* zu = (const char*)((const bf16*)(P.ws + WS_Z) + (size_t)(blk * 16) * DIN + 3 * DCONV + PGD * g);
    const char* wu = (const char*)((const bf16*)(P.ws + WS_POOLWT) + (size_t)g * PGD * PGD);
    bf16* mix = (bf16*)(P.ws + WS_MIX);
    const int fr = lane & 15, fq = lane >> 4, t = blk * 16 + fr;
    const unsigned zl = (unsigned)(fr * DIN + 8 * fq) * 2u, wl = (unsigned)(fr * PGD + 8 * fq) * 2u;
    const int cnt = (t + 1 < k) ? t + 1 : k; const float inv = 1.0f / (float)cnt;
    f32x4 acc[12];
#pragma unroll
    for (int n = 0; n < 12; ++n) acc[n] = (f32x4){0.f, 0.f, 0.f, 0.f};
#pragma unroll 1
    for (int ks = 0; ks < 6; ++ks) {
        float sum[8], self[8];
        unpack8(*(const u32x4*)(zu + ks * 64 + zl), self);
#pragma unroll
        for (int e = 0; e < 8; ++e) sum[e] = self[e];
#pragma unroll
        for (int j = 1; j < k; ++j) { float v[8]; unpack8(*(const u32x4*)(zu + ks * 64 - (long)j * (DIN * 2) + zl), v);
#pragma unroll
            for (int e = 0; e < 8; ++e) sum[e] += v[e]; }
        float pl[8];
#pragma unroll
        for (int e = 0; e < 8; ++e) pl[e] = sum[e] * inv - self[e];
        const bf16x8 pf = __builtin_bit_cast(bf16x8, pack8(pl));
#pragma unroll
        for (int n = 0; n < 12; ++n) { const bf16x8 wf = *(const bf16x8*)(wu + n * (16 * PGD * 2) + ks * 64 + wl); acc[n] = __builtin_amdgcn_mfma_f32_16x16x32_bf16(wf, pf, acc[n], 0, 0, 0); }
    }
#pragma unroll
    for (int n = 0; n < 12; ++n) { const int d = 16 * n + 4 * fq; const f32x4 sc = *(const f32x4*)(P.pool_scale + PGD * g + d);
        u32x2 o; o.x = pk2(acc[n][0] * sc[0], acc[n][1] * sc[1]); o.y = pk2(acc[n][2] * sc[2], acc[n][3] * sc[3]);
        *(u32x2*)(mix + (size_t)t * DMODEL + DCONV + PGD * g + d) = o; }
}
__device__ __forceinline__ void mix_attn_task(const Ptrs& P, int h, int blk, int lane) {
    const bf16* z = (const bf16*)(P.ws + WS_Z); bf16* mix = (bf16*)(P.ws + WS_MIX); const bf16* Kb = (const bf16*)(P.ws + WS_KB); const bf16* Vt = (const bf16*)(P.ws + WS_VT);
    const int fr = lane & 15, fq = lane >> 4, t = blk * 16 + fr;
    bf16x8 qf[4];
#pragma unroll
    for (int ks = 0; ks < 4; ++ks) qf[ks] = *(const bf16x8*)(z + (size_t)t * DIN + 3 * DCONV + DPOOL + 128 * h + 32 * ks + 8 * fq);
    f32x4 s[16];
#pragma unroll
    for (int kb = 0; kb < 16; ++kb) { s[kb] = (f32x4){0.f, 0.f, 0.f, 0.f};
#pragma unroll
        for (int ks = 0; ks < 4; ++ks) { const bf16x8 kf = *(const bf16x8*)(Kb + (size_t)(16 * kb + fr) * 512 + 128 * h + 32 * ks + 8 * fq); s[kb] = __builtin_amdgcn_mfma_f32_16x16x32_bf16(kf, qf[ks], s[kb], 0, 0, 0); } }
    float mx = -3.0e38f;
#pragma unroll
    for (int kb = 0; kb < 16; ++kb) mx = fmaxf(fmaxf(fmaxf(s[kb][0], s[kb][1]), fmaxf(s[kb][2], s[kb][3])), mx);
    mx = fmaxf(mx, __shfl_xor(mx, 16)); mx = fmaxf(mx, __shfl_xor(mx, 32));
    const float c2 = 0.08838834764831845f * 1.4426950408889634f;
    float sum = 0.f;
#pragma unroll
    for (int kb = 0; kb < 16; ++kb)
#pragma unroll
        for (int r = 0; r < 4; ++r) { const float p = __builtin_amdgcn_exp2f((s[kb][r] - mx) * c2); s[kb][r] = p; sum += p; }
    sum += __shfl_xor(sum, 16); sum += __shfl_xor(sum, 32);
    const float inv = 1.0f / sum;
    f32x4 o[8];
#pragma unroll
    for (int db = 0; db < 8; ++db) o[db] = (f32x4){0.f, 0.f, 0.f, 0.f};
#pragma unroll
    for (int ks = 0; ks < 8; ++ks) {
        u32x4 pw; pw.x = pk2(s[2 * ks][0], s[2 * ks][1]); pw.y = pk2(s[2 * ks][2], s[2 * ks][3]); pw.z = pk2(s[2 * ks + 1][0], s[2 * ks + 1][1]); pw.w = pk2(s[2 * ks + 1][2], s[2 * ks + 1][3]);
        const bf16x8 pf = __builtin_bit_cast(bf16x8, pw);
#pragma unroll
        for (int db = 0; db < 8; ++db) { const bf16x8 vf = *(const bf16x8*)(Vt + (size_t)(128 * h + 16 * db + fr) * 256 + 32 * ks + 8 * fq); o[db] = __builtin_amdgcn_mfma_f32_16x16x32_bf16(vf, pf, o[db], 0, 0, 0); }
    }
#pragma unroll
    for (int db = 0; db < 8; ++db) { u32x2 w; w.x = pk2(o[db][0] * inv, o[db][1] * inv); w.y = pk2(o[db][2] * inv, o[db][3] * inv);
        *(u32x2*)(mix + (size_t)t * DMODEL + DCONV + DPOOL + 128 * h + 16 * db + 4 * fq) = w; }
}
template <int R, int C, int PCH> __device__ __forceinline__ void lds_stage_rows(LAS unsigned char* dst, const unsigned char* src, int gp, int tid) {
    constexpr int N = R * C, PER = (N + 511) / 512;
    u32x4 v[PER];
#pragma unroll
    for (int i = 0; i < PER; ++i) { const int idx = tid + 512 * i; if (idx < N) { const int row = idx / C, ch = idx % C; v[i] = *(const u32x4*)(src + (size_t)row * gp + ch * 16); } }
#pragma unroll
    for (int i = 0; i < PER; ++i) { const int idx = tid + 512 * i; if (idx < N) { const int row = idx / C, ch = idx % C; *(LAS u32x4*)(dst + row * (PCH * 16) + (((ch & ~15) | ((ch & 15) ^ (row & 15))) << 4)) = v[i]; } }
}
template <int N> __device__ __forceinline__ float dpp_shrN(float old, float src) { return __builtin_bit_cast(float, __builtin_amdgcn_update_dpp(__builtin_bit_cast(int, old), __builtin_bit_cast(int, src), 0x110 + N, 0xf, 0xf, false)); }
template <int N> __device__ __forceinline__ float dpp_rorN(float src) { return __builtin_bit_cast(float, __builtin_amdgcn_update_dpp(__builtin_bit_cast(int, src), __builtin_bit_cast(int, src), 0x120 + N, 0xf, 0xf, false)); }
template <int N> __device__ __forceinline__ float scan_step(float x, float p) { return x + dpp_shrN<N>(dpp_rorN<N>(p), x); }
template <int N> __device__ __forceinline__ float scan_step_prev(float p) { return p + dpp_shrN<N>(0.f, p); }

__device__ __forceinline__ void mix_attn_wave(const Ptrs& P, LAS unsigned char* ldsK, LAS unsigned char* ldsV, int h, int row0, int lane) {
    const bf16* z = (const bf16*)(P.ws + WS_Z); bf16* mix = (bf16*)(P.ws + WS_MIX);
    const int fr = lane & 15, fq = lane >> 4;
    bf16x8 q0[4], q1[4];
#pragma unroll
    for (int ks = 0; ks < 4; ++ks) { const bf16* qp = z + (size_t)(row0 + fr) * DIN + 3 * DCONV + DPOOL + 128 * h + 32 * ks + 8 * fq; q0[ks] = *(const bf16x8*)qp; q1[ks] = *(const bf16x8*)(qp + 16 * DIN); }
    unsigned offk[4];
#pragma unroll
    for (int ks = 0; ks < 4; ++ks) offk[ks] = (unsigned)(fr * 256 + (((4 * ks + fq) ^ fr) << 4));
    f32x4 s0[16], s1[16];
#pragma unroll
    for (int kb = 0; kb < 16; ++kb) { s0[kb] = (f32x4){0.f, 0.f, 0.f, 0.f}; s1[kb] = (f32x4){0.f, 0.f, 0.f, 0.f};
#pragma unroll
        for (int ks = 0; ks < 4; ++ks) { const bf16x8 kf = *(const LAS bf16x8*)(ldsK + kb * 4096 + offk[ks]);
            s0[kb] = __builtin_amdgcn_mfma_f32_16x16x32_bf16(kf, q0[ks], s0[kb], 0, 0, 0); s1[kb] = __builtin_amdgcn_mfma_f32_16x16x32_bf16(kf, q1[ks], s1[kb], 0, 0, 0); } }
    const float c2 = 0.08838834764831845f * 1.4426950408889634f;
    bf16x8 p0[8], p1[8]; float inv0, inv1;
    {   float mx = -3.0e38f;
#pragma unroll
        for (int kb = 0; kb < 16; ++kb) mx = fmaxf(fmaxf(fmaxf(s0[kb][0], s0[kb][1]), fmaxf(s0[kb][2], s0[kb][3])), mx);
        mx = fmaxf(mx, __shfl_xor(mx, 16)); mx = fmaxf(mx, __shfl_xor(mx, 32));
        float sum = 0.f;
#pragma unroll
        for (int ks = 0; ks < 8; ++ks) { float e[8];
#pragma unroll
            for (int r = 0; r < 4; ++r) { e[r] = __builtin_amdgcn_exp2f((s0[2 * ks][r] - mx) * c2); e[4 + r] = __builtin_amdgcn_exp2f((s0[2 * ks + 1][r] - mx) * c2); }
            sum += ((e[0] + e[1]) + (e[2] + e[3])) + ((e[4] + e[5]) + (e[6] + e[7]));
            p0[ks] = __builtin_bit_cast(bf16x8, pack8(e)); }
        sum += __shfl_xor(sum, 16); sum += __shfl_xor(sum, 32); inv0 = 1.0f / sum; }
    {   float mx = -3.0e38f;
#pragma unroll
        for (int kb = 0; kb < 16; ++kb) mx = fmaxf(fmaxf(fmaxf(s1[kb][0], s1[kb][1]), fmaxf(s1[kb][2], s1[kb][3])), mx);
        mx = fmaxf(mx, __shfl_xor(mx, 16)); mx = fmaxf(mx, __shfl_xor(mx, 32));
        float sum = 0.f;
#pragma unroll
        for (int ks = 0; ks < 8; ++ks) { float e[8];
#pragma unroll
            for (int r = 0; r < 4; ++r) { e[r] = __builtin_amdgcn_exp2f((s1[2 * ks][r] - mx) * c2); e[4 + r] = __builtin_amdgcn_exp2f((s1[2 * ks + 1][r] - mx) * c2); }
            sum += ((e[0] + e[1]) + (e[2] + e[3])) + ((e[4] + e[5]) + (e[6] + e[7]));
            p1[ks] = __builtin_bit_cast(bf16x8, pack8(e)); }
        sum += __shfl_xor(sum, 16); sum += __shfl_xor(sum, 32); inv1 = 1.0f / sum; }
    f32x4 o0[8], o1[8];
#pragma unroll
    for (int db = 0; db < 8; ++db) { o0[db] = (f32x4){0.f, 0.f, 0.f, 0.f}; o1[db] = (f32x4){0.f, 0.f, 0.f, 0.f}; }
#pragma unroll
    for (int ks = 0; ks < 8; ++ks) {
        const unsigned offv = (unsigned)(fr * 512 + ((ks >> 2) << 8) + (((4 * (ks & 3) + fq) ^ fr) << 4));
#pragma unroll
        for (int db = 0; db < 8; ++db) { const bf16x8 vf = *(const LAS bf16x8*)(ldsV + db * 8192 + offv);
            o0[db] = __builtin_amdgcn_mfma_f32_16x16x32_bf16(vf, p0[ks], o0[db], 0, 0, 0); o1[db] = __builtin_amdgcn_mfma_f32_16x16x32_bf16(vf, p1[ks], o1[db], 0, 0, 0); } }
    bf16* op = mix + (size_t)(row0 + fr) * DMODEL + DCONV + DPOOL + 128 * h + 4 * fq;
#pragma unroll
    for (int db = 0; db < 8; ++db) { u32x2 w; w.x = pk2(o0[db][0] * inv0, o0[db][1] * inv0); w.y = pk2(o0[db][2] * inv0, o0[db][3] * inv0); *(u32x2*)(op + 16 * db) = w;
        w.x = pk2(o1[db][0] * inv1, o1[db][1] * inv1); w.y = pk2(o1[db][2] * inv1, o1[db][3] * inv1); *(u32x2*)(op + (size_t)16 * DMODEL + 16 * db) = w; }
}

template <int g> __device__ __forceinline__ void mix_pool_wave(const Ptrs& P, LAS unsigned char* ldsW, int row0, int lane) {
    constexpr int k = 2 << g;
    const bf16* z = (const bf16*)(P.ws + WS_Z); bf16* mix = (bf16*)(P.ws + WS_MIX);
    const int fr = lane & 15, fq = lane >> 4;
    f32x4 acc0[12], acc1[12];
#pragma unroll
    for (int n = 0; n < 12; ++n) { acc0[n] = (f32x4){0.f, 0.f, 0.f, 0.f}; acc1[n] = (f32x4){0.f, 0.f, 0.f, 0.f}; }
    const float invA = 1.0f / (float)((row0 + fr + 1 < k) ? row0 + fr + 1 : k), invB = 1.0f / (float)((row0 + 16 + fr + 1 < k) ? row0 + 16 + fr + 1 : k);
#pragma unroll 1
    for (int ks = 0; ks < 6; ++ks) {
        const bf16* zp = z + (long)(row0 - 16 + fr) * DIN + 3 * DCONV + PGD * g + 32 * ks + 8 * fq;
        float pv[8], xa[8], xb[8], sa[8], sb[8];
        unpack8(*(const u32x4*)zp, pv); unpack8(*(const u32x4*)(zp + 16 * DIN), xa); unpack8(*(const u32x4*)(zp + 32 * DIN), xb);
#pragma unroll
        for (int e = 0; e < 8; ++e) {
            float p = pv[e], a = xa[e], b = xb[e];
            float b1 = scan_step<1>(b, a), a1 = scan_step<1>(a, p), p1 = scan_step_prev<1>(p);
            if (k >= 4) { const float b2 = scan_step<2>(b1, a1), a2 = scan_step<2>(a1, p1), p2 = scan_step_prev<2>(p1); b1 = b2; a1 = a2; p1 = p2; }
            if (k >= 8) { const float b2 = scan_step<4>(b1, a1), a2 = scan_step<4>(a1, p1), p2 = scan_step_prev<4>(p1); b1 = b2; a1 = a2; p1 = p2; }
            if (k >= 16) { const float b2 = scan_step<8>(b1, a1), a2 = scan_step<8>(a1, p1); b1 = b2; a1 = a2; }
            sa[e] = a1 * invA - a; sb[e] = b1 * invB - b; }
        const bf16x8 fa = __builtin_bit_cast(bf16x8, pack8(sa)), fb = __builtin_bit_cast(bf16x8, pack8(sb));
        const unsigned offw = (unsigned)(fr * 512 + ((ks >> 2) << 8) + (((4 * (ks & 3) + fq) ^ fr) << 4));
#pragma unroll
        for (int n = 0; n < 12; ++n) { const bf16x8 wf = *(const LAS bf16x8*)(ldsW + n * 8192 + offw);
            acc0[n] = __builtin_amdgcn_mfma_f32_16x16x32_bf16(wf, fa, acc0[n], 0, 0, 0); acc1[n] = __builtin_amdgcn_mfma_f32_16x16x32_bf16(wf, fb, acc1[n], 0, 0, 0); }
    }
    bf16* op = mix + (size_t)(row0 + fr) * DMODEL + DCONV + PGD * g + 4 * fq;
#pragma unroll
    for (int n = 0; n < 12; ++n) { const f32x4 sc = *(const f32x4*)(P.pool_scale + PGD * g + 16 * n + 4 * fq);
        u32x2 o; o.x = pk2(acc0[n][0] * sc[0], acc0[n][1] * sc[1]); o.y = pk2(acc0[n][2] * sc[2], acc0[n][3] * sc[3]); *(u32x2*)(op + 16 * n) = o;
        o.x = pk2(acc1[n][0] * sc[0], acc1[n][1] * sc[1]); o.y = pk2(acc1[n][2] * sc[2], acc1[n][3] * sc[3]); *(u32x2*)(op + (size_t)16 * DMODEL + 16 * n) = o; }
}

__device__ __forceinline__ void p2_mixer(const Ptrs& P, LAS unsigned char* lds, int w, int tid, int wave, int lane, int tmask) {
    const int sub = w & 3, tile = w >> 2, row0 = tile * 256 + wave * 32;
    if (tmask & 0x1e0) {
        lds_stage_rows<256, 16, 16>(lds, (const unsigned char*)(P.ws + WS_KB) + 256 * sub, 1024, tid);
        lds_stage_rows<128, 32, 32>(lds + 65536, (const unsigned char*)(P.ws + WS_VT) + (size_t)sub * 128 * 512, 512, tid);
        LDS_WAIT(); __syncthreads();
        mix_attn_wave(P, lds, lds + 65536, sub, row0, lane);
        __syncthreads();
    }
    if (tmask & 0x1e) {
        lds_stage_rows<192, 24, 32>(lds, (const unsigned char*)(P.ws + WS_POOLWT) + (size_t)sub * PGD * PGD * 2, PGD * 2, tid);
        LDS_WAIT(); __syncthreads();
        if (sub == 0) mix_pool_wave<0>(P, lds, row0, lane); else if (sub == 1) mix_pool_wave<1>(P, lds, row0, lane); else if (sub == 2) mix_pool_wave<2>(P, lds, row0, lane); else mix_pool_wave<3>(P, lds, row0, lane);
        __syncthreads();
    }
    if (tmask & 1) { for (int b = wave; b < 4; b += 8) mix_conv_task(P, 4 * w + b, lane); }
}

__device__ __forceinline__ void p5_fixup(const Ptrs& P, int gt, int NGT) {
    const float* ub = (const float*)(P.ws + WS_UBND); bf16* act = (bf16*)(P.ws + WS_ACT); const float* cw = P.ffn_conv_w; const float* cb = P.ffn_conv_b;
    for (int i = gt; i < 63 * (DFF / 8); i += NGT) {
        const int pm = 1 + i / (DFF / 8), c = (i % (DFF / 8)) * 8, gi = 256 * (c / 128) + (c % 128);
        const float* p2 = ub + (size_t)((pm - 1) * 4 + 2) * DFF2 + gi; const float* p1 = p2 + DFF2; const float* r0 = ub + (size_t)(pm * 4) * DFF2 + gi; const float* r1 = r0 + DFF2;
        float o0[8], o1[8];
#pragma unroll
        for (int e = 0; e < 8; ++e) {
            const float gw0 = cw[c + e], gw1 = cw[DFF2 + c + e], gw2 = cw[2 * DFF2 + c + e], gb = cb[c + e], vw0 = cw[DFF + c + e], vw1 = cw[DFF2 + DFF + c + e], vw2 = cw[2 * DFF2 + DFF + c + e], vb = cb[DFF + c + e];
            const float G0 = gw2 * r0[e] + (gw1 * p1[e] + (gw0 * p2[e] + gb)), V0 = vw2 * r0[128 + e] + (vw1 * p1[128 + e] + (vw0 * p2[128 + e] + vb));
            const float G1 = gw2 * r1[e] + (gw1 * r0[e] + (gw0 * p1[e] + gb)), V1 = vw2 * r1[128 + e] + (vw1 * r0[128 + e] + (vw0 * p1[128 + e] + vb));
            o0[e] = G0 * __builtin_amdgcn_rcpf(1.0f + __builtin_amdgcn_exp2f(-1.4426950408889634f * G0)) * V0;
            o1[e] = G1 * __builtin_amdgcn_rcpf(1.0f + __builtin_amdgcn_exp2f(-1.4426950408889634f * G1)) * V1; }
        *(u32x4*)(act + (size_t)(256 * pm) * DFF + c) = pack8(o0); *(u32x4*)(act + (size_t)(256 * pm + 1) * DFF + c) = pack8(o1);
    }
}

__device__ __forceinline__ void p7_final(const Ptrs& P, int gw, int NGW, int lane) {
    const float* slab = (const float*)(P.ws + WS_SLAB2);
    for (int m = gw; m < SEQ; m += NGW) {
        const float part = (lane < 32) ? slab[(size_t)m * 32 + lane] : 0.f;
        const float rstd = 1.0f / sqrtf(wave_sum(part) * (1.0f / DMODEL) + EPS);
        f32x4* xr = (f32x4*)(P.out + (size_t)m * DMODEL) + lane; const f32x4* gr = (const f32x4*)P.g_final + lane;
#pragma unroll
        for (int j = 0; j < 8; ++j) { f32x4 v = xr[64 * j]; const f32x4 gg = gr[64 * j]; v = v * rstd * gg; xr[64 * j] = v; }
    }
}

struct Args { const float* in[16]; float* out; unsigned char* ws; int ph_lo, ph_hi; };
__global__ void __launch_bounds__(NWAVES * 64, 2) hybrid_fwd(Args args) {
    extern __shared__ __attribute__((aligned(16))) unsigned char lds_raw[];
    LAS unsigned char* lds = (LAS unsigned char*)lds_raw;
    cg::grid_group grid = cg::this_grid();
    const int tid = threadIdx.x, lane = tid & 63, wave = __builtin_amdgcn_readfirstlane(tid >> 6);
    const int G = gridDim.x, bx = blockIdx.x, vcu = (G % 8 == 0) ? (bx % 8) * (G / 8) + bx / 8 : bx;
    const int gw = vcu * NWAVES + wave, NGW = G * NWAVES;
    volatile LAS unsigned* MISC = (volatile LAS unsigned*)(lds + MISC_OFF);
    if (tid < 32) MISC[tid] = 0u;
    __syncthreads();
    const XcdBarrier bar = xcd_barrier_post((unsigned*)(args.ws + WS_CTL), MISC + 8);
    Ptrs P;
    P.x = args.in[0]; P.mem = args.in[1]; P.g_mix = args.in[2]; P.g_mem = args.in[3]; P.w_in = args.in[4]; P.conv_w = args.in[5]; P.pool_w = args.in[6]; P.pool_scale = args.in[7];
    P.w_kv = args.in[8]; P.w_out = args.in[9]; P.g_ffn = args.in[10]; P.w_up = args.in[11]; P.ffn_conv_w = args.in[12]; P.ffn_conv_b = args.in[13]; P.w_down = args.in[14]; P.g_final = args.in[15];
    P.out = args.out; P.ws = args.ws;
    unsigned char* ws = args.ws;
#if PROBE_SYNC
    for (int i = 0; i < 20; ++i) xcd_barrier(bar);
#endif
    const int lo = args.ph_lo, hi = args.ph_hi;
#define IN(k) (lo <= (k) && (k) < hi)
#define SYNC(k) do { if ((k) + 1 < hi) { if ((k) == 0 && USE_CG_SYNC) grid.sync(); else xcd_barrier(bar); } } while (0)
#define SYNCR(k, b) do { if ((k) + 1 < hi || rp + 1 < NREP(b)) { if ((k) == 0 && USE_CG_SYNC) grid.sync(); else xcd_barrier(bar); } } while (0)
#define NREP(b) ((REPM & (b)) ? 2 : 1)
    if (IN(0) && (PHM & 1)) for (int rp = 0; rp < NREP(1); ++rp) { p0_prologue(P, lds, gw, NGW, wave, lane); SYNCR(0, 1); }
    if (IN(1) && (PHM & 2)) for (int rp = 0; rp < NREP(2); ++rp) {
        pg8::Gemm g{(const bf16*)(ws + WS_H), (const bf16*)(ws + WS_WINT), SEQ, DIN, DMODEL}; pg8::StaticOrder S; S.init(SEQ, DIN, G, bx);
        pg8::EpiZ E{(bf16*)(ws + WS_Z), DIN};
        pg8::gemm_phase<pg8::EpiZ, pg8::StaticOrder, true, true>(lds, g, S, E, lds + XLDS_OFF);
        if (wave < 4) { for (int tt = vcu * 4 + wave; tt < 1024; tt += G * 4) kv_tile(P, tt, lane); }
        SYNCR(1, 2);
    }
    if (IN(2) && (PHM & 4)) for (int rp = 0; rp < NREP(4); ++rp) { p2_mixer(P, lds, vcu, tid, wave, lane, 511);
#if PROBE_P2
        p2_mixer(P, lds, vcu, tid, wave, lane, PROBE_P2);
#endif
        SYNCR(2, 4); }
    if (IN(3) && (PHM & 8)) for (int rp = 0; rp < NREP(8); ++rp) {
        pg8::Gemm g{(const bf16*)(ws + WS_MIX), (const bf16*)(ws + WS_WOUTT), SEQ, DMODEL, DMODEL}; pg8::StaticOrder S; S.init(SEQ, DMODEL, G, bx);
        pg8::EpiResA E{P.x, (bf16*)(ws + WS_X1B), (float*)(ws + WS_SLAB1)};
        pg8::gemm_phase<pg8::EpiResA, pg8::StaticOrder, true, true>(lds, g, S, E, lds + XLDS_OFF);
        SYNCR(3, 8);
    }
#if PROBE_GEMM
    if (IN(3)) {
        pg8::Gemm g{(const bf16*)(ws + WS_X1B), (const bf16*)(ws + WS_WUPT), SEQ, PROBE_N, DMODEL}; pg8::StaticOrder S; S.init(SEQ, PROBE_N, G, bx);
#if PROBE_GEMM == 1
        pg8::EpiZ E{(bf16*)(ws + WS_Z), PROBE_N};
        pg8::gemm_phase<pg8::EpiZ, pg8::StaticOrder, true, true>(lds, g, S, E, lds + XLDS_OFF);
#elif PROBE_GEMM == 2
        pg8::EpiNone E{};
        pg8::gemm_phase<pg8::EpiNone, pg8::StaticOrder, true, true>(lds, g, S, E, lds + XLDS_OFF);
#elif PROBE_GEMM == 3
        pg8::EpiZ E{(bf16*)(ws + WS_Z), PROBE_N};
        pg8::gemm_phase<pg8::EpiZ, pg8::StaticOrder, true, false>(lds, g, S, E, lds + XLDS_OFF);
#elif PROBE_GEMM == 5
        pg8::EpiAct E{(bf16*)(ws + WS_ACT), (const float*)(ws + WS_SLAB1), P.ffn_conv_w, P.ffn_conv_b, (float*)(ws + WS_UBND)};
        pg8::gemm_phase<pg8::EpiAct, pg8::StaticOrder, true, true>(lds, g, S, E, lds + XLDS_OFF);
#elif PROBE_GEMM == 4
        pg8::EpiZ E{(bf16*)(ws + WS_Z), PROBE_N};
        pg8::gemm_phase<pg8::EpiZ, pg8::StaticOrder, false, true>(lds, g, S, E, lds + XLDS_OFF);
#endif
        xcd_barrier(bar);
    }
#endif
    if (IN(4) && (PHM & 16)) for (int rp = 0; rp < NREP(16); ++rp) {
        pg8::Gemm g{(const bf16*)(ws + WS_X1B), (const bf16*)(ws + WS_WUPT), SEQ, DFF2, DMODEL}; pg8::StaticOrder S; S.init(SEQ, DFF2, G, bx);
        pg8::EpiAct E{(bf16*)(ws + WS_ACT), (const float*)(ws + WS_SLAB1), P.ffn_conv_w, P.ffn_conv_b, (float*)(ws + WS_UBND)};
        pg8::gemm_phase<pg8::EpiAct, pg8::StaticOrder, true, true>(lds, g, S, E, lds + XLDS_OFF);
        xcd_barrier(bar);
    }
    if (IN(5) && (PHM & 32)) { p5_fixup(P, vcu * (NWAVES * 64) + tid, G * NWAVES * 64); xcd_barrier(bar); }
    if (IN(6) && (PHM & 64)) {
        pg8::Gemm g{(const bf16*)(ws + WS_ACT), (const bf16*)(ws + WS_WDOWNT), SEQ, DMODEL, DFF}; pg8::PanelOrder S{G, vcu, (SEQ / 256) * (DMODEL / 256)};
        pg8::EpiFinal E{(const bf16*)(ws + WS_X1B), P.out, P.g_final, (unsigned*)(ws + WS_SLAB2), (unsigned*)(ws + WS_CTL) + CW_PANEL, (unsigned*)(ws + WS_CTL) + XB_TMO};
        pg8::gemm_phase<pg8::EpiFinal, pg8::PanelOrder, true, true>(lds, g, S, E, lds + XLDS_OFF);
    }
#undef IN
#undef SYNC
}

extern "C" void kernel_launch(void* const* d_in, const int* in_sizes, int n_in, void* d_out, int out_size, void* d_ws, size_t ws_size, hipStream_t stream) {
    static int grid = 0;
    if (grid == 0) {
        if (n_in != 16 || in_sizes[0] != SEQ * DMODEL || out_size != SEQ * DMODEL || ws_size < WS_END) { fprintf(stderr, "kernel_launch: unexpected shapes (n_in %d, in0 %d, out %d, ws %zu)\n", n_in, n_in > 0 ? in_sizes[0] : -1, out_size, ws_size); grid = -1; return; }
        int dev = 0, cus = 0, per_cu = 0;
        if (hipGetDevice(&dev) != hipSuccess || hipDeviceGetAttribute(&cus, hipDeviceAttributeMultiprocessorCount, dev) != hipSuccess) { grid = -1; return; }
        if (hipFuncSetAttribute((const void*)hybrid_fwd, hipFuncAttributeMaxDynamicSharedMemorySize, LDS_BYTES) != hipSuccess) { fprintf(stderr, "kernel_launch: hipFuncSetAttribute failed\n"); grid = -1; return; }
        if (hipOccupancyMaxActiveBlocksPerMultiprocessor(&per_cu, (const void*)hybrid_fwd, NWAVES * 64, LDS_BYTES) != hipSuccess || per_cu < 1) { fprintf(stderr, "kernel_launch: occupancy query says %d blocks per CU\n", per_cu); (void)hipGetLastError(); per_cu = 1; }
        grid = cus;
        if (grid % 8 != 0 || grid < 8) { fprintf(stderr, "kernel_launch: %d CUs\n", grid); }
    }
    if (grid < 0) return;
    if (hipMemsetAsync((char*)d_ws + WS_CTL, 0, CTL_ZERO_BYTES, stream) != hipSuccess) { fprintf(stderr, "kernel_launch: hipMemsetAsync failed\n"); return; }
    Args a{};
    for (int i = 0; i < 16; ++i) a.in[i] = (const float*)d_in[i];
    a.out = (float*)d_out; a.ws = (unsigned char*)d_ws;
#if MK_PER_PHASE
    for (int ph = 0; ph < NPHASE; ++ph) { a.ph_lo = ph; a.ph_hi = ph + 1; hipLaunchKernelGGL(hybrid_fwd, dim3(grid), dim3(NWAVES * 64), LDS_BYTES, stream, a); }
#else
    a.ph_lo = 0; a.ph_hi = NPHASE;
    void* kargs[] = {&a};
    hipError_t e = hipLaunchCooperativeKernel((const void*)hybrid_fwd, dim3(grid), dim3(NWAVES * 64), kargs, LDS_BYTES, stream);
    if (e != hipSuccess) fprintf(stderr, "kernel_launch: cooperative launch failed: %s (grid %d)\n", hipGetErrorString(e), grid);
#endif
}
```

```cpp
#include <hip/hip_runtime.h>
#include <hip/hip_cooperative_groups.h>
#include <cstdio>
#include <cstdint>
namespace cg = cooperative_groups;
namespace pg8 {
#define PG8_LAS __attribute__((address_space(3)))
typedef unsigned short bf16_t;
typedef short bf16x8 __attribute__((ext_vector_type(8)));
typedef float f32x4 __attribute__((ext_vector_type(4)));
typedef unsigned u32x4 __attribute__((ext_vector_type(4)));
constexpr int BM = 256, BK = 64, HALF = 128, HTB = HALF * BK * 2  , STAGE_BYTES = 8 * HTB, NXCD = 8, WGM = 8;

__host__ __device__ __forceinline__ int lds_byte(int r, int c) { const int st = (r >> 4) * 2 + (c >> 5), rr = r & 15, cc = c & 31, ob = rr * 64 + cc * 2; return st * 1024 + (ob ^ (((ob >> 9) & 1) << 5)); }
__host__ __device__ __forceinline__ void stage_rc(int b, int& R, int& C) { const int st = b / 1024, sb = b % 1024, swz = sb ^ (((sb >> 9) & 1) << 5); R = (st >> 1) * 16 + swz / 64; C = (st & 1) * 32 + (swz % 64) / 2; }
__host__ __device__ __forceinline__ int perm32(int rho) { const int n = rho >> 4, i = rho & 15; return 8 * (i >> 2) + 4 * n + (i & 3); }

struct Unit { int pm, pn; };
struct Gemm { const bf16_t* A; const bf16_t* Bt; int M, N, K; };

struct StaticOrder {
    int nM, nN, nwg, G, c;
    __host__ __device__ void init(int M, int N, int G_, int c_) { nM = M / BM; nN = N / BM; nwg = nM * nN; G = G_; c = c_; }
    __host__ __device__ bool next(int i, Unit& u) const {
        const long L = (long)i * G + c; if (L >= nwg) return false;
        int wgid = (int)L; { const int q = nwg / NXCD, r = nwg % NXCD, xcd = wgid % NXCD, off = wgid / NXCD; wgid = (xcd < r ? xcd * (q + 1) : r * (q + 1) + (xcd - r) * q) + off; }
        const int nig = WGM * nN, gid = wgid / nig, fm = gid * WGM, gsz = (nM - fm) < WGM ? (nM - fm) : WGM;
        u.pm = fm + ((wgid % nig) % gsz); u.pn = (wgid % nig) / gsz; return true;
    }
    __device__ __forceinline__ void a_ready(const Unit&) const {}
    __device__ __forceinline__ void done(const Unit&) const {}
};
__device__ __forceinline__ unsigned cvt_pk_bf16(float lo, float hi) { unsigned r; asm volatile("v_cvt_pk_bf16_f32 %0, %1, %2" : "=v"(r) : "v"(lo), "v"(hi)); return r; }
typedef unsigned u32x2 __attribute__((ext_vector_type(2)));
constexpr int DM = 2048;
constexpr float RMS_EPS = 1e-6f;

struct EpiZ {
    static constexpr bool PERM = true, AFTER_DRAIN = false;
    bf16_t* O; int ldc;
    __device__ __forceinline__ void operator()(const f32x4 (&acc)[2][2][4][2], const Unit& u, int wr, int wc, int fr_, int fq_, PG8_LAS unsigned char*) const {
        int t_ = threadIdx.x; asm volatile("" : "+v"(t_));
        const int fr = t_ & 15, fq = (t_ >> 4) & 3;
        const int row0 = u.pm * BM + wr * 64 + fr, col0 = u.pn * BM + wc * 32 + 8 * fq;
#pragma unroll
        for (int ai = 0; ai < 2; ++ai)
#pragma unroll
            for (int m = 0; m < 4; ++m) { bf16_t* rowp = O + (size_t)(row0 + ai * HALF + m * 16) * ldc + col0;
#pragma unroll
                for (int bj = 0; bj < 2; ++bj) { const f32x4 v0 = acc[ai][bj][m][0], v1 = acc[ai][bj][m][1];
                    u32x4 w; w.x = cvt_pk_bf16(v0[0], v0[1]); w.y = cvt_pk_bf16(v0[2], v0[3]); w.z = cvt_pk_bf16(v1[0], v1[1]); w.w = cvt_pk_bf16(v1[2], v1[3]);
                    *(u32x4*)(rowp + bj * HALF) = w; } }
    }
};

struct EpiNone {
    static constexpr bool PERM = true, AFTER_DRAIN = false;
    __device__ __forceinline__ void operator()(const f32x4 (&acc)[2][2][4][2], const Unit& u, int wr, int wc, int fr, int fq, PG8_LAS unsigned char*) const {
#pragma unroll
        for (int ai = 0; ai < 2; ++ai)
#pragma unroll
            for (int bj = 0; bj < 2; ++bj)
#pragma unroll
                for (int m = 0; m < 4; ++m)
#pragma unroll
                    for (int n = 0; n < 2; ++n) asm volatile("" :: "v"(acc[ai][bj][m][n]));
    }
};
struct EpiResA {
    static constexpr bool PERM = true, AFTER_DRAIN = false;
    const float* R; bf16_t* XB; float* slab;
    __device__ __forceinline__ void operator()(const f32x4 (&acc)[2][2][4][2], const Unit& u, int wr, int wc, int fr_, int fq_, PG8_LAS unsigned char*) const {
        int t_ = threadIdx.x; asm volatile("" : "+v"(t_));
        const int fr = t_ & 15, fq = (t_ >> 4) & 3;
        const int row0 = u.pm * BM + wr * 64 + fr, col0 = u.pn * BM + wc * 32 + 8 * fq;
#pragma unroll
        for (int ai = 0; ai < 2; ++ai) {
            f32x4 r[4][2][2];
#pragma unroll
            for (int m = 0; m < 4; ++m)
#pragma unroll
                for (int bj = 0; bj < 2; ++bj) { const float* p = R + (size_t)(row0 + ai * HALF + m * 16) * DM + col0 + bj * HALF; r[m][bj][0] = *(const f32x4*)p; r[m][bj][1] = *(const f32x4*)(p + 4); }
#pragma unroll
            for (int m = 0; m < 4; ++m) { const int row = row0 + ai * HALF + m * 16; float ss = 0.f;
#pragma unroll
                for (int bj = 0; bj < 2; ++bj) { const f32x4 v0 = acc[ai][bj][m][0] + r[m][bj][0], v1 = acc[ai][bj][m][1] + r[m][bj][1];
                    u32x4 w; w.x = cvt_pk_bf16(v0[0], v0[1]); w.y = cvt_pk_bf16(v0[2], v0[3]); w.z = cvt_pk_bf16(v1[0], v1[1]); w.w = cvt_pk_bf16(v1[2], v1[3]);
                    *(u32x4*)(XB + (size_t)row * DM + col0 + bj * HALF) = w;
                    ss += (v0[0] * v0[0] + v0[1] * v0[1]) + (v0[2] * v0[2] + v0[3] * v0[3]) + (v1[0] * v1[0] + v1[1] * v1[1]) + (v1[2] * v1[2] + v1[3] * v1[3]); }
                ss += __shfl_xor(ss, 16); ss += __shfl_xor(ss, 32);
                if (fq == 0) slab[(size_t)row * 32 + u.pn * 4 + wc] = ss; }
            asm volatile("" ::: "memory"); }
    }
};
struct EpiResB {
    static constexpr bool PERM = true, AFTER_DRAIN = false;
    const bf16_t* RB; float* X; float* slab;
    __device__ __forceinline__ void operator()(const f32x4 (&acc)[2][2][4][2], const Unit& u, int wr, int wc, int fr_, int fq_, PG8_LAS unsigned char*) const {
        int t_ = threadIdx.x; asm volatile("" : "+v"(t_));
        const int fr = t_ & 15, fq = (t_ >> 4) & 3;
        const int row0 = u.pm * BM + wr * 64 + fr, col0 = u.pn * BM + wc * 32 + 8 * fq;
        u32x4 r[2][4][2];
#pragma unroll
        for (int ai = 0; ai < 2; ++ai)
#pragma unroll
            for (int m = 0; m < 4; ++m)
#pragma unroll
                for (int bj = 0; bj < 2; ++bj) r[ai][m][bj] = *(const u32x4*)(RB + (size_t)(row0 + ai * HALF + m * 16) * DM + col0 + bj * HALF);
#pragma unroll
        for (int ai = 0; ai < 2; ++ai)
#pragma unroll
            for (int m = 0; m < 4; ++m) { const int row = row0 + ai * HALF + m * 16; float ss = 0.f;
#pragma unroll
                for (int bj = 0; bj < 2; ++bj) { const u32x4 q = r[ai][m][bj];
                    const f32x4 r0 = {__builtin_bit_cast(float, q.x << 16), __builtin_bit_cast(float, q.x & 0xffff0000u), __builtin_bit_cast(float, q.y << 16), __builtin_bit_cast(float, q.y & 0xffff0000u)};
                    const f32x4 r1 = {__builtin_bit_cast(float, q.z << 16), __builtin_bit_cast(float, q.z & 0xffff0000u), __builtin_bit_cast(float, q.w << 16), __builtin_bit_cast(float, q.w & 0xffff0000u)};
                    const f32x4 v0 = acc[ai][bj][m][0] + r0, v1 = acc[ai][bj][m][1] + r1;
                    float* xp = X + (size_t)row * DM + col0 + bj * HALF; *(f32x4*)xp = v0; *(f32x4*)(xp + 4) = v1;
                    ss += (v0[0] * v0[0] + v0[1] * v0[1]) + (v0[2] * v0[2] + v0[3] * v0[3]) + (v1[0] * v1[0] + v1[1] * v1[1]) + (v1[2] * v1[2] + v1[3] * v1[3]); }
                ss += __shfl_xor(ss, 16); ss += __shfl_xor(ss, 32);
                if (fq == 0) slab[(size_t)row * 32 + u.pn * 4 + wc] = ss; }
    }
};

struct PanelOrder {
    int G, vcu, ntot;
    __device__ __forceinline__ bool next(int i, Unit& u) const { const int L = i * G + vcu; if (L >= ntot) return false; u.pm = L >> 3; u.pn = L & 7; return true; }
    __device__ __forceinline__ void a_ready(const Unit&) const {}
    __device__ __forceinline__ void done(const Unit&) const {}
};
struct EpiFinal {
    static constexpr bool PERM = true, AFTER_DRAIN = false;
    const bf16_t* RB; float* OUT; const float* gfin; unsigned* xbuf; unsigned* cnt; unsigned* tmo;
    __device__ __forceinline__ void operator()(f32x4 (&acc)[2][2][4][2], const Unit& u, int wr, int wc, int fr_, int fq_, PG8_LAS unsigned char* xlds) const {
        int t_ = threadIdx.x; asm volatile("" : "+v"(t_));
        const int fr = t_ & 15, fq = (t_ >> 4) & 3, wid = __builtin_amdgcn_readfirstlane(t_ >> 6);
        const int rl0 = wr * 64 + fr, row0 = u.pm * BM + rl0, col0 = u.pn * BM + wc * 32 + 8 * fq;
        PG8_LAS float* Pt = (PG8_LAS float*)xlds;
        PG8_LAS float* St = (PG8_LAS float*)(xlds + 4096);
        { u32x4 r[2][4][2];
#pragma unroll
          for (int ai = 0; ai < 2; ++ai)
#pragma unroll
            for (int m = 0; m < 4; ++m)
#pragma unroll
                for (int bj = 0; bj < 2; ++bj) r[ai][m][bj] = *(const u32x4*)(RB + (size_t)(row0 + ai * HALF + m * 16) * DM + col0 + bj * HALF);
#pragma unroll
          for (int ai = 0; ai < 2; ++ai)
#pragma unroll
            for (int m = 0; m < 4; ++m) { float ss = 0.f;
#pragma unroll
                for (int bj = 0; bj < 2; ++bj) { const u32x4 q = r[ai][m][bj];
                    const f32x4 r0 = {__builtin_bit_cast(float, q.x << 16), __builtin_bit_cast(float, q.x & 0xffff0000u), __builtin_bit_cast(float, q.y << 16), __builtin_bit_cast(float, q.y & 0xffff0000u)};
                    const f32x4 r1 = {__builtin_bit_cast(float, q.z << 16), __builtin_bit_cast(float, q.z & 0xffff0000u), __builtin_bit_cast(float, q.w << 16), __builtin_bit_cast(float, q.w & 0xffff0000u)};
                    const f32x4 v0 = acc[ai][bj][m][0] + r0, v1 = acc[ai][bj][m][1] + r1; acc[ai][bj][m][0] = v0; acc[ai][bj][m][1] = v1;
                    ss += (v0[0] * v0[0] + v0[1] * v0[1]) + (v0[2] * v0[2] + v0[3] * v0[3]) + (v1[0] * v1[0] + v1[1] * v1[1]) + (v1[2] * v1[2] + v1[3] * v1[3]); }
                ss += __shfl_xor(ss, 16); ss += __shfl_xor(ss, 32);
                if (fq == 0) Pt[(ai * HALF + rl0 + m * 16) * 4 + wc] = ss; } }
        asm volatile("s_waitcnt lgkmcnt(0)" ::: "memory"); __builtin_amdgcn_s_barrier(); asm volatile("" ::: "memory");
        if (t_ < 256) { const float s = (Pt[t_ * 4 + 0] + Pt[t_ * 4 + 1]) + (Pt[t_ * 4 + 2] + Pt[t_ * 4 + 3]);
            __hip_atomic_store(xbuf + (size_t)(u.pm * BM + t_) * 8 + u.pn, __builtin_bit_cast(unsigned, s), __ATOMIC_RELAXED, __HIP_MEMORY_SCOPE_AGENT); }
        asm volatile("s_waitcnt vmcnt(0)" ::: "memory");
        if (t_ < 256 && (t_ & 63) == 0) __hip_atomic_fetch_add(cnt + 64 * u.pm, 1u, __ATOMIC_RELAXED, __HIP_MEMORY_SCOPE_AGENT);
        if (wid == 0) {
            unsigned spins = 0;
            while ((unsigned)__builtin_amdgcn_readfirstlane(__hip_atomic_load(cnt + 64 * u.pm, __ATOMIC_RELAXED, __HIP_MEMORY_SCOPE_AGENT)) < 32u) {
                __builtin_amdgcn_s_sleep(2);
                if (++spins > (1u << 20)) { if ((t_ & 63) == 0) __hip_atomic_store(tmo, 1u, __ATOMIC_RELAXED, __HIP_MEMORY_SCOPE_AGENT); break; } }
            __builtin_amdgcn_fence(__ATOMIC_ACQUIRE, "agent");
        }
        asm volatile("s_waitcnt vmcnt(0) lgkmcnt(0)" ::: "memory"); __builtin_amdgcn_s_barrier(); asm volatile("" ::: "memory");
        if (t_ < 256) { const unsigned long long* sp = (const unsigned long long*)(xbuf + (size_t)(u.pm * BM + t_) * 8); float tot = 0.f;
#pragma unroll
            for (int q = 0; q < 4; ++q) { const unsigned long long w = __hip_atomic_load(sp + q, __ATOMIC_RELAXED, __HIP_MEMORY_SCOPE_AGENT);
                tot += __builtin_bit_cast(float, (unsigned)w); tot += __builtin_bit_cast(float, (unsigned)(w >> 32)); }
            St[t_] = 1.0f / sqrtf(tot * (1.0f / DM) + RMS_EPS); }
        asm volatile("s_waitcnt lgkmcnt(0)" ::: "memory"); __builtin_amdgcn_s_barrier(); asm volatile("" ::: "memory");
        f32x4 gg[2][2];
#pragma unroll
        for (int bj = 0; bj < 2; ++bj) { gg[bj][0] = *(const f32x4*)(gfin + col0 + bj * HALF); gg[bj][1] = *(const f32x4*)(gfin + col0 + bj * HALF + 4); }
#pragma unroll
        for (int ai = 0; ai < 2; ++ai)
#pragma unroll
            for (int m = 0; m < 4; ++m) { const float rstd = St[ai * HALF + rl0 + m * 16]; float* op = OUT + (size_t)(row0 + ai * HALF + m * 16) * DM + col0;
#pragma unroll
                for (int bj = 0; bj < 2; ++bj) { *(f32x4*)(op + bj * HALF) = acc[ai][bj][m][0] * rstd * gg[bj][0]; *(f32x4*)(op + bj * HALF + 4) = acc[ai][bj][m][1] * rstd * gg[bj][1]; } }
    }
};

__device__ __forceinline__ float dpp_shr1(float old, float src) { return __builtin_bit_cast(float, __builtin_amdgcn_update_dpp(__builtin_bit_cast(int, old), __builtin_bit_cast(int, src), 0x111, 0xf, 0xf, false)); }
__device__ __forceinline__ float dpp_shr2(float old, float src) { return __builtin_bit_cast(float, __builtin_amdgcn_update_dpp(__builtin_bit_cast(int, old), __builtin_bit_cast(int, src), 0x112, 0xf, 0xf, false)); }
__device__ __forceinline__ float dpp_ror1(float src) { return __builtin_bit_cast(float, __builtin_amdgcn_mov_dpp(__builtin_bit_cast(int, src), 0x121, 0xf, 0xf, false)); }
__device__ __forceinline__ float dpp_ror2(float src) { return __builtin_bit_cast(float, __builtin_amdgcn_mov_dpp(__builtin_bit_cast(int, src), 0x122, 0xf, 0xf, false)); }
constexpr int FF = 5632, FF2 = 11264;
struct EpiAct {
    static constexpr bool PERM = true, AFTER_DRAIN = false;
    bf16_t* ACT; const float* slab; const float* cw; const float* cb; float* ubnd;
    __device__ __forceinline__ void operator()(f32x4 (&acc)[2][2][4][2], const Unit& u, int wr, int wc, int fr_, int fq_, PG8_LAS unsigned char* xlds) const {
        int t_ = threadIdx.x; asm volatile("" : "+v"(t_));
        const int fr = t_ & 15, fq = (t_ >> 4) & 3;
        const int row0 = u.pm * BM + wr * 64 + fr, cl = wc * 32 + 8 * fq;
#pragma unroll
        for (int ai = 0; ai < 2; ++ai)
#pragma unroll
            for (int m = 0; m < 4; ++m) { const int rg = row0 + ai * HALF + m * 16;
                const f32x4 pa = *(const f32x4*)(slab + (size_t)rg * 32 + 8 * fq), pb = *(const f32x4*)(slab + (size_t)rg * 32 + 8 * fq + 4);
                float s = ((pa[0] + pa[1]) + (pa[2] + pa[3])) + ((pb[0] + pb[1]) + (pb[2] + pb[3]));
                s += __shfl_xor(s, 16); s += __shfl_xor(s, 32);
                const float rstd = 1.0f / sqrtf(s * (1.0f / DM) + RMS_EPS);
#pragma unroll
                for (int bj = 0; bj < 2; ++bj)
#pragma unroll
                    for (int n = 0; n < 2; ++n) acc[ai][bj][m][n] = acc[ai][bj][m][n] * rstd; }
        if (fr >= 14) {
#pragma unroll
            for (int ai = 0; ai < 2; ++ai)
#pragma unroll
                for (int bj = 0; bj < 2; ++bj)
#pragma unroll
                    for (int n = 0; n < 2; ++n) *(PG8_LAS f32x4*)(xlds + ((((2 * ai + wr) * 2 + (fr - 14)) * 256 + 128 * bj + cl + 4 * n) << 2)) = acc[ai][bj][3][n];
            if (wr == 1) {
#pragma unroll
                for (int bj = 0; bj < 2; ++bj)
#pragma unroll
                    for (int n = 0; n < 2; ++n) *(f32x4*)(ubnd + (size_t)(u.pm * 4 + 2 + (fr - 14)) * FF2 + u.pn * BM + 128 * bj + cl + 4 * n) = acc[1][bj][3][n]; }
        }
        if (wr == 0 && fr < 2) {
#pragma unroll
            for (int bj = 0; bj < 2; ++bj)
#pragma unroll
                for (int n = 0; n < 2; ++n) *(f32x4*)(ubnd + (size_t)(u.pm * 4 + fr) * FF2 + u.pn * BM + 128 * bj + cl + 4 * n) = acc[0][bj][0][n]; }
        asm volatile("s_waitcnt lgkmcnt(0)" ::: "memory"); __builtin_amdgcn_s_barrier(); asm volatile("" ::: "memory");
        const int c0 = u.pn * 128 + cl;
        u32x2 hold[2][4];
#pragma unroll
        for (int n = 0; n < 2; ++n) {
            const f32x4 gw0 = *(const f32x4*)(cw + c0 + 4 * n), gw1 = *(const f32x4*)(cw + FF2 + c0 + 4 * n), gw2 = *(const f32x4*)(cw + 2 * FF2 + c0 + 4 * n), gb = *(const f32x4*)(cb + c0 + 4 * n);
            const f32x4 vw0 = *(const f32x4*)(cw + FF + c0 + 4 * n), vw1 = *(const f32x4*)(cw + FF2 + FF + c0 + 4 * n), vw2 = *(const f32x4*)(cw + 2 * FF2 + FF + c0 + 4 * n), vb = *(const f32x4*)(cb + FF + c0 + 4 * n);
#pragma unroll
            for (int ai = 0; ai < 2; ++ai) {
                const int chunk = 2 * ai + wr;
                f32x4 pg = {0.f, 0.f, 0.f, 0.f}, pv = {0.f, 0.f, 0.f, 0.f};
                if (chunk > 0) { const PG8_LAS unsigned char* bp = xlds + ((((chunk - 1) * 2 + (fr & 1)) * 256 + cl + 4 * n) << 2);
                    pg = *(const PG8_LAS f32x4*)bp; pv = *(const PG8_LAS f32x4*)(bp + 512); }
#pragma unroll
                for (int m = 0; m < 4; ++m) {
                    const f32x4 cg = acc[ai][0][m][n], cv = acc[ai][1][m][n]; float a[4];
#pragma unroll
                    for (int j = 0; j < 4; ++j) {
                        const float g1 = dpp_shr1(dpp_ror1(pg[j]), cg[j]), g2 = dpp_shr2(dpp_ror2(pg[j]), cg[j]);
                        const float v1 = dpp_shr1(dpp_ror1(pv[j]), cv[j]), v2 = dpp_shr2(dpp_ror2(pv[j]), cv[j]);
                        const float G = gw2[j] * cg[j] + (gw1[j] * g1 + (gw0[j] * g2 + gb[j]));
                        const float V = vw2[j] * cv[j] + (vw1[j] * v1 + (vw0[j] * v2 + vb[j]));
                        a[j] = G * __builtin_amdgcn_rcpf(1.0f + __builtin_amdgcn_exp2f(-1.4426950408889634f * G)) * V; }
                    u32x2 w; w.x = cvt_pk_bf16(a[0], a[1]); w.y = cvt_pk_bf16(a[2], a[3]);
                    if (n == 0) hold[ai][m] = w;
                    else { u32x4 o; o.x = hold[ai][m].x; o.y = hold[ai][m].y; o.z = w.x; o.w = w.y;
                        *(u32x4*)(ACT + (size_t)(row0 + ai * HALF + m * 16) * FF + c0) = o; }
                    pg = cg; pv = cv;
                }
            }
        }
    }
};

template <class Epi, class Sched, bool ALIGN_EPI = false, bool SP2 = false>
__device__ __forceinline__ void gemm_phase(PG8_LAS unsigned char* lds, const Gemm g, const Sched& S, const Epi& E, PG8_LAS unsigned char* xlds) {
    const int tid = threadIdx.x, wid = __builtin_amdgcn_readfirstlane(tid >> 6), lane = tid & 63, wr = wid >> 2, wc = wid & 3, fr = lane & 15, fq = lane >> 4;
    const int K = g.K, nt = K / BK;
    unsigned voffA[2], voffB[2];
#pragma unroll
    for (int i = 0; i < 2; ++i) { int R, C; stage_rc(tid * 16 + i * 8192, R, C); const int Rb = Epi::PERM ? ((R & ~31) + perm32(R & 31)) : R;
        voffA[i] = (unsigned)(R * K + C) * 2u; voffB[i] = (unsigned)(Rb * K + C) * 2u; }
    const size_t kstep = (size_t)(BK * 2);
    const size_t hstep = (size_t)HALF * K * 2;
    const size_t tstep = 2 * hstep;
    const unsigned ldsw = (unsigned)wid * 1024u;
    const int aoff = lds_byte(wr * 64 + fr, fq * 8), boff = lds_byte(wc * 32 + fr, fq * 8);
#define PG8_SA(b, h) (((b) * 2 + (h)) * HTB)
#define PG8_SB(b, h) ((4 + (b) * 2 + (h)) * HTB)
#define PG8_STAGE(bufoff, gbase, voff) do { _Pragma("unroll") for (int _i = 0; _i < 2; ++_i) \
        __builtin_amdgcn_global_load_lds((const unsigned*)((const char*)(gbase) + (voff)[_i]), (PG8_LAS unsigned*)(lds + (bufoff) + ldsw + _i * 8192), 16, 0, 0); } while (0)
#define PG8_LDA(dst, b, h) do { _Pragma("unroll") for (int m = 0; m < 4; ++m) _Pragma("unroll") for (int k = 0; k < 2; ++k) dst[m][k] = *(const PG8_LAS bf16x8*)(lds + PG8_SA(b, h) + aoff + m * 2048 + k * 1024); } while (0)
#define PG8_LDB(dst, b, h) do { _Pragma("unroll") for (int n = 0; n < 2; ++n) _Pragma("unroll") for (int k = 0; k < 2; ++k) dst[n][k] = *(const PG8_LAS bf16x8*)(lds + PG8_SB(b, h) + boff + n * 2048 + k * 1024); } while (0)
#define PG8_MMA(ai, bj, At, Bt) do { __builtin_amdgcn_s_setprio(1); _Pragma("unroll") for (int m = 0; m < 4; ++m) _Pragma("unroll") for (int n = 0; n < 2; ++n) _Pragma("unroll") for (int k = 0; k < 2; ++k) \
        acc[ai][bj][m][n] = __builtin_amdgcn_mfma_f32_16x16x32_bf16(Bt[n][k], At[m][k], acc[ai][bj][m][n], 0, 0, 0); __builtin_amdgcn_s_setprio(0); } while (0)
#define PG8_WAIT_V(n) asm volatile("s_waitcnt vmcnt(" #n ")" ::: "memory")
#define PG8_WAIT_L(n) asm volatile("s_waitcnt lgkmcnt(" #n ")" ::: "memory")
#define PG8_BAR __builtin_amdgcn_s_barrier()
#define PG8_SCHED __builtin_amdgcn_sched_barrier(0)
    Unit cur, nxt; int ui = 0;
    if (!S.next(0, cur)) return;
    f32x4 acc[2][2][4][2];
#pragma unroll
    for (int a = 0; a < 2; ++a)
#pragma unroll
        for (int b = 0; b < 2; ++b)
#pragma unroll
            for (int m = 0; m < 4; ++m)
#pragma unroll
                for (int n = 0; n < 2; ++n) acc[a][b][m][n] = (f32x4){0.f, 0.f, 0.f, 0.f};
    bf16x8 At[4][2], B0[2][2], B1[2][2];
    const char* cA = (const char*)g.A + (size_t)cur.pm * tstep; const char* cB = (const char*)g.Bt + (size_t)cur.pn * tstep;
    S.a_ready(cur);
    if constexpr (SP2) {
        PG8_STAGE(PG8_SB(0, 0), cB, voffB); PG8_STAGE(PG8_SB(0, 1), cB + hstep, voffB); PG8_STAGE(PG8_SA(0, 0), cA, voffA); PG8_STAGE(PG8_SA(0, 1), cA + hstep, voffA);
        if (wr == 1) PG8_BAR;
        PG8_WAIT_V(2); PG8_BAR;
        PG8_STAGE(PG8_SB(1, 0), cB + kstep, voffB); PG8_STAGE(PG8_SA(1, 0), cA + kstep, voffA); PG8_STAGE(PG8_SB(1, 1), cB + hstep + kstep, voffB);
        PG8_WAIT_V(6); PG8_BAR;
    } else {
        PG8_STAGE(PG8_SB(0, 0), cB, voffB); PG8_STAGE(PG8_SA(0, 0), cA, voffA); PG8_STAGE(PG8_SB(0, 1), cB + hstep, voffB); PG8_STAGE(PG8_SA(0, 1), cA + hstep, voffA);
        if (wr == 1) PG8_BAR;
        PG8_WAIT_V(4); PG8_BAR;
        PG8_STAGE(PG8_SB(1, 0), cB + kstep, voffB); PG8_STAGE(PG8_SA(1, 0), cA + kstep, voffA); PG8_STAGE(PG8_SB(1, 1), cB + hstep + kstep, voffB);
        PG8_WAIT_V(6); PG8_BAR;
    }
    for (;;) {
        const bool has_next = S.next(ui + 1, nxt);
        const char* nA = has_next ? (const char*)g.A + (size_t)nxt.pm * tstep : cA; const char* nB = has_next ? (const char*)g.Bt + (size_t)nxt.pn * tstep : cB;
        for (int t = 0; t < nt; t += 2) {
            const bool last = (t == nt - 2);
            const char* a1 = cA + (size_t)(t + 1) * kstep;
            const char* a2 = last ? nA : cA + (size_t)(t + 2) * kstep; const char* b2 = last ? nB : cB + (size_t)(t + 2) * kstep;
            const char* a3 = a2 + kstep; const char* b3 = b2 + kstep;
            if (last && has_next) S.a_ready(nxt);
            if constexpr (SP2) {
            PG8_LDB(B0, 0, 0); PG8_LDB(B1, 0, 1); PG8_SCHED; PG8_LDA(At, 0, 0); PG8_STAGE(PG8_SA(1, 1), a1 + hstep, voffA);
            PG8_WAIT_V(8); PG8_WAIT_L(0); PG8_BAR; PG8_MMA(0, 0, At, B0); PG8_MMA(0, 1, At, B1); PG8_BAR; PG8_SCHED;
            PG8_LDA(At, 0, 1); PG8_STAGE(PG8_SB(0, 0), b2, voffB); PG8_STAGE(PG8_SB(0, 1), b2 + hstep, voffB); PG8_STAGE(PG8_SA(0, 0), a2, voffA);
            PG8_WAIT_V(8); PG8_WAIT_L(0); PG8_BAR; PG8_MMA(1, 0, At, B0); PG8_MMA(1, 1, At, B1); PG8_BAR; PG8_SCHED;
            PG8_LDB(B0, 1, 0); PG8_LDB(B1, 1, 1); PG8_SCHED; PG8_LDA(At, 1, 0); PG8_STAGE(PG8_SA(0, 1), a2 + hstep, voffA);
            PG8_WAIT_V(8); PG8_WAIT_L(0); PG8_BAR; PG8_MMA(0, 0, At, B0); PG8_MMA(0, 1, At, B1); PG8_BAR; PG8_SCHED;
            PG8_LDA(At, 1, 1); PG8_STAGE(PG8_SB(1, 0), b3, voffB); PG8_STAGE(PG8_SB(1, 1), b3 + hstep, voffB); PG8_STAGE(PG8_SA(1, 0), a3, voffA);
            PG8_WAIT_V(8); PG8_WAIT_L(0); PG8_BAR; PG8_MMA(1, 0, At, B0); PG8_MMA(1, 1, At, B1); PG8_BAR; PG8_SCHED;
            } else {
            PG8_LDB(B0, 0, 0); PG8_SCHED; PG8_LDA(At, 0, 0); PG8_STAGE(PG8_SA(1, 1), a1 + hstep, voffA);
            PG8_WAIT_L(8); PG8_BAR; PG8_WAIT_L(0); PG8_MMA(0, 0, At, B0); PG8_BAR; PG8_SCHED;
            PG8_LDB(B1, 0, 1); PG8_STAGE(PG8_SB(0, 0), b2, voffB);
            PG8_BAR; PG8_WAIT_L(0); PG8_MMA(0, 1, At, B1); PG8_BAR;
            PG8_LDA(At, 0, 1); PG8_STAGE(PG8_SA(0, 0), a2, voffA);
            PG8_BAR; PG8_WAIT_L(0); PG8_MMA(1, 0, At, B0); PG8_BAR; PG8_SCHED;
            PG8_STAGE(PG8_SB(0, 1), b2 + hstep, voffB);
            PG8_WAIT_V(6); PG8_BAR; PG8_MMA(1, 1, At, B1); PG8_BAR;
            PG8_LDB(B0, 1, 0); PG8_SCHED; PG8_LDA(At, 1, 0); PG8_STAGE(PG8_SA(0, 1), a2 + hstep, voffA);
            PG8_WAIT_L(8); PG8_BAR; PG8_WAIT_L(0); PG8_MMA(0, 0, At, B0); PG8_BAR; PG8_SCHED;
            PG8_LDB(B1, 1, 1); PG8_STAGE(PG8_SB(1, 0), b3, voffB);
            PG8_BAR; PG8_WAIT_L(0); PG8_MMA(0, 1, At, B1); PG8_BAR;
            PG8_LDA(At, 1, 1); PG8_STAGE(PG8_SA(1, 0), a3, voffA);
            PG8_BAR; PG8_WAIT_L(0); PG8_MMA(1, 0, At, B0); PG8_BAR; PG8_SCHED;
            PG8_STAGE(PG8_SB(1, 1), b3 + hstep, voffB);
            PG8_WAIT_V(6); PG8_BAR; PG8_MMA(1, 1, At, B1); PG8_BAR;
            }
        }
        if constexpr (ALIGN_EPI) { if (wr == 0) PG8_BAR; }
        if constexpr (!Epi::AFTER_DRAIN) { E(acc, cur, wr, wc, fr, fq, xlds); S.done(cur); }
        if (!has_next) break;
#pragma unroll
        for (int a = 0; a < 2; ++a)
#pragma unroll
            for (int b = 0; b < 2; ++b)
#pragma unroll
                for (int m = 0; m < 4; ++m)
#pragma unroll
                    for (int n = 0; n < 2; ++n) acc[a][b][m][n] = (f32x4){0.f, 0.f, 0.f, 0.f};
        cur = nxt; cA = nA; cB = nB; ++ui;
        if constexpr (ALIGN_EPI) { if (wr == 1) PG8_BAR; }
    }
    PG8_WAIT_V(0);
    if constexpr (!ALIGN_EPI) { if (wr == 0) PG8_BAR; }
    PG8_BAR;

#undef PG8_SA
#undef PG8_SB
#undef PG8_STAGE
#undef PG8_LDA
#undef PG8_LDB
#undef PG8_MMA
#undef PG8_WAIT_V
#undef PG8_WAIT_L
#undef PG8_BAR
#undef PG8_SCHED
}
}

#define GAS __attribute__((address_space(1)))
#define LAS __attribute__((address_space(3)))
typedef unsigned short bf16;
typedef float f32x4 __attribute__((ext_vector_type(4)));
typedef short bf16x8 __attribute__((ext_vector_type(8)));
typedef unsigned u32x4 __attribute__((ext_vector_type(4)));
typedef unsigned u32x2 __attribute__((ext_vector_type(2)));

constexpr int NWAVES = 8;
constexpr int SEQ = 16384, DMODEL = 2048, NMEM = 256, DIN = 3584, DCONV = 768, DPOOL = 768, DXATT = 512, DFF = 5632, DFF2 = 11264;
constexpr int PGD = 192;
constexpr float EPS = 1e-6f;
constexpr int LDS_BYTES = 147456;
#ifndef MK_PER_PHASE
#define MK_PER_PHASE 0
#endif
constexpr int NPHASE = 7;
#ifndef PHM
#define PHM 255
#endif
#ifndef USE_CG_SYNC
#define USE_CG_SYNC 0
#endif
#ifndef PROBE_P2
#define PROBE_P2 0
#endif
#ifndef PROBE_SYNC
#define PROBE_SYNC 0
#endif
#ifndef PROBE_GEMM
#define PROBE_GEMM 0
#endif
#ifndef PROBE_N
#define PROBE_N 2048
#endif
#ifndef REPM
#define REPM 0
#endif

constexpr size_t MiB = 1u << 20;
constexpr size_t WS_KB = 1 * MiB;
constexpr size_t WS_VT = 1 * MiB + 256 * 1024;
constexpr size_t WS_POOLWT = 1 * MiB + 512 * 1024;
constexpr size_t WS_MB = 2 * MiB;
constexpr size_t WS_WKVT = 3 * MiB;
constexpr size_t WS_SLAB1 = 8 * MiB;
constexpr size_t WS_SLAB2 = 10 * MiB;
constexpr size_t WS_WUPT = 12 * MiB;
constexpr size_t WS_WDOWNT = 56 * MiB;
constexpr size_t WS_UBND = 80 * MiB;
constexpr size_t WS_X1B = 96 * MiB;
constexpr size_t WS_ACT = 160 * MiB;
constexpr size_t WS_H = 160 * MiB;
constexpr size_t WS_Z = 225 * MiB;
constexpr size_t WS_ZPAD = WS_Z - (size_t)16 * 3584 * 2;
constexpr size_t WS_MIX = 338 * MiB;
constexpr size_t WS_WINT = 402 * MiB;
constexpr size_t WS_WOUTT = 416 * MiB;
constexpr size_t WS_END = 424 * MiB;

__device__ __forceinline__ unsigned f2bf(float f) { unsigned u = __builtin_bit_cast(unsigned, f); return (u + 0x7fffu + ((u >> 16) & 1u)) >> 16; }
__device__ __forceinline__ unsigned pk2(float lo, float hi) { return f2bf(lo) | (f2bf(hi) << 16); }
__device__ __forceinline__ float bflo(unsigned w) { return __builtin_bit_cast(float, w << 16); }
__device__ __forceinline__ float bfhi(unsigned w) { return __builtin_bit_cast(float, w & 0xffff0000u); }
__device__ __forceinline__ void unpack8(const u32x4 w, float (&f)[8]) { f[0] = bflo(w.x); f[1] = bfhi(w.x); f[2] = bflo(w.y); f[3] = bfhi(w.y); f[4] = bflo(w.z); f[5] = bfhi(w.z); f[6] = bflo(w.w); f[7] = bfhi(w.w); }
__device__ __forceinline__ u32x4 pack8(const float (&f)[8]) { u32x4 w; w.x = pk2(f[0], f[1]); w.y = pk2(f[2], f[3]); w.z = pk2(f[4], f[5]); w.w = pk2(f[6], f[7]); return w; }
__device__ __forceinline__ float wave_sum(float v) {
#pragma unroll
    for (int o = 1; o < 64; o <<= 1) v += __shfl_xor(v, o);
    return v;
}
#define LDS_WAIT() asm volatile("s_waitcnt lgkmcnt(0)" ::: "memory")

typedef GAS unsigned gu32;
constexpr size_t WS_CTL = 0, CTL_ZERO_BYTES = 64 * 1024;
constexpr int CW_PANEL = 4096;
constexpr int MISC_OFF = 131072 + 320;
constexpr int XLDS_OFF = 131072 + 1024;
#define XB_TMO      128
#define XB_XCNT(j)  (256  + 64 * (j))
#define XB_XSUB(j)  (1280 + 64 * (j))
#define XB_XGEN(j)  (2304 + 64 * (j))
#define XB_TOP      3328
#define XB_TOPGEN   3392
#define XCD_BAR_WORDS 3456
#define XB_SPIN_CAP (1u << 18)

__device__ __forceinline__ unsigned xb_ld(unsigned* p)              { return __hip_atomic_load(p, __ATOMIC_RELAXED, __HIP_MEMORY_SCOPE_AGENT); }
__device__ __forceinline__ unsigned xb_add(unsigned* p, unsigned v) { return __hip_atomic_fetch_add(p, v, __ATOMIC_RELAXED, __HIP_MEMORY_SCOPE_AGENT); }
__device__ __forceinline__ unsigned xb_xcc_id() { return (unsigned)__builtin_amdgcn_s_getreg((3 << 11) | 20) & 0xFu; }
#define XB_SPIN(cond, bar) do { unsigned _sp = 0; while (cond) { __builtin_amdgcn_s_sleep(1); \
    if ((++_sp & 255u) == 0u) { if (xb_ld(&(bar)[XB_TMO])) break; if (_sp > XB_SPIN_CAP) { atomicAdd(&(bar)[XB_TMO], 1u); break; } } } } while (0)

struct XcdBarrier {
    unsigned* bar; unsigned x;
    volatile LAS unsigned* st;
};

__device__ __forceinline__ XcdBarrier xcd_barrier_post(unsigned* bar, volatile LAS unsigned* st) {
    XcdBarrier b; b.bar = bar; b.x = xb_xcc_id(); b.st = st;
    if (threadIdx.x == 0) (void)xb_add(&bar[XB_XCNT(b.x)], 1u);
    return b;
}
__device__ __forceinline__ void xcd_barrier_complete(unsigned* bar, unsigned x, unsigned& nloc, unsigned& nx) {
    const unsigned G = gridDim.x * gridDim.y * gridDim.z;
    unsigned sum, cnt, mine, sp = 0u;
    for (;;) {
        sum = 0u; cnt = 0u; mine = 0u;
#pragma unroll
        for (unsigned j = 0; j < 16; ++j) { const unsigned c = xb_ld(&bar[XB_XCNT(j)]); sum += c; cnt += (c > 0u) ? 1u : 0u; mine = (j == x) ? c : mine; }
        if (sum == G) break;
        __builtin_amdgcn_s_sleep(1);
        if ((++sp & 255u) == 0u) { if (xb_ld(&bar[XB_TMO])) break; if (sp > XB_SPIN_CAP) { atomicAdd(&bar[XB_TMO], 1u); break; } }
    }
    nloc = mine > 0u ? mine : 1u; nx = cnt > 0u ? cnt : 1u;
}

__device__ __forceinline__ void xcd_barrier(const XcdBarrier& b) {
    asm volatile("s_waitcnt vmcnt(0)" ::: "memory");
    __syncthreads();
    if (threadIdx.x == 0) {
        unsigned* bar = b.bar;
        __builtin_amdgcn_s_waitcnt(0);
        unsigned nloc = b.st[0], nx = b.st[1];
        if (nloc == 0u) { xcd_barrier_complete(bar, b.x, nloc, nx); b.st[0] = nloc; b.st[1] = nx; }
        const unsigned old = xb_add(&bar[XB_XSUB(b.x)], 1u);
        const unsigned gen = old / nloc;
        if (old + 1u == (gen + 1u) * nloc) {
            __builtin_amdgcn_fence(__ATOMIC_RELEASE, "agent");
            asm volatile("s_waitcnt vmcnt(0)" ::: "memory");
            const unsigned og = xb_add(&bar[XB_TOP], 1u);
            const unsigned tg = og / nx;
            if (og + 1u == (tg + 1u) * nx) xb_add(&bar[XB_TOPGEN], 1u);
            else XB_SPIN(xb_ld(&bar[XB_TOPGEN]) == tg, bar);
            __builtin_amdgcn_fence(__ATOMIC_ACQUIRE, "agent");
            xb_add(&bar[XB_XGEN(b.x)], 1u);
            asm volatile("s_waitcnt vmcnt(0)" ::: "memory");
        } else {
            XB_SPIN(xb_ld(&bar[XB_XGEN(b.x)]) == gen, bar);
            __builtin_amdgcn_fence(__ATOMIC_ACQUIRE, "agent");
            asm volatile("s_waitcnt vmcnt(0)" ::: "memory");
        }
    }
    __syncthreads();
}


template <bool UPMAP> __device__ __forceinline__ void p0_transpose_item(const float* W, int K, int N, bf16* WT, const float* ks, LAS float* scr, int item, int lane) {
    const int nblk = N / 64, kb = item / nblk, nb = item % nblk, k0 = 64 * kb, n0 = 64 * nb;
    const int r0 = !UPMAP ? n0 : (n0 < DFF ? 256 * (n0 / 128) + (n0 % 128) : 256 * ((n0 - DFF) / 128) + 128 + ((n0 - DFF) % 128));
    f32x4 v[16];
    const float* src = W + (size_t)(k0 + (lane >> 4)) * N + n0 + 4 * (lane & 15);
#pragma unroll
    for (int i = 0; i < 16; ++i) v[i] = *(const f32x4*)(src + (size_t)(4 * i) * N);
#pragma unroll
    for (int i = 0; i < 16; ++i) { f32x4 t = v[i]; if (ks) t = t * ks[k0 + 4 * i + (lane >> 4)];
        *(LAS f32x4*)(scr + (4 * i + (lane >> 4)) * 64 + (((lane & 15) ^ ((i >> 1) & 7)) << 2)) = t; }
    LDS_WAIT(); asm volatile("" ::: "memory");
    const int c = lane & 7;
#pragma unroll
    for (int j = 0; j < 8; ++j) { const int nn = (lane >> 3) + 8 * j; const LAS float* sp = scr + (8 * c) * 64 + ((((nn >> 2) ^ c) & 15) << 2) + (nn & 3);
        u32x4 o; o.x = pk2(sp[0 * 64], sp[1 * 64]); o.y = pk2(sp[2 * 64], sp[3 * 64]); o.z = pk2(sp[4 * 64], sp[5 * 64]); o.w = pk2(sp[6 * 64], sp[7 * 64]);
        *(u32x4*)(WT + (size_t)(r0 + nn) * K + k0 + 8 * c) = o; }
    LDS_WAIT(); asm volatile("" ::: "memory");
}
__device__ __forceinline__ void rms_rows2_to_bf16(const float* xa, const float* xb, const float* g, bf16* oa, bf16* ob, int lane) {
    const f32x4* pa = (const f32x4*)xa + lane; const f32x4* pb = (const f32x4*)xb + lane; const f32x4* gr = (const f32x4*)g + lane;
    f32x4 va[8], vb[8]; float sa = 0.f, sb = 0.f;
#pragma unroll
    for (int j = 0; j < 8; ++j) { va[j] = pa[64 * j]; vb[j] = pb[64 * j]; }
#pragma unroll
    for (int j = 0; j < 8; ++j) { sa += (va[j].x * va[j].x + va[j].y * va[j].y) + (va[j].z * va[j].z + va[j].w * va[j].w); sb += (vb[j].x * vb[j].x + vb[j].y * vb[j].y) + (vb[j].z * vb[j].z + vb[j].w * vb[j].w); }
    const float ra = 1.0f / sqrtf(wave_sum(sa) * (1.0f / DMODEL) + EPS), rb = 1.0f / sqrtf(wave_sum(sb) * (1.0f / DMODEL) + EPS);
    u32x2* qa = (u32x2*)oa + lane; u32x2* qb = (u32x2*)ob + lane;
#pragma unroll
    for (int j = 0; j < 8; ++j) { const f32x4 gg = gr[64 * j]; u32x2 w;
        w.x = pk2(va[j].x * ra * gg.x, va[j].y * ra * gg.y); w.y = pk2(va[j].z * ra * gg.z, va[j].w * ra * gg.w); qa[64 * j] = w;
        w.x = pk2(vb[j].x * rb * gg.x, vb[j].y * rb * gg.y); w.y = pk2(vb[j].z * rb * gg.z, vb[j].w * rb * gg.w); qb[64 * j] = w; }
}

struct Ptrs {
    const float *x, *mem, *g_mix, *g_mem, *w_in, *conv_w, *pool_w, *pool_scale, *w_kv, *w_out, *g_ffn, *w_up, *ffn_conv_w, *ffn_conv_b, *w_down, *g_final;
    float* out; unsigned char* ws;
};

constexpr int UP_ITEMS = (DMODEL / 64) * (DFF2 / 64), DN_ITEMS = (DFF / 64) * (DMODEL / 64);
#ifndef UP_IN_P0
#define UP_IN_P0 2560
#endif
__device__ __forceinline__ void p1_idle_work(const Ptrs& P, LAS unsigned char* lds, int iw, int NIW, int wave, int lane);
__device__ __forceinline__ void p0_prologue(const Ptrs& P, LAS unsigned char* lds, int gw, int NGW, int wave, int lane) {
    LAS float* scr = (LAS float*)(lds + wave * 16384);
    unsigned char* ws = P.ws;
    constexpr int I_IN = (DMODEL / 64) * (DIN / 64), I_OUT = (DMODEL / 64) * (DMODEL / 64), I_UP = (DMODEL / 64) * (DFF2 / 64), I_DN = (DFF / 64) * (DMODEL / 64),
                  I_KV = (DMODEL / 64) * (1024 / 64), I_PW = (PGD / 64) * (PGD / 64);
    constexpr int NITEMS = I_IN + I_OUT + UP_IN_P0 + I_KV + 4 * I_PW;
    for (int it = gw; it < NITEMS; it += NGW) {
        int r = it;
        if (r < I_IN) { p0_transpose_item<false>(P.w_in, DMODEL, DIN, (bf16*)(ws + WS_WINT), nullptr, scr, r, lane); continue; } r -= I_IN;
        if (r < I_OUT) { p0_transpose_item<false>(P.w_out, DMODEL, DMODEL, (bf16*)(ws + WS_WOUTT), nullptr, scr, r, lane); continue; } r -= I_OUT;
        if (r < UP_IN_P0) { p0_transpose_item<true>(P.w_up, DMODEL, DFF2, (bf16*)(ws + WS_WUPT), P.g_ffn, scr, r, lane); continue; } r -= UP_IN_P0;
        if (r < I_KV) { p0_transpose_item<false>(P.w_kv, DMODEL, 1024, (bf16*)(ws + WS_WKVT), nullptr, scr, r, lane); continue; } r -= I_KV;
        const int g = r / I_PW; r -= g * I_PW;
        p0_transpose_item<false>(P.pool_w + (size_t)g * PGD * PGD, PGD, PGD, (bf16*)(ws + WS_POOLWT) + (size_t)g * PGD * PGD, nullptr, scr, r, lane);
    }
    for (int i = gw * 64 + lane; i < 16 * DIN * 2 / 16; i += NGW * 64) ((u32x4*)(ws + WS_ZPAD))[i] = (u32x4){0u, 0u, 0u, 0u};
    for (int m = 2 * gw; m < SEQ; m += 2 * NGW) rms_rows2_to_bf16(P.x + (size_t)m * DMODEL, P.x + (size_t)(m + 1) * DMODEL, P.g_mix, (bf16*)(ws + WS_H) + (size_t)m * DMODEL, (bf16*)(ws + WS_H) + (size_t)(m + 1) * DMODEL, lane);
    for (int m = 2 * gw; m < NMEM; m += 2 * NGW) rms_rows2_to_bf16(P.mem + (size_t)m * DMODEL, P.mem + (size_t)(m + 1) * DMODEL, P.g_mem, (bf16*)(ws + WS_MB) + (size_t)m * DMODEL, (bf16*)(ws + WS_MB) + (size_t)(m + 1) * DMODEL, lane);
}

__device__ __forceinline__ void kv_tile(const Ptrs& P, int tt, int lane) {
    const bf16* mB = (const bf16*)(P.ws + WS_MB); const bf16* wT = (const bf16*)(P.ws + WS_WKVT);
    const int rb = tt >> 6, cb = tt & 63, fr = lane & 15, fq = lane >> 4;
    const bf16* ap = mB + (size_t)(16 * rb + fr) * DMODEL + 8 * fq; const bf16* wp = wT + (size_t)(16 * cb + fr) * DMODEL + 8 * fq;
    f32x4 acc = {0.f, 0.f, 0.f, 0.f};
    if (cb < 32) {
#pragma unroll 8
        for (int ks = 0; ks < 64; ++ks) { const bf16x8 a = *(const bf16x8*)(ap + 32 * ks), w = *(const bf16x8*)(wp + 32 * ks); acc = __builtin_amdgcn_mfma_f32_16x16x32_bf16(w, a, acc, 0, 0, 0); }
        u32x2 o; o.x = pk2(acc[0], acc[1]); o.y = pk2(acc[2], acc[3]);
        *(u32x2*)((bf16*)(P.ws + WS_KB) + (size_t)(16 * rb + fr) * 512 + 16 * cb + 4 * fq) = o;
    } else {
#pragma unroll 8
        for (int ks = 0; ks < 64; ++ks) { const bf16x8 a = *(const bf16x8*)(ap + 32 * ks), w = *(const bf16x8*)(wp + 32 * ks); acc = __builtin_amdgcn_mfma_f32_16x16x32_bf16(a, w, acc, 0, 0, 0); }
        u32x2 o; o.x = pk2(acc[0], acc[1]); o.y = pk2(acc[2], acc[3]);
        *(u32x2*)((bf16*)(P.ws + WS_VT) + (size_t)(16 * cb - 512 + fr) * 256 + 32 * (rb >> 1) + 8 * fq + 4 * (rb & 1)) = o;
    }
}

__device__ __forceinline__ void p1_idle_work(const Ptrs& P, LAS unsigned char* lds, int iw, int NIW, int wave, int lane) {
    LAS float* scr = (LAS float*)(lds + wave * 16384);
    for (int tt = iw; tt < 1024; tt += NIW) kv_tile(P, tt, lane);
    constexpr int NEXTRA = DN_ITEMS + (UP_ITEMS - UP_IN_P0);
    for (int it = iw; it < NEXTRA; it += NIW) {
        if (it < DN_ITEMS) p0_transpose_item<false>(P.w_down, DFF, DMODEL, (bf16*)(P.ws + WS_WDOWNT), nullptr, scr, it, lane);
        else p0_transpose_item<true>(P.w_up, DMODEL, DFF2, (bf16*)(P.ws + WS_WUPT), P.g_ffn, scr, UP_IN_P0 + it - DN_ITEMS, lane);
    }
}

__device__ __forceinline__ void mix_conv_task(const Ptrs& P, int blk, int lane) {
    const bf16* z = (const bf16*)(P.ws + WS_Z); bf16* mix = (bf16*)(P.ws + WS_MIX);
    const int t0 = blk * 16;
    for (int cg = lane; cg < DCONV / 8; cg += 64) {
        const int c = cg * 8;
        float w0[8], w1[8], w2[8], p1[8], p2[8];
#pragma unroll
        for (int e = 0; e < 8; ++e) { w0[e] = P.conv_w[c + e]; w1[e] = P.conv_w[DCONV + c + e]; w2[e] = P.conv_w[2 * DCONV + c + e]; }
        { float a[8], b[8]; unpack8(*(const u32x4*)(z + (long)(t0 - 2) * DIN + DCONV + c), a); unpack8(*(const u32x4*)(z + (long)(t0 - 2) * DIN + 2 * DCONV + c), b);
#pragma unroll
          for (int e = 0; e < 8; ++e) p2[e] = a[e] * b[e];
          unpack8(*(const u32x4*)(z + (long)(t0 - 1) * DIN + DCONV + c), a); unpack8(*(const u32x4*)(z + (long)(t0 - 1) * DIN + 2 * DCONV + c), b);
#pragma unroll
          for (int e = 0; e < 8; ++e) p1[e] = a[e] * b[e]; }
#pragma unroll 4
        for (int r = 0; r < 16; ++r) {
            const int t = t0 + r; float p[8], a[8], b[8], g[8], o[8];
            unpack8(*(const u32x4*)(z + (size_t)t * DIN + DCONV + c), a); unpack8(*(const u32x4*)(z + (size_t)t * DIN + 2 * DCONV + c), b); unpack8(*(const u32x4*)(z + (size_t)t * DIN + c), g);
#pragma unroll
            for (int e = 0; e < 8; ++e) { p[e] = a[e] * b[e]; o[e] = g[e] * (w2[e] * p[e] + w1[e] * p1[e] + w0[e] * p2[e]); p2[e] = p1[e]; p1[e] = p[e]; }
            *(u32x4*)(mix + (size_t)t * DMODEL + c) = pack8(o);
        }
    }
}
template <int g> __device__ __forceinline__ void mix_pool_task(const Ptrs& P, int blk, int lane) {
    constexpr int k = 2 << g;
    const char* zu = (const char*)((const bf16*)(P.ws + WS_Z) + (size_t)(blk * 16) * DIN + 3 * DCONV + PGD * g);
    const char* wu = (const char*)((const bf16*)(P.ws + WS_POOLWT) + (size_t)g * PGD * PGD);
    bf16* mix = (bf16*)(P.ws + WS_MIX);
    const int fr = lane & 15, fq = lane >> 4, t = blk * 16 + fr;
    const unsigned zl = (unsigned)(fr * DIN + 8 * fq) * 2u, wl = (unsigned)(fr * PGD + 8 * fq) * 2u;
    const int cnt = (t + 1 < k) ? t + 1 : k; const float inv = 1.0f / (float)cnt;
    f32x4 acc[12];
#pragma unroll
    for (int n = 0; n < 12; ++n) acc[n] = (f32x4){0.f, 0.f, 0.f, 0.f};
#pragma unroll 1
    for (int ks = 0; ks < 6; ++ks) {
        float sum[8], self[8];
        unpack8(*(const u32x4*)(zu + ks * 64 + zl), self);
#pragma unroll
        for (int e = 0; e < 8; ++e) sum[e] = self[e];
#pragma unroll
        for (int j = 1; j < k; ++j) { float v[8]; unpack8(*(const u32x4*)(zu + ks * 64 - (long)j * (DIN * 2) + zl), v);
#pragma unroll
            for (int e = 0; e < 8; ++e) sum[e] += v[e]; }
        float pl[8];
#pragma unroll
        for (int e = 0; e < 8; ++e) pl[e] = sum[e] * inv - self[e];
        const bf16x8 pf = __builtin_bit_cast(bf16x8, pack8(pl));
#pragma unroll
        for (int n = 0; n < 12; ++n) { const bf16x8 wf = *(const bf16x8*)(wu + n * (16 * PGD * 2) + ks * 64 + wl); acc[n] = __builtin_amdgcn_mfma_f32_16x16x32_bf16(wf, pf, acc[n], 0, 0, 0); }
    }
#pragma unroll
    for (int n = 0; n < 12; ++n) { const int d = 16 * n + 4 * fq; const f32x4 sc = *(const f32x4*)(P.pool_scale + PGD * g + d);
        u32x2 o; o.x = pk2(acc[n][0] * sc[0], acc[n][1] * sc[1]); o.y = pk2(acc[n][2] * sc[2], acc[n][3] * sc[3]);
        *(u32x2*)(mix + (size_t)t * DMODEL + DCONV + PGD * g + d) = o; }
}
__device__ __forceinline__ void mix_attn_task(const Ptrs& P, int h, int blk, int lane) {
    const bf16* z = (const bf16*)(P.ws + WS_Z); bf16* mix = (bf16*)(P.ws + WS_MIX); const bf16* Kb = (const bf16*)(P.ws + WS_KB); const bf16* Vt = (const bf16*)(P.ws + WS_VT);
    const int fr = lane & 15, fq = lane >> 4, t = blk * 16 + fr;
    bf16x8 qf[4];
#pragma unroll
    for (int ks = 0; ks < 4; ++ks) qf[ks] = *(const bf16x8*)(z + (size_t)t * DIN + 3 * DCONV + DPOOL + 128 * h + 32 * ks + 8 * fq);
    f32x4 s[16];
#pragma unroll
    for (int kb = 0; kb < 16; ++kb) { s[kb] = (f32x4){0.f, 0.f, 0.f, 0.f};
#pragma unroll
        for (int ks = 0; ks < 4; ++ks) { const bf16x8 kf = *(const bf16x8*)(Kb + (size_t)(16 * kb + fr) * 512 + 128 * h + 32 * ks + 8 * fq); s[kb] = __builtin_amdgcn_mfma_f32_16x16x32_bf16(kf, qf[ks], s[kb], 0, 0, 0); } }
    float mx = -3.0e38f;
#pragma unroll
    for (int kb = 0; kb < 16; ++kb) mx = fmaxf(fmaxf(fmaxf(s[kb][0], s[kb][1]), fmaxf(s[kb][2], s[kb][3])), mx);
    mx = fmaxf(mx, __shfl_xor(mx, 16)); mx = fmaxf(mx, __shfl_xor(mx, 32));
    const float c2 = 0.08838834764831845f * 1.4426950408889634f;
    float sum = 0.f;
#pragma unroll
    for (int kb = 0; kb < 16; ++kb)
#pragma unroll
        for (int r = 0; r < 4; ++r) { const float p = __builtin_amdgcn_exp2f((s[kb][r] - mx) * c2); s[kb][r] = p; sum += p; }
    sum += __shfl_xor(sum, 16); sum += __shfl_xor(sum, 32);
    const float inv = 1.0f / sum;
    f32x4 o[8];
#pragma unroll
    for (int db = 0; db < 8; ++db) o[db] = (f32x4){0.f, 0.f, 0.f, 0.f};
#pragma unroll
    for (int ks = 0; ks < 8; ++ks) {
        u32x4 pw; pw.x = pk2(s[2 * ks][0], s[2 * ks][1]); pw.y = pk2(s[2 * ks][2], s[2 * ks][3]); pw.z = pk2(s[2 * ks + 1][0], s[2 * ks + 1][1]); pw.w = pk2(s[2 * ks + 1][2], s[2 * ks + 1][3]);
        const bf16x8 pf = __builtin_bit_cast(bf16x8, pw);
#pragma unroll
        for (int db = 0; db < 8; ++db) { const bf16x8 vf = *(const bf16x8*)(Vt + (size_t)(128 * h + 16 * db + fr) * 256 + 32 * ks + 8 * fq); o[db] = __builtin_amdgcn_mfma_f32_16x16x32_bf16(vf, pf, o[db], 0, 0, 0); }
    }
#pragma unroll
    for (int db = 0; db < 8; ++db) { u32x2 w; w.x = pk2(o[db][0] * inv, o[db][1] * inv); w.y = pk2(o[db][2] * inv, o[db][3] * inv);
        *(u32x2*)(mix + (size_t)t * DMODEL + DCONV + DPOOL + 128 * h + 16 * db + 4 * fq) = w; }
}
template <int R, int C, int PCH> __device__ __forceinline__ void lds_stage_rows(LAS unsigned char* dst, const unsigned char* src, int gp, int tid) {
    constexpr int N = R * C, PER = (N + 511) / 512;
    u32x4 v[PER];
#pragma unroll
    for (int i = 0; i < PER; ++i) { const int idx = tid + 512 * i; if (idx < N) { const int row = idx / C, ch = idx % C; v[i] = *(const u32x4*)(src + (size_t)row * gp + ch * 16); } }
#pragma unroll
    for (int i = 0; i < PER; ++i) { const int idx = tid + 512 * i; if (idx < N) { const int row = idx / C, ch = idx % C; *(LAS u32x4*)(dst + row * (PCH * 16) + (((ch & ~15) | ((ch & 15) ^ (row & 15))) << 4)) = v[i]; } }
}
template <int N> __device__ __forceinline__ float dpp_shrN(float old, float src) { return __builtin_bit_cast(float, __builtin_amdgcn_update_dpp(__builtin_bit_cast(int, old), __builtin_bit_cast(int, src), 0x110 + N, 0xf, 0xf, false)); }
template <int N> __device__ __forceinline__ float dpp_rorN(float src) { return __builtin_bit_cast(float, __builtin_amdgcn_mov_dpp(__builtin_bit_cast(int, src), 0x120 + N, 0xf, 0xf, false)); }
template <int N> __device__ __forceinline__ float scan_step(float x, float p) { return x + dpp_shrN<N>(dpp_rorN<N>(p), x); }
template <int N> __device__ __forceinline__ float scan_step_prev(float p) { return p + dpp_shrN<N>(0.f, p); }

__device__ __forceinline__ void mix_attn_wave(const Ptrs& P, LAS unsigned char* ldsK, LAS unsigned char* ldsV, int h, int row0, int lane) {
    const bf16* z = (const bf16*)(P.ws + WS_Z); bf16* mix = (bf16*)(P.ws + WS_MIX);
    const int fr = lane & 15, fq = lane >> 4;
    bf16x8 q0[4], q1[4];
#pragma unroll
    for (int ks = 0; ks < 4; ++ks) { const bf16* qp = z + (size_t)(row0 + fr) * DIN + 3 * DCONV + DPOOL + 128 * h + 32 * ks + 8 * fq; q0[ks] = *(const bf16x8*)qp; q1[ks] = *(const bf16x8*)(qp + 16 * DIN); }
    unsigned offk[4];
#pragma unroll
    for (int ks = 0; ks < 4; ++ks) offk[ks] = (unsigned)(fr * 256 + (((4 * ks + fq) ^ fr) << 4));
    f32x4 s0[16], s1[16];
#pragma unroll
    for (int kb = 0; kb < 16; ++kb) { s0[kb] = (f32x4){0.f, 0.f, 0.f, 0.f}; s1[kb] = (f32x4){0.f, 0.f, 0.f, 0.f};
#pragma unroll
        for (int ks = 0; ks < 4; ++ks) { const bf16x8 kf = *(const LAS bf16x8*)(ldsK + kb * 4096 + offk[ks]);
            s0[kb] = __builtin_amdgcn_mfma_f32_16x16x32_bf16(kf, q0[ks], s0[kb], 0, 0, 0); s1[kb] = __builtin_amdgcn_mfma_f32_16x16x32_bf16(kf, q1[ks], s1[kb], 0, 0, 0); } }
    const float c2 = 0.08838834764831845f * 1.4426950408889634f;
    bf16x8 p0[8], p1[8]; float inv0, inv1;
    {   float mx = -3.0e38f;
#pragma unroll
        for (int kb = 0; kb < 16; ++kb) mx = fmaxf(fmaxf(fmaxf(s0[kb][0], s0[kb][1]), fmaxf(s0[kb][2], s0[kb][3])), mx);
        mx = fmaxf(mx, __shfl_xor(mx, 16)); mx = fmaxf(mx, __shfl_xor(mx, 32));
        float sum = 0.f;
#pragma unroll
        for (int ks = 0; ks < 8; ++ks) { float e[8];
#pragma unroll
            for (int r = 0; r < 4; ++r) { e[r] = __builtin_amdgcn_exp2f((s0[2 * ks][r] - mx) * c2); e[4 + r] = __builtin_amdgcn_exp2f((s0[2 * ks + 1][r] - mx) * c2); }
            sum += ((e[0] + e[1]) + (e[2] + e[3])) + ((e[4] + e[5]) + (e[6] + e[7]));
            p0[ks] = __builtin_bit_cast(bf16x8, pack8(e)); }
        sum += __shfl_xor(sum, 16); sum += __shfl_xor(sum, 32); inv0 = 1.0f / sum; }
    {   float mx = -3.0e38f;
#pragma unroll
        for (int kb = 0; kb < 16; ++kb) mx = fmaxf(fmaxf(fmaxf(s1[kb][0], s1[kb][1]), fmaxf(s1[kb][2], s1[kb][3])), mx);
        mx = fmaxf(mx, __shfl_xor(mx, 16)); mx = fmaxf(mx, __shfl_xor(mx, 32));
        float sum = 0.f;
#pragma unroll
        for (int ks = 0; ks < 8; ++ks) { float e[8];
#pragma unroll
            for (int r = 0; r < 4; ++r) { e[r] = __builtin_amdgcn_exp2f((s1[2 * ks][r] - mx) * c2); e[4 + r] = __builtin_amdgcn_exp2f((s1[2 * ks + 1][r] - mx) * c2); }
            sum += ((e[0] + e[1]) + (e[2] + e[3])) + ((e[4] + e[5]) + (e[6] + e[7]));
            p1[ks] = __builtin_bit_cast(bf16x8, pack8(e)); }
        sum += __shfl_xor(sum, 16); sum += __shfl_xor(sum, 32); inv1 = 1.0f / sum; }
    f32x4 o0[8], o1[8];
#pragma unroll
    for (int db = 0; db < 8; ++db) { o0[db] = (f32x4){0.f, 0.f, 0.f, 0.f}; o1[db] = (f32x4){0.f, 0.f, 0.f, 0.f}; }
#pragma unroll
    for (int ks = 0; ks < 8; ++ks) {
        const unsigned offv = (unsigned)(fr * 512 + ((ks >> 2) << 8) + (((4 * (ks & 3) + fq) ^ fr) << 4));
#pragma unroll
        for (int db = 0; db < 8; ++db) { const bf16x8 vf = *(const LAS bf16x8*)(ldsV + db * 8192 + offv);
            o0[db] = __builtin_amdgcn_mfma_f32_16x16x32_bf16(vf, p0[ks], o0[db], 0, 0, 0); o1[db] = __builtin_amdgcn_mfma_f32_16x16x32_bf16(vf, p1[ks], o1[db], 0, 0, 0); } }
    bf16* op = mix + (size_t)(row0 + fr) * DMODEL + DCONV + DPOOL + 128 * h + 4 * fq;
#pragma unroll
    for (int db = 0; db < 8; ++db) { u32x2 w; w.x = pk2(o0[db][0] * inv0, o0[db][1] * inv0); w.y = pk2(o0[db][2] * inv0, o0[db][3] * inv0); *(u32x2*)(op + 16 * db) = w;
        w.x = pk2(o1[db][0] * inv1, o1[db][1] * inv1); w.y = pk2(o1[db][2] * inv1, o1[db][3] * inv1); *(u32x2*)(op + (size_t)16 * DMODEL + 16 * db) = w; }
}

template <int g> __device__ __forceinline__ void mix_pool_wave(const Ptrs& P, LAS unsigned char* ldsW, int row0, int lane) {
    constexpr int k = 2 << g;
    const bf16* z = (const bf16*)(P.ws + WS_Z); bf16* mix = (bf16*)(P.ws + WS_MIX);
    const int fr = lane & 15, fq = lane >> 4;
    f32x4 acc0[12], acc1[12];
#pragma unroll
    for (int n = 0; n < 12; ++n) { acc0[n] = (f32x4){0.f, 0.f, 0.f, 0.f}; acc1[n] = (f32x4){0.f, 0.f, 0.f, 0.f}; }
    const float invA = 1.0f / (float)((row0 + fr + 1 < k) ? row0 + fr + 1 : k), invB = 1.0f / (float)((row0 + 16 + fr + 1 < k) ? row0 + 16 + fr + 1 : k);
#pragma unroll 1
    for (int ks = 0; ks < 6; ++ks) {
        const bf16* zp = z + (long)(row0 - 16 + fr) * DIN + 3 * DCONV + PGD * g + 32 * ks + 8 * fq;
        float pv[8], xa[8], xb[8], sa[8], sb[8];
        unpack8(*(const u32x4*)zp, pv); unpack8(*(const u32x4*)(zp + 16 * DIN), xa); unpack8(*(const u32x4*)(zp + 32 * DIN), xb);
#pragma unroll
        for (int e = 0; e < 8; ++e) {
            float p = pv[e], a = xa[e], b = xb[e];
            float b1 = scan_step<1>(b, a), a1 = scan_step<1>(a, p), p1 = scan_step_prev<1>(p);
            if (k >= 4) { const float b2 = scan_step<2>(b1, a1), a2 = scan_step<2>(a1, p1), p2 = scan_step_prev<2>(p1); b1 = b2; a1 = a2; p1 = p2; }
            if (k >= 8) { const float b2 = scan_step<4>(b1, a1), a2 = scan_step<4>(a1, p1), p2 = scan_step_prev<4>(p1); b1 = b2; a1 = a2; p1 = p2; }
            if (k >= 16) { const float b2 = scan_step<8>(b1, a1), a2 = scan_step<8>(a1, p1); b1 = b2; a1 = a2; }
            sa[e] = a1 * invA - a; sb[e] = b1 * invB - b; }
        const bf16x8 fa = __builtin_bit_cast(bf16x8, pack8(sa)), fb = __builtin_bit_cast(bf16x8, pack8(sb));
        const unsigned offw = (unsigned)(fr * 512 + ((ks >> 2) << 8) + (((4 * (ks & 3) + fq) ^ fr) << 4));
#pragma unroll
        for (int n = 0; n < 12; ++n) { const bf16x8 wf = *(const LAS bf16x8*)(ldsW + n * 8192 + offw);
            acc0[n] = __builtin_amdgcn_mfma_f32_16x16x32_bf16(wf, fa, acc0[n], 0, 0, 0); acc1[n] = __builtin_amdgcn_mfma_f32_16x16x32_bf16(wf, fb, acc1[n], 0, 0, 0); }
    }
    bf16* op = mix + (size_t)(row0 + fr) * DMODEL + DCONV + PGD * g + 4 * fq;
#pragma unroll
    for (int n = 0; n < 12; ++n) { const f32x4 sc = *(const f32x4*)(P.pool_scale + PGD * g + 16 * n + 4 * fq);
        u32x2 o; o.x = pk2(acc0[n][0] * sc[0], acc0[n][1] * sc[1]); o.y = pk2(acc0[n][2] * sc[2], acc0[n][3] * sc[3]); *(u32x2*)(op + 16 * n) = o;
        o.x = pk2(acc1[n][0] * sc[0], acc1[n][1] * sc[1]); o.y = pk2(acc1[n][2] * sc[2], acc1[n][3] * sc[3]); *(u32x2*)(op + (size_t)16 * DMODEL + 16 * n) = o; }
}

__device__ __forceinline__ void p2_mixer(const Ptrs& P, LAS unsigned char* lds, int w, int tid, int wave, int lane, int tmask) {
    const int sub = w & 3, tile = w >> 2, row0 = tile * 256 + wave * 32;
    if (tmask & 0x1e0) {
        lds_stage_rows<256, 16, 16>(lds, (const unsigned char*)(P.ws + WS_KB) + 256 * sub, 1024, tid);
        lds_stage_rows<128, 32, 32>(lds + 65536, (const unsigned char*)(P.ws + WS_VT) + (size_t)sub * 128 * 512, 512, tid);
        LDS_WAIT(); __syncthreads();
        mix_attn_wave(P, lds, lds + 65536, sub, row0, lane);
        __syncthreads();
    }
    if (tmask & 0x1e) {
        lds_stage_rows<192, 24, 32>(lds, (const unsigned char*)(P.ws + WS_POOLWT) + (size_t)sub * PGD * PGD * 2, PGD * 2, tid);
        LDS_WAIT(); __syncthreads();
        if (sub == 0) mix_pool_wave<0>(P, lds, row0, lane); else if (sub == 1) mix_pool_wave<1>(P, lds, row0, lane); else if (sub == 2) mix_pool_wave<2>(P, lds, row0, lane); else mix_pool_wave<3>(P, lds, row0, lane);
        __syncthreads();
    }
    if (tmask & 1) { for (int b = wave; b < 4; b += 8) mix_conv_task(P, 4 * w + b, lane); }
}

__device__ __forceinline__ void p5_fixup(const Ptrs& P, int gt, int NGT) {
    const float* ub = (const float*)(P.ws + WS_UBND); bf16* act = (bf16*)(P.ws + WS_ACT); const float* cw = P.ffn_conv_w; const float* cb = P.ffn_conv_b;
    for (int i = gt; i < 63 * (DFF / 8); i += NGT) {
        const int pm = 1 + i / (DFF / 8), c = (i % (DFF / 8)) * 8, gi = 256 * (c / 128) + (c % 128);
        const float* p2 = ub + (size_t)((pm - 1) * 4 + 2) * DFF2 + gi; const float* p1 = p2 + DFF2; const float* r0 = ub + (size_t)(pm * 4) * DFF2 + gi; const float* r1 = r0 + DFF2;
        float o0[8], o1[8];
#pragma unroll
        for (int e = 0; e < 8; ++e) {
            const float gw0 = cw[c + e], gw1 = cw[DFF2 + c + e], gw2 = cw[2 * DFF2 + c + e], gb = cb[c + e], vw0 = cw[DFF + c + e], vw1 = cw[DFF2 + DFF + c + e], vw2 = cw[2 * DFF2 + DFF + c + e], vb = cb[DFF + c + e];
            const float G0 = gw2 * r0[e] + (gw1 * p1[e] + (gw0 * p2[e] + gb)), V0 = vw2 * r0[128 + e] + (vw1 * p1[128 + e] + (vw0 * p2[128 + e] + vb));
            const float G1 = gw2 * r1[e] + (gw1 * r0[e] + (gw0 * p1[e] + gb)), V1 = vw2 * r1[128 + e] + (vw1 * r0[128 + e] + (vw0 * p1[128 + e] + vb));
            o0[e] = G0 * __builtin_amdgcn_rcpf(1.0f + __builtin_amdgcn_exp2f(-1.4426950408889634f * G0)) * V0;
            o1[e] = G1 * __builtin_amdgcn_rcpf(1.0f + __builtin_amdgcn_exp2f(-1.4426950408889634f * G1)) * V1; }
        *(u32x4*)(act + (size_t)(256 * pm) * DFF + c) = pack8(o0); *(u32x4*)(act + (size_t)(256 * pm + 1) * DFF + c) = pack8(o1);
    }
}

__device__ __forceinline__ void p7_final(const Ptrs& P, int gw, int NGW, int lane) {
    const float* slab = (const float*)(P.ws + WS_SLAB2);
    for (int m = gw; m < SEQ; m += NGW) {
        const float part = (lane < 32) ? slab[(size_t)m * 32 + lane] : 0.f;
        const float rstd = 1.0f / sqrtf(wave_sum(part) * (1.0f / DMODEL) + EPS);
        f32x4* xr = (f32x4*)(P.out + (size_t)m * DMODEL) + lane; const f32x4* gr = (const f32x4*)P.g_final + lane;
#pragma unroll
        for (int j = 0; j < 8; ++j) { f32x4 v = xr[64 * j]; const f32x4 gg = gr[64 * j]; v = v * rstd * gg; xr[64 * j] = v; }
    }
}

struct Args { const float* in[16]; float* out; unsigned char* ws; int ph_lo, ph_hi; };
__global__ void __launch_bounds__(NWAVES * 64, 2) hybrid_fwd(Args args) {
    extern __shared__ __attribute__((aligned(16))) unsigned char lds_raw[];
    LAS unsigned char* lds = (LAS unsigned char*)lds_raw;
    cg::grid_group grid = cg::this_grid();
    const int tid = threadIdx.x, lane = tid & 63, wave = __builtin_amdgcn_readfirstlane(tid >> 6);
    const int G = gridDim.x, bx = blockIdx.x, vcu = (G % 8 == 0) ? (bx % 8) * (G / 8) + bx / 8 : bx;
    const int gw = vcu * NWAVES + wave, NGW = G * NWAVES;
    volatile LAS unsigned* MISC = (volatile LAS unsigned*)(lds + MISC_OFF);
    if (tid < 32) MISC[tid] = 0u;
    __syncthreads();
    const XcdBarrier bar = xcd_barrier_post((unsigned*)(args.ws + WS_CTL), MISC + 8);
    Ptrs P;
    P.x = args.in[0]; P.mem = args.in[1]; P.g_mix = args.in[2]; P.g_mem = args.in[3]; P.w_in = args.in[4]; P.conv_w = args.in[5]; P.pool_w = args.in[6]; P.pool_scale = args.in[7];
    P.w_kv = args.in[8]; P.w_out = args.in[9]; P.g_ffn = args.in[10]; P.w_up = args.in[11]; P.ffn_conv_w = args.in[12]; P.ffn_conv_b = args.in[13]; P.w_down = args.in[14]; P.g_final = args.in[15];
    P.out = args.out; P.ws = args.ws;
    unsigned char* ws = args.ws;
#if PROBE_SYNC
    for (int i = 0; i < 20; ++i) xcd_barrier(bar);
#endif
    const int lo = args.ph_lo, hi = args.ph_hi;
#define IN(k) (lo <= (k) && (k) < hi)
#define SYNC(k) do { if ((k) + 1 < hi) { if ((k) == 0 && USE_CG_SYNC) grid.sync(); else xcd_barrier(bar); } } while (0)
#define SYNCR(k, b) do { if ((k) + 1 < hi || rp + 1 < NREP(b)) { if ((k) == 0 && USE_CG_SYNC) grid.sync(); else xcd_barrier(bar); } } while (0)
#define NREP(b) ((REPM & (b)) ? 2 : 1)
    if (IN(0) && (PHM & 1)) for (int rp = 0; rp < NREP(1); ++rp) { p0_prologue(P, lds, gw, NGW, wave, lane); SYNCR(0, 1); }
    if (IN(1) && (PHM & 2)) for (int rp = 0; rp < NREP(2); ++rp) {
        pg8::Gemm g{(const bf16*)(ws + WS_H), (const bf16*)(ws + WS_WINT), SEQ, DIN, DMODEL}; pg8::StaticOrder S; S.init(SEQ, DIN, G, bx);
        pg8::EpiZ E{(bf16*)(ws + WS_Z), DIN};
        pg8::gemm_phase<pg8::EpiZ, pg8::StaticOrder, true, true>(lds, g, S, E, lds + XLDS_OFF);
        { const int nfull = ((SEQ / 256) * (DIN / 256)) % G;
          if (nfull == 0) p1_idle_work(P, lds, bx * NWAVES + wave, G * NWAVES, wave, lane);
          else if (bx >= nfull) p1_idle_work(P, lds, (bx - nfull) * NWAVES + wave, (G - nfull) * NWAVES, wave, lane); }
        SYNCR(1, 2);
    }
    if (IN(2) && (PHM & 4)) for (int rp = 0; rp < NREP(4); ++rp) { p2_mixer(P, lds, vcu, tid, wave, lane, 511);
#if PROBE_P2
        p2_mixer(P, lds, vcu, tid, wave, lane, PROBE_P2);
#endif
        SYNCR(2, 4); }
    if (IN(3) && (PHM & 8)) for (int rp = 0; rp < NREP(8); ++rp) {
        pg8::Gemm g{(const bf16*)(ws + WS_MIX), (const bf16*)(ws + WS_WOUTT), SEQ, DMODEL, DMODEL}; pg8::StaticOrder S; S.init(SEQ, DMODEL, G, bx);
        pg8::EpiResA E{P.x, (bf16*)(ws + WS_X1B), (float*)(ws + WS_SLAB1)};
        pg8::gemm_phase<pg8::EpiResA, pg8::StaticOrder, true, true>(lds, g, S, E, lds + XLDS_OFF);
        SYNCR(3, 8);
    }
#if PROBE_GEMM
    if (IN(3)) {
        pg8::Gemm g{(const bf16*)(ws + WS_X1B), (const bf16*)(ws + WS_WUPT), SEQ, PROBE_N, DMODEL}; pg8::StaticOrder S; S.init(SEQ, PROBE_N, G, bx);
#if PROBE_GEMM == 1
        pg8::EpiZ E{(bf16*)(ws + WS_Z), PROBE_N};
        pg8::gemm_phase<pg8::EpiZ, pg8::StaticOrder, true, true>(lds, g, S, E, lds + XLDS_OFF);
#elif PROBE_GEMM == 2
        pg8::EpiNone E{};
        pg8::gemm_phase<pg8::EpiNone, pg8::StaticOrder, true, true>(lds, g, S, E, lds + XLDS_OFF);
#elif PROBE_GEMM == 3
        pg8::EpiZ E{(bf16*)(ws + WS_Z), PROBE_N};
        pg8::gemm_phase<pg8::EpiZ, pg8::StaticOrder, true, false>(lds, g, S, E, lds + XLDS_OFF);
#elif PROBE_GEMM == 5
        pg8::EpiAct E{(bf16*)(ws + WS_ACT), (const float*)(ws + WS_SLAB1), P.ffn_conv_w, P.ffn_conv_b, (float*)(ws + WS_UBND)};
        pg8::gemm_phase<pg8::EpiAct, pg8::StaticOrder, true, true>(lds, g, S, E, lds + XLDS_OFF);
#elif PROBE_GEMM == 4
        pg8::EpiZ E{(bf16*)(ws + WS_Z), PROBE_N};
        pg8::gemm_phase<pg8::EpiZ, pg8::StaticOrder, false, true>(lds, g, S, E, lds + XLDS_OFF);
#endif
        xcd_barrier(bar);
    }
#endif
    if (IN(4) && (PHM & 16)) for (int rp = 0; rp < NREP(16); ++rp) {
        pg8::Gemm g{(const bf16*)(ws + WS_X1B), (const bf16*)(ws + WS_WUPT), SEQ, DFF2, DMODEL}; pg8::StaticOrder S; S.init(SEQ, DFF2, G, bx);
        pg8::EpiAct E{(bf16*)(ws + WS_ACT), (const float*)(ws + WS_SLAB1), P.ffn_conv_w, P.ffn_conv_b, (float*)(ws + WS_UBND)};
        pg8::gemm_phase<pg8::EpiAct, pg8::StaticOrder, true, true>(lds, g, S, E, lds + XLDS_OFF);
        xcd_barrier(bar);
    }
    if (IN(5) && (PHM & 32)) { p5_fixup(P, vcu * (NWAVES * 64) + tid, G * NWAVES * 64); xcd_barrier(bar); }
    if (IN(6) && (PHM & 64)) {
        pg8::Gemm g{(const bf16*)(ws + WS_ACT), (const bf16*)(ws + WS_WDOWNT), SEQ, DMODEL, DFF}; pg8::PanelOrder S{G, vcu, (SEQ / 256) * (DMODEL / 256)};
        pg8::EpiFinal E{(const bf16*)(ws + WS_X1B), P.out, P.g_final, (unsigned*)(ws + WS_SLAB2), (unsigned*)(ws + WS_CTL) + CW_PANEL, (unsigned*)(ws + WS_CTL) + XB_TMO};
        pg8::gemm_phase<pg8::EpiFinal, pg8::PanelOrder, true, true>(lds, g, S, E, lds + XLDS_OFF);
    }
#undef IN
#undef SYNC
}

extern "C" void kernel_launch(void* const* d_in, const int* in_sizes, int n_in, void* d_out, int out_size, void* d_ws, size_t ws_size, hipStream_t stream) {
    static int grid = 0;
    if (grid == 0) {
        if (n_in != 16 || in_sizes[0] != SEQ * DMODEL || out_size != SEQ * DMODEL || ws_size < WS_END) { fprintf(stderr, "kernel_launch: unexpected shapes (n_in %d, in0 %d, out %d, ws %zu)\n", n_in, n_in > 0 ? in_sizes[0] : -1, out_size, ws_size); grid = -1; return; }
        int dev = 0, cus = 0, per_cu = 0;
        if (hipGetDevice(&dev) != hipSuccess || hipDeviceGetAttribute(&cus, hipDeviceAttributeMultiprocessorCount, dev) != hipSuccess) { grid = -1; return; }
        if (hipFuncSetAttribute((const void*)hybrid_fwd, hipFuncAttributeMaxDynamicSharedMemorySize, LDS_BYTES) != hipSuccess) { fprintf(stderr, "kernel_launch: hipFuncSetAttribute failed\n"); grid = -1; return; }
        if (hipOccupancyMaxActiveBlocksPerMultiprocessor(&per_cu, (const void*)hybrid_fwd, NWAVES * 64, LDS_BYTES) != hipSuccess || per_cu < 1) { fprintf(stderr, "kernel_launch: occupancy query says %d blocks per CU\n", per_cu); (void)hipGetLastError(); per_cu = 1; }
        grid = cus;
        if (grid % 8 != 0 || grid < 8) { fprintf(stderr, "kernel_launch: %d CUs\n", grid); }
    }
    if (grid < 0) return;
    if (hipMemsetAsync((char*)d_ws + WS_CTL, 0, CTL_ZERO_BYTES, stream) != hipSuccess) { fprintf(stderr, "kernel_launch: hipMemsetAsync failed\n"); return; }
    Args a{};
    for (int i = 0; i < 16; ++i) a.in[i] = (const float*)d_in[i];
    a.out = (float*)d_out; a.ws = (unsigned char*)d_ws;
#if MK_PER_PHASE
    for (int ph = 0; ph < NPHASE; ++ph) { a.ph_lo = ph; a.ph_hi = ph + 1; hipLaunchKernelGGL(hybrid_fwd, dim3(grid), dim3(NWAVES * 64), LDS_BYTES, stream, a); }
#else
    a.ph_lo = 0; a.ph_hi = NPHASE;
    void* kargs[] = {&a};
    hipError_t e = hipLaunchCooperativeKernel((const void*)hybrid_fwd, dim3(grid), dim3(NWAVES * 64), kargs, LDS_BYTES, stream);
    if (e != hipSuccess) fprintf(stderr, "kernel_launch: cooperative launch failed: %s (grid %d)\n", hipGetErrorString(e), grid);
#endif
}
```

```cpp
#include <hip/hip_runtime.h>
#include <hip/hip_cooperative_groups.h>
#include <cstdio>
#include <cstdint>
namespace cg = cooperative_groups;
namespace pg8 {
#define PG8_LAS __attribute__((address_space(3)))
typedef unsigned short bf16_t;
typedef short bf16x8 __attribute__((ext_vector_type(8)));
typedef float f32x4 __attribute__((ext_vector_type(4)));
typedef unsigned u32x4 __attribute__((ext_vector_type(4)));
constexpr int BM = 256, BK = 64, HALF = 128, HTB = HALF * BK * 2  , STAGE_BYTES = 8 * HTB, NXCD = 8, WGM = 8;

__host__ __device__ __forceinline__ int lds_byte(int r, int c) { const int st = (r >> 4) * 2 + (c >> 5), rr = r & 15, cc = c & 31, ob = rr * 64 + cc * 2; return st * 1024 + (ob ^ (((ob >> 9) & 1) << 5)); }
__host__ __device__ __forceinline__ void stage_rc(int b, int& R, int& C) { const int st = b / 1024, sb = b % 1024, swz = sb ^ (((sb >> 9) & 1) << 5); R = (st >> 1) * 16 + swz / 64; C = (st & 1) * 32 + (swz % 64) / 2; }
__host__ __device__ __forceinline__ int perm32(int rho) { const int n = rho >> 4, i = rho & 15; return 8 * (i >> 2) + 4 * n + (i & 3); }

struct Unit { int pm, pn; };
struct Gemm { const bf16_t* A; const bf16_t* Bt; int M, N, K; };

struct StaticOrder {
    int nM, nN, nwg, G, c;
    __host__ __device__ void init(int M, int N, int G_, int c_) { nM = M / BM; nN = N / BM; nwg = nM * nN; G = G_; c = c_; }
    __host__ __device__ bool next(int i, Unit& u) const {
        const long L = (long)i * G + c; if (L >= nwg) return false;
        int wgid = (int)L; { const int q = nwg / NXCD, r = nwg % NXCD, xcd = wgid % NXCD, off = wgid / NXCD; wgid = (xcd < r ? xcd * (q + 1) : r * (q + 1) + (xcd - r) * q) + off; }
        const int nig = WGM * nN, gid = wgid / nig, fm = gid * WGM, gsz = (nM - fm) < WGM ? (nM - fm) : WGM;
        u.pm = fm + ((wgid % nig) % gsz); u.pn = (wgid % nig) / gsz; return true;
    }
    __device__ __forceinline__ void a_ready(const Unit&) const {}
    __device__ __forceinline__ void done(const Unit&) const {}
};
__device__ __forceinline__ unsigned cvt_pk_bf16(float lo, float hi) { unsigned r; asm volatile("v_cvt_pk_bf16_f32 %0, %1, %2" : "=v"(r) : "v"(lo), "v"(hi)); return r; }
typedef unsigned u32x2 __attribute__((ext_vector_type(2)));
constexpr int DM = 2048;
constexpr float RMS_EPS = 1e-6f;

struct EpiZ {
    static constexpr bool PERM = true, AFTER_DRAIN = false;
    bf16_t* O; int ldc;
    __device__ __forceinline__ void operator()(const f32x4 (&acc)[2][2][4][2], const Unit& u, int wr, int wc, int fr_, int fq_, PG8_LAS unsigned char*) const {
        int t_ = threadIdx.x; asm volatile("" : "+v"(t_));
        const int fr = t_ & 15, fq = (t_ >> 4) & 3;
        const int row0 = u.pm * BM + wr * 64 + fr, col0 = u.pn * BM + wc * 32 + 8 * fq;
#pragma unroll
        for (int ai = 0; ai < 2; ++ai)
#pragma unroll
            for (int m = 0; m < 4; ++m) { bf16_t* rowp = O + (size_t)(row0 + ai * HALF + m * 16) * ldc + col0;
#pragma unroll
                for (int bj = 0; bj < 2; ++bj) { const f32x4 v0 = acc[ai][bj][m][0], v1 = acc[ai][bj][m][1];
                    u32x4 w; w.x = cvt_pk_bf16(v0[0], v0[1]); w.y = cvt_pk_bf16(v0[2], v0[3]); w.z = cvt_pk_bf16(v1[0], v1[1]); w.w = cvt_pk_bf16(v1[2], v1[3]);
                    *(u32x4*)(rowp + bj * HALF) = w; } }
    }
};

struct EpiNone {
    static constexpr bool PERM = true, AFTER_DRAIN = false;
    __device__ __forceinline__ void operator()(const f32x4 (&acc)[2][2][4][2], const Unit& u, int wr, int wc, int fr, int fq, PG8_LAS unsigned char*) const {
#pragma unroll
        for (int ai = 0; ai < 2; ++ai)
#pragma unroll
            for (int bj = 0; bj < 2; ++bj)
#pragma unroll
                for (int m = 0; m < 4; ++m)
#pragma unroll
                    for (int n = 0; n < 2; ++n) asm volatile("" :: "v"(acc[ai][bj][m][n]));
    }
};
struct EpiResA {
    static constexpr bool PERM = true, AFTER_DRAIN = false;
    const float* R; bf16_t* XB; float* slab;
    __device__ __forceinline__ void operator()(const f32x4 (&acc)[2][2][4][2], const Unit& u, int wr, int wc, int fr_, int fq_, PG8_LAS unsigned char*) const {
        int t_ = threadIdx.x; asm volatile("" : "+v"(t_));
        const int fr = t_ & 15, fq = (t_ >> 4) & 3;
        const int row0 = u.pm * BM + wr * 64 + fr, col0 = u.pn * BM + wc * 32 + 8 * fq;
#pragma unroll
        for (int ai = 0; ai < 2; ++ai) {
            f32x4 r[4][2][2];
#pragma unroll
            for (int m = 0; m < 4; ++m)
#pragma unroll
                for (int bj = 0; bj < 2; ++bj) { const float* p = R + (size_t)(row0 + ai * HALF + m * 16) * DM + col0 + bj * HALF; r[m][bj][0] = *(const f32x4*)p; r[m][bj][1] = *(const f32x4*)(p + 4); }
#pragma unroll
            for (int m = 0; m < 4; ++m) { const int row = row0 + ai * HALF + m * 16; float ss = 0.f;
#pragma unroll
                for (int bj = 0; bj < 2; ++bj) { const f32x4 v0 = acc[ai][bj][m][0] + r[m][bj][0], v1 = acc[ai][bj][m][1] + r[m][bj][1];
                    u32x4 w; w.x = cvt_pk_bf16(v0[0], v0[1]); w.y = cvt_pk_bf16(v0[2], v0[3]); w.z = cvt_pk_bf16(v1[0], v1[1]); w.w = cvt_pk_bf16(v1[2], v1[3]);
                    *(u32x4*)(XB + (size_t)row * DM + col0 + bj * HALF) = w;
                    ss += (v0[0] * v0[0] + v0[1] * v0[1]) + (v0[2] * v0[2] + v0[3] * v0[3]) + (v1[0] * v1[0] + v1[1] * v1[1]) + (v1[2] * v1[2] + v1[3] * v1[3]); }
                ss += __shfl_xor(ss, 16); ss += __shfl_xor(ss, 32);
                if (fq == 0) slab[(size_t)row * 32 + u.pn * 4 + wc] = ss; }
            asm volatile("" ::: "memory"); }
    }
};
struct EpiResB {
    static constexpr bool PERM = true, AFTER_DRAIN = false;
    const bf16_t* RB; float* X; float* slab;
    __device__ __forceinline__ void operator()(const f32x4 (&acc)[2][2][4][2], const Unit& u, int wr, int wc, int fr_, int fq_, PG8_LAS unsigned char*) const {
        int t_ = threadIdx.x; asm volatile("" : "+v"(t_));
        const int fr = t_ & 15, fq = (t_ >> 4) & 3;
        const int row0 = u.pm * BM + wr * 64 + fr, col0 = u.pn * BM + wc * 32 + 8 * fq;
        u32x4 r[2][4][2];
#pragma unroll
        for (int ai = 0; ai < 2; ++ai)
#pragma unroll
            for (int m = 0; m < 4; ++m)
#pragma unroll
                for (int bj = 0; bj < 2; ++bj) r[ai][m][bj] = *(const u32x4*)(RB + (size_t)(row0 + ai * HALF + m * 16) * DM + col0 + bj * HALF);
#pragma unroll
        for (int ai = 0; ai < 2; ++ai)
#pragma unroll
            for (int m = 0; m < 4; ++m) { const int row = row0 + ai * HALF + m * 16; float ss = 0.f;
#pragma unroll
                for (int bj = 0; bj < 2; ++bj) { const u32x4 q = r[ai][m][bj];
                    const f32x4 r0 = {__builtin_bit_cast(float, q.x << 16), __builtin_bit_cast(float, q.x & 0xffff0000u), __builtin_bit_cast(float, q.y << 16), __builtin_bit_cast(float, q.y & 0xffff0000u)};
                    const f32x4 r1 = {__builtin_bit_cast(float, q.z << 16), __builtin_bit_cast(float, q.z & 0xffff0000u), __builtin_bit_cast(float, q.w << 16), __builtin_bit_cast(float, q.w & 0xffff0000u)};
                    const f32x4 v0 = acc[ai][bj][m][0] + r0, v1 = acc[ai][bj][m][1] + r1;
                    float* xp = X + (size_t)row * DM + col0 + bj * HALF; *(f32x4*)xp = v0; *(f32x4*)(xp + 4) = v1;
                    ss += (v0[0] * v0[0] + v0[1] * v0[1]) + (v0[2] * v0[2] + v0[3] * v0[3]) + (v1[0] * v1[0] + v1[1] * v1[1]) + (v1[2] * v1[2] + v1[3] * v1[3]); }
                ss += __shfl_xor(ss, 16); ss += __shfl_xor(ss, 32);
                if (fq == 0) slab[(size_t)row * 32 + u.pn * 4 + wc] = ss; }
    }
};

struct PanelOrder {
    int G, vcu, ntot;
    __device__ __forceinline__ bool next(int i, Unit& u) const { const int L = i * G + vcu; if (L >= ntot) return false; u.pm = L >> 3; u.pn = L & 7; return true; }
    __device__ __forceinline__ void a_ready(const Unit&) const {}
    __device__ __forceinline__ void done(const Unit&) const {}
};
template <int MODE  > struct EpiNorm {
    static constexpr bool PERM = true, AFTER_DRAIN = false;
    const float* Rf; const bf16_t* Rb; const float* sig_in; float* sig_out; bf16_t* HN; float* OUT; const float* gfin; unsigned* xbuf; unsigned* cnt; unsigned* tmo;
    __device__ __forceinline__ void operator()(f32x4 (&acc)[2][2][4][2], const Unit& u, int wr, int wc, int fr_, int fq_, PG8_LAS unsigned char* xlds) const {
        int t_ = threadIdx.x; asm volatile("" : "+v"(t_));
        const int fr = t_ & 15, fq = (t_ >> 4) & 3, wid = __builtin_amdgcn_readfirstlane(t_ >> 6);
        const int rl0 = wr * 64 + fr, row0 = u.pm * BM + rl0, col0 = u.pn * BM + wc * 32 + 8 * fq;
        PG8_LAS float* Pt = (PG8_LAS float*)xlds;
        PG8_LAS float* St = (PG8_LAS float*)(xlds + 4096);
        if constexpr (MODE == 0) {
#pragma unroll
            for (int ai = 0; ai < 2; ++ai) { f32x4 r[4][2][2];
#pragma unroll
                for (int m = 0; m < 4; ++m)
#pragma unroll
                    for (int bj = 0; bj < 2; ++bj) { const float* p = Rf + (size_t)(row0 + ai * HALF + m * 16) * DM + col0 + bj * HALF; r[m][bj][0] = *(const f32x4*)p; r[m][bj][1] = *(const f32x4*)(p + 4); }
#pragma unroll
                for (int m = 0; m < 4; ++m) { float ss = 0.f;
#pragma unroll
                    for (int bj = 0; bj < 2; ++bj) { const f32x4 v0 = acc[ai][bj][m][0] + r[m][bj][0], v1 = acc[ai][bj][m][1] + r[m][bj][1]; acc[ai][bj][m][0] = v0; acc[ai][bj][m][1] = v1;
                        ss += (v0[0] * v0[0] + v0[1] * v0[1]) + (v0[2] * v0[2] + v0[3] * v0[3]) + (v1[0] * v1[0] + v1[1] * v1[1]) + (v1[2] * v1[2] + v1[3] * v1[3]); }
                    ss += __shfl_xor(ss, 16); ss += __shfl_xor(ss, 32);
                    if (fq == 0) Pt[(ai * HALF + rl0 + m * 16) * 4 + wc] = ss; }
                asm volatile("" ::: "memory"); }
        } else { u32x4 r[2][4][2]; float sg[2][4];
#pragma unroll
            for (int ai = 0; ai < 2; ++ai)
#pragma unroll
                for (int m = 0; m < 4; ++m) { sg[ai][m] = sig_in[row0 + ai * HALF + m * 16];
#pragma unroll
                    for (int bj = 0; bj < 2; ++bj) r[ai][m][bj] = *(const u32x4*)(Rb + (size_t)(row0 + ai * HALF + m * 16) * DM + col0 + bj * HALF); }
#pragma unroll
            for (int ai = 0; ai < 2; ++ai)
#pragma unroll
                for (int m = 0; m < 4; ++m) { float ss = 0.f; const float sgm = sg[ai][m];
#pragma unroll
                    for (int bj = 0; bj < 2; ++bj) { const u32x4 q = r[ai][m][bj];
                        const f32x4 r0 = {__builtin_bit_cast(float, q.x << 16), __builtin_bit_cast(float, q.x & 0xffff0000u), __builtin_bit_cast(float, q.y << 16), __builtin_bit_cast(float, q.y & 0xffff0000u)};
                        const f32x4 r1 = {__builtin_bit_cast(float, q.z << 16), __builtin_bit_cast(float, q.z & 0xffff0000u), __builtin_bit_cast(float, q.w << 16), __builtin_bit_cast(float, q.w & 0xffff0000u)};
                        const f32x4 v0 = acc[ai][bj][m][0] + r0 * sgm, v1 = acc[ai][bj][m][1] + r1 * sgm; acc[ai][bj][m][0] = v0; acc[ai][bj][m][1] = v1;
                        ss += (v0[0] * v0[0] + v0[1] * v0[1]) + (v0[2] * v0[2] + v0[3] * v0[3]) + (v1[0] * v1[0] + v1[1] * v1[1]) + (v1[2] * v1[2] + v1[3] * v1[3]); }
                    ss += __shfl_xor(ss, 16); ss += __shfl_xor(ss, 32);
                    if (fq == 0) Pt[(ai * HALF + rl0 + m * 16) * 4 + wc] = ss; } }
        asm volatile("s_waitcnt lgkmcnt(0)" ::: "memory"); __builtin_amdgcn_s_barrier(); asm volatile("" ::: "memory");
        if (t_ < 256) { const float s = (Pt[t_ * 4 + 0] + Pt[t_ * 4 + 1]) + (Pt[t_ * 4 + 2] + Pt[t_ * 4 + 3]);
            __hip_atomic_store(xbuf + (size_t)(u.pm * BM + t_) * 8 + u.pn, __builtin_bit_cast(unsigned, s), __ATOMIC_RELAXED, __HIP_MEMORY_SCOPE_AGENT); }
        asm volatile("s_waitcnt vmcnt(0)" ::: "memory");
        if (t_ < 256 && (t_ & 63) == 0) __hip_atomic_fetch_add(cnt + 64 * u.pm, 1u, __ATOMIC_RELAXED, __HIP_MEMORY_SCOPE_AGENT);
        if (wid == 0) {
            unsigned spins = 0;
            while ((unsigned)__builtin_amdgcn_readfirstlane(__hip_atomic_load(cnt + 64 * u.pm, __ATOMIC_RELAXED, __HIP_MEMORY_SCOPE_AGENT)) < 32u) {
                __builtin_amdgcn_s_sleep(2);
                if (++spins > (1u << 20)) { if ((t_ & 63) == 0) __hip_atomic_store(tmo, 1u, __ATOMIC_RELAXED, __HIP_MEMORY_SCOPE_AGENT); break; } }
            __builtin_amdgcn_fence(__ATOMIC_ACQUIRE, "agent");
        }
        asm volatile("s_waitcnt vmcnt(0) lgkmcnt(0)" ::: "memory"); __builtin_amdgcn_s_barrier(); asm volatile("" ::: "memory");
        if (t_ < 256) { const unsigned long long* sp = (const unsigned long long*)(xbuf + (size_t)(u.pm * BM + t_) * 8); float tot = 0.f;
#pragma unroll
            for (int q = 0; q < 4; ++q) { const unsigned long long w = __hip_atomic_load(sp + q, __ATOMIC_RELAXED, __HIP_MEMORY_SCOPE_AGENT);
                tot += __builtin_bit_cast(float, (unsigned)w); tot += __builtin_bit_cast(float, (unsigned)(w >> 32)); }
            const float sd = sqrtf(tot * (1.0f / DM) + RMS_EPS);
            St[t_] = 1.0f / sd;
            if (MODE == 0 && u.pn == 0) sig_out[u.pm * BM + t_] = sd; }
        asm volatile("s_waitcnt lgkmcnt(0)" ::: "memory"); __builtin_amdgcn_s_barrier(); asm volatile("" ::: "memory");
        if constexpr (MODE == 0) {
#pragma unroll
            for (int ai = 0; ai < 2; ++ai)
#pragma unroll
                for (int m = 0; m < 4; ++m) { const float rstd = St[ai * HALF + rl0 + m * 16]; bf16_t* op = HN + (size_t)(row0 + ai * HALF + m * 16) * DM + col0;
#pragma unroll
                    for (int bj = 0; bj < 2; ++bj) { const f32x4 v0 = acc[ai][bj][m][0] * rstd, v1 = acc[ai][bj][m][1] * rstd;
                        u32x4 w; w.x = cvt_pk_bf16(v0[0], v0[1]); w.y = cvt_pk_bf16(v0[2], v0[3]); w.z = cvt_pk_bf16(v1[0], v1[1]); w.w = cvt_pk_bf16(v1[2], v1[3]);
                        *(u32x4*)(op + bj * HALF) = w; } }
        } else {
            f32x4 gg[2][2];
#pragma unroll
            for (int bj = 0; bj < 2; ++bj) { gg[bj][0] = *(const f32x4*)(gfin + col0 + bj * HALF); gg[bj][1] = *(const f32x4*)(gfin + col0 + bj * HALF + 4); }
#pragma unroll
            for (int ai = 0; ai < 2; ++ai)
#pragma unroll
                for (int m = 0; m < 4; ++m) { const float rstd = St[ai * HALF + rl0 + m * 16]; float* op = OUT + (size_t)(row0 + ai * HALF + m * 16) * DM + col0;
#pragma unroll
                    for (int bj = 0; bj < 2; ++bj) { *(f32x4*)(op + bj * HALF) = acc[ai][bj][m][0] * rstd * gg[bj][0]; *(f32x4*)(op + bj * HALF + 4) = acc[ai][bj][m][1] * rstd * gg[bj][1]; } }
        }
    }
};

__device__ __forceinline__ float dpp_shr1(float old, float src) { return __builtin_bit_cast(float, __builtin_amdgcn_update_dpp(__builtin_bit_cast(int, old), __builtin_bit_cast(int, src), 0x111, 0xf, 0xf, false)); }
__device__ __forceinline__ float dpp_shr2(float old, float src) { return __builtin_bit_cast(float, __builtin_amdgcn_update_dpp(__builtin_bit_cast(int, old), __builtin_bit_cast(int, src), 0x112, 0xf, 0xf, false)); }
__device__ __forceinline__ float dpp_ror1(float src) { return __builtin_bit_cast(float, __builtin_amdgcn_mov_dpp(__builtin_bit_cast(int, src), 0x121, 0xf, 0xf, false)); }
__device__ __forceinline__ float dpp_ror2(float src) { return __builtin_bit_cast(float, __builtin_amdgcn_mov_dpp(__builtin_bit_cast(int, src), 0x122, 0xf, 0xf, false)); }
constexpr int FF = 5632, FF2 = 11264;
struct EpiAct {
    static constexpr bool PERM = true, AFTER_DRAIN = false;
    bf16_t* ACT; const float* cw; const float* cb; float* ubnd;
    __device__ __forceinline__ void operator()(f32x4 (&acc)[2][2][4][2], const Unit& u, int wr, int wc, int fr_, int fq_, PG8_LAS unsigned char* xlds) const {
        int t_ = threadIdx.x; asm volatile("" : "+v"(t_));
        const int fr = t_ & 15, fq = (t_ >> 4) & 3;
        const int row0 = u.pm * BM + wr * 64 + fr, cl = wc * 32 + 8 * fq;
        if (fr >= 14) {
#pragma unroll
            for (int ai = 0; ai < 2; ++ai)
#pragma unroll
                for (int bj = 0; bj < 2; ++bj)
#pragma unroll
                    for (int n = 0; n < 2; ++n) *(PG8_LAS f32x4*)(xlds + ((((2 * ai + wr) * 2 + (fr - 14)) * 256 + 128 * bj + cl + 4 * n) << 2)) = acc[ai][bj][3][n];
            if (wr == 1) {
#pragma unroll
                for (int bj = 0; bj < 2; ++bj)
#pragma unroll
                    for (int n = 0; n < 2; ++n) *(f32x4*)(ubnd + (size_t)(u.pm * 4 + 2 + (fr - 14)) * FF2 + u.pn * BM + 128 * bj + cl + 4 * n) = acc[1][bj][3][n]; }
        }
        if (wr == 0 && fr < 2) {
#pragma unroll
            for (int bj = 0; bj < 2; ++bj)
#pragma unroll
                for (int n = 0; n < 2; ++n) *(f32x4*)(ubnd + (size_t)(u.pm * 4 + fr) * FF2 + u.pn * BM + 128 * bj + cl + 4 * n) = acc[0][bj][0][n]; }
        asm volatile("s_waitcnt lgkmcnt(0)" ::: "memory"); __builtin_amdgcn_s_barrier(); asm volatile("" ::: "memory");
        const int c0 = u.pn * 128 + cl;
        u32x2 hold[2][4];
#pragma unroll
        for (int n = 0; n < 2; ++n) {
            const f32x4 gw0 = *(const f32x4*)(cw + c0 + 4 * n), gw1 = *(const f32x4*)(cw + FF2 + c0 + 4 * n), gw2 = *(const f32x4*)(cw + 2 * FF2 + c0 + 4 * n), gb = *(const f32x4*)(cb + c0 + 4 * n);
            const f32x4 vw0 = *(const f32x4*)(cw + FF + c0 + 4 * n), vw1 = *(const f32x4*)(cw + FF2 + FF + c0 + 4 * n), vw2 = *(const f32x4*)(cw + 2 * FF2 + FF + c0 + 4 * n), vb = *(const f32x4*)(cb + FF + c0 + 4 * n);
#pragma unroll
            for (int ai = 0; ai < 2; ++ai) {
                const int chunk = 2 * ai + wr;
                f32x4 pg = {0.f, 0.f, 0.f, 0.f}, pv = {0.f, 0.f, 0.f, 0.f};
                if (chunk > 0) { const PG8_LAS unsigned char* bp = xlds + ((((chunk - 1) * 2 + (fr & 1)) * 256 + cl + 4 * n) << 2);
                    pg = *(const PG8_LAS f32x4*)bp; pv = *(const PG8_LAS f32x4*)(bp + 512); }
#pragma unroll
                for (int m = 0; m < 4; ++m) {
                    const f32x4 cg = acc[ai][0][m][n], cv = acc[ai][1][m][n]; float a[4];
#pragma unroll
                    for (int j = 0; j < 4; ++j) {
                        const float g1 = dpp_shr1(dpp_ror1(pg[j]), cg[j]), g2 = dpp_shr2(dpp_ror2(pg[j]), cg[j]);
                        const float v1 = dpp_shr1(dpp_ror1(pv[j]), cv[j]), v2 = dpp_shr2(dpp_ror2(pv[j]), cv[j]);
                        const float G = gw2[j] * cg[j] + (gw1[j] * g1 + (gw0[j] * g2 + gb[j]));
                        const float V = vw2[j] * cv[j] + (vw1[j] * v1 + (vw0[j] * v2 + vb[j]));
                        a[j] = G * __builtin_amdgcn_rcpf(1.0f + __builtin_amdgcn_exp2f(-1.4426950408889634f * G)) * V; }
                    u32x2 w; w.x = cvt_pk_bf16(a[0], a[1]); w.y = cvt_pk_bf16(a[2], a[3]);
                    if (n == 0) hold[ai][m] = w;
                    else { u32x4 o; o.x = hold[ai][m].x; o.y = hold[ai][m].y; o.z = w.x; o.w = w.y;
                        *(u32x4*)(ACT + (size_t)(row0 + ai * HALF + m * 16) * FF + c0) = o; }
                    pg = cg; pv = cv;
                }
            }
        }
    }
};

template <class Epi, class Sched, bool ALIGN_EPI = false, bool SP2 = false>
__device__ __forceinline__ void gemm_phase(PG8_LAS unsigned char* lds, const Gemm g, const Sched& S, const Epi& E, PG8_LAS unsigned char* xlds) {
    const int tid = threadIdx.x, wid = __builtin_amdgcn_readfirstlane(tid >> 6), lane = tid & 63, wr = wid >> 2, wc = wid & 3, fr = lane & 15, fq = lane >> 4;
    const int K = g.K, nt = K / BK;
    unsigned voffA[2], voffB[2];
#pragma unroll
    for (int i = 0; i < 2; ++i) { int R, C; stage_rc(tid * 16 + i * 8192, R, C); const int Rb = Epi::PERM ? ((R & ~31) + perm32(R & 31)) : R;
        voffA[i] = (unsigned)(R * K + C) * 2u; voffB[i] = (unsigned)(Rb * K + C) * 2u; }
    const size_t kstep = (size_t)(BK * 2);
    const size_t hstep = (size_t)HALF * K * 2;
    const size_t tstep = 2 * hstep;
    const unsigned ldsw = (unsigned)wid * 1024u;
    const int aoff = lds_byte(wr * 64 + fr, fq * 8), boff = lds_byte(wc * 32 + fr, fq * 8);
#define PG8_SA(b, h) (((b) * 2 + (h)) * HTB)
#define PG8_SB(b, h) ((4 + (b) * 2 + (h)) * HTB)
#define PG8_STAGE(bufoff, gbase, voff) do { _Pragma("unroll") for (int _i = 0; _i < 2; ++_i) \
        __builtin_amdgcn_global_load_lds((const unsigned*)((const char*)(gbase) + (voff)[_i]), (PG8_LAS unsigned*)(lds + (bufoff) + ldsw + _i * 8192), 16, 0, 0); } while (0)
#define PG8_LDA(dst, b, h) do { _Pragma("unroll") for (int m = 0; m < 4; ++m) _Pragma("unroll") for (int k = 0; k < 2; ++k) dst[m][k] = *(const PG8_LAS bf16x8*)(lds + PG8_SA(b, h) + aoff + m * 2048 + k * 1024); } while (0)
#define PG8_LDB(dst, b, h) do { _Pragma("unroll") for (int n = 0; n < 2; ++n) _Pragma("unroll") for (int k = 0; k < 2; ++k) dst[n][k] = *(const PG8_LAS bf16x8*)(lds + PG8_SB(b, h) + boff + n * 2048 + k * 1024); } while (0)
#define PG8_MMA(ai, bj, At, Bt) do { __builtin_amdgcn_s_setprio(1); _Pragma("unroll") for (int m = 0; m < 4; ++m) _Pragma("unroll") for (int n = 0; n < 2; ++n) _Pragma("unroll") for (int k = 0; k < 2; ++k) \
        acc[ai][bj][m][n] = __builtin_amdgcn_mfma_f32_16x16x32_bf16(Bt[n][k], At[m][k], acc[ai][bj][m][n], 0, 0, 0); __builtin_amdgcn_s_setprio(0); } while (0)
#define PG8_WAIT_V(n) asm volatile("s_waitcnt vmcnt(" #n ")" ::: "memory")
#define PG8_WAIT_L(n) asm volatile("s_waitcnt lgkmcnt(" #n ")" ::: "memory")
#define PG8_BAR __builtin_amdgcn_s_barrier()
#define PG8_SCHED __builtin_amdgcn_sched_barrier(0)
    Unit cur, nxt; int ui = 0;
    if (!S.next(0, cur)) return;
    f32x4 acc[2][2][4][2];
#pragma unroll
    for (int a = 0; a < 2; ++a)
#pragma unroll
        for (int b = 0; b < 2; ++b)
#pragma unroll
            for (int m = 0; m < 4; ++m)
#pragma unroll
                for (int n = 0; n < 2; ++n) acc[a][b][m][n] = (f32x4){0.f, 0.f, 0.f, 0.f};
    bf16x8 At[4][2], B0[2][2], B1[2][2];
    const char* cA = (const char*)g.A + (size_t)cur.pm * tstep; const char* cB = (const char*)g.Bt + (size_t)cur.pn * tstep;
    S.a_ready(cur);
    if constexpr (SP2) {
        PG8_STAGE(PG8_SB(0, 0), cB, voffB); PG8_STAGE(PG8_SB(0, 1), cB + hstep, voffB); PG8_STAGE(PG8_SA(0, 0), cA, voffA); PG8_STAGE(PG8_SA(0, 1), cA + hstep, voffA);
        if (wr == 1) PG8_BAR;
        PG8_WAIT_V(2); PG8_BAR;
        PG8_STAGE(PG8_SB(1, 0), cB + kstep, voffB); PG8_STAGE(PG8_SA(1, 0), cA + kstep, voffA); PG8_STAGE(PG8_SB(1, 1), cB + hstep + kstep, voffB);
        PG8_WAIT_V(6); PG8_BAR;
    } else {
        PG8_STAGE(PG8_SB(0, 0), cB, voffB); PG8_STAGE(PG8_SA(0, 0), cA, voffA); PG8_STAGE(PG8_SB(0, 1), cB + hstep, voffB); PG8_STAGE(PG8_SA(0, 1), cA + hstep, voffA);
        if (wr == 1) PG8_BAR;
        PG8_WAIT_V(4); PG8_BAR;
        PG8_STAGE(PG8_SB(1, 0), cB + kstep, voffB); PG8_STAGE(PG8_SA(1, 0), cA + kstep, voffA); PG8_STAGE(PG8_SB(1, 1), cB + hstep + kstep, voffB);
        PG8_WAIT_V(6); PG8_BAR;
    }
    for (;;) {
        const bool has_next = S.next(ui + 1, nxt);
        const char* nA = has_next ? (const char*)g.A + (size_t)nxt.pm * tstep : cA; const char* nB = has_next ? (const char*)g.Bt + (size_t)nxt.pn * tstep : cB;
        for (int t = 0; t < nt; t += 2) {
            const bool last = (t == nt - 2);
            const char* a1 = cA + (size_t)(t + 1) * kstep;
            const char* a2 = last ? nA : cA + (size_t)(t + 2) * kstep; const char* b2 = last ? nB : cB + (size_t)(t + 2) * kstep;
            const char* a3 = a2 + kstep; const char* b3 = b2 + kstep;
            if (last && has_next) S.a_ready(nxt);
            if constexpr (SP2) {
            PG8_LDB(B0, 0, 0); PG8_LDB(B1, 0, 1); PG8_SCHED; PG8_LDA(At, 0, 0); PG8_STAGE(PG8_SA(1, 1), a1 + hstep, voffA);
            PG8_WAIT_V(8); PG8_WAIT_L(0); PG8_BAR; PG8_MMA(0, 0, At, B0); PG8_MMA(0, 1, At, B1); PG8_BAR; PG8_SCHED;
            PG8_LDA(At, 0, 1); PG8_STAGE(PG8_SB(0, 0), b2, voffB); PG8_STAGE(PG8_SB(0, 1), b2 + hstep, voffB); PG8_STAGE(PG8_SA(0, 0), a2, voffA);
            PG8_WAIT_V(8); PG8_WAIT_L(0); PG8_BAR; PG8_MMA(1, 0, At, B0); PG8_MMA(1, 1, At, B1); PG8_BAR; PG8_SCHED;
            PG8_LDB(B0, 1, 0); PG8_LDB(B1, 1, 1); PG8_SCHED; PG8_LDA(At, 1, 0); PG8_STAGE(PG8_SA(0, 1), a2 + hstep, voffA);
            PG8_WAIT_V(8); PG8_WAIT_L(0); PG8_BAR; PG8_MMA(0, 0, At, B0); PG8_MMA(0, 1, At, B1); PG8_BAR; PG8_SCHED;
            PG8_LDA(At, 1, 1); PG8_STAGE(PG8_SB(1, 0), b3, voffB); PG8_STAGE(PG8_SB(1, 1), b3 + hstep, voffB); PG8_STAGE(PG8_SA(1, 0), a3, voffA);
            PG8_WAIT_V(8); PG8_WAIT_L(0); PG8_BAR; PG8_MMA(1, 0, At, B0); PG8_MMA(1, 1, At, B1); PG8_BAR; PG8_SCHED;
            } else {
            PG8_LDB(B0, 0, 0); PG8_SCHED; PG8_LDA(At, 0, 0); PG8_STAGE(PG8_SA(1, 1), a1 + hstep, voffA);
            PG8_WAIT_L(8); PG8_BAR; PG8_WAIT_L(0); PG8_MMA(0, 0, At, B0); PG8_BAR; PG8_SCHED;
            PG8_LDB(B1, 0, 1); PG8_STAGE(PG8_SB(0, 0), b2, voffB);
            PG8_BAR; PG8_WAIT_L(0); PG8_MMA(0, 1, At, B1); PG8_BAR;
            PG8_LDA(At, 0, 1); PG8_STAGE(PG8_SA(0, 0), a2, voffA);
            PG8_BAR; PG8_WAIT_L(0); PG8_MMA(1, 0, At, B0); PG8_BAR; PG8_SCHED;
            PG8_STAGE(PG8_SB(0, 1), b2 + hstep, voffB);
            PG8_WAIT_V(6); PG8_BAR; PG8_MMA(1, 1, At, B1); PG8_BAR;
            PG8_LDB(B0, 1, 0); PG8_SCHED; PG8_LDA(At, 1, 0); PG8_STAGE(PG8_SA(0, 1), a2 + hstep, voffA);
            PG8_WAIT_L(8); PG8_BAR; PG8_WAIT_L(0); PG8_MMA(0, 0, At, B0); PG8_BAR; PG8_SCHED;
            PG8_LDB(B1, 1, 1); PG8_STAGE(PG8_SB(1, 0), b3, voffB);
            PG8_BAR; PG8_WAIT_L(0); PG8_MMA(0, 1, At, B1); PG8_BAR;
            PG8_LDA(At, 1, 1); PG8_STAGE(PG8_SA(1, 0), a3, voffA);
            PG8_BAR; PG8_WAIT_L(0); PG8_MMA(1, 0, At, B0); PG8_BAR; PG8_SCHED;
            PG8_STAGE(PG8_SB(1, 1), b3 + hstep, voffB);
            PG8_WAIT_V(6); PG8_BAR; PG8_MMA(1, 1, At, B1); PG8_BAR;
            }
        }
        if constexpr (ALIGN_EPI) { if (wr == 0) PG8_BAR; }
        if constexpr (!Epi::AFTER_DRAIN) { E(acc, cur, wr, wc, fr, fq, xlds); S.done(cur); }
        if (!has_next) break;
#pragma unroll
        for (int a = 0; a < 2; ++a)
#pragma unroll
            for (int b = 0; b < 2; ++b)
#pragma unroll
                for (int m = 0; m < 4; ++m)
#pragma unroll
                    for (int n = 0; n < 2; ++n) acc[a][b][m][n] = (f32x4){0.f, 0.f, 0.f, 0.f};
        cur = nxt; cA = nA; cB = nB; ++ui;
        if constexpr (ALIGN_EPI) { if (wr == 1) PG8_BAR; }
    }
    PG8_WAIT_V(0);
    if constexpr (!ALIGN_EPI) { if (wr == 0) PG8_BAR; }
    PG8_BAR;

#undef PG8_SA
#undef PG8_SB
#undef PG8_STAGE
#undef PG8_LDA
#undef PG8_LDB
#undef PG8_MMA
#undef PG8_WAIT_V
#undef PG8_WAIT_L
#undef PG8_BAR
#undef PG8_SCHED
}
}

#define GAS __attribute__((address_space(1)))
#define LAS __attribute__((address_space(3)))
typedef unsigned short bf16;
typedef float f32x4 __attribute__((ext_vector_type(4)));
typedef short bf16x8 __attribute__((ext_vector_type(8)));
typedef unsigned u32x4 __attribute__((ext_vector_type(4)));
typedef unsigned u32x2 __attribute__((ext_vector_type(2)));

constexpr int NWAVES = 8;
constexpr int SEQ = 16384, DMODEL = 2048, NMEM = 256, DIN = 3584, DCONV = 768, DPOOL = 768, DXATT = 512, DFF = 5632, DFF2 = 11264;
constexpr int PGD = 192;
constexpr float EPS = 1e-6f;
constexpr int LDS_BYTES = 147456;
#ifndef MK_PER_PHASE
#define MK_PER_PHASE 0
#endif
constexpr int NPHASE = 7;
#ifndef PHM
#define PHM 255
#endif
#ifndef USE_CG_SYNC
#define USE_CG_SYNC 0
#endif
#ifndef PROBE_P2
#define PROBE_P2 0
#endif
#ifndef PROBE_SYNC
#define PROBE_SYNC 0
#endif
#ifndef PROBE_GEMM
#define PROBE_GEMM 0
#endif
#ifndef PROBE_N
#define PROBE_N 2048
#endif
#ifndef REPM
#define REPM 0
#endif

constexpr size_t MiB = 1u << 20;
constexpr size_t WS_KB = 1 * MiB;
constexpr size_t WS_VT = 1 * MiB + 256 * 1024;
constexpr size_t WS_POOLWT = 1 * MiB + 512 * 1024;
constexpr size_t WS_MB = 2 * MiB;
constexpr size_t WS_WKVT = 3 * MiB;
constexpr size_t WS_SIG = 7 * MiB;
constexpr size_t WS_SLAB1 = 8 * MiB;
constexpr size_t WS_SLAB2 = 10 * MiB;
constexpr size_t WS_WUPT = 12 * MiB;
constexpr size_t WS_WDOWNT = 56 * MiB;
constexpr size_t WS_UBND = 80 * MiB;
constexpr size_t WS_X1B = 96 * MiB;
constexpr size_t WS_ACT = 160 * MiB;
constexpr size_t WS_H = 160 * MiB;
constexpr size_t WS_Z = 225 * MiB;
constexpr size_t WS_ZPAD = WS_Z - (size_t)16 * 3584 * 2;
constexpr size_t WS_MIX = 338 * MiB;
constexpr size_t WS_WINT = 402 * MiB;
constexpr size_t WS_WOUTT = 416 * MiB;
constexpr size_t WS_END = 424 * MiB;

__device__ __forceinline__ unsigned f2bf(float f) { unsigned u = __builtin_bit_cast(unsigned, f); return (u + 0x7fffu + ((u >> 16) & 1u)) >> 16; }
__device__ __forceinline__ unsigned pk2(float lo, float hi) { return f2bf(lo) | (f2bf(hi) << 16); }
__device__ __forceinline__ float bflo(unsigned w) { return __builtin_bit_cast(float, w << 16); }
__device__ __forceinline__ float bfhi(unsigned w) { return __builtin_bit_cast(float, w & 0xffff0000u); }
__device__ __forceinline__ void unpack8(const u32x4 w, float (&f)[8]) { f[0] = bflo(w.x); f[1] = bfhi(w.x); f[2] = bflo(w.y); f[3] = bfhi(w.y); f[4] = bflo(w.z); f[5] = bfhi(w.z); f[6] = bflo(w.w); f[7] = bfhi(w.w); }
__device__ __forceinline__ u32x4 pack8(const float (&f)[8]) { u32x4 w; w.x = pk2(f[0], f[1]); w.y = pk2(f[2], f[3]); w.z = pk2(f[4], f[5]); w.w = pk2(f[6], f[7]); return w; }
__device__ __forceinline__ float wave_sum(float v) {
#pragma unroll
    for (int o = 1; o < 64; o <<= 1) v += __shfl_xor(v, o);
    return v;
}
#define LDS_WAIT() asm volatile("s_waitcnt lgkmcnt(0)" ::: "memory")

typedef GAS unsigned gu32;
constexpr size_t WS_CTL = 0, CTL_ZERO_BYTES = 64 * 1024;
constexpr int CW_PANEL1 = 8192;
constexpr int CW_PANEL = 4096;
constexpr int MISC_OFF = 131072 + 320;
constexpr int XLDS_OFF = 131072 + 1024;
#define XB_TMO      128
#define XB_XCNT(j)  (256  + 64 * (j))
#define XB_XSUB(j)  (1280 + 64 * (j))
#define XB_XGEN(j)  (2304 + 64 * (j))
#define XB_TOP      3328
#define XB_TOPGEN   3392
#define XCD_BAR_WORDS 3456
#define XB_SPIN_CAP (1u << 18)

__device__ __forceinline__ unsigned xb_ld(unsigned* p)              { return __hip_atomic_load(p, __ATOMIC_RELAXED, __HIP_MEMORY_SCOPE_AGENT); }
__device__ __forceinline__ unsigned xb_add(unsigned* p, unsigned v) { return __hip_atomic_fetch_add(p, v, __ATOMIC_RELAXED, __HIP_MEMORY_SCOPE_AGENT); }
__device__ __forceinline__ unsigned xb_xcc_id() { return (unsigned)__builtin_amdgcn_s_getreg((3 << 11) | 20) & 0xFu; }
#define XB_SPIN(cond, bar) do { unsigned _sp = 0; while (cond) { __builtin_amdgcn_s_sleep(1); \
    if ((++_sp & 255u) == 0u) { if (xb_ld(&(bar)[XB_TMO])) break; if (_sp > XB_SPIN_CAP) { atomicAdd(&(bar)[XB_TMO], 1u); break; } } } } while (0)

struct XcdBarrier {
    unsigned* bar; unsigned x;
    volatile LAS unsigned* st;
};

__device__ __forceinline__ XcdBarrier xcd_barrier_post(unsigned* bar, volatile LAS unsigned* st) {
    XcdBarrier b; b.bar = bar; b.x = xb_xcc_id(); b.st = st;
    if (threadIdx.x == 0) (void)xb_add(&bar[XB_XCNT(b.x)], 1u);
    return b;
}
__device__ __forceinline__ void xcd_barrier_complete(unsigned* bar, unsigned x, unsigned& nloc, unsigned& nx) {
    const unsigned G = gridDim.x * gridDim.y * gridDim.z;
    unsigned sum, cnt, mine, sp = 0u;
    for (;;) {
        sum = 0u; cnt = 0u; mine = 0u;
#pragma unroll
        for (unsigned j = 0; j < 16; ++j) { const unsigned c = xb_ld(&bar[XB_XCNT(j)]); sum += c; cnt += (c > 0u) ? 1u : 0u; mine = (j == x) ? c : mine; }
        if (sum == G) break;
        __builtin_amdgcn_s_sleep(1);
        if ((++sp & 255u) == 0u) { if (xb_ld(&bar[XB_TMO])) break; if (sp > XB_SPIN_CAP) { atomicAdd(&bar[XB_TMO], 1u); break; } }
    }
    nloc = mine > 0u ? mine : 1u; nx = cnt > 0u ? cnt : 1u;
}

__device__ __forceinline__ void xcd_barrier(const XcdBarrier& b) {
    asm volatile("s_waitcnt vmcnt(0)" ::: "memory");
    __syncthreads();
    if (threadIdx.x == 0) {
        unsigned* bar = b.bar;
        __builtin_amdgcn_s_waitcnt(0);
        unsigned nloc = b.st[0], nx = b.st[1];
        if (nloc == 0u) { xcd_barrier_complete(bar, b.x, nloc, nx); b.st[0] = nloc; b.st[1] = nx; }
        const unsigned old = xb_add(&bar[XB_XSUB(b.x)], 1u);
        const unsigned gen = old / nloc;
        if (old + 1u == (gen + 1u) * nloc) {
            __builtin_amdgcn_fence(__ATOMIC_RELEASE, "agent");
            asm volatile("s_waitcnt vmcnt(0)" ::: "memory");
            const unsigned og = xb_add(&bar[XB_TOP], 1u);
            const unsigned tg = og / nx;
            if (og + 1u == (tg + 1u) * nx) xb_add(&bar[XB_TOPGEN], 1u);
            else XB_SPIN(xb_ld(&bar[XB_TOPGEN]) == tg, bar);
            __builtin_amdgcn_fence(__ATOMIC_ACQUIRE, "agent");
            xb_add(&bar[XB_XGEN(b.x)], 1u);
            asm volatile("s_waitcnt vmcnt(0)" ::: "memory");
        } else {
            XB_SPIN(xb_ld(&bar[XB_XGEN(b.x)]) == gen, bar);
            __builtin_amdgcn_fence(__ATOMIC_ACQUIRE, "agent");
            asm volatile("s_waitcnt vmcnt(0)" ::: "memory");
        }
    }
    __syncthreads();
}


template <bool UPMAP> __device__ __forceinline__ void p0_transpose_item(const float* W, int K, int N, bf16* WT, const float* ks, LAS float* scr, int item, int lane) {
    const int nblk = N / 64, kb = item / nblk, nb = item % nblk, k0 = 64 * kb, n0 = 64 * nb;
    const int r0 = !UPMAP ? n0 : (n0 < DFF ? 256 * (n0 / 128) + (n0 % 128) : 256 * ((n0 - DFF) / 128) + 128 + ((n0 - DFF) % 128));
    f32x4 v[16];
    const float* src = W + (size_t)(k0 + (lane >> 4)) * N + n0 + 4 * (lane & 15);
#pragma unroll
    for (int i = 0; i < 16; ++i) v[i] = *(const f32x4*)(src + (size_t)(4 * i) * N);
#pragma unroll
    for (int i = 0; i < 16; ++i) { f32x4 t = v[i]; if (ks) t = t * ks[k0 + 4 * i + (lane >> 4)];
        *(LAS f32x4*)(scr + (4 * i + (lane >> 4)) * 64 + (((lane & 15) ^ ((i >> 1) & 7)) << 2)) = t; }
    LDS_WAIT(); asm volatile("" ::: "memory");
    const int c = lane & 7;
#pragma unroll
    for (int j = 0; j < 8; ++j) { const int nn = (lane >> 3) + 8 * j; const LAS float* sp = scr + (8 * c) * 64 + ((((nn >> 2) ^ c) & 15) << 2) + (nn & 3);
        u32x4 o; o.x = pk2(sp[0 * 64], sp[1 * 64]); o.y = pk2(sp[2 * 64], sp[3 * 64]); o.z = pk2(sp[4 * 64], sp[5 * 64]); o.w = pk2(sp[6 * 64], sp[7 * 64]);
        *(u32x4*)(WT + (size_t)(r0 + nn) * K + k0 + 8 * c) = o; }
    LDS_WAIT(); asm volatile("" ::: "memory");
}
__device__ __forceinline__ void rms_rows2_to_bf16(const float* xa, const float* xb, const float* g, bf16* oa, bf16* ob, int lane) {
    const f32x4* pa = (const f32x4*)xa + lane; const f32x4* pb = (const f32x4*)xb + lane; const f32x4* gr = (const f32x4*)g + lane;
    f32x4 va[8], vb[8]; float sa = 0.f, sb = 0.f;
#pragma unroll
    for (int j = 0; j < 8; ++j) { va[j] = pa[64 * j]; vb[j] = pb[64 * j]; }
#pragma unroll
    for (int j = 0; j < 8; ++j) { sa += (va[j].x * va[j].x + va[j].y * va[j].y) + (va[j].z * va[j].z + va[j].w * va[j].w); sb += (vb[j].x * vb[j].x + vb[j].y * vb[j].y) + (vb[j].z * vb[j].z + vb[j].w * vb[j].w); }
    const float ra = 1.0f / sqrtf(wave_sum(sa) * (1.0f / DMODEL) + EPS), rb = 1.0f / sqrtf(wave_sum(sb) * (1.0f / DMODEL) + EPS);
    u32x2* qa = (u32x2*)oa + lane; u32x2* qb = (u32x2*)ob + lane;
#pragma unroll
    for (int j = 0; j < 8; ++j) { const f32x4 gg = gr[64 * j]; u32x2 w;
        w.x = pk2(va[j].x * ra * gg.x, va[j].y * ra * gg.y); w.y = pk2(va[j].z * ra * gg.z, va[j].w * ra * gg.w); qa[64 * j] = w;
        w.x = pk2(vb[j].x * rb * gg.x, vb[j].y * rb * gg.y); w.y = pk2(vb[j].z * rb * gg.z, vb[j].w * rb * gg.w); qb[64 * j] = w; }
}

struct Ptrs {
    const float *x, *mem, *g_mix, *g_mem, *w_in, *conv_w, *pool_w, *pool_scale, *w_kv, *w_out, *g_ffn, *w_up, *ffn_conv_w, *ffn_conv_b, *w_down, *g_final;
    float* out; unsigned char* ws;
};

constexpr int UP_ITEMS = (DMODEL / 64) * (DFF2 / 64), DN_ITEMS = (DFF / 64) * (DMODEL / 64);
#ifndef UP_IN_P0
#define UP_IN_P0 2560
#endif
__device__ __forceinline__ void p1_idle_work(const Ptrs& P, LAS unsigned char* lds, int iw, int NIW, int wave, int lane);
__device__ __forceinline__ void p0_prologue(const Ptrs& P, LAS unsigned char* lds, int gw, int NGW, int wave, int lane) {
    LAS float* scr = (LAS float*)(lds + wave * 16384);
    unsigned char* ws = P.ws;
    constexpr int I_IN = (DMODEL / 64) * (DIN / 64), I_OUT = (DMODEL / 64) * (DMODEL / 64), I_UP = (DMODEL / 64) * (DFF2 / 64), I_DN = (DFF / 64) * (DMODEL / 64),
                  I_KV = (DMODEL / 64) * (1024 / 64), I_PW = (PGD / 64) * (PGD / 64);
    constexpr int NITEMS = I_IN + I_OUT + UP_IN_P0 + I_KV + 4 * I_PW;
    for (int it = gw; it < NITEMS; it += NGW) {
        int r = it;
        if (r < I_IN) { p0_transpose_item<false>(P.w_in, DMODEL, DIN, (bf16*)(ws + WS_WINT), nullptr, scr, r, lane); continue; } r -= I_IN;
        if (r < I_OUT) { p0_transpose_item<false>(P.w_out, DMODEL, DMODEL, (bf16*)(ws + WS_WOUTT), nullptr, scr, r, lane); continue; } r -= I_OUT;
        if (r < UP_IN_P0) { p0_transpose_item<true>(P.w_up, DMODEL, DFF2, (bf16*)(ws + WS_WUPT), P.g_ffn, scr, r, lane); continue; } r -= UP_IN_P0;
        if (r < I_KV) { p0_transpose_item<false>(P.w_kv, DMODEL, 1024, (bf16*)(ws + WS_WKVT), nullptr, scr, r, lane); continue; } r -= I_KV;
        const int g = r / I_PW; r -= g * I_PW;
        p0_transpose_item<false>(P.pool_w + (size_t)g * PGD * PGD, PGD, PGD, (bf16*)(ws + WS_POOLWT) + (size_t)g * PGD * PGD, nullptr, scr, r, lane);
    }
    for (int i = gw * 64 + lane; i < 16 * DIN * 2 / 16; i += NGW * 64) ((u32x4*)(ws + WS_ZPAD))[i] = (u32x4){0u, 0u, 0u, 0u};
    for (int m = 2 * gw; m < SEQ; m += 2 * NGW) rms_rows2_to_bf16(P.x + (size_t)m * DMODEL, P.x + (size_t)(m + 1) * DMODEL, P.g_mix, (bf16*)(ws + WS_H) + (size_t)m * DMODEL, (bf16*)(ws + WS_H) + (size_t)(m + 1) * DMODEL, lane);
    for (int m = 2 * gw; m < NMEM; m += 2 * NGW) rms_rows2_to_bf16(P.mem + (size_t)m * DMODEL, P.mem + (size_t)(m + 1) * DMODEL, P.g_mem, (bf16*)(ws + WS_MB) + (size_t)m * DMODEL, (bf16*)(ws + WS_MB) + (size_t)(m + 1) * DMODEL, lane);
}

__device__ __forceinline__ void kv_tile(const Ptrs& P, int tt, int lane) {
    const bf16* mB = (const bf16*)(P.ws + WS_MB); const bf16* wT = (const bf16*)(P.ws + WS_WKVT);
    const int rb = tt >> 6, cb = tt & 63, fr = lane & 15, fq = lane >> 4;
    const bf16* ap = mB + (size_t)(16 * rb + fr) * DMODEL + 8 * fq; const bf16* wp = wT + (size_t)(16 * cb + fr) * DMODEL + 8 * fq;
    f32x4 acc = {0.f, 0.f, 0.f, 0.f};
    if (cb < 32) {
#pragma unroll 8
        for (int ks = 0; ks < 64; ++ks) { const bf16x8 a = *(const bf16x8*)(ap + 32 * ks), w = *(const bf16x8*)(wp + 32 * ks); acc = __builtin_amdgcn_mfma_f32_16x16x32_bf16(w, a, acc, 0, 0, 0); }
        u32x2 o; o.x = pk2(acc[0], acc[1]); o.y = pk2(acc[2], acc[3]);
        *(u32x2*)((bf16*)(P.ws + WS_KB) + (size_t)(16 * rb + fr) * 512 + 16 * cb + 4 * fq) = o;
    } else {
#pragma unroll 8
        for (int ks = 0; ks < 64; ++ks) { const bf16x8 a = *(const bf16x8*)(ap + 32 * ks), w = *(const bf16x8*)(wp + 32 * ks); acc = __builtin_amdgcn_mfma_f32_16x16x32_bf16(a, w, acc, 0, 0, 0); }
        u32x2 o; o.x = pk2(acc[0], acc[1]); o.y = pk2(acc[2], acc[3]);
        *(u32x2*)((bf16*)(P.ws + WS_VT) + (size_t)(16 * cb - 512 + fr) * 256 + 32 * (rb >> 1) + 8 * fq + 4 * (rb & 1)) = o;
    }
}

__device__ __forceinline__ void p1_idle_work(const Ptrs& P, LAS unsigned char* lds, int iw, int NIW, int wave, int lane) {
    LAS float* scr = (LAS float*)(lds + wave * 16384);
    for (int tt = iw; tt < 1024; tt += NIW) kv_tile(P, tt, lane);
    constexpr int NEXTRA = DN_ITEMS + (UP_ITEMS - UP_IN_P0);
    for (int it = iw; it < NEXTRA; it += NIW) {
        if (it < DN_ITEMS) p0_transpose_item<false>(P.w_down, DFF, DMODEL, (bf16*)(P.ws + WS_WDOWNT), nullptr, scr, it, lane);
        else p0_transpose_item<true>(P.w_up, DMODEL, DFF2, (bf16*)(P.ws + WS_WUPT), P.g_ffn, scr, UP_IN_P0 + it - DN_ITEMS, lane);
    }
}

__device__ __forceinline__ void mix_conv_task(const Ptrs& P, int blk, int lane) {
    const bf16* z = (const bf16*)(P.ws + WS_Z); bf16* mix = (bf16*)(P.ws + WS_MIX);
    const int t0 = blk * 16;
    for (int cg = lane; cg < DCONV / 8; cg += 64) {
        const int c = cg * 8;
        float w0[8], w1[8], w2[8], p1[8], p2[8];
#pragma unroll
        for (int e = 0; e < 8; ++e) { w0[e] = P.conv_w[c + e]; w1[e] = P.conv_w[DCONV + c + e]; w2[e] = P.conv_w[2 * DCONV + c + e]; }
        { float a[8], b[8]; unpack8(*(const u32x4*)(z + (long)(t0 - 2) * DIN + DCONV + c), a); unpack8(*(const u32x4*)(z + (long)(t0 - 2) * DIN + 2 * DCONV + c), b);
#pragma unroll
          for (int e = 0; e < 8; ++e) p2[e] = a[e] * b[e];
          unpack8(*(const u32x4*)(z + (long)(t0 - 1) * DIN + DCONV + c), a); unpack8(*(const u32x4*)(z + (long)(t0 - 1) * DIN + 2 * DCONV + c), b);
#pragma unroll
          for (int e = 0; e < 8; ++e) p1[e] = a[e] * b[e]; }
#pragma unroll 4
        for (int r = 0; r < 16; ++r) {
            const int t = t0 + r; float p[8], a[8], b[8], g[8], o[8];
            unpack8(*(const u32x4*)(z + (size_t)t * DIN + DCONV + c), a); unpack8(*(const u32x4*)(z + (size_t)t * DIN + 2 * DCONV + c), b); unpack8(*(const u32x4*)(z + (size_t)t * DIN + c), g);
#pragma unroll
            for (int e = 0; e < 8; ++e) { p[e] = a[e] * b[e]; o[e] = g[e] * (w2[e] * p[e] + w1[e] * p1[e] + w0[e] * p2[e]); p2[e] = p1[e]; p1[e] = p[e]; }
            *(u32x4*)(mix + (size_t)t * DMODEL + c) = pack8(o);
        }
    }
}
template <int g> __device__ __forceinline__ void mix_pool_task(const Ptrs& P, int blk, int lane) {
    constexpr int k = 2 << g;
    const char* zu = (const char*)((const bf16*)(P.ws + WS_Z) + (size_t)(blk * 16) * DIN + 3 * DCONV + PGD * g);
    const char* wu = (const char*)((const bf16*)(P.ws + WS_POOLWT) + (size_t)g * PGD * PGD);
    bf16* mix = (bf16*)(P.ws + WS_MIX);
    const int fr = lane & 15, fq = lane >> 4, t = blk * 16 + fr;
    const unsigned zl = (unsigned)(fr * DIN + 8 * fq) * 2u, wl = (unsigned)(fr * PGD + 8 * fq) * 2u;
    const int cnt = (t + 1 < k) ? t + 1 : k; const float inv = 1.0f / (float)cnt;
    f32x4 acc[12];
#pragma unroll
    for (int n = 0; n < 12; ++n) acc[n] = (f32x4){0.f, 0.f, 0.f, 0.f};
#pragma unroll 1
    for (int ks = 0; ks < 6; ++ks) {
        float sum[8], self[8];
        unpack8(*(const u32x4*)(zu + ks * 64 + zl), self);
#pragma unroll
        for (int e = 0; e < 8; ++e) sum[e] = self[e];
#pragma unroll
        for (int j = 1; j < k; ++j) { float v[8]; unpack8(*(const u32x4*)(zu + ks * 64 - (long)j * (DIN * 2) + zl), v);
#pragma unroll
            for (int e = 0; e < 8; ++e) sum[e] += v[e]; }
        float pl[8];
#pragma unroll
        for (int e = 0; e < 8; ++e) pl[e] = sum[e] * inv - self[e];
        const bf16x8 pf = __builtin_bit_cast(bf16x8, pack8(pl));
#pragma unroll
        for (int n = 0; n < 12; ++n) { const bf16x8 wf = *(const bf16x8*)(wu + n * (16 * PGD * 2) + ks * 64 + wl); acc[n] = __builtin_amdgcn_mfma_f32_16x16x32_bf16(wf, pf, acc[n], 0, 0, 0); }
    }
#pragma unroll
    for (int n = 0; n < 12; ++n) { const int d = 16 * n + 4 * fq; const f32x4 sc = *(const f32x4*)(P.pool_scale + PGD * g + d);
        u32x2 o; o.x = pk2(acc[n][0] * sc[0], acc[n][1] * sc[1]); o.y = pk2(acc[n][2] * sc[2], acc[n][3] * sc[3]);
        *(u32x2*)(mix + (size_t)t * DMODEL + DCONV + PGD * g + d) = o; }
}
__device__ __forceinline__ void mix_attn_task(const Ptrs& P, int h, int blk, int lane) {
    const bf16* z = (const bf16*)(P.ws + WS_Z); bf16* mix = (bf16*)(P.ws + WS_MIX); const bf16* Kb = (const bf16*)(P.ws + WS_KB); const bf16* Vt = (const bf16*)(P.ws + WS_VT);
    const int fr = lane & 15, fq = lane >> 4, t = blk * 16 + fr;
    bf16x8 qf[4];
#pragma unroll
    for (int ks = 0; ks < 4; ++ks) qf[ks] = *(const bf16x8*)(z + (size_t)t * DIN + 3 * DCONV + DPOOL + 128 * h + 32 * ks + 8 * fq);
    f32x4 s[16];
#pragma unroll
    for (int kb = 0; kb < 16; ++kb) { s[kb] = (f32x4){0.f, 0.f, 0.f, 0.f};
#pragma unroll
        for (int ks = 0; ks < 4; ++ks) { const bf16x8 kf = *(const bf16x8*)(Kb + (size_t)(16 * kb + fr) * 512 + 128 * h + 32 * ks + 8 * fq); s[kb] = __builtin_amdgcn_mfma_f32_16x16x32_bf16(kf, qf[ks], s[kb], 0, 0, 0); } }
    float mx = -3.0e38f;
#pragma unroll
    for (int kb = 0; kb < 16; ++kb) mx = fmaxf(fmaxf(fmaxf(s[kb][0], s[kb][1]), fmaxf(s[kb][2], s[kb][3])), mx);
    mx = fmaxf(mx, __shfl_xor(mx, 16)); mx = fmaxf(mx, __shfl_xor(mx, 32));
    const float c2 = 0.08838834764831845f * 1.4426950408889634f;
    float sum = 0.f;
#pragma unroll
    for (int kb = 0; kb < 16; ++kb)
#pragma unroll
        for (int r = 0; r < 4; ++r) { const float p = __builtin_amdgcn_exp2f((s[kb][r] - mx) * c2); s[kb][r] = p; sum += p; }
    sum += __shfl_xor(sum, 16); sum += __shfl_xor(sum, 32);
    const float inv = 1.0f / sum;
    f32x4 o[8];
#pragma unroll
    for (int db = 0; db < 8; ++db) o[db] = (f32x4){0.f, 0.f, 0.f, 0.f};
#pragma unroll
    for (int ks = 0; ks < 8; ++ks) {
        u32x4 pw; pw.x = pk2(s[2 * ks][0], s[2 * ks][1]); pw.y = pk2(s[2 * ks][2], s[2 * ks][3]); pw.z = pk2(s[2 * ks + 1][0], s[2 * ks + 1][1]); pw.w = pk2(s[2 * ks + 1][2], s[2 * ks + 1][3]);
        const bf16x8 pf = __builtin_bit_cast(bf16x8, pw);
#pragma unroll
        for (int db = 0; db < 8; ++db) { const bf16x8 vf = *(const bf16x8*)(Vt + (size_t)(128 * h + 16 * db + fr) * 256 + 32 * ks + 8 * fq); o[db] = __builtin_amdgcn_mfma_f32_16x16x32_bf16(vf, pf, o[db], 0, 0, 0); }
    }
#pragma unroll
    for (int db = 0; db < 8; ++db) { u32x2 w; w.x = pk2(o[db][0] * inv, o[db][1] * inv); w.y = pk2(o[db][2] * inv, o[db][3] * inv);
        *(u32x2*)(mix + (size_t)t * DMODEL + DCONV + DPOOL + 128 * h + 16 * db + 4 * fq) = w; }
}
template <int R, int C, int PCH> __device__ __forceinline__ void lds_stage_rows(LAS unsigned char* dst, const unsigned char* src, int gp, int tid) {
    constexpr int N = R * C, PER = (N + 511) / 512;
    u32x4 v[PER];
#pragma unroll
    for (int i = 0; i < PER; ++i) { const int idx = tid + 512 * i; if (idx < N) { const int row = idx / C, ch = idx % C; v[i] = *(const u32x4*)(src + (size_t)row * gp + ch * 16); } }
#pragma unroll
    for (int i = 0; i < PER; ++i) { const int idx = tid + 512 * i; if (idx < N) { const int row = idx / C, ch = idx % C; *(LAS u32x4*)(dst + row * (PCH * 16) + (((ch & ~15) | ((ch & 15) ^ (row & 15))) << 4)) = v[i]; } }
}
template <int N> __device__ __forceinline__ float dpp_shrN(float old, float src) { return __builtin_bit_cast(float, __builtin_amdgcn_update_dpp(__builtin_bit_cast(int, old), __builtin_bit_cast(int, src), 0x110 + N, 0xf, 0xf, false)); }
template <int N> __device__ __forceinline__ float dpp_rorN(float src) { return __builtin_bit_cast(float, __builtin_amdgcn_mov_dpp(__builtin_bit_cast(int, src), 0x120 + N, 0xf, 0xf, false)); }
template <int N> __device__ __forceinline__ float scan_step(float x, float p) { return x + dpp_shrN<N>(dpp_rorN<N>(p), x); }
template <int N> __device__ __forceinline__ float scan_step_prev(float p) { return p + dpp_shrN<N>(0.f, p); }

__device__ __forceinline__ void mix_attn_wave(const Ptrs& P, LAS unsigned char* ldsK, LAS unsigned char* ldsV, int h, int row0, int lane) {
    const bf16* z = (const bf16*)(P.ws + WS_Z); bf16* mix = (bf16*)(P.ws + WS_MIX);
    const int fr = lane & 15, fq = lane >> 4;
    bf16x8 q0[4], q1[4];
#pragma unroll
    for (int ks = 0; ks < 4; ++ks) { const bf16* qp = z + (size_t)(row0 + fr) * DIN + 3 * DCONV + DPOOL + 128 * h + 32 * ks + 8 * fq; q0[ks] = *(const bf16x8*)qp; q1[ks] = *(const bf16x8*)(qp + 16 * DIN); }
    unsigned offk[4];
#pragma unroll
    for (int ks = 0; ks < 4; ++ks) offk[ks] = (unsigned)(fr * 256 + (((4 * ks + fq) ^ fr) << 4));
    f32x4 s0[16], s1[16];
#pragma unroll
    for (int kb = 0; kb < 16; ++kb) { s0[kb] = (f32x4){0.f, 0.f, 0.f, 0.f}; s1[kb] = (f32x4){0.f, 0.f, 0.f, 0.f};
#pragma unroll
        for (int ks = 0; ks < 4; ++ks) { const bf16x8 kf = *(const LAS bf16x8*)(ldsK + kb * 4096 + offk[ks]);
            s0[kb] = __builtin_amdgcn_mfma_f32_16x16x32_bf16(kf, q0[ks], s0[kb], 0, 0, 0); s1[kb] = __builtin_amdgcn_mfma_f32_16x16x32_bf16(kf, q1[ks], s1[kb], 0, 0, 0); } }
    const float c2 = 0.08838834764831845f * 1.4426950408889634f;
    bf16x8 p0[8], p1[8]; float inv0, inv1;
    {   float mx = -3.0e38f;
#pragma unroll
        for (int kb = 0; kb < 16; ++kb) mx = fmaxf(fmaxf(fmaxf(s0[kb][0], s0[kb][1]), fmaxf(s0[kb][2], s0[kb][3])), mx);
        mx = fmaxf(mx, __shfl_xor(mx, 16)); mx = fmaxf(mx, __shfl_xor(mx, 32));
        float sum = 0.f;
#pragma unroll
        for (int ks = 0; ks < 8; ++ks) { float e[8];
#pragma unroll
            for (int r = 0; r < 4; ++r) { e[r] = __builtin_amdgcn_exp2f((s0[2 * ks][r] - mx) * c2); e[4 + r] = __builtin_amdgcn_exp2f((s0[2 * ks + 1][r] - mx) * c2); }
            sum += ((e[0] + e[1]) + (e[2] + e[3])) + ((e[4] + e[5]) + (e[6] + e[7]));
            p0[ks] = __builtin_bit_cast(bf16x8, pack8(e)); }
        sum += __shfl_xor(sum, 16); sum += __shfl_xor(sum, 32); inv0 = 1.0f / sum; }
    {   float mx = -3.0e38f;
#pragma unroll
        for (int kb = 0; kb < 16; ++kb) mx = fmaxf(fmaxf(fmaxf(s1[kb][0], s1[kb][1]), fmaxf(s1[kb][2], s1[kb][3])), mx);
        mx = fmaxf(mx, __shfl_xor(mx, 16)); mx = fmaxf(mx, __shfl_xor(mx, 32));
        float sum = 0.f;
#pragma unroll
        for (int ks = 0; ks < 8; ++ks) { float e[8];
#pragma unroll
            for (int r = 0; r < 4; ++r) { e[r] = __builtin_amdgcn_exp2f((s1[2 * ks][r] - mx) * c2); e[4 + r] = __builtin_amdgcn_exp2f((s1[2 * ks + 1][r] - mx) * c2); }
            sum += ((e[0] + e[1]) + (e[2] + e[3])) + ((e[4] + e[5]) + (e[6] + e[7]));
            p1[ks] = __builtin_bit_cast(bf16x8, pack8(e)); }
        sum += __shfl_xor(sum, 16); sum += __shfl_xor(sum, 32); inv1 = 1.0f / sum; }
    f32x4 o0[8], o1[8];
#pragma unroll
    for (int db = 0; db < 8; ++db) { o0[db] = (f32x4){0.f, 0.f, 0.f, 0.f}; o1[db] = (f32x4){0.f, 0.f, 0.f, 0.f}; }
#pragma unroll
    for (int ks = 0; ks < 8; ++ks) {
        const unsigned offv = (unsigned)(fr * 512 + ((ks >> 2) << 8) + (((4 * (ks & 3) + fq) ^ fr) << 4));
#pragma unroll
        for (int db = 0; db < 8; ++db) { const bf16x8 vf = *(const LAS bf16x8*)(ldsV + db * 8192 + offv);
            o0[db] = __builtin_amdgcn_mfma_f32_16x16x32_bf16(vf, p0[ks], o0[db], 0, 0, 0); o1[db] = __builtin_amdgcn_mfma_f32_16x16x32_bf16(vf, p1[ks], o1[db], 0, 0, 0); } }
    bf16* op = mix + (size_t)(row0 + fr) * DMODEL + DCONV + DPOOL + 128 * h + 4 * fq;
#pragma unroll
    for (int db = 0; db < 8; ++db) { u32x2 w; w.x = pk2(o0[db][0] * inv0, o0[db][1] * inv0); w.y = pk2(o0[db][2] * inv0, o0[db][3] * inv0); *(u32x2*)(op + 16 * db) = w;
        w.x = pk2(o1[db][0] * inv1, o1[db][1] * inv1); w.y = pk2(o1[db][2] * inv1, o1[db][3] * inv1); *(u32x2*)(op + (size_t)16 * DMODEL + 16 * db) = w; }
}

template <int g> __device__ __forceinline__ void mix_pool_wave(const Ptrs& P, LAS unsigned char* ldsW, int row0, int lane) {
    constexpr int k = 2 << g;
    const bf16* z = (const bf16*)(P.ws + WS_Z); bf16* mix = (bf16*)(P.ws + WS_MIX);
    const int fr = lane & 15, fq = lane >> 4;
    f32x4 acc0[12], acc1[12];
#pragma unroll
    for (int n = 0; n < 12; ++n) { acc0[n] = (f32x4){0.f, 0.f, 0.f, 0.f}; acc1[n] = (f32x4){0.f, 0.f, 0.f, 0.f}; }
    const float invA = 1.0f / (float)((row0 + fr + 1 < k) ? row0 + fr + 1 : k), invB = 1.0f / (float)((row0 + 16 + fr + 1 < k) ? row0 + 16 + fr + 1 : k);
#pragma unroll 1
    for (int ks = 0; ks < 6; ++ks) {
        const bf16* zp = z + (long)(row0 - 16 + fr) * DIN + 3 * DCONV + PGD * g + 32 * ks + 8 * fq;
        float pv[8], xa[8], xb[8], sa[8], sb[8];
        unpack8(*(const u32x4*)zp, pv); unpack8(*(const u32x4*)(zp + 16 * DIN), xa); unpack8(*(const u32x4*)(zp + 32 * DIN), xb);
#pragma unroll
        for (int e = 0; e < 8; ++e) {
            float p = pv[e], a = xa[e], b = xb[e];
            float b1 = scan_step<1>(b, a), a1 = scan_step<1>(a, p), p1 = scan_step_prev<1>(p);
            if (k >= 4) { const float b2 = scan_step<2>(b1, a1), a2 = scan_step<2>(a1, p1), p2 = scan_step_prev<2>(p1); b1 = b2; a1 = a2; p1 = p2; }
            if (k >= 8) { const float b2 = scan_step<4>(b1, a1), a2 = scan_step<4>(a1, p1), p2 = scan_step_prev<4>(p1); b1 = b2; a1 = a2; p1 = p2; }
            if (k >= 16) { const float b2 = scan_step<8>(b1, a1), a2 = scan_step<8>(a1, p1); b1 = b2; a1 = a2; }
            sa[e] = a1 * invA - a; sb[e] = b1 * invB - b; }
        const bf16x8 fa = __builtin_bit_cast(bf16x8, pack8(sa)), fb = __builtin_bit_cast(bf16x8, pack8(sb));
        const unsigned offw = (unsigned)(fr * 512 + ((ks >> 2) << 8) + (((4 * (ks & 3) + fq) ^ fr) << 4));
#pragma unroll
        for (int n = 0; n < 12; ++n) { const bf16x8 wf = *(const LAS bf16x8*)(ldsW + n * 8192 + offw);
            acc0[n] = __builtin_amdgcn_mfma_f32_16x16x32_bf16(wf, fa, acc0[n], 0, 0, 0); acc1[n] = __builtin_amdgcn_mfma_f32_16x16x32_bf16(wf, fb, acc1[n], 0, 0, 0); }
    }
    bf16* op = mix + (size_t)(row0 + fr) * DMODEL + DCONV + PGD * g + 4 * fq;
#pragma unroll
    for (int n = 0; n < 12; ++n) { const f32x4 sc = *(const f32x4*)(P.pool_scale + PGD * g + 16 * n + 4 * fq);
        u32x2 o; o.x = pk2(acc0[n][0] * sc[0], acc0[n][1] * sc[1]); o.y = pk2(acc0[n][2] * sc[2], acc0[n][3] * sc[3]); *(u32x2*)(op + 16 * n) = o;
        o.x = pk2(acc1[n][0] * sc[0], acc1[n][1] * sc[1]); o.y = pk2(acc1[n][2] * sc[2], acc1[n][3] * sc[3]); *(u32x2*)(op + (size_t)16 * DMODEL + 16 * n) = o; }
}

__device__ __forceinline__ void p2_mixer(const Ptrs& P, LAS unsigned char* lds, int w, int tid, int wave, int lane, int tmask) {
    const int sub = w & 3, tile = w >> 2, row0 = tile * 256 + wave * 32;
    if (tmask & 0x1e0) {
        lds_stage_rows<256, 16, 16>(lds, (const unsigned char*)(P.ws + WS_KB) + 256 * sub, 1024, tid);
        lds_stage_rows<128, 32, 32>(lds + 65536, (const unsigned char*)(P.ws + WS_VT) + (size_t)sub * 128 * 512, 512, tid);
        LDS_WAIT(); __syncthreads();
        mix_attn_wave(P, lds, lds + 65536, sub, row0, lane);
        __syncthreads();
    }
    if (tmask & 0x1e) {
        lds_stage_rows<192, 24, 32>(lds, (const unsigned char*)(P.ws + WS_POOLWT) + (size_t)sub * PGD * PGD * 2, PGD * 2, tid);
        LDS_WAIT(); __syncthreads();
        if (sub == 0) mix_pool_wave<0>(P, lds, row0, lane); else if (sub == 1) mix_pool_wave<1>(P, lds, row0, lane); else if (sub == 2) mix_pool_wave<2>(P, lds, row0, lane); else mix_pool_wave<3>(P, lds, row0, lane);
        __syncthreads();
    }
    if (tmask & 1) { for (int b = wave; b < 4; b += 8) mix_conv_task(P, 4 * w + b, lane); }
}

__device__ __forceinline__ void p5_fixup(const Ptrs& P, int gt, int NGT) {
    const float* ub = (const float*)(P.ws + WS_UBND); bf16* act = (bf16*)(P.ws + WS_ACT); const float* cw = P.ffn_conv_w; const float* cb = P.ffn_conv_b;
    for (int i = gt; i < 63 * (DFF / 8); i += NGT) {
        const int pm = 1 + i / (DFF / 8), c = (i % (DFF / 8)) * 8, gi = 256 * (c / 128) + (c % 128);
        const float* p2 = ub + (size_t)((pm - 1) * 4 + 2) * DFF2 + gi; const float* p1 = p2 + DFF2; const float* r0 = ub + (size_t)(pm * 4) * DFF2 + gi; const float* r1 = r0 + DFF2;
        float o0[8], o1[8];
#pragma unroll
        for (int e = 0; e < 8; ++e) {
            const float gw0 = cw[c + e], gw1 = cw[DFF2 + c + e], gw2 = cw[2 * DFF2 + c + e], gb = cb[c + e], vw0 = cw[DFF + c + e], vw1 = cw[DFF2 + DFF + c + e], vw2 = cw[2 * DFF2 + DFF + c + e], vb = cb[DFF + c + e];
            const float G0 = gw2 * r0[e] + (gw1 * p1[e] + (gw0 * p2[e] + gb)), V0 = vw2 * r0[128 + e] + (vw1 * p1[128 + e] + (vw0 * p2[128 + e] + vb));
            const float G1 = gw2 * r1[e] + (gw1 * r0[e] + (gw0 * p1[e] + gb)), V1 = vw2 * r1[128 + e] + (vw1 * r0[128 + e] + (vw0 * p1[128 + e] + vb));
            o0[e] = G0 * __builtin_amdgcn_rcpf(1.0f + __builtin_amdgcn_exp2f(-1.4426950408889634f * G0)) * V0;
            o1[e] = G1 * __builtin_amdgcn_rcpf(1.0f + __builtin_amdgcn_exp2f(-1.4426950408889634f * G1)) * V1; }
        *(u32x4*)(act + (size_t)(256 * pm) * DFF + c) = pack8(o0); *(u32x4*)(act + (size_t)(256 * pm + 1) * DFF + c) = pack8(o1);
    }
}

__device__ __forceinline__ void p7_final(const Ptrs& P, int gw, int NGW, int lane) {
    const float* slab = (const float*)(P.ws + WS_SLAB2);
    for (int m = gw; m < SEQ; m += NGW) {
        const float part = (lane < 32) ? slab[(size_t)m * 32 + lane] : 0.f;
        const float rstd = 1.0f / sqrtf(wave_sum(part) * (1.0f / DMODEL) + EPS);
        f32x4* xr = (f32x4*)(P.out + (size_t)m * DMODEL) + lane; const f32x4* gr = (const f32x4*)P.g_final + lane;
#pragma unroll
        for (int j = 0; j < 8; ++j) { f32x4 v = xr[64 * j]; const f32x4 gg = gr[64 * j]; v = v * rstd * gg; xr[64 * j] = v; }
    }
}

struct Args { const float* in[16]; float* out; unsigned char* ws; int ph_lo, ph_hi; };
__global__ void __launch_bounds__(NWAVES * 64, 2) hybrid_fwd(Args args) {
    extern __shared__ __attribute__((aligned(16))) unsigned char lds_raw[];
    LAS unsigned char* lds = (LAS unsigned char*)lds_raw;
    cg::grid_group grid = cg::this_grid();
    const int tid = threadIdx.x, lane = tid & 63, wave = __builtin_amdgcn_readfirstlane(tid >> 6);
    const int G = gridDim.x, bx = blockIdx.x, vcu = (G % 8 == 0) ? (bx % 8) * (G / 8) + bx / 8 : bx;
    const int gw = vcu * NWAVES + wave, NGW = G * NWAVES;
    volatile LAS unsigned* MISC = (volatile LAS unsigned*)(lds + MISC_OFF);
    if (tid < 32) MISC[tid] = 0u;
    __syncthreads();
    const XcdBarrier bar = xcd_barrier_post((unsigned*)(args.ws + WS_CTL), MISC + 8);
    Ptrs P;
    P.x = args.in[0]; P.mem = args.in[1]; P.g_mix = args.in[2]; P.g_mem = args.in[3]; P.w_in = args.in[4]; P.conv_w = args.in[5]; P.pool_w = args.in[6]; P.pool_scale = args.in[7];
    P.w_kv = args.in[8]; P.w_out = args.in[9]; P.g_ffn = args.in[10]; P.w_up = args.in[11]; P.ffn_conv_w = args.in[12]; P.ffn_conv_b = args.in[13]; P.w_down = args.in[14]; P.g_final = args.in[15];
    P.out = args.out; P.ws = args.ws;
    unsigned char* ws = args.ws;
#if PROBE_SYNC
    for (int i = 0; i < 20; ++i) xcd_barrier(bar);
#endif
    const int lo = args.ph_lo, hi = args.ph_hi;
#define IN(k) (lo <= (k) && (k) < hi)
#define SYNC(k) do { if ((k) + 1 < hi) { if ((k) == 0 && USE_CG_SYNC) grid.sync(); else xcd_barrier(bar); } } while (0)
#define SYNCR(k, b) do { if ((k) + 1 < hi || rp + 1 < NREP(b)) { if ((k) == 0 && USE_CG_SYNC) grid.sync(); else xcd_barrier(bar); } } while (0)
#define NREP(b) ((REPM & (b)) ? 2 : 1)
    if (IN(0) && (PHM & 1)) for (int rp = 0; rp < NREP(1); ++rp) { p0_prologue(P, lds, gw, NGW, wave, lane); SYNCR(0, 1); }
    if (IN(1) && (PHM & 2)) for (int rp = 0; rp < NREP(2); ++rp) {
        pg8::Gemm g{(const bf16*)(ws + WS_H), (const bf16*)(ws + WS_WINT), SEQ, DIN, DMODEL}; pg8::StaticOrder S; S.init(SEQ, DIN, G, bx);
        pg8::EpiZ E{(bf16*)(ws + WS_Z), DIN};
        pg8::gemm_phase<pg8::EpiZ, pg8::StaticOrder, true, true>(lds, g, S, E, lds + XLDS_OFF);
        { const int nfull = ((SEQ / 256) * (DIN / 256)) % G;
          if (nfull == 0) p1_idle_work(P, lds, bx * NWAVES + wave, G * NWAVES, wave, lane);
          else if (bx >= nfull) p1_idle_work(P, lds, (bx - nfull) * NWAVES + wave, (G - nfull) * NWAVES, wave, lane); }
        SYNCR(1, 2);
    }
    if (IN(2) && (PHM & 4)) for (int rp = 0; rp < NREP(4); ++rp) { p2_mixer(P, lds, vcu, tid, wave, lane, 511);
#if PROBE_P2
        p2_mixer(P, lds, vcu, tid, wave, lane, PROBE_P2);
#endif
        SYNCR(2, 4); }
    if (IN(3) && (PHM & 8)) {
        pg8::Gemm g{(const bf16*)(ws + WS_MIX), (const bf16*)(ws + WS_WOUTT), SEQ, DMODEL, DMODEL}; pg8::PanelOrder S{G, vcu, (SEQ / 256) * (DMODEL / 256)};
        pg8::EpiNorm<0> E{P.x, nullptr, nullptr, (float*)(ws + WS_SIG), (bf16*)(ws + WS_X1B), nullptr, nullptr, (unsigned*)(ws + WS_SLAB1), (unsigned*)(ws + WS_CTL) + CW_PANEL1, (unsigned*)(ws + WS_CTL) + XB_TMO};
        pg8::gemm_phase<pg8::EpiNorm<0>, pg8::PanelOrder, true, true>(lds, g, S, E, lds + XLDS_OFF);
        SYNC(3);
    }
#if PROBE_GEMM
    if (IN(3)) {
        pg8::Gemm g{(const bf16*)(ws + WS_X1B), (const bf16*)(ws + WS_WUPT), SEQ, PROBE_N, DMODEL}; pg8::StaticOrder S; S.init(SEQ, PROBE_N, G, bx);
#if PROBE_GEMM == 1
        pg8::EpiZ E{(bf16*)(ws + WS_Z), PROBE_N};
        pg8::gemm_phase<pg8::EpiZ, pg8::StaticOrder, true, true>(lds, g, S, E, lds + XLDS_OFF);
#elif PROBE_GEMM == 2
        pg8::EpiNone E{};
        pg8::gemm_phase<pg8::EpiNone, pg8::StaticOrder, true, true>(lds, g, S, E, lds + XLDS_OFF);
#elif PROBE_GEMM == 3
        pg8::EpiZ E{(bf16*)(ws + WS_Z), PROBE_N};
        pg8::gemm_phase<pg8::EpiZ, pg8::StaticOrder, true, false>(lds, g, S, E, lds + XLDS_OFF);
#elif PROBE_GEMM == 5
        pg8::EpiAct E{(bf16*)(ws + WS_ACT), P.ffn_conv_w, P.ffn_conv_b, (float*)(ws + WS_UBND)};
        pg8::gemm_phase<pg8::EpiAct, pg8::StaticOrder, true, true>(lds, g, S, E, lds + XLDS_OFF);
#elif PROBE_GEMM == 4
        pg8::EpiZ E{(bf16*)(ws + WS_Z), PROBE_N};
        pg8::gemm_phase<pg8::EpiZ, pg8::StaticOrder, false, true>(lds, g, S, E, lds + XLDS_OFF);
#endif
        xcd_barrier(bar);
    }
#endif
    if (IN(4) && (PHM & 16)) for (int rp = 0; rp < NREP(16); ++rp) {
        pg8::Gemm g{(const bf16*)(ws + WS_X1B), (const bf16*)(ws + WS_WUPT), SEQ, DFF2, DMODEL}; pg8::StaticOrder S; S.init(SEQ, DFF2, G, bx);
        pg8::EpiAct E{(bf16*)(ws + WS_ACT), P.ffn_conv_w, P.ffn_conv_b, (float*)(ws + WS_UBND)};
        pg8::gemm_phase<pg8::EpiAct, pg8::StaticOrder, true, true>(lds, g, S, E, lds + XLDS_OFF);
        xcd_barrier(bar);
    }
    if (IN(5) && (PHM & 32)) { p5_fixup(P, vcu * (NWAVES * 64) + tid, G * NWAVES * 64); xcd_barrier(bar); }
    if (IN(6) && (PHM & 64)) {
        pg8::Gemm g{(const bf16*)(ws + WS_ACT), (const bf16*)(ws + WS_WDOWNT), SEQ, DMODEL, DFF}; pg8::PanelOrder S{G, vcu, (SEQ / 256) * (DMODEL / 256)};
        pg8::EpiNorm<1> E{nullptr, (const bf16*)(ws + WS_X1B), (const float*)(ws + WS_SIG), nullptr, nullptr, P.out, P.g_final, (unsigned*)(ws + WS_SLAB2), (unsigned*)(ws + WS_CTL) + CW_PANEL, (unsigned*)(ws + WS_CTL) + XB_TMO};
        pg8::gemm_phase<pg8::EpiNorm<1>, pg8::PanelOrder, true, true>(lds, g, S, E, lds + XLDS_OFF);
    }
#undef IN
#undef SYNC
}

extern "C" void kernel_launch(void* const* d_in, const int* in_sizes, int n_in, void* d_out, int out_size, void* d_ws, size_t ws_size, hipStream_t stream) {
    static int grid = 0;
    if (grid == 0) {
        if (n_in != 16 || in_sizes[0] != SEQ * DMODEL || out_size != SEQ * DMODEL || ws_size < WS_END) { fprintf(stderr, "kernel_launch: unexpected shapes (n_in %d, in0 %d, out %d, ws %zu)\n", n_in, n_in > 0 ? in_sizes[0] : -1, out_size, ws_size); grid = -1; return; }
        int dev = 0, cus = 0, per_cu = 0;
        if (hipGetDevice(&dev) != hipSuccess || hipDeviceGetAttribute(&cus, hipDeviceAttributeMultiprocessorCount, dev) != hipSuccess) { grid = -1; return; }
        if (hipFuncSetAttribute((const void*)hybrid_fwd, hipFuncAttributeMaxDynamicSharedMemorySize, LDS_BYTES) != hipSuccess) { fprintf(stderr, "kernel_launch: hipFuncSetAttribute failed\n"); grid = -1; return; }
        if (hipOccupancyMaxActiveBlocksPerMultiprocessor(&per_cu, (const void*)hybrid_fwd, NWAVES * 64, LDS_BYTES) != hipSuccess || per_cu < 1) { fprintf(stderr, "kernel_launch: occupancy query says %d blocks per CU\n", per_cu); (void)hipGetLastError(); per_cu = 1; }
        grid = cus;
        if (grid % 8 != 0 || grid < 8) { fprintf(stderr, "kernel_launch: %d CUs\n", grid); }
    }
    if (grid < 0) return;
    if (hipMemsetAsync((char*)d_ws + WS_CTL, 0, CTL_ZERO_BYTES, stream) != hipSuccess) { fprintf(stderr, "kernel_launch: hipMemsetAsync failed\n"); return; }
    Args a{};
    for (int i = 0; i < 16; ++i) a.in[i] = (const float*)d_in[i];
    a.out = (float*)d_out; a.ws = (unsigned char*)d_ws;
#if MK_PER_PHASE
    for (int ph = 0; ph < NPHASE; ++ph) { a.ph_lo = ph; a.ph_hi = ph + 1; hipLaunchKernelGGL(hybrid_fwd, dim3(grid), dim3(NWAVES * 64), LDS_BYTES, stream, a); }
#else
    a.ph_lo = 0; a.ph_hi = NPHASE;
    void* kargs[] = {&a};
    hipError_t e = hipLaunchCooperativeKernel((const void*)hybrid_fwd, dim3(grid), dim3(NWAVES * 64), kargs, LDS_BYTES, stream);
    if (e != hipSuccess) fprintf(stderr, "kernel_launch: cooperative launch failed: %s (grid %d)\n", hipGetErrorString(e), grid);
#endif
}
```

```cpp
#include <hip/hip_runtime.h>
#include <hip/hip_cooperative_groups.h>
#include <cstdio>
#include <cstdint>
namespace cg = cooperative_groups;
namespace pg8 {
#define PG8_LAS __attribute__((address_space(3)))
typedef unsigned short bf16_t;
typedef short bf16x8 __attribute__((ext_vector_type(8)));
typedef float f32x4 __attribute__((ext_vector_type(4)));
typedef unsigned u32x4 __attribute__((ext_vector_type(4)));
constexpr int BM = 256, BK = 64, HALF = 128, HTB = HALF * BK * 2  , STAGE_BYTES = 8 * HTB, NXCD = 8, WGM = 8;

__host__ __device__ __forceinline__ int lds_byte(int r, int c) { const int st = (r >> 4) * 2 + (c >> 5), rr = r & 15, cc = c & 31, ob = rr * 64 + cc * 2; return st * 1024 + (ob ^ (((ob >> 9) & 1) << 5)); }
__host__ __device__ __forceinline__ void stage_rc(int b, int& R, int& C) { const int st = b / 1024, sb = b % 1024, swz = sb ^ (((sb >> 9) & 1) << 5); R = (st >> 1) * 16 + swz / 64; C = (st & 1) * 32 + (swz % 64) / 2; }
__host__ __device__ __forceinline__ int perm32(int rho) { const int n = rho >> 4, i = rho & 15; return 8 * (i >> 2) + 4 * n + (i & 3); }

struct Unit { int pm, pn; };
struct Gemm { const bf16_t* A; const bf16_t* Bt; int M, N, K; };

struct StaticOrder {
    int nM, nN, nwg, G, c;
    __host__ __device__ void init(int M, int N, int G_, int c_) { nM = M / BM; nN = N / BM; nwg = nM * nN; G = G_; c = c_; }
    __host__ __device__ bool next(int i, Unit& u) const {
        const long L = (long)i * G + c; if (L >= nwg) return false;
        int wgid = (int)L; { const int q = nwg / NXCD, r = nwg % NXCD, xcd = wgid % NXCD, off = wgid / NXCD; wgid = (xcd < r ? xcd * (q + 1) : r * (q + 1) + (xcd - r) * q) + off; }
        const int nig = WGM * nN, gid = wgid / nig, fm = gid * WGM, gsz = (nM - fm) < WGM ? (nM - fm) : WGM;
        u.pm = fm + ((wgid % nig) % gsz); u.pn = (wgid % nig) / gsz; return true;
    }
    __device__ __forceinline__ void a_ready(const Unit&) const {}
    __device__ __forceinline__ void done(const Unit&) const {}
};
__device__ __forceinline__ unsigned cvt_pk_bf16(float lo, float hi) { unsigned r; asm volatile("v_cvt_pk_bf16_f32 %0, %1, %2" : "=v"(r) : "v"(lo), "v"(hi)); return r; }
typedef unsigned u32x2 __attribute__((ext_vector_type(2)));
constexpr int DM = 2048;
constexpr float RMS_EPS = 1e-6f;

struct EpiZ {
    static constexpr bool PERM = true, AFTER_DRAIN = false;
    bf16_t* O; int ldc;
    __device__ __forceinline__ void operator()(const f32x4 (&acc)[2][2][4][2], const Unit& u, int wr, int wc, int fr_, int fq_, PG8_LAS unsigned char*) const {
        int t_ = threadIdx.x; asm volatile("" : "+v"(t_));
        const int fr = t_ & 15, fq = (t_ >> 4) & 3;
        const int row0 = u.pm * BM + wr * 64 + fr, col0 = u.pn * BM + wc * 32 + 8 * fq;
#pragma unroll
        for (int ai = 0; ai < 2; ++ai)
#pragma unroll
            for (int m = 0; m < 4; ++m) { bf16_t* rowp = O + (size_t)(row0 + ai * HALF + m * 16) * ldc + col0;
#pragma unroll
                for (int bj = 0; bj < 2; ++bj) { const f32x4 v0 = acc[ai][bj][m][0], v1 = acc[ai][bj][m][1];
                    u32x4 w; w.x = cvt_pk_bf16(v0[0], v0[1]); w.y = cvt_pk_bf16(v0[2], v0[3]); w.z = cvt_pk_bf16(v1[0], v1[1]); w.w = cvt_pk_bf16(v1[2], v1[3]);
                    *(u32x4*)(rowp + bj * HALF) = w; } }
    }
};

struct EpiNone {
    static constexpr bool PERM = true, AFTER_DRAIN = false;
    __device__ __forceinline__ void operator()(const f32x4 (&acc)[2][2][4][2], const Unit& u, int wr, int wc, int fr, int fq, PG8_LAS unsigned char*) const {
#pragma unroll
        for (int ai = 0; ai < 2; ++ai)
#pragma unroll
            for (int bj = 0; bj < 2; ++bj)
#pragma unroll
                for (int m = 0; m < 4; ++m)
#pragma unroll
                    for (int n = 0; n < 2; ++n) asm volatile("" :: "v"(acc[ai][bj][m][n]));
    }
};
struct EpiResA {
    static constexpr bool PERM = true, AFTER_DRAIN = false;
    const float* R; bf16_t* XB; float* slab;
    __device__ __forceinline__ void operator()(const f32x4 (&acc)[2][2][4][2], const Unit& u, int wr, int wc, int fr_, int fq_, PG8_LAS unsigned char*) const {
        int t_ = threadIdx.x; asm volatile("" : "+v"(t_));
        const int fr = t_ & 15, fq = (t_ >> 4) & 3;
        const int row0 = u.pm * BM + wr * 64 + fr, col0 = u.pn * BM + wc * 32 + 8 * fq;
#pragma unroll
        for (int ai = 0; ai < 2; ++ai) {
            f32x4 r[4][2][2];
#pragma unroll
            for (int m = 0; m < 4; ++m)
#pragma unroll
                for (int bj = 0; bj < 2; ++bj) { const float* p = R + (size_t)(row0 + ai * HALF + m * 16) * DM + col0 + bj * HALF; r[m][bj][0] = *(const f32x4*)p; r[m][bj][1] = *(const f32x4*)(p + 4); }
#pragma unroll
            for (int m = 0; m < 4; ++m) { const int row = row0 + ai * HALF + m * 16; float ss = 0.f;
#pragma unroll
                for (int bj = 0; bj < 2; ++bj) { const f32x4 v0 = acc[ai][bj][m][0] + r[m][bj][0], v1 = acc[ai][bj][m][1] + r[m][bj][1];
                    u32x4 w; w.x = cvt_pk_bf16(v0[0], v0[1]); w.y = cvt_pk_bf16(v0[2], v0[3]); w.z = cvt_pk_bf16(v1[0], v1[1]); w.w = cvt_pk_bf16(v1[2], v1[3]);
                    *(u32x4*)(XB + (size_t)row * DM + col0 + bj * HALF) = w;
                    ss += (v0[0] * v0[0] + v0[1] * v0[1]) + (v0[2] * v0[2] + v0[3] * v0[3]) + (v1[0] * v1[0] + v1[1] * v1[1]) + (v1[2] * v1[2] + v1[3] * v1[3]); }
                ss += __shfl_xor(ss, 16); ss += __shfl_xor(ss, 32);
                if (fq == 0) slab[(size_t)row * 32 + u.pn * 4 + wc] = ss; }
            asm volatile("" ::: "memory"); }
    }
};
struct EpiResB {
    static constexpr bool PERM = true, AFTER_DRAIN = false;
    const bf16_t* RB; float* X; float* slab;
    __device__ __forceinline__ void operator()(const f32x4 (&acc)[2][2][4][2], const Unit& u, int wr, int wc, int fr_, int fq_, PG8_LAS unsigned char*) const {
        int t_ = threadIdx.x; asm volatile("" : "+v"(t_));
        const int fr = t_ & 15, fq = (t_ >> 4) & 3;
        const int row0 = u.pm * BM + wr * 64 + fr, col0 = u.pn * BM + wc * 32 + 8 * fq;
        u32x4 r[2][4][2];
#pragma unroll
        for (int ai = 0; ai < 2; ++ai)
#pragma unroll
            for (int m = 0; m < 4; ++m)
#pragma unroll
                for (int bj = 0; bj < 2; ++bj) r[ai][m][bj] = *(const u32x4*)(RB + (size_t)(row0 + ai * HALF + m * 16) * DM + col0 + bj * HALF);
#pragma unroll
        for (int ai = 0; ai < 2; ++ai)
#pragma unroll
            for (int m = 0; m < 4; ++m) { const int row = row0 + ai * HALF + m * 16; float ss = 0.f;
#pragma unroll
                for (int bj = 0; bj < 2; ++bj) { const u32x4 q = r[ai][m][bj];
                    const f32x4 r0 = {__builtin_bit_cast(float, q.x << 16), __builtin_bit_cast(float, q.x & 0xffff0000u), __builtin_bit_cast(float, q.y << 16), __builtin_bit_cast(float, q.y & 0xffff0000u)};
                    const f32x4 r1 = {__builtin_bit_cast(float, q.z << 16), __builtin_bit_cast(float, q.z & 0xffff0000u), __builtin_bit_cast(float, q.w << 16), __builtin_bit_cast(float, q.w & 0xffff0000u)};
                    const f32x4 v0 = acc[ai][bj][m][0] + r0, v1 = acc[ai][bj][m][1] + r1;
                    float* xp = X + (size_t)row * DM + col0 + bj * HALF; *(f32x4*)xp = v0; *(f32x4*)(xp + 4) = v1;
                    ss += (v0[0] * v0[0] + v0[1] * v0[1]) + (v0[2] * v0[2] + v0[3] * v0[3]) + (v1[0] * v1[0] + v1[1] * v1[1]) + (v1[2] * v1[2] + v1[3] * v1[3]); }
                ss += __shfl_xor(ss, 16); ss += __shfl_xor(ss, 32);
                if (fq == 0) slab[(size_t)row * 32 + u.pn * 4 + wc] = ss; }
    }
};

struct PanelOrder {
    int G, vcu, ntot;
    __device__ __forceinline__ bool next(int i, Unit& u) const { const int L = i * G + vcu; if (L >= ntot) return false; u.pm = L >> 3; u.pn = L & 7; return true; }
    __device__ __forceinline__ void a_ready(const Unit&) const {}
    __device__ __forceinline__ void done(const Unit&) const {}
};
template <int MODE  > struct EpiNorm {
    static constexpr bool PERM = true, AFTER_DRAIN = false;
    const float* Rf; const bf16_t* Rb; const float* sig_in; float* sig_out; bf16_t* HN; float* OUT; const float* gfin; unsigned* xbuf; unsigned* cnt; unsigned* tmo;
    __device__ __forceinline__ void operator()(f32x4 (&acc)[2][2][4][2], const Unit& u, int wr, int wc, int fr_, int fq_, PG8_LAS unsigned char* xlds) const {
        int t_ = threadIdx.x; asm volatile("" : "+v"(t_));
        const int fr = t_ & 15, fq = (t_ >> 4) & 3, wid = __builtin_amdgcn_readfirstlane(t_ >> 6);
        const int rl0 = wr * 64 + fr, row0 = u.pm * BM + rl0, col0 = u.pn * BM + wc * 32 + 8 * fq;
        PG8_LAS float* Pt = (PG8_LAS float*)xlds;
        PG8_LAS float* St = (PG8_LAS float*)(xlds + 4096);
        if constexpr (MODE == 0) {
#pragma unroll
            for (int ai = 0; ai < 2; ++ai) { f32x4 r[4][2][2];
#pragma unroll
                for (int m = 0; m < 4; ++m)
#pragma unroll
                    for (int bj = 0; bj < 2; ++bj) { const float* p = Rf + (size_t)(row0 + ai * HALF + m * 16) * DM + col0 + bj * HALF; r[m][bj][0] = *(const f32x4*)p; r[m][bj][1] = *(const f32x4*)(p + 4); }
#pragma unroll
                for (int m = 0; m < 4; ++m) { float ss = 0.f;
#pragma unroll
                    for (int bj = 0; bj < 2; ++bj) { const f32x4 v0 = acc[ai][bj][m][0] + r[m][bj][0], v1 = acc[ai][bj][m][1] + r[m][bj][1]; acc[ai][bj][m][0] = v0; acc[ai][bj][m][1] = v1;
                        ss += (v0[0] * v0[0] + v0[1] * v0[1]) + (v0[2] * v0[2] + v0[3] * v0[3]) + (v1[0] * v1[0] + v1[1] * v1[1]) + (v1[2] * v1[2] + v1[3] * v1[3]); }
                    ss += __shfl_xor(ss, 16); ss += __shfl_xor(ss, 32);
                    if (fq == 0) Pt[(ai * HALF + rl0 + m * 16) * 4 + wc] = ss; }
                asm volatile("" ::: "memory"); }
        } else { u32x4 r[2][4][2]; float sg[2][4];
#pragma unroll
            for (int ai = 0; ai < 2; ++ai)
#pragma unroll
                for (int m = 0; m < 4; ++m) { sg[ai][m] = sig_in[row0 + ai * HALF + m * 16];
#pragma unroll
                    for (int bj = 0; bj < 2; ++bj) r[ai][m][bj] = *(const u32x4*)(Rb + (size_t)(row0 + ai * HALF + m * 16) * DM + col0 + bj * HALF); }
#pragma unroll
            for (int ai = 0; ai < 2; ++ai)
#pragma unroll
                for (int m = 0; m < 4; ++m) { float ss = 0.f; const float sgm = sg[ai][m];
#pragma unroll
                    for (int bj = 0; bj < 2; ++bj) { const u32x4 q = r[ai][m][bj];
                        const f32x4 r0 = {__builtin_bit_cast(float, q.x << 16), __builtin_bit_cast(float, q.x & 0xffff0000u), __builtin_bit_cast(float, q.y << 16), __builtin_bit_cast(float, q.y & 0xffff0000u)};
                        const f32x4 r1 = {__builtin_bit_cast(float, q.z << 16), __builtin_bit_cast(float, q.z & 0xffff0000u), __builtin_bit_cast(float, q.w << 16), __builtin_bit_cast(float, q.w & 0xffff0000u)};
                        const f32x4 v0 = acc[ai][bj][m][0] + r0 * sgm, v1 = acc[ai][bj][m][1] + r1 * sgm; acc[ai][bj][m][0] = v0; acc[ai][bj][m][1] = v1;
                        ss += (v0[0] * v0[0] + v0[1] * v0[1]) + (v0[2] * v0[2] + v0[3] * v0[3]) + (v1[0] * v1[0] + v1[1] * v1[1]) + (v1[2] * v1[2] + v1[3] * v1[3]); }
                    ss += __shfl_xor(ss, 16); ss += __shfl_xor(ss, 32);
                    if (fq == 0) Pt[(ai * HALF + rl0 + m * 16) * 4 + wc] = ss; } }
        asm volatile("s_waitcnt lgkmcnt(0)" ::: "memory"); __builtin_amdgcn_s_barrier(); asm volatile("" ::: "memory");
        if (t_ < 256) { const float s = (Pt[t_ * 4 + 0] + Pt[t_ * 4 + 1]) + (Pt[t_ * 4 + 2] + Pt[t_ * 4 + 3]);
            __hip_atomic_store(xbuf + (size_t)(u.pm * BM + t_) * 8 + u.pn, __builtin_bit_cast(unsigned, s), __ATOMIC_RELAXED, __HIP_MEMORY_SCOPE_AGENT); }
        asm volatile("s_waitcnt vmcnt(0)" ::: "memory");
        if (t_ < 256 && (t_ & 63) == 0) __hip_atomic_fetch_add(cnt + 64 * u.pm, 1u, __ATOMIC_RELAXED, __HIP_MEMORY_SCOPE_AGENT);
        if (wid == 0) {
            unsigned spins = 0;
            while ((unsigned)__builtin_amdgcn_readfirstlane(__hip_atomic_load(cnt + 64 * u.pm, __ATOMIC_RELAXED, __HIP_MEMORY_SCOPE_AGENT)) < 32u) {
                __builtin_amdgcn_s_sleep(2);
                if (++spins > (1u << 20)) { if ((t_ & 63) == 0) __hip_atomic_store(tmo, 1u, __ATOMIC_RELAXED, __HIP_MEMORY_SCOPE_AGENT); break; } }
            __builtin_amdgcn_fence(__ATOMIC_ACQUIRE, "agent");
        }
        asm volatile("s_waitcnt vmcnt(0) lgkmcnt(0)" ::: "memory"); __builtin_amdgcn_s_barrier(); asm volatile("" ::: "memory");
        if (t_ < 256) { const unsigned long long* sp = (const unsigned long long*)(xbuf + (size_t)(u.pm * BM + t_) * 8); float tot = 0.f;
#pragma unroll
            for (int q = 0; q < 4; ++q) { const unsigned long long w = __hip_atomic_load(sp + q, __ATOMIC_RELAXED, __HIP_MEMORY_SCOPE_AGENT);
                tot += __builtin_bit_cast(float, (unsigned)w); tot += __builtin_bit_cast(float, (unsigned)(w >> 32)); }
            const float sd = sqrtf(tot * (1.0f / DM) + RMS_EPS);
            St[t_] = 1.0f / sd;
            if (MODE == 0 && u.pn == 0) sig_out[u.pm * BM + t_] = sd; }
        asm volatile("s_waitcnt lgkmcnt(0)" ::: "memory"); __builtin_amdgcn_s_barrier(); asm volatile("" ::: "memory");
        if constexpr (MODE == 0) {
#pragma unroll
            for (int ai = 0; ai < 2; ++ai)
#pragma unroll
                for (int m = 0; m < 4; ++m) { const float rstd = St[ai * HALF + rl0 + m * 16]; bf16_t* op = HN + (size_t)(row0 + ai * HALF + m * 16) * DM + col0;
#pragma unroll
                    for (int bj = 0; bj < 2; ++bj) { const f32x4 v0 = acc[ai][bj][m][0] * rstd, v1 = acc[ai][bj][m][1] * rstd;
                        u32x4 w; w.x = cvt_pk_bf16(v0[0], v0[1]); w.y = cvt_pk_bf16(v0[2], v0[3]); w.z = cvt_pk_bf16(v1[0], v1[1]); w.w = cvt_pk_bf16(v1[2], v1[3]);
                        *(u32x4*)(op + bj * HALF) = w; } }
        } else {
            f32x4 gg[2][2];
#pragma unroll
            for (int bj = 0; bj < 2; ++bj) { gg[bj][0] = *(const f32x4*)(gfin + col0 + bj * HALF); gg[bj][1] = *(const f32x4*)(gfin + col0 + bj * HALF + 4); }
#pragma unroll
            for (int ai = 0; ai < 2; ++ai)
#pragma unroll
                for (int m = 0; m < 4; ++m) { const float rstd = St[ai * HALF + rl0 + m * 16]; float* op = OUT + (size_t)(row0 + ai * HALF + m * 16) * DM + col0;
#pragma unroll
                    for (int bj = 0; bj < 2; ++bj) { *(f32x4*)(op + bj * HALF) = acc[ai][bj][m][0] * rstd * gg[bj][0]; *(f32x4*)(op + bj * HALF + 4) = acc[ai][bj][m][1] * rstd * gg[bj][1]; } }
        }
    }
};

__device__ __forceinline__ float dpp_shr1(float old, float src) { return __builtin_bit_cast(float, __builtin_amdgcn_update_dpp(__builtin_bit_cast(int, old), __builtin_bit_cast(int, src), 0x111, 0xf, 0xf, false)); }
__device__ __forceinline__ float dpp_shr2(float old, float src) { return __builtin_bit_cast(float, __builtin_amdgcn_update_dpp(__builtin_bit_cast(int, old), __builtin_bit_cast(int, src), 0x112, 0xf, 0xf, false)); }
__device__ __forceinline__ float dpp_ror1(float src) { return __builtin_bit_cast(float, __builtin_amdgcn_mov_dpp(__builtin_bit_cast(int, src), 0x121, 0xf, 0xf, false)); }
__device__ __forceinline__ float dpp_ror2(float src) { return __builtin_bit_cast(float, __builtin_amdgcn_mov_dpp(__builtin_bit_cast(int, src), 0x122, 0xf, 0xf, false)); }
constexpr int FF = 5632, FF2 = 11264;
struct EpiAct {
    static constexpr bool PERM = true, AFTER_DRAIN = false;
    bf16_t* ACT; const float* cw; const float* cb; float* ubnd;
    __device__ __forceinline__ void operator()(f32x4 (&acc)[2][2][4][2], const Unit& u, int wr, int wc, int fr_, int fq_, PG8_LAS unsigned char* xlds) const {
        int t_ = threadIdx.x; asm volatile("" : "+v"(t_));
        const int fr = t_ & 15, fq = (t_ >> 4) & 3;
        const int row0 = u.pm * BM + wr * 64 + fr, cl = wc * 32 + 8 * fq;
        const int c0 = u.pn * 128 + cl;
        f32x4 wgt[2][8];
#pragma unroll
        for (int n = 0; n < 2; ++n) { const float* wp = cw + c0 + 4 * n; const float* bp = cb + c0 + 4 * n;
            wgt[n][0] = *(const f32x4*)wp; wgt[n][1] = *(const f32x4*)(wp + FF2); wgt[n][2] = *(const f32x4*)(wp + 2 * FF2); wgt[n][3] = *(const f32x4*)bp;
            wgt[n][4] = *(const f32x4*)(wp + FF); wgt[n][5] = *(const f32x4*)(wp + FF2 + FF); wgt[n][6] = *(const f32x4*)(wp + 2 * FF2 + FF); wgt[n][7] = *(const f32x4*)(bp + FF); }
        if (fr >= 14) {
#pragma unroll
            for (int ai = 0; ai < 2; ++ai)
#pragma unroll
                for (int bj = 0; bj < 2; ++bj)
#pragma unroll
                    for (int n = 0; n < 2; ++n) *(PG8_LAS f32x4*)(xlds + ((((2 * ai + wr) * 2 + (fr - 14)) * 256 + 128 * bj + cl + 4 * n) << 2)) = acc[ai][bj][3][n];
            if (wr == 1) {
#pragma unroll
                for (int bj = 0; bj < 2; ++bj)
#pragma unroll
                    for (int n = 0; n < 2; ++n) *(f32x4*)(ubnd + (size_t)(u.pm * 4 + 2 + (fr - 14)) * FF2 + u.pn * BM + 128 * bj + cl + 4 * n) = acc[1][bj][3][n]; }
        }
        if (wr == 0 && fr < 2) {
#pragma unroll
            for (int bj = 0; bj < 2; ++bj)
#pragma unroll
                for (int n = 0; n < 2; ++n) *(f32x4*)(ubnd + (size_t)(u.pm * 4 + fr) * FF2 + u.pn * BM + 128 * bj + cl + 4 * n) = acc[0][bj][0][n]; }
        asm volatile("s_waitcnt lgkmcnt(0)" ::: "memory"); __builtin_amdgcn_s_barrier(); asm volatile("" ::: "memory");
        u32x2 hold[2][4];
#pragma unroll
        for (int n = 0; n < 2; ++n) {
            const f32x4 gw0 = wgt[n][0], gw1 = wgt[n][1], gw2 = wgt[n][2], gb = wgt[n][3], vw0 = wgt[n][4], vw1 = wgt[n][5], vw2 = wgt[n][6], vb = wgt[n][7];
#pragma unroll
            for (int ai = 0; ai < 2; ++ai) {
                const int chunk = 2 * ai + wr;
                f32x4 pg = {0.f, 0.f, 0.f, 0.f}, pv = {0.f, 0.f, 0.f, 0.f};
                if (chunk > 0) { const PG8_LAS unsigned char* bp = xlds + ((((chunk - 1) * 2 + (fr & 1)) * 256 + cl + 4 * n) << 2);
                    pg = *(const PG8_LAS f32x4*)bp; pv = *(const PG8_LAS f32x4*)(bp + 512); }
#pragma unroll
                for (int m = 0; m < 4; ++m) {
                    const f32x4 cg = acc[ai][0][m][n], cv = acc[ai][1][m][n]; float a[4];
#pragma unroll
                    for (int j = 0; j < 4; ++j) {
                        const float g1 = dpp_shr1(dpp_ror1(pg[j]), cg[j]), g2 = dpp_shr2(dpp_ror2(pg[j]), cg[j]);
                        const float v1 = dpp_shr1(dpp_ror1(pv[j]), cv[j]), v2 = dpp_shr2(dpp_ror2(pv[j]), cv[j]);
                        const float G = gw2[j] * cg[j] + (gw1[j] * g1 + (gw0[j] * g2 + gb[j]));
                        const float V = vw2[j] * cv[j] + (vw1[j] * v1 + (vw0[j] * v2 + vb[j]));
                        a[j] = G * __builtin_amdgcn_rcpf(1.0f + __builtin_amdgcn_exp2f(-1.4426950408889634f * G)) * V; }
                    u32x2 w; w.x = cvt_pk_bf16(a[0], a[1]); w.y = cvt_pk_bf16(a[2], a[3]);
                    if (n == 0) hold[ai][m] = w;
                    else { u32x4 o; o.x = hold[ai][m].x; o.y = hold[ai][m].y; o.z = w.x; o.w = w.y;
                        *(u32x4*)(ACT + (size_t)(row0 + ai * HALF + m * 16) * FF + c0) = o; }
                    pg = cg; pv = cv;
                }
            }
        }
    }
};

template <class Epi, class Sched, bool ALIGN_EPI = false, bool SP2 = false>
__device__ __forceinline__ void gemm_phase(PG8_LAS unsigned char* lds, const Gemm g, const Sched& S, const Epi& E, PG8_LAS unsigned char* xlds) {
    const int tid = threadIdx.x, wid = __builtin_amdgcn_readfirstlane(tid >> 6), lane = tid & 63, wr = wid >> 2, wc = wid & 3, fr = lane & 15, fq = lane >> 4;
    const int K = g.K, nt = K / BK;
    unsigned voffA[2], voffB[2];
#pragma unroll
    for (int i = 0; i < 2; ++i) { int R, C; stage_rc(tid * 16 + i * 8192, R, C); const int Rb = Epi::PERM ? ((R & ~31) + perm32(R & 31)) : R;
        voffA[i] = (unsigned)(R * K + C) * 2u; voffB[i] = (unsigned)(Rb * K + C) * 2u; }
    const size_t kstep = (size_t)(BK * 2);
    const size_t hstep = (size_t)HALF * K * 2;
    const size_t tstep = 2 * hstep;
    const unsigned ldsw = (unsigned)wid * 1024u;
    const int aoff = lds_byte(wr * 64 + fr, fq * 8), boff = lds_byte(wc * 32 + fr, fq * 8);
#define PG8_SA(b, h) (((b) * 2 + (h)) * HTB)
#define PG8_SB(b, h) ((4 + (b) * 2 + (h)) * HTB)
#define PG8_STAGE(bufoff, gbase, voff) do { _Pragma("unroll") for (int _i = 0; _i < 2; ++_i) \
        __builtin_amdgcn_global_load_lds((const unsigned*)((const char*)(gbase) + (voff)[_i]), (PG8_LAS unsigned*)(lds + (bufoff) + ldsw + _i * 8192), 16, 0, 0); } while (0)
#define PG8_LDA(dst, b, h) do { _Pragma("unroll") for (int m = 0; m < 4; ++m) _Pragma("unroll") for (int k = 0; k < 2; ++k) dst[m][k] = *(const PG8_LAS bf16x8*)(lds + PG8_SA(b, h) + aoff + m * 2048 + k * 1024); } while (0)
#define PG8_LDB(dst, b, h) do { _Pragma("unroll") for (int n = 0; n < 2; ++n) _Pragma("unroll") for (int k = 0; k < 2; ++k) dst[n][k] = *(const PG8_LAS bf16x8*)(lds + PG8_SB(b, h) + boff + n * 2048 + k * 1024); } while (0)
#define PG8_MMA(ai, bj, At, Bt) do { __builtin_amdgcn_s_setprio(1); _Pragma("unroll") for (int m = 0; m < 4; ++m) _Pragma("unroll") for (int n = 0; n < 2; ++n) _Pragma("unroll") for (int k = 0; k < 2; ++k) \
        acc[ai][bj][m][n] = __builtin_amdgcn_mfma_f32_16x16x32_bf16(Bt[n][k], At[m][k], acc[ai][bj][m][n], 0, 0, 0); __builtin_amdgcn_s_setprio(0); } while (0)
#define PG8_WAIT_V(n) asm volatile("s_waitcnt vmcnt(" #n ")" ::: "memory")
#define PG8_WAIT_L(n) asm volatile("s_waitcnt lgkmcnt(" #n ")" ::: "memory")
#define PG8_BAR __builtin_amdgcn_s_barrier()
#define PG8_SCHED __builtin_amdgcn_sched_barrier(0)
    Unit cur, nxt; int ui = 0;
    if (!S.next(0, cur)) return;
    f32x4 acc[2][2][4][2];
#pragma unroll
    for (int a = 0; a < 2; ++a)
#pragma unroll
        for (int b = 0; b < 2; ++b)
#pragma unroll
            for (int m = 0; m < 4; ++m)
#pragma unroll
                for (int n = 0; n < 2; ++n) acc[a][b][m][n] = (f32x4){0.f, 0.f, 0.f, 0.f};
    bf16x8 At[4][2], B0[2][2], B1[2][2];
    const char* cA = (const char*)g.A + (size_t)cur.pm * tstep; const char* cB = (const char*)g.Bt + (size_t)cur.pn * tstep;
    S.a_ready(cur);
    if constexpr (SP2) {
        PG8_STAGE(PG8_SB(0, 0), cB, voffB); PG8_STAGE(PG8_SB(0, 1), cB + hstep, voffB); PG8_STAGE(PG8_SA(0, 0), cA, voffA); PG8_STAGE(PG8_SA(0, 1), cA + hstep, voffA);
        if (wr == 1) PG8_BAR;
        PG8_WAIT_V(2); PG8_BAR;
        PG8_STAGE(PG8_SB(1, 0), cB + kstep, voffB); PG8_STAGE(PG8_SA(1, 0), cA + kstep, voffA); PG8_STAGE(PG8_SB(1, 1), cB + hstep + kstep, voffB);
        PG8_WAIT_V(6); PG8_BAR;
    } else {
        PG8_STAGE(PG8_SB(0, 0), cB, voffB); PG8_STAGE(PG8_SA(0, 0), cA, voffA); PG8_STAGE(PG8_SB(0, 1), cB + hstep, voffB); PG8_STAGE(PG8_SA(0, 1), cA + hstep, voffA);
        if (wr == 1) PG8_BAR;
        PG8_WAIT_V(4); PG8_BAR;
        PG8_STAGE(PG8_SB(1, 0), cB + kstep, voffB); PG8_STAGE(PG8_SA(1, 0), cA + kstep, voffA); PG8_STAGE(PG8_SB(1, 1), cB + hstep + kstep, voffB);
        PG8_WAIT_V(6); PG8_BAR;
    }
    for (;;) {
        const bool has_next = S.next(ui + 1, nxt);
        const char* nA = has_next ? (const char*)g.A + (size_t)nxt.pm * tstep : cA; const char* nB = has_next ? (const char*)g.Bt + (size_t)nxt.pn * tstep : cB;
        for (int t = 0; t < nt; t += 2) {
            const bool last = (t == nt - 2);
            const char* a1 = cA + (size_t)(t + 1) * kstep;
            const char* a2 = last ? nA : cA + (size_t)(t + 2) * kstep; const char* b2 = last ? nB : cB + (size_t)(t + 2) * kstep;
            const char* a3 = a2 + kstep; const char* b3 = b2 + kstep;
            if (last && has_next) S.a_ready(nxt);
            if constexpr (SP2) {
            PG8_LDB(B0, 0, 0); PG8_LDB(B1, 0, 1); PG8_SCHED; PG8_LDA(At, 0, 0); PG8_STAGE(PG8_SA(1, 1), a1 + hstep, voffA);
            PG8_WAIT_V(8); PG8_WAIT_L(0); PG8_BAR; PG8_MMA(0, 0, At, B0); PG8_MMA(0, 1, At, B1); PG8_BAR; PG8_SCHED;
            PG8_LDA(At, 0, 1); PG8_STAGE(PG8_SB(0, 0), b2, voffB); PG8_STAGE(PG8_SB(0, 1), b2 + hstep, voffB); PG8_STAGE(PG8_SA(0, 0), a2, voffA);
            PG8_WAIT_V(8); PG8_WAIT_L(0); PG8_BAR; PG8_MMA(1, 0, At, B0); PG8_MMA(1, 1, At, B1); PG8_BAR; PG8_SCHED;
            PG8_LDB(B0, 1, 0); PG8_LDB(B1, 1, 1); PG8_SCHED; PG8_LDA(At, 1, 0); PG8_STAGE(PG8_SA(0, 1), a2 + hstep, voffA);
            PG8_WAIT_V(8); PG8_WAIT_L(0); PG8_BAR; PG8_MMA(0, 0, At, B0); PG8_MMA(0, 1, At, B1); PG8_BAR; PG8_SCHED;
            PG8_LDA(At, 1, 1); PG8_STAGE(PG8_SB(1, 0), b3, voffB); PG8_STAGE(PG8_SB(1, 1), b3 + hstep, voffB); PG8_STAGE(PG8_SA(1, 0), a3, voffA);
            PG8_WAIT_V(8); PG8_WAIT_L(0); PG8_BAR; PG8_MMA(1, 0, At, B0); PG8_MMA(1, 1, At, B1); PG8_BAR; PG8_SCHED;
            } else {
            PG8_LDB(B0, 0, 0); PG8_SCHED; PG8_LDA(At, 0, 0); PG8_STAGE(PG8_SA(1, 1), a1 + hstep, voffA);
            PG8_WAIT_L(8); PG8_BAR; PG8_WAIT_L(0); PG8_MMA(0, 0, At, B0); PG8_BAR; PG8_SCHED;
            PG8_LDB(B1, 0, 1); PG8_STAGE(PG8_SB(0, 0), b2, voffB);
            PG8_BAR; PG8_WAIT_L(0); PG8_MMA(0, 1, At, B1); PG8_BAR;
            PG8_LDA(At, 0, 1); PG8_STAGE(PG8_SA(0, 0), a2, voffA);
            PG8_BAR; PG8_WAIT_L(0); PG8_MMA(1, 0, At, B0); PG8_BAR; PG8_SCHED;
            PG8_STAGE(PG8_SB(0, 1), b2 + hstep, voffB);
            PG8_WAIT_V(6); PG8_BAR; PG8_MMA(1, 1, At, B1); PG8_BAR;
            PG8_LDB(B0, 1, 0); PG8_SCHED; PG8_LDA(At, 1, 0); PG8_STAGE(PG8_SA(0, 1), a2 + hstep, voffA);
            PG8_WAIT_L(8); PG8_BAR; PG8_WAIT_L(0); PG8_MMA(0, 0, At, B0); PG8_BAR; PG8_SCHED;
            PG8_LDB(B1, 1, 1); PG8_STAGE(PG8_SB(1, 0), b3, voffB);
            PG8_BAR; PG8_WAIT_L(0); PG8_MMA(0, 1, At, B1); PG8_BAR;
            PG8_LDA(At, 1, 1); PG8_STAGE(PG8_SA(1, 0), a3, voffA);
            PG8_BAR; PG8_WAIT_L(0); PG8_MMA(1, 0, At, B0); PG8_BAR; PG8_SCHED;
            PG8_STAGE(PG8_SB(1, 1), b3 + hstep, voffB);
            PG8_WAIT_V(6); PG8_BAR; PG8_MMA(1, 1, At, B1); PG8_BAR;
            }
        }
        if constexpr (ALIGN_EPI) { if (wr == 0) PG8_BAR; }
        if constexpr (!Epi::AFTER_DRAIN) { E(acc, cur, wr, wc, fr, fq, xlds); S.done(cur); }
        if (!has_next) break;
#pragma unroll
        for (int a = 0; a < 2; ++a)
#pragma unroll
            for (int b = 0; b < 2; ++b)
#pragma unroll
                for (int m = 0; m < 4; ++m)
#pragma unroll
                    for (int n = 0; n < 2; ++n) acc[a][b][m][n] = (f32x4){0.f, 0.f, 0.f, 0.f};
        cur = nxt; cA = nA; cB = nB; ++ui;
        if constexpr (ALIGN_EPI) { if (wr == 1) PG8_BAR; }
    }
    PG8_WAIT_V(0);
    if constexpr (!ALIGN_EPI) { if (wr == 0) PG8_BAR; }
    PG8_BAR;

#undef PG8_SA
#undef PG8_SB
#undef PG8_STAGE
#undef PG8_LDA
#undef PG8_LDB
#undef PG8_MMA
#undef PG8_WAIT_V
#undef PG8_WAIT_L
#undef PG8_BAR
#undef PG8_SCHED
}
}

#define GAS __attribute__((address_space(1)))
#define LAS __attribute__((address_space(3)))
typedef unsigned short bf16;
typedef float f32x4 __attribute__((ext_vector_type(4)));
typedef short bf16x8 __attribute__((ext_vector_type(8)));
typedef unsigned u32x4 __attribute__((ext_vector_type(4)));
typedef unsigned u32x2 __attribute__((ext_vector_type(2)));

constexpr int NWAVES = 8;
constexpr int SEQ = 16384, DMODEL = 2048, NMEM = 256, DIN = 3584, DCONV = 768, DPOOL = 768, DXATT = 512, DFF = 5632, DFF2 = 11264;
constexpr int PGD = 192;
constexpr float EPS = 1e-6f;
constexpr int LDS_BYTES = 147456;
#ifndef MK_PER_PHASE
#define MK_PER_PHASE 0
#endif
constexpr int NPHASE = 7;
#ifndef PHM
#define PHM 255
#endif
#ifndef P1_ALIGN
#define P1_ALIGN false
#endif
#ifndef USE_CG_SYNC
#define USE_CG_SYNC 0
#endif
#ifndef PROBE_P2
#define PROBE_P2 0
#endif
#ifndef PROBE_SYNC
#define PROBE_SYNC 0
#endif
#ifndef PROBE_GEMM
#define PROBE_GEMM 0
#endif
#ifndef PROBE_N
#define PROBE_N 2048
#endif
#ifndef REPM
#define REPM 0
#endif

constexpr size_t MiB = 1u << 20;
constexpr size_t WS_KB = 1 * MiB;
constexpr size_t WS_VT = 1 * MiB + 256 * 1024;
constexpr size_t WS_POOLWT = 1 * MiB + 512 * 1024;
constexpr size_t WS_MB = 2 * MiB;
constexpr size_t WS_WKVT = 3 * MiB;
constexpr size_t WS_SIG = 7 * MiB;
constexpr size_t WS_SLAB1 = 8 * MiB;
constexpr size_t WS_SLAB2 = 10 * MiB;
constexpr size_t WS_WUPT = 12 * MiB;
constexpr size_t WS_WDOWNT = 56 * MiB;
constexpr size_t WS_UBND = 80 * MiB;
constexpr size_t WS_X1B = 96 * MiB;
constexpr size_t WS_ACT = 160 * MiB;
constexpr size_t WS_H = 160 * MiB;
constexpr size_t WS_Z = 225 * MiB;
constexpr size_t WS_ZPAD = WS_Z - (size_t)16 * 3584 * 2;
constexpr size_t WS_MIX = 338 * MiB;
constexpr size_t WS_WINT = 402 * MiB;
constexpr size_t WS_WOUTT = 416 * MiB;
constexpr size_t WS_END = 424 * MiB;

__device__ __forceinline__ unsigned f2bf(float f) { unsigned u = __builtin_bit_cast(unsigned, f); return (u + 0x7fffu + ((u >> 16) & 1u)) >> 16; }
__device__ __forceinline__ unsigned pk2(float lo, float hi) { return f2bf(lo) | (f2bf(hi) << 16); }
__device__ __forceinline__ float bflo(unsigned w) { return __builtin_bit_cast(float, w << 16); }
__device__ __forceinline__ float bfhi(unsigned w) { return __builtin_bit_cast(float, w & 0xffff0000u); }
__device__ __forceinline__ void unpack8(const u32x4 w, float (&f)[8]) { f[0] = bflo(w.x); f[1] = bfhi(w.x); f[2] = bflo(w.y); f[3] = bfhi(w.y); f[4] = bflo(w.z); f[5] = bfhi(w.z); f[6] = bflo(w.w); f[7] = bfhi(w.w); }
__device__ __forceinline__ u32x4 pack8(const float (&f)[8]) { u32x4 w; w.x = pk2(f[0], f[1]); w.y = pk2(f[2], f[3]); w.z = pk2(f[4], f[5]); w.w = pk2(f[6], f[7]); return w; }
__device__ __forceinline__ float wave_sum(float v) {
#pragma unroll
    for (int o = 1; o < 64; o <<= 1) v += __shfl_xor(v, o);
    return v;
}
#define LDS_WAIT() asm volatile("s_waitcnt lgkmcnt(0)" ::: "memory")

typedef GAS unsigned gu32;
constexpr size_t WS_CTL = 0, CTL_ZERO_BYTES = 64 * 1024;
constexpr int CW_PANEL1 = 8192;
constexpr int CW_PANEL = 4096;
constexpr int MISC_OFF = 131072 + 320;
constexpr int XLDS_OFF = 131072 + 1024;
#define XB_TMO      128
#define XB_XCNT(j)  (256  + 64 * (j))
#define XB_XSUB(j)  (1280 + 64 * (j))
#define XB_XGEN(j)  (2304 + 64 * (j))
#define XB_TOP      3328
#define XB_TOPGEN   3392
#define XCD_BAR_WORDS 3456
#define XB_SPIN_CAP (1u << 18)

__device__ __forceinline__ unsigned xb_ld(unsigned* p)              { return __hip_atomic_load(p, __ATOMIC_RELAXED, __HIP_MEMORY_SCOPE_AGENT); }
__device__ __forceinline__ unsigned xb_add(unsigned* p, unsigned v) { return __hip_atomic_fetch_add(p, v, __ATOMIC_RELAXED, __HIP_MEMORY_SCOPE_AGENT); }
__device__ __forceinline__ unsigned xb_xcc_id() { return (unsigned)__builtin_amdgcn_s_getreg((3 << 11) | 20) & 0xFu; }
#define XB_SPIN(cond, bar) do { unsigned _sp = 0; while (cond) { __builtin_amdgcn_s_sleep(1); \
    if ((++_sp & 255u) == 0u) { if (xb_ld(&(bar)[XB_TMO])) break; if (_sp > XB_SPIN_CAP) { atomicAdd(&(bar)[XB_TMO], 1u); break; } } } } while (0)

struct XcdBarrier {
    unsigned* bar; unsigned x;
    volatile LAS unsigned* st;
};

__device__ __forceinline__ XcdBarrier xcd_barrier_post(unsigned* bar, volatile LAS unsigned* st) {
    XcdBarrier b; b.bar = bar; b.x = xb_xcc_id(); b.st = st;
    if (threadIdx.x == 0) (void)xb_add(&bar[XB_XCNT(b.x)], 1u);
    return b;
}
__device__ __forceinline__ void xcd_barrier_complete(unsigned* bar, unsigned x, unsigned& nloc, unsigned& nx) {
    const unsigned G = gridDim.x * gridDim.y * gridDim.z;
    unsigned sum, cnt, mine, sp = 0u;
    for (;;) {
        sum = 0u; cnt = 0u; mine = 0u;
#pragma unroll
        for (unsigned j = 0; j < 16; ++j) { const unsigned c = xb_ld(&bar[XB_XCNT(j)]); sum += c; cnt += (c > 0u) ? 1u : 0u; mine = (j == x) ? c : mine; }
        if (sum == G) break;
        __builtin_amdgcn_s_sleep(1);
        if ((++sp & 255u) == 0u) { if (xb_ld(&bar[XB_TMO])) break; if (sp > XB_SPIN_CAP) { atomicAdd(&bar[XB_TMO], 1u); break; } }
    }
    nloc = mine > 0u ? mine : 1u; nx = cnt > 0u ? cnt : 1u;
}

__device__ __forceinline__ void xcd_barrier(const XcdBarrier& b) {
    asm volatile("s_waitcnt vmcnt(0)" ::: "memory");
    __syncthreads();
    if (threadIdx.x == 0) {
        unsigned* bar = b.bar;
        __builtin_amdgcn_s_waitcnt(0);
        unsigned nloc = b.st[0], nx = b.st[1];
        if (nloc == 0u) { xcd_barrier_complete(bar, b.x, nloc, nx); b.st[0] = nloc; b.st[1] = nx; }
        const unsigned old = xb_add(&bar[XB_XSUB(b.x)], 1u);
        const unsigned gen = old / nloc;
        if (old + 1u == (gen + 1u) * nloc) {
            __builtin_amdgcn_fence(__ATOMIC_RELEASE, "agent");
            asm volatile("s_waitcnt vmcnt(0)" ::: "memory");
            const unsigned og = xb_add(&bar[XB_TOP], 1u);
            const unsigned tg = og / nx;
            if (og + 1u == (tg + 1u) * nx) xb_add(&bar[XB_TOPGEN], 1u);
            else XB_SPIN(xb_ld(&bar[XB_TOPGEN]) == tg, bar);
            __builtin_amdgcn_fence(__ATOMIC_ACQUIRE, "agent");
            xb_add(&bar[XB_XGEN(b.x)], 1u);
            asm volatile("s_waitcnt vmcnt(0)" ::: "memory");
        } else {
            XB_SPIN(xb_ld(&bar[XB_XGEN(b.x)]) == gen, bar);
            __builtin_amdgcn_fence(__ATOMIC_ACQUIRE, "agent");
            asm volatile("s_waitcnt vmcnt(0)" ::: "memory");
        }
    }
    __syncthreads();
}


template <bool UPMAP> __device__ __forceinline__ void p0_transpose_item(const float* W, int K, int N, bf16* WT, const float* ks, LAS float* scr, int item, int lane) {
    const int nblk = N / 64, kb = item / nblk, nb = item % nblk, k0 = 64 * kb, n0 = 64 * nb;
    const int r0 = !UPMAP ? n0 : (n0 < DFF ? 256 * (n0 / 128) + (n0 % 128) : 256 * ((n0 - DFF) / 128) + 128 + ((n0 - DFF) % 128));
    f32x4 v[16];
    const float* src = W + (size_t)(k0 + (lane >> 4)) * N + n0 + 4 * (lane & 15);
#pragma unroll
    for (int i = 0; i < 16; ++i) v[i] = *(const f32x4*)(src + (size_t)(4 * i) * N);
#pragma unroll
    for (int i = 0; i < 16; ++i) { f32x4 t = v[i]; if (ks) t = t * ks[k0 + 4 * i + (lane >> 4)];
        *(LAS f32x4*)(scr + (4 * i + (lane >> 4)) * 64 + (((lane & 15) ^ ((i >> 1) & 7)) << 2)) = t; }
    LDS_WAIT(); asm volatile("" ::: "memory");
    const int c = lane & 7;
#pragma unroll
    for (int j = 0; j < 8; ++j) { const int nn = (lane >> 3) + 8 * j; const LAS float* sp = scr + (8 * c) * 64 + ((((nn >> 2) ^ c) & 15) << 2) + (nn & 3);
        u32x4 o; o.x = pk2(sp[0 * 64], sp[1 * 64]); o.y = pk2(sp[2 * 64], sp[3 * 64]); o.z = pk2(sp[4 * 64], sp[5 * 64]); o.w = pk2(sp[6 * 64], sp[7 * 64]);
        *(u32x4*)(WT + (size_t)(r0 + nn) * K + k0 + 8 * c) = o; }
    LDS_WAIT(); asm volatile("" ::: "memory");
}
__device__ __forceinline__ void rms_rows2_to_bf16(const float* xa, const float* xb, const float* g, bf16* oa, bf16* ob, int lane) {
    const f32x4* pa = (const f32x4*)xa + lane; const f32x4* pb = (const f32x4*)xb + lane; const f32x4* gr = (const f32x4*)g + lane;
    f32x4 va[8], vb[8]; float sa = 0.f, sb = 0.f;
#pragma unroll
    for (int j = 0; j < 8; ++j) { va[j] = pa[64 * j]; vb[j] = pb[64 * j]; }
#pragma unroll
    for (int j = 0; j < 8; ++j) { sa += (va[j].x * va[j].x + va[j].y * va[j].y) + (va[j].z * va[j].z + va[j].w * va[j].w); sb += (vb[j].x * vb[j].x + vb[j].y * vb[j].y) + (vb[j].z * vb[j].z + vb[j].w * vb[j].w); }
    const float ra = 1.0f / sqrtf(wave_sum(sa) * (1.0f / DMODEL) + EPS), rb = 1.0f / sqrtf(wave_sum(sb) * (1.0f / DMODEL) + EPS);
    u32x2* qa = (u32x2*)oa + lane; u32x2* qb = (u32x2*)ob + lane;
#pragma unroll
    for (int j = 0; j < 8; ++j) { const f32x4 gg = gr[64 * j]; u32x2 w;
        w.x = pk2(va[j].x * ra * gg.x, va[j].y * ra * gg.y); w.y = pk2(va[j].z * ra * gg.z, va[j].w * ra * gg.w); qa[64 * j] = w;
        w.x = pk2(vb[j].x * rb * gg.x, vb[j].y * rb * gg.y); w.y = pk2(vb[j].z * rb * gg.z, vb[j].w * rb * gg.w); qb[64 * j] = w; }
}

struct Ptrs {
    const float *x, *mem, *g_mix, *g_mem, *w_in, *conv_w, *pool_w, *pool_scale, *w_kv, *w_out, *g_ffn, *w_up, *ffn_conv_w, *ffn_conv_b, *w_down, *g_final;
    float* out; unsigned char* ws;
};

constexpr int UP_ITEMS = (DMODEL / 64) * (DFF2 / 64), DN_ITEMS = (DFF / 64) * (DMODEL / 64);
#ifndef UP_IN_P0
#define UP_IN_P0 2560
#endif
__device__ __forceinline__ void p1_idle_work(const Ptrs& P, LAS unsigned char* lds, int iw, int NIW, int wave, int lane);
__device__ __forceinline__ void p0_prologue(const Ptrs& P, LAS unsigned char* lds, int gw, int NGW, int wave, int lane) {
    LAS float* scr = (LAS float*)(lds + wave * 16384);
    unsigned char* ws = P.ws;
    constexpr int I_IN = (DMODEL / 64) * (DIN / 64), I_OUT = (DMODEL / 64) * (DMODEL / 64), I_UP = (DMODEL / 64) * (DFF2 / 64), I_DN = (DFF / 64) * (DMODEL / 64),
                  I_KV = (DMODEL / 64) * (1024 / 64), I_PW = (PGD / 64) * (PGD / 64);
    constexpr int NITEMS = I_IN + I_OUT + UP_IN_P0 + I_KV + 4 * I_PW;
    for (int it = gw; it < NITEMS; it += NGW) {
        int r = it;
        if (r < I_IN) { p0_transpose_item<false>(P.w_in, DMODEL, DIN, (bf16*)(ws + WS_WINT), nullptr, scr, r, lane); continue; } r -= I_IN;
        if (r < I_OUT) { p0_transpose_item<false>(P.w_out, DMODEL, DMODEL, (bf16*)(ws + WS_WOUTT), nullptr, scr, r, lane); continue; } r -= I_OUT;
        if (r < UP_IN_P0) { p0_transpose_item<true>(P.w_up, DMODEL, DFF2, (bf16*)(ws + WS_WUPT), P.g_ffn, scr, r, lane); continue; } r -= UP_IN_P0;
        if (r < I_KV) { p0_transpose_item<false>(P.w_kv, DMODEL, 1024, (bf16*)(ws + WS_WKVT), nullptr, scr, r, lane); continue; } r -= I_KV;
        const int g = r / I_PW; r -= g * I_PW;
        p0_transpose_item<false>(P.pool_w + (size_t)g * PGD * PGD, PGD, PGD, (bf16*)(ws + WS_POOLWT) + (size_t)g * PGD * PGD, nullptr, scr, r, lane);
    }
    for (int i = gw * 64 + lane; i < 16 * DIN * 2 / 16; i += NGW * 64) ((u32x4*)(ws + WS_ZPAD))[i] = (u32x4){0u, 0u, 0u, 0u};
    for (int m = 2 * gw; m < SEQ; m += 2 * NGW) rms_rows2_to_bf16(P.x + (size_t)m * DMODEL, P.x + (size_t)(m + 1) * DMODEL, P.g_mix, (bf16*)(ws + WS_H) + (size_t)m * DMODEL, (bf16*)(ws + WS_H) + (size_t)(m + 1) * DMODEL, lane);
    for (int m = 2 * gw; m < NMEM; m += 2 * NGW) rms_rows2_to_bf16(P.mem + (size_t)m * DMODEL, P.mem + (size_t)(m + 1) * DMODEL, P.g_mem, (bf16*)(ws + WS_MB) + (size_t)m * DMODEL, (bf16*)(ws + WS_MB) + (size_t)(m + 1) * DMODEL, lane);
}

__device__ __forceinline__ void kv_tile(const Ptrs& P, int tt, int lane) {
    const bf16* mB = (const bf16*)(P.ws + WS_MB); const bf16* wT = (const bf16*)(P.ws + WS_WKVT);
    const int rb = tt >> 6, cb = tt & 63, fr = lane & 15, fq = lane >> 4;
    const bf16* ap = mB + (size_t)(16 * rb + fr) * DMODEL + 8 * fq; const bf16* wp = wT + (size_t)(16 * cb + fr) * DMODEL + 8 * fq;
    f32x4 acc = {0.f, 0.f, 0.f, 0.f};
    if (cb < 32) {
#pragma unroll 8
        for (int ks = 0; ks < 64; ++ks) { const bf16x8 a = *(const bf16x8*)(ap + 32 * ks), w = *(const bf16x8*)(wp + 32 * ks); acc = __builtin_amdgcn_mfma_f32_16x16x32_bf16(w, a, acc, 0, 0, 0); }
        u32x2 o; o.x = pk2(acc[0], acc[1]); o.y = pk2(acc[2], acc[3]);
        *(u32x2*)((bf16*)(P.ws + WS_KB) + (size_t)(16 * rb + fr) * 512 + 16 * cb + 4 * fq) = o;
    } else {
#pragma unroll 8
        for (int ks = 0; ks < 64; ++ks) { const bf16x8 a = *(const bf16x8*)(ap + 32 * ks), w = *(const bf16x8*)(wp + 32 * ks); acc = __builtin_amdgcn_mfma_f32_16x16x32_bf16(a, w, acc, 0, 0, 0); }
        u32x2 o; o.x = pk2(acc[0], acc[1]); o.y = pk2(acc[2], acc[3]);
        *(u32x2*)((bf16*)(P.ws + WS_VT) + (size_t)(16 * cb - 512 + fr) * 256 + 32 * (rb >> 1) + 8 * fq + 4 * (rb & 1)) = o;
    }
}

__device__ __forceinline__ void p1_idle_work(const Ptrs& P, LAS unsigned char* lds, int iw, int NIW, int wave, int lane) {
    LAS float* scr = (LAS float*)(lds + wave * 16384);
    for (int tt = iw; tt < 1024; tt += NIW) kv_tile(P, tt, lane);
    constexpr int NEXTRA = DN_ITEMS + (UP_ITEMS - UP_IN_P0);
    for (int it = iw; it < NEXTRA; it += NIW) {
        if (it < DN_ITEMS) p0_transpose_item<false>(P.w_down, DFF, DMODEL, (bf16*)(P.ws + WS_WDOWNT), nullptr, scr, it, lane);
        else p0_transpose_item<true>(P.w_up, DMODEL, DFF2, (bf16*)(P.ws + WS_WUPT), P.g_ffn, scr, UP_IN_P0 + it - DN_ITEMS, lane);
    }
}

__device__ __forceinline__ void mix_conv_task(const Ptrs& P, int blk, int lane, int cg0, int cg1) {
    const bf16* z = (const bf16*)(P.ws + WS_Z); bf16* mix = (bf16*)(P.ws + WS_MIX);
    const int t0 = blk * 16;
    for (int cg = cg0 + lane; cg < cg1; cg += 64) {
        const int c = cg * 8;
        float w0[8], w1[8], w2[8], p1[8], p2[8];
#pragma unroll
        for (int e = 0; e < 8; ++e) { w0[e] = P.conv_w[c + e]; w1[e] = P.conv_w[DCONV + c + e]; w2[e] = P.conv_w[2 * DCONV + c + e]; }
        { float a[8], b[8]; unpack8(*(const u32x4*)(z + (long)(t0 - 2) * DIN + DCONV + c), a); unpack8(*(const u32x4*)(z + (long)(t0 - 2) * DIN + 2 * DCONV + c), b);
#pragma unroll
          for (int e = 0; e < 8; ++e) p2[e] = a[e] * b[e];
          unpack8(*(const u32x4*)(z + (long)(t0 - 1) * DIN + DCONV + c), a); unpack8(*(const u32x4*)(z + (long)(t0 - 1) * DIN + 2 * DCONV + c), b);
#pragma unroll
          for (int e = 0; e < 8; ++e) p1[e] = a[e] * b[e]; }
#pragma unroll 4
        for (int r = 0; r < 16; ++r) {
            const int t = t0 + r; float p[8], a[8], b[8], g[8], o[8];
            unpack8(*(const u32x4*)(z + (size_t)t * DIN + DCONV + c), a); unpack8(*(const u32x4*)(z + (size_t)t * DIN + 2 * DCONV + c), b); unpack8(*(const u32x4*)(z + (size_t)t * DIN + c), g);
#pragma unroll
            for (int e = 0; e < 8; ++e) { p[e] = a[e] * b[e]; o[e] = g[e] * (w2[e] * p[e] + w1[e] * p1[e] + w0[e] * p2[e]); p2[e] = p1[e]; p1[e] = p[e]; }
            *(u32x4*)(mix + (size_t)t * DMODEL + c) = pack8(o);
        }
    }
}
template <int g> __device__ __forceinline__ void mix_pool_task(const Ptrs& P, int blk, int lane) {
    constexpr int k = 2 << g;
    const char* zu = (const char*)((const bf16*)(P.ws + WS_Z) + (size_t)(blk * 16) * DIN + 3 * DCONV + PGD * g);
    const char* wu = (const char*)((const bf16*)(P.ws + WS_POOLWT) + (size_t)g * PGD * PGD);
    bf16* mix = (bf16*)(P.ws + WS_MIX);
    const int fr = lane & 15, fq = lane >> 4, t = blk * 16 + fr;
    const unsigned zl = (unsigned)(fr * DIN + 8 * fq) * 2u, wl = (unsigned)(fr * PGD + 8 * fq) * 2u;
    const int cnt = (t + 1 < k) ? t + 1 : k; const float inv = 1.0f / (float)cnt;
    f32x4 acc[12];
#pragma unroll
    for (int n = 0; n < 12; ++n) acc[n] = (f32x4){0.f, 0.f, 0.f, 0.f};
#pragma unroll 1
    for (int ks = 0; ks < 6; ++ks) {
        float sum[8], self[8];
        unpack8(*(const u32x4*)(zu + ks * 64 + zl), self);
#pragma unroll
        for (int e = 0; e < 8; ++e) sum[e] = self[e];
#pragma unroll
        for (int j = 1; j < k; ++j) { float v[8]; unpack8(*(const u32x4*)(zu + ks * 64 - (long)j * (DIN * 2) + zl), v);
#pragma unroll
            for (int e = 0; e < 8; ++e) sum[e] += v[e]; }
        float pl[8];
#pragma unroll
        for (int e = 0; e < 8; ++e) pl[e] = sum[e] * inv - self[e];
        const bf16x8 pf = __builtin_bit_cast(bf16x8, pack8(pl));
#pragma unroll
        for (int n = 0; n < 12; ++n) { const bf16x8 wf = *(const bf16x8*)(wu + n * (16 * PGD * 2) + ks * 64 + wl); acc[n] = __builtin_amdgcn_mfma_f32_16x16x32_bf16(wf, pf, acc[n], 0, 0, 0); }
    }
#pragma unroll
    for (int n = 0; n < 12; ++n) { const int d = 16 * n + 4 * fq; const f32x4 sc = *(const f32x4*)(P.pool_scale + PGD * g + d);
        u32x2 o; o.x = pk2(acc[n][0] * sc[0], acc[n][1] * sc[1]); o.y = pk2(acc[n][2] * sc[2], acc[n][3] * sc[3]);
        *(u32x2*)(mix + (size_t)t * DMODEL + DCONV + PGD * g + d) = o; }
}
__device__ __forceinline__ void mix_attn_task(const Ptrs& P, int h, int blk, int lane) {
    const bf16* z = (const bf16*)(P.ws + WS_Z); bf16* mix = (bf16*)(P.ws + WS_MIX); const bf16* Kb = (const bf16*)(P.ws + WS_KB); const bf16* Vt = (const bf16*)(P.ws + WS_VT);
    const int fr = lane & 15, fq = lane >> 4, t = blk * 16 + fr;
    bf16x8 qf[4];
#pragma unroll
    for (int ks = 0; ks < 4; ++ks) qf[ks] = *(const bf16x8*)(z + (size_t)t * DIN + 3 * DCONV + DPOOL + 128 * h + 32 * ks + 8 * fq);
    f32x4 s[16];
#pragma unroll
    for (int kb = 0; kb < 16; ++kb) { s[kb] = (f32x4){0.f, 0.f, 0.f, 0.f};
#pragma unroll
        for (int ks = 0; ks < 4; ++ks) { const bf16x8 kf = *(const bf16x8*)(Kb + (size_t)(16 * kb + fr) * 512 + 128 * h + 32 * ks + 8 * fq); s[kb] = __builtin_amdgcn_mfma_f32_16x16x32_bf16(kf, qf[ks], s[kb], 0, 0, 0); } }
    float mx = -3.0e38f;
#pragma unroll
    for (int kb = 0; kb < 16; ++kb) mx = fmaxf(fmaxf(fmaxf(s[kb][0], s[kb][1]), fmaxf(s[kb][2], s[kb][3])), mx);
    mx = fmaxf(mx, __shfl_xor(mx, 16)); mx = fmaxf(mx, __shfl_xor(mx, 32));
    const float c2 = 0.08838834764831845f * 1.4426950408889634f;
    float sum = 0.f;
#pragma unroll
    for (int kb = 0; kb < 16; ++kb)
#pragma unroll
        for (int r = 0; r < 4; ++r) { const float p = __builtin_amdgcn_exp2f((s[kb][r] - mx) * c2); s[kb][r] = p; sum += p; }
    sum += __shfl_xor(sum, 16); sum += __shfl_xor(sum, 32);
    const float inv = 1.0f / sum;
    f32x4 o[8];
#pragma unroll
    for (int db = 0; db < 8; ++db) o[db] = (f32x4){0.f, 0.f, 0.f, 0.f};
#pragma unroll
    for (int ks = 0; ks < 8; ++ks) {
        u32x4 pw; pw.x = pk2(s[2 * ks][0], s[2 * ks][1]); pw.y = pk2(s[2 * ks][2], s[2 * ks][3]); pw.z = pk2(s[2 * ks + 1][0], s[2 * ks + 1][1]); pw.w = pk2(s[2 * ks + 1][2], s[2 * ks + 1][3]);
        const bf16x8 pf = __builtin_bit_cast(bf16x8, pw);
#pragma unroll
        for (int db = 0; db < 8; ++db) { const bf16x8 vf = *(const bf16x8*)(Vt + (size_t)(128 * h + 16 * db + fr) * 256 + 32 * ks + 8 * fq); o[db] = __builtin_amdgcn_mfma_f32_16x16x32_bf16(vf, pf, o[db], 0, 0, 0); }
    }
#pragma unroll
    for (int db = 0; db < 8; ++db) { u32x2 w; w.x = pk2(o[db][0] * inv, o[db][1] * inv); w.y = pk2(o[db][2] * inv, o[db][3] * inv);
        *(u32x2*)(mix + (size_t)t * DMODEL + DCONV + DPOOL + 128 * h + 16 * db + 4 * fq) = w; }
}
template <int R, int C, int PCH> __device__ __forceinline__ void lds_stage_rows(LAS unsigned char* dst, const unsigned char* src, int gp, int tid) {
    constexpr int N = R * C, PER = (N + 511) / 512;
    u32x4 v[PER];
#pragma unroll
    for (int i = 0; i < PER; ++i) { const int idx = tid + 512 * i; if (idx < N) { const int row = idx / C, ch = idx % C; v[i] = *(const u32x4*)(src + (size_t)row * gp + ch * 16); } }
#pragma unroll
    for (int i = 0; i < PER; ++i) { const int idx = tid + 512 * i; if (idx < N) { const int row = idx / C, ch = idx % C; *(LAS u32x4*)(dst + row * (PCH * 16) + (((ch & ~15) | ((ch & 15) ^ (row & 15))) << 4)) = v[i]; } }
}
template <int N> __device__ __forceinline__ float dpp_shrN(float old, float src) { return __builtin_bit_cast(float, __builtin_amdgcn_update_dpp(__builtin_bit_cast(int, old), __builtin_bit_cast(int, src), 0x110 + N, 0xf, 0xf, false)); }
template <int N> __device__ __forceinline__ float dpp_rorN(float src) { return __builtin_bit_cast(float, __builtin_amdgcn_mov_dpp(__builtin_bit_cast(int, src), 0x120 + N, 0xf, 0xf, false)); }
template <int N> __device__ __forceinline__ float scan_step(float x, float p) { return x + dpp_shrN<N>(dpp_rorN<N>(p), x); }
template <int N> __device__ __forceinline__ float scan_step_prev(float p) { return p + dpp_shrN<N>(0.f, p); }

__device__ __forceinline__ void mix_attn_wave(const Ptrs& P, LAS unsigned char* ldsK, LAS unsigned char* ldsV, int h, int row0, int lane) {
    const bf16* z = (const bf16*)(P.ws + WS_Z); bf16* mix = (bf16*)(P.ws + WS_MIX);
    const int fr = lane & 15, fq = lane >> 4;
    bf16x8 q0[4], q1[4];
#pragma unroll
    for (int ks = 0; ks < 4; ++ks) { const bf16* qp = z + (size_t)(row0 + fr) * DIN + 3 * DCONV + DPOOL + 128 * h + 32 * ks + 8 * fq; q0[ks] = *(const bf16x8*)qp; q1[ks] = *(const bf16x8*)(qp + 16 * DIN); }
    unsigned offk[4];
#pragma unroll
    for (int ks = 0; ks < 4; ++ks) offk[ks] = (unsigned)(fr * 256 + (((4 * ks + fq) ^ fr) << 4));
    f32x4 s0[16], s1[16];
#pragma unroll
    for (int kb = 0; kb < 16; ++kb) { s0[kb] = (f32x4){0.f, 0.f, 0.f, 0.f}; s1[kb] = (f32x4){0.f, 0.f, 0.f, 0.f};
#pragma unroll
        for (int ks = 0; ks < 4; ++ks) { const bf16x8 kf = *(const LAS bf16x8*)(ldsK + kb * 4096 + offk[ks]);
            s0[kb] = __builtin_amdgcn_mfma_f32_16x16x32_bf16(kf, q0[ks], s0[kb], 0, 0, 0); s1[kb] = __builtin_amdgcn_mfma_f32_16x16x32_bf16(kf, q1[ks], s1[kb], 0, 0, 0); } }
    const float c2 = 0.08838834764831845f * 1.4426950408889634f;
    bf16x8 p0[8], p1[8]; float inv0, inv1;
    {   float mx = -3.0e38f;
#pragma unroll
        for (int kb = 0; kb < 16; ++kb) mx = fmaxf(fmaxf(fmaxf(s0[kb][0], s0[kb][1]), fmaxf(s0[kb][2], s0[kb][3])), mx);
        mx = fmaxf(mx, __shfl_xor(mx, 16)); mx = fmaxf(mx, __shfl_xor(mx, 32));
        float sum = 0.f;
#pragma unroll
        for (int ks = 0; ks < 8; ++ks) { float e[8];
#pragma unroll
            for (int r = 0; r < 4; ++r) { e[r] = __builtin_amdgcn_exp2f((s0[2 * ks][r] - mx) * c2); e[4 + r] = __builtin_amdgcn_exp2f((s0[2 * ks + 1][r] - mx) * c2); }
            sum += ((e[0] + e[1]) + (e[2] + e[3])) + ((e[4] + e[5]) + (e[6] + e[7]));
            p0[ks] = __builtin_bit_cast(bf16x8, pack8(e)); }
        sum += __shfl_xor(sum, 16); sum += __shfl_xor(sum, 32); inv0 = 1.0f / sum; }
    {   float mx = -3.0e38f;
#pragma unroll
        for (int kb = 0; kb < 16; ++kb) mx = fmaxf(fmaxf(fmaxf(s1[kb][0], s1[kb][1]), fmaxf(s1[kb][2], s1[kb][3])), mx);
        mx = fmaxf(mx, __shfl_xor(mx, 16)); mx = fmaxf(mx, __shfl_xor(mx, 32));
        float sum = 0.f;
#pragma unroll
        for (int ks = 0; ks < 8; ++ks) { float e[8];
#pragma unroll
            for (int r = 0; r < 4; ++r) { e[r] = __builtin_amdgcn_exp2f((s1[2 * ks][r] - mx) * c2); e[4 + r] = __builtin_amdgcn_exp2f((s1[2 * ks + 1][r] - mx) * c2); }
            sum += ((e[0] + e[1]) + (e[2] + e[3])) + ((e[4] + e[5]) + (e[6] + e[7]));
            p1[ks] = __builtin_bit_cast(bf16x8, pack8(e)); }
        sum += __shfl_xor(sum, 16); sum += __shfl_xor(sum, 32); inv1 = 1.0f / sum; }
    f32x4 o0[8], o1[8];
#pragma unroll
    for (int db = 0; db < 8; ++db) { o0[db] = (f32x4){0.f, 0.f, 0.f, 0.f}; o1[db] = (f32x4){0.f, 0.f, 0.f, 0.f}; }
#pragma unroll
    for (int ks = 0; ks < 8; ++ks) {
        const unsigned offv = (unsigned)(fr * 512 + ((ks >> 2) << 8) + (((4 * (ks & 3) + fq) ^ fr) << 4));
#pragma unroll
        for (int db = 0; db < 8; ++db) { const bf16x8 vf = *(const LAS bf16x8*)(ldsV + db * 8192 + offv);
            o0[db] = __builtin_amdgcn_mfma_f32_16x16x32_bf16(vf, p0[ks], o0[db], 0, 0, 0); o1[db] = __builtin_amdgcn_mfma_f32_16x16x32_bf16(vf, p1[ks], o1[db], 0, 0, 0); } }
    bf16* op = mix + (size_t)(row0 + fr) * DMODEL + DCONV + DPOOL + 128 * h + 4 * fq;
#pragma unroll
    for (int db = 0; db < 8; ++db) { u32x2 w; w.x = pk2(o0[db][0] * inv0, o0[db][1] * inv0); w.y = pk2(o0[db][2] * inv0, o0[db][3] * inv0); *(u32x2*)(op + 16 * db) = w;
        w.x = pk2(o1[db][0] * inv1, o1[db][1] * inv1); w.y = pk2(o1[db][2] * inv1, o1[db][3] * inv1); *(u32x2*)(op + (size_t)16 * DMODEL + 16 * db) = w; }
}

template <int g> __device__ __forceinline__ void mix_pool_wave(const Ptrs& P, LAS unsigned char* ldsW, int row0, int lane) {
    constexpr int k = 2 << g;
    const bf16* z = (const bf16*)(P.ws + WS_Z); bf16* mix = (bf16*)(P.ws + WS_MIX);
    const int fr = lane & 15, fq = lane >> 4;
    f32x4 acc0[12], acc1[12];
#pragma unroll
    for (int n = 0; n < 12; ++n) { acc0[n] = (f32x4){0.f, 0.f, 0.f, 0.f}; acc1[n] = (f32x4){0.f, 0.f, 0.f, 0.f}; }
    const float invA = 1.0f / (float)((row0 + fr + 1 < k) ? row0 + fr + 1 : k), invB = 1.0f / (float)((row0 + 16 + fr + 1 < k) ? row0 + 16 + fr + 1 : k);
#pragma unroll 1
    for (int ks = 0; ks < 6; ++ks) {
        const bf16* zp = z + (long)(row0 - 16 + fr) * DIN + 3 * DCONV + PGD * g + 32 * ks + 8 * fq;
        float pv[8], xa[8], xb[8], sa[8], sb[8];
        unpack8(*(const u32x4*)zp, pv); unpack8(*(const u32x4*)(zp + 16 * DIN), xa); unpack8(*(const u32x4*)(zp + 32 * DIN), xb);
#pragma unroll
        for (int e = 0; e < 8; ++e) {
            float p = pv[e], a = xa[e], b = xb[e];
            float b1 = scan_step<1>(b, a), a1 = scan_step<1>(a, p), p1 = scan_step_prev<1>(p);
            if (k >= 4) { const float b2 = scan_step<2>(b1, a1), a2 = scan_step<2>(a1, p1), p2 = scan_step_prev<2>(p1); b1 = b2; a1 = a2; p1 = p2; }
            if (k >= 8) { const float b2 = scan_step<4>(b1, a1), a2 = scan_step<4>(a1, p1), p2 = scan_step_prev<4>(p1); b1 = b2; a1 = a2; p1 = p2; }
            if (k >= 16) { const float b2 = scan_step<8>(b1, a1), a2 = scan_step<8>(a1, p1); b1 = b2; a1 = a2; }
            sa[e] = a1 * invA - a; sb[e] = b1 * invB - b; }
        const bf16x8 fa = __builtin_bit_cast(bf16x8, pack8(sa)), fb = __builtin_bit_cast(bf16x8, pack8(sb));
        const unsigned offw = (unsigned)(fr * 512 + ((ks >> 2) << 8) + (((4 * (ks & 3) + fq) ^ fr) << 4));
#pragma unroll
        for (int n = 0; n < 12; ++n) { const bf16x8 wf = *(const LAS bf16x8*)(ldsW + n * 8192 + offw);
            acc0[n] = __builtin_amdgcn_mfma_f32_16x16x32_bf16(wf, fa, acc0[n], 0, 0, 0); acc1[n] = __builtin_amdgcn_mfma_f32_16x16x32_bf16(wf, fb, acc1[n], 0, 0, 0); }
    }
    bf16* op = mix + (size_t)(row0 + fr) * DMODEL + DCONV + PGD * g + 4 * fq;
#pragma unroll
    for (int n = 0; n < 12; ++n) { const f32x4 sc = *(const f32x4*)(P.pool_scale + PGD * g + 16 * n + 4 * fq);
        u32x2 o; o.x = pk2(acc0[n][0] * sc[0], acc0[n][1] * sc[1]); o.y = pk2(acc0[n][2] * sc[2], acc0[n][3] * sc[3]); *(u32x2*)(op + 16 * n) = o;
        o.x = pk2(acc1[n][0] * sc[0], acc1[n][1] * sc[1]); o.y = pk2(acc1[n][2] * sc[2], acc1[n][3] * sc[3]); *(u32x2*)(op + (size_t)16 * DMODEL + 16 * n) = o; }
}

__device__ __forceinline__ void p2_mixer(const Ptrs& P, LAS unsigned char* lds, int w, int tid, int wave, int lane, int tmask) {
    const int sub = w & 3, tile = w >> 2, row0 = tile * 256 + (wave & 3) * 64;
    lds_stage_rows<256, 16, 16>(lds, (const unsigned char*)(P.ws + WS_KB) + 256 * sub, 1024, tid);
    lds_stage_rows<128, 32, 32>(lds + 65536, (const unsigned char*)(P.ws + WS_VT) + (size_t)sub * 128 * 512, 512, tid);
    LDS_WAIT(); __syncthreads();
    if (wave < 4) { if (tmask & 0x1e0) {
#pragma unroll 1
        for (int p = 0; p < 2; ++p) { asm volatile("" ::: "memory"); mix_attn_wave(P, lds, lds + 65536, sub, row0 + 32 * p, lane); } } }
    else if (tmask & 1) mix_conv_task(P, 4 * w + (wave - 4), lane, 0, 48);
    __syncthreads();
    lds_stage_rows<192, 24, 32>(lds, (const unsigned char*)(P.ws + WS_POOLWT) + (size_t)sub * PGD * PGD * 2, PGD * 2, tid);
    LDS_WAIT(); __syncthreads();
    if (wave < 4) { if (tmask & 0x1e) {
#pragma unroll 1
        for (int p = 0; p < 2; ++p) { const int r = row0 + 32 * p; asm volatile("" ::: "memory");
            if (sub == 0) mix_pool_wave<0>(P, lds, r, lane); else if (sub == 1) mix_pool_wave<1>(P, lds, r, lane); else if (sub == 2) mix_pool_wave<2>(P, lds, r, lane); else mix_pool_wave<3>(P, lds, r, lane); } } }
    else if (tmask & 1) mix_conv_task(P, 4 * w + (wave - 4), lane, 48, 96);
    __syncthreads();
}

__device__ __forceinline__ void p5_fixup(const Ptrs& P, int gt, int NGT) {
    const float* ub = (const float*)(P.ws + WS_UBND); bf16* act = (bf16*)(P.ws + WS_ACT); const float* cw = P.ffn_conv_w; const float* cb = P.ffn_conv_b;
    for (int i = gt; i < 63 * (DFF / 8); i += NGT) {
        const int pm = 1 + i / (DFF / 8), c = (i % (DFF / 8)) * 8, gi = 256 * (c / 128) + (c % 128);
        const float* p2 = ub + (size_t)((pm - 1) * 4 + 2) * DFF2 + gi; const float* p1 = p2 + DFF2; const float* r0 = ub + (size_t)(pm * 4) * DFF2 + gi; const float* r1 = r0 + DFF2;
        float o0[8], o1[8];
#pragma unroll
        for (int e = 0; e < 8; ++e) {
            const float gw0 = cw[c + e], gw1 = cw[DFF2 + c + e], gw2 = cw[2 * DFF2 + c + e], gb = cb[c + e], vw0 = cw[DFF + c + e], vw1 = cw[DFF2 + DFF + c + e], vw2 = cw[2 * DFF2 + DFF + c + e], vb = cb[DFF + c + e];
            const float G0 = gw2 * r0[e] + (gw1 * p1[e] + (gw0 * p2[e] + gb)), V0 = vw2 * r0[128 + e] + (vw1 * p1[128 + e] + (vw0 * p2[128 + e] + vb));
            const float G1 = gw2 * r1[e] + (gw1 * r0[e] + (gw0 * p1[e] + gb)), V1 = vw2 * r1[128 + e] + (vw1 * r0[128 + e] + (vw0 * p1[128 + e] + vb));
            o0[e] = G0 * __builtin_amdgcn_rcpf(1.0f + __builtin_amdgcn_exp2f(-1.4426950408889634f * G0)) * V0;
            o1[e] = G1 * __builtin_amdgcn_rcpf(1.0f + __builtin_amdgcn_exp2f(-1.4426950408889634f * G1)) * V1; }
        *(u32x4*)(act + (size_t)(256 * pm) * DFF + c) = pack8(o0); *(u32x4*)(act + (size_t)(256 * pm + 1) * DFF + c) = pack8(o1);
    }
}

__device__ __forceinline__ void p7_final(const Ptrs& P, int gw, int NGW, int lane) {
    const float* slab = (const float*)(P.ws + WS_SLAB2);
    for (int m = gw; m < SEQ; m += NGW) {
        const float part = (lane < 32) ? slab[(size_t)m * 32 + lane] : 0.f;
        const float rstd = 1.0f / sqrtf(wave_sum(part) * (1.0f / DMODEL) + EPS);
        f32x4* xr = (f32x4*)(P.out + (size_t)m * DMODEL) + lane; const f32x4* gr = (const f32x4*)P.g_final + lane;
#pragma unroll
        for (int j = 0; j < 8; ++j) { f32x4 v = xr[64 * j]; const f32x4 gg = gr[64 * j]; v = v * rstd * gg; xr[64 * j] = v; }
    }
}

struct Args { const float* in[16]; float* out; unsigned char* ws; int ph_lo, ph_hi; };
__global__ void __launch_bounds__(NWAVES * 64, 2) hybrid_fwd(Args args) {
    extern __shared__ __attribute__((aligned(16))) unsigned char lds_raw[];
    LAS unsigned char* lds = (LAS unsigned char*)lds_raw;
    cg::grid_group grid = cg::this_grid();
    const int tid = threadIdx.x, lane = tid & 63, wave = __builtin_amdgcn_readfirstlane(tid >> 6);
    const int G = gridDim.x, bx = blockIdx.x, vcu = (G % 8 == 0) ? (bx % 8) * (G / 8) + bx / 8 : bx;
    const int gw = vcu * NWAVES + wave, NGW = G * NWAVES;
    volatile LAS unsigned* MISC = (volatile LAS unsigned*)(lds + MISC_OFF);
    if (tid < 32) MISC[tid] = 0u;
    __syncthreads();
    const XcdBarrier bar = xcd_barrier_post((unsigned*)(args.ws + WS_CTL), MISC + 8);
    Ptrs P;
    P.x = args.in[0]; P.mem = args.in[1]; P.g_mix = args.in[2]; P.g_mem = args.in[3]; P.w_in = args.in[4]; P.conv_w = args.in[5]; P.pool_w = args.in[6]; P.pool_scale = args.in[7];
    P.w_kv = args.in[8]; P.w_out = args.in[9]; P.g_ffn = args.in[10]; P.w_up = args.in[11]; P.ffn_conv_w = args.in[12]; P.ffn_conv_b = args.in[13]; P.w_down = args.in[14]; P.g_final = args.in[15];
    P.out = args.out; P.ws = args.ws;
    unsigned char* ws = args.ws;
#if PROBE_SYNC
    for (int i = 0; i < 20; ++i) xcd_barrier(bar);
#endif
    const int lo = args.ph_lo, hi = args.ph_hi;
#define IN(k) (lo <= (k) && (k) < hi)
#define SYNC(k) do { if ((k) + 1 < hi) { if ((k) == 0 && USE_CG_SYNC) grid.sync(); else xcd_barrier(bar); } } while (0)
#define SYNCR(k, b) do { if ((k) + 1 < hi || rp + 1 < NREP(b)) { if ((k) == 0 && USE_CG_SYNC) grid.sync(); else xcd_barrier(bar); } } while (0)
#define NREP(b) ((REPM & (b)) ? 2 : 1)
    if (IN(0) && (PHM & 1)) for (int rp = 0; rp < NREP(1); ++rp) { p0_prologue(P, lds, gw, NGW, wave, lane); SYNCR(0, 1); }
    if (IN(1) && (PHM & 2)) for (int rp = 0; rp < NREP(2); ++rp) {
        pg8::Gemm g{(const bf16*)(ws + WS_H), (const bf16*)(ws + WS_WINT), SEQ, DIN, DMODEL}; pg8::StaticOrder S; S.init(SEQ, DIN, G, bx);
        pg8::EpiZ E{(bf16*)(ws + WS_Z), DIN};
        pg8::gemm_phase<pg8::EpiZ, pg8::StaticOrder, P1_ALIGN, true>(lds, g, S, E, lds + XLDS_OFF);
        { const int nfull = ((SEQ / 256) * (DIN / 256)) % G;
          if (nfull == 0) p1_idle_work(P, lds, bx * NWAVES + wave, G * NWAVES, wave, lane);
          else if (bx >= nfull) p1_idle_work(P, lds, (bx - nfull) * NWAVES + wave, (G - nfull) * NWAVES, wave, lane); }
        SYNCR(1, 2);
    }
    if (IN(2) && (PHM & 4)) for (int rp = 0; rp < NREP(4); ++rp) { p2_mixer(P, lds, vcu, tid, wave, lane, 511);
#if PROBE_P2
        p2_mixer(P, lds, vcu, tid, wave, lane, PROBE_P2);
#endif
        SYNCR(2, 4); }
    if (IN(3) && (PHM & 8)) {
        pg8::Gemm g{(const bf16*)(ws + WS_MIX), (const bf16*)(ws + WS_WOUTT), SEQ, DMODEL, DMODEL}; pg8::PanelOrder S{G, vcu, (SEQ / 256) * (DMODEL / 256)};
        pg8::EpiNorm<0> E{P.x, nullptr, nullptr, (float*)(ws + WS_SIG), (bf16*)(ws + WS_X1B), nullptr, nullptr, (unsigned*)(ws + WS_SLAB1), (unsigned*)(ws + WS_CTL) + CW_PANEL1, (unsigned*)(ws + WS_CTL) + XB_TMO};
        pg8::gemm_phase<pg8::EpiNorm<0>, pg8::PanelOrder, true, true>(lds, g, S, E, lds + XLDS_OFF);
        SYNC(3);
    }
#if PROBE_GEMM
    if (IN(3)) {
        pg8::Gemm g{(const bf16*)(ws + WS_X1B), (const bf16*)(ws + WS_WUPT), SEQ, PROBE_N, DMODEL}; pg8::StaticOrder S; S.init(SEQ, PROBE_N, G, bx);
#if PROBE_GEMM == 1
        pg8::EpiZ E{(bf16*)(ws + WS_Z), PROBE_N};
        pg8::gemm_phase<pg8::EpiZ, pg8::StaticOrder, true, true>(lds, g, S, E, lds + XLDS_OFF);
#elif PROBE_GEMM == 2
        pg8::EpiNone E{};
        pg8::gemm_phase<pg8::EpiNone, pg8::StaticOrder, true, true>(lds, g, S, E, lds + XLDS_OFF);
#elif PROBE_GEMM == 3
        pg8::EpiZ E{(bf16*)(ws + WS_Z), PROBE_N};
        pg8::gemm_phase<pg8::EpiZ, pg8::StaticOrder, true, false>(lds, g, S, E, lds + XLDS_OFF);
#elif PROBE_GEMM == 5
        pg8::EpiAct E{(bf16*)(ws + WS_ACT), P.ffn_conv_w, P.ffn_conv_b, (float*)(ws + WS_UBND)};
        pg8::gemm_phase<pg8::EpiAct, pg8::StaticOrder, true, true>(lds, g, S, E, lds + XLDS_OFF);
#elif PROBE_GEMM == 4
        pg8::EpiZ E{(bf16*)(ws + WS_Z), PROBE_N};
        pg8::gemm_phase<pg8::EpiZ, pg8::StaticOrder, false, true>(lds, g, S, E, lds + XLDS_OFF);
#endif
        xcd_barrier(bar);
    }
#endif
    if (IN(4) && (PHM & 16)) for (int rp = 0; rp < NREP(16); ++rp) {
        pg8::Gemm g{(const bf16*)(ws + WS_X1B), (const bf16*)(ws + WS_WUPT), SEQ, DFF2, DMODEL}; pg8::StaticOrder S; S.init(SEQ, DFF2, G, bx);
        pg8::EpiAct E{(bf16*)(ws + WS_ACT), P.ffn_conv_w, P.ffn_conv_b, (float*)(ws + WS_UBND)};
        pg8::gemm_phase<pg8::EpiAct, pg8::StaticOrder, true, true>(lds, g, S, E, lds + XLDS_OFF);
        SYNCR(4, 16);
    }
    if (IN(5) && (PHM & 32)) { p5_fixup(P, vcu * (NWAVES * 64) + tid, G * NWAVES * 64); SYNC(5); }
    if (IN(6) && (PHM & 64)) {
        pg8::Gemm g{(const bf16*)(ws + WS_ACT), (const bf16*)(ws + WS_WDOWNT), SEQ, DMODEL, DFF}; pg8::PanelOrder S{G, vcu, (SEQ / 256) * (DMODEL / 256)};
        pg8::EpiNorm<1> E{nullptr, (const bf16*)(ws + WS_X1B), (const float*)(ws + WS_SIG), nullptr, nullptr, P.out, P.g_final, (unsigned*)(ws + WS_SLAB2), (unsigned*)(ws + WS_CTL) + CW_PANEL, (unsigned*)(ws + WS_CTL) + XB_TMO};
        pg8::gemm_phase<pg8::EpiNorm<1>, pg8::PanelOrder, true, true>(lds, g, S, E, lds + XLDS_OFF);
    }
#undef IN
#undef SYNC
}

extern "C" void kernel_launch(void* const* d_in, const int* in_sizes, int n_in, void* d_out, int out_size, void* d_ws, size_t ws_size, hipStream_t stream) {
    static int grid = 0;
    if (grid == 0) {
        if (n_in != 16 || in_sizes[0] != SEQ * DMODEL || out_size != SEQ * DMODEL || ws_size < WS_END) { fprintf(stderr, "kernel_launch: unexpected shapes (n_in %d, in0 %d, out %d, ws %zu)\n", n_in, n_in > 0 ? in_sizes[0] : -1, out_size, ws_size); grid = -1; return; }
        int dev = 0, cus = 0, per_cu = 0;
        if (hipGetDevice(&dev) != hipSuccess || hipDeviceGetAttribute(&cus, hipDeviceAttributeMultiprocessorCount, dev) != hipSuccess) { grid = -1; return; }
        if (hipFuncSetAttribute((const void*)hybrid_fwd, hipFuncAttributeMaxDynamicSharedMemorySize, LDS_BYTES) != hipSuccess) { fprintf(stderr, "kernel_launch: hipFuncSetAttribute failed\n"); grid = -1; return; }
        if (hipOccupancyMaxActiveBlocksPerMultiprocessor(&per_cu, (const void*)hybrid_fwd, NWAVES * 64, LDS_BYTES) != hipSuccess || per_cu < 1) { fprintf(stderr, "kernel_launch: occupancy query says %d blocks per CU\n", per_cu); (void)hipGetLastError(); per_cu = 1; }
        grid = cus;
        if (grid % 8 != 0 || grid < 8) { fprintf(stderr, "kernel_launch: %d CUs\n", grid); }
    }
    if (grid < 0) return;
    if (hipMemsetAsync((char*)d_ws + WS_CTL, 0, CTL_ZERO_BYTES, stream) != hipSuccess) { fprintf(stderr, "kernel_launch: hipMemsetAsync failed\n"); return; }
    Args a{};
    for (int i = 0; i < 16; ++i) a.in[i] = (const float*)d_in[i];
    a.out = (float*)d_out; a.ws = (unsigned char*)d_ws;
#if MK_PER_PHASE
    for (int ph = 0; ph < NPHASE; ++ph) { a.ph_lo = ph; a.ph_hi = ph + 1; hipLaunchKernelGGL(hybrid_fwd, dim3(grid), dim3(NWAVES * 64), LDS_BYTES, stream, a); }
#else
    a.ph_lo = 0; a.ph_hi = NPHASE;
    void* kargs[] = {&a};
    hipError_t e = hipLaunchCooperativeKernel((const void*)hybrid_fwd, dim3(grid), dim3(NWAVES * 64), kargs, LDS_BYTES, stream);
    if (e != hipSuccess) fprintf(stderr, "kernel_launch: cooperative launch failed: %s (grid %d)\n", hipGetErrorString(e), grid);
#endif
}
```

```cpp
#include <hip/hip_runtime.h>
#include <hip/hip_cooperative_groups.h>
#include <cstdio>
#include <cstdint>
namespace cg = cooperative_groups;
#ifndef PG8_PRIO
#define PG8_PRIO 0
#endif
namespace pg8 {
#define PG8_LAS __attribute__((address_space(3)))
typedef unsigned short bf16_t;
typedef short bf16x8 __attribute__((ext_vector_type(8)));
typedef float f32x4 __attribute__((ext_vector_type(4)));
typedef unsigned u32x4 __attribute__((ext_vector_type(4)));
constexpr int BM = 256, BK = 64, HALF = 128, HTB = HALF * BK * 2  , STAGE_BYTES = 8 * HTB, NXCD = 8, WGM = 8;

__host__ __device__ __forceinline__ int lds_byte(int r, int c) { const int st = (r >> 4) * 2 + (c >> 5), rr = r & 15, cc = c & 31, ob = rr * 64 + cc * 2; return st * 1024 + (ob ^ (((ob >> 9) & 1) << 5)); }
__host__ __device__ __forceinline__ void stage_rc(int b, int& R, int& C) { const int st = b / 1024, sb = b % 1024, swz = sb ^ (((sb >> 9) & 1) << 5); R = (st >> 1) * 16 + swz / 64; C = (st & 1) * 32 + (swz % 64) / 2; }
__host__ __device__ __forceinline__ int perm32(int rho) { const int n = rho >> 4, i = rho & 15; return 8 * (i >> 2) + 4 * n + (i & 3); }

struct Unit { int pm, pn; };
struct Gemm { const bf16_t* A; const bf16_t* Bt; int M, N, K; };

struct StaticOrder {
    int nM, nN, nwg, G, c;
    __host__ __device__ void init(int M, int N, int G_, int c_) { nM = M / BM; nN = N / BM; nwg = nM * nN; G = G_; c = c_; }
    __host__ __device__ bool next(int i, Unit& u) const {
        const long L = (long)i * G + c; if (L >= nwg) return false;
        int wgid = (int)L; { const int q = nwg / NXCD, r = nwg % NXCD, xcd = wgid % NXCD, off = wgid / NXCD; wgid = (xcd < r ? xcd * (q + 1) : r * (q + 1) + (xcd - r) * q) + off; }
        const int nig = WGM * nN, gid = wgid / nig, fm = gid * WGM, gsz = (nM - fm) < WGM ? (nM - fm) : WGM;
        u.pm = fm + ((wgid % nig) % gsz); u.pn = (wgid % nig) / gsz; return true;
    }
    __device__ __forceinline__ void a_ready(const Unit&) const {}
    __device__ __forceinline__ void done(const Unit&) const {}
};
__device__ __forceinline__ unsigned cvt_pk_bf16(float lo, float hi) { unsigned r; asm volatile("v_cvt_pk_bf16_f32 %0, %1, %2" : "=v"(r) : "v"(lo), "v"(hi)); return r; }
typedef unsigned u32x2 __attribute__((ext_vector_type(2)));
constexpr int DM = 2048;
constexpr float RMS_EPS = 1e-6f;

struct EpiZ {
    static constexpr bool PERM = true, AFTER_DRAIN = false;
    bf16_t* O; int ldc;
    __device__ __forceinline__ void operator()(const f32x4 (&acc)[2][2][4][2], const Unit& u, int wr, int wc, int fr_, int fq_, PG8_LAS unsigned char*) const {
        int t_ = threadIdx.x; asm volatile("" : "+v"(t_));
        const int fr = t_ & 15, fq = (t_ >> 4) & 3;
        const int row0 = u.pm * BM + wr * 64 + fr, col0 = u.pn * BM + wc * 32 + 8 * fq;
#pragma unroll
        for (int ai = 0; ai < 2; ++ai)
#pragma unroll
            for (int m = 0; m < 4; ++m) { bf16_t* rowp = O + (size_t)(row0 + ai * HALF + m * 16) * ldc + col0;
#pragma unroll
                for (int bj = 0; bj < 2; ++bj) { const f32x4 v0 = acc[ai][bj][m][0], v1 = acc[ai][bj][m][1];
                    u32x4 w; w.x = cvt_pk_bf16(v0[0], v0[1]); w.y = cvt_pk_bf16(v0[2], v0[3]); w.z = cvt_pk_bf16(v1[0], v1[1]); w.w = cvt_pk_bf16(v1[2], v1[3]);
                    *(u32x4*)(rowp + bj * HALF) = w; } }
    }
};

struct EpiNone {
    static constexpr bool PERM = true, AFTER_DRAIN = false;
    __device__ __forceinline__ void operator()(const f32x4 (&acc)[2][2][4][2], const Unit& u, int wr, int wc, int fr, int fq, PG8_LAS unsigned char*) const {
#pragma unroll
        for (int ai = 0; ai < 2; ++ai)
#pragma unroll
            for (int bj = 0; bj < 2; ++bj)
#pragma unroll
                for (int m = 0; m < 4; ++m)
#pragma unroll
                    for (int n = 0; n < 2; ++n) asm volatile("" :: "v"(acc[ai][bj][m][n]));
    }
};
struct EpiResA {
    static constexpr bool PERM = true, AFTER_DRAIN = false;
    const float* R; bf16_t* XB; float* slab;
    __device__ __forceinline__ void operator()(const f32x4 (&acc)[2][2][4][2], const Unit& u, int wr, int wc, int fr_, int fq_, PG8_LAS unsigned char*) const {
        int t_ = threadIdx.x; asm volatile("" : "+v"(t_));
        const int fr = t_ & 15, fq = (t_ >> 4) & 3;
        const int row0 = u.pm * BM + wr * 64 + fr, col0 = u.pn * BM + wc * 32 + 8 * fq;
#pragma unroll
        for (int ai = 0; ai < 2; ++ai) {
            f32x4 r[4][2][2];
#pragma unroll
            for (int m = 0; m < 4; ++m)
#pragma unroll
                for (int bj = 0; bj < 2; ++bj) { const float* p = R + (size_t)(row0 + ai * HALF + m * 16) * DM + col0 + bj * HALF; r[m][bj][0] = *(const f32x4*)p; r[m][bj][1] = *(const f32x4*)(p + 4); }
#pragma unroll
            for (int m = 0; m < 4; ++m) { const int row = row0 + ai * HALF + m * 16; float ss = 0.f;
#pragma unroll
                for (int bj = 0; bj < 2; ++bj) { const f32x4 v0 = acc[ai][bj][m][0] + r[m][bj][0], v1 = acc[ai][bj][m][1] + r[m][bj][1];
                    u32x4 w; w.x = cvt_pk_bf16(v0[0], v0[1]); w.y = cvt_pk_bf16(v0[2], v0[3]); w.z = cvt_pk_bf16(v1[0], v1[1]); w.w = cvt_pk_bf16(v1[2], v1[3]);
                    *(u32x4*)(XB + (size_t)row * DM + col0 + bj * HALF) = w;
                    ss += (v0[0] * v0[0] + v0[1] * v0[1]) + (v0[2] * v0[2] + v0[3] * v0[3]) + (v1[0] * v1[0] + v1[1] * v1[1]) + (v1[2] * v1[2] + v1[3] * v1[3]); }
                ss += __shfl_xor(ss, 16); ss += __shfl_xor(ss, 32);
                if (fq == 0) slab[(size_t)row * 32 + u.pn * 4 + wc] = ss; }
            asm volatile("" ::: "memory"); }
    }
};
struct EpiResB {
    static constexpr bool PERM = true, AFTER_DRAIN = false;
    const bf16_t* RB; float* X; float* slab;
    __device__ __forceinline__ void operator()(const f32x4 (&acc)[2][2][4][2], const Unit& u, int wr, int wc, int fr_, int fq_, PG8_LAS unsigned char*) const {
        int t_ = threadIdx.x; asm volatile("" : "+v"(t_));
        const int fr = t_ & 15, fq = (t_ >> 4) & 3;
        const int row0 = u.pm * BM + wr * 64 + fr, col0 = u.pn * BM + wc * 32 + 8 * fq;
        u32x4 r[2][4][2];
#pragma unroll
        for (int ai = 0; ai < 2; ++ai)
#pragma unroll
            for (int m = 0; m < 4; ++m)
#pragma unroll
                for (int bj = 0; bj < 2; ++bj) r[ai][m][bj] = *(const u32x4*)(RB + (size_t)(row0 + ai * HALF + m * 16) * DM + col0 + bj * HALF);
#pragma unroll
        for (int ai = 0; ai < 2; ++ai)
#pragma unroll
            for (int m = 0; m < 4; ++m) { const int row = row0 + ai * HALF + m * 16; float ss = 0.f;
#pragma unroll
                for (int bj = 0; bj < 2; ++bj) { const u32x4 q = r[ai][m][bj];
                    const f32x4 r0 = {__builtin_bit_cast(float, q.x << 16), __builtin_bit_cast(float, q.x & 0xffff0000u), __builtin_bit_cast(float, q.y << 16), __builtin_bit_cast(float, q.y & 0xffff0000u)};
                    const f32x4 r1 = {__builtin_bit_cast(float, q.z << 16), __builtin_bit_cast(float, q.z & 0xffff0000u), __builtin_bit_cast(float, q.w << 16), __builtin_bit_cast(float, q.w & 0xffff0000u)};
                    const f32x4 v0 = acc[ai][bj][m][0] + r0, v1 = acc[ai][bj][m][1] + r1;
                    float* xp = X + (size_t)row * DM + col0 + bj * HALF; *(f32x4*)xp = v0; *(f32x4*)(xp + 4) = v1;
                    ss += (v0[0] * v0[0] + v0[1] * v0[1]) + (v0[2] * v0[2] + v0[3] * v0[3]) + (v1[0] * v1[0] + v1[1] * v1[1]) + (v1[2] * v1[2] + v1[3] * v1[3]); }
                ss += __shfl_xor(ss, 16); ss += __shfl_xor(ss, 32);
                if (fq == 0) slab[(size_t)row * 32 + u.pn * 4 + wc] = ss; }
    }
};

struct PanelOrder {
    int G, vcu, ntot;
    __device__ __forceinline__ bool next(int i, Unit& u) const { const int L = i * G + vcu; if (L >= ntot) return false; u.pm = L >> 3; u.pn = L & 7; return true; }
    __device__ __forceinline__ void a_ready(const Unit&) const {}
    __device__ __forceinline__ void done(const Unit&) const {}
};
template <int MODE  > struct EpiNorm {
    static constexpr bool PERM = (MODE == 0), AFTER_DRAIN = false;
    const float* Rf; const bf16_t* Rb; const float* sig_in; float* sig_out; bf16_t* HN; float* OUT; const float* gfin; unsigned* xbuf; unsigned* cnt; unsigned* tmo;
    __device__ __forceinline__ void operator()(f32x4 (&acc)[2][2][4][2], const Unit& u, int wr, int wc, int fr_, int fq_, PG8_LAS unsigned char* xlds) const {
        int t_ = threadIdx.x; asm volatile("" : "+v"(t_));
        const int fr = t_ & 15, fq = (t_ >> 4) & 3, wid = __builtin_amdgcn_readfirstlane(t_ >> 6);
        const int rl0 = wr * 64 + fr, row0 = u.pm * BM + rl0, col0 = u.pn * BM + wc * 32 + 8 * fq;
        PG8_LAS float* Pt = (PG8_LAS float*)xlds;
        PG8_LAS float* St = (PG8_LAS float*)(xlds + 4096);
        if constexpr (MODE == 0) {
#pragma unroll
            for (int ai = 0; ai < 2; ++ai) { f32x4 r[4][2][2];
#pragma unroll
                for (int m = 0; m < 4; ++m)
#pragma unroll
                    for (int bj = 0; bj < 2; ++bj) { const float* p = Rf + (size_t)(row0 + ai * HALF + m * 16) * DM + col0 + bj * HALF; r[m][bj][0] = *(const f32x4*)p; r[m][bj][1] = *(const f32x4*)(p + 4); }
#pragma unroll
                for (int m = 0; m < 4; ++m) { float ss = 0.f;
#pragma unroll
                    for (int bj = 0; bj < 2; ++bj) { const f32x4 v0 = acc[ai][bj][m][0] + r[m][bj][0], v1 = acc[ai][bj][m][1] + r[m][bj][1]; acc[ai][bj][m][0] = v0; acc[ai][bj][m][1] = v1;
                        ss += (v0[0] * v0[0] + v0[1] * v0[1]) + (v0[2] * v0[2] + v0[3] * v0[3]) + (v1[0] * v1[0] + v1[1] * v1[1]) + (v1[2] * v1[2] + v1[3] * v1[3]); }
                    ss += __shfl_xor(ss, 16); ss += __shfl_xor(ss, 32);
                    if (fq == 0) Pt[(ai * HALF + rl0 + m * 16) * 4 + wc] = ss; }
                asm volatile("" ::: "memory"); }
        } else { u32x2 r[2][4][2][2]; float sg[2][4]; const int colb = u.pn * BM + wc * 32 + 4 * fq;
#pragma unroll
            for (int ai = 0; ai < 2; ++ai)
#pragma unroll
                for (int m = 0; m < 4; ++m) { sg[ai][m] = sig_in[row0 + ai * HALF + m * 16];
#pragma unroll
                    for (int bj = 0; bj < 2; ++bj)
#pragma unroll
                        for (int n = 0; n < 2; ++n) r[ai][m][bj][n] = *(const u32x2*)(Rb + (size_t)(row0 + ai * HALF + m * 16) * DM + colb + bj * HALF + 16 * n); }
#pragma unroll
            for (int ai = 0; ai < 2; ++ai)
#pragma unroll
                for (int m = 0; m < 4; ++m) { float ss = 0.f; const float sgm = sg[ai][m];
#pragma unroll
                    for (int bj = 0; bj < 2; ++bj)
#pragma unroll
                        for (int n = 0; n < 2; ++n) { const u32x2 q = r[ai][m][bj][n];
                            const f32x4 r0 = {__builtin_bit_cast(float, q.x << 16), __builtin_bit_cast(float, q.x & 0xffff0000u), __builtin_bit_cast(float, q.y << 16), __builtin_bit_cast(float, q.y & 0xffff0000u)};
                            const f32x4 v0 = acc[ai][bj][m][n] + r0 * sgm; acc[ai][bj][m][n] = v0;
                            ss += (v0[0] * v0[0] + v0[1] * v0[1]) + (v0[2] * v0[2] + v0[3] * v0[3]); }
                    ss += __shfl_xor(ss, 16); ss += __shfl_xor(ss, 32);
                    if (fq == 0) Pt[(ai * HALF + rl0 + m * 16) * 4 + wc] = ss; } }
        asm volatile("s_waitcnt lgkmcnt(0)" ::: "memory"); __builtin_amdgcn_s_barrier(); asm volatile("" ::: "memory");
        if (t_ < 256) { const float s = (Pt[t_ * 4 + 0] + Pt[t_ * 4 + 1]) + (Pt[t_ * 4 + 2] + Pt[t_ * 4 + 3]);
            __hip_atomic_store(xbuf + (size_t)(u.pm * BM + t_) * 8 + u.pn, __builtin_bit_cast(unsigned, s), __ATOMIC_RELAXED, __HIP_MEMORY_SCOPE_AGENT); }
        asm volatile("s_waitcnt vmcnt(0)" ::: "memory");
        if (t_ < 256 && (t_ & 63) == 0) __hip_atomic_fetch_add(cnt + 64 * u.pm, 1u, __ATOMIC_RELAXED, __HIP_MEMORY_SCOPE_AGENT);
        if (wid == 0) {
            unsigned spins = 0;
            while ((unsigned)__builtin_amdgcn_readfirstlane(__hip_atomic_load(cnt + 64 * u.pm, __ATOMIC_RELAXED, __HIP_MEMORY_SCOPE_AGENT)) < 32u) {
                __builtin_amdgcn_s_sleep(2);
                if (++spins > (1u << 20)) { if ((t_ & 63) == 0) __hip_atomic_store(tmo, 1u, __ATOMIC_RELAXED, __HIP_MEMORY_SCOPE_AGENT); break; } }
            __builtin_amdgcn_fence(__ATOMIC_ACQUIRE, "agent");
        }
        asm volatile("s_waitcnt vmcnt(0) lgkmcnt(0)" ::: "memory"); __builtin_amdgcn_s_barrier(); asm volatile("" ::: "memory");
        if (t_ < 256) { const unsigned long long* sp = (const unsigned long long*)(xbuf + (size_t)(u.pm * BM + t_) * 8); float tot = 0.f;
#pragma unroll
            for (int q = 0; q < 4; ++q) { const unsigned long long w = __hip_atomic_load(sp + q, __ATOMIC_RELAXED, __HIP_MEMORY_SCOPE_AGENT);
                tot += __builtin_bit_cast(float, (unsigned)w); tot += __builtin_bit_cast(float, (unsigned)(w >> 32)); }
            const float sd = sqrtf(tot * (1.0f / DM) + RMS_EPS);
            St[t_] = 1.0f / sd;
            if (MODE == 0 && u.pn == 0) sig_out[u.pm * BM + t_] = sd; }
        asm volatile("s_waitcnt lgkmcnt(0)" ::: "memory"); __builtin_amdgcn_s_barrier(); asm volatile("" ::: "memory");
        if constexpr (MODE == 0) {
#pragma unroll
            for (int ai = 0; ai < 2; ++ai)
#pragma unroll
                for (int m = 0; m < 4; ++m) { const float rstd = St[ai * HALF + rl0 + m * 16]; bf16_t* op = HN + (size_t)(row0 + ai * HALF + m * 16) * DM + col0;
#pragma unroll
                    for (int bj = 0; bj < 2; ++bj) { const f32x4 v0 = acc[ai][bj][m][0] * rstd, v1 = acc[ai][bj][m][1] * rstd;
                        u32x4 w; w.x = cvt_pk_bf16(v0[0], v0[1]); w.y = cvt_pk_bf16(v0[2], v0[3]); w.z = cvt_pk_bf16(v1[0], v1[1]); w.w = cvt_pk_bf16(v1[2], v1[3]);
                        *(u32x4*)(op + bj * HALF) = w; } }
        } else {
            const int colb = u.pn * BM + wc * 32 + 4 * fq; const bool odd = fr & 1;
            f32x4 gg[2][2];
#pragma unroll
            for (int bj = 0; bj < 2; ++bj)
#pragma unroll
                for (int n = 0; n < 2; ++n) gg[bj][n] = *(const f32x4*)(gfin + colb + bj * HALF + 16 * n);
#pragma unroll
            for (int ai = 0; ai < 2; ++ai)
#pragma unroll
                for (int m = 0; m < 4; ++m) { const float rstd = St[ai * HALF + rl0 + m * 16]; float* op = OUT + (size_t)(row0 + ai * HALF + m * 16) * DM + colb;
#pragma unroll
                    for (int bj = 0; bj < 2; ++bj) {
                        const f32x4 o0 = acc[ai][bj][m][0] * rstd * gg[bj][0], o1 = acc[ai][bj][m][1] * rstd * gg[bj][1]; f32x4 dA, dB;
#pragma unroll
                        for (int j = 0; j < 4; ++j) { const float snd = odd ? o0[j] : o1[j];
                            const float rcv = __builtin_bit_cast(float, __builtin_amdgcn_mov_dpp(__builtin_bit_cast(int, snd), 0xB1, 0xf, 0xf, false));
                            dA[j] = odd ? rcv : o0[j]; dB[j] = odd ? o1[j] : rcv; }
                        float* pp = op + bj * HALF + (odd ? 16 : 0);
                        *(f32x4*)(pp - (odd ? DM : 0)) = dA; *(f32x4*)(pp + (odd ? 0 : DM)) = dB; } }
        }
    }
};

__device__ __forceinline__ float dpp_shr1(float old, float src) { return __builtin_bit_cast(float, __builtin_amdgcn_update_dpp(__builtin_bit_cast(int, old), __builtin_bit_cast(int, src), 0x111, 0xf, 0xf, false)); }
__device__ __forceinline__ float dpp_shr2(float old, float src) { return __builtin_bit_cast(float, __builtin_amdgcn_update_dpp(__builtin_bit_cast(int, old), __builtin_bit_cast(int, src), 0x112, 0xf, 0xf, false)); }
__device__ __forceinline__ float dpp_ror1(float src) { return __builtin_bit_cast(float, __builtin_amdgcn_mov_dpp(__builtin_bit_cast(int, src), 0x121, 0xf, 0xf, false)); }
__device__ __forceinline__ float dpp_ror2(float src) { return __builtin_bit_cast(float, __builtin_amdgcn_mov_dpp(__builtin_bit_cast(int, src), 0x122, 0xf, 0xf, false)); }
constexpr int FF = 5632, FF2 = 11264;
struct EpiAct {
    static constexpr bool PERM = true, AFTER_DRAIN = false;
    bf16_t* ACT; const float* cw; const float* cb; float* ubnd;
    __device__ __forceinline__ void operator()(f32x4 (&acc)[2][2][4][2], const Unit& u, int wr, int wc, int fr_, int fq_, PG8_LAS unsigned char* xlds) const {
        int t_ = threadIdx.x; asm volatile("" : "+v"(t_));
        const int fr = t_ & 15, fq = (t_ >> 4) & 3;
        const int row0 = u.pm * BM + wr * 64 + fr, cl = wc * 32 + 8 * fq;
        const int c0 = u.pn * 128 + cl;
        f32x4 wgt[2][8];
#pragma unroll
        for (int n = 0; n < 2; ++n) { const float* wp = cw + c0 + 4 * n; const float* bp = cb + c0 + 4 * n;
            wgt[n][0] = *(const f32x4*)wp; wgt[n][1] = *(const f32x4*)(wp + FF2); wgt[n][2] = *(const f32x4*)(wp + 2 * FF2); wgt[n][3] = *(const f32x4*)bp;
            wgt[n][4] = *(const f32x4*)(wp + FF); wgt[n][5] = *(const f32x4*)(wp + FF2 + FF); wgt[n][6] = *(const f32x4*)(wp + 2 * FF2 + FF); wgt[n][7] = *(const f32x4*)(bp + FF); }
        if (fr >= 14) {
#pragma unroll
            for (int ai = 0; ai < 2; ++ai)
#pragma unroll
                for (int bj = 0; bj < 2; ++bj)
#pragma unroll
                    for (int n = 0; n < 2; ++n) *(PG8_LAS f32x4*)(xlds + ((((2 * ai + wr) * 2 + (fr - 14)) * 256 + 128 * bj + cl + 4 * n) << 2)) = acc[ai][bj][3][n];
            if (wr == 1) {
#pragma unroll
                for (int bj = 0; bj < 2; ++bj)
#pragma unroll
                    for (int n = 0; n < 2; ++n) *(f32x4*)(ubnd + (size_t)(u.pm * 4 + 2 + (fr - 14)) * FF2 + u.pn * BM + 128 * bj + cl + 4 * n) = acc[1][bj][3][n]; }
        }
        if (wr == 0 && fr < 2) {
#pragma unroll
            for (int bj = 0; bj < 2; ++bj)
#pragma unroll
                for (int n = 0; n < 2; ++n) *(f32x4*)(ubnd + (size_t)(u.pm * 4 + fr) * FF2 + u.pn * BM + 128 * bj + cl + 4 * n) = acc[0][bj][0][n]; }
        asm volatile("s_waitcnt lgkmcnt(0)" ::: "memory"); __builtin_amdgcn_s_barrier(); asm volatile("" ::: "memory");
        u32x2 hold[2][4];
#pragma unroll
        for (int n = 0; n < 2; ++n) {
            const f32x4 gw0 = wgt[n][0], gw1 = wgt[n][1], gw2 = wgt[n][2], gb = wgt[n][3], vw0 = wgt[n][4], vw1 = wgt[n][5], vw2 = wgt[n][6], vb = wgt[n][7];
#pragma unroll
            for (int ai = 0; ai < 2; ++ai) {
                const int chunk = 2 * ai + wr;
                f32x4 pg = {0.f, 0.f, 0.f, 0.f}, pv = {0.f, 0.f, 0.f, 0.f};
                if (chunk > 0) { const PG8_LAS unsigned char* bp = xlds + ((((chunk - 1) * 2 + (fr & 1)) * 256 + cl + 4 * n) << 2);
                    pg = *(const PG8_LAS f32x4*)bp; pv = *(const PG8_LAS f32x4*)(bp + 512); }
#pragma unroll
                for (int m = 0; m < 4; ++m) {
                    const f32x4 cg = acc[ai][0][m][n], cv = acc[ai][1][m][n]; float a[4];
#pragma unroll
                    for (int j = 0; j < 4; ++j) {
                        const float g1 = dpp_shr1(dpp_ror1(pg[j]), cg[j]), g2 = dpp_shr2(dpp_ror2(pg[j]), cg[j]);
                        const float v1 = dpp_shr1(dpp_ror1(pv[j]), cv[j]), v2 = dpp_shr2(dpp_ror2(pv[j]), cv[j]);
                        const float G = gw2[j] * cg[j] + (gw1[j] * g1 + (gw0[j] * g2 + gb[j]));
                        const float V = vw2[j] * cv[j] + (vw1[j] * v1 + (vw0[j] * v2 + vb[j]));
                        a[j] = G * __builtin_amdgcn_rcpf(1.0f + __builtin_amdgcn_exp2f(-1.4426950408889634f * G)) * V; }
                    u32x2 w; w.x = cvt_pk_bf16(a[0], a[1]); w.y = cvt_pk_bf16(a[2], a[3]);
                    if (n == 0) hold[ai][m] = w;
                    else { u32x4 o; o.x = hold[ai][m].x; o.y = hold[ai][m].y; o.z = w.x; o.w = w.y;
                        *(u32x4*)(ACT + (size_t)(row0 + ai * HALF + m * 16) * FF + c0) = o; }
                    pg = cg; pv = cv;
                }
            }
        }
    }
};

template <class Epi, class Sched, bool ALIGN_EPI = false, bool SP2 = false>
__device__ __forceinline__ void gemm_phase(PG8_LAS unsigned char* lds, const Gemm g, const Sched& S, const Epi& E, PG8_LAS unsigned char* xlds) {
    const int tid = threadIdx.x, wid = __builtin_amdgcn_readfirstlane(tid >> 6), lane = tid & 63, wr = wid >> 2, wc = wid & 3, fr = lane & 15, fq = lane >> 4;
    const int K = g.K, nt = K / BK;
    unsigned voffA[2], voffB[2];
#pragma unroll
    for (int i = 0; i < 2; ++i) { int R, C; stage_rc(tid * 16 + i * 8192, R, C); const int Rb = Epi::PERM ? ((R & ~31) + perm32(R & 31)) : R;
        voffA[i] = (unsigned)(R * K + C) * 2u; voffB[i] = (unsigned)(Rb * K + C) * 2u; }
    const size_t kstep = (size_t)(BK * 2);
    const size_t hstep = (size_t)HALF * K * 2;
    const size_t tstep = 2 * hstep;
    const unsigned ldsw = (unsigned)wid * 1024u;
    const int aoff = lds_byte(wr * 64 + fr, fq * 8), boff = lds_byte(wc * 32 + fr, fq * 8);
#define PG8_SA(b, h) (((b) * 2 + (h)) * HTB)
#define PG8_SB(b, h) ((4 + (b) * 2 + (h)) * HTB)
#define PG8_STAGE(bufoff, gbase, voff) do { _Pragma("unroll") for (int _i = 0; _i < 2; ++_i) \
        __builtin_amdgcn_global_load_lds((const unsigned*)((const char*)(gbase) + (voff)[_i]), (PG8_LAS unsigned*)(lds + (bufoff) + ldsw + _i * 8192), 16, 0, 0); } while (0)
#define PG8_LDA(dst, b, h) do { _Pragma("unroll") for (int m = 0; m < 4; ++m) _Pragma("unroll") for (int k = 0; k < 2; ++k) dst[m][k] = *(const PG8_LAS bf16x8*)(lds + PG8_SA(b, h) + aoff + m * 2048 + k * 1024); } while (0)
#define PG8_LDB(dst, b, h) do { _Pragma("unroll") for (int n = 0; n < 2; ++n) _Pragma("unroll") for (int k = 0; k < 2; ++k) dst[n][k] = *(const PG8_LAS bf16x8*)(lds + PG8_SB(b, h) + boff + n * 2048 + k * 1024); } while (0)
#define PG8_MMA(ai, bj, At, Bt) do { __builtin_amdgcn_s_setprio(PG8_PRIO); _Pragma("unroll") for (int m = 0; m < 4; ++m) _Pragma("unroll") for (int n = 0; n < 2; ++n) _Pragma("unroll") for (int k = 0; k < 2; ++k) \
        acc[ai][bj][m][n] = __builtin_amdgcn_mfma_f32_16x16x32_bf16(Bt[n][k], At[m][k], acc[ai][bj][m][n], 0, 0, 0); __builtin_amdgcn_s_setprio(0); } while (0)
#define PG8_WAIT_V(n) asm volatile("s_waitcnt vmcnt(" #n ")" ::: "memory")
#define PG8_WAIT_L(n) asm volatile("s_waitcnt lgkmcnt(" #n ")" ::: "memory")
#define PG8_BAR __builtin_amdgcn_s_barrier()
#define PG8_SCHED __builtin_amdgcn_sched_barrier(0)
    Unit cur, nxt; int ui = 0;
    if (!S.next(0, cur)) return;
    f32x4 acc[2][2][4][2];
#pragma unroll
    for (int a = 0; a < 2; ++a)
#pragma unroll
        for (int b = 0; b < 2; ++b)
#pragma unroll
            for (int m = 0; m < 4; ++m)
#pragma unroll
                for (int n = 0; n < 2; ++n) acc[a][b][m][n] = (f32x4){0.f, 0.f, 0.f, 0.f};
    bf16x8 At[4][2], B0[2][2], B1[2][2];
    const char* cA = (const char*)g.A + (size_t)cur.pm * tstep; const char* cB = (const char*)g.Bt + (size_t)cur.pn * tstep;
    S.a_ready(cur);
    if constexpr (SP2) {
        PG8_STAGE(PG8_SB(0, 0), cB, voffB); PG8_STAGE(PG8_SB(0, 1), cB + hstep, voffB); PG8_STAGE(PG8_SA(0, 0), cA, voffA); PG8_STAGE(PG8_SA(0, 1), cA + hstep, voffA);
        if (wr == 1) PG8_BAR;
        PG8_WAIT_V(2); PG8_BAR;
        PG8_STAGE(PG8_SB(1, 0), cB + kstep, voffB); PG8_STAGE(PG8_SA(1, 0), cA + kstep, voffA); PG8_STAGE(PG8_SB(1, 1), cB + hstep + kstep, voffB);
        PG8_WAIT_V(6); PG8_BAR;
    } else {
        PG8_STAGE(PG8_SB(0, 0), cB, voffB); PG8_STAGE(PG8_SA(0, 0), cA, voffA); PG8_STAGE(PG8_SB(0, 1), cB + hstep, voffB); PG8_STAGE(PG8_SA(0, 1), cA + hstep, voffA);
        if (wr == 1) PG8_BAR;
        PG8_WAIT_V(4); PG8_BAR;
        PG8_STAGE(PG8_SB(1, 0), cB + kstep, voffB); PG8_STAGE(PG8_SA(1, 0), cA + kstep, voffA); PG8_STAGE(PG8_SB(1, 1), cB + hstep + kstep, voffB);
        PG8_WAIT_V(6); PG8_BAR;
    }
    for (;;) {
        const bool has_next = S.next(ui + 1, nxt);
        const char* nA = has_next ? (const char*)g.A + (size_t)nxt.pm * tstep : cA; const char* nB = has_next ? (const char*)g.Bt + (size_t)nxt.pn * tstep : cB;
        for (int t = 0; t < nt; t += 2) {
            const bool last = (t == nt - 2);
            const char* a1 = cA + (size_t)(t + 1) * kstep;
            const char* a2 = last ? nA : cA + (size_t)(t + 2) * kstep; const char* b2 = last ? nB : cB + (size_t)(t + 2) * kstep;
            const char* a3 = a2 + kstep; const char* b3 = b2 + kstep;
            if (last && has_next) S.a_ready(nxt);
            if constexpr (SP2) {
            PG8_LDB(B0, 0, 0); PG8_LDB(B1, 0, 1); PG8_SCHED; PG8_LDA(At, 0, 0); PG8_STAGE(PG8_SA(1, 1), a1 + hstep, voffA);
            PG8_WAIT_V(8); PG8_WAIT_L(0); PG8_BAR; PG8_MMA(0, 0, At, B0); PG8_MMA(0, 1, At, B1); PG8_BAR; PG8_SCHED;
            PG8_LDA(At, 0, 1); PG8_STAGE(PG8_SB(0, 0), b2, voffB); PG8_STAGE(PG8_SB(0, 1), b2 + hstep, voffB); PG8_STAGE(PG8_SA(0, 0), a2, voffA);
            PG8_WAIT_V(8); PG8_WAIT_L(0); PG8_BAR; PG8_MMA(1, 0, At, B0); PG8_MMA(1, 1, At, B1); PG8_BAR; PG8_SCHED;
            PG8_LDB(B0, 1, 0); PG8_LDB(B1, 1, 1); PG8_SCHED; PG8_LDA(At, 1, 0); PG8_STAGE(PG8_SA(0, 1), a2 + hstep, voffA);
            PG8_WAIT_V(8); PG8_WAIT_L(0); PG8_BAR; PG8_MMA(0, 0, At, B0); PG8_MMA(0, 1, At, B1); PG8_BAR; PG8_SCHED;
            PG8_LDA(At, 1, 1); PG8_STAGE(PG8_SB(1, 0), b3, voffB); PG8_STAGE(PG8_SB(1, 1), b3 + hstep, voffB); PG8_STAGE(PG8_SA(1, 0), a3, voffA);
            PG8_WAIT_V(8); PG8_WAIT_L(0); PG8_BAR; PG8_MMA(1, 0, At, B0); PG8_MMA(1, 1, At, B1); PG8_BAR; PG8_SCHED;
            } else {
            PG8_LDB(B0, 0, 0); PG8_SCHED; PG8_LDA(At, 0, 0); PG8_STAGE(PG8_SA(1, 1), a1 + hstep, voffA);
            PG8_WAIT_L(8); PG8_BAR; PG8_WAIT_L(0); PG8_MMA(0, 0, At, B0); PG8_BAR; PG8_SCHED;
            PG8_LDB(B1, 0, 1); PG8_STAGE(PG8_SB(0, 0), b2, voffB);
            PG8_BAR; PG8_WAIT_L(0); PG8_MMA(0, 1, At, B1); PG8_BAR;
            PG8_LDA(At, 0, 1); PG8_STAGE(PG8_SA(0, 0), a2, voffA);
            PG8_BAR; PG8_WAIT_L(0); PG8_MMA(1, 0, At, B0); PG8_BAR; PG8_SCHED;
            PG8_STAGE(PG8_SB(0, 1), b2 + hstep, voffB);
            PG8_WAIT_V(6); PG8_BAR; PG8_MMA(1, 1, At, B1); PG8_BAR;
            PG8_LDB(B0, 1, 0); PG8_SCHED; PG8_LDA(At, 1, 0); PG8_STAGE(PG8_SA(0, 1), a2 + hstep, voffA);
            PG8_WAIT_L(8); PG8_BAR; PG8_WAIT_L(0); PG8_MMA(0, 0, At, B0); PG8_BAR; PG8_SCHED;
            PG8_LDB(B1, 1, 1); PG8_STAGE(PG8_SB(1, 0), b3, voffB);
            PG8_BAR; PG8_WAIT_L(0); PG8_MMA(0, 1, At, B1); PG8_BAR;
            PG8_LDA(At, 1, 1); PG8_STAGE(PG8_SA(1, 0), a3, voffA);
            PG8_BAR; PG8_WAIT_L(0); PG8_MMA(1, 0, At, B0); PG8_BAR; PG8_SCHED;
            PG8_STAGE(PG8_SB(1, 1), b3 + hstep, voffB);
            PG8_WAIT_V(6); PG8_BAR; PG8_MMA(1, 1, At, B1); PG8_BAR;
            }
        }
        if constexpr (ALIGN_EPI) { if (wr == 0) PG8_BAR; }
        if constexpr (!Epi::AFTER_DRAIN) { E(acc, cur, wr, wc, fr, fq, xlds); S.done(cur); }
        if (!has_next) break;
#pragma unroll
        for (int a = 0; a < 2; ++a)
#pragma unroll
            for (int b = 0; b < 2; ++b)
#pragma unroll
                for (int m = 0; m < 4; ++m)
#pragma unroll
                    for (int n = 0; n < 2; ++n) acc[a][b][m][n] = (f32x4){0.f, 0.f, 0.f, 0.f};
        cur = nxt; cA = nA; cB = nB; ++ui;
        if constexpr (ALIGN_EPI) { if (wr == 1) PG8_BAR; }
    }
    PG8_WAIT_V(0);
    if constexpr (!ALIGN_EPI) { if (wr == 0) PG8_BAR; }
    PG8_BAR;

#undef PG8_SA
#undef PG8_SB
#undef PG8_STAGE
#undef PG8_LDA
#undef PG8_LDB
#undef PG8_MMA
#undef PG8_WAIT_V
#undef PG8_WAIT_L
#undef PG8_BAR
#undef PG8_SCHED
}
}

#define GAS __attribute__((address_space(1)))
#define LAS __attribute__((address_space(3)))
typedef unsigned short bf16;
typedef float f32x4 __attribute__((ext_vector_type(4)));
typedef short bf16x8 __attribute__((ext_vector_type(8)));
typedef unsigned u32x4 __attribute__((ext_vector_type(4)));
typedef unsigned u32x2 __attribute__((ext_vector_type(2)));

constexpr int NWAVES = 8;
constexpr int SEQ = 16384, DMODEL = 2048, NMEM = 256, DIN = 3584, DCONV = 768, DPOOL = 768, DXATT = 512, DFF = 5632, DFF2 = 11264;
constexpr int PGD = 192;
constexpr float EPS = 1e-6f;
constexpr int LDS_BYTES = 147456;
#ifndef MK_PER_PHASE
#define MK_PER_PHASE 0
#endif
constexpr int NPHASE = 7;
#ifndef PHM
#define PHM 255
#endif
#ifndef P1_ALIGN
#define P1_ALIGN false
#endif
#ifndef USE_CG_SYNC
#define USE_CG_SYNC 0
#endif
#ifndef PROBE_P2
#define PROBE_P2 0
#endif
#ifndef PROBE_SYNC
#define PROBE_SYNC 0
#endif
#ifndef PROBE_GEMM
#define PROBE_GEMM 0
#endif
#ifndef PROBE_N
#define PROBE_N 2048
#endif
#ifndef REPM
#define REPM 0
#endif

constexpr size_t MiB = 1u << 20;
constexpr size_t WS_KB = 1 * MiB;
constexpr size_t WS_VT = 1 * MiB + 256 * 1024;
constexpr size_t WS_POOLWT = 1 * MiB + 512 * 1024;
constexpr size_t WS_MB = 2 * MiB;
constexpr size_t WS_WKVT = 3 * MiB;
constexpr size_t WS_SIG = 7 * MiB;
constexpr size_t WS_SLAB1 = 8 * MiB;
constexpr size_t WS_SLAB2 = 10 * MiB;
constexpr size_t WS_WUPT = 12 * MiB;
constexpr size_t WS_WDOWNT = 56 * MiB;
constexpr size_t WS_UBND = 80 * MiB;
constexpr size_t WS_X1B = 96 * MiB;
constexpr size_t WS_ACT = 160 * MiB;
constexpr size_t WS_H = 160 * MiB;
constexpr size_t WS_Z = 225 * MiB;
constexpr size_t WS_ZPAD = WS_Z - (size_t)16 * 3584 * 2;
constexpr size_t WS_MIX = 338 * MiB;
constexpr size_t WS_WINT = 402 * MiB;
constexpr size_t WS_WOUTT = 416 * MiB;
constexpr size_t WS_END = 424 * MiB;

__device__ __forceinline__ unsigned f2bf(float f) { unsigned u = __builtin_bit_cast(unsigned, f); return (u + 0x7fffu + ((u >> 16) & 1u)) >> 16; }
__device__ __forceinline__ unsigned pk2(float lo, float hi) { return f2bf(lo) | (f2bf(hi) << 16); }
__device__ __forceinline__ float bflo(unsigned w) { return __builtin_bit_cast(float, w << 16); }
__device__ __forceinline__ float bfhi(unsigned w) { return __builtin_bit_cast(float, w & 0xffff0000u); }
__device__ __forceinline__ void unpack8(const u32x4 w, float (&f)[8]) { f[0] = bflo(w.x); f[1] = bfhi(w.x); f[2] = bflo(w.y); f[3] = bfhi(w.y); f[4] = bflo(w.z); f[5] = bfhi(w.z); f[6] = bflo(w.w); f[7] = bfhi(w.w); }
__device__ __forceinline__ u32x4 pack8(const float (&f)[8]) { u32x4 w; w.x = pk2(f[0], f[1]); w.y = pk2(f[2], f[3]); w.z = pk2(f[4], f[5]); w.w = pk2(f[6], f[7]); return w; }
__device__ __forceinline__ float wave_sum(float v) {
#pragma unroll
    for (int o = 1; o < 64; o <<= 1) v += __shfl_xor(v, o);
    return v;
}
#define LDS_WAIT() asm volatile("s_waitcnt lgkmcnt(0)" ::: "memory")

typedef GAS unsigned gu32;
constexpr size_t WS_CTL = 0, CTL_ZERO_BYTES = 64 * 1024;
constexpr int CW_PANEL1 = 8192;
constexpr int CW_PANEL = 4096;
constexpr int MISC_OFF = 131072 + 320;
constexpr int XLDS_OFF = 131072 + 1024;
#define XB_TMO      128
#define XB_XCNT(j)  (256  + 64 * (j))
#define XB_XSUB(j)  (1280 + 64 * (j))
#define XB_XGEN(j)  (2304 + 64 * (j))
#define XB_TOP      3328
#define XB_TOPGEN   3392
#define XCD_BAR_WORDS 3456
#define XB_SPIN_CAP (1u << 18)

__device__ __forceinline__ unsigned xb_ld(unsigned* p)              { return __hip_atomic_load(p, __ATOMIC_RELAXED, __HIP_MEMORY_SCOPE_AGENT); }
__device__ __forceinline__ unsigned xb_add(unsigned* p, unsigned v) { return __hip_atomic_fetch_add(p, v, __ATOMIC_RELAXED, __HIP_MEMORY_SCOPE_AGENT); }
__device__ __forceinline__ unsigned xb_xcc_id() { return (unsigned)__builtin_amdgcn_s_getreg((3 << 11) | 20) & 0xFu; }
#define XB_SPIN(cond, bar) do { unsigned _sp = 0; while (cond) { __builtin_amdgcn_s_sleep(1); \
    if ((++_sp & 255u) == 0u) { if (xb_ld(&(bar)[XB_TMO])) break; if (_sp > XB_SPIN_CAP) { atomicAdd(&(bar)[XB_TMO], 1u); break; } } } } while (0)

struct XcdBarrier {
    unsigned* bar; unsigned x;
    volatile LAS unsigned* st;
};

__device__ __forceinline__ XcdBarrier xcd_barrier_post(unsigned* bar, volatile LAS unsigned* st) {
    XcdBarrier b; b.bar = bar; b.x = xb_xcc_id(); b.st = st;
    if (threadIdx.x == 0) (void)xb_add(&bar[XB_XCNT(b.x)], 1u);
    return b;
}
__device__ __forceinline__ void xcd_barrier_complete(unsigned* bar, unsigned x, unsigned& nloc, unsigned& nx) {
    const unsigned G = gridDim.x * gridDim.y * gridDim.z;
    unsigned sum, cnt, mine, sp = 0u;
    for (;;) {
        sum = 0u; cnt = 0u; mine = 0u;
#pragma unroll
        for (unsigned j = 0; j < 16; ++j) { const unsigned c = xb_ld(&bar[XB_XCNT(j)]); sum += c; cnt += (c > 0u) ? 1u : 0u; mine = (j == x) ? c : mine; }
        if (sum == G) break;
        __builtin_amdgcn_s_sleep(1);
        if ((++sp & 255u) == 0u) { if (xb_ld(&bar[XB_TMO])) break; if (sp > XB_SPIN_CAP) { atomicAdd(&bar[XB_TMO], 1u); break; } }
    }
    nloc = mine > 0u ? mine : 1u; nx = cnt > 0u ? cnt : 1u;
}

__device__ __forceinline__ void xcd_barrier(const XcdBarrier& b) {
    asm volatile("s_waitcnt vmcnt(0)" ::: "memory");
    __syncthreads();
    if (threadIdx.x == 0) {
        unsigned* bar = b.bar;
        __builtin_amdgcn_s_waitcnt(0);
        unsigned nloc = b.st[0], nx = b.st[1];
        if (nloc == 0u) { xcd_barrier_complete(bar, b.x, nloc, nx); b.st[0] = nloc; b.st[1] = nx; }
        const unsigned old = xb_add(&bar[XB_XSUB(b.x)], 1u);
        const unsigned gen = old / nloc;
        if (old + 1u == (gen + 1u) * nloc) {
            __builtin_amdgcn_fence(__ATOMIC_RELEASE, "agent");
            asm volatile("s_waitcnt vmcnt(0)" ::: "memory");
            const unsigned og = xb_add(&bar[XB_TOP], 1u);
            const unsigned tg = og / nx;
            if (og + 1u == (tg + 1u) * nx) xb_add(&bar[XB_TOPGEN], 1u);
            else XB_SPIN(xb_ld(&bar[XB_TOPGEN]) == tg, bar);
            __builtin_amdgcn_fence(__ATOMIC_ACQUIRE, "agent");
            xb_add(&bar[XB_XGEN(b.x)], 1u);
            asm volatile("s_waitcnt vmcnt(0)" ::: "memory");
        } else {
            XB_SPIN(xb_ld(&bar[XB_XGEN(b.x)]) == gen, bar);
            __builtin_amdgcn_fence(__ATOMIC_ACQUIRE, "agent");
            asm volatile("s_waitcnt vmcnt(0)" ::: "memory");
        }
    }
    __syncthreads();
}


template <bool UPMAP> __device__ __forceinline__ void p0_transpose_item(const float* W, int K, int N, bf16* WT, const float* ks, LAS float* scr, int item, int lane) {
    const int nblk = N / 64, kb = item / nblk, nb = item % nblk, k0 = 64 * kb, n0 = 64 * nb;
    const int r0 = !UPMAP ? n0 : (n0 < DFF ? 256 * (n0 / 128) + (n0 % 128) : 256 * ((n0 - DFF) / 128) + 128 + ((n0 - DFF) % 128));
    f32x4 v[16];
    const float* src = W + (size_t)(k0 + (lane >> 4)) * N + n0 + 4 * (lane & 15);
#pragma unroll
    for (int i = 0; i < 16; ++i) v[i] = *(const f32x4*)(src + (size_t)(4 * i) * N);
#pragma unroll
    for (int i = 0; i < 16; ++i) { f32x4 t = v[i]; if (ks) t = t * ks[k0 + 4 * i + (lane >> 4)];
        *(LAS f32x4*)(scr + (4 * i + (lane >> 4)) * 64 + (((lane & 15) ^ ((i >> 1) & 7)) << 2)) = t; }
    LDS_WAIT(); asm volatile("" ::: "memory");
    const int c = lane & 7;
#pragma unroll
    for (int j = 0; j < 8; ++j) { const int nn = (lane >> 3) + 8 * j; const LAS float* sp = scr + (8 * c) * 64 + ((((nn >> 2) ^ c) & 15) << 2) + (nn & 3);
        u32x4 o; o.x = pk2(sp[0 * 64], sp[1 * 64]); o.y = pk2(sp[2 * 64], sp[3 * 64]); o.z = pk2(sp[4 * 64], sp[5 * 64]); o.w = pk2(sp[6 * 64], sp[7 * 64]);
        *(u32x4*)(WT + (size_t)(r0 + nn) * K + k0 + 8 * c) = o; }
    LDS_WAIT(); asm volatile("" ::: "memory");
}
__device__ __forceinline__ void rms_rows2_to_bf16(const float* xa, const float* xb, const float* g, bf16* oa, bf16* ob, int lane) {
    const f32x4* pa = (const f32x4*)xa + lane; const f32x4* pb = (const f32x4*)xb + lane; const f32x4* gr = (const f32x4*)g + lane;
    f32x4 va[8], vb[8]; float sa = 0.f, sb = 0.f;
#pragma unroll
    for (int j = 0; j < 8; ++j) { va[j] = pa[64 * j]; vb[j] = pb[64 * j]; }
#pragma unroll
    for (int j = 0; j < 8; ++j) { sa += (va[j].x * va[j].x + va[j].y * va[j].y) + (va[j].z * va[j].z + va[j].w * va[j].w); sb += (vb[j].x * vb[j].x + vb[j].y * vb[j].y) + (vb[j].z * vb[j].z + vb[j].w * vb[j].w); }
    const float ra = 1.0f / sqrtf(wave_sum(sa) * (1.0f / DMODEL) + EPS), rb = 1.0f / sqrtf(wave_sum(sb) * (1.0f / DMODEL) + EPS);
    u32x2* qa = (u32x2*)oa + lane; u32x2* qb = (u32x2*)ob + lane;
#pragma unroll
    for (int j = 0; j < 8; ++j) { const f32x4 gg = gr[64 * j]; u32x2 w;
        w.x = pk2(va[j].x * ra * gg.x, va[j].y * ra * gg.y); w.y = pk2(va[j].z * ra * gg.z, va[j].w * ra * gg.w); qa[64 * j] = w;
        w.x = pk2(vb[j].x * rb * gg.x, vb[j].y * rb * gg.y); w.y = pk2(vb[j].z * rb * gg.z, vb[j].w * rb * gg.w); qb[64 * j] = w; }
}

struct Ptrs {
    const float *x, *mem, *g_mix, *g_mem, *w_in, *conv_w, *pool_w, *pool_scale, *w_kv, *w_out, *g_ffn, *w_up, *ffn_conv_w, *ffn_conv_b, *w_down, *g_final;
    float* out; unsigned char* ws;
};

constexpr int UP_ITEMS = (DMODEL / 64) * (DFF2 / 64), DN_ITEMS = (DFF / 64) * (DMODEL / 64);
#ifndef UP_IN_P0
#define UP_IN_P0 2560
#endif
__device__ __forceinline__ void p1_idle_work(const Ptrs& P, LAS unsigned char* lds, int iw, int NIW, int wave, int lane);
__device__ __forceinline__ void p0_prologue(const Ptrs& P, LAS unsigned char* lds, int gw, int NGW, int wave, int lane) {
    LAS float* scr = (LAS float*)(lds + wave * 16384);
    unsigned char* ws = P.ws;
    constexpr int I_IN = (DMODEL / 64) * (DIN / 64), I_OUT = (DMODEL / 64) * (DMODEL / 64), I_UP = (DMODEL / 64) * (DFF2 / 64), I_DN = (DFF / 64) * (DMODEL / 64),
                  I_KV = (DMODEL / 64) * (1024 / 64), I_PW = (PGD / 64) * (PGD / 64);
    constexpr int NITEMS = I_IN + I_OUT + UP_IN_P0 + I_KV + 4 * I_PW;
    for (int it = gw; it < NITEMS; it += NGW) {
        int r = it;
        if (r < I_IN) { p0_transpose_item<false>(P.w_in, DMODEL, DIN, (bf16*)(ws + WS_WINT), nullptr, scr, r, lane); continue; } r -= I_IN;
        if (r < I_OUT) { p0_transpose_item<false>(P.w_out, DMODEL, DMODEL, (bf16*)(ws + WS_WOUTT), nullptr, scr, r, lane); continue; } r -= I_OUT;
        if (r < UP_IN_P0) { p0_transpose_item<true>(P.w_up, DMODEL, DFF2, (bf16*)(ws + WS_WUPT), P.g_ffn, scr, r, lane); continue; } r -= UP_IN_P0;
        if (r < I_KV) { p0_transpose_item<false>(P.w_kv, DMODEL, 1024, (bf16*)(ws + WS_WKVT), nullptr, scr, r, lane); continue; } r -= I_KV;
        const int g = r / I_PW; r -= g * I_PW;
        p0_transpose_item<false>(P.pool_w + (size_t)g * PGD * PGD, PGD, PGD, (bf16*)(ws + WS_POOLWT) + (size_t)g * PGD * PGD, nullptr, scr, r, lane);
    }
    for (int i = gw * 64 + lane; i < 16 * DIN * 2 / 16; i += NGW * 64) ((u32x4*)(ws + WS_ZPAD))[i] = (u32x4){0u, 0u, 0u, 0u};
    for (int m = 2 * gw; m < SEQ; m += 2 * NGW) rms_rows2_to_bf16(P.x + (size_t)m * DMODEL, P.x + (size_t)(m + 1) * DMODEL, P.g_mix, (bf16*)(ws + WS_H) + (size_t)m * DMODEL, (bf16*)(ws + WS_H) + (size_t)(m + 1) * DMODEL, lane);
    for (int m = 2 * gw; m < NMEM; m += 2 * NGW) rms_rows2_to_bf16(P.mem + (size_t)m * DMODEL, P.mem + (size_t)(m + 1) * DMODEL, P.g_mem, (bf16*)(ws + WS_MB) + (size_t)m * DMODEL, (bf16*)(ws + WS_MB) + (size_t)(m + 1) * DMODEL, lane);
}

__device__ __forceinline__ void kv_tile(const Ptrs& P, int tt, int lane) {
    const bf16* mB = (const bf16*)(P.ws + WS_MB); const bf16* wT = (const bf16*)(P.ws + WS_WKVT);
    const int rb = tt >> 6, cb = tt & 63, fr = lane & 15, fq = lane >> 4;
    const bf16* ap = mB + (size_t)(16 * rb + fr) * DMODEL + 8 * fq; const bf16* wp = wT + (size_t)(16 * cb + fr) * DMODEL + 8 * fq;
    f32x4 acc = {0.f, 0.f, 0.f, 0.f};
    if (cb < 32) {
#pragma unroll 8
        for (int ks = 0; ks < 64; ++ks) { const bf16x8 a = *(const bf16x8*)(ap + 32 * ks), w = *(const bf16x8*)(wp + 32 * ks); acc = __builtin_amdgcn_mfma_f32_16x16x32_bf16(w, a, acc, 0, 0, 0); }
        u32x2 o; o.x = pk2(acc[0], acc[1]); o.y = pk2(acc[2], acc[3]);
        *(u32x2*)((bf16*)(P.ws + WS_KB) + (size_t)(16 * rb + fr) * 512 + 16 * cb + 4 * fq) = o;
    } else {
#pragma unroll 8
        for (int ks = 0; ks < 64; ++ks) { const bf16x8 a = *(const bf16x8*)(ap + 32 * ks), w = *(const bf16x8*)(wp + 32 * ks); acc = __builtin_amdgcn_mfma_f32_16x16x32_bf16(a, w, acc, 0, 0, 0); }
        u32x2 o; o.x = pk2(acc[0], acc[1]); o.y = pk2(acc[2], acc[3]);
        *(u32x2*)((bf16*)(P.ws + WS_VT) + (size_t)(16 * cb - 512 + fr) * 256 + 32 * (rb >> 1) + 8 * fq + 4 * (rb & 1)) = o;
    }
}

__device__ __forceinline__ void p1_idle_work(const Ptrs& P, LAS unsigned char* lds, int iw, int NIW, int wave, int lane) {
    LAS float* scr = (LAS float*)(lds + wave * 16384);
    for (int tt = iw; tt < 1024; tt += NIW) kv_tile(P, tt, lane);
    constexpr int NEXTRA = DN_ITEMS + (UP_ITEMS - UP_IN_P0);
    for (int it = iw; it < NEXTRA; it += NIW) {
        if (it < DN_ITEMS) p0_transpose_item<false>(P.w_down, DFF, DMODEL, (bf16*)(P.ws + WS_WDOWNT), nullptr, scr, it, lane);
        else p0_transpose_item<true>(P.w_up, DMODEL, DFF2, (bf16*)(P.ws + WS_WUPT), P.g_ffn, scr, UP_IN_P0 + it - DN_ITEMS, lane);
    }
}

__device__ __forceinline__ void mix_conv_task(const Ptrs& P, int blk, int lane, int cg0, int cg1) {
    const bf16* z = (const bf16*)(P.ws + WS_Z); bf16* mix = (bf16*)(P.ws + WS_MIX);
    const int t0 = blk * 16;
    for (int cg = cg0 + lane; cg < cg1; cg += 64) {
        const int c = cg * 8;
        float w0[8], w1[8], w2[8], p1[8], p2[8];
#pragma unroll
        for (int e = 0; e < 8; ++e) { w0[e] = P.conv_w[c + e]; w1[e] = P.conv_w[DCONV + c + e]; w2[e] = P.conv_w[2 * DCONV + c + e]; }
        { float a[8], b[8]; unpack8(*(const u32x4*)(z + (long)(t0 - 2) * DIN + DCONV + c), a); unpack8(*(const u32x4*)(z + (long)(t0 - 2) * DIN + 2 * DCONV + c), b);
#pragma unroll
          for (int e = 0; e < 8; ++e) p2[e] = a[e] * b[e];
          unpack8(*(const u32x4*)(z + (long)(t0 - 1) * DIN + DCONV + c), a); unpack8(*(const u32x4*)(z + (long)(t0 - 1) * DIN + 2 * DCONV + c), b);
#pragma unroll
          for (int e = 0; e < 8; ++e) p1[e] = a[e] * b[e]; }
#pragma unroll 4
        for (int r = 0; r < 16; ++r) {
            const int t = t0 + r; float p[8], a[8], b[8], g[8], o[8];
            unpack8(*(const u32x4*)(z + (size_t)t * DIN + DCONV + c), a); unpack8(*(const u32x4*)(z + (size_t)t * DIN + 2 * DCONV + c), b); unpack8(*(const u32x4*)(z + (size_t)t * DIN + c), g);
#pragma unroll
            for (int e = 0; e < 8; ++e) { p[e] = a[e] * b[e]; o[e] = g[e] * (w2[e] * p[e] + w1[e] * p1[e] + w0[e] * p2[e]); p2[e] = p1[e]; p1[e] = p[e]; }
            *(u32x4*)(mix + (size_t)t * DMODEL + c) = pack8(o);
        }
    }
}
template <int g> __device__ __forceinline__ void mix_pool_task(const Ptrs& P, int blk, int lane) {
    constexpr int k = 2 << g;
    const char* zu = (const char*)((const bf16*)(P.ws + WS_Z) + (size_t)(blk * 16) * DIN + 3 * DCONV + PGD * g);
    const char* wu = (const char*)((const bf16*)(P.ws + WS_POOLWT) + (size_t)g * PGD * PGD);
    bf16* mix = (bf16*)(P.ws + WS_MIX);
    const int fr = lane & 15, fq = lane >> 4, t = blk * 16 + fr;
    const unsigned zl = (unsigned)(fr * DIN + 8 * fq) * 2u, wl = (unsigned)(fr * PGD + 8 * fq) * 2u;
    const int cnt = (t + 1 < k) ? t + 1 : k; const float inv = 1.0f / (float)cnt;
    f32x4 acc[12];
#pragma unroll
    for (int n = 0; n < 12; ++n) acc[n] = (f32x4){0.f, 0.f, 0.f, 0.f};
#pragma unroll 1
    for (int ks = 0; ks < 6; ++ks) {
        float sum[8], self[8];
        unpack8(*(const u32x4*)(zu + ks * 64 + zl), self);
#pragma unroll
        for (int e = 0; e < 8; ++e) sum[e] = self[e];
#pragma unroll
        for (int j = 1; j < k; ++j) { float v[8]; unpack8(*(const u32x4*)(zu + ks * 64 - (long)j * (DIN * 2) + zl), v);
#pragma unroll
            for (int e = 0; e < 8; ++e) sum[e] += v[e]; }
        float pl[8];
#pragma unroll
        for (int e = 0; e < 8; ++e) pl[e] = sum[e] * inv - self[e];
        const bf16x8 pf = __builtin_bit_cast(bf16x8, pack8(pl));
#pragma unroll
        for (int n = 0; n < 12; ++n) { const bf16x8 wf = *(const bf16x8*)(wu + n * (16 * PGD * 2) + ks * 64 + wl); acc[n] = __builtin_amdgcn_mfma_f32_16x16x32_bf16(wf, pf, acc[n], 0, 0, 0); }
    }
#pragma unroll
    for (int n = 0; n < 12; ++n) { const int d = 16 * n + 4 * fq; const f32x4 sc = *(const f32x4*)(P.pool_scale + PGD * g + d);
        u32x2 o; o.x = pk2(acc[n][0] * sc[0], acc[n][1] * sc[1]); o.y = pk2(acc[n][2] * sc[2], acc[n][3] * sc[3]);
        *(u32x2*)(mix + (size_t)t * DMODEL + DCONV + PGD * g + d) = o; }
}
__device__ __forceinline__ void mix_attn_task(const Ptrs& P, int h, int blk, int lane) {
    const bf16* z = (const bf16*)(P.ws + WS_Z); bf16* mix = (bf16*)(P.ws + WS_MIX); const bf16* Kb = (const bf16*)(P.ws + WS_KB); const bf16* Vt = (const bf16*)(P.ws + WS_VT);
    const int fr = lane & 15, fq = lane >> 4, t = blk * 16 + fr;
    bf16x8 qf[4];
#pragma unroll
    for (int ks = 0; ks < 4; ++ks) qf[ks] = *(const bf16x8*)(z + (size_t)t * DIN + 3 * DCONV + DPOOL + 128 * h + 32 * ks + 8 * fq);
    f32x4 s[16];
#pragma unroll
    for (int kb = 0; kb < 16; ++kb) { s[kb] = (f32x4){0.f, 0.f, 0.f, 0.f};
#pragma unroll
        for (int ks = 0; ks < 4; ++ks) { const bf16x8 kf = *(const bf16x8*)(Kb + (size_t)(16 * kb + fr) * 512 + 128 * h + 32 * ks + 8 * fq); s[kb] = __builtin_amdgcn_mfma_f32_16x16x32_bf16(kf, qf[ks], s[kb], 0, 0, 0); } }
    float mx = -3.0e38f;
#pragma unroll
    for (int kb = 0; kb < 16; ++kb) mx = fmaxf(fmaxf(fmaxf(s[kb][0], s[kb][1]), fmaxf(s[kb][2], s[kb][3])), mx);
    mx = fmaxf(mx, __shfl_xor(mx, 16)); mx = fmaxf(mx, __shfl_xor(mx, 32));
    const float c2 = 0.08838834764831845f * 1.4426950408889634f;
    float sum = 0.f;
#pragma unroll
    for (int kb = 0; kb < 16; ++kb)
#pragma unroll
        for (int r = 0; r < 4; ++r) { const float p = __builtin_amdgcn_exp2f((s[kb][r] - mx) * c2); s[kb][r] = p; sum += p; }
    sum += __shfl_xor(sum, 16); sum += __shfl_xor(sum, 32);
    const float inv = 1.0f / sum;
    f32x4 o[8];
#pragma unroll
    for (int db = 0; db < 8; ++db) o[db] = (f32x4){0.f, 0.f, 0.f, 0.f};
#pragma unroll
    for (int ks = 0; ks < 8; ++ks) {
        u32x4 pw; pw.x = pk2(s[2 * ks][0], s[2 * ks][1]); pw.y = pk2(s[2 * ks][2], s[2 * ks][3]); pw.z = pk2(s[2 * ks + 1][0], s[2 * ks + 1][1]); pw.w = pk2(s[2 * ks + 1][2], s[2 * ks + 1][3]);
        const bf16x8 pf = __builtin_bit_cast(bf16x8, pw);
#pragma unroll
        for (int db = 0; db < 8; ++db) { const bf16x8 vf = *(const bf16x8*)(Vt + (size_t)(128 * h + 16 * db + fr) * 256 + 32 * ks + 8 * fq); o[db] = __builtin_amdgcn_mfma_f32_16x16x32_bf16(vf, pf, o[db], 0, 0, 0); }
    }
#pragma unroll
    for (int db = 0; db < 8; ++db) { u32x2 w; w.x = pk2(o[db][0] * inv, o[db][1] * inv); w.y = pk2(o[db][2] * inv, o[db][3] * inv);
        *(u32x2*)(mix + (size_t)t * DMODEL + DCONV + DPOOL + 128 * h + 16 * db + 4 * fq) = w; }
}
template <int R, int C, int PCH> __device__ __forceinline__ void lds_stage_rows(LAS unsigned char* dst, const unsigned char* src, int gp, int tid) {
    constexpr int N = R * C, PER = (N + 511) / 512;
    u32x4 v[PER];
#pragma unroll
    for (int i = 0; i < PER; ++i) { const int idx = tid + 512 * i; if (idx < N) { const int row = idx / C, ch = idx % C; v[i] = *(const u32x4*)(src + (size_t)row * gp + ch * 16); } }
#pragma unroll
    for (int i = 0; i < PER; ++i) { const int idx = tid + 512 * i; if (idx < N) { const int row = idx / C, ch = idx % C; *(LAS u32x4*)(dst + row * (PCH * 16) + (((ch & ~15) | ((ch & 15) ^ (row & 15))) << 4)) = v[i]; } }
}
template <int N> __device__ __forceinline__ float dpp_shrN(float old, float src) { return __builtin_bit_cast(float, __builtin_amdgcn_update_dpp(__builtin_bit_cast(int, old), __builtin_bit_cast(int, src), 0x110 + N, 0xf, 0xf, false)); }
template <int N> __device__ __forceinline__ float dpp_rorN(float src) { return __builtin_bit_cast(float, __builtin_amdgcn_mov_dpp(__builtin_bit_cast(int, src), 0x120 + N, 0xf, 0xf, false)); }
template <int N> __device__ __forceinline__ float scan_step(float x, float p) { return x + dpp_shrN<N>(dpp_rorN<N>(p), x); }
template <int N> __device__ __forceinline__ float scan_step_prev(float p) { return p + dpp_shrN<N>(0.f, p); }

__device__ __forceinline__ void mix_attn_wave(const Ptrs& P, LAS unsigned char* ldsK, LAS unsigned char* ldsV, int h, int row0, int lane) {
    const bf16* z = (const bf16*)(P.ws + WS_Z); bf16* mix = (bf16*)(P.ws + WS_MIX);
    const int fr = lane & 15, fq = lane >> 4;
    bf16x8 q0[4], q1[4];
#pragma unroll
    for (int ks = 0; ks < 4; ++ks) { const bf16* qp = z + (size_t)(row0 + fr) * DIN + 3 * DCONV + DPOOL + 128 * h + 32 * ks + 8 * fq; q0[ks] = *(const bf16x8*)qp; q1[ks] = *(const bf16x8*)(qp + 16 * DIN); }
    unsigned offk[4];
#pragma unroll
    for (int ks = 0; ks < 4; ++ks) offk[ks] = (unsigned)(fr * 256 + (((4 * ks + fq) ^ fr) << 4));
    f32x4 s0[16], s1[16];
#pragma unroll
    for (int kb = 0; kb < 16; ++kb) { s0[kb] = (f32x4){0.f, 0.f, 0.f, 0.f}; s1[kb] = (f32x4){0.f, 0.f, 0.f, 0.f};
#pragma unroll
        for (int ks = 0; ks < 4; ++ks) { const bf16x8 kf = *(const LAS bf16x8*)(ldsK + kb * 4096 + offk[ks]);
            s0[kb] = __builtin_amdgcn_mfma_f32_16x16x32_bf16(kf, q0[ks], s0[kb], 0, 0, 0); s1[kb] = __builtin_amdgcn_mfma_f32_16x16x32_bf16(kf, q1[ks], s1[kb], 0, 0, 0); } }
    const float c2 = 0.08838834764831845f * 1.4426950408889634f;
    bf16x8 p0[8], p1[8]; float inv0, inv1;
    {   float mx = -3.0e38f;
#pragma unroll
        for (int kb = 0; kb < 16; ++kb) mx = fmaxf(fmaxf(fmaxf(s0[kb][0], s0[kb][1]), fmaxf(s0[kb][2], s0[kb][3])), mx);
        mx = fmaxf(mx, __shfl_xor(mx, 16)); mx = fmaxf(mx, __shfl_xor(mx, 32));
        float sum = 0.f;
#pragma unroll
        for (int ks = 0; ks < 8; ++ks) { float e[8];
#pragma unroll
            for (int r = 0; r < 4; ++r) { e[r] = __builtin_amdgcn_exp2f((s0[2 * ks][r] - mx) * c2); e[4 + r] = __builtin_amdgcn_exp2f((s0[2 * ks + 1][r] - mx) * c2); }
            sum += ((e[0] + e[1]) + (e[2] + e[3])) + ((e[4] + e[5]) + (e[6] + e[7]));
            p0[ks] = __builtin_bit_cast(bf16x8, pack8(e)); }
        sum += __shfl_xor(sum, 16); sum += __shfl_xor(sum, 32); inv0 = 1.0f / sum; }
    {   float mx = -3.0e38f;
#pragma unroll
        for (int kb = 0; kb < 16; ++kb) mx = fmaxf(fmaxf(fmaxf(s1[kb][0], s1[kb][1]), fmaxf(s1[kb][2], s1[kb][3])), mx);
        mx = fmaxf(mx, __shfl_xor(mx, 16)); mx = fmaxf(mx, __shfl_xor(mx, 32));
        float sum = 0.f;
#pragma unroll
        for (int ks = 0; ks < 8; ++ks) { float e[8];
#pragma unroll
            for (int r = 0; r < 4; ++r) { e[r] = __builtin_amdgcn_exp2f((s1[2 * ks][r] - mx) * c2); e[4 + r] = __builtin_amdgcn_exp2f((s1[2 * ks + 1][r] - mx) * c2); }
            sum += ((e[0] + e[1]) + (e[2] + e[3])) + ((e[4] + e[5]) + (e[6] + e[7]));
            p1[ks] = __builtin_bit_cast(bf16x8, pack8(e)); }
        sum += __shfl_xor(sum, 16); sum += __shfl_xor(sum, 32); inv1 = 1.0f / sum; }
    f32x4 o0[8], o1[8];
#pragma unroll
    for (int db = 0; db < 8; ++db) { o0[db] = (f32x4){0.f, 0.f, 0.f, 0.f}; o1[db] = (f32x4){0.f, 0.f, 0.f, 0.f}; }
#pragma unroll
    for (int ks = 0; ks < 8; ++ks) {
        const unsigned offv = (unsigned)(fr * 512 + ((ks >> 2) << 8) + (((4 * (ks & 3) + fq) ^ fr) << 4));
#pragma unroll
        for (int db = 0; db < 8; ++db) { const bf16x8 vf = *(const LAS bf16x8*)(ldsV + db * 8192 + offv);
            o0[db] = __builtin_amdgcn_mfma_f32_16x16x32_bf16(vf, p0[ks], o0[db], 0, 0, 0); o1[db] = __builtin_amdgcn_mfma_f32_16x16x32_bf16(vf, p1[ks], o1[db], 0, 0, 0); } }
    bf16* op = mix + (size_t)(row0 + fr) * DMODEL + DCONV + DPOOL + 128 * h + 4 * fq;
#pragma unroll
    for (int db = 0; db < 8; ++db) { u32x2 w; w.x = pk2(o0[db][0] * inv0, o0[db][1] * inv0); w.y = pk2(o0[db][2] * inv0, o0[db][3] * inv0); *(u32x2*)(op + 16 * db) = w;
        w.x = pk2(o1[db][0] * inv1, o1[db][1] * inv1); w.y = pk2(o1[db][2] * inv1, o1[db][3] * inv1); *(u32x2*)(op + (size_t)16 * DMODEL + 16 * db) = w; }
}

template <int g> __device__ __forceinline__ void mix_pool_wave(const Ptrs& P, LAS unsigned char* ldsW, int row0, int lane) {
    constexpr int k = 2 << g;
    const bf16* z = (const bf16*)(P.ws + WS_Z); bf16* mix = (bf16*)(P.ws + WS_MIX);
    const int fr = lane & 15, fq = lane >> 4;
    f32x4 acc0[12], acc1[12];
#pragma unroll
    for (int n = 0; n < 12; ++n) { acc0[n] = (f32x4){0.f, 0.f, 0.f, 0.f}; acc1[n] = (f32x4){0.f, 0.f, 0.f, 0.f}; }
    const float invA = 1.0f / (float)((row0 + fr + 1 < k) ? row0 + fr + 1 : k), invB = 1.0f / (float)((row0 + 16 + fr + 1 < k) ? row0 + 16 + fr + 1 : k);
#pragma unroll 1
    for (int ks = 0; ks < 6; ++ks) {
        const bf16* zp = z + (long)(row0 - 16 + fr) * DIN + 3 * DCONV + PGD * g + 32 * ks + 8 * fq;
        float pv[8], xa[8], xb[8], sa[8], sb[8];
        unpack8(*(const u32x4*)zp, pv); unpack8(*(const u32x4*)(zp + 16 * DIN), xa); unpack8(*(const u32x4*)(zp + 32 * DIN), xb);
#pragma unroll
        for (int e = 0; e < 8; ++e) {
            float p = pv[e], a = xa[e], b = xb[e];
            float b1 = scan_step<1>(b, a), a1 = scan_step<1>(a, p), p1 = scan_step_prev<1>(p);
            if (k >= 4) { const float b2 = scan_step<2>(b1, a1), a2 = scan_step<2>(a1, p1), p2 = scan_step_prev<2>(p1); b1 = b2; a1 = a2; p1 = p2; }
            if (k >= 8) { const float b2 = scan_step<4>(b1, a1), a2 = scan_step<4>(a1, p1), p2 = scan_step_prev<4>(p1); b1 = b2; a1 = a2; p1 = p2; }
            if (k >= 16) { const float b2 = scan_step<8>(b1, a1), a2 = scan_step<8>(a1, p1); b1 = b2; a1 = a2; }
            sa[e] = a1 * invA - a; sb[e] = b1 * invB - b; }
        const bf16x8 fa = __builtin_bit_cast(bf16x8, pack8(sa)), fb = __builtin_bit_cast(bf16x8, pack8(sb));
        const unsigned offw = (unsigned)(fr * 512 + ((ks >> 2) << 8) + (((4 * (ks & 3) + fq) ^ fr) << 4));
#pragma unroll
        for (int n = 0; n < 12; ++n) { const bf16x8 wf = *(const LAS bf16x8*)(ldsW + n * 8192 + offw);
            acc0[n] = __builtin_amdgcn_mfma_f32_16x16x32_bf16(wf, fa, acc0[n], 0, 0, 0); acc1[n] = __builtin_amdgcn_mfma_f32_16x16x32_bf16(wf, fb, acc1[n], 0, 0, 0); }
    }
    bf16* op = mix + (size_t)(row0 + fr) * DMODEL + DCONV + PGD * g + 4 * fq;
#pragma unroll
    for (int n = 0; n < 12; ++n) { const f32x4 sc = *(const f32x4*)(P.pool_scale + PGD * g + 16 * n + 4 * fq);
        u32x2 o; o.x = pk2(acc0[n][0] * sc[0], acc0[n][1] * sc[1]); o.y = pk2(acc0[n][2] * sc[2], acc0[n][3] * sc[3]); *(u32x2*)(op + 16 * n) = o;
        o.x = pk2(acc1[n][0] * sc[0], acc1[n][1] * sc[1]); o.y = pk2(acc1[n][2] * sc[2], acc1[n][3] * sc[3]); *(u32x2*)(op + (size_t)16 * DMODEL + 16 * n) = o; }
}

__device__ __forceinline__ void p2_mixer(const Ptrs& P, LAS unsigned char* lds, int w, int tid, int wave, int lane, int tmask) {
    const int sub = w & 3, tile = w >> 2, row0 = tile * 256 + (wave & 3) * 64;
    lds_stage_rows<256, 16, 16>(lds, (const unsigned char*)(P.ws + WS_KB) + 256 * sub, 1024, tid);
    lds_stage_rows<128, 32, 32>(lds + 65536, (const unsigned char*)(P.ws + WS_VT) + (size_t)sub * 128 * 512, 512, tid);
    LDS_WAIT(); __syncthreads();
    if (wave < 4) { if (tmask & 0x1e0) {
#pragma unroll 1
        for (int p = 0; p < 2; ++p) { asm volatile("" ::: "memory"); mix_attn_wave(P, lds, lds + 65536, sub, row0 + 32 * p, lane); } } }
    else if (tmask & 1) mix_conv_task(P, 4 * w + (wave - 4), lane, 0, 48);
    __syncthreads();
    lds_stage_rows<192, 24, 32>(lds, (const unsigned char*)(P.ws + WS_POOLWT) + (size_t)sub * PGD * PGD * 2, PGD * 2, tid);
    LDS_WAIT(); __syncthreads();
    if (wave < 4) { if (tmask & 0x1e) {
#pragma unroll 1
        for (int p = 0; p < 2; ++p) { const int r = row0 + 32 * p; asm volatile("" ::: "memory");
            if (sub == 0) mix_pool_wave<0>(P, lds, r, lane); else if (sub == 1) mix_pool_wave<1>(P, lds, r, lane); else if (sub == 2) mix_pool_wave<2>(P, lds, r, lane); else mix_pool_wave<3>(P, lds, r, lane); } } }
    else if (tmask & 1) mix_conv_task(P, 4 * w + (wave - 4), lane, 48, 96);
    __syncthreads();
}

__device__ __forceinline__ void p5_fixup(const Ptrs& P, int gt, int NGT) {
    const float* ub = (const float*)(P.ws + WS_UBND); bf16* act = (bf16*)(P.ws + WS_ACT); const float* cw = P.ffn_conv_w; const float* cb = P.ffn_conv_b;
    for (int i = gt; i < 63 * (DFF / 8); i += NGT) {
        const int pm = 1 + i / (DFF / 8), c = (i % (DFF / 8)) * 8, gi = 256 * (c / 128) + (c % 128);
        const float* p2 = ub + (size_t)((pm - 1) * 4 + 2) * DFF2 + gi; const float* p1 = p2 + DFF2; const float* r0 = ub + (size_t)(pm * 4) * DFF2 + gi; const float* r1 = r0 + DFF2;
        float o0[8], o1[8];
#pragma unroll
        for (int e = 0; e < 8; ++e) {
            const float gw0 = cw[c + e], gw1 = cw[DFF2 + c + e], gw2 = cw[2 * DFF2 + c + e], gb = cb[c + e], vw0 = cw[DFF + c + e], vw1 = cw[DFF2 + DFF + c + e], vw2 = cw[2 * DFF2 + DFF + c + e], vb = cb[DFF + c + e];
            const float G0 = gw2 * r0[e] + (gw1 * p1[e] + (gw0 * p2[e] + gb)), V0 = vw2 * r0[128 + e] + (vw1 * p1[128 + e] + (vw0 * p2[128 + e] + vb));
            const float G1 = gw2 * r1[e] + (gw1 * r0[e] + (gw0 * p1[e] + gb)), V1 = vw2 * r1[128 + e] + (vw1 * r0[128 + e] + (vw0 * p1[128 + e] + vb));
            o0[e] = G0 * __builtin_amdgcn_rcpf(1.0f + __builtin_amdgcn_exp2f(-1.4426950408889634f * G0)) * V0;
            o1[e] = G1 * __builtin_amdgcn_rcpf(1.0f + __builtin_amdgcn_exp2f(-1.4426950408889634f * G1)) * V1; }
        *(u32x4*)(act + (size_t)(256 * pm) * DFF + c) = pack8(o0); *(u32x4*)(act + (size_t)(256 * pm + 1) * DFF + c) = pack8(o1);
    }
}

__device__ __forceinline__ void p7_final(const Ptrs& P, int gw, int NGW, int lane) {
    const float* slab = (const float*)(P.ws + WS_SLAB2);
    for (int m = gw; m < SEQ; m += NGW) {
        const float part = (lane < 32) ? slab[(size_t)m * 32 + lane] : 0.f;
        const float rstd = 1.0f / sqrtf(wave_sum(part) * (1.0f / DMODEL) + EPS);
        f32x4* xr = (f32x4*)(P.out + (size_t)m * DMODEL) + lane; const f32x4* gr = (const f32x4*)P.g_final + lane;
#pragma unroll
        for (int j = 0; j < 8; ++j) { f32x4 v = xr[64 * j]; const f32x4 gg = gr[64 * j]; v = v * rstd * gg; xr[64 * j] = v; }
    }
}

struct Args { const float* in[16]; float* out; unsigned char* ws; int ph_lo, ph_hi; };
__global__ void __launch_bounds__(NWAVES * 64, 2) hybrid_fwd(Args args) {
    extern __shared__ __attribute__((aligned(16))) unsigned char lds_raw[];
    LAS unsigned char* lds = (LAS unsigned char*)lds_raw;
    cg::grid_group grid = cg::this_grid();
    const int tid = threadIdx.x, lane = tid & 63, wave = __builtin_amdgcn_readfirstlane(tid >> 6);
    const int G = gridDim.x, bx = blockIdx.x, vcu = (G % 8 == 0) ? (bx % 8) * (G / 8) + bx / 8 : bx;
    const int gw = vcu * NWAVES + wave, NGW = G * NWAVES;
    volatile LAS unsigned* MISC = (volatile LAS unsigned*)(lds + MISC_OFF);
    if (tid < 32) MISC[tid] = 0u;
    __syncthreads();
    const XcdBarrier bar = xcd_barrier_post((unsigned*)(args.ws + WS_CTL), MISC + 8);
    Ptrs P;
    P.x = args.in[0]; P.mem = args.in[1]; P.g_mix = args.in[2]; P.g_mem = args.in[3]; P.w_in = args.in[4]; P.conv_w = args.in[5]; P.pool_w = args.in[6]; P.pool_scale = args.in[7];
    P.w_kv = args.in[8]; P.w_out = args.in[9]; P.g_ffn = args.in[10]; P.w_up = args.in[11]; P.ffn_conv_w = args.in[12]; P.ffn_conv_b = args.in[13]; P.w_down = args.in[14]; P.g_final = args.in[15];
    P.out = args.out; P.ws = args.ws;
    unsigned char* ws = args.ws;
#if PROBE_SYNC
    for (int i = 0; i < 20; ++i) xcd_barrier(bar);
#endif
    const int lo = args.ph_lo, hi = args.ph_hi;
#define IN(k) (lo <= (k) && (k) < hi)
#define SYNC(k) do { if ((k) + 1 < hi) { if ((k) == 0 && USE_CG_SYNC) grid.sync(); else xcd_barrier(bar); } } while (0)
#define SYNCR(k, b) do { if ((k) + 1 < hi || rp + 1 < NREP(b)) { if ((k) == 0 && USE_CG_SYNC) grid.sync(); else xcd_barrier(bar); } } while (0)
#define NREP(b) ((REPM & (b)) ? 2 : 1)
    if (IN(0) && (PHM & 1)) for (int rp = 0; rp < NREP(1); ++rp) { p0_prologue(P, lds, gw, NGW, wave, lane); SYNCR(0, 1); }
    if (IN(1) && (PHM & 2)) for (int rp = 0; rp < NREP(2); ++rp) {
        pg8::Gemm g{(const bf16*)(ws + WS_H), (const bf16*)(ws + WS_WINT), SEQ, DIN, DMODEL}; pg8::StaticOrder S; S.init(SEQ, DIN, G, bx);
        pg8::EpiZ E{(bf16*)(ws + WS_Z), DIN};
        pg8::gemm_phase<pg8::EpiZ, pg8::StaticOrder, P1_ALIGN, true>(lds, g, S, E, lds + XLDS_OFF);
        { const int nfull = ((SEQ / 256) * (DIN / 256)) % G;
          if (nfull == 0) p1_idle_work(P, lds, bx * NWAVES + wave, G * NWAVES, wave, lane);
          else if (bx >= nfull) p1_idle_work(P, lds, (bx - nfull) * NWAVES + wave, (G - nfull) * NWAVES, wave, lane); }
        SYNCR(1, 2);
    }
    if (IN(2) && (PHM & 4)) for (int rp = 0; rp < NREP(4); ++rp) { p2_mixer(P, lds, vcu, tid, wave, lane, 511);
#if PROBE_P2
        p2_mixer(P, lds, vcu, tid, wave, lane, PROBE_P2);
#endif
        SYNCR(2, 4); }
    if (IN(3) && (PHM & 8)) {
        pg8::Gemm g{(const bf16*)(ws + WS_MIX), (const bf16*)(ws + WS_WOUTT), SEQ, DMODEL, DMODEL}; pg8::PanelOrder S{G, vcu, (SEQ / 256) * (DMODEL / 256)};
        pg8::EpiNorm<0> E{P.x, nullptr, nullptr, (float*)(ws + WS_SIG), (bf16*)(ws + WS_X1B), nullptr, nullptr, (unsigned*)(ws + WS_SLAB1), (unsigned*)(ws + WS_CTL) + CW_PANEL1, (unsigned*)(ws + WS_CTL) + XB_TMO};
        pg8::gemm_phase<pg8::EpiNorm<0>, pg8::PanelOrder, true, true>(lds, g, S, E, lds + XLDS_OFF);
        SYNC(3);
    }
#if PROBE_GEMM
    if (IN(3)) {
        pg8::Gemm g{(const bf16*)(ws + WS_X1B), (const bf16*)(ws + WS_WUPT), SEQ, PROBE_N, DMODEL}; pg8::StaticOrder S; S.init(SEQ, PROBE_N, G, bx);
#if PROBE_GEMM == 1
        pg8::EpiZ E{(bf16*)(ws + WS_Z), PROBE_N};
        pg8::gemm_phase<pg8::EpiZ, pg8::StaticOrder, true, true>(lds, g, S, E, lds + XLDS_OFF);
#elif PROBE_GEMM == 2
        pg8::EpiNone E{};
        pg8::gemm_phase<pg8::EpiNone, pg8::StaticOrder, true, true>(lds, g, S, E, lds + XLDS_OFF);
#elif PROBE_GEMM == 3
        pg8::EpiZ E{(bf16*)(ws + WS_Z), PROBE_N};
        pg8::gemm_phase<pg8::EpiZ, pg8::StaticOrder, true, false>(lds, g, S, E, lds + XLDS_OFF);
#elif PROBE_GEMM == 5
        pg8::EpiAct E{(bf16*)(ws + WS_ACT), P.ffn_conv_w, P.ffn_conv_b, (float*)(ws + WS_UBND)};
        pg8::gemm_phase<pg8::EpiAct, pg8::StaticOrder, true, true>(lds, g, S, E, lds + XLDS_OFF);
#elif PROBE_GEMM == 4
        pg8::EpiZ E{(bf16*)(ws + WS_Z), PROBE_N};
        pg8::gemm_phase<pg8::EpiZ, pg8::StaticOrder, false, true>(lds, g, S, E, lds + XLDS_OFF);
#endif
        xcd_barrier(bar);
    }
#endif
    if (IN(4) && (PHM & 16)) for (int rp = 0; rp < NREP(16); ++rp) {
        pg8::Gemm g{(const bf16*)(ws + WS_X1B), (const bf16*)(ws + WS_WUPT), SEQ, DFF2, DMODEL}; pg8::StaticOrder S; S.init(SEQ, DFF2, G, bx);
        pg8::EpiAct E{(bf16*)(ws + WS_ACT), P.ffn_conv_w, P.ffn_conv_b, (float*)(ws + WS_UBND)};
        pg8::gemm_phase<pg8::EpiAct, pg8::StaticOrder, true, true>(lds, g, S, E, lds + XLDS_OFF);
        SYNCR(4, 16);
    }
    if (IN(5) && (PHM & 32)) { p5_fixup(P, vcu * (NWAVES * 64) + tid, G * NWAVES * 64); SYNC(5); }
    if (IN(6) && (PHM & 64)) {
        pg8::Gemm g{(const bf16*)(ws + WS_ACT), (const bf16*)(ws + WS_WDOWNT), SEQ, DMODEL, DFF}; pg8::PanelOrder S{G, vcu, (SEQ / 256) * (DMODEL / 256)};
        pg8::EpiNorm<1> E{nullptr, (const bf16*)(ws + WS_X1B), (const float*)(ws + WS_SIG), nullptr, nullptr, P.out, P.g_final, (unsigned*)(ws + WS_SLAB2), (unsigned*)(ws + WS_CTL) + CW_PANEL, (unsigned*)(ws + WS_CTL) + XB_TMO};
        pg8::gemm_phase<pg8::EpiNorm<1>, pg8::PanelOrder, true, true>(lds, g, S, E, lds + XLDS_OFF);
    }
#undef IN
#undef SYNC
}

extern "C" void kernel_launch(void* const* d_in, const int* in_sizes, int n_in, void* d_out, int out_size, void* d_ws, size_t ws_size, hipStream_t stream) {
    static int grid = 0;
    if (grid == 0) {
        if (n_in != 16 || in_sizes[0] != SEQ * DMODEL || out_size != SEQ * DMODEL || ws_size < WS_END) { fprintf(stderr, "kernel_launch: unexpected shapes (n_in %d, in0 %d, out %d, ws %zu)\n", n_in, n_in > 0 ? in_sizes[0] : -1, out_size, ws_size); grid = -1; return; }
        int dev = 0, cus = 0, per_cu = 0;
        if (hipGetDevice(&dev) != hipSuccess || hipDeviceGetAttribute(&cus, hipDeviceAttributeMultiprocessorCount, dev) != hipSuccess) { grid = -1; return; }
        if (hipFuncSetAttribute((const void*)hybrid_fwd, hipFuncAttributeMaxDynamicSharedMemorySize, LDS_BYTES) != hipSuccess) { fprintf(stderr, "kernel_launch: hipFuncSetAttribute failed\n"); grid = -1; return; }
        if (hipOccupancyMaxActiveBlocksPerMultiprocessor(&per_cu, (const void*)hybrid_fwd, NWAVES * 64, LDS_BYTES) != hipSuccess || per_cu < 1) { fprintf(stderr, "kernel_launch: occupancy query says %d blocks per CU\n", per_cu); (void)hipGetLastError(); per_cu = 1; }
        grid = cus;
        if (grid % 8 != 0 || grid < 8) { fprintf(stderr, "kernel_launch: %d CUs\n", grid); }
    }
    if (grid < 0) return;
    if (hipMemsetAsync((char*)d_ws + WS_CTL, 0, CTL_ZERO_BYTES, stream) != hipSuccess) { fprintf(stderr, "kernel_launch: hipMemsetAsync failed\n"); return; }
    Args a{};
    for (int i = 0; i < 16; ++i) a.in[i] = (const float*)d_in[i];
    a.out = (float*)d_out; a.ws = (unsigned char*)d_ws;
#if MK_PER_PHASE
    for (int ph = 0; ph < NPHASE; ++ph) { a.ph_lo = ph; a.ph_hi = ph + 1; hipLaunchKernelGGL(hybrid_fwd, dim3(grid), dim3(NWAVES * 64), LDS_BYTES, stream, a); }
#else
    a.ph_lo = 0; a.ph_hi = NPHASE;
    void* kargs[] = {&a};
    hipError_t e = hipLaunchCooperativeKernel((const void*)hybrid_fwd, dim3(grid), dim3(NWAVES * 64), kargs, LDS_BYTES, stream);
    if (e != hipSuccess) fprintf(stderr, "kernel_launch: cooperative launch failed: %s (grid %d)\n", hipGetErrorString(e), grid);
#endif
}
```

```cpp
#include <hip/hip_runtime.h>
#include <hip/hip_cooperative_groups.h>
#include <cstdio>
#include <cstdint>
namespace cg = cooperative_groups;
#ifndef PG8_PRIO
#define PG8_PRIO 0
#endif
namespace pg8 {
#define PG8_LAS __attribute__((address_space(3)))
typedef unsigned short bf16_t;
typedef short bf16x8 __attribute__((ext_vector_type(8)));
typedef float f32x4 __attribute__((ext_vector_type(4)));
typedef unsigned u32x4 __attribute__((ext_vector_type(4)));
constexpr int BM = 256, BK = 64, HALF = 128, HTB = HALF * BK * 2  , STAGE_BYTES = 8 * HTB, NXCD = 8, WGM = 8;

__host__ __device__ __forceinline__ int lds_byte(int r, int c) { const int st = (r >> 4) * 2 + (c >> 5), rr = r & 15, cc = c & 31, ob = rr * 64 + cc * 2; return st * 1024 + (ob ^ (((ob >> 9) & 1) << 5)); }
__host__ __device__ __forceinline__ void stage_rc(int b, int& R, int& C) { const int st = b / 1024, sb = b % 1024, swz = sb ^ (((sb >> 9) & 1) << 5); R = (st >> 1) * 16 + swz / 64; C = (st & 1) * 32 + (swz % 64) / 2; }
__host__ __device__ __forceinline__ int perm32(int rho) { const int n = rho >> 4, i = rho & 15; return 8 * (i >> 2) + 4 * n + (i & 3); }

struct Unit { int pm, pn; };
struct Gemm { const bf16_t* A; const bf16_t* Bt; int M, N, K; };

struct StaticOrder {
    int nM, nN, nwg, G, c;
    __host__ __device__ void init(int M, int N, int G_, int c_) { nM = M / BM; nN = N / BM; nwg = nM * nN; G = G_; c = c_; }
    __host__ __device__ bool next(int i, Unit& u) const {
        const long L = (long)i * G + c; if (L >= nwg) return false;
        int wgid = (int)L; { const int q = nwg / NXCD, r = nwg % NXCD, xcd = wgid % NXCD, off = wgid / NXCD; wgid = (xcd < r ? xcd * (q + 1) : r * (q + 1) + (xcd - r) * q) + off; }
        const int nig = WGM * nN, gid = wgid / nig, fm = gid * WGM, gsz = (nM - fm) < WGM ? (nM - fm) : WGM;
        u.pm = fm + ((wgid % nig) % gsz); u.pn = (wgid % nig) / gsz; return true;
    }
    __device__ __forceinline__ void a_ready(const Unit&) const {}
    __device__ __forceinline__ void done(const Unit&) const {}
};
__device__ __forceinline__ unsigned cvt_pk_bf16(float lo, float hi) { unsigned r; asm volatile("v_cvt_pk_bf16_f32 %0, %1, %2" : "=v"(r) : "v"(lo), "v"(hi)); return r; }
typedef unsigned u32x2 __attribute__((ext_vector_type(2)));
constexpr int DM = 2048;
constexpr float RMS_EPS = 1e-6f;

struct EpiZ {
    static constexpr bool PERM = true, AFTER_DRAIN = false;
    bf16_t* O; int ldc;
    __device__ __forceinline__ void operator()(const f32x4 (&acc)[2][2][4][2], const Unit& u, int wr, int wc, int fr_, int fq_, PG8_LAS unsigned char*) const {
        int t_ = threadIdx.x; asm volatile("" : "+v"(t_));
        const int fr = t_ & 15, fq = (t_ >> 4) & 3;
        const int row0 = u.pm * BM + wr * 64 + fr, col0 = u.pn * BM + wc * 32 + 8 * fq;
#pragma unroll
        for (int ai = 0; ai < 2; ++ai)
#pragma unroll
            for (int m = 0; m < 4; ++m) { bf16_t* rowp = O + (size_t)(row0 + ai * HALF + m * 16) * ldc + col0;
#pragma unroll
                for (int bj = 0; bj < 2; ++bj) { const f32x4 v0 = acc[ai][bj][m][0], v1 = acc[ai][bj][m][1];
                    u32x4 w; w.x = cvt_pk_bf16(v0[0], v0[1]); w.y = cvt_pk_bf16(v0[2], v0[3]); w.z = cvt_pk_bf16(v1[0], v1[1]); w.w = cvt_pk_bf16(v1[2], v1[3]);
                    *(u32x4*)(rowp + bj * HALF) = w; } }
    }
};

struct EpiNone {
    static constexpr bool PERM = true, AFTER_DRAIN = false;
    __device__ __forceinline__ void operator()(const f32x4 (&acc)[2][2][4][2], const Unit& u, int wr, int wc, int fr, int fq, PG8_LAS unsigned char*) const {
#pragma unroll
        for (int ai = 0; ai < 2; ++ai)
#pragma unroll
            for (int bj = 0; bj < 2; ++bj)
#pragma unroll
                for (int m = 0; m < 4; ++m)
#pragma unroll
                    for (int n = 0; n < 2; ++n) asm volatile("" :: "v"(acc[ai][bj][m][n]));
    }
};
struct EpiResA {
    static constexpr bool PERM = true, AFTER_DRAIN = false;
    const float* R; bf16_t* XB; float* slab;
    __device__ __forceinline__ void operator()(const f32x4 (&acc)[2][2][4][2], const Unit& u, int wr, int wc, int fr_, int fq_, PG8_LAS unsigned char*) const {
        int t_ = threadIdx.x; asm volatile("" : "+v"(t_));
        const int fr = t_ & 15, fq = (t_ >> 4) & 3;
        const int row0 = u.pm * BM + wr * 64 + fr, col0 = u.pn * BM + wc * 32 + 8 * fq;
#pragma unroll
        for (int ai = 0; ai < 2; ++ai) {
            f32x4 r[4][2][2];
#pragma unroll
            for (int m = 0; m < 4; ++m)
#pragma unroll
                for (int bj = 0; bj < 2; ++bj) { const float* p = R + (size_t)(row0 + ai * HALF + m * 16) * DM + col0 + bj * HALF; r[m][bj][0] = *(const f32x4*)p; r[m][bj][1] = *(const f32x4*)(p + 4); }
#pragma unroll
            for (int m = 0; m < 4; ++m) { const int row = row0 + ai * HALF + m * 16; float ss = 0.f;
#pragma unroll
                for (int bj = 0; bj < 2; ++bj) { const f32x4 v0 = acc[ai][bj][m][0] + r[m][bj][0], v1 = acc[ai][bj][m][1] + r[m][bj][1];
                    u32x4 w; w.x = cvt_pk_bf16(v0[0], v0[1]); w.y = cvt_pk_bf16(v0[2], v0[3]); w.z = cvt_pk_bf16(v1[0], v1[1]); w.w = cvt_pk_bf16(v1[2], v1[3]);
                    *(u32x4*)(XB + (size_t)row * DM + col0 + bj * HALF) = w;
                    ss += (v0[0] * v0[0] + v0[1] * v0[1]) + (v0[2] * v0[2] + v0[3] * v0[3]) + (v1[0] * v1[0] + v1[1] * v1[1]) + (v1[2] * v1[2] + v1[3] * v1[3]); }
                ss += __shfl_xor(ss, 16); ss += __shfl_xor(ss, 32);
                if (fq == 0) slab[(size_t)row * 32 + u.pn * 4 + wc] = ss; }
            asm volatile("" ::: "memory"); }
    }
};
struct EpiResB {
    static constexpr bool PERM = true, AFTER_DRAIN = false;
    const bf16_t* RB; float* X; float* slab;
    __device__ __forceinline__ void operator()(const f32x4 (&acc)[2][2][4][2], const Unit& u, int wr, int wc, int fr_, int fq_, PG8_LAS unsigned char*) const {
        int t_ = threadIdx.x; asm volatile("" : "+v"(t_));
        const int fr = t_ & 15, fq = (t_ >> 4) & 3;
        const int row0 = u.pm * BM + wr * 64 + fr, col0 = u.pn * BM + wc * 32 + 8 * fq;
        u32x4 r[2][4][2];
#pragma unroll
        for (int ai = 0; ai < 2; ++ai)
#pragma unroll
            for (int m = 0; m < 4; ++m)
#pragma unroll
                for (int bj = 0; bj < 2; ++bj) r[ai][m][bj] = *(const u32x4*)(RB + (size_t)(row0 + ai * HALF + m * 16) * DM + col0 + bj * HALF);
#pragma unroll
        for (int ai = 0; ai < 2; ++ai)
#pragma unroll
            for (int m = 0; m < 4; ++m) { const int row = row0 + ai * HALF + m * 16; float ss = 0.f;
#pragma unroll
                for (int bj = 0; bj < 2; ++bj) { const u32x4 q = r[ai][m][bj];
                    const f32x4 r0 = {__builtin_bit_cast(float, q.x << 16), __builtin_bit_cast(float, q.x & 0xffff0000u), __builtin_bit_cast(float, q.y << 16), __builtin_bit_cast(float, q.y & 0xffff0000u)};
                    const f32x4 r1 = {__builtin_bit_cast(float, q.z << 16), __builtin_bit_cast(float, q.z & 0xffff0000u), __builtin_bit_cast(float, q.w << 16), __builtin_bit_cast(float, q.w & 0xffff0000u)};
                    const f32x4 v0 = acc[ai][bj][m][0] + r0, v1 = acc[ai][bj][m][1] + r1;
                    float* xp = X + (size_t)row * DM + col0 + bj * HALF; *(f32x4*)xp = v0; *(f32x4*)(xp + 4) = v1;
                    ss += (v0[0] * v0[0] + v0[1] * v0[1]) + (v0[2] * v0[2] + v0[3] * v0[3]) + (v1[0] * v1[0] + v1[1] * v1[1]) + (v1[2] * v1[2] + v1[3] * v1[3]); }
                ss += __shfl_xor(ss, 16); ss += __shfl_xor(ss, 32);
                if (fq == 0) slab[(size_t)row * 32 + u.pn * 4 + wc] = ss; }
    }
};

struct PanelOrder {
    int G, vcu, ntot;
    __device__ __forceinline__ bool next(int i, Unit& u) const { const int L = i * G + vcu; if (L >= ntot) return false; u.pm = L >> 3; u.pn = L & 7; return true; }
    __device__ __forceinline__ void a_ready(const Unit&) const {}
    __device__ __forceinline__ void done(const Unit&) const {}
};
template <int MODE  > struct EpiNorm {
    static constexpr bool PERM = (MODE == 0), AFTER_DRAIN = false;
    const float* Rf; const bf16_t* Rb; const float* sig_in; float* sig_out; bf16_t* HN; float* OUT; const float* gfin; unsigned* xbuf; unsigned* cnt; unsigned* tmo;
    __device__ __forceinline__ void operator()(f32x4 (&acc)[2][2][4][2], const Unit& u, int wr, int wc, int fr_, int fq_, PG8_LAS unsigned char* xlds) const {
        int t_ = threadIdx.x; asm volatile("" : "+v"(t_));
        const int fr = t_ & 15, fq = (t_ >> 4) & 3, wid = __builtin_amdgcn_readfirstlane(t_ >> 6);
        const int rl0 = wr * 64 + fr, row0 = u.pm * BM + rl0, col0 = u.pn * BM + wc * 32 + 8 * fq;
        PG8_LAS float* Pt = (PG8_LAS float*)xlds;
        PG8_LAS float* St = (PG8_LAS float*)(xlds + 4096);
        if constexpr (MODE == 0) {
#pragma unroll
            for (int ai = 0; ai < 2; ++ai) { f32x4 r[4][2][2];
#pragma unroll
                for (int m = 0; m < 4; ++m)
#pragma unroll
                    for (int bj = 0; bj < 2; ++bj) { const float* p = Rf + (size_t)(row0 + ai * HALF + m * 16) * DM + col0 + bj * HALF; r[m][bj][0] = *(const f32x4*)p; r[m][bj][1] = *(const f32x4*)(p + 4); }
#pragma unroll
                for (int m = 0; m < 4; ++m) { float ss = 0.f;
#pragma unroll
                    for (int bj = 0; bj < 2; ++bj) { const f32x4 v0 = acc[ai][bj][m][0] + r[m][bj][0], v1 = acc[ai][bj][m][1] + r[m][bj][1]; acc[ai][bj][m][0] = v0; acc[ai][bj][m][1] = v1;
                        ss += (v0[0] * v0[0] + v0[1] * v0[1]) + (v0[2] * v0[2] + v0[3] * v0[3]) + (v1[0] * v1[0] + v1[1] * v1[1]) + (v1[2] * v1[2] + v1[3] * v1[3]); }
                    ss += __shfl_xor(ss, 16); ss += __shfl_xor(ss, 32);
                    if (fq == 0) Pt[(ai * HALF + rl0 + m * 16) * 4 + wc] = ss; }
                asm volatile("" ::: "memory"); }
        } else { u32x2 r[2][4][2][2]; float sg[2][4]; const int colb = u.pn * BM + wc * 32 + 4 * fq;
#pragma unroll
            for (int ai = 0; ai < 2; ++ai)
#pragma unroll
                for (int m = 0; m < 4; ++m) { sg[ai][m] = sig_in[row0 + ai * HALF + m * 16];
#pragma unroll
                    for (int bj = 0; bj < 2; ++bj)
#pragma unroll
                        for (int n = 0; n < 2; ++n) r[ai][m][bj][n] = *(const u32x2*)(Rb + (size_t)(row0 + ai * HALF + m * 16) * DM + colb + bj * HALF + 16 * n); }
#pragma unroll
            for (int ai = 0; ai < 2; ++ai)
#pragma unroll
                for (int m = 0; m < 4; ++m) { float ss = 0.f; const float sgm = sg[ai][m];
#pragma unroll
                    for (int bj = 0; bj < 2; ++bj)
#pragma unroll
                        for (int n = 0; n < 2; ++n) { const u32x2 q = r[ai][m][bj][n];
                            const f32x4 r0 = {__builtin_bit_cast(float, q.x << 16), __builtin_bit_cast(float, q.x & 0xffff0000u), __builtin_bit_cast(float, q.y << 16), __builtin_bit_cast(float, q.y & 0xffff0000u)};
                            const f32x4 v0 = acc[ai][bj][m][n] + r0 * sgm; acc[ai][bj][m][n] = v0;
                            ss += (v0[0] * v0[0] + v0[1] * v0[1]) + (v0[2] * v0[2] + v0[3] * v0[3]); }
                    ss += __shfl_xor(ss, 16); ss += __shfl_xor(ss, 32);
                    if (fq == 0) Pt[(ai * HALF + rl0 + m * 16) * 4 + wc] = ss; } }
        asm volatile("s_waitcnt lgkmcnt(0)" ::: "memory"); __builtin_amdgcn_s_barrier(); asm volatile("" ::: "memory");
        if (t_ < 256) { const float s = (Pt[t_ * 4 + 0] + Pt[t_ * 4 + 1]) + (Pt[t_ * 4 + 2] + Pt[t_ * 4 + 3]);
            __hip_atomic_store(xbuf + (size_t)(u.pm * BM + t_) * 8 + u.pn, __builtin_bit_cast(unsigned, s), __ATOMIC_RELAXED, __HIP_MEMORY_SCOPE_AGENT); }
        asm volatile("s_waitcnt vmcnt(0)" ::: "memory");
        if (t_ < 256 && (t_ & 63) == 0) __hip_atomic_fetch_add(cnt + 64 * u.pm, 1u, __ATOMIC_RELAXED, __HIP_MEMORY_SCOPE_AGENT);
        if (wid == 0) {
            unsigned spins = 0;
            while ((unsigned)__builtin_amdgcn_readfirstlane(__hip_atomic_load(cnt + 64 * u.pm, __ATOMIC_RELAXED, __HIP_MEMORY_SCOPE_AGENT)) < 32u) {
                __builtin_amdgcn_s_sleep(2);
                if (++spins > (1u << 20)) { if ((t_ & 63) == 0) __hip_atomic_store(tmo, 1u, __ATOMIC_RELAXED, __HIP_MEMORY_SCOPE_AGENT); break; } }
            __builtin_amdgcn_fence(__ATOMIC_ACQUIRE, "agent");
        }
        asm volatile("s_waitcnt vmcnt(0) lgkmcnt(0)" ::: "memory"); __builtin_amdgcn_s_barrier(); asm volatile("" ::: "memory");
        if (t_ < 256) { const unsigned long long* sp = (const unsigned long long*)(xbuf + (size_t)(u.pm * BM + t_) * 8); float tot = 0.f;
#pragma unroll
            for (int q = 0; q < 4; ++q) { const unsigned long long w = __hip_atomic_load(sp + q, __ATOMIC_RELAXED, __HIP_MEMORY_SCOPE_AGENT);
                tot += __builtin_bit_cast(float, (unsigned)w); tot += __builtin_bit_cast(float, (unsigned)(w >> 32)); }
            const float sd = sqrtf(tot * (1.0f / DM) + RMS_EPS);
            St[t_] = 1.0f / sd;
            if (MODE == 0 && u.pn == 0) sig_out[u.pm * BM + t_] = sd; }
        asm volatile("s_waitcnt lgkmcnt(0)" ::: "memory"); __builtin_amdgcn_s_barrier(); asm volatile("" ::: "memory");
        if constexpr (MODE == 0) {
#pragma unroll
            for (int ai = 0; ai < 2; ++ai)
#pragma unroll
                for (int m = 0; m < 4; ++m) { const float rstd = St[ai * HALF + rl0 + m * 16]; bf16_t* op = HN + (size_t)(row0 + ai * HALF + m * 16) * DM + col0;
#pragma unroll
                    for (int bj = 0; bj < 2; ++bj) { const f32x4 v0 = acc[ai][bj][m][0] * rstd, v1 = acc[ai][bj][m][1] * rstd;
                        u32x4 w; w.x = cvt_pk_bf16(v0[0], v0[1]); w.y = cvt_pk_bf16(v0[2], v0[3]); w.z = cvt_pk_bf16(v1[0], v1[1]); w.w = cvt_pk_bf16(v1[2], v1[3]);
                        *(u32x4*)(op + bj * HALF) = w; } }
        } else {
            const int colb = u.pn * BM + wc * 32 + 4 * fq; const bool odd = fr & 1;
            f32x4 gg[2][2];
#pragma unroll
            for (int bj = 0; bj < 2; ++bj)
#pragma unroll
                for (int n = 0; n < 2; ++n) gg[bj][n] = *(const f32x4*)(gfin + colb + bj * HALF + 16 * n);
#pragma unroll
            for (int ai = 0; ai < 2; ++ai)
#pragma unroll
                for (int m = 0; m < 4; ++m) { const float rstd = St[ai * HALF + rl0 + m * 16]; float* op = OUT + (size_t)(row0 + ai * HALF + m * 16) * DM + colb;
#pragma unroll
                    for (int bj = 0; bj < 2; ++bj) {
                        const f32x4 o0 = acc[ai][bj][m][0] * rstd * gg[bj][0], o1 = acc[ai][bj][m][1] * rstd * gg[bj][1]; f32x4 dA, dB;
#pragma unroll
                        for (int j = 0; j < 4; ++j) { const float snd = odd ? o0[j] : o1[j];
                            const float rcv = __builtin_bit_cast(float, __builtin_amdgcn_mov_dpp(__builtin_bit_cast(int, snd), 0xB1, 0xf, 0xf, false));
                            dA[j] = odd ? rcv : o0[j]; dB[j] = odd ? o1[j] : rcv; }
                        float* pp = op + bj * HALF + (odd ? 16 : 0);
                        *(f32x4*)(pp - (odd ? DM : 0)) = dA; *(f32x4*)(pp + (odd ? 0 : DM)) = dB; } }
        }
    }
};

__device__ __forceinline__ float dpp_shr1(float old, float src) { return __builtin_bit_cast(float, __builtin_amdgcn_update_dpp(__builtin_bit_cast(int, old), __builtin_bit_cast(int, src), 0x111, 0xf, 0xf, false)); }
__device__ __forceinline__ float dpp_shr2(float old, float src) { return __builtin_bit_cast(float, __builtin_amdgcn_update_dpp(__builtin_bit_cast(int, old), __builtin_bit_cast(int, src), 0x112, 0xf, 0xf, false)); }
__device__ __forceinline__ float dpp_ror1(float src) { return __builtin_bit_cast(float, __builtin_amdgcn_mov_dpp(__builtin_bit_cast(int, src), 0x121, 0xf, 0xf, false)); }
__device__ __forceinline__ float dpp_ror2(float src) { return __builtin_bit_cast(float, __builtin_amdgcn_mov_dpp(__builtin_bit_cast(int, src), 0x122, 0xf, 0xf, false)); }
constexpr int FF = 5632, FF2 = 11264;
struct EpiAct {
    static constexpr bool PERM = true, AFTER_DRAIN = false;
    bf16_t* ACT; const float* cw; const float* cb; float* ubnd;
    __device__ __forceinline__ void operator()(f32x4 (&acc)[2][2][4][2], const Unit& u, int wr, int wc, int fr_, int fq_, PG8_LAS unsigned char* xlds) const {
        int t_ = threadIdx.x; asm volatile("" : "+v"(t_));
        const int fr = t_ & 15, fq = (t_ >> 4) & 3;
        const int row0 = u.pm * BM + wr * 64 + fr, cl = wc * 32 + 8 * fq;
        const int c0 = u.pn * 128 + cl;
        f32x4 wgt[2][8];
#pragma unroll
        for (int n = 0; n < 2; ++n) { const float* wp = cw + c0 + 4 * n; const float* bp = cb + c0 + 4 * n;
            wgt[n][0] = *(const f32x4*)wp; wgt[n][1] = *(const f32x4*)(wp + FF2); wgt[n][2] = *(const f32x4*)(wp + 2 * FF2); wgt[n][3] = *(const f32x4*)bp;
            wgt[n][4] = *(const f32x4*)(wp + FF); wgt[n][5] = *(const f32x4*)(wp + FF2 + FF); wgt[n][6] = *(const f32x4*)(wp + 2 * FF2 + FF); wgt[n][7] = *(const f32x4*)(bp + FF); }
        if (fr >= 14) {
#pragma unroll
            for (int ai = 0; ai < 2; ++ai)
#pragma unroll
                for (int bj = 0; bj < 2; ++bj)
#pragma unroll
                    for (int n = 0; n < 2; ++n) *(PG8_LAS f32x4*)(xlds + ((((2 * ai + wr) * 2 + (fr - 14)) * 256 + 128 * bj + cl + 4 * n) << 2)) = acc[ai][bj][3][n];
            if (wr == 1) {
#pragma unroll
                for (int bj = 0; bj < 2; ++bj)
#pragma unroll
                    for (int n = 0; n < 2; ++n) *(f32x4*)(ubnd + (size_t)(u.pm * 4 + 2 + (fr - 14)) * FF2 + u.pn * BM + 128 * bj + cl + 4 * n) = acc[1][bj][3][n]; }
        }
        if (wr == 0 && fr < 2) {
#pragma unroll
            for (int bj = 0; bj < 2; ++bj)
#pragma unroll
                for (int n = 0; n < 2; ++n) *(f32x4*)(ubnd + (size_t)(u.pm * 4 + fr) * FF2 + u.pn * BM + 128 * bj + cl + 4 * n) = acc[0][bj][0][n]; }
        asm volatile("s_waitcnt lgkmcnt(0)" ::: "memory"); __builtin_amdgcn_s_barrier(); asm volatile("" ::: "memory");
        u32x2 hold[2][4];
#pragma unroll
        for (int n = 0; n < 2; ++n) {
            const f32x4 gw0 = wgt[n][0], gw1 = wgt[n][1], gw2 = wgt[n][2], gb = wgt[n][3], vw0 = wgt[n][4], vw1 = wgt[n][5], vw2 = wgt[n][6], vb = wgt[n][7];
#pragma unroll
            for (int ai = 0; ai < 2; ++ai) {
                const int chunk = 2 * ai + wr;
                f32x4 pg = {0.f, 0.f, 0.f, 0.f}, pv = {0.f, 0.f, 0.f, 0.f};
                if (chunk > 0) { const PG8_LAS unsigned char* bp = xlds + ((((chunk - 1) * 2 + (fr & 1)) * 256 + cl + 4 * n) << 2);
                    pg = *(const PG8_LAS f32x4*)bp; pv = *(const PG8_LAS f32x4*)(bp + 512); }
#pragma unroll
                for (int m = 0; m < 4; ++m) {
                    const f32x4 cg = acc[ai][0][m][n], cv = acc[ai][1][m][n]; float a[4];
#pragma unroll
                    for (int j = 0; j < 4; ++j) {
                        const float g1 = dpp_shr1(dpp_ror1(pg[j]), cg[j]), g2 = dpp_shr2(dpp_ror2(pg[j]), cg[j]);
                        const float v1 = dpp_shr1(dpp_ror1(pv[j]), cv[j]), v2 = dpp_shr2(dpp_ror2(pv[j]), cv[j]);
                        const float G = gw2[j] * cg[j] + (gw1[j] * g1 + (gw0[j] * g2 + gb[j]));
                        const float V = vw2[j] * cv[j] + (vw1[j] * v1 + (vw0[j] * v2 + vb[j]));
                        a[j] = G * __builtin_amdgcn_rcpf(1.0f + __builtin_amdgcn_exp2f(-1.4426950408889634f * G)) * V; }
                    u32x2 w; w.x = cvt_pk_bf16(a[0], a[1]); w.y = cvt_pk_bf16(a[2], a[3]);
                    if (n == 0) hold[ai][m] = w;
                    else { u32x4 o; o.x = hold[ai][m].x; o.y = hold[ai][m].y; o.z = w.x; o.w = w.y;
                        if (!(ai == 0 && m == 0 && wr == 0 && u.pm > 0 && fr < 2)) *(u32x4*)(ACT + (size_t)(row0 + ai * HALF + m * 16) * FF + c0) = o; }
                    pg = cg; pv = cv;
                }
            }
        }
    }
};

template <class Epi, class Sched, bool ALIGN_EPI = false, bool SP2 = false>
__device__ __forceinline__ void gemm_phase(PG8_LAS unsigned char* lds, const Gemm g, const Sched& S, const Epi& E, PG8_LAS unsigned char* xlds) {
    const int tid = threadIdx.x, wid = __builtin_amdgcn_readfirstlane(tid >> 6), lane = tid & 63, wr = wid >> 2, wc = wid & 3, fr = lane & 15, fq = lane >> 4;
    const int K = g.K, nt = K / BK;
    unsigned voffA[2], voffB[2];
#pragma unroll
    for (int i = 0; i < 2; ++i) { int R, C; stage_rc(tid * 16 + i * 8192, R, C); const int Rb = Epi::PERM ? ((R & ~31) + perm32(R & 31)) : R;
        voffA[i] = (unsigned)(R * K + C) * 2u; voffB[i] = (unsigned)(Rb * K + C) * 2u; }
    const size_t kstep = (size_t)(BK * 2);
    const size_t hstep = (size_t)HALF * K * 2;
    const size_t tstep = 2 * hstep;
    const unsigned ldsw = (unsigned)wid * 1024u;
    const int aoff = lds_byte(wr * 64 + fr, fq * 8), boff = lds_byte(wc * 32 + fr, fq * 8);
#define PG8_SA(b, h) (((b) * 2 + (h)) * HTB)
#define PG8_SB(b, h) ((4 + (b) * 2 + (h)) * HTB)
#define PG8_STAGE(bufoff, gbase, voff) do { _Pragma("unroll") for (int _i = 0; _i < 2; ++_i) \
        __builtin_amdgcn_global_load_lds((const unsigned*)((const char*)(gbase) + (voff)[_i]), (PG8_LAS unsigned*)(lds + (bufoff) + ldsw + _i * 8192), 16, 0, 0); } while (0)
#define PG8_LDA(dst, b, h) do { _Pragma("unroll") for (int m = 0; m < 4; ++m) _Pragma("unroll") for (int k = 0; k < 2; ++k) dst[m][k] = *(const PG8_LAS bf16x8*)(lds + PG8_SA(b, h) + aoff + m * 2048 + k * 1024); } while (0)
#define PG8_LDB(dst, b, h) do { _Pragma("unroll") for (int n = 0; n < 2; ++n) _Pragma("unroll") for (int k = 0; k < 2; ++k) dst[n][k] = *(const PG8_LAS bf16x8*)(lds + PG8_SB(b, h) + boff + n * 2048 + k * 1024); } while (0)
#define PG8_MMA(ai, bj, At, Bt) do { __builtin_amdgcn_s_setprio(PG8_PRIO); _Pragma("unroll") for (int m = 0; m < 4; ++m) _Pragma("unroll") for (int n = 0; n < 2; ++n) _Pragma("unroll") for (int k = 0; k < 2; ++k) \
        acc[ai][bj][m][n] = __builtin_amdgcn_mfma_f32_16x16x32_bf16(Bt[n][k], At[m][k], acc[ai][bj][m][n], 0, 0, 0); __builtin_amdgcn_s_setprio(0); } while (0)
#define PG8_WAIT_V(n) asm volatile("s_waitcnt vmcnt(" #n ")" ::: "memory")
#define PG8_WAIT_L(n) asm volatile("s_waitcnt lgkmcnt(" #n ")" ::: "memory")
#define PG8_BAR __builtin_amdgcn_s_barrier()
#define PG8_SCHED __builtin_amdgcn_sched_barrier(0)
    Unit cur, nxt; int ui = 0;
    if (!S.next(0, cur)) return;
    f32x4 acc[2][2][4][2];
#pragma unroll
    for (int a = 0; a < 2; ++a)
#pragma unroll
        for (int b = 0; b < 2; ++b)
#pragma unroll
            for (int m = 0; m < 4; ++m)
#pragma unroll
                for (int n = 0; n < 2; ++n) acc[a][b][m][n] = (f32x4){0.f, 0.f, 0.f, 0.f};
    bf16x8 At[4][2], B0[2][2], B1[2][2];
    const char* cA = (const char*)g.A + (size_t)cur.pm * tstep; const char* cB = (const char*)g.Bt + (size_t)cur.pn * tstep;
    S.a_ready(cur);
    if constexpr (SP2) {
        PG8_STAGE(PG8_SB(0, 0), cB, voffB); PG8_STAGE(PG8_SB(0, 1), cB + hstep, voffB); PG8_STAGE(PG8_SA(0, 0), cA, voffA); PG8_STAGE(PG8_SA(0, 1), cA + hstep, voffA);
        if (wr == 1) PG8_BAR;
        PG8_WAIT_V(2); PG8_BAR;
        PG8_STAGE(PG8_SB(1, 0), cB + kstep, voffB); PG8_STAGE(PG8_SA(1, 0), cA + kstep, voffA); PG8_STAGE(PG8_SB(1, 1), cB + hstep + kstep, voffB);
        PG8_WAIT_V(6); PG8_BAR;
    } else {
        PG8_STAGE(PG8_SB(0, 0), cB, voffB); PG8_STAGE(PG8_SA(0, 0), cA, voffA); PG8_STAGE(PG8_SB(0, 1), cB + hstep, voffB); PG8_STAGE(PG8_SA(0, 1), cA + hstep, voffA);
        if (wr == 1) PG8_BAR;
        PG8_WAIT_V(4); PG8_BAR;
        PG8_STAGE(PG8_SB(1, 0), cB + kstep, voffB); PG8_STAGE(PG8_SA(1, 0), cA + kstep, voffA); PG8_STAGE(PG8_SB(1, 1), cB + hstep + kstep, voffB);
        PG8_WAIT_V(6); PG8_BAR;
    }
    for (;;) {
        const bool has_next = S.next(ui + 1, nxt);
        const char* nA = has_next ? (const char*)g.A + (size_t)nxt.pm * tstep : cA; const char* nB = has_next ? (const char*)g.Bt + (size_t)nxt.pn * tstep : cB;
        for (int t = 0; t < nt; t += 2) {
            const bool last = (t == nt - 2);
            const char* a1 = cA + (size_t)(t + 1) * kstep;
            const char* a2 = last ? nA : cA + (size_t)(t + 2) * kstep; const char* b2 = last ? nB : cB + (size_t)(t + 2) * kstep;
            const char* a3 = a2 + kstep; const char* b3 = b2 + kstep;
            if (last && has_next) S.a_ready(nxt);
            if constexpr (SP2) {
            PG8_LDB(B0, 0, 0); PG8_LDB(B1, 0, 1); PG8_SCHED; PG8_LDA(At, 0, 0); PG8_STAGE(PG8_SA(1, 1), a1 + hstep, voffA);
            PG8_WAIT_V(8); PG8_WAIT_L(0); PG8_BAR; PG8_MMA(0, 0, At, B0); PG8_MMA(0, 1, At, B1); PG8_BAR; PG8_SCHED;
            PG8_LDA(At, 0, 1); PG8_STAGE(PG8_SB(0, 0), b2, voffB); PG8_STAGE(PG8_SB(0, 1), b2 + hstep, voffB); PG8_STAGE(PG8_SA(0, 0), a2, voffA);
            PG8_WAIT_V(8); PG8_WAIT_L(0); PG8_BAR; PG8_MMA(1, 0, At, B0); PG8_MMA(1, 1, At, B1); PG8_BAR; PG8_SCHED;
            PG8_LDB(B0, 1, 0); PG8_LDB(B1, 1, 1); PG8_SCHED; PG8_LDA(At, 1, 0); PG8_STAGE(PG8_SA(0, 1), a2 + hstep, voffA);
            PG8_WAIT_V(8); PG8_WAIT_L(0); PG8_BAR; PG8_MMA(0, 0, At, B0); PG8_MMA(0, 1, At, B1); PG8_BAR; PG8_SCHED;
            PG8_LDA(At, 1, 1); PG8_STAGE(PG8_SB(1, 0), b3, voffB); PG8_STAGE(PG8_SB(1, 1), b3 + hstep, voffB); PG8_STAGE(PG8_SA(1, 0), a3, voffA);
            PG8_WAIT_V(8); PG8_WAIT_L(0); PG8_BAR; PG8_MMA(1, 0, At, B0); PG8_MMA(1, 1, At, B1); PG8_BAR; PG8_SCHED;
            } else {
            PG8_LDB(B0, 0, 0); PG8_SCHED; PG8_LDA(At, 0, 0); PG8_STAGE(PG8_SA(1, 1), a1 + hstep, voffA);
            PG8_WAIT_L(8); PG8_BAR; PG8_WAIT_L(0); PG8_MMA(0, 0, At, B0); PG8_BAR; PG8_SCHED;
            PG8_LDB(B1, 0, 1); PG8_STAGE(PG8_SB(0, 0), b2, voffB);
            PG8_BAR; PG8_WAIT_L(0); PG8_MMA(0, 1, At, B1); PG8_BAR;
            PG8_LDA(At, 0, 1); PG8_STAGE(PG8_SA(0, 0), a2, voffA);
            PG8_BAR; PG8_WAIT_L(0); PG8_MMA(1, 0, At, B0); PG8_BAR; PG8_SCHED;
            PG8_STAGE(PG8_SB(0, 1), b2 + hstep, voffB);
            PG8_WAIT_V(6); PG8_BAR; PG8_MMA(1, 1, At, B1); PG8_BAR;
            PG8_LDB(B0, 1, 0); PG8_SCHED; PG8_LDA(At, 1, 0); PG8_STAGE(PG8_SA(0, 1), a2 + hstep, voffA);
            PG8_WAIT_L(8); PG8_BAR; PG8_WAIT_L(0); PG8_MMA(0, 0, At, B0); PG8_BAR; PG8_SCHED;
            PG8_LDB(B1, 1, 1); PG8_STAGE(PG8_SB(1, 0), b3, voffB);
            PG8_BAR; PG8_WAIT_L(0); PG8_MMA(0, 1, At, B1); PG8_BAR;
            PG8_LDA(At, 1, 1); PG8_STAGE(PG8_SA(1, 0), a3, voffA);
            PG8_BAR; PG8_WAIT_L(0); PG8_MMA(1, 0, At, B0); PG8_BAR; PG8_SCHED;
            PG8_STAGE(PG8_SB(1, 1), b3 + hstep, voffB);
            PG8_WAIT_V(6); PG8_BAR; PG8_MMA(1, 1, At, B1); PG8_BAR;
            }
        }
        if constexpr (ALIGN_EPI) { if (wr == 0) PG8_BAR; }
        if constexpr (!Epi::AFTER_DRAIN) { E(acc, cur, wr, wc, fr, fq, xlds); S.done(cur); }
        if (!has_next) break;
#pragma unroll
        for (int a = 0; a < 2; ++a)
#pragma unroll
            for (int b = 0; b < 2; ++b)
#pragma unroll
                for (int m = 0; m < 4; ++m)
#pragma unroll
                    for (int n = 0; n < 2; ++n) acc[a][b][m][n] = (f32x4){0.f, 0.f, 0.f, 0.f};
        cur = nxt; cA = nA; cB = nB; ++ui;
        if constexpr (ALIGN_EPI) { if (wr == 1) PG8_BAR; }
    }
    PG8_WAIT_V(0);
    if constexpr (!ALIGN_EPI) { if (wr == 0) PG8_BAR; }
    PG8_BAR;

#undef PG8_SA
#undef PG8_SB
#undef PG8_STAGE
#undef PG8_LDA
#undef PG8_LDB
#undef PG8_MMA
#undef PG8_WAIT_V
#undef PG8_WAIT_L
#undef PG8_BAR
#undef PG8_SCHED
}
}

#define GAS __attribute__((address_space(1)))
#define LAS __attribute__((address_space(3)))
typedef unsigned short bf16;
typedef float f32x4 __attribute__((ext_vector_type(4)));
typedef short bf16x8 __attribute__((ext_vector_type(8)));
typedef unsigned u32x4 __attribute__((ext_vector_type(4)));
typedef unsigned u32x2 __attribute__((ext_vector_type(2)));

constexpr int NWAVES = 8;
constexpr int SEQ = 16384, DMODEL = 2048, NMEM = 256, DIN = 3584, DCONV = 768, DPOOL = 768, DXATT = 512, DFF = 5632, DFF2 = 11264;
constexpr int PGD = 192;
constexpr float EPS = 1e-6f;
constexpr int LDS_BYTES = 147456;
#ifndef MK_PER_PHASE
#define MK_PER_PHASE 0
#endif
constexpr int NPHASE = 7;
#ifndef PHM
#define PHM 255
#endif
#ifndef FUSE_FIXUP
#define FUSE_FIXUP 0
#endif
#ifndef P1_ALIGN
#define P1_ALIGN false
#endif
#ifndef USE_CG_SYNC
#define USE_CG_SYNC 0
#endif
#ifndef PROBE_P2
#define PROBE_P2 0
#endif
#ifndef PROBE_SYNC
#define PROBE_SYNC 0
#endif
#ifndef PROBE_GEMM
#define PROBE_GEMM 0
#endif
#ifndef PROBE_N
#define PROBE_N 2048
#endif
#ifndef REPM
#define REPM 0
#endif

constexpr size_t MiB = 1u << 20;
constexpr size_t WS_KB = 1 * MiB;
constexpr size_t WS_VT = 1 * MiB + 256 * 1024;
constexpr size_t WS_POOLWT = 1 * MiB + 512 * 1024;
constexpr size_t WS_MB = 2 * MiB;
constexpr size_t WS_WKVT = 3 * MiB;
constexpr size_t WS_SIG = 7 * MiB;
constexpr size_t WS_SLAB1 = 8 * MiB;
constexpr size_t WS_SLAB2 = 10 * MiB;
constexpr size_t WS_WUPT = 12 * MiB;
constexpr size_t WS_WDOWNT = 56 * MiB;
constexpr size_t WS_UBND = 80 * MiB;
constexpr size_t WS_X1B = 96 * MiB;
constexpr size_t WS_ACT = 160 * MiB;
constexpr size_t WS_H = 160 * MiB;
constexpr size_t WS_Z = 225 * MiB;
constexpr size_t WS_ZPAD = WS_Z - (size_t)16 * 3584 * 2;
constexpr size_t WS_MIX = 338 * MiB;
constexpr size_t WS_WINT = 402 * MiB;
constexpr size_t WS_WOUTT = 416 * MiB;
constexpr size_t WS_END = 424 * MiB;

__device__ __forceinline__ unsigned f2bf(float f) { unsigned u = __builtin_bit_cast(unsigned, f); return (u + 0x7fffu + ((u >> 16) & 1u)) >> 16; }
__device__ __forceinline__ unsigned pk2(float lo, float hi) { return f2bf(lo) | (f2bf(hi) << 16); }
__device__ __forceinline__ float bflo(unsigned w) { return __builtin_bit_cast(float, w << 16); }
__device__ __forceinline__ float bfhi(unsigned w) { return __builtin_bit_cast(float, w & 0xffff0000u); }
__device__ __forceinline__ void unpack8(const u32x4 w, float (&f)[8]) { f[0] = bflo(w.x); f[1] = bfhi(w.x); f[2] = bflo(w.y); f[3] = bfhi(w.y); f[4] = bflo(w.z); f[5] = bfhi(w.z); f[6] = bflo(w.w); f[7] = bfhi(w.w); }
__device__ __forceinline__ u32x4 pack8(const float (&f)[8]) { u32x4 w; w.x = pk2(f[0], f[1]); w.y = pk2(f[2], f[3]); w.z = pk2(f[4], f[5]); w.w = pk2(f[6], f[7]); return w; }
__device__ __forceinline__ float wave_sum(float v) {
#pragma unroll
    for (int o = 1; o < 64; o <<= 1) v += __shfl_xor(v, o);
    return v;
}
#define LDS_WAIT() asm volatile("s_waitcnt lgkmcnt(0)" ::: "memory")

typedef GAS unsigned gu32;
constexpr size_t WS_CTL = 0, CTL_ZERO_BYTES = 64 * 1024;
constexpr int CW_PANEL2 = 12288;
constexpr int CW_PANEL1 = 8192;
constexpr int CW_PANEL = 4096;
constexpr int MISC_OFF = 131072 + 320;
constexpr int XLDS_OFF = 131072 + 1024;
#define XB_TMO      128
#define XB_XCNT(j)  (256  + 64 * (j))
#define XB_XSUB(j)  (1280 + 64 * (j))
#define XB_XGEN(j)  (2304 + 64 * (j))
#define XB_TOP      3328
#define XB_TOPGEN   3392
#define XCD_BAR_WORDS 3456
#define XB_SPIN_CAP (1u << 18)

__device__ __forceinline__ unsigned xb_ld(unsigned* p)              { return __hip_atomic_load(p, __ATOMIC_RELAXED, __HIP_MEMORY_SCOPE_AGENT); }
__device__ __forceinline__ unsigned xb_add(unsigned* p, unsigned v) { return __hip_atomic_fetch_add(p, v, __ATOMIC_RELAXED, __HIP_MEMORY_SCOPE_AGENT); }
__device__ __forceinline__ unsigned xb_xcc_id() { return (unsigned)__builtin_amdgcn_s_getreg((3 << 11) | 20) & 0xFu; }
#define XB_SPIN(cond, bar) do { unsigned _sp = 0; while (cond) { __builtin_amdgcn_s_sleep(1); \
    if ((++_sp & 255u) == 0u) { if (xb_ld(&(bar)[XB_TMO])) break; if (_sp > XB_SPIN_CAP) { atomicAdd(&(bar)[XB_TMO], 1u); break; } } } } while (0)

struct XcdBarrier {
    unsigned* bar; unsigned x;
    volatile LAS unsigned* st;
};

__device__ __forceinline__ XcdBarrier xcd_barrier_post(unsigned* bar, volatile LAS unsigned* st) {
    XcdBarrier b; b.bar = bar; b.x = xb_xcc_id(); b.st = st;
    if (threadIdx.x == 0) (void)xb_add(&bar[XB_XCNT(b.x)], 1u);
    return b;
}
__device__ __forceinline__ void xcd_barrier_complete(unsigned* bar, unsigned x, unsigned& nloc, unsigned& nx) {
    const unsigned G = gridDim.x * gridDim.y * gridDim.z;
    unsigned sum, cnt, mine, sp = 0u;
    for (;;) {
        sum = 0u; cnt = 0u; mine = 0u;
#pragma unroll
        for (unsigned j = 0; j < 16; ++j) { const unsigned c = xb_ld(&bar[XB_XCNT(j)]); sum += c; cnt += (c > 0u) ? 1u : 0u; mine = (j == x) ? c : mine; }
        if (sum == G) break;
        __builtin_amdgcn_s_sleep(1);
        if ((++sp & 255u) == 0u) { if (xb_ld(&bar[XB_TMO])) break; if (sp > XB_SPIN_CAP) { atomicAdd(&bar[XB_TMO], 1u); break; } }
    }
    nloc = mine > 0u ? mine : 1u; nx = cnt > 0u ? cnt : 1u;
}

__device__ __forceinline__ void xcd_barrier(const XcdBarrier& b) {
    asm volatile("s_waitcnt vmcnt(0)" ::: "memory");
    __syncthreads();
    if (threadIdx.x == 0) {
        unsigned* bar = b.bar;
        __builtin_amdgcn_s_waitcnt(0);
        unsigned nloc = b.st[0], nx = b.st[1];
        if (nloc == 0u) { xcd_barrier_complete(bar, b.x, nloc, nx); b.st[0] = nloc; b.st[1] = nx; }
        const unsigned old = xb_add(&bar[XB_XSUB(b.x)], 1u);
        const unsigned gen = old / nloc;
        if (old + 1u == (gen + 1u) * nloc) {
            __builtin_amdgcn_fence(__ATOMIC_RELEASE, "agent");
            asm volatile("s_waitcnt vmcnt(0)" ::: "memory");
            const unsigned og = xb_add(&bar[XB_TOP], 1u);
            const unsigned tg = og / nx;
            if (og + 1u == (tg + 1u) * nx) xb_add(&bar[XB_TOPGEN], 1u);
            else XB_SPIN(xb_ld(&bar[XB_TOPGEN]) == tg, bar);
            __builtin_amdgcn_fence(__ATOMIC_ACQUIRE, "agent");
            xb_add(&bar[XB_XGEN(b.x)], 1u);
            asm volatile("s_waitcnt vmcnt(0)" ::: "memory");
        } else {
            XB_SPIN(xb_ld(&bar[XB_XGEN(b.x)]) == gen, bar);
            __builtin_amdgcn_fence(__ATOMIC_ACQUIRE, "agent");
            asm volatile("s_waitcnt vmcnt(0)" ::: "memory");
        }
    }
    __syncthreads();
}


template <bool UPMAP> __device__ __forceinline__ void p0_transpose_item(const float* W, int K, int N, bf16* WT, const float* ks, LAS float* scr, int item, int lane) {
    const int nblk = N / 64, kb = item / nblk, nb = item % nblk, k0 = 64 * kb, n0 = 64 * nb;
    const int r0 = !UPMAP ? n0 : (n0 < DFF ? 256 * (n0 / 128) + (n0 % 128) : 256 * ((n0 - DFF) / 128) + 128 + ((n0 - DFF) % 128));
    f32x4 v[16];
    const float* src = W + (size_t)(k0 + (lane >> 4)) * N + n0 + 4 * (lane & 15);
#pragma unroll
    for (int i = 0; i < 16; ++i) v[i] = *(const f32x4*)(src + (size_t)(4 * i) * N);
#pragma unroll
    for (int i = 0; i < 16; ++i) { f32x4 t = v[i]; if (ks) t = t * ks[k0 + 4 * i + (lane >> 4)];
        *(LAS f32x4*)(scr + (4 * i + (lane >> 4)) * 64 + (((lane & 15) ^ ((i >> 1) & 7)) << 2)) = t; }
    LDS_WAIT(); asm volatile("" ::: "memory");
    const int c = lane & 7;
#pragma unroll
    for (int j = 0; j < 8; ++j) { const int nn = (lane >> 3) + 8 * j; const LAS float* sp = scr + (8 * c) * 64 + ((((nn >> 2) ^ c) & 15) << 2) + (nn & 3);
        u32x4 o; o.x = pk2(sp[0 * 64], sp[1 * 64]); o.y = pk2(sp[2 * 64], sp[3 * 64]); o.z = pk2(sp[4 * 64], sp[5 * 64]); o.w = pk2(sp[6 * 64], sp[7 * 64]);
        *(u32x4*)(WT + (size_t)(r0 + nn) * K + k0 + 8 * c) = o; }
    LDS_WAIT(); asm volatile("" ::: "memory");
}
__device__ __forceinline__ void rms_rows2_to_bf16(const float* xa, const float* xb, const float* g, bf16* oa, bf16* ob, int lane) {
    const f32x4* pa = (const f32x4*)xa + lane; const f32x4* pb = (const f32x4*)xb + lane; const f32x4* gr = (const f32x4*)g + lane;
    f32x4 va[8], vb[8]; float sa = 0.f, sb = 0.f;
#pragma unroll
    for (int j = 0; j < 8; ++j) { va[j] = pa[64 * j]; vb[j] = pb[64 * j]; }
#pragma unroll
    for (int j = 0; j < 8; ++j) { sa += (va[j].x * va[j].x + va[j].y * va[j].y) + (va[j].z * va[j].z + va[j].w * va[j].w); sb += (vb[j].x * vb[j].x + vb[j].y * vb[j].y) + (vb[j].z * vb[j].z + vb[j].w * vb[j].w); }
    const float ra = 1.0f / sqrtf(wave_sum(sa) * (1.0f / DMODEL) + EPS), rb = 1.0f / sqrtf(wave_sum(sb) * (1.0f / DMODEL) + EPS);
    u32x2* qa = (u32x2*)oa + lane; u32x2* qb = (u32x2*)ob + lane;
#pragma unroll
    for (int j = 0; j < 8; ++j) { const f32x4 gg = gr[64 * j]; u32x2 w;
        w.x = pk2(va[j].x * ra * gg.x, va[j].y * ra * gg.y); w.y = pk2(va[j].z * ra * gg.z, va[j].w * ra * gg.w); qa[64 * j] = w;
        w.x = pk2(vb[j].x * rb * gg.x, vb[j].y * rb * gg.y); w.y = pk2(vb[j].z * rb * gg.z, vb[j].w * rb * gg.w); qb[64 * j] = w; }
}

struct Ptrs {
    const float *x, *mem, *g_mix, *g_mem, *w_in, *conv_w, *pool_w, *pool_scale, *w_kv, *w_out, *g_ffn, *w_up, *ffn_conv_w, *ffn_conv_b, *w_down, *g_final;
    float* out; unsigned char* ws;
};

constexpr int UP_ITEMS = (DMODEL / 64) * (DFF2 / 64), DN_ITEMS = (DFF / 64) * (DMODEL / 64);
#ifndef UP_IN_P0
#define UP_IN_P0 2560
#endif
__device__ __forceinline__ void p1_idle_work(const Ptrs& P, LAS unsigned char* lds, int iw, int NIW, int wave, int lane);
__device__ __forceinline__ void p0_prologue(const Ptrs& P, LAS unsigned char* lds, int gw, int NGW, int wave, int lane) {
    LAS float* scr = (LAS float*)(lds + wave * 16384);
    unsigned char* ws = P.ws;
    constexpr int I_IN = (DMODEL / 64) * (DIN / 64), I_OUT = (DMODEL / 64) * (DMODEL / 64), I_UP = (DMODEL / 64) * (DFF2 / 64), I_DN = (DFF / 64) * (DMODEL / 64),
                  I_KV = (DMODEL / 64) * (1024 / 64), I_PW = (PGD / 64) * (PGD / 64);
    constexpr int NITEMS = I_IN + I_OUT + UP_IN_P0 + I_KV + 4 * I_PW;
    for (int it = gw; it < NITEMS; it += NGW) {
        int r = it;
        if (r < I_IN) { p0_transpose_item<false>(P.w_in, DMODEL, DIN, (bf16*)(ws + WS_WINT), nullptr, scr, r, lane); continue; } r -= I_IN;
        if (r < I_OUT) { p0_transpose_item<false>(P.w_out, DMODEL, DMODEL, (bf16*)(ws + WS_WOUTT), nullptr, scr, r, lane); continue; } r -= I_OUT;
        if (r < UP_IN_P0) { p0_transpose_item<true>(P.w_up, DMODEL, DFF2, (bf16*)(ws + WS_WUPT), P.g_ffn, scr, r, lane); continue; } r -= UP_IN_P0;
        if (r < I_KV) { p0_transpose_item<false>(P.w_kv, DMODEL, 1024, (bf16*)(ws + WS_WKVT), nullptr, scr, r, lane); continue; } r -= I_KV;
        const int g = r / I_PW; r -= g * I_PW;
        p0_transpose_item<false>(P.pool_w + (size_t)g * PGD * PGD, PGD, PGD, (bf16*)(ws + WS_POOLWT) + (size_t)g * PGD * PGD, nullptr, scr, r, lane);
    }
    for (int i = gw * 64 + lane; i < 16 * DIN * 2 / 16; i += NGW * 64) ((u32x4*)(ws + WS_ZPAD))[i] = (u32x4){0u, 0u, 0u, 0u};
    for (int m = 2 * gw; m < SEQ; m += 2 * NGW) rms_rows2_to_bf16(P.x + (size_t)m * DMODEL, P.x + (size_t)(m + 1) * DMODEL, P.g_mix, (bf16*)(ws + WS_H) + (size_t)m * DMODEL, (bf16*)(ws + WS_H) + (size_t)(m + 1) * DMODEL, lane);
    for (int m = 2 * gw; m < NMEM; m += 2 * NGW) rms_rows2_to_bf16(P.mem + (size_t)m * DMODEL, P.mem + (size_t)(m + 1) * DMODEL, P.g_mem, (bf16*)(ws + WS_MB) + (size_t)m * DMODEL, (bf16*)(ws + WS_MB) + (size_t)(m + 1) * DMODEL, lane);
}

__device__ __forceinline__ void kv_tile(const Ptrs& P, int tt, int lane) {
    const bf16* mB = (const bf16*)(P.ws + WS_MB); const bf16* wT = (const bf16*)(P.ws + WS_WKVT);
    const int rb = tt >> 6, cb = tt & 63, fr = lane & 15, fq = lane >> 4;
    const bf16* ap = mB + (size_t)(16 * rb + fr) * DMODEL + 8 * fq; const bf16* wp = wT + (size_t)(16 * cb + fr) * DMODEL + 8 * fq;
    f32x4 acc = {0.f, 0.f, 0.f, 0.f};
    if (cb < 32) {
#pragma unroll 8
        for (int ks = 0; ks < 64; ++ks) { const bf16x8 a = *(const bf16x8*)(ap + 32 * ks), w = *(const bf16x8*)(wp + 32 * ks); acc = __builtin_amdgcn_mfma_f32_16x16x32_bf16(w, a, acc, 0, 0, 0); }
        u32x2 o; o.x = pk2(acc[0], acc[1]); o.y = pk2(acc[2], acc[3]);
        *(u32x2*)((bf16*)(P.ws + WS_KB) + (size_t)(16 * rb + fr) * 512 + 16 * cb + 4 * fq) = o;
    } else {
#pragma unroll 8
        for (int ks = 0; ks < 64; ++ks) { const bf16x8 a = *(const bf16x8*)(ap + 32 * ks), w = *(const bf16x8*)(wp + 32 * ks); acc = __builtin_amdgcn_mfma_f32_16x16x32_bf16(a, w, acc, 0, 0, 0); }
        u32x2 o; o.x = pk2(acc[0], acc[1]); o.y = pk2(acc[2], acc[3]);
        *(u32x2*)((bf16*)(P.ws + WS_VT) + (size_t)(16 * cb - 512 + fr) * 256 + 32 * (rb >> 1) + 8 * fq + 4 * (rb & 1)) = o;
    }
}

__device__ __forceinline__ void p1_idle_work(const Ptrs& P, LAS unsigned char* lds, int iw, int NIW, int wave, int lane) {
    LAS float* scr = (LAS float*)(lds + wave * 16384);
    for (int tt = iw; tt < 1024; tt += NIW) kv_tile(P, tt, lane);
    constexpr int NEXTRA = DN_ITEMS + (UP_ITEMS - UP_IN_P0);
    for (int it = iw; it < NEXTRA; it += NIW) {
        if (it < DN_ITEMS) p0_transpose_item<false>(P.w_down, DFF, DMODEL, (bf16*)(P.ws + WS_WDOWNT), nullptr, scr, it, lane);
        else p0_transpose_item<true>(P.w_up, DMODEL, DFF2, (bf16*)(P.ws + WS_WUPT), P.g_ffn, scr, UP_IN_P0 + it - DN_ITEMS, lane);
    }
}

__device__ __forceinline__ void mix_conv_task(const Ptrs& P, int blk, int lane, int cg0, int cg1) {
    const bf16* z = (const bf16*)(P.ws + WS_Z); bf16* mix = (bf16*)(P.ws + WS_MIX);
    const int t0 = blk * 16;
    for (int cg = cg0 + lane; cg < cg1; cg += 64) {
        const int c = cg * 8;
        float w0[8], w1[8], w2[8], p1[8], p2[8];
#pragma unroll
        for (int e = 0; e < 8; ++e) { w0[e] = P.conv_w[c + e]; w1[e] = P.conv_w[DCONV + c + e]; w2[e] = P.conv_w[2 * DCONV + c + e]; }
        { float a[8], b[8]; unpack8(*(const u32x4*)(z + (long)(t0 - 2) * DIN + DCONV + c), a); unpack8(*(const u32x4*)(z + (long)(t0 - 2) * DIN + 2 * DCONV + c), b);
#pragma unroll
          for (int e = 0; e < 8; ++e) p2[e] = a[e] * b[e];
          unpack8(*(const u32x4*)(z + (long)(t0 - 1) * DIN + DCONV + c), a); unpack8(*(const u32x4*)(z + (long)(t0 - 1) * DIN + 2 * DCONV + c), b);
#pragma unroll
          for (int e = 0; e < 8; ++e) p1[e] = a[e] * b[e]; }
#pragma unroll 4
        for (int r = 0; r < 16; ++r) {
            const int t = t0 + r; float p[8], a[8], b[8], g[8], o[8];
            unpack8(*(const u32x4*)(z + (size_t)t * DIN + DCONV + c), a); unpack8(*(const u32x4*)(z + (size_t)t * DIN + 2 * DCONV + c), b); unpack8(*(const u32x4*)(z + (size_t)t * DIN + c), g);
#pragma unroll
            for (int e = 0; e < 8; ++e) { p[e] = a[e] * b[e]; o[e] = g[e] * (w2[e] * p[e] + w1[e] * p1[e] + w0[e] * p2[e]); p2[e] = p1[e]; p1[e] = p[e]; }
            *(u32x4*)(mix + (size_t)t * DMODEL + c) = pack8(o);
        }
    }
}
template <int g> __device__ __forceinline__ void mix_pool_task(const Ptrs& P, int blk, int lane) {
    constexpr int k = 2 << g;
    const char* zu = (const char*)((const bf16*)(P.ws + WS_Z) + (size_t)(blk * 16) * DIN + 3 * DCONV + PGD * g);
    const char* wu = (const char*)((const bf16*)(P.ws + WS_POOLWT) + (size_t)g * PGD * PGD);
    bf16* mix = (bf16*)(P.ws + WS_MIX);
    const int fr = lane & 15, fq = lane >> 4, t = blk * 16 + fr;
    const unsigned zl = (unsigned)(fr * DIN + 8 * fq) * 2u, wl = (unsigned)(fr * PGD + 8 * fq) * 2u;
    const int cnt = (t + 1 < k) ? t + 1 : k; const float inv = 1.0f / (float)cnt;
    f32x4 acc[12];
#pragma unroll
    for (int n = 0; n < 12; ++n) acc[n] = (f32x4){0.f, 0.f, 0.f, 0.f};
#pragma unroll 1
    for (int ks = 0; ks < 6; ++ks) {
        float sum[8], self[8];
        unpack8(*(const u32x4*)(zu + ks * 64 + zl), self);
#pragma unroll
        for (int e = 0; e < 8; ++e) sum[e] = self[e];
#pragma unroll
        for (int j = 1; j < k; ++j) { float v[8]; unpack8(*(const u32x4*)(zu + ks * 64 - (long)j * (DIN * 2) + zl), v);
#pragma unroll
            for (int e = 0; e < 8; ++e) sum[e] += v[e]; }
        float pl[8];
#pragma unroll
        for (int e = 0; e < 8; ++e) pl[e] = sum[e] * inv - self[e];
        const bf16x8 pf = __builtin_bit_cast(bf16x8, pack8(pl));
#pragma unroll
        for (int n = 0; n < 12; ++n) { const bf16x8 wf = *(const bf16x8*)(wu + n * (16 * PGD * 2) + ks * 64 + wl); acc[n] = __builtin_amdgcn_mfma_f32_16x16x32_bf16(wf, pf, acc[n], 0, 0, 0); }
    }
#pragma unroll
    for (int n = 0; n < 12; ++n) { const int d = 16 * n + 4 * fq; const f32x4 sc = *(const f32x4*)(P.pool_scale + PGD * g + d);
        u32x2 o; o.x = pk2(acc[n][0] * sc[0], acc[n][1] * sc[1]); o.y = pk2(acc[n][2] * sc[2], acc[n][3] * sc[3]);
        *(u32x2*)(mix + (size_t)t * DMODEL + DCONV + PGD * g + d) = o; }
}
__device__ __forceinline__ void mix_attn_task(const Ptrs& P, int h, int blk, int lane) {
    const bf16* z = (const bf16*)(P.ws + WS_Z); bf16* mix = (bf16*)(P.ws + WS_MIX); const bf16* Kb = (const bf16*)(P.ws + WS_KB); const bf16* Vt = (const bf16*)(P.ws + WS_VT);
    const int fr = lane & 15, fq = lane >> 4, t = blk * 16 + fr;
    bf16x8 qf[4];
#pragma unroll
    for (int ks = 0; ks < 4; ++ks) qf[ks] = *(const bf16x8*)(z + (size_t)t * DIN + 3 * DCONV + DPOOL + 128 * h + 32 * ks + 8 * fq);
    f32x4 s[16];
#pragma unroll
    for (int kb = 0; kb < 16; ++kb) { s[kb] = (f32x4){0.f, 0.f, 0.f, 0.f};
#pragma unroll
        for (int ks = 0; ks < 4; ++ks) { const bf16x8 kf = *(const bf16x8*)(Kb + (size_t)(16 * kb + fr) * 512 + 128 * h + 32 * ks + 8 * fq); s[kb] = __builtin_amdgcn_mfma_f32_16x16x32_bf16(kf, qf[ks], s[kb], 0, 0, 0); } }
    float mx = -3.0e38f;
#pragma unroll
    for (int kb = 0; kb < 16; ++kb) mx = fmaxf(fmaxf(fmaxf(s[kb][0], s[kb][1]), fmaxf(s[kb][2], s[kb][3])), mx);
    mx = fmaxf(mx, __shfl_xor(mx, 16)); mx = fmaxf(mx, __shfl_xor(mx, 32));
    const float c2 = 0.08838834764831845f * 1.4426950408889634f;
    float sum = 0.f;
#pragma unroll
    for (int kb = 0; kb < 16; ++kb)
#pragma unroll
        for (int r = 0; r < 4; ++r) { const float p = __builtin_amdgcn_exp2f((s[kb][r] - mx) * c2); s[kb][r] = p; sum += p; }
    sum += __shfl_xor(sum, 16); sum += __shfl_xor(sum, 32);
    const float inv = 1.0f / sum;
    f32x4 o[8];
#pragma unroll
    for (int db = 0; db < 8; ++db) o[db] = (f32x4){0.f, 0.f, 0.f, 0.f};
#pragma unroll
    for (int ks = 0; ks < 8; ++ks) {
        u32x4 pw; pw.x = pk2(s[2 * ks][0], s[2 * ks][1]); pw.y = pk2(s[2 * ks][2], s[2 * ks][3]); pw.z = pk2(s[2 * ks + 1][0], s[2 * ks + 1][1]); pw.w = pk2(s[2 * ks + 1][2], s[2 * ks + 1][3]);
        const bf16x8 pf = __builtin_bit_cast(bf16x8, pw);
#pragma unroll
        for (int db = 0; db < 8; ++db) { const bf16x8 vf = *(const bf16x8*)(Vt + (size_t)(128 * h + 16 * db + fr) * 256 + 32 * ks + 8 * fq); o[db] = __builtin_amdgcn_mfma_f32_16x16x32_bf16(vf, pf, o[db], 0, 0, 0); }
    }
#pragma unroll
    for (int db = 0; db < 8; ++db) { u32x2 w; w.x = pk2(o[db][0] * inv, o[db][1] * inv); w.y = pk2(o[db][2] * inv, o[db][3] * inv);
        *(u32x2*)(mix + (size_t)t * DMODEL + DCONV + DPOOL + 128 * h + 16 * db + 4 * fq) = w; }
}
template <int R, int C, int PCH> __device__ __forceinline__ void lds_stage_rows(LAS unsigned char* dst, const unsigned char* src, int gp, int tid) {
    constexpr int N = R * C, PER = (N + 511) / 512;
    u32x4 v[PER];
#pragma unroll
    for (int i = 0; i < PER; ++i) { const int idx = tid + 512 * i; if (idx < N) { const int row = idx / C, ch = idx % C; v[i] = *(const u32x4*)(src + (size_t)row * gp + ch * 16); } }
#pragma unroll
    for (int i = 0; i < PER; ++i) { const int idx = tid + 512 * i; if (idx < N) { const int row = idx / C, ch = idx % C; *(LAS u32x4*)(dst + row * (PCH * 16) + (((ch & ~15) | ((ch & 15) ^ (row & 15))) << 4)) = v[i]; } }
}
template <int N> __device__ __forceinline__ float dpp_shrN(float old, float src) { return __builtin_bit_cast(float, __builtin_amdgcn_update_dpp(__builtin_bit_cast(int, old), __builtin_bit_cast(int, src), 0x110 + N, 0xf, 0xf, false)); }
template <int N> __device__ __forceinline__ float dpp_rorN(float src) { return __builtin_bit_cast(float, __builtin_amdgcn_mov_dpp(__builtin_bit_cast(int, src), 0x120 + N, 0xf, 0xf, false)); }
template <int N> __device__ __forceinline__ float scan_step(float x, float p) { return x + dpp_shrN<N>(dpp_rorN<N>(p), x); }
template <int N> __device__ __forceinline__ float scan_step_prev(float p) { return p + dpp_shrN<N>(0.f, p); }

__device__ __forceinline__ void mix_attn_wave(const Ptrs& P, LAS unsigned char* ldsK, LAS unsigned char* ldsV, int h, int row0, int lane) {
    const bf16* z = (const bf16*)(P.ws + WS_Z); bf16* mix = (bf16*)(P.ws + WS_MIX);
    const int fr = lane & 15, fq = lane >> 4;
    bf16x8 q0[4], q1[4];
#pragma unroll
    for (int ks = 0; ks < 4; ++ks) { const bf16* qp = z + (size_t)(row0 + fr) * DIN + 3 * DCONV + DPOOL + 128 * h + 32 * ks + 8 * fq; q0[ks] = *(const bf16x8*)qp; q1[ks] = *(const bf16x8*)(qp + 16 * DIN); }
    unsigned offk[4];
#pragma unroll
    for (int ks = 0; ks < 4; ++ks) offk[ks] = (unsigned)(fr * 256 + (((4 * ks + fq) ^ fr) << 4));
    f32x4 s0[16], s1[16];
#pragma unroll
    for (int kb = 0; kb < 16; ++kb) { s0[kb] = (f32x4){0.f, 0.f, 0.f, 0.f}; s1[kb] = (f32x4){0.f, 0.f, 0.f, 0.f};
#pragma unroll
        for (int ks = 0; ks < 4; ++ks) { const bf16x8 kf = *(const LAS bf16x8*)(ldsK + kb * 4096 + offk[ks]);
            s0[kb] = __builtin_amdgcn_mfma_f32_16x16x32_bf16(kf, q0[ks], s0[kb], 0, 0, 0); s1[kb] = __builtin_amdgcn_mfma_f32_16x16x32_bf16(kf, q1[ks], s1[kb], 0, 0, 0); } }
    const float c2 = 0.08838834764831845f * 1.4426950408889634f;
    bf16x8 p0[8], p1[8]; float inv0, inv1;
    {   float mx = -3.0e38f;
#pragma unroll
        for (int kb = 0; kb < 16; ++kb) mx = fmaxf(fmaxf(fmaxf(s0[kb][0], s0[kb][1]), fmaxf(s0[kb][2], s0[kb][3])), mx);
        mx = fmaxf(mx, __shfl_xor(mx, 16)); mx = fmaxf(mx, __shfl_xor(mx, 32));
        float sum = 0.f;
#pragma unroll
        for (int ks = 0; ks < 8; ++ks) { float e[8];
#pragma unroll
            for (int r = 0; r < 4; ++r) { e[r] = __builtin_amdgcn_exp2f((s0[2 * ks][r] - mx) * c2); e[4 + r] = __builtin_amdgcn_exp2f((s0[2 * ks + 1][r] - mx) * c2); }
            sum += ((e[0] + e[1]) + (e[2] + e[3])) + ((e[4] + e[5]) + (e[6] + e[7]));
            p0[ks] = __builtin_bit_cast(bf16x8, pack8(e)); }
        sum += __shfl_xor(sum, 16); sum += __shfl_xor(sum, 32); inv0 = 1.0f / sum; }
    {   float mx = -3.0e38f;
#pragma unroll
        for (int kb = 0; kb < 16; ++kb) mx = fmaxf(fmaxf(fmaxf(s1[kb][0], s1[kb][1]), fmaxf(s1[kb][2], s1[kb][3])), mx);
        mx = fmaxf(mx, __shfl_xor(mx, 16)); mx = fmaxf(mx, __shfl_xor(mx, 32));
        float sum = 0.f;
#pragma unroll
        for (int ks = 0; ks < 8; ++ks) { float e[8];
#pragma unroll
            for (int r = 0; r < 4; ++r) { e[r] = __builtin_amdgcn_exp2f((s1[2 * ks][r] - mx) * c2); e[4 + r] = __builtin_amdgcn_exp2f((s1[2 * ks + 1][r] - mx) * c2); }
            sum += ((e[0] + e[1]) + (e[2] + e[3])) + ((e[4] + e[5]) + (e[6] + e[7]));
            p1[ks] = __builtin_bit_cast(bf16x8, pack8(e)); }
        sum += __shfl_xor(sum, 16); sum += __shfl_xor(sum, 32); inv1 = 1.0f / sum; }
    f32x4 o0[8], o1[8];
#pragma unroll
    for (int db = 0; db < 8; ++db) { o0[db] = (f32x4){0.f, 0.f, 0.f, 0.f}; o1[db] = (f32x4){0.f, 0.f, 0.f, 0.f}; }
#pragma unroll
    for (int ks = 0; ks < 8; ++ks) {
        const unsigned offv = (unsigned)(fr * 512 + ((ks >> 2) << 8) + (((4 * (ks & 3) + fq) ^ fr) << 4));
#pragma unroll
        for (int db = 0; db < 8; ++db) { const bf16x8 vf = *(const LAS bf16x8*)(ldsV + db * 8192 + offv);
            o0[db] = __builtin_amdgcn_mfma_f32_16x16x32_bf16(vf, p0[ks], o0[db], 0, 0, 0); o1[db] = __builtin_amdgcn_mfma_f32_16x16x32_bf16(vf, p1[ks], o1[db], 0, 0, 0); } }
    bf16* op = mix + (size_t)(row0 + fr) * DMODEL + DCONV + DPOOL + 128 * h + 4 * fq;
#pragma unroll
    for (int db = 0; db < 8; ++db) { u32x2 w; w.x = pk2(o0[db][0] * inv0, o0[db][1] * inv0); w.y = pk2(o0[db][2] * inv0, o0[db][3] * inv0); *(u32x2*)(op + 16 * db) = w;
        w.x = pk2(o1[db][0] * inv1, o1[db][1] * inv1); w.y = pk2(o1[db][2] * inv1, o1[db][3] * inv1); *(u32x2*)(op + (size_t)16 * DMODEL + 16 * db) = w; }
}

template <int g> __device__ __forceinline__ void mix_pool_wave(const Ptrs& P, LAS unsigned char* ldsW, int row0, int lane) {
    constexpr int k = 2 << g;
    const bf16* z = (const bf16*)(P.ws + WS_Z); bf16* mix = (bf16*)(P.ws + WS_MIX);
    const int fr = lane & 15, fq = lane >> 4;
    f32x4 acc0[12], acc1[12];
#pragma unroll
    for (int n = 0; n < 12; ++n) { acc0[n] = (f32x4){0.f, 0.f, 0.f, 0.f}; acc1[n] = (f32x4){0.f, 0.f, 0.f, 0.f}; }
    const float invA = 1.0f / (float)((row0 + fr + 1 < k) ? row0 + fr + 1 : k), invB = 1.0f / (float)((row0 + 16 + fr + 1 < k) ? row0 + 16 + fr + 1 : k);
#pragma unroll 1
    for (int ks = 0; ks < 6; ++ks) {
        const bf16* zp = z + (long)(row0 - 16 + fr) * DIN + 3 * DCONV + PGD * g + 32 * ks + 8 * fq;
        float pv[8], xa[8], xb[8], sa[8], sb[8];
        unpack8(*(const u32x4*)zp, pv); unpack8(*(const u32x4*)(zp + 16 * DIN), xa); unpack8(*(const u32x4*)(zp + 32 * DIN), xb);
#pragma unroll
        for (int e = 0; e < 8; ++e) {
            float p = pv[e], a = xa[e], b = xb[e];
            float b1 = scan_step<1>(b, a), a1 = scan_step<1>(a, p), p1 = scan_step_prev<1>(p);
            if (k >= 4) { const float b2 = scan_step<2>(b1, a1), a2 = scan_step<2>(a1, p1), p2 = scan_step_prev<2>(p1); b1 = b2; a1 = a2; p1 = p2; }
            if (k >= 8) { const float b2 = scan_step<4>(b1, a1), a2 = scan_step<4>(a1, p1), p2 = scan_step_prev<4>(p1); b1 = b2; a1 = a2; p1 = p2; }
            if (k >= 16) { const float b2 = scan_step<8>(b1, a1), a2 = scan_step<8>(a1, p1); b1 = b2; a1 = a2; }
            sa[e] = a1 * invA - a; sb[e] = b1 * invB - b; }
        const bf16x8 fa = __builtin_bit_cast(bf16x8, pack8(sa)), fb = __builtin_bit_cast(bf16x8, pack8(sb));
        const unsigned offw = (unsigned)(fr * 512 + ((ks >> 2) << 8) + (((4 * (ks & 3) + fq) ^ fr) << 4));
#pragma unroll
        for (int n = 0; n < 12; ++n) { const bf16x8 wf = *(const LAS bf16x8*)(ldsW + n * 8192 + offw);
            acc0[n] = __builtin_amdgcn_mfma_f32_16x16x32_bf16(wf, fa, acc0[n], 0, 0, 0); acc1[n] = __builtin_amdgcn_mfma_f32_16x16x32_bf16(wf, fb, acc1[n], 0, 0, 0); }
    }
    bf16* op = mix + (size_t)(row0 + fr) * DMODEL + DCONV + PGD * g + 4 * fq;
#pragma unroll
    for (int n = 0; n < 12; ++n) { const f32x4 sc = *(const f32x4*)(P.pool_scale + PGD * g + 16 * n + 4 * fq);
        u32x2 o; o.x = pk2(acc0[n][0] * sc[0], acc0[n][1] * sc[1]); o.y = pk2(acc0[n][2] * sc[2], acc0[n][3] * sc[3]); *(u32x2*)(op + 16 * n) = o;
        o.x = pk2(acc1[n][0] * sc[0], acc1[n][1] * sc[1]); o.y = pk2(acc1[n][2] * sc[2], acc1[n][3] * sc[3]); *(u32x2*)(op + (size_t)16 * DMODEL + 16 * n) = o; }
}

__device__ __forceinline__ void p2_mixer(const Ptrs& P, LAS unsigned char* lds, int w, int tid, int wave, int lane, int tmask) {
    const int sub = w & 3, tile = w >> 2, row0 = tile * 256 + (wave & 3) * 64;
    lds_stage_rows<256, 16, 16>(lds, (const unsigned char*)(P.ws + WS_KB) + 256 * sub, 1024, tid);
    lds_stage_rows<128, 32, 32>(lds + 65536, (const unsigned char*)(P.ws + WS_VT) + (size_t)sub * 128 * 512, 512, tid);
    LDS_WAIT(); __syncthreads();
    if (wave < 4) { if (tmask & 0x1e0) {
#pragma unroll 1
        for (int p = 0; p < 2; ++p) { asm volatile("" ::: "memory"); mix_attn_wave(P, lds, lds + 65536, sub, row0 + 32 * p, lane); } } }
    else if (tmask & 1) mix_conv_task(P, 4 * w + (wave - 4), lane, 0, 48);
    __syncthreads();
    lds_stage_rows<192, 24, 32>(lds, (const unsigned char*)(P.ws + WS_POOLWT) + (size_t)sub * PGD * PGD * 2, PGD * 2, tid);
    LDS_WAIT(); __syncthreads();
    if (wave < 4) { if (tmask & 0x1e) {
#pragma unroll 1
        for (int p = 0; p < 2; ++p) { const int r = row0 + 32 * p; asm volatile("" ::: "memory");
            if (sub == 0) mix_pool_wave<0>(P, lds, r, lane); else if (sub == 1) mix_pool_wave<1>(P, lds, r, lane); else if (sub == 2) mix_pool_wave<2>(P, lds, r, lane); else mix_pool_wave<3>(P, lds, r, lane); } } }
    else if (tmask & 1) mix_conv_task(P, 4 * w + (wave - 4), lane, 48, 96);
    __syncthreads();
}

__device__ __forceinline__ void p5_fix_item(const Ptrs& P, int pm, int c) {
    const float* ub = (const float*)(P.ws + WS_UBND); bf16* act = (bf16*)(P.ws + WS_ACT); const float* cw = P.ffn_conv_w; const float* cb = P.ffn_conv_b;
    const int gi = 256 * (c / 128) + (c % 128);
    const float* p2 = ub + (size_t)((pm - 1) * 4 + 2) * DFF2 + gi; const float* p1 = p2 + DFF2; const float* r0 = ub + (size_t)(pm * 4) * DFF2 + gi; const float* r1 = r0 + DFF2;
    float o0[8], o1[8];
#pragma unroll
    for (int e = 0; e < 8; ++e) {
        const float gw0 = cw[c + e], gw1 = cw[DFF2 + c + e], gw2 = cw[2 * DFF2 + c + e], gb = cb[c + e], vw0 = cw[DFF + c + e], vw1 = cw[DFF2 + DFF + c + e], vw2 = cw[2 * DFF2 + DFF + c + e], vb = cb[DFF + c + e];
        const float G0 = gw2 * r0[e] + (gw1 * p1[e] + (gw0 * p2[e] + gb)), V0 = vw2 * r0[128 + e] + (vw1 * p1[128 + e] + (vw0 * p2[128 + e] + vb));
        const float G1 = gw2 * r1[e] + (gw1 * r0[e] + (gw0 * p1[e] + gb)), V1 = vw2 * r1[128 + e] + (vw1 * r0[128 + e] + (vw0 * p1[128 + e] + vb));
        o0[e] = G0 * __builtin_amdgcn_rcpf(1.0f + __builtin_amdgcn_exp2f(-1.4426950408889634f * G0)) * V0;
        o1[e] = G1 * __builtin_amdgcn_rcpf(1.0f + __builtin_amdgcn_exp2f(-1.4426950408889634f * G1)) * V1; }
    *(u32x4*)(act + (size_t)(256 * pm) * DFF + c) = pack8(o0); *(u32x4*)(act + (size_t)(256 * pm + 1) * DFF + c) = pack8(o1);
}
__device__ __forceinline__ void p6_fixup_panels(const Ptrs& P, int vcu, int G, int tid, unsigned* cnt, unsigned* tmo) {
    constexpr int GRP = DFF / 8 / 8;
    const int nround = (512 + G - 1) / G;
    for (int i = 0; i < nround; ++i) { const int L = i * G + vcu; if (L >= 512) break; const int pm = L >> 3, pn = L & 7;
        if (pm > 0 && tid < GRP) p5_fix_item(P, pm, (pn * GRP + tid) * 8); }
    asm volatile("s_waitcnt vmcnt(0)" ::: "memory"); __syncthreads();
    if (tid == 0) {
        __builtin_amdgcn_fence(__ATOMIC_RELEASE, "agent"); asm volatile("s_waitcnt vmcnt(0)" ::: "memory");
        for (int i = 0; i < nround; ++i) { const int L = i * G + vcu; if (L >= 512) break; __hip_atomic_fetch_add(cnt + 64 * (L >> 3), 1u, __ATOMIC_RELAXED, __HIP_MEMORY_SCOPE_AGENT); }
        for (int i = 0; i < nround; ++i) { const int L = i * G + vcu; if (L >= 512) break; unsigned spins = 0;
            while (__hip_atomic_load(cnt + 64 * (L >> 3), __ATOMIC_RELAXED, __HIP_MEMORY_SCOPE_AGENT) < 8u) { __builtin_amdgcn_s_sleep(2); if (++spins > (1u << 20)) { __hip_atomic_store(tmo, 1u, __ATOMIC_RELAXED, __HIP_MEMORY_SCOPE_AGENT); break; } } }
        __builtin_amdgcn_fence(__ATOMIC_ACQUIRE, "agent"); asm volatile("s_waitcnt vmcnt(0)" ::: "memory");
    }
    __syncthreads();
}
__device__ __forceinline__ void p5_fixup(const Ptrs& P, int gt, int NGT) {
    for (int i = gt; i < 63 * (DFF / 8); i += NGT) p5_fix_item(P, 1 + i / (DFF / 8), (i % (DFF / 8)) * 8);
}

__device__ __forceinline__ void p7_final(const Ptrs& P, int gw, int NGW, int lane) {
    const float* slab = (const float*)(P.ws + WS_SLAB2);
    for (int m = gw; m < SEQ; m += NGW) {
        const float part = (lane < 32) ? slab[(size_t)m * 32 + lane] : 0.f;
        const float rstd = 1.0f / sqrtf(wave_sum(part) * (1.0f / DMODEL) + EPS);
        f32x4* xr = (f32x4*)(P.out + (size_t)m * DMODEL) + lane; const f32x4* gr = (const f32x4*)P.g_final + lane;
#pragma unroll
        for (int j = 0; j < 8; ++j) { f32x4 v = xr[64 * j]; const f32x4 gg = gr[64 * j]; v = v * rstd * gg; xr[64 * j] = v; }
    }
}

struct Args { const float* in[16]; float* out; unsigned char* ws; int ph_lo, ph_hi; };
__global__ void __launch_bounds__(NWAVES * 64, 2) hybrid_fwd(Args args) {
    extern __shared__ __attribute__((aligned(16))) unsigned char lds_raw[];
    LAS unsigned char* lds = (LAS unsigned char*)lds_raw;
    cg::grid_group grid = cg::this_grid();
    const int tid = threadIdx.x, lane = tid & 63, wave = __builtin_amdgcn_readfirstlane(tid >> 6);
    const int G = gridDim.x, bx = blockIdx.x, vcu = (G % 8 == 0) ? (bx % 8) * (G / 8) + bx / 8 : bx;
    const int gw = vcu * NWAVES + wave, NGW = G * NWAVES;
    volatile LAS unsigned* MISC = (volatile LAS unsigned*)(lds + MISC_OFF);
    if (tid < 32) MISC[tid] = 0u;
    __syncthreads();
    const XcdBarrier bar = xcd_barrier_post((unsigned*)(args.ws + WS_CTL), MISC + 8);
    Ptrs P;
    P.x = args.in[0]; P.mem = args.in[1]; P.g_mix = args.in[2]; P.g_mem = args.in[3]; P.w_in = args.in[4]; P.conv_w = args.in[5]; P.pool_w = args.in[6]; P.pool_scale = args.in[7];
    P.w_kv = args.in[8]; P.w_out = args.in[9]; P.g_ffn = args.in[10]; P.w_up = args.in[11]; P.ffn_conv_w = args.in[12]; P.ffn_conv_b = args.in[13]; P.w_down = args.in[14]; P.g_final = args.in[15];
    P.out = args.out; P.ws = args.ws;
    unsigned char* ws = args.ws;
#if PROBE_SYNC
    for (int i = 0; i < 20; ++i) xcd_barrier(bar);
#endif
    const int lo = args.ph_lo, hi = args.ph_hi;
#define IN(k) (lo <= (k) && (k) < hi)
#define SYNC(k) do { if ((k) + 1 < hi) { if ((k) == 0 && USE_CG_SYNC) grid.sync(); else xcd_barrier(bar); } } while (0)
#define SYNCR(k, b) do { if ((k) + 1 < hi || rp + 1 < NREP(b)) { if ((k) == 0 && USE_CG_SYNC) grid.sync(); else xcd_barrier(bar); } } while (0)
#define NREP(b) ((REPM & (b)) ? 2 : 1)
    if (IN(0) && (PHM & 1)) for (int rp = 0; rp < NREP(1); ++rp) { p0_prologue(P, lds, gw, NGW, wave, lane); SYNCR(0, 1); }
    if (IN(1) && (PHM & 2)) for (int rp = 0; rp < NREP(2); ++rp) {
        pg8::Gemm g{(const bf16*)(ws + WS_H), (const bf16*)(ws + WS_WINT), SEQ, DIN, DMODEL}; pg8::StaticOrder S; S.init(SEQ, DIN, G, bx);
        pg8::EpiZ E{(bf16*)(ws + WS_Z), DIN};
        pg8::gemm_phase<pg8::EpiZ, pg8::StaticOrder, P1_ALIGN, true>(lds, g, S, E, lds + XLDS_OFF);
        { const int nfull = ((SEQ / 256) * (DIN / 256)) % G;
          if (nfull == 0) p1_idle_work(P, lds, bx * NWAVES + wave, G * NWAVES, wave, lane);
          else if (bx >= nfull) p1_idle_work(P, lds, (bx - nfull) * NWAVES + wave, (G - nfull) * NWAVES, wave, lane); }
        SYNCR(1, 2);
    }
    if (IN(2) && (PHM & 4)) for (int rp = 0; rp < NREP(4); ++rp) { p2_mixer(P, lds, vcu, tid, wave, lane, 511);
#if PROBE_P2
        p2_mixer(P, lds, vcu, tid, wave, lane, PROBE_P2);
#endif
        SYNCR(2, 4); }
    if (IN(3) && (PHM & 8)) {
        pg8::Gemm g{(const bf16*)(ws + WS_MIX), (const bf16*)(ws + WS_WOUTT), SEQ, DMODEL, DMODEL}; pg8::PanelOrder S{G, vcu, (SEQ / 256) * (DMODEL / 256)};
        pg8::EpiNorm<0> E{P.x, nullptr, nullptr, (float*)(ws + WS_SIG), (bf16*)(ws + WS_X1B), nullptr, nullptr, (unsigned*)(ws + WS_SLAB1), (unsigned*)(ws + WS_CTL) + CW_PANEL1, (unsigned*)(ws + WS_CTL) + XB_TMO};
        pg8::gemm_phase<pg8::EpiNorm<0>, pg8::PanelOrder, true, true>(lds, g, S, E, lds + XLDS_OFF);
        SYNC(3);
    }
#if PROBE_GEMM
    if (IN(3)) {
        pg8::Gemm g{(const bf16*)(ws + WS_X1B), (const bf16*)(ws + WS_WUPT), SEQ, PROBE_N, DMODEL}; pg8::StaticOrder S; S.init(SEQ, PROBE_N, G, bx);
#if PROBE_GEMM == 1
        pg8::EpiZ E{(bf16*)(ws + WS_Z), PROBE_N};
        pg8::gemm_phase<pg8::EpiZ, pg8::StaticOrder, true, true>(lds, g, S, E, lds + XLDS_OFF);
#elif PROBE_GEMM == 2
        pg8::EpiNone E{};
        pg8::gemm_phase<pg8::EpiNone, pg8::StaticOrder, true, true>(lds, g, S, E, lds + XLDS_OFF);
#elif PROBE_GEMM == 3
        pg8::EpiZ E{(bf16*)(ws + WS_Z), PROBE_N};
        pg8::gemm_phase<pg8::EpiZ, pg8::StaticOrder, true, false>(lds, g, S, E, lds + XLDS_OFF);
#elif PROBE_GEMM == 5
        pg8::EpiAct E{(bf16*)(ws + WS_ACT), P.ffn_conv_w, P.ffn_conv_b, (float*)(ws + WS_UBND)};
        pg8::gemm_phase<pg8::EpiAct, pg8::StaticOrder, true, true>(lds, g, S, E, lds + XLDS_OFF);
#elif PROBE_GEMM == 4
        pg8::EpiZ E{(bf16*)(ws + WS_Z), PROBE_N};
        pg8::gemm_phase<pg8::EpiZ, pg8::StaticOrder, false, true>(lds, g, S, E, lds + XLDS_OFF);
#endif
        xcd_barrier(bar);
    }
#endif
    if (IN(4) && (PHM & 16)) for (int rp = 0; rp < NREP(16); ++rp) {
        pg8::Gemm g{(const bf16*)(ws + WS_X1B), (const bf16*)(ws + WS_WUPT), SEQ, DFF2, DMODEL}; pg8::StaticOrder S; S.init(SEQ, DFF2, G, bx);
        pg8::EpiAct E{(bf16*)(ws + WS_ACT), P.ffn_conv_w, P.ffn_conv_b, (float*)(ws + WS_UBND)};
        pg8::gemm_phase<pg8::EpiAct, pg8::StaticOrder, true, true>(lds, g, S, E, lds + XLDS_OFF);
        SYNCR(4, 16);
    }
#if !FUSE_FIXUP
    if (IN(5) && (PHM & 32)) { p5_fixup(P, vcu * (NWAVES * 64) + tid, G * NWAVES * 64); SYNC(5); }
#endif
    if (IN(6) && (PHM & 64)) {
#if FUSE_FIXUP
        p6_fixup_panels(P, vcu, G, tid, (unsigned*)(ws + WS_CTL) + CW_PANEL2, (unsigned*)(ws + WS_CTL) + XB_TMO);
#endif
        pg8::Gemm g{(const bf16*)(ws + WS_ACT), (const bf16*)(ws + WS_WDOWNT), SEQ, DMODEL, DFF}; pg8::PanelOrder S{G, vcu, (SEQ / 256) * (DMODEL / 256)};
        pg8::EpiNorm<1> E{nullptr, (const bf16*)(ws + WS_X1B), (const float*)(ws + WS_SIG), nullptr, nullptr, P.out, P.g_final, (unsigned*)(ws + WS_SLAB2), (unsigned*)(ws + WS_CTL) + CW_PANEL, (unsigned*)(ws + WS_CTL) + XB_TMO};
        pg8::gemm_phase<pg8::EpiNorm<1>, pg8::PanelOrder, true, true>(lds, g, S, E, lds + XLDS_OFF);
    }
#undef IN
#undef SYNC
}

extern "C" void kernel_launch(void* const* d_in, const int* in_sizes, int n_in, void* d_out, int out_size, void* d_ws, size_t ws_size, hipStream_t stream) {
    static int grid = 0;
    if (grid == 0) {
        if (n_in != 16 || in_sizes[0] != SEQ * DMODEL || out_size != SEQ * DMODEL || ws_size < WS_END) { fprintf(stderr, "kernel_launch: unexpected shapes (n_in %d, in0 %d, out %d, ws %zu)\n", n_in, n_in > 0 ? in_sizes[0] : -1, out_size, ws_size); grid = -1; return; }
        int dev = 0, cus = 0, per_cu = 0;
        if (hipGetDevice(&dev) != hipSuccess || hipDeviceGetAttribute(&cus, hipDeviceAttributeMultiprocessorCount, dev) != hipSuccess) { grid = -1; return; }
        if (hipFuncSetAttribute((const void*)hybrid_fwd, hipFuncAttributeMaxDynamicSharedMemorySize, LDS_BYTES) != hipSuccess) { fprintf(stderr, "kernel_launch: hipFuncSetAttribute failed\n"); grid = -1; return; }
        if (hipOccupancyMaxActiveBlocksPerMultiprocessor(&per_cu, (const void*)hybrid_fwd, NWAVES * 64, LDS_BYTES) != hipSuccess || per_cu < 1) { fprintf(stderr, "kernel_launch: occupancy query says %d blocks per CU\n", per_cu); (void)hipGetLastError(); per_cu = 1; }
        grid = cus;
        if (grid != 256) { fprintf(stderr, "kernel_launch: this kernel is laid out for one workgroup on each of 256 CUs (the mixer phase and the row-statistics exchanges assume it); the device reports %d\n", grid); if (grid > 256) grid = 256; }
    }
    if (grid < 0) return;
    if (hipMemsetAsync((char*)d_ws + WS_CTL, 0, CTL_ZERO_BYTES, stream) != hipSuccess) { fprintf(stderr, "kernel_launch: hipMemsetAsync failed\n"); return; }
    Args a{};
    for (int i = 0; i < 16; ++i) a.in[i] = (const float*)d_in[i];
    a.out = (float*)d_out; a.ws = (unsigned char*)d_ws;
#if MK_PER_PHASE
    for (int ph = 0; ph < NPHASE; ++ph) { a.ph_lo = ph; a.ph_hi = ph + 1; hipLaunchKernelGGL(hybrid_fwd, dim3(grid), dim3(NWAVES * 64), LDS_BYTES, stream, a); }
#else
    a.ph_lo = 0; a.ph_hi = NPHASE;
    void* kargs[] = {&a};
    hipError_t e = hipLaunchCooperativeKernel((const void*)hybrid_fwd, dim3(grid), dim3(NWAVES * 64), kargs, LDS_BYTES, stream);
    if (e != hipSuccess) fprintf(stderr, "kernel_launch: cooperative launch failed: %s (grid %d)\n", hipGetErrorString(e), grid);
#endif
}
```

```cpp
#include <hip/hip_runtime.h>
#include <hip/hip_cooperative_groups.h>
#include <cstdio>
#include <cstdint>
namespace cg = cooperative_groups;
#ifndef PG8_PRIO
#define PG8_PRIO 0
#endif
namespace pg8 {
#define PG8_LAS __attribute__((address_space(3)))
typedef unsigned short bf16_t;
typedef short bf16x8 __attribute__((ext_vector_type(8)));
typedef float f32x4 __attribute__((ext_vector_type(4)));
typedef unsigned u32x4 __attribute__((ext_vector_type(4)));
constexpr int BM = 256, BK = 64, HALF = 128, HTB = HALF * BK * 2  , STAGE_BYTES = 8 * HTB, NXCD = 8, WGM = 8;

__host__ __device__ __forceinline__ int lds_byte(int r, int c) { const int st = (r >> 4) * 2 + (c >> 5), rr = r & 15, cc = c & 31, ob = rr * 64 + cc * 2; return st * 1024 + (ob ^ (((ob >> 9) & 1) << 5)); }
__host__ __device__ __forceinline__ void stage_rc(int b, int& R, int& C) { const int st = b / 1024, sb = b % 1024, swz = sb ^ (((sb >> 9) & 1) << 5); R = (st >> 1) * 16 + swz / 64; C = (st & 1) * 32 + (swz % 64) / 2; }
__host__ __device__ __forceinline__ int perm32(int rho) { const int n = rho >> 4, i = rho & 15; return 8 * (i >> 2) + 4 * n + (i & 3); }

struct Unit { int pm, pn; };
struct Gemm { const bf16_t* A; const bf16_t* Bt; int M, N, K; };

struct StaticOrder {
    int nM, nN, nwg, G, c;
    __host__ __device__ void init(int M, int N, int G_, int c_) { nM = M / BM; nN = N / BM; nwg = nM * nN; G = G_; c = c_; }
    __host__ __device__ bool next(int i, Unit& u) const {
        const long L = (long)i * G + c; if (L >= nwg) return false;
        int wgid = (int)L; { const int q = nwg / NXCD, r = nwg % NXCD, xcd = wgid % NXCD, off = wgid / NXCD; wgid = (xcd < r ? xcd * (q + 1) : r * (q + 1) + (xcd - r) * q) + off; }
        const int nig = WGM * nN, gid = wgid / nig, fm = gid * WGM, gsz = (nM - fm) < WGM ? (nM - fm) : WGM;
        u.pm = fm + ((wgid % nig) % gsz); u.pn = (wgid % nig) / gsz; return true;
    }
    __device__ __forceinline__ void a_ready(const Unit&) const {}
    __device__ __forceinline__ void done(const Unit&) const {}
};
__device__ __forceinline__ unsigned cvt_pk_bf16(float lo, float hi) { unsigned r; asm volatile("v_cvt_pk_bf16_f32 %0, %1, %2" : "=v"(r) : "v"(lo), "v"(hi)); return r; }
typedef unsigned u32x2 __attribute__((ext_vector_type(2)));
constexpr int DM = 2048;
constexpr float RMS_EPS = 1e-6f;

struct EpiZ {
    static constexpr bool PERM = true, AFTER_DRAIN = false;
    bf16_t* O; int ldc;
    __device__ __forceinline__ void operator()(const f32x4 (&acc)[2][2][4][2], const Unit& u, int wr, int wc, int fr_, int fq_, PG8_LAS unsigned char*) const {
        int t_ = threadIdx.x; asm volatile("" : "+v"(t_));
        const int fr = t_ & 15, fq = (t_ >> 4) & 3;
        const int row0 = u.pm * BM + wr * 64 + fr, col0 = u.pn * BM + wc * 32 + 8 * fq;
#pragma unroll
        for (int ai = 0; ai < 2; ++ai)
#pragma unroll
            for (int m = 0; m < 4; ++m) { bf16_t* rowp = O + (size_t)(row0 + ai * HALF + m * 16) * ldc + col0;
#pragma unroll
                for (int bj = 0; bj < 2; ++bj) { const f32x4 v0 = acc[ai][bj][m][0], v1 = acc[ai][bj][m][1];
                    u32x4 w; w.x = cvt_pk_bf16(v0[0], v0[1]); w.y = cvt_pk_bf16(v0[2], v0[3]); w.z = cvt_pk_bf16(v1[0], v1[1]); w.w = cvt_pk_bf16(v1[2], v1[3]);
                    *(u32x4*)(rowp + bj * HALF) = w; } }
    }
};

struct EpiNone {
    static constexpr bool PERM = true, AFTER_DRAIN = false;
    __device__ __forceinline__ void operator()(const f32x4 (&acc)[2][2][4][2], const Unit& u, int wr, int wc, int fr, int fq, PG8_LAS unsigned char*) const {
#pragma unroll
        for (int ai = 0; ai < 2; ++ai)
#pragma unroll
            for (int bj = 0; bj < 2; ++bj)
#pragma unroll
                for (int m = 0; m < 4; ++m)
#pragma unroll
                    for (int n = 0; n < 2; ++n) asm volatile("" :: "v"(acc[ai][bj][m][n]));
    }
};
struct EpiResA {
    static constexpr bool PERM = true, AFTER_DRAIN = false;
    const float* R; bf16_t* XB; float* slab;
    __device__ __forceinline__ void operator()(const f32x4 (&acc)[2][2][4][2], const Unit& u, int wr, int wc, int fr_, int fq_, PG8_LAS unsigned char*) const {
        int t_ = threadIdx.x; asm volatile("" : "+v"(t_));
        const int fr = t_ & 15, fq = (t_ >> 4) & 3;
        const int row0 = u.pm * BM + wr * 64 + fr, col0 = u.pn * BM + wc * 32 + 8 * fq;
#pragma unroll
        for (int ai = 0; ai < 2; ++ai) {
            f32x4 r[4][2][2];
#pragma unroll
            for (int m = 0; m < 4; ++m)
#pragma unroll
                for (int bj = 0; bj < 2; ++bj) { const float* p = R + (size_t)(row0 + ai * HALF + m * 16) * DM + col0 + bj * HALF; r[m][bj][0] = *(const f32x4*)p; r[m][bj][1] = *(const f32x4*)(p + 4); }
#pragma unroll
            for (int m = 0; m < 4; ++m) { const int row = row0 + ai * HALF + m * 16; float ss = 0.f;
#pragma unroll
                for (int bj = 0; bj < 2; ++bj) { const f32x4 v0 = acc[ai][bj][m][0] + r[m][bj][0], v1 = acc[ai][bj][m][1] + r[m][bj][1];
                    u32x4 w; w.x = cvt_pk_bf16(v0[0], v0[1]); w.y = cvt_pk_bf16(v0[2], v0[3]); w.z = cvt_pk_bf16(v1[0], v1[1]); w.w = cvt_pk_bf16(v1[2], v1[3]);
                    *(u32x4*)(XB + (size_t)row * DM + col0 + bj * HALF) = w;
                    ss += (v0[0] * v0[0] + v0[1] * v0[1]) + (v0[2] * v0[2] + v0[3] * v0[3]) + (v1[0] * v1[0] + v1[1] * v1[1]) + (v1[2] * v1[2] + v1[3] * v1[3]); }
                ss += __shfl_xor(ss, 16); ss += __shfl_xor(ss, 32);
                if (fq == 0) slab[(size_t)row * 32 + u.pn * 4 + wc] = ss; }
            asm volatile("" ::: "memory"); }
    }
};
struct EpiResB {
    static constexpr bool PERM = true, AFTER_DRAIN = false;
    const bf16_t* RB; float* X; float* slab;
    __device__ __forceinline__ void operator()(const f32x4 (&acc)[2][2][4][2], const Unit& u, int wr, int wc, int fr_, int fq_, PG8_LAS unsigned char*) const {
        int t_ = threadIdx.x; asm volatile("" : "+v"(t_));
        const int fr = t_ & 15, fq = (t_ >> 4) & 3;
        const int row0 = u.pm * BM + wr * 64 + fr, col0 = u.pn * BM + wc * 32 + 8 * fq;
        u32x4 r[2][4][2];
#pragma unroll
        for (int ai = 0; ai < 2; ++ai)
#pragma unroll
            for (int m = 0; m < 4; ++m)
#pragma unroll
                for (int bj = 0; bj < 2; ++bj) r[ai][m][bj] = *(const u32x4*)(RB + (size_t)(row0 + ai * HALF + m * 16) * DM + col0 + bj * HALF);
#pragma unroll
        for (int ai = 0; ai < 2; ++ai)
#pragma unroll
            for (int m = 0; m < 4; ++m) { const int row = row0 + ai * HALF + m * 16; float ss = 0.f;
#pragma unroll
                for (int bj = 0; bj < 2; ++bj) { const u32x4 q = r[ai][m][bj];
                    const f32x4 r0 = {__builtin_bit_cast(float, q.x << 16), __builtin_bit_cast(float, q.x & 0xffff0000u), __builtin_bit_cast(float, q.y << 16), __builtin_bit_cast(float, q.y & 0xffff0000u)};
                    const f32x4 r1 = {__builtin_bit_cast(float, q.z << 16), __builtin_bit_cast(float, q.z & 0xffff0000u), __builtin_bit_cast(float, q.w << 16), __builtin_bit_cast(float, q.w & 0xffff0000u)};
                    const f32x4 v0 = acc[ai][bj][m][0] + r0, v1 = acc[ai][bj][m][1] + r1;
                    float* xp = X + (size_t)row * DM + col0 + bj * HALF; *(f32x4*)xp = v0; *(f32x4*)(xp + 4) = v1;
                    ss += (v0[0] * v0[0] + v0[1] * v0[1]) + (v0[2] * v0[2] + v0[3] * v0[3]) + (v1[0] * v1[0] + v1[1] * v1[1]) + (v1[2] * v1[2] + v1[3] * v1[3]); }
                ss += __shfl_xor(ss, 16); ss += __shfl_xor(ss, 32);
                if (fq == 0) slab[(size_t)row * 32 + u.pn * 4 + wc] = ss; }
    }
};

struct PanelOrder {
    int G, vcu, ntot;
    __device__ __forceinline__ bool next(int i, Unit& u) const { const int L = i * G + vcu; if (L >= ntot) return false; u.pm = L >> 3; u.pn = L & 7; return true; }
    __device__ __forceinline__ void a_ready(const Unit&) const {}
    __device__ __forceinline__ void done(const Unit&) const {}
};
template <int MODE  > struct EpiNorm {
    static constexpr bool PERM = (MODE == 0), AFTER_DRAIN = false;
    const float* Rf; const bf16_t* Rb; const float* sig_in; float* sig_out; bf16_t* HN; float* OUT; const float* gfin; unsigned* xbuf; unsigned* cnt; unsigned* tmo;
    __device__ __forceinline__ void operator()(f32x4 (&acc)[2][2][4][2], const Unit& u, int wr, int wc, int fr_, int fq_, PG8_LAS unsigned char* xlds) const {
        int t_ = threadIdx.x; asm volatile("" : "+v"(t_));
        const int fr = t_ & 15, fq = (t_ >> 4) & 3, wid = __builtin_amdgcn_readfirstlane(t_ >> 6);
        const int rl0 = wr * 64 + fr, row0 = u.pm * BM + rl0, col0 = u.pn * BM + wc * 32 + 8 * fq;
        PG8_LAS float* Pt = (PG8_LAS float*)xlds;
        PG8_LAS float* St = (PG8_LAS float*)(xlds + 4096);
        if constexpr (MODE == 0) {
#pragma unroll
            for (int ai = 0; ai < 2; ++ai) { f32x4 r[4][2][2];
#pragma unroll
                for (int m = 0; m < 4; ++m)
#pragma unroll
                    for (int bj = 0; bj < 2; ++bj) { const float* p = Rf + (size_t)(row0 + ai * HALF + m * 16) * DM + col0 + bj * HALF; r[m][bj][0] = *(const f32x4*)p; r[m][bj][1] = *(const f32x4*)(p + 4); }
#pragma unroll
                for (int m = 0; m < 4; ++m) { float ss = 0.f;
#pragma unroll
                    for (int bj = 0; bj < 2; ++bj) { const f32x4 v0 = acc[ai][bj][m][0] + r[m][bj][0], v1 = acc[ai][bj][m][1] + r[m][bj][1]; acc[ai][bj][m][0] = v0; acc[ai][bj][m][1] = v1;
                        ss += (v0[0] * v0[0] + v0[1] * v0[1]) + (v0[2] * v0[2] + v0[3] * v0[3]) + (v1[0] * v1[0] + v1[1] * v1[1]) + (v1[2] * v1[2] + v1[3] * v1[3]); }
                    ss += __shfl_xor(ss, 16); ss += __shfl_xor(ss, 32);
                    if (fq == 0) Pt[(ai * HALF + rl0 + m * 16) * 4 + wc] = ss; }
                asm volatile("" ::: "memory"); }
        } else { u32x2 r[2][4][2][2]; float sg[2][4]; const int colb = u.pn * BM + wc * 32 + 4 * fq;
#pragma unroll
            for (int ai = 0; ai < 2; ++ai)
#pragma unroll
                for (int m = 0; m < 4; ++m) { sg[ai][m] = sig_in[row0 + ai * HALF + m * 16];
#pragma unroll
                    for (int bj = 0; bj < 2; ++bj)
#pragma unroll
                        for (int n = 0; n < 2; ++n) r[ai][m][bj][n] = *(const u32x2*)(Rb + (size_t)(row0 + ai * HALF + m * 16) * DM + colb + bj * HALF + 16 * n); }
#pragma unroll
            for (int ai = 0; ai < 2; ++ai)
#pragma unroll
                for (int m = 0; m < 4; ++m) { float ss = 0.f; const float sgm = sg[ai][m];
#pragma unroll
                    for (int bj = 0; bj < 2; ++bj)
#pragma unroll
                        for (int n = 0; n < 2; ++n) { const u32x2 q = r[ai][m][bj][n];
                            const f32x4 r0 = {__builtin_bit_cast(float, q.x << 16), __builtin_bit_cast(float, q.x & 0xffff0000u), __builtin_bit_cast(float, q.y << 16), __builtin_bit_cast(float, q.y & 0xffff0000u)};
                            const f32x4 v0 = acc[ai][bj][m][n] + r0 * sgm; acc[ai][bj][m][n] = v0;
                            ss += (v0[0] * v0[0] + v0[1] * v0[1]) + (v0[2] * v0[2] + v0[3] * v0[3]); }
                    ss += __shfl_xor(ss, 16); ss += __shfl_xor(ss, 32);
                    if (fq == 0) Pt[(ai * HALF + rl0 + m * 16) * 4 + wc] = ss; } }
        asm volatile("s_waitcnt lgkmcnt(0)" ::: "memory"); __builtin_amdgcn_s_barrier(); asm volatile("" ::: "memory");
        if (t_ < 256) { const float s = (Pt[t_ * 4 + 0] + Pt[t_ * 4 + 1]) + (Pt[t_ * 4 + 2] + Pt[t_ * 4 + 3]);
            __hip_atomic_store(xbuf + (size_t)(u.pm * BM + t_) * 8 + u.pn, __builtin_bit_cast(unsigned, s), __ATOMIC_RELAXED, __HIP_MEMORY_SCOPE_AGENT); }
        asm volatile("s_waitcnt vmcnt(0)" ::: "memory");
        if (t_ < 256 && (t_ & 63) == 0) __hip_atomic_fetch_add(cnt + 64 * u.pm, 1u, __ATOMIC_RELAXED, __HIP_MEMORY_SCOPE_AGENT);
        if (wid == 0) {
            unsigned spins = 0;
            while ((unsigned)__builtin_amdgcn_readfirstlane(__hip_atomic_load(cnt + 64 * u.pm, __ATOMIC_RELAXED, __HIP_MEMORY_SCOPE_AGENT)) < 32u) {
                __builtin_amdgcn_s_sleep(2);
                if (++spins > (1u << 20)) { if ((t_ & 63) == 0) __hip_atomic_store(tmo, 1u, __ATOMIC_RELAXED, __HIP_MEMORY_SCOPE_AGENT); break; } }
            __builtin_amdgcn_fence(__ATOMIC_ACQUIRE, "agent");
        }
        asm volatile("s_waitcnt vmcnt(0) lgkmcnt(0)" ::: "memory"); __builtin_amdgcn_s_barrier(); asm volatile("" ::: "memory");
        if (t_ < 256) { const unsigned long long* sp = (const unsigned long long*)(xbuf + (size_t)(u.pm * BM + t_) * 8); float tot = 0.f;
#pragma unroll
            for (int q = 0; q < 4; ++q) { const unsigned long long w = __hip_atomic_load(sp + q, __ATOMIC_RELAXED, __HIP_MEMORY_SCOPE_AGENT);
                tot += __builtin_bit_cast(float, (unsigned)w); tot += __builtin_bit_cast(float, (unsigned)(w >> 32)); }
            const float sd = sqrtf(tot * (1.0f / DM) + RMS_EPS);
            St[t_] = 1.0f / sd;
            if (MODE == 0 && u.pn == 0) sig_out[u.pm * BM + t_] = sd; }
        asm volatile("s_waitcnt lgkmcnt(0)" ::: "memory"); __builtin_amdgcn_s_barrier(); asm volatile("" ::: "memory");
        if constexpr (MODE == 0) {
#pragma unroll
            for (int ai = 0; ai < 2; ++ai)
#pragma unroll
                for (int m = 0; m < 4; ++m) { const float rstd = St[ai * HALF + rl0 + m * 16]; bf16_t* op = HN + (size_t)(row0 + ai * HALF + m * 16) * DM + col0;
#pragma unroll
                    for (int bj = 0; bj < 2; ++bj) { const f32x4 v0 = acc[ai][bj][m][0] * rstd, v1 = acc[ai][bj][m][1] * rstd;
                        u32x4 w; w.x = cvt_pk_bf16(v0[0], v0[1]); w.y = cvt_pk_bf16(v0[2], v0[3]); w.z = cvt_pk_bf16(v1[0], v1[1]); w.w = cvt_pk_bf16(v1[2], v1[3]);
                        *(u32x4*)(op + bj * HALF) = w; } }
        } else {
            const int colb = u.pn * BM + wc * 32 + 4 * fq; const bool odd = fr & 1;
            f32x4 gg[2][2];
#pragma unroll
            for (int bj = 0; bj < 2; ++bj)
#pragma unroll
                for (int n = 0; n < 2; ++n) gg[bj][n] = *(const f32x4*)(gfin + colb + bj * HALF + 16 * n);
#pragma unroll
            for (int ai = 0; ai < 2; ++ai)
#pragma unroll
                for (int m = 0; m < 4; ++m) { const float rstd = St[ai * HALF + rl0 + m * 16]; float* op = OUT + (size_t)(row0 + ai * HALF + m * 16) * DM + colb;
#pragma unroll
                    for (int bj = 0; bj < 2; ++bj) {
                        const f32x4 o0 = acc[ai][bj][m][0] * rstd * gg[bj][0], o1 = acc[ai][bj][m][1] * rstd * gg[bj][1]; f32x4 dA, dB;
#pragma unroll
                        for (int j = 0; j < 4; ++j) { const float snd = odd ? o0[j] : o1[j];
                            const float rcv = __builtin_bit_cast(float, __builtin_amdgcn_mov_dpp(__builtin_bit_cast(int, snd), 0xB1, 0xf, 0xf, false));
                            dA[j] = odd ? rcv : o0[j]; dB[j] = odd ? o1[j] : rcv; }
                        float* pp = op + bj * HALF + (odd ? 16 : 0);
                        *(f32x4*)(pp - (odd ? DM : 0)) = dA; *(f32x4*)(pp + (odd ? 0 : DM)) = dB; } }
        }
    }
};

__device__ __forceinline__ float dpp_shr1(float old, float src) { return __builtin_bit_cast(float, __builtin_amdgcn_update_dpp(__builtin_bit_cast(int, old), __builtin_bit_cast(int, src), 0x111, 0xf, 0xf, false)); }
__device__ __forceinline__ float dpp_shr2(float old, float src) { return __builtin_bit_cast(float, __builtin_amdgcn_update_dpp(__builtin_bit_cast(int, old), __builtin_bit_cast(int, src), 0x112, 0xf, 0xf, false)); }
__device__ __forceinline__ float dpp_ror1(float src) { return __builtin_bit_cast(float, __builtin_amdgcn_mov_dpp(__builtin_bit_cast(int, src), 0x121, 0xf, 0xf, false)); }
__device__ __forceinline__ float dpp_ror2(float src) { return __builtin_bit_cast(float, __builtin_amdgcn_mov_dpp(__builtin_bit_cast(int, src), 0x122, 0xf, 0xf, false)); }
constexpr int FF = 5632, FF2 = 11264;
struct EpiAct {
    static constexpr bool PERM = true, AFTER_DRAIN = false;
    bf16_t* ACT; const float* cw; const float* cb; float* ubnd;
    __device__ __forceinline__ void operator()(f32x4 (&acc)[2][2][4][2], const Unit& u, int wr, int wc, int fr_, int fq_, PG8_LAS unsigned char* xlds) const {
        int t_ = threadIdx.x; asm volatile("" : "+v"(t_));
        const int fr = t_ & 15, fq = (t_ >> 4) & 3;
        const int row0 = u.pm * BM + wr * 64 + fr, cl = wc * 32 + 8 * fq;
        const int c0 = u.pn * 128 + cl;
        f32x4 wgt[2][8];
#pragma unroll
        for (int n = 0; n < 2; ++n) { const float* wp = cw + c0 + 4 * n; const float* bp = cb + c0 + 4 * n;
            wgt[n][0] = *(const f32x4*)wp; wgt[n][1] = *(const f32x4*)(wp + FF2); wgt[n][2] = *(const f32x4*)(wp + 2 * FF2); wgt[n][3] = *(const f32x4*)bp;
            wgt[n][4] = *(const f32x4*)(wp + FF); wgt[n][5] = *(const f32x4*)(wp + FF2 + FF); wgt[n][6] = *(const f32x4*)(wp + 2 * FF2 + FF); wgt[n][7] = *(const f32x4*)(bp + FF); }
        if (fr >= 14) {
#pragma unroll
            for (int ai = 0; ai < 2; ++ai)
#pragma unroll
                for (int bj = 0; bj < 2; ++bj)
#pragma unroll
                    for (int n = 0; n < 2; ++n) *(PG8_LAS f32x4*)(xlds + ((((2 * ai + wr) * 2 + (fr - 14)) * 256 + 128 * bj + cl + 4 * n) << 2)) = acc[ai][bj][3][n];
            if (wr == 1) {
#pragma unroll
                for (int bj = 0; bj < 2; ++bj)
#pragma unroll
                    for (int n = 0; n < 2; ++n) *(f32x4*)(ubnd + (size_t)(u.pm * 4 + 2 + (fr - 14)) * FF2 + u.pn * BM + 128 * bj + cl + 4 * n) = acc[1][bj][3][n]; }
        }
        if (wr == 0 && fr < 2) {
#pragma unroll
            for (int bj = 0; bj < 2; ++bj)
#pragma unroll
                for (int n = 0; n < 2; ++n) *(f32x4*)(ubnd + (size_t)(u.pm * 4 + fr) * FF2 + u.pn * BM + 128 * bj + cl + 4 * n) = acc[0][bj][0][n]; }
        asm volatile("s_waitcnt lgkmcnt(0)" ::: "memory"); __builtin_amdgcn_s_barrier(); asm volatile("" ::: "memory");
        u32x2 hold[2][4];
#pragma unroll
        for (int n = 0; n < 2; ++n) {
            const f32x4 gw0 = wgt[n][0], gw1 = wgt[n][1], gw2 = wgt[n][2], gb = wgt[n][3], vw0 = wgt[n][4], vw1 = wgt[n][5], vw2 = wgt[n][6], vb = wgt[n][7];
#pragma unroll
            for (int ai = 0; ai < 2; ++ai) {
                const int chunk = 2 * ai + wr;
                f32x4 pg = {0.f, 0.f, 0.f, 0.f}, pv = {0.f, 0.f, 0.f, 0.f};
                if (chunk > 0) { const PG8_LAS unsigned char* bp = xlds + ((((chunk - 1) * 2 + (fr & 1)) * 256 + cl + 4 * n) << 2);
                    pg = *(const PG8_LAS f32x4*)bp; pv = *(const PG8_LAS f32x4*)(bp + 512); }
#pragma unroll
                for (int m = 0; m < 4; ++m) {
                    const f32x4 cg = acc[ai][0][m][n], cv = acc[ai][1][m][n]; float a[4];
#pragma unroll
                    for (int j = 0; j < 4; ++j) {
                        const float g1 = dpp_shr1(dpp_ror1(pg[j]), cg[j]), g2 = dpp_shr2(dpp_ror2(pg[j]), cg[j]);
                        const float v1 = dpp_shr1(dpp_ror1(pv[j]), cv[j]), v2 = dpp_shr2(dpp_ror2(pv[j]), cv[j]);
                        const float G = gw2[j] * cg[j] + (gw1[j] * g1 + (gw0[j] * g2 + gb[j]));
                        const float V = vw2[j] * cv[j] + (vw1[j] * v1 + (vw0[j] * v2 + vb[j]));
                        a[j] = G * __builtin_amdgcn_rcpf(1.0f + __builtin_amdgcn_exp2f(-1.4426950408889634f * G)) * V; }
                    u32x2 w; w.x = cvt_pk_bf16(a[0], a[1]); w.y = cvt_pk_bf16(a[2], a[3]);
                    if (n == 0) hold[ai][m] = w;
                    else { u32x4 o; o.x = hold[ai][m].x; o.y = hold[ai][m].y; o.z = w.x; o.w = w.y;
                        if (!(ai == 0 && m == 0 && wr == 0 && u.pm > 0 && fr < 2)) *(u32x4*)(ACT + (size_t)(row0 + ai * HALF + m * 16) * FF + c0) = o; }
                    pg = cg; pv = cv;
                }
            }
        }
    }
};

template <class Epi, class Sched, bool ALIGN_EPI = false, bool SP2 = false>
__device__ __forceinline__ void gemm_phase(PG8_LAS unsigned char* lds, const Gemm g, const Sched& S, const Epi& E, PG8_LAS unsigned char* xlds) {
    const int tid = threadIdx.x, wid = __builtin_amdgcn_readfirstlane(tid >> 6), lane = tid & 63, wr = wid >> 2, wc = wid & 3, fr = lane & 15, fq = lane >> 4;
    const int K = g.K, nt = K / BK;
    unsigned voffA[2], voffB[2];
#pragma unroll
    for (int i = 0; i < 2; ++i) { int R, C; stage_rc(tid * 16 + i * 8192, R, C); const int Rb = Epi::PERM ? ((R & ~31) + perm32(R & 31)) : R;
        voffA[i] = (unsigned)(R * K + C) * 2u; voffB[i] = (unsigned)(Rb * K + C) * 2u; }
    const size_t kstep = (size_t)(BK * 2);
    const size_t hstep = (size_t)HALF * K * 2;
    const size_t tstep = 2 * hstep;
    const unsigned ldsw = (unsigned)wid * 1024u;
    const int aoff = lds_byte(wr * 64 + fr, fq * 8), boff = lds_byte(wc * 32 + fr, fq * 8);
#define PG8_SA(b, h) (((b) * 2 + (h)) * HTB)
#define PG8_SB(b, h) ((4 + (b) * 2 + (h)) * HTB)
#define PG8_STAGE(bufoff, gbase, voff) do { _Pragma("unroll") for (int _i = 0; _i < 2; ++_i) \
        __builtin_amdgcn_global_load_lds((const unsigned*)((const char*)(gbase) + (voff)[_i]), (PG8_LAS unsigned*)(lds + (bufoff) + ldsw + _i * 8192), 16, 0, 0); } while (0)
#define PG8_LDA(dst, b, h) do { _Pragma("unroll") for (int m = 0; m < 4; ++m) _Pragma("unroll") for (int k = 0; k < 2; ++k) dst[m][k] = *(const PG8_LAS bf16x8*)(lds + PG8_SA(b, h) + aoff + m * 2048 + k * 1024); } while (0)
#define PG8_LDB(dst, b, h) do { _Pragma("unroll") for (int n = 0; n < 2; ++n) _Pragma("unroll") for (int k = 0; k < 2; ++k) dst[n][k] = *(const PG8_LAS bf16x8*)(lds + PG8_SB(b, h) + boff + n * 2048 + k * 1024); } while (0)
#define PG8_MMA(ai, bj, At, Bt) do { __builtin_amdgcn_s_setprio(PG8_PRIO); _Pragma("unroll") for (int m = 0; m < 4; ++m) _Pragma("unroll") for (int n = 0; n < 2; ++n) _Pragma("unroll") for (int k = 0; k < 2; ++k) \
        acc[ai][bj][m][n] = __builtin_amdgcn_mfma_f32_16x16x32_bf16(Bt[n][k], At[m][k], acc[ai][bj][m][n], 0, 0, 0); __builtin_amdgcn_s_setprio(0); } while (0)
#define PG8_WAIT_V(n) asm volatile("s_waitcnt vmcnt(" #n ")" ::: "memory")
#define PG8_WAIT_L(n) asm volatile("s_waitcnt lgkmcnt(" #n ")" ::: "memory")
#define PG8_BAR __builtin_amdgcn_s_barrier()
#define PG8_SCHED __builtin_amdgcn_sched_barrier(0)
    Unit cur, nxt; int ui = 0;
    if (!S.next(0, cur)) return;
    f32x4 acc[2][2][4][2];
#pragma unroll
    for (int a = 0; a < 2; ++a)
#pragma unroll
        for (int b = 0; b < 2; ++b)
#pragma unroll
            for (int m = 0; m < 4; ++m)
#pragma unroll
                for (int n = 0; n < 2; ++n) acc[a][b][m][n] = (f32x4){0.f, 0.f, 0.f, 0.f};
    bf16x8 At[4][2], B0[2][2], B1[2][2];
    const char* cA = (const char*)g.A + (size_t)cur.pm * tstep; const char* cB = (const char*)g.Bt + (size_t)cur.pn * tstep;
    S.a_ready(cur);
    if constexpr (SP2) {
        PG8_STAGE(PG8_SB(0, 0), cB, voffB); PG8_STAGE(PG8_SB(0, 1), cB + hstep, voffB); PG8_STAGE(PG8_SA(0, 0), cA, voffA); PG8_STAGE(PG8_SA(0, 1), cA + hstep, voffA);
        if (wr == 1) PG8_BAR;
        PG8_WAIT_V(2); PG8_BAR;
        PG8_STAGE(PG8_SB(1, 0), cB + kstep, voffB); PG8_STAGE(PG8_SA(1, 0), cA + kstep, voffA); PG8_STAGE(PG8_SB(1, 1), cB + hstep + kstep, voffB);
        PG8_WAIT_V(6); PG8_BAR;
    } else {
        PG8_STAGE(PG8_SB(0, 0), cB, voffB); PG8_STAGE(PG8_SA(0, 0), cA, voffA); PG8_STAGE(PG8_SB(0, 1), cB + hstep, voffB); PG8_STAGE(PG8_SA(0, 1), cA + hstep, voffA);
        if (wr == 1) PG8_BAR;
        PG8_WAIT_V(4); PG8_BAR;
        PG8_STAGE(PG8_SB(1, 0), cB + kstep, voffB); PG8_STAGE(PG8_SA(1, 0), cA + kstep, voffA); PG8_STAGE(PG8_SB(1, 1), cB + hstep + kstep, voffB);
        PG8_WAIT_V(6); PG8_BAR;
    }
    for (;;) {
        const bool has_next = S.next(ui + 1, nxt);
        const char* nA = has_next ? (const char*)g.A + (size_t)nxt.pm * tstep : cA; const char* nB = has_next ? (const char*)g.Bt + (size_t)nxt.pn * tstep : cB;
        for (int t = 0; t < nt; t += 2) {
            const bool last = (t == nt - 2);
            const char* a1 = cA + (size_t)(t + 1) * kstep;
            const char* a2 = last ? nA : cA + (size_t)(t + 2) * kstep; const char* b2 = last ? nB : cB + (size_t)(t + 2) * kstep;
            const char* a3 = a2 + kstep; const char* b3 = b2 + kstep;
            if (last && has_next) S.a_ready(nxt);
            if constexpr (SP2) {
            PG8_LDB(B0, 0, 0); PG8_LDB(B1, 0, 1); PG8_SCHED; PG8_LDA(At, 0, 0); PG8_STAGE(PG8_SA(1, 1), a1 + hstep, voffA);
            PG8_WAIT_V(8); PG8_WAIT_L(0); PG8_BAR; PG8_MMA(0, 0, At, B0); PG8_MMA(0, 1, At, B1); PG8_BAR; PG8_SCHED;
            PG8_LDA(At, 0, 1); PG8_STAGE(PG8_SB(0, 0), b2, voffB); PG8_STAGE(PG8_SB(0, 1), b2 + hstep, voffB); PG8_STAGE(PG8_SA(0, 0), a2, voffA);
            PG8_WAIT_V(8); PG8_WAIT_L(0); PG8_BAR; PG8_MMA(1, 0, At, B0); PG8_MMA(1, 1, At, B1); PG8_BAR; PG8_SCHED;
            PG8_LDB(B0, 1, 0); PG8_LDB(B1, 1, 1); PG8_SCHED; PG8_LDA(At, 1, 0); PG8_STAGE(PG8_SA(0, 1), a2 + hstep, voffA);
            PG8_WAIT_V(8); PG8_WAIT_L(0); PG8_BAR; PG8_MMA(0, 0, At, B0); PG8_MMA(0, 1, At, B1); PG8_BAR; PG8_SCHED;
            PG8_LDA(At, 1, 1); PG8_STAGE(PG8_SB(1, 0), b3, voffB); PG8_STAGE(PG8_SB(1, 1), b3 + hstep, voffB); PG8_STAGE(PG8_SA(1, 0), a3, voffA);
            PG8_WAIT_V(8); PG8_WAIT_L(0); PG8_BAR; PG8_MMA(1, 0, At, B0); PG8_MMA(1, 1, At, B1); PG8_BAR; PG8_SCHED;
            } else {
            PG8_LDB(B0, 0, 0); PG8_SCHED; PG8_LDA(At, 0, 0); PG8_STAGE(PG8_SA(1, 1), a1 + hstep, voffA);
            PG8_WAIT_L(8); PG8_BAR; PG8_WAIT_L(0); PG8_MMA(0, 0, At, B0); PG8_BAR; PG8_SCHED;
            PG8_LDB(B1, 0, 1); PG8_STAGE(PG8_SB(0, 0), b2, voffB);
            PG8_BAR; PG8_WAIT_L(0); PG8_MMA(0, 1, At, B1); PG8_BAR;
            PG8_LDA(At, 0, 1); PG8_STAGE(PG8_SA(0, 0), a2, voffA);
            PG8_BAR; PG8_WAIT_L(0); PG8_MMA(1, 0, At, B0); PG8_BAR; PG8_SCHED;
            PG8_STAGE(PG8_SB(0, 1), b2 + hstep, voffB);
            PG8_WAIT_V(6); PG8_BAR; PG8_MMA(1, 1, At, B1); PG8_BAR;
            PG8_LDB(B0, 1, 0); PG8_SCHED; PG8_LDA(At, 1, 0); PG8_STAGE(PG8_SA(0, 1), a2 + hstep, voffA);
            PG8_WAIT_L(8); PG8_BAR; PG8_WAIT_L(0); PG8_MMA(0, 0, At, B0); PG8_BAR; PG8_SCHED;
            PG8_LDB(B1, 1, 1); PG8_STAGE(PG8_SB(1, 0), b3, voffB);
            PG8_BAR; PG8_WAIT_L(0); PG8_MMA(0, 1, At, B1); PG8_BAR;
            PG8_LDA(At, 1, 1); PG8_STAGE(PG8_SA(1, 0), a3, voffA);
            PG8_BAR; PG8_WAIT_L(0); PG8_MMA(1, 0, At, B0); PG8_BAR; PG8_SCHED;
            PG8_STAGE(PG8_SB(1, 1), b3 + hstep, voffB);
            PG8_WAIT_V(6); PG8_BAR; PG8_MMA(1, 1, At, B1); PG8_BAR;
            }
        }
        if constexpr (ALIGN_EPI) { if (wr == 0) PG8_BAR; }
        if constexpr (!Epi::AFTER_DRAIN) { E(acc, cur, wr, wc, fr, fq, xlds); S.done(cur); }
        if (!has_next) break;
#pragma unroll
        for (int a = 0; a < 2; ++a)
#pragma unroll
            for (int b = 0; b < 2; ++b)
#pragma unroll
                for (int m = 0; m < 4; ++m)
#pragma unroll
                    for (int n = 0; n < 2; ++n) acc[a][b][m][n] = (f32x4){0.f, 0.f, 0.f, 0.f};
        cur = nxt; cA = nA; cB = nB; ++ui;
        if constexpr (ALIGN_EPI) { if (wr == 1) PG8_BAR; }
    }
    PG8_WAIT_V(0);
    if constexpr (!ALIGN_EPI) { if (wr == 0) PG8_BAR; }
    PG8_BAR;

#undef PG8_SA
#undef PG8_SB
#undef PG8_STAGE
#undef PG8_LDA
#undef PG8_LDB
#undef PG8_MMA
#undef PG8_WAIT_V
#undef PG8_WAIT_L
#undef PG8_BAR
#undef PG8_SCHED
}
}

#define GAS __attribute__((address_space(1)))
#define LAS __attribute__((address_space(3)))
typedef unsigned short bf16;
typedef float f32x4 __attribute__((ext_vector_type(4)));
typedef short bf16x8 __attribute__((ext_vector_type(8)));
typedef unsigned u32x4 __attribute__((ext_vector_type(4)));
typedef unsigned u32x2 __attribute__((ext_vector_type(2)));

constexpr int NWAVES = 8;
constexpr int SEQ = 16384, DMODEL = 2048, NMEM = 256, DIN = 3584, DCONV = 768, DPOOL = 768, DXATT = 512, DFF = 5632, DFF2 = 11264;
constexpr int PGD = 192;
constexpr float EPS = 1e-6f;
constexpr int LDS_BYTES = 147456;
#ifndef MK_PER_PHASE
#define MK_PER_PHASE 0
#endif
constexpr int NPHASE = 7;
#ifndef PHM
#define PHM 255
#endif
#ifndef FUSE_FIXUP
#define FUSE_FIXUP 0
#endif
#ifndef P1_ALIGN
#define P1_ALIGN false
#endif
#ifndef USE_CG_SYNC
#define USE_CG_SYNC 0
#endif
#ifndef PROBE_P2
#define PROBE_P2 0
#endif
#ifndef PROBE_SYNC
#define PROBE_SYNC 0
#endif
#ifndef PROBE_GEMM
#define PROBE_GEMM 0
#endif
#ifndef PROBE_N
#define PROBE_N 2048
#endif
#ifndef REPM
#define REPM 0
#endif

constexpr size_t MiB = 1u << 20;
constexpr size_t WS_KB = 1 * MiB;
constexpr size_t WS_VT = 1 * MiB + 256 * 1024;
constexpr size_t WS_POOLWT = 1 * MiB + 512 * 1024;
constexpr size_t WS_MB = 2 * MiB;
constexpr size_t WS_WKVT = 3 * MiB;
constexpr size_t WS_SIG = 7 * MiB;
constexpr size_t WS_SLAB1 = 8 * MiB;
constexpr size_t WS_SLAB2 = 10 * MiB;
constexpr size_t WS_WUPT = 12 * MiB;
constexpr size_t WS_WDOWNT = 56 * MiB;
constexpr size_t WS_UBND = 80 * MiB;
constexpr size_t WS_X1B = 96 * MiB;
constexpr size_t WS_ACT = 160 * MiB;
constexpr size_t WS_H = 160 * MiB;
constexpr size_t WS_Z = 225 * MiB;
constexpr size_t WS_ZPAD = WS_Z - (size_t)16 * 3584 * 2;
constexpr size_t WS_MIX = 338 * MiB;
constexpr size_t WS_WINT = 402 * MiB;
constexpr size_t WS_WOUTT = 416 * MiB;
constexpr size_t WS_END = 424 * MiB;

__device__ __forceinline__ unsigned f2bf(float f) { unsigned u = __builtin_bit_cast(unsigned, f); return (u + 0x7fffu + ((u >> 16) & 1u)) >> 16; }
__device__ __forceinline__ unsigned pk2(float lo, float hi) { return f2bf(lo) | (f2bf(hi) << 16); }
__device__ __forceinline__ float bflo(unsigned w) { return __builtin_bit_cast(float, w << 16); }
__device__ __forceinline__ float bfhi(unsigned w) { return __builtin_bit_cast(float, w & 0xffff0000u); }
__device__ __forceinline__ void unpack8(const u32x4 w, float (&f)[8]) { f[0] = bflo(w.x); f[1] = bfhi(w.x); f[2] = bflo(w.y); f[3] = bfhi(w.y); f[4] = bflo(w.z); f[5] = bfhi(w.z); f[6] = bflo(w.w); f[7] = bfhi(w.w); }
__device__ __forceinline__ u32x4 pack8(const float (&f)[8]) { u32x4 w; w.x = pk2(f[0], f[1]); w.y = pk2(f[2], f[3]); w.z = pk2(f[4], f[5]); w.w = pk2(f[6], f[7]); return w; }
__device__ __forceinline__ float wave_sum(float v) {
#pragma unroll
    for (int o = 1; o < 64; o <<= 1) v += __shfl_xor(v, o);
    return v;
}
#define LDS_WAIT() asm volatile("s_waitcnt lgkmcnt(0)" ::: "memory")

typedef GAS unsigned gu32;
constexpr size_t WS_CTL = 0, CTL_ZERO_BYTES = 64 * 1024;
constexpr int CW_PANEL2 = 12288;
constexpr int CW_PANEL1 = 8192;
constexpr int CW_PANEL = 4096;
constexpr int MISC_OFF = 131072 + 320;
constexpr int XLDS_OFF = 131072 + 1024;
#define XB_TMO      128
#define XB_XCNT(j)  (256  + 64 * (j))
#define XB_XSUB(j)  (1280 + 64 * (j))
#define XB_XGEN(j)  (2304 + 64 * (j))
#define XB_TOP      3328
#define XB_TOPGEN   3392
#define XCD_BAR_WORDS 3456
#define XB_SPIN_CAP (1u << 18)

__device__ __forceinline__ unsigned xb_ld(unsigned* p)              { return __hip_atomic_load(p, __ATOMIC_RELAXED, __HIP_MEMORY_SCOPE_AGENT); }
__device__ __forceinline__ unsigned xb_add(unsigned* p, unsigned v) { return __hip_atomic_fetch_add(p, v, __ATOMIC_RELAXED, __HIP_MEMORY_SCOPE_AGENT); }
__device__ __forceinline__ unsigned xb_xcc_id() { return (unsigned)__builtin_amdgcn_s_getreg((3 << 11) | 20) & 0xFu; }
#define XB_SPIN(cond, bar) do { unsigned _sp = 0; while (cond) { __builtin_amdgcn_s_sleep(1); \
    if ((++_sp & 255u) == 0u) { if (xb_ld(&(bar)[XB_TMO])) break; if (_sp > XB_SPIN_CAP) { atomicAdd(&(bar)[XB_TMO], 1u); break; } } } } while (0)

struct XcdBarrier {
    unsigned* bar; unsigned x;
    volatile LAS unsigned* st;
};

__device__ __forceinline__ XcdBarrier xcd_barrier_post(unsigned* bar, volatile LAS unsigned* st) {
    XcdBarrier b; b.bar = bar; b.x = xb_xcc_id(); b.st = st;
    if (threadIdx.x == 0) (void)xb_add(&bar[XB_XCNT(b.x)], 1u);
    return b;
}
__device__ __forceinline__ void xcd_barrier_complete(unsigned* bar, unsigned x, unsigned& nloc, unsigned& nx) {
    const unsigned G = gridDim.x * gridDim.y * gridDim.z;
    unsigned sum, cnt, mine, sp = 0u;
    for (;;) {
        sum = 0u; cnt = 0u; mine = 0u;
#pragma unroll
        for (unsigned j = 0; j < 16; ++j) { const unsigned c = xb_ld(&bar[XB_XCNT(j)]); sum += c; cnt += (c > 0u) ? 1u : 0u; mine = (j == x) ? c : mine; }
        if (sum == G) break;
        __builtin_amdgcn_s_sleep(1);
        if ((++sp & 255u) == 0u) { if (xb_ld(&bar[XB_TMO])) break; if (sp > XB_SPIN_CAP) { atomicAdd(&bar[XB_TMO], 1u); break; } }
    }
    nloc = mine > 0u ? mine : 1u; nx = cnt > 0u ? cnt : 1u;
}

__device__ __forceinline__ void xcd_barrier(const XcdBarrier& b) {
    asm volatile("s_waitcnt vmcnt(0)" ::: "memory");
    __syncthreads();
    if (threadIdx.x == 0) {
        unsigned* bar = b.bar;
        __builtin_amdgcn_s_waitcnt(0);
        unsigned nloc = b.st[0], nx = b.st[1];
        if (nloc == 0u) { xcd_barrier_complete(bar, b.x, nloc, nx); b.st[0] = nloc; b.st[1] = nx; }
        const unsigned old = xb_add(&bar[XB_XSUB(b.x)], 1u);
        const unsigned gen = old / nloc;
        if (old + 1u == (gen + 1u) * nloc) {
            __builtin_amdgcn_fence(__ATOMIC_RELEASE, "agent");
            asm volatile("s_waitcnt vmcnt(0)" ::: "memory");
            const unsigned og = xb_add(&bar[XB_TOP], 1u);
            const unsigned tg = og / nx;
            if (og + 1u == (tg + 1u) * nx) xb_add(&bar[XB_TOPGEN], 1u);
            else XB_SPIN(xb_ld(&bar[XB_TOPGEN]) == tg, bar);
            __builtin_amdgcn_fence(__ATOMIC_ACQUIRE, "agent");
            xb_add(&bar[XB_XGEN(b.x)], 1u);
            asm volatile("s_waitcnt vmcnt(0)" ::: "memory");
        } else {
            XB_SPIN(xb_ld(&bar[XB_XGEN(b.x)]) == gen, bar);
            __builtin_amdgcn_fence(__ATOMIC_ACQUIRE, "agent");
            asm volatile("s_waitcnt vmcnt(0)" ::: "memory");
        }
    }
    __syncthreads();
}


struct TrItem { const float* src; const float* ks; bf16* dst; int N, K; };
template <bool UPMAP> __device__ __forceinline__ TrItem tr_make(const float* W, int K, int N, bf16* WT, const float* ks, int item) {
    const int nblk = N / 64, kb = item / nblk, nb = item % nblk, k0 = 64 * kb, n0 = 64 * nb;
    const int r0 = !UPMAP ? n0 : (n0 < DFF ? 256 * (n0 / 128) + (n0 % 128) : 256 * ((n0 - DFF) / 128) + 128 + ((n0 - DFF) % 128));
    TrItem t; t.src = W + (size_t)k0 * N + n0; t.ks = ks ? ks + k0 : nullptr; t.dst = WT + (size_t)r0 * K + k0; t.N = N; t.K = K; return t;
}
__device__ __forceinline__ void tr_load(const TrItem& t, f32x4 (&v)[16], int lane) {
    const float* src = t.src + (size_t)(lane >> 4) * t.N + 4 * (lane & 15);
#pragma unroll
    for (int i = 0; i < 16; ++i) v[i] = *(const f32x4*)(src + (size_t)(4 * i) * t.N);
}
__device__ __forceinline__ void tr_store(const TrItem& t, const f32x4 (&v)[16], LAS float* scr, int lane) {
#pragma unroll
    for (int i = 0; i < 16; ++i) { f32x4 x = v[i]; if (t.ks) x = x * t.ks[4 * i + (lane >> 4)];
        *(LAS f32x4*)(scr + (4 * i + (lane >> 4)) * 64 + (((lane & 15) ^ ((i >> 1) & 7)) << 2)) = x; }
    LDS_WAIT(); asm volatile("" ::: "memory");
    const int c = lane & 7;
#pragma unroll
    for (int j = 0; j < 8; ++j) { const int nn = (lane >> 3) + 8 * j; const LAS float* sp = scr + (8 * c) * 64 + ((((nn >> 2) ^ c) & 15) << 2) + (nn & 3);
        u32x4 o; o.x = pk2(sp[0 * 64], sp[1 * 64]); o.y = pk2(sp[2 * 64], sp[3 * 64]); o.z = pk2(sp[4 * 64], sp[5 * 64]); o.w = pk2(sp[6 * 64], sp[7 * 64]);
        *(u32x4*)(t.dst + (size_t)nn * t.K + 8 * c) = o; }
    LDS_WAIT(); asm volatile("" ::: "memory");
}
__device__ __forceinline__ void rms_rows2_to_bf16(const float* xa, const float* xb, const float* g, bf16* oa, bf16* ob, int lane) {
    const f32x4* pa = (const f32x4*)xa + lane; const f32x4* pb = (const f32x4*)xb + lane; const f32x4* gr = (const f32x4*)g + lane;
    f32x4 va[8], vb[8]; float sa = 0.f, sb = 0.f;
#pragma unroll
    for (int j = 0; j < 8; ++j) { va[j] = pa[64 * j]; vb[j] = pb[64 * j]; }
#pragma unroll
    for (int j = 0; j < 8; ++j) { sa += (va[j].x * va[j].x + va[j].y * va[j].y) + (va[j].z * va[j].z + va[j].w * va[j].w); sb += (vb[j].x * vb[j].x + vb[j].y * vb[j].y) + (vb[j].z * vb[j].z + vb[j].w * vb[j].w); }
    const float ra = 1.0f / sqrtf(wave_sum(sa) * (1.0f / DMODEL) + EPS), rb = 1.0f / sqrtf(wave_sum(sb) * (1.0f / DMODEL) + EPS);
    u32x2* qa = (u32x2*)oa + lane; u32x2* qb = (u32x2*)ob + lane;
#pragma unroll
    for (int j = 0; j < 8; ++j) { const f32x4 gg = gr[64 * j]; u32x2 w;
        w.x = pk2(va[j].x * ra * gg.x, va[j].y * ra * gg.y); w.y = pk2(va[j].z * ra * gg.z, va[j].w * ra * gg.w); qa[64 * j] = w;
        w.x = pk2(vb[j].x * rb * gg.x, vb[j].y * rb * gg.y); w.y = pk2(vb[j].z * rb * gg.z, vb[j].w * rb * gg.w); qb[64 * j] = w; }
}

struct Ptrs {
    const float *x, *mem, *g_mix, *g_mem, *w_in, *conv_w, *pool_w, *pool_scale, *w_kv, *w_out, *g_ffn, *w_up, *ffn_conv_w, *ffn_conv_b, *w_down, *g_final;
    float* out; unsigned char* ws;
};

constexpr int UP_ITEMS = (DMODEL / 64) * (DFF2 / 64), DN_ITEMS = (DFF / 64) * (DMODEL / 64);
#ifndef UP_IN_P0
#define UP_IN_P0 4608
#endif
__device__ __forceinline__ void p1_idle_work(const Ptrs& P, LAS unsigned char* lds, int iw, int NIW, int wave, int lane);
template <int LIST> __device__ __forceinline__ TrItem tr_desc(const Ptrs& P, int it) {
    unsigned char* ws = P.ws;
    constexpr int I_IN = (DMODEL / 64) * (DIN / 64), I_OUT = (DMODEL / 64) * (DMODEL / 64), I_KV = (DMODEL / 64) * (1024 / 64), I_PW = (PGD / 64) * (PGD / 64);
    if (LIST == 0) {
        int r = it;
        if (r < I_IN) return tr_make<false>(P.w_in, DMODEL, DIN, (bf16*)(ws + WS_WINT), nullptr, r); r -= I_IN;
        if (r < I_OUT) return tr_make<false>(P.w_out, DMODEL, DMODEL, (bf16*)(ws + WS_WOUTT), nullptr, r); r -= I_OUT;
        if (r < UP_IN_P0) return tr_make<true>(P.w_up, DMODEL, DFF2, (bf16*)(ws + WS_WUPT), P.g_ffn, r); r -= UP_IN_P0;
        if (r < I_KV) return tr_make<false>(P.w_kv, DMODEL, 1024, (bf16*)(ws + WS_WKVT), nullptr, r); r -= I_KV;
        const int g = r / I_PW; r -= g * I_PW;
        return tr_make<false>(P.pool_w + (size_t)g * PGD * PGD, PGD, PGD, (bf16*)(ws + WS_POOLWT) + (size_t)g * PGD * PGD, nullptr, r);
    } else {
        if (it < DN_ITEMS) return tr_make<false>(P.w_down, DFF, DMODEL, (bf16*)(ws + WS_WDOWNT), nullptr, it);
        return tr_make<true>(P.w_up, DMODEL, DFF2, (bf16*)(ws + WS_WUPT), P.g_ffn, UP_IN_P0 + it - DN_ITEMS);
    }
}
template <int LIST> __device__ __forceinline__ void tr_stream(const Ptrs& P, LAS float* scr, int first, int stride, int nitems, int lane) {
    if (first >= nitems) return;
    TrItem cur = tr_desc<LIST>(P, first); f32x4 va[16], vb[16];
    tr_load(cur, va, lane);
    for (int it = first; it < nitems; it += 2 * stride) {
        TrItem nx = cur; const bool h1 = it + stride < nitems; if (h1) { nx = tr_desc<LIST>(P, it + stride); tr_load(nx, vb, lane); }
        tr_store(cur, va, scr, lane);
        if (!h1) break;
        const bool h2 = it + 2 * stride < nitems; if (h2) { cur = tr_desc<LIST>(P, it + 2 * stride); tr_load(cur, va, lane); }
        tr_store(nx, vb, scr, lane);
        if (!h2) break;
    }
}
__device__ __forceinline__ void p0_prologue(const Ptrs& P, LAS unsigned char* lds, int gw, int NGW, int wave, int lane) {
    LAS float* scr = (LAS float*)(lds + wave * 16384);
    unsigned char* ws = P.ws;
    constexpr int NITEMS = (DMODEL / 64) * (DIN / 64) + (DMODEL / 64) * (DMODEL / 64) + UP_IN_P0 + (DMODEL / 64) * (1024 / 64) + 4 * (PGD / 64) * (PGD / 64);
    tr_stream<0>(P, scr, gw, NGW, NITEMS, lane);
    for (int i = gw * 64 + lane; i < 16 * DIN * 2 / 16; i += NGW * 64) ((u32x4*)(ws + WS_ZPAD))[i] = (u32x4){0u, 0u, 0u, 0u};
    for (int m = 2 * gw; m < SEQ; m += 2 * NGW) rms_rows2_to_bf16(P.x + (size_t)m * DMODEL, P.x + (size_t)(m + 1) * DMODEL, P.g_mix, (bf16*)(ws + WS_H) + (size_t)m * DMODEL, (bf16*)(ws + WS_H) + (size_t)(m + 1) * DMODEL, lane);
    for (int m = 2 * gw; m < NMEM; m += 2 * NGW) rms_rows2_to_bf16(P.mem + (size_t)m * DMODEL, P.mem + (size_t)(m + 1) * DMODEL, P.g_mem, (bf16*)(ws + WS_MB) + (size_t)m * DMODEL, (bf16*)(ws + WS_MB) + (size_t)(m + 1) * DMODEL, lane);
}

__device__ __forceinline__ void kv_tile(const Ptrs& P, int tt, int lane) {
    const bf16* mB = (const bf16*)(P.ws + WS_MB); const bf16* wT = (const bf16*)(P.ws + WS_WKVT);
    const int rb = tt >> 6, cb = tt & 63, fr = lane & 15, fq = lane >> 4;
    const bf16* ap = mB + (size_t)(16 * rb + fr) * DMODEL + 8 * fq; const bf16* wp = wT + (size_t)(16 * cb + fr) * DMODEL + 8 * fq;
    const bool kpart = cb < 32;
    f32x4 acc = {0.f, 0.f, 0.f, 0.f};
    bf16x8 a0[8], w0[8], a1[8], w1[8];
#pragma unroll
    for (int i = 0; i < 8; ++i) { a0[i] = *(const bf16x8*)(ap + 32 * i); w0[i] = *(const bf16x8*)(wp + 32 * i); }
#pragma unroll 1
    for (int kb = 0; kb < 8; kb += 2) {
#pragma unroll
        for (int i = 0; i < 8; ++i) { a1[i] = *(const bf16x8*)(ap + 32 * (8 * kb + 8 + i)); w1[i] = *(const bf16x8*)(wp + 32 * (8 * kb + 8 + i)); }
#pragma unroll
        for (int i = 0; i < 8; ++i) acc = kpart ? __builtin_amdgcn_mfma_f32_16x16x32_bf16(w0[i], a0[i], acc, 0, 0, 0) : __builtin_amdgcn_mfma_f32_16x16x32_bf16(a0[i], w0[i], acc, 0, 0, 0);
        if (kb + 2 < 8) {
#pragma unroll
            for (int i = 0; i < 8; ++i) { a0[i] = *(const bf16x8*)(ap + 32 * (8 * kb + 16 + i)); w0[i] = *(const bf16x8*)(wp + 32 * (8 * kb + 16 + i)); } }
#pragma unroll
        for (int i = 0; i < 8; ++i) acc = kpart ? __builtin_amdgcn_mfma_f32_16x16x32_bf16(w1[i], a1[i], acc, 0, 0, 0) : __builtin_amdgcn_mfma_f32_16x16x32_bf16(a1[i], w1[i], acc, 0, 0, 0);
    }
    u32x2 o; o.x = pk2(acc[0], acc[1]); o.y = pk2(acc[2], acc[3]);
    if (kpart) *(u32x2*)((bf16*)(P.ws + WS_KB) + (size_t)(16 * rb + fr) * 512 + 16 * cb + 4 * fq) = o;
    else *(u32x2*)((bf16*)(P.ws + WS_VT) + (size_t)(16 * cb - 512 + fr) * 256 + 32 * (rb >> 1) + 8 * fq + 4 * (rb & 1)) = o;
}

__device__ __forceinline__ void p1_idle_work(const Ptrs& P, LAS unsigned char* lds, int iw, int NIW, int wave, int lane) {
    LAS float* scr = (LAS float*)(lds + wave * 16384);
    for (int tt = iw; tt < 1024; tt += NIW) kv_tile(P, tt, lane);
    tr_stream<1>(P, scr, iw, NIW, DN_ITEMS + (UP_ITEMS - UP_IN_P0), lane);
}

__device__ __forceinline__ void mix_conv_task(const Ptrs& P, int blk, int lane, int cg0, int cg1) {
    const bf16* z = (const bf16*)(P.ws + WS_Z); bf16* mix = (bf16*)(P.ws + WS_MIX);
    const int t0 = blk * 16;
    for (int cg = cg0 + lane; cg < cg1; cg += 64) {
        const int c = cg * 8;
        float w0[8], w1[8], w2[8], p1[8], p2[8];
#pragma unroll
        for (int e = 0; e < 8; ++e) { w0[e] = P.conv_w[c + e]; w1[e] = P.conv_w[DCONV + c + e]; w2[e] = P.conv_w[2 * DCONV + c + e]; }
        { float a[8], b[8]; unpack8(*(const u32x4*)(z + (long)(t0 - 2) * DIN + DCONV + c), a); unpack8(*(const u32x4*)(z + (long)(t0 - 2) * DIN + 2 * DCONV + c), b);
#pragma unroll
          for (int e = 0; e < 8; ++e) p2[e] = a[e] * b[e];
          unpack8(*(const u32x4*)(z + (long)(t0 - 1) * DIN + DCONV + c), a); unpack8(*(const u32x4*)(z + (long)(t0 - 1) * DIN + 2 * DCONV + c), b);
#pragma unroll
          for (int e = 0; e < 8; ++e) p1[e] = a[e] * b[e]; }
#pragma unroll 4
        for (int r = 0; r < 16; ++r) {
            const int t = t0 + r; float p[8], a[8], b[8], g[8], o[8];
            unpack8(*(const u32x4*)(z + (size_t)t * DIN + DCONV + c), a); unpack8(*(const u32x4*)(z + (size_t)t * DIN + 2 * DCONV + c), b); unpack8(*(const u32x4*)(z + (size_t)t * DIN + c), g);
#pragma unroll
            for (int e = 0; e < 8; ++e) { p[e] = a[e] * b[e]; o[e] = g[e] * (w2[e] * p[e] + w1[e] * p1[e] + w0[e] * p2[e]); p2[e] = p1[e]; p1[e] = p[e]; }
            *(u32x4*)(mix + (size_t)t * DMODEL + c) = pack8(o);
        }
    }
}
template <int g> __device__ __forceinline__ void mix_pool_task(const Ptrs& P, int blk, int lane) {
    constexpr int k = 2 << g;
    const char* zu = (const char*)((const bf16*)(P.ws + WS_Z) + (size_t)(blk * 16) * DIN + 3 * DCONV + PGD * g);
    const char* wu = (const char*)((const bf16*)(P.ws + WS_POOLWT) + (size_t)g * PGD * PGD);
    bf16* mix = (bf16*)(P.ws + WS_MIX);
    const int fr = lane & 15, fq = lane >> 4, t = blk * 16 + fr;
    const unsigned zl = (unsigned)(fr * DIN + 8 * fq) * 2u, wl = (unsigned)(fr * PGD + 8 * fq) * 2u;
    const int cnt = (t + 1 < k) ? t + 1 : k; const float inv = 1.0f / (float)cnt;
    f32x4 acc[12];
#pragma unroll
    for (int n = 0; n < 12; ++n) acc[n] = (f32x4){0.f, 0.f, 0.f, 0.f};
#pragma unroll 1
    for (int ks = 0; ks < 6; ++ks) {
        float sum[8], self[8];
        unpack8(*(const u32x4*)(zu + ks * 64 + zl), self);
#pragma unroll
        for (int e = 0; e < 8; ++e) sum[e] = self[e];
#pragma unroll
        for (int j = 1; j < k; ++j) { float v[8]; unpack8(*(const u32x4*)(zu + ks * 64 - (long)j * (DIN * 2) + zl), v);
#pragma unroll
            for (int e = 0; e < 8; ++e) sum[e] += v[e]; }
        float pl[8];
#pragma unroll
        for (int e = 0; e < 8; ++e) pl[e] = sum[e] * inv - self[e];
        const bf16x8 pf = __builtin_bit_cast(bf16x8, pack8(pl));
#pragma unroll
        for (int n = 0; n < 12; ++n) { const bf16x8 wf = *(const bf16x8*)(wu + n * (16 * PGD * 2) + ks * 64 + wl); acc[n] = __builtin_amdgcn_mfma_f32_16x16x32_bf16(wf, pf, acc[n], 0, 0, 0); }
    }
#pragma unroll
    for (int n = 0; n < 12; ++n) { const int d = 16 * n + 4 * fq; const f32x4 sc = *(const f32x4*)(P.pool_scale + PGD * g + d);
        u32x2 o; o.x = pk2(acc[n][0] * sc[0], acc[n][1] * sc[1]); o.y = pk2(acc[n][2] * sc[2], acc[n][3] * sc[3]);
        *(u32x2*)(mix + (size_t)t * DMODEL + DCONV + PGD * g + d) = o; }
}
__device__ __forceinline__ void mix_attn_task(const Ptrs& P, int h, int blk, int lane) {
    const bf16* z = (const bf16*)(P.ws + WS_Z); bf16* mix = (bf16*)(P.ws + WS_MIX); const bf16* Kb = (const bf16*)(P.ws + WS_KB); const bf16* Vt = (const bf16*)(P.ws + WS_VT);
    const int fr = lane & 15, fq = lane >> 4, t = blk * 16 + fr;
    bf16x8 qf[4];
#pragma unroll
    for (int ks = 0; ks < 4; ++ks) qf[ks] = *(const bf16x8*)(z + (size_t)t * DIN + 3 * DCONV + DPOOL + 128 * h + 32 * ks + 8 * fq);
    f32x4 s[16];
#pragma unroll
    for (int kb = 0; kb < 16; ++kb) { s[kb] = (f32x4){0.f, 0.f, 0.f, 0.f};
#pragma unroll
        for (int ks = 0; ks < 4; ++ks) { const bf16x8 kf = *(const bf16x8*)(Kb + (size_t)(16 * kb + fr) * 512 + 128 * h + 32 * ks + 8 * fq); s[kb] = __builtin_amdgcn_mfma_f32_16x16x32_bf16(kf, qf[ks], s[kb], 0, 0, 0); } }
    float mx = -3.0e38f;
#pragma unroll
    for (int kb = 0; kb < 16; ++kb) mx = fmaxf(fmaxf(fmaxf(s[kb][0], s[kb][1]), fmaxf(s[kb][2], s[kb][3])), mx);
    mx = fmaxf(mx, __shfl_xor(mx, 16)); mx = fmaxf(mx, __shfl_xor(mx, 32));
    const float c2 = 0.08838834764831845f * 1.4426950408889634f;
    float sum = 0.f;
#pragma unroll
    for (int kb = 0; kb < 16; ++kb)
#pragma unroll
        for (int r = 0; r < 4; ++r) { const float p = __builtin_amdgcn_exp2f((s[kb][r] - mx) * c2); s[kb][r] = p; sum += p; }
    sum += __shfl_xor(sum, 16); sum += __shfl_xor(sum, 32);
    const float inv = 1.0f / sum;
    f32x4 o[8];
#pragma unroll
    for (int db = 0; db < 8; ++db) o[db] = (f32x4){0.f, 0.f, 0.f, 0.f};
#pragma unroll
    for (int ks = 0; ks < 8; ++ks) {
        u32x4 pw; pw.x = pk2(s[2 * ks][0], s[2 * ks][1]); pw.y = pk2(s[2 * ks][2], s[2 * ks][3]); pw.z = pk2(s[2 * ks + 1][0], s[2 * ks + 1][1]); pw.w = pk2(s[2 * ks + 1][2], s[2 * ks + 1][3]);
        const bf16x8 pf = __builtin_bit_cast(bf16x8, pw);
#pragma unroll
        for (int db = 0; db < 8; ++db) { const bf16x8 vf = *(const bf16x8*)(Vt + (size_t)(128 * h + 16 * db + fr) * 256 + 32 * ks + 8 * fq); o[db] = __builtin_amdgcn_mfma_f32_16x16x32_bf16(vf, pf, o[db], 0, 0, 0); }
    }
#pragma unroll
    for (int db = 0; db < 8; ++db) { u32x2 w; w.x = pk2(o[db][0] * inv, o[db][1] * inv); w.y = pk2(o[db][2] * inv, o[db][3] * inv);
        *(u32x2*)(mix + (size_t)t * DMODEL + DCONV + DPOOL + 128 * h + 16 * db + 4 * fq) = w; }
}
template <int R, int C, int PCH> __device__ __forceinline__ void lds_stage_rows(LAS unsigned char* dst, const unsigned char* src, int gp, int tid) {
    constexpr int N = R * C, PER = (N + 511) / 512;
    u32x4 v[PER];
#pragma unroll
    for (int i = 0; i < PER; ++i) { const int idx = tid + 512 * i; if (idx < N) { const int row = idx / C, ch = idx % C; v[i] = *(const u32x4*)(src + (size_t)row * gp + ch * 16); } }
#pragma unroll
    for (int i = 0; i < PER; ++i) { const int idx = tid + 512 * i; if (idx < N) { const int row = idx / C, ch = idx % C; *(LAS u32x4*)(dst + row * (PCH * 16) + (((ch & ~15) | ((ch & 15) ^ (row & 15))) << 4)) = v[i]; } }
}
template <int N> __device__ __forceinline__ float dpp_shrN(float old, float src) { return __builtin_bit_cast(float, __builtin_amdgcn_update_dpp(__builtin_bit_cast(int, old), __builtin_bit_cast(int, src), 0x110 + N, 0xf, 0xf, false)); }
template <int N> __device__ __forceinline__ float dpp_rorN(float src) { return __builtin_bit_cast(float, __builtin_amdgcn_mov_dpp(__builtin_bit_cast(int, src), 0x120 + N, 0xf, 0xf, false)); }
template <int N> __device__ __forceinline__ float scan_step(float x, float p) { return x + dpp_shrN<N>(dpp_rorN<N>(p), x); }
template <int N> __device__ __forceinline__ float scan_step_prev(float p) { return p + dpp_shrN<N>(0.f, p); }

__device__ __forceinline__ void mix_attn_wave(const Ptrs& P, LAS unsigned char* ldsK, LAS unsigned char* ldsV, int h, int row0, int lane) {
    const bf16* z = (const bf16*)(P.ws + WS_Z); bf16* mix = (bf16*)(P.ws + WS_MIX);
    const int fr = lane & 15, fq = lane >> 4;
    bf16x8 q0[4], q1[4];
#pragma unroll
    for (int ks = 0; ks < 4; ++ks) { const bf16* qp = z + (size_t)(row0 + fr) * DIN + 3 * DCONV + DPOOL + 128 * h + 32 * ks + 8 * fq; q0[ks] = *(const bf16x8*)qp; q1[ks] = *(const bf16x8*)(qp + 16 * DIN); }
    unsigned offk[4];
#pragma unroll
    for (int ks = 0; ks < 4; ++ks) offk[ks] = (unsigned)(fr * 256 + (((4 * ks + fq) ^ fr) << 4));
    f32x4 s0[16], s1[16];
#pragma unroll
    for (int kb = 0; kb < 16; ++kb) { s0[kb] = (f32x4){0.f, 0.f, 0.f, 0.f}; s1[kb] = (f32x4){0.f, 0.f, 0.f, 0.f};
#pragma unroll
        for (int ks = 0; ks < 4; ++ks) { const bf16x8 kf = *(const LAS bf16x8*)(ldsK + kb * 4096 + offk[ks]);
            s0[kb] = __builtin_amdgcn_mfma_f32_16x16x32_bf16(kf, q0[ks], s0[kb], 0, 0, 0); s1[kb] = __builtin_amdgcn_mfma_f32_16x16x32_bf16(kf, q1[ks], s1[kb], 0, 0, 0); } }
    const float c2 = 0.08838834764831845f * 1.4426950408889634f;
    bf16x8 p0[8], p1[8]; float inv0, inv1;
    {   float mx = -3.0e38f;
#pragma unroll
        for (int kb = 0; kb < 16; ++kb) mx = fmaxf(fmaxf(fmaxf(s0[kb][0], s0[kb][1]), fmaxf(s0[kb][2], s0[kb][3])), mx);
        mx = fmaxf(mx, __shfl_xor(mx, 16)); mx = fmaxf(mx, __shfl_xor(mx, 32));
        float sum = 0.f;
#pragma unroll
        for (int ks = 0; ks < 8; ++ks) { float e[8];
#pragma unroll
            for (int r = 0; r < 4; ++r) { e[r] = __builtin_amdgcn_exp2f((s0[2 * ks][r] - mx) * c2); e[4 + r] = __builtin_amdgcn_exp2f((s0[2 * ks + 1][r] - mx) * c2); }
            sum += ((e[0] + e[1]) + (e[2] + e[3])) + ((e[4] + e[5]) + (e[6] + e[7]));
            p0[ks] = __builtin_bit_cast(bf16x8, pack8(e)); }
        sum += __shfl_xor(sum, 16); sum += __shfl_xor(sum, 32); inv0 = 1.0f / sum; }
    {   float mx = -3.0e38f;
#pragma unroll
        for (int kb = 0; kb < 16; ++kb) mx = fmaxf(fmaxf(fmaxf(s1[kb][0], s1[kb][1]), fmaxf(s1[kb][2], s1[kb][3])), mx);
        mx = fmaxf(mx, __shfl_xor(mx, 16)); mx = fmaxf(mx, __shfl_xor(mx, 32));
        float sum = 0.f;
#pragma unroll
        for (int ks = 0; ks < 8; ++ks) { float e[8];
#pragma unroll
            for (int r = 0; r < 4; ++r) { e[r] = __builtin_amdgcn_exp2f((s1[2 * ks][r] - mx) * c2); e[4 + r] = __builtin_amdgcn_exp2f((s1[2 * ks + 1][r] - mx) * c2); }
            sum += ((e[0] + e[1]) + (e[2] + e[3])) + ((e[4] + e[5]) + (e[6] + e[7]));
            p1[ks] = __builtin_bit_cast(bf16x8, pack8(e)); }
        sum += __shfl_xor(sum, 16); sum += __shfl_xor(sum, 32); inv1 = 1.0f / sum; }
    f32x4 o0[8], o1[8];
#pragma unroll
    for (int db = 0; db < 8; ++db) { o0[db] = (f32x4){0.f, 0.f, 0.f, 0.f}; o1[db] = (f32x4){0.f, 0.f, 0.f, 0.f}; }
#pragma unroll
    for (int ks = 0; ks < 8; ++ks) {
        const unsigned offv = (unsigned)(fr * 512 + ((ks >> 2) << 8) + (((4 * (ks & 3) + fq) ^ fr) << 4));
#pragma unroll
        for (int db = 0; db < 8; ++db) { const bf16x8 vf = *(const LAS bf16x8*)(ldsV + db * 8192 + offv);
            o0[db] = __builtin_amdgcn_mfma_f32_16x16x32_bf16(vf, p0[ks], o0[db], 0, 0, 0); o1[db] = __builtin_amdgcn_mfma_f32_16x16x32_bf16(vf, p1[ks], o1[db], 0, 0, 0); } }
    bf16* op = mix + (size_t)(row0 + fr) * DMODEL + DCONV + DPOOL + 128 * h + 4 * fq;
#pragma unroll
    for (int db = 0; db < 8; ++db) { u32x2 w; w.x = pk2(o0[db][0] * inv0, o0[db][1] * inv0); w.y = pk2(o0[db][2] * inv0, o0[db][3] * inv0); *(u32x2*)(op + 16 * db) = w;
        w.x = pk2(o1[db][0] * inv1, o1[db][1] * inv1); w.y = pk2(o1[db][2] * inv1, o1[db][3] * inv1); *(u32x2*)(op + (size_t)16 * DMODEL + 16 * db) = w; }
}

template <int g> __device__ __forceinline__ void mix_pool_wave(const Ptrs& P, LAS unsigned char* ldsW, int row0, int lane) {
    constexpr int k = 2 << g;
    const bf16* z = (const bf16*)(P.ws + WS_Z); bf16* mix = (bf16*)(P.ws + WS_MIX);
    const int fr = lane & 15, fq = lane >> 4;
    f32x4 acc0[12], acc1[12];
#pragma unroll
    for (int n = 0; n < 12; ++n) { acc0[n] = (f32x4){0.f, 0.f, 0.f, 0.f}; acc1[n] = (f32x4){0.f, 0.f, 0.f, 0.f}; }
    const float invA = 1.0f / (float)((row0 + fr + 1 < k) ? row0 + fr + 1 : k), invB = 1.0f / (float)((row0 + 16 + fr + 1 < k) ? row0 + 16 + fr + 1 : k);
#pragma unroll 1
    for (int ks = 0; ks < 6; ++ks) {
        const bf16* zp = z + (long)(row0 - 16 + fr) * DIN + 3 * DCONV + PGD * g + 32 * ks + 8 * fq;
        float pv[8], xa[8], xb[8], sa[8], sb[8];
        unpack8(*(const u32x4*)zp, pv); unpack8(*(const u32x4*)(zp + 16 * DIN), xa); unpack8(*(const u32x4*)(zp + 32 * DIN), xb);
#pragma unroll
        for (int e = 0; e < 8; ++e) {
            float p = pv[e], a = xa[e], b = xb[e];
            float b1 = scan_step<1>(b, a), a1 = scan_step<1>(a, p), p1 = scan_step_prev<1>(p);
            if (k >= 4) { const float b2 = scan_step<2>(b1, a1), a2 = scan_step<2>(a1, p1), p2 = scan_step_prev<2>(p1); b1 = b2; a1 = a2; p1 = p2; }
            if (k >= 8) { const float b2 = scan_step<4>(b1, a1), a2 = scan_step<4>(a1, p1), p2 = scan_step_prev<4>(p1); b1 = b2; a1 = a2; p1 = p2; }
            if (k >= 16) { const float b2 = scan_step<8>(b1, a1), a2 = scan_step<8>(a1, p1); b1 = b2; a1 = a2; }
            sa[e] = a1 * invA - a; sb[e] = b1 * invB - b; }
        const bf16x8 fa = __builtin_bit_cast(bf16x8, pack8(sa)), fb = __builtin_bit_cast(bf16x8, pack8(sb));
        const unsigned offw = (unsigned)(fr * 512 + ((ks >> 2) << 8) + (((4 * (ks & 3) + fq) ^ fr) << 4));
#pragma unroll
        for (int n = 0; n < 12; ++n) { const bf16x8 wf = *(const LAS bf16x8*)(ldsW + n * 8192 + offw);
            acc0[n] = __builtin_amdgcn_mfma_f32_16x16x32_bf16(wf, fa, acc0[n], 0, 0, 0); acc1[n] = __builtin_amdgcn_mfma_f32_16x16x32_bf16(wf, fb, acc1[n], 0, 0, 0); }
    }
    bf16* op = mix + (size_t)(row0 + fr) * DMODEL + DCONV + PGD * g + 4 * fq;
#pragma unroll
    for (int n = 0; n < 12; ++n) { const f32x4 sc = *(const f32x4*)(P.pool_scale + PGD * g + 16 * n + 4 * fq);
        u32x2 o; o.x = pk2(acc0[n][0] * sc[0], acc0[n][1] * sc[1]); o.y = pk2(acc0[n][2] * sc[2], acc0[n][3] * sc[3]); *(u32x2*)(op + 16 * n) = o;
        o.x = pk2(acc1[n][0] * sc[0], acc1[n][1] * sc[1]); o.y = pk2(acc1[n][2] * sc[2], acc1[n][3] * sc[3]); *(u32x2*)(op + (size_t)16 * DMODEL + 16 * n) = o; }
}

__device__ __forceinline__ void p2_mixer(const Ptrs& P, LAS unsigned char* lds, int w, int tid, int wave, int lane, int tmask) {
    const int sub = w & 3, tile = w >> 2, row0 = tile * 256 + (wave & 3) * 64;
    lds_stage_rows<256, 16, 16>(lds, (const unsigned char*)(P.ws + WS_KB) + 256 * sub, 1024, tid);
    lds_stage_rows<128, 32, 32>(lds + 65536, (const unsigned char*)(P.ws + WS_VT) + (size_t)sub * 128 * 512, 512, tid);
    LDS_WAIT(); __syncthreads();
    if (wave < 4) { if (tmask & 0x1e0) {
#pragma unroll 1
        for (int p = 0; p < 2; ++p) { asm volatile("" ::: "memory"); mix_attn_wave(P, lds, lds + 65536, sub, row0 + 32 * p, lane); } } }
    else if (tmask & 1) mix_conv_task(P, 4 * w + (wave - 4), lane, 0, 48);
    __syncthreads();
    lds_stage_rows<192, 24, 32>(lds, (const unsigned char*)(P.ws + WS_POOLWT) + (size_t)sub * PGD * PGD * 2, PGD * 2, tid);
    LDS_WAIT(); __syncthreads();
    if (wave < 4) { if (tmask & 0x1e) {
#pragma unroll 1
        for (int p = 0; p < 2; ++p) { const int r = row0 + 32 * p; asm volatile("" ::: "memory");
            if (sub == 0) mix_pool_wave<0>(P, lds, r, lane); else if (sub == 1) mix_pool_wave<1>(P, lds, r, lane); else if (sub == 2) mix_pool_wave<2>(P, lds, r, lane); else mix_pool_wave<3>(P, lds, r, lane); } } }
    else if (tmask & 1) mix_conv_task(P, 4 * w + (wave - 4), lane, 48, 96);
    __syncthreads();
}

__device__ __forceinline__ void p5_fix_item(const Ptrs& P, int pm, int c) {
    const float* ub = (const float*)(P.ws + WS_UBND); bf16* act = (bf16*)(P.ws + WS_ACT); const float* cw = P.ffn_conv_w; const float* cb = P.ffn_conv_b;
    const int gi = 256 * (c / 128) + (c % 128);
    const float* p2 = ub + (size_t)((pm - 1) * 4 + 2) * DFF2 + gi; const float* p1 = p2 + DFF2; const float* r0 = ub + (size_t)(pm * 4) * DFF2 + gi; const float* r1 = r0 + DFF2;
    float o0[8], o1[8];
#pragma unroll
    for (int e = 0; e < 8; ++e) {
        const float gw0 = cw[c + e], gw1 = cw[DFF2 + c + e], gw2 = cw[2 * DFF2 + c + e], gb = cb[c + e], vw0 = cw[DFF + c + e], vw1 = cw[DFF2 + DFF + c + e], vw2 = cw[2 * DFF2 + DFF + c + e], vb = cb[DFF + c + e];
        const float G0 = gw2 * r0[e] + (gw1 * p1[e] + (gw0 * p2[e] + gb)), V0 = vw2 * r0[128 + e] + (vw1 * p1[128 + e] + (vw0 * p2[128 + e] + vb));
        const float G1 = gw2 * r1[e] + (gw1 * r0[e] + (gw0 * p1[e] + gb)), V1 = vw2 * r1[128 + e] + (vw1 * r0[128 + e] + (vw0 * p1[128 + e] + vb));
        o0[e] = G0 * __builtin_amdgcn_rcpf(1.0f + __builtin_amdgcn_exp2f(-1.4426950408889634f * G0)) * V0;
        o1[e] = G1 * __builtin_amdgcn_rcpf(1.0f + __builtin_amdgcn_exp2f(-1.4426950408889634f * G1)) * V1; }
    *(u32x4*)(act + (size_t)(256 * pm) * DFF + c) = pack8(o0); *(u32x4*)(act + (size_t)(256 * pm + 1) * DFF + c) = pack8(o1);
}
__device__ __forceinline__ void p6_fixup_panels(const Ptrs& P, int vcu, int G, int tid, unsigned* cnt, unsigned* tmo) {
    constexpr int GRP = DFF / 8 / 8;
    const int nround = (512 + G - 1) / G;
    for (int i = 0; i < nround; ++i) { const int L = i * G + vcu; if (L >= 512) break; const int pm = L >> 3, pn = L & 7;
        if (pm > 0 && tid < GRP) p5_fix_item(P, pm, (pn * GRP + tid) * 8); }
    asm volatile("s_waitcnt vmcnt(0)" ::: "memory"); __syncthreads();
    if (tid == 0) {
        __builtin_amdgcn_fence(__ATOMIC_RELEASE, "agent"); asm volatile("s_waitcnt vmcnt(0)" ::: "memory");
        for (int i = 0; i < nround; ++i) { const int L = i * G + vcu; if (L >= 512) break; __hip_atomic_fetch_add(cnt + 64 * (L >> 3), 1u, __ATOMIC_RELAXED, __HIP_MEMORY_SCOPE_AGENT); }
        for (int i = 0; i < nround; ++i) { const int L = i * G + vcu; if (L >= 512) break; unsigned spins = 0;
            while (__hip_atomic_load(cnt + 64 * (L >> 3), __ATOMIC_RELAXED, __HIP_MEMORY_SCOPE_AGENT) < 8u) { __builtin_amdgcn_s_sleep(2); if (++spins > (1u << 20)) { __hip_atomic_store(tmo, 1u, __ATOMIC_RELAXED, __HIP_MEMORY_SCOPE_AGENT); break; } } }
        __builtin_amdgcn_fence(__ATOMIC_ACQUIRE, "agent"); asm volatile("s_waitcnt vmcnt(0)" ::: "memory");
    }
    __syncthreads();
}
__device__ __forceinline__ void p5_fixup(const Ptrs& P, int gt, int NGT) {
    for (int i = gt; i < 63 * (DFF / 8); i += NGT) p5_fix_item(P, 1 + i / (DFF / 8), (i % (DFF / 8)) * 8);
}

__device__ __forceinline__ void p7_final(const Ptrs& P, int gw, int NGW, int lane) {
    const float* slab = (const float*)(P.ws + WS_SLAB2);
    for (int m = gw; m < SEQ; m += NGW) {
        const float part = (lane < 32) ? slab[(size_t)m * 32 + lane] : 0.f;
        const float rstd = 1.0f / sqrtf(wave_sum(part) * (1.0f / DMODEL) + EPS);
        f32x4* xr = (f32x4*)(P.out + (size_t)m * DMODEL) + lane; const f32x4* gr = (const f32x4*)P.g_final + lane;
#pragma unroll
        for (int j = 0; j < 8; ++j) { f32x4 v = xr[64 * j]; const f32x4 gg = gr[64 * j]; v = v * rstd * gg; xr[64 * j] = v; }
    }
}

struct Args { const float* in[16]; float* out; unsigned char* ws; int ph_lo, ph_hi; };
__global__ void __launch_bounds__(NWAVES * 64, 2) hybrid_fwd(Args args) {
    extern __shared__ __attribute__((aligned(16))) unsigned char lds_raw[];
    LAS unsigned char* lds = (LAS unsigned char*)lds_raw;
    cg::grid_group grid = cg::this_grid();
    const int tid = threadIdx.x, lane = tid & 63, wave = __builtin_amdgcn_readfirstlane(tid >> 6);
    const int G = gridDim.x, bx = blockIdx.x, vcu = (G % 8 == 0) ? (bx % 8) * (G / 8) + bx / 8 : bx;
    const int gw = vcu * NWAVES + wave, NGW = G * NWAVES;
    volatile LAS unsigned* MISC = (volatile LAS unsigned*)(lds + MISC_OFF);
    if (tid < 32) MISC[tid] = 0u;
    __syncthreads();
    const XcdBarrier bar = xcd_barrier_post((unsigned*)(args.ws + WS_CTL), MISC + 8);
    Ptrs P;
    P.x = args.in[0]; P.mem = args.in[1]; P.g_mix = args.in[2]; P.g_mem = args.in[3]; P.w_in = args.in[4]; P.conv_w = args.in[5]; P.pool_w = args.in[6]; P.pool_scale = args.in[7];
    P.w_kv = args.in[8]; P.w_out = args.in[9]; P.g_ffn = args.in[10]; P.w_up = args.in[11]; P.ffn_conv_w = args.in[12]; P.ffn_conv_b = args.in[13]; P.w_down = args.in[14]; P.g_final = args.in[15];
    P.out = args.out; P.ws = args.ws;
    unsigned char* ws = args.ws;
#if PROBE_SYNC
    for (int i = 0; i < 20; ++i) xcd_barrier(bar);
#endif
    const int lo = args.ph_lo, hi = args.ph_hi;
#define IN(k) (lo <= (k) && (k) < hi)
#define SYNC(k) do { if ((k) + 1 < hi) { if ((k) == 0 && USE_CG_SYNC) grid.sync(); else xcd_barrier(bar); } } while (0)
#define SYNCR(k, b) do { if ((k) + 1 < hi || rp + 1 < NREP(b)) { if ((k) == 0 && USE_CG_SYNC) grid.sync(); else xcd_barrier(bar); } } while (0)
#define NREP(b) ((REPM & (b)) ? 2 : 1)
    if (IN(0) && (PHM & 1)) for (int rp = 0; rp < NREP(1); ++rp) { p0_prologue(P, lds, gw, NGW, wave, lane); SYNCR(0, 1); }
    if (IN(1) && (PHM & 2)) for (int rp = 0; rp < NREP(2); ++rp) {
        pg8::Gemm g{(const bf16*)(ws + WS_H), (const bf16*)(ws + WS_WINT), SEQ, DIN, DMODEL}; pg8::StaticOrder S; S.init(SEQ, DIN, G, bx);
        pg8::EpiZ E{(bf16*)(ws + WS_Z), DIN};
        pg8::gemm_phase<pg8::EpiZ, pg8::StaticOrder, P1_ALIGN, true>(lds, g, S, E, lds + XLDS_OFF);
        { const int nfull = ((SEQ / 256) * (DIN / 256)) % G;
          if (nfull == 0) p1_idle_work(P, lds, bx * NWAVES + wave, G * NWAVES, wave, lane);
          else if (bx >= nfull) p1_idle_work(P, lds, (bx - nfull) * NWAVES + wave, (G - nfull) * NWAVES, wave, lane); }
        SYNCR(1, 2);
    }
    if (IN(2) && (PHM & 4)) for (int rp = 0; rp < NREP(4); ++rp) { p2_mixer(P, lds, vcu, tid, wave, lane, 511);
#if PROBE_P2
        p2_mixer(P, lds, vcu, tid, wave, lane, PROBE_P2);
#endif
        SYNCR(2, 4); }
    if (IN(3) && (PHM & 8)) {
        pg8::Gemm g{(const bf16*)(ws + WS_MIX), (const bf16*)(ws + WS_WOUTT), SEQ, DMODEL, DMODEL}; pg8::PanelOrder S{G, vcu, (SEQ / 256) * (DMODEL / 256)};
        pg8::EpiNorm<0> E{P.x, nullptr, nullptr, (float*)(ws + WS_SIG), (bf16*)(ws + WS_X1B), nullptr, nullptr, (unsigned*)(ws + WS_SLAB1), (unsigned*)(ws + WS_CTL) + CW_PANEL1, (unsigned*)(ws + WS_CTL) + XB_TMO};
        pg8::gemm_phase<pg8::EpiNorm<0>, pg8::PanelOrder, true, true>(lds, g, S, E, lds + XLDS_OFF);
        SYNC(3);
    }
#if PROBE_GEMM
    if (IN(3)) {
        pg8::Gemm g{(const bf16*)(ws + WS_X1B), (const bf16*)(ws + WS_WUPT), SEQ, PROBE_N, DMODEL}; pg8::StaticOrder S; S.init(SEQ, PROBE_N, G, bx);
#if PROBE_GEMM == 1
        pg8::EpiZ E{(bf16*)(ws + WS_Z), PROBE_N};
        pg8::gemm_phase<pg8::EpiZ, pg8::StaticOrder, true, true>(lds, g, S, E, lds + XLDS_OFF);
#elif PROBE_GEMM == 2
        pg8::EpiNone E{};
        pg8::gemm_phase<pg8::EpiNone, pg8::StaticOrder, true, true>(lds, g, S, E, lds + XLDS_OFF);
#elif PROBE_GEMM == 3
        pg8::EpiZ E{(bf16*)(ws + WS_Z), PROBE_N};
        pg8::gemm_phase<pg8::EpiZ, pg8::StaticOrder, true, false>(lds, g, S, E, lds + XLDS_OFF);
#elif PROBE_GEMM == 5
        pg8::EpiAct E{(bf16*)(ws + WS_ACT), P.ffn_conv_w, P.ffn_conv_b, (float*)(ws + WS_UBND)};
        pg8::gemm_phase<pg8::EpiAct, pg8::StaticOrder, true, true>(lds, g, S, E, lds + XLDS_OFF);
#elif PROBE_GEMM == 4
        pg8::EpiZ E{(bf16*)(ws + WS_Z), PROBE_N};
        pg8::gemm_phase<pg8::EpiZ, pg8::StaticOrder, false, true>(lds, g, S, E, lds + XLDS_OFF);
#endif
        xcd_barrier(bar);
    }
#endif
    if (IN(4) && (PHM & 16)) for (int rp = 0; rp < NREP(16); ++rp) {
        pg8::Gemm g{(const bf16*)(ws + WS_X1B), (const bf16*)(ws + WS_WUPT), SEQ, DFF2, DMODEL}; pg8::StaticOrder S; S.init(SEQ, DFF2, G, bx);
        pg8::EpiAct E{(bf16*)(ws + WS_ACT), P.ffn_conv_w, P.ffn_conv_b, (float*)(ws + WS_UBND)};
        pg8::gemm_phase<pg8::EpiAct, pg8::StaticOrder, true, true>(lds, g, S, E, lds + XLDS_OFF);
        SYNCR(4, 16);
    }
#if !FUSE_FIXUP
    if (IN(5) && (PHM & 32)) { p5_fixup(P, vcu * (NWAVES * 64) + tid, G * NWAVES * 64); SYNC(5); }
#endif
    if (IN(6) && (PHM & 64)) {
#if FUSE_FIXUP
        p6_fixup_panels(P, vcu, G, tid, (unsigned*)(ws + WS_CTL) + CW_PANEL2, (unsigned*)(ws + WS_CTL) + XB_TMO);
#endif
        pg8::Gemm g{(const bf16*)(ws + WS_ACT), (const bf16*)(ws + WS_WDOWNT), SEQ, DMODEL, DFF}; pg8::PanelOrder S{G, vcu, (SEQ / 256) * (DMODEL / 256)};
        pg8::EpiNorm<1> E{nullptr, (const bf16*)(ws + WS_X1B), (const float*)(ws + WS_SIG), nullptr, nullptr, P.out, P.g_final, (unsigned*)(ws + WS_SLAB2), (unsigned*)(ws + WS_CTL) + CW_PANEL, (unsigned*)(ws + WS_CTL) + XB_TMO};
        pg8::gemm_phase<pg8::EpiNorm<1>, pg8::PanelOrder, true, true>(lds, g, S, E, lds + XLDS_OFF);
    }
#undef IN
#undef SYNC
}

extern "C" void kernel_launch(void* const* d_in, const int* in_sizes, int n_in, void* d_out, int out_size, void* d_ws, size_t ws_size, hipStream_t stream) {
    static int grid = 0;
    if (grid == 0) {
        if (n_in != 16 || in_sizes[0] != SEQ * DMODEL || out_size != SEQ * DMODEL || ws_size < WS_END) { fprintf(stderr, "kernel_launch: unexpected shapes (n_in %d, in0 %d, out %d, ws %zu)\n", n_in, n_in > 0 ? in_sizes[0] : -1, out_size, ws_size); grid = -1; return; }
        int dev = 0, cus = 0, per_cu = 0;
        if (hipGetDevice(&dev) != hipSuccess || hipDeviceGetAttribute(&cus, hipDeviceAttributeMultiprocessorCount, dev) != hipSuccess) { grid = -1; return; }
        if (hipFuncSetAttribute((const void*)hybrid_fwd, hipFuncAttributeMaxDynamicSharedMemorySize, LDS_BYTES) != hipSuccess) { fprintf(stderr, "kernel_launch: hipFuncSetAttribute failed\n"); grid = -1; return; }
        if (hipOccupancyMaxActiveBlocksPerMultiprocessor(&per_cu, (const void*)hybrid_fwd, NWAVES * 64, LDS_BYTES) != hipSuccess || per_cu < 1) { fprintf(stderr, "kernel_launch: occupancy query says %d blocks per CU\n", per_cu); (void)hipGetLastError(); per_cu = 1; }
        grid = cus;
        if (grid != 256) { fprintf(stderr, "kernel_launch: this kernel is laid out for one workgroup on each of 256 CUs (the mixer phase and the row-statistics exchanges assume it); the device reports %d\n", grid); if (grid > 256) grid = 256; }
    }
    if (grid < 0) return;
    if (hipMemsetAsync((char*)d_ws + WS_CTL, 0, CTL_ZERO_BYTES, stream) != hipSuccess) { fprintf(stderr, "kernel_launch: hipMemsetAsync failed\n"); return; }
    Args a{};
    for (int i = 0; i < 16; ++i) a.in[i] = (const float*)d_in[i];
    a.out = (float*)d_out; a.ws = (unsigned char*)d_ws;
#if MK_PER_PHASE
    for (int ph = 0; ph < NPHASE; ++ph) { a.ph_lo = ph; a.ph_hi = ph + 1; hipLaunchKernelGGL(hybrid_fwd, dim3(grid), dim3(NWAVES * 64), LDS_BYTES, stream, a); }
#else
    a.ph_lo = 0; a.ph_hi = NPHASE;
    void* kargs[] = {&a};
    hipError_t e = hipLaunchCooperativeKernel((const void*)hybrid_fwd, dim3(grid), dim3(NWAVES * 64), kargs, LDS_BYTES, stream);
    if (e != hipSuccess) fprintf(stderr, "kernel_launch: cooperative launch failed: %s (grid %d)\n", hipGetErrorString(e), grid);
#endif
}
```

```cpp
#include <hip/hip_runtime.h>
#include <hip/hip_cooperative_groups.h>
#include <cstdio>
#include <cstdint>
namespace cg = cooperative_groups;
#ifndef PG8_PRIO
#define PG8_PRIO 0
#endif
namespace pg8 {
#define PG8_LAS __attribute__((address_space(3)))
typedef unsigned short bf16_t;
typedef short bf16x8 __attribute__((ext_vector_type(8)));
typedef float f32x4 __attribute__((ext_vector_type(4)));
typedef unsigned u32x4 __attribute__((ext_vector_type(4)));
constexpr int BM = 256, BK = 64, HALF = 128, HTB = HALF * BK * 2  , STAGE_BYTES = 8 * HTB, NXCD = 8, WGM = 8;

__host__ __device__ __forceinline__ int lds_byte(int r, int c) { const int st = (r >> 4) * 2 + (c >> 5), rr = r & 15, cc = c & 31, ob = rr * 64 + cc * 2; return st * 1024 + (ob ^ (((ob >> 9) & 1) << 5)); }
__host__ __device__ __forceinline__ void stage_rc(int b, int& R, int& C) { const int st = b / 1024, sb = b % 1024, swz = sb ^ (((sb >> 9) & 1) << 5); R = (st >> 1) * 16 + swz / 64; C = (st & 1) * 32 + (swz % 64) / 2; }
__host__ __device__ __forceinline__ int perm32(int rho) { const int n = rho >> 4, i = rho & 15; return 8 * (i >> 2) + 4 * n + (i & 3); }

struct Unit { int pm, pn; };
struct Gemm { const bf16_t* A; const bf16_t* Bt; int M, N, K; };

struct StaticOrder {
    int nM, nN, nwg, G, c;
    __host__ __device__ void init(int M, int N, int G_, int c_) { nM = M / BM; nN = N / BM; nwg = nM * nN; G = G_; c = c_; }
    __host__ __device__ bool next(int i, Unit& u) const {
        const long L = (long)i * G + c; if (L >= nwg) return false;
        int wgid = (int)L; { const int q = nwg / NXCD, r = nwg % NXCD, xcd = wgid % NXCD, off = wgid / NXCD; wgid = (xcd < r ? xcd * (q + 1) : r * (q + 1) + (xcd - r) * q) + off; }
        const int nig = WGM * nN, gid = wgid / nig, fm = gid * WGM, gsz = (nM - fm) < WGM ? (nM - fm) : WGM;
        u.pm = fm + ((wgid % nig) % gsz); u.pn = (wgid % nig) / gsz; return true;
    }
    __device__ __forceinline__ void a_ready(const Unit&) const {}
    __device__ __forceinline__ void done(const Unit&) const {}
};
__device__ __forceinline__ unsigned cvt_pk_bf16(float lo, float hi) { unsigned r; asm volatile("v_cvt_pk_bf16_f32 %0, %1, %2" : "=v"(r) : "v"(lo), "v"(hi)); return r; }
typedef unsigned u32x2 __attribute__((ext_vector_type(2)));
constexpr int DM = 2048;
constexpr float RMS_EPS = 1e-6f;

struct EpiZ {
    static constexpr bool PERM = true, AFTER_DRAIN = false;
    bf16_t* O; int ldc;
    __device__ __forceinline__ void operator()(const f32x4 (&acc)[2][2][4][2], const Unit& u, int wr, int wc, int fr_, int fq_, PG8_LAS unsigned char*) const {
        int t_ = threadIdx.x; asm volatile("" : "+v"(t_));
        const int fr = t_ & 15, fq = (t_ >> 4) & 3;
        const int row0 = u.pm * BM + wr * 64 + fr, col0 = u.pn * BM + wc * 32 + 8 * fq;
#pragma unroll
        for (int ai = 0; ai < 2; ++ai)
#pragma unroll
            for (int m = 0; m < 4; ++m) { bf16_t* rowp = O + (size_t)(row0 + ai * HALF + m * 16) * ldc + col0;
#pragma unroll
                for (int bj = 0; bj < 2; ++bj) { const f32x4 v0 = acc[ai][bj][m][0], v1 = acc[ai][bj][m][1];
                    u32x4 w; w.x = cvt_pk_bf16(v0[0], v0[1]); w.y = cvt_pk_bf16(v0[2], v0[3]); w.z = cvt_pk_bf16(v1[0], v1[1]); w.w = cvt_pk_bf16(v1[2], v1[3]);
                    *(u32x4*)(rowp + bj * HALF) = w; } }
    }
};

struct EpiNone {
    static constexpr bool PERM = true, AFTER_DRAIN = false;
    __device__ __forceinline__ void operator()(const f32x4 (&acc)[2][2][4][2], const Unit& u, int wr, int wc, int fr, int fq, PG8_LAS unsigned char*) const {
#pragma unroll
        for (int ai = 0; ai < 2; ++ai)
#pragma unroll
            for (int bj = 0; bj < 2; ++bj)
#pragma unroll
                for (int m = 0; m < 4; ++m)
#pragma unroll
                    for (int n = 0; n < 2; ++n) asm volatile("" :: "v"(acc[ai][bj][m][n]));
    }
};
struct EpiResA {
    static constexpr bool PERM = true, AFTER_DRAIN = false;
    const float* R; bf16_t* XB; float* slab;
    __device__ __forceinline__ void operator()(const f32x4 (&acc)[2][2][4][2], const Unit& u, int wr, int wc, int fr_, int fq_, PG8_LAS unsigned char*) const {
        int t_ = threadIdx.x; asm volatile("" : "+v"(t_));
        const int fr = t_ & 15, fq = (t_ >> 4) & 3;
        const int row0 = u.pm * BM + wr * 64 + fr, col0 = u.pn * BM + wc * 32 + 8 * fq;
#pragma unroll
        for (int ai = 0; ai < 2; ++ai) {
            f32x4 r[4][2][2];
#pragma unroll
            for (int m = 0; m < 4; ++m)
#pragma unroll
                for (int bj = 0; bj < 2; ++bj) { const float* p = R + (size_t)(row0 + ai * HALF + m * 16) * DM + col0 + bj * HALF; r[m][bj][0] = *(const f32x4*)p; r[m][bj][1] = *(const f32x4*)(p + 4); }
#pragma unroll
            for (int m = 0; m < 4; ++m) { const int row = row0 + ai * HALF + m * 16; float ss = 0.f;
#pragma unroll
                for (int bj = 0; bj < 2; ++bj) { const f32x4 v0 = acc[ai][bj][m][0] + r[m][bj][0], v1 = acc[ai][bj][m][1] + r[m][bj][1];
                    u32x4 w; w.x = cvt_pk_bf16(v0[0], v0[1]); w.y = cvt_pk_bf16(v0[2], v0[3]); w.z = cvt_pk_bf16(v1[0], v1[1]); w.w = cvt_pk_bf16(v1[2], v1[3]);
                    *(u32x4*)(XB + (size_t)row * DM + col0 + bj * HALF) = w;
                    ss += (v0[0] * v0[0] + v0[1] * v0[1]) + (v0[2] * v0[2] + v0[3] * v0[3]) + (v1[0] * v1[0] + v1[1] * v1[1]) + (v1[2] * v1[2] + v1[3] * v1[3]); }
                ss += __shfl_xor(ss, 16); ss += __shfl_xor(ss, 32);
                if (fq == 0) slab[(size_t)row * 32 + u.pn * 4 + wc] = ss; }
            asm volatile("" ::: "memory"); }
    }
};
struct EpiResB {
    static constexpr bool PERM = true, AFTER_DRAIN = false;
    const bf16_t* RB; float* X; float* slab;
    __device__ __forceinline__ void operator()(const f32x4 (&acc)[2][2][4][2], const Unit& u, int wr, int wc, int fr_, int fq_, PG8_LAS unsigned char*) const {
        int t_ = threadIdx.x; asm volatile("" : "+v"(t_));
        const int fr = t_ & 15, fq = (t_ >> 4) & 3;
        const int row0 = u.pm * BM + wr * 64 + fr, col0 = u.pn * BM + wc * 32 + 8 * fq;
        u32x4 r[2][4][2];
#pragma unroll
        for (int ai = 0; ai < 2; ++ai)
#pragma unroll
            for (int m = 0; m < 4; ++m)
#pragma unroll
                for (int bj = 0; bj < 2; ++bj) r[ai][m][bj] = *(const u32x4*)(RB + (size_t)(row0 + ai * HALF + m * 16) * DM + col0 + bj * HALF);
#pragma unroll
        for (int ai = 0; ai < 2; ++ai)
#pragma unroll
            for (int m = 0; m < 4; ++m) { const int row = row0 + ai * HALF + m * 16; float ss = 0.f;
#pragma unroll
                for (int bj = 0; bj < 2; ++bj) { const u32x4 q = r[ai][m][bj];
                    const f32x4 r0 = {__builtin_bit_cast(float, q.x << 16), __builtin_bit_cast(float, q.x & 0xffff0000u), __builtin_bit_cast(float, q.y << 16), __builtin_bit_cast(float, q.y & 0xffff0000u)};
                    const f32x4 r1 = {__builtin_bit_cast(float, q.z << 16), __builtin_bit_cast(float, q.z & 0xffff0000u), __builtin_bit_cast(float, q.w << 16), __builtin_bit_cast(float, q.w & 0xffff0000u)};
                    const f32x4 v0 = acc[ai][bj][m][0] + r0, v1 = acc[ai][bj][m][1] + r1;
                    float* xp = X + (size_t)row * DM + col0 + bj * HALF; *(f32x4*)xp = v0; *(f32x4*)(xp + 4) = v1;
                    ss += (v0[0] * v0[0] + v0[1] * v0[1]) + (v0[2] * v0[2] + v0[3] * v0[3]) + (v1[0] * v1[0] + v1[1] * v1[1]) + (v1[2] * v1[2] + v1[3] * v1[3]); }
                ss += __shfl_xor(ss, 16); ss += __shfl_xor(ss, 32);
                if (fq == 0) slab[(size_t)row * 32 + u.pn * 4 + wc] = ss; }
    }
};

struct PanelOrder {
    int G, vcu, ntot;
    __device__ __forceinline__ bool next(int i, Unit& u) const { const int L = i * G + vcu; if (L >= ntot) return false; u.pm = L >> 3; u.pn = L & 7; return true; }
    __device__ __forceinline__ void a_ready(const Unit&) const {}
    __device__ __forceinline__ void done(const Unit&) const {}
};
template <int MODE  > struct EpiNorm {
    static constexpr bool PERM = (MODE == 0), AFTER_DRAIN = false;
    const float* Rf; const bf16_t* Rb; const float* sig_in; float* sig_out; bf16_t* HN; float* OUT; const float* gfin; unsigned* xbuf; unsigned* cnt; unsigned* tmo;
    __device__ __forceinline__ void operator()(f32x4 (&acc)[2][2][4][2], const Unit& u, int wr, int wc, int fr_, int fq_, PG8_LAS unsigned char* xlds) const {
        int t_ = threadIdx.x; asm volatile("" : "+v"(t_));
        const int fr = t_ & 15, fq = (t_ >> 4) & 3, wid = __builtin_amdgcn_readfirstlane(t_ >> 6);
        const int rl0 = wr * 64 + fr, row0 = u.pm * BM + rl0, col0 = u.pn * BM + wc * 32 + 8 * fq;
        PG8_LAS float* Pt = (PG8_LAS float*)xlds;
        PG8_LAS float* St = (PG8_LAS float*)(xlds + 4096);
        if constexpr (MODE == 0) {
#pragma unroll
            for (int ai = 0; ai < 2; ++ai) { f32x4 r[4][2][2];
#pragma unroll
                for (int m = 0; m < 4; ++m)
#pragma unroll
                    for (int bj = 0; bj < 2; ++bj) { const float* p = Rf + (size_t)(row0 + ai * HALF + m * 16) * DM + col0 + bj * HALF; r[m][bj][0] = *(const f32x4*)p; r[m][bj][1] = *(const f32x4*)(p + 4); }
#pragma unroll
                for (int m = 0; m < 4; ++m) { float ss = 0.f;
#pragma unroll
                    for (int bj = 0; bj < 2; ++bj) { const f32x4 v0 = acc[ai][bj][m][0] + r[m][bj][0], v1 = acc[ai][bj][m][1] + r[m][bj][1]; acc[ai][bj][m][0] = v0; acc[ai][bj][m][1] = v1;
                        ss += (v0[0] * v0[0] + v0[1] * v0[1]) + (v0[2] * v0[2] + v0[3] * v0[3]) + (v1[0] * v1[0] + v1[1] * v1[1]) + (v1[2] * v1[2] + v1[3] * v1[3]); }
                    ss += __shfl_xor(ss, 16); ss += __shfl_xor(ss, 32);
                    if (fq == 0) Pt[(ai * HALF + rl0 + m * 16) * 4 + wc] = ss; }
                asm volatile("" ::: "memory"); }
        } else { u32x2 r[2][4][2][2]; float sg[2][4]; const int colb = u.pn * BM + wc * 32 + 4 * fq;
#pragma unroll
            for (int ai = 0; ai < 2; ++ai)
#pragma unroll
                for (int m = 0; m < 4; ++m) { sg[ai][m] = sig_in[row0 + ai * HALF + m * 16];
#pragma unroll
                    for (int bj = 0; bj < 2; ++bj)
#pragma unroll
                        for (int n = 0; n < 2; ++n) r[ai][m][bj][n] = *(const u32x2*)(Rb + (size_t)(row0 + ai * HALF + m * 16) * DM + colb + bj * HALF + 16 * n); }
#pragma unroll
            for (int ai = 0; ai < 2; ++ai)
#pragma unroll
                for (int m = 0; m < 4; ++m) { float ss = 0.f; const float sgm = sg[ai][m];
#pragma unroll
                    for (int bj = 0; bj < 2; ++bj)
#pragma unroll
                        for (int n = 0; n < 2; ++n) { const u32x2 q = r[ai][m][bj][n];
                            const f32x4 r0 = {__builtin_bit_cast(float, q.x << 16), __builtin_bit_cast(float, q.x & 0xffff0000u), __builtin_bit_cast(float, q.y << 16), __builtin_bit_cast(float, q.y & 0xffff0000u)};
                            const f32x4 v0 = acc[ai][bj][m][n] + r0 * sgm; acc[ai][bj][m][n] = v0;
                            ss += (v0[0] * v0[0] + v0[1] * v0[1]) + (v0[2] * v0[2] + v0[3] * v0[3]); }
                    ss += __shfl_xor(ss, 16); ss += __shfl_xor(ss, 32);
                    if (fq == 0) Pt[(ai * HALF + rl0 + m * 16) * 4 + wc] = ss; } }
        asm volatile("s_waitcnt lgkmcnt(0)" ::: "memory"); __builtin_amdgcn_s_barrier(); asm volatile("" ::: "memory");
        if (t_ < 256) { const float s = (Pt[t_ * 4 + 0] + Pt[t_ * 4 + 1]) + (Pt[t_ * 4 + 2] + Pt[t_ * 4 + 3]);
            __hip_atomic_store(xbuf + (size_t)(u.pm * BM + t_) * 8 + u.pn, __builtin_bit_cast(unsigned, s), __ATOMIC_RELAXED, __HIP_MEMORY_SCOPE_AGENT); }
        asm volatile("s_waitcnt vmcnt(0)" ::: "memory");
        if (t_ < 256 && (t_ & 63) == 0) __hip_atomic_fetch_add(cnt + 64 * u.pm, 1u, __ATOMIC_RELAXED, __HIP_MEMORY_SCOPE_AGENT);
        if (wid == 0) {
            unsigned spins = 0;
            while ((unsigned)__builtin_amdgcn_readfirstlane(__hip_atomic_load(cnt + 64 * u.pm, __ATOMIC_RELAXED, __HIP_MEMORY_SCOPE_AGENT)) < 32u) {
                __builtin_amdgcn_s_sleep(2);
                if (++spins > (1u << 20)) { if ((t_ & 63) == 0) __hip_atomic_store(tmo, 1u, __ATOMIC_RELAXED, __HIP_MEMORY_SCOPE_AGENT); break; } }
            __builtin_amdgcn_fence(__ATOMIC_ACQUIRE, "agent");
        }
        asm volatile("s_waitcnt vmcnt(0) lgkmcnt(0)" ::: "memory"); __builtin_amdgcn_s_barrier(); asm volatile("" ::: "memory");
        if (t_ < 256) { const unsigned long long* sp = (const unsigned long long*)(xbuf + (size_t)(u.pm * BM + t_) * 8); float tot = 0.f;
#pragma unroll
            for (int q = 0; q < 4; ++q) { const unsigned long long w = __hip_atomic_load(sp + q, __ATOMIC_RELAXED, __HIP_MEMORY_SCOPE_AGENT);
                tot += __builtin_bit_cast(float, (unsigned)w); tot += __builtin_bit_cast(float, (unsigned)(w >> 32)); }
            const float sd = sqrtf(tot * (1.0f / DM) + RMS_EPS);
            St[t_] = 1.0f / sd;
            if (MODE == 0 && u.pn == 0) sig_out[u.pm * BM + t_] = sd; }
        asm volatile("s_waitcnt lgkmcnt(0)" ::: "memory"); __builtin_amdgcn_s_barrier(); asm volatile("" ::: "memory");
        if constexpr (MODE == 0) {
#pragma unroll
            for (int ai = 0; ai < 2; ++ai)
#pragma unroll
                for (int m = 0; m < 4; ++m) { const float rstd = St[ai * HALF + rl0 + m * 16]; bf16_t* op = HN + (size_t)(row0 + ai * HALF + m * 16) * DM + col0;
#pragma unroll
                    for (int bj = 0; bj < 2; ++bj) { const f32x4 v0 = acc[ai][bj][m][0] * rstd, v1 = acc[ai][bj][m][1] * rstd;
                        u32x4 w; w.x = cvt_pk_bf16(v0[0], v0[1]); w.y = cvt_pk_bf16(v0[2], v0[3]); w.z = cvt_pk_bf16(v1[0], v1[1]); w.w = cvt_pk_bf16(v1[2], v1[3]);
                        *(u32x4*)(op + bj * HALF) = w; } }
        } else {
            const int colb = u.pn * BM + wc * 32 + 4 * fq; const bool odd = fr & 1;
            f32x4 gg[2][2];
#pragma unroll
            for (int bj = 0; bj < 2; ++bj)
#pragma unroll
                for (int n = 0; n < 2; ++n) gg[bj][n] = *(const f32x4*)(gfin + colb + bj * HALF + 16 * n);
#pragma unroll
            for (int ai = 0; ai < 2; ++ai)
#pragma unroll
                for (int m = 0; m < 4; ++m) { const float rstd = St[ai * HALF + rl0 + m * 16]; float* op = OUT + (size_t)(row0 + ai * HALF + m * 16) * DM + colb;
#pragma unroll
                    for (int bj = 0; bj < 2; ++bj) {
                        const f32x4 o0 = acc[ai][bj][m][0] * rstd * gg[bj][0], o1 = acc[ai][bj][m][1] * rstd * gg[bj][1]; f32x4 dA, dB;
#pragma unroll
                        for (int j = 0; j < 4; ++j) { const float snd = odd ? o0[j] : o1[j];
                            const float rcv = __builtin_bit_cast(float, __builtin_amdgcn_mov_dpp(__builtin_bit_cast(int, snd), 0xB1, 0xf, 0xf, false));
                            dA[j] = odd ? rcv : o0[j]; dB[j] = odd ? o1[j] : rcv; }
                        float* pp = op + bj * HALF + (odd ? 16 : 0);
                        *(f32x4*)(pp - (odd ? DM : 0)) = dA; *(f32x4*)(pp + (odd ? 0 : DM)) = dB; } }
        }
    }
};

__device__ __forceinline__ float dpp_shr1(float old, float src) { return __builtin_bit_cast(float, __builtin_amdgcn_update_dpp(__builtin_bit_cast(int, old), __builtin_bit_cast(int, src), 0x111, 0xf, 0xf, false)); }
__device__ __forceinline__ float dpp_shr2(float old, float src) { return __builtin_bit_cast(float, __builtin_amdgcn_update_dpp(__builtin_bit_cast(int, old), __builtin_bit_cast(int, src), 0x112, 0xf, 0xf, false)); }
__device__ __forceinline__ float dpp_ror1(float src) { return __builtin_bit_cast(float, __builtin_amdgcn_mov_dpp(__builtin_bit_cast(int, src), 0x121, 0xf, 0xf, false)); }
__device__ __forceinline__ float dpp_ror2(float src) { return __builtin_bit_cast(float, __builtin_amdgcn_mov_dpp(__builtin_bit_cast(int, src), 0x122, 0xf, 0xf, false)); }
constexpr int FF = 5632, FF2 = 11264;
typedef _Float16 h2_t __attribute__((ext_vector_type(2)));
__device__ __forceinline__ unsigned pkh(float a, float b) { return __builtin_bit_cast(unsigned, __builtin_amdgcn_cvt_pkrtz(a, b)); }
__device__ __forceinline__ unsigned dppu_shr1(unsigned old, unsigned src) { return (unsigned)__builtin_amdgcn_update_dpp((int)old, (int)src, 0x111, 0xf, 0xf, false); }
__device__ __forceinline__ unsigned dppu_shr2(unsigned old, unsigned src) { return (unsigned)__builtin_amdgcn_update_dpp((int)old, (int)src, 0x112, 0xf, 0xf, false); }
__device__ __forceinline__ unsigned dppu_ror1(unsigned src) { return (unsigned)__builtin_amdgcn_mov_dpp((int)src, 0x121, 0xf, 0xf, false); }
__device__ __forceinline__ unsigned dppu_ror2(unsigned src) { return (unsigned)__builtin_amdgcn_mov_dpp((int)src, 0x122, 0xf, 0xf, false); }
struct EpiAct {
    static constexpr bool PERM = true, AFTER_DRAIN = false;
    bf16_t* ACT; const float* cw; const float* cb; float* ubnd;
    __device__ __forceinline__ void operator()(f32x4 (&acc)[2][2][4][2], const Unit& u, int wr, int wc, int fr_, int fq_, PG8_LAS unsigned char* xlds) const {
        int t_ = threadIdx.x; asm volatile("" : "+v"(t_));
        const int fr = t_ & 15, fq = (t_ >> 4) & 3;
        const int row0 = u.pm * BM + wr * 64 + fr, cl = wc * 32 + 8 * fq;
        const int c0 = u.pn * 128 + cl;
        f32x4 wgt[2][8];
#pragma unroll
        for (int n = 0; n < 2; ++n) { const float* wp = cw + c0 + 4 * n; const float* bp = cb + c0 + 4 * n;
            wgt[n][0] = *(const f32x4*)wp; wgt[n][1] = *(const f32x4*)(wp + FF2); wgt[n][2] = *(const f32x4*)(wp + 2 * FF2); wgt[n][3] = *(const f32x4*)bp;
            wgt[n][4] = *(const f32x4*)(wp + FF); wgt[n][5] = *(const f32x4*)(wp + FF2 + FF); wgt[n][6] = *(const f32x4*)(wp + 2 * FF2 + FF); wgt[n][7] = *(const f32x4*)(bp + FF); }
        if (wr == 1 && fr >= 14) {
#pragma unroll
            for (int bj = 0; bj < 2; ++bj)
#pragma unroll
                for (int n = 0; n < 2; ++n) *(f32x4*)(ubnd + (size_t)(u.pm * 4 + 2 + (fr - 14)) * FF2 + u.pn * BM + 128 * bj + cl + 4 * n) = acc[1][bj][3][n]; }
        if (wr == 0 && fr < 2) {
#pragma unroll
            for (int bj = 0; bj < 2; ++bj)
#pragma unroll
                for (int n = 0; n < 2; ++n) *(f32x4*)(ubnd + (size_t)(u.pm * 4 + fr) * FF2 + u.pn * BM + 128 * bj + cl + 4 * n) = acc[0][bj][0][n]; }
        u32x4 pk[2][4][2];
#pragma unroll
        for (int ai = 0; ai < 2; ++ai)
#pragma unroll
            for (int m = 0; m < 4; ++m)
#pragma unroll
                for (int n = 0; n < 2; ++n) { const f32x4 g = acc[ai][0][m][n], v = acc[ai][1][m][n]; pk[ai][m][n] = (u32x4){pkh(g[0], v[0]), pkh(g[1], v[1]), pkh(g[2], v[2]), pkh(g[3], v[3])}; }
        if (fr >= 14) {
#pragma unroll
            for (int ai = 0; ai < 2; ++ai)
#pragma unroll
                for (int n = 0; n < 2; ++n) *(PG8_LAS u32x4*)(xlds + ((((2 * ai + wr) * 2 + (fr - 14)) * 128 + cl + 4 * n) << 2)) = pk[ai][3][n]; }
        asm volatile("s_waitcnt lgkmcnt(0)" ::: "memory"); __builtin_amdgcn_s_barrier(); asm volatile("" ::: "memory");
        u32x2 hold[2][4];
#pragma unroll
        for (int n = 0; n < 2; ++n) {
            h2_t w0p[4], w1p[4], w2p[4], bp4[4];
#pragma unroll
            for (int j = 0; j < 4; ++j) { w0p[j] = __builtin_bit_cast(h2_t, pkh(wgt[n][0][j], wgt[n][4][j])); w1p[j] = __builtin_bit_cast(h2_t, pkh(wgt[n][1][j], wgt[n][5][j]));
                w2p[j] = __builtin_bit_cast(h2_t, pkh(wgt[n][2][j], wgt[n][6][j])); bp4[j] = __builtin_bit_cast(h2_t, pkh(wgt[n][3][j], wgt[n][7][j])); }
#pragma unroll
            for (int ai = 0; ai < 2; ++ai) {
                const int chunk = 2 * ai + wr;
                u32x4 pp = {0u, 0u, 0u, 0u};
                if (chunk > 0) pp = *(const PG8_LAS u32x4*)(xlds + ((((chunk - 1) * 2 + (fr & 1)) * 128 + cl + 4 * n) << 2));
#pragma unroll
                for (int m = 0; m < 4; ++m) {
                    const u32x4 cur = pk[ai][m][n]; float a[4];
#pragma unroll
                    for (int j = 0; j < 4; ++j) {
                        const unsigned cj = cur[j], pj = pp[j];
                        const h2_t s1 = __builtin_bit_cast(h2_t, dppu_shr1(dppu_ror1(pj), cj)), s2 = __builtin_bit_cast(h2_t, dppu_shr2(dppu_ror2(pj), cj)), ch = __builtin_bit_cast(h2_t, cj);
                        const h2_t r = w2p[j] * ch + (w1p[j] * s1 + (w0p[j] * s2 + bp4[j]));
                        const float G = (float)r.x, V = (float)r.y;
                        a[j] = G * __builtin_amdgcn_rcpf(1.0f + __builtin_amdgcn_exp2f(-1.4426950408889634f * G)) * V; }
                    u32x2 w; w.x = cvt_pk_bf16(a[0], a[1]); w.y = cvt_pk_bf16(a[2], a[3]);
                    if (n == 0) hold[ai][m] = w;
                    else { u32x4 o; o.x = hold[ai][m].x; o.y = hold[ai][m].y; o.z = w.x; o.w = w.y;
                        if (!(ai == 0 && m == 0 && wr == 0 && u.pm > 0 && fr < 2)) *(u32x4*)(ACT + (size_t)(row0 + ai * HALF + m * 16) * FF + c0) = o; }
                    pp = cur;
                }
            }
        }
    }
};

template <class Epi, class Sched, bool ALIGN_EPI = false, bool SP2 = false>
__device__ __forceinline__ void gemm_phase(PG8_LAS unsigned char* lds, const Gemm g, const Sched& S, const Epi& E, PG8_LAS unsigned char* xlds) {
    const int tid = threadIdx.x, wid = __builtin_amdgcn_readfirstlane(tid >> 6), lane = tid & 63, wr = wid >> 2, wc = wid & 3, fr = lane & 15, fq = lane >> 4;
    const int K = g.K, nt = K / BK;
    unsigned voffA[2], voffB[2];
#pragma unroll
    for (int i = 0; i < 2; ++i) { int R, C; stage_rc(tid * 16 + i * 8192, R, C); const int Rb = Epi::PERM ? ((R & ~31) + perm32(R & 31)) : R;
        voffA[i] = (unsigned)(R * K + C) * 2u; voffB[i] = (unsigned)(Rb * K + C) * 2u; }
    const size_t kstep = (size_t)(BK * 2);
    const size_t hstep = (size_t)HALF * K * 2;
    const size_t tstep = 2 * hstep;
    const unsigned ldsw = (unsigned)wid * 1024u;
    const int aoff = lds_byte(wr * 64 + fr, fq * 8), boff = lds_byte(wc * 32 + fr, fq * 8);
#define PG8_SA(b, h) (((b) * 2 + (h)) * HTB)
#define PG8_SB(b, h) ((4 + (b) * 2 + (h)) * HTB)
#define PG8_STAGE(bufoff, gbase, voff) do { _Pragma("unroll") for (int _i = 0; _i < 2; ++_i) \
        __builtin_amdgcn_global_load_lds((const unsigned*)((const char*)(gbase) + (voff)[_i]), (PG8_LAS unsigned*)(lds + (bufoff) + ldsw + _i * 8192), 16, 0, 0); } while (0)
#define PG8_LDA(dst, b, h) do { _Pragma("unroll") for (int m = 0; m < 4; ++m) _Pragma("unroll") for (int k = 0; k < 2; ++k) dst[m][k] = *(const PG8_LAS bf16x8*)(lds + PG8_SA(b, h) + aoff + m * 2048 + k * 1024); } while (0)
#define PG8_LDB(dst, b, h) do { _Pragma("unroll") for (int n = 0; n < 2; ++n) _Pragma("unroll") for (int k = 0; k < 2; ++k) dst[n][k] = *(const PG8_LAS bf16x8*)(lds + PG8_SB(b, h) + boff + n * 2048 + k * 1024); } while (0)
#define PG8_MMA(ai, bj, At, Bt) do { __builtin_amdgcn_s_setprio(PG8_PRIO); _Pragma("unroll") for (int m = 0; m < 4; ++m) _Pragma("unroll") for (int n = 0; n < 2; ++n) _Pragma("unroll") for (int k = 0; k < 2; ++k) \
        acc[ai][bj][m][n] = __builtin_amdgcn_mfma_f32_16x16x32_bf16(Bt[n][k], At[m][k], acc[ai][bj][m][n], 0, 0, 0); __builtin_amdgcn_s_setprio(0); } while (0)
#define PG8_WAIT_V(n) asm volatile("s_waitcnt vmcnt(" #n ")" ::: "memory")
#define PG8_WAIT_L(n) asm volatile("s_waitcnt lgkmcnt(" #n ")" ::: "memory")
#define PG8_BAR __builtin_amdgcn_s_barrier()
#define PG8_SCHED __builtin_amdgcn_sched_barrier(0)
    Unit cur, nxt; int ui = 0;
    if (!S.next(0, cur)) return;
    f32x4 acc[2][2][4][2];
#pragma unroll
    for (int a = 0; a < 2; ++a)
#pragma unroll
        for (int b = 0; b < 2; ++b)
#pragma unroll
            for (int m = 0; m < 4; ++m)
#pragma unroll
                for (int n = 0; n < 2; ++n) acc[a][b][m][n] = (f32x4){0.f, 0.f, 0.f, 0.f};
    bf16x8 At[4][2], B0[2][2], B1[2][2];
    const char* cA = (const char*)g.A + (size_t)cur.pm * tstep; const char* cB = (const char*)g.Bt + (size_t)cur.pn * tstep;
    S.a_ready(cur);
    if constexpr (SP2) {
        PG8_STAGE(PG8_SB(0, 0), cB, voffB); PG8_STAGE(PG8_SB(0, 1), cB + hstep, voffB); PG8_STAGE(PG8_SA(0, 0), cA, voffA); PG8_STAGE(PG8_SA(0, 1), cA + hstep, voffA);
        if (wr == 1) PG8_BAR;
        PG8_WAIT_V(2); PG8_BAR;
        PG8_STAGE(PG8_SB(1, 0), cB + kstep, voffB); PG8_STAGE(PG8_SA(1, 0), cA + kstep, voffA); PG8_STAGE(PG8_SB(1, 1), cB + hstep + kstep, voffB);
        PG8_WAIT_V(6); PG8_BAR;
    } else {
        PG8_STAGE(PG8_SB(0, 0), cB, voffB); PG8_STAGE(PG8_SA(0, 0), cA, voffA); PG8_STAGE(PG8_SB(0, 1), cB + hstep, voffB); PG8_STAGE(PG8_SA(0, 1), cA + hstep, voffA);
        if (wr == 1) PG8_BAR;
        PG8_WAIT_V(4); PG8_BAR;
        PG8_STAGE(PG8_SB(1, 0), cB + kstep, voffB); PG8_STAGE(PG8_SA(1, 0), cA + kstep, voffA); PG8_STAGE(PG8_SB(1, 1), cB + hstep + kstep, voffB);
        PG8_WAIT_V(6); PG8_BAR;
    }
    for (;;) {
        const bool has_next = S.next(ui + 1, nxt);
        const char* nA = has_next ? (const char*)g.A + (size_t)nxt.pm * tstep : cA; const char* nB = has_next ? (const char*)g.Bt + (size_t)nxt.pn * tstep : cB;
        for (int t = 0; t < nt; t += 2) {
            const bool last = (t == nt - 2);
            const char* a1 = cA + (size_t)(t + 1) * kstep;
            const char* a2 = last ? nA : cA + (size_t)(t + 2) * kstep; const char* b2 = last ? nB : cB + (size_t)(t + 2) * kstep;
            const char* a3 = a2 + kstep; const char* b3 = b2 + kstep;
            if (last && has_next) S.a_ready(nxt);
            if constexpr (SP2) {
            PG8_LDB(B0, 0, 0); PG8_LDB(B1, 0, 1); PG8_SCHED; PG8_LDA(At, 0, 0); PG8_STAGE(PG8_SA(1, 1), a1 + hstep, voffA);
            PG8_WAIT_V(8); PG8_WAIT_L(0); PG8_BAR; PG8_MMA(0, 0, At, B0); PG8_MMA(0, 1, At, B1); PG8_BAR; PG8_SCHED;
            PG8_LDA(At, 0, 1); PG8_STAGE(PG8_SB(0, 0), b2, voffB); PG8_STAGE(PG8_SB(0, 1), b2 + hstep, voffB); PG8_STAGE(PG8_SA(0, 0), a2, voffA);
            PG8_WAIT_V(8); PG8_WAIT_L(0); PG8_BAR; PG8_MMA(1, 0, At, B0); PG8_MMA(1, 1, At, B1); PG8_BAR; PG8_SCHED;
            PG8_LDB(B0, 1, 0); PG8_LDB(B1, 1, 1); PG8_SCHED; PG8_LDA(At, 1, 0); PG8_STAGE(PG8_SA(0, 1), a2 + hstep, voffA);
            PG8_WAIT_V(8); PG8_WAIT_L(0); PG8_BAR; PG8_MMA(0, 0, At, B0); PG8_MMA(0, 1, At, B1); PG8_BAR; PG8_SCHED;
            PG8_LDA(At, 1, 1); PG8_STAGE(PG8_SB(1, 0), b3, voffB); PG8_STAGE(PG8_SB(1, 1), b3 + hstep, voffB); PG8_STAGE(PG8_SA(1, 0), a3, voffA);
            PG8_WAIT_V(8); PG8_WAIT_L(0); PG8_BAR; PG8_MMA(1, 0, At, B0); PG8_MMA(1, 1, At, B1); PG8_BAR; PG8_SCHED;
            } else {
            PG8_LDB(B0, 0, 0); PG8_SCHED; PG8_LDA(At, 0, 0); PG8_STAGE(PG8_SA(1, 1), a1 + hstep, voffA);
            PG8_WAIT_L(8); PG8_BAR; PG8_WAIT_L(0); PG8_MMA(0, 0, At, B0); PG8_BAR; PG8_SCHED;
            PG8_LDB(B1, 0, 1); PG8_STAGE(PG8_SB(0, 0), b2, voffB);
            PG8_BAR; PG8_WAIT_L(0); PG8_MMA(0, 1, At, B1); PG8_BAR;
            PG8_LDA(At, 0, 1); PG8_STAGE(PG8_SA(0, 0), a2, voffA);
            PG8_BAR; PG8_WAIT_L(0); PG8_MMA(1, 0, At, B0); PG8_BAR; PG8_SCHED;
            PG8_STAGE(PG8_SB(0, 1), b2 + hstep, voffB);
            PG8_WAIT_V(6); PG8_BAR; PG8_MMA(1, 1, At, B1); PG8_BAR;
            PG8_LDB(B0, 1, 0); PG8_SCHED; PG8_LDA(At, 1, 0); PG8_STAGE(PG8_SA(0, 1), a2 + hstep, voffA);
            PG8_WAIT_L(8); PG8_BAR; PG8_WAIT_L(0); PG8_MMA(0, 0, At, B0); PG8_BAR; PG8_SCHED;
            PG8_LDB(B1, 1, 1); PG8_STAGE(PG8_SB(1, 0), b3, voffB);
            PG8_BAR; PG8_WAIT_L(0); PG8_MMA(0, 1, At, B1); PG8_BAR;
            PG8_LDA(At, 1, 1); PG8_STAGE(PG8_SA(1, 0), a3, voffA);
            PG8_BAR; PG8_WAIT_L(0); PG8_MMA(1, 0, At, B0); PG8_BAR; PG8_SCHED;
            PG8_STAGE(PG8_SB(1, 1), b3 + hstep, voffB);
            PG8_WAIT_V(6); PG8_BAR; PG8_MMA(1, 1, At, B1); PG8_BAR;
            }
        }
        if constexpr (ALIGN_EPI) { if (wr == 0) PG8_BAR; }
        if constexpr (!Epi::AFTER_DRAIN) { E(acc, cur, wr, wc, fr, fq, xlds); S.done(cur); }
        if (!has_next) break;
#pragma unroll
        for (int a = 0; a < 2; ++a)
#pragma unroll
            for (int b = 0; b < 2; ++b)
#pragma unroll
                for (int m = 0; m < 4; ++m)
#pragma unroll
                    for (int n = 0; n < 2; ++n) acc[a][b][m][n] = (f32x4){0.f, 0.f, 0.f, 0.f};
        cur = nxt; cA = nA; cB = nB; ++ui;
        if constexpr (ALIGN_EPI) { if (wr == 1) PG8_BAR; }
    }
    PG8_WAIT_V(0);
    if constexpr (!ALIGN_EPI) { if (wr == 0) PG8_BAR; }
    PG8_BAR;

#undef PG8_SA
#undef PG8_SB
#undef PG8_STAGE
#undef PG8_LDA
#undef PG8_LDB
#undef PG8_MMA
#undef PG8_WAIT_V
#undef PG8_WAIT_L
#undef PG8_BAR
#undef PG8_SCHED
}
}

#define GAS __attribute__((address_space(1)))
#define LAS __attribute__((address_space(3)))
typedef unsigned short bf16;
typedef float f32x4 __attribute__((ext_vector_type(4)));
typedef short bf16x8 __attribute__((ext_vector_type(8)));
typedef unsigned u32x4 __attribute__((ext_vector_type(4)));
typedef unsigned u32x2 __attribute__((ext_vector_type(2)));

constexpr int NWAVES = 8;
constexpr int SEQ = 16384, DMODEL = 2048, NMEM = 256, DIN = 3584, DCONV = 768, DPOOL = 768, DXATT = 512, DFF = 5632, DFF2 = 11264;
constexpr int PGD = 192;
constexpr float EPS = 1e-6f;
constexpr int LDS_BYTES = 147456;
#ifndef MK_PER_PHASE
#define MK_PER_PHASE 0
#endif
constexpr int NPHASE = 7;
#ifndef PHM
#define PHM 255
#endif
#ifndef FUSE_FIXUP
#define FUSE_FIXUP 0
#endif
#ifndef P1_ALIGN
#define P1_ALIGN false
#endif
#ifndef USE_CG_SYNC
#define USE_CG_SYNC 0
#endif
#ifndef PROBE_P2
#define PROBE_P2 0
#endif
#ifndef PROBE_SYNC
#define PROBE_SYNC 0
#endif
#ifndef PROBE_GEMM
#define PROBE_GEMM 0
#endif
#ifndef PROBE_N
#define PROBE_N 2048
#endif
#ifndef REPM
#define REPM 0
#endif

constexpr size_t MiB = 1u << 20;
constexpr size_t WS_KB = 1 * MiB;
constexpr size_t WS_VT = 1 * MiB + 256 * 1024;
constexpr size_t WS_POOLWT = 1 * MiB + 512 * 1024;
constexpr size_t WS_MB = 2 * MiB;
constexpr size_t WS_WKVT = 3 * MiB;
constexpr size_t WS_SIG = 7 * MiB;
constexpr size_t WS_SLAB1 = 8 * MiB;
constexpr size_t WS_SLAB2 = 10 * MiB;
constexpr size_t WS_WUPT = 12 * MiB;
constexpr size_t WS_WDOWNT = 56 * MiB;
constexpr size_t WS_UBND = 80 * MiB;
constexpr size_t WS_X1B = 96 * MiB;
constexpr size_t WS_ACT = 160 * MiB;
constexpr size_t WS_H = 160 * MiB;
constexpr size_t WS_Z = 225 * MiB;
constexpr size_t WS_ZPAD = WS_Z - (size_t)16 * 3584 * 2;
constexpr size_t WS_MIX = 338 * MiB;
constexpr size_t WS_WINT = 402 * MiB;
constexpr size_t WS_WOUTT = 416 * MiB;
constexpr size_t WS_END = 424 * MiB;

__device__ __forceinline__ unsigned f2bf(float f) { unsigned u = __builtin_bit_cast(unsigned, f); return (u + 0x7fffu + ((u >> 16) & 1u)) >> 16; }
__device__ __forceinline__ unsigned pk2(float lo, float hi) { return f2bf(lo) | (f2bf(hi) << 16); }
__device__ __forceinline__ float bflo(unsigned w) { return __builtin_bit_cast(float, w << 16); }
__device__ __forceinline__ float bfhi(unsigned w) { return __builtin_bit_cast(float, w & 0xffff0000u); }
__device__ __forceinline__ void unpack8(const u32x4 w, float (&f)[8]) { f[0] = bflo(w.x); f[1] = bfhi(w.x); f[2] = bflo(w.y); f[3] = bfhi(w.y); f[4] = bflo(w.z); f[5] = bfhi(w.z); f[6] = bflo(w.w); f[7] = bfhi(w.w); }
__device__ __forceinline__ u32x4 pack8(const float (&f)[8]) { u32x4 w; w.x = pk2(f[0], f[1]); w.y = pk2(f[2], f[3]); w.z = pk2(f[4], f[5]); w.w = pk2(f[6], f[7]); return w; }
__device__ __forceinline__ float wave_sum(float v) {
#pragma unroll
    for (int o = 1; o < 64; o <<= 1) v += __shfl_xor(v, o);
    return v;
}
#define LDS_WAIT() asm volatile("s_waitcnt lgkmcnt(0)" ::: "memory")

typedef GAS unsigned gu32;
constexpr size_t WS_CTL = 0, CTL_ZERO_BYTES = 64 * 1024;
constexpr int CW_PANEL2 = 12288;
constexpr int CW_PANEL1 = 8192;
constexpr int CW_PANEL = 4096;
constexpr int MISC_OFF = 131072 + 320;
constexpr int XLDS_OFF = 131072 + 1024;
#define XB_TMO      128
#define XB_XCNT(j)  (256  + 64 * (j))
#define XB_XSUB(j)  (1280 + 64 * (j))
#define XB_XGEN(j)  (2304 + 64 * (j))
#define XB_TOP      3328
#define XB_TOPGEN   3392
#define XCD_BAR_WORDS 3456
#define XB_SPIN_CAP (1u << 18)

__device__ __forceinline__ unsigned xb_ld(unsigned* p)              { return __hip_atomic_load(p, __ATOMIC_RELAXED, __HIP_MEMORY_SCOPE_AGENT); }
__device__ __forceinline__ unsigned xb_add(unsigned* p, unsigned v) { return __hip_atomic_fetch_add(p, v, __ATOMIC_RELAXED, __HIP_MEMORY_SCOPE_AGENT); }
__device__ __forceinline__ unsigned xb_xcc_id() { return (unsigned)__builtin_amdgcn_s_getreg((3 << 11) | 20) & 0xFu; }
#define XB_SPIN(cond, bar) do { unsigned _sp = 0; while (cond) { __builtin_amdgcn_s_sleep(1); \
    if ((++_sp & 255u) == 0u) { if (xb_ld(&(bar)[XB_TMO])) break; if (_sp > XB_SPIN_CAP) { atomicAdd(&(bar)[XB_TMO], 1u); break; } } } } while (0)

struct XcdBarrier {
    unsigned* bar; unsigned x;
    volatile LAS unsigned* st;
};

__device__ __forceinline__ XcdBarrier xcd_barrier_post(unsigned* bar, volatile LAS unsigned* st) {
    XcdBarrier b; b.bar = bar; b.x = xb_xcc_id(); b.st = st;
    if (threadIdx.x == 0) (void)xb_add(&bar[XB_XCNT(b.x)], 1u);
    return b;
}
__device__ __forceinline__ void xcd_barrier_complete(unsigned* bar, unsigned x, unsigned& nloc, unsigned& nx) {
    const unsigned G = gridDim.x * gridDim.y * gridDim.z;
    unsigned sum, cnt, mine, sp = 0u;
    for (;;) {
        sum = 0u; cnt = 0u; mine = 0u;
#pragma unroll
        for (unsigned j = 0; j < 16; ++j) { const unsigned c = xb_ld(&bar[XB_XCNT(j)]); sum += c; cnt += (c > 0u) ? 1u : 0u; mine = (j == x) ? c : mine; }
        if (sum == G) break;
        __builtin_amdgcn_s_sleep(1);
        if ((++sp & 255u) == 0u) { if (xb_ld(&bar[XB_TMO])) break; if (sp > XB_SPIN_CAP) { atomicAdd(&bar[XB_TMO], 1u); break; } }
    }
    nloc = mine > 0u ? mine : 1u; nx = cnt > 0u ? cnt : 1u;
}

__device__ __forceinline__ void xcd_barrier(const XcdBarrier& b) {
    asm volatile("s_waitcnt vmcnt(0)" ::: "memory");
    __syncthreads();
    if (threadIdx.x == 0) {
        unsigned* bar = b.bar;
        __builtin_amdgcn_s_waitcnt(0);
        unsigned nloc = b.st[0], nx = b.st[1];
        if (nloc == 0u) { xcd_barrier_complete(bar, b.x, nloc, nx); b.st[0] = nloc; b.st[1] = nx; }
        const unsigned old = xb_add(&bar[XB_XSUB(b.x)], 1u);
        const unsigned gen = old / nloc;
        if (old + 1u == (gen + 1u) * nloc) {
            __builtin_amdgcn_fence(__ATOMIC_RELEASE, "agent");
            asm volatile("s_waitcnt vmcnt(0)" ::: "memory");
            const unsigned og = xb_add(&bar[XB_TOP], 1u);
            const unsigned tg = og / nx;
            if (og + 1u == (tg + 1u) * nx) xb_add(&bar[XB_TOPGEN], 1u);
            else XB_SPIN(xb_ld(&bar[XB_TOPGEN]) == tg, bar);
            __builtin_amdgcn_fence(__ATOMIC_ACQUIRE, "agent");
            xb_add(&bar[XB_XGEN(b.x)], 1u);
            asm volatile("s_waitcnt vmcnt(0)" ::: "memory");
        } else {
            XB_SPIN(xb_ld(&bar[XB_XGEN(b.x)]) == gen, bar);
            __builtin_amdgcn_fence(__ATOMIC_ACQUIRE, "agent");
            asm volatile("s_waitcnt vmcnt(0)" ::: "memory");
        }
    }
    __syncthreads();
}


struct TrItem { const float* src; const float* ks; bf16* dst; int N, K; };
template <bool UPMAP> __device__ __forceinline__ TrItem tr_make(const float* W, int K, int N, bf16* WT, const float* ks, int item) {
    const int nblk = N / 64, kb = item / nblk, nb = item % nblk, k0 = 64 * kb, n0 = 64 * nb;
    const int r0 = !UPMAP ? n0 : (n0 < DFF ? 256 * (n0 / 128) + (n0 % 128) : 256 * ((n0 - DFF) / 128) + 128 + ((n0 - DFF) % 128));
    TrItem t; t.src = W + (size_t)k0 * N + n0; t.ks = ks ? ks + k0 : nullptr; t.dst = WT + (size_t)r0 * K + k0; t.N = N; t.K = K; return t;
}
__device__ __forceinline__ void tr_load(const TrItem& t, f32x4 (&v)[16], int lane) {
    const float* src = t.src + (size_t)(lane >> 4) * t.N + 4 * (lane & 15);
#pragma unroll
    for (int i = 0; i < 16; ++i) v[i] = *(const f32x4*)(src + (size_t)(4 * i) * t.N);
}
__device__ __forceinline__ void tr_store(const TrItem& t, const f32x4 (&v)[16], LAS float* scr, int lane) {
#pragma unroll
    for (int i = 0; i < 16; ++i) { f32x4 x = v[i]; if (t.ks) x = x * t.ks[4 * i + (lane >> 4)];
        *(LAS f32x4*)(scr + (4 * i + (lane >> 4)) * 64 + (((lane & 15) ^ ((i >> 1) & 7)) << 2)) = x; }
    LDS_WAIT(); asm volatile("" ::: "memory");
    const int c = lane & 7;
#pragma unroll
    for (int j = 0; j < 8; ++j) { const int nn = (lane >> 3) + 8 * j; const LAS float* sp = scr + (8 * c) * 64 + ((((nn >> 2) ^ c) & 15) << 2) + (nn & 3);
        u32x4 o; o.x = pk2(sp[0 * 64], sp[1 * 64]); o.y = pk2(sp[2 * 64], sp[3 * 64]); o.z = pk2(sp[4 * 64], sp[5 * 64]); o.w = pk2(sp[6 * 64], sp[7 * 64]);
        *(u32x4*)(t.dst + (size_t)nn * t.K + 8 * c) = o; }
    LDS_WAIT(); asm volatile("" ::: "memory");
}
__device__ __forceinline__ void rms_rows2_to_bf16(const float* xa, const float* xb, const float* g, bf16* oa, bf16* ob, int lane) {
    const f32x4* pa = (const f32x4*)xa + lane; const f32x4* pb = (const f32x4*)xb + lane; const f32x4* gr = (const f32x4*)g + lane;
    f32x4 va[8], vb[8]; float sa = 0.f, sb = 0.f;
#pragma unroll
    for (int j = 0; j < 8; ++j) { va[j] = pa[64 * j]; vb[j] = pb[64 * j]; }
#pragma unroll
    for (int j = 0; j < 8; ++j) { sa += (va[j].x * va[j].x + va[j].y * va[j].y) + (va[j].z * va[j].z + va[j].w * va[j].w); sb += (vb[j].x * vb[j].x + vb[j].y * vb[j].y) + (vb[j].z * vb[j].z + vb[j].w * vb[j].w); }
    const float ra = 1.0f / sqrtf(wave_sum(sa) * (1.0f / DMODEL) + EPS), rb = 1.0f / sqrtf(wave_sum(sb) * (1.0f / DMODEL) + EPS);
    u32x2* qa = (u32x2*)oa + lane; u32x2* qb = (u32x2*)ob + lane;
#pragma unroll
    for (int j = 0; j < 8; ++j) { const f32x4 gg = gr[64 * j]; u32x2 w;
        w.x = pk2(va[j].x * ra * gg.x, va[j].y * ra * gg.y); w.y = pk2(va[j].z * ra * gg.z, va[j].w * ra * gg.w); qa[64 * j] = w;
        w.x = pk2(vb[j].x * rb * gg.x, vb[j].y * rb * gg.y); w.y = pk2(vb[j].z * rb * gg.z, vb[j].w * rb * gg.w); qb[64 * j] = w; }
}

struct Ptrs {
    const float *x, *mem, *g_mix, *g_mem, *w_in, *conv_w, *pool_w, *pool_scale, *w_kv, *w_out, *g_ffn, *w_up, *ffn_conv_w, *ffn_conv_b, *w_down, *g_final;
    float* out; unsigned char* ws;
};

constexpr int UP_ITEMS = (DMODEL / 64) * (DFF2 / 64), DN_ITEMS = (DFF / 64) * (DMODEL / 64);
#ifndef UP_IN_P0
#define UP_IN_P0 4608
#endif
__device__ __forceinline__ void p1_idle_work(const Ptrs& P, LAS unsigned char* lds, int iw, int NIW, int wave, int lane);
template <int LIST> __device__ __forceinline__ TrItem tr_desc(const Ptrs& P, int it) {
    unsigned char* ws = P.ws;
    constexpr int I_IN = (DMODEL / 64) * (DIN / 64), I_OUT = (DMODEL / 64) * (DMODEL / 64), I_KV = (DMODEL / 64) * (1024 / 64), I_PW = (PGD / 64) * (PGD / 64);
    if (LIST == 0) {
        int r = it;
        if (r < I_IN) return tr_make<false>(P.w_in, DMODEL, DIN, (bf16*)(ws + WS_WINT), nullptr, r); r -= I_IN;
        if (r < I_OUT) return tr_make<false>(P.w_out, DMODEL, DMODEL, (bf16*)(ws + WS_WOUTT), nullptr, r); r -= I_OUT;
        if (r < UP_IN_P0) return tr_make<true>(P.w_up, DMODEL, DFF2, (bf16*)(ws + WS_WUPT), P.g_ffn, r); r -= UP_IN_P0;
        if (r < I_KV) return tr_make<false>(P.w_kv, DMODEL, 1024, (bf16*)(ws + WS_WKVT), nullptr, r); r -= I_KV;
        const int g = r / I_PW; r -= g * I_PW;
        return tr_make<false>(P.pool_w + (size_t)g * PGD * PGD, PGD, PGD, (bf16*)(ws + WS_POOLWT) + (size_t)g * PGD * PGD, nullptr, r);
    } else {
        if (it < DN_ITEMS) return tr_make<false>(P.w_down, DFF, DMODEL, (bf16*)(ws + WS_WDOWNT), nullptr, it);
        return tr_make<true>(P.w_up, DMODEL, DFF2, (bf16*)(ws + WS_WUPT), P.g_ffn, UP_IN_P0 + it - DN_ITEMS);
    }
}
template <int LIST> __device__ __forceinline__ void tr_stream(const Ptrs& P, LAS float* scr, int first, int stride, int nitems, int lane) {
    if (first >= nitems) return;
    TrItem cur = tr_desc<LIST>(P, first); f32x4 va[16], vb[16];
    tr_load(cur, va, lane);
    for (int it = first; it < nitems; it += 2 * stride) {
        TrItem nx = cur; const bool h1 = it + stride < nitems; if (h1) { nx = tr_desc<LIST>(P, it + stride); tr_load(nx, vb, lane); }
        tr_store(cur, va, scr, lane);
        if (!h1) break;
        const bool h2 = it + 2 * stride < nitems; if (h2) { cur = tr_desc<LIST>(P, it + 2 * stride); tr_load(cur, va, lane); }
        tr_store(nx, vb, scr, lane);
        if (!h2) break;
    }
}
__device__ __forceinline__ void p0_prologue(const Ptrs& P, LAS unsigned char* lds, int gw, int NGW, int wave, int lane) {
    LAS float* scr = (LAS float*)(lds + wave * 16384);
    unsigned char* ws = P.ws;
    constexpr int NITEMS = (DMODEL / 64) * (DIN / 64) + (DMODEL / 64) * (DMODEL / 64) + UP_IN_P0 + (DMODEL / 64) * (1024 / 64) + 4 * (PGD / 64) * (PGD / 64);
    tr_stream<0>(P, scr, gw, NGW, NITEMS, lane);
    for (int i = gw * 64 + lane; i < 16 * DIN * 2 / 16; i += NGW * 64) ((u32x4*)(ws + WS_ZPAD))[i] = (u32x4){0u, 0u, 0u, 0u};
    for (int m = 2 * gw; m < SEQ; m += 2 * NGW) rms_rows2_to_bf16(P.x + (size_t)m * DMODEL, P.x + (size_t)(m + 1) * DMODEL, P.g_mix, (bf16*)(ws + WS_H) + (size_t)m * DMODEL, (bf16*)(ws + WS_H) + (size_t)(m + 1) * DMODEL, lane);
    for (int m = 2 * gw; m < NMEM; m += 2 * NGW) rms_rows2_to_bf16(P.mem + (size_t)m * DMODEL, P.mem + (size_t)(m + 1) * DMODEL, P.g_mem, (bf16*)(ws + WS_MB) + (size_t)m * DMODEL, (bf16*)(ws + WS_MB) + (size_t)(m + 1) * DMODEL, lane);
}

__device__ __forceinline__ void kv_tile(const Ptrs& P, int tt, int lane) {
    const bf16* mB = (const bf16*)(P.ws + WS_MB); const bf16* wT = (const bf16*)(P.ws + WS_WKVT);
    const int rb = tt >> 6, cb = tt & 63, fr = lane & 15, fq = lane >> 4;
    const bf16* ap = mB + (size_t)(16 * rb + fr) * DMODEL + 8 * fq; const bf16* wp = wT + (size_t)(16 * cb + fr) * DMODEL + 8 * fq;
    const bool kpart = cb < 32;
    f32x4 acc = {0.f, 0.f, 0.f, 0.f};
    bf16x8 a0[8], w0[8], a1[8], w1[8];
#pragma unroll
    for (int i = 0; i < 8; ++i) { a0[i] = *(const bf16x8*)(ap + 32 * i); w0[i] = *(const bf16x8*)(wp + 32 * i); }
#pragma unroll 1
    for (int kb = 0; kb < 8; kb += 2) {
#pragma unroll
        for (int i = 0; i < 8; ++i) { a1[i] = *(const bf16x8*)(ap + 32 * (8 * kb + 8 + i)); w1[i] = *(const bf16x8*)(wp + 32 * (8 * kb + 8 + i)); }
#pragma unroll
        for (int i = 0; i < 8; ++i) acc = kpart ? __builtin_amdgcn_mfma_f32_16x16x32_bf16(w0[i], a0[i], acc, 0, 0, 0) : __builtin_amdgcn_mfma_f32_16x16x32_bf16(a0[i], w0[i], acc, 0, 0, 0);
        if (kb + 2 < 8) {
#pragma unroll
            for (int i = 0; i < 8; ++i) { a0[i] = *(const bf16x8*)(ap + 32 * (8 * kb + 16 + i)); w0[i] = *(const bf16x8*)(wp + 32 * (8 * kb + 16 + i)); } }
#pragma unroll
        for (int i = 0; i < 8; ++i) acc = kpart ? __builtin_amdgcn_mfma_f32_16x16x32_bf16(w1[i], a1[i], acc, 0, 0, 0) : __builtin_amdgcn_mfma_f32_16x16x32_bf16(a1[i], w1[i], acc, 0, 0, 0);
    }
    u32x2 o; o.x = pk2(acc[0], acc[1]); o.y = pk2(acc[2], acc[3]);
    if (kpart) *(u32x2*)((bf16*)(P.ws + WS_KB) + (size_t)(16 * rb + fr) * 512 + 16 * cb + 4 * fq) = o;
    else *(u32x2*)((bf16*)(P.ws + WS_VT) + (size_t)(16 * cb - 512 + fr) * 256 + 32 * (rb >> 1) + 8 * fq + 4 * (rb & 1)) = o;
}

__device__ __forceinline__ void p1_idle_work(const Ptrs& P, LAS unsigned char* lds, int iw, int NIW, int wave, int lane) {
    LAS float* scr = (LAS float*)(lds + wave * 16384);
    for (int tt = iw; tt < 1024; tt += NIW) kv_tile(P, tt, lane);
    tr_stream<1>(P, scr, iw, NIW, DN_ITEMS + (UP_ITEMS - UP_IN_P0), lane);
}

__device__ __forceinline__ void mix_conv_task(const Ptrs& P, int blk, int lane, int cg0, int cg1) {
    const bf16* z = (const bf16*)(P.ws + WS_Z); bf16* mix = (bf16*)(P.ws + WS_MIX);
    const int t0 = blk * 16;
    for (int cg = cg0 + lane; cg < cg1; cg += 64) {
        const int c = cg * 8;
        float w0[8], w1[8], w2[8], p1[8], p2[8];
#pragma unroll
        for (int e = 0; e < 8; ++e) { w0[e] = P.conv_w[c + e]; w1[e] = P.conv_w[DCONV + c + e]; w2[e] = P.conv_w[2 * DCONV + c + e]; }
        { float a[8], b[8]; unpack8(*(const u32x4*)(z + (long)(t0 - 2) * DIN + DCONV + c), a); unpack8(*(const u32x4*)(z + (long)(t0 - 2) * DIN + 2 * DCONV + c), b);
#pragma unroll
          for (int e = 0; e < 8; ++e) p2[e] = a[e] * b[e];
          unpack8(*(const u32x4*)(z + (long)(t0 - 1) * DIN + DCONV + c), a); unpack8(*(const u32x4*)(z + (long)(t0 - 1) * DIN + 2 * DCONV + c), b);
#pragma unroll
          for (int e = 0; e < 8; ++e) p1[e] = a[e] * b[e]; }
#pragma unroll 4
        for (int r = 0; r < 16; ++r) {
            const int t = t0 + r; float p[8], a[8], b[8], g[8], o[8];
            unpack8(*(const u32x4*)(z + (size_t)t * DIN + DCONV + c), a); unpack8(*(const u32x4*)(z + (size_t)t * DIN + 2 * DCONV + c), b); unpack8(*(const u32x4*)(z + (size_t)t * DIN + c), g);
#pragma unroll
            for (int e = 0; e < 8; ++e) { p[e] = a[e] * b[e]; o[e] = g[e] * (w2[e] * p[e] + w1[e] * p1[e] + w0[e] * p2[e]); p2[e] = p1[e]; p1[e] = p[e]; }
            *(u32x4*)(mix + (size_t)t * DMODEL + c) = pack8(o);
        }
    }
}
template <int g> __device__ __forceinline__ void mix_pool_task(const Ptrs& P, int blk, int lane) {
    constexpr int k = 2 << g;
    const char* zu = (const char*)((const bf16*)(P.ws + WS_Z) + (size_t)(blk * 16) * DIN + 3 * DCONV + PGD * g);
    const char* wu = (const char*)((const bf16*)(P.ws + WS_POOLWT) + (size_t)g * PGD * PGD);
    bf16* mix = (bf16*)(P.ws + WS_MIX);
    const int fr = lane & 15, fq = lane >> 4, t = blk * 16 + fr;
    const unsigned zl = (unsigned)(fr * DIN + 8 * fq) * 2u, wl = (unsigned)(fr * PGD + 8 * fq) * 2u;
    const int cnt = (t + 1 < k) ? t + 1 : k; const float inv = 1.0f / (float)cnt;
    f32x4 acc[12];
#pragma unroll
    for (int n = 0; n < 12; ++n) acc[n] = (f32x4){0.f, 0.f, 0.f, 0.f};
#pragma unroll 1
    for (int ks = 0; ks < 6; ++ks) {
        float sum[8], self[8];
        unpack8(*(const u32x4*)(zu + ks * 64 + zl), self);
#pragma unroll
        for (int e = 0; e < 8; ++e) sum[e] = self[e];
#pragma unroll
        for (int j = 1; j < k; ++j) { float v[8]; unpack8(*(const u32x4*)(zu + ks * 64 - (long)j * (DIN * 2) + zl), v);
#pragma unroll
            for (int e = 0; e < 8; ++e) sum[e] += v[e]; }
        float pl[8];
#pragma unroll
        for (int e = 0; e < 8; ++e) pl[e] = sum[e] * inv - self[e];
        const bf16x8 pf = __builtin_bit_cast(bf16x8, pack8(pl));
#pragma unroll
        for (int n = 0; n < 12; ++n) { const bf16x8 wf = *(const bf16x8*)(wu + n * (16 * PGD * 2) + ks * 64 + wl); acc[n] = __builtin_amdgcn_mfma_f32_16x16x32_bf16(wf, pf, acc[n], 0, 0, 0); }
    }
#pragma unroll
    for (int n = 0; n < 12; ++n) { const int d = 16 * n + 4 * fq; const f32x4 sc = *(const f32x4*)(P.pool_scale + PGD * g + d);
        u32x2 o; o.x = pk2(acc[n][0] * sc[0], acc[n][1] * sc[1]); o.y = pk2(acc[n][2] * sc[2], acc[n][3] * sc[3]);
        *(u32x2*)(mix + (size_t)t * DMODEL + DCONV + PGD * g + d) = o; }
}
__device__ __forceinline__ void mix_attn_task(const Ptrs& P, int h, int blk, int lane) {
    const bf16* z = (const bf16*)(P.ws + WS_Z); bf16* mix = (bf16*)(P.ws + WS_MIX); const bf16* Kb = (const bf16*)(P.ws + WS_KB); const bf16* Vt = (const bf16*)(P.ws + WS_VT);
    const int fr = lane & 15, fq = lane >> 4, t = blk * 16 + fr;
    bf16x8 qf[4];
#pragma unroll
    for (int ks = 0; ks < 4; ++ks) qf[ks] = *(const bf16x8*)(z + (size_t)t * DIN + 3 * DCONV + DPOOL + 128 * h + 32 * ks + 8 * fq);
    f32x4 s[16];
#pragma unroll
    for (int kb = 0; kb < 16; ++kb) { s[kb] = (f32x4){0.f, 0.f, 0.f, 0.f};
#pragma unroll
        for (int ks = 0; ks < 4; ++ks) { const bf16x8 kf = *(const bf16x8*)(Kb + (size_t)(16 * kb + fr) * 512 + 128 * h + 32 * ks + 8 * fq); s[kb] = __builtin_amdgcn_mfma_f32_16x16x32_bf16(kf, qf[ks], s[kb], 0, 0, 0); } }
    float mx = -3.0e38f;
#pragma unroll
    for (int kb = 0; kb < 16; ++kb) mx = fmaxf(fmaxf(fmaxf(s[kb][0], s[kb][1]), fmaxf(s[kb][2], s[kb][3])), mx);
    mx = fmaxf(mx, __shfl_xor(mx, 16)); mx = fmaxf(mx, __shfl_xor(mx, 32));
    const float c2 = 0.08838834764831845f * 1.4426950408889634f;
    float sum = 0.f;
#pragma unroll
    for (int kb = 0; kb < 16; ++kb)
#pragma unroll
        for (int r = 0; r < 4; ++r) { const float p = __builtin_amdgcn_exp2f((s[kb][r] - mx) * c2); s[kb][r] = p; sum += p; }
    sum += __shfl_xor(sum, 16); sum += __shfl_xor(sum, 32);
    const float inv = 1.0f / sum;
    f32x4 o[8];
#pragma unroll
    for (int db = 0; db < 8; ++db) o[db] = (f32x4){0.f, 0.f, 0.f, 0.f};
#pragma unroll
    for (int ks = 0; ks < 8; ++ks) {
        u32x4 pw; pw.x = pk2(s[2 * ks][0], s[2 * ks][1]); pw.y = pk2(s[2 * ks][2], s[2 * ks][3]); pw.z = pk2(s[2 * ks + 1][0], s[2 * ks + 1][1]); pw.w = pk2(s[2 * ks + 1][2], s[2 * ks + 1][3]);
        const bf16x8 pf = __builtin_bit_cast(bf16x8, pw);
#pragma unroll
        for (int db = 0; db < 8; ++db) { const bf16x8 vf = *(const bf16x8*)(Vt + (size_t)(128 * h + 16 * db + fr) * 256 + 32 * ks + 8 * fq); o[db] = __builtin_amdgcn_mfma_f32_16x16x32_bf16(vf, pf, o[db], 0, 0, 0); }
    }
#pragma unroll
    for (int db = 0; db < 8; ++db) { u32x2 w; w.x = pk2(o[db][0] * inv, o[db][1] * inv); w.y = pk2(o[db][2] * inv, o[db][3] * inv);
        *(u32x2*)(mix + (size_t)t * DMODEL + DCONV + DPOOL + 128 * h + 16 * db + 4 * fq) = w; }
}
template <int R, int C, int PCH> __device__ __forceinline__ void lds_stage_rows(LAS unsigned char* dst, const unsigned char* src, int gp, int tid) {
    constexpr int N = R * C, PER = (N + 511) / 512;
    u32x4 v[PER];
#pragma unroll
    for (int i = 0; i < PER; ++i) { const int idx = tid + 512 * i; if (idx < N) { const int row = idx / C, ch = idx % C; v[i] = *(const u32x4*)(src + (size_t)row * gp + ch * 16); } }
#pragma unroll
    for (int i = 0; i < PER; ++i) { const int idx = tid + 512 * i; if (idx < N) { const int row = idx / C, ch = idx % C; *(LAS u32x4*)(dst + row * (PCH * 16) + (((ch & ~15) | ((ch & 15) ^ (row & 15))) << 4)) = v[i]; } }
}
template <int N> __device__ __forceinline__ float dpp_shrN(float old, float src) { return __builtin_bit_cast(float, __builtin_amdgcn_update_dpp(__builtin_bit_cast(int, old), __builtin_bit_cast(int, src), 0x110 + N, 0xf, 0xf, false)); }
template <int N> __device__ __forceinline__ float dpp_rorN(float src) { return __builtin_bit_cast(float, __builtin_amdgcn_mov_dpp(__builtin_bit_cast(int, src), 0x120 + N, 0xf, 0xf, false)); }
template <int N> __device__ __forceinline__ float scan_step(float x, float p) { return x + dpp_shrN<N>(dpp_rorN<N>(p), x); }
template <int N> __device__ __forceinline__ float scan_step_prev(float p) { return p + dpp_shrN<N>(0.f, p); }

__device__ __forceinline__ void mix_attn_wave(const Ptrs& P, LAS unsigned char* ldsK, LAS unsigned char* ldsV, int h, int row0, int lane) {
    const bf16* z = (const bf16*)(P.ws + WS_Z); bf16* mix = (bf16*)(P.ws + WS_MIX);
    const int fr = lane & 15, fq = lane >> 4;
    bf16x8 q0[4], q1[4];
#pragma unroll
    for (int ks = 0; ks < 4; ++ks) { const bf16* qp = z + (size_t)(row0 + fr) * DIN + 3 * DCONV + DPOOL + 128 * h + 32 * ks + 8 * fq; q0[ks] = *(const bf16x8*)qp; q1[ks] = *(const bf16x8*)(qp + 16 * DIN); }
    unsigned offk[4];
#pragma unroll
    for (int ks = 0; ks < 4; ++ks) offk[ks] = (unsigned)(fr * 256 + (((4 * ks + fq) ^ fr) << 4));
    f32x4 s0[16], s1[16];
#pragma unroll
    for (int kb = 0; kb < 16; ++kb) { s0[kb] = (f32x4){0.f, 0.f, 0.f, 0.f}; s1[kb] = (f32x4){0.f, 0.f, 0.f, 0.f};
#pragma unroll
        for (int ks = 0; ks < 4; ++ks) { const bf16x8 kf = *(const LAS bf16x8*)(ldsK + kb * 4096 + offk[ks]);
            s0[kb] = __builtin_amdgcn_mfma_f32_16x16x32_bf16(kf, q0[ks], s0[kb], 0, 0, 0); s1[kb] = __builtin_amdgcn_mfma_f32_16x16x32_bf16(kf, q1[ks], s1[kb], 0, 0, 0); } }
    const float c2 = 0.08838834764831845f * 1.4426950408889634f;
    bf16x8 p0[8], p1[8]; float inv0, inv1;
    {   float mx = -3.0e38f;
#pragma unroll
        for (int kb = 0; kb < 16; ++kb) mx = fmaxf(fmaxf(fmaxf(s0[kb][0], s0[kb][1]), fmaxf(s0[kb][2], s0[kb][3])), mx);
        mx = fmaxf(mx, __shfl_xor(mx, 16)); mx = fmaxf(mx, __shfl_xor(mx, 32));
        float sum = 0.f;
#pragma unroll
        for (int ks = 0; ks < 8; ++ks) { float e[8];
#pragma unroll
            for (int r = 0; r < 4; ++r) { e[r] = __builtin_amdgcn_exp2f((s0[2 * ks][r] - mx) * c2); e[4 + r] = __builtin_amdgcn_exp2f((s0[2 * ks + 1][r] - mx) * c2); }
            sum += ((e[0] + e[1]) + (e[2] + e[3])) + ((e[4] + e[5]) + (e[6] + e[7]));
            p0[ks] = __builtin_bit_cast(bf16x8, pack8(e)); }
        sum += __shfl_xor(sum, 16); sum += __shfl_xor(sum, 32); inv0 = 1.0f / sum; }
    {   float mx = -3.0e38f;
#pragma unroll
        for (int kb = 0; kb < 16; ++kb) mx = fmaxf(fmaxf(fmaxf(s1[kb][0], s1[kb][1]), fmaxf(s1[kb][2], s1[kb][3])), mx);
        mx = fmaxf(mx, __shfl_xor(mx, 16)); mx = fmaxf(mx, __shfl_xor(mx, 32));
        float sum = 0.f;
#pragma unroll
        for (int ks = 0; ks < 8; ++ks) { float e[8];
#pragma unroll
            for (int r = 0; r < 4; ++r) { e[r] = __builtin_amdgcn_exp2f((s1[2 * ks][r] - mx) * c2); e[4 + r] = __builtin_amdgcn_exp2f((s1[2 * ks + 1][r] - mx) * c2); }
            sum += ((e[0] + e[1]) + (e[2] + e[3])) + ((e[4] + e[5]) + (e[6] + e[7]));
            p1[ks] = __builtin_bit_cast(bf16x8, pack8(e)); }
        sum += __shfl_xor(sum, 16); sum += __shfl_xor(sum, 32); inv1 = 1.0f / sum; }
    f32x4 o0[8], o1[8];
#pragma unroll
    for (int db = 0; db < 8; ++db) { o0[db] = (f32x4){0.f, 0.f, 0.f, 0.f}; o1[db] = (f32x4){0.f, 0.f, 0.f, 0.f}; }
#pragma unroll
    for (int ks = 0; ks < 8; ++ks) {
        const unsigned offv = (unsigned)(fr * 512 + ((ks >> 2) << 8) + (((4 * (ks & 3) + fq) ^ fr) << 4));
#pragma unroll
        for (int db = 0; db < 8; ++db) { const bf16x8 vf = *(const LAS bf16x8*)(ldsV + db * 8192 + offv);
            o0[db] = __builtin_amdgcn_mfma_f32_16x16x32_bf16(vf, p0[ks], o0[db], 0, 0, 0); o1[db] = __builtin_amdgcn_mfma_f32_16x16x32_bf16(vf, p1[ks], o1[db], 0, 0, 0); } }
    bf16* op = mix + (size_t)(row0 + fr) * DMODEL + DCONV + DPOOL + 128 * h + 4 * fq;
#pragma unroll
    for (int db = 0; db < 8; ++db) { u32x2 w; w.x = pk2(o0[db][0] * inv0, o0[db][1] * inv0); w.y = pk2(o0[db][2] * inv0, o0[db][3] * inv0); *(u32x2*)(op + 16 * db) = w;
        w.x = pk2(o1[db][0] * inv1, o1[db][1] * inv1); w.y = pk2(o1[db][2] * inv1, o1[db][3] * inv1); *(u32x2*)(op + (size_t)16 * DMODEL + 16 * db) = w; }
}

template <int g> __device__ __forceinline__ void mix_pool_wave(const Ptrs& P, LAS unsigned char* ldsW, int row0, int lane) {
    constexpr int k = 2 << g;
    const bf16* z = (const bf16*)(P.ws + WS_Z); bf16* mix = (bf16*)(P.ws + WS_MIX);
    const int fr = lane & 15, fq = lane >> 4;
    f32x4 acc0[12], acc1[12];
#pragma unroll
    for (int n = 0; n < 12; ++n) { acc0[n] = (f32x4){0.f, 0.f, 0.f, 0.f}; acc1[n] = (f32x4){0.f, 0.f, 0.f, 0.f}; }
    const float invA = 1.0f / (float)((row0 + fr + 1 < k) ? row0 + fr + 1 : k), invB = 1.0f / (float)((row0 + 16 + fr + 1 < k) ? row0 + 16 + fr + 1 : k);
#pragma unroll 1
    for (int ks = 0; ks < 6; ++ks) {
        const bf16* zp = z + (long)(row0 - 16 + fr) * DIN + 3 * DCONV + PGD * g + 32 * ks + 8 * fq;
        float pv[8], xa[8], xb[8], sa[8], sb[8];
        unpack8(*(const u32x4*)zp, pv); unpack8(*(const u32x4*)(zp + 16 * DIN), xa); unpack8(*(const u32x4*)(zp + 32 * DIN), xb);
#pragma unroll
        for (int e = 0; e < 8; ++e) {
            float p = pv[e], a = xa[e], b = xb[e];
            float b1 = scan_step<1>(b, a), a1 = scan_step<1>(a, p), p1 = scan_step_prev<1>(p);
            if (k >= 4) { const float b2 = scan_step<2>(b1, a1), a2 = scan_step<2>(a1, p1), p2 = scan_step_prev<2>(p1); b1 = b2; a1 = a2; p1 = p2; }
            if (k >= 8) { const float b2 = scan_step<4>(b1, a1), a2 = scan_step<4>(a1, p1), p2 = scan_step_prev<4>(p1); b1 = b2; a1 = a2; p1 = p2; }
            if (k >= 16) { const float b2 = scan_step<8>(b1, a1), a2 = scan_step<8>(a1, p1); b1 = b2; a1 = a2; }
            sa[e] = a1 * invA - a; sb[e] = b1 * invB - b; }
        const bf16x8 fa = __builtin_bit_cast(bf16x8, pack8(sa)), fb = __builtin_bit_cast(bf16x8, pack8(sb));
        const unsigned offw = (unsigned)(fr * 512 + ((ks >> 2) << 8) + (((4 * (ks & 3) + fq) ^ fr) << 4));
#pragma unroll
        for (int n = 0; n < 12; ++n) { const bf16x8 wf = *(const LAS bf16x8*)(ldsW + n * 8192 + offw);
            acc0[n] = __builtin_amdgcn_mfma_f32_16x16x32_bf16(wf, fa, acc0[n], 0, 0, 0); acc1[n] = __builtin_amdgcn_mfma_f32_16x16x32_bf16(wf, fb, acc1[n], 0, 0, 0); }
    }
    bf16* op = mix + (size_t)(row0 + fr) * DMODEL + DCONV + PGD * g + 4 * fq;
#pragma unroll
    for (int n = 0; n < 12; ++n) { const f32x4 sc = *(const f32x4*)(P.pool_scale + PGD * g + 16 * n + 4 * fq);
        u32x2 o; o.x = pk2(acc0[n][0] * sc[0], acc0[n][1] * sc[1]); o.y = pk2(acc0[n][2] * sc[2], acc0[n][3] * sc[3]); *(u32x2*)(op + 16 * n) = o;
        o.x = pk2(acc1[n][0] * sc[0], acc1[n][1] * sc[1]); o.y = pk2(acc1[n][2] * sc[2], acc1[n][3] * sc[3]); *(u32x2*)(op + (size_t)16 * DMODEL + 16 * n) = o; }
}

__device__ __forceinline__ void p2_mixer(const Ptrs& P, LAS unsigned char* lds, int w, int tid, int wave, int lane, int tmask) {
    const int sub = w & 3, tile = w >> 2, row0 = tile * 256 + (wave & 3) * 64;
    lds_stage_rows<256, 16, 16>(lds, (const unsigned char*)(P.ws + WS_KB) + 256 * sub, 1024, tid);
    lds_stage_rows<128, 32, 32>(lds + 65536, (const unsigned char*)(P.ws + WS_VT) + (size_t)sub * 128 * 512, 512, tid);
    LDS_WAIT(); __syncthreads();
    if (wave < 4) { if (tmask & 0x1e0) {
#pragma unroll 1
        for (int p = 0; p < 2; ++p) { asm volatile("" ::: "memory"); mix_attn_wave(P, lds, lds + 65536, sub, row0 + 32 * p, lane); } } }
    else if (tmask & 1) mix_conv_task(P, 4 * w + (wave - 4), lane, 0, 48);
    __syncthreads();
    lds_stage_rows<192, 24, 32>(lds, (const unsigned char*)(P.ws + WS_POOLWT) + (size_t)sub * PGD * PGD * 2, PGD * 2, tid);
    LDS_WAIT(); __syncthreads();
    if (wave < 4) { if (tmask & 0x1e) {
#pragma unroll 1
        for (int p = 0; p < 2; ++p) { const int r = row0 + 32 * p; asm volatile("" ::: "memory");
            if (sub == 0) mix_pool_wave<0>(P, lds, r, lane); else if (sub == 1) mix_pool_wave<1>(P, lds, r, lane); else if (sub == 2) mix_pool_wave<2>(P, lds, r, lane); else mix_pool_wave<3>(P, lds, r, lane); } } }
    else if (tmask & 1) mix_conv_task(P, 4 * w + (wave - 4), lane, 48, 96);
    __syncthreads();
}

__device__ __forceinline__ void p5_fix_item(const Ptrs& P, int pm, int c) {
    const float* ub = (const float*)(P.ws + WS_UBND); bf16* act = (bf16*)(P.ws + WS_ACT); const float* cw = P.ffn_conv_w; const float* cb = P.ffn_conv_b;
    const int gi = 256 * (c / 128) + (c % 128);
    const float* p2 = ub + (size_t)((pm - 1) * 4 + 2) * DFF2 + gi; const float* p1 = p2 + DFF2; const float* r0 = ub + (size_t)(pm * 4) * DFF2 + gi; const float* r1 = r0 + DFF2;
    float o0[8], o1[8];
#pragma unroll
    for (int e = 0; e < 8; ++e) {
        const float gw0 = cw[c + e], gw1 = cw[DFF2 + c + e], gw2 = cw[2 * DFF2 + c + e], gb = cb[c + e], vw0 = cw[DFF + c + e], vw1 = cw[DFF2 + DFF + c + e], vw2 = cw[2 * DFF2 + DFF + c + e], vb = cb[DFF + c + e];
        const float G0 = gw2 * r0[e] + (gw1 * p1[e] + (gw0 * p2[e] + gb)), V0 = vw2 * r0[128 + e] + (vw1 * p1[128 + e] + (vw0 * p2[128 + e] + vb));
        const float G1 = gw2 * r1[e] + (gw1 * r0[e] + (gw0 * p1[e] + gb)), V1 = vw2 * r1[128 + e] + (vw1 * r0[128 + e] + (vw0 * p1[128 + e] + vb));
        o0[e] = G0 * __builtin_amdgcn_rcpf(1.0f + __builtin_amdgcn_exp2f(-1.4426950408889634f * G0)) * V0;
        o1[e] = G1 * __builtin_amdgcn_rcpf(1.0f + __builtin_amdgcn_exp2f(-1.4426950408889634f * G1)) * V1; }
    *(u32x4*)(act + (size_t)(256 * pm) * DFF + c) = pack8(o0); *(u32x4*)(act + (size_t)(256 * pm + 1) * DFF + c) = pack8(o1);
}
__device__ __forceinline__ void p6_fixup_panels(const Ptrs& P, int vcu, int G, int tid, unsigned* cnt, unsigned* tmo) {
    constexpr int GRP = DFF / 8 / 8;
    const int nround = (512 + G - 1) / G;
    for (int i = 0; i < nround; ++i) { const int L = i * G + vcu; if (L >= 512) break; const int pm = L >> 3, pn = L & 7;
        if (pm > 0 && tid < GRP) p5_fix_item(P, pm, (pn * GRP + tid) * 8); }
    asm volatile("s_waitcnt vmcnt(0)" ::: "memory"); __syncthreads();
    if (tid == 0) {
        __builtin_amdgcn_fence(__ATOMIC_RELEASE, "agent"); asm volatile("s_waitcnt vmcnt(0)" ::: "memory");
        for (int i = 0; i < nround; ++i) { const int L = i * G + vcu; if (L >= 512) break; __hip_atomic_fetch_add(cnt + 64 * (L >> 3), 1u, __ATOMIC_RELAXED, __HIP_MEMORY_SCOPE_AGENT); }
        for (int i = 0; i < nround; ++i) { const int L = i * G + vcu; if (L >= 512) break; unsigned spins = 0;
            while (__hip_atomic_load(cnt + 64 * (L >> 3), __ATOMIC_RELAXED, __HIP_MEMORY_SCOPE_AGENT) < 8u) { __builtin_amdgcn_s_sleep(2); if (++spins > (1u << 20)) { __hip_atomic_store(tmo, 1u, __ATOMIC_RELAXED, __HIP_MEMORY_SCOPE_AGENT); break; } } }
        __builtin_amdgcn_fence(__ATOMIC_ACQUIRE, "agent"); asm volatile("s_waitcnt vmcnt(0)" ::: "memory");
    }
    __syncthreads();
}
__device__ __forceinline__ void p5_fixup(const Ptrs& P, int gt, int NGT) {
    for (int i = gt; i < 63 * (DFF / 8); i += NGT) p5_fix_item(P, 1 + i / (DFF / 8), (i % (DFF / 8)) * 8);
}

__device__ __forceinline__ void p7_final(const Ptrs& P, int gw, int NGW, int lane) {
    const float* slab = (const float*)(P.ws + WS_SLAB2);
    for (int m = gw; m < SEQ; m += NGW) {
        const float part = (lane < 32) ? slab[(size_t)m * 32 + lane] : 0.f;
        const float rstd = 1.0f / sqrtf(wave_sum(part) * (1.0f / DMODEL) + EPS);
        f32x4* xr = (f32x4*)(P.out + (size_t)m * DMODEL) + lane; const f32x4* gr = (const f32x4*)P.g_final + lane;
#pragma unroll
        for (int j = 0; j < 8; ++j) { f32x4 v = xr[64 * j]; const f32x4 gg = gr[64 * j]; v = v * rstd * gg; xr[64 * j] = v; }
    }
}

struct Args { const float* in[16]; float* out; unsigned char* ws; int ph_lo, ph_hi; };
__global__ void __launch_bounds__(NWAVES * 64, 2) hybrid_fwd(Args args) {
    extern __shared__ __attribute__((aligned(16))) unsigned char lds_raw[];
    LAS unsigned char* lds = (LAS unsigned char*)lds_raw;
    cg::grid_group grid = cg::this_grid();
    const int tid = threadIdx.x, lane = tid & 63, wave = __builtin_amdgcn_readfirstlane(tid >> 6);
    const int G = gridDim.x, bx = blockIdx.x, vcu = (G % 8 == 0) ? (bx % 8) * (G / 8) + bx / 8 : bx;
    const int gw = vcu * NWAVES + wave, NGW = G * NWAVES;
    volatile LAS unsigned* MISC = (volatile LAS unsigned*)(lds + MISC_OFF);
    if (tid < 32) MISC[tid] = 0u;
    __syncthreads();
    const XcdBarrier bar = xcd_barrier_post((unsigned*)(args.ws + WS_CTL), MISC + 8);
    Ptrs P;
    P.x = args.in[0]; P.mem = args.in[1]; P.g_mix = args.in[2]; P.g_mem = args.in[3]; P.w_in = args.in[4]; P.conv_w = args.in[5]; P.pool_w = args.in[6]; P.pool_scale = args.in[7];
    P.w_kv = args.in[8]; P.w_out = args.in[9]; P.g_ffn = args.in[10]; P.w_up = args.in[11]; P.ffn_conv_w = args.in[12]; P.ffn_conv_b = args.in[13]; P.w_down = args.in[14]; P.g_final = args.in[15];
    P.out = args.out; P.ws = args.ws;
    unsigned char* ws = args.ws;
#if PROBE_SYNC
    for (int i = 0; i < 20; ++i) xcd_barrier(bar);
#endif
    const int lo = args.ph_lo, hi = args.ph_hi;
#define IN(k) (lo <= (k) && (k) < hi)
#define SYNC(k) do { if ((k) + 1 < hi) { if ((k) == 0 && USE_CG_SYNC) grid.sync(); else xcd_barrier(bar); } } while (0)
#define SYNCR(k, b) do { if ((k) + 1 < hi || rp + 1 < NREP(b)) { if ((k) == 0 && USE_CG_SYNC) grid.sync(); else xcd_barrier(bar); } } while (0)
#define NREP(b) ((REPM & (b)) ? 2 : 1)
    if (IN(0) && (PHM & 1)) for (int rp = 0; rp < NREP(1); ++rp) { p0_prologue(P, lds, gw, NGW, wave, lane); SYNCR(0, 1); }
    if (IN(1) && (PHM & 2)) for (int rp = 0; rp < NREP(2); ++rp) {
        pg8::Gemm g{(const bf16*)(ws + WS_H), (const bf16*)(ws + WS_WINT), SEQ, DIN, DMODEL}; pg8::StaticOrder S; S.init(SEQ, DIN, G, bx);
        pg8::EpiZ E{(bf16*)(ws + WS_Z), DIN};
        pg8::gemm_phase<pg8::EpiZ, pg8::StaticOrder, P1_ALIGN, true>(lds, g, S, E, lds + XLDS_OFF);
        { const int nfull = ((SEQ / 256) * (DIN / 256)) % G;
          if (nfull == 0) p1_idle_work(P, lds, bx * NWAVES + wave, G * NWAVES, wave, lane);
          else if (bx >= nfull) p1_idle_work(P, lds, (bx - nfull) * NWAVES + wave, (G - nfull) * NWAVES, wave, lane); }
        SYNCR(1, 2);
    }
    if (IN(2) && (PHM & 4)) for (int rp = 0; rp < NREP(4); ++rp) { p2_mixer(P, lds, vcu, tid, wave, lane, 511);
#if PROBE_P2
        p2_mixer(P, lds, vcu, tid, wave, lane, PROBE_P2);
#endif
        SYNCR(2, 4); }
    if (IN(3) && (PHM & 8)) {
        pg8::Gemm g{(const bf16*)(ws + WS_MIX), (const bf16*)(ws + WS_WOUTT), SEQ, DMODEL, DMODEL}; pg8::PanelOrder S{G, vcu, (SEQ / 256) * (DMODEL / 256)};
        pg8::EpiNorm<0> E{P.x, nullptr, nullptr, (float*)(ws + WS_SIG), (bf16*)(ws + WS_X1B), nullptr, nullptr, (unsigned*)(ws + WS_SLAB1), (unsigned*)(ws + WS_CTL) + CW_PANEL1, (unsigned*)(ws + WS_CTL) + XB_TMO};
        pg8::gemm_phase<pg8::EpiNorm<0>, pg8::PanelOrder, true, true>(lds, g, S, E, lds + XLDS_OFF);
        SYNC(3);
    }
#if PROBE_GEMM
    if (IN(3)) {
        pg8::Gemm g{(const bf16*)(ws + WS_X1B), (const bf16*)(ws + WS_WUPT), SEQ, PROBE_N, DMODEL}; pg8::StaticOrder S; S.init(SEQ, PROBE_N, G, bx);
#if PROBE_GEMM == 1
        pg8::EpiZ E{(bf16*)(ws + WS_Z), PROBE_N};
        pg8::gemm_phase<pg8::EpiZ, pg8::StaticOrder, true, true>(lds, g, S, E, lds + XLDS_OFF);
#elif PROBE_GEMM == 2
        pg8::EpiNone E{};
        pg8::gemm_phase<pg8::EpiNone, pg8::StaticOrder, true, true>(lds, g, S, E, lds + XLDS_OFF);
#elif PROBE_GEMM == 3
        pg8::EpiZ E{(bf16*)(ws + WS_Z), PROBE_N};
        pg8::gemm_phase<pg8::EpiZ, pg8::StaticOrder, true, false>(lds, g, S, E, lds + XLDS_OFF);
#elif PROBE_GEMM == 5
        pg8::EpiAct E{(bf16*)(ws + WS_ACT), P.ffn_conv_w, P.ffn_conv_b, (float*)(ws + WS_UBND)};
        pg8::gemm_phase<pg8::EpiAct, pg8::StaticOrder, true, true>(lds, g, S, E, lds + XLDS_OFF);
#elif PROBE_GEMM == 4
        pg8::EpiZ E{(bf16*)(ws + WS_Z), PROBE_N};
        pg8::gemm_phase<pg8::EpiZ, pg8::StaticOrder, false, true>(lds, g, S, E, lds + XLDS_OFF);
#endif
        xcd_barrier(bar);
    }
#endif
    if (IN(4) && (PHM & 16)) for (int rp = 0; rp < NREP(16); ++rp) {
        pg8::Gemm g{(const bf16*)(ws + WS_X1B), (const bf16*)(ws + WS_WUPT), SEQ, DFF2, DMODEL}; pg8::StaticOrder S; S.init(SEQ, DFF2, G, bx);
        pg8::EpiAct E{(bf16*)(ws + WS_ACT), P.ffn_conv_w, P.ffn_conv_b, (float*)(ws + WS_UBND)};
        pg8::gemm_phase<pg8::EpiAct, pg8::StaticOrder, true, true>(lds, g, S, E, lds + XLDS_OFF);
        SYNCR(4, 16);
    }
#if !FUSE_FIXUP
    if (IN(5) && (PHM & 32)) { p5_fixup(P, vcu * (NWAVES * 64) + tid, G * NWAVES * 64); SYNC(5); }
#endif
    if (IN(6) && (PHM & 64)) {
#if FUSE_FIXUP
        p6_fixup_panels(P, vcu, G, tid, (unsigned*)(ws + WS_CTL) + CW_PANEL2, (unsigned*)(ws + WS_CTL) + XB_TMO);
#endif
        pg8::Gemm g{(const bf16*)(ws + WS_ACT), (const bf16*)(ws + WS_WDOWNT), SEQ, DMODEL, DFF}; pg8::PanelOrder S{G, vcu, (SEQ / 256) * (DMODEL / 256)};
        pg8::EpiNorm<1> E{nullptr, (const bf16*)(ws + WS_X1B), (const float*)(ws + WS_SIG), nullptr, nullptr, P.out, P.g_final, (unsigned*)(ws + WS_SLAB2), (unsigned*)(ws + WS_CTL) + CW_PANEL, (unsigned*)(ws + WS_CTL) + XB_TMO};
        pg8::gemm_phase<pg8::EpiNorm<1>, pg8::PanelOrder, true, true>(lds, g, S, E, lds + XLDS_OFF);
    }
#undef IN
#undef SYNC
}

extern "C" void kernel_launch(void* const* d_in, const int* in_sizes, int n_in, void* d_out, int out_size, void* d_ws, size_t ws_size, hipStream_t stream) {
    static int grid = 0;
    if (grid == 0) {
        if (n_in != 16 || in_sizes[0] != SEQ * DMODEL || out_size != SEQ * DMODEL || ws_size < WS_END) { fprintf(stderr, "kernel_launch: unexpected shapes (n_in %d, in0 %d, out %d, ws %zu)\n", n_in, n_in > 0 ? in_sizes[0] : -1, out_size, ws_size); grid = -1; return; }
        int dev = 0, cus = 0, per_cu = 0;
        if (hipGetDevice(&dev) != hipSuccess || hipDeviceGetAttribute(&cus, hipDeviceAttributeMultiprocessorCount, dev) != hipSuccess) { grid = -1; return; }
        if (hipFuncSetAttribute((const void*)hybrid_fwd, hipFuncAttributeMaxDynamicSharedMemorySize, LDS_BYTES) != hipSuccess) { fprintf(stderr, "kernel_launch: hipFuncSetAttribute failed\n"); grid = -1; return; }
        if (hipOccupancyMaxActiveBlocksPerMultiprocessor(&per_cu, (const void*)hybrid_fwd, NWAVES * 64, LDS_BYTES) != hipSuccess || per_cu < 1) { fprintf(stderr, "kernel_launch: occupancy query says %d blocks per CU\n", per_cu); (void)hipGetLastError(); per_cu = 1; }
        grid = cus;
        if (grid != 256) { fprintf(stderr, "kernel_launch: this kernel is laid out for one workgroup on each of 256 CUs (the mixer phase and the row-statistics exchanges assume it); the device reports %d\n", grid); if (grid > 256) grid = 256; }
    }
    if (grid < 0) return;
    if (hipMemsetAsync((char*)d_ws + WS_CTL, 0, CTL_ZERO_BYTES, stream) != hipSuccess) { fprintf(stderr, "kernel_launch: hipMemsetAsync failed\n"); return; }
    Args a{};
    for (int i = 0; i < 16; ++i) a.in[i] = (const float*)d_in[i];
    a.out = (float*)d_out; a.ws = (unsigned char*)d_ws;
#if MK_PER_PHASE
    for (int ph = 0; ph < NPHASE; ++ph) { a.ph_lo = ph; a.ph_hi = ph + 1; hipLaunchKernelGGL(hybrid_fwd, dim3(grid), dim3(NWAVES * 64), LDS_BYTES, stream, a); }
#else
    a.ph_lo = 0; a.ph_hi = NPHASE;
    void* kargs[] = {&a};
    hipError_t e = hipLaunchCooperativeKernel((const void*)hybrid_fwd, dim3(grid), dim3(NWAVES * 64), kargs, LDS_BYTES, stream);
    if (e != hipSuccess) fprintf(stderr, "kernel_launch: cooperative launch failed: %s (grid %d)\n", hipGetErrorString(e), grid);
#endif
}
```

```cpp
#include <hip/hip_runtime.h>
#include <hip/hip_cooperative_groups.h>
#include <cstdio>
#include <cstdint>
namespace cg = cooperative_groups;
#ifndef PG8_PRIO
#define PG8_PRIO 0
#endif
namespace pg8 {
#define PG8_LAS __attribute__((address_space(3)))
typedef unsigned short bf16_t;
typedef short bf16x8 __attribute__((ext_vector_type(8)));
typedef float f32x4 __attribute__((ext_vector_type(4)));
typedef unsigned u32x4 __attribute__((ext_vector_type(4)));
constexpr int BM = 256, BK = 64, HALF = 128, HTB = HALF * BK * 2  , STAGE_BYTES = 8 * HTB, NXCD = 8, WGM = 8;

__host__ __device__ __forceinline__ int lds_byte(int r, int c) { const int st = (r >> 4) * 2 + (c >> 5), rr = r & 15, cc = c & 31, ob = rr * 64 + cc * 2; return st * 1024 + (ob ^ (((ob >> 9) & 1) << 5)); }
__host__ __device__ __forceinline__ void stage_rc(int b, int& R, int& C) { const int st = b / 1024, sb = b % 1024, swz = sb ^ (((sb >> 9) & 1) << 5); R = (st >> 1) * 16 + swz / 64; C = (st & 1) * 32 + (swz % 64) / 2; }
__host__ __device__ __forceinline__ int perm32(int rho) { const int n = rho >> 4, i = rho & 15; return 8 * (i >> 2) + 4 * n + (i & 3); }

struct Unit { int pm, pn; };
struct Gemm { const bf16_t* A; const bf16_t* Bt; int M, N, K; };

struct StaticOrder {
    int nM, nN, nwg, G, c, wgm;
    __host__ __device__ void init(int M, int N, int G_, int c_, int wgm_ = WGM) { nM = M / BM; nN = N / BM; nwg = nM * nN; G = G_; c = c_; wgm = wgm_; }
    __host__ __device__ bool next(int i, Unit& u) const {
        const long L = (long)i * G + c; if (L >= nwg) return false;
        int wgid = (int)L; { const int q = nwg / NXCD, r = nwg % NXCD, xcd = wgid % NXCD, off = wgid / NXCD; wgid = (xcd < r ? xcd * (q + 1) : r * (q + 1) + (xcd - r) * q) + off; }
        const int nig = wgm * nN, gid = wgid / nig, fm = gid * wgm, gsz = (nM - fm) < wgm ? (nM - fm) : wgm;
        u.pm = fm + ((wgid % nig) % gsz); u.pn = (wgid % nig) / gsz; return true;
    }
    __device__ __forceinline__ void a_ready(const Unit&) const {}
    __device__ __forceinline__ void done(const Unit&) const {}
};
__device__ __forceinline__ unsigned cvt_pk_bf16(float lo, float hi) { unsigned r; asm volatile("v_cvt_pk_bf16_f32 %0, %1, %2" : "=v"(r) : "v"(lo), "v"(hi)); return r; }
typedef unsigned u32x2 __attribute__((ext_vector_type(2)));
constexpr int DM = 2048;
constexpr float RMS_EPS = 1e-6f;

struct EpiZ {
    static constexpr bool PERM = true, AFTER_DRAIN = false;
    bf16_t* O; int ldc;
    __device__ __forceinline__ void operator()(const f32x4 (&acc)[2][2][4][2], const Unit& u, int wr, int wc, int fr_, int fq_, PG8_LAS unsigned char*) const {
        int t_ = threadIdx.x; asm volatile("" : "+v"(t_));
        const int fr = t_ & 15, fq = (t_ >> 4) & 3;
        const int row0 = u.pm * BM + wr * 64 + fr, col0 = u.pn * BM + wc * 32 + 8 * fq;
#pragma unroll
        for (int ai = 0; ai < 2; ++ai)
#pragma unroll
            for (int m = 0; m < 4; ++m) { bf16_t* rowp = O + (size_t)(row0 + ai * HALF + m * 16) * ldc + col0;
#pragma unroll
                for (int bj = 0; bj < 2; ++bj) { const f32x4 v0 = acc[ai][bj][m][0], v1 = acc[ai][bj][m][1];
                    u32x4 w; w.x = cvt_pk_bf16(v0[0], v0[1]); w.y = cvt_pk_bf16(v0[2], v0[3]); w.z = cvt_pk_bf16(v1[0], v1[1]); w.w = cvt_pk_bf16(v1[2], v1[3]);
                    *(u32x4*)(rowp + bj * HALF) = w; } }
    }
};

struct EpiNone {
    static constexpr bool PERM = true, AFTER_DRAIN = false;
    __device__ __forceinline__ void operator()(const f32x4 (&acc)[2][2][4][2], const Unit& u, int wr, int wc, int fr, int fq, PG8_LAS unsigned char*) const {
#pragma unroll
        for (int ai = 0; ai < 2; ++ai)
#pragma unroll
            for (int bj = 0; bj < 2; ++bj)
#pragma unroll
                for (int m = 0; m < 4; ++m)
#pragma unroll
                    for (int n = 0; n < 2; ++n) asm volatile("" :: "v"(acc[ai][bj][m][n]));
    }
};
struct EpiResA {
    static constexpr bool PERM = true, AFTER_DRAIN = false;
    const float* R; bf16_t* XB; float* slab;
    __device__ __forceinline__ void operator()(const f32x4 (&acc)[2][2][4][2], const Unit& u, int wr, int wc, int fr_, int fq_, PG8_LAS unsigned char*) const {
        int t_ = threadIdx.x; asm volatile("" : "+v"(t_));
        const int fr = t_ & 15, fq = (t_ >> 4) & 3;
        const int row0 = u.pm * BM + wr * 64 + fr, col0 = u.pn * BM + wc * 32 + 8 * fq;
#pragma unroll
        for (int ai = 0; ai < 2; ++ai) {
            f32x4 r[4][2][2];
#pragma unroll
            for (int m = 0; m < 4; ++m)
#pragma unroll
                for (int bj = 0; bj < 2; ++bj) { const float* p = R + (size_t)(row0 + ai * HALF + m * 16) * DM + col0 + bj * HALF; r[m][bj][0] = *(const f32x4*)p; r[m][bj][1] = *(const f32x4*)(p + 4); }
#pragma unroll
            for (int m = 0; m < 4; ++m) { const int row = row0 + ai * HALF + m * 16; float ss = 0.f;
#pragma unroll
                for (int bj = 0; bj < 2; ++bj) { const f32x4 v0 = acc[ai][bj][m][0] + r[m][bj][0], v1 = acc[ai][bj][m][1] + r[m][bj][1];
                    u32x4 w; w.x = cvt_pk_bf16(v0[0], v0[1]); w.y = cvt_pk_bf16(v0[2], v0[3]); w.z = cvt_pk_bf16(v1[0], v1[1]); w.w = cvt_pk_bf16(v1[2], v1[3]);
                    *(u32x4*)(XB + (size_t)row * DM + col0 + bj * HALF) = w;
                    ss += (v0[0] * v0[0] + v0[1] * v0[1]) + (v0[2] * v0[2] + v0[3] * v0[3]) + (v1[0] * v1[0] + v1[1] * v1[1]) + (v1[2] * v1[2] + v1[3] * v1[3]); }
                ss += __shfl_xor(ss, 16); ss += __shfl_xor(ss, 32);
                if (fq == 0) slab[(size_t)row * 32 + u.pn * 4 + wc] = ss; }
            asm volatile("" ::: "memory"); }
    }
};
struct EpiResB {
    static constexpr bool PERM = true, AFTER_DRAIN = false;
    const bf16_t* RB; float* X; float* slab;
    __device__ __forceinline__ void operator()(const f32x4 (&acc)[2][2][4][2], const Unit& u, int wr, int wc, int fr_, int fq_, PG8_LAS unsigned char*) const {
        int t_ = threadIdx.x; asm volatile("" : "+v"(t_));
        const int fr = t_ & 15, fq = (t_ >> 4) & 3;
        const int row0 = u.pm * BM + wr * 64 + fr, col0 = u.pn * BM + wc * 32 + 8 * fq;
        u32x4 r[2][4][2];
#pragma unroll
        for (int ai = 0; ai < 2; ++ai)
#pragma unroll
            for (int m = 0; m < 4; ++m)
#pragma unroll
                for (int bj = 0; bj < 2; ++bj) r[ai][m][bj] = *(const u32x4*)(RB + (size_t)(row0 + ai * HALF + m * 16) * DM + col0 + bj * HALF);
#pragma unroll
        for (int ai = 0; ai < 2; ++ai)
#pragma unroll
            for (int m = 0; m < 4; ++m) { const int row = row0 + ai * HALF + m * 16; float ss = 0.f;
#pragma unroll
                for (int bj = 0; bj < 2; ++bj) { const u32x4 q = r[ai][m][bj];
                    const f32x4 r0 = {__builtin_bit_cast(float, q.x << 16), __builtin_bit_cast(float, q.x & 0xffff0000u), __builtin_bit_cast(float, q.y << 16), __builtin_bit_cast(float, q.y & 0xffff0000u)};
                    const f32x4 r1 = {__builtin_bit_cast(float, q.z << 16), __builtin_bit_cast(float, q.z & 0xffff0000u), __builtin_bit_cast(float, q.w << 16), __builtin_bit_cast(float, q.w & 0xffff0000u)};
                    const f32x4 v0 = acc[ai][bj][m][0] + r0, v1 = acc[ai][bj][m][1] + r1;
                    float* xp = X + (size_t)row * DM + col0 + bj * HALF; *(f32x4*)xp = v0; *(f32x4*)(xp + 4) = v1;
                    ss += (v0[0] * v0[0] + v0[1] * v0[1]) + (v0[2] * v0[2] + v0[3] * v0[3]) + (v1[0] * v1[0] + v1[1] * v1[1]) + (v1[2] * v1[2] + v1[3] * v1[3]); }
                ss += __shfl_xor(ss, 16); ss += __shfl_xor(ss, 32);
                if (fq == 0) slab[(size_t)row * 32 + u.pn * 4 + wc] = ss; }
    }
};

struct PanelOrder {
    int G, vcu, ntot;
    __device__ __forceinline__ bool next(int i, Unit& u) const { const int L = i * G + vcu; if (L >= ntot) return false; u.pm = L >> 3; u.pn = L & 7; return true; }
    __device__ __forceinline__ void a_ready(const Unit&) const {}
    __device__ __forceinline__ void done(const Unit&) const {}
};
template <int MODE  > struct EpiNorm {
    static constexpr bool PERM = (MODE == 0), AFTER_DRAIN = false;
    const float* Rf; const bf16_t* Rb; const float* sig_in; float* sig_out; bf16_t* HN; float* OUT; const float* gfin; unsigned* xbuf; unsigned* cnt; unsigned* tmo;
    __device__ __forceinline__ void operator()(f32x4 (&acc)[2][2][4][2], const Unit& u, int wr, int wc, int fr_, int fq_, PG8_LAS unsigned char* xlds) const {
        int t_ = threadIdx.x; asm volatile("" : "+v"(t_));
        const int fr = t_ & 15, fq = (t_ >> 4) & 3, wid = __builtin_amdgcn_readfirstlane(t_ >> 6);
        const int rl0 = wr * 64 + fr, row0 = u.pm * BM + rl0, col0 = u.pn * BM + wc * 32 + 8 * fq;
        PG8_LAS float* Pt = (PG8_LAS float*)xlds;
        PG8_LAS float* St = (PG8_LAS float*)(xlds + 4096);
        if constexpr (MODE == 0) {
#pragma unroll
            for (int ai = 0; ai < 2; ++ai) { f32x4 r[4][2][2];
#pragma unroll
                for (int m = 0; m < 4; ++m)
#pragma unroll
                    for (int bj = 0; bj < 2; ++bj) { const float* p = Rf + (size_t)(row0 + ai * HALF + m * 16) * DM + col0 + bj * HALF; r[m][bj][0] = *(const f32x4*)p; r[m][bj][1] = *(const f32x4*)(p + 4); }
#pragma unroll
                for (int m = 0; m < 4; ++m) { float ss = 0.f;
#pragma unroll
                    for (int bj = 0; bj < 2; ++bj) { const f32x4 v0 = acc[ai][bj][m][0] + r[m][bj][0], v1 = acc[ai][bj][m][1] + r[m][bj][1]; acc[ai][bj][m][0] = v0; acc[ai][bj][m][1] = v1;
                        ss += (v0[0] * v0[0] + v0[1] * v0[1]) + (v0[2] * v0[2] + v0[3] * v0[3]) + (v1[0] * v1[0] + v1[1] * v1[1]) + (v1[2] * v1[2] + v1[3] * v1[3]); }
                    ss += __shfl_xor(ss, 16); ss += __shfl_xor(ss, 32);
                    if (fq == 0) Pt[(ai * HALF + rl0 + m * 16) * 4 + wc] = ss; }
                asm volatile("" ::: "memory"); }
        } else { u32x2 r[2][4][2][2]; float sg[2][4]; const int colb = u.pn * BM + wc * 32 + 4 * fq;
#pragma unroll
            for (int ai = 0; ai < 2; ++ai)
#pragma unroll
                for (int m = 0; m < 4; ++m) { sg[ai][m] = sig_in[row0 + ai * HALF + m * 16];
#pragma unroll
                    for (int bj = 0; bj < 2; ++bj)
#pragma unroll
                        for (int n = 0; n < 2; ++n) r[ai][m][bj][n] = *(const u32x2*)(Rb + (size_t)(row0 + ai * HALF + m * 16) * DM + colb + bj * HALF + 16 * n); }
#pragma unroll
            for (int ai = 0; ai < 2; ++ai)
#pragma unroll
                for (int m = 0; m < 4; ++m) { float ss = 0.f; const float sgm = sg[ai][m];
#pragma unroll
                    for (int bj = 0; bj < 2; ++bj)
#pragma unroll
                        for (int n = 0; n < 2; ++n) { const u32x2 q = r[ai][m][bj][n];
                            const f32x4 r0 = {__builtin_bit_cast(float, q.x << 16), __builtin_bit_cast(float, q.x & 0xffff0000u), __builtin_bit_cast(float, q.y << 16), __builtin_bit_cast(float, q.y & 0xffff0000u)};
                            const f32x4 v0 = acc[ai][bj][m][n] + r0 * sgm; acc[ai][bj][m][n] = v0;
                            ss += (v0[0] * v0[0] + v0[1] * v0[1]) + (v0[2] * v0[2] + v0[3] * v0[3]); }
                    ss += __shfl_xor(ss, 16); ss += __shfl_xor(ss, 32);
                    if (fq == 0) Pt[(ai * HALF + rl0 + m * 16) * 4 + wc] = ss; } }
        asm volatile("s_waitcnt lgkmcnt(0)" ::: "memory"); __builtin_amdgcn_s_barrier(); asm volatile("" ::: "memory");
        if (t_ < 256) { const float s = (Pt[t_ * 4 + 0] + Pt[t_ * 4 + 1]) + (Pt[t_ * 4 + 2] + Pt[t_ * 4 + 3]);
            __hip_atomic_store(xbuf + (size_t)(u.pm * BM + t_) * 8 + u.pn, __builtin_bit_cast(unsigned, s), __ATOMIC_RELAXED, __HIP_MEMORY_SCOPE_AGENT); }
        asm volatile("s_waitcnt vmcnt(0)" ::: "memory");
        if (t_ < 256 && (t_ & 63) == 0) __hip_atomic_fetch_add(cnt + 64 * u.pm, 1u, __ATOMIC_RELAXED, __HIP_MEMORY_SCOPE_AGENT);
        if (wid == 0) {
            unsigned spins = 0;
            while ((unsigned)__builtin_amdgcn_readfirstlane(__hip_atomic_load(cnt + 64 * u.pm, __ATOMIC_RELAXED, __HIP_MEMORY_SCOPE_AGENT)) < 32u) {
                __builtin_amdgcn_s_sleep(2);
                if (++spins > (1u << 20)) { if ((t_ & 63) == 0) __hip_atomic_store(tmo, 1u, __ATOMIC_RELAXED, __HIP_MEMORY_SCOPE_AGENT); break; } }
            __builtin_amdgcn_fence(__ATOMIC_ACQUIRE, "agent");
        }
        asm volatile("s_waitcnt vmcnt(0) lgkmcnt(0)" ::: "memory"); __builtin_amdgcn_s_barrier(); asm volatile("" ::: "memory");
        if (t_ < 256) { const unsigned long long* sp = (const unsigned long long*)(xbuf + (size_t)(u.pm * BM + t_) * 8); float tot = 0.f;
#pragma unroll
            for (int q = 0; q < 4; ++q) { const unsigned long long w = __hip_atomic_load(sp + q, __ATOMIC_RELAXED, __HIP_MEMORY_SCOPE_AGENT);
                tot += __builtin_bit_cast(float, (unsigned)w); tot += __builtin_bit_cast(float, (unsigned)(w >> 32)); }
            const float sd = sqrtf(tot * (1.0f / DM) + RMS_EPS);
            St[t_] = 1.0f / sd;
            if (MODE == 0 && u.pn == 0) sig_out[u.pm * BM + t_] = sd; }
        asm volatile("s_waitcnt lgkmcnt(0)" ::: "memory"); __builtin_amdgcn_s_barrier(); asm volatile("" ::: "memory");
        if constexpr (MODE == 0) {
#pragma unroll
            for (int ai = 0; ai < 2; ++ai)
#pragma unroll
                for (int m = 0; m < 4; ++m) { const float rstd = St[ai * HALF + rl0 + m * 16]; bf16_t* op = HN + (size_t)(row0 + ai * HALF + m * 16) * DM + col0;
#pragma unroll
                    for (int bj = 0; bj < 2; ++bj) { const f32x4 v0 = acc[ai][bj][m][0] * rstd, v1 = acc[ai][bj][m][1] * rstd;
                        u32x4 w; w.x = cvt_pk_bf16(v0[0], v0[1]); w.y = cvt_pk_bf16(v0[2], v0[3]); w.z = cvt_pk_bf16(v1[0], v1[1]); w.w = cvt_pk_bf16(v1[2], v1[3]);
                        *(u32x4*)(op + bj * HALF) = w; } }
        } else {
            const int colb = u.pn * BM + wc * 32 + 4 * fq; const bool odd = fr & 1;
            f32x4 gg[2][2];
#pragma unroll
            for (int bj = 0; bj < 2; ++bj)
#pragma unroll
                for (int n = 0; n < 2; ++n) gg[bj][n] = *(const f32x4*)(gfin + colb + bj * HALF + 16 * n);
#pragma unroll
            for (int ai = 0; ai < 2; ++ai)
#pragma unroll
                for (int m = 0; m < 4; ++m) { const float rstd = St[ai * HALF + rl0 + m * 16]; float* op = OUT + (size_t)(row0 + ai * HALF + m * 16) * DM + colb;
#pragma unroll
                    for (int bj = 0; bj < 2; ++bj) {
                        const f32x4 o0 = acc[ai][bj][m][0] * rstd * gg[bj][0], o1 = acc[ai][bj][m][1] * rstd * gg[bj][1]; f32x4 dA, dB;
#pragma unroll
                        for (int j = 0; j < 4; ++j) { const float snd = odd ? o0[j] : o1[j];
                            const float rcv = __builtin_bit_cast(float, __builtin_amdgcn_mov_dpp(__builtin_bit_cast(int, snd), 0xB1, 0xf, 0xf, false));
                            dA[j] = odd ? rcv : o0[j]; dB[j] = odd ? o1[j] : rcv; }
                        float* pp = op + bj * HALF + (odd ? 16 : 0);
                        *(f32x4*)(pp - (odd ? DM : 0)) = dA; *(f32x4*)(pp + (odd ? 0 : DM)) = dB; } }
        }
    }
};

__device__ __forceinline__ float dpp_shr1(float old, float src) { return __builtin_bit_cast(float, __builtin_amdgcn_update_dpp(__builtin_bit_cast(int, old), __builtin_bit_cast(int, src), 0x111, 0xf, 0xf, false)); }
__device__ __forceinline__ float dpp_shr2(float old, float src) { return __builtin_bit_cast(float, __builtin_amdgcn_update_dpp(__builtin_bit_cast(int, old), __builtin_bit_cast(int, src), 0x112, 0xf, 0xf, false)); }
__device__ __forceinline__ float dpp_ror1(float src) { return __builtin_bit_cast(float, __builtin_amdgcn_mov_dpp(__builtin_bit_cast(int, src), 0x121, 0xf, 0xf, false)); }
__device__ __forceinline__ float dpp_ror2(float src) { return __builtin_bit_cast(float, __builtin_amdgcn_mov_dpp(__builtin_bit_cast(int, src), 0x122, 0xf, 0xf, false)); }
constexpr int FF = 5632, FF2 = 11264;
typedef _Float16 h2_t __attribute__((ext_vector_type(2)));
__device__ __forceinline__ unsigned pkh(float a, float b) { return __builtin_bit_cast(unsigned, __builtin_amdgcn_cvt_pkrtz(a, b)); }
__device__ __forceinline__ unsigned dppu_shr1(unsigned old, unsigned src) { return (unsigned)__builtin_amdgcn_update_dpp((int)old, (int)src, 0x111, 0xf, 0xf, false); }
__device__ __forceinline__ unsigned dppu_shr2(unsigned old, unsigned src) { return (unsigned)__builtin_amdgcn_update_dpp((int)old, (int)src, 0x112, 0xf, 0xf, false); }
__device__ __forceinline__ unsigned dppu_ror1(unsigned src) { return (unsigned)__builtin_amdgcn_mov_dpp((int)src, 0x121, 0xf, 0xf, false); }
__device__ __forceinline__ unsigned dppu_ror2(unsigned src) { return (unsigned)__builtin_amdgcn_mov_dpp((int)src, 0x122, 0xf, 0xf, false); }
struct EpiAct {
    static constexpr bool PERM = true, AFTER_DRAIN = false;
    bf16_t* ACT; const float* cw; const float* cb; float* ubnd;
    __device__ __forceinline__ void operator()(f32x4 (&acc)[2][2][4][2], const Unit& u, int wr, int wc, int fr_, int fq_, PG8_LAS unsigned char* xlds) const {
        int t_ = threadIdx.x; asm volatile("" : "+v"(t_));
        const int fr = t_ & 15, fq = (t_ >> 4) & 3;
        const int row0 = u.pm * BM + wr * 64 + fr, cl = wc * 32 + 8 * fq;
        const int c0 = u.pn * 128 + cl;
        f32x4 wgt[2][8];
#pragma unroll
        for (int n = 0; n < 2; ++n) { const float* wp = cw + c0 + 4 * n; const float* bp = cb + c0 + 4 * n;
            wgt[n][0] = *(const f32x4*)wp; wgt[n][1] = *(const f32x4*)(wp + FF2); wgt[n][2] = *(const f32x4*)(wp + 2 * FF2); wgt[n][3] = *(const f32x4*)bp;
            wgt[n][4] = *(const f32x4*)(wp + FF); wgt[n][5] = *(const f32x4*)(wp + FF2 + FF); wgt[n][6] = *(const f32x4*)(wp + 2 * FF2 + FF); wgt[n][7] = *(const f32x4*)(bp + FF); }
        if (wr == 1 && fr >= 14) {
#pragma unroll
            for (int bj = 0; bj < 2; ++bj)
#pragma unroll
                for (int n = 0; n < 2; ++n) *(f32x4*)(ubnd + (size_t)(u.pm * 4 + 2 + (fr - 14)) * FF2 + u.pn * BM + 128 * bj + cl + 4 * n) = acc[1][bj][3][n]; }
        if (wr == 0 && fr < 2) {
#pragma unroll
            for (int bj = 0; bj < 2; ++bj)
#pragma unroll
                for (int n = 0; n < 2; ++n) *(f32x4*)(ubnd + (size_t)(u.pm * 4 + fr) * FF2 + u.pn * BM + 128 * bj + cl + 4 * n) = acc[0][bj][0][n]; }
        u32x4 pk[2][4][2];
#pragma unroll
        for (int ai = 0; ai < 2; ++ai)
#pragma unroll
            for (int m = 0; m < 4; ++m)
#pragma unroll
                for (int n = 0; n < 2; ++n) { const f32x4 g = acc[ai][0][m][n], v = acc[ai][1][m][n]; pk[ai][m][n] = (u32x4){pkh(g[0], v[0]), pkh(g[1], v[1]), pkh(g[2], v[2]), pkh(g[3], v[3])}; }
        if (fr >= 14) {
#pragma unroll
            for (int ai = 0; ai < 2; ++ai)
#pragma unroll
                for (int n = 0; n < 2; ++n) *(PG8_LAS u32x4*)(xlds + ((((2 * ai + wr) * 2 + (fr - 14)) * 128 + cl + 4 * n) << 2)) = pk[ai][3][n]; }
        asm volatile("s_waitcnt lgkmcnt(0)" ::: "memory"); __builtin_amdgcn_s_barrier(); asm volatile("" ::: "memory");
        u32x2 hold[2][4];
#pragma unroll
        for (int n = 0; n < 2; ++n) {
            h2_t w0p[4], w1p[4], w2p[4], bp4[4];
#pragma unroll
            for (int j = 0; j < 4; ++j) { w0p[j] = __builtin_bit_cast(h2_t, pkh(wgt[n][0][j], wgt[n][4][j])); w1p[j] = __builtin_bit_cast(h2_t, pkh(wgt[n][1][j], wgt[n][5][j]));
                w2p[j] = __builtin_bit_cast(h2_t, pkh(wgt[n][2][j], wgt[n][6][j])); bp4[j] = __builtin_bit_cast(h2_t, pkh(wgt[n][3][j], wgt[n][7][j])); }
#pragma unroll
            for (int ai = 0; ai < 2; ++ai) {
                const int chunk = 2 * ai + wr;
                u32x4 pp = {0u, 0u, 0u, 0u};
                if (chunk > 0) pp = *(const PG8_LAS u32x4*)(xlds + ((((chunk - 1) * 2 + (fr & 1)) * 128 + cl + 4 * n) << 2));
#pragma unroll
                for (int m = 0; m < 4; ++m) {
                    const u32x4 cur = pk[ai][m][n]; float a[4];
#pragma unroll
                    for (int j = 0; j < 4; ++j) {
                        const unsigned cj = cur[j], pj = pp[j];
                        const h2_t s1 = __builtin_bit_cast(h2_t, dppu_shr1(dppu_ror1(pj), cj)), s2 = __builtin_bit_cast(h2_t, dppu_shr2(dppu_ror2(pj), cj)), ch = __builtin_bit_cast(h2_t, cj);
                        const h2_t r = w2p[j] * ch + (w1p[j] * s1 + (w0p[j] * s2 + bp4[j]));
                        const float G = (float)r.x, V = (float)r.y;
                        a[j] = G * __builtin_amdgcn_rcpf(1.0f + __builtin_amdgcn_exp2f(-1.4426950408889634f * G)) * V; }
                    u32x2 w; w.x = cvt_pk_bf16(a[0], a[1]); w.y = cvt_pk_bf16(a[2], a[3]);
                    if (n == 0) hold[ai][m] = w;
                    else { u32x4 o; o.x = hold[ai][m].x; o.y = hold[ai][m].y; o.z = w.x; o.w = w.y;
                        if (!(ai == 0 && m == 0 && wr == 0 && u.pm > 0 && fr < 2)) *(u32x4*)(ACT + (size_t)(row0 + ai * HALF + m * 16) * FF + c0) = o; }
                    pp = cur;
                }
            }
        }
    }
};

template <class Epi, class Sched, bool ALIGN_EPI = false, bool SP2 = false>
__device__ __forceinline__ void gemm_phase(PG8_LAS unsigned char* lds, const Gemm g, const Sched& S, const Epi& E, PG8_LAS unsigned char* xlds) {
    const int tid = threadIdx.x, wid = __builtin_amdgcn_readfirstlane(tid >> 6), lane = tid & 63, wr = wid >> 2, wc = wid & 3, fr = lane & 15, fq = lane >> 4;
    const int K = g.K, nt = K / BK;
    unsigned voffA[2], voffB[2];
#pragma unroll
    for (int i = 0; i < 2; ++i) { int R, C; stage_rc(tid * 16 + i * 8192, R, C); const int Rb = Epi::PERM ? ((R & ~31) + perm32(R & 31)) : R;
        voffA[i] = (unsigned)(R * K + C) * 2u; voffB[i] = (unsigned)(Rb * K + C) * 2u; }
    const size_t kstep = (size_t)(BK * 2);
    const size_t hstep = (size_t)HALF * K * 2;
    const size_t tstep = 2 * hstep;
    const unsigned ldsw = (unsigned)wid * 1024u;
    const int aoff = lds_byte(wr * 64 + fr, fq * 8), boff = lds_byte(wc * 32 + fr, fq * 8);
#define PG8_SA(b, h) (((b) * 2 + (h)) * HTB)
#define PG8_SB(b, h) ((4 + (b) * 2 + (h)) * HTB)
#define PG8_STAGE(bufoff, gbase, voff) do { _Pragma("unroll") for (int _i = 0; _i < 2; ++_i) \
        __builtin_amdgcn_global_load_lds((const unsigned*)((const char*)(gbase) + (voff)[_i]), (PG8_LAS unsigned*)(lds + (bufoff) + ldsw + _i * 8192), 16, 0, 0); } while (0)
#define PG8_LDA(dst, b, h) do { _Pragma("unroll") for (int m = 0; m < 4; ++m) _Pragma("unroll") for (int k = 0; k < 2; ++k) dst[m][k] = *(const PG8_LAS bf16x8*)(lds + PG8_SA(b, h) + aoff + m * 2048 + k * 1024); } while (0)
#define PG8_LDB(dst, b, h) do { _Pragma("unroll") for (int n = 0; n < 2; ++n) _Pragma("unroll") for (int k = 0; k < 2; ++k) dst[n][k] = *(const PG8_LAS bf16x8*)(lds + PG8_SB(b, h) + boff + n * 2048 + k * 1024); } while (0)
#define PG8_MMA(ai, bj, At, Bt) do { __builtin_amdgcn_s_setprio(PG8_PRIO); _Pragma("unroll") for (int m = 0; m < 4; ++m) _Pragma("unroll") for (int n = 0; n < 2; ++n) _Pragma("unroll") for (int k = 0; k < 2; ++k) \
        acc[ai][bj][m][n] = __builtin_amdgcn_mfma_f32_16x16x32_bf16(Bt[n][k], At[m][k], acc[ai][bj][m][n], 0, 0, 0); __builtin_amdgcn_s_setprio(0); } while (0)
#define PG8_WAIT_V(n) asm volatile("s_waitcnt vmcnt(" #n ")" ::: "memory")
#define PG8_WAIT_L(n) asm volatile("s_waitcnt lgkmcnt(" #n ")" ::: "memory")
#define PG8_BAR __builtin_amdgcn_s_barrier()
#define PG8_SCHED __builtin_amdgcn_sched_barrier(0)
    Unit cur, nxt; int ui = 0;
    if (!S.next(0, cur)) return;
    f32x4 acc[2][2][4][2];
#pragma unroll
    for (int a = 0; a < 2; ++a)
#pragma unroll
        for (int b = 0; b < 2; ++b)
#pragma unroll
            for (int m = 0; m < 4; ++m)
#pragma unroll
                for (int n = 0; n < 2; ++n) acc[a][b][m][n] = (f32x4){0.f, 0.f, 0.f, 0.f};
    bf16x8 At[4][2], B0[2][2], B1[2][2];
    const char* cA = (const char*)g.A + (size_t)cur.pm * tstep; const char* cB = (const char*)g.Bt + (size_t)cur.pn * tstep;
    S.a_ready(cur);
    if constexpr (SP2) {
        PG8_STAGE(PG8_SB(0, 0), cB, voffB); PG8_STAGE(PG8_SB(0, 1), cB + hstep, voffB); PG8_STAGE(PG8_SA(0, 0), cA, voffA); PG8_STAGE(PG8_SA(0, 1), cA + hstep, voffA);
        if (wr == 1) PG8_BAR;
        PG8_WAIT_V(2); PG8_BAR;
        PG8_STAGE(PG8_SB(1, 0), cB + kstep, voffB); PG8_STAGE(PG8_SA(1, 0), cA + kstep, voffA); PG8_STAGE(PG8_SB(1, 1), cB + hstep + kstep, voffB);
        PG8_WAIT_V(6); PG8_BAR;
    } else {
        PG8_STAGE(PG8_SB(0, 0), cB, voffB); PG8_STAGE(PG8_SA(0, 0), cA, voffA); PG8_STAGE(PG8_SB(0, 1), cB + hstep, voffB); PG8_STAGE(PG8_SA(0, 1), cA + hstep, voffA);
        if (wr == 1) PG8_BAR;
        PG8_WAIT_V(4); PG8_BAR;
        PG8_STAGE(PG8_SB(1, 0), cB + kstep, voffB); PG8_STAGE(PG8_SA(1, 0), cA + kstep, voffA); PG8_STAGE(PG8_SB(1, 1), cB + hstep + kstep, voffB);
        PG8_WAIT_V(6); PG8_BAR;
    }
    for (;;) {
        const bool has_next = S.next(ui + 1, nxt);
        const char* nA = has_next ? (const char*)g.A + (size_t)nxt.pm * tstep : cA; const char* nB = has_next ? (const char*)g.Bt + (size_t)nxt.pn * tstep : cB;
        for (int t = 0; t < nt; t += 2) {
            const bool last = (t == nt - 2);
            const char* a1 = cA + (size_t)(t + 1) * kstep;
            const char* a2 = last ? nA : cA + (size_t)(t + 2) * kstep; const char* b2 = last ? nB : cB + (size_t)(t + 2) * kstep;
            const char* a3 = a2 + kstep; const char* b3 = b2 + kstep;
            if (last && has_next) S.a_ready(nxt);
            if constexpr (SP2) {
            PG8_LDB(B0, 0, 0); PG8_LDB(B1, 0, 1); PG8_SCHED; PG8_LDA(At, 0, 0); PG8_STAGE(PG8_SA(1, 1), a1 + hstep, voffA);
            PG8_WAIT_V(8); PG8_WAIT_L(0); PG8_BAR; PG8_MMA(0, 0, At, B0); PG8_MMA(0, 1, At, B1); PG8_BAR; PG8_SCHED;
            PG8_LDA(At, 0, 1); PG8_STAGE(PG8_SB(0, 0), b2, voffB); PG8_STAGE(PG8_SB(0, 1), b2 + hstep, voffB); PG8_STAGE(PG8_SA(0, 0), a2, voffA);
            PG8_WAIT_V(8); PG8_WAIT_L(0); PG8_BAR; PG8_MMA(1, 0, At, B0); PG8_MMA(1, 1, At, B1); PG8_BAR; PG8_SCHED;
            PG8_LDB(B0, 1, 0); PG8_LDB(B1, 1, 1); PG8_SCHED; PG8_LDA(At, 1, 0); PG8_STAGE(PG8_SA(0, 1), a2 + hstep, voffA);
            PG8_WAIT_V(8); PG8_WAIT_L(0); PG8_BAR; PG8_MMA(0, 0, At, B0); PG8_MMA(0, 1, At, B1); PG8_BAR; PG8_SCHED;
            PG8_LDA(At, 1, 1); PG8_STAGE(PG8_SB(1, 0), b3, voffB); PG8_STAGE(PG8_SB(1, 1), b3 + hstep, voffB); PG8_STAGE(PG8_SA(1, 0), a3, voffA);
            PG8_WAIT_V(8); PG8_WAIT_L(0); PG8_BAR; PG8_MMA(1, 0, At, B0); PG8_MMA(1, 1, At, B1); PG8_BAR; PG8_SCHED;
            } else {
            PG8_LDB(B0, 0, 0); PG8_SCHED; PG8_LDA(At, 0, 0); PG8_STAGE(PG8_SA(1, 1), a1 + hstep, voffA);
            PG8_WAIT_L(8); PG8_BAR; PG8_WAIT_L(0); PG8_MMA(0, 0, At, B0); PG8_BAR; PG8_SCHED;
            PG8_LDB(B1, 0, 1); PG8_STAGE(PG8_SB(0, 0), b2, voffB);
            PG8_BAR; PG8_WAIT_L(0); PG8_MMA(0, 1, At, B1); PG8_BAR;
            PG8_LDA(At, 0, 1); PG8_STAGE(PG8_SA(0, 0), a2, voffA);
            PG8_BAR; PG8_WAIT_L(0); PG8_MMA(1, 0, At, B0); PG8_BAR; PG8_SCHED;
            PG8_STAGE(PG8_SB(0, 1), b2 + hstep, voffB);
            PG8_WAIT_V(6); PG8_BAR; PG8_MMA(1, 1, At, B1); PG8_BAR;
            PG8_LDB(B0, 1, 0); PG8_SCHED; PG8_LDA(At, 1, 0); PG8_STAGE(PG8_SA(0, 1), a2 + hstep, voffA);
            PG8_WAIT_L(8); PG8_BAR; PG8_WAIT_L(0); PG8_MMA(0, 0, At, B0); PG8_BAR; PG8_SCHED;
            PG8_LDB(B1, 1, 1); PG8_STAGE(PG8_SB(1, 0), b3, voffB);
            PG8_BAR; PG8_WAIT_L(0); PG8_MMA(0, 1, At, B1); PG8_BAR;
            PG8_LDA(At, 1, 1); PG8_STAGE(PG8_SA(1, 0), a3, voffA);
            PG8_BAR; PG8_WAIT_L(0); PG8_MMA(1, 0, At, B0); PG8_BAR; PG8_SCHED;
            PG8_STAGE(PG8_SB(1, 1), b3 + hstep, voffB);
            PG8_WAIT_V(6); PG8_BAR; PG8_MMA(1, 1, At, B1); PG8_BAR;
            }
        }
        if constexpr (ALIGN_EPI) { if (wr == 0) PG8_BAR; }
        if constexpr (!Epi::AFTER_DRAIN) { E(acc, cur, wr, wc, fr, fq, xlds); S.done(cur); }
        if (!has_next) break;
#pragma unroll
        for (int a = 0; a < 2; ++a)
#pragma unroll
            for (int b = 0; b < 2; ++b)
#pragma unroll
                for (int m = 0; m < 4; ++m)
#pragma unroll
                    for (int n = 0; n < 2; ++n) acc[a][b][m][n] = (f32x4){0.f, 0.f, 0.f, 0.f};
        cur = nxt; cA = nA; cB = nB; ++ui;
        if constexpr (ALIGN_EPI) { if (wr == 1) PG8_BAR; }
    }
    PG8_WAIT_V(0);
    if constexpr (!ALIGN_EPI) { if (wr == 0) PG8_BAR; }
    PG8_BAR;

#undef PG8_SA
#undef PG8_SB
#undef PG8_STAGE
#undef PG8_LDA
#undef PG8_LDB
#undef PG8_MMA
#undef PG8_WAIT_V
#undef PG8_WAIT_L
#undef PG8_BAR
#undef PG8_SCHED
}
}

#define GAS __attribute__((address_space(1)))
#define LAS __attribute__((address_space(3)))
typedef unsigned short bf16;
typedef float f32x4 __attribute__((ext_vector_type(4)));
typedef short bf16x8 __attribute__((ext_vector_type(8)));
typedef unsigned u32x4 __attribute__((ext_vector_type(4)));
typedef unsigned u32x2 __attribute__((ext_vector_type(2)));

constexpr int NWAVES = 8;
constexpr int SEQ = 16384, DMODEL = 2048, NMEM = 256, DIN = 3584, DCONV = 768, DPOOL = 768, DXATT = 512, DFF = 5632, DFF2 = 11264;
constexpr int PGD = 192;
constexpr float EPS = 1e-6f;
constexpr int LDS_BYTES = 147456;
#ifndef MK_PER_PHASE
#define MK_PER_PHASE 0
#endif
constexpr int NPHASE = 7;
#ifndef PHM
#define PHM 255
#endif
#ifndef FUSE_FIXUP
#define FUSE_FIXUP 0
#endif
#ifndef P1_WGM
#define P1_WGM 4
#endif
#ifndef P4_WGM
#define P4_WGM 4
#endif
#ifndef P1_ALIGN
#define P1_ALIGN false
#endif
#ifndef USE_CG_SYNC
#define USE_CG_SYNC 0
#endif
#ifndef PROBE_P2
#define PROBE_P2 0
#endif
#ifndef PROBE_SYNC
#define PROBE_SYNC 0
#endif
#ifndef PROBE_GEMM
#define PROBE_GEMM 0
#endif
#ifndef PROBE_N
#define PROBE_N 2048
#endif
#ifndef REPM
#define REPM 0
#endif

constexpr size_t MiB = 1u << 20;
constexpr size_t WS_KB = 1 * MiB;
constexpr size_t WS_VT = 1 * MiB + 256 * 1024;
constexpr size_t WS_POOLWT = 1 * MiB + 512 * 1024;
constexpr size_t WS_MB = 2 * MiB;
constexpr size_t WS_WKVT = 3 * MiB;
constexpr size_t WS_SIG = 7 * MiB;
constexpr size_t WS_SLAB1 = 8 * MiB;
constexpr size_t WS_SLAB2 = 10 * MiB;
constexpr size_t WS_WUPT = 12 * MiB;
constexpr size_t WS_WDOWNT = 56 * MiB;
constexpr size_t WS_UBND = 80 * MiB;
constexpr size_t WS_X1B = 96 * MiB;
constexpr size_t WS_ACT = 160 * MiB;
constexpr size_t WS_H = 160 * MiB;
constexpr size_t WS_Z = 225 * MiB;
constexpr size_t WS_ZPAD = WS_Z - (size_t)16 * 3584 * 2;
constexpr size_t WS_MIX = 338 * MiB;
constexpr size_t WS_WINT = 402 * MiB;
constexpr size_t WS_WOUTT = 416 * MiB;
constexpr size_t WS_END = 424 * MiB;

__device__ __forceinline__ unsigned f2bf(float f) { unsigned u = __builtin_bit_cast(unsigned, f); return (u + 0x7fffu + ((u >> 16) & 1u)) >> 16; }
__device__ __forceinline__ unsigned pk2(float lo, float hi) { return f2bf(lo) | (f2bf(hi) << 16); }
__device__ __forceinline__ float bflo(unsigned w) { return __builtin_bit_cast(float, w << 16); }
__device__ __forceinline__ float bfhi(unsigned w) { return __builtin_bit_cast(float, w & 0xffff0000u); }
__device__ __forceinline__ void unpack8(const u32x4 w, float (&f)[8]) { f[0] = bflo(w.x); f[1] = bfhi(w.x); f[2] = bflo(w.y); f[3] = bfhi(w.y); f[4] = bflo(w.z); f[5] = bfhi(w.z); f[6] = bflo(w.w); f[7] = bfhi(w.w); }
__device__ __forceinline__ u32x4 pack8(const float (&f)[8]) { u32x4 w; w.x = pk2(f[0], f[1]); w.y = pk2(f[2], f[3]); w.z = pk2(f[4], f[5]); w.w = pk2(f[6], f[7]); return w; }
__device__ __forceinline__ float wave_sum(float v) {
#pragma unroll
    for (int o = 1; o < 64; o <<= 1) v += __shfl_xor(v, o);
    return v;
}
#define LDS_WAIT() asm volatile("s_waitcnt lgkmcnt(0)" ::: "memory")

typedef GAS unsigned gu32;
constexpr size_t WS_CTL = 0, CTL_ZERO_BYTES = 64 * 1024;
constexpr int CW_PANEL2 = 12288;
constexpr int CW_PANEL1 = 8192;
constexpr int CW_PANEL = 4096;
constexpr int MISC_OFF = 131072 + 320;
constexpr int XLDS_OFF = 131072 + 1024;
#define XB_TMO      128
#define XB_XCNT(j)  (256  + 64 * (j))
#define XB_XSUB(j)  (1280 + 64 * (j))
#define XB_XGEN(j)  (2304 + 64 * (j))
#define XB_TOP      3328
#define XB_TOPGEN   3392
#define XCD_BAR_WORDS 3456
#define XB_SPIN_CAP (1u << 18)

__device__ __forceinline__ unsigned xb_ld(unsigned* p)              { return __hip_atomic_load(p, __ATOMIC_RELAXED, __HIP_MEMORY_SCOPE_AGENT); }
__device__ __forceinline__ unsigned xb_add(unsigned* p, unsigned v) { return __hip_atomic_fetch_add(p, v, __ATOMIC_RELAXED, __HIP_MEMORY_SCOPE_AGENT); }
__device__ __forceinline__ unsigned xb_xcc_id() { return (unsigned)__builtin_amdgcn_s_getreg((3 << 11) | 20) & 0xFu; }
#define XB_SPIN(cond, bar) do { unsigned _sp = 0; while (cond) { __builtin_amdgcn_s_sleep(1); \
    if ((++_sp & 255u) == 0u) { if (xb_ld(&(bar)[XB_TMO])) break; if (_sp > XB_SPIN_CAP) { atomicAdd(&(bar)[XB_TMO], 1u); break; } } } } while (0)

struct XcdBarrier {
    unsigned* bar; unsigned x;
    volatile LAS unsigned* st;
};

__device__ __forceinline__ XcdBarrier xcd_barrier_post(unsigned* bar, volatile LAS unsigned* st) {
    XcdBarrier b; b.bar = bar; b.x = xb_xcc_id(); b.st = st;
    if (threadIdx.x == 0) (void)xb_add(&bar[XB_XCNT(b.x)], 1u);
    return b;
}
__device__ __forceinline__ void xcd_barrier_complete(unsigned* bar, unsigned x, unsigned& nloc, unsigned& nx) {
    const unsigned G = gridDim.x * gridDim.y * gridDim.z;
    unsigned sum, cnt, mine, sp = 0u;
    for (;;) {
        sum = 0u; cnt = 0u; mine = 0u;
#pragma unroll
        for (unsigned j = 0; j < 16; ++j) { const unsigned c = xb_ld(&bar[XB_XCNT(j)]); sum += c; cnt += (c > 0u) ? 1u : 0u; mine = (j == x) ? c : mine; }
        if (sum == G) break;
        __builtin_amdgcn_s_sleep(1);
        if ((++sp & 255u) == 0u) { if (xb_ld(&bar[XB_TMO])) break; if (sp > XB_SPIN_CAP) { atomicAdd(&bar[XB_TMO], 1u); break; } }
    }
    nloc = mine > 0u ? mine : 1u; nx = cnt > 0u ? cnt : 1u;
}

__device__ __forceinline__ void xcd_barrier(const XcdBarrier& b) {
    asm volatile("s_waitcnt vmcnt(0)" ::: "memory");
    __syncthreads();
    if (threadIdx.x == 0) {
        unsigned* bar = b.bar;
        __builtin_amdgcn_s_waitcnt(0);
        unsigned nloc = b.st[0], nx = b.st[1];
        if (nloc == 0u) { xcd_barrier_complete(bar, b.x, nloc, nx); b.st[0] = nloc; b.st[1] = nx; }
        const unsigned old = xb_add(&bar[XB_XSUB(b.x)], 1u);
        const unsigned gen = old / nloc;
        if (old + 1u == (gen + 1u) * nloc) {
            __builtin_amdgcn_fence(__ATOMIC_RELEASE, "agent");
            asm volatile("s_waitcnt vmcnt(0)" ::: "memory");
            const unsigned og = xb_add(&bar[XB_TOP], 1u);
            const unsigned tg = og / nx;
            if (og + 1u == (tg + 1u) * nx) xb_add(&bar[XB_TOPGEN], 1u);
            else XB_SPIN(xb_ld(&bar[XB_TOPGEN]) == tg, bar);
            __builtin_amdgcn_fence(__ATOMIC_ACQUIRE, "agent");
            xb_add(&bar[XB_XGEN(b.x)], 1u);
            asm volatile("s_waitcnt vmcnt(0)" ::: "memory");
        } else {
            XB_SPIN(xb_ld(&bar[XB_XGEN(b.x)]) == gen, bar);
            __builtin_amdgcn_fence(__ATOMIC_ACQUIRE, "agent");
            asm volatile("s_waitcnt vmcnt(0)" ::: "memory");
        }
    }
    __syncthreads();
}


struct TrItem { const float* src; const float* ks; bf16* dst; int N, K; };
template <bool UPMAP> __device__ __forceinline__ TrItem tr_make(const float* W, int K, int N, bf16* WT, const float* ks, int item) {
    const int nblk = N / 64, kb = item / nblk, nb = item % nblk, k0 = 64 * kb, n0 = 64 * nb;
    const int r0 = !UPMAP ? n0 : (n0 < DFF ? 256 * (n0 / 128) + (n0 % 128) : 256 * ((n0 - DFF) / 128) + 128 + ((n0 - DFF) % 128));
    TrItem t; t.src = W + (size_t)k0 * N + n0; t.ks = ks ? ks + k0 : nullptr; t.dst = WT + (size_t)r0 * K + k0; t.N = N; t.K = K; return t;
}
__device__ __forceinline__ void tr_load(const TrItem& t, f32x4 (&v)[16], int lane) {
    const float* src = t.src + (size_t)(lane >> 4) * t.N + 4 * (lane & 15);
#pragma unroll
    for (int i = 0; i < 16; ++i) v[i] = *(const f32x4*)(src + (size_t)(4 * i) * t.N);
}
__device__ __forceinline__ void tr_store(const TrItem& t, const f32x4 (&v)[16], LAS float* scr, int lane) {
#pragma unroll
    for (int i = 0; i < 16; ++i) { f32x4 x = v[i]; if (t.ks) x = x * t.ks[4 * i + (lane >> 4)];
        *(LAS f32x4*)(scr + (4 * i + (lane >> 4)) * 64 + (((lane & 15) ^ ((i >> 1) & 7)) << 2)) = x; }
    LDS_WAIT(); asm volatile("" ::: "memory");
    const int c = lane & 7;
#pragma unroll
    for (int j = 0; j < 8; ++j) { const int nn = (lane >> 3) + 8 * j; const LAS float* sp = scr + (8 * c) * 64 + ((((nn >> 2) ^ c) & 15) << 2) + (nn & 3);
        u32x4 o; o.x = pk2(sp[0 * 64], sp[1 * 64]); o.y = pk2(sp[2 * 64], sp[3 * 64]); o.z = pk2(sp[4 * 64], sp[5 * 64]); o.w = pk2(sp[6 * 64], sp[7 * 64]);
        *(u32x4*)(t.dst + (size_t)nn * t.K + 8 * c) = o; }
    LDS_WAIT(); asm volatile("" ::: "memory");
}
__device__ __forceinline__ void rms_rows2_to_bf16(const float* xa, const float* xb, const float* g, bf16* oa, bf16* ob, int lane) {
    const f32x4* pa = (const f32x4*)xa + lane; const f32x4* pb = (const f32x4*)xb + lane; const f32x4* gr = (const f32x4*)g + lane;
    f32x4 va[8], vb[8]; float sa = 0.f, sb = 0.f;
#pragma unroll
    for (int j = 0; j < 8; ++j) { va[j] = pa[64 * j]; vb[j] = pb[64 * j]; }
#pragma unroll
    for (int j = 0; j < 8; ++j) { sa += (va[j].x * va[j].x + va[j].y * va[j].y) + (va[j].z * va[j].z + va[j].w * va[j].w); sb += (vb[j].x * vb[j].x + vb[j].y * vb[j].y) + (vb[j].z * vb[j].z + vb[j].w * vb[j].w); }
    const float ra = 1.0f / sqrtf(wave_sum(sa) * (1.0f / DMODEL) + EPS), rb = 1.0f / sqrtf(wave_sum(sb) * (1.0f / DMODEL) + EPS);
    u32x2* qa = (u32x2*)oa + lane; u32x2* qb = (u32x2*)ob + lane;
#pragma unroll
    for (int j = 0; j < 8; ++j) { const f32x4 gg = gr[64 * j]; u32x2 w;
        w.x = pk2(va[j].x * ra * gg.x, va[j].y * ra * gg.y); w.y = pk2(va[j].z * ra * gg.z, va[j].w * ra * gg.w); qa[64 * j] = w;
        w.x = pk2(vb[j].x * rb * gg.x, vb[j].y * rb * gg.y); w.y = pk2(vb[j].z * rb * gg.z, vb[j].w * rb * gg.w); qb[64 * j] = w; }
}

struct Ptrs {
    const float *x, *mem, *g_mix, *g_mem, *w_in, *conv_w, *pool_w, *pool_scale, *w_kv, *w_out, *g_ffn, *w_up, *ffn_conv_w, *ffn_conv_b, *w_down, *g_final;
    float* out; unsigned char* ws;
};

constexpr int UP_ITEMS = (DMODEL / 64) * (DFF2 / 64), DN_ITEMS = (DFF / 64) * (DMODEL / 64);
#ifndef UP_IN_P0
#define UP_IN_P0 4608
#endif
__device__ __forceinline__ void p1_idle_work(const Ptrs& P, LAS unsigned char* lds, int iw, int NIW, int wave, int lane);
template <int LIST> __device__ __forceinline__ TrItem tr_desc(const Ptrs& P, int it) {
    unsigned char* ws = P.ws;
    constexpr int I_IN = (DMODEL / 64) * (DIN / 64), I_OUT = (DMODEL / 64) * (DMODEL / 64), I_KV = (DMODEL / 64) * (1024 / 64), I_PW = (PGD / 64) * (PGD / 64);
    if (LIST == 0) {
        int r = it;
        if (r < I_IN) return tr_make<false>(P.w_in, DMODEL, DIN, (bf16*)(ws + WS_WINT), nullptr, r); r -= I_IN;
        if (r < I_OUT) return tr_make<false>(P.w_out, DMODEL, DMODEL, (bf16*)(ws + WS_WOUTT), nullptr, r); r -= I_OUT;
        if (r < UP_IN_P0) return tr_make<true>(P.w_up, DMODEL, DFF2, (bf16*)(ws + WS_WUPT), P.g_ffn, r); r -= UP_IN_P0;
        if (r < I_KV) return tr_make<false>(P.w_kv, DMODEL, 1024, (bf16*)(ws + WS_WKVT), nullptr, r); r -= I_KV;
        const int g = r / I_PW; r -= g * I_PW;
        return tr_make<false>(P.pool_w + (size_t)g * PGD * PGD, PGD, PGD, (bf16*)(ws + WS_POOLWT) + (size_t)g * PGD * PGD, nullptr, r);
    } else {
        if (it < DN_ITEMS) return tr_make<false>(P.w_down, DFF, DMODEL, (bf16*)(ws + WS_WDOWNT), nullptr, it);
        return tr_make<true>(P.w_up, DMODEL, DFF2, (bf16*)(ws + WS_WUPT), P.g_ffn, UP_IN_P0 + it - DN_ITEMS);
    }
}
template <int LIST> __device__ __forceinline__ void tr_stream(const Ptrs& P, LAS float* scr, int first, int stride, int nitems, int lane) {
    if (first >= nitems) return;
    TrItem cur = tr_desc<LIST>(P, first); f32x4 va[16], vb[16];
    tr_load(cur, va, lane);
    for (int it = first; it < nitems; it += 2 * stride) {
        TrItem nx = cur; const bool h1 = it + stride < nitems; if (h1) { nx = tr_desc<LIST>(P, it + stride); tr_load(nx, vb, lane); }
        tr_store(cur, va, scr, lane);
        if (!h1) break;
        const bool h2 = it + 2 * stride < nitems; if (h2) { cur = tr_desc<LIST>(P, it + 2 * stride); tr_load(cur, va, lane); }
        tr_store(nx, vb, scr, lane);
        if (!h2) break;
    }
}
__device__ __forceinline__ void p0_prologue(const Ptrs& P, LAS unsigned char* lds, int gw, int NGW, int wave, int lane) {
    LAS float* scr = (LAS float*)(lds + wave * 16384);
    unsigned char* ws = P.ws;
    constexpr int NITEMS = (DMODEL / 64) * (DIN / 64) + (DMODEL / 64) * (DMODEL / 64) + UP_IN_P0 + (DMODEL / 64) * (1024 / 64) + 4 * (PGD / 64) * (PGD / 64);
    tr_stream<0>(P, scr, gw, NGW, NITEMS, lane);
    for (int i = gw * 64 + lane; i < 16 * DIN * 2 / 16; i += NGW * 64) ((u32x4*)(ws + WS_ZPAD))[i] = (u32x4){0u, 0u, 0u, 0u};
    for (int m = 2 * gw; m < SEQ; m += 2 * NGW) rms_rows2_to_bf16(P.x + (size_t)m * DMODEL, P.x + (size_t)(m + 1) * DMODEL, P.g_mix, (bf16*)(ws + WS_H) + (size_t)m * DMODEL, (bf16*)(ws + WS_H) + (size_t)(m + 1) * DMODEL, lane);
    for (int m = 2 * gw; m < NMEM; m += 2 * NGW) rms_rows2_to_bf16(P.mem + (size_t)m * DMODEL, P.mem + (size_t)(m + 1) * DMODEL, P.g_mem, (bf16*)(ws + WS_MB) + (size_t)m * DMODEL, (bf16*)(ws + WS_MB) + (size_t)(m + 1) * DMODEL, lane);
}

__device__ __forceinline__ void kv_tile(const Ptrs& P, int tt, int lane) {
    const bf16* mB = (const bf16*)(P.ws + WS_MB); const bf16* wT = (const bf16*)(P.ws + WS_WKVT);
    const int rb = tt >> 6, cb = tt & 63, fr = lane & 15, fq = lane >> 4;
    const bf16* ap = mB + (size_t)(16 * rb + fr) * DMODEL + 8 * fq; const bf16* wp = wT + (size_t)(16 * cb + fr) * DMODEL + 8 * fq;
    const bool kpart = cb < 32;
    f32x4 acc = {0.f, 0.f, 0.f, 0.f};
    bf16x8 a0[8], w0[8], a1[8], w1[8];
#pragma unroll
    for (int i = 0; i < 8; ++i) { a0[i] = *(const bf16x8*)(ap + 32 * i); w0[i] = *(const bf16x8*)(wp + 32 * i); }
#pragma unroll 1
    for (int kb = 0; kb < 8; kb += 2) {
#pragma unroll
        for (int i = 0; i < 8; ++i) { a1[i] = *(const bf16x8*)(ap + 32 * (8 * kb + 8 + i)); w1[i] = *(const bf16x8*)(wp + 32 * (8 * kb + 8 + i)); }
#pragma unroll
        for (int i = 0; i < 8; ++i) acc = kpart ? __builtin_amdgcn_mfma_f32_16x16x32_bf16(w0[i], a0[i], acc, 0, 0, 0) : __builtin_amdgcn_mfma_f32_16x16x32_bf16(a0[i], w0[i], acc, 0, 0, 0);
        if (kb + 2 < 8) {
#pragma unroll
            for (int i = 0; i < 8; ++i) { a0[i] = *(const bf16x8*)(ap + 32 * (8 * kb + 16 + i)); w0[i] = *(const bf16x8*)(wp + 32 * (8 * kb + 16 + i)); } }
#pragma unroll
        for (int i = 0; i < 8; ++i) acc = kpart ? __builtin_amdgcn_mfma_f32_16x16x32_bf16(w1[i], a1[i], acc, 0, 0, 0) : __builtin_amdgcn_mfma_f32_16x16x32_bf16(a1[i], w1[i], acc, 0, 0, 0);
    }
    u32x2 o; o.x = pk2(acc[0], acc[1]); o.y = pk2(acc[2], acc[3]);
    if (kpart) *(u32x2*)((bf16*)(P.ws + WS_KB) + (size_t)(16 * rb + fr) * 512 + 16 * cb + 4 * fq) = o;
    else *(u32x2*)((bf16*)(P.ws + WS_VT) + (size_t)(16 * cb - 512 + fr) * 256 + 32 * (rb >> 1) + 8 * fq + 4 * (rb & 1)) = o;
}

__device__ __forceinline__ void p1_idle_work(const Ptrs& P, LAS unsigned char* lds, int iw, int NIW, int wave, int lane) {
    LAS float* scr = (LAS float*)(lds + wave * 16384);
    for (int tt = iw; tt < 1024; tt += NIW) kv_tile(P, tt, lane);
    tr_stream<1>(P, scr, iw, NIW, DN_ITEMS + (UP_ITEMS - UP_IN_P0), lane);
}

__device__ __forceinline__ void mix_conv_task(const Ptrs& P, int blk, int lane, int cg0, int cg1) {
    const bf16* z = (const bf16*)(P.ws + WS_Z); bf16* mix = (bf16*)(P.ws + WS_MIX);
    const int t0 = blk * 16;
    for (int cg = cg0 + lane; cg < cg1; cg += 64) {
        const int c = cg * 8;
        float w0[8], w1[8], w2[8], p1[8], p2[8];
#pragma unroll
        for (int e = 0; e < 8; ++e) { w0[e] = P.conv_w[c + e]; w1[e] = P.conv_w[DCONV + c + e]; w2[e] = P.conv_w[2 * DCONV + c + e]; }
        { float a[8], b[8]; unpack8(*(const u32x4*)(z + (long)(t0 - 2) * DIN + DCONV + c), a); unpack8(*(const u32x4*)(z + (long)(t0 - 2) * DIN + 2 * DCONV + c), b);
#pragma unroll
          for (int e = 0; e < 8; ++e) p2[e] = a[e] * b[e];
          unpack8(*(const u32x4*)(z + (long)(t0 - 1) * DIN + DCONV + c), a); unpack8(*(const u32x4*)(z + (long)(t0 - 1) * DIN + 2 * DCONV + c), b);
#pragma unroll
          for (int e = 0; e < 8; ++e) p1[e] = a[e] * b[e]; }
#pragma unroll 4
        for (int r = 0; r < 16; ++r) {
            const int t = t0 + r; float p[8], a[8], b[8], g[8], o[8];
            unpack8(*(const u32x4*)(z + (size_t)t * DIN + DCONV + c), a); unpack8(*(const u32x4*)(z + (size_t)t * DIN + 2 * DCONV + c), b); unpack8(*(const u32x4*)(z + (size_t)t * DIN + c), g);
#pragma unroll
            for (int e = 0; e < 8; ++e) { p[e] = a[e] * b[e]; o[e] = g[e] * (w2[e] * p[e] + w1[e] * p1[e] + w0[e] * p2[e]); p2[e] = p1[e]; p1[e] = p[e]; }
            *(u32x4*)(mix + (size_t)t * DMODEL + c) = pack8(o);
        }
    }
}
template <int g> __device__ __forceinline__ void mix_pool_task(const Ptrs& P, int blk, int lane) {
    constexpr int k = 2 << g;
    const char* zu = (const char*)((const bf16*)(P.ws + WS_Z) + (size_t)(blk * 16) * DIN + 3 * DCONV + PGD * g);
    const char* wu = (const char*)((const bf16*)(P.ws + WS_POOLWT) + (size_t)g * PGD * PGD);
    bf16* mix = (bf16*)(P.ws + WS_MIX);
    const int fr = lane & 15, fq = lane >> 4, t = blk * 16 + fr;
    const unsigned zl = (unsigned)(fr * DIN + 8 * fq) * 2u, wl = (unsigned)(fr * PGD + 8 * fq) * 2u;
    const int cnt = (t + 1 < k) ? t + 1 : k; const float inv = 1.0f / (float)cnt;
    f32x4 acc[12];
#pragma unroll
    for (int n = 0; n < 12; ++n) acc[n] = (f32x4){0.f, 0.f, 0.f, 0.f};
#pragma unroll 1
    for (int ks = 0; ks < 6; ++ks) {
        float sum[8], self[8];
        unpack8(*(const u32x4*)(zu + ks * 64 + zl), self);
#pragma unroll
        for (int e = 0; e < 8; ++e) sum[e] = self[e];
#pragma unroll
        for (int j = 1; j < k; ++j) { float v[8]; unpack8(*(const u32x4*)(zu + ks * 64 - (long)j * (DIN * 2) + zl), v);
#pragma unroll
            for (int e = 0; e < 8; ++e) sum[e] += v[e]; }
        float pl[8];
#pragma unroll
        for (int e = 0; e < 8; ++e) pl[e] = sum[e] * inv - self[e];
        const bf16x8 pf = __builtin_bit_cast(bf16x8, pack8(pl));
#pragma unroll
        for (int n = 0; n < 12; ++n) { const bf16x8 wf = *(const bf16x8*)(wu + n * (16 * PGD * 2) + ks * 64 + wl); acc[n] = __builtin_amdgcn_mfma_f32_16x16x32_bf16(wf, pf, acc[n], 0, 0, 0); }
    }
#pragma unroll
    for (int n = 0; n < 12; ++n) { const int d = 16 * n + 4 * fq; const f32x4 sc = *(const f32x4*)(P.pool_scale + PGD * g + d);
        u32x2 o; o.x = pk2(acc[n][0] * sc[0], acc[n][1] * sc[1]); o.y = pk2(acc[n][2] * sc[2], acc[n][3] * sc[3]);
        *(u32x2*)(mix + (size_t)t * DMODEL + DCONV + PGD * g + d) = o; }
}
__device__ __forceinline__ void mix_attn_task(const Ptrs& P, int h, int blk, int lane) {
    const bf16* z = (const bf16*)(P.ws + WS_Z); bf16* mix = (bf16*)(P.ws + WS_MIX); const bf16* Kb = (const bf16*)(P.ws + WS_KB); const bf16* Vt = (const bf16*)(P.ws + WS_VT);
    const int fr = lane & 15, fq = lane >> 4, t = blk * 16 + fr;
    bf16x8 qf[4];
#pragma unroll
    for (int ks = 0; ks < 4; ++ks) qf[ks] = *(const bf16x8*)(z + (size_t)t * DIN + 3 * DCONV + DPOOL + 128 * h + 32 * ks + 8 * fq);
    f32x4 s[16];
#pragma unroll
    for (int kb = 0; kb < 16; ++kb) { s[kb] = (f32x4){0.f, 0.f, 0.f, 0.f};
#pragma unroll
        for (int ks = 0; ks < 4; ++ks) { const bf16x8 kf = *(const bf16x8*)(Kb + (size_t)(16 * kb + fr) * 512 + 128 * h + 32 * ks + 8 * fq); s[kb] = __builtin_amdgcn_mfma_f32_16x16x32_bf16(kf, qf[ks], s[kb], 0, 0, 0); } }
    float mx = -3.0e38f;
#pragma unroll
    for (int kb = 0; kb < 16; ++kb) mx = fmaxf(fmaxf(fmaxf(s[kb][0], s[kb][1]), fmaxf(s[kb][2], s[kb][3])), mx);
    mx = fmaxf(mx, __shfl_xor(mx, 16)); mx = fmaxf(mx, __shfl_xor(mx, 32));
    const float c2 = 0.08838834764831845f * 1.4426950408889634f;
    float sum = 0.f;
#pragma unroll
    for (int kb = 0; kb < 16; ++kb)
#pragma unroll
        for (int r = 0; r < 4; ++r) { const float p = __builtin_amdgcn_exp2f((s[kb][r] - mx) * c2); s[kb][r] = p; sum += p; }
    sum += __shfl_xor(sum, 16); sum += __shfl_xor(sum, 32);
    const float inv = 1.0f / sum;
    f32x4 o[8];
#pragma unroll
    for (int db = 0; db < 8; ++db) o[db] = (f32x4){0.f, 0.f, 0.f, 0.f};
#pragma unroll
    for (int ks = 0; ks < 8; ++ks) {
        u32x4 pw; pw.x = pk2(s[2 * ks][0], s[2 * ks][1]); pw.y = pk2(s[2 * ks][2], s[2 * ks][3]); pw.z = pk2(s[2 * ks + 1][0], s[2 * ks + 1][1]); pw.w = pk2(s[2 * ks + 1][2], s[2 * ks + 1][3]);
        const bf16x8 pf = __builtin_bit_cast(bf16x8, pw);
#pragma unroll
        for (int db = 0; db < 8; ++db) { const bf16x8 vf = *(const bf16x8*)(Vt + (size_t)(128 * h + 16 * db + fr) * 256 + 32 * ks + 8 * fq); o[db] = __builtin_amdgcn_mfma_f32_16x16x32_bf16(vf, pf, o[db], 0, 0, 0); }
    }
#pragma unroll
    for (int db = 0; db < 8; ++db) { u32x2 w; w.x = pk2(o[db][0] * inv, o[db][1] * inv); w.y = pk2(o[db][2] * inv, o[db][3] * inv);
        *(u32x2*)(mix + (size_t)t * DMODEL + DCONV + DPOOL + 128 * h + 16 * db + 4 * fq) = w; }
}
template <int R, int C, int PCH> __device__ __forceinline__ void lds_stage_rows(LAS unsigned char* dst, const unsigned char* src, int gp, int tid) {
    constexpr int N = R * C, PER = (N + 511) / 512;
    u32x4 v[PER];
#pragma unroll
    for (int i = 0; i < PER; ++i) { const int idx = tid + 512 * i; if (idx < N) { const int row = idx / C, ch = idx % C; v[i] = *(const u32x4*)(src + (size_t)row * gp + ch * 16); } }
#pragma unroll
    for (int i = 0; i < PER; ++i) { const int idx = tid + 512 * i; if (idx < N) { const int row = idx / C, ch = idx % C; *(LAS u32x4*)(dst + row * (PCH * 16) + (((ch & ~15) | ((ch & 15) ^ (row & 15))) << 4)) = v[i]; } }
}
template <int N> __device__ __forceinline__ float dpp_shrN(float old, float src) { return __builtin_bit_cast(float, __builtin_amdgcn_update_dpp(__builtin_bit_cast(int, old), __builtin_bit_cast(int, src), 0x110 + N, 0xf, 0xf, false)); }
template <int N> __device__ __forceinline__ float dpp_rorN(float src) { return __builtin_bit_cast(float, __builtin_amdgcn_mov_dpp(__builtin_bit_cast(int, src), 0x120 + N, 0xf, 0xf, false)); }
template <int N> __device__ __forceinline__ float scan_step(float x, float p) { return x + dpp_shrN<N>(dpp_rorN<N>(p), x); }
template <int N> __device__ __forceinline__ float scan_step_prev(float p) { return p + dpp_shrN<N>(0.f, p); }

__device__ __forceinline__ void mix_attn_wave(const Ptrs& P, LAS unsigned char* ldsK, LAS unsigned char* ldsV, int h, int row0, int lane) {
    const bf16* z = (const bf16*)(P.ws + WS_Z); bf16* mix = (bf16*)(P.ws + WS_MIX);
    const int fr = lane & 15, fq = lane >> 4;
    bf16x8 q0[4], q1[4];
#pragma unroll
    for (int ks = 0; ks < 4; ++ks) { const bf16* qp = z + (size_t)(row0 + fr) * DIN + 3 * DCONV + DPOOL + 128 * h + 32 * ks + 8 * fq; q0[ks] = *(const bf16x8*)qp; q1[ks] = *(const bf16x8*)(qp + 16 * DIN); }
    unsigned offk[4];
#pragma unroll
    for (int ks = 0; ks < 4; ++ks) offk[ks] = (unsigned)(fr * 256 + (((4 * ks + fq) ^ fr) << 4));
    f32x4 s0[16], s1[16];
#pragma unroll
    for (int kb = 0; kb < 16; ++kb) { s0[kb] = (f32x4){0.f, 0.f, 0.f, 0.f}; s1[kb] = (f32x4){0.f, 0.f, 0.f, 0.f};
#pragma unroll
        for (int ks = 0; ks < 4; ++ks) { const bf16x8 kf = *(const LAS bf16x8*)(ldsK + kb * 4096 + offk[ks]);
            s0[kb] = __builtin_amdgcn_mfma_f32_16x16x32_bf16(kf, q0[ks], s0[kb], 0, 0, 0); s1[kb] = __builtin_amdgcn_mfma_f32_16x16x32_bf16(kf, q1[ks], s1[kb], 0, 0, 0); } }
    const float c2 = 0.08838834764831845f * 1.4426950408889634f;
    bf16x8 p0[8], p1[8]; float inv0, inv1;
    {   float mx = -3.0e38f;
#pragma unroll
        for (int kb = 0; kb < 16; ++kb) mx = fmaxf(fmaxf(fmaxf(s0[kb][0], s0[kb][1]), fmaxf(s0[kb][2], s0[kb][3])), mx);
        mx = fmaxf(mx, __shfl_xor(mx, 16)); mx = fmaxf(mx, __shfl_xor(mx, 32));
        float sum = 0.f;
#pragma unroll
        for (int ks = 0; ks < 8; ++ks) { float e[8];
#pragma unroll
            for (int r = 0; r < 4; ++r) { e[r] = __builtin_amdgcn_exp2f((s0[2 * ks][r] - mx) * c2); e[4 + r] = __builtin_amdgcn_exp2f((s0[2 * ks + 1][r] - mx) * c2); }
            sum += ((e[0] + e[1]) + (e[2] + e[3])) + ((e[4] + e[5]) + (e[6] + e[7]));
            p0[ks] = __builtin_bit_cast(bf16x8, pack8(e)); }
        sum += __shfl_xor(sum, 16); sum += __shfl_xor(sum, 32); inv0 = 1.0f / sum; }
    {   float mx = -3.0e38f;
#pragma unroll
        for (int kb = 0; kb < 16; ++kb) mx = fmaxf(fmaxf(fmaxf(s1[kb][0], s1[kb][1]), fmaxf(s1[kb][2], s1[kb][3])), mx);
        mx = fmaxf(mx, __shfl_xor(mx, 16)); mx = fmaxf(mx, __shfl_xor(mx, 32));
        float sum = 0.f;
#pragma unroll
        for (int ks = 0; ks < 8; ++ks) { float e[8];
#pragma unroll
            for (int r = 0; r < 4; ++r) { e[r] = __builtin_amdgcn_exp2f((s1[2 * ks][r] - mx) * c2); e[4 + r] = __builtin_amdgcn_exp2f((s1[2 * ks + 1][r] - mx) * c2); }
            sum += ((e[0] + e[1]) + (e[2] + e[3])) + ((e[4] + e[5]) + (e[6] + e[7]));
            p1[ks] = __builtin_bit_cast(bf16x8, pack8(e)); }
        sum += __shfl_xor(sum, 16); sum += __shfl_xor(sum, 32); inv1 = 1.0f / sum; }
    f32x4 o0[8], o1[8];
#pragma unroll
    for (int db = 0; db < 8; ++db) { o0[db] = (f32x4){0.f, 0.f, 0.f, 0.f}; o1[db] = (f32x4){0.f, 0.f, 0.f, 0.f}; }
#pragma unroll
    for (int ks = 0; ks < 8; ++ks) {
        const unsigned offv = (unsigned)(fr * 512 + ((ks >> 2) << 8) + (((4 * (ks & 3) + fq) ^ fr) << 4));
#pragma unroll
        for (int db = 0; db < 8; ++db) { const bf16x8 vf = *(const LAS bf16x8*)(ldsV + db * 8192 + offv);
            o0[db] = __builtin_amdgcn_mfma_f32_16x16x32_bf16(vf, p0[ks], o0[db], 0, 0, 0); o1[db] = __builtin_amdgcn_mfma_f32_16x16x32_bf16(vf, p1[ks], o1[db], 0, 0, 0); } }
    bf16* op = mix + (size_t)(row0 + fr) * DMODEL + DCONV + DPOOL + 128 * h + 4 * fq;
#pragma unroll
    for (int db = 0; db < 8; ++db) { u32x2 w; w.x = pk2(o0[db][0] * inv0, o0[db][1] * inv0); w.y = pk2(o0[db][2] * inv0, o0[db][3] * inv0); *(u32x2*)(op + 16 * db) = w;
        w.x = pk2(o1[db][0] * inv1, o1[db][1] * inv1); w.y = pk2(o1[db][2] * inv1, o1[db][3] * inv1); *(u32x2*)(op + (size_t)16 * DMODEL + 16 * db) = w; }
}

template <int g> __device__ __forceinline__ void mix_pool_wave(const Ptrs& P, LAS unsigned char* ldsW, int row0, int lane) {
    constexpr int k = 2 << g;
    const bf16* z = (const bf16*)(P.ws + WS_Z); bf16* mix = (bf16*)(P.ws + WS_MIX);
    const int fr = lane & 15, fq = lane >> 4;
    f32x4 acc0[12], acc1[12];
#pragma unroll
    for (int n = 0; n < 12; ++n) { acc0[n] = (f32x4){0.f, 0.f, 0.f, 0.f}; acc1[n] = (f32x4){0.f, 0.f, 0.f, 0.f}; }
    const float invA = 1.0f / (float)((row0 + fr + 1 < k) ? row0 + fr + 1 : k), invB = 1.0f / (float)((row0 + 16 + fr + 1 < k) ? row0 + 16 + fr + 1 : k);
#pragma unroll 1
    for (int ks = 0; ks < 6; ++ks) {
        const bf16* zp = z + (long)(row0 - 16 + fr) * DIN + 3 * DCONV + PGD * g + 32 * ks + 8 * fq;
        float pv[8], xa[8], xb[8], sa[8], sb[8];
        unpack8(*(const u32x4*)zp, pv); unpack8(*(const u32x4*)(zp + 16 * DIN), xa); unpack8(*(const u32x4*)(zp + 32 * DIN), xb);
#pragma unroll
        for (int e = 0; e < 8; ++e) {
            float p = pv[e], a = xa[e], b = xb[e];
            float b1 = scan_step<1>(b, a), a1 = scan_step<1>(a, p), p1 = scan_step_prev<1>(p);
            if (k >= 4) { const float b2 = scan_step<2>(b1, a1), a2 = scan_step<2>(a1, p1), p2 = scan_step_prev<2>(p1); b1 = b2; a1 = a2; p1 = p2; }
            if (k >= 8) { const float b2 = scan_step<4>(b1, a1), a2 = scan_step<4>(a1, p1), p2 = scan_step_prev<4>(p1); b1 = b2; a1 = a2; p1 = p2; }
            if (k >= 16) { const float b2 = scan_step<8>(b1, a1), a2 = scan_step<8>(a1, p1); b1 = b2; a1 = a2; }
            sa[e] = a1 * invA - a; sb[e] = b1 * invB - b; }
        const bf16x8 fa = __builtin_bit_cast(bf16x8, pack8(sa)), fb = __builtin_bit_cast(bf16x8, pack8(sb));
        const unsigned offw = (unsigned)(fr * 512 + ((ks >> 2) << 8) + (((4 * (ks & 3) + fq) ^ fr) << 4));
#pragma unroll
        for (int n = 0; n < 12; ++n) { const bf16x8 wf = *(const LAS bf16x8*)(ldsW + n * 8192 + offw);
            acc0[n] = __builtin_amdgcn_mfma_f32_16x16x32_bf16(wf, fa, acc0[n], 0, 0, 0); acc1[n] = __builtin_amdgcn_mfma_f32_16x16x32_bf16(wf, fb, acc1[n], 0, 0, 0); }
    }
    bf16* op = mix + (size_t)(row0 + fr) * DMODEL + DCONV + PGD * g + 4 * fq;
#pragma unroll
    for (int n = 0; n < 12; ++n) { const f32x4 sc = *(const f32x4*)(P.pool_scale + PGD * g + 16 * n + 4 * fq);
        u32x2 o; o.x = pk2(acc0[n][0] * sc[0], acc0[n][1] * sc[1]); o.y = pk2(acc0[n][2] * sc[2], acc0[n][3] * sc[3]); *(u32x2*)(op + 16 * n) = o;
        o.x = pk2(acc1[n][0] * sc[0], acc1[n][1] * sc[1]); o.y = pk2(acc1[n][2] * sc[2], acc1[n][3] * sc[3]); *(u32x2*)(op + (size_t)16 * DMODEL + 16 * n) = o; }
}

__device__ __forceinline__ void p2_mixer(const Ptrs& P, LAS unsigned char* lds, int w, int tid, int wave, int lane, int tmask) {
    const int sub = w & 3, tile = w >> 2, row0 = tile * 256 + (wave & 3) * 64;
    lds_stage_rows<256, 16, 16>(lds, (const unsigned char*)(P.ws + WS_KB) + 256 * sub, 1024, tid);
    lds_stage_rows<128, 32, 32>(lds + 65536, (const unsigned char*)(P.ws + WS_VT) + (size_t)sub * 128 * 512, 512, tid);
    LDS_WAIT(); __syncthreads();
    if (wave < 4) { if (tmask & 0x1e0) {
#pragma unroll 1
        for (int p = 0; p < 2; ++p) { asm volatile("" ::: "memory"); mix_attn_wave(P, lds, lds + 65536, sub, row0 + 32 * p, lane); } } }
    else if (tmask & 1) mix_conv_task(P, 4 * w + (wave - 4), lane, 0, 48);
    __syncthreads();
    lds_stage_rows<192, 24, 32>(lds, (const unsigned char*)(P.ws + WS_POOLWT) + (size_t)sub * PGD * PGD * 2, PGD * 2, tid);
    LDS_WAIT(); __syncthreads();
    if (wave < 4) { if (tmask & 0x1e) {
#pragma unroll 1
        for (int p = 0; p < 2; ++p) { const int r = row0 + 32 * p; asm volatile("" ::: "memory");
            if (sub == 0) mix_pool_wave<0>(P, lds, r, lane); else if (sub == 1) mix_pool_wave<1>(P, lds, r, lane); else if (sub == 2) mix_pool_wave<2>(P, lds, r, lane); else mix_pool_wave<3>(P, lds, r, lane); } } }
    else if (tmask & 1) mix_conv_task(P, 4 * w + (wave - 4), lane, 48, 96);
    __syncthreads();
}

__device__ __forceinline__ void p5_fix_item(const Ptrs& P, int pm, int c) {
    const float* ub = (const float*)(P.ws + WS_UBND); bf16* act = (bf16*)(P.ws + WS_ACT); const float* cw = P.ffn_conv_w; const float* cb = P.ffn_conv_b;
    const int gi = 256 * (c / 128) + (c % 128);
    const float* p2 = ub + (size_t)((pm - 1) * 4 + 2) * DFF2 + gi; const float* p1 = p2 + DFF2; const float* r0 = ub + (size_t)(pm * 4) * DFF2 + gi; const float* r1 = r0 + DFF2;
    float o0[8], o1[8];
#pragma unroll
    for (int e = 0; e < 8; ++e) {
        const float gw0 = cw[c + e], gw1 = cw[DFF2 + c + e], gw2 = cw[2 * DFF2 + c + e], gb = cb[c + e], vw0 = cw[DFF + c + e], vw1 = cw[DFF2 + DFF + c + e], vw2 = cw[2 * DFF2 + DFF + c + e], vb = cb[DFF + c + e];
        const float G0 = gw2 * r0[e] + (gw1 * p1[e] + (gw0 * p2[e] + gb)), V0 = vw2 * r0[128 + e] + (vw1 * p1[128 + e] + (vw0 * p2[128 + e] + vb));
        const float G1 = gw2 * r1[e] + (gw1 * r0[e] + (gw0 * p1[e] + gb)), V1 = vw2 * r1[128 + e] + (vw1 * r0[128 + e] + (vw0 * p1[128 + e] + vb));
        o0[e] = G0 * __builtin_amdgcn_rcpf(1.0f + __builtin_amdgcn_exp2f(-1.4426950408889634f * G0)) * V0;
        o1[e] = G1 * __builtin_amdgcn_rcpf(1.0f + __builtin_amdgcn_exp2f(-1.4426950408889634f * G1)) * V1; }
    *(u32x4*)(act + (size_t)(256 * pm) * DFF + c) = pack8(o0); *(u32x4*)(act + (size_t)(256 * pm + 1) * DFF + c) = pack8(o1);
}
__device__ __forceinline__ void p6_fixup_panels(const Ptrs& P, int vcu, int G, int tid, unsigned* cnt, unsigned* tmo) {
    constexpr int GRP = DFF / 8 / 8;
    const int nround = (512 + G - 1) / G;
    for (int i = 0; i < nround; ++i) { const int L = i * G + vcu; if (L >= 512) break; const int pm = L >> 3, pn = L & 7;
        if (pm > 0 && tid < GRP) p5_fix_item(P, pm, (pn * GRP + tid) * 8); }
    asm volatile("s_waitcnt vmcnt(0)" ::: "memory"); __syncthreads();
    if (tid == 0) {
        __builtin_amdgcn_fence(__ATOMIC_RELEASE, "agent"); asm volatile("s_waitcnt vmcnt(0)" ::: "memory");
        for (int i = 0; i < nround; ++i) { const int L = i * G + vcu; if (L >= 512) break; __hip_atomic_fetch_add(cnt + 64 * (L >> 3), 1u, __ATOMIC_RELAXED, __HIP_MEMORY_SCOPE_AGENT); }
        for (int i = 0; i < nround; ++i) { const int L = i * G + vcu; if (L >= 512) break; unsigned spins = 0;
            while (__hip_atomic_load(cnt + 64 * (L >> 3), __ATOMIC_RELAXED, __HIP_MEMORY_SCOPE_AGENT) < 8u) { __builtin_amdgcn_s_sleep(2); if (++spins > (1u << 20)) { __hip_atomic_store(tmo, 1u, __ATOMIC_RELAXED, __HIP_MEMORY_SCOPE_AGENT); break; } } }
        __builtin_amdgcn_fence(__ATOMIC_ACQUIRE, "agent"); asm volatile("s_waitcnt vmcnt(0)" ::: "memory");
    }
    __syncthreads();
}
__device__ __forceinline__ void p5_fixup(const Ptrs& P, int gt, int NGT) {
    for (int i = gt; i < 63 * (DFF / 8); i += NGT) p5_fix_item(P, 1 + i / (DFF / 8), (i % (DFF / 8)) * 8);
}

__device__ __forceinline__ void p7_final(const Ptrs& P, int gw, int NGW, int lane) {
    const float* slab = (const float*)(P.ws + WS_SLAB2);
    for (int m = gw; m < SEQ; m += NGW) {
        const float part = (lane < 32) ? slab[(size_t)m * 32 + lane] : 0.f;
        const float rstd = 1.0f / sqrtf(wave_sum(part) * (1.0f / DMODEL) + EPS);
        f32x4* xr = (f32x4*)(P.out + (size_t)m * DMODEL) + lane; const f32x4* gr = (const f32x4*)P.g_final + lane;
#pragma unroll
        for (int j = 0; j < 8; ++j) { f32x4 v = xr[64 * j]; const f32x4 gg = gr[64 * j]; v = v * rstd * gg; xr[64 * j] = v; }
    }
}

struct Args { const float* in[16]; float* out; unsigned char* ws; int ph_lo, ph_hi; };
__global__ void __launch_bounds__(NWAVES * 64, 2) hybrid_fwd(Args args) {
    extern __shared__ __attribute__((aligned(16))) unsigned char lds_raw[];
    LAS unsigned char* lds = (LAS unsigned char*)lds_raw;
    cg::grid_group grid = cg::this_grid();
    const int tid = threadIdx.x, lane = tid & 63, wave = __builtin_amdgcn_readfirstlane(tid >> 6);
    const int G = gridDim.x, bx = blockIdx.x, vcu = (G % 8 == 0) ? (bx % 8) * (G / 8) + bx / 8 : bx;
    const int gw = vcu * NWAVES + wave, NGW = G * NWAVES;
    volatile LAS unsigned* MISC = (volatile LAS unsigned*)(lds + MISC_OFF);
    if (tid < 32) MISC[tid] = 0u;
    __syncthreads();
    const XcdBarrier bar = xcd_barrier_post((unsigned*)(args.ws + WS_CTL), MISC + 8);
    Ptrs P;
    P.x = args.in[0]; P.mem = args.in[1]; P.g_mix = args.in[2]; P.g_mem = args.in[3]; P.w_in = args.in[4]; P.conv_w = args.in[5]; P.pool_w = args.in[6]; P.pool_scale = args.in[7];
    P.w_kv = args.in[8]; P.w_out = args.in[9]; P.g_ffn = args.in[10]; P.w_up = args.in[11]; P.ffn_conv_w = args.in[12]; P.ffn_conv_b = args.in[13]; P.w_down = args.in[14]; P.g_final = args.in[15];
    P.out = args.out; P.ws = args.ws;
    unsigned char* ws = args.ws;
#if PROBE_SYNC
    for (int i = 0; i < 20; ++i) xcd_barrier(bar);
#endif
    const int lo = args.ph_lo, hi = args.ph_hi;
#define IN(k) (lo <= (k) && (k) < hi)
#define SYNC(k) do { if ((k) + 1 < hi) { if ((k) == 0 && USE_CG_SYNC) grid.sync(); else xcd_barrier(bar); } } while (0)
#define SYNCR(k, b) do { if ((k) + 1 < hi || rp + 1 < NREP(b)) { if ((k) == 0 && USE_CG_SYNC) grid.sync(); else xcd_barrier(bar); } } while (0)
#define NREP(b) ((REPM & (b)) ? 2 : 1)
    if (IN(0) && (PHM & 1)) for (int rp = 0; rp < NREP(1); ++rp) { p0_prologue(P, lds, gw, NGW, wave, lane); SYNCR(0, 1); }
    if (IN(1) && (PHM & 2)) for (int rp = 0; rp < NREP(2); ++rp) {
        pg8::Gemm g{(const bf16*)(ws + WS_H), (const bf16*)(ws + WS_WINT), SEQ, DIN, DMODEL}; pg8::StaticOrder S; S.init(SEQ, DIN, G, bx, P1_WGM);
        pg8::EpiZ E{(bf16*)(ws + WS_Z), DIN};
        pg8::gemm_phase<pg8::EpiZ, pg8::StaticOrder, P1_ALIGN, true>(lds, g, S, E, lds + XLDS_OFF);
        { const int nfull = ((SEQ / 256) * (DIN / 256)) % G;
          if (nfull == 0) p1_idle_work(P, lds, bx * NWAVES + wave, G * NWAVES, wave, lane);
          else if (bx >= nfull) p1_idle_work(P, lds, (bx - nfull) * NWAVES + wave, (G - nfull) * NWAVES, wave, lane); }
        SYNCR(1, 2);
    }
    if (IN(2) && (PHM & 4)) for (int rp = 0; rp < NREP(4); ++rp) { p2_mixer(P, lds, vcu, tid, wave, lane, 511);
#if PROBE_P2
        p2_mixer(P, lds, vcu, tid, wave, lane, PROBE_P2);
#endif
        SYNCR(2, 4); }
    if (IN(3) && (PHM & 8)) {
        pg8::Gemm g{(const bf16*)(ws + WS_MIX), (const bf16*)(ws + WS_WOUTT), SEQ, DMODEL, DMODEL}; pg8::PanelOrder S{G, vcu, (SEQ / 256) * (DMODEL / 256)};
        pg8::EpiNorm<0> E{P.x, nullptr, nullptr, (float*)(ws + WS_SIG), (bf16*)(ws + WS_X1B), nullptr, nullptr, (unsigned*)(ws + WS_SLAB1), (unsigned*)(ws + WS_CTL) + CW_PANEL1, (unsigned*)(ws + WS_CTL) + XB_TMO};
        pg8::gemm_phase<pg8::EpiNorm<0>, pg8::PanelOrder, true, true>(lds, g, S, E, lds + XLDS_OFF);
        SYNC(3);
    }
#if PROBE_GEMM
    if (IN(3)) {
        pg8::Gemm g{(const bf16*)(ws + WS_X1B), (const bf16*)(ws + WS_WUPT), SEQ, PROBE_N, DMODEL}; pg8::StaticOrder S; S.init(SEQ, PROBE_N, G, bx);
#if PROBE_GEMM == 1
        pg8::EpiZ E{(bf16*)(ws + WS_Z), PROBE_N};
        pg8::gemm_phase<pg8::EpiZ, pg8::StaticOrder, true, true>(lds, g, S, E, lds + XLDS_OFF);
#elif PROBE_GEMM == 2
        pg8::EpiNone E{};
        pg8::gemm_phase<pg8::EpiNone, pg8::StaticOrder, true, true>(lds, g, S, E, lds + XLDS_OFF);
#elif PROBE_GEMM == 3
        pg8::EpiZ E{(bf16*)(ws + WS_Z), PROBE_N};
        pg8::gemm_phase<pg8::EpiZ, pg8::StaticOrder, true, false>(lds, g, S, E, lds + XLDS_OFF);
#elif PROBE_GEMM == 5
        pg8::EpiAct E{(bf16*)(ws + WS_ACT), P.ffn_conv_w, P.ffn_conv_b, (float*)(ws + WS_UBND)};
        pg8::gemm_phase<pg8::EpiAct, pg8::StaticOrder, true, true>(lds, g, S, E, lds + XLDS_OFF);
#elif PROBE_GEMM == 4
        pg8::EpiZ E{(bf16*)(ws + WS_Z), PROBE_N};
        pg8::gemm_phase<pg8::EpiZ, pg8::StaticOrder, false, true>(lds, g, S, E, lds + XLDS_OFF);
#endif
        xcd_barrier(bar);
    }
#endif
    if (IN(4) && (PHM & 16)) for (int rp = 0; rp < NREP(16); ++rp) {
        pg8::Gemm g{(const bf16*)(ws + WS_X1B), (const bf16*)(ws + WS_WUPT), SEQ, DFF2, DMODEL}; pg8::StaticOrder S; S.init(SEQ, DFF2, G, bx, P4_WGM);
        pg8::EpiAct E{(bf16*)(ws + WS_ACT), P.ffn_conv_w, P.ffn_conv_b, (float*)(ws + WS_UBND)};
        pg8::gemm_phase<pg8::EpiAct, pg8::StaticOrder, true, true>(lds, g, S, E, lds + XLDS_OFF);
        SYNCR(4, 16);
    }
#if !FUSE_FIXUP
    if (IN(5) && (PHM & 32)) { p5_fixup(P, vcu * (NWAVES * 64) + tid, G * NWAVES * 64); SYNC(5); }
#endif
    if (IN(6) && (PHM & 64)) {
#if FUSE_FIXUP
        p6_fixup_panels(P, vcu, G, tid, (unsigned*)(ws + WS_CTL) + CW_PANEL2, (unsigned*)(ws + WS_CTL) + XB_TMO);
#endif
        pg8::Gemm g{(const bf16*)(ws + WS_ACT), (const bf16*)(ws + WS_WDOWNT), SEQ, DMODEL, DFF}; pg8::PanelOrder S{G, vcu, (SEQ / 256) * (DMODEL / 256)};
        pg8::EpiNorm<1> E{nullptr, (const bf16*)(ws + WS_X1B), (const float*)(ws + WS_SIG), nullptr, nullptr, P.out, P.g_final, (unsigned*)(ws + WS_SLAB2), (unsigned*)(ws + WS_CTL) + CW_PANEL, (unsigned*)(ws + WS_CTL) + XB_TMO};
        pg8::gemm_phase<pg8::EpiNorm<1>, pg8::PanelOrder, true, true>(lds, g, S, E, lds + XLDS_OFF);
    }
#undef IN
#undef SYNC
}

extern "C" void kernel_launch(void* const* d_in, const int* in_sizes, int n_in, void* d_out, int out_size, void* d_ws, size_t ws_size, hipStream_t stream) {
    static int grid = 0;
    if (grid == 0) {
        if (n_in != 16 || in_sizes[0] != SEQ * DMODEL || out_size != SEQ * DMODEL || ws_size < WS_END) { fprintf(stderr, "kernel_launch: unexpected shapes (n_in %d, in0 %d, out %d, ws %zu)\n", n_in, n_in > 0 ? in_sizes[0] : -1, out_size, ws_size); grid = -1; return; }
        int dev = 0, cus = 0, per_cu = 0;
        if (hipGetDevice(&dev) != hipSuccess || hipDeviceGetAttribute(&cus, hipDeviceAttributeMultiprocessorCount, dev) != hipSuccess) { grid = -1; return; }
        if (hipFuncSetAttribute((const void*)hybrid_fwd, hipFuncAttributeMaxDynamicSharedMemorySize, LDS_BYTES) != hipSuccess) { fprintf(stderr, "kernel_launch: hipFuncSetAttribute failed\n"); grid = -1; return; }
        if (hipOccupancyMaxActiveBlocksPerMultiprocessor(&per_cu, (const void*)hybrid_fwd, NWAVES * 64, LDS_BYTES) != hipSuccess || per_cu < 1) { fprintf(stderr, "kernel_launch: occupancy query says %d blocks per CU\n", per_cu); (void)hipGetLastError(); per_cu = 1; }
        grid = cus;
        if (grid != 256) { fprintf(stderr, "kernel_launch: this kernel is laid out for one workgroup on each of 256 CUs (the mixer phase and the row-statistics exchanges assume it); the device reports %d\n", grid); if (grid > 256) grid = 256; }
    }
    if (grid < 0) return;
    if (hipMemsetAsync((char*)d_ws + WS_CTL, 0, CTL_ZERO_BYTES, stream) != hipSuccess) { fprintf(stderr, "kernel_launch: hipMemsetAsync failed\n"); return; }
    Args a{};
    for (int i = 0; i < 16; ++i) a.in[i] = (const float*)d_in[i];
    a.out = (float*)d_out; a.ws = (unsigned char*)d_ws;
#if MK_PER_PHASE
    for (int ph = 0; ph < NPHASE; ++ph) { a.ph_lo = ph; a.ph_hi = ph + 1; hipLaunchKernelGGL(hybrid_fwd, dim3(grid), dim3(NWAVES * 64), LDS_BYTES, stream, a); }
#else
    a.ph_lo = 0; a.ph_hi = NPHASE;
    void* kargs[] = {&a};
    hipError_t e = hipLaunchCooperativeKernel((const void*)hybrid_fwd, dim3(grid), dim3(NWAVES * 64), kargs, LDS_BYTES, stream);
    if (e != hipSuccess) fprintf(stderr, "kernel_launch: cooperative launch failed: %s (grid %d)\n", hipGetErrorString(e), grid);
#endif
}
```

```cpp
#include <hip/hip_runtime.h>
#include <hip/hip_cooperative_groups.h>
#include <cstdio>
#include <cstdint>
namespace cg = cooperative_groups;
#ifndef PG8_PRIO
#define PG8_PRIO 0
#endif
namespace pg8 {
#define PG8_LAS __attribute__((address_space(3)))
typedef unsigned short bf16_t;
typedef short bf16x8 __attribute__((ext_vector_type(8)));
typedef float f32x4 __attribute__((ext_vector_type(4)));
typedef unsigned u32x4 __attribute__((ext_vector_type(4)));
constexpr int BM = 256, BK = 64, HALF = 128, HTB = HALF * BK * 2  , STAGE_BYTES = 8 * HTB, NXCD = 8, WGM = 8;

__host__ __device__ __forceinline__ int lds_byte(int r, int c) { const int st = (r >> 4) * 2 + (c >> 5), rr = r & 15, cc = c & 31, ob = rr * 64 + cc * 2; return st * 1024 + (ob ^ (((ob >> 9) & 1) << 5)); }
__host__ __device__ __forceinline__ void stage_rc(int b, int& R, int& C) { const int st = b / 1024, sb = b % 1024, swz = sb ^ (((sb >> 9) & 1) << 5); R = (st >> 1) * 16 + swz / 64; C = (st & 1) * 32 + (swz % 64) / 2; }
__host__ __device__ __forceinline__ int perm32(int rho) { const int n = rho >> 4, i = rho & 15; return 8 * (i >> 2) + 4 * n + (i & 3); }

struct Unit { int pm, pn; };
struct Gemm { const bf16_t* A; const bf16_t* Bt; int M, N, K; };

struct StaticOrder {
    int nM, nN, nwg, G, c, wgm;
    __host__ __device__ void init(int M, int N, int G_, int c_, int wgm_ = WGM) { nM = M / BM; nN = N / BM; nwg = nM * nN; G = G_; c = c_; wgm = wgm_; }
    __host__ __device__ bool next(int i, Unit& u) const {
        const long L = (long)i * G + c; if (L >= nwg) return false;
        int wgid = (int)L; { const int q = nwg / NXCD, r = nwg % NXCD, xcd = wgid % NXCD, off = wgid / NXCD; wgid = (xcd < r ? xcd * (q + 1) : r * (q + 1) + (xcd - r) * q) + off; }
        const int nig = wgm * nN, gid = wgid / nig, fm = gid * wgm, gsz = (nM - fm) < wgm ? (nM - fm) : wgm;
        u.pm = fm + ((wgid % nig) % gsz); u.pn = (wgid % nig) / gsz; return true;
    }
    __device__ __forceinline__ void a_ready(const Unit&) const {}
    __device__ __forceinline__ void done(const Unit&) const {}
};
__device__ __forceinline__ unsigned cvt_pk_bf16(float lo, float hi) { unsigned r; asm volatile("v_cvt_pk_bf16_f32 %0, %1, %2" : "=v"(r) : "v"(lo), "v"(hi)); return r; }
typedef unsigned u32x2 __attribute__((ext_vector_type(2)));
constexpr int DM = 2048;
constexpr float RMS_EPS = 1e-6f;

struct EpiZ {
    static constexpr bool PERM = true, AFTER_DRAIN = false;
    bf16_t* O; int ldc;
    __device__ __forceinline__ void operator()(const f32x4 (&acc)[2][2][4][2], const Unit& u, int wr, int wc, int fr_, int fq_, PG8_LAS unsigned char*) const {
        int t_ = threadIdx.x; asm volatile("" : "+v"(t_));
        const int fr = t_ & 15, fq = (t_ >> 4) & 3;
        const int row0 = u.pm * BM + wr * 64 + fr, col0 = u.pn * BM + wc * 32 + 8 * fq;
#pragma unroll
        for (int ai = 0; ai < 2; ++ai)
#pragma unroll
            for (int m = 0; m < 4; ++m) { bf16_t* rowp = O + (size_t)(row0 + ai * HALF + m * 16) * ldc + col0;
#pragma unroll
                for (int bj = 0; bj < 2; ++bj) { const f32x4 v0 = acc[ai][bj][m][0], v1 = acc[ai][bj][m][1];
                    u32x4 w; w.x = cvt_pk_bf16(v0[0], v0[1]); w.y = cvt_pk_bf16(v0[2], v0[3]); w.z = cvt_pk_bf16(v1[0], v1[1]); w.w = cvt_pk_bf16(v1[2], v1[3]);
                    *(u32x4*)(rowp + bj * HALF) = w; } }
    }
};

struct EpiNone {
    static constexpr bool PERM = true, AFTER_DRAIN = false;
    __device__ __forceinline__ void operator()(const f32x4 (&acc)[2][2][4][2], const Unit& u, int wr, int wc, int fr, int fq, PG8_LAS unsigned char*) const {
#pragma unroll
        for (int ai = 0; ai < 2; ++ai)
#pragma unroll
            for (int bj = 0; bj < 2; ++bj)
#pragma unroll
                for (int m = 0; m < 4; ++m)
#pragma unroll
                    for (int n = 0; n < 2; ++n) asm volatile("" :: "v"(acc[ai][bj][m][n]));
    }
};
struct EpiResA {
    static constexpr bool PERM = true, AFTER_DRAIN = false;
    const float* R; bf16_t* XB; float* slab;
    __device__ __forceinline__ void operator()(const f32x4 (&acc)[2][2][4][2], const Unit& u, int wr, int wc, int fr_, int fq_, PG8_LAS unsigned char*) const {
        int t_ = threadIdx.x; asm volatile("" : "+v"(t_));
        const int fr = t_ & 15, fq = (t_ >> 4) & 3;
        const int row0 = u.pm * BM + wr * 64 + fr, col0 = u.pn * BM + wc * 32 + 8 * fq;
#pragma unroll
        for (int ai = 0; ai < 2; ++ai) {
            f32x4 r[4][2][2];
#pragma unroll
            for (int m = 0; m < 4; ++m)
#pragma unroll
                for (int bj = 0; bj < 2; ++bj) { const float* p = R + (size_t)(row0 + ai * HALF + m * 16) * DM + col0 + bj * HALF; r[m][bj][0] = *(const f32x4*)p; r[m][bj][1] = *(const f32x4*)(p + 4); }
#pragma unroll
            for (int m = 0; m < 4; ++m) { const int row = row0 + ai * HALF + m * 16; float ss = 0.f;
#pragma unroll
                for (int bj = 0; bj < 2; ++bj) { const f32x4 v0 = acc[ai][bj][m][0] + r[m][bj][0], v1 = acc[ai][bj][m][1] + r[m][bj][1];
                    u32x4 w; w.x = cvt_pk_bf16(v0[0], v0[1]); w.y = cvt_pk_bf16(v0[2], v0[3]); w.z = cvt_pk_bf16(v1[0], v1[1]); w.w = cvt_pk_bf16(v1[2], v1[3]);
                    *(u32x4*)(XB + (size_t)row * DM + col0 + bj * HALF) = w;
                    ss += (v0[0] * v0[0] + v0[1] * v0[1]) + (v0[2] * v0[2] + v0[3] * v0[3]) + (v1[0] * v1[0] + v1[1] * v1[1]) + (v1[2] * v1[2] + v1[3] * v1[3]); }
                ss += __shfl_xor(ss, 16); ss += __shfl_xor(ss, 32);
                if (fq == 0) slab[(size_t)row * 32 + u.pn * 4 + wc] = ss; }
            asm volatile("" ::: "memory"); }
    }
};
struct EpiResB {
    static constexpr bool PERM = true, AFTER_DRAIN = false;
    const bf16_t* RB; float* X; float* slab;
    __device__ __forceinline__ void operator()(const f32x4 (&acc)[2][2][4][2], const Unit& u, int wr, int wc, int fr_, int fq_, PG8_LAS unsigned char*) const {
        int t_ = threadIdx.x; asm volatile("" : "+v"(t_));
        const int fr = t_ & 15, fq = (t_ >> 4) & 3;
        const int row0 = u.pm * BM + wr * 64 + fr, col0 = u.pn * BM + wc * 32 + 8 * fq;
        u32x4 r[2][4][2];
#pragma unroll
        for (int ai = 0; ai < 2; ++ai)
#pragma unroll
            for (int m = 0; m < 4; ++m)
#pragma unroll
                for (int bj = 0; bj < 2; ++bj) r[ai][m][bj] = *(const u32x4*)(RB + (size_t)(row0 + ai * HALF + m * 16) * DM + col0 + bj * HALF);
#pragma unroll
        for (int ai = 0; ai < 2; ++ai)
#pragma unroll
            for (int m = 0; m < 4; ++m) { const int row = row0 + ai * HALF + m * 16; float ss = 0.f;
#pragma unroll
                for (int bj = 0; bj < 2; ++bj) { const u32x4 q = r[ai][m][bj];
                    const f32x4 r0 = {__builtin_bit_cast(float, q.x << 16), __builtin_bit_cast(float, q.x & 0xffff0000u), __builtin_bit_cast(float, q.y << 16), __builtin_bit_cast(float, q.y & 0xffff0000u)};
                    const f32x4 r1 = {__builtin_bit_cast(float, q.z << 16), __builtin_bit_cast(float, q.z & 0xffff0000u), __builtin_bit_cast(float, q.w << 16), __builtin_bit_cast(float, q.w & 0xffff0000u)};
                    const f32x4 v0 = acc[ai][bj][m][0] + r0, v1 = acc[ai][bj][m][1] + r1;
                    float* xp = X + (size_t)row * DM + col0 + bj * HALF; *(f32x4*)xp = v0; *(f32x4*)(xp + 4) = v1;
                    ss += (v0[0] * v0[0] + v0[1] * v0[1]) + (v0[2] * v0[2] + v0[3] * v0[3]) + (v1[0] * v1[0] + v1[1] * v1[1]) + (v1[2] * v1[2] + v1[3] * v1[3]); }
                ss += __shfl_xor(ss, 16); ss += __shfl_xor(ss, 32);
                if (fq == 0) slab[(size_t)row * 32 + u.pn * 4 + wc] = ss; }
    }
};

struct PanelOrder {
    int G, vcu, ntot;
    __device__ __forceinline__ bool next(int i, Unit& u) const { const int L = i * G + vcu; if (L >= ntot) return false; u.pm = L >> 3; u.pn = L & 7; return true; }
    __device__ __forceinline__ void a_ready(const Unit&) const {}
    __device__ __forceinline__ void done(const Unit&) const {}
};
template <int MODE  > struct EpiNorm {
    static constexpr bool PERM = (MODE == 0), AFTER_DRAIN = false;
    const float* Rf; const bf16_t* Rb; const float* sig_in; float* sig_out; bf16_t* HN; float* OUT; const float* gfin; unsigned* xbuf; unsigned* cnt; unsigned* tmo;
    __device__ __forceinline__ void operator()(f32x4 (&acc)[2][2][4][2], const Unit& u, int wr, int wc, int fr_, int fq_, PG8_LAS unsigned char* xlds) const {
        int t_ = threadIdx.x; asm volatile("" : "+v"(t_));
        const int fr = t_ & 15, fq = (t_ >> 4) & 3, wid = __builtin_amdgcn_readfirstlane(t_ >> 6);
        const int rl0 = wr * 64 + fr, row0 = u.pm * BM + rl0, col0 = u.pn * BM + wc * 32 + 8 * fq;
        PG8_LAS float* Pt = (PG8_LAS float*)xlds;
        PG8_LAS float* St = (PG8_LAS float*)(xlds + 4096);
        if constexpr (MODE == 0) {
            f32x4 gi[2][2];
#pragma unroll
            for (int bj = 0; bj < 2; ++bj) { gi[bj][0] = *(const f32x4*)(gfin + col0 + bj * HALF); gi[bj][1] = *(const f32x4*)(gfin + col0 + bj * HALF + 4); }
#pragma unroll
            for (int ai = 0; ai < 2; ++ai) { u32x4 r[4][2]; float sg[4];
#pragma unroll
                for (int m = 0; m < 4; ++m) { sg[m] = sig_in[row0 + ai * HALF + m * 16];
#pragma unroll
                    for (int bj = 0; bj < 2; ++bj) r[m][bj] = *(const u32x4*)(Rb + (size_t)(row0 + ai * HALF + m * 16) * DM + col0 + bj * HALF); }
#pragma unroll
                for (int m = 0; m < 4; ++m) { float ss = 0.f; const float sgm = sg[m];
#pragma unroll
                    for (int bj = 0; bj < 2; ++bj) { const u32x4 q = r[m][bj];
                        const f32x4 r0 = {__builtin_bit_cast(float, q.x << 16), __builtin_bit_cast(float, q.x & 0xffff0000u), __builtin_bit_cast(float, q.y << 16), __builtin_bit_cast(float, q.y & 0xffff0000u)};
                        const f32x4 r1 = {__builtin_bit_cast(float, q.z << 16), __builtin_bit_cast(float, q.z & 0xffff0000u), __builtin_bit_cast(float, q.w << 16), __builtin_bit_cast(float, q.w & 0xffff0000u)};
                        const f32x4 v0 = acc[ai][bj][m][0] + r0 * gi[bj][0] * sgm, v1 = acc[ai][bj][m][1] + r1 * gi[bj][1] * sgm; acc[ai][bj][m][0] = v0; acc[ai][bj][m][1] = v1;
                        ss += (v0[0] * v0[0] + v0[1] * v0[1]) + (v0[2] * v0[2] + v0[3] * v0[3]) + (v1[0] * v1[0] + v1[1] * v1[1]) + (v1[2] * v1[2] + v1[3] * v1[3]); }
                    ss += __shfl_xor(ss, 16); ss += __shfl_xor(ss, 32);
                    if (fq == 0) Pt[(ai * HALF + rl0 + m * 16) * 4 + wc] = ss; }
                asm volatile("" ::: "memory"); }
        } else { u32x2 r[2][4][2][2]; float sg[2][4]; const int colb = u.pn * BM + wc * 32 + 4 * fq;
#pragma unroll
            for (int ai = 0; ai < 2; ++ai)
#pragma unroll
                for (int m = 0; m < 4; ++m) { sg[ai][m] = sig_in[row0 + ai * HALF + m * 16];
#pragma unroll
                    for (int bj = 0; bj < 2; ++bj)
#pragma unroll
                        for (int n = 0; n < 2; ++n) r[ai][m][bj][n] = *(const u32x2*)(Rb + (size_t)(row0 + ai * HALF + m * 16) * DM + colb + bj * HALF + 16 * n); }
#pragma unroll
            for (int ai = 0; ai < 2; ++ai)
#pragma unroll
                for (int m = 0; m < 4; ++m) { float ss = 0.f; const float sgm = sg[ai][m];
#pragma unroll
                    for (int bj = 0; bj < 2; ++bj)
#pragma unroll
                        for (int n = 0; n < 2; ++n) { const u32x2 q = r[ai][m][bj][n];
                            const f32x4 r0 = {__builtin_bit_cast(float, q.x << 16), __builtin_bit_cast(float, q.x & 0xffff0000u), __builtin_bit_cast(float, q.y << 16), __builtin_bit_cast(float, q.y & 0xffff0000u)};
                            const f32x4 v0 = acc[ai][bj][m][n] + r0 * sgm; acc[ai][bj][m][n] = v0;
                            ss += (v0[0] * v0[0] + v0[1] * v0[1]) + (v0[2] * v0[2] + v0[3] * v0[3]); }
                    ss += __shfl_xor(ss, 16); ss += __shfl_xor(ss, 32);
                    if (fq == 0) Pt[(ai * HALF + rl0 + m * 16) * 4 + wc] = ss; } }
        asm volatile("s_waitcnt lgkmcnt(0)" ::: "memory"); __builtin_amdgcn_s_barrier(); asm volatile("" ::: "memory");
        if (t_ < 256) { const float s = (Pt[t_ * 4 + 0] + Pt[t_ * 4 + 1]) + (Pt[t_ * 4 + 2] + Pt[t_ * 4 + 3]);
            __hip_atomic_store(xbuf + (size_t)(u.pm * BM + t_) * 8 + u.pn, __builtin_bit_cast(unsigned, s), __ATOMIC_RELAXED, __HIP_MEMORY_SCOPE_AGENT); }
        asm volatile("s_waitcnt vmcnt(0)" ::: "memory");
        if (t_ < 256 && (t_ & 63) == 0) __hip_atomic_fetch_add(cnt + 64 * u.pm, 1u, __ATOMIC_RELAXED, __HIP_MEMORY_SCOPE_AGENT);
        if (wid == 0) {
            unsigned spins = 0;
            while ((unsigned)__builtin_amdgcn_readfirstlane(__hip_atomic_load(cnt + 64 * u.pm, __ATOMIC_RELAXED, __HIP_MEMORY_SCOPE_AGENT)) < 32u) {
                __builtin_amdgcn_s_sleep(2);
                if (++spins > (1u << 20)) { if ((t_ & 63) == 0) __hip_atomic_store(tmo, 1u, __ATOMIC_RELAXED, __HIP_MEMORY_SCOPE_AGENT); break; } }
            __builtin_amdgcn_fence(__ATOMIC_ACQUIRE, "agent");
        }
        asm volatile("s_waitcnt vmcnt(0) lgkmcnt(0)" ::: "memory"); __builtin_amdgcn_s_barrier(); asm volatile("" ::: "memory");
        if (t_ < 256) { const unsigned long long* sp = (const unsigned long long*)(xbuf + (size_t)(u.pm * BM + t_) * 8); float tot = 0.f;
#pragma unroll
            for (int q = 0; q < 4; ++q) { const unsigned long long w = __hip_atomic_load(sp + q, __ATOMIC_RELAXED, __HIP_MEMORY_SCOPE_AGENT);
                tot += __builtin_bit_cast(float, (unsigned)w); tot += __builtin_bit_cast(float, (unsigned)(w >> 32)); }
            const float sd = sqrtf(tot * (1.0f / DM) + RMS_EPS);
            St[t_] = 1.0f / sd;
            if (MODE == 0 && u.pn == 0) sig_out[u.pm * BM + t_] = sd; }
        asm volatile("s_waitcnt lgkmcnt(0)" ::: "memory"); __builtin_amdgcn_s_barrier(); asm volatile("" ::: "memory");
        if constexpr (MODE == 0) {
#pragma unroll
            for (int ai = 0; ai < 2; ++ai)
#pragma unroll
                for (int m = 0; m < 4; ++m) { const float rstd = St[ai * HALF + rl0 + m * 16]; bf16_t* op = HN + (size_t)(row0 + ai * HALF + m * 16) * DM + col0;
#pragma unroll
                    for (int bj = 0; bj < 2; ++bj) { const f32x4 v0 = acc[ai][bj][m][0] * rstd, v1 = acc[ai][bj][m][1] * rstd;
                        u32x4 w; w.x = cvt_pk_bf16(v0[0], v0[1]); w.y = cvt_pk_bf16(v0[2], v0[3]); w.z = cvt_pk_bf16(v1[0], v1[1]); w.w = cvt_pk_bf16(v1[2], v1[3]);
                        *(u32x4*)(op + bj * HALF) = w; } }
        } else {
            const int colb = u.pn * BM + wc * 32 + 4 * fq; const bool odd = fr & 1;
            f32x4 gg[2][2];
#pragma unroll
            for (int bj = 0; bj < 2; ++bj)
#pragma unroll
                for (int n = 0; n < 2; ++n) gg[bj][n] = *(const f32x4*)(gfin + colb + bj * HALF + 16 * n);
#pragma unroll
            for (int ai = 0; ai < 2; ++ai)
#pragma unroll
                for (int m = 0; m < 4; ++m) { const float rstd = St[ai * HALF + rl0 + m * 16]; float* op = OUT + (size_t)(row0 + ai * HALF + m * 16) * DM + colb;
#pragma unroll
                    for (int bj = 0; bj < 2; ++bj) {
                        const f32x4 o0 = acc[ai][bj][m][0] * rstd * gg[bj][0], o1 = acc[ai][bj][m][1] * rstd * gg[bj][1]; f32x4 dA, dB;
#pragma unroll
                        for (int j = 0; j < 4; ++j) { const float snd = odd ? o0[j] : o1[j];
                            const float rcv = __builtin_bit_cast(float, __builtin_amdgcn_mov_dpp(__builtin_bit_cast(int, snd), 0xB1, 0xf, 0xf, false));
                            dA[j] = odd ? rcv : o0[j]; dB[j] = odd ? o1[j] : rcv; }
                        float* pp = op + bj * HALF + (odd ? 16 : 0);
                        *(f32x4*)(pp - (odd ? DM : 0)) = dA; *(f32x4*)(pp + (odd ? 0 : DM)) = dB; } }
        }
    }
};

__device__ __forceinline__ float dpp_shr1(float old, float src) { return __builtin_bit_cast(float, __builtin_amdgcn_update_dpp(__builtin_bit_cast(int, old), __builtin_bit_cast(int, src), 0x111, 0xf, 0xf, false)); }
__device__ __forceinline__ float dpp_shr2(float old, float src) { return __builtin_bit_cast(float, __builtin_amdgcn_update_dpp(__builtin_bit_cast(int, old), __builtin_bit_cast(int, src), 0x112, 0xf, 0xf, false)); }
__device__ __forceinline__ float dpp_ror1(float src) { return __builtin_bit_cast(float, __builtin_amdgcn_mov_dpp(__builtin_bit_cast(int, src), 0x121, 0xf, 0xf, false)); }
__device__ __forceinline__ float dpp_ror2(float src) { return __builtin_bit_cast(float, __builtin_amdgcn_mov_dpp(__builtin_bit_cast(int, src), 0x122, 0xf, 0xf, false)); }
constexpr int FF = 5632, FF2 = 11264;
typedef _Float16 h2_t __attribute__((ext_vector_type(2)));
__device__ __forceinline__ unsigned pkh(float a, float b) { return __builtin_bit_cast(unsigned, __builtin_amdgcn_cvt_pkrtz(a, b)); }
__device__ __forceinline__ unsigned dppu_shr1(unsigned old, unsigned src) { return (unsigned)__builtin_amdgcn_update_dpp((int)old, (int)src, 0x111, 0xf, 0xf, false); }
__device__ __forceinline__ unsigned dppu_shr2(unsigned old, unsigned src) { return (unsigned)__builtin_amdgcn_update_dpp((int)old, (int)src, 0x112, 0xf, 0xf, false); }
__device__ __forceinline__ unsigned dppu_ror1(unsigned src) { return (unsigned)__builtin_amdgcn_mov_dpp((int)src, 0x121, 0xf, 0xf, false); }
__device__ __forceinline__ unsigned dppu_ror2(unsigned src) { return (unsigned)__builtin_amdgcn_mov_dpp((int)src, 0x122, 0xf, 0xf, false); }
struct EpiAct {
    static constexpr bool PERM = true, AFTER_DRAIN = false;
    bf16_t* ACT; const float* cw; const float* cb; float* ubnd;
    __device__ __forceinline__ void operator()(f32x4 (&acc)[2][2][4][2], const Unit& u, int wr, int wc, int fr_, int fq_, PG8_LAS unsigned char* xlds) const {
        int t_ = threadIdx.x; asm volatile("" : "+v"(t_));
        const int fr = t_ & 15, fq = (t_ >> 4) & 3;
        const int row0 = u.pm * BM + wr * 64 + fr, cl = wc * 32 + 8 * fq;
        const int c0 = u.pn * 128 + cl;
        f32x4 wgt[2][8];
#pragma unroll
        for (int n = 0; n < 2; ++n) { const float* wp = cw + c0 + 4 * n; const float* bp = cb + c0 + 4 * n;
            wgt[n][0] = *(const f32x4*)wp; wgt[n][1] = *(const f32x4*)(wp + FF2); wgt[n][2] = *(const f32x4*)(wp + 2 * FF2); wgt[n][3] = *(const f32x4*)bp;
            wgt[n][4] = *(const f32x4*)(wp + FF); wgt[n][5] = *(const f32x4*)(wp + FF2 + FF); wgt[n][6] = *(const f32x4*)(wp + 2 * FF2 + FF); wgt[n][7] = *(const f32x4*)(bp + FF); }
        if (wr == 1 && fr >= 14) {
#pragma unroll
            for (int bj = 0; bj < 2; ++bj)
#pragma unroll
                for (int n = 0; n < 2; ++n) *(f32x4*)(ubnd + (size_t)(u.pm * 4 + 2 + (fr - 14)) * FF2 + u.pn * BM + 128 * bj + cl + 4 * n) = acc[1][bj][3][n]; }
        if (wr == 0 && fr < 2) {
#pragma unroll
            for (int bj = 0; bj < 2; ++bj)
#pragma unroll
                for (int n = 0; n < 2; ++n) *(f32x4*)(ubnd + (size_t)(u.pm * 4 + fr) * FF2 + u.pn * BM + 128 * bj + cl + 4 * n) = acc[0][bj][0][n]; }
        u32x4 pk[2][4][2];
#pragma unroll
        for (int ai = 0; ai < 2; ++ai)
#pragma unroll
            for (int m = 0; m < 4; ++m)
#pragma unroll
                for (int n = 0; n < 2; ++n) { const f32x4 g = acc[ai][0][m][n], v = acc[ai][1][m][n]; pk[ai][m][n] = (u32x4){pkh(g[0], v[0]), pkh(g[1], v[1]), pkh(g[2], v[2]), pkh(g[3], v[3])}; }
        if (fr >= 14) {
#pragma unroll
            for (int ai = 0; ai < 2; ++ai)
#pragma unroll
                for (int n = 0; n < 2; ++n) *(PG8_LAS u32x4*)(xlds + ((((2 * ai + wr) * 2 + (fr - 14)) * 128 + cl + 4 * n) << 2)) = pk[ai][3][n]; }
        asm volatile("s_waitcnt lgkmcnt(0)" ::: "memory"); __builtin_amdgcn_s_barrier(); asm volatile("" ::: "memory");
        u32x2 hold[2][4];
#pragma unroll
        for (int n = 0; n < 2; ++n) {
            h2_t w0p[4], w1p[4], w2p[4], bp4[4];
#pragma unroll
            for (int j = 0; j < 4; ++j) { w0p[j] = __builtin_bit_cast(h2_t, pkh(wgt[n][0][j], wgt[n][4][j])); w1p[j] = __builtin_bit_cast(h2_t, pkh(wgt[n][1][j], wgt[n][5][j]));
                w2p[j] = __builtin_bit_cast(h2_t, pkh(wgt[n][2][j], wgt[n][6][j])); bp4[j] = __builtin_bit_cast(h2_t, pkh(wgt[n][3][j], wgt[n][7][j])); }
#pragma unroll
            for (int ai = 0; ai < 2; ++ai) {
                const int chunk = 2 * ai + wr;
                u32x4 pp = {0u, 0u, 0u, 0u};
                if (chunk > 0) pp = *(const PG8_LAS u32x4*)(xlds + ((((chunk - 1) * 2 + (fr & 1)) * 128 + cl + 4 * n) << 2));
#pragma unroll
                for (int m = 0; m < 4; ++m) {
                    const u32x4 cur = pk[ai][m][n]; float a[4];
#pragma unroll
                    for (int j = 0; j < 4; ++j) {
                        const unsigned cj = cur[j], pj = pp[j];
                        const h2_t s1 = __builtin_bit_cast(h2_t, dppu_shr1(dppu_ror1(pj), cj)), s2 = __builtin_bit_cast(h2_t, dppu_shr2(dppu_ror2(pj), cj)), ch = __builtin_bit_cast(h2_t, cj);
                        const h2_t r = w2p[j] * ch + (w1p[j] * s1 + (w0p[j] * s2 + bp4[j]));
                        const float G = (float)r.x, V = (float)r.y;
                        a[j] = G * __builtin_amdgcn_rcpf(1.0f + __builtin_amdgcn_exp2f(-1.4426950408889634f * G)) * V; }
                    u32x2 w; w.x = cvt_pk_bf16(a[0], a[1]); w.y = cvt_pk_bf16(a[2], a[3]);
                    if (n == 0) hold[ai][m] = w;
                    else { u32x4 o; o.x = hold[ai][m].x; o.y = hold[ai][m].y; o.z = w.x; o.w = w.y;
                        if (!(ai == 0 && m == 0 && wr == 0 && u.pm > 0 && fr < 2)) *(u32x4*)(ACT + (size_t)(row0 + ai * HALF + m * 16) * FF + c0) = o; }
                    pp = cur;
                }
            }
        }
    }
};

template <class Epi, class Sched, bool ALIGN_EPI = false, bool SP2 = false>
__device__ __forceinline__ void gemm_phase(PG8_LAS unsigned char* lds, const Gemm g, const Sched& S, const Epi& E, PG8_LAS unsigned char* xlds) {
    const int tid = threadIdx.x, wid = __builtin_amdgcn_readfirstlane(tid >> 6), lane = tid & 63, wr = wid >> 2, wc = wid & 3, fr = lane & 15, fq = lane >> 4;
    const int K = g.K, nt = K / BK;
    unsigned voffA[2], voffB[2];
#pragma unroll
    for (int i = 0; i < 2; ++i) { int R, C; stage_rc(tid * 16 + i * 8192, R, C); const int Rb = Epi::PERM ? ((R & ~31) + perm32(R & 31)) : R;
        voffA[i] = (unsigned)(R * K + C) * 2u; voffB[i] = (unsigned)(Rb * K + C) * 2u; }
    const size_t kstep = (size_t)(BK * 2);
    const size_t hstep = (size_t)HALF * K * 2;
    const size_t tstep = 2 * hstep;
    const unsigned ldsw = (unsigned)wid * 1024u;
    const int aoff = lds_byte(wr * 64 + fr, fq * 8), boff = lds_byte(wc * 32 + fr, fq * 8);
#define PG8_SA(b, h) (((b) * 2 + (h)) * HTB)
#define PG8_SB(b, h) ((4 + (b) * 2 + (h)) * HTB)
#define PG8_STAGE(bufoff, gbase, voff) do { _Pragma("unroll") for (int _i = 0; _i < 2; ++_i) \
        __builtin_amdgcn_global_load_lds((const unsigned*)((const char*)(gbase) + (voff)[_i]), (PG8_LAS unsigned*)(lds + (bufoff) + ldsw + _i * 8192), 16, 0, 0); } while (0)
#define PG8_LDA(dst, b, h) do { _Pragma("unroll") for (int m = 0; m < 4; ++m) _Pragma("unroll") for (int k = 0; k < 2; ++k) dst[m][k] = *(const PG8_LAS bf16x8*)(lds + PG8_SA(b, h) + aoff + m * 2048 + k * 1024); } while (0)
#define PG8_LDB(dst, b, h) do { _Pragma("unroll") for (int n = 0; n < 2; ++n) _Pragma("unroll") for (int k = 0; k < 2; ++k) dst[n][k] = *(const PG8_LAS bf16x8*)(lds + PG8_SB(b, h) + boff + n * 2048 + k * 1024); } while (0)
#define PG8_MMA(ai, bj, At, Bt) do { __builtin_amdgcn_s_setprio(PG8_PRIO); _Pragma("unroll") for (int m = 0; m < 4; ++m) _Pragma("unroll") for (int n = 0; n < 2; ++n) _Pragma("unroll") for (int k = 0; k < 2; ++k) \
        acc[ai][bj][m][n] = __builtin_amdgcn_mfma_f32_16x16x32_bf16(Bt[n][k], At[m][k], acc[ai][bj][m][n], 0, 0, 0); __builtin_amdgcn_s_setprio(0); } while (0)
#define PG8_WAIT_V(n) asm volatile("s_waitcnt vmcnt(" #n ")" ::: "memory")
#define PG8_WAIT_L(n) asm volatile("s_waitcnt lgkmcnt(" #n ")" ::: "memory")
#define PG8_BAR __builtin_amdgcn_s_barrier()
#define PG8_SCHED __builtin_amdgcn_sched_barrier(0)
    Unit cur, nxt; int ui = 0;
    if (!S.next(0, cur)) return;
    f32x4 acc[2][2][4][2];
#pragma unroll
    for (int a = 0; a < 2; ++a)
#pragma unroll
        for (int b = 0; b < 2; ++b)
#pragma unroll
            for (int m = 0; m < 4; ++m)
#pragma unroll
                for (int n = 0; n < 2; ++n) acc[a][b][m][n] = (f32x4){0.f, 0.f, 0.f, 0.f};
    bf16x8 At[4][2], B0[2][2], B1[2][2];
    const char* cA = (const char*)g.A + (size_t)cur.pm * tstep; const char* cB = (const char*)g.Bt + (size_t)cur.pn * tstep;
    S.a_ready(cur);
    if constexpr (SP2) {
        PG8_STAGE(PG8_SB(0, 0), cB, voffB); PG8_STAGE(PG8_SB(0, 1), cB + hstep, voffB); PG8_STAGE(PG8_SA(0, 0), cA, voffA); PG8_STAGE(PG8_SA(0, 1), cA + hstep, voffA);
        if (wr == 1) PG8_BAR;
        PG8_WAIT_V(2); PG8_BAR;
        PG8_STAGE(PG8_SB(1, 0), cB + kstep, voffB); PG8_STAGE(PG8_SA(1, 0), cA + kstep, voffA); PG8_STAGE(PG8_SB(1, 1), cB + hstep + kstep, voffB);
        PG8_WAIT_V(6); PG8_BAR;
    } else {
        PG8_STAGE(PG8_SB(0, 0), cB, voffB); PG8_STAGE(PG8_SA(0, 0), cA, voffA); PG8_STAGE(PG8_SB(0, 1), cB + hstep, voffB); PG8_STAGE(PG8_SA(0, 1), cA + hstep, voffA);
        if (wr == 1) PG8_BAR;
        PG8_WAIT_V(4); PG8_BAR;
        PG8_STAGE(PG8_SB(1, 0), cB + kstep, voffB); PG8_STAGE(PG8_SA(1, 0), cA + kstep, voffA); PG8_STAGE(PG8_SB(1, 1), cB + hstep + kstep, voffB);
        PG8_WAIT_V(6); PG8_BAR;
    }
    for (;;) {
        const bool has_next = S.next(ui + 1, nxt);
        const char* nA = has_next ? (const char*)g.A + (size_t)nxt.pm * tstep : cA; const char* nB = has_next ? (const char*)g.Bt + (size_t)nxt.pn * tstep : cB;
        for (int t = 0; t < nt; t += 2) {
            const bool last = (t == nt - 2);
            const char* a1 = cA + (size_t)(t + 1) * kstep;
            const char* a2 = last ? nA : cA + (size_t)(t + 2) * kstep; const char* b2 = last ? nB : cB + (size_t)(t + 2) * kstep;
            const char* a3 = a2 + kstep; const char* b3 = b2 + kstep;
            if (last && has_next) S.a_ready(nxt);
            if constexpr (SP2) {
            PG8_LDB(B0, 0, 0); PG8_LDB(B1, 0, 1); PG8_SCHED; PG8_LDA(At, 0, 0); PG8_STAGE(PG8_SA(1, 1), a1 + hstep, voffA);
            PG8_WAIT_V(8); PG8_WAIT_L(0); PG8_BAR; PG8_MMA(0, 0, At, B0); PG8_MMA(0, 1, At, B1); PG8_BAR; PG8_SCHED;
            PG8_LDA(At, 0, 1); PG8_STAGE(PG8_SB(0, 0), b2, voffB); PG8_STAGE(PG8_SB(0, 1), b2 + hstep, voffB); PG8_STAGE(PG8_SA(0, 0), a2, voffA);
            PG8_WAIT_V(8); PG8_WAIT_L(0); PG8_BAR; PG8_MMA(1, 0, At, B0); PG8_MMA(1, 1, At, B1); PG8_BAR; PG8_SCHED;
            PG8_LDB(B0, 1, 0); PG8_LDB(B1, 1, 1); PG8_SCHED; PG8_LDA(At, 1, 0); PG8_STAGE(PG8_SA(0, 1), a2 + hstep, voffA);
            PG8_WAIT_V(8); PG8_WAIT_L(0); PG8_BAR; PG8_MMA(0, 0, At, B0); PG8_MMA(0, 1, At, B1); PG8_BAR; PG8_SCHED;
            PG8_LDA(At, 1, 1); PG8_STAGE(PG8_SB(1, 0), b3, voffB); PG8_STAGE(PG8_SB(1, 1), b3 + hstep, voffB); PG8_STAGE(PG8_SA(1, 0), a3, voffA);
            PG8_WAIT_V(8); PG8_WAIT_L(0); PG8_BAR; PG8_MMA(1, 0, At, B0); PG8_MMA(1, 1, At, B1); PG8_BAR; PG8_SCHED;
            } else {
            PG8_LDB(B0, 0, 0); PG8_SCHED; PG8_LDA(At, 0, 0); PG8_STAGE(PG8_SA(1, 1), a1 + hstep, voffA);
            PG8_WAIT_L(8); PG8_BAR; PG8_WAIT_L(0); PG8_MMA(0, 0, At, B0); PG8_BAR; PG8_SCHED;
            PG8_LDB(B1, 0, 1); PG8_STAGE(PG8_SB(0, 0), b2, voffB);
            PG8_BAR; PG8_WAIT_L(0); PG8_MMA(0, 1, At, B1); PG8_BAR;
            PG8_LDA(At, 0, 1); PG8_STAGE(PG8_SA(0, 0), a2, voffA);
            PG8_BAR; PG8_WAIT_L(0); PG8_MMA(1, 0, At, B0); PG8_BAR; PG8_SCHED;
            PG8_STAGE(PG8_SB(0, 1), b2 + hstep, voffB);
            PG8_WAIT_V(6); PG8_BAR; PG8_MMA(1, 1, At, B1); PG8_BAR;
            PG8_LDB(B0, 1, 0); PG8_SCHED; PG8_LDA(At, 1, 0); PG8_STAGE(PG8_SA(0, 1), a2 + hstep, voffA);
            PG8_WAIT_L(8); PG8_BAR; PG8_WAIT_L(0); PG8_MMA(0, 0, At, B0); PG8_BAR; PG8_SCHED;
            PG8_LDB(B1, 1, 1); PG8_STAGE(PG8_SB(1, 0), b3, voffB);
            PG8_BAR; PG8_WAIT_L(0); PG8_MMA(0, 1, At, B1); PG8_BAR;
            PG8_LDA(At, 1, 1); PG8_STAGE(PG8_SA(1, 0), a3, voffA);
            PG8_BAR; PG8_WAIT_L(0); PG8_MMA(1, 0, At, B0); PG8_BAR; PG8_SCHED;
            PG8_STAGE(PG8_SB(1, 1), b3 + hstep, voffB);
            PG8_WAIT_V(6); PG8_BAR; PG8_MMA(1, 1, At, B1); PG8_BAR;
            }
        }
        if constexpr (ALIGN_EPI) { if (wr == 0) PG8_BAR; }
        if constexpr (!Epi::AFTER_DRAIN) { E(acc, cur, wr, wc, fr, fq, xlds); S.done(cur); }
        if (!has_next) break;
#pragma unroll
        for (int a = 0; a < 2; ++a)
#pragma unroll
            for (int b = 0; b < 2; ++b)
#pragma unroll
                for (int m = 0; m < 4; ++m)
#pragma unroll
                    for (int n = 0; n < 2; ++n) acc[a][b][m][n] = (f32x4){0.f, 0.f, 0.f, 0.f};
        cur = nxt; cA = nA; cB = nB; ++ui;
        if constexpr (ALIGN_EPI) { if (wr == 1) PG8_BAR; }
    }
    PG8_WAIT_V(0);
    if constexpr (!ALIGN_EPI) { if (wr == 0) PG8_BAR; }
    PG8_BAR;

#undef PG8_SA
#undef PG8_SB
#undef PG8_STAGE
#undef PG8_LDA
#undef PG8_LDB
#undef PG8_MMA
#undef PG8_WAIT_V
#undef PG8_WAIT_L
#undef PG8_BAR
#undef PG8_SCHED
}
}

#define GAS __attribute__((address_space(1)))
#define LAS __attribute__((address_space(3)))
typedef unsigned short bf16;
typedef float f32x4 __attribute__((ext_vector_type(4)));
typedef short bf16x8 __attribute__((ext_vector_type(8)));
typedef unsigned u32x4 __attribute__((ext_vector_type(4)));
typedef unsigned u32x2 __attribute__((ext_vector_type(2)));

constexpr int NWAVES = 8;
constexpr int SEQ = 16384, DMODEL = 2048, NMEM = 256, DIN = 3584, DCONV = 768, DPOOL = 768, DXATT = 512, DFF = 5632, DFF2 = 11264;
constexpr int PGD = 192;
constexpr float EPS = 1e-6f;
constexpr int LDS_BYTES = 147456;
#ifndef MK_PER_PHASE
#define MK_PER_PHASE 0
#endif
constexpr int NPHASE = 7;
#ifndef PHM
#define PHM 255
#endif
#ifndef FUSE_FIXUP
#define FUSE_FIXUP 0
#endif
#ifndef P1_WGM
#define P1_WGM 4
#endif
#ifndef P4_WGM
#define P4_WGM 4
#endif
#ifndef P1_ALIGN
#define P1_ALIGN false
#endif
#ifndef USE_CG_SYNC
#define USE_CG_SYNC 0
#endif
#ifndef PROBE_P2
#define PROBE_P2 0
#endif
#ifndef PROBE_SYNC
#define PROBE_SYNC 0
#endif
#ifndef PROBE_GEMM
#define PROBE_GEMM 0
#endif
#ifndef PROBE_N
#define PROBE_N 2048
#endif
#ifndef REPM
#define REPM 0
#endif

constexpr size_t MiB = 1u << 20;
constexpr size_t WS_KB = 1 * MiB;
constexpr size_t WS_VT = 1 * MiB + 256 * 1024;
constexpr size_t WS_POOLWT = 1 * MiB + 512 * 1024;
constexpr size_t WS_MB = 2 * MiB;
constexpr size_t WS_WKVT = 3 * MiB;
constexpr size_t WS_SIGX = 7 * MiB + 128 * 1024;
constexpr size_t WS_GINV = 7 * MiB + 256 * 1024;
constexpr size_t WS_SIG = 7 * MiB;
constexpr size_t WS_SLAB1 = 8 * MiB;
constexpr size_t WS_SLAB2 = 10 * MiB;
constexpr size_t WS_WUPT = 12 * MiB;
constexpr size_t WS_WDOWNT = 56 * MiB;
constexpr size_t WS_UBND = 80 * MiB;
constexpr size_t WS_X1B = 96 * MiB;
constexpr size_t WS_ACT = 160 * MiB;
constexpr size_t WS_H = 160 * MiB;
constexpr size_t WS_Z = 225 * MiB;
constexpr size_t WS_ZPAD = WS_Z - (size_t)16 * 3584 * 2;
constexpr size_t WS_MIX = 338 * MiB;
constexpr size_t WS_WINT = 402 * MiB;
constexpr size_t WS_WOUTT = 416 * MiB;
constexpr size_t WS_END = 424 * MiB;

__device__ __forceinline__ unsigned f2bf(float f) { unsigned u = __builtin_bit_cast(unsigned, f); return (u + 0x7fffu + ((u >> 16) & 1u)) >> 16; }
__device__ __forceinline__ unsigned pk2(float lo, float hi) { return f2bf(lo) | (f2bf(hi) << 16); }
__device__ __forceinline__ float bflo(unsigned w) { return __builtin_bit_cast(float, w << 16); }
__device__ __forceinline__ float bfhi(unsigned w) { return __builtin_bit_cast(float, w & 0xffff0000u); }
__device__ __forceinline__ void unpack8(const u32x4 w, float (&f)[8]) { f[0] = bflo(w.x); f[1] = bfhi(w.x); f[2] = bflo(w.y); f[3] = bfhi(w.y); f[4] = bflo(w.z); f[5] = bfhi(w.z); f[6] = bflo(w.w); f[7] = bfhi(w.w); }
__device__ __forceinline__ u32x4 pack8(const float (&f)[8]) { u32x4 w; w.x = pk2(f[0], f[1]); w.y = pk2(f[2], f[3]); w.z = pk2(f[4], f[5]); w.w = pk2(f[6], f[7]); return w; }
__device__ __forceinline__ float wave_sum(float v) {
#pragma unroll
    for (int o = 1; o < 64; o <<= 1) v += __shfl_xor(v, o);
    return v;
}
#define LDS_WAIT() asm volatile("s_waitcnt lgkmcnt(0)" ::: "memory")

typedef GAS unsigned gu32;
constexpr size_t WS_CTL = 0, CTL_ZERO_BYTES = 64 * 1024;
constexpr int CW_PANEL2 = 12288;
constexpr int CW_PANEL1 = 8192;
constexpr int CW_PANEL = 4096;
constexpr int MISC_OFF = 131072 + 320;
constexpr int XLDS_OFF = 131072 + 1024;
#define XB_TMO      128
#define XB_XCNT(j)  (256  + 64 * (j))
#define XB_XSUB(j)  (1280 + 64 * (j))
#define XB_XGEN(j)  (2304 + 64 * (j))
#define XB_TOP      3328
#define XB_TOPGEN   3392
#define XCD_BAR_WORDS 3456
#define XB_SPIN_CAP (1u << 18)

__device__ __forceinline__ unsigned xb_ld(unsigned* p)              { return __hip_atomic_load(p, __ATOMIC_RELAXED, __HIP_MEMORY_SCOPE_AGENT); }
__device__ __forceinline__ unsigned xb_add(unsigned* p, unsigned v) { return __hip_atomic_fetch_add(p, v, __ATOMIC_RELAXED, __HIP_MEMORY_SCOPE_AGENT); }
__device__ __forceinline__ unsigned xb_xcc_id() { return (unsigned)__builtin_amdgcn_s_getreg((3 << 11) | 20) & 0xFu; }
#define XB_SPIN(cond, bar) do { unsigned _sp = 0; while (cond) { __builtin_amdgcn_s_sleep(1); \
    if ((++_sp & 255u) == 0u) { if (xb_ld(&(bar)[XB_TMO])) break; if (_sp > XB_SPIN_CAP) { atomicAdd(&(bar)[XB_TMO], 1u); break; } } } } while (0)

struct XcdBarrier {
    unsigned* bar; unsigned x;
    volatile LAS unsigned* st;
};

__device__ __forceinline__ XcdBarrier xcd_barrier_post(unsigned* bar, volatile LAS unsigned* st) {
    XcdBarrier b; b.bar = bar; b.x = xb_xcc_id(); b.st = st;
    if (threadIdx.x == 0) (void)xb_add(&bar[XB_XCNT(b.x)], 1u);
    return b;
}
__device__ __forceinline__ void xcd_barrier_complete(unsigned* bar, unsigned x, unsigned& nloc, unsigned& nx) {
    const unsigned G = gridDim.x * gridDim.y * gridDim.z;
    unsigned sum, cnt, mine, sp = 0u;
    for (;;) {
        sum = 0u; cnt = 0u; mine = 0u;
#pragma unroll
        for (unsigned j = 0; j < 16; ++j) { const unsigned c = xb_ld(&bar[XB_XCNT(j)]); sum += c; cnt += (c > 0u) ? 1u : 0u; mine = (j == x) ? c : mine; }
        if (sum == G) break;
        __builtin_amdgcn_s_sleep(1);
        if ((++sp & 255u) == 0u) { if (xb_ld(&bar[XB_TMO])) break; if (sp > XB_SPIN_CAP) { atomicAdd(&bar[XB_TMO], 1u); break; } }
    }
    nloc = mine > 0u ? mine : 1u; nx = cnt > 0u ? cnt : 1u;
}

__device__ __forceinline__ void xcd_barrier(const XcdBarrier& b) {
    asm volatile("s_waitcnt vmcnt(0)" ::: "memory");
    __syncthreads();
    if (threadIdx.x == 0) {
        unsigned* bar = b.bar;
        __builtin_amdgcn_s_waitcnt(0);
        unsigned nloc = b.st[0], nx = b.st[1];
        if (nloc == 0u) { xcd_barrier_complete(bar, b.x, nloc, nx); b.st[0] = nloc; b.st[1] = nx; }
        const unsigned old = xb_add(&bar[XB_XSUB(b.x)], 1u);
        const unsigned gen = old / nloc;
        if (old + 1u == (gen + 1u) * nloc) {
            __builtin_amdgcn_fence(__ATOMIC_RELEASE, "agent");
            asm volatile("s_waitcnt vmcnt(0)" ::: "memory");
            const unsigned og = xb_add(&bar[XB_TOP], 1u);
            const unsigned tg = og / nx;
            if (og + 1u == (tg + 1u) * nx) xb_add(&bar[XB_TOPGEN], 1u);
            else XB_SPIN(xb_ld(&bar[XB_TOPGEN]) == tg, bar);
            __builtin_amdgcn_fence(__ATOMIC_ACQUIRE, "agent");
            xb_add(&bar[XB_XGEN(b.x)], 1u);
            asm volatile("s_waitcnt vmcnt(0)" ::: "memory");
        } else {
            XB_SPIN(xb_ld(&bar[XB_XGEN(b.x)]) == gen, bar);
            __builtin_amdgcn_fence(__ATOMIC_ACQUIRE, "agent");
            asm volatile("s_waitcnt vmcnt(0)" ::: "memory");
        }
    }
    __syncthreads();
}


struct TrItem { const float* src; const float* ks; bf16* dst; int N, K; };
template <bool UPMAP> __device__ __forceinline__ TrItem tr_make(const float* W, int K, int N, bf16* WT, const float* ks, int item) {
    const int nblk = N / 64, kb = item / nblk, nb = item % nblk, k0 = 64 * kb, n0 = 64 * nb;
    const int r0 = !UPMAP ? n0 : (n0 < DFF ? 256 * (n0 / 128) + (n0 % 128) : 256 * ((n0 - DFF) / 128) + 128 + ((n0 - DFF) % 128));
    TrItem t; t.src = W + (size_t)k0 * N + n0; t.ks = ks ? ks + k0 : nullptr; t.dst = WT + (size_t)r0 * K + k0; t.N = N; t.K = K; return t;
}
__device__ __forceinline__ void tr_load(const TrItem& t, f32x4 (&v)[16], int lane) {
    const float* src = t.src + (size_t)(lane >> 4) * t.N + 4 * (lane & 15);
#pragma unroll
    for (int i = 0; i < 16; ++i) v[i] = *(const f32x4*)(src + (size_t)(4 * i) * t.N);
}
__device__ __forceinline__ void tr_store(const TrItem& t, const f32x4 (&v)[16], LAS float* scr, int lane) {
#pragma unroll
    for (int i = 0; i < 16; ++i) { f32x4 x = v[i]; if (t.ks) x = x * t.ks[4 * i + (lane >> 4)];
        *(LAS f32x4*)(scr + (4 * i + (lane >> 4)) * 64 + (((lane & 15) ^ ((i >> 1) & 7)) << 2)) = x; }
    LDS_WAIT(); asm volatile("" ::: "memory");
    const int c = lane & 7;
#pragma unroll
    for (int j = 0; j < 8; ++j) { const int nn = (lane >> 3) + 8 * j; const LAS float* sp = scr + (8 * c) * 64 + ((((nn >> 2) ^ c) & 15) << 2) + (nn & 3);
        u32x4 o; o.x = pk2(sp[0 * 64], sp[1 * 64]); o.y = pk2(sp[2 * 64], sp[3 * 64]); o.z = pk2(sp[4 * 64], sp[5 * 64]); o.w = pk2(sp[6 * 64], sp[7 * 64]);
        *(u32x4*)(t.dst + (size_t)nn * t.K + 8 * c) = o; }
    LDS_WAIT(); asm volatile("" ::: "memory");
}
__device__ __forceinline__ void rms_rows2_to_bf16(const float* xa, const float* xb, const float* g, bf16* oa, bf16* ob, int lane, float* sig2 = nullptr) {
    const f32x4* pa = (const f32x4*)xa + lane; const f32x4* pb = (const f32x4*)xb + lane; const f32x4* gr = (const f32x4*)g + lane;
    f32x4 va[8], vb[8]; float sa = 0.f, sb = 0.f;
#pragma unroll
    for (int j = 0; j < 8; ++j) { va[j] = pa[64 * j]; vb[j] = pb[64 * j]; }
#pragma unroll
    for (int j = 0; j < 8; ++j) { sa += (va[j].x * va[j].x + va[j].y * va[j].y) + (va[j].z * va[j].z + va[j].w * va[j].w); sb += (vb[j].x * vb[j].x + vb[j].y * vb[j].y) + (vb[j].z * vb[j].z + vb[j].w * vb[j].w); }
    const float da = sqrtf(wave_sum(sa) * (1.0f / DMODEL) + EPS), db = sqrtf(wave_sum(sb) * (1.0f / DMODEL) + EPS), ra = 1.0f / da, rb = 1.0f / db;
    if (sig2 && lane == 0) { sig2[0] = da; sig2[1] = db; }
    u32x2* qa = (u32x2*)oa + lane; u32x2* qb = (u32x2*)ob + lane;
#pragma unroll
    for (int j = 0; j < 8; ++j) { const f32x4 gg = gr[64 * j]; u32x2 w;
        w.x = pk2(va[j].x * ra * gg.x, va[j].y * ra * gg.y); w.y = pk2(va[j].z * ra * gg.z, va[j].w * ra * gg.w); qa[64 * j] = w;
        w.x = pk2(vb[j].x * rb * gg.x, vb[j].y * rb * gg.y); w.y = pk2(vb[j].z * rb * gg.z, vb[j].w * rb * gg.w); qb[64 * j] = w; }
}

struct Ptrs {
    const float *x, *mem, *g_mix, *g_mem, *w_in, *conv_w, *pool_w, *pool_scale, *w_kv, *w_out, *g_ffn, *w_up, *ffn_conv_w, *ffn_conv_b, *w_down, *g_final;
    float* out; unsigned char* ws;
};

constexpr int UP_ITEMS = (DMODEL / 64) * (DFF2 / 64), DN_ITEMS = (DFF / 64) * (DMODEL / 64);
#ifndef UP_IN_P0
#define UP_IN_P0 4608
#endif
__device__ __forceinline__ void p1_idle_work(const Ptrs& P, LAS unsigned char* lds, int iw, int NIW, int wave, int lane);
template <int LIST> __device__ __forceinline__ TrItem tr_desc(const Ptrs& P, int it) {
    unsigned char* ws = P.ws;
    constexpr int I_IN = (DMODEL / 64) * (DIN / 64), I_OUT = (DMODEL / 64) * (DMODEL / 64), I_KV = (DMODEL / 64) * (1024 / 64), I_PW = (PGD / 64) * (PGD / 64);
    if (LIST == 0) {
        int r = it;
        if (r < I_IN) return tr_make<false>(P.w_in, DMODEL, DIN, (bf16*)(ws + WS_WINT), nullptr, r); r -= I_IN;
        if (r < I_OUT) return tr_make<false>(P.w_out, DMODEL, DMODEL, (bf16*)(ws + WS_WOUTT), nullptr, r); r -= I_OUT;
        if (r < UP_IN_P0) return tr_make<true>(P.w_up, DMODEL, DFF2, (bf16*)(ws + WS_WUPT), P.g_ffn, r); r -= UP_IN_P0;
        if (r < I_KV) return tr_make<false>(P.w_kv, DMODEL, 1024, (bf16*)(ws + WS_WKVT), nullptr, r); r -= I_KV;
        const int g = r / I_PW; r -= g * I_PW;
        return tr_make<false>(P.pool_w + (size_t)g * PGD * PGD, PGD, PGD, (bf16*)(ws + WS_POOLWT) + (size_t)g * PGD * PGD, nullptr, r);
    } else {
        if (it < DN_ITEMS) return tr_make<false>(P.w_down, DFF, DMODEL, (bf16*)(ws + WS_WDOWNT), nullptr, it);
        return tr_make<true>(P.w_up, DMODEL, DFF2, (bf16*)(ws + WS_WUPT), P.g_ffn, UP_IN_P0 + it - DN_ITEMS);
    }
}
template <int LIST> __device__ __forceinline__ void tr_stream(const Ptrs& P, LAS float* scr, int first, int stride, int nitems, int lane) {
    if (first >= nitems) return;
    TrItem cur = tr_desc<LIST>(P, first); f32x4 va[16], vb[16];
    tr_load(cur, va, lane);
    for (int it = first; it < nitems; it += 2 * stride) {
        TrItem nx = cur; const bool h1 = it + stride < nitems; if (h1) { nx = tr_desc<LIST>(P, it + stride); tr_load(nx, vb, lane); }
        tr_store(cur, va, scr, lane);
        if (!h1) break;
        const bool h2 = it + 2 * stride < nitems; if (h2) { cur = tr_desc<LIST>(P, it + 2 * stride); tr_load(cur, va, lane); }
        tr_store(nx, vb, scr, lane);
        if (!h2) break;
    }
}
__device__ __forceinline__ void p0_prologue(const Ptrs& P, LAS unsigned char* lds, int gw, int NGW, int wave, int lane) {
    LAS float* scr = (LAS float*)(lds + wave * 16384);
    unsigned char* ws = P.ws;
    constexpr int NITEMS = (DMODEL / 64) * (DIN / 64) + (DMODEL / 64) * (DMODEL / 64) + UP_IN_P0 + (DMODEL / 64) * (1024 / 64) + 4 * (PGD / 64) * (PGD / 64);
    tr_stream<0>(P, scr, gw, NGW, NITEMS, lane);
    for (int i = gw * 64 + lane; i < DMODEL; i += NGW * 64) ((float*)(ws + WS_GINV))[i] = 1.0f / P.g_mix[i];
    for (int i = gw * 64 + lane; i < 16 * DIN * 2 / 16; i += NGW * 64) ((u32x4*)(ws + WS_ZPAD))[i] = (u32x4){0u, 0u, 0u, 0u};
    for (int m = 2 * gw; m < SEQ; m += 2 * NGW) rms_rows2_to_bf16(P.x + (size_t)m * DMODEL, P.x + (size_t)(m + 1) * DMODEL, P.g_mix, (bf16*)(ws + WS_H) + (size_t)m * DMODEL, (bf16*)(ws + WS_H) + (size_t)(m + 1) * DMODEL, lane, (float*)(ws + WS_SIGX) + m);
    for (int m = 2 * gw; m < NMEM; m += 2 * NGW) rms_rows2_to_bf16(P.mem + (size_t)m * DMODEL, P.mem + (size_t)(m + 1) * DMODEL, P.g_mem, (bf16*)(ws + WS_MB) + (size_t)m * DMODEL, (bf16*)(ws + WS_MB) + (size_t)(m + 1) * DMODEL, lane);
}

__device__ __forceinline__ void kv_tile(const Ptrs& P, int tt, int lane) {
    const bf16* mB = (const bf16*)(P.ws + WS_MB); const bf16* wT = (const bf16*)(P.ws + WS_WKVT);
    const int rb = tt >> 6, cb = tt & 63, fr = lane & 15, fq = lane >> 4;
    const bf16* ap = mB + (size_t)(16 * rb + fr) * DMODEL + 8 * fq; const bf16* wp = wT + (size_t)(16 * cb + fr) * DMODEL + 8 * fq;
    const bool kpart = cb < 32;
    f32x4 acc = {0.f, 0.f, 0.f, 0.f};
    bf16x8 a0[8], w0[8], a1[8], w1[8];
#pragma unroll
    for (int i = 0; i < 8; ++i) { a0[i] = *(const bf16x8*)(ap + 32 * i); w0[i] = *(const bf16x8*)(wp + 32 * i); }
#pragma unroll 1
    for (int kb = 0; kb < 8; kb += 2) {
#pragma unroll
        for (int i = 0; i < 8; ++i) { a1[i] = *(const bf16x8*)(ap + 32 * (8 * kb + 8 + i)); w1[i] = *(const bf16x8*)(wp + 32 * (8 * kb + 8 + i)); }
#pragma unroll
        for (int i = 0; i < 8; ++i) acc = kpart ? __builtin_amdgcn_mfma_f32_16x16x32_bf16(w0[i], a0[i], acc, 0, 0, 0) : __builtin_amdgcn_mfma_f32_16x16x32_bf16(a0[i], w0[i], acc, 0, 0, 0);
        if (kb + 2 < 8) {
#pragma unroll
            for (int i = 0; i < 8; ++i) { a0[i] = *(const bf16x8*)(ap + 32 * (8 * kb + 16 + i)); w0[i] = *(const bf16x8*)(wp + 32 * (8 * kb + 16 + i)); } }
#pragma unroll
        for (int i = 0; i < 8; ++i) acc = kpart ? __builtin_amdgcn_mfma_f32_16x16x32_bf16(w1[i], a1[i], acc, 0, 0, 0) : __builtin_amdgcn_mfma_f32_16x16x32_bf16(a1[i], w1[i], acc, 0, 0, 0);
    }
    u32x2 o; o.x = pk2(acc[0], acc[1]); o.y = pk2(acc[2], acc[3]);
    if (kpart) *(u32x2*)((bf16*)(P.ws + WS_KB) + (size_t)(16 * rb + fr) * 512 + 16 * cb + 4 * fq) = o;
    else *(u32x2*)((bf16*)(P.ws + WS_VT) + (size_t)(16 * cb - 512 + fr) * 256 + 32 * (rb >> 1) + 8 * fq + 4 * (rb & 1)) = o;
}

__device__ __forceinline__ void p1_idle_work(const Ptrs& P, LAS unsigned char* lds, int iw, int NIW, int wave, int lane) {
    LAS float* scr = (LAS float*)(lds + wave * 16384);
    for (int tt = iw; tt < 1024; tt += NIW) kv_tile(P, tt, lane);
    tr_stream<1>(P, scr, iw, NIW, DN_ITEMS + (UP_ITEMS - UP_IN_P0), lane);
}

__device__ __forceinline__ void mix_conv_task(const Ptrs& P, int blk, int lane, int cg0, int cg1) {
    const bf16* z = (const bf16*)(P.ws + WS_Z); bf16* mix = (bf16*)(P.ws + WS_MIX);
    const int t0 = blk * 16;
    for (int cg = cg0 + lane; cg < cg1; cg += 64) {
        const int c = cg * 8;
        float w0[8], w1[8], w2[8], p1[8], p2[8];
#pragma unroll
        for (int e = 0; e < 8; ++e) { w0[e] = P.conv_w[c + e]; w1[e] = P.conv_w[DCONV + c + e]; w2[e] = P.conv_w[2 * DCONV + c + e]; }
        { float a[8], b[8]; unpack8(*(const u32x4*)(z + (long)(t0 - 2) * DIN + DCONV + c), a); unpack8(*(const u32x4*)(z + (long)(t0 - 2) * DIN + 2 * DCONV + c), b);
#pragma unroll
          for (int e = 0; e < 8; ++e) p2[e] = a[e] * b[e];
          unpack8(*(const u32x4*)(z + (long)(t0 - 1) * DIN + DCONV + c), a); unpack8(*(const u32x4*)(z + (long)(t0 - 1) * DIN + 2 * DCONV + c), b);
#pragma unroll
          for (int e = 0; e < 8; ++e) p1[e] = a[e] * b[e]; }
#pragma unroll 4
        for (int r = 0; r < 16; ++r) {
            const int t = t0 + r; float p[8], a[8], b[8], g[8], o[8];
            unpack8(*(const u32x4*)(z + (size_t)t * DIN + DCONV + c), a); unpack8(*(const u32x4*)(z + (size_t)t * DIN + 2 * DCONV + c), b); unpack8(*(const u32x4*)(z + (size_t)t * DIN + c), g);
#pragma unroll
            for (int e = 0; e < 8; ++e) { p[e] = a[e] * b[e]; o[e] = g[e] * (w2[e] * p[e] + w1[e] * p1[e] + w0[e] * p2[e]); p2[e] = p1[e]; p1[e] = p[e]; }
            *(u32x4*)(mix + (size_t)t * DMODEL + c) = pack8(o);
        }
    }
}
template <int g> __device__ __forceinline__ void mix_pool_task(const Ptrs& P, int blk, int lane) {
    constexpr int k = 2 << g;
    const char* zu = (const char*)((const bf16*)(P.ws + WS_Z) + (size_t)(blk * 16) * DIN + 3 * DCONV + PGD * g);
    const char* wu = (const char*)((const bf16*)(P.ws + WS_POOLWT) + (size_t)g * PGD * PGD);
    bf16* mix = (bf16*)(P.ws + WS_MIX);
    const int fr = lane & 15, fq = lane >> 4, t = blk * 16 + fr;
    const unsigned zl = (unsigned)(fr * DIN + 8 * fq) * 2u, wl = (unsigned)(fr * PGD + 8 * fq) * 2u;
    const int cnt = (t + 1 < k) ? t + 1 : k; const float inv = 1.0f / (float)cnt;
    f32x4 acc[12];
#pragma unroll
    for (int n = 0; n < 12; ++n) acc[n] = (f32x4){0.f, 0.f, 0.f, 0.f};
#pragma unroll 1
    for (int ks = 0; ks < 6; ++ks) {
        float sum[8], self[8];
        unpack8(*(const u32x4*)(zu + ks * 64 + zl), self);
#pragma unroll
        for (int e = 0; e < 8; ++e) sum[e] = self[e];
#pragma unroll
        for (int j = 1; j < k; ++j) { float v[8]; unpack8(*(const u32x4*)(zu + ks * 64 - (long)j * (DIN * 2) + zl), v);
#pragma unroll
            for (int e = 0; e < 8; ++e) sum[e] += v[e]; }
        float pl[8];
#pragma unroll
        for (int e = 0; e < 8; ++e) pl[e] = sum[e] * inv - self[e];
        const bf16x8 pf = __builtin_bit_cast(bf16x8, pack8(pl));
#pragma unroll
        for (int n = 0; n < 12; ++n) { const bf16x8 wf = *(const bf16x8*)(wu + n * (16 * PGD * 2) + ks * 64 + wl); acc[n] = __builtin_amdgcn_mfma_f32_16x16x32_bf16(wf, pf, acc[n], 0, 0, 0); }
    }
#pragma unroll
    for (int n = 0; n < 12; ++n) { const int d = 16 * n + 4 * fq; const f32x4 sc = *(const f32x4*)(P.pool_scale + PGD * g + d);
        u32x2 o; o.x = pk2(acc[n][0] * sc[0], acc[n][1] * sc[1]); o.y = pk2(acc[n][2] * sc[2], acc[n][3] * sc[3]);
        *(u32x2*)(mix + (size_t)t * DMODEL + DCONV + PGD * g + d) = o; }
}
__device__ __forceinline__ void mix_attn_task(const Ptrs& P, int h, int blk, int lane) {
    const bf16* z = (const bf16*)(P.ws + WS_Z); bf16* mix = (bf16*)(P.ws + WS_MIX); const bf16* Kb = (const bf16*)(P.ws + WS_KB); const bf16* Vt = (const bf16*)(P.ws + WS_VT);
    const int fr = lane & 15, fq = lane >> 4, t = blk * 16 + fr;
    bf16x8 qf[4];
#pragma unroll
    for (int ks = 0; ks < 4; ++ks) qf[ks] = *(const bf16x8*)(z + (size_t)t * DIN + 3 * DCONV + DPOOL + 128 * h + 32 * ks + 8 * fq);
    f32x4 s[16];
#pragma unroll
    for (int kb = 0; kb < 16; ++kb) { s[kb] = (f32x4){0.f, 0.f, 0.f, 0.f};
#pragma unroll
        for (int ks = 0; ks < 4; ++ks) { const bf16x8 kf = *(const bf16x8*)(Kb + (size_t)(16 * kb + fr) * 512 + 128 * h + 32 * ks + 8 * fq); s[kb] = __builtin_amdgcn_mfma_f32_16x16x32_bf16(kf, qf[ks], s[kb], 0, 0, 0); } }
    float mx = -3.0e38f;
#pragma unroll
    for (int kb = 0; kb < 16; ++kb) mx = fmaxf(fmaxf(fmaxf(s[kb][0], s[kb][1]), fmaxf(s[kb][2], s[kb][3])), mx);
    mx = fmaxf(mx, __shfl_xor(mx, 16)); mx = fmaxf(mx, __shfl_xor(mx, 32));
    const float c2 = 0.08838834764831845f * 1.4426950408889634f;
    float sum = 0.f;
#pragma unroll
    for (int kb = 0; kb < 16; ++kb)
#pragma unroll
        for (int r = 0; r < 4; ++r) { const float p = __builtin_amdgcn_exp2f((s[kb][r] - mx) * c2); s[kb][r] = p; sum += p; }
    sum += __shfl_xor(sum, 16); sum += __shfl_xor(sum, 32);
    const float inv = 1.0f / sum;
    f32x4 o[8];
#pragma unroll
    for (int db = 0; db < 8; ++db) o[db] = (f32x4){0.f, 0.f, 0.f, 0.f};
#pragma unroll
    for (int ks = 0; ks < 8; ++ks) {
        u32x4 pw; pw.x = pk2(s[2 * ks][0], s[2 * ks][1]); pw.y = pk2(s[2 * ks][2], s[2 * ks][3]); pw.z = pk2(s[2 * ks + 1][0], s[2 * ks + 1][1]); pw.w = pk2(s[2 * ks + 1][2], s[2 * ks + 1][3]);
        const bf16x8 pf = __builtin_bit_cast(bf16x8, pw);
#pragma unroll
        for (int db = 0; db < 8; ++db) { const bf16x8 vf = *(const bf16x8*)(Vt + (size_t)(128 * h + 16 * db + fr) * 256 + 32 * ks + 8 * fq); o[db] = __builtin_amdgcn_mfma_f32_16x16x32_bf16(vf, pf, o[db], 0, 0, 0); }
    }
#pragma unroll
    for (int db = 0; db < 8; ++db) { u32x2 w; w.x = pk2(o[db][0] * inv, o[db][1] * inv); w.y = pk2(o[db][2] * inv, o[db][3] * inv);
        *(u32x2*)(mix + (size_t)t * DMODEL + DCONV + DPOOL + 128 * h + 16 * db + 4 * fq) = w; }
}
template <int R, int C, int PCH> __device__ __forceinline__ void lds_stage_rows(LAS unsigned char* dst, const unsigned char* src, int gp, int tid) {
    constexpr int N = R * C, PER = (N + 511) / 512;
    u32x4 v[PER];
#pragma unroll
    for (int i = 0; i < PER; ++i) { const int idx = tid + 512 * i; if (idx < N) { const int row = idx / C, ch = idx % C; v[i] = *(const u32x4*)(src + (size_t)row * gp + ch * 16); } }
#pragma unroll
    for (int i = 0; i < PER; ++i) { const int idx = tid + 512 * i; if (idx < N) { const int row = idx / C, ch = idx % C; *(LAS u32x4*)(dst + row * (PCH * 16) + (((ch & ~15) | ((ch & 15) ^ (row & 15))) << 4)) = v[i]; } }
}
template <int N> __device__ __forceinline__ float dpp_shrN(float old, float src) { return __builtin_bit_cast(float, __builtin_amdgcn_update_dpp(__builtin_bit_cast(int, old), __builtin_bit_cast(int, src), 0x110 + N, 0xf, 0xf, false)); }
template <int N> __device__ __forceinline__ float dpp_rorN(float src) { return __builtin_bit_cast(float, __builtin_amdgcn_mov_dpp(__builtin_bit_cast(int, src), 0x120 + N, 0xf, 0xf, false)); }
template <int N> __device__ __forceinline__ float scan_step(float x, float p) { return x + dpp_shrN<N>(dpp_rorN<N>(p), x); }
template <int N> __device__ __forceinline__ float scan_step_prev(float p) { return p + dpp_shrN<N>(0.f, p); }

__device__ __forceinline__ void mix_attn_wave(const Ptrs& P, LAS unsigned char* ldsK, LAS unsigned char* ldsV, int h, int row0, int lane) {
    const bf16* z = (const bf16*)(P.ws + WS_Z); bf16* mix = (bf16*)(P.ws + WS_MIX);
    const int fr = lane & 15, fq = lane >> 4;
    bf16x8 q0[4], q1[4];
#pragma unroll
    for (int ks = 0; ks < 4; ++ks) { const bf16* qp = z + (size_t)(row0 + fr) * DIN + 3 * DCONV + DPOOL + 128 * h + 32 * ks + 8 * fq; q0[ks] = *(const bf16x8*)qp; q1[ks] = *(const bf16x8*)(qp + 16 * DIN); }
    unsigned offk[4];
#pragma unroll
    for (int ks = 0; ks < 4; ++ks) offk[ks] = (unsigned)(fr * 256 + (((4 * ks + fq) ^ fr) << 4));
    f32x4 s0[16], s1[16];
#pragma unroll
    for (int kb = 0; kb < 16; ++kb) { s0[kb] = (f32x4){0.f, 0.f, 0.f, 0.f}; s1[kb] = (f32x4){0.f, 0.f, 0.f, 0.f};
#pragma unroll
        for (int ks = 0; ks < 4; ++ks) { const bf16x8 kf = *(const LAS bf16x8*)(ldsK + kb * 4096 + offk[ks]);
            s0[kb] = __builtin_amdgcn_mfma_f32_16x16x32_bf16(kf, q0[ks], s0[kb], 0, 0, 0); s1[kb] = __builtin_amdgcn_mfma_f32_16x16x32_bf16(kf, q1[ks], s1[kb], 0, 0, 0); } }
    const float c2 = 0.08838834764831845f * 1.4426950408889634f;
    bf16x8 p0[8], p1[8]; float inv0, inv1;
    {   float mx = -3.0e38f;
#pragma unroll
        for (int kb = 0; kb < 16; ++kb) mx = fmaxf(fmaxf(fmaxf(s0[kb][0], s0[kb][1]), fmaxf(s0[kb][2], s0[kb][3])), mx);
        mx = fmaxf(mx, __shfl_xor(mx, 16)); mx = fmaxf(mx, __shfl_xor(mx, 32));
        float sum = 0.f;
#pragma unroll
        for (int ks = 0; ks < 8; ++ks) { float e[8];
#pragma unroll
            for (int r = 0; r < 4; ++r) { e[r] = __builtin_amdgcn_exp2f((s0[2 * ks][r] - mx) * c2); e[4 + r] = __builtin_amdgcn_exp2f((s0[2 * ks + 1][r] - mx) * c2); }
            sum += ((e[0] + e[1]) + (e[2] + e[3])) + ((e[4] + e[5]) + (e[6] + e[7]));
            p0[ks] = __builtin_bit_cast(bf16x8, pack8(e)); }
        sum += __shfl_xor(sum, 16); sum += __shfl_xor(sum, 32); inv0 = 1.0f / sum; }
    {   float mx = -3.0e38f;
#pragma unroll
        for (int kb = 0; kb < 16; ++kb) mx = fmaxf(fmaxf(fmaxf(s1[kb][0], s1[kb][1]), fmaxf(s1[kb][2], s1[kb][3])), mx);
        mx = fmaxf(mx, __shfl_xor(mx, 16)); mx = fmaxf(mx, __shfl_xor(mx, 32));
        float sum = 0.f;
#pragma unroll
        for (int ks = 0; ks < 8; ++ks) { float e[8];
#pragma unroll
            for (int r = 0; r < 4; ++r) { e[r] = __builtin_amdgcn_exp2f((s1[2 * ks][r] - mx) * c2); e[4 + r] = __builtin_amdgcn_exp2f((s1[2 * ks + 1][r] - mx) * c2); }
            sum += ((e[0] + e[1]) + (e[2] + e[3])) + ((e[4] + e[5]) + (e[6] + e[7]));
            p1[ks] = __builtin_bit_cast(bf16x8, pack8(e)); }
        sum += __shfl_xor(sum, 16); sum += __shfl_xor(sum, 32); inv1 = 1.0f / sum; }
    f32x4 o0[8], o1[8];
#pragma unroll
    for (int db = 0; db < 8; ++db) { o0[db] = (f32x4){0.f, 0.f, 0.f, 0.f}; o1[db] = (f32x4){0.f, 0.f, 0.f, 0.f}; }
#pragma unroll
    for (int ks = 0; ks < 8; ++ks) {
        const unsigned offv = (unsigned)(fr * 512 + ((ks >> 2) << 8) + (((4 * (ks & 3) + fq) ^ fr) << 4));
#pragma unroll
        for (int db = 0; db < 8; ++db) { const bf16x8 vf = *(const LAS bf16x8*)(ldsV + db * 8192 + offv);
            o0[db] = __builtin_amdgcn_mfma_f32_16x16x32_bf16(vf, p0[ks], o0[db], 0, 0, 0); o1[db] = __builtin_amdgcn_mfma_f32_16x16x32_bf16(vf, p1[ks], o1[db], 0, 0, 0); } }
    bf16* op = mix + (size_t)(row0 + fr) * DMODEL + DCONV + DPOOL + 128 * h + 4 * fq;
#pragma unroll
    for (int db = 0; db < 8; ++db) { u32x2 w; w.x = pk2(o0[db][0] * inv0, o0[db][1] * inv0); w.y = pk2(o0[db][2] * inv0, o0[db][3] * inv0); *(u32x2*)(op + 16 * db) = w;
        w.x = pk2(o1[db][0] * inv1, o1[db][1] * inv1); w.y = pk2(o1[db][2] * inv1, o1[db][3] * inv1); *(u32x2*)(op + (size_t)16 * DMODEL + 16 * db) = w; }
}

template <int g> __device__ __forceinline__ void mix_pool_wave(const Ptrs& P, LAS unsigned char* ldsW, int row0, int lane) {
    constexpr int k = 2 << g;
    const bf16* z = (const bf16*)(P.ws + WS_Z); bf16* mix = (bf16*)(P.ws + WS_MIX);
    const int fr = lane & 15, fq = lane >> 4;
    f32x4 acc0[12], acc1[12];
#pragma unroll
    for (int n = 0; n < 12; ++n) { acc0[n] = (f32x4){0.f, 0.f, 0.f, 0.f}; acc1[n] = (f32x4){0.f, 0.f, 0.f, 0.f}; }
    const float invA = 1.0f / (float)((row0 + fr + 1 < k) ? row0 + fr + 1 : k), invB = 1.0f / (float)((row0 + 16 + fr + 1 < k) ? row0 + 16 + fr + 1 : k);
#pragma unroll 1
    for (int ks = 0; ks < 6; ++ks) {
        const bf16* zp = z + (long)(row0 - 16 + fr) * DIN + 3 * DCONV + PGD * g + 32 * ks + 8 * fq;
        float pv[8], xa[8], xb[8], sa[8], sb[8];
        unpack8(*(const u32x4*)zp, pv); unpack8(*(const u32x4*)(zp + 16 * DIN), xa); unpack8(*(const u32x4*)(zp + 32 * DIN), xb);
#pragma unroll
        for (int e = 0; e < 8; ++e) {
            float p = pv[e], a = xa[e], b = xb[e];
            float b1 = scan_step<1>(b, a), a1 = scan_step<1>(a, p), p1 = scan_step_prev<1>(p);
            if (k >= 4) { const float b2 = scan_step<2>(b1, a1), a2 = scan_step<2>(a1, p1), p2 = scan_step_prev<2>(p1); b1 = b2; a1 = a2; p1 = p2; }
            if (k >= 8) { const float b2 = scan_step<4>(b1, a1), a2 = scan_step<4>(a1, p1), p2 = scan_step_prev<4>(p1); b1 = b2; a1 = a2; p1 = p2; }
            if (k >= 16) { const float b2 = scan_step<8>(b1, a1), a2 = scan_step<8>(a1, p1); b1 = b2; a1 = a2; }
            sa[e] = a1 * invA - a; sb[e] = b1 * invB - b; }
        const bf16x8 fa = __builtin_bit_cast(bf16x8, pack8(sa)), fb = __builtin_bit_cast(bf16x8, pack8(sb));
        const unsigned offw = (unsigned)(fr * 512 + ((ks >> 2) << 8) + (((4 * (ks & 3) + fq) ^ fr) << 4));
#pragma unroll
        for (int n = 0; n < 12; ++n) { const bf16x8 wf = *(const LAS bf16x8*)(ldsW + n * 8192 + offw);
            acc0[n] = __builtin_amdgcn_mfma_f32_16x16x32_bf16(wf, fa, acc0[n], 0, 0, 0); acc1[n] = __builtin_amdgcn_mfma_f32_16x16x32_bf16(wf, fb, acc1[n], 0, 0, 0); }
    }
    bf16* op = mix + (size_t)(row0 + fr) * DMODEL + DCONV + PGD * g + 4 * fq;
#pragma unroll
    for (int n = 0; n < 12; ++n) { const f32x4 sc = *(const f32x4*)(P.pool_scale + PGD * g + 16 * n + 4 * fq);
        u32x2 o; o.x = pk2(acc0[n][0] * sc[0], acc0[n][1] * sc[1]); o.y = pk2(acc0[n][2] * sc[2], acc0[n][3] * sc[3]); *(u32x2*)(op + 16 * n) = o;
        o.x = pk2(acc1[n][0] * sc[0], acc1[n][1] * sc[1]); o.y = pk2(acc1[n][2] * sc[2], acc1[n][3] * sc[3]); *(u32x2*)(op + (size_t)16 * DMODEL + 16 * n) = o; }
}

__device__ __forceinline__ void p2_mixer(const Ptrs& P, LAS unsigned char* lds, int w, int tid, int wave, int lane, int tmask) {
    const int sub = w & 3, tile = w >> 2, row0 = tile * 256 + (wave & 3) * 64;
    lds_stage_rows<256, 16, 16>(lds, (const unsigned char*)(P.ws + WS_KB) + 256 * sub, 1024, tid);
    lds_stage_rows<128, 32, 32>(lds + 65536, (const unsigned char*)(P.ws + WS_VT) + (size_t)sub * 128 * 512, 512, tid);
    LDS_WAIT(); __syncthreads();
    if (wave < 4) { if (tmask & 0x1e0) {
#pragma unroll 1
        for (int p = 0; p < 2; ++p) { asm volatile("" ::: "memory"); mix_attn_wave(P, lds, lds + 65536, sub, row0 + 32 * p, lane); } } }
    else if (tmask & 1) mix_conv_task(P, 4 * w + (wave - 4), lane, 0, 48);
    __syncthreads();
    lds_stage_rows<192, 24, 32>(lds, (const unsigned char*)(P.ws + WS_POOLWT) + (size_t)sub * PGD * PGD * 2, PGD * 2, tid);
    LDS_WAIT(); __syncthreads();
    if (wave < 4) { if (tmask & 0x1e) {
#pragma unroll 1
        for (int p = 0; p < 2; ++p) { const int r = row0 + 32 * p; asm volatile("" ::: "memory");
            if (sub == 0) mix_pool_wave<0>(P, lds, r, lane); else if (sub == 1) mix_pool_wave<1>(P, lds, r, lane); else if (sub == 2) mix_pool_wave<2>(P, lds, r, lane); else mix_pool_wave<3>(P, lds, r, lane); } } }
    else if (tmask & 1) mix_conv_task(P, 4 * w + (wave - 4), lane, 48, 96);
    __syncthreads();
}

__device__ __forceinline__ void p5_fix_item(const Ptrs& P, int pm, int c) {
    const float* ub = (const float*)(P.ws + WS_UBND); bf16* act = (bf16*)(P.ws + WS_ACT); const float* cw = P.ffn_conv_w; const float* cb = P.ffn_conv_b;
    const int gi = 256 * (c / 128) + (c % 128);
    const float* p2 = ub + (size_t)((pm - 1) * 4 + 2) * DFF2 + gi; const float* p1 = p2 + DFF2; const float* r0 = ub + (size_t)(pm * 4) * DFF2 + gi; const float* r1 = r0 + DFF2;
    float o0[8], o1[8];
#pragma unroll
    for (int e = 0; e < 8; ++e) {
        const float gw0 = cw[c + e], gw1 = cw[DFF2 + c + e], gw2 = cw[2 * DFF2 + c + e], gb = cb[c + e], vw0 = cw[DFF + c + e], vw1 = cw[DFF2 + DFF + c + e], vw2 = cw[2 * DFF2 + DFF + c + e], vb = cb[DFF + c + e];
        const float G0 = gw2 * r0[e] + (gw1 * p1[e] + (gw0 * p2[e] + gb)), V0 = vw2 * r0[128 + e] + (vw1 * p1[128 + e] + (vw0 * p2[128 + e] + vb));
        const float G1 = gw2 * r1[e] + (gw1 * r0[e] + (gw0 * p1[e] + gb)), V1 = vw2 * r1[128 + e] + (vw1 * r0[128 + e] + (vw0 * p1[128 + e] + vb));
        o0[e] = G0 * __builtin_amdgcn_rcpf(1.0f + __builtin_amdgcn_exp2f(-1.4426950408889634f * G0)) * V0;
        o1[e] = G1 * __builtin_amdgcn_rcpf(1.0f + __builtin_amdgcn_exp2f(-1.4426950408889634f * G1)) * V1; }
    *(u32x4*)(act + (size_t)(256 * pm) * DFF + c) = pack8(o0); *(u32x4*)(act + (size_t)(256 * pm + 1) * DFF + c) = pack8(o1);
}
__device__ __forceinline__ void p6_fixup_panels(const Ptrs& P, int vcu, int G, int tid, unsigned* cnt, unsigned* tmo) {
    constexpr int GRP = DFF / 8 / 8;
    const int nround = (512 + G - 1) / G;
    for (int i = 0; i < nround; ++i) { const int L = i * G + vcu; if (L >= 512) break; const int pm = L >> 3, pn = L & 7;
        if (pm > 0 && tid < GRP) p5_fix_item(P, pm, (pn * GRP + tid) * 8); }
    asm volatile("s_waitcnt vmcnt(0)" ::: "memory"); __syncthreads();
    if (tid == 0) {
        __builtin_amdgcn_fence(__ATOMIC_RELEASE, "agent"); asm volatile("s_waitcnt vmcnt(0)" ::: "memory");
        for (int i = 0; i < nround; ++i) { const int L = i * G + vcu; if (L >= 512) break; __hip_atomic_fetch_add(cnt + 64 * (L >> 3), 1u, __ATOMIC_RELAXED, __HIP_MEMORY_SCOPE_AGENT); }
        for (int i = 0; i < nround; ++i) { const int L = i * G + vcu; if (L >= 512) break; unsigned spins = 0;
            while (__hip_atomic_load(cnt + 64 * (L >> 3), __ATOMIC_RELAXED, __HIP_MEMORY_SCOPE_AGENT) < 8u) { __builtin_amdgcn_s_sleep(2); if (++spins > (1u << 20)) { __hip_atomic_store(tmo, 1u, __ATOMIC_RELAXED, __HIP_MEMORY_SCOPE_AGENT); break; } } }
        __builtin_amdgcn_fence(__ATOMIC_ACQUIRE, "agent"); asm volatile("s_waitcnt vmcnt(0)" ::: "memory");
    }
    __syncthreads();
}
__device__ __forceinline__ void p5_fixup(const Ptrs& P, int gt, int NGT) {
    for (int i = gt; i < 63 * (DFF / 8); i += NGT) p5_fix_item(P, 1 + i / (DFF / 8), (i % (DFF / 8)) * 8);
}

__device__ __forceinline__ void p7_final(const Ptrs& P, int gw, int NGW, int lane) {
    const float* slab = (const float*)(P.ws + WS_SLAB2);
    for (int m = gw; m < SEQ; m += NGW) {
        const float part = (lane < 32) ? slab[(size_t)m * 32 + lane] : 0.f;
        const float rstd = 1.0f / sqrtf(wave_sum(part) * (1.0f / DMODEL) + EPS);
        f32x4* xr = (f32x4*)(P.out + (size_t)m * DMODEL) + lane; const f32x4* gr = (const f32x4*)P.g_final + lane;
#pragma unroll
        for (int j = 0; j < 8; ++j) { f32x4 v = xr[64 * j]; const f32x4 gg = gr[64 * j]; v = v * rstd * gg; xr[64 * j] = v; }
    }
}

struct Args { const float* in[16]; float* out; unsigned char* ws; int ph_lo, ph_hi; };
__global__ void __launch_bounds__(NWAVES * 64, 2) hybrid_fwd(Args args) {
    extern __shared__ __attribute__((aligned(16))) unsigned char lds_raw[];
    LAS unsigned char* lds = (LAS unsigned char*)lds_raw;
    cg::grid_group grid = cg::this_grid();
    const int tid = threadIdx.x, lane = tid & 63, wave = __builtin_amdgcn_readfirstlane(tid >> 6);
    const int G = gridDim.x, bx = blockIdx.x, vcu = (G % 8 == 0) ? (bx % 8) * (G / 8) + bx / 8 : bx;
    const int gw = vcu * NWAVES + wave, NGW = G * NWAVES;
    volatile LAS unsigned* MISC = (volatile LAS unsigned*)(lds + MISC_OFF);
    if (tid < 32) MISC[tid] = 0u;
    __syncthreads();
    const XcdBarrier bar = xcd_barrier_post((unsigned*)(args.ws + WS_CTL), MISC + 8);
    Ptrs P;
    P.x = args.in[0]; P.mem = args.in[1]; P.g_mix = args.in[2]; P.g_mem = args.in[3]; P.w_in = args.in[4]; P.conv_w = args.in[5]; P.pool_w = args.in[6]; P.pool_scale = args.in[7];
    P.w_kv = args.in[8]; P.w_out = args.in[9]; P.g_ffn = args.in[10]; P.w_up = args.in[11]; P.ffn_conv_w = args.in[12]; P.ffn_conv_b = args.in[13]; P.w_down = args.in[14]; P.g_final = args.in[15];
    P.out = args.out; P.ws = args.ws;
    unsigned char* ws = args.ws;
#if PROBE_SYNC
    for (int i = 0; i < 20; ++i) xcd_barrier(bar);
#endif
    const int lo = args.ph_lo, hi = args.ph_hi;
#define IN(k) (lo <= (k) && (k) < hi)
#define SYNC(k) do { if ((k) + 1 < hi) { if ((k) == 0 && USE_CG_SYNC) grid.sync(); else xcd_barrier(bar); } } while (0)
#define SYNCR(k, b) do { if ((k) + 1 < hi || rp + 1 < NREP(b)) { if ((k) == 0 && USE_CG_SYNC) grid.sync(); else xcd_barrier(bar); } } while (0)
#define NREP(b) ((REPM & (b)) ? 2 : 1)
    if (IN(0) && (PHM & 1)) for (int rp = 0; rp < NREP(1); ++rp) { p0_prologue(P, lds, gw, NGW, wave, lane); SYNCR(0, 1); }
    if (IN(1) && (PHM & 2)) for (int rp = 0; rp < NREP(2); ++rp) {
        pg8::Gemm g{(const bf16*)(ws + WS_H), (const bf16*)(ws + WS_WINT), SEQ, DIN, DMODEL}; pg8::StaticOrder S; S.init(SEQ, DIN, G, bx, P1_WGM);
        pg8::EpiZ E{(bf16*)(ws + WS_Z), DIN};
        pg8::gemm_phase<pg8::EpiZ, pg8::StaticOrder, P1_ALIGN, true>(lds, g, S, E, lds + XLDS_OFF);
        { const int nfull = ((SEQ / 256) * (DIN / 256)) % G;
          if (nfull == 0) p1_idle_work(P, lds, bx * NWAVES + wave, G * NWAVES, wave, lane);
          else if (bx >= nfull) p1_idle_work(P, lds, (bx - nfull) * NWAVES + wave, (G - nfull) * NWAVES, wave, lane); }
        SYNCR(1, 2);
    }
    if (IN(2) && (PHM & 4)) for (int rp = 0; rp < NREP(4); ++rp) { p2_mixer(P, lds, vcu, tid, wave, lane, 511);
#if PROBE_P2
        p2_mixer(P, lds, vcu, tid, wave, lane, PROBE_P2);
#endif
        SYNCR(2, 4); }
    if (IN(3) && (PHM & 8)) {
        pg8::Gemm g{(const bf16*)(ws + WS_MIX), (const bf16*)(ws + WS_WOUTT), SEQ, DMODEL, DMODEL}; pg8::PanelOrder S{G, vcu, (SEQ / 256) * (DMODEL / 256)};
        pg8::EpiNorm<0> E{nullptr, (const bf16*)(ws + WS_H), (const float*)(ws + WS_SIGX), (float*)(ws + WS_SIG), (bf16*)(ws + WS_X1B), nullptr, (const float*)(ws + WS_GINV), (unsigned*)(ws + WS_SLAB1), (unsigned*)(ws + WS_CTL) + CW_PANEL1, (unsigned*)(ws + WS_CTL) + XB_TMO};
        pg8::gemm_phase<pg8::EpiNorm<0>, pg8::PanelOrder, true, true>(lds, g, S, E, lds + XLDS_OFF);
        SYNC(3);
    }
#if PROBE_GEMM
    if (IN(3)) {
        pg8::Gemm g{(const bf16*)(ws + WS_X1B), (const bf16*)(ws + WS_WUPT), SEQ, PROBE_N, DMODEL}; pg8::StaticOrder S; S.init(SEQ, PROBE_N, G, bx);
#if PROBE_GEMM == 1
        pg8::EpiZ E{(bf16*)(ws + WS_Z), PROBE_N};
        pg8::gemm_phase<pg8::EpiZ, pg8::StaticOrder, true, true>(lds, g, S, E, lds + XLDS_OFF);
#elif PROBE_GEMM == 2
        pg8::EpiNone E{};
        pg8::gemm_phase<pg8::EpiNone, pg8::StaticOrder, true, true>(lds, g, S, E, lds + XLDS_OFF);
#elif PROBE_GEMM == 3
        pg8::EpiZ E{(bf16*)(ws + WS_Z), PROBE_N};
        pg8::gemm_phase<pg8::EpiZ, pg8::StaticOrder, true, false>(lds, g, S, E, lds + XLDS_OFF);
#elif PROBE_GEMM == 5
        pg8::EpiAct E{(bf16*)(ws + WS_ACT), P.ffn_conv_w, P.ffn_conv_b, (float*)(ws + WS_UBND)};
        pg8::gemm_phase<pg8::EpiAct, pg8::StaticOrder, true, true>(lds, g, S, E, lds + XLDS_OFF);
#elif PROBE_GEMM == 4
        pg8::EpiZ E{(bf16*)(ws + WS_Z), PROBE_N};
        pg8::gemm_phase<pg8::EpiZ, pg8::StaticOrder, false, true>(lds, g, S, E, lds + XLDS_OFF);
#endif
        xcd_barrier(bar);
    }
#endif
    if (IN(4) && (PHM & 16)) for (int rp = 0; rp < NREP(16); ++rp) {
        pg8::Gemm g{(const bf16*)(ws + WS_X1B), (const bf16*)(ws + WS_WUPT), SEQ, DFF2, DMODEL}; pg8::StaticOrder S; S.init(SEQ, DFF2, G, bx, P4_WGM);
        pg8::EpiAct E{(bf16*)(ws + WS_ACT), P.ffn_conv_w, P.ffn_conv_b, (float*)(ws + WS_UBND)};
        pg8::gemm_phase<pg8::EpiAct, pg8::StaticOrder, true, true>(lds, g, S, E, lds + XLDS_OFF);
        SYNCR(4, 16);
    }
#if !FUSE_FIXUP
    if (IN(5) && (PHM & 32)) { p5_fixup(P, vcu * (NWAVES * 64) + tid, G * NWAVES * 64); SYNC(5); }
#endif
    if (IN(6) && (PHM & 64)) {
#if FUSE_FIXUP
        p6_fixup_panels(P, vcu, G, tid, (unsigned*)(ws + WS_CTL) + CW_PANEL2, (unsigned*)(ws + WS_CTL) + XB_TMO);
#endif
        pg8::Gemm g{(const bf16*)(ws + WS_ACT), (const bf16*)(ws + WS_WDOWNT), SEQ, DMODEL, DFF}; pg8::PanelOrder S{G, vcu, (SEQ / 256) * (DMODEL / 256)};
        pg8::EpiNorm<1> E{nullptr, (const bf16*)(ws + WS_X1B), (const float*)(ws + WS_SIG), nullptr, nullptr, P.out, P.g_final, (unsigned*)(ws + WS_SLAB2), (unsigned*)(ws + WS_CTL) + CW_PANEL, (unsigned*)(ws + WS_CTL) + XB_TMO};
        pg8::gemm_phase<pg8::EpiNorm<1>, pg8::PanelOrder, true, true>(lds, g, S, E, lds + XLDS_OFF);
    }
#undef IN
#undef SYNC
}

extern "C" void kernel_launch(void* const* d_in, const int* in_sizes, int n_in, void* d_out, int out_size, void* d_ws, size_t ws_size, hipStream_t stream) {
    static int grid = 0;
    if (grid == 0) {
        if (n_in != 16 || in_sizes[0] != SEQ * DMODEL || out_size != SEQ * DMODEL || ws_size < WS_END) { fprintf(stderr, "kernel_launch: unexpected shapes (n_in %d, in0 %d, out %d, ws %zu)\n", n_in, n_in > 0 ? in_sizes[0] : -1, out_size, ws_size); grid = -1; return; }
        int dev = 0, cus = 0, per_cu = 0;
        if (hipGetDevice(&dev) != hipSuccess || hipDeviceGetAttribute(&cus, hipDeviceAttributeMultiprocessorCount, dev) != hipSuccess) { grid = -1; return; }
        if (hipFuncSetAttribute((const void*)hybrid_fwd, hipFuncAttributeMaxDynamicSharedMemorySize, LDS_BYTES) != hipSuccess) { fprintf(stderr, "kernel_launch: hipFuncSetAttribute failed\n"); grid = -1; return; }
        if (hipOccupancyMaxActiveBlocksPerMultiprocessor(&per_cu, (const void*)hybrid_fwd, NWAVES * 64, LDS_BYTES) != hipSuccess || per_cu < 1) { fprintf(stderr, "kernel_launch: occupancy query says %d blocks per CU\n", per_cu); (void)hipGetLastError(); per_cu = 1; }
        grid = cus;
        if (grid != 256) { fprintf(stderr, "kernel_launch: this kernel is laid out for one workgroup on each of 256 CUs (the mixer phase and the row-statistics exchanges assume it); the device reports %d\n", grid); if (grid > 256) grid = 256; }
    }
    if (grid < 0) return;
    if (hipMemsetAsync((char*)d_ws + WS_CTL, 0, CTL_ZERO_BYTES, stream) != hipSuccess) { fprintf(stderr, "kernel_launch: hipMemsetAsync failed\n"); return; }
    Args a{};
    for (int i = 0; i < 16; ++i) a.in[i] = (const float*)d_in[i];
    a.out = (float*)d_out; a.ws = (unsigned char*)d_ws;
#if MK_PER_PHASE
    for (int ph = 0; ph < NPHASE; ++ph) { a.ph_lo = ph; a.ph_hi = ph + 1; hipLaunchKernelGGL(hybrid_fwd, dim3(grid), dim3(NWAVES * 64), LDS_BYTES, stream, a); }
#else
    a.ph_lo = 0; a.ph_hi = NPHASE;
    void* kargs[] = {&a};
    hipError_t e = hipLaunchCooperativeKernel((const void*)hybrid_fwd, dim3(grid), dim3(NWAVES * 64), kargs, LDS_BYTES, stream);
    if (e != hipSuccess) fprintf(stderr, "kernel_launch: cooperative launch failed: %s (grid %d)\n", hipGetErrorString(e), grid);
#endif
}
```

```cpp
#include <hip/hip_runtime.h>
#include <hip/hip_cooperative_groups.h>
#include <cstdio>
#include <cstdint>
namespace cg = cooperative_groups;
#ifndef PG8_PRIO
#define PG8_PRIO 0
#endif
namespace pg8 {
#define PG8_LAS __attribute__((address_space(3)))
typedef unsigned short bf16_t;
typedef short bf16x8 __attribute__((ext_vector_type(8)));
typedef float f32x4 __attribute__((ext_vector_type(4)));
typedef unsigned u32x4 __attribute__((ext_vector_type(4)));
constexpr int BM = 256, BK = 64, HALF = 128, HTB = HALF * BK * 2  , STAGE_BYTES = 8 * HTB, NXCD = 8, WGM = 8;

__host__ __device__ __forceinline__ int lds_byte(int r, int c) { const int st = (r >> 4) * 2 + (c >> 5), rr = r & 15, cc = c & 31, ob = rr * 64 + cc * 2; return st * 1024 + (ob ^ (((ob >> 9) & 1) << 5)); }
__host__ __device__ __forceinline__ void stage_rc(int b, int& R, int& C) { const int st = b / 1024, sb = b % 1024, swz = sb ^ (((sb >> 9) & 1) << 5); R = (st >> 1) * 16 + swz / 64; C = (st & 1) * 32 + (swz % 64) / 2; }
__host__ __device__ __forceinline__ int perm32(int rho) { const int n = rho >> 4, i = rho & 15; return 8 * (i >> 2) + 4 * n + (i & 3); }

struct Unit { int pm, pn; };
struct Gemm { const bf16_t* A; const bf16_t* Bt; int M, N, K; };

struct StaticOrder {
    int nM, nN, nwg, G, c, wgm;
    __host__ __device__ void init(int M, int N, int G_, int c_, int wgm_ = WGM) { nM = M / BM; nN = N / BM; nwg = nM * nN; G = G_; c = c_; wgm = wgm_; }
    __host__ __device__ bool next(int i, Unit& u) const {
        const long L = (long)i * G + c; if (L >= nwg) return false;
        int wgid = (int)L; { const int q = nwg / NXCD, r = nwg % NXCD, xcd = wgid % NXCD, off = wgid / NXCD; wgid = (xcd < r ? xcd * (q + 1) : r * (q + 1) + (xcd - r) * q) + off; }
        const int nig = wgm * nN, gid = wgid / nig, fm = gid * wgm, gsz = (nM - fm) < wgm ? (nM - fm) : wgm;
        u.pm = fm + ((wgid % nig) % gsz); u.pn = (wgid % nig) / gsz; return true;
    }
    __device__ __forceinline__ void a_ready(const Unit&) const {}
    __device__ __forceinline__ void done(const Unit&) const {}
};
__device__ __forceinline__ unsigned cvt_pk_bf16(float lo, float hi) { unsigned r; asm volatile("v_cvt_pk_bf16_f32 %0, %1, %2" : "=v"(r) : "v"(lo), "v"(hi)); return r; }
typedef unsigned u32x2 __attribute__((ext_vector_type(2)));
constexpr int DM = 2048;
constexpr float RMS_EPS = 1e-6f;

__device__ __forceinline__ void qswap_pieces(const u32x4 w0, const u32x4 w1, bool odd, u32x4& dA, u32x4& dB) {
#pragma unroll
    for (int j = 0; j < 4; ++j) { const unsigned snd = odd ? w0[j] : w1[j];
        const unsigned rcv = (unsigned)__builtin_amdgcn_mov_dpp((int)snd, 0xB1, 0xf, 0xf, false);
        dA[j] = odd ? rcv : w0[j]; dB[j] = odd ? w1[j] : rcv; }
}
struct EpiZ {
    static constexpr bool PERM = true, AFTER_DRAIN = false;
    bf16_t* O; int ldc;
    __device__ __forceinline__ void operator()(const f32x4 (&acc)[2][2][4][2], const Unit& u, int wr, int wc, int fr_, int fq_, PG8_LAS unsigned char*) const {
        int t_ = threadIdx.x; asm volatile("" : "+v"(t_));
        const int fr = t_ & 15, fq = (t_ >> 4) & 3; const bool odd = fr & 1;
        const int rowe = u.pm * BM + wr * 64 + (fr & ~1), colp = u.pn * BM + wc * 64 + 8 * fq + (odd ? 32 : 0);
#pragma unroll
        for (int ai = 0; ai < 2; ++ai)
#pragma unroll
            for (int m = 0; m < 4; ++m) { u32x4 w0, w1, dA, dB;
                { const f32x4 v0 = acc[ai][0][m][0], v1 = acc[ai][0][m][1]; w0.x = cvt_pk_bf16(v0[0], v0[1]); w0.y = cvt_pk_bf16(v0[2], v0[3]); w0.z = cvt_pk_bf16(v1[0], v1[1]); w0.w = cvt_pk_bf16(v1[2], v1[3]); }
                { const f32x4 v0 = acc[ai][1][m][0], v1 = acc[ai][1][m][1]; w1.x = cvt_pk_bf16(v0[0], v0[1]); w1.y = cvt_pk_bf16(v0[2], v0[3]); w1.z = cvt_pk_bf16(v1[0], v1[1]); w1.w = cvt_pk_bf16(v1[2], v1[3]); }
                qswap_pieces(w0, w1, odd, dA, dB);
                bf16_t* p = O + (size_t)(rowe + ai * HALF + m * 16) * ldc + colp;
                *(u32x4*)p = dA; *(u32x4*)(p + ldc) = dB; }
    }
};

struct EpiNone {
    static constexpr bool PERM = true, AFTER_DRAIN = false;
    __device__ __forceinline__ void operator()(const f32x4 (&acc)[2][2][4][2], const Unit& u, int wr, int wc, int fr, int fq, PG8_LAS unsigned char*) const {
#pragma unroll
        for (int ai = 0; ai < 2; ++ai)
#pragma unroll
            for (int bj = 0; bj < 2; ++bj)
#pragma unroll
                for (int m = 0; m < 4; ++m)
#pragma unroll
                    for (int n = 0; n < 2; ++n) asm volatile("" :: "v"(acc[ai][bj][m][n]));
    }
};
struct EpiResA {
    static constexpr bool PERM = true, AFTER_DRAIN = false;
    const float* R; bf16_t* XB; float* slab;
    __device__ __forceinline__ void operator()(const f32x4 (&acc)[2][2][4][2], const Unit& u, int wr, int wc, int fr_, int fq_, PG8_LAS unsigned char*) const {
        int t_ = threadIdx.x; asm volatile("" : "+v"(t_));
        const int fr = t_ & 15, fq = (t_ >> 4) & 3;
        const int row0 = u.pm * BM + wr * 64 + fr, col0 = u.pn * BM + wc * 32 + 8 * fq;
#pragma unroll
        for (int ai = 0; ai < 2; ++ai) {
            f32x4 r[4][2][2];
#pragma unroll
            for (int m = 0; m < 4; ++m)
#pragma unroll
                for (int bj = 0; bj < 2; ++bj) { const float* p = R + (size_t)(row0 + ai * HALF + m * 16) * DM + col0 + bj * HALF; r[m][bj][0] = *(const f32x4*)p; r[m][bj][1] = *(const f32x4*)(p + 4); }
#pragma unroll
            for (int m = 0; m < 4; ++m) { const int row = row0 + ai * HALF + m * 16; float ss = 0.f;
#pragma unroll
                for (int bj = 0; bj < 2; ++bj) { const f32x4 v0 = acc[ai][bj][m][0] + r[m][bj][0], v1 = acc[ai][bj][m][1] + r[m][bj][1];
                    u32x4 w; w.x = cvt_pk_bf16(v0[0], v0[1]); w.y = cvt_pk_bf16(v0[2], v0[3]); w.z = cvt_pk_bf16(v1[0], v1[1]); w.w = cvt_pk_bf16(v1[2], v1[3]);
                    *(u32x4*)(XB + (size_t)row * DM + col0 + bj * HALF) = w;
                    ss += (v0[0] * v0[0] + v0[1] * v0[1]) + (v0[2] * v0[2] + v0[3] * v0[3]) + (v1[0] * v1[0] + v1[1] * v1[1]) + (v1[2] * v1[2] + v1[3] * v1[3]); }
                ss += __shfl_xor(ss, 16); ss += __shfl_xor(ss, 32);
                if (fq == 0) slab[(size_t)row * 32 + u.pn * 4 + wc] = ss; }
            asm volatile("" ::: "memory"); }
    }
};
struct EpiResB {
    static constexpr bool PERM = true, AFTER_DRAIN = false;
    const bf16_t* RB; float* X; float* slab;
    __device__ __forceinline__ void operator()(const f32x4 (&acc)[2][2][4][2], const Unit& u, int wr, int wc, int fr_, int fq_, PG8_LAS unsigned char*) const {
        int t_ = threadIdx.x; asm volatile("" : "+v"(t_));
        const int fr = t_ & 15, fq = (t_ >> 4) & 3;
        const int row0 = u.pm * BM + wr * 64 + fr, col0 = u.pn * BM + wc * 32 + 8 * fq;
        u32x4 r[2][4][2];
#pragma unroll
        for (int ai = 0; ai < 2; ++ai)
#pragma unroll
            for (int m = 0; m < 4; ++m)
#pragma unroll
                for (int bj = 0; bj < 2; ++bj) r[ai][m][bj] = *(const u32x4*)(RB + (size_t)(row0 + ai * HALF + m * 16) * DM + col0 + bj * HALF);
#pragma unroll
        for (int ai = 0; ai < 2; ++ai)
#pragma unroll
            for (int m = 0; m < 4; ++m) { const int row = row0 + ai * HALF + m * 16; float ss = 0.f;
#pragma unroll
                for (int bj = 0; bj < 2; ++bj) { const u32x4 q = r[ai][m][bj];
                    const f32x4 r0 = {__builtin_bit_cast(float, q.x << 16), __builtin_bit_cast(float, q.x & 0xffff0000u), __builtin_bit_cast(float, q.y << 16), __builtin_bit_cast(float, q.y & 0xffff0000u)};
                    const f32x4 r1 = {__builtin_bit_cast(float, q.z << 16), __builtin_bit_cast(float, q.z & 0xffff0000u), __builtin_bit_cast(float, q.w << 16), __builtin_bit_cast(float, q.w & 0xffff0000u)};
                    const f32x4 v0 = acc[ai][bj][m][0] + r0, v1 = acc[ai][bj][m][1] + r1;
                    float* xp = X + (size_t)row * DM + col0 + bj * HALF; *(f32x4*)xp = v0; *(f32x4*)(xp + 4) = v1;
                    ss += (v0[0] * v0[0] + v0[1] * v0[1]) + (v0[2] * v0[2] + v0[3] * v0[3]) + (v1[0] * v1[0] + v1[1] * v1[1]) + (v1[2] * v1[2] + v1[3] * v1[3]); }
                ss += __shfl_xor(ss, 16); ss += __shfl_xor(ss, 32);
                if (fq == 0) slab[(size_t)row * 32 + u.pn * 4 + wc] = ss; }
    }
};

struct PanelOrder {
    int G, vcu, ntot;
    __device__ __forceinline__ bool next(int i, Unit& u) const { const int L = i * G + vcu; if (L >= ntot) return false; u.pm = L >> 3; u.pn = L & 7; return true; }
    __device__ __forceinline__ void a_ready(const Unit&) const {}
    __device__ __forceinline__ void done(const Unit&) const {}
};
template <int MODE  > struct EpiNorm {
    static constexpr bool PERM = (MODE == 0), AFTER_DRAIN = false;
    const float* Rf; const bf16_t* Rb; const float* sig_in; float* sig_out; bf16_t* HN; float* OUT; const float* gfin; unsigned* xbuf; unsigned* cnt; unsigned* tmo;
    __device__ __forceinline__ void operator()(f32x4 (&acc)[2][2][4][2], const Unit& u, int wr, int wc, int fr_, int fq_, PG8_LAS unsigned char* xlds) const {
        int t_ = threadIdx.x; asm volatile("" : "+v"(t_));
        const int fr = t_ & 15, fq = (t_ >> 4) & 3, wid = __builtin_amdgcn_readfirstlane(t_ >> 6);
        const int rl0 = wr * 64 + fr, row0 = u.pm * BM + rl0, col0 = u.pn * BM + wc * 64 + 8 * fq;
        PG8_LAS float* Pt = (PG8_LAS float*)xlds;
        PG8_LAS float* St = (PG8_LAS float*)(xlds + 4096);
        if constexpr (MODE == 0) {
            f32x4 gi[2][2];
#pragma unroll
            for (int bj = 0; bj < 2; ++bj) { gi[bj][0] = *(const f32x4*)(gfin + col0 + bj * 32); gi[bj][1] = *(const f32x4*)(gfin + col0 + bj * 32 + 4); }
#pragma unroll
            for (int ai = 0; ai < 2; ++ai) { u32x4 r[4][2]; float sg[4];
#pragma unroll
                for (int m = 0; m < 4; ++m) { sg[m] = sig_in[row0 + ai * HALF + m * 16];
#pragma unroll
                    for (int bj = 0; bj < 2; ++bj) r[m][bj] = *(const u32x4*)(Rb + (size_t)(row0 + ai * HALF + m * 16) * DM + col0 + bj * 32); }
#pragma unroll
                for (int m = 0; m < 4; ++m) { float ss = 0.f; const float sgm = sg[m];
#pragma unroll
                    for (int bj = 0; bj < 2; ++bj) { const u32x4 q = r[m][bj];
                        const f32x4 r0 = {__builtin_bit_cast(float, q.x << 16), __builtin_bit_cast(float, q.x & 0xffff0000u), __builtin_bit_cast(float, q.y << 16), __builtin_bit_cast(float, q.y & 0xffff0000u)};
                        const f32x4 r1 = {__builtin_bit_cast(float, q.z << 16), __builtin_bit_cast(float, q.z & 0xffff0000u), __builtin_bit_cast(float, q.w << 16), __builtin_bit_cast(float, q.w & 0xffff0000u)};
                        const f32x4 v0 = acc[ai][bj][m][0] + r0 * gi[bj][0] * sgm, v1 = acc[ai][bj][m][1] + r1 * gi[bj][1] * sgm; acc[ai][bj][m][0] = v0; acc[ai][bj][m][1] = v1;
                        ss += (v0[0] * v0[0] + v0[1] * v0[1]) + (v0[2] * v0[2] + v0[3] * v0[3]) + (v1[0] * v1[0] + v1[1] * v1[1]) + (v1[2] * v1[2] + v1[3] * v1[3]); }
                    ss += __shfl_xor(ss, 16); ss += __shfl_xor(ss, 32);
                    if (fq == 0) Pt[(ai * HALF + rl0 + m * 16) * 4 + wc] = ss; }
                asm volatile("" ::: "memory"); }
        } else { u32x2 r[2][4][2][2]; float sg[2][4]; const int colb = u.pn * BM + wc * 32 + 4 * fq;
#pragma unroll
            for (int ai = 0; ai < 2; ++ai)
#pragma unroll
                for (int m = 0; m < 4; ++m) { sg[ai][m] = sig_in[row0 + ai * HALF + m * 16];
#pragma unroll
                    for (int bj = 0; bj < 2; ++bj)
#pragma unroll
                        for (int n = 0; n < 2; ++n) r[ai][m][bj][n] = *(const u32x2*)(Rb + (size_t)(row0 + ai * HALF + m * 16) * DM + colb + bj * HALF + 16 * n); }
#pragma unroll
            for (int ai = 0; ai < 2; ++ai)
#pragma unroll
                for (int m = 0; m < 4; ++m) { float ss = 0.f; const float sgm = sg[ai][m];
#pragma unroll
                    for (int bj = 0; bj < 2; ++bj)
#pragma unroll
                        for (int n = 0; n < 2; ++n) { const u32x2 q = r[ai][m][bj][n];
                            const f32x4 r0 = {__builtin_bit_cast(float, q.x << 16), __builtin_bit_cast(float, q.x & 0xffff0000u), __builtin_bit_cast(float, q.y << 16), __builtin_bit_cast(float, q.y & 0xffff0000u)};
                            const f32x4 v0 = acc[ai][bj][m][n] + r0 * sgm; acc[ai][bj][m][n] = v0;
                            ss += (v0[0] * v0[0] + v0[1] * v0[1]) + (v0[2] * v0[2] + v0[3] * v0[3]); }
                    ss += __shfl_xor(ss, 16); ss += __shfl_xor(ss, 32);
                    if (fq == 0) Pt[(ai * HALF + rl0 + m * 16) * 4 + wc] = ss; } }
        asm volatile("s_waitcnt lgkmcnt(0)" ::: "memory"); __builtin_amdgcn_s_barrier(); asm volatile("" ::: "memory");
        if (t_ < 256) { const float s = (Pt[t_ * 4 + 0] + Pt[t_ * 4 + 1]) + (Pt[t_ * 4 + 2] + Pt[t_ * 4 + 3]);
            __hip_atomic_store(xbuf + (size_t)(u.pm * BM + t_) * 8 + u.pn, __builtin_bit_cast(unsigned, s), __ATOMIC_RELAXED, __HIP_MEMORY_SCOPE_AGENT); }
        asm volatile("s_waitcnt vmcnt(0)" ::: "memory");
        if (t_ < 256 && (t_ & 63) == 0) __hip_atomic_fetch_add(cnt + 64 * u.pm, 1u, __ATOMIC_RELAXED, __HIP_MEMORY_SCOPE_AGENT);
        if (wid == 0) {
            unsigned spins = 0;
            while ((unsigned)__builtin_amdgcn_readfirstlane(__hip_atomic_load(cnt + 64 * u.pm, __ATOMIC_RELAXED, __HIP_MEMORY_SCOPE_AGENT)) < 32u) {
                __builtin_amdgcn_s_sleep(2);
                if (++spins > (1u << 20)) { if ((t_ & 63) == 0) __hip_atomic_store(tmo, 1u, __ATOMIC_RELAXED, __HIP_MEMORY_SCOPE_AGENT); break; } }
            __builtin_amdgcn_fence(__ATOMIC_ACQUIRE, "agent");
        }
        asm volatile("s_waitcnt vmcnt(0) lgkmcnt(0)" ::: "memory"); __builtin_amdgcn_s_barrier(); asm volatile("" ::: "memory");
        if (t_ < 256) { const unsigned long long* sp = (const unsigned long long*)(xbuf + (size_t)(u.pm * BM + t_) * 8); float tot = 0.f;
#pragma unroll
            for (int q = 0; q < 4; ++q) { const unsigned long long w = __hip_atomic_load(sp + q, __ATOMIC_RELAXED, __HIP_MEMORY_SCOPE_AGENT);
                tot += __builtin_bit_cast(float, (unsigned)w); tot += __builtin_bit_cast(float, (unsigned)(w >> 32)); }
            const float sd = sqrtf(tot * (1.0f / DM) + RMS_EPS);
            St[t_] = 1.0f / sd;
            if (MODE == 0 && u.pn == 0) sig_out[u.pm * BM + t_] = sd; }
        asm volatile("s_waitcnt lgkmcnt(0)" ::: "memory"); __builtin_amdgcn_s_barrier(); asm volatile("" ::: "memory");
        if constexpr (MODE == 0) {
            const bool odd = fr & 1;
#pragma unroll
            for (int ai = 0; ai < 2; ++ai)
#pragma unroll
                for (int m = 0; m < 4; ++m) { const float rstd = St[ai * HALF + rl0 + m * 16]; u32x4 w0, w1, dA, dB;
                    { const f32x4 v0 = acc[ai][0][m][0] * rstd, v1 = acc[ai][0][m][1] * rstd; w0.x = cvt_pk_bf16(v0[0], v0[1]); w0.y = cvt_pk_bf16(v0[2], v0[3]); w0.z = cvt_pk_bf16(v1[0], v1[1]); w0.w = cvt_pk_bf16(v1[2], v1[3]); }
                    { const f32x4 v0 = acc[ai][1][m][0] * rstd, v1 = acc[ai][1][m][1] * rstd; w1.x = cvt_pk_bf16(v0[0], v0[1]); w1.y = cvt_pk_bf16(v0[2], v0[3]); w1.z = cvt_pk_bf16(v1[0], v1[1]); w1.w = cvt_pk_bf16(v1[2], v1[3]); }
                    qswap_pieces(w0, w1, odd, dA, dB);
                    bf16_t* p = HN + (size_t)((row0 & ~1) + ai * HALF + m * 16) * DM + col0 + (odd ? 32 : 0);
                    *(u32x4*)p = dA; *(u32x4*)(p + DM) = dB; }
        } else {
            const int colb = u.pn * BM + wc * 32 + 4 * fq; const bool odd = fr & 1;
            f32x4 gg[2][2];
#pragma unroll
            for (int bj = 0; bj < 2; ++bj)
#pragma unroll
                for (int n = 0; n < 2; ++n) gg[bj][n] = *(const f32x4*)(gfin + colb + bj * HALF + 16 * n);
#pragma unroll
            for (int ai = 0; ai < 2; ++ai)
#pragma unroll
                for (int m = 0; m < 4; ++m) { const float rstd = St[ai * HALF + rl0 + m * 16]; float* op = OUT + (size_t)(row0 + ai * HALF + m * 16) * DM + colb;
#pragma unroll
                    for (int bj = 0; bj < 2; ++bj) {
                        const f32x4 o0 = acc[ai][bj][m][0] * rstd * gg[bj][0], o1 = acc[ai][bj][m][1] * rstd * gg[bj][1]; f32x4 dA, dB;
#pragma unroll
                        for (int j = 0; j < 4; ++j) { const float snd = odd ? o0[j] : o1[j];
                            const float rcv = __builtin_bit_cast(float, __builtin_amdgcn_mov_dpp(__builtin_bit_cast(int, snd), 0xB1, 0xf, 0xf, false));
                            dA[j] = odd ? rcv : o0[j]; dB[j] = odd ? o1[j] : rcv; }
                        float* pp = op + bj * HALF + (odd ? 16 : 0);
                        *(f32x4*)(pp - (odd ? DM : 0)) = dA; *(f32x4*)(pp + (odd ? 0 : DM)) = dB; } }
        }
    }
};

__device__ __forceinline__ float dpp_shr1(float old, float src) { return __builtin_bit_cast(float, __builtin_amdgcn_update_dpp(__builtin_bit_cast(int, old), __builtin_bit_cast(int, src), 0x111, 0xf, 0xf, false)); }
__device__ __forceinline__ float dpp_shr2(float old, float src) { return __builtin_bit_cast(float, __builtin_amdgcn_update_dpp(__builtin_bit_cast(int, old), __builtin_bit_cast(int, src), 0x112, 0xf, 0xf, false)); }
__device__ __forceinline__ float dpp_ror1(float src) { return __builtin_bit_cast(float, __builtin_amdgcn_mov_dpp(__builtin_bit_cast(int, src), 0x121, 0xf, 0xf, false)); }
__device__ __forceinline__ float dpp_ror2(float src) { return __builtin_bit_cast(float, __builtin_amdgcn_mov_dpp(__builtin_bit_cast(int, src), 0x122, 0xf, 0xf, false)); }
constexpr int FF = 5632, FF2 = 11264;
typedef _Float16 h2_t __attribute__((ext_vector_type(2)));
__device__ __forceinline__ unsigned pkh(float a, float b) { return __builtin_bit_cast(unsigned, __builtin_amdgcn_cvt_pkrtz(a, b)); }
__device__ __forceinline__ unsigned dppu_shr1(unsigned old, unsigned src) { return (unsigned)__builtin_amdgcn_update_dpp((int)old, (int)src, 0x111, 0xf, 0xf, false); }
__device__ __forceinline__ unsigned dppu_shr2(unsigned old, unsigned src) { return (unsigned)__builtin_amdgcn_update_dpp((int)old, (int)src, 0x112, 0xf, 0xf, false); }
__device__ __forceinline__ unsigned dppu_ror1(unsigned src) { return (unsigned)__builtin_amdgcn_mov_dpp((int)src, 0x121, 0xf, 0xf, false); }
__device__ __forceinline__ unsigned dppu_ror2(unsigned src) { return (unsigned)__builtin_amdgcn_mov_dpp((int)src, 0x122, 0xf, 0xf, false); }
struct EpiAct {
    static constexpr bool PERM = true, AFTER_DRAIN = false;
    bf16_t* ACT; const float* cw; const float* cb; float* ubnd;
    __device__ __forceinline__ void operator()(f32x4 (&acc)[2][2][4][2], const Unit& u, int wr, int wc, int fr_, int fq_, PG8_LAS unsigned char* xlds) const {
        int t_ = threadIdx.x; asm volatile("" : "+v"(t_));
        const int fr = t_ & 15, fq = (t_ >> 4) & 3;
        const int row0 = u.pm * BM + wr * 64 + fr, cl = wc * 32 + 8 * fq;
        const int c0 = u.pn * 128 + cl;
        f32x4 wgt[2][8];
#pragma unroll
        for (int n = 0; n < 2; ++n) { const float* wp = cw + c0 + 4 * n; const float* bp = cb + c0 + 4 * n;
            wgt[n][0] = *(const f32x4*)wp; wgt[n][1] = *(const f32x4*)(wp + FF2); wgt[n][2] = *(const f32x4*)(wp + 2 * FF2); wgt[n][3] = *(const f32x4*)bp;
            wgt[n][4] = *(const f32x4*)(wp + FF); wgt[n][5] = *(const f32x4*)(wp + FF2 + FF); wgt[n][6] = *(const f32x4*)(wp + 2 * FF2 + FF); wgt[n][7] = *(const f32x4*)(bp + FF); }
        if (wr == 1 && fr >= 14) {
#pragma unroll
            for (int bj = 0; bj < 2; ++bj)
#pragma unroll
                for (int n = 0; n < 2; ++n) *(f32x4*)(ubnd + (size_t)(u.pm * 4 + 2 + (fr - 14)) * FF2 + u.pn * BM + 64 * wc + 32 * bj + 8 * fq + 4 * n) = acc[1][bj][3][n]; }
        if (wr == 0 && fr < 2) {
#pragma unroll
            for (int bj = 0; bj < 2; ++bj)
#pragma unroll
                for (int n = 0; n < 2; ++n) *(f32x4*)(ubnd + (size_t)(u.pm * 4 + fr) * FF2 + u.pn * BM + 64 * wc + 32 * bj + 8 * fq + 4 * n) = acc[0][bj][0][n]; }
        u32x4 pk[2][4][2];
#pragma unroll
        for (int ai = 0; ai < 2; ++ai)
#pragma unroll
            for (int m = 0; m < 4; ++m)
#pragma unroll
                for (int n = 0; n < 2; ++n) { const f32x4 g = acc[ai][0][m][n], v = acc[ai][1][m][n]; pk[ai][m][n] = (u32x4){pkh(g[0], v[0]), pkh(g[1], v[1]), pkh(g[2], v[2]), pkh(g[3], v[3])}; }
        if (fr >= 14) {
#pragma unroll
            for (int ai = 0; ai < 2; ++ai)
#pragma unroll
                for (int n = 0; n < 2; ++n) *(PG8_LAS u32x4*)(xlds + ((((2 * ai + wr) * 2 + (fr - 14)) * 128 + cl + 4 * n) << 2)) = pk[ai][3][n]; }
        asm volatile("s_waitcnt lgkmcnt(0)" ::: "memory"); __builtin_amdgcn_s_barrier(); asm volatile("" ::: "memory");
        u32x2 hold[2][4];
#pragma unroll
        for (int n = 0; n < 2; ++n) {
            h2_t w0p[4], w1p[4], w2p[4], bp4[4];
#pragma unroll
            for (int j = 0; j < 4; ++j) { w0p[j] = __builtin_bit_cast(h2_t, pkh(wgt[n][0][j], wgt[n][4][j])); w1p[j] = __builtin_bit_cast(h2_t, pkh(wgt[n][1][j], wgt[n][5][j]));
                w2p[j] = __builtin_bit_cast(h2_t, pkh(wgt[n][2][j], wgt[n][6][j])); bp4[j] = __builtin_bit_cast(h2_t, pkh(wgt[n][3][j], wgt[n][7][j])); }
#pragma unroll
            for (int ai = 0; ai < 2; ++ai) {
                const int chunk = 2 * ai + wr;
                u32x4 pp = {0u, 0u, 0u, 0u};
                if (chunk > 0) pp = *(const PG8_LAS u32x4*)(xlds + ((((chunk - 1) * 2 + (fr & 1)) * 128 + cl + 4 * n) << 2));
#pragma unroll
                for (int m = 0; m < 4; ++m) {
                    const u32x4 cur = pk[ai][m][n]; float a[4];
#pragma unroll
                    for (int j = 0; j < 4; ++j) {
                        const unsigned cj = cur[j], pj = pp[j];
                        const h2_t s1 = __builtin_bit_cast(h2_t, dppu_shr1(dppu_ror1(pj), cj)), s2 = __builtin_bit_cast(h2_t, dppu_shr2(dppu_ror2(pj), cj)), ch = __builtin_bit_cast(h2_t, cj);
                        const h2_t r = w2p[j] * ch + (w1p[j] * s1 + (w0p[j] * s2 + bp4[j]));
                        const float G = (float)r.x, V = (float)r.y;
                        a[j] = G * __builtin_amdgcn_rcpf(1.0f + __builtin_amdgcn_exp2f(-1.4426950408889634f * G)) * V; }
                    u32x2 w; w.x = cvt_pk_bf16(a[0], a[1]); w.y = cvt_pk_bf16(a[2], a[3]);
                    if (n == 0) hold[ai][m] = w;
                    else { u32x4 o; o.x = hold[ai][m].x; o.y = hold[ai][m].y; o.z = w.x; o.w = w.y;
                        if (!(ai == 0 && m == 0 && wr == 0 && u.pm > 0 && fr < 2)) *(u32x4*)(ACT + (size_t)(row0 + ai * HALF + m * 16) * FF + c0) = o; }
                    pp = cur;
                }
            }
        }
    }
};

template <class Epi, class Sched, bool ALIGN_EPI = false, bool SP2 = false>
__device__ __forceinline__ void gemm_phase(PG8_LAS unsigned char* lds, const Gemm g, const Sched& S, const Epi& E, PG8_LAS unsigned char* xlds) {
    const int tid = threadIdx.x, wid = __builtin_amdgcn_readfirstlane(tid >> 6), lane = tid & 63, wr = wid >> 2, wc = wid & 3, fr = lane & 15, fq = lane >> 4;
    const int K = g.K, nt = K / BK;
    unsigned voffA[2], voffB[2], voffB1[2];
#pragma unroll
    for (int i = 0; i < 2; ++i) { int R, C; stage_rc(tid * 16 + i * 8192, R, C); const int Rb0 = Epi::PERM ? (64 * (R >> 5) + perm32(R & 31)) : R, Rb1 = Epi::PERM ? Rb0 + 32 : R + HALF;
        voffA[i] = (unsigned)(R * K + C) * 2u; voffB[i] = (unsigned)(Rb0 * K + C) * 2u; voffB1[i] = (unsigned)(Rb1 * K + C) * 2u; }
    const size_t kstep = (size_t)(BK * 2);
    const size_t hstep = (size_t)HALF * K * 2;
    const size_t tstep = 2 * hstep;
    const unsigned ldsw = (unsigned)wid * 1024u;
    const int aoff = lds_byte(wr * 64 + fr, fq * 8), boff = lds_byte(wc * 32 + fr, fq * 8);
#define PG8_SA(b, h) (((b) * 2 + (h)) * HTB)
#define PG8_SB(b, h) ((4 + (b) * 2 + (h)) * HTB)
#define PG8_STAGE(bufoff, gbase, voff) do { _Pragma("unroll") for (int _i = 0; _i < 2; ++_i) \
        __builtin_amdgcn_global_load_lds((const unsigned*)((const char*)(gbase) + (voff)[_i]), (PG8_LAS unsigned*)(lds + (bufoff) + ldsw + _i * 8192), 16, 0, 0); } while (0)
#define PG8_LDA(dst, b, h) do { _Pragma("unroll") for (int m = 0; m < 4; ++m) _Pragma("unroll") for (int k = 0; k < 2; ++k) dst[m][k] = *(const PG8_LAS bf16x8*)(lds + PG8_SA(b, h) + aoff + m * 2048 + k * 1024); } while (0)
#define PG8_LDB(dst, b, h) do { _Pragma("unroll") for (int n = 0; n < 2; ++n) _Pragma("unroll") for (int k = 0; k < 2; ++k) dst[n][k] = *(const PG8_LAS bf16x8*)(lds + PG8_SB(b, h) + boff + n * 2048 + k * 1024); } while (0)
#define PG8_MMA(ai, bj, At, Bt) do { __builtin_amdgcn_s_setprio(PG8_PRIO); _Pragma("unroll") for (int m = 0; m < 4; ++m) _Pragma("unroll") for (int n = 0; n < 2; ++n) _Pragma("unroll") for (int k = 0; k < 2; ++k) \
        acc[ai][bj][m][n] = __builtin_amdgcn_mfma_f32_16x16x32_bf16(Bt[n][k], At[m][k], acc[ai][bj][m][n], 0, 0, 0); __builtin_amdgcn_s_setprio(0); } while (0)
#define PG8_WAIT_V(n) asm volatile("s_waitcnt vmcnt(" #n ")" ::: "memory")
#define PG8_WAIT_L(n) asm volatile("s_waitcnt lgkmcnt(" #n ")" ::: "memory")
#define PG8_BAR __builtin_amdgcn_s_barrier()
#define PG8_SCHED __builtin_amdgcn_sched_barrier(0)
    Unit cur, nxt; int ui = 0;
    if (!S.next(0, cur)) return;
    f32x4 acc[2][2][4][2];
#pragma unroll
    for (int a = 0; a < 2; ++a)
#pragma unroll
        for (int b = 0; b < 2; ++b)
#pragma unroll
            for (int m = 0; m < 4; ++m)
#pragma unroll
                for (int n = 0; n < 2; ++n) acc[a][b][m][n] = (f32x4){0.f, 0.f, 0.f, 0.f};
    bf16x8 At[4][2], B0[2][2], B1[2][2];
    const char* cA = (const char*)g.A + (size_t)cur.pm * tstep; const char* cB = (const char*)g.Bt + (size_t)cur.pn * tstep;
    S.a_ready(cur);
    if constexpr (SP2) {
        PG8_STAGE(PG8_SB(0, 0), cB, voffB); PG8_STAGE(PG8_SB(0, 1), cB, voffB1); PG8_STAGE(PG8_SA(0, 0), cA, voffA); PG8_STAGE(PG8_SA(0, 1), cA + hstep, voffA);
        if (wr == 1) PG8_BAR;
        PG8_WAIT_V(2); PG8_BAR;
        PG8_STAGE(PG8_SB(1, 0), cB + kstep, voffB); PG8_STAGE(PG8_SA(1, 0), cA + kstep, voffA); PG8_STAGE(PG8_SB(1, 1), cB + kstep, voffB1);
        PG8_WAIT_V(6); PG8_BAR;
    } else {
        PG8_STAGE(PG8_SB(0, 0), cB, voffB); PG8_STAGE(PG8_SA(0, 0), cA, voffA); PG8_STAGE(PG8_SB(0, 1), cB, voffB1); PG8_STAGE(PG8_SA(0, 1), cA + hstep, voffA);
        if (wr == 1) PG8_BAR;
        PG8_WAIT_V(4); PG8_BAR;
        PG8_STAGE(PG8_SB(1, 0), cB + kstep, voffB); PG8_STAGE(PG8_SA(1, 0), cA + kstep, voffA); PG8_STAGE(PG8_SB(1, 1), cB + kstep, voffB1);
        PG8_WAIT_V(6); PG8_BAR;
    }
    for (;;) {
        const bool has_next = S.next(ui + 1, nxt);
        const char* nA = has_next ? (const char*)g.A + (size_t)nxt.pm * tstep : cA; const char* nB = has_next ? (const char*)g.Bt + (size_t)nxt.pn * tstep : cB;
        for (int t = 0; t < nt; t += 2) {
            const bool last = (t == nt - 2);
            const char* a1 = cA + (size_t)(t + 1) * kstep;
            const char* a2 = last ? nA : cA + (size_t)(t + 2) * kstep; const char* b2 = last ? nB : cB + (size_t)(t + 2) * kstep;
            const char* a3 = a2 + kstep; const char* b3 = b2 + kstep;
            if (last && has_next) S.a_ready(nxt);
            if constexpr (SP2) {
            PG8_LDB(B0, 0, 0); PG8_LDB(B1, 0, 1); PG8_SCHED; PG8_LDA(At, 0, 0); PG8_STAGE(PG8_SA(1, 1), a1 + hstep, voffA);
            PG8_WAIT_V(8); PG8_WAIT_L(0); PG8_BAR; PG8_MMA(0, 0, At, B0); PG8_MMA(0, 1, At, B1); PG8_BAR; PG8_SCHED;
            PG8_LDA(At, 0, 1); PG8_STAGE(PG8_SB(0, 0), b2, voffB); PG8_STAGE(PG8_SB(0, 1), b2, voffB1); PG8_STAGE(PG8_SA(0, 0), a2, voffA);
            PG8_WAIT_V(8); PG8_WAIT_L(0); PG8_BAR; PG8_MMA(1, 0, At, B0); PG8_MMA(1, 1, At, B1); PG8_BAR; PG8_SCHED;
            PG8_LDB(B0, 1, 0); PG8_LDB(B1, 1, 1); PG8_SCHED; PG8_LDA(At, 1, 0); PG8_STAGE(PG8_SA(0, 1), a2 + hstep, voffA);
            PG8_WAIT_V(8); PG8_WAIT_L(0); PG8_BAR; PG8_MMA(0, 0, At, B0); PG8_MMA(0, 1, At, B1); PG8_BAR; PG8_SCHED;
            PG8_LDA(At, 1, 1); PG8_STAGE(PG8_SB(1, 0), b3, voffB); PG8_STAGE(PG8_SB(1, 1), b3, voffB1); PG8_STAGE(PG8_SA(1, 0), a3, voffA);
            PG8_WAIT_V(8); PG8_WAIT_L(0); PG8_BAR; PG8_MMA(1, 0, At, B0); PG8_MMA(1, 1, At, B1); PG8_BAR; PG8_SCHED;
            } else {
            PG8_LDB(B0, 0, 0); PG8_SCHED; PG8_LDA(At, 0, 0); PG8_STAGE(PG8_SA(1, 1), a1 + hstep, voffA);
            PG8_WAIT_L(8); PG8_BAR; PG8_WAIT_L(0); PG8_MMA(0, 0, At, B0); PG8_BAR; PG8_SCHED;
            PG8_LDB(B1, 0, 1); PG8_STAGE(PG8_SB(0, 0), b2, voffB);
            PG8_BAR; PG8_WAIT_L(0); PG8_MMA(0, 1, At, B1); PG8_BAR;
            PG8_LDA(At, 0, 1); PG8_STAGE(PG8_SA(0, 0), a2, voffA);
            PG8_BAR; PG8_WAIT_L(0); PG8_MMA(1, 0, At, B0); PG8_BAR; PG8_SCHED;
            PG8_STAGE(PG8_SB(0, 1), b2, voffB1);
            PG8_WAIT_V(6); PG8_BAR; PG8_MMA(1, 1, At, B1); PG8_BAR;
            PG8_LDB(B0, 1, 0); PG8_SCHED; PG8_LDA(At, 1, 0); PG8_STAGE(PG8_SA(0, 1), a2 + hstep, voffA);
            PG8_WAIT_L(8); PG8_BAR; PG8_WAIT_L(0); PG8_MMA(0, 0, At, B0); PG8_BAR; PG8_SCHED;
            PG8_LDB(B1, 1, 1); PG8_STAGE(PG8_SB(1, 0), b3, voffB);
            PG8_BAR; PG8_WAIT_L(0); PG8_MMA(0, 1, At, B1); PG8_BAR;
            PG8_LDA(At, 1, 1); PG8_STAGE(PG8_SA(1, 0), a3, voffA);
            PG8_BAR; PG8_WAIT_L(0); PG8_MMA(1, 0, At, B0); PG8_BAR; PG8_SCHED;
            PG8_STAGE(PG8_SB(1, 1), b3, voffB1);
            PG8_WAIT_V(6); PG8_BAR; PG8_MMA(1, 1, At, B1); PG8_BAR;
            }
        }
        if constexpr (ALIGN_EPI) { if (wr == 0) PG8_BAR; }
        if constexpr (!Epi::AFTER_DRAIN) { E(acc, cur, wr, wc, fr, fq, xlds); S.done(cur); }
        if (!has_next) break;
#pragma unroll
        for (int a = 0; a < 2; ++a)
#pragma unroll
            for (int b = 0; b < 2; ++b)
#pragma unroll
                for (int m = 0; m < 4; ++m)
#pragma unroll
                    for (int n = 0; n < 2; ++n) acc[a][b][m][n] = (f32x4){0.f, 0.f, 0.f, 0.f};
        cur = nxt; cA = nA; cB = nB; ++ui;
        if constexpr (ALIGN_EPI) { if (wr == 1) PG8_BAR; }
    }
    PG8_WAIT_V(0);
    if constexpr (!ALIGN_EPI) { if (wr == 0) PG8_BAR; }
    PG8_BAR;

#undef PG8_SA
#undef PG8_SB
#undef PG8_STAGE
#undef PG8_LDA
#undef PG8_LDB
#undef PG8_MMA
#undef PG8_WAIT_V
#undef PG8_WAIT_L
#undef PG8_BAR
#undef PG8_SCHED
}
}

#define GAS __attribute__((address_space(1)))
#define LAS __attribute__((address_space(3)))
typedef unsigned short bf16;
typedef float f32x4 __attribute__((ext_vector_type(4)));
typedef short bf16x8 __attribute__((ext_vector_type(8)));
typedef unsigned u32x4 __attribute__((ext_vector_type(4)));
typedef unsigned u32x2 __attribute__((ext_vector_type(2)));

constexpr int NWAVES = 8;
constexpr int SEQ = 16384, DMODEL = 2048, NMEM = 256, DIN = 3584, DCONV = 768, DPOOL = 768, DXATT = 512, DFF = 5632, DFF2 = 11264;
constexpr int PGD = 192;
constexpr float EPS = 1e-6f;
constexpr int LDS_BYTES = 147456;
#ifndef MK_PER_PHASE
#define MK_PER_PHASE 0
#endif
constexpr int NPHASE = 7;
#ifndef PHM
#define PHM 255
#endif
#ifndef FUSE_FIXUP
#define FUSE_FIXUP 0
#endif
#ifndef P1_WGM
#define P1_WGM 4
#endif
#ifndef P4_WGM
#define P4_WGM 4
#endif
#ifndef P1_ALIGN
#define P1_ALIGN false
#endif
#ifndef USE_CG_SYNC
#define USE_CG_SYNC 0
#endif
#ifndef PROBE_P2
#define PROBE_P2 0
#endif
#ifndef PROBE_SYNC
#define PROBE_SYNC 0
#endif
#ifndef PROBE_GEMM
#define PROBE_GEMM 0
#endif
#ifndef PROBE_N
#define PROBE_N 2048
#endif
#ifndef REPM
#define REPM 0
#endif

constexpr size_t MiB = 1u << 20;
constexpr size_t WS_KB = 1 * MiB;
constexpr size_t WS_VT = 1 * MiB + 256 * 1024;
constexpr size_t WS_POOLWT = 1 * MiB + 512 * 1024;
constexpr size_t WS_MB = 2 * MiB;
constexpr size_t WS_WKVT = 3 * MiB;
constexpr size_t WS_SIGX = 7 * MiB + 128 * 1024;
constexpr size_t WS_GINV = 7 * MiB + 256 * 1024;
constexpr size_t WS_SIG = 7 * MiB;
constexpr size_t WS_SLAB1 = 8 * MiB;
constexpr size_t WS_SLAB2 = 10 * MiB;
constexpr size_t WS_WUPT = 12 * MiB;
constexpr size_t WS_WDOWNT = 56 * MiB;
constexpr size_t WS_UBND = 80 * MiB;
constexpr size_t WS_X1B = 96 * MiB;
constexpr size_t WS_ACT = 160 * MiB;
constexpr size_t WS_H = 160 * MiB;
constexpr size_t WS_Z = 225 * MiB;
constexpr size_t WS_ZPAD = WS_Z - (size_t)16 * 3584 * 2;
constexpr size_t WS_MIX = 338 * MiB;
constexpr size_t WS_WINT = 402 * MiB;
constexpr size_t WS_WOUTT = 416 * MiB;
constexpr size_t WS_END = 424 * MiB;

__device__ __forceinline__ unsigned f2bf(float f) { unsigned u = __builtin_bit_cast(unsigned, f); return (u + 0x7fffu + ((u >> 16) & 1u)) >> 16; }
__device__ __forceinline__ unsigned pk2(float lo, float hi) { return f2bf(lo) | (f2bf(hi) << 16); }
__device__ __forceinline__ float bflo(unsigned w) { return __builtin_bit_cast(float, w << 16); }
__device__ __forceinline__ float bfhi(unsigned w) { return __builtin_bit_cast(float, w & 0xffff0000u); }
__device__ __forceinline__ void unpack8(const u32x4 w, float (&f)[8]) { f[0] = bflo(w.x); f[1] = bfhi(w.x); f[2] = bflo(w.y); f[3] = bfhi(w.y); f[4] = bflo(w.z); f[5] = bfhi(w.z); f[6] = bflo(w.w); f[7] = bfhi(w.w); }
__device__ __forceinline__ u32x4 pack8(const float (&f)[8]) { u32x4 w; w.x = pk2(f[0], f[1]); w.y = pk2(f[2], f[3]); w.z = pk2(f[4], f[5]); w.w = pk2(f[6], f[7]); return w; }
__device__ __forceinline__ float wave_sum(float v) {
#pragma unroll
    for (int o = 1; o < 64; o <<= 1) v += __shfl_xor(v, o);
    return v;
}
#define LDS_WAIT() asm volatile("s_waitcnt lgkmcnt(0)" ::: "memory")

typedef GAS unsigned gu32;
constexpr size_t WS_CTL = 0, CTL_ZERO_BYTES = 64 * 1024;
constexpr int CW_PANEL2 = 12288;
constexpr int CW_PANEL1 = 8192;
constexpr int CW_PANEL = 4096;
constexpr int MISC_OFF = 131072 + 320;
constexpr int XLDS_OFF = 131072 + 1024;
#define XB_TMO      128
#define XB_XCNT(j)  (256  + 64 * (j))
#define XB_XSUB(j)  (1280 + 64 * (j))
#define XB_XGEN(j)  (2304 + 64 * (j))
#define XB_TOP      3328
#define XB_TOPGEN   3392
#define XCD_BAR_WORDS 3456
#define XB_SPIN_CAP (1u << 18)

__device__ __forceinline__ unsigned xb_ld(unsigned* p)              { return __hip_atomic_load(p, __ATOMIC_RELAXED, __HIP_MEMORY_SCOPE_AGENT); }
__device__ __forceinline__ unsigned xb_add(unsigned* p, unsigned v) { return __hip_atomic_fetch_add(p, v, __ATOMIC_RELAXED, __HIP_MEMORY_SCOPE_AGENT); }
__device__ __forceinline__ unsigned xb_xcc_id() { return (unsigned)__builtin_amdgcn_s_getreg((3 << 11) | 20) & 0xFu; }
#define XB_SPIN(cond, bar) do { unsigned _sp = 0; while (cond) { __builtin_amdgcn_s_sleep(1); \
    if ((++_sp & 255u) == 0u) { if (xb_ld(&(bar)[XB_TMO])) break; if (_sp > XB_SPIN_CAP) { atomicAdd(&(bar)[XB_TMO], 1u); break; } } } } while (0)

struct XcdBarrier {
    unsigned* bar; unsigned x;
    volatile LAS unsigned* st;
};

__device__ __forceinline__ XcdBarrier xcd_barrier_post(unsigned* bar, volatile LAS unsigned* st) {
    XcdBarrier b; b.bar = bar; b.x = xb_xcc_id(); b.st = st;
    if (threadIdx.x == 0) (void)xb_add(&bar[XB_XCNT(b.x)], 1u);
    return b;
}
__device__ __forceinline__ void xcd_barrier_complete(unsigned* bar, unsigned x, unsigned& nloc, unsigned& nx) {
    const unsigned G = gridDim.x * gridDim.y * gridDim.z;
    unsigned sum, cnt, mine, sp = 0u;
    for (;;) {
        sum = 0u; cnt = 0u; mine = 0u;
#pragma unroll
        for (unsigned j = 0; j < 16; ++j) { const unsigned c = xb_ld(&bar[XB_XCNT(j)]); sum += c; cnt += (c > 0u) ? 1u : 0u; mine = (j == x) ? c : mine; }
        if (sum == G) break;
        __builtin_amdgcn_s_sleep(1);
        if ((++sp & 255u) == 0u) { if (xb_ld(&bar[XB_TMO])) break; if (sp > XB_SPIN_CAP) { atomicAdd(&bar[XB_TMO], 1u); break; } }
    }
    nloc = mine > 0u ? mine : 1u; nx = cnt > 0u ? cnt : 1u;
}

__device__ __forceinline__ void xcd_barrier(const XcdBarrier& b) {
    asm volatile("s_waitcnt vmcnt(0)" ::: "memory");
    __syncthreads();
    if (threadIdx.x == 0) {
        unsigned* bar = b.bar;
        __builtin_amdgcn_s_waitcnt(0);
        unsigned nloc = b.st[0], nx = b.st[1];
        if (nloc == 0u) { xcd_barrier_complete(bar, b.x, nloc, nx); b.st[0] = nloc; b.st[1] = nx; }
        const unsigned old = xb_add(&bar[XB_XSUB(b.x)], 1u);
        const unsigned gen = old / nloc;
        if (old + 1u == (gen + 1u) * nloc) {
            __builtin_amdgcn_fence(__ATOMIC_RELEASE, "agent");
            asm volatile("s_waitcnt vmcnt(0)" ::: "memory");
            const unsigned og = xb_add(&bar[XB_TOP], 1u);
            const unsigned tg = og / nx;
            if (og + 1u == (tg + 1u) * nx) xb_add(&bar[XB_TOPGEN], 1u);
            else XB_SPIN(xb_ld(&bar[XB_TOPGEN]) == tg, bar);
            __builtin_amdgcn_fence(__ATOMIC_ACQUIRE, "agent");
            xb_add(&bar[XB_XGEN(b.x)], 1u);
            asm volatile("s_waitcnt vmcnt(0)" ::: "memory");
        } else {
            XB_SPIN(xb_ld(&bar[XB_XGEN(b.x)]) == gen, bar);
            __builtin_amdgcn_fence(__ATOMIC_ACQUIRE, "agent");
            asm volatile("s_waitcnt vmcnt(0)" ::: "memory");
        }
    }
    __syncthreads();
}


struct TrItem { const float* src; const float* ks; bf16* dst; int N, K, skip; };
template <bool UPMAP> __device__ __forceinline__ TrItem tr_make(const float* W, int K, int N, bf16* WT, const float* ks, int item) {
    const int nblk = N / 64, kb = item / nblk, nb = item % nblk, k0 = 64 * kb, n0 = 64 * nb;
    const int np = (n0 < DFF) ? n0 : n0 - DFF;
    const int r0 = !UPMAP ? n0 : 256 * (np / 128) + 64 * ((np % 128) / 32) + ((n0 < DFF) ? 0 : 32);
    TrItem t; t.src = W + (size_t)k0 * N + n0; t.ks = ks ? ks + k0 : nullptr; t.dst = WT + (size_t)r0 * K + k0; t.N = N; t.K = K; t.skip = UPMAP ? 32 : 0; return t;
}
__device__ __forceinline__ void tr_load(const TrItem& t, f32x4 (&v)[16], int lane) {
    const float* src = t.src + (size_t)(lane >> 4) * t.N + 4 * (lane & 15);
#pragma unroll
    for (int i = 0; i < 16; ++i) v[i] = *(const f32x4*)(src + (size_t)(4 * i) * t.N);
}
__device__ __forceinline__ void tr_store(const TrItem& t, const f32x4 (&v)[16], LAS float* scr, int lane) {
#pragma unroll
    for (int i = 0; i < 16; ++i) { f32x4 x = v[i]; if (t.ks) x = x * t.ks[4 * i + (lane >> 4)];
        *(LAS f32x4*)(scr + (4 * i + (lane >> 4)) * 64 + (((lane & 15) ^ ((i >> 1) & 7)) << 2)) = x; }
    LDS_WAIT(); asm volatile("" ::: "memory");
    const int c = lane & 7;
#pragma unroll
    for (int j = 0; j < 8; ++j) { const int nn = (lane >> 3) + 8 * j; const LAS float* sp = scr + (8 * c) * 64 + ((((nn >> 2) ^ c) & 15) << 2) + (nn & 3);
        u32x4 o; o.x = pk2(sp[0 * 64], sp[1 * 64]); o.y = pk2(sp[2 * 64], sp[3 * 64]); o.z = pk2(sp[4 * 64], sp[5 * 64]); o.w = pk2(sp[6 * 64], sp[7 * 64]);
        *(u32x4*)(t.dst + (size_t)(nn + (nn >= 32 ? t.skip : 0)) * t.K + 8 * c) = o; }
    LDS_WAIT(); asm volatile("" ::: "memory");
}
__device__ __forceinline__ void rms_rows2_to_bf16(const float* xa, const float* xb, const float* g, bf16* oa, bf16* ob, int lane, float* sig2 = nullptr) {
    const f32x4* pa = (const f32x4*)xa + lane; const f32x4* pb = (const f32x4*)xb + lane; const f32x4* gr = (const f32x4*)g + lane;
    f32x4 va[8], vb[8]; float sa = 0.f, sb = 0.f;
#pragma unroll
    for (int j = 0; j < 8; ++j) { va[j] = pa[64 * j]; vb[j] = pb[64 * j]; }
#pragma unroll
    for (int j = 0; j < 8; ++j) { sa += (va[j].x * va[j].x + va[j].y * va[j].y) + (va[j].z * va[j].z + va[j].w * va[j].w); sb += (vb[j].x * vb[j].x + vb[j].y * vb[j].y) + (vb[j].z * vb[j].z + vb[j].w * vb[j].w); }
    const float da = sqrtf(wave_sum(sa) * (1.0f / DMODEL) + EPS), db = sqrtf(wave_sum(sb) * (1.0f / DMODEL) + EPS), ra = 1.0f / da, rb = 1.0f / db;
    if (sig2 && lane == 0) { sig2[0] = da; sig2[1] = db; }
    u32x2* qa = (u32x2*)oa + lane; u32x2* qb = (u32x2*)ob + lane;
#pragma unroll
    for (int j = 0; j < 8; ++j) { const f32x4 gg = gr[64 * j]; u32x2 w;
        w.x = pk2(va[j].x * ra * gg.x, va[j].y * ra * gg.y); w.y = pk2(va[j].z * ra * gg.z, va[j].w * ra * gg.w); qa[64 * j] = w;
        w.x = pk2(vb[j].x * rb * gg.x, vb[j].y * rb * gg.y); w.y = pk2(vb[j].z * rb * gg.z, vb[j].w * rb * gg.w); qb[64 * j] = w; }
}

struct Ptrs {
    const float *x, *mem, *g_mix, *g_mem, *w_in, *conv_w, *pool_w, *pool_scale, *w_kv, *w_out, *g_ffn, *w_up, *ffn_conv_w, *ffn_conv_b, *w_down, *g_final;
    float* out; unsigned char* ws;
};

constexpr int UP_ITEMS = (DMODEL / 64) * (DFF2 / 64), DN_ITEMS = (DFF / 64) * (DMODEL / 64);
#ifndef UP_IN_P0
#define UP_IN_P0 4608
#endif
__device__ __forceinline__ void p1_idle_work(const Ptrs& P, LAS unsigned char* lds, int iw, int NIW, int wave, int lane);
template <int LIST> __device__ __forceinline__ TrItem tr_desc(const Ptrs& P, int it) {
    unsigned char* ws = P.ws;
    constexpr int I_IN = (DMODEL / 64) * (DIN / 64), I_OUT = (DMODEL / 64) * (DMODEL / 64), I_KV = (DMODEL / 64) * (1024 / 64), I_PW = (PGD / 64) * (PGD / 64);
    if (LIST == 0) {
        int r = it;
        if (r < I_IN) return tr_make<false>(P.w_in, DMODEL, DIN, (bf16*)(ws + WS_WINT), nullptr, r); r -= I_IN;
        if (r < I_OUT) return tr_make<false>(P.w_out, DMODEL, DMODEL, (bf16*)(ws + WS_WOUTT), nullptr, r); r -= I_OUT;
        if (r < UP_IN_P0) return tr_make<true>(P.w_up, DMODEL, DFF2, (bf16*)(ws + WS_WUPT), P.g_ffn, r); r -= UP_IN_P0;
        if (r < I_KV) return tr_make<false>(P.w_kv, DMODEL, 1024, (bf16*)(ws + WS_WKVT), nullptr, r); r -= I_KV;
        const int g = r / I_PW; r -= g * I_PW;
        return tr_make<false>(P.pool_w + (size_t)g * PGD * PGD, PGD, PGD, (bf16*)(ws + WS_POOLWT) + (size_t)g * PGD * PGD, nullptr, r);
    } else {
        if (it < DN_ITEMS) return tr_make<false>(P.w_down, DFF, DMODEL, (bf16*)(ws + WS_WDOWNT), nullptr, it);
        return tr_make<true>(P.w_up, DMODEL, DFF2, (bf16*)(ws + WS_WUPT), P.g_ffn, UP_IN_P0 + it - DN_ITEMS);
    }
}
template <int LIST> __device__ __forceinline__ void tr_stream(const Ptrs& P, LAS float* scr, int first, int stride, int nitems, int lane) {
    if (first >= nitems) return;
    TrItem cur = tr_desc<LIST>(P, first); f32x4 va[16], vb[16];
    tr_load(cur, va, lane);
    for (int it = first; it < nitems; it += 2 * stride) {
        TrItem nx = cur; const bool h1 = it + stride < nitems; if (h1) { nx = tr_desc<LIST>(P, it + stride); tr_load(nx, vb, lane); }
        tr_store(cur, va, scr, lane);
        if (!h1) break;
        const bool h2 = it + 2 * stride < nitems; if (h2) { cur = tr_desc<LIST>(P, it + 2 * stride); tr_load(cur, va, lane); }
        tr_store(nx, vb, scr, lane);
        if (!h2) break;
    }
}
__device__ __forceinline__ void p0_prologue(const Ptrs& P, LAS unsigned char* lds, int gw, int NGW, int wave, int lane) {
    LAS float* scr = (LAS float*)(lds + wave * 16384);
    unsigned char* ws = P.ws;
    constexpr int NITEMS = (DMODEL / 64) * (DIN / 64) + (DMODEL / 64) * (DMODEL / 64) + UP_IN_P0 + (DMODEL / 64) * (1024 / 64) + 4 * (PGD / 64) * (PGD / 64);
    tr_stream<0>(P, scr, gw, NGW, NITEMS, lane);
    for (int i = gw * 64 + lane; i < DMODEL; i += NGW * 64) ((float*)(ws + WS_GINV))[i] = 1.0f / P.g_mix[i];
    for (int i = gw * 64 + lane; i < 16 * DIN * 2 / 16; i += NGW * 64) ((u32x4*)(ws + WS_ZPAD))[i] = (u32x4){0u, 0u, 0u, 0u};
    for (int m = 2 * gw; m < SEQ; m += 2 * NGW) rms_rows2_to_bf16(P.x + (size_t)m * DMODEL, P.x + (size_t)(m + 1) * DMODEL, P.g_mix, (bf16*)(ws + WS_H) + (size_t)m * DMODEL, (bf16*)(ws + WS_H) + (size_t)(m + 1) * DMODEL, lane, (float*)(ws + WS_SIGX) + m);
    for (int m = 2 * gw; m < NMEM; m += 2 * NGW) rms_rows2_to_bf16(P.mem + (size_t)m * DMODEL, P.mem + (size_t)(m + 1) * DMODEL, P.g_mem, (bf16*)(ws + WS_MB) + (size_t)m * DMODEL, (bf16*)(ws + WS_MB) + (size_t)(m + 1) * DMODEL, lane);
}

__device__ __forceinline__ void kv_tile(const Ptrs& P, int tt, int lane) {
    const bf16* mB = (const bf16*)(P.ws + WS_MB); const bf16* wT = (const bf16*)(P.ws + WS_WKVT);
    const int rb = tt >> 6, cb = tt & 63, fr = lane & 15, fq = lane >> 4;
    const bf16* ap = mB + (size_t)(16 * rb + fr) * DMODEL + 8 * fq; const bf16* wp = wT + (size_t)(16 * cb + fr) * DMODEL + 8 * fq;
    const bool kpart = cb < 32;
    f32x4 acc = {0.f, 0.f, 0.f, 0.f};
    bf16x8 a0[8], w0[8], a1[8], w1[8];
#pragma unroll
    for (int i = 0; i < 8; ++i) { a0[i] = *(const bf16x8*)(ap + 32 * i); w0[i] = *(const bf16x8*)(wp + 32 * i); }
#pragma unroll 1
    for (int kb = 0; kb < 8; kb += 2) {
#pragma unroll
        for (int i = 0; i < 8; ++i) { a1[i] = *(const bf16x8*)(ap + 32 * (8 * kb + 8 + i)); w1[i] = *(const bf16x8*)(wp + 32 * (8 * kb + 8 + i)); }
#pragma unroll
        for (int i = 0; i < 8; ++i) acc = kpart ? __builtin_amdgcn_mfma_f32_16x16x32_bf16(w0[i], a0[i], acc, 0, 0, 0) : __builtin_amdgcn_mfma_f32_16x16x32_bf16(a0[i], w0[i], acc, 0, 0, 0);
        if (kb + 2 < 8) {
#pragma unroll
            for (int i = 0; i < 8; ++i) { a0[i] = *(const bf16x8*)(ap + 32 * (8 * kb + 16 + i)); w0[i] = *(const bf16x8*)(wp + 32 * (8 * kb + 16 + i)); } }
#pragma unroll
        for (int i = 0; i < 8; ++i) acc = kpart ? __builtin_amdgcn_mfma_f32_16x16x32_bf16(w1[i], a1[i], acc, 0, 0, 0) : __builtin_amdgcn_mfma_f32_16x16x32_bf16(a1[i], w1[i], acc, 0, 0, 0);
    }
    u32x2 o; o.x = pk2(acc[0], acc[1]); o.y = pk2(acc[2], acc[3]);
    if (kpart) *(u32x2*)((bf16*)(P.ws + WS_KB) + (size_t)(16 * rb + fr) * 512 + 16 * cb + 4 * fq) = o;
    else *(u32x2*)((bf16*)(P.ws + WS_VT) + (size_t)(16 * cb - 512 + fr) * 256 + 32 * (rb >> 1) + 8 * fq + 4 * (rb & 1)) = o;
}

__device__ __forceinline__ void p1_idle_work(const Ptrs& P, LAS unsigned char* lds, int iw, int NIW, int wave, int lane) {
    LAS float* scr = (LAS float*)(lds + wave * 16384);
    for (int tt = iw; tt < 1024; tt += NIW) kv_tile(P, tt, lane);
    tr_stream<1>(P, scr, iw, NIW, DN_ITEMS + (UP_ITEMS - UP_IN_P0), lane);
}

__device__ __forceinline__ void mix_conv_task(const Ptrs& P, int blk, int lane, int cg0, int cg1) {
    const bf16* z = (const bf16*)(P.ws + WS_Z); bf16* mix = (bf16*)(P.ws + WS_MIX);
    const int t0 = blk * 16;
    for (int cg = cg0 + lane; cg < cg1; cg += 64) {
        const int c = cg * 8;
        float w0[8], w1[8], w2[8], p1[8], p2[8];
#pragma unroll
        for (int e = 0; e < 8; ++e) { w0[e] = P.conv_w[c + e]; w1[e] = P.conv_w[DCONV + c + e]; w2[e] = P.conv_w[2 * DCONV + c + e]; }
        { float a[8], b[8]; unpack8(*(const u32x4*)(z + (long)(t0 - 2) * DIN + DCONV + c), a); unpack8(*(const u32x4*)(z + (long)(t0 - 2) * DIN + 2 * DCONV + c), b);
#pragma unroll
          for (int e = 0; e < 8; ++e) p2[e] = a[e] * b[e];
          unpack8(*(const u32x4*)(z + (long)(t0 - 1) * DIN + DCONV + c), a); unpack8(*(const u32x4*)(z + (long)(t0 - 1) * DIN + 2 * DCONV + c), b);
#pragma unroll
          for (int e = 0; e < 8; ++e) p1[e] = a[e] * b[e]; }
#pragma unroll 4
        for (int r = 0; r < 16; ++r) {
            const int t = t0 + r; float p[8], a[8], b[8], g[8], o[8];
            unpack8(*(const u32x4*)(z + (size_t)t * DIN + DCONV + c), a); unpack8(*(const u32x4*)(z + (size_t)t * DIN + 2 * DCONV + c), b); unpack8(*(const u32x4*)(z + (size_t)t * DIN + c), g);
#pragma unroll
            for (int e = 0; e < 8; ++e) { p[e] = a[e] * b[e]; o[e] = g[e] * (w2[e] * p[e] + w1[e] * p1[e] + w0[e] * p2[e]); p2[e] = p1[e]; p1[e] = p[e]; }
            *(u32x4*)(mix + (size_t)t * DMODEL + c) = pack8(o);
        }
    }
}
template <int g> __device__ __forceinline__ void mix_pool_task(const Ptrs& P, int blk, int lane) {
    constexpr int k = 2 << g;
    const char* zu = (const char*)((const bf16*)(P.ws + WS_Z) + (size_t)(blk * 16) * DIN + 3 * DCONV + PGD * g);
    const char* wu = (const char*)((const bf16*)(P.ws + WS_POOLWT) + (size_t)g * PGD * PGD);
    bf16* mix = (bf16*)(P.ws + WS_MIX);
    const int fr = lane & 15, fq = lane >> 4, t = blk * 16 + fr;
    const unsigned zl = (unsigned)(fr * DIN + 8 * fq) * 2u, wl = (unsigned)(fr * PGD + 8 * fq) * 2u;
    const int cnt = (t + 1 < k) ? t + 1 : k; const float inv = 1.0f / (float)cnt;
    f32x4 acc[12];
#pragma unroll
    for (int n = 0; n < 12; ++n) acc[n] = (f32x4){0.f, 0.f, 0.f, 0.f};
#pragma unroll 1
    for (int ks = 0; ks < 6; ++ks) {
        float sum[8], self[8];
        unpack8(*(const u32x4*)(zu + ks * 64 + zl), self);
#pragma unroll
        for (int e = 0; e < 8; ++e) sum[e] = self[e];
#pragma unroll
        for (int j = 1; j < k; ++j) { float v[8]; unpack8(*(const u32x4*)(zu + ks * 64 - (long)j * (DIN * 2) + zl), v);
#pragma unroll
            for (int e = 0; e < 8; ++e) sum[e] += v[e]; }
        float pl[8];
#pragma unroll
        for (int e = 0; e < 8; ++e) pl[e] = sum[e] * inv - self[e];
        const bf16x8 pf = __builtin_bit_cast(bf16x8, pack8(pl));
#pragma unroll
        for (int n = 0; n < 12; ++n) { const bf16x8 wf = *(const bf16x8*)(wu + n * (16 * PGD * 2) + ks * 64 + wl); acc[n] = __builtin_amdgcn_mfma_f32_16x16x32_bf16(wf, pf, acc[n], 0, 0, 0); }
    }
#pragma unroll
    for (int n = 0; n < 12; ++n) { const int d = 16 * n + 4 * fq; const f32x4 sc = *(const f32x4*)(P.pool_scale + PGD * g + d);
        u32x2 o; o.x = pk2(acc[n][0] * sc[0], acc[n][1] * sc[1]); o.y = pk2(acc[n][2] * sc[2], acc[n][3] * sc[3]);
        *(u32x2*)(mix + (size_t)t * DMODEL + DCONV + PGD * g + d) = o; }
}
__device__ __forceinline__ void mix_attn_task(const Ptrs& P, int h, int blk, int lane) {
    const bf16* z = (const bf16*)(P.ws + WS_Z); bf16* mix = (bf16*)(P.ws + WS_MIX); const bf16* Kb = (const bf16*)(P.ws + WS_KB); const bf16* Vt = (const bf16*)(P.ws + WS_VT);
    const int fr = lane & 15, fq = lane >> 4, t = blk * 16 + fr;
    bf16x8 qf[4];
#pragma unroll
    for (int ks = 0; ks < 4; ++ks) qf[ks] = *(const bf16x8*)(z + (size_t)t * DIN + 3 * DCONV + DPOOL + 128 * h + 32 * ks + 8 * fq);
    f32x4 s[16];
#pragma unroll
    for (int kb = 0; kb < 16; ++kb) { s[kb] = (f32x4){0.f, 0.f, 0.f, 0.f};
#pragma unroll
        for (int ks = 0; ks < 4; ++ks) { const bf16x8 kf = *(const bf16x8*)(Kb + (size_t)(16 * kb + fr) * 512 + 128 * h + 32 * ks + 8 * fq); s[kb] = __builtin_amdgcn_mfma_f32_16x16x32_bf16(kf, qf[ks], s[kb], 0, 0, 0); } }
    float mx = -3.0e38f;
#pragma unroll
    for (int kb = 0; kb < 16; ++kb) mx = fmaxf(fmaxf(fmaxf(s[kb][0], s[kb][1]), fmaxf(s[kb][2], s[kb][3])), mx);
    mx = fmaxf(mx, __shfl_xor(mx, 16)); mx = fmaxf(mx, __shfl_xor(mx, 32));
    const float c2 = 0.08838834764831845f * 1.4426950408889634f;
    float sum = 0.f;
#pragma unroll
    for (int kb = 0; kb < 16; ++kb)
#pragma unroll
        for (int r = 0; r < 4; ++r) { const float p = __builtin_amdgcn_exp2f((s[kb][r] - mx) * c2); s[kb][r] = p; sum += p; }
    sum += __shfl_xor(sum, 16); sum += __shfl_xor(sum, 32);
    const float inv = 1.0f / sum;
    f32x4 o[8];
#pragma unroll
    for (int db = 0; db < 8; ++db) o[db] = (f32x4){0.f, 0.f, 0.f, 0.f};
#pragma unroll
    for (int ks = 0; ks < 8; ++ks) {
        u32x4 pw; pw.x = pk2(s[2 * ks][0], s[2 * ks][1]); pw.y = pk2(s[2 * ks][2], s[2 * ks][3]); pw.z = pk2(s[2 * ks + 1][0], s[2 * ks + 1][1]); pw.w = pk2(s[2 * ks + 1][2], s[2 * ks + 1][3]);
        const bf16x8 pf = __builtin_bit_cast(bf16x8, pw);
#pragma unroll
        for (int db = 0; db < 8; ++db) { const bf16x8 vf = *(const bf16x8*)(Vt + (size_t)(128 * h + 16 * db + fr) * 256 + 32 * ks + 8 * fq); o[db] = __builtin_amdgcn_mfma_f32_16x16x32_bf16(vf, pf, o[db], 0, 0, 0); }
    }
#pragma unroll
    for (int db = 0; db < 8; ++db) { u32x2 w; w.x = pk2(o[db][0] * inv, o[db][1] * inv); w.y = pk2(o[db][2] * inv, o[db][3] * inv);
        *(u32x2*)(mix + (size_t)t * DMODEL + DCONV + DPOOL + 128 * h + 16 * db + 4 * fq) = w; }
}
template <int R, int C, int PCH> __device__ __forceinline__ void lds_stage_rows(LAS unsigned char* dst, const unsigned char* src, int gp, int tid) {
    constexpr int N = R * C, PER = (N + 511) / 512;
    u32x4 v[PER];
#pragma unroll
    for (int i = 0; i < PER; ++i) { const int idx = tid + 512 * i; if (idx < N) { const int row = idx / C, ch = idx % C; v[i] = *(const u32x4*)(src + (size_t)row * gp + ch * 16); } }
#pragma unroll
    for (int i = 0; i < PER; ++i) { const int idx = tid + 512 * i; if (idx < N) { const int row = idx / C, ch = idx % C; *(LAS u32x4*)(dst + row * (PCH * 16) + (((ch & ~15) | ((ch & 15) ^ (row & 15))) << 4)) = v[i]; } }
}
template <int N> __device__ __forceinline__ float dpp_shrN(float old, float src) { return __builtin_bit_cast(float, __builtin_amdgcn_update_dpp(__builtin_bit_cast(int, old), __builtin_bit_cast(int, src), 0x110 + N, 0xf, 0xf, false)); }
template <int N> __device__ __forceinline__ float dpp_rorN(float src) { return __builtin_bit_cast(float, __builtin_amdgcn_mov_dpp(__builtin_bit_cast(int, src), 0x120 + N, 0xf, 0xf, false)); }
template <int N> __device__ __forceinline__ float scan_step(float x, float p) { return x + dpp_shrN<N>(dpp_rorN<N>(p), x); }
template <int N> __device__ __forceinline__ float scan_step_prev(float p) { return p + dpp_shrN<N>(0.f, p); }

__device__ __forceinline__ void mix_attn_wave(const Ptrs& P, LAS unsigned char* ldsK, LAS unsigned char* ldsV, int h, int row0, int lane) {
    const bf16* z = (const bf16*)(P.ws + WS_Z); bf16* mix = (bf16*)(P.ws + WS_MIX);
    const int fr = lane & 15, fq = lane >> 4;
    bf16x8 q0[4], q1[4];
#pragma unroll
    for (int ks = 0; ks < 4; ++ks) { const bf16* qp = z + (size_t)(row0 + fr) * DIN + 3 * DCONV + DPOOL + 128 * h + 32 * ks + 8 * fq; q0[ks] = *(const bf16x8*)qp; q1[ks] = *(const bf16x8*)(qp + 16 * DIN); }
    unsigned offk[4];
#pragma unroll
    for (int ks = 0; ks < 4; ++ks) offk[ks] = (unsigned)(fr * 256 + (((4 * ks + fq) ^ fr) << 4));
    f32x4 s0[16], s1[16];
#pragma unroll
    for (int kb = 0; kb < 16; ++kb) { s0[kb] = (f32x4){0.f, 0.f, 0.f, 0.f}; s1[kb] = (f32x4){0.f, 0.f, 0.f, 0.f};
#pragma unroll
        for (int ks = 0; ks < 4; ++ks) { const bf16x8 kf = *(const LAS bf16x8*)(ldsK + kb * 4096 + offk[ks]);
            s0[kb] = __builtin_amdgcn_mfma_f32_16x16x32_bf16(kf, q0[ks], s0[kb], 0, 0, 0); s1[kb] = __builtin_amdgcn_mfma_f32_16x16x32_bf16(kf, q1[ks], s1[kb], 0, 0, 0); } }
    const float c2 = 0.08838834764831845f * 1.4426950408889634f;
    bf16x8 p0[8], p1[8]; float inv0, inv1;
    {   float mx = -3.0e38f;
#pragma unroll
        for (int kb = 0; kb < 16; ++kb) mx = fmaxf(fmaxf(fmaxf(s0[kb][0], s0[kb][1]), fmaxf(s0[kb][2], s0[kb][3])), mx);
        mx = fmaxf(mx, __shfl_xor(mx, 16)); mx = fmaxf(mx, __shfl_xor(mx, 32));
        float sum = 0.f;
#pragma unroll
        for (int ks = 0; ks < 8; ++ks) { float e[8];
#pragma unroll
            for (int r = 0; r < 4; ++r) { e[r] = __builtin_amdgcn_exp2f((s0[2 * ks][r] - mx) * c2); e[4 + r] = __builtin_amdgcn_exp2f((s0[2 * ks + 1][r] - mx) * c2); }
            sum += ((e[0] + e[1]) + (e[2] + e[3])) + ((e[4] + e[5]) + (e[6] + e[7]));
            p0[ks] = __builtin_bit_cast(bf16x8, pack8(e)); }
        sum += __shfl_xor(sum, 16); sum += __shfl_xor(sum, 32); inv0 = 1.0f / sum; }
    {   float mx = -3.0e38f;
#pragma unroll
        for (int kb = 0; kb < 16; ++kb) mx = fmaxf(fmaxf(fmaxf(s1[kb][0], s1[kb][1]), fmaxf(s1[kb][2], s1[kb][3])), mx);
        mx = fmaxf(mx, __shfl_xor(mx, 16)); mx = fmaxf(mx, __shfl_xor(mx, 32));
        float sum = 0.f;
#pragma unroll
        for (int ks = 0; ks < 8; ++ks) { float e[8];
#pragma unroll
            for (int r = 0; r < 4; ++r) { e[r] = __builtin_amdgcn_exp2f((s1[2 * ks][r] - mx) * c2); e[4 + r] = __builtin_amdgcn_exp2f((s1[2 * ks + 1][r] - mx) * c2); }
            sum += ((e[0] + e[1]) + (e[2] + e[3])) + ((e[4] + e[5]) + (e[6] + e[7]));
            p1[ks] = __builtin_bit_cast(bf16x8, pack8(e)); }
        sum += __shfl_xor(sum, 16); sum += __shfl_xor(sum, 32); inv1 = 1.0f / sum; }
    f32x4 o0[8], o1[8];
#pragma unroll
    for (int db = 0; db < 8; ++db) { o0[db] = (f32x4){0.f, 0.f, 0.f, 0.f}; o1[db] = (f32x4){0.f, 0.f, 0.f, 0.f}; }
#pragma unroll
    for (int ks = 0; ks < 8; ++ks) {
        const unsigned offv = (unsigned)(fr * 512 + ((ks >> 2) << 8) + (((4 * (ks & 3) + fq) ^ fr) << 4));
#pragma unroll
        for (int db = 0; db < 8; ++db) { const bf16x8 vf = *(const LAS bf16x8*)(ldsV + db * 8192 + offv);
            o0[db] = __builtin_amdgcn_mfma_f32_16x16x32_bf16(vf, p0[ks], o0[db], 0, 0, 0); o1[db] = __builtin_amdgcn_mfma_f32_16x16x32_bf16(vf, p1[ks], o1[db], 0, 0, 0); } }
    bf16* op = mix + (size_t)(row0 + fr) * DMODEL + DCONV + DPOOL + 128 * h + 4 * fq;
#pragma unroll
    for (int db = 0; db < 8; ++db) { u32x2 w; w.x = pk2(o0[db][0] * inv0, o0[db][1] * inv0); w.y = pk2(o0[db][2] * inv0, o0[db][3] * inv0); *(u32x2*)(op + 16 * db) = w;
        w.x = pk2(o1[db][0] * inv1, o1[db][1] * inv1); w.y = pk2(o1[db][2] * inv1, o1[db][3] * inv1); *(u32x2*)(op + (size_t)16 * DMODEL + 16 * db) = w; }
}

template <int g> __device__ __forceinline__ void mix_pool_wave(const Ptrs& P, LAS unsigned char* ldsW, int row0, int lane) {
    constexpr int k = 2 << g;
    const bf16* z = (const bf16*)(P.ws + WS_Z); bf16* mix = (bf16*)(P.ws + WS_MIX);
    const int fr = lane & 15, fq = lane >> 4;
    f32x4 acc0[12], acc1[12];
#pragma unroll
    for (int n = 0; n < 12; ++n) { acc0[n] = (f32x4){0.f, 0.f, 0.f, 0.f}; acc1[n] = (f32x4){0.f, 0.f, 0.f, 0.f}; }
    const float invA = 1.0f / (float)((row0 + fr + 1 < k) ? row0 + fr + 1 : k), invB = 1.0f / (float)((row0 + 16 + fr + 1 < k) ? row0 + 16 + fr + 1 : k);
#pragma unroll 1
    for (int ks = 0; ks < 6; ++ks) {
        const bf16* zp = z + (long)(row0 - 16 + fr) * DIN + 3 * DCONV + PGD * g + 32 * ks + 8 * fq;
        float pv[8], xa[8], xb[8], sa[8], sb[8];
        unpack8(*(const u32x4*)zp, pv); unpack8(*(const u32x4*)(zp + 16 * DIN), xa); unpack8(*(const u32x4*)(zp + 32 * DIN), xb);
#pragma unroll
        for (int e = 0; e < 8; ++e) {
            float p = pv[e], a = xa[e], b = xb[e];
            float b1 = scan_step<1>(b, a), a1 = scan_step<1>(a, p), p1 = scan_step_prev<1>(p);
            if (k >= 4) { const float b2 = scan_step<2>(b1, a1), a2 = scan_step<2>(a1, p1), p2 = scan_step_prev<2>(p1); b1 = b2; a1 = a2; p1 = p2; }
            if (k >= 8) { const float b2 = scan_step<4>(b1, a1), a2 = scan_step<4>(a1, p1), p2 = scan_step_prev<4>(p1); b1 = b2; a1 = a2; p1 = p2; }
            if (k >= 16) { const float b2 = scan_step<8>(b1, a1), a2 = scan_step<8>(a1, p1); b1 = b2; a1 = a2; }
            sa[e] = a1 * invA - a; sb[e] = b1 * invB - b; }
        const bf16x8 fa = __builtin_bit_cast(bf16x8, pack8(sa)), fb = __builtin_bit_cast(bf16x8, pack8(sb));
        const unsigned offw = (unsigned)(fr * 512 + ((ks >> 2) << 8) + (((4 * (ks & 3) + fq) ^ fr) << 4));
#pragma unroll
        for (int n = 0; n < 12; ++n) { const bf16x8 wf = *(const LAS bf16x8*)(ldsW + n * 8192 + offw);
            acc0[n] = __builtin_amdgcn_mfma_f32_16x16x32_bf16(wf, fa, acc0[n], 0, 0, 0); acc1[n] = __builtin_amdgcn_mfma_f32_16x16x32_bf16(wf, fb, acc1[n], 0, 0, 0); }
    }
    bf16* op = mix + (size_t)(row0 + fr) * DMODEL + DCONV + PGD * g + 4 * fq;
#pragma unroll
    for (int n = 0; n < 12; ++n) { const f32x4 sc = *(const f32x4*)(P.pool_scale + PGD * g + 16 * n + 4 * fq);
        u32x2 o; o.x = pk2(acc0[n][0] * sc[0], acc0[n][1] * sc[1]); o.y = pk2(acc0[n][2] * sc[2], acc0[n][3] * sc[3]); *(u32x2*)(op + 16 * n) = o;
        o.x = pk2(acc1[n][0] * sc[0], acc1[n][1] * sc[1]); o.y = pk2(acc1[n][2] * sc[2], acc1[n][3] * sc[3]); *(u32x2*)(op + (size_t)16 * DMODEL + 16 * n) = o; }
}

__device__ __forceinline__ void p2_mixer(const Ptrs& P, LAS unsigned char* lds, int w, int tid, int wave, int lane, int tmask) {
    const int sub = w & 3, tile = w >> 2, row0 = tile * 256 + (wave & 3) * 64;
    lds_stage_rows<256, 16, 16>(lds, (const unsigned char*)(P.ws + WS_KB) + 256 * sub, 1024, tid);
    lds_stage_rows<128, 32, 32>(lds + 65536, (const unsigned char*)(P.ws + WS_VT) + (size_t)sub * 128 * 512, 512, tid);
    LDS_WAIT(); __syncthreads();
    if (wave < 4) { if (tmask & 0x1e0) {
#pragma unroll 1
        for (int p = 0; p < 2; ++p) { asm volatile("" ::: "memory"); mix_attn_wave(P, lds, lds + 65536, sub, row0 + 32 * p, lane); } } }
    else if (tmask & 1) mix_conv_task(P, 4 * w + (wave - 4), lane, 0, 48);
    __syncthreads();
    lds_stage_rows<192, 24, 32>(lds, (const unsigned char*)(P.ws + WS_POOLWT) + (size_t)sub * PGD * PGD * 2, PGD * 2, tid);
    LDS_WAIT(); __syncthreads();
    if (wave < 4) { if (tmask & 0x1e) {
#pragma unroll 1
        for (int p = 0; p < 2; ++p) { const int r = row0 + 32 * p; asm volatile("" ::: "memory");
            if (sub == 0) mix_pool_wave<0>(P, lds, r, lane); else if (sub == 1) mix_pool_wave<1>(P, lds, r, lane); else if (sub == 2) mix_pool_wave<2>(P, lds, r, lane); else mix_pool_wave<3>(P, lds, r, lane); } } }
    else if (tmask & 1) mix_conv_task(P, 4 * w + (wave - 4), lane, 48, 96);
    __syncthreads();
}

__device__ __forceinline__ void p5_fix_item(const Ptrs& P, int pm, int c) {
    const float* ub = (const float*)(P.ws + WS_UBND); bf16* act = (bf16*)(P.ws + WS_ACT); const float* cw = P.ffn_conv_w; const float* cb = P.ffn_conv_b;
    const int gi = 256 * (c / 128) + 64 * ((c % 128) / 32) + (c % 32);
    const float* p2 = ub + (size_t)((pm - 1) * 4 + 2) * DFF2 + gi; const float* p1 = p2 + DFF2; const float* r0 = ub + (size_t)(pm * 4) * DFF2 + gi; const float* r1 = r0 + DFF2;
    float o0[8], o1[8];
#pragma unroll
    for (int e = 0; e < 8; ++e) {
        const float gw0 = cw[c + e], gw1 = cw[DFF2 + c + e], gw2 = cw[2 * DFF2 + c + e], gb = cb[c + e], vw0 = cw[DFF + c + e], vw1 = cw[DFF2 + DFF + c + e], vw2 = cw[2 * DFF2 + DFF + c + e], vb = cb[DFF + c + e];
        const float G0 = gw2 * r0[e] + (gw1 * p1[e] + (gw0 * p2[e] + gb)), V0 = vw2 * r0[32 + e] + (vw1 * p1[32 + e] + (vw0 * p2[32 + e] + vb));
        const float G1 = gw2 * r1[e] + (gw1 * r0[e] + (gw0 * p1[e] + gb)), V1 = vw2 * r1[32 + e] + (vw1 * r0[32 + e] + (vw0 * p1[32 + e] + vb));
        o0[e] = G0 * __builtin_amdgcn_rcpf(1.0f + __builtin_amdgcn_exp2f(-1.4426950408889634f * G0)) * V0;
        o1[e] = G1 * __builtin_amdgcn_rcpf(1.0f + __builtin_amdgcn_exp2f(-1.4426950408889634f * G1)) * V1; }
    *(u32x4*)(act + (size_t)(256 * pm) * DFF + c) = pack8(o0); *(u32x4*)(act + (size_t)(256 * pm + 1) * DFF + c) = pack8(o1);
}
__device__ __forceinline__ void p6_fixup_panels(const Ptrs& P, int vcu, int G, int tid, unsigned* cnt, unsigned* tmo) {
    constexpr int GRP = DFF / 8 / 8;
    const int nround = (512 + G - 1) / G;
    for (int i = 0; i < nround; ++i) { const int L = i * G + vcu; if (L >= 512) break; const int pm = L >> 3, pn = L & 7;
        if (pm > 0 && tid < GRP) p5_fix_item(P, pm, (pn * GRP + tid) * 8); }
    asm volatile("s_waitcnt vmcnt(0)" ::: "memory"); __syncthreads();
    if (tid == 0) {
        __builtin_amdgcn_fence(__ATOMIC_RELEASE, "agent"); asm volatile("s_waitcnt vmcnt(0)" ::: "memory");
        for (int i = 0; i < nround; ++i) { const int L = i * G + vcu; if (L >= 512) break; __hip_atomic_fetch_add(cnt + 64 * (L >> 3), 1u, __ATOMIC_RELAXED, __HIP_MEMORY_SCOPE_AGENT); }
        for (int i = 0; i < nround; ++i) { const int L = i * G + vcu; if (L >= 512) break; unsigned spins = 0;
            while (__hip_atomic_load(cnt + 64 * (L >> 3), __ATOMIC_RELAXED, __HIP_MEMORY_SCOPE_AGENT) < 8u) { __builtin_amdgcn_s_sleep(2); if (++spins > (1u << 20)) { __hip_atomic_store(tmo, 1u, __ATOMIC_RELAXED, __HIP_MEMORY_SCOPE_AGENT); break; } } }
        __builtin_amdgcn_fence(__ATOMIC_ACQUIRE, "agent"); asm volatile("s_waitcnt vmcnt(0)" ::: "memory");
    }
    __syncthreads();
}
__device__ __forceinline__ void p5_fixup(const Ptrs& P, int gt, int NGT) {
    for (int i = gt; i < 63 * (DFF / 8); i += NGT) p5_fix_item(P, 1 + i / (DFF / 8), (i % (DFF / 8)) * 8);
}

__device__ __forceinline__ void p7_final(const Ptrs& P, int gw, int NGW, int lane) {
    const float* slab = (const float*)(P.ws + WS_SLAB2);
    for (int m = gw; m < SEQ; m += NGW) {
        const float part = (lane < 32) ? slab[(size_t)m * 32 + lane] : 0.f;
        const float rstd = 1.0f / sqrtf(wave_sum(part) * (1.0f / DMODEL) + EPS);
        f32x4* xr = (f32x4*)(P.out + (size_t)m * DMODEL) + lane; const f32x4* gr = (const f32x4*)P.g_final + lane;
#pragma unroll
        for (int j = 0; j < 8; ++j) { f32x4 v = xr[64 * j]; const f32x4 gg = gr[64 * j]; v = v * rstd * gg; xr[64 * j] = v; }
    }
}

struct Args { const float* in[16]; float* out; unsigned char* ws; int ph_lo, ph_hi; };
__global__ void __launch_bounds__(NWAVES * 64, 2) hybrid_fwd(Args args) {
    extern __shared__ __attribute__((aligned(16))) unsigned char lds_raw[];
    LAS unsigned char* lds = (LAS unsigned char*)lds_raw;
    cg::grid_group grid = cg::this_grid();
    const int tid = threadIdx.x, lane = tid & 63, wave = __builtin_amdgcn_readfirstlane(tid >> 6);
    const int G = gridDim.x, bx = blockIdx.x, vcu = (G % 8 == 0) ? (bx % 8) * (G / 8) + bx / 8 : bx;
    const int gw = vcu * NWAVES + wave, NGW = G * NWAVES;
    volatile LAS unsigned* MISC = (volatile LAS unsigned*)(lds + MISC_OFF);
    if (tid < 32) MISC[tid] = 0u;
    __syncthreads();
    const XcdBarrier bar = xcd_barrier_post((unsigned*)(args.ws + WS_CTL), MISC + 8);
    Ptrs P;
    P.x = args.in[0]; P.mem = args.in[1]; P.g_mix = args.in[2]; P.g_mem = args.in[3]; P.w_in = args.in[4]; P.conv_w = args.in[5]; P.pool_w = args.in[6]; P.pool_scale = args.in[7];
    P.w_kv = args.in[8]; P.w_out = args.in[9]; P.g_ffn = args.in[10]; P.w_up = args.in[11]; P.ffn_conv_w = args.in[12]; P.ffn_conv_b = args.in[13]; P.w_down = args.in[14]; P.g_final = args.in[15];
    P.out = args.out; P.ws = args.ws;
    unsigned char* ws = args.ws;
#if PROBE_SYNC
    for (int i = 0; i < 20; ++i) xcd_barrier(bar);
#endif
    const int lo = args.ph_lo, hi = args.ph_hi;
#define IN(k) (lo <= (k) && (k) < hi)
#define SYNC(k) do { if ((k) + 1 < hi) { if ((k) == 0 && USE_CG_SYNC) grid.sync(); else xcd_barrier(bar); } } while (0)
#define SYNCR(k, b) do { if ((k) + 1 < hi || rp + 1 < NREP(b)) { if ((k) == 0 && USE_CG_SYNC) grid.sync(); else xcd_barrier(bar); } } while (0)
#define NREP(b) ((REPM & (b)) ? 2 : 1)
    if (IN(0) && (PHM & 1)) for (int rp = 0; rp < NREP(1); ++rp) { p0_prologue(P, lds, gw, NGW, wave, lane); SYNCR(0, 1); }
    if (IN(1) && (PHM & 2)) for (int rp = 0; rp < NREP(2); ++rp) {
        pg8::Gemm g{(const bf16*)(ws + WS_H), (const bf16*)(ws + WS_WINT), SEQ, DIN, DMODEL}; pg8::StaticOrder S; S.init(SEQ, DIN, G, bx, P1_WGM);
        pg8::EpiZ E{(bf16*)(ws + WS_Z), DIN};
        pg8::gemm_phase<pg8::EpiZ, pg8::StaticOrder, P1_ALIGN, true>(lds, g, S, E, lds + XLDS_OFF);
        { const int nfull = ((SEQ / 256) * (DIN / 256)) % G;
          if (nfull == 0) p1_idle_work(P, lds, bx * NWAVES + wave, G * NWAVES, wave, lane);
          else if (bx >= nfull) p1_idle_work(P, lds, (bx - nfull) * NWAVES + wave, (G - nfull) * NWAVES, wave, lane); }
        SYNCR(1, 2);
    }
    if (IN(2) && (PHM & 4)) for (int rp = 0; rp < NREP(4); ++rp) { p2_mixer(P, lds, vcu, tid, wave, lane, 511);
#if PROBE_P2
        p2_mixer(P, lds, vcu, tid, wave, lane, PROBE_P2);
#endif
        SYNCR(2, 4); }
    if (IN(3) && (PHM & 8)) {
        pg8::Gemm g{(const bf16*)(ws + WS_MIX), (const bf16*)(ws + WS_WOUTT), SEQ, DMODEL, DMODEL}; pg8::PanelOrder S{G, vcu, (SEQ / 256) * (DMODEL / 256)};
        pg8::EpiNorm<0> E{nullptr, (const bf16*)(ws + WS_H), (const float*)(ws + WS_SIGX), (float*)(ws + WS_SIG), (bf16*)(ws + WS_X1B), nullptr, (const float*)(ws + WS_GINV), (unsigned*)(ws + WS_SLAB1), (unsigned*)(ws + WS_CTL) + CW_PANEL1, (unsigned*)(ws + WS_CTL) + XB_TMO};
        pg8::gemm_phase<pg8::EpiNorm<0>, pg8::PanelOrder, true, true>(lds, g, S, E, lds + XLDS_OFF);
        SYNC(3);
    }
#if PROBE_GEMM
    if (IN(3)) {
        pg8::Gemm g{(const bf16*)(ws + WS_X1B), (const bf16*)(ws + WS_WUPT), SEQ, PROBE_N, DMODEL}; pg8::StaticOrder S; S.init(SEQ, PROBE_N, G, bx);
#if PROBE_GEMM == 1
        pg8::EpiZ E{(bf16*)(ws + WS_Z), PROBE_N};
        pg8::gemm_phase<pg8::EpiZ, pg8::StaticOrder, true, true>(lds, g, S, E, lds + XLDS_OFF);
#elif PROBE_GEMM == 2
        pg8::EpiNone E{};
        pg8::gemm_phase<pg8::EpiNone, pg8::StaticOrder, true, true>(lds, g, S, E, lds + XLDS_OFF);
#elif PROBE_GEMM == 3
        pg8::EpiZ E{(bf16*)(ws + WS_Z), PROBE_N};
        pg8::gemm_phase<pg8::EpiZ, pg8::StaticOrder, true, false>(lds, g, S, E, lds + XLDS_OFF);
#elif PROBE_GEMM == 5
        pg8::EpiAct E{(bf16*)(ws + WS_ACT), P.ffn_conv_w, P.ffn_conv_b, (float*)(ws + WS_UBND)};
        pg8::gemm_phase<pg8::EpiAct, pg8::StaticOrder, true, true>(lds, g, S, E, lds + XLDS_OFF);
#elif PROBE_GEMM == 4
        pg8::EpiZ E{(bf16*)(ws + WS_Z), PROBE_N};
        pg8::gemm_phase<pg8::EpiZ, pg8::StaticOrder, false, true>(lds, g, S, E, lds + XLDS_OFF);
#endif
        xcd_barrier(bar);
    }
#endif
    if (IN(4) && (PHM & 16)) for (int rp = 0; rp < NREP(16); ++rp) {
        pg8::Gemm g{(const bf16*)(ws + WS_X1B), (const bf16*)(ws + WS_WUPT), SEQ, DFF2, DMODEL}; pg8::StaticOrder S; S.init(SEQ, DFF2, G, bx, P4_WGM);
        pg8::EpiAct E{(bf16*)(ws + WS_ACT), P.ffn_conv_w, P.ffn_conv_b, (float*)(ws + WS_UBND)};
        pg8::gemm_phase<pg8::EpiAct, pg8::StaticOrder, true, true>(lds, g, S, E, lds + XLDS_OFF);
        SYNCR(4, 16);
    }
#if !FUSE_FIXUP
    if (IN(5) && (PHM & 32)) { p5_fixup(P, vcu * (NWAVES * 64) + tid, G * NWAVES * 64); SYNC(5); }
#endif
    if (IN(6) && (PHM & 64)) {
#if FUSE_FIXUP
        p6_fixup_panels(P, vcu, G, tid, (unsigned*)(ws + WS_CTL) + CW_PANEL2, (unsigned*)(ws + WS_CTL) + XB_TMO);
#endif
        pg8::Gemm g{(const bf16*)(ws + WS_ACT), (const bf16*)(ws + WS_WDOWNT), SEQ, DMODEL, DFF}; pg8::PanelOrder S{G, vcu, (SEQ / 256) * (DMODEL / 256)};
        pg8::EpiNorm<1> E{nullptr, (const bf16*)(ws + WS_X1B), (const float*)(ws + WS_SIG), nullptr, nullptr, P.out, P.g_final, (unsigned*)(ws + WS_SLAB2), (unsigned*)(ws + WS_CTL) + CW_PANEL, (unsigned*)(ws + WS_CTL) + XB_TMO};
        pg8::gemm_phase<pg8::EpiNorm<1>, pg8::PanelOrder, true, true>(lds, g, S, E, lds + XLDS_OFF);
    }
#undef IN
#undef SYNC
}

extern "C" void kernel_launch(void* const* d_in, const int* in_sizes, int n_in, void* d_out, int out_size, void* d_ws, size_t ws_size, hipStream_t stream) {
    static int grid = 0;
    if (grid == 0) {
        if (n_in != 16 || in_sizes[0] != SEQ * DMODEL || out_size != SEQ * DMODEL || ws_size < WS_END) { fprintf(stderr, "kernel_launch: unexpected shapes (n_in %d, in0 %d, out %d, ws %zu)\n", n_in, n_in > 0 ? in_sizes[0] : -1, out_size, ws_size); grid = -1; return; }
        int dev = 0, cus = 0, per_cu = 0;
        if (hipGetDevice(&dev) != hipSuccess || hipDeviceGetAttribute(&cus, hipDeviceAttributeMultiprocessorCount, dev) != hipSuccess) { grid = -1; return; }
        if (hipFuncSetAttribute((const void*)hybrid_fwd, hipFuncAttributeMaxDynamicSharedMemorySize, LDS_BYTES) != hipSuccess) { fprintf(stderr, "kernel_launch: hipFuncSetAttribute failed\n"); grid = -1; return; }
        if (hipOccupancyMaxActiveBlocksPerMultiprocessor(&per_cu, (const void*)hybrid_fwd, NWAVES * 64, LDS_BYTES) != hipSuccess || per_cu < 1) { fprintf(stderr, "kernel_launch: occupancy query says %d blocks per CU\n", per_cu); (void)hipGetLastError(); per_cu = 1; }
        grid = cus;
        if (grid != 256) { fprintf(stderr, "kernel_launch: this kernel is laid out for one workgroup on each of 256 CUs (the mixer phase and the row-statistics exchanges assume it); the device reports %d\n", grid); if (grid > 256) grid = 256; }
    }
    if (grid < 0) return;
    if (hipMemsetAsync((char*)d_ws + WS_CTL, 0, CTL_ZERO_BYTES, stream) != hipSuccess) { fprintf(stderr, "kernel_launch: hipMemsetAsync failed\n"); return; }
    Args a{};
    for (int i = 0; i < 16; ++i) a.in[i] = (const float*)d_in[i];
    a.out = (float*)d_out; a.ws = (unsigned char*)d_ws;
#if MK_PER_PHASE
    for (int ph = 0; ph < NPHASE; ++ph) { a.ph_lo = ph; a.ph_hi = ph + 1; hipLaunchKernelGGL(hybrid_fwd, dim3(grid), dim3(NWAVES * 64), LDS_BYTES, stream, a); }
#else
    a.ph_lo = 0; a.ph_hi = NPHASE;
    void* kargs[] = {&a};
    hipError_t e = hipLaunchCooperativeKernel((const void*)hybrid_fwd, dim3(grid), dim3(NWAVES * 64), kargs, LDS_BYTES, stream);
    if (e != hipSuccess) fprintf(stderr, "kernel_launch: cooperative launch failed: %s (grid %d)\n", hipGetErrorString(e), grid);
#endif
}
```

```cpp
#include <hip/hip_runtime.h>
#include <hip/hip_cooperative_groups.h>
#include <cstdio>
#include <cstdint>
namespace cg = cooperative_groups;
#ifndef XCHG_ACQUIRE
#define XCHG_ACQUIRE 0
#endif
#ifndef PG8_PRIO
#define PG8_PRIO 0
#endif
namespace pg8 {
#define PG8_LAS __attribute__((address_space(3)))
typedef unsigned short bf16_t;
typedef short bf16x8 __attribute__((ext_vector_type(8)));
typedef float f32x4 __attribute__((ext_vector_type(4)));
typedef unsigned u32x4 __attribute__((ext_vector_type(4)));
constexpr int BM = 256, BK = 64, HALF = 128, HTB = HALF * BK * 2  , STAGE_BYTES = 8 * HTB, NXCD = 8, WGM = 8;

__host__ __device__ __forceinline__ int lds_byte(int r, int c) { const int st = (r >> 4) * 2 + (c >> 5), rr = r & 15, cc = c & 31, ob = rr * 64 + cc * 2; return st * 1024 + (ob ^ (((ob >> 9) & 1) << 5)); }
__host__ __device__ __forceinline__ void stage_rc(int b, int& R, int& C) { const int st = b / 1024, sb = b % 1024, swz = sb ^ (((sb >> 9) & 1) << 5); R = (st >> 1) * 16 + swz / 64; C = (st & 1) * 32 + (swz % 64) / 2; }
__host__ __device__ __forceinline__ int perm32(int rho) { const int n = rho >> 4, i = rho & 15; return 8 * (i >> 2) + 4 * n + (i & 3); }

struct Unit { int pm, pn; };
struct Gemm { const bf16_t* A; const bf16_t* Bt; int M, N, K; };

struct StaticOrder {
    int nM, nN, nwg, G, c, wgm;
    __host__ __device__ void init(int M, int N, int G_, int c_, int wgm_ = WGM) { nM = M / BM; nN = N / BM; nwg = nM * nN; G = G_; c = c_; wgm = wgm_; }
    __host__ __device__ bool next(int i, Unit& u) const {
        const long L = (long)i * G + c; if (L >= nwg) return false;
        int wgid = (int)L; { const int q = nwg / NXCD, r = nwg % NXCD, xcd = wgid % NXCD, off = wgid / NXCD; wgid = (xcd < r ? xcd * (q + 1) : r * (q + 1) + (xcd - r) * q) + off; }
        const int nig = wgm * nN, gid = wgid / nig, fm = gid * wgm, gsz = (nM - fm) < wgm ? (nM - fm) : wgm;
        u.pm = fm + ((wgid % nig) % gsz); u.pn = (wgid % nig) / gsz; return true;
    }
    __device__ __forceinline__ void a_ready(const Unit&) const {}
    __device__ __forceinline__ void done(const Unit&) const {}
};
__device__ __forceinline__ unsigned cvt_pk_bf16(float lo, float hi) { unsigned r; asm volatile("v_cvt_pk_bf16_f32 %0, %1, %2" : "=v"(r) : "v"(lo), "v"(hi)); return r; }
typedef unsigned u32x2 __attribute__((ext_vector_type(2)));
constexpr int DM = 2048;
constexpr float RMS_EPS = 1e-6f;

__device__ __forceinline__ void qswap_pieces(const u32x4 w0, const u32x4 w1, bool odd, u32x4& dA, u32x4& dB) {
#pragma unroll
    for (int j = 0; j < 4; ++j) { const unsigned snd = odd ? w0[j] : w1[j];
        const unsigned rcv = (unsigned)__builtin_amdgcn_mov_dpp((int)snd, 0xB1, 0xf, 0xf, false);
        dA[j] = odd ? rcv : w0[j]; dB[j] = odd ? w1[j] : rcv; }
}
struct EpiZ {
    static constexpr bool PERM = true, AFTER_DRAIN = false;
    bf16_t* O; int ldc;
    __device__ __forceinline__ void operator()(const f32x4 (&acc)[2][2][4][2], const Unit& u, int wr, int wc, int fr_, int fq_, PG8_LAS unsigned char*) const {
        int t_ = threadIdx.x; asm volatile("" : "+v"(t_));
        const int fr = t_ & 15, fq = (t_ >> 4) & 3; const bool odd = fr & 1;
        const int rowe = u.pm * BM + wr * 64 + (fr & ~1), colp = u.pn * BM + wc * 64 + 8 * fq + (odd ? 32 : 0);
#pragma unroll
        for (int ai = 0; ai < 2; ++ai)
#pragma unroll
            for (int m = 0; m < 4; ++m) { u32x4 w0, w1, dA, dB;
                { const f32x4 v0 = acc[ai][0][m][0], v1 = acc[ai][0][m][1]; w0.x = cvt_pk_bf16(v0[0], v0[1]); w0.y = cvt_pk_bf16(v0[2], v0[3]); w0.z = cvt_pk_bf16(v1[0], v1[1]); w0.w = cvt_pk_bf16(v1[2], v1[3]); }
                { const f32x4 v0 = acc[ai][1][m][0], v1 = acc[ai][1][m][1]; w1.x = cvt_pk_bf16(v0[0], v0[1]); w1.y = cvt_pk_bf16(v0[2], v0[3]); w1.z = cvt_pk_bf16(v1[0], v1[1]); w1.w = cvt_pk_bf16(v1[2], v1[3]); }
                qswap_pieces(w0, w1, odd, dA, dB);
                bf16_t* p = O + (size_t)(rowe + ai * HALF + m * 16) * ldc + colp;
                *(u32x4*)p = dA; *(u32x4*)(p + ldc) = dB; }
    }
};

struct EpiNone {
    static constexpr bool PERM = true, AFTER_DRAIN = false;
    __device__ __forceinline__ void operator()(const f32x4 (&acc)[2][2][4][2], const Unit& u, int wr, int wc, int fr, int fq, PG8_LAS unsigned char*) const {
#pragma unroll
        for (int ai = 0; ai < 2; ++ai)
#pragma unroll
            for (int bj = 0; bj < 2; ++bj)
#pragma unroll
                for (int m = 0; m < 4; ++m)
#pragma unroll
                    for (int n = 0; n < 2; ++n) asm volatile("" :: "v"(acc[ai][bj][m][n]));
    }
};
struct EpiResA {
    static constexpr bool PERM = true, AFTER_DRAIN = false;
    const float* R; bf16_t* XB; float* slab;
    __device__ __forceinline__ void operator()(const f32x4 (&acc)[2][2][4][2], const Unit& u, int wr, int wc, int fr_, int fq_, PG8_LAS unsigned char*) const {
        int t_ = threadIdx.x; asm volatile("" : "+v"(t_));
        const int fr = t_ & 15, fq = (t_ >> 4) & 3;
        const int row0 = u.pm * BM + wr * 64 + fr, col0 = u.pn * BM + wc * 32 + 8 * fq;
#pragma unroll
        for (int ai = 0; ai < 2; ++ai) {
            f32x4 r[4][2][2];
#pragma unroll
            for (int m = 0; m < 4; ++m)
#pragma unroll
                for (int bj = 0; bj < 2; ++bj) { const float* p = R + (size_t)(row0 + ai * HALF + m * 16) * DM + col0 + bj * HALF; r[m][bj][0] = *(const f32x4*)p; r[m][bj][1] = *(const f32x4*)(p + 4); }
#pragma unroll
            for (int m = 0; m < 4; ++m) { const int row = row0 + ai * HALF + m * 16; float ss = 0.f;
#pragma unroll
                for (int bj = 0; bj < 2; ++bj) { const f32x4 v0 = acc[ai][bj][m][0] + r[m][bj][0], v1 = acc[ai][bj][m][1] + r[m][bj][1];
                    u32x4 w; w.x = cvt_pk_bf16(v0[0], v0[1]); w.y = cvt_pk_bf16(v0[2], v0[3]); w.z = cvt_pk_bf16(v1[0], v1[1]); w.w = cvt_pk_bf16(v1[2], v1[3]);
                    *(u32x4*)(XB + (size_t)row * DM + col0 + bj * HALF) = w;
                    ss += (v0[0] * v0[0] + v0[1] * v0[1]) + (v0[2] * v0[2] + v0[3] * v0[3]) + (v1[0] * v1[0] + v1[1] * v1[1]) + (v1[2] * v1[2] + v1[3] * v1[3]); }
                ss += __shfl_xor(ss, 16); ss += __shfl_xor(ss, 32);
                if (fq == 0) slab[(size_t)row * 32 + u.pn * 4 + wc] = ss; }
            asm volatile("" ::: "memory"); }
    }
};
struct EpiResB {
    static constexpr bool PERM = true, AFTER_DRAIN = false;
    const bf16_t* RB; float* X; float* slab;
    __device__ __forceinline__ void operator()(const f32x4 (&acc)[2][2][4][2], const Unit& u, int wr, int wc, int fr_, int fq_, PG8_LAS unsigned char*) const {
        int t_ = threadIdx.x; asm volatile("" : "+v"(t_));
        const int fr = t_ & 15, fq = (t_ >> 4) & 3;
        const int row0 = u.pm * BM + wr * 64 + fr, col0 = u.pn * BM + wc * 32 + 8 * fq;
        u32x4 r[2][4][2];
#pragma unroll
        for (int ai = 0; ai < 2; ++ai)
#pragma unroll
            for (int m = 0; m < 4; ++m)
#pragma unroll
                for (int bj = 0; bj < 2; ++bj) r[ai][m][bj] = *(const u32x4*)(RB + (size_t)(row0 + ai * HALF + m * 16) * DM + col0 + bj * HALF);
#pragma unroll
        for (int ai = 0; ai < 2; ++ai)
#pragma unroll
            for (int m = 0; m < 4; ++m) { const int row = row0 + ai * HALF + m * 16; float ss = 0.f;
#pragma unroll
                for (int bj = 0; bj < 2; ++bj) { const u32x4 q = r[ai][m][bj];
                    const f32x4 r0 = {__builtin_bit_cast(float, q.x << 16), __builtin_bit_cast(float, q.x & 0xffff0000u), __builtin_bit_cast(float, q.y << 16), __builtin_bit_cast(float, q.y & 0xffff0000u)};
                    const f32x4 r1 = {__builtin_bit_cast(float, q.z << 16), __builtin_bit_cast(float, q.z & 0xffff0000u), __builtin_bit_cast(float, q.w << 16), __builtin_bit_cast(float, q.w & 0xffff0000u)};
                    const f32x4 v0 = acc[ai][bj][m][0] + r0, v1 = acc[ai][bj][m][1] + r1;
                    float* xp = X + (size_t)row * DM + col0 + bj * HALF; *(f32x4*)xp = v0; *(f32x4*)(xp + 4) = v1;
                    ss += (v0[0] * v0[0] + v0[1] * v0[1]) + (v0[2] * v0[2] + v0[3] * v0[3]) + (v1[0] * v1[0] + v1[1] * v1[1]) + (v1[2] * v1[2] + v1[3] * v1[3]); }
                ss += __shfl_xor(ss, 16); ss += __shfl_xor(ss, 32);
                if (fq == 0) slab[(size_t)row * 32 + u.pn * 4 + wc] = ss; }
    }
};

struct PanelOrder {
    int G, vcu, ntot;
    __device__ __forceinline__ bool next(int i, Unit& u) const { const int L = i * G + vcu; if (L >= ntot) return false; u.pm = L >> 3; u.pn = L & 7; return true; }
    __device__ __forceinline__ void a_ready(const Unit&) const {}
    __device__ __forceinline__ void done(const Unit&) const {}
};
template <int MODE  > struct EpiNorm {
    static constexpr bool PERM = (MODE == 0), AFTER_DRAIN = false;
    const float* Rf; const bf16_t* Rb; const float* sig_in; float* sig_out; bf16_t* HN; float* OUT; const float* gfin; unsigned* xbuf; unsigned* cnt; unsigned* tmo;
    __device__ __forceinline__ void operator()(f32x4 (&acc)[2][2][4][2], const Unit& u, int wr, int wc, int fr_, int fq_, PG8_LAS unsigned char* xlds) const {
        int t_ = threadIdx.x; asm volatile("" : "+v"(t_));
        const int fr = t_ & 15, fq = (t_ >> 4) & 3, wid = __builtin_amdgcn_readfirstlane(t_ >> 6);
        const int rl0 = wr * 64 + fr, row0 = u.pm * BM + rl0, col0 = u.pn * BM + wc * 64 + 8 * fq;
        PG8_LAS float* Pt = (PG8_LAS float*)xlds;
        PG8_LAS float* St = (PG8_LAS float*)(xlds + 4096);
        if constexpr (MODE == 0) {
            f32x4 gi[2][2];
#pragma unroll
            for (int bj = 0; bj < 2; ++bj) { gi[bj][0] = *(const f32x4*)(gfin + col0 + bj * 32); gi[bj][1] = *(const f32x4*)(gfin + col0 + bj * 32 + 4); }
#pragma unroll
            for (int ai = 0; ai < 2; ++ai) { u32x4 r[4][2]; float sg[4];
#pragma unroll
                for (int m = 0; m < 4; ++m) { sg[m] = sig_in[row0 + ai * HALF + m * 16];
#pragma unroll
                    for (int bj = 0; bj < 2; ++bj) r[m][bj] = *(const u32x4*)(Rb + (size_t)(row0 + ai * HALF + m * 16) * DM + col0 + bj * 32); }
#pragma unroll
                for (int m = 0; m < 4; ++m) { float ss = 0.f; const float sgm = sg[m];
#pragma unroll
                    for (int bj = 0; bj < 2; ++bj) { const u32x4 q = r[m][bj];
                        const f32x4 r0 = {__builtin_bit_cast(float, q.x << 16), __builtin_bit_cast(float, q.x & 0xffff0000u), __builtin_bit_cast(float, q.y << 16), __builtin_bit_cast(float, q.y & 0xffff0000u)};
                        const f32x4 r1 = {__builtin_bit_cast(float, q.z << 16), __builtin_bit_cast(float, q.z & 0xffff0000u), __builtin_bit_cast(float, q.w << 16), __builtin_bit_cast(float, q.w & 0xffff0000u)};
                        const f32x4 v0 = acc[ai][bj][m][0] + r0 * gi[bj][0] * sgm, v1 = acc[ai][bj][m][1] + r1 * gi[bj][1] * sgm; acc[ai][bj][m][0] = v0; acc[ai][bj][m][1] = v1;
                        ss += (v0[0] * v0[0] + v0[1] * v0[1]) + (v0[2] * v0[2] + v0[3] * v0[3]) + (v1[0] * v1[0] + v1[1] * v1[1]) + (v1[2] * v1[2] + v1[3] * v1[3]); }
                    ss += __shfl_xor(ss, 16); ss += __shfl_xor(ss, 32);
                    if (fq == 0) Pt[(ai * HALF + rl0 + m * 16) * 4 + wc] = ss; }
                asm volatile("" ::: "memory"); }
        } else { u32x2 r[2][4][2][2]; float sg[2][4]; const int colb = u.pn * BM + wc * 32 + 4 * fq;
#pragma unroll
            for (int ai = 0; ai < 2; ++ai)
#pragma unroll
                for (int m = 0; m < 4; ++m) { sg[ai][m] = sig_in[row0 + ai * HALF + m * 16];
#pragma unroll
                    for (int bj = 0; bj < 2; ++bj)
#pragma unroll
                        for (int n = 0; n < 2; ++n) r[ai][m][bj][n] = *(const u32x2*)(Rb + (size_t)(row0 + ai * HALF + m * 16) * DM + colb + bj * HALF + 16 * n); }
#pragma unroll
            for (int ai = 0; ai < 2; ++ai)
#pragma unroll
                for (int m = 0; m < 4; ++m) { float ss = 0.f; const float sgm = sg[ai][m];
#pragma unroll
                    for (int bj = 0; bj < 2; ++bj)
#pragma unroll
                        for (int n = 0; n < 2; ++n) { const u32x2 q = r[ai][m][bj][n];
                            const f32x4 r0 = {__builtin_bit_cast(float, q.x << 16), __builtin_bit_cast(float, q.x & 0xffff0000u), __builtin_bit_cast(float, q.y << 16), __builtin_bit_cast(float, q.y & 0xffff0000u)};
                            const f32x4 v0 = acc[ai][bj][m][n] + r0 * sgm; acc[ai][bj][m][n] = v0;
                            ss += (v0[0] * v0[0] + v0[1] * v0[1]) + (v0[2] * v0[2] + v0[3] * v0[3]); }
                    ss += __shfl_xor(ss, 16); ss += __shfl_xor(ss, 32);
                    if (fq == 0) Pt[(ai * HALF + rl0 + m * 16) * 4 + wc] = ss; } }
        asm volatile("s_waitcnt lgkmcnt(0)" ::: "memory"); __builtin_amdgcn_s_barrier(); asm volatile("" ::: "memory");
        if (t_ < 256) { const float s = (Pt[t_ * 4 + 0] + Pt[t_ * 4 + 1]) + (Pt[t_ * 4 + 2] + Pt[t_ * 4 + 3]);
            __hip_atomic_store(xbuf + (size_t)(u.pm * BM + t_) * 8 + u.pn, __builtin_bit_cast(unsigned, s), __ATOMIC_RELAXED, __HIP_MEMORY_SCOPE_AGENT); }
        asm volatile("s_waitcnt vmcnt(0)" ::: "memory");
        if (t_ < 256 && (t_ & 63) == 0) __hip_atomic_fetch_add(cnt + 64 * u.pm, 1u, __ATOMIC_RELAXED, __HIP_MEMORY_SCOPE_AGENT);
        if (wid == 0) {
            unsigned spins = 0;
            while ((unsigned)__builtin_amdgcn_readfirstlane(__hip_atomic_load(cnt + 64 * u.pm, __ATOMIC_RELAXED, __HIP_MEMORY_SCOPE_AGENT)) < 32u) {
                __builtin_amdgcn_s_sleep(2);
                if (++spins > (1u << 20)) { if ((t_ & 63) == 0) __hip_atomic_store(tmo, 1u, __ATOMIC_RELAXED, __HIP_MEMORY_SCOPE_AGENT); break; } }
#if XCHG_ACQUIRE
            __builtin_amdgcn_fence(__ATOMIC_ACQUIRE, "agent");
#endif
        }
        asm volatile("s_waitcnt vmcnt(0) lgkmcnt(0)" ::: "memory"); __builtin_amdgcn_s_barrier(); asm volatile("" ::: "memory");
        if (t_ < 256) { const unsigned long long* sp = (const unsigned long long*)(xbuf + (size_t)(u.pm * BM + t_) * 8); float tot = 0.f;
#pragma unroll
            for (int q = 0; q < 4; ++q) { const unsigned long long w = __hip_atomic_load(sp + q, __ATOMIC_RELAXED, __HIP_MEMORY_SCOPE_AGENT);
                tot += __builtin_bit_cast(float, (unsigned)w); tot += __builtin_bit_cast(float, (unsigned)(w >> 32)); }
            const float sd = sqrtf(tot * (1.0f / DM) + RMS_EPS);
            St[t_] = 1.0f / sd;
            if (MODE == 0 && u.pn == 0) sig_out[u.pm * BM + t_] = sd; }
        asm volatile("s_waitcnt lgkmcnt(0)" ::: "memory"); __builtin_amdgcn_s_barrier(); asm volatile("" ::: "memory");
        if constexpr (MODE == 0) {
            const bool odd = fr & 1;
#pragma unroll
            for (int ai = 0; ai < 2; ++ai)
#pragma unroll
                for (int m = 0; m < 4; ++m) { const float rstd = St[ai * HALF + rl0 + m * 16]; u32x4 w0, w1, dA, dB;
                    { const f32x4 v0 = acc[ai][0][m][0] * rstd, v1 = acc[ai][0][m][1] * rstd; w0.x = cvt_pk_bf16(v0[0], v0[1]); w0.y = cvt_pk_bf16(v0[2], v0[3]); w0.z = cvt_pk_bf16(v1[0], v1[1]); w0.w = cvt_pk_bf16(v1[2], v1[3]); }
                    { const f32x4 v0 = acc[ai][1][m][0] * rstd, v1 = acc[ai][1][m][1] * rstd; w1.x = cvt_pk_bf16(v0[0], v0[1]); w1.y = cvt_pk_bf16(v0[2], v0[3]); w1.z = cvt_pk_bf16(v1[0], v1[1]); w1.w = cvt_pk_bf16(v1[2], v1[3]); }
                    qswap_pieces(w0, w1, odd, dA, dB);
                    bf16_t* p = HN + (size_t)((row0 & ~1) + ai * HALF + m * 16) * DM + col0 + (odd ? 32 : 0);
                    *(u32x4*)p = dA; *(u32x4*)(p + DM) = dB; }
        } else {
            const int colb = u.pn * BM + wc * 32 + 4 * fq; const bool odd = fr & 1;
            f32x4 gg[2][2];
#pragma unroll
            for (int bj = 0; bj < 2; ++bj)
#pragma unroll
                for (int n = 0; n < 2; ++n) gg[bj][n] = *(const f32x4*)(gfin + colb + bj * HALF + 16 * n);
#pragma unroll
            for (int ai = 0; ai < 2; ++ai)
#pragma unroll
                for (int m = 0; m < 4; ++m) { const float rstd = St[ai * HALF + rl0 + m * 16]; float* op = OUT + (size_t)(row0 + ai * HALF + m * 16) * DM + colb;
#pragma unroll
                    for (int bj = 0; bj < 2; ++bj) {
                        const f32x4 o0 = acc[ai][bj][m][0] * rstd * gg[bj][0], o1 = acc[ai][bj][m][1] * rstd * gg[bj][1]; f32x4 dA, dB;
#pragma unroll
                        for (int j = 0; j < 4; ++j) { const float snd = odd ? o0[j] : o1[j];
                            const float rcv = __builtin_bit_cast(float, __builtin_amdgcn_mov_dpp(__builtin_bit_cast(int, snd), 0xB1, 0xf, 0xf, false));
                            dA[j] = odd ? rcv : o0[j]; dB[j] = odd ? o1[j] : rcv; }
                        float* pp = op + bj * HALF + (odd ? 16 : 0);
                        *(f32x4*)(pp - (odd ? DM : 0)) = dA; *(f32x4*)(pp + (odd ? 0 : DM)) = dB; } }
        }
    }
};

__device__ __forceinline__ float dpp_shr1(float old, float src) { return __builtin_bit_cast(float, __builtin_amdgcn_update_dpp(__builtin_bit_cast(int, old), __builtin_bit_cast(int, src), 0x111, 0xf, 0xf, false)); }
__device__ __forceinline__ float dpp_shr2(float old, float src) { return __builtin_bit_cast(float, __builtin_amdgcn_update_dpp(__builtin_bit_cast(int, old), __builtin_bit_cast(int, src), 0x112, 0xf, 0xf, false)); }
__device__ __forceinline__ float dpp_ror1(float src) { return __builtin_bit_cast(float, __builtin_amdgcn_mov_dpp(__builtin_bit_cast(int, src), 0x121, 0xf, 0xf, false)); }
__device__ __forceinline__ float dpp_ror2(float src) { return __builtin_bit_cast(float, __builtin_amdgcn_mov_dpp(__builtin_bit_cast(int, src), 0x122, 0xf, 0xf, false)); }
constexpr int FF = 5632, FF2 = 11264;
typedef _Float16 h2_t __attribute__((ext_vector_type(2)));
__device__ __forceinline__ unsigned pkh(float a, float b) { return __builtin_bit_cast(unsigned, __builtin_amdgcn_cvt_pkrtz(a, b)); }
__device__ __forceinline__ unsigned dppu_shr1(unsigned old, unsigned src) { return (unsigned)__builtin_amdgcn_update_dpp((int)old, (int)src, 0x111, 0xf, 0xf, false); }
__device__ __forceinline__ unsigned dppu_shr2(unsigned old, unsigned src) { return (unsigned)__builtin_amdgcn_update_dpp((int)old, (int)src, 0x112, 0xf, 0xf, false); }
__device__ __forceinline__ unsigned dppu_ror1(unsigned src) { return (unsigned)__builtin_amdgcn_mov_dpp((int)src, 0x121, 0xf, 0xf, false); }
__device__ __forceinline__ unsigned dppu_ror2(unsigned src) { return (unsigned)__builtin_amdgcn_mov_dpp((int)src, 0x122, 0xf, 0xf, false); }
struct EpiAct {
    static constexpr bool PERM = true, AFTER_DRAIN = false;
    bf16_t* ACT; const float* cw; const float* cb; float* ubnd;
    __device__ __forceinline__ void operator()(f32x4 (&acc)[2][2][4][2], const Unit& u, int wr, int wc, int fr_, int fq_, PG8_LAS unsigned char* xlds) const {
        int t_ = threadIdx.x; asm volatile("" : "+v"(t_));
        const int fr = t_ & 15, fq = (t_ >> 4) & 3;
        const int row0 = u.pm * BM + wr * 64 + fr, cl = wc * 32 + 8 * fq;
        const int c0 = u.pn * 128 + cl;
        f32x4 wgt[2][8];
#pragma unroll
        for (int n = 0; n < 2; ++n) { const float* wp = cw + c0 + 4 * n; const float* bp = cb + c0 + 4 * n;
            wgt[n][0] = *(const f32x4*)wp; wgt[n][1] = *(const f32x4*)(wp + FF2); wgt[n][2] = *(const f32x4*)(wp + 2 * FF2); wgt[n][3] = *(const f32x4*)bp;
            wgt[n][4] = *(const f32x4*)(wp + FF); wgt[n][5] = *(const f32x4*)(wp + FF2 + FF); wgt[n][6] = *(const f32x4*)(wp + 2 * FF2 + FF); wgt[n][7] = *(const f32x4*)(bp + FF); }
        if (wr == 1 && fr >= 14) {
#pragma unroll
            for (int bj = 0; bj < 2; ++bj)
#pragma unroll
                for (int n = 0; n < 2; ++n) *(f32x4*)(ubnd + (size_t)(u.pm * 4 + 2 + (fr - 14)) * FF2 + u.pn * BM + 64 * wc + 32 * bj + 8 * fq + 4 * n) = acc[1][bj][3][n]; }
        if (wr == 0 && fr < 2) {
#pragma unroll
            for (int bj = 0; bj < 2; ++bj)
#pragma unroll
                for (int n = 0; n < 2; ++n) *(f32x4*)(ubnd + (size_t)(u.pm * 4 + fr) * FF2 + u.pn * BM + 64 * wc + 32 * bj + 8 * fq + 4 * n) = acc[0][bj][0][n]; }
        u32x4 pk[2][4][2];
#pragma unroll
        for (int ai = 0; ai < 2; ++ai)
#pragma unroll
            for (int m = 0; m < 4; ++m)
#pragma unroll
                for (int n = 0; n < 2; ++n) { const f32x4 g = acc[ai][0][m][n], v = acc[ai][1][m][n]; pk[ai][m][n] = (u32x4){pkh(g[0], v[0]), pkh(g[1], v[1]), pkh(g[2], v[2]), pkh(g[3], v[3])}; }
        if (fr >= 14) {
#pragma unroll
            for (int ai = 0; ai < 2; ++ai)
#pragma unroll
                for (int n = 0; n < 2; ++n) *(PG8_LAS u32x4*)(xlds + ((((2 * ai + wr) * 2 + (fr - 14)) * 128 + cl + 4 * n) << 2)) = pk[ai][3][n]; }
        asm volatile("s_waitcnt lgkmcnt(0)" ::: "memory"); __builtin_amdgcn_s_barrier(); asm volatile("" ::: "memory");
        u32x2 hold[2][4];
#pragma unroll
        for (int n = 0; n < 2; ++n) {
            h2_t w0p[4], w1p[4], w2p[4], bp4[4];
#pragma unroll
            for (int j = 0; j < 4; ++j) { w0p[j] = __builtin_bit_cast(h2_t, pkh(wgt[n][0][j], wgt[n][4][j])); w1p[j] = __builtin_bit_cast(h2_t, pkh(wgt[n][1][j], wgt[n][5][j]));
                w2p[j] = __builtin_bit_cast(h2_t, pkh(wgt[n][2][j], wgt[n][6][j])); bp4[j] = __builtin_bit_cast(h2_t, pkh(wgt[n][3][j], wgt[n][7][j])); }
#pragma unroll
            for (int ai = 0; ai < 2; ++ai) {
                const int chunk = 2 * ai + wr;
                u32x4 pp = {0u, 0u, 0u, 0u};
                if (chunk > 0) pp = *(const PG8_LAS u32x4*)(xlds + ((((chunk - 1) * 2 + (fr & 1)) * 128 + cl + 4 * n) << 2));
#pragma unroll
                for (int m = 0; m < 4; ++m) {
                    const u32x4 cur = pk[ai][m][n]; float a[4];
#pragma unroll
                    for (int j = 0; j < 4; ++j) {
                        const unsigned cj = cur[j], pj = pp[j];
                        const h2_t s1 = __builtin_bit_cast(h2_t, dppu_shr1(dppu_ror1(pj), cj)), s2 = __builtin_bit_cast(h2_t, dppu_shr2(dppu_ror2(pj), cj)), ch = __builtin_bit_cast(h2_t, cj);
                        const h2_t r = w2p[j] * ch + (w1p[j] * s1 + (w0p[j] * s2 + bp4[j]));
                        const float G = (float)r.x, V = (float)r.y;
                        a[j] = G * __builtin_amdgcn_rcpf(1.0f + __builtin_amdgcn_exp2f(-1.4426950408889634f * G)) * V; }
                    u32x2 w; w.x = cvt_pk_bf16(a[0], a[1]); w.y = cvt_pk_bf16(a[2], a[3]);
                    if (n == 0) hold[ai][m] = w;
                    else { u32x4 o; o.x = hold[ai][m].x; o.y = hold[ai][m].y; o.z = w.x; o.w = w.y;
                        if (!(ai == 0 && m == 0 && wr == 0 && u.pm > 0 && fr < 2)) *(u32x4*)(ACT + (size_t)(row0 + ai * HALF + m * 16) * FF + c0) = o; }
                    pp = cur;
                }
            }
        }
    }
};

template <class Epi, class Sched, bool ALIGN_EPI = false, bool SP2 = false>
__device__ __forceinline__ void gemm_phase(PG8_LAS unsigned char* lds, const Gemm g, const Sched& S, const Epi& E, PG8_LAS unsigned char* xlds) {
    const int tid = threadIdx.x, wid = __builtin_amdgcn_readfirstlane(tid >> 6), lane = tid & 63, wr = wid >> 2, wc = wid & 3, fr = lane & 15, fq = lane >> 4;
    const int K = g.K, nt = K / BK;
    unsigned voffA[2], voffB[2], voffB1[2];
#pragma unroll
    for (int i = 0; i < 2; ++i) { int R, C; stage_rc(tid * 16 + i * 8192, R, C); const int Rb0 = Epi::PERM ? (64 * (R >> 5) + perm32(R & 31)) : R, Rb1 = Epi::PERM ? Rb0 + 32 : R + HALF;
        voffA[i] = (unsigned)(R * K + C) * 2u; voffB[i] = (unsigned)(Rb0 * K + C) * 2u; voffB1[i] = (unsigned)(Rb1 * K + C) * 2u; }
    const size_t kstep = (size_t)(BK * 2);
    const size_t hstep = (size_t)HALF * K * 2;
    const size_t tstep = 2 * hstep;
    const unsigned ldsw = (unsigned)wid * 1024u;
    const int aoff = lds_byte(wr * 64 + fr, fq * 8), boff = lds_byte(wc * 32 + fr, fq * 8);
#define PG8_SA(b, h) (((b) * 2 + (h)) * HTB)
#define PG8_SB(b, h) ((4 + (b) * 2 + (h)) * HTB)
#define PG8_STAGE(bufoff, gbase, voff) do { _Pragma("unroll") for (int _i = 0; _i < 2; ++_i) \
        __builtin_amdgcn_global_load_lds((const unsigned*)((const char*)(gbase) + (voff)[_i]), (PG8_LAS unsigned*)(lds + (bufoff) + ldsw + _i * 8192), 16, 0, 0); } while (0)
#define PG8_LDA(dst, b, h) do { _Pragma("unroll") for (int m = 0; m < 4; ++m) _Pragma("unroll") for (int k = 0; k < 2; ++k) dst[m][k] = *(const PG8_LAS bf16x8*)(lds + PG8_SA(b, h) + aoff + m * 2048 + k * 1024); } while (0)
#define PG8_LDB(dst, b, h) do { _Pragma("unroll") for (int n = 0; n < 2; ++n) _Pragma("unroll") for (int k = 0; k < 2; ++k) dst[n][k] = *(const PG8_LAS bf16x8*)(lds + PG8_SB(b, h) + boff + n * 2048 + k * 1024); } while (0)
#define PG8_MMA(ai, bj, At, Bt) do { __builtin_amdgcn_s_setprio(PG8_PRIO); _Pragma("unroll") for (int m = 0; m < 4; ++m) _Pragma("unroll") for (int n = 0; n < 2; ++n) _Pragma("unroll") for (int k = 0; k < 2; ++k) \
        acc[ai][bj][m][n] = __builtin_amdgcn_mfma_f32_16x16x32_bf16(Bt[n][k], At[m][k], acc[ai][bj][m][n], 0, 0, 0); __builtin_amdgcn_s_setprio(0); } while (0)
#define PG8_WAIT_V(n) asm volatile("s_waitcnt vmcnt(" #n ")" ::: "memory")
#define PG8_WAIT_L(n) asm volatile("s_waitcnt lgkmcnt(" #n ")" ::: "memory")
#define PG8_BAR __builtin_amdgcn_s_barrier()
#define PG8_SCHED __builtin_amdgcn_sched_barrier(0)
    Unit cur, nxt; int ui = 0;
    if (!S.next(0, cur)) return;
    f32x4 acc[2][2][4][2];
#pragma unroll
    for (int a = 0; a < 2; ++a)
#pragma unroll
        for (int b = 0; b < 2; ++b)
#pragma unroll
            for (int m = 0; m < 4; ++m)
#pragma unroll
                for (int n = 0; n < 2; ++n) acc[a][b][m][n] = (f32x4){0.f, 0.f, 0.f, 0.f};
    bf16x8 At[4][2], B0[2][2], B1[2][2];
    const char* cA = (const char*)g.A + (size_t)cur.pm * tstep; const char* cB = (const char*)g.Bt + (size_t)cur.pn * tstep;
    S.a_ready(cur);
    if constexpr (SP2) {
        PG8_STAGE(PG8_SB(0, 0), cB, voffB); PG8_STAGE(PG8_SB(0, 1), cB, voffB1); PG8_STAGE(PG8_SA(0, 0), cA, voffA); PG8_STAGE(PG8_SA(0, 1), cA + hstep, voffA);
        if (wr == 1) PG8_BAR;
        PG8_WAIT_V(2); PG8_BAR;
        PG8_STAGE(PG8_SB(1, 0), cB + kstep, voffB); PG8_STAGE(PG8_SA(1, 0), cA + kstep, voffA); PG8_STAGE(PG8_SB(1, 1), cB + kstep, voffB1);
        PG8_WAIT_V(6); PG8_BAR;
    } else {
        PG8_STAGE(PG8_SB(0, 0), cB, voffB); PG8_STAGE(PG8_SA(0, 0), cA, voffA); PG8_STAGE(PG8_SB(0, 1), cB, voffB1); PG8_STAGE(PG8_SA(0, 1), cA + hstep, voffA);
        if (wr == 1) PG8_BAR;
        PG8_WAIT_V(4); PG8_BAR;
        PG8_STAGE(PG8_SB(1, 0), cB + kstep, voffB); PG8_STAGE(PG8_SA(1, 0), cA + kstep, voffA); PG8_STAGE(PG8_SB(1, 1), cB + kstep, voffB1);
        PG8_WAIT_V(6); PG8_BAR;
    }
    for (;;) {
        const bool has_next = S.next(ui + 1, nxt);
        const char* nA = has_next ? (const char*)g.A + (size_t)nxt.pm * tstep : cA; const char* nB = has_next ? (const char*)g.Bt + (size_t)nxt.pn * tstep : cB;
        for (int t = 0; t < nt; t += 2) {
            const bool last = (t == nt - 2);
            const char* a1 = cA + (size_t)(t + 1) * kstep;
            const char* a2 = last ? nA : cA + (size_t)(t + 2) * kstep; const char* b2 = last ? nB : cB + (size_t)(t + 2) * kstep;
            const char* a3 = a2 + kstep; const char* b3 = b2 + kstep;
            if (last && has_next) S.a_ready(nxt);
            if constexpr (SP2) {
            PG8_LDB(B0, 0, 0); PG8_LDB(B1, 0, 1); PG8_SCHED; PG8_LDA(At, 0, 0); PG8_STAGE(PG8_SA(1, 1), a1 + hstep, voffA);
            PG8_WAIT_V(8); PG8_WAIT_L(0); PG8_BAR; PG8_MMA(0, 0, At, B0); PG8_MMA(0, 1, At, B1); PG8_BAR; PG8_SCHED;
            PG8_LDA(At, 0, 1); PG8_STAGE(PG8_SB(0, 0), b2, voffB); PG8_STAGE(PG8_SB(0, 1), b2, voffB1); PG8_STAGE(PG8_SA(0, 0), a2, voffA);
            PG8_WAIT_V(8); PG8_WAIT_L(0); PG8_BAR; PG8_MMA(1, 0, At, B0); PG8_MMA(1, 1, At, B1); PG8_BAR; PG8_SCHED;
            PG8_LDB(B0, 1, 0); PG8_LDB(B1, 1, 1); PG8_SCHED; PG8_LDA(At, 1, 0); PG8_STAGE(PG8_SA(0, 1), a2 + hstep, voffA);
            PG8_WAIT_V(8); PG8_WAIT_L(0); PG8_BAR; PG8_MMA(0, 0, At, B0); PG8_MMA(0, 1, At, B1); PG8_BAR; PG8_SCHED;
            PG8_LDA(At, 1, 1); PG8_STAGE(PG8_SB(1, 0), b3, voffB); PG8_STAGE(PG8_SB(1, 1), b3, voffB1); PG8_STAGE(PG8_SA(1, 0), a3, voffA);
            PG8_WAIT_V(8); PG8_WAIT_L(0); PG8_BAR; PG8_MMA(1, 0, At, B0); PG8_MMA(1, 1, At, B1); PG8_BAR; PG8_SCHED;
            } else {
            PG8_LDB(B0, 0, 0); PG8_SCHED; PG8_LDA(At, 0, 0); PG8_STAGE(PG8_SA(1, 1), a1 + hstep, voffA);
            PG8_WAIT_L(8); PG8_BAR; PG8_WAIT_L(0); PG8_MMA(0, 0, At, B0); PG8_BAR; PG8_SCHED;
            PG8_LDB(B1, 0, 1); PG8_STAGE(PG8_SB(0, 0), b2, voffB);
            PG8_BAR; PG8_WAIT_L(0); PG8_MMA(0, 1, At, B1); PG8_BAR;
            PG8_LDA(At, 0, 1); PG8_STAGE(PG8_SA(0, 0), a2, voffA);
            PG8_BAR; PG8_WAIT_L(0); PG8_MMA(1, 0, At, B0); PG8_BAR; PG8_SCHED;
            PG8_STAGE(PG8_SB(0, 1), b2, voffB1);
            PG8_WAIT_V(6); PG8_BAR; PG8_MMA(1, 1, At, B1); PG8_BAR;
            PG8_LDB(B0, 1, 0); PG8_SCHED; PG8_LDA(At, 1, 0); PG8_STAGE(PG8_SA(0, 1), a2 + hstep, voffA);
            PG8_WAIT_L(8); PG8_BAR; PG8_WAIT_L(0); PG8_MMA(0, 0, At, B0); PG8_BAR; PG8_SCHED;
            PG8_LDB(B1, 1, 1); PG8_STAGE(PG8_SB(1, 0), b3, voffB);
            PG8_BAR; PG8_WAIT_L(0); PG8_MMA(0, 1, At, B1); PG8_BAR;
            PG8_LDA(At, 1, 1); PG8_STAGE(PG8_SA(1, 0), a3, voffA);
            PG8_BAR; PG8_WAIT_L(0); PG8_MMA(1, 0, At, B0); PG8_BAR; PG8_SCHED;
            PG8_STAGE(PG8_SB(1, 1), b3, voffB1);
            PG8_WAIT_V(6); PG8_BAR; PG8_MMA(1, 1, At, B1); PG8_BAR;
            }
        }
        if constexpr (ALIGN_EPI) { if (wr == 0) PG8_BAR; }
        if constexpr (!Epi::AFTER_DRAIN) { E(acc, cur, wr, wc, fr, fq, xlds); S.done(cur); }
        if (!has_next) break;
#pragma unroll
        for (int a = 0; a < 2; ++a)
#pragma unroll
            for (int b = 0; b < 2; ++b)
#pragma unroll
                for (int m = 0; m < 4; ++m)
#pragma unroll
                    for (int n = 0; n < 2; ++n) acc[a][b][m][n] = (f32x4){0.f, 0.f, 0.f, 0.f};
        cur = nxt; cA = nA; cB = nB; ++ui;
        if constexpr (ALIGN_EPI) { if (wr == 1) PG8_BAR; }
    }
    PG8_WAIT_V(0);
    if constexpr (!ALIGN_EPI) { if (wr == 0) PG8_BAR; }
    PG8_BAR;

#undef PG8_SA
#undef PG8_SB
#undef PG8_STAGE
#undef PG8_LDA
#undef PG8_LDB
#undef PG8_MMA
#undef PG8_WAIT_V
#undef PG8_WAIT_L
#undef PG8_BAR
#undef PG8_SCHED
}
}

#define GAS __attribute__((address_space(1)))
#define LAS __attribute__((address_space(3)))
typedef unsigned short bf16;
typedef float f32x4 __attribute__((ext_vector_type(4)));
typedef short bf16x8 __attribute__((ext_vector_type(8)));
typedef unsigned u32x4 __attribute__((ext_vector_type(4)));
typedef unsigned u32x2 __attribute__((ext_vector_type(2)));

constexpr int NWAVES = 8;
constexpr int SEQ = 16384, DMODEL = 2048, NMEM = 256, DIN = 3584, DCONV = 768, DPOOL = 768, DXATT = 512, DFF = 5632, DFF2 = 11264;
constexpr int PGD = 192;
constexpr float EPS = 1e-6f;
constexpr int LDS_BYTES = 147456;
#ifndef MK_PER_PHASE
#define MK_PER_PHASE 0
#endif
constexpr int NPHASE = 7;
#ifndef PHM
#define PHM 255
#endif
#ifndef FUSE_FIXUP
#define FUSE_FIXUP 0
#endif
#ifndef P1_WGM
#define P1_WGM 4
#endif
#ifndef P4_WGM
#define P4_WGM 4
#endif
#ifndef P1_ALIGN
#define P1_ALIGN false
#endif
#ifndef USE_CG_SYNC
#define USE_CG_SYNC 0
#endif
#ifndef PROBE_P2
#define PROBE_P2 0
#endif
#ifndef PROBE_SYNC
#define PROBE_SYNC 0
#endif
#ifndef PROBE_GEMM
#define PROBE_GEMM 0
#endif
#ifndef PROBE_N
#define PROBE_N 2048
#endif
#ifndef REPM
#define REPM 0
#endif

constexpr size_t MiB = 1u << 20;
constexpr size_t WS_KB = 1 * MiB;
constexpr size_t WS_VT = 1 * MiB + 256 * 1024;
constexpr size_t WS_POOLWT = 1 * MiB + 512 * 1024;
constexpr size_t WS_MB = 2 * MiB;
constexpr size_t WS_WKVT = 3 * MiB;
constexpr size_t WS_SIGX = 7 * MiB + 128 * 1024;
constexpr size_t WS_GINV = 7 * MiB + 256 * 1024;
constexpr size_t WS_SIG = 7 * MiB;
constexpr size_t WS_SLAB1 = 8 * MiB;
constexpr size_t WS_SLAB2 = 10 * MiB;
constexpr size_t WS_WUPT = 12 * MiB;
constexpr size_t WS_WDOWNT = 56 * MiB;
constexpr size_t WS_UBND = 80 * MiB;
constexpr size_t WS_X1B = 96 * MiB;
constexpr size_t WS_ACT = 160 * MiB;
constexpr size_t WS_H = 160 * MiB;
constexpr size_t WS_Z = 225 * MiB;
constexpr size_t WS_ZPAD = WS_Z - (size_t)16 * 3584 * 2;
constexpr size_t WS_MIX = 338 * MiB;
constexpr size_t WS_WINT = 402 * MiB;
constexpr size_t WS_WOUTT = 416 * MiB;
constexpr size_t WS_END = 424 * MiB;

__device__ __forceinline__ unsigned f2bf(float f) { unsigned u = __builtin_bit_cast(unsigned, f); return (u + 0x7fffu + ((u >> 16) & 1u)) >> 16; }
__device__ __forceinline__ unsigned pk2(float lo, float hi) { return f2bf(lo) | (f2bf(hi) << 16); }
__device__ __forceinline__ float bflo(unsigned w) { return __builtin_bit_cast(float, w << 16); }
__device__ __forceinline__ float bfhi(unsigned w) { return __builtin_bit_cast(float, w & 0xffff0000u); }
__device__ __forceinline__ void unpack8(const u32x4 w, float (&f)[8]) { f[0] = bflo(w.x); f[1] = bfhi(w.x); f[2] = bflo(w.y); f[3] = bfhi(w.y); f[4] = bflo(w.z); f[5] = bfhi(w.z); f[6] = bflo(w.w); f[7] = bfhi(w.w); }
__device__ __forceinline__ u32x4 pack8(const float (&f)[8]) { u32x4 w; w.x = pk2(f[0], f[1]); w.y = pk2(f[2], f[3]); w.z = pk2(f[4], f[5]); w.w = pk2(f[6], f[7]); return w; }
__device__ __forceinline__ float wave_sum(float v) {
#pragma unroll
    for (int o = 1; o < 64; o <<= 1) v += __shfl_xor(v, o);
    return v;
}
#define LDS_WAIT() asm volatile("s_waitcnt lgkmcnt(0)" ::: "memory")

typedef GAS unsigned gu32;
constexpr size_t WS_CTL = 0, CTL_ZERO_BYTES = 64 * 1024;
constexpr int CW_PANEL2 = 12288;
constexpr int CW_PANEL1 = 8192;
constexpr int CW_PANEL = 4096;
constexpr int MISC_OFF = 131072 + 320;
constexpr int XLDS_OFF = 131072 + 1024;
#define XB_TMO      128
#define XB_XCNT(j)  (256  + 64 * (j))
#define XB_XSUB(j)  (1280 + 64 * (j))
#define XB_XGEN(j)  (2304 + 64 * (j))
#define XB_TOP      3328
#define XB_TOPGEN   3392
#define XCD_BAR_WORDS 3456
#define XB_SPIN_CAP (1u << 18)

__device__ __forceinline__ unsigned xb_ld(unsigned* p)              { return __hip_atomic_load(p, __ATOMIC_RELAXED, __HIP_MEMORY_SCOPE_AGENT); }
__device__ __forceinline__ unsigned xb_add(unsigned* p, unsigned v) { return __hip_atomic_fetch_add(p, v, __ATOMIC_RELAXED, __HIP_MEMORY_SCOPE_AGENT); }
__device__ __forceinline__ unsigned xb_xcc_id() { return (unsigned)__builtin_amdgcn_s_getreg((3 << 11) | 20) & 0xFu; }
#define XB_SPIN(cond, bar) do { unsigned _sp = 0; while (cond) { __builtin_amdgcn_s_sleep(1); \
    if ((++_sp & 255u) == 0u) { if (xb_ld(&(bar)[XB_TMO])) break; if (_sp > XB_SPIN_CAP) { atomicAdd(&(bar)[XB_TMO], 1u); break; } } } } while (0)

struct XcdBarrier {
    unsigned* bar; unsigned x;
    volatile LAS unsigned* st;
};

__device__ __forceinline__ XcdBarrier xcd_barrier_post(unsigned* bar, volatile LAS unsigned* st) {
    XcdBarrier b; b.bar = bar; b.x = xb_xcc_id(); b.st = st;
    if (threadIdx.x == 0) (void)xb_add(&bar[XB_XCNT(b.x)], 1u);
    return b;
}
__device__ __forceinline__ void xcd_barrier_complete(unsigned* bar, unsigned x, unsigned& nloc, unsigned& nx) {
    const unsigned G = gridDim.x * gridDim.y * gridDim.z;
    unsigned sum, cnt, mine, sp = 0u;
    for (;;) {
        sum = 0u; cnt = 0u; mine = 0u;
#pragma unroll
        for (unsigned j = 0; j < 16; ++j) { const unsigned c = xb_ld(&bar[XB_XCNT(j)]); sum += c; cnt += (c > 0u) ? 1u : 0u; mine = (j == x) ? c : mine; }
        if (sum == G) break;
        __builtin_amdgcn_s_sleep(1);
        if ((++sp & 255u) == 0u) { if (xb_ld(&bar[XB_TMO])) break; if (sp > XB_SPIN_CAP) { atomicAdd(&bar[XB_TMO], 1u); break; } }
    }
    nloc = mine > 0u ? mine : 1u; nx = cnt > 0u ? cnt : 1u;
}

__device__ __forceinline__ void xcd_barrier(const XcdBarrier& b) {
    asm volatile("s_waitcnt vmcnt(0)" ::: "memory");
    __syncthreads();
    if (threadIdx.x == 0) {
        unsigned* bar = b.bar;
        __builtin_amdgcn_s_waitcnt(0);
        unsigned nloc = b.st[0], nx = b.st[1];
        if (nloc == 0u) { xcd_barrier_complete(bar, b.x, nloc, nx); b.st[0] = nloc; b.st[1] = nx; }
        const unsigned old = xb_add(&bar[XB_XSUB(b.x)], 1u);
        const unsigned gen = old / nloc;
        if (old + 1u == (gen + 1u) * nloc) {
            __builtin_amdgcn_fence(__ATOMIC_RELEASE, "agent");
            asm volatile("s_waitcnt vmcnt(0)" ::: "memory");
            const unsigned og = xb_add(&bar[XB_TOP], 1u);
            const unsigned tg = og / nx;
            if (og + 1u == (tg + 1u) * nx) xb_add(&bar[XB_TOPGEN], 1u);
            else XB_SPIN(xb_ld(&bar[XB_TOPGEN]) == tg, bar);
            __builtin_amdgcn_fence(__ATOMIC_ACQUIRE, "agent");
            xb_add(&bar[XB_XGEN(b.x)], 1u);
            asm volatile("s_waitcnt vmcnt(0)" ::: "memory");
        } else {
            XB_SPIN(xb_ld(&bar[XB_XGEN(b.x)]) == gen, bar);
            __builtin_amdgcn_fence(__ATOMIC_ACQUIRE, "agent");
            asm volatile("s_waitcnt vmcnt(0)" ::: "memory");
        }
    }
    __syncthreads();
}


struct TrItem { const float* src; const float* ks; bf16* dst; int N, K, skip; };
template <bool UPMAP> __device__ __forceinline__ TrItem tr_make(const float* W, int K, int N, bf16* WT, const float* ks, int item) {
    const int nblk = N / 64, kb = item / nblk, nb = item % nblk, k0 = 64 * kb, n0 = 64 * nb;
    const int np = (n0 < DFF) ? n0 : n0 - DFF;
    const int r0 = !UPMAP ? n0 : 256 * (np / 128) + 64 * ((np % 128) / 32) + ((n0 < DFF) ? 0 : 32);
    TrItem t; t.src = W + (size_t)k0 * N + n0; t.ks = ks ? ks + k0 : nullptr; t.dst = WT + (size_t)r0 * K + k0; t.N = N; t.K = K; t.skip = UPMAP ? 32 : 0; return t;
}
__device__ __forceinline__ void tr_load(const TrItem& t, f32x4 (&v)[16], int lane) {
    const float* src = t.src + (size_t)(lane >> 4) * t.N + 4 * (lane & 15);
#pragma unroll
    for (int i = 0; i < 16; ++i) v[i] = *(const f32x4*)(src + (size_t)(4 * i) * t.N);
}
__device__ __forceinline__ void tr_store(const TrItem& t, const f32x4 (&v)[16], LAS float* scr, int lane) {
#pragma unroll
    for (int i = 0; i < 16; ++i) { f32x4 x = v[i]; if (t.ks) x = x * t.ks[4 * i + (lane >> 4)];
        *(LAS f32x4*)(scr + (4 * i + (lane >> 4)) * 64 + (((lane & 15) ^ ((i >> 1) & 7)) << 2)) = x; }
    LDS_WAIT(); asm volatile("" ::: "memory");
    const int c = lane & 7;
#pragma unroll
    for (int j = 0; j < 8; ++j) { const int nn = (lane >> 3) + 8 * j; const LAS float* sp = scr + (8 * c) * 64 + ((((nn >> 2) ^ c) & 15) << 2) + (nn & 3);
        u32x4 o; o.x = pk2(sp[0 * 64], sp[1 * 64]); o.y = pk2(sp[2 * 64], sp[3 * 64]); o.z = pk2(sp[4 * 64], sp[5 * 64]); o.w = pk2(sp[6 * 64], sp[7 * 64]);
        *(u32x4*)(t.dst + (size_t)(nn + (nn >= 32 ? t.skip : 0)) * t.K + 8 * c) = o; }
    LDS_WAIT(); asm volatile("" ::: "memory");
}
__device__ __forceinline__ void rms_rows2_to_bf16(const float* xa, const float* xb, const float* g, bf16* oa, bf16* ob, int lane, float* sig2 = nullptr) {
    const f32x4* pa = (const f32x4*)xa + lane; const f32x4* pb = (const f32x4*)xb + lane; const f32x4* gr = (const f32x4*)g + lane;
    f32x4 va[8], vb[8]; float sa = 0.f, sb = 0.f;
#pragma unroll
    for (int j = 0; j < 8; ++j) { va[j] = pa[64 * j]; vb[j] = pb[64 * j]; }
#pragma unroll
    for (int j = 0; j < 8; ++j) { sa += (va[j].x * va[j].x + va[j].y * va[j].y) + (va[j].z * va[j].z + va[j].w * va[j].w); sb += (vb[j].x * vb[j].x + vb[j].y * vb[j].y) + (vb[j].z * vb[j].z + vb[j].w * vb[j].w); }
    const float da = sqrtf(wave_sum(sa) * (1.0f / DMODEL) + EPS), db = sqrtf(wave_sum(sb) * (1.0f / DMODEL) + EPS), ra = 1.0f / da, rb = 1.0f / db;
    if (sig2 && lane == 0) { sig2[0] = da; sig2[1] = db; }
    u32x2* qa = (u32x2*)oa + lane; u32x2* qb = (u32x2*)ob + lane;
#pragma unroll
    for (int j = 0; j < 8; ++j) { const f32x4 gg = gr[64 * j]; u32x2 w;
        w.x = pk2(va[j].x * ra * gg.x, va[j].y * ra * gg.y); w.y = pk2(va[j].z * ra * gg.z, va[j].w * ra * gg.w); qa[64 * j] = w;
        w.x = pk2(vb[j].x * rb * gg.x, vb[j].y * rb * gg.y); w.y = pk2(vb[j].z * rb * gg.z, vb[j].w * rb * gg.w); qb[64 * j] = w; }
}

struct Ptrs {
    const float *x, *mem, *g_mix, *g_mem, *w_in, *conv_w, *pool_w, *pool_scale, *w_kv, *w_out, *g_ffn, *w_up, *ffn_conv_w, *ffn_conv_b, *w_down, *g_final;
    float* out; unsigned char* ws;
};

constexpr int UP_ITEMS = (DMODEL / 64) * (DFF2 / 64), DN_ITEMS = (DFF / 64) * (DMODEL / 64);
#ifndef DN_IN_P1
#define DN_IN_P1 2816
#endif
#ifndef UP_IN_P0
#define UP_IN_P0 4608
#endif
__device__ __forceinline__ void p1_idle_work(const Ptrs& P, LAS unsigned char* lds, int iw, int NIW, int wave, int lane);
template <int LIST> __device__ __forceinline__ TrItem tr_desc(const Ptrs& P, int it) {
    unsigned char* ws = P.ws;
    constexpr int I_IN = (DMODEL / 64) * (DIN / 64), I_OUT = (DMODEL / 64) * (DMODEL / 64), I_KV = (DMODEL / 64) * (1024 / 64), I_PW = (PGD / 64) * (PGD / 64);
    if (LIST == 0) {
        int r = it;
        if (r < I_IN) return tr_make<false>(P.w_in, DMODEL, DIN, (bf16*)(ws + WS_WINT), nullptr, r); r -= I_IN;
        if (r < I_OUT) return tr_make<false>(P.w_out, DMODEL, DMODEL, (bf16*)(ws + WS_WOUTT), nullptr, r); r -= I_OUT;
        if (r < UP_IN_P0) return tr_make<true>(P.w_up, DMODEL, DFF2, (bf16*)(ws + WS_WUPT), P.g_ffn, r); r -= UP_IN_P0;
        if (r < I_KV) return tr_make<false>(P.w_kv, DMODEL, 1024, (bf16*)(ws + WS_WKVT), nullptr, r); r -= I_KV;
        const int g = r / I_PW; r -= g * I_PW;
        return tr_make<false>(P.pool_w + (size_t)g * PGD * PGD, PGD, PGD, (bf16*)(ws + WS_POOLWT) + (size_t)g * PGD * PGD, nullptr, r);
    } else {
        if (LIST == 2) return tr_make<false>(P.w_down, DFF, DMODEL, (bf16*)(ws + WS_WDOWNT), nullptr, DN_IN_P1 + it);
        if (it < DN_IN_P1) return tr_make<false>(P.w_down, DFF, DMODEL, (bf16*)(ws + WS_WDOWNT), nullptr, it);
        return tr_make<true>(P.w_up, DMODEL, DFF2, (bf16*)(ws + WS_WUPT), P.g_ffn, UP_IN_P0 + it - DN_IN_P1);
    }
}
template <int LIST> __device__ __forceinline__ void tr_stream(const Ptrs& P, LAS float* scr, int first, int stride, int nitems, int lane) {
    if (first >= nitems) return;
    TrItem cur = tr_desc<LIST>(P, first); f32x4 va[16], vb[16];
    tr_load(cur, va, lane);
    for (int it = first; it < nitems; it += 2 * stride) {
        TrItem nx = cur; const bool h1 = it + stride < nitems; if (h1) { nx = tr_desc<LIST>(P, it + stride); tr_load(nx, vb, lane); }
        tr_store(cur, va, scr, lane);
        if (!h1) break;
        const bool h2 = it + 2 * stride < nitems; if (h2) { cur = tr_desc<LIST>(P, it + 2 * stride); tr_load(cur, va, lane); }
        tr_store(nx, vb, scr, lane);
        if (!h2) break;
    }
}
__device__ __forceinline__ void p0_prologue(const Ptrs& P, LAS unsigned char* lds, int gw, int NGW, int wave, int lane) {
    LAS float* scr = (LAS float*)(lds + wave * 16384);
    unsigned char* ws = P.ws;
    constexpr int NITEMS = (DMODEL / 64) * (DIN / 64) + (DMODEL / 64) * (DMODEL / 64) + UP_IN_P0 + (DMODEL / 64) * (1024 / 64) + 4 * (PGD / 64) * (PGD / 64);
    tr_stream<0>(P, scr, gw, NGW, NITEMS, lane);
    for (int i = gw * 64 + lane; i < DMODEL; i += NGW * 64) ((float*)(ws + WS_GINV))[i] = 1.0f / P.g_mix[i];
    for (int i = gw * 64 + lane; i < 16 * DIN * 2 / 16; i += NGW * 64) ((u32x4*)(ws + WS_ZPAD))[i] = (u32x4){0u, 0u, 0u, 0u};
    for (int m = 2 * gw; m < SEQ; m += 2 * NGW) rms_rows2_to_bf16(P.x + (size_t)m * DMODEL, P.x + (size_t)(m + 1) * DMODEL, P.g_mix, (bf16*)(ws + WS_H) + (size_t)m * DMODEL, (bf16*)(ws + WS_H) + (size_t)(m + 1) * DMODEL, lane, (float*)(ws + WS_SIGX) + m);
    for (int m = 2 * gw; m < NMEM; m += 2 * NGW) rms_rows2_to_bf16(P.mem + (size_t)m * DMODEL, P.mem + (size_t)(m + 1) * DMODEL, P.g_mem, (bf16*)(ws + WS_MB) + (size_t)m * DMODEL, (bf16*)(ws + WS_MB) + (size_t)(m + 1) * DMODEL, lane);
}

__device__ __forceinline__ void kv_tile(const Ptrs& P, int tt, int lane) {
    const bf16* mB = (const bf16*)(P.ws + WS_MB); const bf16* wT = (const bf16*)(P.ws + WS_WKVT);
    const int rb = tt >> 6, cb = tt & 63, fr = lane & 15, fq = lane >> 4;
    const bf16* ap = mB + (size_t)(16 * rb + fr) * DMODEL + 8 * fq; const bf16* wp = wT + (size_t)(16 * cb + fr) * DMODEL + 8 * fq;
    const bool kpart = cb < 32;
    f32x4 acc = {0.f, 0.f, 0.f, 0.f};
    bf16x8 a0[8], w0[8], a1[8], w1[8];
#pragma unroll
    for (int i = 0; i < 8; ++i) { a0[i] = *(const bf16x8*)(ap + 32 * i); w0[i] = *(const bf16x8*)(wp + 32 * i); }
#pragma unroll 1
    for (int kb = 0; kb < 8; kb += 2) {
#pragma unroll
        for (int i = 0; i < 8; ++i) { a1[i] = *(const bf16x8*)(ap + 32 * (8 * kb + 8 + i)); w1[i] = *(const bf16x8*)(wp + 32 * (8 * kb + 8 + i)); }
#pragma unroll
        for (int i = 0; i < 8; ++i) acc = kpart ? __builtin_amdgcn_mfma_f32_16x16x32_bf16(w0[i], a0[i], acc, 0, 0, 0) : __builtin_amdgcn_mfma_f32_16x16x32_bf16(a0[i], w0[i], acc, 0, 0, 0);
        if (kb + 2 < 8) {
#pragma unroll
            for (int i = 0; i < 8; ++i) { a0[i] = *(const bf16x8*)(ap + 32 * (8 * kb + 16 + i)); w0[i] = *(const bf16x8*)(wp + 32 * (8 * kb + 16 + i)); } }
#pragma unroll
        for (int i = 0; i < 8; ++i) acc = kpart ? __builtin_amdgcn_mfma_f32_16x16x32_bf16(w1[i], a1[i], acc, 0, 0, 0) : __builtin_amdgcn_mfma_f32_16x16x32_bf16(a1[i], w1[i], acc, 0, 0, 0);
    }
    u32x2 o; o.x = pk2(acc[0], acc[1]); o.y = pk2(acc[2], acc[3]);
    if (kpart) *(u32x2*)((bf16*)(P.ws + WS_KB) + (size_t)(16 * rb + fr) * 512 + 16 * cb + 4 * fq) = o;
    else *(u32x2*)((bf16*)(P.ws + WS_VT) + (size_t)(16 * cb - 512 + fr) * 256 + 32 * (rb >> 1) + 8 * fq + 4 * (rb & 1)) = o;
}

__device__ __forceinline__ void p1_idle_work(const Ptrs& P, LAS unsigned char* lds, int iw, int NIW, int wave, int lane) {
    LAS float* scr = (LAS float*)(lds + wave * 16384);
    for (int tt = iw; tt < 1024; tt += NIW) kv_tile(P, tt, lane);
    tr_stream<1>(P, scr, iw, NIW, DN_IN_P1 + (UP_ITEMS - UP_IN_P0), lane);
}

__device__ __forceinline__ void mix_conv_task(const Ptrs& P, int blk, int lane, int cg0, int cg1) {
    const bf16* z = (const bf16*)(P.ws + WS_Z); bf16* mix = (bf16*)(P.ws + WS_MIX);
    const int t0 = blk * 16;
    for (int cg = cg0 + lane; cg < cg1; cg += 64) {
        const int c = cg * 8;
        float w0[8], w1[8], w2[8], p1[8], p2[8];
#pragma unroll
        for (int e = 0; e < 8; ++e) { w0[e] = P.conv_w[c + e]; w1[e] = P.conv_w[DCONV + c + e]; w2[e] = P.conv_w[2 * DCONV + c + e]; }
        { float a[8], b[8]; unpack8(*(const u32x4*)(z + (long)(t0 - 2) * DIN + DCONV + c), a); unpack8(*(const u32x4*)(z + (long)(t0 - 2) * DIN + 2 * DCONV + c), b);
#pragma unroll
          for (int e = 0; e < 8; ++e) p2[e] = a[e] * b[e];
          unpack8(*(const u32x4*)(z + (long)(t0 - 1) * DIN + DCONV + c), a); unpack8(*(const u32x4*)(z + (long)(t0 - 1) * DIN + 2 * DCONV + c), b);
#pragma unroll
          for (int e = 0; e < 8; ++e) p1[e] = a[e] * b[e]; }
#pragma unroll 4
        for (int r = 0; r < 16; ++r) {
            const int t = t0 + r; float p[8], a[8], b[8], g[8], o[8];
            unpack8(*(const u32x4*)(z + (size_t)t * DIN + DCONV + c), a); unpack8(*(const u32x4*)(z + (size_t)t * DIN + 2 * DCONV + c), b); unpack8(*(const u32x4*)(z + (size_t)t * DIN + c), g);
#pragma unroll
            for (int e = 0; e < 8; ++e) { p[e] = a[e] * b[e]; o[e] = g[e] * (w2[e] * p[e] + w1[e] * p1[e] + w0[e] * p2[e]); p2[e] = p1[e]; p1[e] = p[e]; }
            *(u32x4*)(mix + (size_t)t * DMODEL + c) = pack8(o);
        }
    }
}
template <int g> __device__ __forceinline__ void mix_pool_task(const Ptrs& P, int blk, int lane) {
    constexpr int k = 2 << g;
    const char* zu = (const char*)((const bf16*)(P.ws + WS_Z) + (size_t)(blk * 16) * DIN + 3 * DCONV + PGD * g);
    const char* wu = (const char*)((const bf16*)(P.ws + WS_POOLWT) + (size_t)g * PGD * PGD);
    bf16* mix = (bf16*)(P.ws + WS_MIX);
    const int fr = lane & 15, fq = lane >> 4, t = blk * 16 + fr;
    const unsigned zl = (unsigned)(fr * DIN + 8 * fq) * 2u, wl = (unsigned)(fr * PGD + 8 * fq) * 2u;
    const int cnt = (t + 1 < k) ? t + 1 : k; const float inv = 1.0f / (float)cnt;
    f32x4 acc[12];
#pragma unroll
    for (int n = 0; n < 12; ++n) acc[n] = (f32x4){0.f, 0.f, 0.f, 0.f};
#pragma unroll 1
    for (int ks = 0; ks < 6; ++ks) {
        float sum[8], self[8];
        unpack8(*(const u32x4*)(zu + ks * 64 + zl), self);
#pragma unroll
        for (int e = 0; e < 8; ++e) sum[e] = self[e];
#pragma unroll
        for (int j = 1; j < k; ++j) { float v[8]; unpack8(*(const u32x4*)(zu + ks * 64 - (long)j * (DIN * 2) + zl), v);
#pragma unroll
            for (int e = 0; e < 8; ++e) sum[e] += v[e]; }
        float pl[8];
#pragma unroll
        for (int e = 0; e < 8; ++e) pl[e] = sum[e] * inv - self[e];
        const bf16x8 pf = __builtin_bit_cast(bf16x8, pack8(pl));
#pragma unroll
        for (int n = 0; n < 12; ++n) { const bf16x8 wf = *(const bf16x8*)(wu + n * (16 * PGD * 2) + ks * 64 + wl); acc[n] = __builtin_amdgcn_mfma_f32_16x16x32_bf16(wf, pf, acc[n], 0, 0, 0); }
    }
#pragma unroll
    for (int n = 0; n < 12; ++n) { const int d = 16 * n + 4 * fq; const f32x4 sc = *(const f32x4*)(P.pool_scale + PGD * g + d);
        u32x2 o; o.x = pk2(acc[n][0] * sc[0], acc[n][1] * sc[1]); o.y = pk2(acc[n][2] * sc[2], acc[n][3] * sc[3]);
        *(u32x2*)(mix + (size_t)t * DMODEL + DCONV + PGD * g + d) = o; }
}
__device__ __forceinline__ void mix_attn_task(const Ptrs& P, int h, int blk, int lane) {
    const bf16* z = (const bf16*)(P.ws + WS_Z); bf16* mix = (bf16*)(P.ws + WS_MIX); const bf16* Kb = (const bf16*)(P.ws + WS_KB); const bf16* Vt = (const bf16*)(P.ws + WS_VT);
    const int fr = lane & 15, fq = lane >> 4, t = blk * 16 + fr;
    bf16x8 qf[4];
#pragma unroll
    for (int ks = 0; ks < 4; ++ks) qf[ks] = *(const bf16x8*)(z + (size_t)t * DIN + 3 * DCONV + DPOOL + 128 * h + 32 * ks + 8 * fq);
    f32x4 s[16];
#pragma unroll
    for (int kb = 0; kb < 16; ++kb) { s[kb] = (f32x4){0.f, 0.f, 0.f, 0.f};
#pragma unroll
        for (int ks = 0; ks < 4; ++ks) { const bf16x8 kf = *(const bf16x8*)(Kb + (size_t)(16 * kb + fr) * 512 + 128 * h + 32 * ks + 8 * fq); s[kb] = __builtin_amdgcn_mfma_f32_16x16x32_bf16(kf, qf[ks], s[kb], 0, 0, 0); } }
    float mx = -3.0e38f;
#pragma unroll
    for (int kb = 0; kb < 16; ++kb) mx = fmaxf(fmaxf(fmaxf(s[kb][0], s[kb][1]), fmaxf(s[kb][2], s[kb][3])), mx);
    mx = fmaxf(mx, __shfl_xor(mx, 16)); mx = fmaxf(mx, __shfl_xor(mx, 32));
    const float c2 = 0.08838834764831845f * 1.4426950408889634f;
    float sum = 0.f;
#pragma unroll
    for (int kb = 0; kb < 16; ++kb)
#pragma unroll
        for (int r = 0; r < 4; ++r) { const float p = __builtin_amdgcn_exp2f((s[kb][r] - mx) * c2); s[kb][r] = p; sum += p; }
    sum += __shfl_xor(sum, 16); sum += __shfl_xor(sum, 32);
    const float inv = 1.0f / sum;
    f32x4 o[8];
#pragma unroll
    for (int db = 0; db < 8; ++db) o[db] = (f32x4){0.f, 0.f, 0.f, 0.f};
#pragma unroll
    for (int ks = 0; ks < 8; ++ks) {
        u32x4 pw; pw.x = pk2(s[2 * ks][0], s[2 * ks][1]); pw.y = pk2(s[2 * ks][2], s[2 * ks][3]); pw.z = pk2(s[2 * ks + 1][0], s[2 * ks + 1][1]); pw.w = pk2(s[2 * ks + 1][2], s[2 * ks + 1][3]);
        const bf16x8 pf = __builtin_bit_cast(bf16x8, pw);
#pragma unroll
        for (int db = 0; db < 8; ++db) { const bf16x8 vf = *(const bf16x8*)(Vt + (size_t)(128 * h + 16 * db + fr) * 256 + 32 * ks + 8 * fq); o[db] = __builtin_amdgcn_mfma_f32_16x16x32_bf16(vf, pf, o[db], 0, 0, 0); }
    }
#pragma unroll
    for (int db = 0; db < 8; ++db) { u32x2 w; w.x = pk2(o[db][0] * inv, o[db][1] * inv); w.y = pk2(o[db][2] * inv, o[db][3] * inv);
        *(u32x2*)(mix + (size_t)t * DMODEL + DCONV + DPOOL + 128 * h + 16 * db + 4 * fq) = w; }
}
template <int R, int C, int PCH> __device__ __forceinline__ void lds_stage_rows(LAS unsigned char* dst, const unsigned char* src, int gp, int tid) {
    constexpr int N = R * C, PER = (N + 511) / 512;
    u32x4 v[PER];
#pragma unroll
    for (int i = 0; i < PER; ++i) { const int idx = tid + 512 * i; if (idx < N) { const int row = idx / C, ch = idx % C; v[i] = *(const u32x4*)(src + (size_t)row * gp + ch * 16); } }
#pragma unroll
    for (int i = 0; i < PER; ++i) { const int idx = tid + 512 * i; if (idx < N) { const int row = idx / C, ch = idx % C; *(LAS u32x4*)(dst + row * (PCH * 16) + (((ch & ~15) | ((ch & 15) ^ (row & 15))) << 4)) = v[i]; } }
}
template <int N> __device__ __forceinline__ float dpp_shrN(float old, float src) { return __builtin_bit_cast(float, __builtin_amdgcn_update_dpp(__builtin_bit_cast(int, old), __builtin_bit_cast(int, src), 0x110 + N, 0xf, 0xf, false)); }
template <int N> __device__ __forceinline__ float dpp_rorN(float src) { return __builtin_bit_cast(float, __builtin_amdgcn_mov_dpp(__builtin_bit_cast(int, src), 0x120 + N, 0xf, 0xf, false)); }
template <int N> __device__ __forceinline__ float scan_step(float x, float p) { return x + dpp_shrN<N>(dpp_rorN<N>(p), x); }
template <int N> __device__ __forceinline__ float scan_step_prev(float p) { return p + dpp_shrN<N>(0.f, p); }

__device__ __forceinline__ void mix_attn_wave(const Ptrs& P, LAS unsigned char* ldsK, LAS unsigned char* ldsV, int h, int row0, int lane) {
    const bf16* z = (const bf16*)(P.ws + WS_Z); bf16* mix = (bf16*)(P.ws + WS_MIX);
    const int fr = lane & 15, fq = lane >> 4;
    bf16x8 q0[4], q1[4];
#pragma unroll
    for (int ks = 0; ks < 4; ++ks) { const bf16* qp = z + (size_t)(row0 + fr) * DIN + 3 * DCONV + DPOOL + 128 * h + 32 * ks + 8 * fq; q0[ks] = *(const bf16x8*)qp; q1[ks] = *(const bf16x8*)(qp + 16 * DIN); }
    unsigned offk[4];
#pragma unroll
    for (int ks = 0; ks < 4; ++ks) offk[ks] = (unsigned)(fr * 256 + (((4 * ks + fq) ^ fr) << 4));
    f32x4 s0[16], s1[16];
#pragma unroll
    for (int kb = 0; kb < 16; ++kb) { s0[kb] = (f32x4){0.f, 0.f, 0.f, 0.f}; s1[kb] = (f32x4){0.f, 0.f, 0.f, 0.f};
#pragma unroll
        for (int ks = 0; ks < 4; ++ks) { const bf16x8 kf = *(const LAS bf16x8*)(ldsK + kb * 4096 + offk[ks]);
            s0[kb] = __builtin_amdgcn_mfma_f32_16x16x32_bf16(kf, q0[ks], s0[kb], 0, 0, 0); s1[kb] = __builtin_amdgcn_mfma_f32_16x16x32_bf16(kf, q1[ks], s1[kb], 0, 0, 0); } }
    const float c2 = 0.08838834764831845f * 1.4426950408889634f;
    bf16x8 p0[8], p1[8]; float inv0, inv1;
    {   float mx = -3.0e38f;
#pragma unroll
        for (int kb = 0; kb < 16; ++kb) mx = fmaxf(fmaxf(fmaxf(s0[kb][0], s0[kb][1]), fmaxf(s0[kb][2], s0[kb][3])), mx);
        mx = fmaxf(mx, __shfl_xor(mx, 16)); mx = fmaxf(mx, __shfl_xor(mx, 32));
        float sum = 0.f;
#pragma unroll
        for (int ks = 0; ks < 8; ++ks) { float e[8];
#pragma unroll
            for (int r = 0; r < 4; ++r) { e[r] = __builtin_amdgcn_exp2f((s0[2 * ks][r] - mx) * c2); e[4 + r] = __builtin_amdgcn_exp2f((s0[2 * ks + 1][r] - mx) * c2); }
            sum += ((e[0] + e[1]) + (e[2] + e[3])) + ((e[4] + e[5]) + (e[6] + e[7]));
            p0[ks] = __builtin_bit_cast(bf16x8, pack8(e)); }
        sum += __shfl_xor(sum, 16); sum += __shfl_xor(sum, 32); inv0 = 1.0f / sum; }
    {   float mx = -3.0e38f;
#pragma unroll
        for (int kb = 0; kb < 16; ++kb) mx = fmaxf(fmaxf(fmaxf(s1[kb][0], s1[kb][1]), fmaxf(s1[kb][2], s1[kb][3])), mx);
        mx = fmaxf(mx, __shfl_xor(mx, 16)); mx = fmaxf(mx, __shfl_xor(mx, 32));
        float sum = 0.f;
#pragma unroll
        for (int ks = 0; ks < 8; ++ks) { float e[8];
#pragma unroll
            for (int r = 0; r < 4; ++r) { e[r] = __builtin_amdgcn_exp2f((s1[2 * ks][r] - mx) * c2); e[4 + r] = __builtin_amdgcn_exp2f((s1[2 * ks + 1][r] - mx) * c2); }
            sum += ((e[0] + e[1]) + (e[2] + e[3])) + ((e[4] + e[5]) + (e[6] + e[7]));
            p1[ks] = __builtin_bit_cast(bf16x8, pack8(e)); }
        sum += __shfl_xor(sum, 16); sum += __shfl_xor(sum, 32); inv1 = 1.0f / sum; }
    f32x4 o0[8], o1[8];
#pragma unroll
    for (int db = 0; db < 8; ++db) { o0[db] = (f32x4){0.f, 0.f, 0.f, 0.f}; o1[db] = (f32x4){0.f, 0.f, 0.f, 0.f}; }
#pragma unroll
    for (int ks = 0; ks < 8; ++ks) {
        const unsigned offv = (unsigned)(fr * 512 + ((ks >> 2) << 8) + (((4 * (ks & 3) + fq) ^ fr) << 4));
#pragma unroll
        for (int db = 0; db < 8; ++db) { const bf16x8 vf = *(const LAS bf16x8*)(ldsV + db * 8192 + offv);
            o0[db] = __builtin_amdgcn_mfma_f32_16x16x32_bf16(vf, p0[ks], o0[db], 0, 0, 0); o1[db] = __builtin_amdgcn_mfma_f32_16x16x32_bf16(vf, p1[ks], o1[db], 0, 0, 0); } }
    bf16* op = mix + (size_t)(row0 + fr) * DMODEL + DCONV + DPOOL + 128 * h + 4 * fq;
#pragma unroll
    for (int db = 0; db < 8; ++db) { u32x2 w; w.x = pk2(o0[db][0] * inv0, o0[db][1] * inv0); w.y = pk2(o0[db][2] * inv0, o0[db][3] * inv0); *(u32x2*)(op + 16 * db) = w;
        w.x = pk2(o1[db][0] * inv1, o1[db][1] * inv1); w.y = pk2(o1[db][2] * inv1, o1[db][3] * inv1); *(u32x2*)(op + (size_t)16 * DMODEL + 16 * db) = w; }
}

template <int g> __device__ __forceinline__ void mix_pool_wave(const Ptrs& P, LAS unsigned char* ldsW, int row0, int lane) {
    constexpr int k = 2 << g;
    const bf16* z = (const bf16*)(P.ws + WS_Z); bf16* mix = (bf16*)(P.ws + WS_MIX);
    const int fr = lane & 15, fq = lane >> 4;
    f32x4 acc0[12], acc1[12];
#pragma unroll
    for (int n = 0; n < 12; ++n) { acc0[n] = (f32x4){0.f, 0.f, 0.f, 0.f}; acc1[n] = (f32x4){0.f, 0.f, 0.f, 0.f}; }
    const float invA = 1.0f / (float)((row0 + fr + 1 < k) ? row0 + fr + 1 : k), invB = 1.0f / (float)((row0 + 16 + fr + 1 < k) ? row0 + 16 + fr + 1 : k);
#pragma unroll 1
    for (int ks = 0; ks < 6; ++ks) {
        const bf16* zp = z + (long)(row0 - 16 + fr) * DIN + 3 * DCONV + PGD * g + 32 * ks + 8 * fq;
        float pv[8], xa[8], xb[8], sa[8], sb[8];
        unpack8(*(const u32x4*)zp, pv); unpack8(*(const u32x4*)(zp + 16 * DIN), xa); unpack8(*(const u32x4*)(zp + 32 * DIN), xb);
#pragma unroll
        for (int e = 0; e < 8; ++e) {
            float p = pv[e], a = xa[e], b = xb[e];
            float b1 = scan_step<1>(b, a), a1 = scan_step<1>(a, p), p1 = scan_step_prev<1>(p);
            if (k >= 4) { const float b2 = scan_step<2>(b1, a1), a2 = scan_step<2>(a1, p1), p2 = scan_step_prev<2>(p1); b1 = b2; a1 = a2; p1 = p2; }
            if (k >= 8) { const float b2 = scan_step<4>(b1, a1), a2 = scan_step<4>(a1, p1), p2 = scan_step_prev<4>(p1); b1 = b2; a1 = a2; p1 = p2; }
            if (k >= 16) { const float b2 = scan_step<8>(b1, a1), a2 = scan_step<8>(a1, p1); b1 = b2; a1 = a2; }
            sa[e] = a1 * invA - a; sb[e] = b1 * invB - b; }
        const bf16x8 fa = __builtin_bit_cast(bf16x8, pack8(sa)), fb = __builtin_bit_cast(bf16x8, pack8(sb));
        const unsigned offw = (unsigned)(fr * 512 + ((ks >> 2) << 8) + (((4 * (ks & 3) + fq) ^ fr) << 4));
#pragma unroll
        for (int n = 0; n < 12; ++n) { const bf16x8 wf = *(const LAS bf16x8*)(ldsW + n * 8192 + offw);
            acc0[n] = __builtin_amdgcn_mfma_f32_16x16x32_bf16(wf, fa, acc0[n], 0, 0, 0); acc1[n] = __builtin_amdgcn_mfma_f32_16x16x32_bf16(wf, fb, acc1[n], 0, 0, 0); }
    }
    bf16* op = mix + (size_t)(row0 + fr) * DMODEL + DCONV + PGD * g + 4 * fq;
#pragma unroll
    for (int n = 0; n < 12; ++n) { const f32x4 sc = *(const f32x4*)(P.pool_scale + PGD * g + 16 * n + 4 * fq);
        u32x2 o; o.x = pk2(acc0[n][0] * sc[0], acc0[n][1] * sc[1]); o.y = pk2(acc0[n][2] * sc[2], acc0[n][3] * sc[3]); *(u32x2*)(op + 16 * n) = o;
        o.x = pk2(acc1[n][0] * sc[0], acc1[n][1] * sc[1]); o.y = pk2(acc1[n][2] * sc[2], acc1[n][3] * sc[3]); *(u32x2*)(op + (size_t)16 * DMODEL + 16 * n) = o; }
}

__device__ __forceinline__ void p2_mixer(const Ptrs& P, LAS unsigned char* lds, int w, int tid, int wave, int lane, int tmask) {
    const int sub = w & 3, tile = w >> 2, row0 = tile * 256 + (wave & 3) * 64;
    lds_stage_rows<256, 16, 16>(lds, (const unsigned char*)(P.ws + WS_KB) + 256 * sub, 1024, tid);
    lds_stage_rows<128, 32, 32>(lds + 65536, (const unsigned char*)(P.ws + WS_VT) + (size_t)sub * 128 * 512, 512, tid);
    LDS_WAIT(); __syncthreads();
    if (wave < 4) { if (tmask & 0x1e0) {
#pragma unroll 1
        for (int p = 0; p < 2; ++p) { asm volatile("" ::: "memory"); mix_attn_wave(P, lds, lds + 65536, sub, row0 + 32 * p, lane); } } }
    else if (tmask & 1) mix_conv_task(P, 4 * w + (wave - 4), lane, 0, 48);
    __syncthreads();
    lds_stage_rows<192, 24, 32>(lds, (const unsigned char*)(P.ws + WS_POOLWT) + (size_t)sub * PGD * PGD * 2, PGD * 2, tid);
    LDS_WAIT(); __syncthreads();
    if (wave < 4) { if (tmask & 0x1e) {
#pragma unroll 1
        for (int p = 0; p < 2; ++p) { const int r = row0 + 32 * p; asm volatile("" ::: "memory");
            if (sub == 0) mix_pool_wave<0>(P, lds, r, lane); else if (sub == 1) mix_pool_wave<1>(P, lds, r, lane); else if (sub == 2) mix_pool_wave<2>(P, lds, r, lane); else mix_pool_wave<3>(P, lds, r, lane); } } }
    else if (tmask & 1) mix_conv_task(P, 4 * w + (wave - 4), lane, 48, 96);
    __syncthreads();
}

__device__ __forceinline__ void p5_fix_item(const Ptrs& P, int pm, int c) {
    const float* ub = (const float*)(P.ws + WS_UBND); bf16* act = (bf16*)(P.ws + WS_ACT); const float* cw = P.ffn_conv_w; const float* cb = P.ffn_conv_b;
    const int gi = 256 * (c / 128) + 64 * ((c % 128) / 32) + (c % 32);
    const float* p2 = ub + (size_t)((pm - 1) * 4 + 2) * DFF2 + gi; const float* p1 = p2 + DFF2; const float* r0 = ub + (size_t)(pm * 4) * DFF2 + gi; const float* r1 = r0 + DFF2;
    float o0[8], o1[8];
#pragma unroll
    for (int e = 0; e < 8; ++e) {
        const float gw0 = cw[c + e], gw1 = cw[DFF2 + c + e], gw2 = cw[2 * DFF2 + c + e], gb = cb[c + e], vw0 = cw[DFF + c + e], vw1 = cw[DFF2 + DFF + c + e], vw2 = cw[2 * DFF2 + DFF + c + e], vb = cb[DFF + c + e];
        const float G0 = gw2 * r0[e] + (gw1 * p1[e] + (gw0 * p2[e] + gb)), V0 = vw2 * r0[32 + e] + (vw1 * p1[32 + e] + (vw0 * p2[32 + e] + vb));
        const float G1 = gw2 * r1[e] + (gw1 * r0[e] + (gw0 * p1[e] + gb)), V1 = vw2 * r1[32 + e] + (vw1 * r0[32 + e] + (vw0 * p1[32 + e] + vb));
        o0[e] = G0 * __builtin_amdgcn_rcpf(1.0f + __builtin_amdgcn_exp2f(-1.4426950408889634f * G0)) * V0;
        o1[e] = G1 * __builtin_amdgcn_rcpf(1.0f + __builtin_amdgcn_exp2f(-1.4426950408889634f * G1)) * V1; }
    *(u32x4*)(act + (size_t)(256 * pm) * DFF + c) = pack8(o0); *(u32x4*)(act + (size_t)(256 * pm + 1) * DFF + c) = pack8(o1);
}
__device__ __forceinline__ void p6_fixup_panels(const Ptrs& P, int vcu, int G, int tid, unsigned* cnt, unsigned* tmo) {
    constexpr int GRP = DFF / 8 / 8;
    const int nround = (512 + G - 1) / G;
    for (int i = 0; i < nround; ++i) { const int L = i * G + vcu; if (L >= 512) break; const int pm = L >> 3, pn = L & 7;
        if (pm > 0 && tid < GRP) p5_fix_item(P, pm, (pn * GRP + tid) * 8); }
    asm volatile("s_waitcnt vmcnt(0)" ::: "memory"); __syncthreads();
    if (tid == 0) {
        __builtin_amdgcn_fence(__ATOMIC_RELEASE, "agent"); asm volatile("s_waitcnt vmcnt(0)" ::: "memory");
        for (int i = 0; i < nround; ++i) { const int L = i * G + vcu; if (L >= 512) break; __hip_atomic_fetch_add(cnt + 64 * (L >> 3), 1u, __ATOMIC_RELAXED, __HIP_MEMORY_SCOPE_AGENT); }
        for (int i = 0; i < nround; ++i) { const int L = i * G + vcu; if (L >= 512) break; unsigned spins = 0;
            while (__hip_atomic_load(cnt + 64 * (L >> 3), __ATOMIC_RELAXED, __HIP_MEMORY_SCOPE_AGENT) < 8u) { __builtin_amdgcn_s_sleep(2); if (++spins > (1u << 20)) { __hip_atomic_store(tmo, 1u, __ATOMIC_RELAXED, __HIP_MEMORY_SCOPE_AGENT); break; } } }
        __builtin_amdgcn_fence(__ATOMIC_ACQUIRE, "agent"); asm volatile("s_waitcnt vmcnt(0)" ::: "memory");
    }
    __syncthreads();
}
__device__ __forceinline__ void p5_fixup(const Ptrs& P, int gt, int NGT) {
    for (int i = gt; i < 63 * (DFF / 8); i += NGT) p5_fix_item(P, 1 + i / (DFF / 8), (i % (DFF / 8)) * 8);
}

__device__ __forceinline__ void p7_final(const Ptrs& P, int gw, int NGW, int lane) {
    const float* slab = (const float*)(P.ws + WS_SLAB2);
    for (int m = gw; m < SEQ; m += NGW) {
        const float part = (lane < 32) ? slab[(size_t)m * 32 + lane] : 0.f;
        const float rstd = 1.0f / sqrtf(wave_sum(part) * (1.0f / DMODEL) + EPS);
        f32x4* xr = (f32x4*)(P.out + (size_t)m * DMODEL) + lane; const f32x4* gr = (const f32x4*)P.g_final + lane;
#pragma unroll
        for (int j = 0; j < 8; ++j) { f32x4 v = xr[64 * j]; const f32x4 gg = gr[64 * j]; v = v * rstd * gg; xr[64 * j] = v; }
    }
}

struct Args { const float* in[16]; float* out; unsigned char* ws; int ph_lo, ph_hi; };
__global__ void __launch_bounds__(NWAVES * 64, 2) hybrid_fwd(Args args) {
    extern __shared__ __attribute__((aligned(16))) unsigned char lds_raw[];
    LAS unsigned char* lds = (LAS unsigned char*)lds_raw;
    cg::grid_group grid = cg::this_grid();
    const int tid = threadIdx.x, lane = tid & 63, wave = __builtin_amdgcn_readfirstlane(tid >> 6);
    const int G = gridDim.x, bx = blockIdx.x, vcu = (G % 8 == 0) ? (bx % 8) * (G / 8) + bx / 8 : bx;
    const int gw = vcu * NWAVES + wave, NGW = G * NWAVES;
    volatile LAS unsigned* MISC = (volatile LAS unsigned*)(lds + MISC_OFF);
    if (tid < 32) MISC[tid] = 0u;
    __syncthreads();
    const XcdBarrier bar = xcd_barrier_post((unsigned*)(args.ws + WS_CTL), MISC + 8);
    Ptrs P;
    P.x = args.in[0]; P.mem = args.in[1]; P.g_mix = args.in[2]; P.g_mem = args.in[3]; P.w_in = args.in[4]; P.conv_w = args.in[5]; P.pool_w = args.in[6]; P.pool_scale = args.in[7];
    P.w_kv = args.in[8]; P.w_out = args.in[9]; P.g_ffn = args.in[10]; P.w_up = args.in[11]; P.ffn_conv_w = args.in[12]; P.ffn_conv_b = args.in[13]; P.w_down = args.in[14]; P.g_final = args.in[15];
    P.out = args.out; P.ws = args.ws;
    unsigned char* ws = args.ws;
#if PROBE_SYNC
    for (int i = 0; i < 20; ++i) xcd_barrier(bar);
#endif
    const int lo = args.ph_lo, hi = args.ph_hi;
#define IN(k) (lo <= (k) && (k) < hi)
#define SYNC(k) do { if ((k) + 1 < hi) { if ((k) == 0 && USE_CG_SYNC) grid.sync(); else xcd_barrier(bar); } } while (0)
#define SYNCR(k, b) do { if ((k) + 1 < hi || rp + 1 < NREP(b)) { if ((k) == 0 && USE_CG_SYNC) grid.sync(); else xcd_barrier(bar); } } while (0)
#define NREP(b) ((REPM & (b)) ? 2 : 1)
    if (IN(0) && (PHM & 1)) for (int rp = 0; rp < NREP(1); ++rp) { p0_prologue(P, lds, gw, NGW, wave, lane); SYNCR(0, 1); }
    if (IN(1) && (PHM & 2)) for (int rp = 0; rp < NREP(2); ++rp) {
        pg8::Gemm g{(const bf16*)(ws + WS_H), (const bf16*)(ws + WS_WINT), SEQ, DIN, DMODEL}; pg8::StaticOrder S; S.init(SEQ, DIN, G, bx, P1_WGM);
        pg8::EpiZ E{(bf16*)(ws + WS_Z), DIN};
        pg8::gemm_phase<pg8::EpiZ, pg8::StaticOrder, P1_ALIGN, true>(lds, g, S, E, lds + XLDS_OFF);
        { const int nfull = ((SEQ / 256) * (DIN / 256)) % G;
          if (nfull == 0) p1_idle_work(P, lds, bx * NWAVES + wave, G * NWAVES, wave, lane);
          else if (bx >= nfull) p1_idle_work(P, lds, (bx - nfull) * NWAVES + wave, (G - nfull) * NWAVES, wave, lane); }
        SYNCR(1, 2);
    }
    if (IN(2) && (PHM & 4)) for (int rp = 0; rp < NREP(4); ++rp) { p2_mixer(P, lds, vcu, tid, wave, lane, 511);
#if PROBE_P2
        p2_mixer(P, lds, vcu, tid, wave, lane, PROBE_P2);
#endif
        SYNCR(2, 4); }
    if (IN(3) && (PHM & 8)) {
        pg8::Gemm g{(const bf16*)(ws + WS_MIX), (const bf16*)(ws + WS_WOUTT), SEQ, DMODEL, DMODEL}; pg8::PanelOrder S{G, vcu, (SEQ / 256) * (DMODEL / 256)};
        pg8::EpiNorm<0> E{nullptr, (const bf16*)(ws + WS_H), (const float*)(ws + WS_SIGX), (float*)(ws + WS_SIG), (bf16*)(ws + WS_X1B), nullptr, (const float*)(ws + WS_GINV), (unsigned*)(ws + WS_SLAB1), (unsigned*)(ws + WS_CTL) + CW_PANEL1, (unsigned*)(ws + WS_CTL) + XB_TMO};
        pg8::gemm_phase<pg8::EpiNorm<0>, pg8::PanelOrder, true, true>(lds, g, S, E, lds + XLDS_OFF);
        SYNC(3);
    }
#if PROBE_GEMM
    if (IN(3)) {
        pg8::Gemm g{(const bf16*)(ws + WS_X1B), (const bf16*)(ws + WS_WUPT), SEQ, PROBE_N, DMODEL}; pg8::StaticOrder S; S.init(SEQ, PROBE_N, G, bx);
#if PROBE_GEMM == 1
        pg8::EpiZ E{(bf16*)(ws + WS_Z), PROBE_N};
        pg8::gemm_phase<pg8::EpiZ, pg8::StaticOrder, true, true>(lds, g, S, E, lds + XLDS_OFF);
#elif PROBE_GEMM == 2
        pg8::EpiNone E{};
        pg8::gemm_phase<pg8::EpiNone, pg8::StaticOrder, true, true>(lds, g, S, E, lds + XLDS_OFF);
#elif PROBE_GEMM == 3
        pg8::EpiZ E{(bf16*)(ws + WS_Z), PROBE_N};
        pg8::gemm_phase<pg8::EpiZ, pg8::StaticOrder, true, false>(lds, g, S, E, lds + XLDS_OFF);
#elif PROBE_GEMM == 5
        pg8::EpiAct E{(bf16*)(ws + WS_ACT), P.ffn_conv_w, P.ffn_conv_b, (float*)(ws + WS_UBND)};
        pg8::gemm_phase<pg8::EpiAct, pg8::StaticOrder, true, true>(lds, g, S, E, lds + XLDS_OFF);
#elif PROBE_GEMM == 4
        pg8::EpiZ E{(bf16*)(ws + WS_Z), PROBE_N};
        pg8::gemm_phase<pg8::EpiZ, pg8::StaticOrder, false, true>(lds, g, S, E, lds + XLDS_OFF);
#endif
        xcd_barrier(bar);
    }
#endif
    if (IN(4) && (PHM & 16)) for (int rp = 0; rp < NREP(16); ++rp) {
        pg8::Gemm g{(const bf16*)(ws + WS_X1B), (const bf16*)(ws + WS_WUPT), SEQ, DFF2, DMODEL}; pg8::StaticOrder S; S.init(SEQ, DFF2, G, bx, P4_WGM);
        pg8::EpiAct E{(bf16*)(ws + WS_ACT), P.ffn_conv_w, P.ffn_conv_b, (float*)(ws + WS_UBND)};
        pg8::gemm_phase<pg8::EpiAct, pg8::StaticOrder, true, true>(lds, g, S, E, lds + XLDS_OFF);
        SYNCR(4, 16);
    }
#if !FUSE_FIXUP
    if (IN(5) && (PHM & 32)) { p5_fixup(P, vcu * (NWAVES * 64) + tid, G * NWAVES * 64); tr_stream<2>(P, (LAS float*)(lds + wave * 16384), gw, NGW, DN_ITEMS - DN_IN_P1, lane); SYNC(5); }
#endif
    if (IN(6) && (PHM & 64)) {
#if FUSE_FIXUP
        p6_fixup_panels(P, vcu, G, tid, (unsigned*)(ws + WS_CTL) + CW_PANEL2, (unsigned*)(ws + WS_CTL) + XB_TMO);
#endif
        pg8::Gemm g{(const bf16*)(ws + WS_ACT), (const bf16*)(ws + WS_WDOWNT), SEQ, DMODEL, DFF}; pg8::PanelOrder S{G, vcu, (SEQ / 256) * (DMODEL / 256)};
        pg8::EpiNorm<1> E{nullptr, (const bf16*)(ws + WS_X1B), (const float*)(ws + WS_SIG), nullptr, nullptr, P.out, P.g_final, (unsigned*)(ws + WS_SLAB2), (unsigned*)(ws + WS_CTL) + CW_PANEL, (unsigned*)(ws + WS_CTL) + XB_TMO};
        pg8::gemm_phase<pg8::EpiNorm<1>, pg8::PanelOrder, true, true>(lds, g, S, E, lds + XLDS_OFF);
    }
#undef IN
#undef SYNC
}

extern "C" void kernel_launch(void* const* d_in, const int* in_sizes, int n_in, void* d_out, int out_size, void* d_ws, size_t ws_size, hipStream_t stream) {
    static int grid = 0;
    if (grid == 0) {
        if (n_in != 16 || in_sizes[0] != SEQ * DMODEL || out_size != SEQ * DMODEL || ws_size < WS_END) { fprintf(stderr, "kernel_launch: unexpected shapes (n_in %d, in0 %d, out %d, ws %zu)\n", n_in, n_in > 0 ? in_sizes[0] : -1, out_size, ws_size); grid = -1; return; }
        int dev = 0, cus = 0, per_cu = 0;
        if (hipGetDevice(&dev) != hipSuccess || hipDeviceGetAttribute(&cus, hipDeviceAttributeMultiprocessorCount, dev) != hipSuccess) { grid = -1; return; }
        if (hipFuncSetAttribute((const void*)hybrid_fwd, hipFuncAttributeMaxDynamicSharedMemorySize, LDS_BYTES) != hipSuccess) { fprintf(stderr, "kernel_launch: hipFuncSetAttribute failed\n"); grid = -1; return; }
        if (hipOccupancyMaxActiveBlocksPerMultiprocessor(&per_cu, (const void*)hybrid_fwd, NWAVES * 64, LDS_BYTES) != hipSuccess || per_cu < 1) { fprintf(stderr, "kernel_launch: occupancy query says %d blocks per CU\n", per_cu); (void)hipGetLastError(); per_cu = 1; }
        grid = cus;
        if (grid != 256) { fprintf(stderr, "kernel_launch: this kernel is laid out for one workgroup on each of 256 CUs (the mixer phase and the row-statistics exchanges assume it); the device reports %d\n", grid); if (grid > 256) grid = 256; }
    }
    if (grid < 0) return;
    if (hipMemsetAsync((char*)d_ws + WS_CTL, 0, CTL_ZERO_BYTES, stream) != hipSuccess) { fprintf(stderr, "kernel_launch: hipMemsetAsync failed\n"); return; }
    Args a{};
    for (int i = 0; i < 16; ++i) a.in[i] = (const float*)d_in[i];
    a.out = (float*)d_out; a.ws = (unsigned char*)d_ws;
#if MK_PER_PHASE
    for (int ph = 0; ph < NPHASE; ++ph) { a.ph_lo = ph; a.ph_hi = ph + 1; hipLaunchKernelGGL(hybrid_fwd, dim3(grid), dim3(NWAVES * 64), LDS_BYTES, stream, a); }
#else
    a.ph_lo = 0; a.ph_hi = NPHASE;
    void* kargs[] = {&a};
    hipError_t e = hipLaunchCooperativeKernel((const void*)hybrid_fwd, dim3(grid), dim3(NWAVES * 64), kargs, LDS_BYTES, stream);
    if (e != hipSuccess) fprintf(stderr, "kernel_launch: cooperative launch failed: %s (grid %d)\n", hipGetErrorString(e), grid);
#endif
}
```

```cpp
#include <hip/hip_runtime.h>
#include <hip/hip_cooperative_groups.h>
#include <cstdio>
#include <cstdint>
namespace cg = cooperative_groups;
#ifndef TR_NT
#define TR_NT 1
#endif
#ifndef XCHG_ACQUIRE
#define XCHG_ACQUIRE 0
#endif
#ifndef PG8_PRIO
#define PG8_PRIO 0
#endif
namespace pg8 {
#define PG8_LAS __attribute__((address_space(3)))
typedef unsigned short bf16_t;
typedef short bf16x8 __attribute__((ext_vector_type(8)));
typedef float f32x4 __attribute__((ext_vector_type(4)));
typedef unsigned u32x4 __attribute__((ext_vector_type(4)));
constexpr int BM = 256, BK = 64, HALF = 128, HTB = HALF * BK * 2  , STAGE_BYTES = 8 * HTB, NXCD = 8, WGM = 8;

__host__ __device__ __forceinline__ int lds_byte(int r, int c) { const int st = (r >> 4) * 2 + (c >> 5), rr = r & 15, cc = c & 31, ob = rr * 64 + cc * 2; return st * 1024 + (ob ^ (((ob >> 9) & 1) << 5)); }
__host__ __device__ __forceinline__ void stage_rc(int b, int& R, int& C) { const int st = b / 1024, sb = b % 1024, swz = sb ^ (((sb >> 9) & 1) << 5); R = (st >> 1) * 16 + swz / 64; C = (st & 1) * 32 + (swz % 64) / 2; }
__host__ __device__ __forceinline__ int perm32(int rho) { const int n = rho >> 4, i = rho & 15; return 8 * (i >> 2) + 4 * n + (i & 3); }

struct Unit { int pm, pn; };
struct Gemm { const bf16_t* A; const bf16_t* Bt; int M, N, K; };

struct StaticOrder {
    int nM, nN, nwg, G, c, wgm;
    __host__ __device__ void init(int M, int N, int G_, int c_, int wgm_ = WGM) { nM = M / BM; nN = N / BM; nwg = nM * nN; G = G_; c = c_; wgm = wgm_; }
    __host__ __device__ bool next(int i, Unit& u) const {
        const long L = (long)i * G + c; if (L >= nwg) return false;
        int wgid = (int)L; { const int q = nwg / NXCD, r = nwg % NXCD, xcd = wgid % NXCD, off = wgid / NXCD; wgid = (xcd < r ? xcd * (q + 1) : r * (q + 1) + (xcd - r) * q) + off; }
        const int nig = wgm * nN, gid = wgid / nig, fm = gid * wgm, gsz = (nM - fm) < wgm ? (nM - fm) : wgm;
        u.pm = fm + ((wgid % nig) % gsz); u.pn = (wgid % nig) / gsz; return true;
    }
    __device__ __forceinline__ void a_ready(const Unit&) const {}
    __device__ __forceinline__ void done(const Unit&) const {}
};
__device__ __forceinline__ unsigned cvt_pk_bf16(float lo, float hi) { unsigned r; asm volatile("v_cvt_pk_bf16_f32 %0, %1, %2" : "=v"(r) : "v"(lo), "v"(hi)); return r; }
typedef unsigned u32x2 __attribute__((ext_vector_type(2)));
constexpr int DM = 2048;
constexpr float RMS_EPS = 1e-6f;

__device__ __forceinline__ void qswap_pieces(const u32x4 w0, const u32x4 w1, bool odd, u32x4& dA, u32x4& dB) {
#pragma unroll
    for (int j = 0; j < 4; ++j) { const unsigned snd = odd ? w0[j] : w1[j];
        const unsigned rcv = (unsigned)__builtin_amdgcn_mov_dpp((int)snd, 0xB1, 0xf, 0xf, false);
        dA[j] = odd ? rcv : w0[j]; dB[j] = odd ? w1[j] : rcv; }
}
struct EpiZ {
    static constexpr bool PERM = true, AFTER_DRAIN = false;
    bf16_t* O; int ldc;
    __device__ __forceinline__ void operator()(const f32x4 (&acc)[2][2][4][2], const Unit& u, int wr, int wc, int fr_, int fq_, PG8_LAS unsigned char*) const {
        int t_ = threadIdx.x; asm volatile("" : "+v"(t_));
        const int fr = t_ & 15, fq = (t_ >> 4) & 3; const bool odd = fr & 1;
        const int rowe = u.pm * BM + wr * 64 + (fr & ~1), colp = u.pn * BM + wc * 64 + 8 * fq + (odd ? 32 : 0);
#pragma unroll
        for (int ai = 0; ai < 2; ++ai)
#pragma unroll
            for (int m = 0; m < 4; ++m) { u32x4 w0, w1, dA, dB;
                { const f32x4 v0 = acc[ai][0][m][0], v1 = acc[ai][0][m][1]; w0.x = cvt_pk_bf16(v0[0], v0[1]); w0.y = cvt_pk_bf16(v0[2], v0[3]); w0.z = cvt_pk_bf16(v1[0], v1[1]); w0.w = cvt_pk_bf16(v1[2], v1[3]); }
                { const f32x4 v0 = acc[ai][1][m][0], v1 = acc[ai][1][m][1]; w1.x = cvt_pk_bf16(v0[0], v0[1]); w1.y = cvt_pk_bf16(v0[2], v0[3]); w1.z = cvt_pk_bf16(v1[0], v1[1]); w1.w = cvt_pk_bf16(v1[2], v1[3]); }
                qswap_pieces(w0, w1, odd, dA, dB);
                bf16_t* p = O + (size_t)(rowe + ai * HALF + m * 16) * ldc + colp;
                *(u32x4*)p = dA; *(u32x4*)(p + ldc) = dB; }
    }
};

struct EpiNone {
    static constexpr bool PERM = true, AFTER_DRAIN = false;
    __device__ __forceinline__ void operator()(const f32x4 (&acc)[2][2][4][2], const Unit& u, int wr, int wc, int fr, int fq, PG8_LAS unsigned char*) const {
#pragma unroll
        for (int ai = 0; ai < 2; ++ai)
#pragma unroll
            for (int bj = 0; bj < 2; ++bj)
#pragma unroll
                for (int m = 0; m < 4; ++m)
#pragma unroll
                    for (int n = 0; n < 2; ++n) asm volatile("" :: "v"(acc[ai][bj][m][n]));
    }
};
struct EpiResA {
    static constexpr bool PERM = true, AFTER_DRAIN = false;
    const float* R; bf16_t* XB; float* slab;
    __device__ __forceinline__ void operator()(const f32x4 (&acc)[2][2][4][2], const Unit& u, int wr, int wc, int fr_, int fq_, PG8_LAS unsigned char*) const {
        int t_ = threadIdx.x; asm volatile("" : "+v"(t_));
        const int fr = t_ & 15, fq = (t_ >> 4) & 3;
        const int row0 = u.pm * BM + wr * 64 + fr, col0 = u.pn * BM + wc * 32 + 8 * fq;
#pragma unroll
        for (int ai = 0; ai < 2; ++ai) {
            f32x4 r[4][2][2];
#pragma unroll
            for (int m = 0; m < 4; ++m)
#pragma unroll
                for (int bj = 0; bj < 2; ++bj) { const float* p = R + (size_t)(row0 + ai * HALF + m * 16) * DM + col0 + bj * HALF; r[m][bj][0] = *(const f32x4*)p; r[m][bj][1] = *(const f32x4*)(p + 4); }
#pragma unroll
            for (int m = 0; m < 4; ++m) { const int row = row0 + ai * HALF + m * 16; float ss = 0.f;
#pragma unroll
                for (int bj = 0; bj < 2; ++bj) { const f32x4 v0 = acc[ai][bj][m][0] + r[m][bj][0], v1 = acc[ai][bj][m][1] + r[m][bj][1];
                    u32x4 w; w.x = cvt_pk_bf16(v0[0], v0[1]); w.y = cvt_pk_bf16(v0[2], v0[3]); w.z = cvt_pk_bf16(v1[0], v1[1]); w.w = cvt_pk_bf16(v1[2], v1[3]);
                    *(u32x4*)(XB + (size_t)row * DM + col0 + bj * HALF) = w;
                    ss += (v0[0] * v0[0] + v0[1] * v0[1]) + (v0[2] * v0[2] + v0[3] * v0[3]) + (v1[0] * v1[0] + v1[1] * v1[1]) + (v1[2] * v1[2] + v1[3] * v1[3]); }
                ss += __shfl_xor(ss, 16); ss += __shfl_xor(ss, 32);
                if (fq == 0) slab[(size_t)row * 32 + u.pn * 4 + wc] = ss; }
            asm volatile("" ::: "memory"); }
    }
};
struct EpiResB {
    static constexpr bool PERM = true, AFTER_DRAIN = false;
    const bf16_t* RB; float* X; float* slab;
    __device__ __forceinline__ void operator()(const f32x4 (&acc)[2][2][4][2], const Unit& u, int wr, int wc, int fr_, int fq_, PG8_LAS unsigned char*) const {
        int t_ = threadIdx.x; asm volatile("" : "+v"(t_));
        const int fr = t_ & 15, fq = (t_ >> 4) & 3;
        const int row0 = u.pm * BM + wr * 64 + fr, col0 = u.pn * BM + wc * 32 + 8 * fq;
        u32x4 r[2][4][2];
#pragma unroll
        for (int ai = 0; ai < 2; ++ai)
#pragma unroll
            for (int m = 0; m < 4; ++m)
#pragma unroll
                for (int bj = 0; bj < 2; ++bj) r[ai][m][bj] = *(const u32x4*)(RB + (size_t)(row0 + ai * HALF + m * 16) * DM + col0 + bj * HALF);
#pragma unroll
        for (int ai = 0; ai < 2; ++ai)
#pragma unroll
            for (int m = 0; m < 4; ++m) { const int row = row0 + ai * HALF + m * 16; float ss = 0.f;
#pragma unroll
                for (int bj = 0; bj < 2; ++bj) { const u32x4 q = r[ai][m][bj];
                    const f32x4 r0 = {__builtin_bit_cast(float, q.x << 16), __builtin_bit_cast(float, q.x & 0xffff0000u), __builtin_bit_cast(float, q.y << 16), __builtin_bit_cast(float, q.y & 0xffff0000u)};
                    const f32x4 r1 = {__builtin_bit_cast(float, q.z << 16), __builtin_bit_cast(float, q.z & 0xffff0000u), __builtin_bit_cast(float, q.w << 16), __builtin_bit_cast(float, q.w & 0xffff0000u)};
                    const f32x4 v0 = acc[ai][bj][m][0] + r0, v1 = acc[ai][bj][m][1] + r1;
                    float* xp = X + (size_t)row * DM + col0 + bj * HALF; *(f32x4*)xp = v0; *(f32x4*)(xp + 4) = v1;
                    ss += (v0[0] * v0[0] + v0[1] * v0[1]) + (v0[2] * v0[2] + v0[3] * v0[3]) + (v1[0] * v1[0] + v1[1] * v1[1]) + (v1[2] * v1[2] + v1[3] * v1[3]); }
                ss += __shfl_xor(ss, 16); ss += __shfl_xor(ss, 32);
                if (fq == 0) slab[(size_t)row * 32 + u.pn * 4 + wc] = ss; }
    }
};

struct PanelOrder {
    int G, vcu, ntot;
    __device__ __forceinline__ bool next(int i, Unit& u) const { const int L = i * G + vcu; if (L >= ntot) return false; u.pm = L >> 3; u.pn = L & 7; return true; }
    __device__ __forceinline__ void a_ready(const Unit&) const {}
    __device__ __forceinline__ void done(const Unit&) const {}
};
template <int MODE  > struct EpiNorm {
    static constexpr bool PERM = (MODE == 0), AFTER_DRAIN = false;
    const float* Rf; const bf16_t* Rb; const float* sig_in; float* sig_out; bf16_t* HN; float* OUT; const float* gfin; unsigned* xbuf; unsigned* cnt; unsigned* tmo;
    __device__ __forceinline__ void operator()(f32x4 (&acc)[2][2][4][2], const Unit& u, int wr, int wc, int fr_, int fq_, PG8_LAS unsigned char* xlds) const {
        int t_ = threadIdx.x; asm volatile("" : "+v"(t_));
        const int fr = t_ & 15, fq = (t_ >> 4) & 3, wid = __builtin_amdgcn_readfirstlane(t_ >> 6);
        const int rl0 = wr * 64 + fr, row0 = u.pm * BM + rl0, col0 = u.pn * BM + wc * 64 + 8 * fq;
        PG8_LAS float* Pt = (PG8_LAS float*)xlds;
        PG8_LAS float* St = (PG8_LAS float*)(xlds + 4096);
        if constexpr (MODE == 0) {
            f32x4 gi[2][2];
#pragma unroll
            for (int bj = 0; bj < 2; ++bj) { gi[bj][0] = *(const f32x4*)(gfin + col0 + bj * 32); gi[bj][1] = *(const f32x4*)(gfin + col0 + bj * 32 + 4); }
#pragma unroll
            for (int ai = 0; ai < 2; ++ai) { u32x4 r[4][2]; float sg[4];
#pragma unroll
                for (int m = 0; m < 4; ++m) { sg[m] = sig_in[row0 + ai * HALF + m * 16];
#pragma unroll
                    for (int bj = 0; bj < 2; ++bj) r[m][bj] = __builtin_nontemporal_load((const u32x4*)(Rb + (size_t)(row0 + ai * HALF + m * 16) * DM + col0 + bj * 32)); }
#pragma unroll
                for (int m = 0; m < 4; ++m) { float ss = 0.f; const float sgm = sg[m];
#pragma unroll
                    for (int bj = 0; bj < 2; ++bj) { const u32x4 q = r[m][bj];
                        const f32x4 r0 = {__builtin_bit_cast(float, q.x << 16), __builtin_bit_cast(float, q.x & 0xffff0000u), __builtin_bit_cast(float, q.y << 16), __builtin_bit_cast(float, q.y & 0xffff0000u)};
                        const f32x4 r1 = {__builtin_bit_cast(float, q.z << 16), __builtin_bit_cast(float, q.z & 0xffff0000u), __builtin_bit_cast(float, q.w << 16), __builtin_bit_cast(float, q.w & 0xffff0000u)};
                        const f32x4 v0 = acc[ai][bj][m][0] + r0 * gi[bj][0] * sgm, v1 = acc[ai][bj][m][1] + r1 * gi[bj][1] * sgm; acc[ai][bj][m][0] = v0; acc[ai][bj][m][1] = v1;
                        ss += (v0[0] * v0[0] + v0[1] * v0[1]) + (v0[2] * v0[2] + v0[3] * v0[3]) + (v1[0] * v1[0] + v1[1] * v1[1]) + (v1[2] * v1[2] + v1[3] * v1[3]); }
                    ss += __shfl_xor(ss, 16); ss += __shfl_xor(ss, 32);
                    if (fq == 0) Pt[(ai * HALF + rl0 + m * 16) * 4 + wc] = ss; }
                asm volatile("" ::: "memory"); }
        } else { u32x2 r[2][4][2][2]; float sg[2][4]; const int colb = u.pn * BM + wc * 32 + 4 * fq;
#pragma unroll
            for (int ai = 0; ai < 2; ++ai)
#pragma unroll
                for (int m = 0; m < 4; ++m) { sg[ai][m] = sig_in[row0 + ai * HALF + m * 16];
#pragma unroll
                    for (int bj = 0; bj < 2; ++bj)
#pragma unroll
                        for (int n = 0; n < 2; ++n) r[ai][m][bj][n] = __builtin_nontemporal_load((const u32x2*)(Rb + (size_t)(row0 + ai * HALF + m * 16) * DM + colb + bj * HALF + 16 * n)); }
#pragma unroll
            for (int ai = 0; ai < 2; ++ai)
#pragma unroll
                for (int m = 0; m < 4; ++m) { float ss = 0.f; const float sgm = sg[ai][m];
#pragma unroll
                    for (int bj = 0; bj < 2; ++bj)
#pragma unroll
                        for (int n = 0; n < 2; ++n) { const u32x2 q = r[ai][m][bj][n];
                            const f32x4 r0 = {__builtin_bit_cast(float, q.x << 16), __builtin_bit_cast(float, q.x & 0xffff0000u), __builtin_bit_cast(float, q.y << 16), __builtin_bit_cast(float, q.y & 0xffff0000u)};
                            const f32x4 v0 = acc[ai][bj][m][n] + r0 * sgm; acc[ai][bj][m][n] = v0;
                            ss += (v0[0] * v0[0] + v0[1] * v0[1]) + (v0[2] * v0[2] + v0[3] * v0[3]); }
                    ss += __shfl_xor(ss, 16); ss += __shfl_xor(ss, 32);
                    if (fq == 0) Pt[(ai * HALF + rl0 + m * 16) * 4 + wc] = ss; } }
        asm volatile("s_waitcnt lgkmcnt(0)" ::: "memory"); __builtin_amdgcn_s_barrier(); asm volatile("" ::: "memory");
        if (t_ < 256) { const float s = (Pt[t_ * 4 + 0] + Pt[t_ * 4 + 1]) + (Pt[t_ * 4 + 2] + Pt[t_ * 4 + 3]);
            __hip_atomic_store(xbuf + (size_t)(u.pm * BM + t_) * 8 + u.pn, __builtin_bit_cast(unsigned, s), __ATOMIC_RELAXED, __HIP_MEMORY_SCOPE_AGENT); }
        asm volatile("s_waitcnt vmcnt(0)" ::: "memory");
        if (t_ < 256 && (t_ & 63) == 0) __hip_atomic_fetch_add(cnt + 64 * u.pm, 1u, __ATOMIC_RELAXED, __HIP_MEMORY_SCOPE_AGENT);
        if (wid == 0) {
            unsigned spins = 0;
            while ((unsigned)__builtin_amdgcn_readfirstlane(__hip_atomic_load(cnt + 64 * u.pm, __ATOMIC_RELAXED, __HIP_MEMORY_SCOPE_AGENT)) < 32u) {
                __builtin_amdgcn_s_sleep(2);
                if (++spins > (1u << 20)) { if ((t_ & 63) == 0) __hip_atomic_store(tmo, 1u, __ATOMIC_RELAXED, __HIP_MEMORY_SCOPE_AGENT); break; } }
#if XCHG_ACQUIRE
            __builtin_amdgcn_fence(__ATOMIC_ACQUIRE, "agent");
#endif
        }
        asm volatile("s_waitcnt vmcnt(0) lgkmcnt(0)" ::: "memory"); __builtin_amdgcn_s_barrier(); asm volatile("" ::: "memory");
        if (t_ < 256) { const unsigned long long* sp = (const unsigned long long*)(xbuf + (size_t)(u.pm * BM + t_) * 8); float tot = 0.f;
#pragma unroll
            for (int q = 0; q < 4; ++q) { const unsigned long long w = __hip_atomic_load(sp + q, __ATOMIC_RELAXED, __HIP_MEMORY_SCOPE_AGENT);
                tot += __builtin_bit_cast(float, (unsigned)w); tot += __builtin_bit_cast(float, (unsigned)(w >> 32)); }
            const float sd = sqrtf(tot * (1.0f / DM) + RMS_EPS);
            St[t_] = 1.0f / sd;
            if (MODE == 0 && u.pn == 0) sig_out[u.pm * BM + t_] = sd; }
        asm volatile("s_waitcnt lgkmcnt(0)" ::: "memory"); __builtin_amdgcn_s_barrier(); asm volatile("" ::: "memory");
        if constexpr (MODE == 0) {
            const bool odd = fr & 1;
#pragma unroll
            for (int ai = 0; ai < 2; ++ai)
#pragma unroll
                for (int m = 0; m < 4; ++m) { const float rstd = St[ai * HALF + rl0 + m * 16]; u32x4 w0, w1, dA, dB;
                    { const f32x4 v0 = acc[ai][0][m][0] * rstd, v1 = acc[ai][0][m][1] * rstd; w0.x = cvt_pk_bf16(v0[0], v0[1]); w0.y = cvt_pk_bf16(v0[2], v0[3]); w0.z = cvt_pk_bf16(v1[0], v1[1]); w0.w = cvt_pk_bf16(v1[2], v1[3]); }
                    { const f32x4 v0 = acc[ai][1][m][0] * rstd, v1 = acc[ai][1][m][1] * rstd; w1.x = cvt_pk_bf16(v0[0], v0[1]); w1.y = cvt_pk_bf16(v0[2], v0[3]); w1.z = cvt_pk_bf16(v1[0], v1[1]); w1.w = cvt_pk_bf16(v1[2], v1[3]); }
                    qswap_pieces(w0, w1, odd, dA, dB);
                    bf16_t* p = HN + (size_t)((row0 & ~1) + ai * HALF + m * 16) * DM + col0 + (odd ? 32 : 0);
                    *(u32x4*)p = dA; *(u32x4*)(p + DM) = dB; }
        } else {
            const int colb = u.pn * BM + wc * 32 + 4 * fq; const bool odd = fr & 1;
            f32x4 gg[2][2];
#pragma unroll
            for (int bj = 0; bj < 2; ++bj)
#pragma unroll
                for (int n = 0; n < 2; ++n) gg[bj][n] = *(const f32x4*)(gfin + colb + bj * HALF + 16 * n);
#pragma unroll
            for (int ai = 0; ai < 2; ++ai)
#pragma unroll
                for (int m = 0; m < 4; ++m) { const float rstd = St[ai * HALF + rl0 + m * 16]; float* op = OUT + (size_t)(row0 + ai * HALF + m * 16) * DM + colb;
#pragma unroll
                    for (int bj = 0; bj < 2; ++bj) {
                        const f32x4 o0 = acc[ai][bj][m][0] * rstd * gg[bj][0], o1 = acc[ai][bj][m][1] * rstd * gg[bj][1]; f32x4 dA, dB;
#pragma unroll
                        for (int j = 0; j < 4; ++j) { const float snd = odd ? o0[j] : o1[j];
                            const float rcv = __builtin_bit_cast(float, __builtin_amdgcn_mov_dpp(__builtin_bit_cast(int, snd), 0xB1, 0xf, 0xf, false));
                            dA[j] = odd ? rcv : o0[j]; dB[j] = odd ? o1[j] : rcv; }
                        float* pp = op + bj * HALF + (odd ? 16 : 0);
                        __builtin_nontemporal_store(dA, (f32x4*)(pp - (odd ? DM : 0))); __builtin_nontemporal_store(dB, (f32x4*)(pp + (odd ? 0 : DM))); } }
        }
    }
};

__device__ __forceinline__ float dpp_shr1(float old, float src) { return __builtin_bit_cast(float, __builtin_amdgcn_update_dpp(__builtin_bit_cast(int, old), __builtin_bit_cast(int, src), 0x111, 0xf, 0xf, false)); }
__device__ __forceinline__ float dpp_shr2(float old, float src) { return __builtin_bit_cast(float, __builtin_amdgcn_update_dpp(__builtin_bit_cast(int, old), __builtin_bit_cast(int, src), 0x112, 0xf, 0xf, false)); }
__device__ __forceinline__ float dpp_ror1(float src) { return __builtin_bit_cast(float, __builtin_amdgcn_mov_dpp(__builtin_bit_cast(int, src), 0x121, 0xf, 0xf, false)); }
__device__ __forceinline__ float dpp_ror2(float src) { return __builtin_bit_cast(float, __builtin_amdgcn_mov_dpp(__builtin_bit_cast(int, src), 0x122, 0xf, 0xf, false)); }
constexpr int FF = 5632, FF2 = 11264;
typedef _Float16 h2_t __attribute__((ext_vector_type(2)));
__device__ __forceinline__ unsigned pkh(float a, float b) { return __builtin_bit_cast(unsigned, __builtin_amdgcn_cvt_pkrtz(a, b)); }
__device__ __forceinline__ unsigned dppu_shr1(unsigned old, unsigned src) { return (unsigned)__builtin_amdgcn_update_dpp((int)old, (int)src, 0x111, 0xf, 0xf, false); }
__device__ __forceinline__ unsigned dppu_shr2(unsigned old, unsigned src) { return (unsigned)__builtin_amdgcn_update_dpp((int)old, (int)src, 0x112, 0xf, 0xf, false); }
__device__ __forceinline__ unsigned dppu_ror1(unsigned src) { return (unsigned)__builtin_amdgcn_mov_dpp((int)src, 0x121, 0xf, 0xf, false); }
__device__ __forceinline__ unsigned dppu_ror2(unsigned src) { return (unsigned)__builtin_amdgcn_mov_dpp((int)src, 0x122, 0xf, 0xf, false); }
struct EpiAct {
    static constexpr bool PERM = true, AFTER_DRAIN = false;
    bf16_t* ACT; const float* cw; const float* cb; float* ubnd;
    __device__ __forceinline__ void operator()(f32x4 (&acc)[2][2][4][2], const Unit& u, int wr, int wc, int fr_, int fq_, PG8_LAS unsigned char* xlds) const {
        int t_ = threadIdx.x; asm volatile("" : "+v"(t_));
        const int fr = t_ & 15, fq = (t_ >> 4) & 3;
        const int row0 = u.pm * BM + wr * 64 + fr, cl = wc * 32 + 8 * fq;
        const int c0 = u.pn * 128 + cl;
        f32x4 wgt[2][8];
#pragma unroll
        for (int n = 0; n < 2; ++n) { const float* wp = cw + c0 + 4 * n; const float* bp = cb + c0 + 4 * n;
            wgt[n][0] = *(const f32x4*)wp; wgt[n][1] = *(const f32x4*)(wp + FF2); wgt[n][2] = *(const f32x4*)(wp + 2 * FF2); wgt[n][3] = *(const f32x4*)bp;
            wgt[n][4] = *(const f32x4*)(wp + FF); wgt[n][5] = *(const f32x4*)(wp + FF2 + FF); wgt[n][6] = *(const f32x4*)(wp + 2 * FF2 + FF); wgt[n][7] = *(const f32x4*)(bp + FF); }
        if (wr == 1 && fr >= 14) {
#pragma unroll
            for (int bj = 0; bj < 2; ++bj)
#pragma unroll
                for (int n = 0; n < 2; ++n) *(f32x4*)(ubnd + (size_t)(u.pm * 4 + 2 + (fr - 14)) * FF2 + u.pn * BM + 64 * wc + 32 * bj + 8 * fq + 4 * n) = acc[1][bj][3][n]; }
        if (wr == 0 && fr < 2) {
#pragma unroll
            for (int bj = 0; bj < 2; ++bj)
#pragma unroll
                for (int n = 0; n < 2; ++n) *(f32x4*)(ubnd + (size_t)(u.pm * 4 + fr) * FF2 + u.pn * BM + 64 * wc + 32 * bj + 8 * fq + 4 * n) = acc[0][bj][0][n]; }
        u32x4 pk[2][4][2];
#pragma unroll
        for (int ai = 0; ai < 2; ++ai)
#pragma unroll
            for (int m = 0; m < 4; ++m)
#pragma unroll
                for (int n = 0; n < 2; ++n) { const f32x4 g = acc[ai][0][m][n], v = acc[ai][1][m][n]; pk[ai][m][n] = (u32x4){pkh(g[0], v[0]), pkh(g[1], v[1]), pkh(g[2], v[2]), pkh(g[3], v[3])}; }
        if (fr >= 14) {
#pragma unroll
            for (int ai = 0; ai < 2; ++ai)
#pragma unroll
                for (int n = 0; n < 2; ++n) *(PG8_LAS u32x4*)(xlds + ((((2 * ai + wr) * 2 + (fr - 14)) * 128 + cl + 4 * n) << 2)) = pk[ai][3][n]; }
        asm volatile("s_waitcnt lgkmcnt(0)" ::: "memory"); __builtin_amdgcn_s_barrier(); asm volatile("" ::: "memory");
        u32x2 hold[2][4];
#pragma unroll
        for (int n = 0; n < 2; ++n) {
            h2_t w0p[4], w1p[4], w2p[4], bp4[4];
#pragma unroll
            for (int j = 0; j < 4; ++j) { w0p[j] = __builtin_bit_cast(h2_t, pkh(wgt[n][0][j], wgt[n][4][j])); w1p[j] = __builtin_bit_cast(h2_t, pkh(wgt[n][1][j], wgt[n][5][j]));
                w2p[j] = __builtin_bit_cast(h2_t, pkh(wgt[n][2][j], wgt[n][6][j])); bp4[j] = __builtin_bit_cast(h2_t, pkh(wgt[n][3][j], wgt[n][7][j])); }
#pragma unroll
            for (int ai = 0; ai < 2; ++ai) {
                const int chunk = 2 * ai + wr;
                u32x4 pp = {0u, 0u, 0u, 0u};
                if (chunk > 0) pp = *(const PG8_LAS u32x4*)(xlds + ((((chunk - 1) * 2 + (fr & 1)) * 128 + cl + 4 * n) << 2));
#pragma unroll
                for (int m = 0; m < 4; ++m) {
                    const u32x4 cur = pk[ai][m][n]; float a[4];
#pragma unroll
                    for (int j = 0; j < 4; ++j) {
                        const unsigned cj = cur[j], pj = pp[j];
                        const h2_t s1 = __builtin_bit_cast(h2_t, dppu_shr1(dppu_ror1(pj), cj)), s2 = __builtin_bit_cast(h2_t, dppu_shr2(dppu_ror2(pj), cj)), ch = __builtin_bit_cast(h2_t, cj);
                        const h2_t r = w2p[j] * ch + (w1p[j] * s1 + (w0p[j] * s2 + bp4[j]));
                        const float G = (float)r.x, V = (float)r.y;
                        a[j] = G * __builtin_amdgcn_rcpf(1.0f + __builtin_amdgcn_exp2f(-1.4426950408889634f * G)) * V; }
                    u32x2 w; w.x = cvt_pk_bf16(a[0], a[1]); w.y = cvt_pk_bf16(a[2], a[3]);
                    if (n == 0) hold[ai][m] = w;
                    else { u32x4 o; o.x = hold[ai][m].x; o.y = hold[ai][m].y; o.z = w.x; o.w = w.y;
                        if (!(ai == 0 && m == 0 && wr == 0 && u.pm > 0 && fr < 2)) *(u32x4*)(ACT + (size_t)(row0 + ai * HALF + m * 16) * FF + c0) = o; }
                    pp = cur;
                }
            }
        }
    }
};

template <class Epi, class Sched, bool ALIGN_EPI = false, bool SP2 = false>
__device__ __forceinline__ void gemm_phase(PG8_LAS unsigned char* lds, const Gemm g, const Sched& S, const Epi& E, PG8_LAS unsigned char* xlds) {
    const int tid = threadIdx.x, wid = __builtin_amdgcn_readfirstlane(tid >> 6), lane = tid & 63, wr = wid >> 2, wc = wid & 3, fr = lane & 15, fq = lane >> 4;
    const int K = g.K, nt = K / BK;
    unsigned voffA[2], voffB[2], voffB1[2];
#pragma unroll
    for (int i = 0; i < 2; ++i) { int R, C; stage_rc(tid * 16 + i * 8192, R, C); const int Rb0 = Epi::PERM ? (64 * (R >> 5) + perm32(R & 31)) : R, Rb1 = Epi::PERM ? Rb0 + 32 : R + HALF;
        voffA[i] = (unsigned)(R * K + C) * 2u; voffB[i] = (unsigned)(Rb0 * K + C) * 2u; voffB1[i] = (unsigned)(Rb1 * K + C) * 2u; }
    const size_t kstep = (size_t)(BK * 2);
    const size_t hstep = (size_t)HALF * K * 2;
    const size_t tstep = 2 * hstep;
    const unsigned ldsw = (unsigned)wid * 1024u;
    const int aoff = lds_byte(wr * 64 + fr, fq * 8), boff = lds_byte(wc * 32 + fr, fq * 8);
#define PG8_SA(b, h) (((b) * 2 + (h)) * HTB)
#define PG8_SB(b, h) ((4 + (b) * 2 + (h)) * HTB)
#define PG8_STAGE(bufoff, gbase, voff) do { _Pragma("unroll") for (int _i = 0; _i < 2; ++_i) \
        __builtin_amdgcn_global_load_lds((const unsigned*)((const char*)(gbase) + (voff)[_i]), (PG8_LAS unsigned*)(lds + (bufoff) + ldsw + _i * 8192), 16, 0, 0); } while (0)
#define PG8_LDA(dst, b, h) do { _Pragma("unroll") for (int m = 0; m < 4; ++m) _Pragma("unroll") for (int k = 0; k < 2; ++k) dst[m][k] = *(const PG8_LAS bf16x8*)(lds + PG8_SA(b, h) + aoff + m * 2048 + k * 1024); } while (0)
#define PG8_LDB(dst, b, h) do { _Pragma("unroll") for (int n = 0; n < 2; ++n) _Pragma("unroll") for (int k = 0; k < 2; ++k) dst[n][k] = *(const PG8_LAS bf16x8*)(lds + PG8_SB(b, h) + boff + n * 2048 + k * 1024); } while (0)
#define PG8_MMA(ai, bj, At, Bt) do { __builtin_amdgcn_s_setprio(PG8_PRIO); _Pragma("unroll") for (int m = 0; m < 4; ++m) _Pragma("unroll") for (int n = 0; n < 2; ++n) _Pragma("unroll") for (int k = 0; k < 2; ++k) \
        acc[ai][bj][m][n] = __builtin_amdgcn_mfma_f32_16x16x32_bf16(Bt[n][k], At[m][k], acc[ai][bj][m][n], 0, 0, 0); __builtin_amdgcn_s_setprio(0); } while (0)
#define PG8_WAIT_V(n) asm volatile("s_waitcnt vmcnt(" #n ")" ::: "memory")
#define PG8_WAIT_L(n) asm volatile("s_waitcnt lgkmcnt(" #n ")" ::: "memory")
#define PG8_BAR __builtin_amdgcn_s_barrier()
#define PG8_SCHED __builtin_amdgcn_sched_barrier(0)
    Unit cur, nxt; int ui = 0;
    if (!S.next(0, cur)) return;
    f32x4 acc[2][2][4][2];
#pragma unroll
    for (int a = 0; a < 2; ++a)
#pragma unroll
        for (int b = 0; b < 2; ++b)
#pragma unroll
            for (int m = 0; m < 4; ++m)
#pragma unroll
                for (int n = 0; n < 2; ++n) acc[a][b][m][n] = (f32x4){0.f, 0.f, 0.f, 0.f};
    bf16x8 At[4][2], B0[2][2], B1[2][2];
    const char* cA = (const char*)g.A + (size_t)cur.pm * tstep; const char* cB = (const char*)g.Bt + (size_t)cur.pn * tstep;
    S.a_ready(cur);
    if constexpr (SP2) {
        PG8_STAGE(PG8_SB(0, 0), cB, voffB); PG8_STAGE(PG8_SB(0, 1), cB, voffB1); PG8_STAGE(PG8_SA(0, 0), cA, voffA); PG8_STAGE(PG8_SA(0, 1), cA + hstep, voffA);
        if (wr == 1) PG8_BAR;
        PG8_WAIT_V(2); PG8_BAR;
        PG8_STAGE(PG8_SB(1, 0), cB + kstep, voffB); PG8_STAGE(PG8_SA(1, 0), cA + kstep, voffA); PG8_STAGE(PG8_SB(1, 1), cB + kstep, voffB1);
        PG8_WAIT_V(6); PG8_BAR;
    } else {
        PG8_STAGE(PG8_SB(0, 0), cB, voffB); PG8_STAGE(PG8_SA(0, 0), cA, voffA); PG8_STAGE(PG8_SB(0, 1), cB, voffB1); PG8_STAGE(PG8_SA(0, 1), cA + hstep, voffA);
        if (wr == 1) PG8_BAR;
        PG8_WAIT_V(4); PG8_BAR;
        PG8_STAGE(PG8_SB(1, 0), cB + kstep, voffB); PG8_STAGE(PG8_SA(1, 0), cA + kstep, voffA); PG8_STAGE(PG8_SB(1, 1), cB + kstep, voffB1);
        PG8_WAIT_V(6); PG8_BAR;
    }
    for (;;) {
        const bool has_next = S.next(ui + 1, nxt);
        const char* nA = has_next ? (const char*)g.A + (size_t)nxt.pm * tstep : cA; const char* nB = has_next ? (const char*)g.Bt + (size_t)nxt.pn * tstep : cB;
        for (int t = 0; t < nt; t += 2) {
            const bool last = (t == nt - 2);
            const char* a1 = cA + (size_t)(t + 1) * kstep;
            const char* a2 = last ? nA : cA + (size_t)(t + 2) * kstep; const char* b2 = last ? nB : cB + (size_t)(t + 2) * kstep;
            const char* a3 = a2 + kstep; const char* b3 = b2 + kstep;
            if (last && has_next) S.a_ready(nxt);
            if constexpr (SP2) {
            PG8_LDB(B0, 0, 0); PG8_LDB(B1, 0, 1); PG8_SCHED; PG8_LDA(At, 0, 0); PG8_STAGE(PG8_SA(1, 1), a1 + hstep, voffA);
            PG8_WAIT_V(8); PG8_WAIT_L(0); PG8_BAR; PG8_MMA(0, 0, At, B0); PG8_MMA(0, 1, At, B1); PG8_BAR; PG8_SCHED;
            PG8_LDA(At, 0, 1); PG8_STAGE(PG8_SB(0, 0), b2, voffB); PG8_STAGE(PG8_SB(0, 1), b2, voffB1); PG8_STAGE(PG8_SA(0, 0), a2, voffA);
            PG8_WAIT_V(8); PG8_WAIT_L(0); PG8_BAR; PG8_MMA(1, 0, At, B0); PG8_MMA(1, 1, At, B1); PG8_BAR; PG8_SCHED;
            PG8_LDB(B0, 1, 0); PG8_LDB(B1, 1, 1); PG8_SCHED; PG8_LDA(At, 1, 0); PG8_STAGE(PG8_SA(0, 1), a2 + hstep, voffA);
            PG8_WAIT_V(8); PG8_WAIT_L(0); PG8_BAR; PG8_MMA(0, 0, At, B0); PG8_MMA(0, 1, At, B1); PG8_BAR; PG8_SCHED;
            PG8_LDA(At, 1, 1); PG8_STAGE(PG8_SB(1, 0), b3, voffB); PG8_STAGE(PG8_SB(1, 1), b3, voffB1); PG8_STAGE(PG8_SA(1, 0), a3, voffA);
            PG8_WAIT_V(8); PG8_WAIT_L(0); PG8_BAR; PG8_MMA(1, 0, At, B0); PG8_MMA(1, 1, At, B1); PG8_BAR; PG8_SCHED;
            } else {
            PG8_LDB(B0, 0, 0); PG8_SCHED; PG8_LDA(At, 0, 0); PG8_STAGE(PG8_SA(1, 1), a1 + hstep, voffA);
            PG8_WAIT_L(8); PG8_BAR; PG8_WAIT_L(0); PG8_MMA(0, 0, At, B0); PG8_BAR; PG8_SCHED;
            PG8_LDB(B1, 0, 1); PG8_STAGE(PG8_SB(0, 0), b2, voffB);
            PG8_BAR; PG8_WAIT_L(0); PG8_MMA(0, 1, At, B1); PG8_BAR;
            PG8_LDA(At, 0, 1); PG8_STAGE(PG8_SA(0, 0), a2, voffA);
            PG8_BAR; PG8_WAIT_L(0); PG8_MMA(1, 0, At, B0); PG8_BAR; PG8_SCHED;
            PG8_STAGE(PG8_SB(0, 1), b2, voffB1);
            PG8_WAIT_V(6); PG8_BAR; PG8_MMA(1, 1, At, B1); PG8_BAR;
            PG8_LDB(B0, 1, 0); PG8_SCHED; PG8_LDA(At, 1, 0); PG8_STAGE(PG8_SA(0, 1), a2 + hstep, voffA);
            PG8_WAIT_L(8); PG8_BAR; PG8_WAIT_L(0); PG8_MMA(0, 0, At, B0); PG8_BAR; PG8_SCHED;
            PG8_LDB(B1, 1, 1); PG8_STAGE(PG8_SB(1, 0), b3, voffB);
            PG8_BAR; PG8_WAIT_L(0); PG8_MMA(0, 1, At, B1); PG8_BAR;
            PG8_LDA(At, 1, 1); PG8_STAGE(PG8_SA(1, 0), a3, voffA);
            PG8_BAR; PG8_WAIT_L(0); PG8_MMA(1, 0, At, B0); PG8_BAR; PG8_SCHED;
            PG8_STAGE(PG8_SB(1, 1), b3, voffB1);
            PG8_WAIT_V(6); PG8_BAR; PG8_MMA(1, 1, At, B1); PG8_BAR;
            }
        }
        if constexpr (ALIGN_EPI) { if (wr == 0) PG8_BAR; }
        if constexpr (!Epi::AFTER_DRAIN) { E(acc, cur, wr, wc, fr, fq, xlds); S.done(cur); }
        if (!has_next) break;
#pragma unroll
        for (int a = 0; a < 2; ++a)
#pragma unroll
            for (int b = 0; b < 2; ++b)
#pragma unroll
                for (int m = 0; m < 4; ++m)
#pragma unroll
                    for (int n = 0; n < 2; ++n) acc[a][b][m][n] = (f32x4){0.f, 0.f, 0.f, 0.f};
        cur = nxt; cA = nA; cB = nB; ++ui;
        if constexpr (ALIGN_EPI) { if (wr == 1) PG8_BAR; }
    }
    PG8_WAIT_V(0);
    if constexpr (!ALIGN_EPI) { if (wr == 0) PG8_BAR; }
    PG8_BAR;

#undef PG8_SA
#undef PG8_SB
#undef PG8_STAGE
#undef PG8_LDA
#undef PG8_LDB
#undef PG8_MMA
#undef PG8_WAIT_V
#undef PG8_WAIT_L
#undef PG8_BAR
#undef PG8_SCHED
}
}

#define GAS __attribute__((address_space(1)))
#define LAS __attribute__((address_space(3)))
typedef unsigned short bf16;
typedef float f32x4 __attribute__((ext_vector_type(4)));
typedef short bf16x8 __attribute__((ext_vector_type(8)));
typedef unsigned u32x4 __attribute__((ext_vector_type(4)));
typedef unsigned u32x2 __attribute__((ext_vector_type(2)));

constexpr int NWAVES = 8;
constexpr int SEQ = 16384, DMODEL = 2048, NMEM = 256, DIN = 3584, DCONV = 768, DPOOL = 768, DXATT = 512, DFF = 5632, DFF2 = 11264;
constexpr int PGD = 192;
constexpr float EPS = 1e-6f;
constexpr int LDS_BYTES = 147456;
#ifndef MK_PER_PHASE
#define MK_PER_PHASE 0
#endif
constexpr int NPHASE = 7;
#ifndef PHM
#define PHM 255
#endif
#ifndef FUSE_FIXUP
#define FUSE_FIXUP 0
#endif
#ifndef P1_WGM
#define P1_WGM 4
#endif
#ifndef P4_WGM
#define P4_WGM 4
#endif
#ifndef P1_ALIGN
#define P1_ALIGN false
#endif
#ifndef USE_CG_SYNC
#define USE_CG_SYNC 0
#endif
#ifndef PROBE_P2
#define PROBE_P2 0
#endif
#ifndef PROBE_SYNC
#define PROBE_SYNC 0
#endif
#ifndef PROBE_GEMM
#define PROBE_GEMM 0
#endif
#ifndef PROBE_N
#define PROBE_N 2048
#endif
#ifndef REPM
#define REPM 0
#endif

constexpr size_t MiB = 1u << 20;
constexpr size_t WS_KB = 1 * MiB;
constexpr size_t WS_VT = 1 * MiB + 256 * 1024;
constexpr size_t WS_POOLWT = 1 * MiB + 512 * 1024;
constexpr size_t WS_MB = 2 * MiB;
constexpr size_t WS_WKVT = 3 * MiB;
constexpr size_t WS_SIGX = 7 * MiB + 128 * 1024;
constexpr size_t WS_GINV = 7 * MiB + 256 * 1024;
constexpr size_t WS_SIG = 7 * MiB;
constexpr size_t WS_SLAB1 = 8 * MiB;
constexpr size_t WS_SLAB2 = 10 * MiB;
constexpr size_t WS_WUPT = 12 * MiB;
constexpr size_t WS_WDOWNT = 56 * MiB;
constexpr size_t WS_UBND = 80 * MiB;
constexpr size_t WS_X1B = 96 * MiB;
constexpr size_t WS_ACT = 160 * MiB;
constexpr size_t WS_H = 160 * MiB;
constexpr size_t WS_Z = 225 * MiB;
constexpr size_t WS_ZPAD = WS_Z - (size_t)16 * 3584 * 2;
constexpr size_t WS_MIX = 338 * MiB;
constexpr size_t WS_WINT = 402 * MiB;
constexpr size_t WS_WOUTT = 416 * MiB;
constexpr size_t WS_END = 424 * MiB;

__device__ __forceinline__ unsigned f2bf(float f) { unsigned u = __builtin_bit_cast(unsigned, f); return (u + 0x7fffu + ((u >> 16) & 1u)) >> 16; }
__device__ __forceinline__ unsigned pk2(float lo, float hi) { return f2bf(lo) | (f2bf(hi) << 16); }
__device__ __forceinline__ float bflo(unsigned w) { return __builtin_bit_cast(float, w << 16); }
__device__ __forceinline__ float bfhi(unsigned w) { return __builtin_bit_cast(float, w & 0xffff0000u); }
__device__ __forceinline__ void unpack8(const u32x4 w, float (&f)[8]) { f[0] = bflo(w.x); f[1] = bfhi(w.x); f[2] = bflo(w.y); f[3] = bfhi(w.y); f[4] = bflo(w.z); f[5] = bfhi(w.z); f[6] = bflo(w.w); f[7] = bfhi(w.w); }
__device__ __forceinline__ u32x4 pack8(const float (&f)[8]) { u32x4 w; w.x = pk2(f[0], f[1]); w.y = pk2(f[2], f[3]); w.z = pk2(f[4], f[5]); w.w = pk2(f[6], f[7]); return w; }
__device__ __forceinline__ float wave_sum(float v) {
#pragma unroll
    for (int o = 1; o < 64; o <<= 1) v += __shfl_xor(v, o);
    return v;
}
#define LDS_WAIT() asm volatile("s_waitcnt lgkmcnt(0)" ::: "memory")

typedef GAS unsigned gu32;
constexpr size_t WS_CTL = 0, CTL_ZERO_BYTES = 64 * 1024;
constexpr int CW_PANEL2 = 12288;
constexpr int CW_PANEL1 = 8192;
constexpr int CW_PANEL = 4096;
constexpr int MISC_OFF = 131072 + 320;
constexpr int XLDS_OFF = 131072 + 1024;
#define XB_TMO      128
#define XB_XCNT(j)  (256  + 64 * (j))
#define XB_XSUB(j)  (1280 + 64 * (j))
#define XB_XGEN(j)  (2304 + 64 * (j))
#define XB_TOP      3328
#define XB_TOPGEN   3392
#define XCD_BAR_WORDS 3456
#define XB_SPIN_CAP (1u << 18)

__device__ __forceinline__ unsigned xb_ld(unsigned* p)              { return __hip_atomic_load(p, __ATOMIC_RELAXED, __HIP_MEMORY_SCOPE_AGENT); }
__device__ __forceinline__ unsigned xb_add(unsigned* p, unsigned v) { return __hip_atomic_fetch_add(p, v, __ATOMIC_RELAXED, __HIP_MEMORY_SCOPE_AGENT); }
__device__ __forceinline__ unsigned xb_xcc_id() { return (unsigned)__builtin_amdgcn_s_getreg((3 << 11) | 20) & 0xFu; }
#define XB_SPIN(cond, bar) do { unsigned _sp = 0; while (cond) { __builtin_amdgcn_s_sleep(1); \
    if ((++_sp & 255u) == 0u) { if (xb_ld(&(bar)[XB_TMO])) break; if (_sp > XB_SPIN_CAP) { atomicAdd(&(bar)[XB_TMO], 1u); break; } } } } while (0)

struct XcdBarrier {
    unsigned* bar; unsigned x;
    volatile LAS unsigned* st;
};

__device__ __forceinline__ XcdBarrier xcd_barrier_post(unsigned* bar, volatile LAS unsigned* st) {
    XcdBarrier b; b.bar = bar; b.x = xb_xcc_id(); b.st = st;
    if (threadIdx.x == 0) (void)xb_add(&bar[XB_XCNT(b.x)], 1u);
    return b;
}
__device__ __forceinline__ void xcd_barrier_complete(unsigned* bar, unsigned x, unsigned& nloc, unsigned& nx) {
    const unsigned G = gridDim.x * gridDim.y * gridDim.z;
    unsigned sum, cnt, mine, sp = 0u;
    for (;;) {
        sum = 0u; cnt = 0u; mine = 0u;
#pragma unroll
        for (unsigned j = 0; j < 16; ++j) { const unsigned c = xb_ld(&bar[XB_XCNT(j)]); sum += c; cnt += (c > 0u) ? 1u : 0u; mine = (j == x) ? c : mine; }
        if (sum == G) break;
        __builtin_amdgcn_s_sleep(1);
        if ((++sp & 255u) == 0u) { if (xb_ld(&bar[XB_TMO])) break; if (sp > XB_SPIN_CAP) { atomicAdd(&bar[XB_TMO], 1u); break; } }
    }
    nloc = mine > 0u ? mine : 1u; nx = cnt > 0u ? cnt : 1u;
}

__device__ __forceinline__ void xcd_barrier(const XcdBarrier& b) {
    asm volatile("s_waitcnt vmcnt(0)" ::: "memory");
    __syncthreads();
    if (threadIdx.x == 0) {
        unsigned* bar = b.bar;
        __builtin_amdgcn_s_waitcnt(0);
        unsigned nloc = b.st[0], nx = b.st[1];
        if (nloc == 0u) { xcd_barrier_complete(bar, b.x, nloc, nx); b.st[0] = nloc; b.st[1] = nx; }
        const unsigned old = xb_add(&bar[XB_XSUB(b.x)], 1u);
        const unsigned gen = old / nloc;
        if (old + 1u == (gen + 1u) * nloc) {
            __builtin_amdgcn_fence(__ATOMIC_RELEASE, "agent");
            asm volatile("s_waitcnt vmcnt(0)" ::: "memory");
            const unsigned og = xb_add(&bar[XB_TOP], 1u);
            const unsigned tg = og / nx;
            if (og + 1u == (tg + 1u) * nx) xb_add(&bar[XB_TOPGEN], 1u);
            else XB_SPIN(xb_ld(&bar[XB_TOPGEN]) == tg, bar);
            __builtin_amdgcn_fence(__ATOMIC_ACQUIRE, "agent");
            xb_add(&bar[XB_XGEN(b.x)], 1u);
            asm volatile("s_waitcnt vmcnt(0)" ::: "memory");
        } else {
            XB_SPIN(xb_ld(&bar[XB_XGEN(b.x)]) == gen, bar);
            __builtin_amdgcn_fence(__ATOMIC_ACQUIRE, "agent");
            asm volatile("s_waitcnt vmcnt(0)" ::: "memory");
        }
    }
    __syncthreads();
}


struct TrItem { const float* src; const float* ks; bf16* dst; int N, K, skip; };
template <bool UPMAP> __device__ __forceinline__ TrItem tr_make(const float* W, int K, int N, bf16* WT, const float* ks, int item) {
    const int nblk = N / 64, kb = item / nblk, nb = item % nblk, k0 = 64 * kb, n0 = 64 * nb;
    const int np = (n0 < DFF) ? n0 : n0 - DFF;
    const int r0 = !UPMAP ? n0 : 256 * (np / 128) + 64 * ((np % 128) / 32) + ((n0 < DFF) ? 0 : 32);
    TrItem t; t.src = W + (size_t)k0 * N + n0; t.ks = ks ? ks + k0 : nullptr; t.dst = WT + (size_t)r0 * K + k0; t.N = N; t.K = K; t.skip = UPMAP ? 32 : 0; return t;
}
__device__ __forceinline__ void tr_load(const TrItem& t, f32x4 (&v)[16], int lane) {
    const float* src = t.src + (size_t)(lane >> 4) * t.N + 4 * (lane & 15);
#pragma unroll
    for (int i = 0; i < 16; ++i) v[i] = TR_NT ? __builtin_nontemporal_load((const f32x4*)(src + (size_t)(4 * i) * t.N)) : *(const f32x4*)(src + (size_t)(4 * i) * t.N);
}
__device__ __forceinline__ void tr_store(const TrItem& t, const f32x4 (&v)[16], LAS float* scr, int lane) {
#pragma unroll
    for (int i = 0; i < 16; ++i) { f32x4 x = v[i]; if (t.ks) x = x * t.ks[4 * i + (lane >> 4)];
        *(LAS f32x4*)(scr + (4 * i + (lane >> 4)) * 64 + (((lane & 15) ^ ((i >> 1) & 7)) << 2)) = x; }
    LDS_WAIT(); asm volatile("" ::: "memory");
    const int c = lane & 7;
#pragma unroll
    for (int j = 0; j < 8; ++j) { const int nn = (lane >> 3) + 8 * j; const LAS float* sp = scr + (8 * c) * 64 + ((((nn >> 2) ^ c) & 15) << 2) + (nn & 3);
        u32x4 o; o.x = pk2(sp[0 * 64], sp[1 * 64]); o.y = pk2(sp[2 * 64], sp[3 * 64]); o.z = pk2(sp[4 * 64], sp[5 * 64]); o.w = pk2(sp[6 * 64], sp[7 * 64]);
        *(u32x4*)(t.dst + (size_t)(nn + (nn >= 32 ? t.skip : 0)) * t.K + 8 * c) = o; }
    LDS_WAIT(); asm volatile("" ::: "memory");
}
__device__ __forceinline__ void rms_rows2_to_bf16(const float* xa, const float* xb, const float* g, bf16* oa, bf16* ob, int lane, float* sig2 = nullptr) {
    const f32x4* pa = (const f32x4*)xa + lane; const f32x4* pb = (const f32x4*)xb + lane; const f32x4* gr = (const f32x4*)g + lane;
    f32x4 va[8], vb[8]; float sa = 0.f, sb = 0.f;
#pragma unroll
    for (int j = 0; j < 8; ++j) { va[j] = __builtin_nontemporal_load(pa + 64 * j); vb[j] = __builtin_nontemporal_load(pb + 64 * j); }
#pragma unroll
    for (int j = 0; j < 8; ++j) { sa += (va[j].x * va[j].x + va[j].y * va[j].y) + (va[j].z * va[j].z + va[j].w * va[j].w); sb += (vb[j].x * vb[j].x + vb[j].y * vb[j].y) + (vb[j].z * vb[j].z + vb[j].w * vb[j].w); }
    const float da = sqrtf(wave_sum(sa) * (1.0f / DMODEL) + EPS), db = sqrtf(wave_sum(sb) * (1.0f / DMODEL) + EPS), ra = 1.0f / da, rb = 1.0f / db;
    if (sig2 && lane == 0) { sig2[0] = da; sig2[1] = db; }
    u32x2* qa = (u32x2*)oa + lane; u32x2* qb = (u32x2*)ob + lane;
#pragma unroll
    for (int j = 0; j < 8; ++j) { const f32x4 gg = gr[64 * j]; u32x2 w;
        w.x = pk2(va[j].x * ra * gg.x, va[j].y * ra * gg.y); w.y = pk2(va[j].z * ra * gg.z, va[j].w * ra * gg.w); qa[64 * j] = w;
        w.x = pk2(vb[j].x * rb * gg.x, vb[j].y * rb * gg.y); w.y = pk2(vb[j].z * rb * gg.z, vb[j].w * rb * gg.w); qb[64 * j] = w; }
}

struct Ptrs {
    const float *x, *mem, *g_mix, *g_mem, *w_in, *conv_w, *pool_w, *pool_scale, *w_kv, *w_out, *g_ffn, *w_up, *ffn_conv_w, *ffn_conv_b, *w_down, *g_final;
    float* out; unsigned char* ws;
};

constexpr int UP_ITEMS = (DMODEL / 64) * (DFF2 / 64), DN_ITEMS = (DFF / 64) * (DMODEL / 64);
#ifndef DN_IN_P1
#define DN_IN_P1 2816
#endif
#ifndef UP_IN_P0
#define UP_IN_P0 4608
#endif
__device__ __forceinline__ void p1_idle_work(const Ptrs& P, LAS unsigned char* lds, int iw, int NIW, int wave, int lane);
template <int LIST> __device__ __forceinline__ TrItem tr_desc(const Ptrs& P, int it) {
    unsigned char* ws = P.ws;
    constexpr int I_IN = (DMODEL / 64) * (DIN / 64), I_OUT = (DMODEL / 64) * (DMODEL / 64), I_KV = (DMODEL / 64) * (1024 / 64), I_PW = (PGD / 64) * (PGD / 64);
    if (LIST == 0) {
        int r = it;
        if (r < I_IN) return tr_make<false>(P.w_in, DMODEL, DIN, (bf16*)(ws + WS_WINT), nullptr, r); r -= I_IN;
        if (r < I_OUT) return tr_make<false>(P.w_out, DMODEL, DMODEL, (bf16*)(ws + WS_WOUTT), nullptr, r); r -= I_OUT;
        if (r < UP_IN_P0) return tr_make<true>(P.w_up, DMODEL, DFF2, (bf16*)(ws + WS_WUPT), P.g_ffn, r); r -= UP_IN_P0;
        if (r < I_KV) return tr_make<false>(P.w_kv, DMODEL, 1024, (bf16*)(ws + WS_WKVT), nullptr, r); r -= I_KV;
        const int g = r / I_PW; r -= g * I_PW;
        return tr_make<false>(P.pool_w + (size_t)g * PGD * PGD, PGD, PGD, (bf16*)(ws + WS_POOLWT) + (size_t)g * PGD * PGD, nullptr, r);
    } else {
        if (LIST == 2) return tr_make<false>(P.w_down, DFF, DMODEL, (bf16*)(ws + WS_WDOWNT), nullptr, DN_IN_P1 + it);
        if (it < DN_IN_P1) return tr_make<false>(P.w_down, DFF, DMODEL, (bf16*)(ws + WS_WDOWNT), nullptr, it);
        return tr_make<true>(P.w_up, DMODEL, DFF2, (bf16*)(ws + WS_WUPT), P.g_ffn, UP_IN_P0 + it - DN_IN_P1);
    }
}
template <int LIST> __device__ __forceinline__ void tr_stream(const Ptrs& P, LAS float* scr, int first, int stride, int nitems, int lane) {
    if (first >= nitems) return;
    TrItem cur = tr_desc<LIST>(P, first); f32x4 va[16], vb[16];
    tr_load(cur, va, lane);
    for (int it = first; it < nitems; it += 2 * stride) {
        TrItem nx = cur; const bool h1 = it + stride < nitems; if (h1) { nx = tr_desc<LIST>(P, it + stride); tr_load(nx, vb, lane); }
        tr_store(cur, va, scr, lane);
        if (!h1) break;
        const bool h2 = it + 2 * stride < nitems; if (h2) { cur = tr_desc<LIST>(P, it + 2 * stride); tr_load(cur, va, lane); }
        tr_store(nx, vb, scr, lane);
        if (!h2) break;
    }
}
__device__ __forceinline__ void p0_prologue(const Ptrs& P, LAS unsigned char* lds, int gw, int NGW, int wave, int lane) {
    LAS float* scr = (LAS float*)(lds + wave * 16384);
    unsigned char* ws = P.ws;
    constexpr int NITEMS = (DMODEL / 64) * (DIN / 64) + (DMODEL / 64) * (DMODEL / 64) + UP_IN_P0 + (DMODEL / 64) * (1024 / 64) + 4 * (PGD / 64) * (PGD / 64);
    tr_stream<0>(P, scr, gw, NGW, NITEMS, lane);
    for (int i = gw * 64 + lane; i < DMODEL; i += NGW * 64) ((float*)(ws + WS_GINV))[i] = 1.0f / P.g_mix[i];
    for (int i = gw * 64 + lane; i < 16 * DIN * 2 / 16; i += NGW * 64) ((u32x4*)(ws + WS_ZPAD))[i] = (u32x4){0u, 0u, 0u, 0u};
    for (int m = 2 * gw; m < SEQ; m += 2 * NGW) rms_rows2_to_bf16(P.x + (size_t)m * DMODEL, P.x + (size_t)(m + 1) * DMODEL, P.g_mix, (bf16*)(ws + WS_H) + (size_t)m * DMODEL, (bf16*)(ws + WS_H) + (size_t)(m + 1) * DMODEL, lane, (float*)(ws + WS_SIGX) + m);
    for (int m = 2 * gw; m < NMEM; m += 2 * NGW) rms_rows2_to_bf16(P.mem + (size_t)m * DMODEL, P.mem + (size_t)(m + 1) * DMODEL, P.g_mem, (bf16*)(ws + WS_MB) + (size_t)m * DMODEL, (bf16*)(ws + WS_MB) + (size_t)(m + 1) * DMODEL, lane);
}

__device__ __forceinline__ void kv_tile(const Ptrs& P, int tt, int lane) {
    const bf16* mB = (const bf16*)(P.ws + WS_MB); const bf16* wT = (const bf16*)(P.ws + WS_WKVT);
    const int rb = tt >> 6, cb = tt & 63, fr = lane & 15, fq = lane >> 4;
    const bf16* ap = mB + (size_t)(16 * rb + fr) * DMODEL + 8 * fq; const bf16* wp = wT + (size_t)(16 * cb + fr) * DMODEL + 8 * fq;
    const bool kpart = cb < 32;
    f32x4 acc = {0.f, 0.f, 0.f, 0.f};
    bf16x8 a0[8], w0[8], a1[8], w1[8];
#pragma unroll
    for (int i = 0; i < 8; ++i) { a0[i] = *(const bf16x8*)(ap + 32 * i); w0[i] = *(const bf16x8*)(wp + 32 * i); }
#pragma unroll 1
    for (int kb = 0; kb < 8; kb += 2) {
#pragma unroll
        for (int i = 0; i < 8; ++i) { a1[i] = *(const bf16x8*)(ap + 32 * (8 * kb + 8 + i)); w1[i] = *(const bf16x8*)(wp + 32 * (8 * kb + 8 + i)); }
#pragma unroll
        for (int i = 0; i < 8; ++i) acc = kpart ? __builtin_amdgcn_mfma_f32_16x16x32_bf16(w0[i], a0[i], acc, 0, 0, 0) : __builtin_amdgcn_mfma_f32_16x16x32_bf16(a0[i], w0[i], acc, 0, 0, 0);
        if (kb + 2 < 8) {
#pragma unroll
            for (int i = 0; i < 8; ++i) { a0[i] = *(const bf16x8*)(ap + 32 * (8 * kb + 16 + i)); w0[i] = *(const bf16x8*)(wp + 32 * (8 * kb + 16 + i)); } }
#pragma unroll
        for (int i = 0; i < 8; ++i) acc = kpart ? __builtin_amdgcn_mfma_f32_16x16x32_bf16(w1[i], a1[i], acc, 0, 0, 0) : __builtin_amdgcn_mfma_f32_16x16x32_bf16(a1[i], w1[i], acc, 0, 0, 0);
    }
    u32x2 o; o.x = pk2(acc[0], acc[1]); o.y = pk2(acc[2], acc[3]);
    if (kpart) *(u32x2*)((bf16*)(P.ws + WS_KB) + (size_t)(16 * rb + fr) * 512 + 16 * cb + 4 * fq) = o;
    else *(u32x2*)((bf16*)(P.ws + WS_VT) + (size_t)(16 * cb - 512 + fr) * 256 + 32 * (rb >> 1) + 8 * fq + 4 * (rb & 1)) = o;
}

__device__ __forceinline__ void p1_idle_work(const Ptrs& P, LAS unsigned char* lds, int iw, int NIW, int wave, int lane) {
    LAS float* scr = (LAS float*)(lds + wave * 16384);
    for (int tt = iw; tt < 1024; tt += NIW) kv_tile(P, tt, lane);
    tr_stream<1>(P, scr, iw, NIW, DN_IN_P1 + (UP_ITEMS - UP_IN_P0), lane);
}

__device__ __forceinline__ void mix_conv_task(const Ptrs& P, int blk, int lane, int cg0, int cg1) {
    const bf16* z = (const bf16*)(P.ws + WS_Z); bf16* mix = (bf16*)(P.ws + WS_MIX);
    const int t0 = blk * 16;
    for (int cg = cg0 + lane; cg < cg1; cg += 64) {
        const int c = cg * 8;
        float w0[8], w1[8], w2[8], p1[8], p2[8];
#pragma unroll
        for (int e = 0; e < 8; ++e) { w0[e] = P.conv_w[c + e]; w1[e] = P.conv_w[DCONV + c + e]; w2[e] = P.conv_w[2 * DCONV + c + e]; }
        { float a[8], b[8]; unpack8(*(const u32x4*)(z + (long)(t0 - 2) * DIN + DCONV + c), a); unpack8(*(const u32x4*)(z + (long)(t0 - 2) * DIN + 2 * DCONV + c), b);
#pragma unroll
          for (int e = 0; e < 8; ++e) p2[e] = a[e] * b[e];
          unpack8(*(const u32x4*)(z + (long)(t0 - 1) * DIN + DCONV + c), a); unpack8(*(const u32x4*)(z + (long)(t0 - 1) * DIN + 2 * DCONV + c), b);
#pragma unroll
          for (int e = 0; e < 8; ++e) p1[e] = a[e] * b[e]; }
#pragma unroll 4
        for (int r = 0; r < 16; ++r) {
            const int t = t0 + r; float p[8], a[8], b[8], g[8], o[8];
            unpack8(__builtin_nontemporal_load((const u32x4*)(z + (size_t)t * DIN + DCONV + c)), a); unpack8(__builtin_nontemporal_load((const u32x4*)(z + (size_t)t * DIN + 2 * DCONV + c)), b); unpack8(__builtin_nontemporal_load((const u32x4*)(z + (size_t)t * DIN + c)), g);
#pragma unroll
            for (int e = 0; e < 8; ++e) { p[e] = a[e] * b[e]; o[e] = g[e] * (w2[e] * p[e] + w1[e] * p1[e] + w0[e] * p2[e]); p2[e] = p1[e]; p1[e] = p[e]; }
            *(u32x4*)(mix + (size_t)t * DMODEL + c) = pack8(o);
        }
    }
}
template <int g> __device__ __forceinline__ void mix_pool_task(const Ptrs& P, int blk, int lane) {
    constexpr int k = 2 << g;
    const char* zu = (const char*)((const bf16*)(P.ws + WS_Z) + (size_t)(blk * 16) * DIN + 3 * DCONV + PGD * g);
    const char* wu = (const char*)((const bf16*)(P.ws + WS_POOLWT) + (size_t)g * PGD * PGD);
    bf16* mix = (bf16*)(P.ws + WS_MIX);
    const int fr = lane & 15, fq = lane >> 4, t = blk * 16 + fr;
    const unsigned zl = (unsigned)(fr * DIN + 8 * fq) * 2u, wl = (unsigned)(fr * PGD + 8 * fq) * 2u;
    const int cnt = (t + 1 < k) ? t + 1 : k; const float inv = 1.0f / (float)cnt;
    f32x4 acc[12];
#pragma unroll
    for (int n = 0; n < 12; ++n) acc[n] = (f32x4){0.f, 0.f, 0.f, 0.f};
#pragma unroll 1
    for (int ks = 0; ks < 6; ++ks) {
        float sum[8], self[8];
        unpack8(*(const u32x4*)(zu + ks * 64 + zl), self);
#pragma unroll
        for (int e = 0; e < 8; ++e) sum[e] = self[e];
#pragma unroll
        for (int j = 1; j < k; ++j) { float v[8]; unpack8(*(const u32x4*)(zu + ks * 64 - (long)j * (DIN * 2) + zl), v);
#pragma unroll
            for (int e = 0; e < 8; ++e) sum[e] += v[e]; }
        float pl[8];
#pragma unroll
        for (int e = 0; e < 8; ++e) pl[e] = sum[e] * inv - self[e];
        const bf16x8 pf = __builtin_bit_cast(bf16x8, pack8(pl));
#pragma unroll
        for (int n = 0; n < 12; ++n) { const bf16x8 wf = *(const bf16x8*)(wu + n * (16 * PGD * 2) + ks * 64 + wl); acc[n] = __builtin_amdgcn_mfma_f32_16x16x32_bf16(wf, pf, acc[n], 0, 0, 0); }
    }
#pragma unroll
    for (int n = 0; n < 12; ++n) { const int d = 16 * n + 4 * fq; const f32x4 sc = *(const f32x4*)(P.pool_scale + PGD * g + d);
        u32x2 o; o.x = pk2(acc[n][0] * sc[0], acc[n][1] * sc[1]); o.y = pk2(acc[n][2] * sc[2], acc[n][3] * sc[3]);
        *(u32x2*)(mix + (size_t)t * DMODEL + DCONV + PGD * g + d) = o; }
}
__device__ __forceinline__ void mix_attn_task(const Ptrs& P, int h, int blk, int lane) {
    const bf16* z = (const bf16*)(P.ws + WS_Z); bf16* mix = (bf16*)(P.ws + WS_MIX); const bf16* Kb = (const bf16*)(P.ws + WS_KB); const bf16* Vt = (const bf16*)(P.ws + WS_VT);
    const int fr = lane & 15, fq = lane >> 4, t = blk * 16 + fr;
    bf16x8 qf[4];
#pragma unroll
    for (int ks = 0; ks < 4; ++ks) qf[ks] = *(const bf16x8*)(z + (size_t)t * DIN + 3 * DCONV + DPOOL + 128 * h + 32 * ks + 8 * fq);
    f32x4 s[16];
#pragma unroll
    for (int kb = 0; kb < 16; ++kb) { s[kb] = (f32x4){0.f, 0.f, 0.f, 0.f};
#pragma unroll
        for (int ks = 0; ks < 4; ++ks) { const bf16x8 kf = *(const bf16x8*)(Kb + (size_t)(16 * kb + fr) * 512 + 128 * h + 32 * ks + 8 * fq); s[kb] = __builtin_amdgcn_mfma_f32_16x16x32_bf16(kf, qf[ks], s[kb], 0, 0, 0); } }
    float mx = -3.0e38f;
#pragma unroll
    for (int kb = 0; kb < 16; ++kb) mx = fmaxf(fmaxf(fmaxf(s[kb][0], s[kb][1]), fmaxf(s[kb][2], s[kb][3])), mx);
    mx = fmaxf(mx, __shfl_xor(mx, 16)); mx = fmaxf(mx, __shfl_xor(mx, 32));
    const float c2 = 0.08838834764831845f * 1.4426950408889634f;
    float sum = 0.f;
#pragma unroll
    for (int kb = 0; kb < 16; ++kb)
#pragma unroll
        for (int r = 0; r < 4; ++r) { const float p = __builtin_amdgcn_exp2f((s[kb][r] - mx) * c2); s[kb][r] = p; sum += p; }
    sum += __shfl_xor(sum, 16); sum += __shfl_xor(sum, 32);
    const float inv = 1.0f / sum;
    f32x4 o[8];
#pragma unroll
    for (int db = 0; db < 8; ++db) o[db] = (f32x4){0.f, 0.f, 0.f, 0.f};
#pragma unroll
    for (int ks = 0; ks < 8; ++ks) {
        u32x4 pw; pw.x = pk2(s[2 * ks][0], s[2 * ks][1]); pw.y = pk2(s[2 * ks][2], s[2 * ks][3]); pw.z = pk2(s[2 * ks + 1][0], s[2 * ks + 1][1]); pw.w = pk2(s[2 * ks + 1][2], s[2 * ks + 1][3]);
        const bf16x8 pf = __builtin_bit_cast(bf16x8, pw);
#pragma unroll
        for (int db = 0; db < 8; ++db) { const bf16x8 vf = *(const bf16x8*)(Vt + (size_t)(128 * h + 16 * db + fr) * 256 + 32 * ks + 8 * fq); o[db] = __builtin_amdgcn_mfma_f32_16x16x32_bf16(vf, pf, o[db], 0, 0, 0); }
    }
#pragma unroll
    for (int db = 0; db < 8; ++db) { u32x2 w; w.x = pk2(o[db][0] * inv, o[db][1] * inv); w.y = pk2(o[db][2] * inv, o[db][3] * inv);
        *(u32x2*)(mix + (size_t)t * DMODEL + DCONV + DPOOL + 128 * h + 16 * db + 4 * fq) = w; }
}
template <int R, int C, int PCH> __device__ __forceinline__ void lds_stage_rows(LAS unsigned char* dst, const unsigned char* src, int gp, int tid) {
    constexpr int N = R * C, PER = (N + 511) / 512;
    u32x4 v[PER];
#pragma unroll
    for (int i = 0; i < PER; ++i) { const int idx = tid + 512 * i; if (idx < N) { const int row = idx / C, ch = idx % C; v[i] = *(const u32x4*)(src + (size_t)row * gp + ch * 16); } }
#pragma unroll
    for (int i = 0; i < PER; ++i) { const int idx = tid + 512 * i; if (idx < N) { const int row = idx / C, ch = idx % C; *(LAS u32x4*)(dst + row * (PCH * 16) + (((ch & ~15) | ((ch & 15) ^ (row & 15))) << 4)) = v[i]; } }
}
template <int N> __device__ __forceinline__ float dpp_shrN(float old, float src) { return __builtin_bit_cast(float, __builtin_amdgcn_update_dpp(__builtin_bit_cast(int, old), __builtin_bit_cast(int, src), 0x110 + N, 0xf, 0xf, false)); }
template <int N> __device__ __forceinline__ float dpp_rorN(float src) { return __builtin_bit_cast(float, __builtin_amdgcn_mov_dpp(__builtin_bit_cast(int, src), 0x120 + N, 0xf, 0xf, false)); }
template <int N> __device__ __forceinline__ float scan_step(float x, float p) { return x + dpp_shrN<N>(dpp_rorN<N>(p), x); }
template <int N> __device__ __forceinline__ float scan_step_prev(float p) { return p + dpp_shrN<N>(0.f, p); }

__device__ __forceinline__ void mix_attn_wave(const Ptrs& P, LAS unsigned char* ldsK, LAS unsigned char* ldsV, int h, int row0, int lane) {
    const bf16* z = (const bf16*)(P.ws + WS_Z); bf16* mix = (bf16*)(P.ws + WS_MIX);
    const int fr = lane & 15, fq = lane >> 4;
    bf16x8 q0[4], q1[4];
#pragma unroll
    for (int ks = 0; ks < 4; ++ks) { const bf16* qp = z + (size_t)(row0 + fr) * DIN + 3 * DCONV + DPOOL + 128 * h + 32 * ks + 8 * fq; q0[ks] = __builtin_nontemporal_load((const bf16x8*)qp); q1[ks] = __builtin_nontemporal_load((const bf16x8*)(qp + 16 * DIN)); }
    unsigned offk[4];
#pragma unroll
    for (int ks = 0; ks < 4; ++ks) offk[ks] = (unsigned)(fr * 256 + (((4 * ks + fq) ^ fr) << 4));
    f32x4 s0[16], s1[16];
#pragma unroll
    for (int kb = 0; kb < 16; ++kb) { s0[kb] = (f32x4){0.f, 0.f, 0.f, 0.f}; s1[kb] = (f32x4){0.f, 0.f, 0.f, 0.f};
#pragma unroll
        for (int ks = 0; ks < 4; ++ks) { const bf16x8 kf = *(const LAS bf16x8*)(ldsK + kb * 4096 + offk[ks]);
            s0[kb] = __builtin_amdgcn_mfma_f32_16x16x32_bf16(kf, q0[ks], s0[kb], 0, 0, 0); s1[kb] = __builtin_amdgcn_mfma_f32_16x16x32_bf16(kf, q1[ks], s1[kb], 0, 0, 0); } }
    const float c2 = 0.08838834764831845f * 1.4426950408889634f;
    bf16x8 p0[8], p1[8]; float inv0, inv1;
    {   float mx = -3.0e38f;
#pragma unroll
        for (int kb = 0; kb < 16; ++kb) mx = fmaxf(fmaxf(fmaxf(s0[kb][0], s0[kb][1]), fmaxf(s0[kb][2], s0[kb][3])), mx);
        mx = fmaxf(mx, __shfl_xor(mx, 16)); mx = fmaxf(mx, __shfl_xor(mx, 32));
        float sum = 0.f;
#pragma unroll
        for (int ks = 0; ks < 8; ++ks) { float e[8];
#pragma unroll
            for (int r = 0; r < 4; ++r) { e[r] = __builtin_amdgcn_exp2f((s0[2 * ks][r] - mx) * c2); e[4 + r] = __builtin_amdgcn_exp2f((s0[2 * ks + 1][r] - mx) * c2); }
            sum += ((e[0] + e[1]) + (e[2] + e[3])) + ((e[4] + e[5]) + (e[6] + e[7]));
            p0[ks] = __builtin_bit_cast(bf16x8, pack8(e)); }
        sum += __shfl_xor(sum, 16); sum += __shfl_xor(sum, 32); inv0 = 1.0f / sum; }
    {   float mx = -3.0e38f;
#pragma unroll
        for (int kb = 0; kb < 16; ++kb) mx = fmaxf(fmaxf(fmaxf(s1[kb][0], s1[kb][1]), fmaxf(s1[kb][2], s1[kb][3])), mx);
        mx = fmaxf(mx, __shfl_xor(mx, 16)); mx = fmaxf(mx, __shfl_xor(mx, 32));
        float sum = 0.f;
#pragma unroll
        for (int ks = 0; ks < 8; ++ks) { float e[8];
#pragma unroll
            for (int r = 0; r < 4; ++r) { e[r] = __builtin_amdgcn_exp2f((s1[2 * ks][r] - mx) * c2); e[4 + r] = __builtin_amdgcn_exp2f((s1[2 * ks + 1][r] - mx) * c2); }
            sum += ((e[0] + e[1]) + (e[2] + e[3])) + ((e[4] + e[5]) + (e[6] + e[7]));
            p1[ks] = __builtin_bit_cast(bf16x8, pack8(e)); }
        sum += __shfl_xor(sum, 16); sum += __shfl_xor(sum, 32); inv1 = 1.0f / sum; }
    f32x4 o0[8], o1[8];
#pragma unroll
    for (int db = 0; db < 8; ++db) { o0[db] = (f32x4){0.f, 0.f, 0.f, 0.f}; o1[db] = (f32x4){0.f, 0.f, 0.f, 0.f}; }
#pragma unroll
    for (int ks = 0; ks < 8; ++ks) {
        const unsigned offv = (unsigned)(fr * 512 + ((ks >> 2) << 8) + (((4 * (ks & 3) + fq) ^ fr) << 4));
#pragma unroll
        for (int db = 0; db < 8; ++db) { const bf16x8 vf = *(const LAS bf16x8*)(ldsV + db * 8192 + offv);
            o0[db] = __builtin_amdgcn_mfma_f32_16x16x32_bf16(vf, p0[ks], o0[db], 0, 0, 0); o1[db] = __builtin_amdgcn_mfma_f32_16x16x32_bf16(vf, p1[ks], o1[db], 0, 0, 0); } }
    bf16* op = mix + (size_t)(row0 + fr) * DMODEL + DCONV + DPOOL + 128 * h + 4 * fq;
#pragma unroll
    for (int db = 0; db < 8; ++db) { u32x2 w; w.x = pk2(o0[db][0] * inv0, o0[db][1] * inv0); w.y = pk2(o0[db][2] * inv0, o0[db][3] * inv0); *(u32x2*)(op + 16 * db) = w;
        w.x = pk2(o1[db][0] * inv1, o1[db][1] * inv1); w.y = pk2(o1[db][2] * inv1, o1[db][3] * inv1); *(u32x2*)(op + (size_t)16 * DMODEL + 16 * db) = w; }
}

template <int g> __device__ __forceinline__ void mix_pool_wave(const Ptrs& P, LAS unsigned char* ldsW, int row0, int lane) {
    constexpr int k = 2 << g;
    const bf16* z = (const bf16*)(P.ws + WS_Z); bf16* mix = (bf16*)(P.ws + WS_MIX);
    const int fr = lane & 15, fq = lane >> 4;
    f32x4 acc0[12], acc1[12];
#pragma unroll
    for (int n = 0; n < 12; ++n) { acc0[n] = (f32x4){0.f, 0.f, 0.f, 0.f}; acc1[n] = (f32x4){0.f, 0.f, 0.f, 0.f}; }
    const float invA = 1.0f / (float)((row0 + fr + 1 < k) ? row0 + fr + 1 : k), invB = 1.0f / (float)((row0 + 16 + fr + 1 < k) ? row0 + 16 + fr + 1 : k);
#pragma unroll 1
    for (int ks = 0; ks < 6; ++ks) {
        const bf16* zp = z + (long)(row0 - 16 + fr) * DIN + 3 * DCONV + PGD * g + 32 * ks + 8 * fq;
        float pv[8], xa[8], xb[8], sa[8], sb[8];
        unpack8(__builtin_nontemporal_load((const u32x4*)zp), pv); unpack8(__builtin_nontemporal_load((const u32x4*)(zp + 16 * DIN)), xa); unpack8(__builtin_nontemporal_load((const u32x4*)(zp + 32 * DIN)), xb);
#pragma unroll
        for (int e = 0; e < 8; ++e) {
            float p = pv[e], a = xa[e], b = xb[e];
            float b1 = scan_step<1>(b, a), a1 = scan_step<1>(a, p), p1 = scan_step_prev<1>(p);
            if (k >= 4) { const float b2 = scan_step<2>(b1, a1), a2 = scan_step<2>(a1, p1), p2 = scan_step_prev<2>(p1); b1 = b2; a1 = a2; p1 = p2; }
            if (k >= 8) { const float b2 = scan_step<4>(b1, a1), a2 = scan_step<4>(a1, p1), p2 = scan_step_prev<4>(p1); b1 = b2; a1 = a2; p1 = p2; }
            if (k >= 16) { const float b2 = scan_step<8>(b1, a1), a2 = scan_step<8>(a1, p1); b1 = b2; a1 = a2; }
            sa[e] = a1 * invA - a; sb[e] = b1 * invB - b; }
        const bf16x8 fa = __builtin_bit_cast(bf16x8, pack8(sa)), fb = __builtin_bit_cast(bf16x8, pack8(sb));
        const unsigned offw = (unsigned)(fr * 512 + ((ks >> 2) << 8) + (((4 * (ks & 3) + fq) ^ fr) << 4));
#pragma unroll
        for (int n = 0; n < 12; ++n) { const bf16x8 wf = *(const LAS bf16x8*)(ldsW + n * 8192 + offw);
            acc0[n] = __builtin_amdgcn_mfma_f32_16x16x32_bf16(wf, fa, acc0[n], 0, 0, 0); acc1[n] = __builtin_amdgcn_mfma_f32_16x16x32_bf16(wf, fb, acc1[n], 0, 0, 0); }
    }
    bf16* op = mix + (size_t)(row0 + fr) * DMODEL + DCONV + PGD * g + 4 * fq;
#pragma unroll
    for (int n = 0; n < 12; ++n) { const f32x4 sc = *(const f32x4*)(P.pool_scale + PGD * g + 16 * n + 4 * fq);
        u32x2 o; o.x = pk2(acc0[n][0] * sc[0], acc0[n][1] * sc[1]); o.y = pk2(acc0[n][2] * sc[2], acc0[n][3] * sc[3]); *(u32x2*)(op + 16 * n) = o;
        o.x = pk2(acc1[n][0] * sc[0], acc1[n][1] * sc[1]); o.y = pk2(acc1[n][2] * sc[2], acc1[n][3] * sc[3]); *(u32x2*)(op + (size_t)16 * DMODEL + 16 * n) = o; }
}

__device__ __forceinline__ void p2_mixer(const Ptrs& P, LAS unsigned char* lds, int w, int tid, int wave, int lane, int tmask) {
    const int sub = w & 3, tile = w >> 2, row0 = tile * 256 + (wave & 3) * 64;
    lds_stage_rows<256, 16, 16>(lds, (const unsigned char*)(P.ws + WS_KB) + 256 * sub, 1024, tid);
    lds_stage_rows<128, 32, 32>(lds + 65536, (const unsigned char*)(P.ws + WS_VT) + (size_t)sub * 128 * 512, 512, tid);
    LDS_WAIT(); __syncthreads();
    if (wave < 4) { if (tmask & 0x1e0) {
#pragma unroll 1
        for (int p = 0; p < 2; ++p) { asm volatile("" ::: "memory"); mix_attn_wave(P, lds, lds + 65536, sub, row0 + 32 * p, lane); } } }
    else if (tmask & 1) mix_conv_task(P, 4 * w + (wave - 4), lane, 0, 48);
    __syncthreads();
    lds_stage_rows<192, 24, 32>(lds, (const unsigned char*)(P.ws + WS_POOLWT) + (size_t)sub * PGD * PGD * 2, PGD * 2, tid);
    LDS_WAIT(); __syncthreads();
    if (wave < 4) { if (tmask & 0x1e) {
#pragma unroll 1
        for (int p = 0; p < 2; ++p) { const int r = row0 + 32 * p; asm volatile("" ::: "memory");
            if (sub == 0) mix_pool_wave<0>(P, lds, r, lane); else if (sub == 1) mix_pool_wave<1>(P, lds, r, lane); else if (sub == 2) mix_pool_wave<2>(P, lds, r, lane); else mix_pool_wave<3>(P, lds, r, lane); } } }
    else if (tmask & 1) mix_conv_task(P, 4 * w + (wave - 4), lane, 48, 96);
    __syncthreads();
}

__device__ __forceinline__ void p5_fix_item(const Ptrs& P, int pm, int c) {
    const float* ub = (const float*)(P.ws + WS_UBND); bf16* act = (bf16*)(P.ws + WS_ACT); const float* cw = P.ffn_conv_w; const float* cb = P.ffn_conv_b;
    const int gi = 256 * (c / 128) + 64 * ((c % 128) / 32) + (c % 32);
    const float* p2 = ub + (size_t)((pm - 1) * 4 + 2) * DFF2 + gi; const float* p1 = p2 + DFF2; const float* r0 = ub + (size_t)(pm * 4) * DFF2 + gi; const float* r1 = r0 + DFF2;
    float o0[8], o1[8];
#pragma unroll
    for (int e = 0; e < 8; ++e) {
        const float gw0 = cw[c + e], gw1 = cw[DFF2 + c + e], gw2 = cw[2 * DFF2 + c + e], gb = cb[c + e], vw0 = cw[DFF + c + e], vw1 = cw[DFF2 + DFF + c + e], vw2 = cw[2 * DFF2 + DFF + c + e], vb = cb[DFF + c + e];
        const float G0 = gw2 * r0[e] + (gw1 * p1[e] + (gw0 * p2[e] + gb)), V0 = vw2 * r0[32 + e] + (vw1 * p1[32 + e] + (vw0 * p2[32 + e] + vb));
        const float G1 = gw2 * r1[e] + (gw1 * r0[e] + (gw0 * p1[e] + gb)), V1 = vw2 * r1[32 + e] + (vw1 * r0[32 + e] + (vw0 * p1[32 + e] + vb));
        o0[e] = G0 * __builtin_amdgcn_rcpf(1.0f + __builtin_amdgcn_exp2f(-1.4426950408889634f * G0)) * V0;
        o1[e] = G1 * __builtin_amdgcn_rcpf(1.0f + __builtin_amdgcn_exp2f(-1.4426950408889634f * G1)) * V1; }
    *(u32x4*)(act + (size_t)(256 * pm) * DFF + c) = pack8(o0); *(u32x4*)(act + (size_t)(256 * pm + 1) * DFF + c) = pack8(o1);
}
__device__ __forceinline__ void p6_fixup_panels(const Ptrs& P, int vcu, int G, int tid, unsigned* cnt, unsigned* tmo) {
    constexpr int GRP = DFF / 8 / 8;
    const int nround = (512 + G - 1) / G;
    for (int i = 0; i < nround; ++i) { const int L = i * G + vcu; if (L >= 512) break; const int pm = L >> 3, pn = L & 7;
        if (pm > 0 && tid < GRP) p5_fix_item(P, pm, (pn * GRP + tid) * 8); }
    asm volatile("s_waitcnt vmcnt(0)" ::: "memory"); __syncthreads();
    if (tid == 0) {
        __builtin_amdgcn_fence(__ATOMIC_RELEASE, "agent"); asm volatile("s_waitcnt vmcnt(0)" ::: "memory");
        for (int i = 0; i < nround; ++i) { const int L = i * G + vcu; if (L >= 512) break; __hip_atomic_fetch_add(cnt + 64 * (L >> 3), 1u, __ATOMIC_RELAXED, __HIP_MEMORY_SCOPE_AGENT); }
        for (int i = 0; i < nround; ++i) { const int L = i * G + vcu; if (L >= 512) break; unsigned spins = 0;
            while (__hip_atomic_load(cnt + 64 * (L >> 3), __ATOMIC_RELAXED, __HIP_MEMORY_SCOPE_AGENT) < 8u) { __builtin_amdgcn_s_sleep(2); if (++spins > (1u << 20)) { __hip_atomic_store(tmo, 1u, __ATOMIC_RELAXED, __HIP_MEMORY_SCOPE_AGENT); break; } } }
        __builtin_amdgcn_fence(__ATOMIC_ACQUIRE, "agent"); asm volatile("s_waitcnt vmcnt(0)" ::: "memory");
    }
    __syncthreads();
}
__device__ __forceinline__ void p5_fixup(const Ptrs& P, int gt, int NGT) {
    for (int i = gt; i < 63 * (DFF / 8); i += NGT) p5_fix_item(P, 1 + i / (DFF / 8), (i % (DFF / 8)) * 8);
}

__device__ __forceinline__ void p7_final(const Ptrs& P, int gw, int NGW, int lane) {
    const float* slab = (const float*)(P.ws + WS_SLAB2);
    for (int m = gw; m < SEQ; m += NGW) {
        const float part = (lane < 32) ? slab[(size_t)m * 32 + lane] : 0.f;
        const float rstd = 1.0f / sqrtf(wave_sum(part) * (1.0f / DMODEL) + EPS);
        f32x4* xr = (f32x4*)(P.out + (size_t)m * DMODEL) + lane; const f32x4* gr = (const f32x4*)P.g_final + lane;
#pragma unroll
        for (int j = 0; j < 8; ++j) { f32x4 v = xr[64 * j]; const f32x4 gg = gr[64 * j]; v = v * rstd * gg; xr[64 * j] = v; }
    }
}

struct Args { const float* in[16]; float* out; unsigned char* ws; int ph_lo, ph_hi; };
__global__ void __launch_bounds__(NWAVES * 64, 2) hybrid_fwd(Args args) {
    extern __shared__ __attribute__((aligned(16))) unsigned char lds_raw[];
    LAS unsigned char* lds = (LAS unsigned char*)lds_raw;
    cg::grid_group grid = cg::this_grid();
    const int tid = threadIdx.x, lane = tid & 63, wave = __builtin_amdgcn_readfirstlane(tid >> 6);
    const int G = gridDim.x, bx = blockIdx.x, vcu = (G % 8 == 0) ? (bx % 8) * (G / 8) + bx / 8 : bx;
    const int gw = vcu * NWAVES + wave, NGW = G * NWAVES;
    volatile LAS unsigned* MISC = (volatile LAS unsigned*)(lds + MISC_OFF);
    if (tid < 32) MISC[tid] = 0u;
    __syncthreads();
    const XcdBarrier bar = xcd_barrier_post((unsigned*)(args.ws + WS_CTL), MISC + 8);
    Ptrs P;
    P.x = args.in[0]; P.mem = args.in[1]; P.g_mix = args.in[2]; P.g_mem = args.in[3]; P.w_in = args.in[4]; P.conv_w = args.in[5]; P.pool_w = args.in[6]; P.pool_scale = args.in[7];
    P.w_kv = args.in[8]; P.w_out = args.in[9]; P.g_ffn = args.in[10]; P.w_up = args.in[11]; P.ffn_conv_w = args.in[12]; P.ffn_conv_b = args.in[13]; P.w_down = args.in[14]; P.g_final = args.in[15];
    P.out = args.out; P.ws = args.ws;
    unsigned char* ws = args.ws;
#if PROBE_SYNC
    for (int i = 0; i < 20; ++i) xcd_barrier(bar);
#endif
    const int lo = args.ph_lo, hi = args.ph_hi;
#define IN(k) (lo <= (k) && (k) < hi)
#define SYNC(k) do { if ((k) + 1 < hi) { if ((k) == 0 && USE_CG_SYNC) grid.sync(); else xcd_barrier(bar); } } while (0)
#define SYNCR(k, b) do { if ((k) + 1 < hi || rp + 1 < NREP(b)) { if ((k) == 0 && USE_CG_SYNC) grid.sync(); else xcd_barrier(bar); } } while (0)
#define NREP(b) ((REPM & (b)) ? 2 : 1)
    if (IN(0) && (PHM & 1)) for (int rp = 0; rp < NREP(1); ++rp) { p0_prologue(P, lds, gw, NGW, wave, lane); SYNCR(0, 1); }
    if (IN(1) && (PHM & 2)) for (int rp = 0; rp < NREP(2); ++rp) {
        pg8::Gemm g{(const bf16*)(ws + WS_H), (const bf16*)(ws + WS_WINT), SEQ, DIN, DMODEL}; pg8::StaticOrder S; S.init(SEQ, DIN, G, bx, P1_WGM);
        pg8::EpiZ E{(bf16*)(ws + WS_Z), DIN};
        pg8::gemm_phase<pg8::EpiZ, pg8::StaticOrder, P1_ALIGN, true>(lds, g, S, E, lds + XLDS_OFF);
        { const int nfull = ((SEQ / 256) * (DIN / 256)) % G;
          if (nfull == 0) p1_idle_work(P, lds, bx * NWAVES + wave, G * NWAVES, wave, lane);
          else if (bx >= nfull) p1_idle_work(P, lds, (bx - nfull) * NWAVES + wave, (G - nfull) * NWAVES, wave, lane); }
        SYNCR(1, 2);
    }
    if (IN(2) && (PHM & 4)) for (int rp = 0; rp < NREP(4); ++rp) { p2_mixer(P, lds, vcu, tid, wave, lane, 511);
#if PROBE_P2
        p2_mixer(P, lds, vcu, tid, wave, lane, PROBE_P2);
#endif
        SYNCR(2, 4); }
    if (IN(3) && (PHM & 8)) {
        pg8::Gemm g{(const bf16*)(ws + WS_MIX), (const bf16*)(ws + WS_WOUTT), SEQ, DMODEL, DMODEL}; pg8::PanelOrder S{G, vcu, (SEQ / 256) * (DMODEL / 256)};
        pg8::EpiNorm<0> E{nullptr, (const bf16*)(ws + WS_H), (const float*)(ws + WS_SIGX), (float*)(ws + WS_SIG), (bf16*)(ws + WS_X1B), nullptr, (const float*)(ws + WS_GINV), (unsigned*)(ws + WS_SLAB1), (unsigned*)(ws + WS_CTL) + CW_PANEL1, (unsigned*)(ws + WS_CTL) + XB_TMO};
        pg8::gemm_phase<pg8::EpiNorm<0>, pg8::PanelOrder, true, true>(lds, g, S, E, lds + XLDS_OFF);
        SYNC(3);
    }
#if PROBE_GEMM
    if (IN(3)) {
        pg8::Gemm g{(const bf16*)(ws + WS_X1B), (const bf16*)(ws + WS_WUPT), SEQ, PROBE_N, DMODEL}; pg8::StaticOrder S; S.init(SEQ, PROBE_N, G, bx);
#if PROBE_GEMM == 1
        pg8::EpiZ E{(bf16*)(ws + WS_Z), PROBE_N};
        pg8::gemm_phase<pg8::EpiZ, pg8::StaticOrder, true, true>(lds, g, S, E, lds + XLDS_OFF);
#elif PROBE_GEMM == 2
        pg8::EpiNone E{};
        pg8::gemm_phase<pg8::EpiNone, pg8::StaticOrder, true, true>(lds, g, S, E, lds + XLDS_OFF);
#elif PROBE_GEMM == 3
        pg8::EpiZ E{(bf16*)(ws + WS_Z), PROBE_N};
        pg8::gemm_phase<pg8::EpiZ, pg8::StaticOrder, true, false>(lds, g, S, E, lds + XLDS_OFF);
#elif PROBE_GEMM == 5
        pg8::EpiAct E{(bf16*)(ws + WS_ACT), P.ffn_conv_w, P.ffn_conv_b, (float*)(ws + WS_UBND)};
        pg8::gemm_phase<pg8::EpiAct, pg8::StaticOrder, true, true>(lds, g, S, E, lds + XLDS_OFF);
#elif PROBE_GEMM == 4
        pg8::EpiZ E{(bf16*)(ws + WS_Z), PROBE_N};
        pg8::gemm_phase<pg8::EpiZ, pg8::StaticOrder, false, true>(lds, g, S, E, lds + XLDS_OFF);
#endif
        xcd_barrier(bar);
    }
#endif
    if (IN(4) && (PHM & 16)) for (int rp = 0; rp < NREP(16); ++rp) {
        pg8::Gemm g{(const bf16*)(ws + WS_X1B), (const bf16*)(ws + WS_WUPT), SEQ, DFF2, DMODEL}; pg8::StaticOrder S; S.init(SEQ, DFF2, G, bx, P4_WGM);
        pg8::EpiAct E{(bf16*)(ws + WS_ACT), P.ffn_conv_w, P.ffn_conv_b, (float*)(ws + WS_UBND)};
        pg8::gemm_phase<pg8::EpiAct, pg8::StaticOrder, true, true>(lds, g, S, E, lds + XLDS_OFF);
        SYNCR(4, 16);
    }
#if !FUSE_FIXUP
    if (IN(5) && (PHM & 32)) { p5_fixup(P, vcu * (NWAVES * 64) + tid, G * NWAVES * 64); tr_stream<2>(P, (LAS float*)(lds + wave * 16384), gw, NGW, DN_ITEMS - DN_IN_P1, lane); SYNC(5); }
#endif
    if (IN(6) && (PHM & 64)) {
#if FUSE_FIXUP
        p6_fixup_panels(P, vcu, G, tid, (unsigned*)(ws + WS_CTL) + CW_PANEL2, (unsigned*)(ws + WS_CTL) + XB_TMO);
#endif
        pg8::Gemm g{(const bf16*)(ws + WS_ACT), (const bf16*)(ws + WS_WDOWNT), SEQ, DMODEL, DFF}; pg8::PanelOrder S{G, vcu, (SEQ / 256) * (DMODEL / 256)};
        pg8::EpiNorm<1> E{nullptr, (const bf16*)(ws + WS_X1B), (const float*)(ws + WS_SIG), nullptr, nullptr, P.out, P.g_final, (unsigned*)(ws + WS_SLAB2), (unsigned*)(ws + WS_CTL) + CW_PANEL, (unsigned*)(ws + WS_CTL) + XB_TMO};
        pg8::gemm_phase<pg8::EpiNorm<1>, pg8::PanelOrder, true, true>(lds, g, S, E, lds + XLDS_OFF);
    }
#undef IN
#undef SYNC
}

extern "C" void kernel_launch(void* const* d_in, const int* in_sizes, int n_in, void* d_out, int out_size, void* d_ws, size_t ws_size, hipStream_t stream) {
    static int grid = 0;
    if (grid == 0) {
        if (n_in != 16 || in_sizes[0] != SEQ * DMODEL || out_size != SEQ * DMODEL || ws_size < WS_END) { fprintf(stderr, "kernel_launch: unexpected shapes (n_in %d, in0 %d, out %d, ws %zu)\n", n_in, n_in > 0 ? in_sizes[0] : -1, out_size, ws_size); grid = -1; return; }
        int dev = 0, cus = 0, per_cu = 0;
        if (hipGetDevice(&dev) != hipSuccess || hipDeviceGetAttribute(&cus, hipDeviceAttributeMultiprocessorCount, dev) != hipSuccess) { grid = -1; return; }
        if (hipFuncSetAttribute((const void*)hybrid_fwd, hipFuncAttributeMaxDynamicSharedMemorySize, LDS_BYTES) != hipSuccess) { fprintf(stderr, "kernel_launch: hipFuncSetAttribute failed\n"); grid = -1; return; }
        if (hipOccupancyMaxActiveBlocksPerMultiprocessor(&per_cu, (const void*)hybrid_fwd, NWAVES * 64, LDS_BYTES) != hipSuccess || per_cu < 1) { fprintf(stderr, "kernel_launch: occupancy query says %d blocks per CU\n", per_cu); (void)hipGetLastError(); per_cu = 1; }
        grid = cus;
        if (grid != 256) { fprintf(stderr, "kernel_launch: this kernel is laid out for one workgroup on each of 256 CUs (the mixer phase and the row-statistics exchanges assume it); the device reports %d\n", grid); if (grid > 256) grid = 256; }
    }
    if (grid < 0) return;
    if (hipMemsetAsync((char*)d_ws + WS_CTL, 0, CTL_ZERO_BYTES, stream) != hipSuccess) { fprintf(stderr, "kernel_launch: hipMemsetAsync failed\n"); return; }
    Args a{};
    for (int i = 0; i < 16; ++i) a.in[i] = (const float*)d_in[i];
    a.out = (float*)d_out; a.ws = (unsigned char*)d_ws;
#if MK_PER_PHASE
    for (int ph = 0; ph < NPHASE; ++ph) { a.ph_lo = ph; a.ph_hi = ph + 1; hipLaunchKernelGGL(hybrid_fwd, dim3(grid), dim3(NWAVES * 64), LDS_BYTES, stream, a); }
#else
    a.ph_lo = 0; a.ph_hi = NPHASE;
    void* kargs[] = {&a};
    hipError_t e = hipLaunchCooperativeKernel((const void*)hybrid_fwd, dim3(grid), dim3(NWAVES * 64), kargs, LDS_BYTES, stream);
    if (e != hipSuccess) fprintf(stderr, "kernel_launch: cooperative launch failed: %s (grid %d)\n", hipGetErrorString(e), grid);
#endif
}
```

```cpp
#include <hip/hip_runtime.h>
#include <hip/hip_cooperative_groups.h>
#include <cstdio>
#include <cstdint>
namespace cg = cooperative_groups;
#ifndef NT_MIX
#define NT_MIX 1
#endif
#ifndef NT_OUT
#define NT_OUT 4
#endif
#ifndef TR_NT
#define TR_NT 1
#endif
#ifndef XCHG_ACQUIRE
#define XCHG_ACQUIRE 0
#endif
#ifndef PG8_PRIO
#define PG8_PRIO 0
#endif
namespace pg8 {
#define PG8_LAS __attribute__((address_space(3)))
typedef unsigned short bf16_t;
typedef short bf16x8 __attribute__((ext_vector_type(8)));
typedef float f32x4 __attribute__((ext_vector_type(4)));
typedef unsigned u32x4 __attribute__((ext_vector_type(4)));
constexpr int BM = 256, BK = 64, HALF = 128, HTB = HALF * BK * 2  , STAGE_BYTES = 8 * HTB, NXCD = 8, WGM = 8;

__host__ __device__ __forceinline__ int lds_byte(int r, int c) { const int st = (r >> 4) * 2 + (c >> 5), rr = r & 15, cc = c & 31, ob = rr * 64 + cc * 2; return st * 1024 + (ob ^ (((ob >> 9) & 1) << 5)); }
__host__ __device__ __forceinline__ void stage_rc(int b, int& R, int& C) { const int st = b / 1024, sb = b % 1024, swz = sb ^ (((sb >> 9) & 1) << 5); R = (st >> 1) * 16 + swz / 64; C = (st & 1) * 32 + (swz % 64) / 2; }
__host__ __device__ __forceinline__ int perm32(int rho) { const int n = rho >> 4, i = rho & 15; return 8 * (i >> 2) + 4 * n + (i & 3); }

struct Unit { int pm, pn; };
struct Gemm { const bf16_t* A; const bf16_t* Bt; int M, N, K; };

struct StaticOrder {
    int nM, nN, nwg, G, c, wgm;
    __host__ __device__ void init(int M, int N, int G_, int c_, int wgm_ = WGM) { nM = M / BM; nN = N / BM; nwg = nM * nN; G = G_; c = c_; wgm = wgm_; }
    __host__ __device__ bool next(int i, Unit& u) const {
        const long L = (long)i * G + c; if (L >= nwg) return false;
        int wgid = (int)L; { const int q = nwg / NXCD, r = nwg % NXCD, xcd = wgid % NXCD, off = wgid / NXCD; wgid = (xcd < r ? xcd * (q + 1) : r * (q + 1) + (xcd - r) * q) + off; }
        const int nig = wgm * nN, gid = wgid / nig, fm = gid * wgm, gsz = (nM - fm) < wgm ? (nM - fm) : wgm;
        u.pm = fm + ((wgid % nig) % gsz); u.pn = (wgid % nig) / gsz; return true;
    }
    __device__ __forceinline__ void a_ready(const Unit&) const {}
    __device__ __forceinline__ void done(const Unit&) const {}
};
__device__ __forceinline__ unsigned cvt_pk_bf16(float lo, float hi) { unsigned r; asm volatile("v_cvt_pk_bf16_f32 %0, %1, %2" : "=v"(r) : "v"(lo), "v"(hi)); return r; }
typedef unsigned u32x2 __attribute__((ext_vector_type(2)));
constexpr int DM = 2048;
constexpr float RMS_EPS = 1e-6f;

__device__ __forceinline__ void qswap_pieces(const u32x4 w0, const u32x4 w1, bool odd, u32x4& dA, u32x4& dB) {
#pragma unroll
    for (int j = 0; j < 4; ++j) { const unsigned snd = odd ? w0[j] : w1[j];
        const unsigned rcv = (unsigned)__builtin_amdgcn_mov_dpp((int)snd, 0xB1, 0xf, 0xf, false);
        dA[j] = odd ? rcv : w0[j]; dB[j] = odd ? w1[j] : rcv; }
}
struct EpiZ {
    static constexpr bool PERM = true, AFTER_DRAIN = false;
    bf16_t* O; int ldc;
    __device__ __forceinline__ void operator()(const f32x4 (&acc)[2][2][4][2], const Unit& u, int wr, int wc, int fr_, int fq_, PG8_LAS unsigned char*) const {
        int t_ = threadIdx.x; asm volatile("" : "+v"(t_));
        const int fr = t_ & 15, fq = (t_ >> 4) & 3; const bool odd = fr & 1;
        const int rowe = u.pm * BM + wr * 64 + (fr & ~1), colp = u.pn * BM + wc * 64 + 8 * fq + (odd ? 32 : 0);
#pragma unroll
        for (int ai = 0; ai < 2; ++ai)
#pragma unroll
            for (int m = 0; m < 4; ++m) { u32x4 w0, w1, dA, dB;
                { const f32x4 v0 = acc[ai][0][m][0], v1 = acc[ai][0][m][1]; w0.x = cvt_pk_bf16(v0[0], v0[1]); w0.y = cvt_pk_bf16(v0[2], v0[3]); w0.z = cvt_pk_bf16(v1[0], v1[1]); w0.w = cvt_pk_bf16(v1[2], v1[3]); }
                { const f32x4 v0 = acc[ai][1][m][0], v1 = acc[ai][1][m][1]; w1.x = cvt_pk_bf16(v0[0], v0[1]); w1.y = cvt_pk_bf16(v0[2], v0[3]); w1.z = cvt_pk_bf16(v1[0], v1[1]); w1.w = cvt_pk_bf16(v1[2], v1[3]); }
                qswap_pieces(w0, w1, odd, dA, dB);
                bf16_t* p = O + (size_t)(rowe + ai * HALF + m * 16) * ldc + colp;
                if (NT_OUT & 1) { __builtin_nontemporal_store(dA, (u32x4*)p); __builtin_nontemporal_store(dB, (u32x4*)(p + ldc)); } else { *(u32x4*)p = dA; *(u32x4*)(p + ldc) = dB; } }
    }
};

struct EpiNone {
    static constexpr bool PERM = true, AFTER_DRAIN = false;
    __device__ __forceinline__ void operator()(const f32x4 (&acc)[2][2][4][2], const Unit& u, int wr, int wc, int fr, int fq, PG8_LAS unsigned char*) const {
#pragma unroll
        for (int ai = 0; ai < 2; ++ai)
#pragma unroll
            for (int bj = 0; bj < 2; ++bj)
#pragma unroll
                for (int m = 0; m < 4; ++m)
#pragma unroll
                    for (int n = 0; n < 2; ++n) asm volatile("" :: "v"(acc[ai][bj][m][n]));
    }
};
struct EpiResA {
    static constexpr bool PERM = true, AFTER_DRAIN = false;
    const float* R; bf16_t* XB; float* slab;
    __device__ __forceinline__ void operator()(const f32x4 (&acc)[2][2][4][2], const Unit& u, int wr, int wc, int fr_, int fq_, PG8_LAS unsigned char*) const {
        int t_ = threadIdx.x; asm volatile("" : "+v"(t_));
        const int fr = t_ & 15, fq = (t_ >> 4) & 3;
        const int row0 = u.pm * BM + wr * 64 + fr, col0 = u.pn * BM + wc * 32 + 8 * fq;
#pragma unroll
        for (int ai = 0; ai < 2; ++ai) {
            f32x4 r[4][2][2];
#pragma unroll
            for (int m = 0; m < 4; ++m)
#pragma unroll
                for (int bj = 0; bj < 2; ++bj) { const float* p = R + (size_t)(row0 + ai * HALF + m * 16) * DM + col0 + bj * HALF; r[m][bj][0] = *(const f32x4*)p; r[m][bj][1] = *(const f32x4*)(p + 4); }
#pragma unroll
            for (int m = 0; m < 4; ++m) { const int row = row0 + ai * HALF + m * 16; float ss = 0.f;
#pragma unroll
                for (int bj = 0; bj < 2; ++bj) { const f32x4 v0 = acc[ai][bj][m][0] + r[m][bj][0], v1 = acc[ai][bj][m][1] + r[m][bj][1];
                    u32x4 w; w.x = cvt_pk_bf16(v0[0], v0[1]); w.y = cvt_pk_bf16(v0[2], v0[3]); w.z = cvt_pk_bf16(v1[0], v1[1]); w.w = cvt_pk_bf16(v1[2], v1[3]);
                    *(u32x4*)(XB + (size_t)row * DM + col0 + bj * HALF) = w;
                    ss += (v0[0] * v0[0] + v0[1] * v0[1]) + (v0[2] * v0[2] + v0[3] * v0[3]) + (v1[0] * v1[0] + v1[1] * v1[1]) + (v1[2] * v1[2] + v1[3] * v1[3]); }
                ss += __shfl_xor(ss, 16); ss += __shfl_xor(ss, 32);
                if (fq == 0) slab[(size_t)row * 32 + u.pn * 4 + wc] = ss; }
            asm volatile("" ::: "memory"); }
    }
};
struct EpiResB {
    static constexpr bool PERM = true, AFTER_DRAIN = false;
    const bf16_t* RB; float* X; float* slab;
    __device__ __forceinline__ void operator()(const f32x4 (&acc)[2][2][4][2], const Unit& u, int wr, int wc, int fr_, int fq_, PG8_LAS unsigned char*) const {
        int t_ = threadIdx.x; asm volatile("" : "+v"(t_));
        const int fr = t_ & 15, fq = (t_ >> 4) & 3;
        const int row0 = u.pm * BM + wr * 64 + fr, col0 = u.pn * BM + wc * 32 + 8 * fq;
        u32x4 r[2][4][2];
#pragma unroll
        for (int ai = 0; ai < 2; ++ai)
#pragma unroll
            for (int m = 0; m < 4; ++m)
#pragma unroll
                for (int bj = 0; bj < 2; ++bj) r[ai][m][bj] = *(const u32x4*)(RB + (size_t)(row0 + ai * HALF + m * 16) * DM + col0 + bj * HALF);
#pragma unroll
        for (int ai = 0; ai < 2; ++ai)
#pragma unroll
            for (int m = 0; m < 4; ++m) { const int row = row0 + ai * HALF + m * 16; float ss = 0.f;
#pragma unroll
                for (int bj = 0; bj < 2; ++bj) { const u32x4 q = r[ai][m][bj];
                    const f32x4 r0 = {__builtin_bit_cast(float, q.x << 16), __builtin_bit_cast(float, q.x & 0xffff0000u), __builtin_bit_cast(float, q.y << 16), __builtin_bit_cast(float, q.y & 0xffff0000u)};
                    const f32x4 r1 = {__builtin_bit_cast(float, q.z << 16), __builtin_bit_cast(float, q.z & 0xffff0000u), __builtin_bit_cast(float, q.w << 16), __builtin_bit_cast(float, q.w & 0xffff0000u)};
                    const f32x4 v0 = acc[ai][bj][m][0] + r0, v1 = acc[ai][bj][m][1] + r1;
                    float* xp = X + (size_t)row * DM + col0 + bj * HALF; *(f32x4*)xp = v0; *(f32x4*)(xp + 4) = v1;
                    ss += (v0[0] * v0[0] + v0[1] * v0[1]) + (v0[2] * v0[2] + v0[3] * v0[3]) + (v1[0] * v1[0] + v1[1] * v1[1]) + (v1[2] * v1[2] + v1[3] * v1[3]); }
                ss += __shfl_xor(ss, 16); ss += __shfl_xor(ss, 32);
                if (fq == 0) slab[(size_t)row * 32 + u.pn * 4 + wc] = ss; }
    }
};

struct PanelOrder {
    int G, vcu, ntot;
    __device__ __forceinline__ bool next(int i, Unit& u) const { const int L = i * G + vcu; if (L >= ntot) return false; u.pm = L >> 3; u.pn = L & 7; return true; }
    __device__ __forceinline__ void a_ready(const Unit&) const {}
    __device__ __forceinline__ void done(const Unit&) const {}
};
template <int MODE  > struct EpiNorm {
    static constexpr bool PERM = (MODE == 0), AFTER_DRAIN = false;
    const float* Rf; const bf16_t* Rb; const float* sig_in; float* sig_out; bf16_t* HN; float* OUT; const float* gfin; unsigned* xbuf; unsigned* cnt; unsigned* tmo;
    __device__ __forceinline__ void operator()(f32x4 (&acc)[2][2][4][2], const Unit& u, int wr, int wc, int fr_, int fq_, PG8_LAS unsigned char* xlds) const {
        int t_ = threadIdx.x; asm volatile("" : "+v"(t_));
        const int fr = t_ & 15, fq = (t_ >> 4) & 3, wid = __builtin_amdgcn_readfirstlane(t_ >> 6);
        const int rl0 = wr * 64 + fr, row0 = u.pm * BM + rl0, col0 = u.pn * BM + wc * 64 + 8 * fq;
        PG8_LAS float* Pt = (PG8_LAS float*)xlds;
        PG8_LAS float* St = (PG8_LAS float*)(xlds + 4096);
        if constexpr (MODE == 0) {
            f32x4 gi[2][2];
#pragma unroll
            for (int bj = 0; bj < 2; ++bj) { gi[bj][0] = *(const f32x4*)(gfin + col0 + bj * 32); gi[bj][1] = *(const f32x4*)(gfin + col0 + bj * 32 + 4); }
#pragma unroll
            for (int ai = 0; ai < 2; ++ai) { u32x4 r[4][2]; float sg[4];
#pragma unroll
                for (int m = 0; m < 4; ++m) { sg[m] = sig_in[row0 + ai * HALF + m * 16];
#pragma unroll
                    for (int bj = 0; bj < 2; ++bj) r[m][bj] = __builtin_nontemporal_load((const u32x4*)(Rb + (size_t)(row0 + ai * HALF + m * 16) * DM + col0 + bj * 32)); }
#pragma unroll
                for (int m = 0; m < 4; ++m) { float ss = 0.f; const float sgm = sg[m];
#pragma unroll
                    for (int bj = 0; bj < 2; ++bj) { const u32x4 q = r[m][bj];
                        const f32x4 r0 = {__builtin_bit_cast(float, q.x << 16), __builtin_bit_cast(float, q.x & 0xffff0000u), __builtin_bit_cast(float, q.y << 16), __builtin_bit_cast(float, q.y & 0xffff0000u)};
                        const f32x4 r1 = {__builtin_bit_cast(float, q.z << 16), __builtin_bit_cast(float, q.z & 0xffff0000u), __builtin_bit_cast(float, q.w << 16), __builtin_bit_cast(float, q.w & 0xffff0000u)};
                        const f32x4 v0 = acc[ai][bj][m][0] + r0 * gi[bj][0] * sgm, v1 = acc[ai][bj][m][1] + r1 * gi[bj][1] * sgm; acc[ai][bj][m][0] = v0; acc[ai][bj][m][1] = v1;
                        ss += (v0[0] * v0[0] + v0[1] * v0[1]) + (v0[2] * v0[2] + v0[3] * v0[3]) + (v1[0] * v1[0] + v1[1] * v1[1]) + (v1[2] * v1[2] + v1[3] * v1[3]); }
                    ss += __shfl_xor(ss, 16); ss += __shfl_xor(ss, 32);
                    if (fq == 0) Pt[(ai * HALF + rl0 + m * 16) * 4 + wc] = ss; }
                asm volatile("" ::: "memory"); }
        } else { u32x2 r[2][4][2][2]; float sg[2][4]; const int colb = u.pn * BM + wc * 32 + 4 * fq;
#pragma unroll
            for (int ai = 0; ai < 2; ++ai)
#pragma unroll
                for (int m = 0; m < 4; ++m) { sg[ai][m] = sig_in[row0 + ai * HALF + m * 16];
#pragma unroll
                    for (int bj = 0; bj < 2; ++bj)
#pragma unroll
                        for (int n = 0; n < 2; ++n) r[ai][m][bj][n] = __builtin_nontemporal_load((const u32x2*)(Rb + (size_t)(row0 + ai * HALF + m * 16) * DM + colb + bj * HALF + 16 * n)); }
#pragma unroll
            for (int ai = 0; ai < 2; ++ai)
#pragma unroll
                for (int m = 0; m < 4; ++m) { float ss = 0.f; const float sgm = sg[ai][m];
#pragma unroll
                    for (int bj = 0; bj < 2; ++bj)
#pragma unroll
                        for (int n = 0; n < 2; ++n) { const u32x2 q = r[ai][m][bj][n];
                            const f32x4 r0 = {__builtin_bit_cast(float, q.x << 16), __builtin_bit_cast(float, q.x & 0xffff0000u), __builtin_bit_cast(float, q.y << 16), __builtin_bit_cast(float, q.y & 0xffff0000u)};
                            const f32x4 v0 = acc[ai][bj][m][n] + r0 * sgm; acc[ai][bj][m][n] = v0;
                            ss += (v0[0] * v0[0] + v0[1] * v0[1]) + (v0[2] * v0[2] + v0[3] * v0[3]); }
                    ss += __shfl_xor(ss, 16); ss += __shfl_xor(ss, 32);
                    if (fq == 0) Pt[(ai * HALF + rl0 + m * 16) * 4 + wc] = ss; } }
        asm volatile("s_waitcnt lgkmcnt(0)" ::: "memory"); __builtin_amdgcn_s_barrier(); asm volatile("" ::: "memory");
        if (t_ < 256) { const float s = (Pt[t_ * 4 + 0] + Pt[t_ * 4 + 1]) + (Pt[t_ * 4 + 2] + Pt[t_ * 4 + 3]);
            __hip_atomic_store(xbuf + (size_t)(u.pm * BM + t_) * 8 + u.pn, __builtin_bit_cast(unsigned, s), __ATOMIC_RELAXED, __HIP_MEMORY_SCOPE_AGENT); }
        asm volatile("s_waitcnt vmcnt(0)" ::: "memory");
        if (t_ < 256 && (t_ & 63) == 0) __hip_atomic_fetch_add(cnt + 64 * u.pm, 1u, __ATOMIC_RELAXED, __HIP_MEMORY_SCOPE_AGENT);
        if (wid == 0) {
            unsigned spins = 0;
            while ((unsigned)__builtin_amdgcn_readfirstlane(__hip_atomic_load(cnt + 64 * u.pm, __ATOMIC_RELAXED, __HIP_MEMORY_SCOPE_AGENT)) < 32u) {
                __builtin_amdgcn_s_sleep(2);
                if (++spins > (1u << 20)) { if ((t_ & 63) == 0) __hip_atomic_store(tmo, 1u, __ATOMIC_RELAXED, __HIP_MEMORY_SCOPE_AGENT); break; } }
#if XCHG_ACQUIRE
            __builtin_amdgcn_fence(__ATOMIC_ACQUIRE, "agent");
#endif
        }
        asm volatile("s_waitcnt vmcnt(0) lgkmcnt(0)" ::: "memory"); __builtin_amdgcn_s_barrier(); asm volatile("" ::: "memory");
        if (t_ < 256) { const unsigned long long* sp = (const unsigned long long*)(xbuf + (size_t)(u.pm * BM + t_) * 8); float tot = 0.f;
#pragma unroll
            for (int q = 0; q < 4; ++q) { const unsigned long long w = __hip_atomic_load(sp + q, __ATOMIC_RELAXED, __HIP_MEMORY_SCOPE_AGENT);
                tot += __builtin_bit_cast(float, (unsigned)w); tot += __builtin_bit_cast(float, (unsigned)(w >> 32)); }
            const float sd = sqrtf(tot * (1.0f / DM) + RMS_EPS);
            St[t_] = 1.0f / sd;
            if (MODE == 0 && u.pn == 0) sig_out[u.pm * BM + t_] = sd; }
        asm volatile("s_waitcnt lgkmcnt(0)" ::: "memory"); __builtin_amdgcn_s_barrier(); asm volatile("" ::: "memory");
        if constexpr (MODE == 0) {
            const bool odd = fr & 1;
#pragma unroll
            for (int ai = 0; ai < 2; ++ai)
#pragma unroll
                for (int m = 0; m < 4; ++m) { const float rstd = St[ai * HALF + rl0 + m * 16]; u32x4 w0, w1, dA, dB;
                    { const f32x4 v0 = acc[ai][0][m][0] * rstd, v1 = acc[ai][0][m][1] * rstd; w0.x = cvt_pk_bf16(v0[0], v0[1]); w0.y = cvt_pk_bf16(v0[2], v0[3]); w0.z = cvt_pk_bf16(v1[0], v1[1]); w0.w = cvt_pk_bf16(v1[2], v1[3]); }
                    { const f32x4 v0 = acc[ai][1][m][0] * rstd, v1 = acc[ai][1][m][1] * rstd; w1.x = cvt_pk_bf16(v0[0], v0[1]); w1.y = cvt_pk_bf16(v0[2], v0[3]); w1.z = cvt_pk_bf16(v1[0], v1[1]); w1.w = cvt_pk_bf16(v1[2], v1[3]); }
                    qswap_pieces(w0, w1, odd, dA, dB);
                    bf16_t* p = HN + (size_t)((row0 & ~1) + ai * HALF + m * 16) * DM + col0 + (odd ? 32 : 0);
                    if (NT_OUT & 2) { __builtin_nontemporal_store(dA, (u32x4*)p); __builtin_nontemporal_store(dB, (u32x4*)(p + DM)); } else { *(u32x4*)p = dA; *(u32x4*)(p + DM) = dB; } }
        } else {
            const int colb = u.pn * BM + wc * 32 + 4 * fq; const bool odd = fr & 1;
            f32x4 gg[2][2];
#pragma unroll
            for (int bj = 0; bj < 2; ++bj)
#pragma unroll
                for (int n = 0; n < 2; ++n) gg[bj][n] = *(const f32x4*)(gfin + colb + bj * HALF + 16 * n);
#pragma unroll
            for (int ai = 0; ai < 2; ++ai)
#pragma unroll
                for (int m = 0; m < 4; ++m) { const float rstd = St[ai * HALF + rl0 + m * 16]; float* op = OUT + (size_t)(row0 + ai * HALF + m * 16) * DM + colb;
#pragma unroll
                    for (int bj = 0; bj < 2; ++bj) {
                        const f32x4 o0 = acc[ai][bj][m][0] * rstd * gg[bj][0], o1 = acc[ai][bj][m][1] * rstd * gg[bj][1]; f32x4 dA, dB;
#pragma unroll
                        for (int j = 0; j < 4; ++j) { const float snd = odd ? o0[j] : o1[j];
                            const float rcv = __builtin_bit_cast(float, __builtin_amdgcn_mov_dpp(__builtin_bit_cast(int, snd), 0xB1, 0xf, 0xf, false));
                            dA[j] = odd ? rcv : o0[j]; dB[j] = odd ? o1[j] : rcv; }
                        float* pp = op + bj * HALF + (odd ? 16 : 0);
                        __builtin_nontemporal_store(dA, (f32x4*)(pp - (odd ? DM : 0))); __builtin_nontemporal_store(dB, (f32x4*)(pp + (odd ? 0 : DM))); } }
        }
    }
};

__device__ __forceinline__ float dpp_shr1(float old, float src) { return __builtin_bit_cast(float, __builtin_amdgcn_update_dpp(__builtin_bit_cast(int, old), __builtin_bit_cast(int, src), 0x111, 0xf, 0xf, false)); }
__device__ __forceinline__ float dpp_shr2(float old, float src) { return __builtin_bit_cast(float, __builtin_amdgcn_update_dpp(__builtin_bit_cast(int, old), __builtin_bit_cast(int, src), 0x112, 0xf, 0xf, false)); }
__device__ __forceinline__ float dpp_ror1(float src) { return __builtin_bit_cast(float, __builtin_amdgcn_mov_dpp(__builtin_bit_cast(int, src), 0x121, 0xf, 0xf, false)); }
__device__ __forceinline__ float dpp_ror2(float src) { return __builtin_bit_cast(float, __builtin_amdgcn_mov_dpp(__builtin_bit_cast(int, src), 0x122, 0xf, 0xf, false)); }
constexpr int FF = 5632, FF2 = 11264;
typedef _Float16 h2_t __attribute__((ext_vector_type(2)));
__device__ __forceinline__ unsigned pkh(float a, float b) { return __builtin_bit_cast(unsigned, __builtin_amdgcn_cvt_pkrtz(a, b)); }
__device__ __forceinline__ unsigned dppu_shr1(unsigned old, unsigned src) { return (unsigned)__builtin_amdgcn_update_dpp((int)old, (int)src, 0x111, 0xf, 0xf, false); }
__device__ __forceinline__ unsigned dppu_shr2(unsigned old, unsigned src) { return (unsigned)__builtin_amdgcn_update_dpp((int)old, (int)src, 0x112, 0xf, 0xf, false); }
__device__ __forceinline__ unsigned dppu_ror1(unsigned src) { return (unsigned)__builtin_amdgcn_mov_dpp((int)src, 0x121, 0xf, 0xf, false); }
__device__ __forceinline__ unsigned dppu_ror2(unsigned src) { return (unsigned)__builtin_amdgcn_mov_dpp((int)src, 0x122, 0xf, 0xf, false); }
struct EpiAct {
    static constexpr bool PERM = true, AFTER_DRAIN = false;
    bf16_t* ACT; const float* cw; const float* cb; float* ubnd;
    __device__ __forceinline__ void operator()(f32x4 (&acc)[2][2][4][2], const Unit& u, int wr, int wc, int fr_, int fq_, PG8_LAS unsigned char* xlds) const {
        int t_ = threadIdx.x; asm volatile("" : "+v"(t_));
        const int fr = t_ & 15, fq = (t_ >> 4) & 3;
        const int row0 = u.pm * BM + wr * 64 + fr, cl = wc * 32 + 8 * fq;
        const int c0 = u.pn * 128 + cl;
        f32x4 wgt[2][8];
#pragma unroll
        for (int n = 0; n < 2; ++n) { const float* wp = cw + c0 + 4 * n; const float* bp = cb + c0 + 4 * n;
            wgt[n][0] = *(const f32x4*)wp; wgt[n][1] = *(const f32x4*)(wp + FF2); wgt[n][2] = *(const f32x4*)(wp + 2 * FF2); wgt[n][3] = *(const f32x4*)bp;
            wgt[n][4] = *(const f32x4*)(wp + FF); wgt[n][5] = *(const f32x4*)(wp + FF2 + FF); wgt[n][6] = *(const f32x4*)(wp + 2 * FF2 + FF); wgt[n][7] = *(const f32x4*)(bp + FF); }
        if (wr == 1 && fr >= 14) {
#pragma unroll
            for (int bj = 0; bj < 2; ++bj)
#pragma unroll
                for (int n = 0; n < 2; ++n) *(f32x4*)(ubnd + (size_t)(u.pm * 4 + 2 + (fr - 14)) * FF2 + u.pn * BM + 64 * wc + 32 * bj + 8 * fq + 4 * n) = acc[1][bj][3][n]; }
        if (wr == 0 && fr < 2) {
#pragma unroll
            for (int bj = 0; bj < 2; ++bj)
#pragma unroll
                for (int n = 0; n < 2; ++n) *(f32x4*)(ubnd + (size_t)(u.pm * 4 + fr) * FF2 + u.pn * BM + 64 * wc + 32 * bj + 8 * fq + 4 * n) = acc[0][bj][0][n]; }
        u32x4 pk[2][4][2];
#pragma unroll
        for (int ai = 0; ai < 2; ++ai)
#pragma unroll
            for (int m = 0; m < 4; ++m)
#pragma unroll
                for (int n = 0; n < 2; ++n) { const f32x4 g = acc[ai][0][m][n], v = acc[ai][1][m][n]; pk[ai][m][n] = (u32x4){pkh(g[0], v[0]), pkh(g[1], v[1]), pkh(g[2], v[2]), pkh(g[3], v[3])}; }
        if (fr >= 14) {
#pragma unroll
            for (int ai = 0; ai < 2; ++ai)
#pragma unroll
                for (int n = 0; n < 2; ++n) *(PG8_LAS u32x4*)(xlds + ((((2 * ai + wr) * 2 + (fr - 14)) * 128 + cl + 4 * n) << 2)) = pk[ai][3][n]; }
        asm volatile("s_waitcnt lgkmcnt(0)" ::: "memory"); __builtin_amdgcn_s_barrier(); asm volatile("" ::: "memory");
        u32x2 hold[2][4];
#pragma unroll
        for (int n = 0; n < 2; ++n) {
            h2_t w0p[4], w1p[4], w2p[4], bp4[4];
#pragma unroll
            for (int j = 0; j < 4; ++j) { w0p[j] = __builtin_bit_cast(h2_t, pkh(wgt[n][0][j], wgt[n][4][j])); w1p[j] = __builtin_bit_cast(h2_t, pkh(wgt[n][1][j], wgt[n][5][j]));
                w2p[j] = __builtin_bit_cast(h2_t, pkh(wgt[n][2][j], wgt[n][6][j])); bp4[j] = __builtin_bit_cast(h2_t, pkh(wgt[n][3][j], wgt[n][7][j])); }
#pragma unroll
            for (int ai = 0; ai < 2; ++ai) {
                const int chunk = 2 * ai + wr;
                u32x4 pp = {0u, 0u, 0u, 0u};
                if (chunk > 0) pp = *(const PG8_LAS u32x4*)(xlds + ((((chunk - 1) * 2 + (fr & 1)) * 128 + cl + 4 * n) << 2));
#pragma unroll
                for (int m = 0; m < 4; ++m) {
                    const u32x4 cur = pk[ai][m][n]; float a[4];
#pragma unroll
                    for (int j = 0; j < 4; ++j) {
                        const unsigned cj = cur[j], pj = pp[j];
                        const h2_t s1 = __builtin_bit_cast(h2_t, dppu_shr1(dppu_ror1(pj), cj)), s2 = __builtin_bit_cast(h2_t, dppu_shr2(dppu_ror2(pj), cj)), ch = __builtin_bit_cast(h2_t, cj);
                        const h2_t r = w2p[j] * ch + (w1p[j] * s1 + (w0p[j] * s2 + bp4[j]));
                        const float G = (float)r.x, V = (float)r.y;
                        a[j] = G * __builtin_amdgcn_rcpf(1.0f + __builtin_amdgcn_exp2f(-1.4426950408889634f * G)) * V; }
                    u32x2 w; w.x = cvt_pk_bf16(a[0], a[1]); w.y = cvt_pk_bf16(a[2], a[3]);
                    if (n == 0) hold[ai][m] = w;
                    else { u32x4 o; o.x = hold[ai][m].x; o.y = hold[ai][m].y; o.z = w.x; o.w = w.y;
                        if (!(ai == 0 && m == 0 && wr == 0 && u.pm > 0 && fr < 2)) { if (NT_OUT & 4) __builtin_nontemporal_store(o, (u32x4*)(ACT + (size_t)(row0 + ai * HALF + m * 16) * FF + c0)); else *(u32x4*)(ACT + (size_t)(row0 + ai * HALF + m * 16) * FF + c0) = o; } }
                    pp = cur;
                }
            }
        }
    }
};

template <class Epi, class Sched, bool ALIGN_EPI = false, bool SP2 = false>
__device__ __forceinline__ void gemm_phase(PG8_LAS unsigned char* lds, const Gemm g, const Sched& S, const Epi& E, PG8_LAS unsigned char* xlds) {
    const int tid = threadIdx.x, wid = __builtin_amdgcn_readfirstlane(tid >> 6), lane = tid & 63, wr = wid >> 2, wc = wid & 3, fr = lane & 15, fq = lane >> 4;
    const int K = g.K, nt = K / BK;
    unsigned voffA[2], voffB[2], voffB1[2];
#pragma unroll
    for (int i = 0; i < 2; ++i) { int R, C; stage_rc(tid * 16 + i * 8192, R, C); const int Rb0 = Epi::PERM ? (64 * (R >> 5) + perm32(R & 31)) : R, Rb1 = Epi::PERM ? Rb0 + 32 : R + HALF;
        voffA[i] = (unsigned)(R * K + C) * 2u; voffB[i] = (unsigned)(Rb0 * K + C) * 2u; voffB1[i] = (unsigned)(Rb1 * K + C) * 2u; }
    const size_t kstep = (size_t)(BK * 2);
    const size_t hstep = (size_t)HALF * K * 2;
    const size_t tstep = 2 * hstep;
    const unsigned ldsw = (unsigned)wid * 1024u;
    const int aoff = lds_byte(wr * 64 + fr, fq * 8), boff = lds_byte(wc * 32 + fr, fq * 8);
#define PG8_SA(b, h) (((b) * 2 + (h)) * HTB)
#define PG8_SB(b, h) ((4 + (b) * 2 + (h)) * HTB)
#define PG8_STAGE(bufoff, gbase, voff) do { _Pragma("unroll") for (int _i = 0; _i < 2; ++_i) \
        __builtin_amdgcn_global_load_lds((const unsigned*)((const char*)(gbase) + (voff)[_i]), (PG8_LAS unsigned*)(lds + (bufoff) + ldsw + _i * 8192), 16, 0, 0); } while (0)
#define PG8_LDA(dst, b, h) do { _Pragma("unroll") for (int m = 0; m < 4; ++m) _Pragma("unroll") for (int k = 0; k < 2; ++k) dst[m][k] = *(const PG8_LAS bf16x8*)(lds + PG8_SA(b, h) + aoff + m * 2048 + k * 1024); } while (0)
#define PG8_LDB(dst, b, h) do { _Pragma("unroll") for (int n = 0; n < 2; ++n) _Pragma("unroll") for (int k = 0; k < 2; ++k) dst[n][k] = *(const PG8_LAS bf16x8*)(lds + PG8_SB(b, h) + boff + n * 2048 + k * 1024); } while (0)
#define PG8_MMA(ai, bj, At, Bt) do { __builtin_amdgcn_s_setprio(PG8_PRIO); _Pragma("unroll") for (int m = 0; m < 4; ++m) _Pragma("unroll") for (int n = 0; n < 2; ++n) _Pragma("unroll") for (int k = 0; k < 2; ++k) \
        acc[ai][bj][m][n] = __builtin_amdgcn_mfma_f32_16x16x32_bf16(Bt[n][k], At[m][k], acc[ai][bj][m][n], 0, 0, 0); __builtin_amdgcn_s_setprio(0); } while (0)
#define PG8_WAIT_V(n) asm volatile("s_waitcnt vmcnt(" #n ")" ::: "memory")
#define PG8_WAIT_L(n) asm volatile("s_waitcnt lgkmcnt(" #n ")" ::: "memory")
#define PG8_BAR __builtin_amdgcn_s_barrier()
#define PG8_SCHED __builtin_amdgcn_sched_barrier(0)
    Unit cur, nxt; int ui = 0;
    if (!S.next(0, cur)) return;
    f32x4 acc[2][2][4][2];
#pragma unroll
    for (int a = 0; a < 2; ++a)
#pragma unroll
        for (int b = 0; b < 2; ++b)
#pragma unroll
            for (int m = 0; m < 4; ++m)
#pragma unroll
                for (int n = 0; n < 2; ++n) acc[a][b][m][n] = (f32x4){0.f, 0.f, 0.f, 0.f};
    bf16x8 At[4][2], B0[2][2], B1[2][2];
    const char* cA = (const char*)g.A + (size_t)cur.pm * tstep; const char* cB = (const char*)g.Bt + (size_t)cur.pn * tstep;
    S.a_ready(cur);
    if constexpr (SP2) {
        PG8_STAGE(PG8_SB(0, 0), cB, voffB); PG8_STAGE(PG8_SB(0, 1), cB, voffB1); PG8_STAGE(PG8_SA(0, 0), cA, voffA); PG8_STAGE(PG8_SA(0, 1), cA + hstep, voffA);
        if (wr == 1) PG8_BAR;
        PG8_WAIT_V(2); PG8_BAR;
        PG8_STAGE(PG8_SB(1, 0), cB + kstep, voffB); PG8_STAGE(PG8_SA(1, 0), cA + kstep, voffA); PG8_STAGE(PG8_SB(1, 1), cB + kstep, voffB1);
        PG8_WAIT_V(6); PG8_BAR;
    } else {
        PG8_STAGE(PG8_SB(0, 0), cB, voffB); PG8_STAGE(PG8_SA(0, 0), cA, voffA); PG8_STAGE(PG8_SB(0, 1), cB, voffB1); PG8_STAGE(PG8_SA(0, 1), cA + hstep, voffA);
        if (wr == 1) PG8_BAR;
        PG8_WAIT_V(4); PG8_BAR;
        PG8_STAGE(PG8_SB(1, 0), cB + kstep, voffB); PG8_STAGE(PG8_SA(1, 0), cA + kstep, voffA); PG8_STAGE(PG8_SB(1, 1), cB + kstep, voffB1);
        PG8_WAIT_V(6); PG8_BAR;
    }
    for (;;) {
        const bool has_next = S.next(ui + 1, nxt);
        const char* nA = has_next ? (const char*)g.A + (size_t)nxt.pm * tstep : cA; const char* nB = has_next ? (const char*)g.Bt + (size_t)nxt.pn * tstep : cB;
        for (int t = 0; t < nt; t += 2) {
            const bool last = (t == nt - 2);
            const char* a1 = cA + (size_t)(t + 1) * kstep;
            const char* a2 = last ? nA : cA + (size_t)(t + 2) * kstep; const char* b2 = last ? nB : cB + (size_t)(t + 2) * kstep;
            const char* a3 = a2 + kstep; const char* b3 = b2 + kstep;
            if (last && has_next) S.a_ready(nxt);
            if constexpr (SP2) {
            PG8_LDB(B0, 0, 0); PG8_LDB(B1, 0, 1); PG8_SCHED; PG8_LDA(At, 0, 0); PG8_STAGE(PG8_SA(1, 1), a1 + hstep, voffA);
            PG8_WAIT_V(8); PG8_WAIT_L(0); PG8_BAR; PG8_MMA(0, 0, At, B0); PG8_MMA(0, 1, At, B1); PG8_BAR; PG8_SCHED;
            PG8_LDA(At, 0, 1); PG8_STAGE(PG8_SB(0, 0), b2, voffB); PG8_STAGE(PG8_SB(0, 1), b2, voffB1); PG8_STAGE(PG8_SA(0, 0), a2, voffA);
            PG8_WAIT_V(8); PG8_WAIT_L(0); PG8_BAR; PG8_MMA(1, 0, At, B0); PG8_MMA(1, 1, At, B1); PG8_BAR; PG8_SCHED;
            PG8_LDB(B0, 1, 0); PG8_LDB(B1, 1, 1); PG8_SCHED; PG8_LDA(At, 1, 0); PG8_STAGE(PG8_SA(0, 1), a2 + hstep, voffA);
            PG8_WAIT_V(8); PG8_WAIT_L(0); PG8_BAR; PG8_MMA(0, 0, At, B0); PG8_MMA(0, 1, At, B1); PG8_BAR; PG8_SCHED;
            PG8_LDA(At, 1, 1); PG8_STAGE(PG8_SB(1, 0), b3, voffB); PG8_STAGE(PG8_SB(1, 1), b3, voffB1); PG8_STAGE(PG8_SA(1, 0), a3, voffA);
            PG8_WAIT_V(8); PG8_WAIT_L(0); PG8_BAR; PG8_MMA(1, 0, At, B0); PG8_MMA(1, 1, At, B1); PG8_BAR; PG8_SCHED;
            } else {
            PG8_LDB(B0, 0, 0); PG8_SCHED; PG8_LDA(At, 0, 0); PG8_STAGE(PG8_SA(1, 1), a1 + hstep, voffA);
            PG8_WAIT_L(8); PG8_BAR; PG8_WAIT_L(0); PG8_MMA(0, 0, At, B0); PG8_BAR; PG8_SCHED;
            PG8_LDB(B1, 0, 1); PG8_STAGE(PG8_SB(0, 0), b2, voffB);
            PG8_BAR; PG8_WAIT_L(0); PG8_MMA(0, 1, At, B1); PG8_BAR;
            PG8_LDA(At, 0, 1); PG8_STAGE(PG8_SA(0, 0), a2, voffA);
            PG8_BAR; PG8_WAIT_L(0); PG8_MMA(1, 0, At, B0); PG8_BAR; PG8_SCHED;
            PG8_STAGE(PG8_SB(0, 1), b2, voffB1);
            PG8_WAIT_V(6); PG8_BAR; PG8_MMA(1, 1, At, B1); PG8_BAR;
            PG8_LDB(B0, 1, 0); PG8_SCHED; PG8_LDA(At, 1, 0); PG8_STAGE(PG8_SA(0, 1), a2 + hstep, voffA);
            PG8_WAIT_L(8); PG8_BAR; PG8_WAIT_L(0); PG8_MMA(0, 0, At, B0); PG8_BAR; PG8_SCHED;
            PG8_LDB(B1, 1, 1); PG8_STAGE(PG8_SB(1, 0), b3, voffB);
            PG8_BAR; PG8_WAIT_L(0); PG8_MMA(0, 1, At, B1); PG8_BAR;
            PG8_LDA(At, 1, 1); PG8_STAGE(PG8_SA(1, 0), a3, voffA);
            PG8_BAR; PG8_WAIT_L(0); PG8_MMA(1, 0, At, B0); PG8_BAR; PG8_SCHED;
            PG8_STAGE(PG8_SB(1, 1), b3, voffB1);
            PG8_WAIT_V(6); PG8_BAR; PG8_MMA(1, 1, At, B1); PG8_BAR;
            }
        }
        if constexpr (ALIGN_EPI) { if (wr == 0) PG8_BAR; }
        if constexpr (!Epi::AFTER_DRAIN) { E(acc, cur, wr, wc, fr, fq, xlds); S.done(cur); }
        if (!has_next) break;
#pragma unroll
        for (int a = 0; a < 2; ++a)
#pragma unroll
            for (int b = 0; b < 2; ++b)
#pragma unroll
                for (int m = 0; m < 4; ++m)
#pragma unroll
                    for (int n = 0; n < 2; ++n) acc[a][b][m][n] = (f32x4){0.f, 0.f, 0.f, 0.f};
        cur = nxt; cA = nA; cB = nB; ++ui;
        if constexpr (ALIGN_EPI) { if (wr == 1) PG8_BAR; }
    }
    PG8_WAIT_V(0);
    if constexpr (!ALIGN_EPI) { if (wr == 0) PG8_BAR; }
    PG8_BAR;

#undef PG8_SA
#undef PG8_SB
#undef PG8_STAGE
#undef PG8_LDA
#undef PG8_LDB
#undef PG8_MMA
#undef PG8_WAIT_V
#undef PG8_WAIT_L
#undef PG8_BAR
#undef PG8_SCHED
}
}

#define GAS __attribute__((address_space(1)))
#define LAS __attribute__((address_space(3)))
typedef unsigned short bf16;
typedef float f32x4 __attribute__((ext_vector_type(4)));
typedef short bf16x8 __attribute__((ext_vector_type(8)));
typedef unsigned u32x4 __attribute__((ext_vector_type(4)));
typedef unsigned u32x2 __attribute__((ext_vector_type(2)));

constexpr int NWAVES = 8;
constexpr int SEQ = 16384, DMODEL = 2048, NMEM = 256, DIN = 3584, DCONV = 768, DPOOL = 768, DXATT = 512, DFF = 5632, DFF2 = 11264;
constexpr int PGD = 192;
constexpr float EPS = 1e-6f;
constexpr int LDS_BYTES = 147456;
#ifndef MK_PER_PHASE
#define MK_PER_PHASE 0
#endif
constexpr int NPHASE = 7;
#ifndef PHM
#define PHM 255
#endif
#ifndef FUSE_FIXUP
#define FUSE_FIXUP 0
#endif
#ifndef P1_WGM
#define P1_WGM 4
#endif
#ifndef P4_WGM
#define P4_WGM 4
#endif
#ifndef P1_ALIGN
#define P1_ALIGN false
#endif
#ifndef USE_CG_SYNC
#define USE_CG_SYNC 0
#endif
#ifndef PROBE_P2
#define PROBE_P2 0
#endif
#ifndef PROBE_SYNC
#define PROBE_SYNC 0
#endif
#ifndef PROBE_GEMM
#define PROBE_GEMM 0
#endif
#ifndef PROBE_N
#define PROBE_N 2048
#endif
#ifndef REPM
#define REPM 0
#endif

constexpr size_t MiB = 1u << 20;
constexpr size_t WS_KB = 1 * MiB;
constexpr size_t WS_VT = 1 * MiB + 256 * 1024;
constexpr size_t WS_POOLWT = 1 * MiB + 512 * 1024;
constexpr size_t WS_MB = 2 * MiB;
constexpr size_t WS_WKVT = 3 * MiB;
constexpr size_t WS_SIGX = 7 * MiB + 128 * 1024;
constexpr size_t WS_GINV = 7 * MiB + 256 * 1024;
constexpr size_t WS_SIG = 7 * MiB;
constexpr size_t WS_SLAB1 = 8 * MiB;
constexpr size_t WS_SLAB2 = 10 * MiB;
constexpr size_t WS_WUPT = 12 * MiB;
constexpr size_t WS_WDOWNT = 56 * MiB;
constexpr size_t WS_UBND = 80 * MiB;
constexpr size_t WS_X1B = 96 * MiB;
constexpr size_t WS_ACT = 160 * MiB;
constexpr size_t WS_H = 160 * MiB;
constexpr size_t WS_Z = 225 * MiB;
constexpr size_t WS_ZPAD = WS_Z - (size_t)16 * 3584 * 2;
constexpr size_t WS_MIX = 338 * MiB;
constexpr size_t WS_WINT = 402 * MiB;
constexpr size_t WS_WOUTT = 416 * MiB;
constexpr size_t WS_END = 424 * MiB;

__device__ __forceinline__ unsigned f2bf(float f) { unsigned u = __builtin_bit_cast(unsigned, f); return (u + 0x7fffu + ((u >> 16) & 1u)) >> 16; }
__device__ __forceinline__ unsigned pk2(float lo, float hi) { return f2bf(lo) | (f2bf(hi) << 16); }
__device__ __forceinline__ float bflo(unsigned w) { return __builtin_bit_cast(float, w << 16); }
__device__ __forceinline__ float bfhi(unsigned w) { return __builtin_bit_cast(float, w & 0xffff0000u); }
__device__ __forceinline__ void unpack8(const u32x4 w, float (&f)[8]) { f[0] = bflo(w.x); f[1] = bfhi(w.x); f[2] = bflo(w.y); f[3] = bfhi(w.y); f[4] = bflo(w.z); f[5] = bfhi(w.z); f[6] = bflo(w.w); f[7] = bfhi(w.w); }
__device__ __forceinline__ u32x4 pack8(const float (&f)[8]) { u32x4 w; w.x = pk2(f[0], f[1]); w.y = pk2(f[2], f[3]); w.z = pk2(f[4], f[5]); w.w = pk2(f[6], f[7]); return w; }
__device__ __forceinline__ float wave_sum(float v) {
#pragma unroll
    for (int o = 1; o < 64; o <<= 1) v += __shfl_xor(v, o);
    return v;
}
#define LDS_WAIT() asm volatile("s_waitcnt lgkmcnt(0)" ::: "memory")

typedef GAS unsigned gu32;
constexpr size_t WS_CTL = 0, CTL_ZERO_BYTES = 64 * 1024;
constexpr int CW_PANEL2 = 12288;
constexpr int CW_PANEL1 = 8192;
constexpr int CW_PANEL = 4096;
constexpr int MISC_OFF = 131072 + 320;
constexpr int XLDS_OFF = 131072 + 1024;
#define XB_TMO      128
#define XB_XCNT(j)  (256  + 64 * (j))
#define XB_XSUB(j)  (1280 + 64 * (j))
#define XB_XGEN(j)  (2304 + 64 * (j))
#define XB_TOP      3328
#define XB_TOPGEN   3392
#define XCD_BAR_WORDS 3456
#define XB_SPIN_CAP (1u << 18)

__device__ __forceinline__ unsigned xb_ld(unsigned* p)              { return __hip_atomic_load(p, __ATOMIC_RELAXED, __HIP_MEMORY_SCOPE_AGENT); }
__device__ __forceinline__ unsigned xb_add(unsigned* p, unsigned v) { return __hip_atomic_fetch_add(p, v, __ATOMIC_RELAXED, __HIP_MEMORY_SCOPE_AGENT); }
__device__ __forceinline__ unsigned xb_xcc_id() { return (unsigned)__builtin_amdgcn_s_getreg((3 << 11) | 20) & 0xFu; }
#define XB_SPIN(cond, bar) do { unsigned _sp = 0; while (cond) { __builtin_amdgcn_s_sleep(1); \
    if ((++_sp & 255u) == 0u) { if (xb_ld(&(bar)[XB_TMO])) break; if (_sp > XB_SPIN_CAP) { atomicAdd(&(bar)[XB_TMO], 1u); break; } } } } while (0)

struct XcdBarrier {
    unsigned* bar; unsigned x;
    volatile LAS unsigned* st;
};

__device__ __forceinline__ XcdBarrier xcd_barrier_post(unsigned* bar, volatile LAS unsigned* st) {
    XcdBarrier b; b.bar = bar; b.x = xb_xcc_id(); b.st = st;
    if (threadIdx.x == 0) (void)xb_add(&bar[XB_XCNT(b.x)], 1u);
    return b;
}
__device__ __forceinline__ void xcd_barrier_complete(unsigned* bar, unsigned x, unsigned& nloc, unsigned& nx) {
    const unsigned G = gridDim.x * gridDim.y * gridDim.z;
    unsigned sum, cnt, mine, sp = 0u;
    for (;;) {
        sum = 0u; cnt = 0u; mine = 0u;
#pragma unroll
        for (unsigned j = 0; j < 16; ++j) { const unsigned c = xb_ld(&bar[XB_XCNT(j)]); sum += c; cnt += (c > 0u) ? 1u : 0u; mine = (j == x) ? c : mine; }
        if (sum == G) break;
        __builtin_amdgcn_s_sleep(1);
        if ((++sp & 255u) == 0u) { if (xb_ld(&bar[XB_TMO])) break; if (sp > XB_SPIN_CAP) { atomicAdd(&bar[XB_TMO], 1u); break; } }
    }
    nloc = mine > 0u ? mine : 1u; nx = cnt > 0u ? cnt : 1u;
}

__device__ __forceinline__ void xcd_barrier(const XcdBarrier& b) {
    asm volatile("s_waitcnt vmcnt(0)" ::: "memory");
    __syncthreads();
    if (threadIdx.x == 0) {
        unsigned* bar = b.bar;
        __builtin_amdgcn_s_waitcnt(0);
        unsigned nloc = b.st[0], nx = b.st[1];
        if (nloc == 0u) { xcd_barrier_complete(bar, b.x, nloc, nx); b.st[0] = nloc; b.st[1] = nx; }
        const unsigned old = xb_add(&bar[XB_XSUB(b.x)], 1u);
        const unsigned gen = old / nloc;
        if (old + 1u == (gen + 1u) * nloc) {
            __builtin_amdgcn_fence(__ATOMIC_RELEASE, "agent");
            asm volatile("s_waitcnt vmcnt(0)" ::: "memory");
            const unsigned og = xb_add(&bar[XB_TOP], 1u);
            const unsigned tg = og / nx;
            if (og + 1u == (tg + 1u) * nx) xb_add(&bar[XB_TOPGEN], 1u);
            else XB_SPIN(xb_ld(&bar[XB_TOPGEN]) == tg, bar);
            __builtin_amdgcn_fence(__ATOMIC_ACQUIRE, "agent");
            xb_add(&bar[XB_XGEN(b.x)], 1u);
            asm volatile("s_waitcnt vmcnt(0)" ::: "memory");
        } else {
            XB_SPIN(xb_ld(&bar[XB_XGEN(b.x)]) == gen, bar);
            __builtin_amdgcn_fence(__ATOMIC_ACQUIRE, "agent");
            asm volatile("s_waitcnt vmcnt(0)" ::: "memory");
        }
    }
    __syncthreads();
}


struct TrItem { const float* src; const float* ks; bf16* dst; int N, K, skip; };
template <bool UPMAP> __device__ __forceinline__ TrItem tr_make(const float* W, int K, int N, bf16* WT, const float* ks, int item) {
    const int nblk = N / 64, kb = item / nblk, nb = item % nblk, k0 = 64 * kb, n0 = 64 * nb;
    const int np = (n0 < DFF) ? n0 : n0 - DFF;
    const int r0 = !UPMAP ? n0 : 256 * (np / 128) + 64 * ((np % 128) / 32) + ((n0 < DFF) ? 0 : 32);
    TrItem t; t.src = W + (size_t)k0 * N + n0; t.ks = ks ? ks + k0 : nullptr; t.dst = WT + (size_t)r0 * K + k0; t.N = N; t.K = K; t.skip = UPMAP ? 32 : 0; return t;
}
__device__ __forceinline__ void tr_load(const TrItem& t, f32x4 (&v)[16], int lane) {
    const float* src = t.src + (size_t)(lane >> 4) * t.N + 4 * (lane & 15);
#pragma unroll
    for (int i = 0; i < 16; ++i) v[i] = TR_NT ? __builtin_nontemporal_load((const f32x4*)(src + (size_t)(4 * i) * t.N)) : *(const f32x4*)(src + (size_t)(4 * i) * t.N);
}
__device__ __forceinline__ void tr_store(const TrItem& t, const f32x4 (&v)[16], LAS float* scr, int lane) {
#pragma unroll
    for (int i = 0; i < 16; ++i) { f32x4 x = v[i]; if (t.ks) x = x * t.ks[4 * i + (lane >> 4)];
        *(LAS f32x4*)(scr + (4 * i + (lane >> 4)) * 64 + (((lane & 15) ^ ((i >> 1) & 7)) << 2)) = x; }
    LDS_WAIT(); asm volatile("" ::: "memory");
    const int c = lane & 7;
#pragma unroll
    for (int j = 0; j < 8; ++j) { const int nn = (lane >> 3) + 8 * j; const LAS float* sp = scr + (8 * c) * 64 + ((((nn >> 2) ^ c) & 15) << 2) + (nn & 3);
        u32x4 o; o.x = pk2(sp[0 * 64], sp[1 * 64]); o.y = pk2(sp[2 * 64], sp[3 * 64]); o.z = pk2(sp[4 * 64], sp[5 * 64]); o.w = pk2(sp[6 * 64], sp[7 * 64]);
        *(u32x4*)(t.dst + (size_t)(nn + (nn >= 32 ? t.skip : 0)) * t.K + 8 * c) = o; }
    LDS_WAIT(); asm volatile("" ::: "memory");
}
__device__ __forceinline__ void rms_rows2_to_bf16(const float* xa, const float* xb, const float* g, bf16* oa, bf16* ob, int lane, float* sig2 = nullptr) {
    const f32x4* pa = (const f32x4*)xa + lane; const f32x4* pb = (const f32x4*)xb + lane; const f32x4* gr = (const f32x4*)g + lane;
    f32x4 va[8], vb[8]; float sa = 0.f, sb = 0.f;
#pragma unroll
    for (int j = 0; j < 8; ++j) { va[j] = __builtin_nontemporal_load(pa + 64 * j); vb[j] = __builtin_nontemporal_load(pb + 64 * j); }
#pragma unroll
    for (int j = 0; j < 8; ++j) { sa += (va[j].x * va[j].x + va[j].y * va[j].y) + (va[j].z * va[j].z + va[j].w * va[j].w); sb += (vb[j].x * vb[j].x + vb[j].y * vb[j].y) + (vb[j].z * vb[j].z + vb[j].w * vb[j].w); }
    const float da = sqrtf(wave_sum(sa) * (1.0f / DMODEL) + EPS), db = sqrtf(wave_sum(sb) * (1.0f / DMODEL) + EPS), ra = 1.0f / da, rb = 1.0f / db;
    if (sig2 && lane == 0) { sig2[0] = da; sig2[1] = db; }
    u32x2* qa = (u32x2*)oa + lane; u32x2* qb = (u32x2*)ob + lane;
#pragma unroll
    for (int j = 0; j < 8; ++j) { const f32x4 gg = gr[64 * j]; u32x2 w;
        w.x = pk2(va[j].x * ra * gg.x, va[j].y * ra * gg.y); w.y = pk2(va[j].z * ra * gg.z, va[j].w * ra * gg.w); qa[64 * j] = w;
        w.x = pk2(vb[j].x * rb * gg.x, vb[j].y * rb * gg.y); w.y = pk2(vb[j].z * rb * gg.z, vb[j].w * rb * gg.w); qb[64 * j] = w; }
}

struct Ptrs {
    const float *x, *mem, *g_mix, *g_mem, *w_in, *conv_w, *pool_w, *pool_scale, *w_kv, *w_out, *g_ffn, *w_up, *ffn_conv_w, *ffn_conv_b, *w_down, *g_final;
    float* out; unsigned char* ws;
};

constexpr int UP_ITEMS = (DMODEL / 64) * (DFF2 / 64), DN_ITEMS = (DFF / 64) * (DMODEL / 64);
#ifndef DN_IN_P1
#define DN_IN_P1 2816
#endif
#ifndef UP_IN_P0
#define UP_IN_P0 4608
#endif
__device__ __forceinline__ void p1_idle_work(const Ptrs& P, LAS unsigned char* lds, int iw, int NIW, int wave, int lane);
template <int LIST> __device__ __forceinline__ TrItem tr_desc(const Ptrs& P, int it) {
    unsigned char* ws = P.ws;
    constexpr int I_IN = (DMODEL / 64) * (DIN / 64), I_OUT = (DMODEL / 64) * (DMODEL / 64), I_KV = (DMODEL / 64) * (1024 / 64), I_PW = (PGD / 64) * (PGD / 64);
    if (LIST == 0) {
        int r = it;
        if (r < I_IN) return tr_make<false>(P.w_in, DMODEL, DIN, (bf16*)(ws + WS_WINT), nullptr, r); r -= I_IN;
        if (r < I_OUT) return tr_make<false>(P.w_out, DMODEL, DMODEL, (bf16*)(ws + WS_WOUTT), nullptr, r); r -= I_OUT;
        if (r < UP_IN_P0) return tr_make<true>(P.w_up, DMODEL, DFF2, (bf16*)(ws + WS_WUPT), P.g_ffn, r); r -= UP_IN_P0;
        if (r < I_KV) return tr_make<false>(P.w_kv, DMODEL, 1024, (bf16*)(ws + WS_WKVT), nullptr, r); r -= I_KV;
        const int g = r / I_PW; r -= g * I_PW;
        return tr_make<false>(P.pool_w + (size_t)g * PGD * PGD, PGD, PGD, (bf16*)(ws + WS_POOLWT) + (size_t)g * PGD * PGD, nullptr, r);
    } else {
        if (LIST == 2) return tr_make<false>(P.w_down, DFF, DMODEL, (bf16*)(ws + WS_WDOWNT), nullptr, DN_IN_P1 + it);
        if (it < DN_IN_P1) return tr_make<false>(P.w_down, DFF, DMODEL, (bf16*)(ws + WS_WDOWNT), nullptr, it);
        return tr_make<true>(P.w_up, DMODEL, DFF2, (bf16*)(ws + WS_WUPT), P.g_ffn, UP_IN_P0 + it - DN_IN_P1);
    }
}
template <int LIST> __device__ __forceinline__ void tr_stream(const Ptrs& P, LAS float* scr, int first, int stride, int nitems, int lane) {
    if (first >= nitems) return;
    TrItem cur = tr_desc<LIST>(P, first); f32x4 va[16], vb[16];
    tr_load(cur, va, lane);
    for (int it = first; it < nitems; it += 2 * stride) {
        TrItem nx = cur; const bool h1 = it + stride < nitems; if (h1) { nx = tr_desc<LIST>(P, it + stride); tr_load(nx, vb, lane); }
        tr_store(cur, va, scr, lane);
        if (!h1) break;
        const bool h2 = it + 2 * stride < nitems; if (h2) { cur = tr_desc<LIST>(P, it + 2 * stride); tr_load(cur, va, lane); }
        tr_store(nx, vb, scr, lane);
        if (!h2) break;
    }
}
__device__ __forceinline__ void p0_prologue(const Ptrs& P, LAS unsigned char* lds, int gw, int NGW, int wave, int lane) {
    LAS float* scr = (LAS float*)(lds + wave * 16384);
    unsigned char* ws = P.ws;
    constexpr int NITEMS = (DMODEL / 64) * (DIN / 64) + (DMODEL / 64) * (DMODEL / 64) + UP_IN_P0 + (DMODEL / 64) * (1024 / 64) + 4 * (PGD / 64) * (PGD / 64);
    tr_stream<0>(P, scr, gw, NGW, NITEMS, lane);
    for (int i = gw * 64 + lane; i < DMODEL; i += NGW * 64) ((float*)(ws + WS_GINV))[i] = 1.0f / P.g_mix[i];
    for (int i = gw * 64 + lane; i < 16 * DIN * 2 / 16; i += NGW * 64) ((u32x4*)(ws + WS_ZPAD))[i] = (u32x4){0u, 0u, 0u, 0u};
    for (int m = 2 * gw; m < SEQ; m += 2 * NGW) rms_rows2_to_bf16(P.x + (size_t)m * DMODEL, P.x + (size_t)(m + 1) * DMODEL, P.g_mix, (bf16*)(ws + WS_H) + (size_t)m * DMODEL, (bf16*)(ws + WS_H) + (size_t)(m + 1) * DMODEL, lane, (float*)(ws + WS_SIGX) + m);
    for (int m = 2 * gw; m < NMEM; m += 2 * NGW) rms_rows2_to_bf16(P.mem + (size_t)m * DMODEL, P.mem + (size_t)(m + 1) * DMODEL, P.g_mem, (bf16*)(ws + WS_MB) + (size_t)m * DMODEL, (bf16*)(ws + WS_MB) + (size_t)(m + 1) * DMODEL, lane);
}

__device__ __forceinline__ void kv_tile(const Ptrs& P, int tt, int lane) {
    const bf16* mB = (const bf16*)(P.ws + WS_MB); const bf16* wT = (const bf16*)(P.ws + WS_WKVT);
    const int rb = tt >> 6, cb = tt & 63, fr = lane & 15, fq = lane >> 4;
    const bf16* ap = mB + (size_t)(16 * rb + fr) * DMODEL + 8 * fq; const bf16* wp = wT + (size_t)(16 * cb + fr) * DMODEL + 8 * fq;
    const bool kpart = cb < 32;
    f32x4 acc = {0.f, 0.f, 0.f, 0.f};
    bf16x8 a0[8], w0[8], a1[8], w1[8];
#pragma unroll
    for (int i = 0; i < 8; ++i) { a0[i] = *(const bf16x8*)(ap + 32 * i); w0[i] = *(const bf16x8*)(wp + 32 * i); }
#pragma unroll 1
    for (int kb = 0; kb < 8; kb += 2) {
#pragma unroll
        for (int i = 0; i < 8; ++i) { a1[i] = *(const bf16x8*)(ap + 32 * (8 * kb + 8 + i)); w1[i] = *(const bf16x8*)(wp + 32 * (8 * kb + 8 + i)); }
#pragma unroll
        for (int i = 0; i < 8; ++i) acc = kpart ? __builtin_amdgcn_mfma_f32_16x16x32_bf16(w0[i], a0[i], acc, 0, 0, 0) : __builtin_amdgcn_mfma_f32_16x16x32_bf16(a0[i], w0[i], acc, 0, 0, 0);
        if (kb + 2 < 8) {
#pragma unroll
            for (int i = 0; i < 8; ++i) { a0[i] = *(const bf16x8*)(ap + 32 * (8 * kb + 16 + i)); w0[i] = *(const bf16x8*)(wp + 32 * (8 * kb + 16 + i)); } }
#pragma unroll
        for (int i = 0; i < 8; ++i) acc = kpart ? __builtin_amdgcn_mfma_f32_16x16x32_bf16(w1[i], a1[i], acc, 0, 0, 0) : __builtin_amdgcn_mfma_f32_16x16x32_bf16(a1[i], w1[i], acc, 0, 0, 0);
    }
    u32x2 o; o.x = pk2(acc[0], acc[1]); o.y = pk2(acc[2], acc[3]);
    if (kpart) *(u32x2*)((bf16*)(P.ws + WS_KB) + (size_t)(16 * rb + fr) * 512 + 16 * cb + 4 * fq) = o;
    else *(u32x2*)((bf16*)(P.ws + WS_VT) + (size_t)(16 * cb - 512 + fr) * 256 + 32 * (rb >> 1) + 8 * fq + 4 * (rb & 1)) = o;
}

__device__ __forceinline__ void p1_idle_work(const Ptrs& P, LAS unsigned char* lds, int iw, int NIW, int wave, int lane) {
    LAS float* scr = (LAS float*)(lds + wave * 16384);
    for (int tt = iw; tt < 1024; tt += NIW) kv_tile(P, tt, lane);
    tr_stream<1>(P, scr, iw, NIW, DN_IN_P1 + (UP_ITEMS - UP_IN_P0), lane);
}

__device__ __forceinline__ void mix_conv_task(const Ptrs& P, int blk, int lane, int cg0, int cg1) {
    const bf16* z = (const bf16*)(P.ws + WS_Z); bf16* mix = (bf16*)(P.ws + WS_MIX);
    const int t0 = blk * 16;
    for (int cg = cg0 + lane; cg < cg1; cg += 64) {
        const int c = cg * 8;
        float w0[8], w1[8], w2[8], p1[8], p2[8];
#pragma unroll
        for (int e = 0; e < 8; ++e) { w0[e] = P.conv_w[c + e]; w1[e] = P.conv_w[DCONV + c + e]; w2[e] = P.conv_w[2 * DCONV + c + e]; }
        { float a[8], b[8]; unpack8(*(const u32x4*)(z + (long)(t0 - 2) * DIN + DCONV + c), a); unpack8(*(const u32x4*)(z + (long)(t0 - 2) * DIN + 2 * DCONV + c), b);
#pragma unroll
          for (int e = 0; e < 8; ++e) p2[e] = a[e] * b[e];
          unpack8(*(const u32x4*)(z + (long)(t0 - 1) * DIN + DCONV + c), a); unpack8(*(const u32x4*)(z + (long)(t0 - 1) * DIN + 2 * DCONV + c), b);
#pragma unroll
          for (int e = 0; e < 8; ++e) p1[e] = a[e] * b[e]; }
#pragma unroll 4
        for (int r = 0; r < 16; ++r) {
            const int t = t0 + r; float p[8], a[8], b[8], g[8], o[8];
            unpack8(__builtin_nontemporal_load((const u32x4*)(z + (size_t)t * DIN + DCONV + c)), a); unpack8(__builtin_nontemporal_load((const u32x4*)(z + (size_t)t * DIN + 2 * DCONV + c)), b); unpack8(__builtin_nontemporal_load((const u32x4*)(z + (size_t)t * DIN + c)), g);
#pragma unroll
            for (int e = 0; e < 8; ++e) { p[e] = a[e] * b[e]; o[e] = g[e] * (w2[e] * p[e] + w1[e] * p1[e] + w0[e] * p2[e]); p2[e] = p1[e]; p1[e] = p[e]; }
            if (NT_MIX) __builtin_nontemporal_store(pack8(o), (u32x4*)(mix + (size_t)t * DMODEL + c)); else *(u32x4*)(mix + (size_t)t * DMODEL + c) = pack8(o);
        }
    }
}
template <int g> __device__ __forceinline__ void mix_pool_task(const Ptrs& P, int blk, int lane) {
    constexpr int k = 2 << g;
    const char* zu = (const char*)((const bf16*)(P.ws + WS_Z) + (size_t)(blk * 16) * DIN + 3 * DCONV + PGD * g);
    const char* wu = (const char*)((const bf16*)(P.ws + WS_POOLWT) + (size_t)g * PGD * PGD);
    bf16* mix = (bf16*)(P.ws + WS_MIX);
    const int fr = lane & 15, fq = lane >> 4, t = blk * 16 + fr;
    const unsigned zl = (unsigned)(fr * DIN + 8 * fq) * 2u, wl = (unsigned)(fr * PGD + 8 * fq) * 2u;
    const int cnt = (t + 1 < k) ? t + 1 : k; const float inv = 1.0f / (float)cnt;
    f32x4 acc[12];
#pragma unroll
    for (int n = 0; n < 12; ++n) acc[n] = (f32x4){0.f, 0.f, 0.f, 0.f};
#pragma unroll 1
    for (int ks = 0; ks < 6; ++ks) {
        float sum[8], self[8];
        unpack8(*(const u32x4*)(zu + ks * 64 + zl), self);
#pragma unroll
        for (int e = 0; e < 8; ++e) sum[e] = self[e];
#pragma unroll
        for (int j = 1; j < k; ++j) { float v[8]; unpack8(*(const u32x4*)(zu + ks * 64 - (long)j * (DIN * 2) + zl), v);
#pragma unroll
            for (int e = 0; e < 8; ++e) sum[e] += v[e]; }
        float pl[8];
#pragma unroll
        for (int e = 0; e < 8; ++e) pl[e] = sum[e] * inv - self[e];
        const bf16x8 pf = __builtin_bit_cast(bf16x8, pack8(pl));
#pragma unroll
        for (int n = 0; n < 12; ++n) { const bf16x8 wf = *(const bf16x8*)(wu + n * (16 * PGD * 2) + ks * 64 + wl); acc[n] = __builtin_amdgcn_mfma_f32_16x16x32_bf16(wf, pf, acc[n], 0, 0, 0); }
    }
#pragma unroll
    for (int n = 0; n < 12; ++n) { const int d = 16 * n + 4 * fq; const f32x4 sc = *(const f32x4*)(P.pool_scale + PGD * g + d);
        u32x2 o; o.x = pk2(acc[n][0] * sc[0], acc[n][1] * sc[1]); o.y = pk2(acc[n][2] * sc[2], acc[n][3] * sc[3]);
        *(u32x2*)(mix + (size_t)t * DMODEL + DCONV + PGD * g + d) = o; }
}
__device__ __forceinline__ void mix_attn_task(const Ptrs& P, int h, int blk, int lane) {
    const bf16* z = (const bf16*)(P.ws + WS_Z); bf16* mix = (bf16*)(P.ws + WS_MIX); const bf16* Kb = (const bf16*)(P.ws + WS_KB); const bf16* Vt = (const bf16*)(P.ws + WS_VT);
    const int fr = lane & 15, fq = lane >> 4, t = blk * 16 + fr;
    bf16x8 qf[4];
#pragma unroll
    for (int ks = 0; ks < 4; ++ks) qf[ks] = *(const bf16x8*)(z + (size_t)t * DIN + 3 * DCONV + DPOOL + 128 * h + 32 * ks + 8 * fq);
    f32x4 s[16];
#pragma unroll
    for (int kb = 0; kb < 16; ++kb) { s[kb] = (f32x4){0.f, 0.f, 0.f, 0.f};
#pragma unroll
        for (int ks = 0; ks < 4; ++ks) { const bf16x8 kf = *(const bf16x8*)(Kb + (size_t)(16 * kb + fr) * 512 + 128 * h + 32 * ks + 8 * fq); s[kb] = __builtin_amdgcn_mfma_f32_16x16x32_bf16(kf, qf[ks], s[kb], 0, 0, 0); } }
    float mx = -3.0e38f;
#pragma unroll
    for (int kb = 0; kb < 16; ++kb) mx = fmaxf(fmaxf(fmaxf(s[kb][0], s[kb][1]), fmaxf(s[kb][2], s[kb][3])), mx);
    mx = fmaxf(mx, __shfl_xor(mx, 16)); mx = fmaxf(mx, __shfl_xor(mx, 32));
    const float c2 = 0.08838834764831845f * 1.4426950408889634f;
    float sum = 0.f;
#pragma unroll
    for (int kb = 0; kb < 16; ++kb)
#pragma unroll
        for (int r = 0; r < 4; ++r) { const float p = __builtin_amdgcn_exp2f((s[kb][r] - mx) * c2); s[kb][r] = p; sum += p; }
    sum += __shfl_xor(sum, 16); sum += __shfl_xor(sum, 32);
    const float inv = 1.0f / sum;
    f32x4 o[8];
#pragma unroll
    for (int db = 0; db < 8; ++db) o[db] = (f32x4){0.f, 0.f, 0.f, 0.f};
#pragma unroll
    for (int ks = 0; ks < 8; ++ks) {
        u32x4 pw; pw.x = pk2(s[2 * ks][0], s[2 * ks][1]); pw.y = pk2(s[2 * ks][2], s[2 * ks][3]); pw.z = pk2(s[2 * ks + 1][0], s[2 * ks + 1][1]); pw.w = pk2(s[2 * ks + 1][2], s[2 * ks + 1][3]);
        const bf16x8 pf = __builtin_bit_cast(bf16x8, pw);
#pragma unroll
        for (int db = 0; db < 8; ++db) { const bf16x8 vf = *(const bf16x8*)(Vt + (size_t)(128 * h + 16 * db + fr) * 256 + 32 * ks + 8 * fq); o[db] = __builtin_amdgcn_mfma_f32_16x16x32_bf16(vf, pf, o[db], 0, 0, 0); }
    }
#pragma unroll
    for (int db = 0; db < 8; ++db) { u32x2 w; w.x = pk2(o[db][0] * inv, o[db][1] * inv); w.y = pk2(o[db][2] * inv, o[db][3] * inv);
        *(u32x2*)(mix + (size_t)t * DMODEL + DCONV + DPOOL + 128 * h + 16 * db + 4 * fq) = w; }
}
template <int R, int C, int PCH> __device__ __forceinline__ void lds_stage_rows(LAS unsigned char* dst, const unsigned char* src, int gp, int tid) {
    constexpr int N = R * C, PER = (N + 511) / 512;
    u32x4 v[PER];
#pragma unroll
    for (int i = 0; i < PER; ++i) { const int idx = tid + 512 * i; if (idx < N) { const int row = idx / C, ch = idx % C; v[i] = *(const u32x4*)(src + (size_t)row * gp + ch * 16); } }
#pragma unroll
    for (int i = 0; i < PER; ++i) { const int idx = tid + 512 * i; if (idx < N) { const int row = idx / C, ch = idx % C; *(LAS u32x4*)(dst + row * (PCH * 16) + (((ch & ~15) | ((ch & 15) ^ (row & 15))) << 4)) = v[i]; } }
}
template <int N> __device__ __forceinline__ float dpp_shrN(float old, float src) { return __builtin_bit_cast(float, __builtin_amdgcn_update_dpp(__builtin_bit_cast(int, old), __builtin_bit_cast(int, src), 0x110 + N, 0xf, 0xf, false)); }
template <int N> __device__ __forceinline__ float dpp_rorN(float src) { return __builtin_bit_cast(float, __builtin_amdgcn_mov_dpp(__builtin_bit_cast(int, src), 0x120 + N, 0xf, 0xf, false)); }
template <int N> __device__ __forceinline__ float scan_step(float x, float p) { return x + dpp_shrN<N>(dpp_rorN<N>(p), x); }
template <int N> __device__ __forceinline__ float scan_step_prev(float p) { return p + dpp_shrN<N>(0.f, p); }

__device__ __forceinline__ void mix_attn_wave(const Ptrs& P, LAS unsigned char* ldsK, LAS unsigned char* ldsV, int h, int row0, int lane) {
    const bf16* z = (const bf16*)(P.ws + WS_Z); bf16* mix = (bf16*)(P.ws + WS_MIX);
    const int fr = lane & 15, fq = lane >> 4;
    bf16x8 q0[4], q1[4];
#pragma unroll
    for (int ks = 0; ks < 4; ++ks) { const bf16* qp = z + (size_t)(row0 + fr) * DIN + 3 * DCONV + DPOOL + 128 * h + 32 * ks + 8 * fq; q0[ks] = __builtin_nontemporal_load((const bf16x8*)qp); q1[ks] = __builtin_nontemporal_load((const bf16x8*)(qp + 16 * DIN)); }
    unsigned offk[4];
#pragma unroll
    for (int ks = 0; ks < 4; ++ks) offk[ks] = (unsigned)(fr * 256 + (((4 * ks + fq) ^ fr) << 4));
    f32x4 s0[16], s1[16];
#pragma unroll
    for (int kb = 0; kb < 16; ++kb) { s0[kb] = (f32x4){0.f, 0.f, 0.f, 0.f}; s1[kb] = (f32x4){0.f, 0.f, 0.f, 0.f};
#pragma unroll
        for (int ks = 0; ks < 4; ++ks) { const bf16x8 kf = *(const LAS bf16x8*)(ldsK + kb * 4096 + offk[ks]);
            s0[kb] = __builtin_amdgcn_mfma_f32_16x16x32_bf16(kf, q0[ks], s0[kb], 0, 0, 0); s1[kb] = __builtin_amdgcn_mfma_f32_16x16x32_bf16(kf, q1[ks], s1[kb], 0, 0, 0); } }
    const float c2 = 0.08838834764831845f * 1.4426950408889634f;
    bf16x8 p0[8], p1[8]; float inv0, inv1;
    {   float mx = -3.0e38f;
#pragma unroll
        for (int kb = 0; kb < 16; ++kb) mx = fmaxf(fmaxf(fmaxf(s0[kb][0], s0[kb][1]), fmaxf(s0[kb][2], s0[kb][3])), mx);
        mx = fmaxf(mx, __shfl_xor(mx, 16)); mx = fmaxf(mx, __shfl_xor(mx, 32));
        float sum = 0.f;
#pragma unroll
        for (int ks = 0; ks < 8; ++ks) { float e[8];
#pragma unroll
            for (int r = 0; r < 4; ++r) { e[r] = __builtin_amdgcn_exp2f((s0[2 * ks][r] - mx) * c2); e[4 + r] = __builtin_amdgcn_exp2f((s0[2 * ks + 1][r] - mx) * c2); }
            sum += ((e[0] + e[1]) + (e[2] + e[3])) + ((e[4] + e[5]) + (e[6] + e[7]));
            p0[ks] = __builtin_bit_cast(bf16x8, pack8(e)); }
        sum += __shfl_xor(sum, 16); sum += __shfl_xor(sum, 32); inv0 = 1.0f / sum; }
    {   float mx = -3.0e38f;
#pragma unroll
        for (int kb = 0; kb < 16; ++kb) mx = fmaxf(fmaxf(fmaxf(s1[kb][0], s1[kb][1]), fmaxf(s1[kb][2], s1[kb][3])), mx);
        mx = fmaxf(mx, __shfl_xor(mx, 16)); mx = fmaxf(mx, __shfl_xor(mx, 32));
        float sum = 0.f;
#pragma unroll
        for (int ks = 0; ks < 8; ++ks) { float e[8];
#pragma unroll
            for (int r = 0; r < 4; ++r) { e[r] = __builtin_amdgcn_exp2f((s1[2 * ks][r] - mx) * c2); e[4 + r] = __builtin_amdgcn_exp2f((s1[2 * ks + 1][r] - mx) * c2); }
            sum += ((e[0] + e[1]) + (e[2] + e[3])) + ((e[4] + e[5]) + (e[6] + e[7]));
            p1[ks] = __builtin_bit_cast(bf16x8, pack8(e)); }
        sum += __shfl_xor(sum, 16); sum += __shfl_xor(sum, 32); inv1 = 1.0f / sum; }
    f32x4 o0[8], o1[8];
#pragma unroll
    for (int db = 0; db < 8; ++db) { o0[db] = (f32x4){0.f, 0.f, 0.f, 0.f}; o1[db] = (f32x4){0.f, 0.f, 0.f, 0.f}; }
#pragma unroll
    for (int ks = 0; ks < 8; ++ks) {
        const unsigned offv = (unsigned)(fr * 512 + ((ks >> 2) << 8) + (((4 * (ks & 3) + fq) ^ fr) << 4));
#pragma unroll
        for (int db = 0; db < 8; ++db) { const bf16x8 vf = *(const LAS bf16x8*)(ldsV + db * 8192 + offv);
            o0[db] = __builtin_amdgcn_mfma_f32_16x16x32_bf16(vf, p0[ks], o0[db], 0, 0, 0); o1[db] = __builtin_amdgcn_mfma_f32_16x16x32_bf16(vf, p1[ks], o1[db], 0, 0, 0); } }
    bf16* op = mix + (size_t)(row0 + fr) * DMODEL + DCONV + DPOOL + 128 * h + 4 * fq;
#pragma unroll
    for (int db = 0; db < 8; ++db) { u32x2 w; w.x = pk2(o0[db][0] * inv0, o0[db][1] * inv0); w.y = pk2(o0[db][2] * inv0, o0[db][3] * inv0); *(u32x2*)(op + 16 * db) = w;
        w.x = pk2(o1[db][0] * inv1, o1[db][1] * inv1); w.y = pk2(o1[db][2] * inv1, o1[db][3] * inv1); *(u32x2*)(op + (size_t)16 * DMODEL + 16 * db) = w; }
}

template <int g> __device__ __forceinline__ void mix_pool_wave(const Ptrs& P, LAS unsigned char* ldsW, int row0, int lane) {
    constexpr int k = 2 << g;
    const bf16* z = (const bf16*)(P.ws + WS_Z); bf16* mix = (bf16*)(P.ws + WS_MIX);
    const int fr = lane & 15, fq = lane >> 4;
    f32x4 acc0[12], acc1[12];
#pragma unroll
    for (int n = 0; n < 12; ++n) { acc0[n] = (f32x4){0.f, 0.f, 0.f, 0.f}; acc1[n] = (f32x4){0.f, 0.f, 0.f, 0.f}; }
    const float invA = 1.0f / (float)((row0 + fr + 1 < k) ? row0 + fr + 1 : k), invB = 1.0f / (float)((row0 + 16 + fr + 1 < k) ? row0 + 16 + fr + 1 : k);
#pragma unroll 1
    for (int ks = 0; ks < 6; ++ks) {
        const bf16* zp = z + (long)(row0 - 16 + fr) * DIN + 3 * DCONV + PGD * g + 32 * ks + 8 * fq;
        float pv[8], xa[8], xb[8], sa[8], sb[8];
        unpack8(__builtin_nontemporal_load((const u32x4*)zp), pv); unpack8(__builtin_nontemporal_load((const u32x4*)(zp + 16 * DIN)), xa); unpack8(__builtin_nontemporal_load((const u32x4*)(zp + 32 * DIN)), xb);
#pragma unroll
        for (int e = 0; e < 8; ++e) {
            float p = pv[e], a = xa[e], b = xb[e];
            float b1 = scan_step<1>(b, a), a1 = scan_step<1>(a, p), p1 = scan_step_prev<1>(p);
            if (k >= 4) { const float b2 = scan_step<2>(b1, a1), a2 = scan_step<2>(a1, p1), p2 = scan_step_prev<2>(p1); b1 = b2; a1 = a2; p1 = p2; }
            if (k >= 8) { const float b2 = scan_step<4>(b1, a1), a2 = scan_step<4>(a1, p1), p2 = scan_step_prev<4>(p1); b1 = b2; a1 = a2; p1 = p2; }
            if (k >= 16) { const float b2 = scan_step<8>(b1, a1), a2 = scan_step<8>(a1, p1); b1 = b2; a1 = a2; }
            sa[e] = a1 * invA - a; sb[e] = b1 * invB - b; }
        const bf16x8 fa = __builtin_bit_cast(bf16x8, pack8(sa)), fb = __builtin_bit_cast(bf16x8, pack8(sb));
        const unsigned offw = (unsigned)(fr * 512 + ((ks >> 2) << 8) + (((4 * (ks & 3) + fq) ^ fr) << 4));
#pragma unroll
        for (int n = 0; n < 12; ++n) { const bf16x8 wf = *(const LAS bf16x8*)(ldsW + n * 8192 + offw);
            acc0[n] = __builtin_amdgcn_mfma_f32_16x16x32_bf16(wf, fa, acc0[n], 0, 0, 0); acc1[n] = __builtin_amdgcn_mfma_f32_16x16x32_bf16(wf, fb, acc1[n], 0, 0, 0); }
    }
    bf16* op = mix + (size_t)(row0 + fr) * DMODEL + DCONV + PGD * g + 4 * fq;
#pragma unroll
    for (int n = 0; n < 12; ++n) { const f32x4 sc = *(const f32x4*)(P.pool_scale + PGD * g + 16 * n + 4 * fq);
        u32x2 o; o.x = pk2(acc0[n][0] * sc[0], acc0[n][1] * sc[1]); o.y = pk2(acc0[n][2] * sc[2], acc0[n][3] * sc[3]); *(u32x2*)(op + 16 * n) = o;
        o.x = pk2(acc1[n][0] * sc[0], acc1[n][1] * sc[1]); o.y = pk2(acc1[n][2] * sc[2], acc1[n][3] * sc[3]); *(u32x2*)(op + (size_t)16 * DMODEL + 16 * n) = o; }
}

__device__ __forceinline__ void p2_mixer(const Ptrs& P, LAS unsigned char* lds, int w, int tid, int wave, int lane, int tmask) {
    const int sub = w & 3, tile = w >> 2, row0 = tile * 256 + (wave & 3) * 64;
    lds_stage_rows<256, 16, 16>(lds, (const unsigned char*)(P.ws + WS_KB) + 256 * sub, 1024, tid);
    lds_stage_rows<128, 32, 32>(lds + 65536, (const unsigned char*)(P.ws + WS_VT) + (size_t)sub * 128 * 512, 512, tid);
    LDS_WAIT(); __syncthreads();
    if (wave < 4) { if (tmask & 0x1e0) {
#pragma unroll 1
        for (int p = 0; p < 2; ++p) { asm volatile("" ::: "memory"); mix_attn_wave(P, lds, lds + 65536, sub, row0 + 32 * p, lane); } } }
    else if (tmask & 1) mix_conv_task(P, 4 * w + (wave - 4), lane, 0, 48);
    __syncthreads();
    lds_stage_rows<192, 24, 32>(lds, (const unsigned char*)(P.ws + WS_POOLWT) + (size_t)sub * PGD * PGD * 2, PGD * 2, tid);
    LDS_WAIT(); __syncthreads();
    if (wave < 4) { if (tmask & 0x1e) {
#pragma unroll 1
        for (int p = 0; p < 2; ++p) { const int r = row0 + 32 * p; asm volatile("" ::: "memory");
            if (sub == 0) mix_pool_wave<0>(P, lds, r, lane); else if (sub == 1) mix_pool_wave<1>(P, lds, r, lane); else if (sub == 2) mix_pool_wave<2>(P, lds, r, lane); else mix_pool_wave<3>(P, lds, r, lane); } } }
    else if (tmask & 1) mix_conv_task(P, 4 * w + (wave - 4), lane, 48, 96);
    __syncthreads();
}

__device__ __forceinline__ void p5_fix_item(const Ptrs& P, int pm, int c) {
    const float* ub = (const float*)(P.ws + WS_UBND); bf16* act = (bf16*)(P.ws + WS_ACT); const float* cw = P.ffn_conv_w; const float* cb = P.ffn_conv_b;
    const int gi = 256 * (c / 128) + 64 * ((c % 128) / 32) + (c % 32);
    const float* p2 = ub + (size_t)((pm - 1) * 4 + 2) * DFF2 + gi; const float* p1 = p2 + DFF2; const float* r0 = ub + (size_t)(pm * 4) * DFF2 + gi; const float* r1 = r0 + DFF2;
    float o0[8], o1[8];
#pragma unroll
    for (int e = 0; e < 8; ++e) {
        const float gw0 = cw[c + e], gw1 = cw[DFF2 + c + e], gw2 = cw[2 * DFF2 + c + e], gb = cb[c + e], vw0 = cw[DFF + c + e], vw1 = cw[DFF2 + DFF + c + e], vw2 = cw[2 * DFF2 + DFF + c + e], vb = cb[DFF + c + e];
        const float G0 = gw2 * r0[e] + (gw1 * p1[e] + (gw0 * p2[e] + gb)), V0 = vw2 * r0[32 + e] + (vw1 * p1[32 + e] + (vw0 * p2[32 + e] + vb));
        const float G1 = gw2 * r1[e] + (gw1 * r0[e] + (gw0 * p1[e] + gb)), V1 = vw2 * r1[32 + e] + (vw1 * r0[32 + e] + (vw0 * p1[32 + e] + vb));
        o0[e] = G0 * __builtin_amdgcn_rcpf(1.0f + __builtin_amdgcn_exp2f(-1.4426950408889634f * G0)) * V0;
        o1[e] = G1 * __builtin_amdgcn_rcpf(1.0f + __builtin_amdgcn_exp2f(-1.4426950408889634f * G1)) * V1; }
    *(u32x4*)(act + (size_t)(256 * pm) * DFF + c) = pack8(o0); *(u32x4*)(act + (size_t)(256 * pm + 1) * DFF + c) = pack8(o1);
}
__device__ __forceinline__ void p6_fixup_panels(const Ptrs& P, int vcu, int G, int tid, unsigned* cnt, unsigned* tmo) {
    constexpr int GRP = DFF / 8 / 8;
    const int nround = (512 + G - 1) / G;
    for (int i = 0; i < nround; ++i) { const int L = i * G + vcu; if (L >= 512) break; const int pm = L >> 3, pn = L & 7;
        if (pm > 0 && tid < GRP) p5_fix_item(P, pm, (pn * GRP + tid) * 8); }
    asm volatile("s_waitcnt vmcnt(0)" ::: "memory"); __syncthreads();
    if (tid == 0) {
        __builtin_amdgcn_fence(__ATOMIC_RELEASE, "agent"); asm volatile("s_waitcnt vmcnt(0)" ::: "memory");
        for (int i = 0; i < nround; ++i) { const int L = i * G + vcu; if (L >= 512) break; __hip_atomic_fetch_add(cnt + 64 * (L >> 3), 1u, __ATOMIC_RELAXED, __HIP_MEMORY_SCOPE_AGENT); }
        for (int i = 0; i < nround; ++i) { const int L = i * G + vcu; if (L >= 512) break; unsigned spins = 0;
            while (__hip_atomic_load(cnt + 64 * (L >> 3), __ATOMIC_RELAXED, __HIP_MEMORY_SCOPE_AGENT) < 8u) { __builtin_amdgcn_s_sleep(2); if (++spins > (1u << 20)) { __hip_atomic_store(tmo, 1u, __ATOMIC_RELAXED, __HIP_MEMORY_SCOPE_AGENT); break; } } }
        __builtin_amdgcn_fence(__ATOMIC_ACQUIRE, "agent"); asm volatile("s_waitcnt vmcnt(0)" ::: "memory");
    }
    __syncthreads();
}
__device__ __forceinline__ void p5_fixup(const Ptrs& P, int gt, int NGT) {
    for (int i = gt; i < 63 * (DFF / 8); i += NGT) p5_fix_item(P, 1 + i / (DFF / 8), (i % (DFF / 8)) * 8);
}

__device__ __forceinline__ void p7_final(const Ptrs& P, int gw, int NGW, int lane) {
    const float* slab = (const float*)(P.ws + WS_SLAB2);
    for (int m = gw; m < SEQ; m += NGW) {
        const float part = (lane < 32) ? slab[(size_t)m * 32 + lane] : 0.f;
        const float rstd = 1.0f / sqrtf(wave_sum(part) * (1.0f / DMODEL) + EPS);
        f32x4* xr = (f32x4*)(P.out + (size_t)m * DMODEL) + lane; const f32x4* gr = (const f32x4*)P.g_final + lane;
#pragma unroll
        for (int j = 0; j < 8; ++j) { f32x4 v = xr[64 * j]; const f32x4 gg = gr[64 * j]; v = v * rstd * gg; xr[64 * j] = v; }
    }
}

struct Args { const float* in[16]; float* out; unsigned char* ws; int ph_lo, ph_hi; };
__global__ void __launch_bounds__(NWAVES * 64, 2) hybrid_fwd(Args args) {
    extern __shared__ __attribute__((aligned(16))) unsigned char lds_raw[];
    LAS unsigned char* lds = (LAS unsigned char*)lds_raw;
    cg::grid_group grid = cg::this_grid();
    const int tid = threadIdx.x, lane = tid & 63, wave = __builtin_amdgcn_readfirstlane(tid >> 6);
    const int G = gridDim.x, bx = blockIdx.x, vcu = (G % 8 == 0) ? (bx % 8) * (G / 8) + bx / 8 : bx;
    const int gw = vcu * NWAVES + wave, NGW = G * NWAVES;
    volatile LAS unsigned* MISC = (volatile LAS unsigned*)(lds + MISC_OFF);
    if (tid < 32) MISC[tid] = 0u;
    __syncthreads();
    const XcdBarrier bar = xcd_barrier_post((unsigned*)(args.ws + WS_CTL), MISC + 8);
    Ptrs P;
    P.x = args.in[0]; P.mem = args.in[1]; P.g_mix = args.in[2]; P.g_mem = args.in[3]; P.w_in = args.in[4]; P.conv_w = args.in[5]; P.pool_w = args.in[6]; P.pool_scale = args.in[7];
    P.w_kv = args.in[8]; P.w_out = args.in[9]; P.g_ffn = args.in[10]; P.w_up = args.in[11]; P.ffn_conv_w = args.in[12]; P.ffn_conv_b = args.in[13]; P.w_down = args.in[14]; P.g_final = args.in[15];
    P.out = args.out; P.ws = args.ws;
    unsigned char* ws = args.ws;
#if PROBE_SYNC
    for (int i = 0; i < 20; ++i) xcd_barrier(bar);
#endif
    const int lo = args.ph_lo, hi = args.ph_hi;
#define IN(k) (lo <= (k) && (k) < hi)
#define SYNC(k) do { if ((k) + 1 < hi) { if ((k) == 0 && USE_CG_SYNC) grid.sync(); else xcd_barrier(bar); } } while (0)
#define SYNCR(k, b) do { if ((k) + 1 < hi || rp + 1 < NREP(b)) { if ((k) == 0 && USE_CG_SYNC) grid.sync(); else xcd_barrier(bar); } } while (0)
#define NREP(b) ((REPM & (b)) ? 2 : 1)
    if (IN(0) && (PHM & 1)) for (int rp = 0; rp < NREP(1); ++rp) { p0_prologue(P, lds, gw, NGW, wave, lane); SYNCR(0, 1); }
    if (IN(1) && (PHM & 2)) for (int rp = 0; rp < NREP(2); ++rp) {
        pg8::Gemm g{(const bf16*)(ws + WS_H), (const bf16*)(ws + WS_WINT), SEQ, DIN, DMODEL}; pg8::StaticOrder S; S.init(SEQ, DIN, G, bx, P1_WGM);
        pg8::EpiZ E{(bf16*)(ws + WS_Z), DIN};
        pg8::gemm_phase<pg8::EpiZ, pg8::StaticOrder, P1_ALIGN, true>(lds, g, S, E, lds + XLDS_OFF);
        { const int nfull = ((SEQ / 256) * (DIN / 256)) % G;
          if (nfull == 0) p1_idle_work(P, lds, bx * NWAVES + wave, G * NWAVES, wave, lane);
          else if (bx >= nfull) p1_idle_work(P, lds, (bx - nfull) * NWAVES + wave, (G - nfull) * NWAVES, wave, lane); }
        SYNCR(1, 2);
    }
    if (IN(2) && (PHM & 4)) for (int rp = 0; rp < NREP(4); ++rp) { p2_mixer(P, lds, vcu, tid, wave, lane, 511);
#if PROBE_P2
        p2_mixer(P, lds, vcu, tid, wave, lane, PROBE_P2);
#endif
        SYNCR(2, 4); }
    if (IN(3) && (PHM & 8)) {
        pg8::Gemm g{(const bf16*)(ws + WS_MIX), (const bf16*)(ws + WS_WOUTT), SEQ, DMODEL, DMODEL}; pg8::PanelOrder S{G, vcu, (SEQ / 256) * (DMODEL / 256)};
        pg8::EpiNorm<0> E{nullptr, (const bf16*)(ws + WS_H), (const float*)(ws + WS_SIGX), (float*)(ws + WS_SIG), (bf16*)(ws + WS_X1B), nullptr, (const float*)(ws + WS_GINV), (unsigned*)(ws + WS_SLAB1), (unsigned*)(ws + WS_CTL) + CW_PANEL1, (unsigned*)(ws + WS_CTL) + XB_TMO};
        pg8::gemm_phase<pg8::EpiNorm<0>, pg8::PanelOrder, true, true>(lds, g, S, E, lds + XLDS_OFF);
        SYNC(3);
    }
#if PROBE_GEMM
    if (IN(3)) {
        pg8::Gemm g{(const bf16*)(ws + WS_X1B), (const bf16*)(ws + WS_WUPT), SEQ, PROBE_N, DMODEL}; pg8::StaticOrder S; S.init(SEQ, PROBE_N, G, bx);
#if PROBE_GEMM == 1
        pg8::EpiZ E{(bf16*)(ws + WS_Z), PROBE_N};
        pg8::gemm_phase<pg8::EpiZ, pg8::StaticOrder, true, true>(lds, g, S, E, lds + XLDS_OFF);
#elif PROBE_GEMM == 2
        pg8::EpiNone E{};
        pg8::gemm_phase<pg8::EpiNone, pg8::StaticOrder, true, true>(lds, g, S, E, lds + XLDS_OFF);
#elif PROBE_GEMM == 3
        pg8::EpiZ E{(bf16*)(ws + WS_Z), PROBE_N};
        pg8::gemm_phase<pg8::EpiZ, pg8::StaticOrder, true, false>(lds, g, S, E, lds + XLDS_OFF);
#elif PROBE_GEMM == 5
        pg8::EpiAct E{(bf16*)(ws + WS_ACT), P.ffn_conv_w, P.ffn_conv_b, (float*)(ws + WS_UBND)};
        pg8::gemm_phase<pg8::EpiAct, pg8::StaticOrder, true, true>(lds, g, S, E, lds + XLDS_OFF);
#elif PROBE_GEMM == 4
        pg8::EpiZ E{(bf16*)(ws + WS_Z), PROBE_N};
        pg8::gemm_phase<pg8::EpiZ, pg8::StaticOrder, false, true>(lds, g, S, E, lds + XLDS_OFF);
#endif
        xcd_barrier(bar);
    }
#endif
    if (IN(4) && (PHM & 16)) for (int rp = 0; rp < NREP(16); ++rp) {
        pg8::Gemm g{(const bf16*)(ws + WS_X1B), (const bf16*)(ws + WS_WUPT), SEQ, DFF2, DMODEL}; pg8::StaticOrder S; S.init(SEQ, DFF2, G, bx, P4_WGM);
        pg8::EpiAct E{(bf16*)(ws + WS_ACT), P.ffn_conv_w, P.ffn_conv_b, (float*)(ws + WS_UBND)};
        pg8::gemm_phase<pg8::EpiAct, pg8::StaticOrder, true, true>(lds, g, S, E, lds + XLDS_OFF);
        SYNCR(4, 16);
    }
#if !FUSE_FIXUP
    if (IN(5) && (PHM & 32)) { p5_fixup(P, vcu * (NWAVES * 64) + tid, G * NWAVES * 64); tr_stream<2>(P, (LAS float*)(lds + wave * 16384), gw, NGW, DN_ITEMS - DN_IN_P1, lane); SYNC(5); }
#endif
    if (IN(6) && (PHM & 64)) {
#if FUSE_FIXUP
        p6_fixup_panels(P, vcu, G, tid, (unsigned*)(ws + WS_CTL) + CW_PANEL2, (unsigned*)(ws + WS_CTL) + XB_TMO);
#endif
        pg8::Gemm g{(const bf16*)(ws + WS_ACT), (const bf16*)(ws + WS_WDOWNT), SEQ, DMODEL, DFF}; pg8::PanelOrder S{G, vcu, (SEQ / 256) * (DMODEL / 256)};
        pg8::EpiNorm<1> E{nullptr, (const bf16*)(ws + WS_X1B), (const float*)(ws + WS_SIG), nullptr, nullptr, P.out, P.g_final, (unsigned*)(ws + WS_SLAB2), (unsigned*)(ws + WS_CTL) + CW_PANEL, (unsigned*)(ws + WS_CTL) + XB_TMO};
        pg8::gemm_phase<pg8::EpiNorm<1>, pg8::PanelOrder, true, true>(lds, g, S, E, lds + XLDS_OFF);
    }
#undef IN
#undef SYNC
}

extern "C" void kernel_launch(void* const* d_in, const int* in_sizes, int n_in, void* d_out, int out_size, void* d_ws, size_t ws_size, hipStream_t stream) {
    static int grid = 0;
    if (grid == 0) {
        if (n_in != 16 || in_sizes[0] != SEQ * DMODEL || out_size != SEQ * DMODEL || ws_size < WS_END) { fprintf(stderr, "kernel_launch: unexpected shapes (n_in %d, in0 %d, out %d, ws %zu)\n", n_in, n_in > 0 ? in_sizes[0] : -1, out_size, ws_size); grid = -1; return; }
        int dev = 0, cus = 0, per_cu = 0;
        if (hipGetDevice(&dev) != hipSuccess || hipDeviceGetAttribute(&cus, hipDeviceAttributeMultiprocessorCount, dev) != hipSuccess) { grid = -1; return; }
        if (hipFuncSetAttribute((const void*)hybrid_fwd, hipFuncAttributeMaxDynamicSharedMemorySize, LDS_BYTES) != hipSuccess) { fprintf(stderr, "kernel_launch: hipFuncSetAttribute failed\n"); grid = -1; return; }
        if (hipOccupancyMaxActiveBlocksPerMultiprocessor(&per_cu, (const void*)hybrid_fwd, NWAVES * 64, LDS_BYTES) != hipSuccess || per_cu < 1) { fprintf(stderr, "kernel_launch: occupancy query says %d blocks per CU\n", per_cu); (void)hipGetLastError(); per_cu = 1; }
        grid = cus;
        if (grid != 256) { fprintf(stderr, "kernel_launch: this kernel is laid out for one workgroup on each of 256 CUs (the mixer phase and the row-statistics exchanges assume it); the device reports %d\n", grid); if (grid > 256) grid = 256; }
    }
    if (grid < 0) return;
    if (hipMemsetAsync((char*)d_ws + WS_CTL, 0, CTL_ZERO_BYTES, stream) != hipSuccess) { fprintf(stderr, "kernel_launch: hipMemsetAsync failed\n"); return; }
    Args a{};
    for (int i = 0; i < 16; ++i) a.in[i] = (const float*)d_in[i];
    a.out = (float*)d_out; a.ws = (unsigned char*)d_ws;
#if MK_PER_PHASE
    for (int ph = 0; ph < NPHASE; ++ph) { a.ph_lo = ph; a.ph_hi = ph + 1; hipLaunchKernelGGL(hybrid_fwd, dim3(grid), dim3(NWAVES * 64), LDS_BYTES, stream, a); }
#else
    a.ph_lo = 0; a.ph_hi = NPHASE;
    void* kargs[] = {&a};
    hipError_t e = hipLaunchCooperativeKernel((const void*)hybrid_fwd, dim3(grid), dim3(NWAVES * 64), kargs, LDS_BYTES, stream);
    if (e != hipSuccess) fprintf(stderr, "kernel_launch: cooperative launch failed: %s (grid %d)\n", hipGetErrorString(e), grid);
#endif
}
```

```cpp
#include <hip/hip_runtime.h>
#include <hip/hip_cooperative_groups.h>
#include <cstdio>
#include <cstdint>
namespace cg = cooperative_groups;
#ifndef P1_SPLIT_TAIL
#define P1_SPLIT_TAIL 0
#endif
#ifndef P4_AUXB
#define P4_AUXB 1
#endif
#ifndef NT_MIX
#define NT_MIX 0
#endif
#ifndef NT_OUT
#define NT_OUT 4
#endif
#ifndef TR_NT
#define TR_NT 1
#endif
#ifndef XCHG_ACQUIRE
#define XCHG_ACQUIRE 0
#endif
#ifndef PG8_T8
#define PG8_T8 1
#endif
#ifndef EARLY_A
#define EARLY_A true
#endif
#ifndef PG8_PRIO
#define PG8_PRIO 0
#endif
namespace pg8 {
#define PG8_LAS __attribute__((address_space(3)))
typedef unsigned short bf16_t;
typedef short bf16x8 __attribute__((ext_vector_type(8)));
typedef float f32x4 __attribute__((ext_vector_type(4)));
typedef unsigned u32x4 __attribute__((ext_vector_type(4)));
constexpr int BM = 256, BK = 64, HALF = 128, HTB = HALF * BK * 2  , STAGE_BYTES = 8 * HTB, NXCD = 8, WGM = 8;

__host__ __device__ __forceinline__ int lds_byte(int r, int c) { const int st = (r >> 4) * 2 + (c >> 5), rr = r & 15, cc = c & 31, ob = rr * 64 + cc * 2; return st * 1024 + (ob ^ (((ob >> 9) & 1) << 5)); }
__host__ __device__ __forceinline__ void stage_rc(int b, int& R, int& C) { const int st = b / 1024, sb = b % 1024, swz = sb ^ (((sb >> 9) & 1) << 5); R = (st >> 1) * 16 + swz / 64; C = (st & 1) * 32 + (swz % 64) / 2; }
__host__ __device__ __forceinline__ int invperm32(int x) { return 16 * ((x >> 2) & 1) + 4 * (x >> 3) + (x & 3); }
__host__ __device__ __forceinline__ int perm32(int rho) { const int n = rho >> 4, i = rho & 15; return 8 * (i >> 2) + 4 * n + (i & 3); }

struct Unit { int pm, pn, hs, seq; };
struct Gemm { const bf16_t* A; const bf16_t* Bt; int M, N, K; };

struct StaticOrder {
    int nM, nN, nwg, G, c, wgm;
    __host__ __device__ void init(int M, int N, int G_, int c_, int wgm_ = WGM) { nM = M / BM; nN = N / BM; nwg = nM * nN; G = G_; c = c_; wgm = wgm_; }
    __host__ __device__ void map(int L, Unit& u) const {
        int wgid = L; { const int q = nwg / NXCD, r = nwg % NXCD, xcd = wgid % NXCD, off = wgid / NXCD; wgid = (xcd < r ? xcd * (q + 1) : r * (q + 1) + (xcd - r) * q) + off; }
        const int nig = wgm * nN, gid = wgid / nig, fm = gid * wgm, gsz = (nM - fm) < wgm ? (nM - fm) : wgm;
        u.pm = fm + ((wgid % nig) % gsz); u.pn = (wgid % nig) / gsz; u.hs = 0;
    }
    __host__ __device__ bool next(int i, Unit& u) const { const long L = (long)i * G + c; if (L >= nwg) return false; map((int)L, u); return true; }
    __device__ __forceinline__ void a_ready(const Unit&) const {}
    __device__ __forceinline__ void done(const Unit&) const {}
};
struct TailSplitOrder : StaticOrder {
    __host__ __device__ bool next(int i, Unit& u) const {
        const int nfr = nwg / G, nrem = nwg - nfr * G;
        if (G != 256 || nrem != 128) return StaticOrder::next(i, u);
        if (i < nfr) { map(i * G + c, u); return true; }
        if (i > nfr) return false;
        map(nfr * G + (c / 16) * 8 + (c % 8), u); u.hs = 1 + ((c / 8) & 1); return true;
    }
};
__device__ __forceinline__ unsigned cvt_pk_bf16(float lo, float hi) { unsigned r; asm volatile("v_cvt_pk_bf16_f32 %0, %1, %2" : "=v"(r) : "v"(lo), "v"(hi)); return r; }
typedef unsigned u32x2 __attribute__((ext_vector_type(2)));
constexpr int DM = 2048;
constexpr float RMS_EPS = 1e-6f;

__device__ __forceinline__ void qswap_pieces(const u32x4 w0, const u32x4 w1, bool odd, u32x4& dA, u32x4& dB) {
#pragma unroll
    for (int j = 0; j < 4; ++j) { const unsigned snd = odd ? w0[j] : w1[j];
        const unsigned rcv = (unsigned)__builtin_amdgcn_mov_dpp((int)snd, 0xB1, 0xf, 0xf, false);
        dA[j] = odd ? rcv : w0[j]; dB[j] = odd ? w1[j] : rcv; }
}
struct EpiZ {
    static constexpr bool PERM = true, AFTER_DRAIN = false, AMAP2 = false;
    bf16_t* O; int ldc;
    __device__ __forceinline__ void operator()(const f32x4 (&acc)[2][2][4][2], const Unit& u, int wr, int wc, int fr_, int fq_, PG8_LAS unsigned char*) const {
        int t_ = threadIdx.x; asm volatile("" : "+v"(t_));
        const int fr = t_ & 15, fq = (t_ >> 4) & 3; const bool odd = fr & 1;
        const int rowe = u.pm * BM + (u.hs == 2 ? HALF : 0) + wr * 64 + (fr & ~1), colp = u.pn * BM + wc * 64 + 8 * fq + (odd ? 32 : 0);
#pragma unroll
        for (int ai = 0; ai < 2; ++ai) { if (ai == 1 && u.hs) break;
#pragma unroll
            for (int m = 0; m < 4; ++m) { u32x4 w0, w1, dA, dB;
                { const f32x4 v0 = acc[ai][0][m][0], v1 = acc[ai][0][m][1]; w0.x = cvt_pk_bf16(v0[0], v0[1]); w0.y = cvt_pk_bf16(v0[2], v0[3]); w0.z = cvt_pk_bf16(v1[0], v1[1]); w0.w = cvt_pk_bf16(v1[2], v1[3]); }
                { const f32x4 v0 = acc[ai][1][m][0], v1 = acc[ai][1][m][1]; w1.x = cvt_pk_bf16(v0[0], v0[1]); w1.y = cvt_pk_bf16(v0[2], v0[3]); w1.z = cvt_pk_bf16(v1[0], v1[1]); w1.w = cvt_pk_bf16(v1[2], v1[3]); }
                qswap_pieces(w0, w1, odd, dA, dB);
                bf16_t* p = O + (size_t)(rowe + ai * HALF + m * 16) * ldc + colp;
                if (NT_OUT & 1) { __builtin_nontemporal_store(dA, (u32x4*)p); __builtin_nontemporal_store(dB, (u32x4*)(p + ldc)); } else { *(u32x4*)p = dA; *(u32x4*)(p + ldc) = dB; } } }
    }
};

constexpr int ZW = 2816;
struct EpiZin {
    static constexpr bool PERM = true, AFTER_DRAIN = false, AMAP2 = false;
    bf16_t* O;
    __device__ __forceinline__ void operator()(const f32x4 (&acc)[2][2][4][2], const Unit& u, int wr, int wc, int fr_, int fq_, PG8_LAS unsigned char*) const {
        int t_ = threadIdx.x; asm volatile("" : "+v"(t_));
        const int fr = t_ & 15, fq = (t_ >> 4) & 3; const bool odd = fr & 1;
        if (u.pn >= 3 && u.pn < 9) {
            bf16_t* p0 = O + (size_t)(u.pm * BM + wr * 64 + fr) * ZW + 768 + 128 * (u.pn - 3) + 32 * wc + 8 * fq;
            u32x4 w[2][4];
#pragma unroll
            for (int ai = 0; ai < 2; ++ai)
#pragma unroll
                for (int m = 0; m < 4; ++m) { const f32x4 v0 = acc[ai][0][m][0] * acc[ai][1][m][0], v1 = acc[ai][0][m][1] * acc[ai][1][m][1];
                    w[ai][m].x = cvt_pk_bf16(v0[0], v0[1]); w[ai][m].y = cvt_pk_bf16(v0[2], v0[3]); w[ai][m].z = cvt_pk_bf16(v1[0], v1[1]); w[ai][m].w = cvt_pk_bf16(v1[2], v1[3]); }
            asm volatile("s_waitcnt vmcnt(0)" ::: "memory");
#pragma unroll
            for (int ai = 0; ai < 2; ++ai)
#pragma unroll
                for (int m = 0; m < 4; ++m) *(u32x4*)(p0 + (size_t)(ai * HALF + m * 16) * ZW) = w[ai][m];
        } else {
            const int cbase = u.pn < 3 ? 256 * u.pn : 256 * u.pn - 768;
            const int rowe = u.pm * BM + wr * 64 + (fr & ~1), colp = cbase + wc * 64 + 8 * fq + (odd ? 32 : 0);
            u32x4 dA[2][4], dB[2][4];
#pragma unroll
            for (int ai = 0; ai < 2; ++ai)
#pragma unroll
                for (int m = 0; m < 4; ++m) { u32x4 w0, w1;
                    { const f32x4 v0 = acc[ai][0][m][0], v1 = acc[ai][0][m][1]; w0.x = cvt_pk_bf16(v0[0], v0[1]); w0.y = cvt_pk_bf16(v0[2], v0[3]); w0.z = cvt_pk_bf16(v1[0], v1[1]); w0.w = cvt_pk_bf16(v1[2], v1[3]); }
                    { const f32x4 v0 = acc[ai][1][m][0], v1 = acc[ai][1][m][1]; w1.x = cvt_pk_bf16(v0[0], v0[1]); w1.y = cvt_pk_bf16(v0[2], v0[3]); w1.z = cvt_pk_bf16(v1[0], v1[1]); w1.w = cvt_pk_bf16(v1[2], v1[3]); }
                    qswap_pieces(w0, w1, odd, dA[ai][m], dB[ai][m]); }
            asm volatile("s_waitcnt vmcnt(0)" ::: "memory");
#pragma unroll
            for (int ai = 0; ai < 2; ++ai)
#pragma unroll
                for (int m = 0; m < 4; ++m) { bf16_t* p = O + (size_t)(rowe + ai * HALF + m * 16) * ZW + colp; *(u32x4*)p = dA[ai][m]; *(u32x4*)(p + ZW) = dB[ai][m]; }
        }
    }
};

struct EpiNone {
    static constexpr bool PERM = true, AFTER_DRAIN = false, AMAP2 = false;
    __device__ __forceinline__ void operator()(const f32x4 (&acc)[2][2][4][2], const Unit& u, int wr, int wc, int fr, int fq, PG8_LAS unsigned char*) const {
#pragma unroll
        for (int ai = 0; ai < 2; ++ai)
#pragma unroll
            for (int bj = 0; bj < 2; ++bj)
#pragma unroll
                for (int m = 0; m < 4; ++m)
#pragma unroll
                    for (int n = 0; n < 2; ++n) asm volatile("" :: "v"(acc[ai][bj][m][n]));
    }
};
struct EpiResA {
    static constexpr bool PERM = true, AFTER_DRAIN = false, AMAP2 = false;
    const float* R; bf16_t* XB; float* slab;
    __device__ __forceinline__ void operator()(const f32x4 (&acc)[2][2][4][2], const Unit& u, int wr, int wc, int fr_, int fq_, PG8_LAS unsigned char*) const {
        int t_ = threadIdx.x; asm volatile("" : "+v"(t_));
        const int fr = t_ & 15, fq = (t_ >> 4) & 3;
        const int row0 = u.pm * BM + wr * 64 + fr, col0 = u.pn * BM + wc * 32 + 8 * fq;
#pragma unroll
        for (int ai = 0; ai < 2; ++ai) {
            f32x4 r[4][2][2];
#pragma unroll
            for (int m = 0; m < 4; ++m)
#pragma unroll
                for (int bj = 0; bj < 2; ++bj) { const float* p = R + (size_t)(row0 + ai * HALF + m * 16) * DM + col0 + bj * HALF; r[m][bj][0] = *(const f32x4*)p; r[m][bj][1] = *(const f32x4*)(p + 4); }
#pragma unroll
            for (int m = 0; m < 4; ++m) { const int row = row0 + ai * HALF + m * 16; float ss = 0.f;
#pragma unroll
                for (int bj = 0; bj < 2; ++bj) { const f32x4 v0 = acc[ai][bj][m][0] + r[m][bj][0], v1 = acc[ai][bj][m][1] + r[m][bj][1];
                    u32x4 w; w.x = cvt_pk_bf16(v0[0], v0[1]); w.y = cvt_pk_bf16(v0[2], v0[3]); w.z = cvt_pk_bf16(v1[0], v1[1]); w.w = cvt_pk_bf16(v1[2], v1[3]);
                    *(u32x4*)(XB + (size_t)row * DM + col0 + bj * HALF) = w;
                    ss += (v0[0] * v0[0] + v0[1] * v0[1]) + (v0[2] * v0[2] + v0[3] * v0[3]) + (v1[0] * v1[0] + v1[1] * v1[1]) + (v1[2] * v1[2] + v1[3] * v1[3]); }
                ss += __shfl_xor(ss, 16); ss += __shfl_xor(ss, 32);
                if (fq == 0) slab[(size_t)row * 32 + u.pn * 4 + wc] = ss; }
            asm volatile("" ::: "memory"); }
    }
};
struct EpiResB {
    static constexpr bool PERM = true, AFTER_DRAIN = false, AMAP2 = false;
    const bf16_t* RB; float* X; float* slab;
    __device__ __forceinline__ void operator()(const f32x4 (&acc)[2][2][4][2], const Unit& u, int wr, int wc, int fr_, int fq_, PG8_LAS unsigned char*) const {
        int t_ = threadIdx.x; asm volatile("" : "+v"(t_));
        const int fr = t_ & 15, fq = (t_ >> 4) & 3;
        const int row0 = u.pm * BM + wr * 64 + fr, col0 = u.pn * BM + wc * 32 + 8 * fq;
        u32x4 r[2][4][2];
#pragma unroll
        for (int ai = 0; ai < 2; ++ai)
#pragma unroll
            for (int m = 0; m < 4; ++m)
#pragma unroll
                for (int bj = 0; bj < 2; ++bj) r[ai][m][bj] = *(const u32x4*)(RB + (size_t)(row0 + ai * HALF + m * 16) * DM + col0 + bj * HALF);
#pragma unroll
        for (int ai = 0; ai < 2; ++ai)
#pragma unroll
            for (int m = 0; m < 4; ++m) { const int row = row0 + ai * HALF + m * 16; float ss = 0.f;
#pragma unroll
                for (int bj = 0; bj < 2; ++bj) { const u32x4 q = r[ai][m][bj];
                    const f32x4 r0 = {__builtin_bit_cast(float, q.x << 16), __builtin_bit_cast(float, q.x & 0xffff0000u), __builtin_bit_cast(float, q.y << 16), __builtin_bit_cast(float, q.y & 0xffff0000u)};
                    const f32x4 r1 = {__builtin_bit_cast(float, q.z << 16), __builtin_bit_cast(float, q.z & 0xffff0000u), __builtin_bit_cast(float, q.w << 16), __builtin_bit_cast(float, q.w & 0xffff0000u)};
                    const f32x4 v0 = acc[ai][bj][m][0] + r0, v1 = acc[ai][bj][m][1] + r1;
                    float* xp = X + (size_t)row * DM + col0 + bj * HALF; *(f32x4*)xp = v0; *(f32x4*)(xp + 4) = v1;
                    ss += (v0[0] * v0[0] + v0[1] * v0[1]) + (v0[2] * v0[2] + v0[3] * v0[3]) + (v1[0] * v1[0] + v1[1] * v1[1]) + (v1[2] * v1[2] + v1[3] * v1[3]); }
                ss += __shfl_xor(ss, 16); ss += __shfl_xor(ss, 32);
                if (fq == 0) slab[(size_t)row * 32 + u.pn * 4 + wc] = ss; }
    }
};

struct PanelOrder {
    int G, vcu, ntot;
    __device__ __forceinline__ bool next(int i, Unit& u) const { const int L = i * G + vcu; if (L >= ntot) return false; u.pm = L >> 3; u.pn = L & 7; u.hs = 0; return true; }
    __device__ __forceinline__ void a_ready(const Unit&) const {}
    __device__ __forceinline__ void done(const Unit&) const {}
};
struct OneUnit {
    int pm, pn;
    __device__ __forceinline__ bool next(int i, Unit& u) const { if (i) return false; u.pm = pm; u.pn = pn; u.hs = 0; return true; }
    __device__ __forceinline__ void a_ready(const Unit&) const {}
    __device__ __forceinline__ void done(const Unit&) const {}
};
struct EpiVt {
    static constexpr bool PERM = true, AFTER_DRAIN = false, AMAP2 = false;
    bf16_t* VT;
    __device__ __forceinline__ void operator()(const f32x4 (&acc)[2][2][4][2], const Unit& u, int wr, int wc, int fr_, int fq_, PG8_LAS unsigned char*) const {
        int t_ = threadIdx.x; asm volatile("" : "+v"(t_));
        const int fr = t_ & 15, fq = (t_ >> 4) & 3;
#pragma unroll
        for (int ai = 0; ai < 2; ++ai)
#pragma unroll
            for (int m = 0; m < 4; ++m) { const int d = u.pm * BM + ai * HALF + wr * 64 + m * 16 + fr; bf16_t* rowp = VT + (size_t)((d & ~31) + invperm32(d & 31)) * 256;
#pragma unroll
                for (int bj = 0; bj < 2; ++bj)
#pragma unroll
                    for (int n = 0; n < 2; ++n) { const f32x4 v = acc[ai][bj][m][n]; u32x2 w; w.x = cvt_pk_bf16(v[0], v[1]); w.y = cvt_pk_bf16(v[2], v[3]);
                        *(u32x2*)(rowp + 32 * (2 * wc + bj) + 8 * (2 * (fq & 1) + n) + 4 * (fq >> 1)) = w; } }
    }
};
template <int MODE  > struct EpiNorm {
    static constexpr bool PERM = true, AFTER_DRAIN = false, AMAP2 = false;
    const float* Rf; const bf16_t* Rb; const float* sig_in; float* sig_out; bf16_t* HN; float* OUT; const float* gfin; unsigned* xbuf; unsigned* cnt; unsigned* tmo;
    __device__ __forceinline__ void operator()(f32x4 (&acc)[2][2][4][2], const Unit& u, int wr, int wc, int fr_, int fq_, PG8_LAS unsigned char* xlds) const {
        int t_ = threadIdx.x; asm volatile("" : "+v"(t_));
        const int fr = t_ & 15, fq = (t_ >> 4) & 3, wid = __builtin_amdgcn_readfirstlane(t_ >> 6);
        const int rl0 = wr * 64 + fr, row0 = u.pm * BM + rl0, col0 = u.pn * BM + wc * 64 + 8 * fq;
        PG8_LAS float* Pt = (PG8_LAS float*)xlds;
        PG8_LAS float* St = (PG8_LAS float*)(xlds + 4096);
        if constexpr (MODE == 0) {
            f32x4 gi[2][2];
#pragma unroll
            for (int bj = 0; bj < 2; ++bj) { gi[bj][0] = *(const f32x4*)(gfin + col0 + bj * 32); gi[bj][1] = *(const f32x4*)(gfin + col0 + bj * 32 + 4); }
#pragma unroll
            for (int ai = 0; ai < 2; ++ai) { u32x4 r[4][2]; float sg[4];
#pragma unroll
                for (int m = 0; m < 4; ++m) { sg[m] = sig_in[row0 + ai * HALF + m * 16];
#pragma unroll
                    for (int bj = 0; bj < 2; ++bj) r[m][bj] = __builtin_nontemporal_load((const u32x4*)(Rb + (size_t)(row0 + ai * HALF + m * 16) * DM + col0 + bj * 32)); }
#pragma unroll
                for (int m = 0; m < 4; ++m) { float ss = 0.f; const float sgm = sg[m];
#pragma unroll
                    for (int bj = 0; bj < 2; ++bj) { const u32x4 q = r[m][bj];
                        const f32x4 r0 = {__builtin_bit_cast(float, q.x << 16), __builtin_bit_cast(float, q.x & 0xffff0000u), __builtin_bit_cast(float, q.y << 16), __builtin_bit_cast(float, q.y & 0xffff0000u)};
                        const f32x4 r1 = {__builtin_bit_cast(float, q.z << 16), __builtin_bit_cast(float, q.z & 0xffff0000u), __builtin_bit_cast(float, q.w << 16), __builtin_bit_cast(float, q.w & 0xffff0000u)};
                        const f32x4 v0 = acc[ai][bj][m][0] + r0 * gi[bj][0] * sgm, v1 = acc[ai][bj][m][1] + r1 * gi[bj][1] * sgm; acc[ai][bj][m][0] = v0; acc[ai][bj][m][1] = v1;
                        ss += (v0[0] * v0[0] + v0[1] * v0[1]) + (v0[2] * v0[2] + v0[3] * v0[3]) + (v1[0] * v1[0] + v1[1] * v1[1]) + (v1[2] * v1[2] + v1[3] * v1[3]); }
                    ss += __shfl_xor(ss, 16); ss += __shfl_xor(ss, 32);
                    if (fq == 0) Pt[(ai * HALF + rl0 + m * 16) * 4 + wc] = ss; }
                asm volatile("" ::: "memory"); }
        } else {
#pragma unroll
            for (int ai = 0; ai < 2; ++ai) { u32x4 r[4][2]; float sg[4];
#pragma unroll
                for (int m = 0; m < 4; ++m) { sg[m] = sig_in[row0 + ai * HALF + m * 16];
#pragma unroll
                    for (int bj = 0; bj < 2; ++bj) r[m][bj] = __builtin_nontemporal_load((const u32x4*)(Rb + (size_t)(row0 + ai * HALF + m * 16) * DM + col0 + bj * 32)); }
#pragma unroll
                for (int m = 0; m < 4; ++m) { float ss = 0.f; const float sgm = sg[m];
#pragma unroll
                    for (int bj = 0; bj < 2; ++bj) { const u32x4 q = r[m][bj];
                        const f32x4 r0 = {__builtin_bit_cast(float, q.x << 16), __builtin_bit_cast(float, q.x & 0xffff0000u), __builtin_bit_cast(float, q.y << 16), __builtin_bit_cast(float, q.y & 0xffff0000u)};
                        const f32x4 r1 = {__builtin_bit_cast(float, q.z << 16), __builtin_bit_cast(float, q.z & 0xffff0000u), __builtin_bit_cast(float, q.w << 16), __builtin_bit_cast(float, q.w & 0xffff0000u)};
                        const f32x4 v0 = acc[ai][bj][m][0] + r0 * sgm, v1 = acc[ai][bj][m][1] + r1 * sgm; acc[ai][bj][m][0] = v0; acc[ai][bj][m][1] = v1;
                        ss += (v0[0] * v0[0] + v0[1] * v0[1]) + (v0[2] * v0[2] + v0[3] * v0[3]) + (v1[0] * v1[0] + v1[1] * v1[1]) + (v1[2] * v1[2] + v1[3] * v1[3]); }
                    ss += __shfl_xor(ss, 16); ss += __shfl_xor(ss, 32);
                    if (fq == 0) Pt[(ai * HALF + rl0 + m * 16) * 4 + wc] = ss; }
                asm volatile("" ::: "memory"); } }
        asm volatile("s_waitcnt lgkmcnt(0)" ::: "memory"); __builtin_amdgcn_s_barrier(); asm volatile("" ::: "memory");
        if (t_ < 256) { const float s = (Pt[t_ * 4 + 0] + Pt[t_ * 4 + 1]) + (Pt[t_ * 4 + 2] + Pt[t_ * 4 + 3]);
            __hip_atomic_store(xbuf + (size_t)(u.pm * BM + t_) * 8 + u.pn, __builtin_bit_cast(unsigned, s), __ATOMIC_RELAXED, __HIP_MEMORY_SCOPE_AGENT); }
        asm volatile("s_waitcnt vmcnt(0)" ::: "memory");
        if (t_ < 256 && (t_ & 63) == 0) __hip_atomic_fetch_add(cnt + 64 * u.pm, 1u, __ATOMIC_RELAXED, __HIP_MEMORY_SCOPE_AGENT);
        if (wid == 0) {
            unsigned spins = 0;
            while ((unsigned)__builtin_amdgcn_readfirstlane(__hip_atomic_load(cnt + 64 * u.pm, __ATOMIC_RELAXED, __HIP_MEMORY_SCOPE_AGENT)) < 32u) {
                __builtin_amdgcn_s_sleep(2);
                if (++spins > (1u << 20)) { if ((t_ & 63) == 0) __hip_atomic_store(tmo, 1u, __ATOMIC_RELAXED, __HIP_MEMORY_SCOPE_AGENT); break; } }
#if XCHG_ACQUIRE
            __builtin_amdgcn_fence(__ATOMIC_ACQUIRE, "agent");
#endif
        }
        asm volatile("s_waitcnt vmcnt(0) lgkmcnt(0)" ::: "memory"); __builtin_amdgcn_s_barrier(); asm volatile("" ::: "memory");
        if (t_ < 256) { const unsigned long long* sp = (const unsigned long long*)(xbuf + (size_t)(u.pm * BM + t_) * 8); float tot = 0.f;
#pragma unroll
            for (int q = 0; q < 4; ++q) { const unsigned long long w = __hip_atomic_load(sp + q, __ATOMIC_RELAXED, __HIP_MEMORY_SCOPE_AGENT);
                tot += __builtin_bit_cast(float, (unsigned)w); tot += __builtin_bit_cast(float, (unsigned)(w >> 32)); }
            const float sd = sqrtf(tot * (1.0f / DM) + RMS_EPS);
            St[t_] = 1.0f / sd;
            if (MODE == 0 && u.pn == 0) sig_out[u.pm * BM + t_] = sd; }
        asm volatile("s_waitcnt lgkmcnt(0)" ::: "memory"); __builtin_amdgcn_s_barrier(); asm volatile("" ::: "memory");
        if constexpr (MODE == 0) {
            const bool odd = fr & 1;
#pragma unroll
            for (int ai = 0; ai < 2; ++ai)
#pragma unroll
                for (int m = 0; m < 4; ++m) { const float rstd = St[ai * HALF + rl0 + m * 16]; u32x4 w0, w1, dA, dB;
                    { const f32x4 v0 = acc[ai][0][m][0] * rstd, v1 = acc[ai][0][m][1] * rstd; w0.x = cvt_pk_bf16(v0[0], v0[1]); w0.y = cvt_pk_bf16(v0[2], v0[3]); w0.z = cvt_pk_bf16(v1[0], v1[1]); w0.w = cvt_pk_bf16(v1[2], v1[3]); }
                    { const f32x4 v0 = acc[ai][1][m][0] * rstd, v1 = acc[ai][1][m][1] * rstd; w1.x = cvt_pk_bf16(v0[0], v0[1]); w1.y = cvt_pk_bf16(v0[2], v0[3]); w1.z = cvt_pk_bf16(v1[0], v1[1]); w1.w = cvt_pk_bf16(v1[2], v1[3]); }
                    qswap_pieces(w0, w1, odd, dA, dB);
                    bf16_t* p = HN + (size_t)((row0 & ~1) + ai * HALF + m * 16) * DM + col0 + (odd ? 32 : 0);
                    if (NT_OUT & 2) { __builtin_nontemporal_store(dA, (u32x4*)p); __builtin_nontemporal_store(dB, (u32x4*)(p + DM)); } else { *(u32x4*)p = dA; *(u32x4*)(p + DM) = dB; } }
        } else {
            const bool odd = fr & 1;
            f32x4 gg[2][2];
#pragma unroll
            for (int bj = 0; bj < 2; ++bj)
#pragma unroll
                for (int n = 0; n < 2; ++n) gg[bj][n] = *(const f32x4*)(gfin + col0 + bj * 32 + 4 * n);
#pragma unroll
            for (int ai = 0; ai < 2; ++ai)
#pragma unroll
                for (int m = 0; m < 4; ++m) { const float rstd = St[ai * HALF + rl0 + m * 16]; float* op = OUT + (size_t)(row0 + ai * HALF + m * 16) * DM + col0;
#pragma unroll
                    for (int bj = 0; bj < 2; ++bj) {
                        const f32x4 o0 = acc[ai][bj][m][0] * rstd * gg[bj][0], o1 = acc[ai][bj][m][1] * rstd * gg[bj][1]; f32x4 dA, dB;
#pragma unroll
                        for (int j = 0; j < 4; ++j) { const float snd = odd ? o0[j] : o1[j];
                            const float rcv = __builtin_bit_cast(float, __builtin_amdgcn_mov_dpp(__builtin_bit_cast(int, snd), 0xB1, 0xf, 0xf, false));
                            dA[j] = odd ? rcv : o0[j]; dB[j] = odd ? o1[j] : rcv; }
                        float* pp = op + bj * 32 + (odd ? 4 : 0);
                        __builtin_nontemporal_store(dA, (f32x4*)(pp - (odd ? DM : 0))); __builtin_nontemporal_store(dB, (f32x4*)(pp + (odd ? 0 : DM))); } }
        }
    }
};

__device__ __forceinline__ float dpp_shr1(float old, float src) { return __builtin_bit_cast(float, __builtin_amdgcn_update_dpp(__builtin_bit_cast(int, old), __builtin_bit_cast(int, src), 0x111, 0xf, 0xf, false)); }
__device__ __forceinline__ float dpp_shr2(float old, float src) { return __builtin_bit_cast(float, __builtin_amdgcn_update_dpp(__builtin_bit_cast(int, old), __builtin_bit_cast(int, src), 0x112, 0xf, 0xf, false)); }
__device__ __forceinline__ float dpp_ror1(float src) { return __builtin_bit_cast(float, __builtin_amdgcn_mov_dpp(__builtin_bit_cast(int, src), 0x121, 0xf, 0xf, false)); }
__device__ __forceinline__ float dpp_ror2(float src) { return __builtin_bit_cast(float, __builtin_amdgcn_mov_dpp(__builtin_bit_cast(int, src), 0x122, 0xf, 0xf, false)); }
constexpr int FF = 5632, FF2 = 11264;
typedef _Float16 h2_t __attribute__((ext_vector_type(2)));
__device__ __forceinline__ unsigned pkh(float a, float b) { return __builtin_bit_cast(unsigned, __builtin_amdgcn_cvt_pkrtz(a, b)); }
__device__ __forceinline__ unsigned dppu_shr1(unsigned old, unsigned src) { return (unsigned)__builtin_amdgcn_update_dpp((int)old, (int)src, 0x111, 0xf, 0xf, false); }
__device__ __forceinline__ unsigned dppu_shr2(unsigned old, unsigned src) { return (unsigned)__builtin_amdgcn_update_dpp((int)old, (int)src, 0x112, 0xf, 0xf, false); }
__device__ __forceinline__ unsigned dppu_ror1(unsigned src) { return (unsigned)__builtin_amdgcn_mov_dpp((int)src, 0x121, 0xf, 0xf, false); }
__device__ __forceinline__ unsigned dppu_ror2(unsigned src) { return (unsigned)__builtin_amdgcn_mov_dpp((int)src, 0x122, 0xf, 0xf, false); }
struct EpiAct {
    static constexpr bool PERM = true, AFTER_DRAIN = false, AMAP2 = true;
    bf16_t* ACT; const float* cw; const float* cb; float* ubnd;
    __device__ __forceinline__ void operator()(f32x4 (&acc)[2][2][4][2], const Unit& u, int wr, int wc, int fr_, int fq_, PG8_LAS unsigned char* xlds) const {
        int t_ = threadIdx.x; asm volatile("" : "+v"(t_));
        const int fr = t_ & 15, fq = (t_ >> 4) & 3;
        const int row0 = u.pm * BM + wr * 128 + fr, cl = wc * 32 + 8 * fq;
        const int c0 = u.pn * 128 + cl;
        PG8_LAS float* wl = (PG8_LAS float*)(xlds + 2048 + __builtin_amdgcn_readfirstlane(t_ >> 6) * 1024);
        { const int l = t_ & 63, arr = l >> 3, cc = u.pn * 128 + wc * 32 + 4 * (l & 7);
          const float* src = (arr & 3) == 3 ? cb + cc + (arr >> 2) * FF : cw + (arr & 3) * FF2 + cc + (arr >> 2) * FF;
          *(PG8_LAS f32x4*)(wl + arr * 32 + 4 * (l & 7)) = *(const f32x4*)src; }
        if (wr == 1 && fr >= 14) {
#pragma unroll
            for (int bj = 0; bj < 2; ++bj)
#pragma unroll
                for (int n = 0; n < 2; ++n) *(f32x4*)(ubnd + (size_t)(u.pm * 4 + 2 + (fr - 14)) * FF2 + u.pn * BM + 64 * wc + 32 * bj + 8 * fq + 4 * n) = acc[1][bj][3][n]; }
        if (wr == 0 && fr < 2) {
#pragma unroll
            for (int bj = 0; bj < 2; ++bj)
#pragma unroll
                for (int n = 0; n < 2; ++n) *(f32x4*)(ubnd + (size_t)(u.pm * 4 + fr) * FF2 + u.pn * BM + 64 * wc + 32 * bj + 8 * fq + 4 * n) = acc[0][bj][0][n]; }
        u32x4 pk[2][4][2];
#pragma unroll
        for (int ai = 0; ai < 2; ++ai)
#pragma unroll
            for (int m = 0; m < 4; ++m)
#pragma unroll
                for (int n = 0; n < 2; ++n) { const f32x4 g = acc[ai][0][m][n], v = acc[ai][1][m][n]; pk[ai][m][n] = (u32x4){pkh(g[0], v[0]), pkh(g[1], v[1]), pkh(g[2], v[2]), pkh(g[3], v[3])}; }
        volatile PG8_LAS unsigned* flag = (volatile PG8_LAS unsigned*)(xlds - 640) + wc;
        if (wr == 0) {
            if (fr >= 14) {
#pragma unroll
                for (int n = 0; n < 2; ++n) *(PG8_LAS u32x4*)(xlds + ((((fr - 14)) * 128 + cl + 4 * n) << 2)) = pk[1][3][n]; }
            asm volatile("s_waitcnt lgkmcnt(0)" ::: "memory");
            if ((t_ & 63) == 0) *flag = (unsigned)u.seq;
        }
        u32x4 bnd[2] = {{0u, 0u, 0u, 0u}, {0u, 0u, 0u, 0u}};
        if (wr == 1) {
            unsigned spins = 0;
            while (*flag < (unsigned)u.seq) { __builtin_amdgcn_s_sleep(1); if (++spins > (1u << 22)) break; }
            asm volatile("" ::: "memory");
#pragma unroll
            for (int n = 0; n < 2; ++n) bnd[n] = *(const PG8_LAS u32x4*)(xlds + ((((fr & 1)) * 128 + cl + 4 * n) << 2));
        }
        asm volatile("s_waitcnt vmcnt(0) lgkmcnt(0)" ::: "memory");
        f32x4 wgt[2][8];
#pragma unroll
        for (int n = 0; n < 2; ++n)
#pragma unroll
            for (int a = 0; a < 8; ++a) wgt[n][a] = *(const PG8_LAS f32x4*)(wl + a * 32 + 8 * fq + 4 * n);
        u32x2 hold[2][4];
#pragma unroll
        for (int n = 0; n < 2; ++n) {
            h2_t w0p[4], w1p[4], w2p[4], bp4[4];
#pragma unroll
            for (int j = 0; j < 4; ++j) { w0p[j] = __builtin_bit_cast(h2_t, pkh(wgt[n][0][j], wgt[n][4][j])); w1p[j] = __builtin_bit_cast(h2_t, pkh(wgt[n][1][j], wgt[n][5][j]));
                w2p[j] = __builtin_bit_cast(h2_t, pkh(wgt[n][2][j], wgt[n][6][j])); bp4[j] = __builtin_bit_cast(h2_t, pkh(wgt[n][3][j], wgt[n][7][j])); }
            u32x4 pp = bnd[n];
#pragma unroll
            for (int ai = 0; ai < 2; ++ai) {
#pragma unroll
                for (int m = 0; m < 4; ++m) {
                    const u32x4 cur = pk[ai][m][n]; float a[4];
#pragma unroll
                    for (int j = 0; j < 4; ++j) {
                        const unsigned cj = cur[j], pj = pp[j];
                        const h2_t s1 = __builtin_bit_cast(h2_t, dppu_shr1(dppu_ror1(pj), cj)), s2 = __builtin_bit_cast(h2_t, dppu_shr2(dppu_ror2(pj), cj)), ch = __builtin_bit_cast(h2_t, cj);
                        const h2_t r = w2p[j] * ch + (w1p[j] * s1 + (w0p[j] * s2 + bp4[j]));
                        const float G = (float)r.x, V = (float)r.y;
                        a[j] = G * __builtin_amdgcn_rcpf(1.0f + __builtin_amdgcn_exp2f(-1.4426950408889634f * G)) * V; }
                    u32x2 w; w.x = cvt_pk_bf16(a[0], a[1]); w.y = cvt_pk_bf16(a[2], a[3]);
                    if (n == 0) hold[ai][m] = w;
                    else { u32x4 o; o.x = hold[ai][m].x; o.y = hold[ai][m].y; o.z = w.x; o.w = w.y;
                        if (!(ai == 0 && m == 0 && wr == 0 && u.pm > 0 && fr < 2)) { if (NT_OUT & 4) __builtin_nontemporal_store(o, (u32x4*)(ACT + (size_t)(row0 + ai * 64 + m * 16) * FF + c0)); else *(u32x4*)(ACT + (size_t)(row0 + ai * 64 + m * 16) * FF + c0) = o; } }
                    pp = cur;
                }
            }
        }
    }
};

template <class Epi, class Sched, bool ALIGN_EPI = false, bool SP2 = false, int AUXB = 0  , bool HALFU = false  , bool EARLYA = false  >
__device__ __forceinline__ void gemm_phase(PG8_LAS unsigned char* lds, const Gemm g, const Sched& S, const Epi& E, PG8_LAS unsigned char* xlds) {
    int tid_ = threadIdx.x; asm volatile("" : "+v"(tid_));
    const int tid = tid_, wid = __builtin_amdgcn_readfirstlane(tid >> 6), lane = tid & 63, wr = wid >> 2, wc = wid & 3, fr = lane & 15, fq = lane >> 4;
    const int K = g.K, nt = K / BK;
    unsigned voffA[2], voffB[2];
#pragma unroll
    for (int i = 0; i < 2; ++i) { int R, C; stage_rc(tid * 16 + i * 8192, R, C); const int Rb0 = Epi::PERM ? (64 * (R >> 5) + perm32(R & 31)) : R;
        const int Ra0 = Epi::AMAP2 ? (128 * (R >> 6) + (R & 63)) : R;
        voffA[i] = (unsigned)(Ra0 * K + C) * 2u; voffB[i] = (unsigned)(Rb0 * K + C) * 2u; }
    const size_t kstep = (size_t)(BK * 2);
    const size_t hstep = (size_t)HALF * K * 2;
    const size_t hA = Epi::AMAP2 ? (size_t)64 * K * 2 : hstep, hB = Epi::PERM ? (size_t)32 * K * 2 : hstep;
    const size_t tstep = 2 * hstep;
    const unsigned ldsw = (unsigned)wid * 1024u;
    const int aoff = lds_byte(wr * 64 + fr, fq * 8), boff = lds_byte(wc * 32 + fr, fq * 8);
#define PG8_SA(b, h) (((b) * 2 + (h)) * HTB)
#define PG8_SB(b, h) ((4 + (b) * 2 + (h)) * HTB)
#if PG8_T8
    const __amdgpu_buffer_rsrc_t rsA = __builtin_amdgcn_make_buffer_rsrc((void*)g.A, 0, 0x7fffffff, 0x00020000), rsB = __builtin_amdgcn_make_buffer_rsrc((void*)g.Bt, 0, 0x7fffffff, 0x00020000);
#define PG8_STAGE(bufoff, gbase, voff) do { const int _so = (int)((const char*)(gbase) - (const char*)g.A); _Pragma("unroll") for (int _i = 0; _i < 2; ++_i) \
        __builtin_amdgcn_raw_ptr_buffer_load_lds(rsA, (PG8_LAS void*)(lds + (bufoff) + ldsw + _i * 8192), 16, (int)(voff)[_i], _so, 0, 0); } while (0)
#define PG8_STAGEB(bufoff, gbase, voff) do { const int _so = (int)((const char*)(gbase) - (const char*)g.Bt); _Pragma("unroll") for (int _i = 0; _i < 2; ++_i) \
        __builtin_amdgcn_raw_ptr_buffer_load_lds(rsB, (PG8_LAS void*)(lds + (bufoff) + ldsw + _i * 8192), 16, (int)(voff)[_i], _so, 0, AUXB); } while (0)
#else
#define PG8_STAGE(bufoff, gbase, voff) do { _Pragma("unroll") for (int _i = 0; _i < 2; ++_i) \
        __builtin_amdgcn_global_load_lds((const unsigned*)((const char*)(gbase) + (voff)[_i]), (PG8_LAS unsigned*)(lds + (bufoff) + ldsw + _i * 8192), 16, 0, 0); } while (0)
#define PG8_STAGEB(bufoff, gbase, voff) do { _Pragma("unroll") for (int _i = 0; _i < 2; ++_i) \
        __builtin_amdgcn_global_load_lds((const unsigned*)((const char*)(gbase) + (voff)[_i]), (PG8_LAS unsigned*)(lds + (bufoff) + ldsw + _i * 8192), 16, 0, AUXB); } while (0)
#endif
#define PG8_LDA(dst, b, h) do { _Pragma("unroll") for (int m = 0; m < 4; ++m) _Pragma("unroll") for (int k = 0; k < 2; ++k) dst[m][k] = *(const PG8_LAS bf16x8*)(lds + PG8_SA(b, h) + aoff + m * 2048 + k * 1024); } while (0)
#define PG8_LDB(dst, b, h) do { _Pragma("unroll") for (int n = 0; n < 2; ++n) _Pragma("unroll") for (int k = 0; k < 2; ++k) dst[n][k] = *(const PG8_LAS bf16x8*)(lds + PG8_SB(b, h) + boff + n * 2048 + k * 1024); } while (0)
#define PG8_MMA(ai, bj, At, Bt) do { __builtin_amdgcn_s_setprio(PG8_PRIO); _Pragma("unroll") for (int m = 0; m < 4; ++m) _Pragma("unroll") for (int n = 0; n < 2; ++n) _Pragma("unroll") for (int k = 0; k < 2; ++k) \
        acc[ai][bj][m][n] = __builtin_amdgcn_mfma_f32_16x16x32_bf16(Bt[n][k], At[m][k], acc[ai][bj][m][n], 0, 0, 0); __builtin_amdgcn_s_setprio(0); } while (0)
#define PG8_WAIT_V(n) asm volatile("s_waitcnt vmcnt(" #n ")" ::: "memory")
#define PG8_WAIT_L(n) asm volatile("s_waitcnt lgkmcnt(" #n ")" ::: "memory")
#define PG8_BAR __builtin_amdgcn_s_barrier()
#define PG8_SCHED __builtin_amdgcn_sched_barrier(0)
    Unit cur, nxt; int ui = 0;
    if (!S.next(0, cur)) return;
    f32x4 acc[2][2][4][2];
#pragma unroll
    for (int a = 0; a < 2; ++a)
#pragma unroll
        for (int b = 0; b < 2; ++b)
#pragma unroll
            for (int m = 0; m < 4; ++m)
#pragma unroll
                for (int n = 0; n < 2; ++n) acc[a][b][m][n] = (f32x4){0.f, 0.f, 0.f, 0.f};
    bf16x8 At[4][2], B0[2][2], B1[2][2];
    const char* cA = (const char*)g.A + (size_t)cur.pm * tstep + ((HALFU && cur.hs == 2) ? hstep : 0); const char* cB = (const char*)g.Bt + (size_t)cur.pn * tstep;
    S.a_ready(cur);
    if constexpr (SP2) {
        PG8_STAGEB(PG8_SB(0, 0), cB, voffB); PG8_STAGEB(PG8_SB(0, 1), cB + hB, voffB); PG8_STAGE(PG8_SA(0, 0), cA, voffA); PG8_STAGE(PG8_SA(0, 1), cA + hA, voffA);
        if (wr == 1) PG8_BAR;
        PG8_WAIT_V(2); PG8_BAR;
        PG8_STAGEB(PG8_SB(1, 0), cB + kstep, voffB); PG8_STAGE(PG8_SA(1, 0), cA + kstep, voffA); PG8_STAGEB(PG8_SB(1, 1), cB + kstep + hB, voffB);
        PG8_WAIT_V(6); PG8_BAR;
    } else {
        PG8_STAGEB(PG8_SB(0, 0), cB, voffB); PG8_STAGE(PG8_SA(0, 0), cA, voffA); PG8_STAGEB(PG8_SB(0, 1), cB + hB, voffB); PG8_STAGE(PG8_SA(0, 1), cA + hA, voffA);
        if (wr == 1) PG8_BAR;
        PG8_WAIT_V(4); PG8_BAR;
        PG8_STAGEB(PG8_SB(1, 0), cB + kstep, voffB); PG8_STAGE(PG8_SA(1, 0), cA + kstep, voffA); PG8_STAGEB(PG8_SB(1, 1), cB + kstep + hB, voffB);
        PG8_WAIT_V(6); PG8_BAR;
    }
    for (;;) {
        const bool has_next = S.next(ui + 1, nxt);
        const char* nA = has_next ? (const char*)g.A + (size_t)nxt.pm * tstep + ((HALFU && nxt.hs == 2) ? hstep : 0) : cA; const char* nB = has_next ? (const char*)g.Bt + (size_t)nxt.pn * tstep : cB;
        for (int t = 0; t < nt; t += 2) {
            const bool last = (t == nt - 2);
            const char* a1 = cA + (size_t)(t + 1) * kstep;
            const char* a2 = last ? nA : cA + (size_t)(t + 2) * kstep; const char* b2 = last ? nB : cB + (size_t)(t + 2) * kstep;
            const char* a3 = a2 + kstep; const char* b3 = b2 + kstep;
            if (last && has_next) S.a_ready(nxt);
            const bool sk = EARLYA && ui > 0 && t == 0;
            if constexpr (SP2) {
            PG8_LDB(B0, 0, 0); PG8_LDB(B1, 0, 1); PG8_SCHED; PG8_LDA(At, 0, 0); if (!sk) PG8_STAGE(PG8_SA(1, 1), a1 + hA, voffA);
            if (!sk) PG8_WAIT_V(8); PG8_WAIT_L(0); PG8_BAR; PG8_MMA(0, 0, At, B0); PG8_MMA(0, 1, At, B1); PG8_BAR; PG8_SCHED;
            PG8_LDA(At, 0, 1); PG8_STAGEB(PG8_SB(0, 0), b2, voffB); PG8_STAGEB(PG8_SB(0, 1), b2 + hB, voffB); PG8_STAGE(PG8_SA(0, 0), a2, voffA);
            if (!sk) PG8_WAIT_V(8); PG8_WAIT_L(0); PG8_BAR; if (!(HALFU && cur.hs)) { PG8_MMA(1, 0, At, B0); PG8_MMA(1, 1, At, B1); } PG8_BAR; PG8_SCHED;
            PG8_LDB(B0, 1, 0); PG8_LDB(B1, 1, 1); PG8_SCHED; PG8_LDA(At, 1, 0); PG8_STAGE(PG8_SA(0, 1), a2 + hA, voffA);
            if (!sk) PG8_WAIT_V(8); PG8_WAIT_L(0); PG8_BAR; PG8_MMA(0, 0, At, B0); PG8_MMA(0, 1, At, B1); PG8_BAR; PG8_SCHED;
            PG8_LDA(At, 1, 1); PG8_STAGEB(PG8_SB(1, 0), b3, voffB); PG8_STAGEB(PG8_SB(1, 1), b3 + hB, voffB); PG8_STAGE(PG8_SA(1, 0), a3, voffA);
            PG8_WAIT_V(8); PG8_WAIT_L(0); PG8_BAR; if (!(HALFU && cur.hs)) { PG8_MMA(1, 0, At, B0); PG8_MMA(1, 1, At, B1); } PG8_BAR; PG8_SCHED;
            } else {
            PG8_LDB(B0, 0, 0); PG8_SCHED; PG8_LDA(At, 0, 0); PG8_STAGE(PG8_SA(1, 1), a1 + hA, voffA);
            PG8_WAIT_L(8); PG8_BAR; PG8_WAIT_L(0); PG8_MMA(0, 0, At, B0); PG8_BAR; PG8_SCHED;
            PG8_LDB(B1, 0, 1); PG8_STAGEB(PG8_SB(0, 0), b2, voffB);
            PG8_BAR; PG8_WAIT_L(0); PG8_MMA(0, 1, At, B1); PG8_BAR;
            PG8_LDA(At, 0, 1); PG8_STAGE(PG8_SA(0, 0), a2, voffA);
            PG8_BAR; PG8_WAIT_L(0); PG8_MMA(1, 0, At, B0); PG8_BAR; PG8_SCHED;
            PG8_STAGEB(PG8_SB(0, 1), b2 + hB, voffB);
            PG8_WAIT_V(6); PG8_BAR; PG8_MMA(1, 1, At, B1); PG8_BAR;
            PG8_LDB(B0, 1, 0); PG8_SCHED; PG8_LDA(At, 1, 0); PG8_STAGE(PG8_SA(0, 1), a2 + hA, voffA);
            PG8_WAIT_L(8); PG8_BAR; PG8_WAIT_L(0); PG8_MMA(0, 0, At, B0); PG8_BAR; PG8_SCHED;
            PG8_LDB(B1, 1, 1); PG8_STAGEB(PG8_SB(1, 0), b3, voffB);
            PG8_BAR; PG8_WAIT_L(0); PG8_MMA(0, 1, At, B1); PG8_BAR;
            PG8_LDA(At, 1, 1); PG8_STAGE(PG8_SA(1, 0), a3, voffA);
            PG8_BAR; PG8_WAIT_L(0); PG8_MMA(1, 0, At, B0); PG8_BAR; PG8_SCHED;
            PG8_STAGEB(PG8_SB(1, 1), b3 + hB, voffB);
            PG8_WAIT_V(6); PG8_BAR; PG8_MMA(1, 1, At, B1); PG8_BAR;
            }
        }
        if constexpr (ALIGN_EPI) { if (wr == 0) PG8_BAR; }
        if constexpr (EARLYA) { static_assert(!EARLYA || (ALIGN_EPI && SP2), "early As[1][1] needs the aligned epilogue"); if (has_next) PG8_STAGE(PG8_SA(1, 1), nA + kstep + hA, voffA); }
        cur.seq = ui + 1;
        if constexpr (!Epi::AFTER_DRAIN) { E(acc, cur, wr, wc, fr, fq, xlds); S.done(cur); }
        if (!has_next) break;
#pragma unroll
        for (int a = 0; a < 2; ++a)
#pragma unroll
            for (int b = 0; b < 2; ++b)
#pragma unroll
                for (int m = 0; m < 4; ++m)
#pragma unroll
                    for (int n = 0; n < 2; ++n) acc[a][b][m][n] = (f32x4){0.f, 0.f, 0.f, 0.f};
        cur = nxt; cA = nA; cB = nB; ++ui;
        if constexpr (ALIGN_EPI) { if (wr == 1) PG8_BAR; }
    }
    PG8_WAIT_V(0);
    if constexpr (!ALIGN_EPI) { if (wr == 0) PG8_BAR; }
    PG8_BAR;

#undef PG8_SA
#undef PG8_SB
#undef PG8_STAGE
#undef PG8_STAGEB
#undef PG8_LDA
#undef PG8_LDB
#undef PG8_MMA
#undef PG8_WAIT_V
#undef PG8_WAIT_L
#undef PG8_BAR
#undef PG8_SCHED
}
}

#define GAS __attribute__((address_space(1)))
#define LAS __attribute__((address_space(3)))
typedef unsigned short bf16;
typedef float f32x4 __attribute__((ext_vector_type(4)));
typedef short bf16x8 __attribute__((ext_vector_type(8)));
typedef unsigned u32x4 __attribute__((ext_vector_type(4)));
typedef unsigned u32x2 __attribute__((ext_vector_type(2)));

constexpr int NWAVES = 8;
constexpr int SEQ = 16384, DMODEL = 2048, NMEM = 256, DIN = 3584, DCONV = 768, DPOOL = 768, DXATT = 512, DFF = 5632, DFF2 = 11264;
constexpr int PGD = 192;
constexpr float EPS = 1e-6f;
constexpr int LDS_BYTES = 147456;
#ifndef MK_PER_PHASE
#define MK_PER_PHASE 0
#endif
constexpr int NPHASE = 7;
#ifndef PHM
#define PHM 255
#endif
#ifndef FUSE_FIXUP
#define FUSE_FIXUP 1
#endif
#ifndef P1_WGM
#define P1_WGM 4
#endif
#ifndef P4_WGM
#define P4_WGM 4
#endif
#ifndef P1_ALIGN
#define P1_ALIGN false
#endif
#ifndef USE_CG_SYNC
#define USE_CG_SYNC 0
#endif
#ifndef PROBE_P2
#define PROBE_P2 0
#endif
#ifndef PROBE_SYNC
#define PROBE_SYNC 0
#endif
#ifndef PROBE_GEMM
#define PROBE_GEMM 0
#endif
#ifndef PROBE_N
#define PROBE_N 2048
#endif
#ifndef REPM
#define REPM 0
#endif

constexpr size_t MiB = 1u << 20;
constexpr size_t WS_KB = 1 * MiB;
constexpr size_t WS_VT = 1 * MiB + 256 * 1024;
constexpr size_t WS_POOLWT = 1 * MiB + 512 * 1024;
constexpr size_t WS_MB = 2 * MiB;
constexpr size_t WS_WKVT = 3 * MiB;
constexpr size_t WS_SIGX = 7 * MiB + 128 * 1024;
constexpr size_t WS_GINV = 7 * MiB + 256 * 1024;
constexpr size_t WS_SIG = 7 * MiB;
constexpr size_t WS_SLAB1 = 8 * MiB;
constexpr size_t WS_SLAB2 = 10 * MiB;
constexpr size_t WS_WUPT = 12 * MiB;
constexpr size_t WS_WDOWNT = 56 * MiB;
constexpr size_t WS_UBND = 80 * MiB;
constexpr size_t WS_X1B = 96 * MiB;
constexpr size_t WS_ACT = 160 * MiB;
constexpr size_t WS_H = 160 * MiB;
constexpr size_t WS_Z = 225 * MiB;
constexpr size_t WS_ZPAD = WS_Z - (size_t)16 * 3584 * 2;
constexpr size_t WS_MIX = 338 * MiB;
constexpr size_t WS_WINT = 402 * MiB;
constexpr size_t WS_WOUTT = 416 * MiB;
constexpr size_t WS_END = 424 * MiB;

__device__ __forceinline__ unsigned f2bf(float f) { unsigned u = __builtin_bit_cast(unsigned, f); return (u + 0x7fffu + ((u >> 16) & 1u)) >> 16; }
__device__ __forceinline__ unsigned pk2(float lo, float hi) { unsigned r; asm("v_cvt_pk_bf16_f32 %0, %1, %2" : "=v"(r) : "v"(lo), "v"(hi)); return r; }
__device__ __forceinline__ float bflo(unsigned w) { return __builtin_bit_cast(float, w << 16); }
__device__ __forceinline__ float bfhi(unsigned w) { return __builtin_bit_cast(float, w & 0xffff0000u); }
__device__ __forceinline__ void unpack8(const u32x4 w, float (&f)[8]) { f[0] = bflo(w.x); f[1] = bfhi(w.x); f[2] = bflo(w.y); f[3] = bfhi(w.y); f[4] = bflo(w.z); f[5] = bfhi(w.z); f[6] = bflo(w.w); f[7] = bfhi(w.w); }
__device__ __forceinline__ u32x4 pack8(const float (&f)[8]) { u32x4 w; w.x = pk2(f[0], f[1]); w.y = pk2(f[2], f[3]); w.z = pk2(f[4], f[5]); w.w = pk2(f[6], f[7]); return w; }
__device__ __forceinline__ float wave_sum(float v) {
#pragma unroll
    for (int o = 1; o < 64; o <<= 1) v += __shfl_xor(v, o);
    return v;
}
#define LDS_WAIT() asm volatile("s_waitcnt lgkmcnt(0)" ::: "memory")

typedef GAS unsigned gu32;
constexpr size_t WS_CTL = 0, CTL_ZERO_BYTES = 64 * 1024;
constexpr int CW_PANEL2 = 12288;
constexpr int CW_PANEL1 = 8192;
constexpr int CW_PANEL = 4096;
constexpr int MISC_OFF = 131072 + 320;
static_assert(131072 + 1024 - 640 == 131072 + 320 + 16 * 4, "EpiAct's hand-off flags are MISC[16..19]");
constexpr int XLDS_OFF = 131072 + 1024;
#define XB_TMO      128
#define XB_XCNT(j)  (256  + 64 * (j))
#define XB_XSUB(j)  (1280 + 64 * (j))
#define XB_XGEN(j)  (2304 + 64 * (j))
#define XB_TOP      3328
#define XB_TOPGEN   3392
#define XCD_BAR_WORDS 3456
#define XB_SPIN_CAP (1u << 18)

__device__ __forceinline__ unsigned xb_ld(unsigned* p)              { return __hip_atomic_load(p, __ATOMIC_RELAXED, __HIP_MEMORY_SCOPE_AGENT); }
__device__ __forceinline__ unsigned xb_add(unsigned* p, unsigned v) { return __hip_atomic_fetch_add(p, v, __ATOMIC_RELAXED, __HIP_MEMORY_SCOPE_AGENT); }
__device__ __forceinline__ unsigned xb_xcc_id() { return (unsigned)__builtin_amdgcn_s_getreg((3 << 11) | 20) & 0xFu; }
#define XB_SPIN(cond, bar) do { unsigned _sp = 0; while (cond) { __builtin_amdgcn_s_sleep(1); \
    if ((++_sp & 255u) == 0u) { if (xb_ld(&(bar)[XB_TMO])) break; if (_sp > XB_SPIN_CAP) { atomicAdd(&(bar)[XB_TMO], 1u); break; } } } } while (0)

struct XcdBarrier {
    unsigned* bar; unsigned x;
    volatile LAS unsigned* st;
};

__device__ __forceinline__ XcdBarrier xcd_barrier_post(unsigned* bar, volatile LAS unsigned* st) {
    XcdBarrier b; b.bar = bar; b.x = xb_xcc_id(); b.st = st;
    if (threadIdx.x == 0) (void)xb_add(&bar[XB_XCNT(b.x)], 1u);
    return b;
}
__device__ __forceinline__ void xcd_barrier_complete(unsigned* bar, unsigned x, unsigned& nloc, unsigned& nx) {
    const unsigned G = gridDim.x * gridDim.y * gridDim.z;
    unsigned sum, cnt, mine, sp = 0u;
    for (;;) {
        sum = 0u; cnt = 0u; mine = 0u;
#pragma unroll
        for (unsigned j = 0; j < 16; ++j) { const unsigned c = xb_ld(&bar[XB_XCNT(j)]); sum += c; cnt += (c > 0u) ? 1u : 0u; mine = (j == x) ? c : mine; }
        if (sum == G) break;
        __builtin_amdgcn_s_sleep(1);
        if ((++sp & 255u) == 0u) { if (xb_ld(&bar[XB_TMO])) break; if (sp > XB_SPIN_CAP) { atomicAdd(&bar[XB_TMO], 1u); break; } }
    }
    nloc = mine > 0u ? mine : 1u; nx = cnt > 0u ? cnt : 1u;
}

__device__ __forceinline__ void xcd_barrier(const XcdBarrier& b) {
    asm volatile("s_waitcnt vmcnt(0)" ::: "memory");
    __syncthreads();
    if (threadIdx.x == 0) {
        unsigned* bar = b.bar;
        __builtin_amdgcn_s_waitcnt(0);
        unsigned nloc = b.st[0], nx = b.st[1];
        if (nloc == 0u) { xcd_barrier_complete(bar, b.x, nloc, nx); b.st[0] = nloc; b.st[1] = nx; }
        const unsigned old = xb_add(&bar[XB_XSUB(b.x)], 1u);
        const unsigned gen = old / nloc;
        if (old + 1u == (gen + 1u) * nloc) {
            __builtin_amdgcn_fence(__ATOMIC_RELEASE, "agent");
            asm volatile("s_waitcnt vmcnt(0)" ::: "memory");
            const unsigned og = xb_add(&bar[XB_TOP], 1u);
            const unsigned tg = og / nx;
            if (og + 1u == (tg + 1u) * nx) xb_add(&bar[XB_TOPGEN], 1u);
            else XB_SPIN(xb_ld(&bar[XB_TOPGEN]) == tg, bar);
            __builtin_amdgcn_fence(__ATOMIC_ACQUIRE, "agent");
            xb_add(&bar[XB_XGEN(b.x)], 1u);
            asm volatile("s_waitcnt vmcnt(0)" ::: "memory");
        } else {
            XB_SPIN(xb_ld(&bar[XB_XGEN(b.x)]) == gen, bar);
            __builtin_amdgcn_fence(__ATOMIC_ACQUIRE, "agent");
            asm volatile("s_waitcnt vmcnt(0)" ::: "memory");
        }
    }
    __syncthreads();
}


struct TrItem { const float* src; const float* ks; bf16* dst; int N, K, skip, rperm; };
template <bool UPMAP> __device__ __forceinline__ TrItem tr_make(const float* W, int K, int N, bf16* WT, const float* ks, int item) {
    const int nblk = N / 64, kb = item / nblk, nb = item % nblk, k0 = 64 * kb, n0 = 64 * nb;
    const int np = (n0 < DFF) ? n0 : n0 - DFF;
    const int r0 = !UPMAP ? n0 : 256 * (np / 128) + 64 * ((np % 128) / 32) + ((n0 < DFF) ? 0 : 32);
    TrItem t; t.src = W + (size_t)k0 * N + n0; t.ks = ks ? ks + k0 : nullptr; t.dst = WT + (size_t)r0 * K + k0; t.N = N; t.K = K; t.skip = UPMAP ? 32 : 0; t.rperm = 0; return t;
}
__device__ __forceinline__ void tr_load(const TrItem& t, f32x4 (&v)[16], int lane) {
    const float* src = t.src + (size_t)(lane >> 4) * t.N + 4 * (lane & 15);
#pragma unroll
    for (int i = 0; i < 16; ++i) v[i] = TR_NT ? __builtin_nontemporal_load((const f32x4*)(src + (size_t)(4 * i) * t.N)) : *(const f32x4*)(src + (size_t)(4 * i) * t.N);
}
__device__ __forceinline__ void tr_store(const TrItem& t, const f32x4 (&v)[16], LAS float* scr, int lane) {
#pragma unroll
    for (int i = 0; i < 16; ++i) { f32x4 x = v[i]; if (t.ks) x = x * t.ks[4 * i + (lane >> 4)];
        *(LAS f32x4*)(scr + (4 * i + (lane >> 4)) * 64 + (((lane & 15) ^ ((i >> 1) & 7)) << 2)) = x; }
    LDS_WAIT(); asm volatile("" ::: "memory");
    const int c = lane & 7;
#pragma unroll
    for (int j = 0; j < 8; ++j) { const int nn = (lane >> 3) + 8 * j; const LAS float* sp = scr + (8 * c) * 64 + ((((nn >> 2) ^ c) & 15) << 2) + (nn & 3);
        u32x4 o; o.x = pk2(sp[0 * 64], sp[1 * 64]); o.y = pk2(sp[2 * 64], sp[3 * 64]); o.z = pk2(sp[4 * 64], sp[5 * 64]); o.w = pk2(sp[6 * 64], sp[7 * 64]);
        const int orow = t.rperm ? ((nn & ~31) + pg8::invperm32(nn & 31)) : nn + (nn >= 32 ? t.skip : 0);
        *(u32x4*)(t.dst + (size_t)orow * t.K + 8 * c) = o; }
    LDS_WAIT(); asm volatile("" ::: "memory");
}
__device__ __forceinline__ void rms_rows2_to_bf16(const float* xa, const float* xb, const float* g, bf16* oa, bf16* ob, int lane, float* sig2 = nullptr) {
    const f32x4* pa = (const f32x4*)xa + lane; const f32x4* pb = (const f32x4*)xb + lane; const f32x4* gr = (const f32x4*)g + lane;
    f32x4 va[8], vb[8]; float sa = 0.f, sb = 0.f;
#pragma unroll
    for (int j = 0; j < 8; ++j) { va[j] = __builtin_nontemporal_load(pa + 64 * j); vb[j] = __builtin_nontemporal_load(pb + 64 * j); }
#pragma unroll
    for (int j = 0; j < 8; ++j) { sa += (va[j].x * va[j].x + va[j].y * va[j].y) + (va[j].z * va[j].z + va[j].w * va[j].w); sb += (vb[j].x * vb[j].x + vb[j].y * vb[j].y) + (vb[j].z * vb[j].z + vb[j].w * vb[j].w); }
    const float da = sqrtf(wave_sum(sa) * (1.0f / DMODEL) + EPS), db = sqrtf(wave_sum(sb) * (1.0f / DMODEL) + EPS), ra = 1.0f / da, rb = 1.0f / db;
    if (sig2 && lane == 0) { sig2[0] = da; sig2[1] = db; }
    u32x2* qa = (u32x2*)oa + lane; u32x2* qb = (u32x2*)ob + lane;
#pragma unroll
    for (int j = 0; j < 8; ++j) { const f32x4 gg = gr[64 * j]; u32x2 w;
        w.x = pk2(va[j].x * ra * gg.x, va[j].y * ra * gg.y); w.y = pk2(va[j].z * ra * gg.z, va[j].w * ra * gg.w); qa[64 * j] = w;
        w.x = pk2(vb[j].x * rb * gg.x, vb[j].y * rb * gg.y); w.y = pk2(vb[j].z * rb * gg.z, vb[j].w * rb * gg.w); qb[64 * j] = w; }
}

struct Ptrs {
    const float *x, *mem, *g_mix, *g_mem, *w_in, *conv_w, *pool_w, *pool_scale, *w_kv, *w_out, *g_ffn, *w_up, *ffn_conv_w, *ffn_conv_b, *w_down, *g_final;
    float* out; unsigned char* ws;
};

constexpr int UP_ITEMS = (DMODEL / 64) * (DFF2 / 64), DN_ITEMS = (DFF / 64) * (DMODEL / 64);
#ifndef DN_IN_P1
#define DN_IN_P1 2816
#endif
#ifndef UP_IN_P0
#define UP_IN_P0 2048
#endif
__device__ __forceinline__ void p1_idle_work(const Ptrs& P, LAS unsigned char* lds, int iw, int NIW, int wave, int lane);
template <int LIST> __device__ __forceinline__ TrItem tr_desc(const Ptrs& P, int it) {
    unsigned char* ws = P.ws;
    constexpr int I_IN = (DMODEL / 64) * (DIN / 64), I_OUT = (DMODEL / 64) * (DMODEL / 64), I_KV = (DMODEL / 64) * (1024 / 64), I_PW = (PGD / 64) * (PGD / 64);
    if (LIST == 0) {
        int r = it;
        if (r < I_IN) {
            TrItem t = tr_make<false>(P.w_in, DMODEL, DIN, (bf16*)(ws + WS_WINT), nullptr, r);
            const int n0 = 64 * (r % (DIN / 64)), k0 = 64 * (r / (DIN / 64));
            if (n0 >= DCONV && n0 < 3 * DCONV) { const bool cx = n0 >= 2 * DCONV; const int np = n0 - (cx ? 2 * DCONV : DCONV);
                const int r0 = DCONV + 256 * (np / 128) + 64 * ((np % 128) / 32) + (cx ? 32 : 0);
                t.dst = (bf16*)(ws + WS_WINT) + (size_t)r0 * DMODEL + k0; t.skip = 32; }
            return t; }
        r -= I_IN;
        if (r < I_OUT) return tr_make<false>(P.w_out, DMODEL, DMODEL, (bf16*)(ws + WS_WOUTT), nullptr, r); r -= I_OUT;
        if (r < UP_IN_P0) return tr_make<true>(P.w_up, DMODEL, DFF2, (bf16*)(ws + WS_WUPT), P.g_ffn, r); r -= UP_IN_P0;
        if (r < I_KV) return tr_make<false>(P.w_kv, DMODEL, 1024, (bf16*)(ws + WS_WKVT), nullptr, r); r -= I_KV;
        const int g = r / I_PW; r -= g * I_PW;
        { TrItem t = tr_make<false>(P.pool_w + (size_t)g * PGD * PGD, PGD, PGD, (bf16*)(ws + WS_POOLWT) + (size_t)g * PGD * PGD, nullptr, r); t.rperm = 1; return t; }
    } else {
        if (LIST == 2) return tr_make<false>(P.w_down, DFF, DMODEL, (bf16*)(ws + WS_WDOWNT), nullptr, DN_IN_P1 + it);
        if (it < DN_IN_P1) return tr_make<false>(P.w_down, DFF, DMODEL, (bf16*)(ws + WS_WDOWNT), nullptr, it);
        return tr_make<true>(P.w_up, DMODEL, DFF2, (bf16*)(ws + WS_WUPT), P.g_ffn, UP_IN_P0 + it - DN_IN_P1);
    }
}
template <int LIST> __device__ __forceinline__ void tr_stream(const Ptrs& P, LAS float* scr, int first, int stride, int nitems, int lane) {
    if (first >= nitems) return;
    TrItem cur = tr_desc<LIST>(P, first); f32x4 va[16], vb[16];
    tr_load(cur, va, lane);
    for (int it = first; it < nitems; it += 2 * stride) {
        TrItem nx = cur; const bool h1 = it + stride < nitems; if (h1) { nx = tr_desc<LIST>(P, it + stride); tr_load(nx, vb, lane); }
        tr_store(cur, va, scr, lane);
        if (!h1) break;
        const bool h2 = it + 2 * stride < nitems; if (h2) { cur = tr_desc<LIST>(P, it + 2 * stride); tr_load(cur, va, lane); }
        tr_store(nx, vb, scr, lane);
        if (!h2) break;
    }
}
__device__ __forceinline__ void p0_prologue(const Ptrs& P, LAS unsigned char* lds, int gw, int NGW, int wave, int lane) {
    LAS float* scr = (LAS float*)(lds + wave * 16384);
    unsigned char* ws = P.ws;
    constexpr int NITEMS = (DMODEL / 64) * (DIN / 64) + (DMODEL / 64) * (DMODEL / 64) + UP_IN_P0 + (DMODEL / 64) * (1024 / 64) + 4 * (PGD / 64) * (PGD / 64);
    tr_stream<0>(P, scr, gw, NGW, NITEMS, lane);
#if P1_SPLIT_TAIL
    tr_stream<1>(P, scr, gw, NGW, DN_IN_P1 + (UP_ITEMS - UP_IN_P0), lane);
#endif
    for (int i = gw * 64 + lane; i < DMODEL; i += NGW * 64) ((float*)(ws + WS_GINV))[i] = 1.0f / P.g_mix[i];
    for (int i = gw * 64 + lane; i < 16 * DIN * 2 / 16; i += NGW * 64) ((u32x4*)(ws + WS_ZPAD))[i] = (u32x4){0u, 0u, 0u, 0u};
    for (int m = 2 * gw; m < SEQ; m += 2 * NGW) rms_rows2_to_bf16(P.x + (size_t)m * DMODEL, P.x + (size_t)(m + 1) * DMODEL, P.g_mix, (bf16*)(ws + WS_H) + (size_t)m * DMODEL, (bf16*)(ws + WS_H) + (size_t)(m + 1) * DMODEL, lane, (float*)(ws + WS_SIGX) + m);
    for (int m = 2 * gw; m < NMEM; m += 2 * NGW) rms_rows2_to_bf16(P.mem + (size_t)m * DMODEL, P.mem + (size_t)(m + 1) * DMODEL, P.g_mem, (bf16*)(ws + WS_MB) + (size_t)m * DMODEL, (bf16*)(ws + WS_MB) + (size_t)(m + 1) * DMODEL, lane);
}

__device__ __forceinline__ void kv_tile(const Ptrs& P, int tt, int lane) {
    const bf16* mB = (const bf16*)(P.ws + WS_MB); const bf16* wT = (const bf16*)(P.ws + WS_WKVT);
    const int rb = tt >> 6, cb = tt & 63, fr = lane & 15, fq = lane >> 4;
    const bf16* ap = mB + (size_t)(16 * rb + fr) * DMODEL + 8 * fq; const bf16* wp = wT + (size_t)(16 * cb + fr) * DMODEL + 8 * fq;
    const bool kpart = cb < 32;
    f32x4 acc = {0.f, 0.f, 0.f, 0.f};
    bf16x8 a0[8], w0[8], a1[8], w1[8];
#pragma unroll
    for (int i = 0; i < 8; ++i) { a0[i] = *(const bf16x8*)(ap + 32 * i); w0[i] = *(const bf16x8*)(wp + 32 * i); }
#pragma unroll 1
    for (int kb = 0; kb < 8; kb += 2) {
#pragma unroll
        for (int i = 0; i < 8; ++i) { a1[i] = *(const bf16x8*)(ap + 32 * (8 * kb + 8 + i)); w1[i] = *(const bf16x8*)(wp + 32 * (8 * kb + 8 + i)); }
#pragma unroll
        for (int i = 0; i < 8; ++i) acc = kpart ? __builtin_amdgcn_mfma_f32_16x16x32_bf16(w0[i], a0[i], acc, 0, 0, 0) : __builtin_amdgcn_mfma_f32_16x16x32_bf16(a0[i], w0[i], acc, 0, 0, 0);
        if (kb + 2 < 8) {
#pragma unroll
            for (int i = 0; i < 8; ++i) { a0[i] = *(const bf16x8*)(ap + 32 * (8 * kb + 16 + i)); w0[i] = *(const bf16x8*)(wp + 32 * (8 * kb + 16 + i)); } }
#pragma unroll
        for (int i = 0; i < 8; ++i) acc = kpart ? __builtin_amdgcn_mfma_f32_16x16x32_bf16(w1[i], a1[i], acc, 0, 0, 0) : __builtin_amdgcn_mfma_f32_16x16x32_bf16(a1[i], w1[i], acc, 0, 0, 0);
    }
    u32x2 o; o.x = pk2(acc[0], acc[1]); o.y = pk2(acc[2], acc[3]);
    if (kpart) *(u32x2*)((bf16*)(P.ws + WS_KB) + (size_t)(16 * rb + fr) * 512 + 16 * cb + 4 * fq) = o;
    else { const int dv = 16 * cb - 512 + fr;
        *(u32x2*)((bf16*)(P.ws + WS_VT) + (size_t)((dv & ~31) + pg8::invperm32(dv & 31)) * 256 + 32 * (rb >> 1) + 8 * fq + 4 * (rb & 1)) = o; }
}

__device__ __forceinline__ void p1_idle_work(const Ptrs& P, LAS unsigned char* lds, int iw, int NIW, int wave, int lane) {
    LAS float* scr = (LAS float*)(lds + wave * 16384);
    tr_stream<1>(P, scr, iw, NIW, DN_IN_P1 + (UP_ITEMS - UP_IN_P0), lane);
}

template <int NR> __device__ __forceinline__ void mix_conv_rows(const Ptrs& P, int t0, int lane, int cg0, int cg1) {
    const bf16* z = (const bf16*)(P.ws + WS_Z); bf16* mix = (bf16*)(P.ws + WS_MIX);
    constexpr int ZW = pg8::ZW;
    for (int cg = cg0 + lane; cg < cg1; cg += 64) {
        const int c = cg * 8;
        float w0[8], w1[8], w2[8], p1[8], p2[8];
#pragma unroll
        for (int e = 0; e < 8; ++e) { w0[e] = P.conv_w[c + e]; w1[e] = P.conv_w[DCONV + c + e]; w2[e] = P.conv_w[2 * DCONV + c + e]; }
        unpack8(*(const u32x4*)(z + (long)(t0 - 2) * ZW + DCONV + c), p2); unpack8(*(const u32x4*)(z + (long)(t0 - 1) * ZW + DCONV + c), p1);
        constexpr int CB = 4;
#pragma unroll 1
        for (int r0 = 0; r0 < NR; r0 += CB) {
            u32x4 rp[CB], rg[CB];
#pragma unroll
            for (int r = 0; r < CB; ++r) { const size_t t = (size_t)(t0 + r0 + r);
                rp[r] = __builtin_nontemporal_load((const u32x4*)(z + t * ZW + DCONV + c)); rg[r] = __builtin_nontemporal_load((const u32x4*)(z + t * ZW + c)); }
#pragma unroll
            for (int r = 0; r < CB; ++r) { const size_t t = (size_t)(t0 + r0 + r); float p[8], g[8], o[8];
                unpack8(rp[r], p); unpack8(rg[r], g);
#pragma unroll
                for (int e = 0; e < 8; ++e) { o[e] = g[e] * (w2[e] * p[e] + w1[e] * p1[e] + w0[e] * p2[e]); p2[e] = p1[e]; p1[e] = p[e]; }
                if (NT_MIX) __builtin_nontemporal_store(pack8(o), (u32x4*)(mix + t * DMODEL + c)); else *(u32x4*)(mix + t * DMODEL + c) = pack8(o); }
        }
    }
}
template <int g> __device__ __forceinline__ void mix_pool_task(const Ptrs& P, int blk, int lane) {
    constexpr int k = 2 << g;
    const char* zu = (const char*)((const bf16*)(P.ws + WS_Z) + (size_t)(blk * 16) * DIN + 3 * DCONV + PGD * g);
    const char* wu = (const char*)((const bf16*)(P.ws + WS_POOLWT) + (size_t)g * PGD * PGD);
    bf16* mix = (bf16*)(P.ws + WS_MIX);
    const int fr = lane & 15, fq = lane >> 4, t = blk * 16 + fr;
    const unsigned zl = (unsigned)(fr * DIN + 8 * fq) * 2u, wl = (unsigned)(fr * PGD + 8 * fq) * 2u;
    const int cnt = (t + 1 < k) ? t + 1 : k; const float inv = 1.0f / (float)cnt;
    f32x4 acc[12];
#pragma unroll
    for (int n = 0; n < 12; ++n) acc[n] = (f32x4){0.f, 0.f, 0.f, 0.f};
#pragma unroll 1
    for (int ks = 0; ks < 6; ++ks) {
        float sum[8], self[8];
        unpack8(*(const u32x4*)(zu + ks * 64 + zl), self);
#pragma unroll
        for (int e = 0; e < 8; ++e) sum[e] = self[e];
#pragma unroll
        for (int j = 1; j < k; ++j) { float v[8]; unpack8(*(const u32x4*)(zu + ks * 64 - (long)j * (DIN * 2) + zl), v);
#pragma unroll
            for (int e = 0; e < 8; ++e) sum[e] += v[e]; }
        float pl[8];
#pragma unroll
        for (int e = 0; e < 8; ++e) pl[e] = sum[e] * inv - self[e];
        const bf16x8 pf = __builtin_bit_cast(bf16x8, pack8(pl));
#pragma unroll
        for (int n = 0; n < 12; ++n) { const bf16x8 wf = *(const bf16x8*)(wu + n * (16 * PGD * 2) + ks * 64 + wl); acc[n] = __builtin_amdgcn_mfma_f32_16x16x32_bf16(wf, pf, acc[n], 0, 0, 0); }
    }
#pragma unroll
    for (int n = 0; n < 12; ++n) { const int d = 16 * n + 4 * fq; const f32x4 sc = *(const f32x4*)(P.pool_scale + PGD * g + d);
        u32x2 o; o.x = pk2(acc[n][0] * sc[0], acc[n][1] * sc[1]); o.y = pk2(acc[n][2] * sc[2], acc[n][3] * sc[3]);
        *(u32x2*)(mix + (size_t)t * DMODEL + DCONV + PGD * g + d) = o; }
}
__device__ __forceinline__ void mix_attn_task(const Ptrs& P, int h, int blk, int lane) {
    const bf16* z = (const bf16*)(P.ws + WS_Z); bf16* mix = (bf16*)(P.ws + WS_MIX); const bf16* Kb = (const bf16*)(P.ws + WS_KB); const bf16* Vt = (const bf16*)(P.ws + WS_VT);
    const int fr = lane & 15, fq = lane >> 4, t = blk * 16 + fr;
    bf16x8 qf[4];
#pragma unroll
    for (int ks = 0; ks < 4; ++ks) qf[ks] = *(const bf16x8*)(z + (size_t)t * DIN + 3 * DCONV + DPOOL + 128 * h + 32 * ks + 8 * fq);
    f32x4 s[16];
#pragma unroll
    for (int kb = 0; kb < 16; ++kb) { s[kb] = (f32x4){0.f, 0.f, 0.f, 0.f};
#pragma unroll
        for (int ks = 0; ks < 4; ++ks) { const bf16x8 kf = *(const bf16x8*)(Kb + (size_t)(16 * kb + fr) * 512 + 128 * h + 32 * ks + 8 * fq); s[kb] = __builtin_amdgcn_mfma_f32_16x16x32_bf16(kf, qf[ks], s[kb], 0, 0, 0); } }
    float mx = -3.0e38f;
#pragma unroll
    for (int kb = 0; kb < 16; ++kb) mx = fmaxf(fmaxf(fmaxf(s[kb][0], s[kb][1]), fmaxf(s[kb][2], s[kb][3])), mx);
    mx = fmaxf(mx, __shfl_xor(mx, 16)); mx = fmaxf(mx, __shfl_xor(mx, 32));
    const float c2 = 0.08838834764831845f * 1.4426950408889634f;
    float sum = 0.f;
#pragma unroll
    for (int kb = 0; kb < 16; ++kb)
#pragma unroll
        for (int r = 0; r < 4; ++r) { const float p = __builtin_amdgcn_exp2f((s[kb][r] - mx) * c2); s[kb][r] = p; sum += p; }
    sum += __shfl_xor(sum, 16); sum += __shfl_xor(sum, 32);
    const float inv = 1.0f / sum;
    f32x4 o[8];
#pragma unroll
    for (int db = 0; db < 8; ++db) o[db] = (f32x4){0.f, 0.f, 0.f, 0.f};
#pragma unroll
    for (int ks = 0; ks < 8; ++ks) {
        u32x4 pw; pw.x = pk2(s[2 * ks][0], s[2 * ks][1]); pw.y = pk2(s[2 * ks][2], s[2 * ks][3]); pw.z = pk2(s[2 * ks + 1][0], s[2 * ks + 1][1]); pw.w = pk2(s[2 * ks + 1][2], s[2 * ks + 1][3]);
        const bf16x8 pf = __builtin_bit_cast(bf16x8, pw);
#pragma unroll
        for (int db = 0; db < 8; ++db) { const bf16x8 vf = *(const bf16x8*)(Vt + (size_t)(128 * h + 16 * db + fr) * 256 + 32 * ks + 8 * fq); o[db] = __builtin_amdgcn_mfma_f32_16x16x32_bf16(vf, pf, o[db], 0, 0, 0); }
    }
#pragma unroll
    for (int db = 0; db < 8; ++db) { u32x2 w; w.x = pk2(o[db][0] * inv, o[db][1] * inv); w.y = pk2(o[db][2] * inv, o[db][3] * inv);
        *(u32x2*)(mix + (size_t)t * DMODEL + DCONV + DPOOL + 128 * h + 16 * db + 4 * fq) = w; }
}
template <int R, int C, int PCH> __device__ __forceinline__ void lds_stage_rows(LAS unsigned char* dst, const unsigned char* src, int gp, int tid) {
    constexpr int N = R * C, PER = (N + 511) / 512;
    u32x4 v[PER];
#pragma unroll
    for (int i = 0; i < PER; ++i) { const int idx = tid + 512 * i; if (idx < N) { const int row = idx / C, ch = idx % C; v[i] = *(const u32x4*)(src + (size_t)row * gp + ch * 16); } }
#pragma unroll
    for (int i = 0; i < PER; ++i) { const int idx = tid + 512 * i; if (idx < N) { const int row = idx / C, ch = idx % C; *(LAS u32x4*)(dst + row * (PCH * 16) + (((ch & ~15) | ((ch & 15) ^ (row & 15))) << 4)) = v[i]; } }
}
template <int N> __device__ __forceinline__ float dpp_shrN(float old, float src) { return __builtin_bit_cast(float, __builtin_amdgcn_update_dpp(__builtin_bit_cast(int, old), __builtin_bit_cast(int, src), 0x110 + N, 0xf, 0xf, false)); }
template <int N> __device__ __forceinline__ float dpp_rorN(float src) { return __builtin_bit_cast(float, __builtin_amdgcn_mov_dpp(__builtin_bit_cast(int, src), 0x120 + N, 0xf, 0xf, false)); }
template <int N> __device__ __forceinline__ float scan_step(float x, float p) { return x + dpp_shrN<N>(dpp_rorN<N>(p), x); }
template <int N> __device__ __forceinline__ float scan_step_prev(float p) { return p + dpp_shrN<N>(0.f, p); }

__device__ __forceinline__ void mix_attn_wave(const Ptrs& P, LAS unsigned char* ldsK, LAS unsigned char* ldsV, int h, int row0, int lane) {
    const bf16* z = (const bf16*)(P.ws + WS_Z); bf16* mix = (bf16*)(P.ws + WS_MIX);
    const int fr = lane & 15, fq = lane >> 4;
    bf16x8 q0[4], q1[4];
#pragma unroll
    for (int ks = 0; ks < 4; ++ks) { const bf16* qp = z + (size_t)(row0 + fr) * pg8::ZW + 2 * DCONV + DPOOL + 128 * h + 32 * ks + 8 * fq; q0[ks] = __builtin_nontemporal_load((const bf16x8*)qp); q1[ks] = __builtin_nontemporal_load((const bf16x8*)(qp + 16 * pg8::ZW)); }
    unsigned offk[4];
#pragma unroll
    for (int ks = 0; ks < 4; ++ks) offk[ks] = (unsigned)(fr * 256 + (((4 * ks + fq) ^ fr) << 4));
    f32x4 s0[16], s1[16];
#pragma unroll
    for (int kb = 0; kb < 16; ++kb) { s0[kb] = (f32x4){0.f, 0.f, 0.f, 0.f}; s1[kb] = (f32x4){0.f, 0.f, 0.f, 0.f}; }
    {
        bf16x8 kfa[4], kfb[4];
#pragma unroll
        for (int ks = 0; ks < 4; ++ks) kfa[ks] = *(const LAS bf16x8*)(ldsK + offk[ks]);
#pragma unroll
        for (int kb = 0; kb < 16; kb += 2) {
#pragma unroll
            for (int ks = 0; ks < 4; ++ks) kfb[ks] = *(const LAS bf16x8*)(ldsK + (kb + 1) * 4096 + offk[ks]);
            __builtin_amdgcn_sched_barrier(0);
#pragma unroll
            for (int ks = 0; ks < 4; ++ks) { s0[kb] = __builtin_amdgcn_mfma_f32_16x16x32_bf16(kfa[ks], q0[ks], s0[kb], 0, 0, 0); s1[kb] = __builtin_amdgcn_mfma_f32_16x16x32_bf16(kfa[ks], q1[ks], s1[kb], 0, 0, 0); }
            __builtin_amdgcn_sched_barrier(0);
            if (kb + 2 < 16) {
#pragma unroll
                for (int ks = 0; ks < 4; ++ks) kfa[ks] = *(const LAS bf16x8*)(ldsK + (kb + 2) * 4096 + offk[ks]); }
            __builtin_amdgcn_sched_barrier(0);
#pragma unroll
            for (int ks = 0; ks < 4; ++ks) { s0[kb + 1] = __builtin_amdgcn_mfma_f32_16x16x32_bf16(kfb[ks], q0[ks], s0[kb + 1], 0, 0, 0); s1[kb + 1] = __builtin_amdgcn_mfma_f32_16x16x32_bf16(kfb[ks], q1[ks], s1[kb + 1], 0, 0, 0); }
            __builtin_amdgcn_sched_barrier(0);
        }
    }
    const float c2 = 0.08838834764831845f * 1.4426950408889634f;
    bf16x8 p0[8], p1[8]; float inv0, inv1;
    {   float mx = -3.0e38f;
#pragma unroll
        for (int kb = 0; kb < 16; ++kb) mx = fmaxf(fmaxf(fmaxf(s0[kb][0], s0[kb][1]), fmaxf(s0[kb][2], s0[kb][3])), mx);
        mx = fmaxf(mx, __shfl_xor(mx, 16)); mx = fmaxf(mx, __shfl_xor(mx, 32));
        float sum = 0.f;
#pragma unroll
        for (int ks = 0; ks < 8; ++ks) { float e[8];
#pragma unroll
            for (int r = 0; r < 4; ++r) { e[r] = __builtin_amdgcn_exp2f((s0[2 * ks][r] - mx) * c2); e[4 + r] = __builtin_amdgcn_exp2f((s0[2 * ks + 1][r] - mx) * c2); }
            sum += ((e[0] + e[1]) + (e[2] + e[3])) + ((e[4] + e[5]) + (e[6] + e[7]));
            p0[ks] = __builtin_bit_cast(bf16x8, pack8(e)); }
        sum += __shfl_xor(sum, 16); sum += __shfl_xor(sum, 32); inv0 = 1.0f / sum; }
    {   float mx = -3.0e38f;
#pragma unroll
        for (int kb = 0; kb < 16; ++kb) mx = fmaxf(fmaxf(fmaxf(s1[kb][0], s1[kb][1]), fmaxf(s1[kb][2], s1[kb][3])), mx);
        mx = fmaxf(mx, __shfl_xor(mx, 16)); mx = fmaxf(mx, __shfl_xor(mx, 32));
        float sum = 0.f;
#pragma unroll
        for (int ks = 0; ks < 8; ++ks) { float e[8];
#pragma unroll
            for (int r = 0; r < 4; ++r) { e[r] = __builtin_amdgcn_exp2f((s1[2 * ks][r] - mx) * c2); e[4 + r] = __builtin_amdgcn_exp2f((s1[2 * ks + 1][r] - mx) * c2); }
            sum += ((e[0] + e[1]) + (e[2] + e[3])) + ((e[4] + e[5]) + (e[6] + e[7]));
            p1[ks] = __builtin_bit_cast(bf16x8, pack8(e)); }
        sum += __shfl_xor(sum, 16); sum += __shfl_xor(sum, 32); inv1 = 1.0f / sum; }
    f32x4 o0[8], o1[8];
#pragma unroll
    for (int db = 0; db < 8; ++db) { o0[db] = (f32x4){0.f, 0.f, 0.f, 0.f}; o1[db] = (f32x4){0.f, 0.f, 0.f, 0.f}; }
    {
        bf16x8 vfa[8], vfb[8];
#define MIX_OFFV(ks) ((unsigned)(fr * 512 + (((ks) >> 2) << 8) + (((4 * ((ks) & 3) + fq) ^ fr) << 4)))
#pragma unroll
        for (int db = 0; db < 8; ++db) vfa[db] = *(const LAS bf16x8*)(ldsV + db * 8192 + MIX_OFFV(0));
#pragma unroll
        for (int ks = 0; ks < 8; ks += 2) {
#pragma unroll
            for (int db = 0; db < 8; ++db) vfb[db] = *(const LAS bf16x8*)(ldsV + db * 8192 + MIX_OFFV(ks + 1));
            __builtin_amdgcn_sched_barrier(0);
#pragma unroll
            for (int db = 0; db < 8; ++db) { o0[db] = __builtin_amdgcn_mfma_f32_16x16x32_bf16(vfa[db], p0[ks], o0[db], 0, 0, 0); o1[db] = __builtin_amdgcn_mfma_f32_16x16x32_bf16(vfa[db], p1[ks], o1[db], 0, 0, 0); }
            __builtin_amdgcn_sched_barrier(0);
            if (ks + 2 < 8) {
#pragma unroll
                for (int db = 0; db < 8; ++db) vfa[db] = *(const LAS bf16x8*)(ldsV + db * 8192 + MIX_OFFV(ks + 2)); }
            __builtin_amdgcn_sched_barrier(0);
#pragma unroll
            for (int db = 0; db < 8; ++db) { o0[db] = __builtin_amdgcn_mfma_f32_16x16x32_bf16(vfb[db], p0[ks + 1], o0[db], 0, 0, 0); o1[db] = __builtin_amdgcn_mfma_f32_16x16x32_bf16(vfb[db], p1[ks + 1], o1[db], 0, 0, 0); }
            __builtin_amdgcn_sched_barrier(0);
        }
#undef MIX_OFFV
    }
    bf16* op = mix + (size_t)(row0 + fr) * DMODEL + DCONV + DPOOL + 128 * h + 8 * fq;
#pragma unroll
    for (int g = 0; g < 4; ++g) { u32x4 w;
        w.x = pk2(o0[2 * g][0] * inv0, o0[2 * g][1] * inv0); w.y = pk2(o0[2 * g][2] * inv0, o0[2 * g][3] * inv0); w.z = pk2(o0[2 * g + 1][0] * inv0, o0[2 * g + 1][1] * inv0); w.w = pk2(o0[2 * g + 1][2] * inv0, o0[2 * g + 1][3] * inv0);
        *(u32x4*)(op + 32 * g) = w;
        w.x = pk2(o1[2 * g][0] * inv1, o1[2 * g][1] * inv1); w.y = pk2(o1[2 * g][2] * inv1, o1[2 * g][3] * inv1); w.z = pk2(o1[2 * g + 1][0] * inv1, o1[2 * g + 1][1] * inv1); w.w = pk2(o1[2 * g + 1][2] * inv1, o1[2 * g + 1][3] * inv1);
        *(u32x4*)(op + (size_t)16 * DMODEL + 32 * g) = w; }
}

template <int g> __device__ __forceinline__ void mix_pool_wave(const Ptrs& P, LAS unsigned char* ldsW, int row0, int lane) {
    constexpr int k = 2 << g;
    const bf16* z = (const bf16*)(P.ws + WS_Z); bf16* mix = (bf16*)(P.ws + WS_MIX);
    const int fr = lane & 15, fq = lane >> 4;
    f32x4 acc0[12], acc1[12];
#pragma unroll
    for (int n = 0; n < 12; ++n) { acc0[n] = (f32x4){0.f, 0.f, 0.f, 0.f}; acc1[n] = (f32x4){0.f, 0.f, 0.f, 0.f}; }
    const float invA = 1.0f / (float)((row0 + fr + 1 < k) ? row0 + fr + 1 : k), invB = 1.0f / (float)((row0 + 16 + fr + 1 < k) ? row0 + 16 + fr + 1 : k);
    const bf16* zp0 = z + (long)(row0 - 16 + fr) * pg8::ZW + 2 * DCONV + PGD * g + 8 * fq;
    u32x4 n0 = __builtin_nontemporal_load((const u32x4*)zp0), n1 = __builtin_nontemporal_load((const u32x4*)(zp0 + 16 * pg8::ZW)), n2 = __builtin_nontemporal_load((const u32x4*)(zp0 + 32 * pg8::ZW));
#pragma unroll 1
    for (int ks = 0; ks < 6; ++ks) {
        const u32x4 c0 = n0, c1 = n1, c2 = n2;
        if (ks + 1 < 6) { const bf16* zp = zp0 + 32 * (ks + 1); n0 = __builtin_nontemporal_load((const u32x4*)zp); n1 = __builtin_nontemporal_load((const u32x4*)(zp + 16 * pg8::ZW)); n2 = __builtin_nontemporal_load((const u32x4*)(zp + 32 * pg8::ZW)); }
        bf16x8 wfr[12];
        { const unsigned offw = (unsigned)(fr * 512 + ((ks >> 2) << 8) + (((4 * (ks & 3) + fq) ^ fr) << 4));
#pragma unroll
          for (int n = 0; n < 12; ++n) wfr[n] = *(const LAS bf16x8*)(ldsW + n * 8192 + offw); }
        __builtin_amdgcn_sched_barrier(0);
        float pv[8], xa[8], xb[8], sa[8], sb[8];
        unpack8(c0, pv); unpack8(c1, xa); unpack8(c2, xb);
#pragma unroll
        for (int e = 0; e < 8; ++e) {
            float p = pv[e], a = xa[e], b = xb[e];
            float b1 = scan_step<1>(b, a), a1 = scan_step<1>(a, p), p1 = scan_step_prev<1>(p);
            if (k >= 4) { const float b2 = scan_step<2>(b1, a1), a2 = scan_step<2>(a1, p1), p2 = scan_step_prev<2>(p1); b1 = b2; a1 = a2; p1 = p2; }
            if (k >= 8) { const float b2 = scan_step<4>(b1, a1), a2 = scan_step<4>(a1, p1), p2 = scan_step_prev<4>(p1); b1 = b2; a1 = a2; p1 = p2; }
            if (k >= 16) { const float b2 = scan_step<8>(b1, a1), a2 = scan_step<8>(a1, p1); b1 = b2; a1 = a2; }
            sa[e] = a1 * invA - a; sb[e] = b1 * invB - b; }
        const bf16x8 fa = __builtin_bit_cast(bf16x8, pack8(sa)), fb = __builtin_bit_cast(bf16x8, pack8(sb));
#pragma unroll
        for (int n = 0; n < 12; ++n) { acc0[n] = __builtin_amdgcn_mfma_f32_16x16x32_bf16(wfr[n], fa, acc0[n], 0, 0, 0); acc1[n] = __builtin_amdgcn_mfma_f32_16x16x32_bf16(wfr[n], fb, acc1[n], 0, 0, 0); }
    }
    bf16* op = mix + (size_t)(row0 + fr) * DMODEL + DCONV + PGD * g + 8 * fq;
#pragma unroll
    for (int q = 0; q < 6; ++q) { const f32x4 sa = *(const f32x4*)(P.pool_scale + PGD * g + 32 * q + 8 * fq), sb = *(const f32x4*)(P.pool_scale + PGD * g + 32 * q + 8 * fq + 4); u32x4 o;
        o.x = pk2(acc0[2 * q][0] * sa[0], acc0[2 * q][1] * sa[1]); o.y = pk2(acc0[2 * q][2] * sa[2], acc0[2 * q][3] * sa[3]); o.z = pk2(acc0[2 * q + 1][0] * sb[0], acc0[2 * q + 1][1] * sb[1]); o.w = pk2(acc0[2 * q + 1][2] * sb[2], acc0[2 * q + 1][3] * sb[3]);
        *(u32x4*)(op + 32 * q) = o;
        o.x = pk2(acc1[2 * q][0] * sa[0], acc1[2 * q][1] * sa[1]); o.y = pk2(acc1[2 * q][2] * sa[2], acc1[2 * q][3] * sa[3]); o.z = pk2(acc1[2 * q + 1][0] * sb[0], acc1[2 * q + 1][1] * sb[1]); o.w = pk2(acc1[2 * q + 1][2] * sb[2], acc1[2 * q + 1][3] * sb[3]);
        *(u32x4*)(op + (size_t)16 * DMODEL + 32 * q) = o; }
}

__device__ __forceinline__ void p2_mixer(const Ptrs& P, LAS unsigned char* lds, int w, int tid, int wave, int lane, int tmask) {
    const int sub = w & 3, tile = w >> 2, rowA = tile * 256 + wave * 32;
    const int ct0 = (4 * w + (wave & 3)) * 16, cg0 = 48 * (wave >> 2);
    lds_stage_rows<256, 16, 16>(lds, (const unsigned char*)(P.ws + WS_KB) + 256 * sub, 1024, tid);
    lds_stage_rows<128, 32, 32>(lds + 65536, (const unsigned char*)(P.ws + WS_VT) + (size_t)sub * 128 * 512, 512, tid);
    LDS_WAIT(); __syncthreads();
    if (wave >= 4 && (tmask & 1)) mix_conv_rows<8>(P, ct0, lane, cg0, cg0 + 48);
    if (tmask & 0x1e0) mix_attn_wave(P, lds, lds + 65536, sub, rowA, lane);
    if (wave < 4 && (tmask & 1)) mix_conv_rows<8>(P, ct0, lane, cg0, cg0 + 48);
    __syncthreads();
    lds_stage_rows<192, 24, 32>(lds, (const unsigned char*)(P.ws + WS_POOLWT) + (size_t)sub * PGD * PGD * 2, PGD * 2, tid);
    LDS_WAIT(); __syncthreads();
    if (wave >= 4 && (tmask & 1)) mix_conv_rows<8>(P, ct0 + 8, lane, cg0, cg0 + 48);
    if (tmask & 0x1e) { if (sub == 0) mix_pool_wave<0>(P, lds, rowA, lane); else if (sub == 1) mix_pool_wave<1>(P, lds, rowA, lane); else if (sub == 2) mix_pool_wave<2>(P, lds, rowA, lane); else mix_pool_wave<3>(P, lds, rowA, lane); }
    if (wave < 4 && (tmask & 1)) mix_conv_rows<8>(P, ct0 + 8, lane, cg0, cg0 + 48);
    __syncthreads();
}

__device__ __forceinline__ void p5_fix_item(const Ptrs& P, int pm, int c) {
    const float* ub = (const float*)(P.ws + WS_UBND); bf16* act = (bf16*)(P.ws + WS_ACT); const float* cw = P.ffn_conv_w; const float* cb = P.ffn_conv_b;
    const int gi = 256 * (c / 128) + 64 * ((c % 128) / 32) + (c % 32);
    const float* p2 = ub + (size_t)((pm - 1) * 4 + 2) * DFF2 + gi; const float* p1 = p2 + DFF2; const float* r0 = ub + (size_t)(pm * 4) * DFF2 + gi; const float* r1 = r0 + DFF2;
    float o0[8], o1[8];
#pragma unroll
    for (int e = 0; e < 8; ++e) {
        const float gw0 = cw[c + e], gw1 = cw[DFF2 + c + e], gw2 = cw[2 * DFF2 + c + e], gb = cb[c + e], vw0 = cw[DFF + c + e], vw1 = cw[DFF2 + DFF + c + e], vw2 = cw[2 * DFF2 + DFF + c + e], vb = cb[DFF + c + e];
        const float G0 = gw2 * r0[e] + (gw1 * p1[e] + (gw0 * p2[e] + gb)), V0 = vw2 * r0[32 + e] + (vw1 * p1[32 + e] + (vw0 * p2[32 + e] + vb));
        const float G1 = gw2 * r1[e] + (gw1 * r0[e] + (gw0 * p1[e] + gb)), V1 = vw2 * r1[32 + e] + (vw1 * r0[32 + e] + (vw0 * p1[32 + e] + vb));
        o0[e] = G0 * __builtin_amdgcn_rcpf(1.0f + __builtin_amdgcn_exp2f(-1.4426950408889634f * G0)) * V0;
        o1[e] = G1 * __builtin_amdgcn_rcpf(1.0f + __builtin_amdgcn_exp2f(-1.4426950408889634f * G1)) * V1; }
    *(u32x4*)(act + (size_t)(256 * pm) * DFF + c) = pack8(o0); *(u32x4*)(act + (size_t)(256 * pm + 1) * DFF + c) = pack8(o1);
}
__device__ __forceinline__ void p6_fixup_panels(const Ptrs& P, int vcu, int G, int tid, unsigned* cnt, unsigned* tmo) {
    constexpr int GRP = DFF / 8 / 8;
    const int nround = (512 + G - 1) / G;
    for (int i = 0; i < nround; ++i) { const int L = i * G + vcu; if (L >= 512) break; const int pm = L >> 3, pn = L & 7;
        if (pm > 0 && tid < GRP) p5_fix_item(P, pm, (pn * GRP + tid) * 8); }
    asm volatile("s_waitcnt vmcnt(0)" ::: "memory"); __syncthreads();
    if (tid == 0) {
        __builtin_amdgcn_fence(__ATOMIC_RELEASE, "agent"); asm volatile("s_waitcnt vmcnt(0)" ::: "memory");
        for (int i = 0; i < nround; ++i) { const int L = i * G + vcu; if (L >= 512) break; __hip_atomic_fetch_add(cnt + 64 * (L >> 3), 1u, __ATOMIC_RELAXED, __HIP_MEMORY_SCOPE_AGENT); }
        for (int i = 0; i < nround; ++i) { const int L = i * G + vcu; if (L >= 512) break; unsigned spins = 0;
            while (__hip_atomic_load(cnt + 64 * (L >> 3), __ATOMIC_RELAXED, __HIP_MEMORY_SCOPE_AGENT) < 8u) { __builtin_amdgcn_s_sleep(2); if (++spins > (1u << 20)) { __hip_atomic_store(tmo, 1u, __ATOMIC_RELAXED, __HIP_MEMORY_SCOPE_AGENT); break; } } }
        __builtin_amdgcn_fence(__ATOMIC_ACQUIRE, "agent"); asm volatile("s_waitcnt vmcnt(0)" ::: "memory");
    }
    __syncthreads();
}
__device__ __forceinline__ void p5_fixup(const Ptrs& P, int gt, int NGT) {
    for (int i = gt; i < 63 * (DFF / 8); i += NGT) p5_fix_item(P, 1 + i / (DFF / 8), (i % (DFF / 8)) * 8);
}

__device__ __forceinline__ void p7_final(const Ptrs& P, int gw, int NGW, int lane) {
    const float* slab = (const float*)(P.ws + WS_SLAB2);
    for (int m = gw; m < SEQ; m += NGW) {
        const float part = (lane < 32) ? slab[(size_t)m * 32 + lane] : 0.f;
        const float rstd = 1.0f / sqrtf(wave_sum(part) * (1.0f / DMODEL) + EPS);
        f32x4* xr = (f32x4*)(P.out + (size_t)m * DMODEL) + lane; const f32x4* gr = (const f32x4*)P.g_final + lane;
#pragma unroll
        for (int j = 0; j < 8; ++j) { f32x4 v = xr[64 * j]; const f32x4 gg = gr[64 * j]; v = v * rstd * gg; xr[64 * j] = v; }
    }
}

struct Args { const float* in[16]; float* out; unsigned char* ws; int ph_lo, ph_hi; };
__global__ void __launch_bounds__(NWAVES * 64, 2) hybrid_fwd(Args args) {
    extern __shared__ __attribute__((aligned(16))) unsigned char lds_raw[];
    LAS unsigned char* lds = (LAS unsigned char*)lds_raw;
    cg::grid_group grid = cg::this_grid();
    const int tid = threadIdx.x, lane = tid & 63, wave = __builtin_amdgcn_readfirstlane(tid >> 6);
    const int G = gridDim.x, bx = blockIdx.x, vcu = (G % 8 == 0) ? (bx % 8) * (G / 8) + bx / 8 : bx;
    const int gw = vcu * NWAVES + wave, NGW = G * NWAVES;
    volatile LAS unsigned* MISC = (volatile LAS unsigned*)(lds + MISC_OFF);
    if (tid < 32) MISC[tid] = 0u;
    __syncthreads();
    const XcdBarrier bar = xcd_barrier_post((unsigned*)(args.ws + WS_CTL), MISC + 8);
    Ptrs P;
    P.x = args.in[0]; P.mem = args.in[1]; P.g_mix = args.in[2]; P.g_mem = args.in[3]; P.w_in = args.in[4]; P.conv_w = args.in[5]; P.pool_w = args.in[6]; P.pool_scale = args.in[7];
    P.w_kv = args.in[8]; P.w_out = args.in[9]; P.g_ffn = args.in[10]; P.w_up = args.in[11]; P.ffn_conv_w = args.in[12]; P.ffn_conv_b = args.in[13]; P.w_down = args.in[14]; P.g_final = args.in[15];
    P.out = args.out; P.ws = args.ws;
    unsigned char* ws = args.ws;
#if PROBE_SYNC
    for (int i = 0; i < 20; ++i) xcd_barrier(bar);
#endif
    const int lo = args.ph_lo, hi = args.ph_hi;
#ifndef CODE_PAD
#define CODE_PAD 4
#endif
    { _Pragma("unroll") for (int i_ = 0; i_ < CODE_PAD; ++i_) asm volatile("s_nop 0"); }
#define IN(k) (lo <= (k) && (k) < hi)
#define SYNC(k) do { if ((k) + 1 < hi) { if ((k) == 0 && USE_CG_SYNC) grid.sync(); else xcd_barrier(bar); } } while (0)
#define SYNCR(k, b) do { if ((k) + 1 < hi || rp + 1 < NREP(b)) { if ((k) == 0 && USE_CG_SYNC) grid.sync(); else xcd_barrier(bar); } } while (0)
#define NREP(b) ((REPM & (b)) ? 2 : 1)
    if (IN(0) && (PHM & 1)) for (int rp = 0; rp < NREP(1); ++rp) { p0_prologue(P, lds, gw, NGW, wave, lane); SYNCR(0, 1); }
    if (IN(1) && (PHM & 2)) for (int rp = 0; rp < NREP(2); ++rp) {
        pg8::Gemm g{(const bf16*)(ws + WS_H), (const bf16*)(ws + WS_WINT), SEQ, DIN, DMODEL}; pg8::EpiZ E{(bf16*)(ws + WS_Z), DIN};
#if P1_SPLIT_TAIL
        pg8::TailSplitOrder S; S.init(SEQ, DIN, G, bx, P1_WGM);
        pg8::gemm_phase<pg8::EpiZ, pg8::TailSplitOrder, P1_ALIGN, true, 0, true>(lds, g, S, E, lds + XLDS_OFF);
        for (int tt = gw; tt < 1024; tt += NGW) kv_tile(P, tt, lane);
#else
        pg8::StaticOrder S; S.init(SEQ, DIN, G, bx, P1_WGM); pg8::EpiZin EZ{(bf16*)(ws + WS_Z)};
        pg8::gemm_phase<pg8::EpiZin, pg8::StaticOrder, true, true, 0, false, EARLY_A>(lds, g, S, EZ, lds + XLDS_OFF);
        { const int nfull = ((SEQ / 256) * (DIN / 256)) % G;
          if (nfull == 0 || G - nfull < 8) { const int i0 = nfull ? bx - nfull : bx, n0 = nfull ? G - nfull : G;
              if (i0 >= 0) { for (int tt = i0 * NWAVES + wave; tt < 1024; tt += n0 * NWAVES) kv_tile(P, tt, lane); p1_idle_work(P, lds, i0 * NWAVES + wave, n0 * NWAVES, wave, lane); } }
          else if (bx >= nfull) { const int ii = bx - nfull;
              if (ii < 2) { pg8::Gemm gk{(const bf16*)(ws + WS_MB), (const bf16*)(ws + WS_WKVT), NMEM, 512, DMODEL}; pg8::OneUnit S1{0, ii}; pg8::EpiZ EK{(bf16*)(ws + WS_KB), 512};
                  pg8::gemm_phase<pg8::EpiZ, pg8::OneUnit, true, true>(lds, gk, S1, EK, lds + XLDS_OFF); }
              else if (ii < 4) { pg8::Gemm gv{(const bf16*)(ws + WS_WKVT) + (size_t)512 * DMODEL, (const bf16*)(ws + WS_MB), 512, NMEM, DMODEL}; pg8::OneUnit S1{ii - 2, 0}; pg8::EpiVt EV{(bf16*)(ws + WS_VT)};
                  pg8::gemm_phase<pg8::EpiVt, pg8::OneUnit, true, true>(lds, gv, S1, EV, lds + XLDS_OFF); }
              else p1_idle_work(P, lds, (ii - 4) * NWAVES + wave, (G - nfull - 4) * NWAVES, wave, lane); } }
#endif
        SYNCR(1, 2);
    }
    if (IN(2) && (PHM & 4)) for (int rp = 0; rp < NREP(4); ++rp) { p2_mixer(P, lds, vcu, tid, wave, lane, 511);
#if PROBE_P2
        p2_mixer(P, lds, vcu, tid, wave, lane, PROBE_P2);
#endif
        SYNCR(2, 4); }
    if (IN(3) && (PHM & 8)) {
        pg8::Gemm g{(const bf16*)(ws + WS_MIX), (const bf16*)(ws + WS_WOUTT), SEQ, DMODEL, DMODEL}; pg8::PanelOrder S{G, vcu, (SEQ / 256) * (DMODEL / 256)};
        pg8::EpiNorm<0> E{nullptr, (const bf16*)(ws + WS_H), (const float*)(ws + WS_SIGX), (float*)(ws + WS_SIG), (bf16*)(ws + WS_X1B), nullptr, (const float*)(ws + WS_GINV), (unsigned*)(ws + WS_SLAB1), (unsigned*)(ws + WS_CTL) + CW_PANEL1, (unsigned*)(ws + WS_CTL) + XB_TMO};
        pg8::gemm_phase<pg8::EpiNorm<0>, pg8::PanelOrder, true, true, 0, false, EARLY_A>(lds, g, S, E, lds + XLDS_OFF);
        SYNC(3);
    }
#if PROBE_GEMM
    if (IN(3)) {
        pg8::Gemm g{(const bf16*)(ws + WS_X1B), (const bf16*)(ws + WS_WUPT), SEQ, PROBE_N, DMODEL}; pg8::StaticOrder S; S.init(SEQ, PROBE_N, G, bx);
#if PROBE_GEMM == 1
        pg8::EpiZ E{(bf16*)(ws + WS_Z), PROBE_N};
        pg8::gemm_phase<pg8::EpiZ, pg8::StaticOrder, true, true>(lds, g, S, E, lds + XLDS_OFF);
#elif PROBE_GEMM == 2
        pg8::EpiNone E{};
        pg8::gemm_phase<pg8::EpiNone, pg8::StaticOrder, true, true>(lds, g, S, E, lds + XLDS_OFF);
#elif PROBE_GEMM == 3
        pg8::EpiZ E{(bf16*)(ws + WS_Z), PROBE_N};
        pg8::gemm_phase<pg8::EpiZ, pg8::StaticOrder, true, false>(lds, g, S, E, lds + XLDS_OFF);
#elif PROBE_GEMM == 5
        pg8::EpiAct E{(bf16*)(ws + WS_ACT), P.ffn_conv_w, P.ffn_conv_b, (float*)(ws + WS_UBND)};
        pg8::gemm_phase<pg8::EpiAct, pg8::StaticOrder, true, true>(lds, g, S, E, lds + XLDS_OFF);
#elif PROBE_GEMM == 4
        pg8::EpiZ E{(bf16*)(ws + WS_Z), PROBE_N};
        pg8::gemm_phase<pg8::EpiZ, pg8::StaticOrder, false, true>(lds, g, S, E, lds + XLDS_OFF);
#endif
        xcd_barrier(bar);
    }
#endif
    if (IN(4) && (PHM & 16)) for (int rp = 0; rp < NREP(16); ++rp) {
        pg8::Gemm g{(const bf16*)(ws + WS_X1B), (const bf16*)(ws + WS_WUPT), SEQ, DFF2, DMODEL}; pg8::StaticOrder S; S.init(SEQ, DFF2, G, bx, P4_WGM);
        pg8::EpiAct E{(bf16*)(ws + WS_ACT), P.ffn_conv_w, P.ffn_conv_b, (float*)(ws + WS_UBND)};
        pg8::gemm_phase<pg8::EpiAct, pg8::StaticOrder, true, true, P4_AUXB, false, EARLY_A>(lds, g, S, E, lds + XLDS_OFF);
        SYNCR(4, 16);
    }
#if !FUSE_FIXUP
    if (IN(5) && (PHM & 32)) { p5_fixup(P, vcu * (NWAVES * 64) + tid, G * NWAVES * 64); tr_stream<2>(P, (LAS float*)(lds + wave * 16384), gw, NGW, DN_ITEMS - DN_IN_P1, lane); SYNC(5); }
#endif
    if (IN(6) && (PHM & 64)) {
#if FUSE_FIXUP
        p6_fixup_panels(P, vcu, G, tid, (unsigned*)(ws + WS_CTL) + CW_PANEL2, (unsigned*)(ws + WS_CTL) + XB_TMO);
#endif
        pg8::Gemm g{(const bf16*)(ws + WS_ACT), (const bf16*)(ws + WS_WDOWNT), SEQ, DMODEL, DFF}; pg8::PanelOrder S{G, vcu, (SEQ / 256) * (DMODEL / 256)};
        pg8::EpiNorm<1> E{nullptr, (const bf16*)(ws + WS_X1B), (const float*)(ws + WS_SIG), nullptr, nullptr, P.out, P.g_final, (unsigned*)(ws + WS_SLAB2), (unsigned*)(ws + WS_CTL) + CW_PANEL, (unsigned*)(ws + WS_CTL) + XB_TMO};
        pg8::gemm_phase<pg8::EpiNorm<1>, pg8::PanelOrder, true, true, 0, false, EARLY_A>(lds, g, S, E, lds + XLDS_OFF);
    }
#undef IN
#undef SYNC
}

extern "C" void kernel_launch(void* const* d_in, const int* in_sizes, int n_in, void* d_out, int out_size, void* d_ws, size_t ws_size, hipStream_t stream) {
    static int grid = 0;
    if (grid == 0) {
        if (n_in != 16 || in_sizes[0] != SEQ * DMODEL || out_size != SEQ * DMODEL || ws_size < WS_END) { fprintf(stderr, "kernel_launch: unexpected shapes (n_in %d, in0 %d, out %d, ws %zu)\n", n_in, n_in > 0 ? in_sizes[0] : -1, out_size, ws_size); grid = -1; return; }
        int dev = 0, cus = 0, per_cu = 0;
        if (hipGetDevice(&dev) != hipSuccess || hipDeviceGetAttribute(&cus, hipDeviceAttributeMultiprocessorCount, dev) != hipSuccess) { grid = -1; return; }
        if (hipFuncSetAttribute((const void*)hybrid_fwd, hipFuncAttributeMaxDynamicSharedMemorySize, LDS_BYTES) != hipSuccess) { fprintf(stderr, "kernel_launch: hipFuncSetAttribute failed\n"); grid = -1; return; }
        if (hipOccupancyMaxActiveBlocksPerMultiprocessor(&per_cu, (const void*)hybrid_fwd, NWAVES * 64, LDS_BYTES) != hipSuccess || per_cu < 1) { fprintf(stderr, "kernel_launch: occupancy query says %d blocks per CU\n", per_cu); (void)hipGetLastError(); per_cu = 1; }
        grid = cus;
        if (grid != 256) { fprintf(stderr, "kernel_launch: this kernel is laid out for one workgroup on each of 256 CUs (the mixer phase and the row-statistics exchanges assume it); the device reports %d\n", grid); if (grid > 256) grid = 256; }
    }
    if (grid < 0) return;
    if (hipMemsetAsync((char*)d_ws + WS_CTL, 0, CTL_ZERO_BYTES, stream) != hipSuccess) { fprintf(stderr, "kernel_launch: hipMemsetAsync failed\n"); return; }
    Args a{};
    for (int i = 0; i < 16; ++i) a.in[i] = (const float*)d_in[i];
    a.out = (float*)d_out; a.ws = (unsigned char*)d_ws;
#if MK_PER_PHASE
    for (int ph = 0; ph < NPHASE; ++ph) { a.ph_lo = ph; a.ph_hi = ph + 1; hipLaunchKernelGGL(hybrid_fwd, dim3(grid), dim3(NWAVES * 64), LDS_BYTES, stream, a); }
#else
    a.ph_lo = 0; a.ph_hi = NPHASE;
    void* kargs[] = {&a};
    hipError_t e = hipLaunchCooperativeKernel((const void*)hybrid_fwd, dim3(grid), dim3(NWAVES * 64), kargs, LDS_BYTES, stream);
    if (e != hipSuccess) fprintf(stderr, "kernel_launch: cooperative launch failed: %s (grid %d)\n", hipGetErrorString(e), grid);
#endif
}
```
